# Optimizing an MI355X kernel written in HIP

```python
import jax, jax.numpy as jnp
from jax import lax
import numpy as np

D_MODEL = 1024
BATCH = 8
SEQ = 4096
DEPTH = 4

HEAD_DIM = 64
HG_HEADS = 4
HG_KEY = 64
HG_VAL = 64
SB_HEADS = 6
FOX_HEADS = 6
HG_KW = HG_HEADS * HG_KEY
HG_WIDTH = HG_HEADS * HG_VAL
SB_WIDTH = SB_HEADS * HEAD_DIM
FOX_WIDTH = FOX_HEADS * HEAD_DIM
MIX_WIDTH = HG_WIDTH + SB_WIDTH + FOX_WIDTH
SPLIT_SIZES = (HG_KW, HG_KW, HG_WIDTH, HG_WIDTH, SB_WIDTH, SB_WIDTH, SB_WIDTH,
               FOX_WIDTH, FOX_WIDTH, FOX_WIDTH, FOX_HEADS)
IN_COLS = sum(SPLIT_SIZES)
D_FF = 4 * D_MODEL
HG_CHUNK = 64
BLOCK_Q = 128
EPS = 1e-6
LB_FLOOR = 1e-30
NEG_BIG = -1e30

kernel_name = "hybrid_hgrn2_stickbreak_fox_block"


def rms_norm(x, g):
    x32 = x.astype(jnp.float32)
    y = x32 * lax.rsqrt(jnp.mean(x32 * x32, axis=-1, keepdims=True) + EPS)
    return y * g.astype(jnp.float32)


def hgrn2_mixer(q, f_logit, i, g, lb, norm_g):
    B, T, _ = q.shape
    dt = i.dtype
    C, H, N = HG_CHUNK, HG_HEADS, T // HG_CHUNK
    lb = lb.astype(jnp.float32)
    fl = f_logit.astype(jnp.float32)
    log_f = jnp.logaddexp(jax.nn.log_sigmoid(fl),
                          jnp.log(jnp.maximum(lb, LB_FLOOR)) + jax.nn.log_sigmoid(-fl))
    k = (1.0 - lb) * jax.nn.sigmoid(-fl)

    def to_chunks(a, d):
        return a.astype(jnp.float32).reshape(B, N, C, H, d).transpose(1, 0, 3, 2, 4)

    xs = (to_chunks(q, HG_KEY), to_chunks(k, HG_KEY), to_chunks(i, HG_VAL), to_chunks(log_f, HG_KEY))
    causal = jnp.tril(jnp.ones((C, C), bool))[None, None, :, :, None]

    def step(S, inp):
        qc, kc, vc, lfc = inp
        b = jnp.cumsum(lfc, axis=2)
        diff = b[:, :, :, None, :] - b[:, :, None, :, :]
        decay = jnp.where(causal, jnp.exp(jnp.where(causal, diff, 0.0)), 0.0)
        A = jnp.einsum('bhtk,bhsk,bhtsk->bhts', qc, kc, decay)
        o = (jnp.einsum('bhtk,bhkv->bhtv', qc * jnp.exp(b), S)
             + jnp.einsum('bhts,bhsv->bhtv', A, vc))
        b_end = b[:, :, -1:, :]
        S_new = (jnp.exp(b_end[:, :, 0, :])[..., None] * S
                 + jnp.einsum('bhsk,bhsv->bhkv', kc * jnp.exp(b_end - b), vc))
        return S_new, o

    S0 = jnp.zeros((B, H, HG_KEY, HG_VAL), jnp.float32)
    _, o = lax.scan(step, S0, xs)
    o = o.transpose(1, 0, 3, 2, 4).reshape(B, T, H, HG_VAL)
    o = rms_norm(o, norm_g).reshape(B, T, HG_WIDTH).astype(dt)
    return o * jax.nn.silu(g)


def to_heads(a, n):
    B, T, _ = a.shape
    return a.reshape(B, T, n, HEAD_DIM).transpose(0, 2, 1, 3)


def from_blocks(o):
    nb, B, H, Q, D = o.shape
    return o.transpose(1, 0, 3, 2, 4).reshape(B, nb * Q, H * D)


def stick_breaking_attn(q, k, v):
    B, H, T, D = q.shape
    nb = T // BLOCK_Q
    scale = jnp.float32(1.0 / np.sqrt(HEAD_DIM))
    qb = q.reshape(B, H, nb, BLOCK_Q, D).transpose(2, 0, 1, 3, 4)
    kpos = jnp.arange(T)

    def block(args):
        qi, idx = args
        qpos = idx * BLOCK_Q + jnp.arange(BLOCK_Q)
        z = jnp.einsum('bhqd,bhsd->bhqs', qi, k) * scale
        mask = kpos[None, :] < qpos[:, None]
        log_1mb = jnp.where(mask, jax.nn.log_sigmoid(-z), 0.0)
        tail = lax.cumsum(log_1mb, axis=3, reverse=True) - log_1mb
        A = jnp.where(mask, jnp.exp(jnp.where(mask, jax.nn.log_sigmoid(z) + tail, 0.0)), 0.0)
        return jnp.einsum('bhqs,bhsd->bhqd', A.astype(v.dtype), v)

    return from_blocks(lax.map(block, (qb, jnp.arange(nb))))


def forgetting_attn(q, k, v, c):
    B, H, T, D = q.shape
    nb = T // BLOCK_Q
    scale = jnp.float32(1.0 / np.sqrt(HEAD_DIM))
    qb = q.reshape(B, H, nb, BLOCK_Q, D).transpose(2, 0, 1, 3, 4)
    cb = c.reshape(B, H, nb, BLOCK_Q).transpose(2, 0, 1, 3)
    kpos = jnp.arange(T)

    def block(args):
        qi, ci, idx = args
        qpos = idx * BLOCK_Q + jnp.arange(BLOCK_Q)
        mask = kpos[None, :] <= qpos[:, None]
        bias = jnp.where(mask, ci[..., :, None] - c[..., None, :], 0.0)
        s = jnp.einsum('bhqd,bhsd->bhqs', qi, k) * scale + bias
        p = jax.nn.softmax(jnp.where(mask, s, NEG_BIG), axis=-1)
        return jnp.einsum('bhqs,bhsd->bhqd', p.astype(v.dtype), v)

    return from_blocks(lax.map(block, (qb, cb, jnp.arange(nb))))


def setup_inputs(seed: int = 0) -> dict:
    key = jax.random.key(seed)
    ks = jax.random.split(key, 16)
    f32 = jnp.float32
    nrm = lambda k, shape, s: jax.random.normal(k, shape, f32) * s
    return {
        "x": jax.random.normal(ks[0], (BATCH, SEQ, D_MODEL), f32),
        "lb_logits": nrm(ks[1], (DEPTH, HG_KW), 0.1),
        "norm1_g": 1.0 + nrm(ks[2], (DEPTH, D_MODEL), 0.02),
        "w_in": nrm(ks[3], (DEPTH, D_MODEL, IN_COLS), D_MODEL ** -0.5),
        "hg_norm_g": 1.0 + nrm(ks[4], (DEPTH, HG_VAL), 0.02),
        "sb_q_norm_g": 1.0 + nrm(ks[5], (DEPTH, HEAD_DIM), 0.02),
        "sb_k_norm_g": 1.0 + nrm(ks[6], (DEPTH, HEAD_DIM), 0.02),
        "fox_q_norm_g": 1.0 + nrm(ks[7], (DEPTH, HEAD_DIM), 0.02),
        "fox_k_norm_g": 1.0 + nrm(ks[8], (DEPTH, HEAD_DIM), 0.02),
        "fox_f_bias": 3.0 + nrm(ks[9], (DEPTH, FOX_HEADS), 0.1),
        "w_out": nrm(ks[10], (DEPTH, MIX_WIDTH, D_MODEL), MIX_WIDTH ** -0.5),
        "norm2_g": 1.0 + nrm(ks[11], (DEPTH, D_MODEL), 0.02),
        "w_ff1": nrm(ks[12], (DEPTH, D_MODEL, D_FF), D_MODEL ** -0.5),
        "w_ff2": nrm(ks[13], (DEPTH, D_FF, D_MODEL), D_FF ** -0.5),
    }


def reference(x, lb_logits, norm1_g, w_in, hg_norm_g, sb_q_norm_g, sb_k_norm_g,
              fox_q_norm_g, fox_k_norm_g, fox_f_bias, w_out, norm2_g, w_ff1, w_ff2):
    dt = x.dtype
    p_lb = jax.nn.softmax(lb_logits.astype(jnp.float32), axis=0)
    lower_bounds = jnp.cumsum(p_lb, axis=0) - p_lb[0:1]
    offsets = [int(o) for o in np.cumsum(SPLIT_SIZES)[:-1]]

    for l in range(DEPTH):
        h = rms_norm(x, norm1_g[l]).astype(dt)
        proj = h @ w_in[l]
        (hq, hf, hi, hg, sq, sk, sv, fq, fk, fv, ff) = jnp.split(proj, offsets, axis=-1)

        o_hg = hgrn2_mixer(hq, hf, hi, hg, lower_bounds[l], hg_norm_g[l])

        o_sb = stick_breaking_attn(rms_norm(to_heads(sq, SB_HEADS), sb_q_norm_g[l]),
                                   rms_norm(to_heads(sk, SB_HEADS), sb_k_norm_g[l]),
                                   to_heads(sv, SB_HEADS)).astype(dt)

        log_fg = jax.nn.log_sigmoid(ff.astype(jnp.float32) + fox_f_bias[l].astype(jnp.float32))
        c = jnp.cumsum(log_fg, axis=1).transpose(0, 2, 1)
        o_fox = forgetting_attn(rms_norm(to_heads(fq, FOX_HEADS), fox_q_norm_g[l]),
                                rms_norm(to_heads(fk, FOX_HEADS), fox_k_norm_g[l]),
                                to_heads(fv, FOX_HEADS), c).astype(dt)

        mix = jnp.concatenate([o_hg, o_sb, o_fox], axis=-1)
        x = x + mix @ w_out[l]

        h2 = rms_norm(x, norm2_g[l]).astype(dt)
        x = x + jnp.square(jax.nn.relu(h2 @ w_ff1[l])) @ w_ff2[l]
    return x
```

```cpp
#include <hip/hip_runtime.h>
#include <hip/hip_cooperative_groups.h>
#include <cstdio>
#include <cstdint>
namespace cg = cooperative_groups;
namespace pg8 {
#define PG8_LAS __attribute__((address_space(3)))
typedef unsigned short bf16_t;
typedef short bf16x8 __attribute__((ext_vector_type(8)));
typedef float f32x4 __attribute__((ext_vector_type(4)));
typedef unsigned u32x4 __attribute__((ext_vector_type(4)));
constexpr int BM = 256, BK = 64, HALF = 128, HTB = HALF * BK * 2  , STAGE_BYTES = 8 * HTB, NXCD = 8, WGM = 8;

__host__ __device__ __forceinline__ int lds_byte(int r, int c) { const int st = (r >> 4) * 2 + (c >> 5), rr = r & 15, cc = c & 31, ob = rr * 64 + cc * 2; return st * 1024 + (ob ^ (((ob >> 9) & 1) << 5)); }
__host__ __device__ __forceinline__ void stage_rc(int b, int& R, int& C) { const int st = b / 1024, sb = b % 1024, swz = sb ^ (((sb >> 9) & 1) << 5); R = (st >> 1) * 16 + swz / 64; C = (st & 1) * 32 + (swz % 64) / 2; }
__host__ __device__ __forceinline__ int perm32(int rho) { const int n = rho >> 4, i = rho & 15; return 8 * (i >> 2) + 4 * n + (i & 3); }

struct Unit { int pm, pn; };
struct Gemm { const bf16_t* A; const bf16_t* Bt; int M, N, K; };

struct StaticOrder {
    int nM, nN, nwg, G, c;
    __host__ __device__ void init(int M, int N, int G_, int c_) { nM = M / BM; nN = N / BM; nwg = nM * nN; G = G_; c = c_; }
    __host__ __device__ bool next(int i, Unit& u) const {
        const long L = (long)i * G + c; if (L >= nwg) return false;
        int wgid = (int)L; { const int q = nwg / NXCD, r = nwg % NXCD, xcd = wgid % NXCD, off = wgid / NXCD; wgid = (xcd < r ? xcd * (q + 1) : r * (q + 1) + (xcd - r) * q) + off; }
        const int nig = WGM * nN, gid = wgid / nig, fm = gid * WGM, gsz = (nM - fm) < WGM ? (nM - fm) : WGM;
        u.pm = fm + ((wgid % nig) % gsz); u.pn = (wgid % nig) / gsz; return true;
    }
    __device__ __forceinline__ void a_ready(const Unit&) const {}
    __device__ __forceinline__ void done(const Unit&) const {}
};

__device__ __forceinline__ unsigned cvt_pk_bf16(float lo, float hi) { unsigned r; asm volatile("v_cvt_pk_bf16_f32 %0, %1, %2" : "=v"(r) : "v"(lo), "v"(hi)); return r; }
typedef float f32x2 __attribute__((ext_vector_type(2)));
template <class Epi, class Sched, bool ALIGN_EPI = false, bool SP2 = false>
__device__ __forceinline__ void gemm_phase(PG8_LAS unsigned char* lds, const Gemm g, const Sched& S, const Epi& E) {
    int tid_ = threadIdx.x; asm volatile("" : "+v"(tid_));
    const int tid = tid_, wid = __builtin_amdgcn_readfirstlane(tid >> 6), lane = tid & 63, wr = wid >> 2, wc = wid & 3, fr = lane & 15, fq = lane >> 4;
    const int K = g.K, nt = K / BK;
    unsigned voffA[2], voffB[2];
#pragma unroll
    for (int i = 0; i < 2; ++i) { int R, C; stage_rc(tid * 16 + i * 8192, R, C); const int Rb = Epi::PERM ? ((R & ~31) + perm32(R & 31)) : R;
        voffA[i] = (unsigned)(R * K + C) * 2u; voffB[i] = (unsigned)(Rb * K + C) * 2u; }
    const size_t kstep = (size_t)(BK * 2);
    const size_t hstep = (size_t)HALF * K * 2;
    const size_t tstep = 2 * hstep;
    const unsigned ldsw = (unsigned)wid * 1024u;
    const int aoff = lds_byte(wr * 64 + fr, fq * 8), boff = lds_byte(wc * 32 + fr, fq * 8);
#define PG8_SA(b, h) (((b) * 2 + (h)) * HTB)
#define PG8_SB(b, h) ((4 + (b) * 2 + (h)) * HTB)
#define PG8_STAGE(bufoff, gbase, voff) do { _Pragma("unroll") for (int _i = 0; _i < 2; ++_i) \
        __builtin_amdgcn_global_load_lds((const unsigned*)((const char*)(gbase) + (voff)[_i]), (PG8_LAS unsigned*)(lds + (bufoff) + ldsw + _i * 8192), 16, 0, 0); } while (0)
#define PG8_LDA(dst, b, h) do { _Pragma("unroll") for (int m = 0; m < 4; ++m) _Pragma("unroll") for (int k = 0; k < 2; ++k) dst[m][k] = *(const PG8_LAS bf16x8*)(lds + PG8_SA(b, h) + aoff + m * 2048 + k * 1024); } while (0)
#define PG8_LDB(dst, b, h) do { _Pragma("unroll") for (int n = 0; n < 2; ++n) _Pragma("unroll") for (int k = 0; k < 2; ++k) dst[n][k] = *(const PG8_LAS bf16x8*)(lds + PG8_SB(b, h) + boff + n * 2048 + k * 1024); } while (0)
#define PG8_MMA(ai, bj, At, Bt) do { __builtin_amdgcn_s_setprio(1); _Pragma("unroll") for (int m = 0; m < 4; ++m) _Pragma("unroll") for (int n = 0; n < 2; ++n) _Pragma("unroll") for (int k = 0; k < 2; ++k) \
        acc[ai][bj][m][n] = __builtin_amdgcn_mfma_f32_16x16x32_bf16(Bt[n][k], At[m][k], acc[ai][bj][m][n], 0, 0, 0); __builtin_amdgcn_s_setprio(0); } while (0)
#define PG8_WAIT_V(n) asm volatile("s_waitcnt vmcnt(" #n ")" ::: "memory")
#define PG8_WAIT_L(n) asm volatile("s_waitcnt lgkmcnt(" #n ")" ::: "memory")
#define PG8_BAR __builtin_amdgcn_s_barrier()
#define PG8_SCHED __builtin_amdgcn_sched_barrier(0)
    Unit cur, nxt; int ui = 0;
    if (!S.next(0, cur)) return;
    f32x4 acc[2][2][4][2];
#pragma unroll
    for (int a = 0; a < 2; ++a)
#pragma unroll
        for (int b = 0; b < 2; ++b)
#pragma unroll
            for (int m = 0; m < 4; ++m)
#pragma unroll
                for (int n = 0; n < 2; ++n) acc[a][b][m][n] = (f32x4){0.f, 0.f, 0.f, 0.f};
    bf16x8 At[4][2], B0[2][2], B1[2][2];
    const char* cA = (const char*)g.A + (size_t)cur.pm * tstep; const char* cB = (const char*)g.Bt + (size_t)cur.pn * tstep;
    S.a_ready(cur);
    if constexpr (SP2) {
        PG8_STAGE(PG8_SB(0, 0), cB, voffB); PG8_STAGE(PG8_SB(0, 1), cB + hstep, voffB); PG8_STAGE(PG8_SA(0, 0), cA, voffA); PG8_STAGE(PG8_SA(0, 1), cA + hstep, voffA);
        if (wr == 1) PG8_BAR;
        PG8_WAIT_V(2); PG8_BAR;
        PG8_STAGE(PG8_SB(1, 0), cB + kstep, voffB); PG8_STAGE(PG8_SA(1, 0), cA + kstep, voffA); PG8_STAGE(PG8_SB(1, 1), cB + hstep + kstep, voffB);
        PG8_WAIT_V(6); PG8_BAR;
    } else {
        PG8_STAGE(PG8_SB(0, 0), cB, voffB); PG8_STAGE(PG8_SA(0, 0), cA, voffA); PG8_STAGE(PG8_SB(0, 1), cB + hstep, voffB); PG8_STAGE(PG8_SA(0, 1), cA + hstep, voffA);
        if (wr == 1) PG8_BAR;
        PG8_WAIT_V(4); PG8_BAR;
        PG8_STAGE(PG8_SB(1, 0), cB + kstep, voffB); PG8_STAGE(PG8_SA(1, 0), cA + kstep, voffA); PG8_STAGE(PG8_SB(1, 1), cB + hstep + kstep, voffB);
        PG8_WAIT_V(6); PG8_BAR;
    }
    for (;;) {
        const bool has_next = S.next(ui + 1, nxt);
        const char* nA = has_next ? (const char*)g.A + (size_t)nxt.pm * tstep : cA; const char* nB = has_next ? (const char*)g.Bt + (size_t)nxt.pn * tstep : cB;
        for (int t = 0; t < nt; t += 2) {
            const bool last = (t == nt - 2);
            const char* a1 = cA + (size_t)(t + 1) * kstep;
            const char* a2 = last ? nA : cA + (size_t)(t + 2) * kstep; const char* b2 = last ? nB : cB + (size_t)(t + 2) * kstep;
            const char* a3 = a2 + kstep; const char* b3 = b2 + kstep;
            if (last && has_next) S.a_ready(nxt);
            if constexpr (SP2) {
            PG8_LDB(B0, 0, 0); PG8_LDB(B1, 0, 1); PG8_SCHED; PG8_LDA(At, 0, 0); PG8_STAGE(PG8_SA(1, 1), a1 + hstep, voffA);
            PG8_WAIT_V(8); PG8_WAIT_L(0); PG8_BAR; PG8_MMA(0, 0, At, B0); PG8_MMA(0, 1, At, B1); PG8_BAR; PG8_SCHED;
            PG8_LDA(At, 0, 1); PG8_STAGE(PG8_SB(0, 0), b2, voffB); PG8_STAGE(PG8_SB(0, 1), b2 + hstep, voffB); PG8_STAGE(PG8_SA(0, 0), a2, voffA);
            PG8_WAIT_V(8); PG8_WAIT_L(0); PG8_BAR; PG8_MMA(1, 0, At, B0); PG8_MMA(1, 1, At, B1); PG8_BAR; PG8_SCHED;
            PG8_LDB(B0, 1, 0); PG8_LDB(B1, 1, 1); PG8_SCHED; PG8_LDA(At, 1, 0); PG8_STAGE(PG8_SA(0, 1), a2 + hstep, voffA);
            PG8_WAIT_V(8); PG8_WAIT_L(0); PG8_BAR; PG8_MMA(0, 0, At, B0); PG8_MMA(0, 1, At, B1); PG8_BAR; PG8_SCHED;
            PG8_LDA(At, 1, 1); PG8_STAGE(PG8_SB(1, 0), b3, voffB); PG8_STAGE(PG8_SB(1, 1), b3 + hstep, voffB); PG8_STAGE(PG8_SA(1, 0), a3, voffA);
            PG8_WAIT_V(8); PG8_WAIT_L(0); PG8_BAR; PG8_MMA(1, 0, At, B0); PG8_MMA(1, 1, At, B1); PG8_BAR; PG8_SCHED;
            } else {
            PG8_LDB(B0, 0, 0); PG8_SCHED; PG8_LDA(At, 0, 0); PG8_STAGE(PG8_SA(1, 1), a1 + hstep, voffA);
            PG8_WAIT_L(8); PG8_BAR; PG8_WAIT_L(0); PG8_MMA(0, 0, At, B0); PG8_BAR; PG8_SCHED;
            PG8_LDB(B1, 0, 1); PG8_STAGE(PG8_SB(0, 0), b2, voffB);
            PG8_BAR; PG8_WAIT_L(0); PG8_MMA(0, 1, At, B1); PG8_BAR;
            PG8_LDA(At, 0, 1); PG8_STAGE(PG8_SA(0, 0), a2, voffA);
            PG8_BAR; PG8_WAIT_L(0); PG8_MMA(1, 0, At, B0); PG8_BAR; PG8_SCHED;
            PG8_STAGE(PG8_SB(0, 1), b2 + hstep, voffB);
            PG8_WAIT_V(6); PG8_BAR; PG8_MMA(1, 1, At, B1); PG8_BAR;
            PG8_LDB(B0, 1, 0); PG8_SCHED; PG8_LDA(At, 1, 0); PG8_STAGE(PG8_SA(0, 1), a2 + hstep, voffA);
            PG8_WAIT_L(8); PG8_BAR; PG8_WAIT_L(0); PG8_MMA(0, 0, At, B0); PG8_BAR; PG8_SCHED;
            PG8_LDB(B1, 1, 1); PG8_STAGE(PG8_SB(1, 0), b3, voffB);
            PG8_BAR; PG8_WAIT_L(0); PG8_MMA(0, 1, At, B1); PG8_BAR;
            PG8_LDA(At, 1, 1); PG8_STAGE(PG8_SA(1, 0), a3, voffA);
            PG8_BAR; PG8_WAIT_L(0); PG8_MMA(1, 0, At, B0); PG8_BAR; PG8_SCHED;
            PG8_STAGE(PG8_SB(1, 1), b3 + hstep, voffB);
            PG8_WAIT_V(6); PG8_BAR; PG8_MMA(1, 1, At, B1); PG8_BAR;
            }
        }
        if constexpr (ALIGN_EPI) { if (wr == 0) PG8_BAR; }
        if constexpr (!Epi::AFTER_DRAIN) { E(acc, cur, wr, wc, fr, fq); S.done(cur); }
        if (!has_next) break;
#pragma unroll
        for (int a = 0; a < 2; ++a)
#pragma unroll
            for (int b = 0; b < 2; ++b)
#pragma unroll
                for (int m = 0; m < 4; ++m)
#pragma unroll
                    for (int n = 0; n < 2; ++n) acc[a][b][m][n] = (f32x4){0.f, 0.f, 0.f, 0.f};
        cur = nxt; cA = nA; cB = nB; ++ui;
        if constexpr (ALIGN_EPI) { if (wr == 1) PG8_BAR; }
    }
    PG8_WAIT_V(0);
    if constexpr (!ALIGN_EPI) { if (wr == 0) PG8_BAR; }
    PG8_BAR;
    if constexpr (Epi::AFTER_DRAIN) { E.fused(acc, cur, wr, wc, fr, fq, lds, wid, lane); S.done(cur); }
#undef PG8_SA
#undef PG8_SB
#undef PG8_STAGE
#undef PG8_LDA
#undef PG8_LDB
#undef PG8_MMA
#undef PG8_WAIT_V
#undef PG8_WAIT_L
#undef PG8_BAR
#undef PG8_SCHED
}
}

constexpr int BATCH = 8, SEQ = 4096, DM = 1024, DEPTH = 4, M = BATCH * SEQ, INC = 3334, NIN = 3584, DFF = 4096;
constexpr float EPS = 1e-6f;
constexpr size_t MiB = 1u << 20;
constexpr size_t WS_SS = 1 * MiB;
constexpr size_t WS_LB = 3 * MiB;
constexpr size_t WS_W = 4 * MiB;
constexpr size_t W_LAYER = 25 * MiB, W_OUT = 7 * MiB, W_1 = 9 * MiB, W_2 = 17 * MiB;
constexpr size_t WS_XB = 104 * MiB;
constexpr size_t WS_P = 168 * MiB;
constexpr size_t P_HQ = 0, P_HK = 16 * MiB, P_HI = 32 * MiB, P_HG = 48 * MiB, P_HLF = 64 * MiB, P_SQ = 96 * MiB, P_FQ = 168 * MiB, P_LF = 240 * MiB, P_CC = 241 * MiB, P_US = 242 * MiB;
constexpr size_t HEADBUF = 24 * MiB;
constexpr size_t WS_MIX = 426 * MiB;
constexpr size_t WS_U = 168 * MiB;
constexpr size_t WS_END = 490 * MiB;
constexpr int LDS_BYTES = 147456;

typedef pg8::bf16_t bf16_t;
typedef pg8::f32x4 f32x4;
typedef unsigned u32x4 __attribute__((ext_vector_type(4)));
typedef unsigned u32x2 __attribute__((ext_vector_type(2)));
#define LAS __attribute__((address_space(3)))

__device__ __forceinline__ unsigned f2bf(float f) { unsigned u = __builtin_bit_cast(unsigned, f); return (u + 0x7fffu + ((u >> 16) & 1u)) >> 16; }
__device__ __forceinline__ unsigned pk2(float lo, float hi) { return pg8::cvt_pk_bf16(lo, hi); }
__device__ __forceinline__ float bf2f(unsigned short b) { return __builtin_bit_cast(float, (unsigned)b << 16); }
__device__ __forceinline__ float bflo(unsigned w) { return __builtin_bit_cast(float, w << 16); }
__device__ __forceinline__ float bfhi(unsigned w) { return __builtin_bit_cast(float, w & 0xffff0000u); }
__device__ __forceinline__ float logsig(float x) { return fminf(x, 0.f) - log1pf(expf(-fabsf(x))); }
__device__ __forceinline__ float wave_sum(float v) {
#pragma unroll
    for (int o = 1; o < 64; o <<= 1) v += __shfl_xor(v, o);
    return v;
}
__device__ __forceinline__ float rowscale(const float* ss, int row, int fq) {
    const f32x4 p = *(const f32x4*)(ss + (size_t)row * 16 + 4 * fq);
    float s = (p[0] + p[1]) + (p[2] + p[3]);
    s += __shfl_xor(s, 16); s += __shfl_xor(s, 32);
    return rsqrtf(s * (1.0f / DM) + EPS);
}

#define ROWFENCE() asm volatile("" ::: "memory")
struct EpiResid {
    static constexpr bool PERM = true, AFTER_DRAIN = false;
    const float* xold; float* xnew; bf16_t* xb; float* ss;
    __device__ __forceinline__ void operator()(const f32x4 (&acc)[2][2][4][2], const pg8::Unit& u, int wr, int wc, int fr, int fq) const {
        const int row0 = u.pm * 256 + wr * 64 + fr, col0 = u.pn * 256 + wc * 32 + 8 * fq;
#pragma unroll
        for (int ai = 0; ai < 2; ++ai)
#pragma unroll
            for (int m = 0; m < 4; ++m) {
                const int row = row0 + ai * 128 + m * 16; float sq = 0.f;
#pragma unroll
                for (int bj = 0; bj < 2; ++bj) {
                    const size_t off = (size_t)row * DM + col0 + bj * 128;
                    const f32x4 o0 = *(const f32x4*)(xold + off), o1 = *(const f32x4*)(xold + off + 4);
                    const f32x4 v0 = acc[ai][bj][m][0] + o0, v1 = acc[ai][bj][m][1] + o1;
                    *(f32x4*)(xnew + off) = v0; *(f32x4*)(xnew + off + 4) = v1;
                    u32x4 w; w.x = pk2(v0[0], v0[1]); w.y = pk2(v0[2], v0[3]); w.z = pk2(v1[0], v1[1]); w.w = pk2(v1[2], v1[3]);
                    *(u32x4*)(xb + off) = w;
                    sq += (v0[0] * v0[0] + v0[1] * v0[1]) + (v0[2] * v0[2] + v0[3] * v0[3]) + (v1[0] * v1[0] + v1[1] * v1[1]) + (v1[2] * v1[2] + v1[3] * v1[3]);
                }
                sq += __shfl_xor(sq, 16); sq += __shfl_xor(sq, 32);
                if (fq == 0) ss[(size_t)row * 16 + u.pn * 4 + wc] = sq;
                ROWFENCE();
            }
    }
};
struct EpiRelu2 {
    static constexpr bool PERM = true, AFTER_DRAIN = false;
    bf16_t* U; const float* ss;
    __device__ __forceinline__ void operator()(const f32x4 (&acc)[2][2][4][2], const pg8::Unit& u, int wr, int wc, int fr, int fq) const {
        const int row0 = u.pm * 256 + wr * 64 + fr, col0 = u.pn * 256 + wc * 32 + 8 * fq;
#pragma unroll
        for (int ai = 0; ai < 2; ++ai)
#pragma unroll
            for (int m = 0; m < 4; ++m) {
                const int row = row0 + ai * 128 + m * 16; const float rs = rowscale(ss, row, fq);
#pragma unroll
                for (int bj = 0; bj < 2; ++bj) {
                    f32x4 v0 = acc[ai][bj][m][0] * rs, v1 = acc[ai][bj][m][1] * rs;
                    v0 = __builtin_elementwise_max(v0, (f32x4){0.f, 0.f, 0.f, 0.f}); v1 = __builtin_elementwise_max(v1, (f32x4){0.f, 0.f, 0.f, 0.f});
                    v0 = v0 * v0; v1 = v1 * v1;
                    u32x4 w; w.x = pk2(v0[0], v0[1]); w.y = pk2(v0[2], v0[3]); w.z = pk2(v1[0], v1[1]); w.w = pk2(v1[2], v1[3]);
                    *(u32x4*)(U + (size_t)row * DFF + col0 + bj * 128) = w;
                }
                ROWFENCE();
            }
    }
};
struct EpiInProj {
    static constexpr bool PERM = true, AFTER_DRAIN = false;
    const float* ss; unsigned char* P; const float* lbt;
    const float* gt; const float* fbias;
    __device__ __forceinline__ void operator()(const f32x4 (&acc)[2][2][4][2], const pg8::Unit& u, int wr, int wc, int fr, int fq) const {
        const int slot = u.pn * 4 + wc;
        if (slot > 52) return;
        const int row0 = u.pm * 256 + wr * 64 + fr;
        if (slot < 16) {
            const int kind = slot >> 2, cb = (slot & 3) * 64 + 8 * fq;
            if (kind == 1) {
                float* HLF = (float*)(P + P_HLF); bf16_t* HK = (bf16_t*)(P + P_HK);
#pragma unroll
                for (int ai = 0; ai < 2; ++ai)
#pragma unroll
                    for (int m = 0; m < 4; ++m) {
                        const int row = row0 + ai * 128 + m * 16; const float rs = rowscale(ss, row, fq);
#pragma unroll
                        for (int bj = 0; bj < 2; ++bj) {
                            float lf[8], kk[8];
#pragma unroll
                            for (int n = 0; n < 2; ++n) {
                                const f32x4 ll = *(const f32x4*)(lbt + cb + 32 * bj + 4 * n), om = *(const f32x4*)(lbt + 256 + cb + 32 * bj + 4 * n);
#pragma unroll
                                for (int i = 0; i < 4; ++i) {
                                    const float fl = acc[ai][bj][m][n][i] * rs;
                                    const float a = fminf(fl, 0.f) - __logf(1.0f + __expf(-fabsf(fl)));
                                    const float an = a - fl;
                                    const float b = ll[i] + an;
                                    lf[4 * n + i] = fmaxf(a, b) + __logf(1.0f + __expf(-fabsf(a - b)));
                                    kk[4 * n + i] = om[i] * __expf(an);
                                }
                            }
                            const size_t off = (size_t)row * 256 + cb + 32 * bj;
                            *(f32x4*)(HLF + off) = (f32x4){lf[0], lf[1], lf[2], lf[3]}; *(f32x4*)(HLF + off + 4) = (f32x4){lf[4], lf[5], lf[6], lf[7]};
                            u32x4 w; w.x = pk2(kk[0], kk[1]); w.y = pk2(kk[2], kk[3]); w.z = pk2(kk[4], kk[5]); w.w = pk2(kk[6], kk[7]);
                            *(u32x4*)(HK + off) = w;
                        }
                        ROWFENCE();
                    }
            } else {
                bf16_t* dst = (bf16_t*)(P + (kind == 0 ? P_HQ : (kind == 2 ? P_HI : P_HG)));
#pragma unroll
                for (int ai = 0; ai < 2; ++ai)
#pragma unroll
                    for (int m = 0; m < 4; ++m) {
                        const int row = row0 + ai * 128 + m * 16; const float rs = rowscale(ss, row, fq);
#pragma unroll
                        for (int bj = 0; bj < 2; ++bj) {
                            const f32x4 v0 = acc[ai][bj][m][0] * rs, v1 = acc[ai][bj][m][1] * rs;
                            u32x4 w; w.x = pk2(v0[0], v0[1]); w.y = pk2(v0[2], v0[3]); w.z = pk2(v1[0], v1[1]); w.w = pk2(v1[2], v1[3]);
                            *(u32x4*)(dst + (size_t)row * 256 + cb + 32 * bj) = w;
                        }
                        ROWFENCE();
                    }
            }
        } else if (slot < 52) {
            const int s2 = slot - 16, grp = s2 / 6, h = s2 % 6, role = grp % 3;
            bf16_t* dst = (bf16_t*)(P + P_SQ + (size_t)grp * HEADBUF) + (size_t)((u.pm >> 4) * 6 + h) * SEQ * 64 + 8 * fq;
            const float* gp = gt + (grp - (grp >= 3 ? 1 : 0)) * 64 + 8 * fq;
            const float qs = (role == 0) ? 0.125f : 1.0f;
#pragma unroll
            for (int ai = 0; ai < 2; ++ai)
#pragma unroll
                for (int m = 0; m < 4; ++m) {
                    const int row = row0 + ai * 128 + m * 16; const float rs = rowscale(ss, row, fq);
                    float fac = rs;
                    if (role != 2) {
                        float sq = 0.f;
#pragma unroll
                        for (int bj = 0; bj < 2; ++bj)
#pragma unroll
                            for (int n = 0; n < 2; ++n) { const f32x4 x = acc[ai][bj][m][n]; sq += (x[0] * x[0] + x[1] * x[1]) + (x[2] * x[2] + x[3] * x[3]); }
                        sq += __shfl_xor(sq, 16); sq += __shfl_xor(sq, 32);
                        fac = rs * rsqrtf(rs * rs * sq * (1.0f / 64.0f) + EPS) * qs;
                    }
                    const int t = row & (SEQ - 1);
#pragma unroll
                    for (int bj = 0; bj < 2; ++bj) {
                        f32x4 v0 = acc[ai][bj][m][0] * fac, v1 = acc[ai][bj][m][1] * fac;
                        if (role != 2) { v0 = v0 * *(const f32x4*)(gp + 32 * bj); v1 = v1 * *(const f32x4*)(gp + 32 * bj + 4); }
                        u32x4 w; w.x = pk2(v0[0], v0[1]); w.y = pk2(v0[2], v0[3]); w.z = pk2(v1[0], v1[1]); w.w = pk2(v1[2], v1[3]);
                        *(u32x4*)(dst + (size_t)t * 64 + 32 * bj) = w;
                    }
                    ROWFENCE();
                }
        } else {
            float* LF = (float*)(P + P_LF);
#pragma unroll
            for (int ai = 0; ai < 2; ++ai)
#pragma unroll
                for (int m = 0; m < 4; ++m) {
                    const int row = row0 + ai * 128 + m * 16; const float rs = rowscale(ss, row, fq);
                    if (fq == 0) {
                        const f32x4 a0 = acc[ai][0][m][0], a1 = acc[ai][0][m][1];
                        *(f32x4*)(LF + (size_t)row * 8) = (f32x4){logsig(a0[0] * rs + fbias[0]), logsig(a0[1] * rs + fbias[1]), logsig(a0[2] * rs + fbias[2]), logsig(a0[3] * rs + fbias[3])};
                        *(f32x4*)(LF + (size_t)row * 8 + 4) = (f32x4){logsig(a1[0] * rs + fbias[4]), logsig(a1[1] * rs + fbias[5]), 0.f, 0.f};
                    }
                    ROWFENCE();
                }
        }
    }
};

__device__ __forceinline__ void tr_item(const float* W, int ldw, int ncols_valid, int src_col0, int k0, const float* gain, bf16_t* WT, int K, int n0, LAS float* scr, int lane) {
#pragma unroll 8
    for (int i = 0; i < 32; ++i) { const int kk = 2 * i + (lane >> 5), c = src_col0 + (lane & 31);
        float v = (c < ncols_valid) ? W[(size_t)(k0 + kk) * ldw + c] : 0.f; if (gain) v *= gain[k0 + kk]; scr[kk * 33 + (lane & 31)] = v; }
    asm volatile("s_waitcnt lgkmcnt(0)" ::: "memory");
    const int c = lane & 7;
#pragma unroll
    for (int j = 0; j < 4; ++j) { const int n = (lane >> 3) + 8 * j; const LAS float* s = scr + (8 * c) * 33 + n;
        u32x4 o; o.x = pk2(s[0 * 33], s[1 * 33]); o.y = pk2(s[2 * 33], s[3 * 33]); o.z = pk2(s[4 * 33], s[5 * 33]); o.w = pk2(s[6 * 33], s[7 * 33]);
        *(u32x4*)(WT + (size_t)(n0 + n) * K + k0 + 8 * c) = o; }
    asm volatile("s_waitcnt lgkmcnt(0)" ::: "memory");
}

__device__ __forceinline__ void unpack8(const u32x4 w, float* d) { d[0] = bflo(w.x); d[1] = bfhi(w.x); d[2] = bflo(w.y); d[3] = bfhi(w.y); d[4] = bflo(w.z); d[5] = bfhi(w.z); d[6] = bflo(w.w); d[7] = bfhi(w.w); }

__device__ __forceinline__ void fox_cumsum_item(int bh, const float* LF, float* CC, LAS float* sc) {
    int tid_ = threadIdx.x; asm volatile("" : "+v"(tid_)); const int tid = tid_, lane = tid & 63, wave = tid >> 6, b = bh / 6, h = bh % 6;
    float v[8]; float run = 0.f;
#pragma unroll
    for (int i = 0; i < 8; ++i) { run += LF[((size_t)b * SEQ + tid * 8 + i) * 8 + h]; v[i] = run; }
    float s = run;
#pragma unroll
    for (int o = 1; o < 64; o <<= 1) { const float n = __shfl_up(s, o); if (lane >= o) s += n; }
    __syncthreads();
    if (lane == 63) sc[wave] = s;
    __syncthreads();
    float base = s - run;
    for (int w = 0; w < wave; ++w) base += sc[w];
#pragma unroll
    for (int i = 0; i < 8; ++i) CC[(size_t)bh * SEQ + tid * 8 + i] = v[i] + base;
}

__device__ __forceinline__ void stage_kv(const bf16_t* Kb, const bf16_t* Vb, int kt, LAS float* Kf, LAS float* Vf) {
    int tid_ = threadIdx.x; asm volatile("" : "+v"(tid_)); const int tid = tid_, key = tid >> 3, c8 = tid & 7;
    const u32x4 kw = *(const u32x4*)(Kb + ((size_t)(kt * 64 + key)) * 64 + c8 * 8), vw = *(const u32x4*)(Vb + ((size_t)(kt * 64 + key)) * 64 + c8 * 8);
    float kf[8], vf[8]; unpack8(kw, kf); unpack8(vw, vf);
    *(LAS f32x4*)(Kf + key * 64 + c8 * 8) = (f32x4){kf[0], kf[1], kf[2], kf[3]}; *(LAS f32x4*)(Kf + key * 64 + c8 * 8 + 4) = (f32x4){kf[4], kf[5], kf[6], kf[7]};
    *(LAS f32x4*)(Vf + key * 64 + c8 * 8) = (f32x4){vf[0], vf[1], vf[2], vf[3]}; *(LAS f32x4*)(Vf + key * 64 + c8 * 8 + 4) = (f32x4){vf[4], vf[5], vf[6], vf[7]};
}

__device__ __forceinline__ void fox_naive_item(int item, unsigned char* P, bf16_t* MIX, LAS float* lds) {
    int tid_ = threadIdx.x; asm volatile("" : "+v"(tid_)); const int tid = tid_, bh = item >> 3, qblk = item & 7, b = bh / 6, h = bh % 6, t = qblk * 512 + tid;
    const bf16_t* Qp = (const bf16_t*)(P + P_FQ) + ((size_t)bh * SEQ + t) * 64;
    const bf16_t* Kb = (const bf16_t*)(P + P_FQ + HEADBUF) + (size_t)bh * SEQ * 64;
    const bf16_t* Vb = (const bf16_t*)(P + P_FQ + 2 * HEADBUF) + (size_t)bh * SEQ * 64;
    const float* CC = (const float*)(P + P_CC) + (size_t)bh * SEQ;
    float q[64], o[64];
#pragma unroll
    for (int c = 0; c < 8; ++c) unpack8(*(const u32x4*)(Qp + c * 8), q + c * 8);
#pragma unroll
    for (int d = 0; d < 64; ++d) o[d] = 0.f;
    float m = -1e30f, l = 0.f; const float ct = CC[t];
    LAS float* Kf = lds; LAS float* Vf = lds + 4096; LAS float* cs = lds + 8192;
    const int ntile = (qblk + 1) * 8;
    for (int kt = 0; kt < ntile; ++kt) {
        __syncthreads();
        stage_kv(Kb, Vb, kt, Kf, Vf); if (tid < 64) cs[tid] = CC[kt * 64 + tid];
        __syncthreads();
        for (int s = 0; s < 64; ++s) {
            float z = 0.f;
#pragma unroll
            for (int d = 0; d < 64; ++d) z += q[d] * Kf[s * 64 + d];
            const float x = (kt * 64 + s <= t) ? z + (ct - cs[s]) : -1e30f;
            const float mn = fmaxf(m, x), sc = __expf(m - mn), p = __expf(x - mn);
            l = l * sc + p;
#pragma unroll
            for (int d = 0; d < 64; ++d) o[d] = o[d] * sc + p * Vf[s * 64 + d];
            m = mn;
        }
    }
    const float inv = 1.0f / l;
    bf16_t* op = MIX + ((size_t)b * SEQ + t) * DM + 640 + h * 64;
#pragma unroll
    for (int c = 0; c < 8; ++c) { u32x4 w; w.x = pk2(o[c * 8] * inv, o[c * 8 + 1] * inv); w.y = pk2(o[c * 8 + 2] * inv, o[c * 8 + 3] * inv); w.z = pk2(o[c * 8 + 4] * inv, o[c * 8 + 5] * inv); w.w = pk2(o[c * 8 + 6] * inv, o[c * 8 + 7] * inv); *(u32x4*)(op + c * 8) = w; }
}

__device__ __forceinline__ void sb_naive_item(int item, unsigned char* P, bf16_t* MIX, LAS float* lds) {
    int tid_ = threadIdx.x; asm volatile("" : "+v"(tid_)); const int tid = tid_, bh = item >> 3, qblk = item & 7, b = bh / 6, h = bh % 6, t = qblk * 512 + tid;
    const bf16_t* Qp = (const bf16_t*)(P + P_SQ) + ((size_t)bh * SEQ + t) * 64;
    const bf16_t* Kb = (const bf16_t*)(P + P_SQ + HEADBUF) + (size_t)bh * SEQ * 64;
    const bf16_t* Vb = (const bf16_t*)(P + P_SQ + 2 * HEADBUF) + (size_t)bh * SEQ * 64;
    float q[64], o[64];
#pragma unroll
    for (int c = 0; c < 8; ++c) unpack8(*(const u32x4*)(Qp + c * 8), q + c * 8);
#pragma unroll
    for (int d = 0; d < 64; ++d) o[d] = 0.f;
    float tail = 0.f;
    LAS float* Kf = lds; LAS float* Vf = lds + 4096;
    for (int kt = qblk * 8 + 7; kt >= 0; --kt) {
        __syncthreads();
        stage_kv(Kb, Vb, kt, Kf, Vf);
        __syncthreads();
        for (int s = 63; s >= 0; --s) {
            float z = 0.f;
#pragma unroll
            for (int d = 0; d < 64; ++d) z += q[d] * Kf[s * 64 + d];
            const float ls = fminf(z, 0.f) - __logf(1.0f + __expf(-fabsf(z)));
            const bool act = (kt * 64 + s) < t;
            const float A = act ? __expf(ls + tail) : 0.f;
#pragma unroll
            for (int d = 0; d < 64; ++d) o[d] += A * Vf[s * 64 + d];
            tail += act ? (ls - z) : 0.f;
        }
        if (__syncthreads_and(tail < -100.f)) break;
    }
    bf16_t* op = MIX + ((size_t)b * SEQ + t) * DM + 256 + h * 64;
#pragma unroll
    for (int c = 0; c < 8; ++c) { u32x4 w; w.x = pk2(o[c * 8], o[c * 8 + 1]); w.y = pk2(o[c * 8 + 2], o[c * 8 + 3]); w.z = pk2(o[c * 8 + 4], o[c * 8 + 5]); w.w = pk2(o[c * 8 + 6], o[c * 8 + 7]); *(u32x4*)(op + c * 8) = w; }
}

__device__ __forceinline__ void hgrn_naive_item(int item, unsigned char* P, bf16_t* MIX, const float* hgn, LAS float* lds) {
    int tid_ = threadIdx.x; asm volatile("" : "+v"(tid_)); const int tid = tid_, lane = tid & 63, w = tid >> 6, kg = lane >> 3, vi = lane & 7, vcol = 8 * w + vi, b = item >> 2, h = item & 3;
    const bf16_t* HQ = (const bf16_t*)(P + P_HQ); const bf16_t* HK = (const bf16_t*)(P + P_HK); const bf16_t* HI = (const bf16_t*)(P + P_HI); const bf16_t* HG = (const bf16_t*)(P + P_HG);
    const float* HLF = (const float*)(P + P_HLF);
    LAS float* qf = lds; LAS float* kf = lds + 4096; LAS float* ff = lds + 8192; LAS float* vf = lds + 12288; LAS float* ob = lds + 16384;
    float S[8];
#pragma unroll
    for (int j = 0; j < 8; ++j) S[j] = 0.f;
    const int tok = tid >> 3, c8 = tid & 7;
    float gn[8];
#pragma unroll
    for (int e = 0; e < 8; ++e) gn[e] = hgn[c8 * 8 + e];
    for (int c = 0; c < 64; ++c) {
        const size_t off = ((size_t)b * SEQ + c * 64 + tok) * 256 + h * 64 + c8 * 8;
        __syncthreads();
        {
            float a[8];
            unpack8(*(const u32x4*)(HQ + off), a);
#pragma unroll
            for (int e = 0; e < 8; ++e) qf[tok * 64 + c8 * 8 + e] = a[e];
            unpack8(*(const u32x4*)(HK + off), a);
#pragma unroll
            for (int e = 0; e < 8; ++e) kf[tok * 64 + c8 * 8 + e] = a[e];
            unpack8(*(const u32x4*)(HI + off), a);
#pragma unroll
            for (int e = 0; e < 8; ++e) vf[tok * 64 + c8 * 8 + e] = a[e];
            const f32x4 l0 = *(const f32x4*)(HLF + off), l1 = *(const f32x4*)(HLF + off + 4);
#pragma unroll
            for (int e = 0; e < 4; ++e) { ff[tok * 64 + c8 * 8 + e] = expf(l0[e]); ff[tok * 64 + c8 * 8 + 4 + e] = expf(l1[e]); }
        }
        __syncthreads();
        for (int tk = 0; tk < 64; ++tk) {
            const float vv = vf[tk * 64 + vcol]; float op = 0.f;
#pragma unroll
            for (int j = 0; j < 8; ++j) { const int k = 8 * kg + j; S[j] = ff[tk * 64 + k] * S[j] + kf[tk * 64 + k] * vv; op += qf[tk * 64 + k] * S[j]; }
            op += __shfl_xor(op, 8); op += __shfl_xor(op, 16); op += __shfl_xor(op, 32);
            if (kg == 0) ob[tk * 64 + vcol] = op;
        }
        __syncthreads();
        {
            float ov[8], g[8]; float sq = 0.f;
#pragma unroll
            for (int e = 0; e < 8; ++e) { ov[e] = ob[tok * 64 + c8 * 8 + e]; sq += ov[e] * ov[e]; }
            sq += __shfl_xor(sq, 1); sq += __shfl_xor(sq, 2); sq += __shfl_xor(sq, 4);
            const float rn = rsqrtf(sq * (1.0f / 64.0f) + EPS);
            unpack8(*(const u32x4*)(HG + off), g);
            float r[8];
#pragma unroll
            for (int e = 0; e < 8; ++e) r[e] = ov[e] * rn * gn[e] * (g[e] / (1.0f + expf(-g[e])));
            u32x4 wv; wv.x = pk2(r[0], r[1]); wv.y = pk2(r[2], r[3]); wv.z = pk2(r[4], r[5]); wv.w = pk2(r[6], r[7]);
            *(u32x4*)(MIX + ((size_t)b * SEQ + c * 64 + tok) * DM + h * 64 + c8 * 8) = wv;
        }
    }
}

struct Args { const float* in[14]; float* out; unsigned char* ws; int ph_lo, ph_hi; };
constexpr int NPHASE = 1 + 6 * DEPTH;

__global__ void __launch_bounds__(512, 2) fwd(Args a) {
    extern __shared__ __attribute__((aligned(16))) unsigned char lds[];
    cg::grid_group grid = cg::this_grid();
    LAS unsigned char* L = (LAS unsigned char*)lds;
    for (int ph = a.ph_lo; ph < a.ph_hi; ++ph) {
        int G = gridDim.x, bx = blockIdx.x; asm volatile("" : "+s"(G), "+s"(bx));
        typedef const __attribute__((address_space(4))) Args* KArgP;
        KArgP ap = (KArgP)__builtin_amdgcn_kernarg_segment_ptr(); asm volatile("" : "+s"(ap));
        unsigned char* ws = ap->ws;
        float* SS = (float*)(ws + WS_SS); float* LB = (float*)(ws + WS_LB);
        bf16_t* XB = (bf16_t*)(ws + WS_XB); bf16_t* MIX = (bf16_t*)(ws + WS_MIX); bf16_t* UB = (bf16_t*)(ws + WS_U);
        unsigned char* P = ws + WS_P;
        if (ph == 0) {
            int tid = threadIdx.x; asm volatile("" : "+v"(tid)); const int lane = tid & 63, wave = __builtin_amdgcn_readfirstlane(tid >> 6);
            LAS float* scr = (LAS float*)(L + wave * 16384);
            const int gw = bx * 8 + wave, NGW = G * 8;
            constexpr int I_IN = 16 * 112, I_OUT = 16 * 32, I_1 = 16 * 128, I_2 = 64 * 32, I_L = I_IN + I_OUT + I_1 + I_2;
            for (int it = gw; it < DEPTH * I_L; it += NGW) {
                const int l = it / I_L; int r = it % I_L;
                unsigned char* wl = ws + WS_W + (size_t)l * W_LAYER;
                if (r < I_IN) { const int kb = r / 112, nb = r % 112, n0 = nb * 32, pn = n0 >> 8, p = n0 & 255, slot = 4 * pn + ((p & 127) >> 5), sc0 = 64 * slot + 32 * (p >> 7);
                    tr_item(ap->in[3] + (size_t)l * DM * INC, INC, INC, sc0, kb * 64, ap->in[2] + l * DM, (bf16_t*)wl, DM, n0, scr, lane); continue; }
                r -= I_IN;
                if (r < I_OUT) { const int kb = r / 32, nb = r % 32; tr_item(ap->in[10] + (size_t)l * DM * DM, DM, DM, nb * 32, kb * 64, nullptr, (bf16_t*)(wl + W_OUT), DM, nb * 32, scr, lane); continue; }
                r -= I_OUT;
                if (r < I_1) { const int kb = r / 128, nb = r % 128; tr_item(ap->in[12] + (size_t)l * DM * DFF, DFF, DFF, nb * 32, kb * 64, ap->in[11] + l * DM, (bf16_t*)(wl + W_1), DM, nb * 32, scr, lane); continue; }
                r -= I_1;
                { const int kb = r / 32, nb = r % 32; tr_item(ap->in[13] + (size_t)l * DFF * DM, DM, DM, nb * 32, kb * 64, nullptr, (bf16_t*)(wl + W_2), DFF, nb * 32, scr, lane); }
            }
            const float* x = ap->in[0];
            for (int m = gw; m < M; m += NGW) {
                const f32x4* xr = (const f32x4*)(x + (size_t)m * DM) + lane; f32x4 v[4]; float s = 0.f;
#pragma unroll
                for (int j = 0; j < 4; ++j) { v[j] = xr[64 * j]; s += (v[j][0] * v[j][0] + v[j][1] * v[j][1]) + (v[j][2] * v[j][2] + v[j][3] * v[j][3]); }
                const float tot = wave_sum(s);
                u32x2* o8 = (u32x2*)(XB + (size_t)m * DM) + lane;
#pragma unroll
                for (int j = 0; j < 4; ++j) { u32x2 w; w.x = pk2(v[j][0], v[j][1]); w.y = pk2(v[j][2], v[j][3]); o8[64 * j] = w; }
                if (lane < 16) SS[(size_t)m * 16 + lane] = (lane == 0) ? tot : 0.f;
            }
            if (bx == 1) {
                for (int i = tid; i < 1024; i += 512) { const int l = i >> 8, wh = (i >> 6) & 3, d = i & 63; LB[2048 + i] = ap->in[5 + wh][l * 64 + d]; }
                if (tid < 32) { const int l = tid >> 3, e = tid & 7; LB[3072 + tid] = (e < 6) ? ap->in[9][l * 6 + e] : 0.f; }
            }
            if (bx == 0 && tid < 256) {
                const float* lg = ap->in[1]; float e[DEPTH]; float mx = -1e30f, sum = 0.f;
#pragma unroll
                for (int l = 0; l < DEPTH; ++l) mx = fmaxf(mx, lg[l * 256 + tid]);
#pragma unroll
                for (int l = 0; l < DEPTH; ++l) { e[l] = expf(lg[l * 256 + tid] - mx); sum += e[l]; }
                float c = 0.f;
#pragma unroll
                for (int l = 0; l < DEPTH; ++l) { if (l > 0) c += e[l] / sum; LB[l * 512 + tid] = logf(fmaxf(c, 1e-30f)); LB[l * 512 + 256 + tid] = 1.0f - c; }
            }
        } else {
            const int l = (ph - 1) / 6, k = (ph - 1) % 6;
            unsigned char* wl = ws + WS_W + (size_t)l * W_LAYER;
            if (k == 0) {
                pg8::Gemm g{XB, (const bf16_t*)wl, M, NIN, DM}; pg8::StaticOrder S; S.init(M, NIN, G, bx);
                EpiInProj E{SS, P, LB + l * 512, LB + 2048 + l * 256, LB + 3072 + l * 8};
                pg8::gemm_phase<EpiInProj, pg8::StaticOrder, true, true>(L, g, S, E);
            } else if (k == 1) {
                for (int it = bx; it < 464; it += G) {
                    if (it < 32) hgrn_naive_item(it, P, MIX, ap->in[4] + l * 64, (LAS float*)L);
                    else if (it < 80) fox_cumsum_item(it - 32, (const float*)(P + P_LF), (float*)(P + P_CC), (LAS float*)L);
                    else sb_naive_item(it - 80, P, MIX, (LAS float*)L);
                    __syncthreads();
                }
            } else if (k == 2) {
                for (int i = bx; i < 384; i += G) { const int it = 383 - i; fox_naive_item(((it % 48) << 3) | (it / 48), P, MIX, (LAS float*)L); __syncthreads(); }
            } else if (k == 4) {
                pg8::Gemm g{XB, (const bf16_t*)(wl + W_1), M, DFF, DM}; pg8::StaticOrder S; S.init(M, DFF, G, bx);
                EpiRelu2 E{UB, SS};
                pg8::gemm_phase<EpiRelu2, pg8::StaticOrder, true, true>(L, g, S, E);
            } else {
                const bool ff2 = (k == 5);
                pg8::Gemm g{ff2 ? UB : MIX, (const bf16_t*)(wl + (ff2 ? W_2 : W_OUT)), M, DM, ff2 ? DFF : DM}; pg8::StaticOrder S; S.init(M, DM, G, bx);
                EpiResid E{(!ff2 && l == 0) ? ap->in[0] : ap->out, ap->out, XB, SS};
                pg8::gemm_phase<EpiResid, pg8::StaticOrder, true, true>(L, g, S, E);
            }
        }
        if (ph + 1 < a.ph_hi) grid.sync();
    }
}

#ifndef MK_MULTI
#define MK_MULTI 0
#endif
extern "C" void kernel_launch(void* const* d_in, const int* in_sizes, int n_in, void* d_out, int out_size, void* d_ws, size_t ws_size, hipStream_t stream) {
    static int grid = 0;
    if (grid == 0) {
        int dev = 0, cus = 0, per = 0;
        if (n_in != 14 || out_size != M * DM || ws_size < WS_END) { fprintf(stderr, "kernel_launch: unexpected shapes (n_in %d out %d ws %zu)\n", n_in, out_size, ws_size); grid = -1; return; }
        (void)hipGetDevice(&dev); (void)hipDeviceGetAttribute(&cus, hipDeviceAttributeMultiprocessorCount, dev);
        (void)hipFuncSetAttribute((const void*)fwd, hipFuncAttributeMaxDynamicSharedMemorySize, LDS_BYTES);
        (void)hipOccupancyMaxActiveBlocksPerMultiprocessor(&per, (const void*)fwd, 512, LDS_BYTES);
        if (per < 1) per = 1;
        grid = cus * per;
        fprintf(stderr, "kernel_launch: grid %d (cus %d x %d)\n", grid, cus, per);
    }
    if (grid < 0) return;
    Args a{};
    for (int i = 0; i < 14; ++i) a.in[i] = (const float*)d_in[i];
    a.out = (float*)d_out; a.ws = (unsigned char*)d_ws;
#if MK_MULTI
    for (int ph = 0; ph < NPHASE; ++ph) { a.ph_lo = ph; a.ph_hi = ph + 1; hipLaunchKernelGGL(fwd, dim3(grid), dim3(512), LDS_BYTES, stream, a); }
#else
    a.ph_lo = 0; a.ph_hi = NPHASE;
    void* args[] = {&a};
    hipError_t e = hipLaunchCooperativeKernel((const void*)fwd, dim3(grid), dim3(512), args, LDS_BYTES, stream);
    if (e != hipSuccess) fprintf(stderr, "kernel_launch: cooperative launch failed: %s (grid %d)\n", hipGetErrorString(e), grid);
#endif
}
```

```cpp
#include <hip/hip_runtime.h>
#include <hip/hip_cooperative_groups.h>
#include <cstdio>
#include <cstdint>
namespace cg = cooperative_groups;
namespace pg8 {
#define PG8_LAS __attribute__((address_space(3)))
typedef unsigned short bf16_t;
typedef short bf16x8 __attribute__((ext_vector_type(8)));
typedef float f32x4 __attribute__((ext_vector_type(4)));
typedef unsigned u32x4 __attribute__((ext_vector_type(4)));
constexpr int BM = 256, BK = 64, HALF = 128, HTB = HALF * BK * 2  , STAGE_BYTES = 8 * HTB, NXCD = 8, WGM = 8;

__host__ __device__ __forceinline__ int lds_byte(int r, int c) { const int st = (r >> 4) * 2 + (c >> 5), rr = r & 15, cc = c & 31, ob = rr * 64 + cc * 2; return st * 1024 + (ob ^ (((ob >> 9) & 1) << 5)); }
__host__ __device__ __forceinline__ void stage_rc(int b, int& R, int& C) { const int st = b / 1024, sb = b % 1024, swz = sb ^ (((sb >> 9) & 1) << 5); R = (st >> 1) * 16 + swz / 64; C = (st & 1) * 32 + (swz % 64) / 2; }
__host__ __device__ __forceinline__ int perm32(int rho) { const int n = rho >> 4, i = rho & 15; return 8 * (i >> 2) + 4 * n + (i & 3); }

struct Unit { int pm, pn; };
struct Gemm { const bf16_t* A; const bf16_t* Bt; int M, N, K; };

struct StaticOrder {
    int nM, nN, nwg, G, c;
    __host__ __device__ void init(int M, int N, int G_, int c_) { nM = M / BM; nN = N / BM; nwg = nM * nN; G = G_; c = c_; }
    __host__ __device__ bool next(int i, Unit& u) const {
        const long L = (long)i * G + c; if (L >= nwg) return false;
        int wgid = (int)L; { const int q = nwg / NXCD, r = nwg % NXCD, xcd = wgid % NXCD, off = wgid / NXCD; wgid = (xcd < r ? xcd * (q + 1) : r * (q + 1) + (xcd - r) * q) + off; }
        const int nig = WGM * nN, gid = wgid / nig, fm = gid * WGM, gsz = (nM - fm) < WGM ? (nM - fm) : WGM;
        u.pm = fm + ((wgid % nig) % gsz); u.pn = (wgid % nig) / gsz; return true;
    }
    __device__ __forceinline__ void a_ready(const Unit&) const {}
    __device__ __forceinline__ void done(const Unit&) const {}
};

__device__ __forceinline__ unsigned cvt_pk_bf16(float lo, float hi) { unsigned r; asm volatile("v_cvt_pk_bf16_f32 %0, %1, %2" : "=v"(r) : "v"(lo), "v"(hi)); return r; }
typedef float f32x2 __attribute__((ext_vector_type(2)));
template <class Epi, class Sched, bool ALIGN_EPI = false, bool SP2 = false>
__device__ __forceinline__ void gemm_phase(PG8_LAS unsigned char* lds, const Gemm g, const Sched& S, const Epi& E) {
    int tid_ = threadIdx.x; asm volatile("" : "+v"(tid_));
    const int tid = tid_, wid = __builtin_amdgcn_readfirstlane(tid >> 6), lane = tid & 63, wr = wid >> 2, wc = wid & 3, fr = lane & 15, fq = lane >> 4;
    const int K = g.K, nt = K / BK;
    unsigned voffA[2], voffB[2];
#pragma unroll
    for (int i = 0; i < 2; ++i) { int R, C; stage_rc(tid * 16 + i * 8192, R, C); const int Rb = Epi::PERM ? ((R & ~31) + perm32(R & 31)) : R;
        voffA[i] = (unsigned)(R * K + C) * 2u; voffB[i] = (unsigned)(Rb * K + C) * 2u; }
    const size_t kstep = (size_t)(BK * 2);
    const size_t hstep = (size_t)HALF * K * 2;
    const size_t tstep = 2 * hstep;
    const unsigned ldsw = (unsigned)wid * 1024u;
    const int aoff = lds_byte(wr * 64 + fr, fq * 8), boff = lds_byte(wc * 32 + fr, fq * 8);
#define PG8_SA(b, h) (((b) * 2 + (h)) * HTB)
#define PG8_SB(b, h) ((4 + (b) * 2 + (h)) * HTB)
#define PG8_STAGE(bufoff, gbase, voff) do { _Pragma("unroll") for (int _i = 0; _i < 2; ++_i) \
        __builtin_amdgcn_global_load_lds((const unsigned*)((const char*)(gbase) + (voff)[_i]), (PG8_LAS unsigned*)(lds + (bufoff) + ldsw + _i * 8192), 16, 0, 0); } while (0)
#define PG8_LDA(dst, b, h) do { _Pragma("unroll") for (int m = 0; m < 4; ++m) _Pragma("unroll") for (int k = 0; k < 2; ++k) dst[m][k] = *(const PG8_LAS bf16x8*)(lds + PG8_SA(b, h) + aoff + m * 2048 + k * 1024); } while (0)
#define PG8_LDB(dst, b, h) do { _Pragma("unroll") for (int n = 0; n < 2; ++n) _Pragma("unroll") for (int k = 0; k < 2; ++k) dst[n][k] = *(const PG8_LAS bf16x8*)(lds + PG8_SB(b, h) + boff + n * 2048 + k * 1024); } while (0)
#define PG8_MMA(ai, bj, At, Bt) do { __builtin_amdgcn_s_setprio(1); _Pragma("unroll") for (int m = 0; m < 4; ++m) _Pragma("unroll") for (int n = 0; n < 2; ++n) _Pragma("unroll") for (int k = 0; k < 2; ++k) \
        acc[ai][bj][m][n] = __builtin_amdgcn_mfma_f32_16x16x32_bf16(Bt[n][k], At[m][k], acc[ai][bj][m][n], 0, 0, 0); __builtin_amdgcn_s_setprio(0); } while (0)
#define PG8_WAIT_V(n) asm volatile("s_waitcnt vmcnt(" #n ")" ::: "memory")
#define PG8_WAIT_L(n) asm volatile("s_waitcnt lgkmcnt(" #n ")" ::: "memory")
#define PG8_BAR __builtin_amdgcn_s_barrier()
#define PG8_SCHED __builtin_amdgcn_sched_barrier(0)
    Unit cur, nxt; int ui = 0;
    if (!S.next(0, cur)) return;
    f32x4 acc[2][2][4][2];
#pragma unroll
    for (int a = 0; a < 2; ++a)
#pragma unroll
        for (int b = 0; b < 2; ++b)
#pragma unroll
            for (int m = 0; m < 4; ++m)
#pragma unroll
                for (int n = 0; n < 2; ++n) acc[a][b][m][n] = (f32x4){0.f, 0.f, 0.f, 0.f};
    bf16x8 At[4][2], B0[2][2], B1[2][2];
    const char* cA = (const char*)g.A + (size_t)cur.pm * tstep; const char* cB = (const char*)g.Bt + (size_t)cur.pn * tstep;
    S.a_ready(cur);
    if constexpr (SP2) {
        PG8_STAGE(PG8_SB(0, 0), cB, voffB); PG8_STAGE(PG8_SB(0, 1), cB + hstep, voffB); PG8_STAGE(PG8_SA(0, 0), cA, voffA); PG8_STAGE(PG8_SA(0, 1), cA + hstep, voffA);
        if (wr == 1) PG8_BAR;
        PG8_WAIT_V(2); PG8_BAR;
        PG8_STAGE(PG8_SB(1, 0), cB + kstep, voffB); PG8_STAGE(PG8_SA(1, 0), cA + kstep, voffA); PG8_STAGE(PG8_SB(1, 1), cB + hstep + kstep, voffB);
        PG8_WAIT_V(6); PG8_BAR;
    } else {
        PG8_STAGE(PG8_SB(0, 0), cB, voffB); PG8_STAGE(PG8_SA(0, 0), cA, voffA); PG8_STAGE(PG8_SB(0, 1), cB + hstep, voffB); PG8_STAGE(PG8_SA(0, 1), cA + hstep, voffA);
        if (wr == 1) PG8_BAR;
        PG8_WAIT_V(4); PG8_BAR;
        PG8_STAGE(PG8_SB(1, 0), cB + kstep, voffB); PG8_STAGE(PG8_SA(1, 0), cA + kstep, voffA); PG8_STAGE(PG8_SB(1, 1), cB + hstep + kstep, voffB);
        PG8_WAIT_V(6); PG8_BAR;
    }
    for (;;) {
        const bool has_next = S.next(ui + 1, nxt);
        const char* nA = has_next ? (const char*)g.A + (size_t)nxt.pm * tstep : cA; const char* nB = has_next ? (const char*)g.Bt + (size_t)nxt.pn * tstep : cB;
        for (int t = 0; t < nt; t += 2) {
            const bool last = (t == nt - 2);
            const char* a1 = cA + (size_t)(t + 1) * kstep;
            const char* a2 = last ? nA : cA + (size_t)(t + 2) * kstep; const char* b2 = last ? nB : cB + (size_t)(t + 2) * kstep;
            const char* a3 = a2 + kstep; const char* b3 = b2 + kstep;
            if (last && has_next) S.a_ready(nxt);
            if constexpr (SP2) {
            PG8_LDB(B0, 0, 0); PG8_LDB(B1, 0, 1); PG8_SCHED; PG8_LDA(At, 0, 0); PG8_STAGE(PG8_SA(1, 1), a1 + hstep, voffA);
            PG8_WAIT_V(8); PG8_WAIT_L(0); PG8_BAR; PG8_MMA(0, 0, At, B0); PG8_MMA(0, 1, At, B1); PG8_BAR; PG8_SCHED;
            PG8_LDA(At, 0, 1); PG8_STAGE(PG8_SB(0, 0), b2, voffB); PG8_STAGE(PG8_SB(0, 1), b2 + hstep, voffB); PG8_STAGE(PG8_SA(0, 0), a2, voffA);
            PG8_WAIT_V(8); PG8_WAIT_L(0); PG8_BAR; PG8_MMA(1, 0, At, B0); PG8_MMA(1, 1, At, B1); PG8_BAR; PG8_SCHED;
            PG8_LDB(B0, 1, 0); PG8_LDB(B1, 1, 1); PG8_SCHED; PG8_LDA(At, 1, 0); PG8_STAGE(PG8_SA(0, 1), a2 + hstep, voffA);
            PG8_WAIT_V(8); PG8_WAIT_L(0); PG8_BAR; PG8_MMA(0, 0, At, B0); PG8_MMA(0, 1, At, B1); PG8_BAR; PG8_SCHED;
            PG8_LDA(At, 1, 1); PG8_STAGE(PG8_SB(1, 0), b3, voffB); PG8_STAGE(PG8_SB(1, 1), b3 + hstep, voffB); PG8_STAGE(PG8_SA(1, 0), a3, voffA);
            PG8_WAIT_V(8); PG8_WAIT_L(0); PG8_BAR; PG8_MMA(1, 0, At, B0); PG8_MMA(1, 1, At, B1); PG8_BAR; PG8_SCHED;
            } else {
            PG8_LDB(B0, 0, 0); PG8_SCHED; PG8_LDA(At, 0, 0); PG8_STAGE(PG8_SA(1, 1), a1 + hstep, voffA);
            PG8_WAIT_L(8); PG8_BAR; PG8_WAIT_L(0); PG8_MMA(0, 0, At, B0); PG8_BAR; PG8_SCHED;
            PG8_LDB(B1, 0, 1); PG8_STAGE(PG8_SB(0, 0), b2, voffB);
            PG8_BAR; PG8_WAIT_L(0); PG8_MMA(0, 1, At, B1); PG8_BAR;
            PG8_LDA(At, 0, 1); PG8_STAGE(PG8_SA(0, 0), a2, voffA);
            PG8_BAR; PG8_WAIT_L(0); PG8_MMA(1, 0, At, B0); PG8_BAR; PG8_SCHED;
            PG8_STAGE(PG8_SB(0, 1), b2 + hstep, voffB);
            PG8_WAIT_V(6); PG8_BAR; PG8_MMA(1, 1, At, B1); PG8_BAR;
            PG8_LDB(B0, 1, 0); PG8_SCHED; PG8_LDA(At, 1, 0); PG8_STAGE(PG8_SA(0, 1), a2 + hstep, voffA);
            PG8_WAIT_L(8); PG8_BAR; PG8_WAIT_L(0); PG8_MMA(0, 0, At, B0); PG8_BAR; PG8_SCHED;
            PG8_LDB(B1, 1, 1); PG8_STAGE(PG8_SB(1, 0), b3, voffB);
            PG8_BAR; PG8_WAIT_L(0); PG8_MMA(0, 1, At, B1); PG8_BAR;
            PG8_LDA(At, 1, 1); PG8_STAGE(PG8_SA(1, 0), a3, voffA);
            PG8_BAR; PG8_WAIT_L(0); PG8_MMA(1, 0, At, B0); PG8_BAR; PG8_SCHED;
            PG8_STAGE(PG8_SB(1, 1), b3 + hstep, voffB);
            PG8_WAIT_V(6); PG8_BAR; PG8_MMA(1, 1, At, B1); PG8_BAR;
            }
        }
        if constexpr (ALIGN_EPI) { if (wr == 0) PG8_BAR; }
        if constexpr (!Epi::AFTER_DRAIN) { E(acc, cur, wr, wc, fr, fq); S.done(cur); }
        if (!has_next) break;
#pragma unroll
        for (int a = 0; a < 2; ++a)
#pragma unroll
            for (int b = 0; b < 2; ++b)
#pragma unroll
                for (int m = 0; m < 4; ++m)
#pragma unroll
                    for (int n = 0; n < 2; ++n) acc[a][b][m][n] = (f32x4){0.f, 0.f, 0.f, 0.f};
        cur = nxt; cA = nA; cB = nB; ++ui;
        if constexpr (ALIGN_EPI) { if (wr == 1) PG8_BAR; }
    }
    PG8_WAIT_V(0);
    if constexpr (!ALIGN_EPI) { if (wr == 0) PG8_BAR; }
    PG8_BAR;
    if constexpr (Epi::AFTER_DRAIN) { E.fused(acc, cur, wr, wc, fr, fq, lds, wid, lane); S.done(cur); }
#undef PG8_SA
#undef PG8_SB
#undef PG8_STAGE
#undef PG8_LDA
#undef PG8_LDB
#undef PG8_MMA
#undef PG8_WAIT_V
#undef PG8_WAIT_L
#undef PG8_BAR
#undef PG8_SCHED
}
}
#include <hip/hip_bf16.h>
#include <cmath>
namespace attn_body {
using bf16=__hip_bfloat16;
using bf16x8=__attribute__((ext_vector_type(8)))short;
using s16x4=__attribute__((ext_vector_type(4)))short;
using f32x16=__attribute__((ext_vector_type(16)))float;
using u32x4=__attribute__((ext_vector_type(4)))unsigned;
using f32x4v=__attribute__((ext_vector_type(4)))float;
constexpr int SEQ=4096,D=64,DM=64,OPITCH=1024;
constexpr int LDS_C=98304;
constexpr int NW=8,QBLK=32,QB=QBLK*NW,KVBLK=64,NQB=SEQ/QB;
constexpr int ATTN_UNIT_ROWS=QB;
__device__ __forceinline__ int crow(int r,int hi){return (r&3)+8*(r>>2)+4*hi;}
#define SBAR() __builtin_amdgcn_sched_barrier(0)
__device__ __forceinline__ void cmask(f32x16&p0,f32x16&p1,int jb,int qrel,int hi){
  const float NEG=-INFINITY; int kb=64*jb+4*hi;
  #pragma unroll
  for(int r=0;r<16;++r){int kv=kb+(r&3)+8*(r>>2); if(kv>qrel)p0[r]=NEG; if(kv+32>qrel)p1[r]=NEG;}
}

constexpr int NSLOT=3, SLOTB=8192;
constexpr int LDS_K=0, LDS_V=NSLOT*SLOTB, LDS_WS=2*NSLOT*SLOTB, LDS_OST=LDS_WS+NW*64*4, LDS_BYTES=LDS_OST+NW*4096;
constexpr float C2=0.125f*1.4426950408889634f;
__device__ __forceinline__ void glds16(const void*gsrc,unsigned lds_dst){unsigned keep;
  asm volatile("s_mov_b32 %0, m0\n\ts_mov_b32 m0, %2\n\ts_nop 0\n\tglobal_load_lds_dwordx4 %1, off\n\ts_mov_b32 m0, %0":"=&s"(keep):"v"(gsrc),"s"(lds_dst):"memory");}
__device__ __forceinline__ float max3f(float a,float b,float c){float r;asm("v_max3_f32 %0, %1, %2, %3":"=v"(r):"v"(a),"v"(b),"v"(c));return r;}
__device__ __forceinline__ float max2f(float a,float b){float r;asm("v_max_f32_e32 %0, %1, %2":"=v"(r):"v"(a),"v"(b));return r;}
__device__ __forceinline__ float fadd_s(float a,float b){float r;asm("v_add_f32_e32 %0, %1, %2":"=v"(r):"v"(a),"v"(b));return r;}
__device__ __forceinline__ float fsub_s(float a,float b){float r;asm("v_sub_f32_e32 %0, %1, %2":"=v"(r):"v"(a),"v"(b));return r;}
typedef float f32x2_t __attribute__((ext_vector_type(2))); typedef __bf16 bf16x2_t __attribute__((ext_vector_type(2)));
__device__ __forceinline__ unsigned cvtpk_s(float lo,float hi){f32x2_t v={lo,hi};bf16x2_t b=__builtin_convertvector(v,bf16x2_t);return __builtin_bit_cast(unsigned,b);}
#define WAIT_BAR(N) asm volatile("s_waitcnt vmcnt(" #N ") lgkmcnt(0)\n\ts_barrier":::"memory")

__device__ __forceinline__ void qkt(f32x16&p0,f32x16&p1,const char*Kslot,const bf16x8*qr,const f32x16&negm,int r32,int hi){
  const char*kb=Kslot+hi*1024+r32*16;
  #pragma unroll
  for(int d0=0;d0<4;++d0){
    const bf16x8 b0=*reinterpret_cast<const bf16x8*>(kb+d0*2048);
    const bf16x8 b1=*reinterpret_cast<const bf16x8*>(kb+d0*2048+512);
    if(d0==0){p0=__builtin_amdgcn_mfma_f32_32x32x16_bf16(b0,qr[0],negm,0,0,0);p1=__builtin_amdgcn_mfma_f32_32x32x16_bf16(b1,qr[0],negm,0,0,0);}
    else{p0=__builtin_amdgcn_mfma_f32_32x32x16_bf16(b0,qr[d0],p0,0,0,0);p1=__builtin_amdgcn_mfma_f32_32x32x16_bf16(b1,qr[d0],p1,0,0,0);}}
}
typedef __attribute__((address_space(3))) const char* lds_cptr;
typedef short v4i16_t __attribute__((ext_vector_type(4)));
__device__ __forceinline__ void kload8(bf16x8*kf,lds_cptr kp){
  kf[0]=*(const __attribute__((address_space(3))) bf16x8*)(kp);      kf[1]=*(const __attribute__((address_space(3))) bf16x8*)(kp+512);
  kf[2]=*(const __attribute__((address_space(3))) bf16x8*)(kp+2048); kf[3]=*(const __attribute__((address_space(3))) bf16x8*)(kp+2560);
  kf[4]=*(const __attribute__((address_space(3))) bf16x8*)(kp+4096); kf[5]=*(const __attribute__((address_space(3))) bf16x8*)(kp+4608);
  kf[6]=*(const __attribute__((address_space(3))) bf16x8*)(kp+6144); kf[7]=*(const __attribute__((address_space(3))) bf16x8*)(kp+6656);
}
__device__ __forceinline__ void kload2(bf16x8*kf,lds_cptr kp,int j){ kf[2*j]=*(const __attribute__((address_space(3))) bf16x8*)(kp+j*2048); kf[2*j+1]=*(const __attribute__((address_space(3))) bf16x8*)(kp+j*2048+512); }
__device__ __forceinline__ s16x4 vtr(lds_cptr p){ return __builtin_bit_cast(s16x4,__builtin_amdgcn_ds_read_tr16_b64_v4i16((__attribute__((address_space(3))) v4i16_t*)p)); }
__device__ __forceinline__ float rowmax(const f32x16&p0,const f32x16&p1){
  float a=max3f(p0[0],p0[1],p1[0]),b=max3f(p0[2],p0[3],p1[1]);a=max3f(a,p1[2],p1[3]);
  #pragma unroll
  for(int r=4;r<16;r+=4){a=max3f(a,p0[r],p0[r+1]);b=max3f(b,p0[r+2],p0[r+3]);a=max3f(a,p1[r],p1[r+1]);b=max3f(b,p1[r+2],p1[r+3]);}
  const float m=max2f(a,b);
  auto rr=__builtin_amdgcn_permlane32_swap(__float_as_uint(m),__float_as_uint(m),false,false);
  return max2f(__uint_as_float(rr[0]),__uint_as_float(rr[1]));
}
__device__ __forceinline__ void pv(f32x16*o,int vb,bf16x8 pa0,bf16x8 pa1,bf16x8 pa2,bf16x8 pa3){
  #pragma unroll
  for(int d0=0;d0<2;++d0){s16x4 lo[4],hi[4];
    #pragma unroll
    for(int ks=0;ks<4;++ks){
      asm volatile("ds_read_b64_tr_b16 %0,%1 offset:%c2":"=&v"(lo[ks]):"v"(vb),"i"(d0*4096+ks*1024):"memory");
      asm volatile("ds_read_b64_tr_b16 %0,%1 offset:%c2":"=&v"(hi[ks]):"v"(vb),"i"(d0*4096+ks*1024+512):"memory");}
    asm volatile("s_waitcnt lgkmcnt(0)":::"memory");SBAR();
    #define PK(k) (bf16x8){lo[k][0],lo[k][1],lo[k][2],lo[k][3],hi[k][0],hi[k][1],hi[k][2],hi[k][3]}
    o[d0]=__builtin_amdgcn_mfma_f32_32x32x16_bf16(pa0,PK(0),o[d0],0,0,0);
    o[d0]=__builtin_amdgcn_mfma_f32_32x32x16_bf16(pa1,PK(1),o[d0],0,0,0);
    o[d0]=__builtin_amdgcn_mfma_f32_32x32x16_bf16(pa2,PK(2),o[d0],0,0,0);
    o[d0]=__builtin_amdgcn_mfma_f32_32x32x16_bf16(pa3,PK(3),o[d0],0,0,0);
    #undef PK
  }
}

#ifndef ATTN_STORE16
#define ATTN_STORE16(p,v) (*(u32x4*)(p)=(v))
#endif
template<int THRL> __device__ __forceinline__ void attn_unit(int qb,const bf16*Q,const bf16*__restrict__ K,const bf16*__restrict__ V,bf16*O,const float*__restrict__ Cg,char*shm){
  int tid_=threadIdx.x; asm volatile("":"+v"(tid_)); const int tid=tid_,lane=tid&63,r32=lane&31,hi=lane>>5; const int wid=__builtin_amdgcn_readfirstlane(tid>>6);
  const int q0=qb*QB;
  const bf16*Qw=Q+(long)(q0+wid*QBLK)*DM;
  const bf16*Kh=K,*Vh=V;
  const lds_cptr shm3=(lds_cptr)shm;
  const unsigned lds0=(unsigned)(uintptr_t)shm;
  float*wsf=(float*)(shm+LDS_WS)+wid*64;
  const bf16*ksrc=Kh+(long)lane*DM+wid*8;
  const bf16*vsrc=Vh+(long)(16*(wid&3)+(lane>>2))*DM+(wid>>2)*32+(lane&3)*8;
  const unsigned kdst=lds0+LDS_K+wid*1024, vdst=lds0+LDS_V+wid*1024;
  #define DMA_K(t,slot) glds16(ksrc+(long)(t)*KVBLK*DM,(unsigned)__builtin_amdgcn_readfirstlane(kdst+(slot)))
  #define DMA_V(t,slot) glds16(vsrc+(long)(t)*KVBLK*DM,(unsigned)__builtin_amdgcn_readfirstlane(vdst+(slot)))
  const int vb0=(int)(lds0+LDS_V)+((lane>>4)&1)*32+(lane&3)*8+(4*hi+((lane&15)>>2))*64;
  const char*Kbase=shm+LDS_K; bf16x8 kf[8];
  const lds_cptr kp0=shm3+LDS_K+hi*1024+r32*16; const lds_cptr vp0=shm3+LDS_V+((lane>>4)&1)*32+(lane&3)*8+(4*hi+((lane&15)>>2))*64;
  const int NT=(q0+QB)/KVBLK;
  { typedef __attribute__((address_space(3))) float lf32; lf32*cl_=(lf32*)(shm3+LDS_C); for(int i=tid;i<q0+QB;i+=NW*64)cl_[i]=Cg[i]; }
  DMA_K(0,0);DMA_V(0,0);DMA_K(1,SLOTB);
  bf16x8 qr[4];
  #pragma unroll
  for(int d0=0;d0<4;++d0)qr[d0]=*reinterpret_cast<const bf16x8*>(&Qw[(long)r32*DM+d0*16+hi*8]);
  float mhat=0.f,l_reg=0.f;f32x16 o[2];o[0]=f32x16{};o[1]=f32x16{};f32x16 negm=f32x16{};asm volatile("":"+v"(negm));
  const int qrel=wid*QBLK+r32;
  #define CMASK(P0,P1,t) do{int jb_=(t)-(NT-4); if(jb_>=0)cmask(P0,P1,jb_,qrel,hi);}while(0)
  typedef __attribute__((address_space(3))) const float* lds_fptr; typedef __attribute__((address_space(3))) const f32x4v* lds_f4ptr;
  const lds_fptr cl0=(lds_fptr)(shm3+LDS_C)+4*hi;
  #define BIAS(P0,P1,t) do{ const lds_fptr cb_=cl0+64*(t); _Pragma("unroll") for(int g_=0;g_<4;++g_){ const f32x4v a_=*(lds_f4ptr)(cb_+8*g_), b_=*(lds_f4ptr)(cb_+32+8*g_); \
      _Pragma("unroll") for(int i_=0;i_<4;++i_){P0[4*g_+i_]-=a_[i_];P1[4*g_+i_]-=b_[i_];} } }while(0)
  bool resc=false;
  #define START(P0,P1) do{ const float rm=rowmax(P0,P1); resc=false; \
    { const float dl=rm; mhat=fadd_s(mhat,dl); \
      _Pragma("unroll") for(int r=0;r<16;++r){P0[r]=fsub_s(P0[r],dl);P1[r]=fsub_s(P1[r],dl);} \
      _Pragma("unroll") for(int r=0;r<16;++r)negm[r]=-mhat; asm volatile("":"+v"(negm)); } \
    _Pragma("unroll") for(int r=0;r<16;++r)P0[r]=__builtin_amdgcn_exp2f(P0[r]); }while(0)
  #define RESC() do{ if(resc){ asm volatile("s_waitcnt lgkmcnt(0)":::"memory"); \
      _Pragma("unroll") for(int d_=0;d_<2;++d_) _Pragma("unroll") for(int r=0;r<16;++r)o[d_][r]*=wsf[crow(r,hi)]; } }while(0)
  f32x16 pA0,pA1,pB0,pB1;
  int sl_prev=0,sl_cur=0,sl_next=SLOTB;
  #define ROT() do{sl_prev=sl_cur;sl_cur=sl_next;sl_next=(sl_next==(NSLOT-1)*SLOTB)?0:sl_next+SLOTB;}while(0)
  DMA_K(2,2*SLOTB);
  WAIT_BAR(3);
  qkt(pA0,pA1,Kbase,qr,negm,r32,hi);asm volatile("s_nop 15\n\ts_nop 7":"+v"(pA0),"+v"(pA1));BIAS(pA0,pA1,0);CMASK(pA0,pA1,0);
  START(pA0,pA1);
  _Pragma("unroll") for(int r=0;r<16;++r)pA1[r]=__builtin_amdgcn_exp2f(pA1[r]);
  WAIT_BAR(0);
  DMA_K(3,0);DMA_V(1,SLOTB);
  ROT();
  kload8(kf,kp0+sl_cur);
  WAIT_BAR(2);
  s16x4 vlo[8],vhi[8]; u32x4 pw0,pw1,pw2,pw3;
  #define PKW(P,B) cvtpk_s(P[B],P[B+1])
  #define PAF(k) __builtin_bit_cast(bf16x8,pw##k)
  #define VFR(i) (bf16x8){vlo[i][0],vlo[i][1],vlo[i][2],vlo[i][3],vhi[i][0],vhi[i][1],vhi[i][2],vhi[i][3]}
  #define PIN(x) asm volatile("":"+v"(x))
  #define MX3(a,b,c) __builtin_fmaxf(__builtin_fmaxf((a),(b)),(c))
  #define GAPA(MF,A0,A1,A2,A3,W0,W1,PW) do{ MF; sacc+=A0; sacc+=A1; sacc+=A2; sacc+=A3; PIN(sacc); W0; W1; PIN(PW); SBAR(); }while(0)
  #define EX(v) __builtin_amdgcn_exp2f(v)
  #define GAPB(MF,X,B) do{ MF; X[B]=EX(X[B]); X[B+1]=EX(X[B+1]); X[B+2]=EX(X[B+2]); X[B+3]=EX(X[B+3]); PIN(X); SBAR(); }while(0)
  #define VRD(i) do{ vlo[i]=vtr(vp_+(((i)>>2)*4096+((i)&3)*1024)); vhi[i]=vtr(vp_+(((i)>>2)*4096+((i)&3)*1024+512)); }while(0)
  #define KRD(G,j) do{ if(G){ kload2(kf,kp0+sl_next,j); SBAR(); } }while(0)
  #define STEP(C0,C1,P0,P1,t,GK,GV,GL) do{ SBAR(); \
    const lds_cptr vp_=vp0+sl_prev; \
    VRD(0); SBAR(); float sacc=(P0[0]+P0[1]); \
    GAPA(C0=__builtin_amdgcn_mfma_f32_32x32x16_bf16(kf[0],qr[0],negm,0,0,0), P0[2],P0[3],P0[4],P0[5],     pw0[0]=PKW(P0,0), pw0[1]=PKW(P0,2), pw0); \
    VRD(4); SBAR(); GAPA(C1=__builtin_amdgcn_mfma_f32_32x32x16_bf16(kf[1],qr[0],negm,0,0,0), P0[6],P0[7],P0[8],P0[9],     pw0[2]=PKW(P0,4), pw0[3]=PKW(P0,6), pw0); \
    VRD(1); SBAR(); GAPA(C0=__builtin_amdgcn_mfma_f32_32x32x16_bf16(kf[2],qr[1],C0,0,0,0),   P0[10],P0[11],P0[12],P0[13], pw1[0]=PKW(P0,8), pw1[1]=PKW(P0,10), pw1); \
    VRD(5); SBAR(); GAPA(C1=__builtin_amdgcn_mfma_f32_32x32x16_bf16(kf[3],qr[1],C1,0,0,0),   P0[14],P0[15],P1[0],P1[1],   pw1[2]=PKW(P0,12),pw1[3]=PKW(P0,14), pw1); \
    VRD(2); SBAR(); GAPA(C0=__builtin_amdgcn_mfma_f32_32x32x16_bf16(kf[4],qr[2],C0,0,0,0),   P1[2],P1[3],P1[4],P1[5],     pw2[0]=PKW(P1,0), pw2[1]=PKW(P1,2), pw2); \
    VRD(6); SBAR(); GAPA(C1=__builtin_amdgcn_mfma_f32_32x32x16_bf16(kf[5],qr[2],C1,0,0,0),   P1[6],P1[7],P1[8],P1[9],     pw2[2]=PKW(P1,4), pw2[3]=PKW(P1,6), pw2); \
    VRD(3); SBAR(); GAPA(C0=__builtin_amdgcn_mfma_f32_32x32x16_bf16(kf[6],qr[3],C0,0,0,0),   P1[10],P1[11],P1[12],P1[13], pw3[0]=PKW(P1,8), pw3[1]=PKW(P1,10), pw3); \
    VRD(7); SBAR(); GAPA(C1=__builtin_amdgcn_mfma_f32_32x32x16_bf16(kf[7],qr[3],C1,0,0,0),   P1[14],P1[15],0.f,0.f,       pw3[2]=PKW(P1,12),pw3[3]=PKW(P1,14), pw3); \
    l_reg+=sacc; \
    if(GK){DMA_K((t)+3,sl_cur);} if(GV){DMA_V((t)+1,sl_next);} \
    BIAS(C0,C1,t); CMASK(C0,C1,t); \
    { float a=MX3(C0[0],C0[1],C1[0]),b=MX3(C0[2],C0[3],C1[1]); a=MX3(a,C1[2],C1[3]); \
      _Pragma("unroll") for(int r=4;r<16;r+=4){a=MX3(a,C0[r],C0[r+1]);b=MX3(b,C0[r+2],C0[r+3]);a=MX3(a,C1[r],C1[r+1]);b=MX3(b,C1[r+2],C1[r+3]);} \
      float rm=__builtin_fmaxf(a,b); { auto rr=__builtin_amdgcn_permlane32_swap(__float_as_uint(rm),__float_as_uint(rm),false,false); rm=__builtin_fmaxf(__uint_as_float(rr[0]),__uint_as_float(rr[1])); } \
      resc=false; \
      if(__builtin_expect(__any(rm>(float)THRL),0)){ const float dl=__builtin_fmaxf(rm,0.f); mhat+=dl; \
        _Pragma("unroll") for(int r=0;r<16;++r){C0[r]-=dl;C1[r]-=dl;} \
        _Pragma("unroll") for(int r=0;r<16;++r)negm[r]=-mhat; asm volatile("":"+v"(negm)); \
        const float f=__builtin_amdgcn_exp2f(-dl); l_reg*=f; if(hi==0)wsf[r32]=f; resc=true; } } \
    SBAR(); \
    GAPB(o[0]=__builtin_amdgcn_mfma_f32_32x32x16_bf16(PAF(0),VFR(0),o[0],0,0,0), C0,0); \
    GAPB(o[1]=__builtin_amdgcn_mfma_f32_32x32x16_bf16(PAF(0),VFR(4),o[1],0,0,0), C0,4); \
    KRD(GL,0); GAPB(o[0]=__builtin_amdgcn_mfma_f32_32x32x16_bf16(PAF(1),VFR(1),o[0],0,0,0), C0,8); \
    KRD(GL,1); GAPB(o[1]=__builtin_amdgcn_mfma_f32_32x32x16_bf16(PAF(1),VFR(5),o[1],0,0,0), C0,12); \
    KRD(GL,2); GAPB(o[0]=__builtin_amdgcn_mfma_f32_32x32x16_bf16(PAF(2),VFR(2),o[0],0,0,0), C1,0); \
    KRD(GL,3); GAPB(o[1]=__builtin_amdgcn_mfma_f32_32x32x16_bf16(PAF(2),VFR(6),o[1],0,0,0), C1,4); \
    GAPB(o[0]=__builtin_amdgcn_mfma_f32_32x32x16_bf16(PAF(3),VFR(3),o[0],0,0,0), C1,8); \
    GAPB(o[1]=__builtin_amdgcn_mfma_f32_32x32x16_bf16(PAF(3),VFR(7),o[1],0,0,0), C1,12); \
    }while(0)
  int t=1;
  #undef CMASK
  #define CMASK(P0,P1,t) do{}while(0)
  for(;t+5<NT;t+=2){
    STEP(pB0,pB1,pA0,pA1,t,true,true,true);     WAIT_BAR(2); RESC(); ROT();
    STEP(pA0,pA1,pB0,pB1,t+1,true,true,true);   WAIT_BAR(2); RESC(); ROT();
  }
  #undef CMASK
  #define CMASK(P0,P1,t) do{int jb_=(t)-(NT-4); if(jb_>=0)cmask(P0,P1,jb_,qrel,hi);}while(0)
  #define ENDW(tt) do{ if((tt)+3<NT){WAIT_BAR(2);} else if((tt)+2<NT){WAIT_BAR(1);} else {WAIT_BAR(0);} }while(0)
  for(;t+1<NT;t+=2){
    STEP(pB0,pB1,pA0,pA1,t,(t+3<NT),(t+1<NT),(t+1<NT));       ENDW(t);   RESC(); ROT();
    STEP(pA0,pA1,pB0,pB1,t+1,(t+4<NT),(t+2<NT),(t+2<NT));     ENDW(t+1); RESC(); ROT();
  }
  STEP(pB0,pB1,pA0,pA1,NT-1,false,false,false); RESC();
  { float sacc=pB0[0]+pB0[1]; _Pragma("unroll") for(int r=2;r<16;++r)sacc+=pB0[r]; _Pragma("unroll") for(int r=0;r<16;++r)sacc+=pB1[r]; l_reg+=sacc;
    pw0=(u32x4){PKW(pB0,0),PKW(pB0,2),PKW(pB0,4),PKW(pB0,6)};pw1=(u32x4){PKW(pB0,8),PKW(pB0,10),PKW(pB0,12),PKW(pB0,14)};pw2=(u32x4){PKW(pB1,0),PKW(pB1,2),PKW(pB1,4),PKW(pB1,6)};pw3=(u32x4){PKW(pB1,8),PKW(pB1,10),PKW(pB1,12),PKW(pB1,14)};
    SBAR(); pv(o,vb0+sl_cur,PAF(0),PAF(1),PAF(2),PAF(3)); }
  #undef PKW
  #undef PAF
  #undef VFR
  #undef PIN
  #undef MX3
  #undef GAPA
  #undef GAPB
  #undef EX
  #undef VRD
  #undef KRD
  #undef STEP
  #undef ENDW
  {auto rr=__builtin_amdgcn_permlane32_swap(__float_as_uint(l_reg),__float_as_uint(l_reg),false,false);l_reg=__uint_as_float(rr[0])+__uint_as_float(rr[1]);}
  if(hi==0)wsf[32+r32]=l_reg;asm volatile("s_waitcnt lgkmcnt(0)":::"memory");
  float rli[16];
  #pragma unroll
  for(int r=0;r<16;++r)rli[r]=__builtin_amdgcn_rcpf(wsf[32+crow(r,hi)]);
  bf16*Ow=O+(long)(q0+wid*QBLK)*OPITCH;
  { bf16*stg=(bf16*)(shm+LDS_OST)+wid*2048;
    #pragma unroll
    for(int r=0;r<16;++r){const int orow=crow(r,hi);
      #pragma unroll
      for(int d0=0;d0<2;++d0)stg[orow*64+d0*32+r32]=__float2bfloat16(o[d0][r]*rli[r]);}
    asm volatile("s_waitcnt lgkmcnt(0)":::"memory");
    #pragma unroll
    for(int i=0;i<4;++i){const int row=i*8+(lane>>3),ch=lane&7; const u32x4 v=*(const u32x4*)(stg+row*64+ch*8); ATTN_STORE16(Ow+(long)row*OPITCH+ch*8,v);} }
  asm volatile("s_waitcnt lgkmcnt(0)\n\ts_barrier":::"memory");
  #undef DMA_K
  #undef DMA_V
  #undef CMASK
  #undef BIAS
  #undef START
  #undef RESC
  #undef ROT
}
#undef SBAR
#undef WAIT_BAR
}

constexpr int BATCH = 8, SEQ = 4096, DM = 1024, DEPTH = 4, M = BATCH * SEQ, INC = 3334, NIN = 3584, DFF = 4096;
constexpr float EPS = 1e-6f;
constexpr size_t MiB = 1u << 20;
constexpr size_t WS_SS = 1 * MiB;
constexpr size_t WS_LB = 3 * MiB;
constexpr size_t WS_W = 4 * MiB;
constexpr size_t W_LAYER = 25 * MiB, W_OUT = 7 * MiB, W_1 = 9 * MiB, W_2 = 17 * MiB;
constexpr size_t WS_XB = 104 * MiB;
constexpr size_t WS_P = 168 * MiB;
constexpr size_t P_HQ = 0, P_HK = 16 * MiB, P_HI = 32 * MiB, P_HG = 48 * MiB, P_HLF = 64 * MiB, P_SQ = 96 * MiB, P_FQ = 168 * MiB, P_LF = 240 * MiB, P_CC = 241 * MiB, P_US = 242 * MiB;
constexpr size_t HEADBUF = 24 * MiB;
constexpr size_t WS_MIX = 426 * MiB;
constexpr size_t WS_U = 168 * MiB;
constexpr size_t WS_END = 490 * MiB;
constexpr int LDS_BYTES = 147456;

typedef pg8::bf16_t bf16_t;
typedef pg8::f32x4 f32x4;
typedef unsigned u32x4 __attribute__((ext_vector_type(4)));
typedef unsigned u32x2 __attribute__((ext_vector_type(2)));
#define LAS __attribute__((address_space(3)))

__device__ __forceinline__ unsigned f2bf(float f) { unsigned u = __builtin_bit_cast(unsigned, f); return (u + 0x7fffu + ((u >> 16) & 1u)) >> 16; }
__device__ __forceinline__ unsigned pk2(float lo, float hi) { return pg8::cvt_pk_bf16(lo, hi); }
__device__ __forceinline__ float bf2f(unsigned short b) { return __builtin_bit_cast(float, (unsigned)b << 16); }
__device__ __forceinline__ float bflo(unsigned w) { return __builtin_bit_cast(float, w << 16); }
__device__ __forceinline__ float bfhi(unsigned w) { return __builtin_bit_cast(float, w & 0xffff0000u); }
__device__ __forceinline__ float logsig(float x) { return fminf(x, 0.f) - log1pf(expf(-fabsf(x))); }
__device__ __forceinline__ float wave_sum(float v) {
#pragma unroll
    for (int o = 1; o < 64; o <<= 1) v += __shfl_xor(v, o);
    return v;
}
__device__ __forceinline__ float rowscale(const float* ss, int row, int fq) {
    const f32x4 p = *(const f32x4*)(ss + (size_t)row * 16 + 4 * fq);
    float s = (p[0] + p[1]) + (p[2] + p[3]);
    s += __shfl_xor(s, 16); s += __shfl_xor(s, 32);
    return rsqrtf(s * (1.0f / DM) + EPS);
}

#define ROWFENCE() asm volatile("" ::: "memory")
struct EpiResid {
    static constexpr bool PERM = true, AFTER_DRAIN = false;
    const float* xold; float* xnew; bf16_t* xb; float* ss;
    __device__ __forceinline__ void operator()(const f32x4 (&acc)[2][2][4][2], const pg8::Unit& u, int wr, int wc, int fr, int fq) const {
        const int row0 = u.pm * 256 + wr * 64 + fr, col0 = u.pn * 256 + wc * 32 + 8 * fq;
#pragma unroll
        for (int ai = 0; ai < 2; ++ai)
#pragma unroll
            for (int m = 0; m < 4; ++m) {
                const int row = row0 + ai * 128 + m * 16; float sq = 0.f;
#pragma unroll
                for (int bj = 0; bj < 2; ++bj) {
                    const size_t off = (size_t)row * DM + col0 + bj * 128;
                    const f32x4 o0 = *(const f32x4*)(xold + off), o1 = *(const f32x4*)(xold + off + 4);
                    const f32x4 v0 = acc[ai][bj][m][0] + o0, v1 = acc[ai][bj][m][1] + o1;
                    *(f32x4*)(xnew + off) = v0; *(f32x4*)(xnew + off + 4) = v1;
                    u32x4 w; w.x = pk2(v0[0], v0[1]); w.y = pk2(v0[2], v0[3]); w.z = pk2(v1[0], v1[1]); w.w = pk2(v1[2], v1[3]);
                    *(u32x4*)(xb + off) = w;
                    sq += (v0[0] * v0[0] + v0[1] * v0[1]) + (v0[2] * v0[2] + v0[3] * v0[3]) + (v1[0] * v1[0] + v1[1] * v1[1]) + (v1[2] * v1[2] + v1[3] * v1[3]);
                }
                sq += __shfl_xor(sq, 16); sq += __shfl_xor(sq, 32);
                if (fq == 0) ss[(size_t)row * 16 + u.pn * 4 + wc] = sq;
                ROWFENCE();
            }
    }
};
struct EpiRelu2 {
    static constexpr bool PERM = true, AFTER_DRAIN = false;
    bf16_t* U; const float* ss;
    __device__ __forceinline__ void operator()(const f32x4 (&acc)[2][2][4][2], const pg8::Unit& u, int wr, int wc, int fr, int fq) const {
        const int row0 = u.pm * 256 + wr * 64 + fr, col0 = u.pn * 256 + wc * 32 + 8 * fq;
#pragma unroll
        for (int ai = 0; ai < 2; ++ai)
#pragma unroll
            for (int m = 0; m < 4; ++m) {
                const int row = row0 + ai * 128 + m * 16; const float rs = rowscale(ss, row, fq);
#pragma unroll
                for (int bj = 0; bj < 2; ++bj) {
                    f32x4 v0 = acc[ai][bj][m][0] * rs, v1 = acc[ai][bj][m][1] * rs;
                    v0 = __builtin_elementwise_max(v0, (f32x4){0.f, 0.f, 0.f, 0.f}); v1 = __builtin_elementwise_max(v1, (f32x4){0.f, 0.f, 0.f, 0.f});
                    v0 = v0 * v0; v1 = v1 * v1;
                    u32x4 w; w.x = pk2(v0[0], v0[1]); w.y = pk2(v0[2], v0[3]); w.z = pk2(v1[0], v1[1]); w.w = pk2(v1[2], v1[3]);
                    *(u32x4*)(U + (size_t)row * DFF + col0 + bj * 128) = w;
                }
                ROWFENCE();
            }
    }
};
struct EpiInProj {
    static constexpr bool PERM = true, AFTER_DRAIN = false;
    const float* ss; unsigned char* P; const float* lbt;
    const float* gt; const float* fbias;
    __device__ __forceinline__ void operator()(const f32x4 (&acc)[2][2][4][2], const pg8::Unit& u, int wr, int wc, int fr, int fq) const {
        const int slot = u.pn * 4 + wc;
        if (slot > 52) return;
        const int row0 = u.pm * 256 + wr * 64 + fr;
        if (slot < 16) {
            const int kind = slot >> 2, cb = (slot & 3) * 64 + 8 * fq;
            if (kind == 1) {
                float* HLF = (float*)(P + P_HLF); bf16_t* HK = (bf16_t*)(P + P_HK);
#pragma unroll
                for (int ai = 0; ai < 2; ++ai)
#pragma unroll
                    for (int m = 0; m < 4; ++m) {
                        const int row = row0 + ai * 128 + m * 16; const float rs = rowscale(ss, row, fq);
#pragma unroll
                        for (int bj = 0; bj < 2; ++bj) {
                            float lf[8], kk[8];
#pragma unroll
                            for (int n = 0; n < 2; ++n) {
                                const f32x4 ll = *(const f32x4*)(lbt + cb + 32 * bj + 4 * n), om = *(const f32x4*)(lbt + 256 + cb + 32 * bj + 4 * n);
#pragma unroll
                                for (int i = 0; i < 4; ++i) {
                                    const float fl = acc[ai][bj][m][n][i] * rs;
                                    const float a = fminf(fl, 0.f) - __logf(1.0f + __expf(-fabsf(fl)));
                                    const float an = a - fl;
                                    const float b = ll[i] + an;
                                    lf[4 * n + i] = fmaxf(a, b) + __logf(1.0f + __expf(-fabsf(a - b)));
                                    kk[4 * n + i] = om[i] * __expf(an);
                                }
                            }
                            const size_t off = (size_t)row * 256 + cb + 32 * bj;
                            *(f32x4*)(HLF + off) = (f32x4){lf[0], lf[1], lf[2], lf[3]}; *(f32x4*)(HLF + off + 4) = (f32x4){lf[4], lf[5], lf[6], lf[7]};
                            u32x4 w; w.x = pk2(kk[0], kk[1]); w.y = pk2(kk[2], kk[3]); w.z = pk2(kk[4], kk[5]); w.w = pk2(kk[6], kk[7]);
                            *(u32x4*)(HK + off) = w;
                        }
                        ROWFENCE();
                    }
            } else {
                bf16_t* dst = (bf16_t*)(P + (kind == 0 ? P_HQ : (kind == 2 ? P_HI : P_HG)));
#pragma unroll
                for (int ai = 0; ai < 2; ++ai)
#pragma unroll
                    for (int m = 0; m < 4; ++m) {
                        const int row = row0 + ai * 128 + m * 16; const float rs = rowscale(ss, row, fq);
#pragma unroll
                        for (int bj = 0; bj < 2; ++bj) {
                            const f32x4 v0 = acc[ai][bj][m][0] * rs, v1 = acc[ai][bj][m][1] * rs;
                            u32x4 w; w.x = pk2(v0[0], v0[1]); w.y = pk2(v0[2], v0[3]); w.z = pk2(v1[0], v1[1]); w.w = pk2(v1[2], v1[3]);
                            *(u32x4*)(dst + (size_t)row * 256 + cb + 32 * bj) = w;
                        }
                        ROWFENCE();
                    }
            }
        } else if (slot < 52) {
            const int s2 = slot - 16, grp = s2 / 6, h = s2 % 6, role = grp % 3;
            bf16_t* dst = (bf16_t*)(P + P_SQ + (size_t)grp * HEADBUF) + (size_t)((u.pm >> 4) * 6 + h) * SEQ * 64 + 8 * fq;
            const float* gp = gt + (grp - (grp >= 3 ? 1 : 0)) * 64 + 8 * fq;
            const float qs = (role == 0) ? (grp == 3 ? 0.125f * 1.4426950408889634f : 0.125f) : 1.0f;
#pragma unroll
            for (int ai = 0; ai < 2; ++ai)
#pragma unroll
                for (int m = 0; m < 4; ++m) {
                    const int row = row0 + ai * 128 + m * 16; const float rs = rowscale(ss, row, fq);
                    float fac = rs;
                    if (role != 2) {
                        float sq = 0.f;
#pragma unroll
                        for (int bj = 0; bj < 2; ++bj)
#pragma unroll
                            for (int n = 0; n < 2; ++n) { const f32x4 x = acc[ai][bj][m][n]; sq += (x[0] * x[0] + x[1] * x[1]) + (x[2] * x[2] + x[3] * x[3]); }
                        sq += __shfl_xor(sq, 16); sq += __shfl_xor(sq, 32);
                        fac = rs * rsqrtf(rs * rs * sq * (1.0f / 64.0f) + EPS) * qs;
                    }
                    const int t = row & (SEQ - 1);
#pragma unroll
                    for (int bj = 0; bj < 2; ++bj) {
                        f32x4 v0 = acc[ai][bj][m][0] * fac, v1 = acc[ai][bj][m][1] * fac;
                        if (role != 2) { v0 = v0 * *(const f32x4*)(gp + 32 * bj); v1 = v1 * *(const f32x4*)(gp + 32 * bj + 4); }
                        u32x4 w; w.x = pk2(v0[0], v0[1]); w.y = pk2(v0[2], v0[3]); w.z = pk2(v1[0], v1[1]); w.w = pk2(v1[2], v1[3]);
                        *(u32x4*)(dst + (size_t)t * 64 + 32 * bj) = w;
                    }
                    ROWFENCE();
                }
        } else {
            float* LF = (float*)(P + P_LF);
#pragma unroll
            for (int ai = 0; ai < 2; ++ai)
#pragma unroll
                for (int m = 0; m < 4; ++m) {
                    const int row = row0 + ai * 128 + m * 16; const float rs = rowscale(ss, row, fq);
                    if (fq == 0) {
                        const f32x4 a0 = acc[ai][0][m][0], a1 = acc[ai][0][m][1];
                        *(f32x4*)(LF + (size_t)row * 8) = (f32x4){logsig(a0[0] * rs + fbias[0]), logsig(a0[1] * rs + fbias[1]), logsig(a0[2] * rs + fbias[2]), logsig(a0[3] * rs + fbias[3])};
                        *(f32x4*)(LF + (size_t)row * 8 + 4) = (f32x4){logsig(a1[0] * rs + fbias[4]), logsig(a1[1] * rs + fbias[5]), 0.f, 0.f};
                    }
                    ROWFENCE();
                }
        }
    }
};

__device__ __forceinline__ void tr_item(const float* W, int ldw, int ncols_valid, int src_col0, int k0, const float* gain, bf16_t* WT, int K, int n0, LAS float* scr, int lane) {
#pragma unroll 8
    for (int i = 0; i < 32; ++i) { const int kk = 2 * i + (lane >> 5), c = src_col0 + (lane & 31);
        float v = (c < ncols_valid) ? W[(size_t)(k0 + kk) * ldw + c] : 0.f; if (gain) v *= gain[k0 + kk]; scr[kk * 33 + (lane & 31)] = v; }
    asm volatile("s_waitcnt lgkmcnt(0)" ::: "memory");
    const int c = lane & 7;
#pragma unroll
    for (int j = 0; j < 4; ++j) { const int n = (lane >> 3) + 8 * j; const LAS float* s = scr + (8 * c) * 33 + n;
        u32x4 o; o.x = pk2(s[0 * 33], s[1 * 33]); o.y = pk2(s[2 * 33], s[3 * 33]); o.z = pk2(s[4 * 33], s[5 * 33]); o.w = pk2(s[6 * 33], s[7 * 33]);
        *(u32x4*)(WT + (size_t)(n0 + n) * K + k0 + 8 * c) = o; }
    asm volatile("s_waitcnt lgkmcnt(0)" ::: "memory");
}

__device__ __forceinline__ void unpack8(const u32x4 w, float* d) { d[0] = bflo(w.x); d[1] = bfhi(w.x); d[2] = bflo(w.y); d[3] = bfhi(w.y); d[4] = bflo(w.z); d[5] = bfhi(w.z); d[6] = bflo(w.w); d[7] = bfhi(w.w); }

__device__ __forceinline__ void fox_cumsum_item(int bh, const float* LF, float* CC, LAS float* sc) {
    int tid_ = threadIdx.x; asm volatile("" : "+v"(tid_)); const int tid = tid_, lane = tid & 63, wave = tid >> 6, b = bh / 6, h = bh % 6;
    float v[8]; float run = 0.f;
#pragma unroll
    for (int i = 0; i < 8; ++i) { run += LF[((size_t)b * SEQ + tid * 8 + i) * 8 + h]; v[i] = run; }
    float s = run;
#pragma unroll
    for (int o = 1; o < 64; o <<= 1) { const float n = __shfl_up(s, o); if (lane >= o) s += n; }
    __syncthreads();
    if (lane == 63) sc[wave] = s;
    __syncthreads();
    float base = s - run;
    for (int w = 0; w < wave; ++w) base += sc[w];
#pragma unroll
    for (int i = 0; i < 8; ++i) CC[(size_t)bh * SEQ + tid * 8 + i] = (v[i] + base) * 1.4426950408889634f;
}

__device__ __forceinline__ void stage_kv(const bf16_t* Kb, const bf16_t* Vb, int kt, LAS float* Kf, LAS float* Vf) {
    int tid_ = threadIdx.x; asm volatile("" : "+v"(tid_)); const int tid = tid_, key = tid >> 3, c8 = tid & 7;
    const u32x4 kw = *(const u32x4*)(Kb + ((size_t)(kt * 64 + key)) * 64 + c8 * 8), vw = *(const u32x4*)(Vb + ((size_t)(kt * 64 + key)) * 64 + c8 * 8);
    float kf[8], vf[8]; unpack8(kw, kf); unpack8(vw, vf);
    *(LAS f32x4*)(Kf + key * 64 + c8 * 8) = (f32x4){kf[0], kf[1], kf[2], kf[3]}; *(LAS f32x4*)(Kf + key * 64 + c8 * 8 + 4) = (f32x4){kf[4], kf[5], kf[6], kf[7]};
    *(LAS f32x4*)(Vf + key * 64 + c8 * 8) = (f32x4){vf[0], vf[1], vf[2], vf[3]}; *(LAS f32x4*)(Vf + key * 64 + c8 * 8 + 4) = (f32x4){vf[4], vf[5], vf[6], vf[7]};
}

__device__ __forceinline__ void fox_naive_item(int item, unsigned char* P, bf16_t* MIX, LAS float* lds) {
    int tid_ = threadIdx.x; asm volatile("" : "+v"(tid_)); const int tid = tid_, bh = item >> 3, qblk = item & 7, b = bh / 6, h = bh % 6, t = qblk * 512 + tid;
    const bf16_t* Qp = (const bf16_t*)(P + P_FQ) + ((size_t)bh * SEQ + t) * 64;
    const bf16_t* Kb = (const bf16_t*)(P + P_FQ + HEADBUF) + (size_t)bh * SEQ * 64;
    const bf16_t* Vb = (const bf16_t*)(P + P_FQ + 2 * HEADBUF) + (size_t)bh * SEQ * 64;
    const float* CC = (const float*)(P + P_CC) + (size_t)bh * SEQ;
    float q[64], o[64];
#pragma unroll
    for (int c = 0; c < 8; ++c) unpack8(*(const u32x4*)(Qp + c * 8), q + c * 8);
#pragma unroll
    for (int d = 0; d < 64; ++d) o[d] = 0.f;
    float m = -1e30f, l = 0.f; const float ct = CC[t];
    LAS float* Kf = lds; LAS float* Vf = lds + 4096; LAS float* cs = lds + 8192;
    const int ntile = (qblk + 1) * 8;
    for (int kt = 0; kt < ntile; ++kt) {
        __syncthreads();
        stage_kv(Kb, Vb, kt, Kf, Vf); if (tid < 64) cs[tid] = CC[kt * 64 + tid];
        __syncthreads();
        for (int s = 0; s < 64; ++s) {
            float z = 0.f;
#pragma unroll
            for (int d = 0; d < 64; ++d) z += q[d] * Kf[s * 64 + d];
            const float x = (kt * 64 + s <= t) ? z + (ct - cs[s]) : -1e30f;
            const float mn = fmaxf(m, x), sc = __expf(m - mn), p = __expf(x - mn);
            l = l * sc + p;
#pragma unroll
            for (int d = 0; d < 64; ++d) o[d] = o[d] * sc + p * Vf[s * 64 + d];
            m = mn;
        }
    }
    const float inv = 1.0f / l;
    bf16_t* op = MIX + ((size_t)b * SEQ + t) * DM + 640 + h * 64;
#pragma unroll
    for (int c = 0; c < 8; ++c) { u32x4 w; w.x = pk2(o[c * 8] * inv, o[c * 8 + 1] * inv); w.y = pk2(o[c * 8 + 2] * inv, o[c * 8 + 3] * inv); w.z = pk2(o[c * 8 + 4] * inv, o[c * 8 + 5] * inv); w.w = pk2(o[c * 8 + 6] * inv, o[c * 8 + 7] * inv); *(u32x4*)(op + c * 8) = w; }
}

__device__ __forceinline__ void sb_naive_item(int item, unsigned char* P, bf16_t* MIX, LAS float* lds) {
    int tid_ = threadIdx.x; asm volatile("" : "+v"(tid_)); const int tid = tid_, bh = item >> 3, qblk = item & 7, b = bh / 6, h = bh % 6, t = qblk * 512 + tid;
    const bf16_t* Qp = (const bf16_t*)(P + P_SQ) + ((size_t)bh * SEQ + t) * 64;
    const bf16_t* Kb = (const bf16_t*)(P + P_SQ + HEADBUF) + (size_t)bh * SEQ * 64;
    const bf16_t* Vb = (const bf16_t*)(P + P_SQ + 2 * HEADBUF) + (size_t)bh * SEQ * 64;
    float q[64], o[64];
#pragma unroll
    for (int c = 0; c < 8; ++c) unpack8(*(const u32x4*)(Qp + c * 8), q + c * 8);
#pragma unroll
    for (int d = 0; d < 64; ++d) o[d] = 0.f;
    float tail = 0.f;
    LAS float* Kf = lds; LAS float* Vf = lds + 4096;
    for (int kt = qblk * 8 + 7; kt >= 0; --kt) {
        __syncthreads();
        stage_kv(Kb, Vb, kt, Kf, Vf);
        __syncthreads();
        for (int s = 63; s >= 0; --s) {
            float z = 0.f;
#pragma unroll
            for (int d = 0; d < 64; ++d) z += q[d] * Kf[s * 64 + d];
            const float ls = fminf(z, 0.f) - __logf(1.0f + __expf(-fabsf(z)));
            const bool act = (kt * 64 + s) < t;
            const float A = act ? __expf(ls + tail) : 0.f;
#pragma unroll
            for (int d = 0; d < 64; ++d) o[d] += A * Vf[s * 64 + d];
            tail += act ? (ls - z) : 0.f;
        }
        if (__syncthreads_and(tail < -100.f)) break;
    }
    bf16_t* op = MIX + ((size_t)b * SEQ + t) * DM + 256 + h * 64;
#pragma unroll
    for (int c = 0; c < 8; ++c) { u32x4 w; w.x = pk2(o[c * 8], o[c * 8 + 1]); w.y = pk2(o[c * 8 + 2], o[c * 8 + 3]); w.z = pk2(o[c * 8 + 4], o[c * 8 + 5]); w.w = pk2(o[c * 8 + 6], o[c * 8 + 7]); *(u32x4*)(op + c * 8) = w; }
}

__device__ __forceinline__ void hgrn_naive_item(int item, unsigned char* P, bf16_t* MIX, const float* hgn, LAS float* lds) {
    int tid_ = threadIdx.x; asm volatile("" : "+v"(tid_)); const int tid = tid_, lane = tid & 63, w = tid >> 6, kg = lane >> 3, vi = lane & 7, vcol = 8 * w + vi, b = item >> 2, h = item & 3;
    const bf16_t* HQ = (const bf16_t*)(P + P_HQ); const bf16_t* HK = (const bf16_t*)(P + P_HK); const bf16_t* HI = (const bf16_t*)(P + P_HI); const bf16_t* HG = (const bf16_t*)(P + P_HG);
    const float* HLF = (const float*)(P + P_HLF);
    LAS float* qf = lds; LAS float* kf = lds + 4096; LAS float* ff = lds + 8192; LAS float* vf = lds + 12288; LAS float* ob = lds + 16384;
    float S[8];
#pragma unroll
    for (int j = 0; j < 8; ++j) S[j] = 0.f;
    const int tok = tid >> 3, c8 = tid & 7;
    float gn[8];
#pragma unroll
    for (int e = 0; e < 8; ++e) gn[e] = hgn[c8 * 8 + e];
    for (int c = 0; c < 64; ++c) {
        const size_t off = ((size_t)b * SEQ + c * 64 + tok) * 256 + h * 64 + c8 * 8;
        __syncthreads();
        {
            float a[8];
            unpack8(*(const u32x4*)(HQ + off), a);
#pragma unroll
            for (int e = 0; e < 8; ++e) qf[tok * 64 + c8 * 8 + e] = a[e];
            unpack8(*(const u32x4*)(HK + off), a);
#pragma unroll
            for (int e = 0; e < 8; ++e) kf[tok * 64 + c8 * 8 + e] = a[e];
            unpack8(*(const u32x4*)(HI + off), a);
#pragma unroll
            for (int e = 0; e < 8; ++e) vf[tok * 64 + c8 * 8 + e] = a[e];
            const f32x4 l0 = *(const f32x4*)(HLF + off), l1 = *(const f32x4*)(HLF + off + 4);
#pragma unroll
            for (int e = 0; e < 4; ++e) { ff[tok * 64 + c8 * 8 + e] = expf(l0[e]); ff[tok * 64 + c8 * 8 + 4 + e] = expf(l1[e]); }
        }
        __syncthreads();
        for (int tk = 0; tk < 64; ++tk) {
            const float vv = vf[tk * 64 + vcol]; float op = 0.f;
#pragma unroll
            for (int j = 0; j < 8; ++j) { const int k = 8 * kg + j; S[j] = ff[tk * 64 + k] * S[j] + kf[tk * 64 + k] * vv; op += qf[tk * 64 + k] * S[j]; }
            op += __shfl_xor(op, 8); op += __shfl_xor(op, 16); op += __shfl_xor(op, 32);
            if (kg == 0) ob[tk * 64 + vcol] = op;
        }
        __syncthreads();
        {
            float ov[8], g[8]; float sq = 0.f;
#pragma unroll
            for (int e = 0; e < 8; ++e) { ov[e] = ob[tok * 64 + c8 * 8 + e]; sq += ov[e] * ov[e]; }
            sq += __shfl_xor(sq, 1); sq += __shfl_xor(sq, 2); sq += __shfl_xor(sq, 4);
            const float rn = rsqrtf(sq * (1.0f / 64.0f) + EPS);
            unpack8(*(const u32x4*)(HG + off), g);
            float r[8];
#pragma unroll
            for (int e = 0; e < 8; ++e) r[e] = ov[e] * rn * gn[e] * (g[e] / (1.0f + expf(-g[e])));
            u32x4 wv; wv.x = pk2(r[0], r[1]); wv.y = pk2(r[2], r[3]); wv.z = pk2(r[4], r[5]); wv.w = pk2(r[6], r[7]);
            *(u32x4*)(MIX + ((size_t)b * SEQ + c * 64 + tok) * DM + h * 64 + c8 * 8) = wv;
        }
    }
}

struct Args { const float* in[14]; float* out; unsigned char* ws; int ph_lo, ph_hi; };
constexpr int NPHASE = 1 + 6 * DEPTH;

__global__ void __launch_bounds__(512, 2) fwd(Args a) {
    extern __shared__ __attribute__((aligned(16))) unsigned char lds[];
    cg::grid_group grid = cg::this_grid();
    LAS unsigned char* L = (LAS unsigned char*)lds;
    for (int ph = a.ph_lo; ph < a.ph_hi; ++ph) {
        int G = gridDim.x, bx = blockIdx.x; asm volatile("" : "+s"(G), "+s"(bx));
        typedef const __attribute__((address_space(4))) Args* KArgP;
        KArgP ap = (KArgP)__builtin_amdgcn_kernarg_segment_ptr(); asm volatile("" : "+s"(ap));
        unsigned char* ws = ap->ws;
        float* SS = (float*)(ws + WS_SS); float* LB = (float*)(ws + WS_LB);
        bf16_t* XB = (bf16_t*)(ws + WS_XB); bf16_t* MIX = (bf16_t*)(ws + WS_MIX); bf16_t* UB = (bf16_t*)(ws + WS_U);
        unsigned char* P = ws + WS_P;
        if (ph == 0) {
            int tid = threadIdx.x; asm volatile("" : "+v"(tid)); const int lane = tid & 63, wave = __builtin_amdgcn_readfirstlane(tid >> 6);
            LAS float* scr = (LAS float*)(L + wave * 16384);
            const int gw = bx * 8 + wave, NGW = G * 8;
            constexpr int I_IN = 16 * 112, I_OUT = 16 * 32, I_1 = 16 * 128, I_2 = 64 * 32, I_L = I_IN + I_OUT + I_1 + I_2;
            for (int it = gw; it < DEPTH * I_L; it += NGW) {
                const int l = it / I_L; int r = it % I_L;
                unsigned char* wl = ws + WS_W + (size_t)l * W_LAYER;
                if (r < I_IN) { const int kb = r / 112, nb = r % 112, n0 = nb * 32, pn = n0 >> 8, p = n0 & 255, slot = 4 * pn + ((p & 127) >> 5), sc0 = 64 * slot + 32 * (p >> 7);
                    tr_item(ap->in[3] + (size_t)l * DM * INC, INC, INC, sc0, kb * 64, ap->in[2] + l * DM, (bf16_t*)wl, DM, n0, scr, lane); continue; }
                r -= I_IN;
                if (r < I_OUT) { const int kb = r / 32, nb = r % 32; tr_item(ap->in[10] + (size_t)l * DM * DM, DM, DM, nb * 32, kb * 64, nullptr, (bf16_t*)(wl + W_OUT), DM, nb * 32, scr, lane); continue; }
                r -= I_OUT;
                if (r < I_1) { const int kb = r / 128, nb = r % 128; tr_item(ap->in[12] + (size_t)l * DM * DFF, DFF, DFF, nb * 32, kb * 64, ap->in[11] + l * DM, (bf16_t*)(wl + W_1), DM, nb * 32, scr, lane); continue; }
                r -= I_1;
                { const int kb = r / 32, nb = r % 32; tr_item(ap->in[13] + (size_t)l * DFF * DM, DM, DM, nb * 32, kb * 64, nullptr, (bf16_t*)(wl + W_2), DFF, nb * 32, scr, lane); }
            }
            const float* x = ap->in[0];
            for (int m = gw; m < M; m += NGW) {
                const f32x4* xr = (const f32x4*)(x + (size_t)m * DM) + lane; f32x4 v[4]; float s = 0.f;
#pragma unroll
                for (int j = 0; j < 4; ++j) { v[j] = xr[64 * j]; s += (v[j][0] * v[j][0] + v[j][1] * v[j][1]) + (v[j][2] * v[j][2] + v[j][3] * v[j][3]); }
                const float tot = wave_sum(s);
                u32x2* o8 = (u32x2*)(XB + (size_t)m * DM) + lane;
#pragma unroll
                for (int j = 0; j < 4; ++j) { u32x2 w; w.x = pk2(v[j][0], v[j][1]); w.y = pk2(v[j][2], v[j][3]); o8[64 * j] = w; }
                if (lane < 16) SS[(size_t)m * 16 + lane] = (lane == 0) ? tot : 0.f;
            }
            if (bx == 2 && tid < 64) ((unsigned*)ws)[tid] = 0u;
            if (bx == 1) {
                for (int i = tid; i < 1024; i += 512) { const int l = i >> 8, wh = (i >> 6) & 3, d = i & 63; LB[2048 + i] = ap->in[5 + wh][l * 64 + d]; }
                if (tid < 32) { const int l = tid >> 3, e = tid & 7; LB[3072 + tid] = (e < 6) ? ap->in[9][l * 6 + e] : 0.f; }
            }
            if (bx == 0 && tid < 256) {
                const float* lg = ap->in[1]; float e[DEPTH]; float mx = -1e30f, sum = 0.f;
#pragma unroll
                for (int l = 0; l < DEPTH; ++l) mx = fmaxf(mx, lg[l * 256 + tid]);
#pragma unroll
                for (int l = 0; l < DEPTH; ++l) { e[l] = expf(lg[l * 256 + tid] - mx); sum += e[l]; }
                float c = 0.f;
#pragma unroll
                for (int l = 0; l < DEPTH; ++l) { if (l > 0) c += e[l] / sum; LB[l * 512 + tid] = logf(fmaxf(c, 1e-30f)); LB[l * 512 + 256 + tid] = 1.0f - c; }
            }
        } else {
            const int l = (ph - 1) / 6, k = (ph - 1) % 6;
            unsigned char* wl = ws + WS_W + (size_t)l * W_LAYER;
            if (k == 0) {
                pg8::Gemm g{XB, (const bf16_t*)wl, M, NIN, DM}; pg8::StaticOrder S; S.init(M, NIN, G, bx);
                EpiInProj E{SS, P, LB + l * 512, LB + 2048 + l * 256, LB + 3072 + l * 8};
                pg8::gemm_phase<EpiInProj, pg8::StaticOrder, true, true>(L, g, S, E);
            } else if (k == 1) {
                for (int it = bx; it < 464; it += G) {
                    if (it < 32) hgrn_naive_item(it, P, MIX, ap->in[4] + l * 64, (LAS float*)L);
                    else if (it < 80) fox_cumsum_item(it - 32, (const float*)(P + P_LF), (float*)(P + P_CC), (LAS float*)L);
                    else sb_naive_item(it - 80, P, MIX, (LAS float*)L);
                    __syncthreads();
                }
            } else if (k == 2) {
                int tid = threadIdx.x; asm volatile("" : "+v"(tid));
                unsigned* ctr = (unsigned*)ws + l * 16;
                volatile LAS int* sh = (volatile LAS int*)(L + LDS_BYTES - 64);
                for (;;) {
                    if (tid == 0) sh[0] = (int)atomicAdd(ctr, 1u);
                    __syncthreads();
                    const int idx = __builtin_amdgcn_readfirstlane(sh[0]);
                    __syncthreads();
                    if (idx >= 768) break;
                    const int qb = 15 - idx / 48, bh = idx % 48, b = bh / 6, h = bh % 6;
                    typedef attn_body::bf16 abf;
                    attn_body::attn_unit<8>(qb, (const abf*)(P + P_FQ) + (size_t)bh * SEQ * 64, (const abf*)(P + P_FQ + HEADBUF) + (size_t)bh * SEQ * 64, (const abf*)(P + P_FQ + 2 * HEADBUF) + (size_t)bh * SEQ * 64,
                                            (abf*)MIX + (size_t)b * SEQ * DM + 640 + h * 64, (const float*)(P + P_CC) + (size_t)bh * SEQ, (char*)lds);
                }
            } else if (k == 4) {
                pg8::Gemm g{XB, (const bf16_t*)(wl + W_1), M, DFF, DM}; pg8::StaticOrder S; S.init(M, DFF, G, bx);
                EpiRelu2 E{UB, SS};
                pg8::gemm_phase<EpiRelu2, pg8::StaticOrder, true, true>(L, g, S, E);
            } else {
                const bool ff2 = (k == 5);
                pg8::Gemm g{ff2 ? UB : MIX, (const bf16_t*)(wl + (ff2 ? W_2 : W_OUT)), M, DM, ff2 ? DFF : DM}; pg8::StaticOrder S; S.init(M, DM, G, bx);
                EpiResid E{(!ff2 && l == 0) ? ap->in[0] : ap->out, ap->out, XB, SS};
                pg8::gemm_phase<EpiResid, pg8::StaticOrder, true, true>(L, g, S, E);
            }
        }
        if (ph + 1 < a.ph_hi) grid.sync();
    }
}

#ifndef MK_MULTI
#define MK_MULTI 0
#endif
extern "C" void kernel_launch(void* const* d_in, const int* in_sizes, int n_in, void* d_out, int out_size, void* d_ws, size_t ws_size, hipStream_t stream) {
    static int grid = 0;
    if (grid == 0) {
        int dev = 0, cus = 0, per = 0;
        if (n_in != 14 || out_size != M * DM || ws_size < WS_END) { fprintf(stderr, "kernel_launch: unexpected shapes (n_in %d out %d ws %zu)\n", n_in, out_size, ws_size); grid = -1; return; }
        (void)hipGetDevice(&dev); (void)hipDeviceGetAttribute(&cus, hipDeviceAttributeMultiprocessorCount, dev);
        (void)hipFuncSetAttribute((const void*)fwd, hipFuncAttributeMaxDynamicSharedMemorySize, LDS_BYTES);
        (void)hipOccupancyMaxActiveBlocksPerMultiprocessor(&per, (const void*)fwd, 512, LDS_BYTES);
        if (per < 1) per = 1;
        grid = cus * per;
        fprintf(stderr, "kernel_launch: grid %d (cus %d x %d)\n", grid, cus, per);
    }
    if (grid < 0) return;
    Args a{};
    for (int i = 0; i < 14; ++i) a.in[i] = (const float*)d_in[i];
    a.out = (float*)d_out; a.ws = (unsigned char*)d_ws;
#if MK_MULTI
    for (int ph = 0; ph < NPHASE; ++ph) { a.ph_lo = ph; a.ph_hi = ph + 1; hipLaunchKernelGGL(fwd, dim3(grid), dim3(512), LDS_BYTES, stream, a); }
#else
    a.ph_lo = 0; a.ph_hi = NPHASE;
    void* args[] = {&a};
    hipError_t e = hipLaunchCooperativeKernel((const void*)fwd, dim3(grid), dim3(512), args, LDS_BYTES, stream);
    if (e != hipSuccess) fprintf(stderr, "kernel_launch: cooperative launch failed: %s (grid %d)\n", hipGetErrorString(e), grid);
#endif
}
```

```cpp
#include <hip/hip_runtime.h>
#include <hip/hip_cooperative_groups.h>
#include <cstdio>
#include <cstdint>
namespace cg = cooperative_groups;
namespace pg8 {
#define PG8_LAS __attribute__((address_space(3)))
typedef unsigned short bf16_t;
typedef short bf16x8 __attribute__((ext_vector_type(8)));
typedef float f32x4 __attribute__((ext_vector_type(4)));
typedef unsigned u32x4 __attribute__((ext_vector_type(4)));
constexpr int BM = 256, BK = 64, HALF = 128, HTB = HALF * BK * 2  , STAGE_BYTES = 8 * HTB, NXCD = 8, WGM = 8;

__host__ __device__ __forceinline__ int lds_byte(int r, int c) { const int st = (r >> 4) * 2 + (c >> 5), rr = r & 15, cc = c & 31, ob = rr * 64 + cc * 2; return st * 1024 + (ob ^ (((ob >> 9) & 1) << 5)); }
__host__ __device__ __forceinline__ void stage_rc(int b, int& R, int& C) { const int st = b / 1024, sb = b % 1024, swz = sb ^ (((sb >> 9) & 1) << 5); R = (st >> 1) * 16 + swz / 64; C = (st & 1) * 32 + (swz % 64) / 2; }
__host__ __device__ __forceinline__ int perm32(int rho) { const int n = rho >> 4, i = rho & 15; return 8 * (i >> 2) + 4 * n + (i & 3); }

struct Unit { int pm, pn; };
struct Gemm { const bf16_t* A; const bf16_t* Bt; int M, N, K; };

struct StaticOrder {
    int nM, nN, nwg, G, c;
    __host__ __device__ void init(int M, int N, int G_, int c_) { nM = M / BM; nN = N / BM; nwg = nM * nN; G = G_; c = c_; }
    __host__ __device__ bool next(int i, Unit& u) const {
        const long L = (long)i * G + c; if (L >= nwg) return false;
        int wgid = (int)L; { const int q = nwg / NXCD, r = nwg % NXCD, xcd = wgid % NXCD, off = wgid / NXCD; wgid = (xcd < r ? xcd * (q + 1) : r * (q + 1) + (xcd - r) * q) + off; }
        const int nig = WGM * nN, gid = wgid / nig, fm = gid * WGM, gsz = (nM - fm) < WGM ? (nM - fm) : WGM;
        u.pm = fm + ((wgid % nig) % gsz); u.pn = (wgid % nig) / gsz; return true;
    }
    __device__ __forceinline__ void a_ready(const Unit&) const {}
    __device__ __forceinline__ void done(const Unit&) const {}
};

__device__ __forceinline__ unsigned cvt_pk_bf16(float lo, float hi) { unsigned r; asm volatile("v_cvt_pk_bf16_f32 %0, %1, %2" : "=v"(r) : "v"(lo), "v"(hi)); return r; }
typedef float f32x2 __attribute__((ext_vector_type(2)));
template <class Epi, class Sched, bool ALIGN_EPI = false, bool SP2 = false>
__device__ __forceinline__ void gemm_phase(PG8_LAS unsigned char* lds, const Gemm g, const Sched& S, const Epi& E) {
    int tid_ = threadIdx.x; asm volatile("" : "+v"(tid_));
    const int tid = tid_, wid = __builtin_amdgcn_readfirstlane(tid >> 6), lane = tid & 63, wr = wid >> 2, wc = wid & 3, fr = lane & 15, fq = lane >> 4;
    const int K = g.K, nt = K / BK;
    unsigned voffA[2], voffB[2];
#pragma unroll
    for (int i = 0; i < 2; ++i) { int R, C; stage_rc(tid * 16 + i * 8192, R, C); const int Rb = Epi::PERM ? ((R & ~31) + perm32(R & 31)) : R;
        voffA[i] = (unsigned)(R * K + C) * 2u; voffB[i] = (unsigned)(Rb * K + C) * 2u; }
    const size_t kstep = (size_t)(BK * 2);
    const size_t hstep = (size_t)HALF * K * 2;
    const size_t tstep = 2 * hstep;
    const unsigned ldsw = (unsigned)wid * 1024u;
    const int aoff = lds_byte(wr * 64 + fr, fq * 8), boff = lds_byte(wc * 32 + fr, fq * 8);
#define PG8_SA(b, h) (((b) * 2 + (h)) * HTB)
#define PG8_SB(b, h) ((4 + (b) * 2 + (h)) * HTB)
#define PG8_STAGE(bufoff, gbase, voff) do { _Pragma("unroll") for (int _i = 0; _i < 2; ++_i) \
        __builtin_amdgcn_global_load_lds((const unsigned*)((const char*)(gbase) + (voff)[_i]), (PG8_LAS unsigned*)(lds + (bufoff) + ldsw + _i * 8192), 16, 0, 0); } while (0)
#define PG8_LDA(dst, b, h) do { _Pragma("unroll") for (int m = 0; m < 4; ++m) _Pragma("unroll") for (int k = 0; k < 2; ++k) dst[m][k] = *(const PG8_LAS bf16x8*)(lds + PG8_SA(b, h) + aoff + m * 2048 + k * 1024); } while (0)
#define PG8_LDB(dst, b, h) do { _Pragma("unroll") for (int n = 0; n < 2; ++n) _Pragma("unroll") for (int k = 0; k < 2; ++k) dst[n][k] = *(const PG8_LAS bf16x8*)(lds + PG8_SB(b, h) + boff + n * 2048 + k * 1024); } while (0)
#define PG8_MMA(ai, bj, At, Bt) do { __builtin_amdgcn_s_setprio(1); _Pragma("unroll") for (int m = 0; m < 4; ++m) _Pragma("unroll") for (int n = 0; n < 2; ++n) _Pragma("unroll") for (int k = 0; k < 2; ++k) \
        acc[ai][bj][m][n] = __builtin_amdgcn_mfma_f32_16x16x32_bf16(Bt[n][k], At[m][k], acc[ai][bj][m][n], 0, 0, 0); __builtin_amdgcn_s_setprio(0); } while (0)
#define PG8_WAIT_V(n) asm volatile("s_waitcnt vmcnt(" #n ")" ::: "memory")
#define PG8_WAIT_L(n) asm volatile("s_waitcnt lgkmcnt(" #n ")" ::: "memory")
#define PG8_BAR __builtin_amdgcn_s_barrier()
#define PG8_SCHED __builtin_amdgcn_sched_barrier(0)
    Unit cur, nxt; int ui = 0;
    if (!S.next(0, cur)) return;
    f32x4 acc[2][2][4][2];
#pragma unroll
    for (int a = 0; a < 2; ++a)
#pragma unroll
        for (int b = 0; b < 2; ++b)
#pragma unroll
            for (int m = 0; m < 4; ++m)
#pragma unroll
                for (int n = 0; n < 2; ++n) acc[a][b][m][n] = (f32x4){0.f, 0.f, 0.f, 0.f};
    bf16x8 At[4][2], B0[2][2], B1[2][2];
    const char* cA = (const char*)g.A + (size_t)cur.pm * tstep; const char* cB = (const char*)g.Bt + (size_t)cur.pn * tstep;
    S.a_ready(cur);
    if constexpr (SP2) {
        PG8_STAGE(PG8_SB(0, 0), cB, voffB); PG8_STAGE(PG8_SB(0, 1), cB + hstep, voffB); PG8_STAGE(PG8_SA(0, 0), cA, voffA); PG8_STAGE(PG8_SA(0, 1), cA + hstep, voffA);
        if (wr == 1) PG8_BAR;
        PG8_WAIT_V(2); PG8_BAR;
        PG8_STAGE(PG8_SB(1, 0), cB + kstep, voffB); PG8_STAGE(PG8_SA(1, 0), cA + kstep, voffA); PG8_STAGE(PG8_SB(1, 1), cB + hstep + kstep, voffB);
        PG8_WAIT_V(6); PG8_BAR;
    } else {
        PG8_STAGE(PG8_SB(0, 0), cB, voffB); PG8_STAGE(PG8_SA(0, 0), cA, voffA); PG8_STAGE(PG8_SB(0, 1), cB + hstep, voffB); PG8_STAGE(PG8_SA(0, 1), cA + hstep, voffA);
        if (wr == 1) PG8_BAR;
        PG8_WAIT_V(4); PG8_BAR;
        PG8_STAGE(PG8_SB(1, 0), cB + kstep, voffB); PG8_STAGE(PG8_SA(1, 0), cA + kstep, voffA); PG8_STAGE(PG8_SB(1, 1), cB + hstep + kstep, voffB);
        PG8_WAIT_V(6); PG8_BAR;
    }
    for (;;) {
        const bool has_next = S.next(ui + 1, nxt);
        const char* nA = has_next ? (const char*)g.A + (size_t)nxt.pm * tstep : cA; const char* nB = has_next ? (const char*)g.Bt + (size_t)nxt.pn * tstep : cB;
        for (int t = 0; t < nt; t += 2) {
            const bool last = (t == nt - 2);
            const char* a1 = cA + (size_t)(t + 1) * kstep;
            const char* a2 = last ? nA : cA + (size_t)(t + 2) * kstep; const char* b2 = last ? nB : cB + (size_t)(t + 2) * kstep;
            const char* a3 = a2 + kstep; const char* b3 = b2 + kstep;
            if (last && has_next) S.a_ready(nxt);
            if constexpr (SP2) {
            PG8_LDB(B0, 0, 0); PG8_LDB(B1, 0, 1); PG8_SCHED; PG8_LDA(At, 0, 0); PG8_STAGE(PG8_SA(1, 1), a1 + hstep, voffA);
            PG8_WAIT_V(8); PG8_WAIT_L(0); PG8_BAR; PG8_MMA(0, 0, At, B0); PG8_MMA(0, 1, At, B1); PG8_BAR; PG8_SCHED;
            PG8_LDA(At, 0, 1); PG8_STAGE(PG8_SB(0, 0), b2, voffB); PG8_STAGE(PG8_SB(0, 1), b2 + hstep, voffB); PG8_STAGE(PG8_SA(0, 0), a2, voffA);
            PG8_WAIT_V(8); PG8_WAIT_L(0); PG8_BAR; PG8_MMA(1, 0, At, B0); PG8_MMA(1, 1, At, B1); PG8_BAR; PG8_SCHED;
            PG8_LDB(B0, 1, 0); PG8_LDB(B1, 1, 1); PG8_SCHED; PG8_LDA(At, 1, 0); PG8_STAGE(PG8_SA(0, 1), a2 + hstep, voffA);
            PG8_WAIT_V(8); PG8_WAIT_L(0); PG8_BAR; PG8_MMA(0, 0, At, B0); PG8_MMA(0, 1, At, B1); PG8_BAR; PG8_SCHED;
            PG8_LDA(At, 1, 1); PG8_STAGE(PG8_SB(1, 0), b3, voffB); PG8_STAGE(PG8_SB(1, 1), b3 + hstep, voffB); PG8_STAGE(PG8_SA(1, 0), a3, voffA);
            PG8_WAIT_V(8); PG8_WAIT_L(0); PG8_BAR; PG8_MMA(1, 0, At, B0); PG8_MMA(1, 1, At, B1); PG8_BAR; PG8_SCHED;
            } else {
            PG8_LDB(B0, 0, 0); PG8_SCHED; PG8_LDA(At, 0, 0); PG8_STAGE(PG8_SA(1, 1), a1 + hstep, voffA);
            PG8_WAIT_L(8); PG8_BAR; PG8_WAIT_L(0); PG8_MMA(0, 0, At, B0); PG8_BAR; PG8_SCHED;
            PG8_LDB(B1, 0, 1); PG8_STAGE(PG8_SB(0, 0), b2, voffB);
            PG8_BAR; PG8_WAIT_L(0); PG8_MMA(0, 1, At, B1); PG8_BAR;
            PG8_LDA(At, 0, 1); PG8_STAGE(PG8_SA(0, 0), a2, voffA);
            PG8_BAR; PG8_WAIT_L(0); PG8_MMA(1, 0, At, B0); PG8_BAR; PG8_SCHED;
            PG8_STAGE(PG8_SB(0, 1), b2 + hstep, voffB);
            PG8_WAIT_V(6); PG8_BAR; PG8_MMA(1, 1, At, B1); PG8_BAR;
            PG8_LDB(B0, 1, 0); PG8_SCHED; PG8_LDA(At, 1, 0); PG8_STAGE(PG8_SA(0, 1), a2 + hstep, voffA);
            PG8_WAIT_L(8); PG8_BAR; PG8_WAIT_L(0); PG8_MMA(0, 0, At, B0); PG8_BAR; PG8_SCHED;
            PG8_LDB(B1, 1, 1); PG8_STAGE(PG8_SB(1, 0), b3, voffB);
            PG8_BAR; PG8_WAIT_L(0); PG8_MMA(0, 1, At, B1); PG8_BAR;
            PG8_LDA(At, 1, 1); PG8_STAGE(PG8_SA(1, 0), a3, voffA);
            PG8_BAR; PG8_WAIT_L(0); PG8_MMA(1, 0, At, B0); PG8_BAR; PG8_SCHED;
            PG8_STAGE(PG8_SB(1, 1), b3 + hstep, voffB);
            PG8_WAIT_V(6); PG8_BAR; PG8_MMA(1, 1, At, B1); PG8_BAR;
            }
        }
        if constexpr (ALIGN_EPI) { if (wr == 0) PG8_BAR; }
        if constexpr (!Epi::AFTER_DRAIN) { E(acc, cur, wr, wc, fr, fq); S.done(cur); }
        if (!has_next) break;
#pragma unroll
        for (int a = 0; a < 2; ++a)
#pragma unroll
            for (int b = 0; b < 2; ++b)
#pragma unroll
                for (int m = 0; m < 4; ++m)
#pragma unroll
                    for (int n = 0; n < 2; ++n) acc[a][b][m][n] = (f32x4){0.f, 0.f, 0.f, 0.f};
        cur = nxt; cA = nA; cB = nB; ++ui;
        if constexpr (ALIGN_EPI) { if (wr == 1) PG8_BAR; }
    }
    PG8_WAIT_V(0);
    if constexpr (!ALIGN_EPI) { if (wr == 0) PG8_BAR; }
    PG8_BAR;
    if constexpr (Epi::AFTER_DRAIN) { E.fused(acc, cur, wr, wc, fr, fq, lds, wid, lane); S.done(cur); }
#undef PG8_SA
#undef PG8_SB
#undef PG8_STAGE
#undef PG8_LDA
#undef PG8_LDB
#undef PG8_MMA
#undef PG8_WAIT_V
#undef PG8_WAIT_L
#undef PG8_BAR
#undef PG8_SCHED
}
}
#include <hip/hip_bf16.h>
#include <cmath>
namespace attn_body {
using bf16=__hip_bfloat16;
using bf16x8=__attribute__((ext_vector_type(8)))short;
using s16x4=__attribute__((ext_vector_type(4)))short;
using f32x16=__attribute__((ext_vector_type(16)))float;
using u32x4=__attribute__((ext_vector_type(4)))unsigned;
using f32x4v=__attribute__((ext_vector_type(4)))float;
constexpr int SEQ=4096,D=64,DM=64,OPITCH=1024;
constexpr int LDS_C=98304;
constexpr int NW=8,QBLK=32,QB=QBLK*NW,KVBLK=64,NQB=SEQ/QB;
constexpr int ATTN_UNIT_ROWS=QB;
__device__ __forceinline__ int crow(int r,int hi){return (r&3)+8*(r>>2)+4*hi;}
#define SBAR() __builtin_amdgcn_sched_barrier(0)
__device__ __forceinline__ void cmask(f32x16&p0,f32x16&p1,int jb,int qrel,int hi){
  const float NEG=-INFINITY; int kb=64*jb+4*hi;
  #pragma unroll
  for(int r=0;r<16;++r){int kv=kb+(r&3)+8*(r>>2); if(kv>qrel)p0[r]=NEG; if(kv+32>qrel)p1[r]=NEG;}
}

constexpr int NSLOT=3, SLOTB=8192;
constexpr int LDS_K=0, LDS_V=NSLOT*SLOTB, LDS_WS=2*NSLOT*SLOTB, LDS_OST=LDS_WS+NW*64*4, LDS_BYTES=LDS_OST+NW*4096;
constexpr float C2=0.125f*1.4426950408889634f;
__device__ __forceinline__ void glds16(const void*gsrc,unsigned lds_dst){unsigned keep;
  asm volatile("s_mov_b32 %0, m0\n\ts_mov_b32 m0, %2\n\ts_nop 0\n\tglobal_load_lds_dwordx4 %1, off\n\ts_mov_b32 m0, %0":"=&s"(keep):"v"(gsrc),"s"(lds_dst):"memory");}
__device__ __forceinline__ float max3f(float a,float b,float c){float r;asm("v_max3_f32 %0, %1, %2, %3":"=v"(r):"v"(a),"v"(b),"v"(c));return r;}
__device__ __forceinline__ float max2f(float a,float b){float r;asm("v_max_f32_e32 %0, %1, %2":"=v"(r):"v"(a),"v"(b));return r;}
__device__ __forceinline__ float fadd_s(float a,float b){float r;asm("v_add_f32_e32 %0, %1, %2":"=v"(r):"v"(a),"v"(b));return r;}
__device__ __forceinline__ float fsub_s(float a,float b){float r;asm("v_sub_f32_e32 %0, %1, %2":"=v"(r):"v"(a),"v"(b));return r;}
typedef float f32x2_t __attribute__((ext_vector_type(2))); typedef __bf16 bf16x2_t __attribute__((ext_vector_type(2)));
__device__ __forceinline__ unsigned cvtpk_s(float lo,float hi){f32x2_t v={lo,hi};bf16x2_t b=__builtin_convertvector(v,bf16x2_t);return __builtin_bit_cast(unsigned,b);}
#define WAIT_BAR(N) asm volatile("s_waitcnt vmcnt(" #N ") lgkmcnt(0)\n\ts_barrier":::"memory")

__device__ __forceinline__ void qkt(f32x16&p0,f32x16&p1,const char*Kslot,const bf16x8*qr,const f32x16&negm,int r32,int hi){
  const char*kb=Kslot+hi*1024+r32*16;
  #pragma unroll
  for(int d0=0;d0<4;++d0){
    const bf16x8 b0=*reinterpret_cast<const bf16x8*>(kb+d0*2048);
    const bf16x8 b1=*reinterpret_cast<const bf16x8*>(kb+d0*2048+512);
    if(d0==0){p0=__builtin_amdgcn_mfma_f32_32x32x16_bf16(b0,qr[0],negm,0,0,0);p1=__builtin_amdgcn_mfma_f32_32x32x16_bf16(b1,qr[0],negm,0,0,0);}
    else{p0=__builtin_amdgcn_mfma_f32_32x32x16_bf16(b0,qr[d0],p0,0,0,0);p1=__builtin_amdgcn_mfma_f32_32x32x16_bf16(b1,qr[d0],p1,0,0,0);}}
}
typedef __attribute__((address_space(3))) const char* lds_cptr;
typedef short v4i16_t __attribute__((ext_vector_type(4)));
__device__ __forceinline__ void kload8(bf16x8*kf,lds_cptr kp){
  kf[0]=*(const __attribute__((address_space(3))) bf16x8*)(kp);      kf[1]=*(const __attribute__((address_space(3))) bf16x8*)(kp+512);
  kf[2]=*(const __attribute__((address_space(3))) bf16x8*)(kp+2048); kf[3]=*(const __attribute__((address_space(3))) bf16x8*)(kp+2560);
  kf[4]=*(const __attribute__((address_space(3))) bf16x8*)(kp+4096); kf[5]=*(const __attribute__((address_space(3))) bf16x8*)(kp+4608);
  kf[6]=*(const __attribute__((address_space(3))) bf16x8*)(kp+6144); kf[7]=*(const __attribute__((address_space(3))) bf16x8*)(kp+6656);
}
__device__ __forceinline__ void kload2(bf16x8*kf,lds_cptr kp,int j){ kf[2*j]=*(const __attribute__((address_space(3))) bf16x8*)(kp+j*2048); kf[2*j+1]=*(const __attribute__((address_space(3))) bf16x8*)(kp+j*2048+512); }
__device__ __forceinline__ s16x4 vtr(lds_cptr p){ return __builtin_bit_cast(s16x4,__builtin_amdgcn_ds_read_tr16_b64_v4i16((__attribute__((address_space(3))) v4i16_t*)p)); }
__device__ __forceinline__ float rowmax(const f32x16&p0,const f32x16&p1){
  float a=max3f(p0[0],p0[1],p1[0]),b=max3f(p0[2],p0[3],p1[1]);a=max3f(a,p1[2],p1[3]);
  #pragma unroll
  for(int r=4;r<16;r+=4){a=max3f(a,p0[r],p0[r+1]);b=max3f(b,p0[r+2],p0[r+3]);a=max3f(a,p1[r],p1[r+1]);b=max3f(b,p1[r+2],p1[r+3]);}
  const float m=max2f(a,b);
  auto rr=__builtin_amdgcn_permlane32_swap(__float_as_uint(m),__float_as_uint(m),false,false);
  return max2f(__uint_as_float(rr[0]),__uint_as_float(rr[1]));
}
__device__ __forceinline__ void pv(f32x16*o,int vb,bf16x8 pa0,bf16x8 pa1,bf16x8 pa2,bf16x8 pa3){
  #pragma unroll
  for(int d0=0;d0<2;++d0){s16x4 lo[4],hi[4];
    #pragma unroll
    for(int ks=0;ks<4;++ks){
      asm volatile("ds_read_b64_tr_b16 %0,%1 offset:%c2":"=&v"(lo[ks]):"v"(vb),"i"(d0*4096+ks*1024):"memory");
      asm volatile("ds_read_b64_tr_b16 %0,%1 offset:%c2":"=&v"(hi[ks]):"v"(vb),"i"(d0*4096+ks*1024+512):"memory");}
    asm volatile("s_waitcnt lgkmcnt(0)":::"memory");SBAR();
    #define PK(k) (bf16x8){lo[k][0],lo[k][1],lo[k][2],lo[k][3],hi[k][0],hi[k][1],hi[k][2],hi[k][3]}
    o[d0]=__builtin_amdgcn_mfma_f32_32x32x16_bf16(pa0,PK(0),o[d0],0,0,0);
    o[d0]=__builtin_amdgcn_mfma_f32_32x32x16_bf16(pa1,PK(1),o[d0],0,0,0);
    o[d0]=__builtin_amdgcn_mfma_f32_32x32x16_bf16(pa2,PK(2),o[d0],0,0,0);
    o[d0]=__builtin_amdgcn_mfma_f32_32x32x16_bf16(pa3,PK(3),o[d0],0,0,0);
    #undef PK
  }
}

#ifndef ATTN_STORE16
#define ATTN_STORE16(p,v) (*(u32x4*)(p)=(v))
#endif
template<int THRL> __device__ __forceinline__ void attn_unit(int qb,const bf16*Q,const bf16*__restrict__ K,const bf16*__restrict__ V,bf16*O,const float*__restrict__ Cg,char*shm){
  int tid_=threadIdx.x; asm volatile("":"+v"(tid_)); const int tid=tid_,lane=tid&63,r32=lane&31,hi=lane>>5; const int wid=__builtin_amdgcn_readfirstlane(tid>>6);
  const int q0=qb*QB;
  const bf16*Qw=Q+(long)(q0+wid*QBLK)*DM;
  const bf16*Kh=K,*Vh=V;
  const lds_cptr shm3=(lds_cptr)shm;
  const unsigned lds0=(unsigned)(uintptr_t)shm;
  float*wsf=(float*)(shm+LDS_WS)+wid*64;
  const bf16*ksrc=Kh+(long)lane*DM+wid*8;
  const bf16*vsrc=Vh+(long)(16*(wid&3)+(lane>>2))*DM+(wid>>2)*32+(lane&3)*8;
  const unsigned kdst=lds0+LDS_K+wid*1024, vdst=lds0+LDS_V+wid*1024;
  #define DMA_K(t,slot) glds16(ksrc+(long)(t)*KVBLK*DM,(unsigned)__builtin_amdgcn_readfirstlane(kdst+(slot)))
  #define DMA_V(t,slot) glds16(vsrc+(long)(t)*KVBLK*DM,(unsigned)__builtin_amdgcn_readfirstlane(vdst+(slot)))
  const int vb0=(int)(lds0+LDS_V)+((lane>>4)&1)*32+(lane&3)*8+(4*hi+((lane&15)>>2))*64;
  const char*Kbase=shm+LDS_K; bf16x8 kf[8];
  const lds_cptr kp0=shm3+LDS_K+hi*1024+r32*16; const lds_cptr vp0=shm3+LDS_V+((lane>>4)&1)*32+(lane&3)*8+(4*hi+((lane&15)>>2))*64;
  const int NT=(q0+QB)/KVBLK;
  { typedef __attribute__((address_space(3))) float lf32; lf32*cl_=(lf32*)(shm3+LDS_C); for(int i=tid;i<q0+QB;i+=NW*64)cl_[i]=Cg[i]; }
  DMA_K(0,0);DMA_V(0,0);DMA_K(1,SLOTB);
  bf16x8 qr[4];
  #pragma unroll
  for(int d0=0;d0<4;++d0)qr[d0]=*reinterpret_cast<const bf16x8*>(&Qw[(long)r32*DM+d0*16+hi*8]);
  float mhat=0.f,l_reg=0.f;f32x16 o[2];o[0]=f32x16{};o[1]=f32x16{};f32x16 negm=f32x16{};asm volatile("":"+v"(negm));
  const int qrel=wid*QBLK+r32;
  #define CMASK(P0,P1,t) do{int jb_=(t)-(NT-4); if(jb_>=0)cmask(P0,P1,jb_,qrel,hi);}while(0)
  typedef __attribute__((address_space(3))) const float* lds_fptr; typedef __attribute__((address_space(3))) const f32x4v* lds_f4ptr;
  const lds_fptr cl0=(lds_fptr)(shm3+LDS_C)+4*hi;
  #define BIAS(P0,P1,t) do{ const lds_fptr cb_=cl0+64*(t); _Pragma("unroll") for(int g_=0;g_<4;++g_){ const f32x4v a_=*(lds_f4ptr)(cb_+8*g_), b_=*(lds_f4ptr)(cb_+32+8*g_); \
      _Pragma("unroll") for(int i_=0;i_<4;++i_){P0[4*g_+i_]-=a_[i_];P1[4*g_+i_]-=b_[i_];} } }while(0)
  bool resc=false;
  #define START(P0,P1) do{ const float rm=rowmax(P0,P1); resc=false; \
    { const float dl=rm; mhat=fadd_s(mhat,dl); \
      _Pragma("unroll") for(int r=0;r<16;++r){P0[r]=fsub_s(P0[r],dl);P1[r]=fsub_s(P1[r],dl);} \
      _Pragma("unroll") for(int r=0;r<16;++r)negm[r]=-mhat; asm volatile("":"+v"(negm)); } \
    _Pragma("unroll") for(int r=0;r<16;++r)P0[r]=__builtin_amdgcn_exp2f(P0[r]); }while(0)
  #define RESC() do{ if(resc){ asm volatile("s_waitcnt lgkmcnt(0)":::"memory"); \
      _Pragma("unroll") for(int d_=0;d_<2;++d_) _Pragma("unroll") for(int r=0;r<16;++r)o[d_][r]*=wsf[crow(r,hi)]; } }while(0)
  f32x16 pA0,pA1,pB0,pB1;
  int sl_prev=0,sl_cur=0,sl_next=SLOTB;
  #define ROT() do{sl_prev=sl_cur;sl_cur=sl_next;sl_next=(sl_next==(NSLOT-1)*SLOTB)?0:sl_next+SLOTB;}while(0)
  DMA_K(2,2*SLOTB);
  WAIT_BAR(3);
  qkt(pA0,pA1,Kbase,qr,negm,r32,hi);asm volatile("s_nop 15\n\ts_nop 7":"+v"(pA0),"+v"(pA1));BIAS(pA0,pA1,0);CMASK(pA0,pA1,0);
  START(pA0,pA1);
  _Pragma("unroll") for(int r=0;r<16;++r)pA1[r]=__builtin_amdgcn_exp2f(pA1[r]);
  WAIT_BAR(0);
  DMA_K(3,0);DMA_V(1,SLOTB);
  ROT();
  kload8(kf,kp0+sl_cur);
  WAIT_BAR(2);
  s16x4 vlo[8],vhi[8]; u32x4 pw0,pw1,pw2,pw3;
  #define PKW(P,B) cvtpk_s(P[B],P[B+1])
  #define PAF(k) __builtin_bit_cast(bf16x8,pw##k)
  #define VFR(i) (bf16x8){vlo[i][0],vlo[i][1],vlo[i][2],vlo[i][3],vhi[i][0],vhi[i][1],vhi[i][2],vhi[i][3]}
  #define PIN(x) asm volatile("":"+v"(x))
  #define MX3(a,b,c) __builtin_fmaxf(__builtin_fmaxf((a),(b)),(c))
  #define GAPA(MF,A0,A1,A2,A3,W0,W1,PW) do{ MF; sacc+=A0; sacc+=A1; sacc+=A2; sacc+=A3; PIN(sacc); W0; W1; PIN(PW); SBAR(); }while(0)
  #define EX(v) __builtin_amdgcn_exp2f(v)
  #define GAPB(MF,X,B) do{ MF; X[B]=EX(X[B]); X[B+1]=EX(X[B+1]); X[B+2]=EX(X[B+2]); X[B+3]=EX(X[B+3]); PIN(X); SBAR(); }while(0)
  #define VRD(i) do{ vlo[i]=vtr(vp_+(((i)>>2)*4096+((i)&3)*1024)); vhi[i]=vtr(vp_+(((i)>>2)*4096+((i)&3)*1024+512)); }while(0)
  #define KRD(G,j) do{ if(G){ kload2(kf,kp0+sl_next,j); SBAR(); } }while(0)
  #define STEP(C0,C1,P0,P1,t,GK,GV,GL) do{ SBAR(); \
    const lds_cptr vp_=vp0+sl_prev; \
    VRD(0); SBAR(); float sacc=(P0[0]+P0[1]); \
    GAPA(C0=__builtin_amdgcn_mfma_f32_32x32x16_bf16(kf[0],qr[0],negm,0,0,0), P0[2],P0[3],P0[4],P0[5],     pw0[0]=PKW(P0,0), pw0[1]=PKW(P0,2), pw0); \
    VRD(4); SBAR(); GAPA(C1=__builtin_amdgcn_mfma_f32_32x32x16_bf16(kf[1],qr[0],negm,0,0,0), P0[6],P0[7],P0[8],P0[9],     pw0[2]=PKW(P0,4), pw0[3]=PKW(P0,6), pw0); \
    VRD(1); SBAR(); GAPA(C0=__builtin_amdgcn_mfma_f32_32x32x16_bf16(kf[2],qr[1],C0,0,0,0),   P0[10],P0[11],P0[12],P0[13], pw1[0]=PKW(P0,8), pw1[1]=PKW(P0,10), pw1); \
    VRD(5); SBAR(); GAPA(C1=__builtin_amdgcn_mfma_f32_32x32x16_bf16(kf[3],qr[1],C1,0,0,0),   P0[14],P0[15],P1[0],P1[1],   pw1[2]=PKW(P0,12),pw1[3]=PKW(P0,14), pw1); \
    VRD(2); SBAR(); GAPA(C0=__builtin_amdgcn_mfma_f32_32x32x16_bf16(kf[4],qr[2],C0,0,0,0),   P1[2],P1[3],P1[4],P1[5],     pw2[0]=PKW(P1,0), pw2[1]=PKW(P1,2), pw2); \
    VRD(6); SBAR(); GAPA(C1=__builtin_amdgcn_mfma_f32_32x32x16_bf16(kf[5],qr[2],C1,0,0,0),   P1[6],P1[7],P1[8],P1[9],     pw2[2]=PKW(P1,4), pw2[3]=PKW(P1,6), pw2); \
    VRD(3); SBAR(); GAPA(C0=__builtin_amdgcn_mfma_f32_32x32x16_bf16(kf[6],qr[3],C0,0,0,0),   P1[10],P1[11],P1[12],P1[13], pw3[0]=PKW(P1,8), pw3[1]=PKW(P1,10), pw3); \
    VRD(7); SBAR(); GAPA(C1=__builtin_amdgcn_mfma_f32_32x32x16_bf16(kf[7],qr[3],C1,0,0,0),   P1[14],P1[15],0.f,0.f,       pw3[2]=PKW(P1,12),pw3[3]=PKW(P1,14), pw3); \
    l_reg+=sacc; \
    if(GK){DMA_K((t)+3,sl_cur);} if(GV){DMA_V((t)+1,sl_next);} \
    BIAS(C0,C1,t); CMASK(C0,C1,t); \
    { float a=MX3(C0[0],C0[1],C1[0]),b=MX3(C0[2],C0[3],C1[1]); a=MX3(a,C1[2],C1[3]); \
      _Pragma("unroll") for(int r=4;r<16;r+=4){a=MX3(a,C0[r],C0[r+1]);b=MX3(b,C0[r+2],C0[r+3]);a=MX3(a,C1[r],C1[r+1]);b=MX3(b,C1[r+2],C1[r+3]);} \
      float rm=__builtin_fmaxf(a,b); { auto rr=__builtin_amdgcn_permlane32_swap(__float_as_uint(rm),__float_as_uint(rm),false,false); rm=__builtin_fmaxf(__uint_as_float(rr[0]),__uint_as_float(rr[1])); } \
      resc=false; \
      if(__builtin_expect(__any(rm>(float)THRL),0)){ const float dl=__builtin_fmaxf(rm,0.f); mhat+=dl; \
        _Pragma("unroll") for(int r=0;r<16;++r){C0[r]-=dl;C1[r]-=dl;} \
        _Pragma("unroll") for(int r=0;r<16;++r)negm[r]=-mhat; asm volatile("":"+v"(negm)); \
        const float f=__builtin_amdgcn_exp2f(-dl); l_reg*=f; if(hi==0)wsf[r32]=f; resc=true; } } \
    SBAR(); \
    GAPB(o[0]=__builtin_amdgcn_mfma_f32_32x32x16_bf16(PAF(0),VFR(0),o[0],0,0,0), C0,0); \
    GAPB(o[1]=__builtin_amdgcn_mfma_f32_32x32x16_bf16(PAF(0),VFR(4),o[1],0,0,0), C0,4); \
    KRD(GL,0); GAPB(o[0]=__builtin_amdgcn_mfma_f32_32x32x16_bf16(PAF(1),VFR(1),o[0],0,0,0), C0,8); \
    KRD(GL,1); GAPB(o[1]=__builtin_amdgcn_mfma_f32_32x32x16_bf16(PAF(1),VFR(5),o[1],0,0,0), C0,12); \
    KRD(GL,2); GAPB(o[0]=__builtin_amdgcn_mfma_f32_32x32x16_bf16(PAF(2),VFR(2),o[0],0,0,0), C1,0); \
    KRD(GL,3); GAPB(o[1]=__builtin_amdgcn_mfma_f32_32x32x16_bf16(PAF(2),VFR(6),o[1],0,0,0), C1,4); \
    GAPB(o[0]=__builtin_amdgcn_mfma_f32_32x32x16_bf16(PAF(3),VFR(3),o[0],0,0,0), C1,8); \
    GAPB(o[1]=__builtin_amdgcn_mfma_f32_32x32x16_bf16(PAF(3),VFR(7),o[1],0,0,0), C1,12); \
    }while(0)
  int t=1;
  #undef CMASK
  #define CMASK(P0,P1,t) do{}while(0)
  for(;t+5<NT;t+=2){
    STEP(pB0,pB1,pA0,pA1,t,true,true,true);     WAIT_BAR(2); RESC(); ROT();
    STEP(pA0,pA1,pB0,pB1,t+1,true,true,true);   WAIT_BAR(2); RESC(); ROT();
  }
  #undef CMASK
  #define CMASK(P0,P1,t) do{int jb_=(t)-(NT-4); if(jb_>=0)cmask(P0,P1,jb_,qrel,hi);}while(0)
  #define ENDW(tt) do{ if((tt)+3<NT){WAIT_BAR(2);} else if((tt)+2<NT){WAIT_BAR(1);} else {WAIT_BAR(0);} }while(0)
  for(;t+1<NT;t+=2){
    STEP(pB0,pB1,pA0,pA1,t,(t+3<NT),(t+1<NT),(t+1<NT));       ENDW(t);   RESC(); ROT();
    STEP(pA0,pA1,pB0,pB1,t+1,(t+4<NT),(t+2<NT),(t+2<NT));     ENDW(t+1); RESC(); ROT();
  }
  STEP(pB0,pB1,pA0,pA1,NT-1,false,false,false); RESC();
  { float sacc=pB0[0]+pB0[1]; _Pragma("unroll") for(int r=2;r<16;++r)sacc+=pB0[r]; _Pragma("unroll") for(int r=0;r<16;++r)sacc+=pB1[r]; l_reg+=sacc;
    pw0=(u32x4){PKW(pB0,0),PKW(pB0,2),PKW(pB0,4),PKW(pB0,6)};pw1=(u32x4){PKW(pB0,8),PKW(pB0,10),PKW(pB0,12),PKW(pB0,14)};pw2=(u32x4){PKW(pB1,0),PKW(pB1,2),PKW(pB1,4),PKW(pB1,6)};pw3=(u32x4){PKW(pB1,8),PKW(pB1,10),PKW(pB1,12),PKW(pB1,14)};
    SBAR(); pv(o,vb0+sl_cur,PAF(0),PAF(1),PAF(2),PAF(3)); }
  #undef PKW
  #undef PAF
  #undef VFR
  #undef PIN
  #undef MX3
  #undef GAPA
  #undef GAPB
  #undef EX
  #undef VRD
  #undef KRD
  #undef STEP
  #undef ENDW
  {auto rr=__builtin_amdgcn_permlane32_swap(__float_as_uint(l_reg),__float_as_uint(l_reg),false,false);l_reg=__uint_as_float(rr[0])+__uint_as_float(rr[1]);}
  if(hi==0)wsf[32+r32]=l_reg;asm volatile("s_waitcnt lgkmcnt(0)":::"memory");
  float rli[16];
  #pragma unroll
  for(int r=0;r<16;++r)rli[r]=__builtin_amdgcn_rcpf(wsf[32+crow(r,hi)]);
  bf16*Ow=O+(long)(q0+wid*QBLK)*OPITCH;
  { bf16*stg=(bf16*)(shm+LDS_OST)+wid*2048;
    #pragma unroll
    for(int r=0;r<16;++r){const int orow=crow(r,hi);
      #pragma unroll
      for(int d0=0;d0<2;++d0)stg[orow*64+d0*32+r32]=__float2bfloat16(o[d0][r]*rli[r]);}
    asm volatile("s_waitcnt lgkmcnt(0)":::"memory");
    #pragma unroll
    for(int i=0;i<4;++i){const int row=i*8+(lane>>3),ch=lane&7; const u32x4 v=*(const u32x4*)(stg+row*64+ch*8); ATTN_STORE16(Ow+(long)row*OPITCH+ch*8,v);} }
  asm volatile("s_waitcnt lgkmcnt(0)\n\ts_barrier":::"memory");
  #undef DMA_K
  #undef DMA_V
  #undef CMASK
  #undef BIAS
  #undef START
  #undef RESC
  #undef ROT
}
#undef SBAR
#undef WAIT_BAR
}

constexpr int BATCH = 8, SEQ = 4096, DM = 1024, DEPTH = 4, M = BATCH * SEQ, INC = 3334, NIN = 3584, DFF = 4096;
constexpr float EPS = 1e-6f;
constexpr size_t MiB = 1u << 20;
constexpr size_t WS_SS = 1 * MiB;
constexpr size_t WS_LB = 3 * MiB;
constexpr size_t WS_DD = 3 * MiB + 512 * 1024;
constexpr size_t WS_W = 4 * MiB;
constexpr size_t W_LAYER = 25 * MiB, W_OUT = 7 * MiB, W_1 = 9 * MiB, W_2 = 17 * MiB;
constexpr size_t WS_XB = 104 * MiB;
constexpr size_t WS_P = 168 * MiB;
constexpr size_t P_HQ = 0, P_HK = 16 * MiB, P_HI = 32 * MiB, P_HG = 48 * MiB, P_HLF = 64 * MiB, P_SQ = 96 * MiB, P_FQ = 168 * MiB, P_LF = 240 * MiB, P_CC = 241 * MiB, P_US = 242 * MiB;
constexpr size_t HEADBUF = 24 * MiB;
constexpr size_t WS_MIX = 442 * MiB;
constexpr size_t WS_U = 168 * MiB;
constexpr size_t WS_END = 506 * MiB;
constexpr int LDS_BYTES = 147456;

typedef pg8::bf16_t bf16_t;
typedef pg8::f32x4 f32x4;
typedef unsigned u32x4 __attribute__((ext_vector_type(4)));
typedef unsigned u32x2 __attribute__((ext_vector_type(2)));
#define LAS __attribute__((address_space(3)))

__device__ __forceinline__ unsigned f2bf(float f) { unsigned u = __builtin_bit_cast(unsigned, f); return (u + 0x7fffu + ((u >> 16) & 1u)) >> 16; }
__device__ __forceinline__ unsigned pk2(float lo, float hi) { return pg8::cvt_pk_bf16(lo, hi); }
__device__ __forceinline__ float bf2f(unsigned short b) { return __builtin_bit_cast(float, (unsigned)b << 16); }
__device__ __forceinline__ float bflo(unsigned w) { return __builtin_bit_cast(float, w << 16); }
__device__ __forceinline__ float bfhi(unsigned w) { return __builtin_bit_cast(float, w & 0xffff0000u); }
__device__ __forceinline__ float logsig(float x) { return fminf(x, 0.f) - log1pf(expf(-fabsf(x))); }
__device__ __forceinline__ float wave_sum(float v) {
#pragma unroll
    for (int o = 1; o < 64; o <<= 1) v += __shfl_xor(v, o);
    return v;
}
__device__ __forceinline__ float rowscale(const float* ss, int row, int fq) {
    const f32x4 p = *(const f32x4*)(ss + (size_t)row * 16 + 4 * fq);
    float s = (p[0] + p[1]) + (p[2] + p[3]);
    s += __shfl_xor(s, 16); s += __shfl_xor(s, 32);
    return rsqrtf(s * (1.0f / DM) + EPS);
}

#define ROWFENCE() asm volatile("" ::: "memory")
struct EpiResid {
    static constexpr bool PERM = true, AFTER_DRAIN = false;
    const float* xold; float* xnew; bf16_t* xb; float* ss;
    __device__ __forceinline__ void operator()(const f32x4 (&acc)[2][2][4][2], const pg8::Unit& u, int wr, int wc, int fr, int fq) const {
        const int row0 = u.pm * 256 + wr * 64 + fr, col0 = u.pn * 256 + wc * 32 + 8 * fq;
#pragma unroll
        for (int ai = 0; ai < 2; ++ai)
#pragma unroll
            for (int m = 0; m < 4; ++m) {
                const int row = row0 + ai * 128 + m * 16; float sq = 0.f;
#pragma unroll
                for (int bj = 0; bj < 2; ++bj) {
                    const size_t off = (size_t)row * DM + col0 + bj * 128;
                    const f32x4 o0 = *(const f32x4*)(xold + off), o1 = *(const f32x4*)(xold + off + 4);
                    const f32x4 v0 = acc[ai][bj][m][0] + o0, v1 = acc[ai][bj][m][1] + o1;
                    *(f32x4*)(xnew + off) = v0; *(f32x4*)(xnew + off + 4) = v1;
                    u32x4 w; w.x = pk2(v0[0], v0[1]); w.y = pk2(v0[2], v0[3]); w.z = pk2(v1[0], v1[1]); w.w = pk2(v1[2], v1[3]);
                    *(u32x4*)(xb + off) = w;
                    sq += (v0[0] * v0[0] + v0[1] * v0[1]) + (v0[2] * v0[2] + v0[3] * v0[3]) + (v1[0] * v1[0] + v1[1] * v1[1]) + (v1[2] * v1[2] + v1[3] * v1[3]);
                }
                sq += __shfl_xor(sq, 16); sq += __shfl_xor(sq, 32);
                if (fq == 0) ss[(size_t)row * 16 + u.pn * 4 + wc] = sq;
                ROWFENCE();
            }
    }
};
struct EpiRelu2 {
    static constexpr bool PERM = true, AFTER_DRAIN = false;
    bf16_t* U; const float* ss;
    __device__ __forceinline__ void operator()(const f32x4 (&acc)[2][2][4][2], const pg8::Unit& u, int wr, int wc, int fr, int fq) const {
        const int row0 = u.pm * 256 + wr * 64 + fr, col0 = u.pn * 256 + wc * 32 + 8 * fq;
#pragma unroll
        for (int ai = 0; ai < 2; ++ai)
#pragma unroll
            for (int m = 0; m < 4; ++m) {
                const int row = row0 + ai * 128 + m * 16; const float rs = rowscale(ss, row, fq);
#pragma unroll
                for (int bj = 0; bj < 2; ++bj) {
                    f32x4 v0 = acc[ai][bj][m][0] * rs, v1 = acc[ai][bj][m][1] * rs;
                    v0 = __builtin_elementwise_max(v0, (f32x4){0.f, 0.f, 0.f, 0.f}); v1 = __builtin_elementwise_max(v1, (f32x4){0.f, 0.f, 0.f, 0.f});
                    v0 = v0 * v0; v1 = v1 * v1;
                    u32x4 w; w.x = pk2(v0[0], v0[1]); w.y = pk2(v0[2], v0[3]); w.z = pk2(v1[0], v1[1]); w.w = pk2(v1[2], v1[3]);
                    *(u32x4*)(U + (size_t)row * DFF + col0 + bj * 128) = w;
                }
                ROWFENCE();
            }
    }
};
struct EpiInProj {
    static constexpr bool PERM = true, AFTER_DRAIN = false;
    const float* ss; unsigned char* P; const float* lbt;
    const float* gt; const float* fbias;
    __device__ __forceinline__ void operator()(const f32x4 (&acc)[2][2][4][2], const pg8::Unit& u, int wr, int wc, int fr, int fq) const {
        const int slot = u.pn * 4 + wc;
        if (slot > 52) return;
        const int row0 = u.pm * 256 + wr * 64 + fr;
        if (slot < 16) {
            const int kind = slot >> 2, cb = (slot & 3) * 64 + 8 * fq;
            if (kind == 1) {
                float* HLF = (float*)(P + P_HLF); bf16_t* HK = (bf16_t*)(P + P_HK);
#pragma unroll
                for (int ai = 0; ai < 2; ++ai)
#pragma unroll
                    for (int m = 0; m < 4; ++m) {
                        const int row = row0 + ai * 128 + m * 16; const float rs = rowscale(ss, row, fq);
#pragma unroll
                        for (int bj = 0; bj < 2; ++bj) {
                            float lf[8], kk[8];
#pragma unroll
                            for (int n = 0; n < 2; ++n) {
                                const f32x4 ll = *(const f32x4*)(lbt + cb + 32 * bj + 4 * n), om = *(const f32x4*)(lbt + 256 + cb + 32 * bj + 4 * n);
#pragma unroll
                                for (int i = 0; i < 4; ++i) {
                                    const float fl = acc[ai][bj][m][n][i] * rs;
                                    const float a = fminf(fl, 0.f) - __logf(1.0f + __expf(-fabsf(fl)));
                                    const float an = a - fl;
                                    const float b = ll[i] + an;
                                    lf[4 * n + i] = fmaxf(a, b) + __logf(1.0f + __expf(-fabsf(a - b)));
                                    kk[4 * n + i] = om[i] * __expf(an);
                                }
                            }
                            const size_t off = (size_t)row * 256 + cb + 32 * bj;
                            *(f32x4*)(HLF + off) = (f32x4){lf[0], lf[1], lf[2], lf[3]}; *(f32x4*)(HLF + off + 4) = (f32x4){lf[4], lf[5], lf[6], lf[7]};
                            u32x4 w; w.x = pk2(kk[0], kk[1]); w.y = pk2(kk[2], kk[3]); w.z = pk2(kk[4], kk[5]); w.w = pk2(kk[6], kk[7]);
                            *(u32x4*)(HK + off) = w;
                        }
                        ROWFENCE();
                    }
            } else {
                bf16_t* dst = (bf16_t*)(P + (kind == 0 ? P_HQ : (kind == 2 ? P_HI : P_HG)));
#pragma unroll
                for (int ai = 0; ai < 2; ++ai)
#pragma unroll
                    for (int m = 0; m < 4; ++m) {
                        const int row = row0 + ai * 128 + m * 16; const float rs = rowscale(ss, row, fq);
#pragma unroll
                        for (int bj = 0; bj < 2; ++bj) {
                            const f32x4 v0 = acc[ai][bj][m][0] * rs, v1 = acc[ai][bj][m][1] * rs;
                            u32x4 w; w.x = pk2(v0[0], v0[1]); w.y = pk2(v0[2], v0[3]); w.z = pk2(v1[0], v1[1]); w.w = pk2(v1[2], v1[3]);
                            *(u32x4*)(dst + (size_t)row * 256 + cb + 32 * bj) = w;
                        }
                        ROWFENCE();
                    }
            }
        } else if (slot < 52) {
            const int s2 = slot - 16, grp = s2 / 6, h = s2 % 6, role = grp % 3;
            bf16_t* dst = (bf16_t*)(P + P_SQ + (size_t)grp * HEADBUF) + (size_t)((u.pm >> 4) * 6 + h) * SEQ * 64 + 8 * fq;
            const float* gp = gt + (grp - (grp >= 3 ? 1 : 0)) * 64 + 8 * fq;
            const float qs = (role == 0) ? (grp == 3 ? 0.125f * 1.4426950408889634f : 0.125f) : 1.0f;
#pragma unroll
            for (int ai = 0; ai < 2; ++ai)
#pragma unroll
                for (int m = 0; m < 4; ++m) {
                    const int row = row0 + ai * 128 + m * 16; const float rs = rowscale(ss, row, fq);
                    float fac = rs;
                    if (role != 2) {
                        float sq = 0.f;
#pragma unroll
                        for (int bj = 0; bj < 2; ++bj)
#pragma unroll
                            for (int n = 0; n < 2; ++n) { const f32x4 x = acc[ai][bj][m][n]; sq += (x[0] * x[0] + x[1] * x[1]) + (x[2] * x[2] + x[3] * x[3]); }
                        sq += __shfl_xor(sq, 16); sq += __shfl_xor(sq, 32);
                        fac = rs * rsqrtf(rs * rs * sq * (1.0f / 64.0f) + EPS) * qs;
                    }
                    const int t = row & (SEQ - 1);
#pragma unroll
                    for (int bj = 0; bj < 2; ++bj) {
                        f32x4 v0 = acc[ai][bj][m][0] * fac, v1 = acc[ai][bj][m][1] * fac;
                        if (role != 2) { v0 = v0 * *(const f32x4*)(gp + 32 * bj); v1 = v1 * *(const f32x4*)(gp + 32 * bj + 4); }
                        u32x4 w; w.x = pk2(v0[0], v0[1]); w.y = pk2(v0[2], v0[3]); w.z = pk2(v1[0], v1[1]); w.w = pk2(v1[2], v1[3]);
                        *(u32x4*)(dst + (size_t)t * 64 + 32 * bj) = w;
                    }
                    ROWFENCE();
                }
        } else {
            float* LF = (float*)(P + P_LF);
#pragma unroll
            for (int ai = 0; ai < 2; ++ai)
#pragma unroll
                for (int m = 0; m < 4; ++m) {
                    const int row = row0 + ai * 128 + m * 16; const float rs = rowscale(ss, row, fq);
                    if (fq == 0) {
                        const f32x4 a0 = acc[ai][0][m][0], a1 = acc[ai][0][m][1];
                        *(f32x4*)(LF + (size_t)row * 8) = (f32x4){logsig(a0[0] * rs + fbias[0]), logsig(a0[1] * rs + fbias[1]), logsig(a0[2] * rs + fbias[2]), logsig(a0[3] * rs + fbias[3])};
                        *(f32x4*)(LF + (size_t)row * 8 + 4) = (f32x4){logsig(a1[0] * rs + fbias[4]), logsig(a1[1] * rs + fbias[5]), 0.f, 0.f};
                    }
                    ROWFENCE();
                }
        }
    }
};

__device__ __forceinline__ void tr_item(const float* W, int ldw, int ncols_valid, int src_col0, int k0, const float* gain, bf16_t* WT, int K, int n0, LAS float* scr, int lane) {
#pragma unroll 8
    for (int i = 0; i < 32; ++i) { const int kk = 2 * i + (lane >> 5), c = src_col0 + (lane & 31);
        float v = (c < ncols_valid) ? W[(size_t)(k0 + kk) * ldw + c] : 0.f; if (gain) v *= gain[k0 + kk]; scr[kk * 33 + (lane & 31)] = v; }
    asm volatile("s_waitcnt lgkmcnt(0)" ::: "memory");
    const int c = lane & 7;
#pragma unroll
    for (int j = 0; j < 4; ++j) { const int n = (lane >> 3) + 8 * j; const LAS float* s = scr + (8 * c) * 33 + n;
        u32x4 o; o.x = pk2(s[0 * 33], s[1 * 33]); o.y = pk2(s[2 * 33], s[3 * 33]); o.z = pk2(s[4 * 33], s[5 * 33]); o.w = pk2(s[6 * 33], s[7 * 33]);
        *(u32x4*)(WT + (size_t)(n0 + n) * K + k0 + 8 * c) = o; }
    asm volatile("s_waitcnt lgkmcnt(0)" ::: "memory");
}

__device__ __forceinline__ void unpack8(const u32x4 w, float* d) { d[0] = bflo(w.x); d[1] = bfhi(w.x); d[2] = bflo(w.y); d[3] = bfhi(w.y); d[4] = bflo(w.z); d[5] = bfhi(w.z); d[6] = bflo(w.w); d[7] = bfhi(w.w); }

__device__ __forceinline__ void fox_cumsum_item(int bh, const float* LF, float* CC, LAS float* sc) {
    int tid_ = threadIdx.x; asm volatile("" : "+v"(tid_)); const int tid = tid_, lane = tid & 63, wave = tid >> 6, b = bh / 6, h = bh % 6;
    float v[8]; float run = 0.f;
#pragma unroll
    for (int i = 0; i < 8; ++i) { run += LF[((size_t)b * SEQ + tid * 8 + i) * 8 + h]; v[i] = run; }
    float s = run;
#pragma unroll
    for (int o = 1; o < 64; o <<= 1) { const float n = __shfl_up(s, o); if (lane >= o) s += n; }
    __syncthreads();
    if (lane == 63) sc[wave] = s;
    __syncthreads();
    float base = s - run;
    for (int w = 0; w < wave; ++w) base += sc[w];
#pragma unroll
    for (int i = 0; i < 8; ++i) CC[(size_t)bh * SEQ + tid * 8 + i] = (v[i] + base) * 1.4426950408889634f;
}

__device__ __forceinline__ void stage_kv(const bf16_t* Kb, const bf16_t* Vb, int kt, LAS float* Kf, LAS float* Vf) {
    int tid_ = threadIdx.x; asm volatile("" : "+v"(tid_)); const int tid = tid_, key = tid >> 3, c8 = tid & 7;
    const u32x4 kw = *(const u32x4*)(Kb + ((size_t)(kt * 64 + key)) * 64 + c8 * 8), vw = *(const u32x4*)(Vb + ((size_t)(kt * 64 + key)) * 64 + c8 * 8);
    float kf[8], vf[8]; unpack8(kw, kf); unpack8(vw, vf);
    *(LAS f32x4*)(Kf + key * 64 + c8 * 8) = (f32x4){kf[0], kf[1], kf[2], kf[3]}; *(LAS f32x4*)(Kf + key * 64 + c8 * 8 + 4) = (f32x4){kf[4], kf[5], kf[6], kf[7]};
    *(LAS f32x4*)(Vf + key * 64 + c8 * 8) = (f32x4){vf[0], vf[1], vf[2], vf[3]}; *(LAS f32x4*)(Vf + key * 64 + c8 * 8 + 4) = (f32x4){vf[4], vf[5], vf[6], vf[7]};
}

__device__ __forceinline__ void fox_naive_item(int item, unsigned char* P, bf16_t* MIX, LAS float* lds) {
    int tid_ = threadIdx.x; asm volatile("" : "+v"(tid_)); const int tid = tid_, bh = item >> 3, qblk = item & 7, b = bh / 6, h = bh % 6, t = qblk * 512 + tid;
    const bf16_t* Qp = (const bf16_t*)(P + P_FQ) + ((size_t)bh * SEQ + t) * 64;
    const bf16_t* Kb = (const bf16_t*)(P + P_FQ + HEADBUF) + (size_t)bh * SEQ * 64;
    const bf16_t* Vb = (const bf16_t*)(P + P_FQ + 2 * HEADBUF) + (size_t)bh * SEQ * 64;
    const float* CC = (const float*)(P + P_CC) + (size_t)bh * SEQ;
    float q[64], o[64];
#pragma unroll
    for (int c = 0; c < 8; ++c) unpack8(*(const u32x4*)(Qp + c * 8), q + c * 8);
#pragma unroll
    for (int d = 0; d < 64; ++d) o[d] = 0.f;
    float m = -1e30f, l = 0.f; const float ct = CC[t];
    LAS float* Kf = lds; LAS float* Vf = lds + 4096; LAS float* cs = lds + 8192;
    const int ntile = (qblk + 1) * 8;
    for (int kt = 0; kt < ntile; ++kt) {
        __syncthreads();
        stage_kv(Kb, Vb, kt, Kf, Vf); if (tid < 64) cs[tid] = CC[kt * 64 + tid];
        __syncthreads();
        for (int s = 0; s < 64; ++s) {
            float z = 0.f;
#pragma unroll
            for (int d = 0; d < 64; ++d) z += q[d] * Kf[s * 64 + d];
            const float x = (kt * 64 + s <= t) ? z + (ct - cs[s]) : -1e30f;
            const float mn = fmaxf(m, x), sc = __expf(m - mn), p = __expf(x - mn);
            l = l * sc + p;
#pragma unroll
            for (int d = 0; d < 64; ++d) o[d] = o[d] * sc + p * Vf[s * 64 + d];
            m = mn;
        }
    }
    const float inv = 1.0f / l;
    bf16_t* op = MIX + ((size_t)b * SEQ + t) * DM + 640 + h * 64;
#pragma unroll
    for (int c = 0; c < 8; ++c) { u32x4 w; w.x = pk2(o[c * 8] * inv, o[c * 8 + 1] * inv); w.y = pk2(o[c * 8 + 2] * inv, o[c * 8 + 3] * inv); w.z = pk2(o[c * 8 + 4] * inv, o[c * 8 + 5] * inv); w.w = pk2(o[c * 8 + 6] * inv, o[c * 8 + 7] * inv); *(u32x4*)(op + c * 8) = w; }
}

__device__ __forceinline__ void sb_naive_item(int item, unsigned char* P, bf16_t* MIX, LAS float* lds) {
    int tid_ = threadIdx.x; asm volatile("" : "+v"(tid_)); const int tid = tid_, bh = item >> 3, qblk = item & 7, b = bh / 6, h = bh % 6, t = qblk * 512 + tid;
    const bf16_t* Qp = (const bf16_t*)(P + P_SQ) + ((size_t)bh * SEQ + t) * 64;
    const bf16_t* Kb = (const bf16_t*)(P + P_SQ + HEADBUF) + (size_t)bh * SEQ * 64;
    const bf16_t* Vb = (const bf16_t*)(P + P_SQ + 2 * HEADBUF) + (size_t)bh * SEQ * 64;
    float q[64], o[64];
#pragma unroll
    for (int c = 0; c < 8; ++c) unpack8(*(const u32x4*)(Qp + c * 8), q + c * 8);
#pragma unroll
    for (int d = 0; d < 64; ++d) o[d] = 0.f;
    float tail = 0.f;
    LAS float* Kf = lds; LAS float* Vf = lds + 4096;
    for (int kt = qblk * 8 + 7; kt >= 0; --kt) {
        __syncthreads();
        stage_kv(Kb, Vb, kt, Kf, Vf);
        __syncthreads();
        for (int s = 63; s >= 0; --s) {
            float z = 0.f;
#pragma unroll
            for (int d = 0; d < 64; ++d) z += q[d] * Kf[s * 64 + d];
            const float ls = fminf(z, 0.f) - __logf(1.0f + __expf(-fabsf(z)));
            const bool act = (kt * 64 + s) < t;
            const float A = act ? __expf(ls + tail) : 0.f;
#pragma unroll
            for (int d = 0; d < 64; ++d) o[d] += A * Vf[s * 64 + d];
            tail += act ? (ls - z) : 0.f;
        }
        if (__syncthreads_and(tail < -100.f)) break;
    }
    bf16_t* op = MIX + ((size_t)b * SEQ + t) * DM + 256 + h * 64;
#pragma unroll
    for (int c = 0; c < 8; ++c) { u32x4 w; w.x = pk2(o[c * 8], o[c * 8 + 1]); w.y = pk2(o[c * 8 + 2], o[c * 8 + 3]); w.z = pk2(o[c * 8 + 4], o[c * 8 + 5]); w.w = pk2(o[c * 8 + 6], o[c * 8 + 7]); *(u32x4*)(op + c * 8) = w; }
}

__device__ __forceinline__ void hgrn_naive_item(int item, unsigned char* P, bf16_t* MIX, const float* hgn, LAS float* lds) {
    int tid_ = threadIdx.x; asm volatile("" : "+v"(tid_)); const int tid = tid_, lane = tid & 63, w = tid >> 6, kg = lane >> 3, vi = lane & 7, vcol = 8 * w + vi, b = item >> 2, h = item & 3;
    const bf16_t* HQ = (const bf16_t*)(P + P_HQ); const bf16_t* HK = (const bf16_t*)(P + P_HK); const bf16_t* HI = (const bf16_t*)(P + P_HI); const bf16_t* HG = (const bf16_t*)(P + P_HG);
    const float* HLF = (const float*)(P + P_HLF);
    LAS float* qf = lds; LAS float* kf = lds + 4096; LAS float* ff = lds + 8192; LAS float* vf = lds + 12288; LAS float* ob = lds + 16384;
    float S[8];
#pragma unroll
    for (int j = 0; j < 8; ++j) S[j] = 0.f;
    const int tok = tid >> 3, c8 = tid & 7;
    float gn[8];
#pragma unroll
    for (int e = 0; e < 8; ++e) gn[e] = hgn[c8 * 8 + e];
    for (int c = 0; c < 64; ++c) {
        const size_t off = ((size_t)b * SEQ + c * 64 + tok) * 256 + h * 64 + c8 * 8;
        __syncthreads();
        {
            float a[8];
            unpack8(*(const u32x4*)(HQ + off), a);
#pragma unroll
            for (int e = 0; e < 8; ++e) qf[tok * 64 + c8 * 8 + e] = a[e];
            unpack8(*(const u32x4*)(HK + off), a);
#pragma unroll
            for (int e = 0; e < 8; ++e) kf[tok * 64 + c8 * 8 + e] = a[e];
            unpack8(*(const u32x4*)(HI + off), a);
#pragma unroll
            for (int e = 0; e < 8; ++e) vf[tok * 64 + c8 * 8 + e] = a[e];
            const f32x4 l0 = *(const f32x4*)(HLF + off), l1 = *(const f32x4*)(HLF + off + 4);
#pragma unroll
            for (int e = 0; e < 4; ++e) { ff[tok * 64 + c8 * 8 + e] = expf(l0[e]); ff[tok * 64 + c8 * 8 + 4 + e] = expf(l1[e]); }
        }
        __syncthreads();
        for (int tk = 0; tk < 64; ++tk) {
            const float vv = vf[tk * 64 + vcol]; float op = 0.f;
#pragma unroll
            for (int j = 0; j < 8; ++j) { const int k = 8 * kg + j; S[j] = ff[tk * 64 + k] * S[j] + kf[tk * 64 + k] * vv; op += qf[tk * 64 + k] * S[j]; }
            op += __shfl_xor(op, 8); op += __shfl_xor(op, 16); op += __shfl_xor(op, 32);
            if (kg == 0) ob[tk * 64 + vcol] = op;
        }
        __syncthreads();
        {
            float ov[8], g[8]; float sq = 0.f;
#pragma unroll
            for (int e = 0; e < 8; ++e) { ov[e] = ob[tok * 64 + c8 * 8 + e]; sq += ov[e] * ov[e]; }
            sq += __shfl_xor(sq, 1); sq += __shfl_xor(sq, 2); sq += __shfl_xor(sq, 4);
            const float rn = rsqrtf(sq * (1.0f / 64.0f) + EPS);
            unpack8(*(const u32x4*)(HG + off), g);
            float r[8];
#pragma unroll
            for (int e = 0; e < 8; ++e) r[e] = ov[e] * rn * gn[e] * (g[e] / (1.0f + expf(-g[e])));
            u32x4 wv; wv.x = pk2(r[0], r[1]); wv.y = pk2(r[2], r[3]); wv.z = pk2(r[4], r[5]); wv.w = pk2(r[6], r[7]);
            *(u32x4*)(MIX + ((size_t)b * SEQ + c * 64 + tok) * DM + h * 64 + c8 * 8) = wv;
        }
    }
}

constexpr int HG_SLOT = 32768, HG_PRE = 16384, HG_TOT = 16384 + 1280, HG_VT = 20480, HG_VP = 72;
typedef short hbf16x8 __attribute__((ext_vector_type(8)));
typedef short hbf16x4 __attribute__((ext_vector_type(4)));
__device__ __forceinline__ hbf16x8 pack8(const float* x) { u32x4 w; w.x = pk2(x[0], x[1]); w.y = pk2(x[2], x[3]); w.z = pk2(x[4], x[5]); w.w = pk2(x[6], x[7]); return __builtin_bit_cast(hbf16x8, w); }

__device__ __forceinline__ void hg_stage(int tid, size_t row0, int h, const float* HLF, const bf16_t* HI, LAS unsigned char* sb) {
    const int lt = tid & 255, k = lt & 63, seg = lt >> 6;
    LAS float* bl = (LAS float*)sb; LAS float* pre = (LAS float*)(sb + HG_PRE); LAS float* tot = (LAS float*)(sb + HG_TOT); LAS bf16_t* vt = (LAS bf16_t*)(sb + HG_VT);
    float run = 0.f;
#pragma unroll
    for (int i = 0; i < 16; ++i) { const int t = 16 * seg + i; run += HLF[(row0 + t) * 256 + h * 64 + k]; bl[t * 64 + k] = run; }
    tot[seg * 64 + k] = run;
    {
        const int s = lt >> 2, c0 = (lt & 3) * 16;
        const u32x4 w0 = *(const u32x4*)(HI + (row0 + s) * 256 + h * 64 + c0), w1 = *(const u32x4*)(HI + (row0 + s) * 256 + h * 64 + c0 + 8);
        const unsigned ww[8] = {w0.x, w0.y, w0.z, w0.w, w1.x, w1.y, w1.z, w1.w};
#pragma unroll
        for (int e = 0; e < 8; ++e) { vt[(c0 + 2 * e) * HG_VP + s] = (bf16_t)(ww[e] & 0xffffu); vt[(c0 + 2 * e + 1) * HG_VP + s] = (bf16_t)(ww[e] >> 16); }
    }
    __syncthreads();
    if (lt < 64) { float p = 0.f;
#pragma unroll
        for (int sg = 0; sg < 4; ++sg) { pre[sg * 64 + lt] = p; p += tot[sg * 64 + lt]; }
        pre[4 * 64 + lt] = p; }
    __syncthreads();
}

__device__ __forceinline__ void hgrn_a_item(int item, unsigned char* P, float* DD, LAS unsigned char* L) {
    int tid_ = threadIdx.x; asm volatile("" : "+v"(tid_)); const int tid = tid_, lane = tid & 63, wq = (tid >> 6) & 3, cs = tid >> 8, r = lane & 15, g = lane >> 4;
    const int bh = item >> 5, chunk = (item & 31) * 2 + cs, b = bh >> 2, h = bh & 3;
    const size_t row0 = (size_t)b * SEQ + chunk * 64;
    const bf16_t* HK = (const bf16_t*)(P + P_HK); float* UT = (float*)(P + P_US);
    LAS unsigned char* sb = L + cs * HG_SLOT;
    hg_stage(tid, row0, h, (const float*)(P + P_HLF), (const bf16_t*)(P + P_HI), sb);
    const LAS float* bl = (const LAS float*)sb; const LAS float* pre = (const LAS float*)(sb + HG_PRE); const LAS unsigned char* vt = sb + HG_VT;
    const int k = 16 * wq + r; const float pre4 = pre[4 * 64 + k];
    hbf16x8 af[2];
#pragma unroll
    for (int ks = 0; ks < 2; ++ks) { const float pj = pre4 - pre[(2 * ks + (g >> 1)) * 64 + k]; float x[8];
#pragma unroll
        for (int j = 0; j < 8; ++j) { const int s = 32 * ks + 8 * g + j; x[j] = bf2f(HK[(row0 + s) * 256 + h * 64 + k]) * __expf(pj - bl[s * 64 + k]); }
        af[ks] = pack8(x); }
    float* ut = UT + ((size_t)(bh * 64 + chunk) * 64) * 64;
#pragma unroll
    for (int vtile = 0; vtile < 4; ++vtile) { f32x4 acc = {0.f, 0.f, 0.f, 0.f};
#pragma unroll
        for (int ks = 0; ks < 2; ++ks) { const hbf16x8 bf = *(const LAS hbf16x8*)(vt + (16 * vtile + r) * (HG_VP * 2) + (32 * ks + 8 * g) * 2); acc = __builtin_amdgcn_mfma_f32_16x16x32_bf16(af[ks], bf, acc, 0, 0, 0); }
        *(f32x4*)(ut + (size_t)(16 * vtile + r) * 64 + 16 * wq + 4 * g) = acc; }
    if (g == 0) DD[(size_t)(bh * 64 + chunk) * 64 + k] = __expf(pre4);
}

__device__ __forceinline__ void hgrn_b_scan(int bx, int G, unsigned char* P, const float* DD) {
    int tid_ = threadIdx.x; asm volatile("" : "+v"(tid_));
    float* UT = (float*)(P + P_US);
    for (int gid = bx * 512 + tid_; gid < 32 * 4096; gid += G * 512) {
        const int bh = gid >> 12, e = gid & 4095; float* u = UT + (size_t)bh * 64 * 4096 + e; const float* dd = DD + (size_t)bh * 64 * 64 + (e & 63);
        float S = 0.f;
        for (int c0 = 0; c0 < 64; c0 += 8) { float tu[8], td[8];
#pragma unroll
            for (int i = 0; i < 8; ++i) { tu[i] = u[(size_t)(c0 + i) * 4096]; td[i] = dd[(c0 + i) * 64]; }
#pragma unroll
            for (int i = 0; i < 8; ++i) { u[(size_t)(c0 + i) * 4096] = S; S = td[i] * S + tu[i]; } }
    }
}

__device__ __forceinline__ void hgrn_c_item(int item, unsigned char* P, bf16_t* MIX, const float* hgn, LAS unsigned char* L) {
    int tid_ = threadIdx.x; asm volatile("" : "+v"(tid_)); const int tid = tid_, lane = tid & 63, I = (tid >> 6) & 3, cs = tid >> 8, r = lane & 15, g = lane >> 4;
    const int bh = item >> 5, chunk = (item & 31) * 2 + cs, b = bh >> 2, h = bh & 3;
    const size_t row0 = (size_t)b * SEQ + chunk * 64;
    const bf16_t* HQ = (const bf16_t*)(P + P_HQ); const bf16_t* HK = (const bf16_t*)(P + P_HK); const bf16_t* HG = (const bf16_t*)(P + P_HG); const float* ST = (const float*)(P + P_US);
    LAS unsigned char* sb = L + cs * HG_SLOT;
    hg_stage(tid, row0, h, (const float*)(P + P_HLF), (const bf16_t*)(P + P_HI), sb);
    const LAS float* bl = (const LAS float*)sb; const LAS float* pre = (const LAS float*)(sb + HG_PRE); const LAS unsigned char* vt = sb + HG_VT;
    const int t = 16 * I + r;
    hbf16x8 qtf[2], qhf[2];
#pragma unroll
    for (int ks = 0; ks < 2; ++ks) { const int kb = 32 * ks + 8 * g; float q[8], xt[8], xh[8];
        unpack8(*(const u32x4*)(HQ + (row0 + t) * 256 + h * 64 + kb), q);
#pragma unroll
        for (int j = 0; j < 8; ++j) { xt[j] = q[j] * __expf(bl[t * 64 + kb + j]); xh[j] = xt[j] * __expf(pre[I * 64 + kb + j]); }
        qtf[ks] = pack8(xt); qhf[ks] = pack8(xh); }
    f32x4 at[4];
#pragma unroll
    for (int J = 0; J < 4; ++J) { at[J] = (f32x4){0.f, 0.f, 0.f, 0.f};
        if (J <= I) { const int s = 16 * J + r;
#pragma unroll
            for (int ks = 0; ks < 2; ++ks) { const int kb = 32 * ks + 8 * g; float kk[8], x[8];
                unpack8(*(const u32x4*)(HK + (row0 + s) * 256 + h * 64 + kb), kk);
#pragma unroll
                for (int j = 0; j < 8; ++j) x[j] = kk[j] * __expf(fminf(pre[I * 64 + kb + j] - pre[J * 64 + kb + j] - bl[s * 64 + kb + j], 80.f));
                at[J] = __builtin_amdgcn_mfma_f32_16x16x32_bf16(pack8(x), qtf[ks], at[J], 0, 0, 0); }
            if (J == I) {
#pragma unroll
                for (int i = 0; i < 4; ++i) at[J][i] = (4 * g + i <= r) ? at[J][i] : 0.f; } } }
    hbf16x8 pf[2];
#pragma unroll
    for (int k2 = 0; k2 < 2; ++k2) { const float x[8] = {at[2 * k2][0], at[2 * k2][1], at[2 * k2][2], at[2 * k2][3], at[2 * k2 + 1][0], at[2 * k2 + 1][1], at[2 * k2 + 1][2], at[2 * k2 + 1][3]}; pf[k2] = pack8(x); }
    const float* st = ST + ((size_t)(bh * 64 + chunk) * 64) * 64;
    f32x4 o[4];
#pragma unroll
    for (int vtile = 0; vtile < 4; ++vtile) { f32x4 acc = {0.f, 0.f, 0.f, 0.f}; const int v = 16 * vtile + r;
#pragma unroll
        for (int ks = 0; ks < 2; ++ks) { const float* sp = st + (size_t)v * 64 + 32 * ks + 8 * g; const f32x4 s0 = *(const f32x4*)sp, s1 = *(const f32x4*)(sp + 4);
            const float x[8] = {s0[0], s0[1], s0[2], s0[3], s1[0], s1[1], s1[2], s1[3]};
            acc = __builtin_amdgcn_mfma_f32_16x16x32_bf16(qhf[ks], pack8(x), acc, 0, 0, 0); }
#pragma unroll
        for (int k2 = 0; k2 < 2; ++k2) { if (k2 == 0 || I >= 2) {
            const hbf16x4 v0 = *(const LAS hbf16x4*)(vt + v * (HG_VP * 2) + (32 * k2 + 4 * g) * 2), v1 = *(const LAS hbf16x4*)(vt + v * (HG_VP * 2) + (32 * k2 + 16 + 4 * g) * 2);
            const hbf16x8 vf = {v0[0], v0[1], v0[2], v0[3], v1[0], v1[1], v1[2], v1[3]};
            acc = __builtin_amdgcn_mfma_f32_16x16x32_bf16(pf[k2], vf, acc, 0, 0, 0); } }
        o[vtile] = acc; }
#pragma unroll
    for (int i = 0; i < 4; ++i) { float sq = 0.f;
#pragma unroll
        for (int vtile = 0; vtile < 4; ++vtile) sq += o[vtile][i] * o[vtile][i];
        sq += __shfl_xor(sq, 1); sq += __shfl_xor(sq, 2); sq += __shfl_xor(sq, 4); sq += __shfl_xor(sq, 8);
        const float rn = rsqrtf(sq * (1.0f / 64.0f) + EPS); const size_t row = row0 + 16 * I + 4 * g + i;
#pragma unroll
        for (int vtile = 0; vtile < 4; ++vtile) { const int v = 16 * vtile + r; const float gg = bf2f(HG[row * 256 + h * 64 + v]);
            MIX[row * DM + h * 64 + v] = (bf16_t)f2bf(o[vtile][i] * rn * hgn[v] * (gg / (1.0f + __expf(-gg)))); } }
}

struct Args { const float* in[14]; float* out; unsigned char* ws; int ph_lo, ph_hi; };
constexpr int NPHASE = 1 + 7 * DEPTH;

__global__ void __launch_bounds__(512, 2) fwd(Args a) {
    extern __shared__ __attribute__((aligned(16))) unsigned char lds[];
    cg::grid_group grid = cg::this_grid();
    LAS unsigned char* L = (LAS unsigned char*)lds;
    for (int ph = a.ph_lo; ph < a.ph_hi; ++ph) {
        int G = gridDim.x, bx = blockIdx.x; asm volatile("" : "+s"(G), "+s"(bx));
        typedef const __attribute__((address_space(4))) Args* KArgP;
        KArgP ap = (KArgP)__builtin_amdgcn_kernarg_segment_ptr(); asm volatile("" : "+s"(ap));
        unsigned char* ws = ap->ws;
        float* SS = (float*)(ws + WS_SS); float* LB = (float*)(ws + WS_LB);
        bf16_t* XB = (bf16_t*)(ws + WS_XB); bf16_t* MIX = (bf16_t*)(ws + WS_MIX); bf16_t* UB = (bf16_t*)(ws + WS_U);
        unsigned char* P = ws + WS_P;
        if (ph == 0) {
            int tid = threadIdx.x; asm volatile("" : "+v"(tid)); const int lane = tid & 63, wave = __builtin_amdgcn_readfirstlane(tid >> 6);
            LAS float* scr = (LAS float*)(L + wave * 16384);
            const int gw = bx * 8 + wave, NGW = G * 8;
            constexpr int I_IN = 16 * 112, I_OUT = 16 * 32, I_1 = 16 * 128, I_2 = 64 * 32, I_L = I_IN + I_OUT + I_1 + I_2;
            for (int it = gw; it < DEPTH * I_L; it += NGW) {
                const int l = it / I_L; int r = it % I_L;
                unsigned char* wl = ws + WS_W + (size_t)l * W_LAYER;
                if (r < I_IN) { const int kb = r / 112, nb = r % 112, n0 = nb * 32, pn = n0 >> 8, p = n0 & 255, slot = 4 * pn + ((p & 127) >> 5), sc0 = 64 * slot + 32 * (p >> 7);
                    tr_item(ap->in[3] + (size_t)l * DM * INC, INC, INC, sc0, kb * 64, ap->in[2] + l * DM, (bf16_t*)wl, DM, n0, scr, lane); continue; }
                r -= I_IN;
                if (r < I_OUT) { const int kb = r / 32, nb = r % 32; tr_item(ap->in[10] + (size_t)l * DM * DM, DM, DM, nb * 32, kb * 64, nullptr, (bf16_t*)(wl + W_OUT), DM, nb * 32, scr, lane); continue; }
                r -= I_OUT;
                if (r < I_1) { const int kb = r / 128, nb = r % 128; tr_item(ap->in[12] + (size_t)l * DM * DFF, DFF, DFF, nb * 32, kb * 64, ap->in[11] + l * DM, (bf16_t*)(wl + W_1), DM, nb * 32, scr, lane); continue; }
                r -= I_1;
                { const int kb = r / 32, nb = r % 32; tr_item(ap->in[13] + (size_t)l * DFF * DM, DM, DM, nb * 32, kb * 64, nullptr, (bf16_t*)(wl + W_2), DFF, nb * 32, scr, lane); }
            }
            const float* x = ap->in[0];
            for (int m = gw; m < M; m += NGW) {
                const f32x4* xr = (const f32x4*)(x + (size_t)m * DM) + lane; f32x4 v[4]; float s = 0.f;
#pragma unroll
                for (int j = 0; j < 4; ++j) { v[j] = xr[64 * j]; s += (v[j][0] * v[j][0] + v[j][1] * v[j][1]) + (v[j][2] * v[j][2] + v[j][3] * v[j][3]); }
                const float tot = wave_sum(s);
                u32x2* o8 = (u32x2*)(XB + (size_t)m * DM) + lane;
#pragma unroll
                for (int j = 0; j < 4; ++j) { u32x2 w; w.x = pk2(v[j][0], v[j][1]); w.y = pk2(v[j][2], v[j][3]); o8[64 * j] = w; }
                if (lane < 16) SS[(size_t)m * 16 + lane] = (lane == 0) ? tot : 0.f;
            }
            if (bx == 2 && tid < 64) ((unsigned*)ws)[tid] = 0u;
            if (bx == 1) {
                for (int i = tid; i < 1024; i += 512) { const int l = i >> 8, wh = (i >> 6) & 3, d = i & 63; LB[2048 + i] = ap->in[5 + wh][l * 64 + d]; }
                if (tid < 32) { const int l = tid >> 3, e = tid & 7; LB[3072 + tid] = (e < 6) ? ap->in[9][l * 6 + e] : 0.f; }
            }
            if (bx == 0 && tid < 256) {
                const float* lg = ap->in[1]; float e[DEPTH]; float mx = -1e30f, sum = 0.f;
#pragma unroll
                for (int l = 0; l < DEPTH; ++l) mx = fmaxf(mx, lg[l * 256 + tid]);
#pragma unroll
                for (int l = 0; l < DEPTH; ++l) { e[l] = expf(lg[l * 256 + tid] - mx); sum += e[l]; }
                float c = 0.f;
#pragma unroll
                for (int l = 0; l < DEPTH; ++l) { if (l > 0) c += e[l] / sum; LB[l * 512 + tid] = logf(fmaxf(c, 1e-30f)); LB[l * 512 + 256 + tid] = 1.0f - c; }
            }
        } else {
            const int l = (ph - 1) / 7, k = (ph - 1) % 7;
            unsigned char* wl = ws + WS_W + (size_t)l * W_LAYER;
            if (k == 0) {
                pg8::Gemm g{XB, (const bf16_t*)wl, M, NIN, DM}; pg8::StaticOrder S; S.init(M, NIN, G, bx);
                EpiInProj E{SS, P, LB + l * 512, LB + 2048 + l * 256, LB + 3072 + l * 8};
                pg8::gemm_phase<EpiInProj, pg8::StaticOrder, true, true>(L, g, S, E);
            } else if (k == 1) {
                int tid = threadIdx.x; asm volatile("" : "+v"(tid));
                unsigned* ctr = (unsigned*)ws + l * 16 + 1;
                volatile LAS int* sh = (volatile LAS int*)(L + LDS_BYTES - 64);
                for (;;) {
                    if (tid == 0) sh[0] = (int)atomicAdd(ctr, 1u);
                    __syncthreads();
                    const int idx = __builtin_amdgcn_readfirstlane(sh[0]);
                    __syncthreads();
                    if (idx >= 1456) break;
                    if (idx < 384) { const int it = 383 - idx; sb_naive_item(((it % 48) << 3) | (it / 48), P, MIX, (LAS float*)L); }
                    else if (idx < 432) fox_cumsum_item(idx - 384, (const float*)(P + P_LF), (float*)(P + P_CC), (LAS float*)L);
                    else hgrn_a_item(idx - 432, P, (float*)(ws + WS_DD), L);
                    __syncthreads();
                }
            } else if (k == 2) {
                hgrn_b_scan(bx, G, P, (const float*)(ws + WS_DD));
            } else if (k == 3) {
                int tid = threadIdx.x; asm volatile("" : "+v"(tid));
                unsigned* ctr = (unsigned*)ws + l * 16;
                volatile LAS int* sh = (volatile LAS int*)(L + LDS_BYTES - 64);
                for (;;) {
                    if (tid == 0) sh[0] = (int)atomicAdd(ctr, 1u);
                    __syncthreads();
                    const int idx = __builtin_amdgcn_readfirstlane(sh[0]);
                    __syncthreads();
                    if (idx >= 768 + 1024) break;
                    if (idx >= 768) { hgrn_c_item(idx - 768, P, MIX, ap->in[4] + l * 64, L); __syncthreads(); continue; }
                    const int qb = 15 - idx / 48, bh = idx % 48, b = bh / 6, h = bh % 6;
                    typedef attn_body::bf16 abf;
                    attn_body::attn_unit<8>(qb, (const abf*)(P + P_FQ) + (size_t)bh * SEQ * 64, (const abf*)(P + P_FQ + HEADBUF) + (size_t)bh * SEQ * 64, (const abf*)(P + P_FQ + 2 * HEADBUF) + (size_t)bh * SEQ * 64,
                                            (abf*)MIX + (size_t)b * SEQ * DM + 640 + h * 64, (const float*)(P + P_CC) + (size_t)bh * SEQ, (char*)lds);
                }
            } else if (k == 5) {
                pg8::Gemm g{XB, (const bf16_t*)(wl + W_1), M, DFF, DM}; pg8::StaticOrder S; S.init(M, DFF, G, bx);
                EpiRelu2 E{UB, SS};
                pg8::gemm_phase<EpiRelu2, pg8::StaticOrder, true, true>(L, g, S, E);
            } else {
                const bool ff2 = (k == 6);
                pg8::Gemm g{ff2 ? UB : MIX, (const bf16_t*)(wl + (ff2 ? W_2 : W_OUT)), M, DM, ff2 ? DFF : DM}; pg8::StaticOrder S; S.init(M, DM, G, bx);
                EpiResid E{(!ff2 && l == 0) ? ap->in[0] : ap->out, ap->out, XB, SS};
                pg8::gemm_phase<EpiResid, pg8::StaticOrder, true, true>(L, g, S, E);
            }
        }
        if (ph + 1 < a.ph_hi) grid.sync();
    }
}

#ifndef MK_MULTI
#define MK_MULTI 0
#endif
extern "C" void kernel_launch(void* const* d_in, const int* in_sizes, int n_in, void* d_out, int out_size, void* d_ws, size_t ws_size, hipStream_t stream) {
    static int grid = 0;
    if (grid == 0) {
        int dev = 0, cus = 0, per = 0;
        if (n_in != 14 || out_size != M * DM || ws_size < WS_END) { fprintf(stderr, "kernel_launch: unexpected shapes (n_in %d out %d ws %zu)\n", n_in, out_size, ws_size); grid = -1; return; }
        (void)hipGetDevice(&dev); (void)hipDeviceGetAttribute(&cus, hipDeviceAttributeMultiprocessorCount, dev);
        (void)hipFuncSetAttribute((const void*)fwd, hipFuncAttributeMaxDynamicSharedMemorySize, LDS_BYTES);
        (void)hipOccupancyMaxActiveBlocksPerMultiprocessor(&per, (const void*)fwd, 512, LDS_BYTES);
        if (per < 1) per = 1;
        grid = cus * per;
        fprintf(stderr, "kernel_launch: grid %d (cus %d x %d)\n", grid, cus, per);
    }
    if (grid < 0) return;
    Args a{};
    for (int i = 0; i < 14; ++i) a.in[i] = (const float*)d_in[i];
    a.out = (float*)d_out; a.ws = (unsigned char*)d_ws;
#if MK_MULTI
    for (int ph = 0; ph < NPHASE; ++ph) { a.ph_lo = ph; a.ph_hi = ph + 1; hipLaunchKernelGGL(fwd, dim3(grid), dim3(512), LDS_BYTES, stream, a); }
#else
    a.ph_lo = 0; a.ph_hi = NPHASE;
    void* args[] = {&a};
    hipError_t e = hipLaunchCooperativeKernel((const void*)fwd, dim3(grid), dim3(512), args, LDS_BYTES, stream);
    if (e != hipSuccess) fprintf(stderr, "kernel_launch: cooperative launch failed: %s (grid %d)\n", hipGetErrorString(e), grid);
#endif
}
```

```cpp
#include <hip/hip_runtime.h>
#include <hip/hip_cooperative_groups.h>
#include <cstdio>
#include <cstdint>
namespace cg = cooperative_groups;
namespace pg8 {
#define PG8_LAS __attribute__((address_space(3)))
typedef unsigned short bf16_t;
typedef short bf16x8 __attribute__((ext_vector_type(8)));
typedef float f32x4 __attribute__((ext_vector_type(4)));
typedef unsigned u32x4 __attribute__((ext_vector_type(4)));
constexpr int BM = 256, BK = 64, HALF = 128, HTB = HALF * BK * 2  , STAGE_BYTES = 8 * HTB, NXCD = 8, WGM = 8;

__host__ __device__ __forceinline__ int lds_byte(int r, int c) { const int st = (r >> 4) * 2 + (c >> 5), rr = r & 15, cc = c & 31, ob = rr * 64 + cc * 2; return st * 1024 + (ob ^ (((ob >> 9) & 1) << 5)); }
__host__ __device__ __forceinline__ void stage_rc(int b, int& R, int& C) { const int st = b / 1024, sb = b % 1024, swz = sb ^ (((sb >> 9) & 1) << 5); R = (st >> 1) * 16 + swz / 64; C = (st & 1) * 32 + (swz % 64) / 2; }
__host__ __device__ __forceinline__ int perm32(int rho) { const int n = rho >> 4, i = rho & 15; return 8 * (i >> 2) + 4 * n + (i & 3); }

struct Unit { int pm, pn; };
struct Gemm { const bf16_t* A; const bf16_t* Bt; int M, N, K; };

struct StaticOrder {
    int nM, nN, nwg, G, c;
    __host__ __device__ void init(int M, int N, int G_, int c_) { nM = M / BM; nN = N / BM; nwg = nM * nN; G = G_; c = c_; }
    __host__ __device__ bool next(int i, Unit& u) const {
        const long L = (long)i * G + c; if (L >= nwg) return false;
        int wgid = (int)L; { const int q = nwg / NXCD, r = nwg % NXCD, xcd = wgid % NXCD, off = wgid / NXCD; wgid = (xcd < r ? xcd * (q + 1) : r * (q + 1) + (xcd - r) * q) + off; }
        const int nig = WGM * nN, gid = wgid / nig, fm = gid * WGM, gsz = (nM - fm) < WGM ? (nM - fm) : WGM;
        u.pm = fm + ((wgid % nig) % gsz); u.pn = (wgid % nig) / gsz; return true;
    }
    __device__ __forceinline__ void a_ready(const Unit&) const {}
    __device__ __forceinline__ void done(const Unit&) const {}
};

__device__ __forceinline__ unsigned cvt_pk_bf16(float lo, float hi) { unsigned r; asm volatile("v_cvt_pk_bf16_f32 %0, %1, %2" : "=v"(r) : "v"(lo), "v"(hi)); return r; }
typedef float f32x2 __attribute__((ext_vector_type(2)));
template <class Epi, class Sched, bool ALIGN_EPI = false, bool SP2 = false>
__device__ __forceinline__ void gemm_phase(PG8_LAS unsigned char* lds, const Gemm g, const Sched& S, const Epi& E) {
    int tid_ = threadIdx.x; asm volatile("" : "+v"(tid_));
    const int tid = tid_, wid = __builtin_amdgcn_readfirstlane(tid >> 6), lane = tid & 63, wr = wid >> 2, wc = wid & 3, fr = lane & 15, fq = lane >> 4;
    const int K = g.K, nt = K / BK;
    unsigned voffA[2], voffB[2];
#pragma unroll
    for (int i = 0; i < 2; ++i) { int R, C; stage_rc(tid * 16 + i * 8192, R, C); const int Rb = Epi::PERM ? ((R & ~31) + perm32(R & 31)) : R;
        voffA[i] = (unsigned)(R * K + C) * 2u; voffB[i] = (unsigned)(Rb * K + C) * 2u; }
    const size_t kstep = (size_t)(BK * 2);
    const size_t hstep = (size_t)HALF * K * 2;
    const size_t tstep = 2 * hstep;
    const unsigned ldsw = (unsigned)wid * 1024u;
    const int aoff = lds_byte(wr * 64 + fr, fq * 8), boff = lds_byte(wc * 32 + fr, fq * 8);
#define PG8_SA(b, h) (((b) * 2 + (h)) * HTB)
#define PG8_SB(b, h) ((4 + (b) * 2 + (h)) * HTB)
#define PG8_STAGE(bufoff, gbase, voff) do { _Pragma("unroll") for (int _i = 0; _i < 2; ++_i) \
        __builtin_amdgcn_global_load_lds((const unsigned*)((const char*)(gbase) + (voff)[_i]), (PG8_LAS unsigned*)(lds + (bufoff) + ldsw + _i * 8192), 16, 0, 0); } while (0)
#define PG8_LDA(dst, b, h) do { _Pragma("unroll") for (int m = 0; m < 4; ++m) _Pragma("unroll") for (int k = 0; k < 2; ++k) dst[m][k] = *(const PG8_LAS bf16x8*)(lds + PG8_SA(b, h) + aoff + m * 2048 + k * 1024); } while (0)
#define PG8_LDB(dst, b, h) do { _Pragma("unroll") for (int n = 0; n < 2; ++n) _Pragma("unroll") for (int k = 0; k < 2; ++k) dst[n][k] = *(const PG8_LAS bf16x8*)(lds + PG8_SB(b, h) + boff + n * 2048 + k * 1024); } while (0)
#define PG8_MMA(ai, bj, At, Bt) do { __builtin_amdgcn_s_setprio(1); _Pragma("unroll") for (int m = 0; m < 4; ++m) _Pragma("unroll") for (int n = 0; n < 2; ++n) _Pragma("unroll") for (int k = 0; k < 2; ++k) \
        acc[ai][bj][m][n] = __builtin_amdgcn_mfma_f32_16x16x32_bf16(Bt[n][k], At[m][k], acc[ai][bj][m][n], 0, 0, 0); __builtin_amdgcn_s_setprio(0); } while (0)
#define PG8_WAIT_V(n) asm volatile("s_waitcnt vmcnt(" #n ")" ::: "memory")
#define PG8_WAIT_L(n) asm volatile("s_waitcnt lgkmcnt(" #n ")" ::: "memory")
#define PG8_BAR __builtin_amdgcn_s_barrier()
#define PG8_SCHED __builtin_amdgcn_sched_barrier(0)
    Unit cur, nxt; int ui = 0;
    if (!S.next(0, cur)) return;
    f32x4 acc[2][2][4][2];
#pragma unroll
    for (int a = 0; a < 2; ++a)
#pragma unroll
        for (int b = 0; b < 2; ++b)
#pragma unroll
            for (int m = 0; m < 4; ++m)
#pragma unroll
                for (int n = 0; n < 2; ++n) acc[a][b][m][n] = (f32x4){0.f, 0.f, 0.f, 0.f};
    bf16x8 At[4][2], B0[2][2], B1[2][2];
    const char* cA = (const char*)g.A + (size_t)cur.pm * tstep; const char* cB = (const char*)g.Bt + (size_t)cur.pn * tstep;
    S.a_ready(cur);
    if constexpr (SP2) {
        PG8_STAGE(PG8_SB(0, 0), cB, voffB); PG8_STAGE(PG8_SB(0, 1), cB + hstep, voffB); PG8_STAGE(PG8_SA(0, 0), cA, voffA); PG8_STAGE(PG8_SA(0, 1), cA + hstep, voffA);
        if (wr == 1) PG8_BAR;
        PG8_WAIT_V(2); PG8_BAR;
        PG8_STAGE(PG8_SB(1, 0), cB + kstep, voffB); PG8_STAGE(PG8_SA(1, 0), cA + kstep, voffA); PG8_STAGE(PG8_SB(1, 1), cB + hstep + kstep, voffB);
        PG8_WAIT_V(6); PG8_BAR;
    } else {
        PG8_STAGE(PG8_SB(0, 0), cB, voffB); PG8_STAGE(PG8_SA(0, 0), cA, voffA); PG8_STAGE(PG8_SB(0, 1), cB + hstep, voffB); PG8_STAGE(PG8_SA(0, 1), cA + hstep, voffA);
        if (wr == 1) PG8_BAR;
        PG8_WAIT_V(4); PG8_BAR;
        PG8_STAGE(PG8_SB(1, 0), cB + kstep, voffB); PG8_STAGE(PG8_SA(1, 0), cA + kstep, voffA); PG8_STAGE(PG8_SB(1, 1), cB + hstep + kstep, voffB);
        PG8_WAIT_V(6); PG8_BAR;
    }
    for (;;) {
        const bool has_next = S.next(ui + 1, nxt);
        const char* nA = has_next ? (const char*)g.A + (size_t)nxt.pm * tstep : cA; const char* nB = has_next ? (const char*)g.Bt + (size_t)nxt.pn * tstep : cB;
        for (int t = 0; t < nt; t += 2) {
            const bool last = (t == nt - 2);
            const char* a1 = cA + (size_t)(t + 1) * kstep;
            const char* a2 = last ? nA : cA + (size_t)(t + 2) * kstep; const char* b2 = last ? nB : cB + (size_t)(t + 2) * kstep;
            const char* a3 = a2 + kstep; const char* b3 = b2 + kstep;
            if (last && has_next) S.a_ready(nxt);
            if constexpr (SP2) {
            PG8_LDB(B0, 0, 0); PG8_LDB(B1, 0, 1); PG8_SCHED; PG8_LDA(At, 0, 0); PG8_STAGE(PG8_SA(1, 1), a1 + hstep, voffA);
            PG8_WAIT_V(8); PG8_WAIT_L(0); PG8_BAR; PG8_MMA(0, 0, At, B0); PG8_MMA(0, 1, At, B1); PG8_BAR; PG8_SCHED;
            PG8_LDA(At, 0, 1); PG8_STAGE(PG8_SB(0, 0), b2, voffB); PG8_STAGE(PG8_SB(0, 1), b2 + hstep, voffB); PG8_STAGE(PG8_SA(0, 0), a2, voffA);
            PG8_WAIT_V(8); PG8_WAIT_L(0); PG8_BAR; PG8_MMA(1, 0, At, B0); PG8_MMA(1, 1, At, B1); PG8_BAR; PG8_SCHED;
            PG8_LDB(B0, 1, 0); PG8_LDB(B1, 1, 1); PG8_SCHED; PG8_LDA(At, 1, 0); PG8_STAGE(PG8_SA(0, 1), a2 + hstep, voffA);
            PG8_WAIT_V(8); PG8_WAIT_L(0); PG8_BAR; PG8_MMA(0, 0, At, B0); PG8_MMA(0, 1, At, B1); PG8_BAR; PG8_SCHED;
            PG8_LDA(At, 1, 1); PG8_STAGE(PG8_SB(1, 0), b3, voffB); PG8_STAGE(PG8_SB(1, 1), b3 + hstep, voffB); PG8_STAGE(PG8_SA(1, 0), a3, voffA);
            PG8_WAIT_V(8); PG8_WAIT_L(0); PG8_BAR; PG8_MMA(1, 0, At, B0); PG8_MMA(1, 1, At, B1); PG8_BAR; PG8_SCHED;
            } else {
            PG8_LDB(B0, 0, 0); PG8_SCHED; PG8_LDA(At, 0, 0); PG8_STAGE(PG8_SA(1, 1), a1 + hstep, voffA);
            PG8_WAIT_L(8); PG8_BAR; PG8_WAIT_L(0); PG8_MMA(0, 0, At, B0); PG8_BAR; PG8_SCHED;
            PG8_LDB(B1, 0, 1); PG8_STAGE(PG8_SB(0, 0), b2, voffB);
            PG8_BAR; PG8_WAIT_L(0); PG8_MMA(0, 1, At, B1); PG8_BAR;
            PG8_LDA(At, 0, 1); PG8_STAGE(PG8_SA(0, 0), a2, voffA);
            PG8_BAR; PG8_WAIT_L(0); PG8_MMA(1, 0, At, B0); PG8_BAR; PG8_SCHED;
            PG8_STAGE(PG8_SB(0, 1), b2 + hstep, voffB);
            PG8_WAIT_V(6); PG8_BAR; PG8_MMA(1, 1, At, B1); PG8_BAR;
            PG8_LDB(B0, 1, 0); PG8_SCHED; PG8_LDA(At, 1, 0); PG8_STAGE(PG8_SA(0, 1), a2 + hstep, voffA);
            PG8_WAIT_L(8); PG8_BAR; PG8_WAIT_L(0); PG8_MMA(0, 0, At, B0); PG8_BAR; PG8_SCHED;
            PG8_LDB(B1, 1, 1); PG8_STAGE(PG8_SB(1, 0), b3, voffB);
            PG8_BAR; PG8_WAIT_L(0); PG8_MMA(0, 1, At, B1); PG8_BAR;
            PG8_LDA(At, 1, 1); PG8_STAGE(PG8_SA(1, 0), a3, voffA);
            PG8_BAR; PG8_WAIT_L(0); PG8_MMA(1, 0, At, B0); PG8_BAR; PG8_SCHED;
            PG8_STAGE(PG8_SB(1, 1), b3 + hstep, voffB);
            PG8_WAIT_V(6); PG8_BAR; PG8_MMA(1, 1, At, B1); PG8_BAR;
            }
        }
        if constexpr (ALIGN_EPI) { if (wr == 0) PG8_BAR; }
        if constexpr (!Epi::AFTER_DRAIN) { E(acc, cur, wr, wc, fr, fq); S.done(cur); }
        if (!has_next) break;
#pragma unroll
        for (int a = 0; a < 2; ++a)
#pragma unroll
            for (int b = 0; b < 2; ++b)
#pragma unroll
                for (int m = 0; m < 4; ++m)
#pragma unroll
                    for (int n = 0; n < 2; ++n) acc[a][b][m][n] = (f32x4){0.f, 0.f, 0.f, 0.f};
        cur = nxt; cA = nA; cB = nB; ++ui;
        if constexpr (ALIGN_EPI) { if (wr == 1) PG8_BAR; }
    }
    PG8_WAIT_V(0);
    if constexpr (!ALIGN_EPI) { if (wr == 0) PG8_BAR; }
    PG8_BAR;
    if constexpr (Epi::AFTER_DRAIN) { E.fused(acc, cur, wr, wc, fr, fq, lds, wid, lane); S.done(cur); }
#undef PG8_SA
#undef PG8_SB
#undef PG8_STAGE
#undef PG8_LDA
#undef PG8_LDB
#undef PG8_MMA
#undef PG8_WAIT_V
#undef PG8_WAIT_L
#undef PG8_BAR
#undef PG8_SCHED
}
}
#include <hip/hip_bf16.h>
#include <cmath>
namespace attn_body {
using bf16=__hip_bfloat16;
using bf16x8=__attribute__((ext_vector_type(8)))short;
using s16x4=__attribute__((ext_vector_type(4)))short;
using f32x16=__attribute__((ext_vector_type(16)))float;
using u32x4=__attribute__((ext_vector_type(4)))unsigned;
using f32x4v=__attribute__((ext_vector_type(4)))float;
constexpr int SEQ=4096,D=64,DM=64,OPITCH=1024;
constexpr int LDS_C=98304;
constexpr int NW=8,QBLK=32,QB=QBLK*NW,KVBLK=64,NQB=SEQ/QB;
constexpr int ATTN_UNIT_ROWS=QB;
__device__ __forceinline__ int crow(int r,int hi){return (r&3)+8*(r>>2)+4*hi;}
#define SBAR() __builtin_amdgcn_sched_barrier(0)
__device__ __forceinline__ void cmask(f32x16&p0,f32x16&p1,int jb,int qrel,int hi){
  const float NEG=-INFINITY; int kb=64*jb+4*hi;
  #pragma unroll
  for(int r=0;r<16;++r){int kv=kb+(r&3)+8*(r>>2); if(kv>qrel)p0[r]=NEG; if(kv+32>qrel)p1[r]=NEG;}
}

constexpr int NSLOT=3, SLOTB=8192;
constexpr int LDS_K=0, LDS_V=NSLOT*SLOTB, LDS_WS=2*NSLOT*SLOTB, LDS_OST=LDS_WS+NW*64*4, LDS_BYTES=LDS_OST+NW*4096;
constexpr float C2=0.125f*1.4426950408889634f;
__device__ __forceinline__ void glds16(const void*gsrc,unsigned lds_dst){unsigned keep;
  asm volatile("s_mov_b32 %0, m0\n\ts_mov_b32 m0, %2\n\ts_nop 0\n\tglobal_load_lds_dwordx4 %1, off\n\ts_mov_b32 m0, %0":"=&s"(keep):"v"(gsrc),"s"(lds_dst):"memory");}
__device__ __forceinline__ float max3f(float a,float b,float c){float r;asm("v_max3_f32 %0, %1, %2, %3":"=v"(r):"v"(a),"v"(b),"v"(c));return r;}
__device__ __forceinline__ float max2f(float a,float b){float r;asm("v_max_f32_e32 %0, %1, %2":"=v"(r):"v"(a),"v"(b));return r;}
__device__ __forceinline__ float fadd_s(float a,float b){float r;asm("v_add_f32_e32 %0, %1, %2":"=v"(r):"v"(a),"v"(b));return r;}
__device__ __forceinline__ float fsub_s(float a,float b){float r;asm("v_sub_f32_e32 %0, %1, %2":"=v"(r):"v"(a),"v"(b));return r;}
typedef float f32x2_t __attribute__((ext_vector_type(2))); typedef __bf16 bf16x2_t __attribute__((ext_vector_type(2)));
__device__ __forceinline__ unsigned cvtpk_s(float lo,float hi){f32x2_t v={lo,hi};bf16x2_t b=__builtin_convertvector(v,bf16x2_t);return __builtin_bit_cast(unsigned,b);}
#define WAIT_BAR(N) asm volatile("s_waitcnt vmcnt(" #N ") lgkmcnt(0)\n\ts_barrier":::"memory")

__device__ __forceinline__ void qkt(f32x16&p0,f32x16&p1,const char*Kslot,const bf16x8*qr,const f32x16&negm,int r32,int hi){
  const char*kb=Kslot+hi*1024+r32*16;
  #pragma unroll
  for(int d0=0;d0<4;++d0){
    const bf16x8 b0=*reinterpret_cast<const bf16x8*>(kb+d0*2048);
    const bf16x8 b1=*reinterpret_cast<const bf16x8*>(kb+d0*2048+512);
    if(d0==0){p0=__builtin_amdgcn_mfma_f32_32x32x16_bf16(b0,qr[0],negm,0,0,0);p1=__builtin_amdgcn_mfma_f32_32x32x16_bf16(b1,qr[0],negm,0,0,0);}
    else{p0=__builtin_amdgcn_mfma_f32_32x32x16_bf16(b0,qr[d0],p0,0,0,0);p1=__builtin_amdgcn_mfma_f32_32x32x16_bf16(b1,qr[d0],p1,0,0,0);}}
}
typedef __attribute__((address_space(3))) const char* lds_cptr;
typedef short v4i16_t __attribute__((ext_vector_type(4)));
__device__ __forceinline__ void kload8(bf16x8*kf,lds_cptr kp){
  kf[0]=*(const __attribute__((address_space(3))) bf16x8*)(kp);      kf[1]=*(const __attribute__((address_space(3))) bf16x8*)(kp+512);
  kf[2]=*(const __attribute__((address_space(3))) bf16x8*)(kp+2048); kf[3]=*(const __attribute__((address_space(3))) bf16x8*)(kp+2560);
  kf[4]=*(const __attribute__((address_space(3))) bf16x8*)(kp+4096); kf[5]=*(const __attribute__((address_space(3))) bf16x8*)(kp+4608);
  kf[6]=*(const __attribute__((address_space(3))) bf16x8*)(kp+6144); kf[7]=*(const __attribute__((address_space(3))) bf16x8*)(kp+6656);
}
__device__ __forceinline__ void kload2(bf16x8*kf,lds_cptr kp,int j){ kf[2*j]=*(const __attribute__((address_space(3))) bf16x8*)(kp+j*2048); kf[2*j+1]=*(const __attribute__((address_space(3))) bf16x8*)(kp+j*2048+512); }
__device__ __forceinline__ s16x4 vtr(lds_cptr p){ return __builtin_bit_cast(s16x4,__builtin_amdgcn_ds_read_tr16_b64_v4i16((__attribute__((address_space(3))) v4i16_t*)p)); }
__device__ __forceinline__ float rowmax(const f32x16&p0,const f32x16&p1){
  float a=max3f(p0[0],p0[1],p1[0]),b=max3f(p0[2],p0[3],p1[1]);a=max3f(a,p1[2],p1[3]);
  #pragma unroll
  for(int r=4;r<16;r+=4){a=max3f(a,p0[r],p0[r+1]);b=max3f(b,p0[r+2],p0[r+3]);a=max3f(a,p1[r],p1[r+1]);b=max3f(b,p1[r+2],p1[r+3]);}
  const float m=max2f(a,b);
  auto rr=__builtin_amdgcn_permlane32_swap(__float_as_uint(m),__float_as_uint(m),false,false);
  return max2f(__uint_as_float(rr[0]),__uint_as_float(rr[1]));
}
__device__ __forceinline__ void pv(f32x16*o,int vb,bf16x8 pa0,bf16x8 pa1,bf16x8 pa2,bf16x8 pa3){
  #pragma unroll
  for(int d0=0;d0<2;++d0){s16x4 lo[4],hi[4];
    #pragma unroll
    for(int ks=0;ks<4;++ks){
      asm volatile("ds_read_b64_tr_b16 %0,%1 offset:%c2":"=&v"(lo[ks]):"v"(vb),"i"(d0*4096+ks*1024):"memory");
      asm volatile("ds_read_b64_tr_b16 %0,%1 offset:%c2":"=&v"(hi[ks]):"v"(vb),"i"(d0*4096+ks*1024+512):"memory");}
    asm volatile("s_waitcnt lgkmcnt(0)":::"memory");SBAR();
    #define PK(k) (bf16x8){lo[k][0],lo[k][1],lo[k][2],lo[k][3],hi[k][0],hi[k][1],hi[k][2],hi[k][3]}
    o[d0]=__builtin_amdgcn_mfma_f32_32x32x16_bf16(pa0,PK(0),o[d0],0,0,0);
    o[d0]=__builtin_amdgcn_mfma_f32_32x32x16_bf16(pa1,PK(1),o[d0],0,0,0);
    o[d0]=__builtin_amdgcn_mfma_f32_32x32x16_bf16(pa2,PK(2),o[d0],0,0,0);
    o[d0]=__builtin_amdgcn_mfma_f32_32x32x16_bf16(pa3,PK(3),o[d0],0,0,0);
    #undef PK
  }
}

#ifndef ATTN_STORE16
#define ATTN_STORE16(p,v) (*(u32x4*)(p)=(v))
#endif
template<int THRL> __device__ __forceinline__ void attn_unit(int qb,const bf16*Q,const bf16*__restrict__ K,const bf16*__restrict__ V,bf16*O,const float*__restrict__ Cg,char*shm){
  int tid_=threadIdx.x; asm volatile("":"+v"(tid_)); const int tid=tid_,lane=tid&63,r32=lane&31,hi=lane>>5; const int wid=__builtin_amdgcn_readfirstlane(tid>>6);
  const int q0=qb*QB;
  const bf16*Qw=Q+(long)(q0+wid*QBLK)*DM;
  const bf16*Kh=K,*Vh=V;
  const lds_cptr shm3=(lds_cptr)shm;
  const unsigned lds0=(unsigned)(uintptr_t)shm;
  float*wsf=(float*)(shm+LDS_WS)+wid*64;
  const bf16*ksrc=Kh+(long)lane*DM+wid*8;
  const bf16*vsrc=Vh+(long)(16*(wid&3)+(lane>>2))*DM+(wid>>2)*32+(lane&3)*8;
  const unsigned kdst=lds0+LDS_K+wid*1024, vdst=lds0+LDS_V+wid*1024;
  #define DMA_K(t,slot) glds16(ksrc+(long)(t)*KVBLK*DM,(unsigned)__builtin_amdgcn_readfirstlane(kdst+(slot)))
  #define DMA_V(t,slot) glds16(vsrc+(long)(t)*KVBLK*DM,(unsigned)__builtin_amdgcn_readfirstlane(vdst+(slot)))
  const int vb0=(int)(lds0+LDS_V)+((lane>>4)&1)*32+(lane&3)*8+(4*hi+((lane&15)>>2))*64;
  const char*Kbase=shm+LDS_K; bf16x8 kf[8];
  const lds_cptr kp0=shm3+LDS_K+hi*1024+r32*16; const lds_cptr vp0=shm3+LDS_V+((lane>>4)&1)*32+(lane&3)*8+(4*hi+((lane&15)>>2))*64;
  const int NT=(q0+QB)/KVBLK;
  { typedef __attribute__((address_space(3))) float lf32; lf32*cl_=(lf32*)(shm3+LDS_C); for(int i=tid;i<q0+QB;i+=NW*64)cl_[i]=Cg[i]; }
  DMA_K(0,0);DMA_V(0,0);DMA_K(1,SLOTB);
  bf16x8 qr[4];
  #pragma unroll
  for(int d0=0;d0<4;++d0)qr[d0]=*reinterpret_cast<const bf16x8*>(&Qw[(long)r32*DM+d0*16+hi*8]);
  float mhat=0.f,l_reg=0.f;f32x16 o[2];o[0]=f32x16{};o[1]=f32x16{};f32x16 negm=f32x16{};asm volatile("":"+v"(negm));
  const int qrel=wid*QBLK+r32;
  #define CMASK(P0,P1,t) do{int jb_=(t)-(NT-4); if(jb_>=0)cmask(P0,P1,jb_,qrel,hi);}while(0)
  typedef __attribute__((address_space(3))) const float* lds_fptr; typedef __attribute__((address_space(3))) const f32x4v* lds_f4ptr;
  const lds_fptr cl0=(lds_fptr)(shm3+LDS_C)+4*hi;
  #define BIAS(P0,P1,t) do{ const lds_fptr cb_=cl0+64*(t); _Pragma("unroll") for(int g_=0;g_<4;++g_){ const f32x4v a_=*(lds_f4ptr)(cb_+8*g_), b_=*(lds_f4ptr)(cb_+32+8*g_); \
      _Pragma("unroll") for(int i_=0;i_<4;++i_){P0[4*g_+i_]-=a_[i_];P1[4*g_+i_]-=b_[i_];} } }while(0)
  bool resc=false;
  #define START(P0,P1) do{ const float rm=rowmax(P0,P1); resc=false; \
    { const float dl=rm; mhat=fadd_s(mhat,dl); \
      _Pragma("unroll") for(int r=0;r<16;++r){P0[r]=fsub_s(P0[r],dl);P1[r]=fsub_s(P1[r],dl);} \
      _Pragma("unroll") for(int r=0;r<16;++r)negm[r]=-mhat; asm volatile("":"+v"(negm)); } \
    _Pragma("unroll") for(int r=0;r<16;++r)P0[r]=__builtin_amdgcn_exp2f(P0[r]); }while(0)
  #define RESC() do{ if(resc){ asm volatile("s_waitcnt lgkmcnt(0)":::"memory"); \
      _Pragma("unroll") for(int d_=0;d_<2;++d_) _Pragma("unroll") for(int r=0;r<16;++r)o[d_][r]*=wsf[crow(r,hi)]; } }while(0)
  f32x16 pA0,pA1,pB0,pB1;
  int sl_prev=0,sl_cur=0,sl_next=SLOTB;
  #define ROT() do{sl_prev=sl_cur;sl_cur=sl_next;sl_next=(sl_next==(NSLOT-1)*SLOTB)?0:sl_next+SLOTB;}while(0)
  DMA_K(2,2*SLOTB);
  WAIT_BAR(3);
  qkt(pA0,pA1,Kbase,qr,negm,r32,hi);asm volatile("s_nop 15\n\ts_nop 7":"+v"(pA0),"+v"(pA1));BIAS(pA0,pA1,0);CMASK(pA0,pA1,0);
  START(pA0,pA1);
  _Pragma("unroll") for(int r=0;r<16;++r)pA1[r]=__builtin_amdgcn_exp2f(pA1[r]);
  WAIT_BAR(0);
  DMA_K(3,0);DMA_V(1,SLOTB);
  ROT();
  kload8(kf,kp0+sl_cur);
  WAIT_BAR(2);
  s16x4 vlo[8],vhi[8]; u32x4 pw0,pw1,pw2,pw3;
  #define PKW(P,B) cvtpk_s(P[B],P[B+1])
  #define PAF(k) __builtin_bit_cast(bf16x8,pw##k)
  #define VFR(i) (bf16x8){vlo[i][0],vlo[i][1],vlo[i][2],vlo[i][3],vhi[i][0],vhi[i][1],vhi[i][2],vhi[i][3]}
  #define PIN(x) asm volatile("":"+v"(x))
  #define MX3(a,b,c) __builtin_fmaxf(__builtin_fmaxf((a),(b)),(c))
  #define GAPA(MF,A0,A1,A2,A3,W0,W1,PW) do{ MF; sacc+=A0; sacc+=A1; sacc+=A2; sacc+=A3; PIN(sacc); W0; W1; PIN(PW); SBAR(); }while(0)
  #define EX(v) __builtin_amdgcn_exp2f(v)
  #define GAPB(MF,X,B) do{ MF; X[B]=EX(X[B]); X[B+1]=EX(X[B+1]); X[B+2]=EX(X[B+2]); X[B+3]=EX(X[B+3]); PIN(X); SBAR(); }while(0)
  #define VRD(i) do{ vlo[i]=vtr(vp_+(((i)>>2)*4096+((i)&3)*1024)); vhi[i]=vtr(vp_+(((i)>>2)*4096+((i)&3)*1024+512)); }while(0)
  #define KRD(G,j) do{ if(G){ kload2(kf,kp0+sl_next,j); SBAR(); } }while(0)
  #define STEP(C0,C1,P0,P1,t,GK,GV,GL) do{ SBAR(); \
    const lds_cptr vp_=vp0+sl_prev; \
    VRD(0); SBAR(); float sacc=(P0[0]+P0[1]); \
    GAPA(C0=__builtin_amdgcn_mfma_f32_32x32x16_bf16(kf[0],qr[0],negm,0,0,0), P0[2],P0[3],P0[4],P0[5],     pw0[0]=PKW(P0,0), pw0[1]=PKW(P0,2), pw0); \
    VRD(4); SBAR(); GAPA(C1=__builtin_amdgcn_mfma_f32_32x32x16_bf16(kf[1],qr[0],negm,0,0,0), P0[6],P0[7],P0[8],P0[9],     pw0[2]=PKW(P0,4), pw0[3]=PKW(P0,6), pw0); \
    VRD(1); SBAR(); GAPA(C0=__builtin_amdgcn_mfma_f32_32x32x16_bf16(kf[2],qr[1],C0,0,0,0),   P0[10],P0[11],P0[12],P0[13], pw1[0]=PKW(P0,8), pw1[1]=PKW(P0,10), pw1); \
    VRD(5); SBAR(); GAPA(C1=__builtin_amdgcn_mfma_f32_32x32x16_bf16(kf[3],qr[1],C1,0,0,0),   P0[14],P0[15],P1[0],P1[1],   pw1[2]=PKW(P0,12),pw1[3]=PKW(P0,14), pw1); \
    VRD(2); SBAR(); GAPA(C0=__builtin_amdgcn_mfma_f32_32x32x16_bf16(kf[4],qr[2],C0,0,0,0),   P1[2],P1[3],P1[4],P1[5],     pw2[0]=PKW(P1,0), pw2[1]=PKW(P1,2), pw2); \
    VRD(6); SBAR(); GAPA(C1=__builtin_amdgcn_mfma_f32_32x32x16_bf16(kf[5],qr[2],C1,0,0,0),   P1[6],P1[7],P1[8],P1[9],     pw2[2]=PKW(P1,4), pw2[3]=PKW(P1,6), pw2); \
    VRD(3); SBAR(); GAPA(C0=__builtin_amdgcn_mfma_f32_32x32x16_bf16(kf[6],qr[3],C0,0,0,0),   P1[10],P1[11],P1[12],P1[13], pw3[0]=PKW(P1,8), pw3[1]=PKW(P1,10), pw3); \
    VRD(7); SBAR(); GAPA(C1=__builtin_amdgcn_mfma_f32_32x32x16_bf16(kf[7],qr[3],C1,0,0,0),   P1[14],P1[15],0.f,0.f,       pw3[2]=PKW(P1,12),pw3[3]=PKW(P1,14), pw3); \
    l_reg+=sacc; \
    if(GK){DMA_K((t)+3,sl_cur);} if(GV){DMA_V((t)+1,sl_next);} \
    BIAS(C0,C1,t); CMASK(C0,C1,t); \
    { float a=MX3(C0[0],C0[1],C1[0]),b=MX3(C0[2],C0[3],C1[1]); a=MX3(a,C1[2],C1[3]); \
      _Pragma("unroll") for(int r=4;r<16;r+=4){a=MX3(a,C0[r],C0[r+1]);b=MX3(b,C0[r+2],C0[r+3]);a=MX3(a,C1[r],C1[r+1]);b=MX3(b,C1[r+2],C1[r+3]);} \
      float rm=__builtin_fmaxf(a,b); { auto rr=__builtin_amdgcn_permlane32_swap(__float_as_uint(rm),__float_as_uint(rm),false,false); rm=__builtin_fmaxf(__uint_as_float(rr[0]),__uint_as_float(rr[1])); } \
      resc=false; \
      if(__builtin_expect(__any(rm>(float)THRL),0)){ const float dl=__builtin_fmaxf(rm,0.f); mhat+=dl; \
        _Pragma("unroll") for(int r=0;r<16;++r){C0[r]-=dl;C1[r]-=dl;} \
        _Pragma("unroll") for(int r=0;r<16;++r)negm[r]=-mhat; asm volatile("":"+v"(negm)); \
        const float f=__builtin_amdgcn_exp2f(-dl); l_reg*=f; if(hi==0)wsf[r32]=f; resc=true; } } \
    SBAR(); \
    GAPB(o[0]=__builtin_amdgcn_mfma_f32_32x32x16_bf16(PAF(0),VFR(0),o[0],0,0,0), C0,0); \
    GAPB(o[1]=__builtin_amdgcn_mfma_f32_32x32x16_bf16(PAF(0),VFR(4),o[1],0,0,0), C0,4); \
    KRD(GL,0); GAPB(o[0]=__builtin_amdgcn_mfma_f32_32x32x16_bf16(PAF(1),VFR(1),o[0],0,0,0), C0,8); \
    KRD(GL,1); GAPB(o[1]=__builtin_amdgcn_mfma_f32_32x32x16_bf16(PAF(1),VFR(5),o[1],0,0,0), C0,12); \
    KRD(GL,2); GAPB(o[0]=__builtin_amdgcn_mfma_f32_32x32x16_bf16(PAF(2),VFR(2),o[0],0,0,0), C1,0); \
    KRD(GL,3); GAPB(o[1]=__builtin_amdgcn_mfma_f32_32x32x16_bf16(PAF(2),VFR(6),o[1],0,0,0), C1,4); \
    GAPB(o[0]=__builtin_amdgcn_mfma_f32_32x32x16_bf16(PAF(3),VFR(3),o[0],0,0,0), C1,8); \
    GAPB(o[1]=__builtin_amdgcn_mfma_f32_32x32x16_bf16(PAF(3),VFR(7),o[1],0,0,0), C1,12); \
    }while(0)
  int t=1;
  #undef CMASK
  #define CMASK(P0,P1,t) do{}while(0)
  for(;t+5<NT;t+=2){
    STEP(pB0,pB1,pA0,pA1,t,true,true,true);     WAIT_BAR(2); RESC(); ROT();
    STEP(pA0,pA1,pB0,pB1,t+1,true,true,true);   WAIT_BAR(2); RESC(); ROT();
  }
  #undef CMASK
  #define CMASK(P0,P1,t) do{int jb_=(t)-(NT-4); if(jb_>=0)cmask(P0,P1,jb_,qrel,hi);}while(0)
  #define ENDW(tt) do{ if((tt)+3<NT){WAIT_BAR(2);} else if((tt)+2<NT){WAIT_BAR(1);} else {WAIT_BAR(0);} }while(0)
  for(;t+1<NT;t+=2){
    STEP(pB0,pB1,pA0,pA1,t,(t+3<NT),(t+1<NT),(t+1<NT));       ENDW(t);   RESC(); ROT();
    STEP(pA0,pA1,pB0,pB1,t+1,(t+4<NT),(t+2<NT),(t+2<NT));     ENDW(t+1); RESC(); ROT();
  }
  STEP(pB0,pB1,pA0,pA1,NT-1,false,false,false); RESC();
  { float sacc=pB0[0]+pB0[1]; _Pragma("unroll") for(int r=2;r<16;++r)sacc+=pB0[r]; _Pragma("unroll") for(int r=0;r<16;++r)sacc+=pB1[r]; l_reg+=sacc;
    pw0=(u32x4){PKW(pB0,0),PKW(pB0,2),PKW(pB0,4),PKW(pB0,6)};pw1=(u32x4){PKW(pB0,8),PKW(pB0,10),PKW(pB0,12),PKW(pB0,14)};pw2=(u32x4){PKW(pB1,0),PKW(pB1,2),PKW(pB1,4),PKW(pB1,6)};pw3=(u32x4){PKW(pB1,8),PKW(pB1,10),PKW(pB1,12),PKW(pB1,14)};
    SBAR(); pv(o,vb0+sl_cur,PAF(0),PAF(1),PAF(2),PAF(3)); }
  #undef PKW
  #undef PAF
  #undef VFR
  #undef PIN
  #undef MX3
  #undef GAPA
  #undef GAPB
  #undef EX
  #undef VRD
  #undef KRD
  #undef STEP
  #undef ENDW
  {auto rr=__builtin_amdgcn_permlane32_swap(__float_as_uint(l_reg),__float_as_uint(l_reg),false,false);l_reg=__uint_as_float(rr[0])+__uint_as_float(rr[1]);}
  if(hi==0)wsf[32+r32]=l_reg;asm volatile("s_waitcnt lgkmcnt(0)":::"memory");
  float rli[16];
  #pragma unroll
  for(int r=0;r<16;++r)rli[r]=__builtin_amdgcn_rcpf(wsf[32+crow(r,hi)]);
  bf16*Ow=O+(long)(q0+wid*QBLK)*OPITCH;
  { bf16*stg=(bf16*)(shm+LDS_OST)+wid*2048;
    #pragma unroll
    for(int r=0;r<16;++r){const int orow=crow(r,hi);
      #pragma unroll
      for(int d0=0;d0<2;++d0)stg[orow*64+d0*32+r32]=__float2bfloat16(o[d0][r]*rli[r]);}
    asm volatile("s_waitcnt lgkmcnt(0)":::"memory");
    #pragma unroll
    for(int i=0;i<4;++i){const int row=i*8+(lane>>3),ch=lane&7; const u32x4 v=*(const u32x4*)(stg+row*64+ch*8); ATTN_STORE16(Ow+(long)row*OPITCH+ch*8,v);} }
  asm volatile("s_waitcnt lgkmcnt(0)\n\ts_barrier":::"memory");
  #undef DMA_K
  #undef DMA_V
  #undef CMASK
  #undef BIAS
  #undef START
  #undef RESC
  #undef ROT
}
__device__ __forceinline__ void sb_unit(int qb,const bf16*Q,const bf16*__restrict__ K,const bf16*__restrict__ V,bf16*O,char*shm){
  int tid_=threadIdx.x; asm volatile("":"+v"(tid_)); const int tid=tid_,lane=tid&63,r32=lane&31,hi=lane>>5; const int wid=__builtin_amdgcn_readfirstlane(tid>>6);
  const int q0=qb*QB;
  const bf16*Qw=Q+(long)(q0+wid*QBLK)*DM;
  const unsigned lds0=(unsigned)(uintptr_t)shm;
  typedef __attribute__((address_space(3))) int lds_i32; typedef __attribute__((address_space(3))) const u32x4* lds_u4ptr;
  lds_i32*flags=(lds_i32*)((lds_cptr)shm+LDS_WS);
  const bf16*ksrc=K+(long)lane*DM+wid*8;
  const bf16*vsrc=V+(long)(16*(wid&3)+(lane>>2))*DM+(wid>>2)*32+(lane&3)*8;
  const unsigned kdst=lds0+LDS_K+wid*1024, vdst=lds0+LDS_V+wid*1024;
  #define DMA_K(t,slot) glds16(ksrc+(long)(t)*KVBLK*DM,(unsigned)__builtin_amdgcn_readfirstlane(kdst+(slot)))
  #define DMA_V(t,slot) glds16(vsrc+(long)(t)*KVBLK*DM,(unsigned)__builtin_amdgcn_readfirstlane(vdst+(slot)))
  const int vb0=(int)(lds0+LDS_V)+((lane>>4)&1)*32+(lane&3)*8+(4*hi+((lane&15)>>2))*64;
  const int NT=(q0+QB)/KVBLK;
  DMA_K(NT-1,0);DMA_V(NT-1,0);
  bf16x8 qr[4];
  #pragma unroll
  for(int d0=0;d0<4;++d0)qr[d0]=*reinterpret_cast<const bf16x8*>(&Qw[(long)r32*DM+d0*16+hi*8]);
  f32x16 o[2];o[0]=f32x16{};o[1]=f32x16{};
  float T=0.f; const int t_abs=q0+wid*QBLK+r32;
  for(int i=0;;++i){
    const int jt=NT-1-i; const int slot=(i&1)*SLOTB; const bool more=jt>0;
    if(more){DMA_K(jt-1,slot^SLOTB);DMA_V(jt-1,slot^SLOTB); WAIT_BAR(2);} else {WAIT_BAR(0);}
    f32x16 x0,x1; { f32x16 zero=f32x16{}; qkt(x0,x1,shm+LDS_K+slot,qr,zero,r32,hi); }
    f32x16 n0,n1;
    const bool band=(jt>=NT-4); const int kb=64*jt+4*hi;
    #pragma unroll
    for(int r=0;r<16;++r){
      const float z0=x0[r],z1=x1[r];
      const float l0=__builtin_amdgcn_logf(1.0f+__builtin_amdgcn_exp2f(-__builtin_fabsf(z0))), l1=__builtin_amdgcn_logf(1.0f+__builtin_amdgcn_exp2f(-__builtin_fabsf(z1)));
      float a0=__builtin_fminf(z0,0.f)-l0, a1=__builtin_fminf(z1,0.f)-l1, m0=__builtin_fminf(-z0,0.f)-l0, m1=__builtin_fminf(-z1,0.f)-l1;
      if(band){ const int kv=kb+(r&3)+8*(r>>2); if(!(kv<t_abs)){a0=-INFINITY;m0=0.f;} if(!(kv+32<t_abs)){a1=-INFINITY;m1=0.f;} }
      x0[r]=a0;x1[r]=a1;n0[r]=m0;n1[r]=m1;
    }
    float g0[4],g1[4],p0s[4],p1s[4];
    #pragma unroll
    for(int a=0;a<4;++a){ g0[a]=(n0[4*a]+n0[4*a+1])+(n0[4*a+2]+n0[4*a+3]); g1[a]=(n1[4*a]+n1[4*a+1])+(n1[4*a+2]+n1[4*a+3]);
      { auto rr=__builtin_amdgcn_permlane32_swap(__float_as_uint(g0[a]),__float_as_uint(g0[a]),false,false); p0s[a]=__uint_as_float(hi?rr[0]:rr[1]); }
      { auto rr=__builtin_amdgcn_permlane32_swap(__float_as_uint(g1[a]),__float_as_uint(g1[a]),false,false); p1s[a]=__uint_as_float(hi?rr[0]:rr[1]); } }
    float run=T;
    #pragma unroll
    for(int a=3;a>=0;--a){ float off=run+(hi?0.f:p1s[a]); run+=g1[a]+p1s[a];
      const float t3=off,t2=t3+n1[4*a+3],t1=t2+n1[4*a+2],t0=t1+n1[4*a+1];
      x1[4*a+3]=__builtin_amdgcn_exp2f(x1[4*a+3]+t3); x1[4*a+2]=__builtin_amdgcn_exp2f(x1[4*a+2]+t2); x1[4*a+1]=__builtin_amdgcn_exp2f(x1[4*a+1]+t1); x1[4*a]=__builtin_amdgcn_exp2f(x1[4*a]+t0); }
    #pragma unroll
    for(int a=3;a>=0;--a){ float off=run+(hi?0.f:p0s[a]); run+=g0[a]+p0s[a];
      const float t3=off,t2=t3+n0[4*a+3],t1=t2+n0[4*a+2],t0=t1+n0[4*a+1];
      x0[4*a+3]=__builtin_amdgcn_exp2f(x0[4*a+3]+t3); x0[4*a+2]=__builtin_amdgcn_exp2f(x0[4*a+2]+t2); x0[4*a+1]=__builtin_amdgcn_exp2f(x0[4*a+1]+t1); x0[4*a]=__builtin_amdgcn_exp2f(x0[4*a]+t0); }
    T=run;
    u32x4 pw0,pw1,pw2,pw3;
    pw0=(u32x4){cvtpk_s(x0[0],x0[1]),cvtpk_s(x0[2],x0[3]),cvtpk_s(x0[4],x0[5]),cvtpk_s(x0[6],x0[7])};
    pw1=(u32x4){cvtpk_s(x0[8],x0[9]),cvtpk_s(x0[10],x0[11]),cvtpk_s(x0[12],x0[13]),cvtpk_s(x0[14],x0[15])};
    pw2=(u32x4){cvtpk_s(x1[0],x1[1]),cvtpk_s(x1[2],x1[3]),cvtpk_s(x1[4],x1[5]),cvtpk_s(x1[6],x1[7])};
    pw3=(u32x4){cvtpk_s(x1[8],x1[9]),cvtpk_s(x1[10],x1[11]),cvtpk_s(x1[12],x1[13]),cvtpk_s(x1[14],x1[15])};
    SBAR(); pv(o,vb0+slot,__builtin_bit_cast(bf16x8,pw0),__builtin_bit_cast(bf16x8,pw1),__builtin_bit_cast(bf16x8,pw2),__builtin_bit_cast(bf16x8,pw3));
    const int dw=__all(T<-150.f)?1:0;
    if(lane==0)flags[wid]=dw;
    WAIT_BAR(2);
    const u32x4 f0=*(lds_u4ptr)(flags), f1=*(lds_u4ptr)(flags+4);
    const bool alld=((f0.x&f0.y&f0.z&f0.w)&(f1.x&f1.y&f1.z&f1.w))!=0;
    if(!more||alld)break;
  }
  WAIT_BAR(0);
  bf16*Ow=O+(long)(q0+wid*QBLK)*OPITCH;
  { bf16*stg=(bf16*)(shm+LDS_OST)+wid*2048;
    #pragma unroll
    for(int r=0;r<16;++r){const int orow=crow(r,hi);
      #pragma unroll
      for(int d0=0;d0<2;++d0)stg[orow*64+d0*32+r32]=__float2bfloat16(o[d0][r]);}
    asm volatile("s_waitcnt lgkmcnt(0)":::"memory");
    #pragma unroll
    for(int i=0;i<4;++i){const int row=i*8+(lane>>3),ch=lane&7; const u32x4 v=*(const u32x4*)(stg+row*64+ch*8); ATTN_STORE16(Ow+(long)row*OPITCH+ch*8,v);} }
  asm volatile("s_waitcnt lgkmcnt(0)\n\ts_barrier":::"memory");
  #undef DMA_K
  #undef DMA_V
}
#undef SBAR
#undef WAIT_BAR
}

constexpr int BATCH = 8, SEQ = 4096, DM = 1024, DEPTH = 4, M = BATCH * SEQ, INC = 3334, NIN = 3584, DFF = 4096;
constexpr float EPS = 1e-6f;
constexpr size_t MiB = 1u << 20;
constexpr size_t WS_SS = 1 * MiB;
constexpr size_t WS_LB = 3 * MiB;
constexpr size_t WS_DD = 3 * MiB + 512 * 1024;
constexpr size_t WS_W = 4 * MiB;
constexpr size_t W_LAYER = 25 * MiB, W_OUT = 7 * MiB, W_1 = 9 * MiB, W_2 = 17 * MiB;
constexpr size_t WS_XB = 104 * MiB;
constexpr size_t WS_P = 168 * MiB;
constexpr size_t P_HQ = 0, P_HK = 16 * MiB, P_HI = 32 * MiB, P_HG = 48 * MiB, P_HLF = 64 * MiB, P_SQ = 96 * MiB, P_FQ = 168 * MiB, P_LF = 240 * MiB, P_CC = 241 * MiB, P_US = 242 * MiB;
constexpr size_t HEADBUF = 24 * MiB;
constexpr size_t WS_MIX = 442 * MiB;
constexpr size_t WS_U = 168 * MiB;
constexpr size_t WS_END = 506 * MiB;
constexpr int LDS_BYTES = 147456;

typedef pg8::bf16_t bf16_t;
typedef pg8::f32x4 f32x4;
typedef unsigned u32x4 __attribute__((ext_vector_type(4)));
typedef unsigned u32x2 __attribute__((ext_vector_type(2)));
#define LAS __attribute__((address_space(3)))

__device__ __forceinline__ unsigned f2bf(float f) { unsigned u = __builtin_bit_cast(unsigned, f); return (u + 0x7fffu + ((u >> 16) & 1u)) >> 16; }
__device__ __forceinline__ unsigned pk2(float lo, float hi) { return pg8::cvt_pk_bf16(lo, hi); }
__device__ __forceinline__ float bf2f(unsigned short b) { return __builtin_bit_cast(float, (unsigned)b << 16); }
__device__ __forceinline__ float bflo(unsigned w) { return __builtin_bit_cast(float, w << 16); }
__device__ __forceinline__ float bfhi(unsigned w) { return __builtin_bit_cast(float, w & 0xffff0000u); }
__device__ __forceinline__ float logsig(float x) { return fminf(x, 0.f) - log1pf(expf(-fabsf(x))); }
__device__ __forceinline__ float wave_sum(float v) {
#pragma unroll
    for (int o = 1; o < 64; o <<= 1) v += __shfl_xor(v, o);
    return v;
}
__device__ __forceinline__ float rowscale(const float* ss, int row, int fq) {
    const f32x4 p = *(const f32x4*)(ss + (size_t)row * 16 + 4 * fq);
    float s = (p[0] + p[1]) + (p[2] + p[3]);
    s += __shfl_xor(s, 16); s += __shfl_xor(s, 32);
    return rsqrtf(s * (1.0f / DM) + EPS);
}

#define ROWFENCE() asm volatile("" ::: "memory")
struct EpiResid {
    static constexpr bool PERM = true, AFTER_DRAIN = false;
    const float* xold; float* xnew; bf16_t* xb; float* ss;
    __device__ __forceinline__ void operator()(const f32x4 (&acc)[2][2][4][2], const pg8::Unit& u, int wr, int wc, int fr, int fq) const {
        const int row0 = u.pm * 256 + wr * 64 + fr, col0 = u.pn * 256 + wc * 32 + 8 * fq;
#pragma unroll
        for (int ai = 0; ai < 2; ++ai)
#pragma unroll
            for (int m = 0; m < 4; ++m) {
                const int row = row0 + ai * 128 + m * 16; float sq = 0.f;
#pragma unroll
                for (int bj = 0; bj < 2; ++bj) {
                    const size_t off = (size_t)row * DM + col0 + bj * 128;
                    const f32x4 o0 = *(const f32x4*)(xold + off), o1 = *(const f32x4*)(xold + off + 4);
                    const f32x4 v0 = acc[ai][bj][m][0] + o0, v1 = acc[ai][bj][m][1] + o1;
                    *(f32x4*)(xnew + off) = v0; *(f32x4*)(xnew + off + 4) = v1;
                    u32x4 w; w.x = pk2(v0[0], v0[1]); w.y = pk2(v0[2], v0[3]); w.z = pk2(v1[0], v1[1]); w.w = pk2(v1[2], v1[3]);
                    *(u32x4*)(xb + off) = w;
                    sq += (v0[0] * v0[0] + v0[1] * v0[1]) + (v0[2] * v0[2] + v0[3] * v0[3]) + (v1[0] * v1[0] + v1[1] * v1[1]) + (v1[2] * v1[2] + v1[3] * v1[3]);
                }
                sq += __shfl_xor(sq, 16); sq += __shfl_xor(sq, 32);
                if (fq == 0) ss[(size_t)row * 16 + u.pn * 4 + wc] = sq;
                ROWFENCE();
            }
    }
};
struct EpiRelu2 {
    static constexpr bool PERM = true, AFTER_DRAIN = false;
    bf16_t* U; const float* ss;
    __device__ __forceinline__ void operator()(const f32x4 (&acc)[2][2][4][2], const pg8::Unit& u, int wr, int wc, int fr, int fq) const {
        const int row0 = u.pm * 256 + wr * 64 + fr, col0 = u.pn * 256 + wc * 32 + 8 * fq;
#pragma unroll
        for (int ai = 0; ai < 2; ++ai)
#pragma unroll
            for (int m = 0; m < 4; ++m) {
                const int row = row0 + ai * 128 + m * 16; const float rs = rowscale(ss, row, fq);
#pragma unroll
                for (int bj = 0; bj < 2; ++bj) {
                    f32x4 v0 = acc[ai][bj][m][0] * rs, v1 = acc[ai][bj][m][1] * rs;
                    v0 = __builtin_elementwise_max(v0, (f32x4){0.f, 0.f, 0.f, 0.f}); v1 = __builtin_elementwise_max(v1, (f32x4){0.f, 0.f, 0.f, 0.f});
                    v0 = v0 * v0; v1 = v1 * v1;
                    u32x4 w; w.x = pk2(v0[0], v0[1]); w.y = pk2(v0[2], v0[3]); w.z = pk2(v1[0], v1[1]); w.w = pk2(v1[2], v1[3]);
                    *(u32x4*)(U + (size_t)row * DFF + col0 + bj * 128) = w;
                }
                ROWFENCE();
            }
    }
};
struct EpiInProj {
    static constexpr bool PERM = true, AFTER_DRAIN = false;
    const float* ss; unsigned char* P; const float* lbt;
    const float* gt; const float* fbias;
    __device__ __forceinline__ void operator()(const f32x4 (&acc)[2][2][4][2], const pg8::Unit& u, int wr, int wc, int fr, int fq) const {
        const int slot = u.pn * 4 + wc;
        if (slot > 52) return;
        const int row0 = u.pm * 256 + wr * 64 + fr;
        if (slot < 16) {
            const int kind = slot >> 2, cb = (slot & 3) * 64 + 8 * fq;
            if (kind == 1) {
                float* HLF = (float*)(P + P_HLF); bf16_t* HK = (bf16_t*)(P + P_HK);
#pragma unroll
                for (int ai = 0; ai < 2; ++ai)
#pragma unroll
                    for (int m = 0; m < 4; ++m) {
                        const int row = row0 + ai * 128 + m * 16; const float rs = rowscale(ss, row, fq);
#pragma unroll
                        for (int bj = 0; bj < 2; ++bj) {
                            float lf[8], kk[8];
#pragma unroll
                            for (int n = 0; n < 2; ++n) {
                                const f32x4 ll = *(const f32x4*)(lbt + cb + 32 * bj + 4 * n), om = *(const f32x4*)(lbt + 256 + cb + 32 * bj + 4 * n);
#pragma unroll
                                for (int i = 0; i < 4; ++i) {
                                    const float fl = acc[ai][bj][m][n][i] * rs;
                                    const float a = fminf(fl, 0.f) - __logf(1.0f + __expf(-fabsf(fl)));
                                    const float an = a - fl;
                                    const float b = ll[i] + an;
                                    lf[4 * n + i] = fmaxf(a, b) + __logf(1.0f + __expf(-fabsf(a - b)));
                                    kk[4 * n + i] = om[i] * __expf(an);
                                }
                            }
                            const size_t off = (size_t)row * 256 + cb + 32 * bj;
                            *(f32x4*)(HLF + off) = (f32x4){lf[0], lf[1], lf[2], lf[3]}; *(f32x4*)(HLF + off + 4) = (f32x4){lf[4], lf[5], lf[6], lf[7]};
                            u32x4 w; w.x = pk2(kk[0], kk[1]); w.y = pk2(kk[2], kk[3]); w.z = pk2(kk[4], kk[5]); w.w = pk2(kk[6], kk[7]);
                            *(u32x4*)(HK + off) = w;
                        }
                        ROWFENCE();
                    }
            } else {
                bf16_t* dst = (bf16_t*)(P + (kind == 0 ? P_HQ : (kind == 2 ? P_HI : P_HG)));
#pragma unroll
                for (int ai = 0; ai < 2; ++ai)
#pragma unroll
                    for (int m = 0; m < 4; ++m) {
                        const int row = row0 + ai * 128 + m * 16; const float rs = rowscale(ss, row, fq);
#pragma unroll
                        for (int bj = 0; bj < 2; ++bj) {
                            const f32x4 v0 = acc[ai][bj][m][0] * rs, v1 = acc[ai][bj][m][1] * rs;
                            u32x4 w; w.x = pk2(v0[0], v0[1]); w.y = pk2(v0[2], v0[3]); w.z = pk2(v1[0], v1[1]); w.w = pk2(v1[2], v1[3]);
                            *(u32x4*)(dst + (size_t)row * 256 + cb + 32 * bj) = w;
                        }
                        ROWFENCE();
                    }
            }
        } else if (slot < 52) {
            const int s2 = slot - 16, grp = s2 / 6, h = s2 % 6, role = grp % 3;
            bf16_t* dst = (bf16_t*)(P + P_SQ + (size_t)grp * HEADBUF) + (size_t)((u.pm >> 4) * 6 + h) * SEQ * 64 + 8 * fq;
            const float* gp = gt + (grp - (grp >= 3 ? 1 : 0)) * 64 + 8 * fq;
            const float qs = (role == 0) ? 0.125f * 1.4426950408889634f : 1.0f;
#pragma unroll
            for (int ai = 0; ai < 2; ++ai)
#pragma unroll
                for (int m = 0; m < 4; ++m) {
                    const int row = row0 + ai * 128 + m * 16; const float rs = rowscale(ss, row, fq);
                    float fac = rs;
                    if (role != 2) {
                        float sq = 0.f;
#pragma unroll
                        for (int bj = 0; bj < 2; ++bj)
#pragma unroll
                            for (int n = 0; n < 2; ++n) { const f32x4 x = acc[ai][bj][m][n]; sq += (x[0] * x[0] + x[1] * x[1]) + (x[2] * x[2] + x[3] * x[3]); }
                        sq += __shfl_xor(sq, 16); sq += __shfl_xor(sq, 32);
                        fac = rs * rsqrtf(rs * rs * sq * (1.0f / 64.0f) + EPS) * qs;
                    }
                    const int t = row & (SEQ - 1);
#pragma unroll
                    for (int bj = 0; bj < 2; ++bj) {
                        f32x4 v0 = acc[ai][bj][m][0] * fac, v1 = acc[ai][bj][m][1] * fac;
                        if (role != 2) { v0 = v0 * *(const f32x4*)(gp + 32 * bj); v1 = v1 * *(const f32x4*)(gp + 32 * bj + 4); }
                        u32x4 w; w.x = pk2(v0[0], v0[1]); w.y = pk2(v0[2], v0[3]); w.z = pk2(v1[0], v1[1]); w.w = pk2(v1[2], v1[3]);
                        *(u32x4*)(dst + (size_t)t * 64 + 32 * bj) = w;
                    }
                    ROWFENCE();
                }
        } else {
            float* LF = (float*)(P + P_LF);
#pragma unroll
            for (int ai = 0; ai < 2; ++ai)
#pragma unroll
                for (int m = 0; m < 4; ++m) {
                    const int row = row0 + ai * 128 + m * 16; const float rs = rowscale(ss, row, fq);
                    if (fq == 0) {
                        const f32x4 a0 = acc[ai][0][m][0], a1 = acc[ai][0][m][1];
                        *(f32x4*)(LF + (size_t)row * 8) = (f32x4){logsig(a0[0] * rs + fbias[0]), logsig(a0[1] * rs + fbias[1]), logsig(a0[2] * rs + fbias[2]), logsig(a0[3] * rs + fbias[3])};
                        *(f32x4*)(LF + (size_t)row * 8 + 4) = (f32x4){logsig(a1[0] * rs + fbias[4]), logsig(a1[1] * rs + fbias[5]), 0.f, 0.f};
                    }
                    ROWFENCE();
                }
        }
    }
};

__device__ __forceinline__ void tr_item(const float* W, int ldw, int ncols_valid, int src_col0, int k0, const float* gain, bf16_t* WT, int K, int n0, LAS float* scr, int lane) {
#pragma unroll 8
    for (int i = 0; i < 32; ++i) { const int kk = 2 * i + (lane >> 5), c = src_col0 + (lane & 31);
        float v = (c < ncols_valid) ? W[(size_t)(k0 + kk) * ldw + c] : 0.f; if (gain) v *= gain[k0 + kk]; scr[kk * 33 + (lane & 31)] = v; }
    asm volatile("s_waitcnt lgkmcnt(0)" ::: "memory");
    const int c = lane & 7;
#pragma unroll
    for (int j = 0; j < 4; ++j) { const int n = (lane >> 3) + 8 * j; const LAS float* s = scr + (8 * c) * 33 + n;
        u32x4 o; o.x = pk2(s[0 * 33], s[1 * 33]); o.y = pk2(s[2 * 33], s[3 * 33]); o.z = pk2(s[4 * 33], s[5 * 33]); o.w = pk2(s[6 * 33], s[7 * 33]);
        *(u32x4*)(WT + (size_t)(n0 + n) * K + k0 + 8 * c) = o; }
    asm volatile("s_waitcnt lgkmcnt(0)" ::: "memory");
}

__device__ __forceinline__ void unpack8(const u32x4 w, float* d) { d[0] = bflo(w.x); d[1] = bfhi(w.x); d[2] = bflo(w.y); d[3] = bfhi(w.y); d[4] = bflo(w.z); d[5] = bfhi(w.z); d[6] = bflo(w.w); d[7] = bfhi(w.w); }

__device__ __forceinline__ void fox_cumsum_item(int bh, const float* LF, float* CC, LAS float* sc) {
    int tid_ = threadIdx.x; asm volatile("" : "+v"(tid_)); const int tid = tid_, lane = tid & 63, wave = tid >> 6, b = bh / 6, h = bh % 6;
    float v[8]; float run = 0.f;
#pragma unroll
    for (int i = 0; i < 8; ++i) { run += LF[((size_t)b * SEQ + tid * 8 + i) * 8 + h]; v[i] = run; }
    float s = run;
#pragma unroll
    for (int o = 1; o < 64; o <<= 1) { const float n = __shfl_up(s, o); if (lane >= o) s += n; }
    __syncthreads();
    if (lane == 63) sc[wave] = s;
    __syncthreads();
    float base = s - run;
    for (int w = 0; w < wave; ++w) base += sc[w];
#pragma unroll
    for (int i = 0; i < 8; ++i) CC[(size_t)bh * SEQ + tid * 8 + i] = (v[i] + base) * 1.4426950408889634f;
}

__device__ __forceinline__ void stage_kv(const bf16_t* Kb, const bf16_t* Vb, int kt, LAS float* Kf, LAS float* Vf) {
    int tid_ = threadIdx.x; asm volatile("" : "+v"(tid_)); const int tid = tid_, key = tid >> 3, c8 = tid & 7;
    const u32x4 kw = *(const u32x4*)(Kb + ((size_t)(kt * 64 + key)) * 64 + c8 * 8), vw = *(const u32x4*)(Vb + ((size_t)(kt * 64 + key)) * 64 + c8 * 8);
    float kf[8], vf[8]; unpack8(kw, kf); unpack8(vw, vf);
    *(LAS f32x4*)(Kf + key * 64 + c8 * 8) = (f32x4){kf[0], kf[1], kf[2], kf[3]}; *(LAS f32x4*)(Kf + key * 64 + c8 * 8 + 4) = (f32x4){kf[4], kf[5], kf[6], kf[7]};
    *(LAS f32x4*)(Vf + key * 64 + c8 * 8) = (f32x4){vf[0], vf[1], vf[2], vf[3]}; *(LAS f32x4*)(Vf + key * 64 + c8 * 8 + 4) = (f32x4){vf[4], vf[5], vf[6], vf[7]};
}

__device__ __forceinline__ void fox_naive_item(int item, unsigned char* P, bf16_t* MIX, LAS float* lds) {
    int tid_ = threadIdx.x; asm volatile("" : "+v"(tid_)); const int tid = tid_, bh = item >> 3, qblk = item & 7, b = bh / 6, h = bh % 6, t = qblk * 512 + tid;
    const bf16_t* Qp = (const bf16_t*)(P + P_FQ) + ((size_t)bh * SEQ + t) * 64;
    const bf16_t* Kb = (const bf16_t*)(P + P_FQ + HEADBUF) + (size_t)bh * SEQ * 64;
    const bf16_t* Vb = (const bf16_t*)(P + P_FQ + 2 * HEADBUF) + (size_t)bh * SEQ * 64;
    const float* CC = (const float*)(P + P_CC) + (size_t)bh * SEQ;
    float q[64], o[64];
#pragma unroll
    for (int c = 0; c < 8; ++c) unpack8(*(const u32x4*)(Qp + c * 8), q + c * 8);
#pragma unroll
    for (int d = 0; d < 64; ++d) o[d] = 0.f;
    float m = -1e30f, l = 0.f; const float ct = CC[t];
    LAS float* Kf = lds; LAS float* Vf = lds + 4096; LAS float* cs = lds + 8192;
    const int ntile = (qblk + 1) * 8;
    for (int kt = 0; kt < ntile; ++kt) {
        __syncthreads();
        stage_kv(Kb, Vb, kt, Kf, Vf); if (tid < 64) cs[tid] = CC[kt * 64 + tid];
        __syncthreads();
        for (int s = 0; s < 64; ++s) {
            float z = 0.f;
#pragma unroll
            for (int d = 0; d < 64; ++d) z += q[d] * Kf[s * 64 + d];
            const float x = (kt * 64 + s <= t) ? z + (ct - cs[s]) : -1e30f;
            const float mn = fmaxf(m, x), sc = __expf(m - mn), p = __expf(x - mn);
            l = l * sc + p;
#pragma unroll
            for (int d = 0; d < 64; ++d) o[d] = o[d] * sc + p * Vf[s * 64 + d];
            m = mn;
        }
    }
    const float inv = 1.0f / l;
    bf16_t* op = MIX + ((size_t)b * SEQ + t) * DM + 640 + h * 64;
#pragma unroll
    for (int c = 0; c < 8; ++c) { u32x4 w; w.x = pk2(o[c * 8] * inv, o[c * 8 + 1] * inv); w.y = pk2(o[c * 8 + 2] * inv, o[c * 8 + 3] * inv); w.z = pk2(o[c * 8 + 4] * inv, o[c * 8 + 5] * inv); w.w = pk2(o[c * 8 + 6] * inv, o[c * 8 + 7] * inv); *(u32x4*)(op + c * 8) = w; }
}

__device__ __forceinline__ void sb_naive_item(int item, unsigned char* P, bf16_t* MIX, LAS float* lds) {
    int tid_ = threadIdx.x; asm volatile("" : "+v"(tid_)); const int tid = tid_, bh = item >> 3, qblk = item & 7, b = bh / 6, h = bh % 6, t = qblk * 512 + tid;
    const bf16_t* Qp = (const bf16_t*)(P + P_SQ) + ((size_t)bh * SEQ + t) * 64;
    const bf16_t* Kb = (const bf16_t*)(P + P_SQ + HEADBUF) + (size_t)bh * SEQ * 64;
    const bf16_t* Vb = (const bf16_t*)(P + P_SQ + 2 * HEADBUF) + (size_t)bh * SEQ * 64;
    float q[64], o[64];
#pragma unroll
    for (int c = 0; c < 8; ++c) unpack8(*(const u32x4*)(Qp + c * 8), q + c * 8);
#pragma unroll
    for (int d = 0; d < 64; ++d) o[d] = 0.f;
    float tail = 0.f;
    LAS float* Kf = lds; LAS float* Vf = lds + 4096;
    for (int kt = qblk * 8 + 7; kt >= 0; --kt) {
        __syncthreads();
        stage_kv(Kb, Vb, kt, Kf, Vf);
        __syncthreads();
        for (int s = 63; s >= 0; --s) {
            float z = 0.f;
#pragma unroll
            for (int d = 0; d < 64; ++d) z += q[d] * Kf[s * 64 + d];
            const float ls = fminf(z, 0.f) - __logf(1.0f + __expf(-fabsf(z)));
            const bool act = (kt * 64 + s) < t;
            const float A = act ? __expf(ls + tail) : 0.f;
#pragma unroll
            for (int d = 0; d < 64; ++d) o[d] += A * Vf[s * 64 + d];
            tail += act ? (ls - z) : 0.f;
        }
        if (__syncthreads_and(tail < -100.f)) break;
    }
    bf16_t* op = MIX + ((size_t)b * SEQ + t) * DM + 256 + h * 64;
#pragma unroll
    for (int c = 0; c < 8; ++c) { u32x4 w; w.x = pk2(o[c * 8], o[c * 8 + 1]); w.y = pk2(o[c * 8 + 2], o[c * 8 + 3]); w.z = pk2(o[c * 8 + 4], o[c * 8 + 5]); w.w = pk2(o[c * 8 + 6], o[c * 8 + 7]); *(u32x4*)(op + c * 8) = w; }
}

__device__ __forceinline__ void hgrn_naive_item(int item, unsigned char* P, bf16_t* MIX, const float* hgn, LAS float* lds) {
    int tid_ = threadIdx.x; asm volatile("" : "+v"(tid_)); const int tid = tid_, lane = tid & 63, w = tid >> 6, kg = lane >> 3, vi = lane & 7, vcol = 8 * w + vi, b = item >> 2, h = item & 3;
    const bf16_t* HQ = (const bf16_t*)(P + P_HQ); const bf16_t* HK = (const bf16_t*)(P + P_HK); const bf16_t* HI = (const bf16_t*)(P + P_HI); const bf16_t* HG = (const bf16_t*)(P + P_HG);
    const float* HLF = (const float*)(P + P_HLF);
    LAS float* qf = lds; LAS float* kf = lds + 4096; LAS float* ff = lds + 8192; LAS float* vf = lds + 12288; LAS float* ob = lds + 16384;
    float S[8];
#pragma unroll
    for (int j = 0; j < 8; ++j) S[j] = 0.f;
    const int tok = tid >> 3, c8 = tid & 7;
    float gn[8];
#pragma unroll
    for (int e = 0; e < 8; ++e) gn[e] = hgn[c8 * 8 + e];
    for (int c = 0; c < 64; ++c) {
        const size_t off = ((size_t)b * SEQ + c * 64 + tok) * 256 + h * 64 + c8 * 8;
        __syncthreads();
        {
            float a[8];
            unpack8(*(const u32x4*)(HQ + off), a);
#pragma unroll
            for (int e = 0; e < 8; ++e) qf[tok * 64 + c8 * 8 + e] = a[e];
            unpack8(*(const u32x4*)(HK + off), a);
#pragma unroll
            for (int e = 0; e < 8; ++e) kf[tok * 64 + c8 * 8 + e] = a[e];
            unpack8(*(const u32x4*)(HI + off), a);
#pragma unroll
            for (int e = 0; e < 8; ++e) vf[tok * 64 + c8 * 8 + e] = a[e];
            const f32x4 l0 = *(const f32x4*)(HLF + off), l1 = *(const f32x4*)(HLF + off + 4);
#pragma unroll
            for (int e = 0; e < 4; ++e) { ff[tok * 64 + c8 * 8 + e] = expf(l0[e]); ff[tok * 64 + c8 * 8 + 4 + e] = expf(l1[e]); }
        }
        __syncthreads();
        for (int tk = 0; tk < 64; ++tk) {
            const float vv = vf[tk * 64 + vcol]; float op = 0.f;
#pragma unroll
            for (int j = 0; j < 8; ++j) { const int k = 8 * kg + j; S[j] = ff[tk * 64 + k] * S[j] + kf[tk * 64 + k] * vv; op += qf[tk * 64 + k] * S[j]; }
            op += __shfl_xor(op, 8); op += __shfl_xor(op, 16); op += __shfl_xor(op, 32);
            if (kg == 0) ob[tk * 64 + vcol] = op;
        }
        __syncthreads();
        {
            float ov[8], g[8]; float sq = 0.f;
#pragma unroll
            for (int e = 0; e < 8; ++e) { ov[e] = ob[tok * 64 + c8 * 8 + e]; sq += ov[e] * ov[e]; }
            sq += __shfl_xor(sq, 1); sq += __shfl_xor(sq, 2); sq += __shfl_xor(sq, 4);
            const float rn = rsqrtf(sq * (1.0f / 64.0f) + EPS);
            unpack8(*(const u32x4*)(HG + off), g);
            float r[8];
#pragma unroll
            for (int e = 0; e < 8; ++e) r[e] = ov[e] * rn * gn[e] * (g[e] / (1.0f + expf(-g[e])));
            u32x4 wv; wv.x = pk2(r[0], r[1]); wv.y = pk2(r[2], r[3]); wv.z = pk2(r[4], r[5]); wv.w = pk2(r[6], r[7]);
            *(u32x4*)(MIX + ((size_t)b * SEQ + c * 64 + tok) * DM + h * 64 + c8 * 8) = wv;
        }
    }
}

constexpr int HG_SLOT = 32768, HG_PRE = 16384, HG_TOT = 16384 + 1280, HG_VT = 20480, HG_VP = 72;
typedef short hbf16x8 __attribute__((ext_vector_type(8)));
typedef short hbf16x4 __attribute__((ext_vector_type(4)));
__device__ __forceinline__ hbf16x8 pack8(const float* x) { u32x4 w; w.x = pk2(x[0], x[1]); w.y = pk2(x[2], x[3]); w.z = pk2(x[4], x[5]); w.w = pk2(x[6], x[7]); return __builtin_bit_cast(hbf16x8, w); }

__device__ __forceinline__ void hg_stage(int tid, size_t row0, int h, const float* HLF, const bf16_t* HI, LAS unsigned char* sb) {
    const int lt = tid & 255, k = lt & 63, seg = lt >> 6;
    LAS float* bl = (LAS float*)sb; LAS float* pre = (LAS float*)(sb + HG_PRE); LAS float* tot = (LAS float*)(sb + HG_TOT); LAS bf16_t* vt = (LAS bf16_t*)(sb + HG_VT);
    float run = 0.f;
#pragma unroll
    for (int i = 0; i < 16; ++i) { const int t = 16 * seg + i; run += HLF[(row0 + t) * 256 + h * 64 + k]; bl[t * 64 + k] = run; }
    tot[seg * 64 + k] = run;
    {
        const int s = lt >> 2, c0 = (lt & 3) * 16;
        const u32x4 w0 = *(const u32x4*)(HI + (row0 + s) * 256 + h * 64 + c0), w1 = *(const u32x4*)(HI + (row0 + s) * 256 + h * 64 + c0 + 8);
        const unsigned ww[8] = {w0.x, w0.y, w0.z, w0.w, w1.x, w1.y, w1.z, w1.w};
#pragma unroll
        for (int e = 0; e < 8; ++e) { vt[(c0 + 2 * e) * HG_VP + s] = (bf16_t)(ww[e] & 0xffffu); vt[(c0 + 2 * e + 1) * HG_VP + s] = (bf16_t)(ww[e] >> 16); }
    }
    __syncthreads();
    if (lt < 64) { float p = 0.f;
#pragma unroll
        for (int sg = 0; sg < 4; ++sg) { pre[sg * 64 + lt] = p; p += tot[sg * 64 + lt]; }
        pre[4 * 64 + lt] = p; }
    __syncthreads();
}

__device__ __forceinline__ void hgrn_a_item(int item, unsigned char* P, float* DD, LAS unsigned char* L) {
    int tid_ = threadIdx.x; asm volatile("" : "+v"(tid_)); const int tid = tid_, lane = tid & 63, wq = (tid >> 6) & 3, cs = tid >> 8, r = lane & 15, g = lane >> 4;
    const int bh = item >> 5, chunk = (item & 31) * 2 + cs, b = bh >> 2, h = bh & 3;
    const size_t row0 = (size_t)b * SEQ + chunk * 64;
    const bf16_t* HK = (const bf16_t*)(P + P_HK); float* UT = (float*)(P + P_US);
    LAS unsigned char* sb = L + cs * HG_SLOT;
    hg_stage(tid, row0, h, (const float*)(P + P_HLF), (const bf16_t*)(P + P_HI), sb);
    const LAS float* bl = (const LAS float*)sb; const LAS float* pre = (const LAS float*)(sb + HG_PRE); const LAS unsigned char* vt = sb + HG_VT;
    const int k = 16 * wq + r; const float pre4 = pre[4 * 64 + k];
    hbf16x8 af[2];
#pragma unroll
    for (int ks = 0; ks < 2; ++ks) { const float pj = pre4 - pre[(2 * ks + (g >> 1)) * 64 + k]; float x[8];
#pragma unroll
        for (int j = 0; j < 8; ++j) { const int s = 32 * ks + 8 * g + j; x[j] = bf2f(HK[(row0 + s) * 256 + h * 64 + k]) * __expf(pj - bl[s * 64 + k]); }
        af[ks] = pack8(x); }
    float* ut = UT + ((size_t)(bh * 64 + chunk) * 64) * 64;
#pragma unroll
    for (int vtile = 0; vtile < 4; ++vtile) { f32x4 acc = {0.f, 0.f, 0.f, 0.f};
#pragma unroll
        for (int ks = 0; ks < 2; ++ks) { const hbf16x8 bf = *(const LAS hbf16x8*)(vt + (16 * vtile + r) * (HG_VP * 2) + (32 * ks + 8 * g) * 2); acc = __builtin_amdgcn_mfma_f32_16x16x32_bf16(af[ks], bf, acc, 0, 0, 0); }
        *(f32x4*)(ut + (size_t)(16 * vtile + r) * 64 + 16 * wq + 4 * g) = acc; }
    if (g == 0) DD[(size_t)(bh * 64 + chunk) * 64 + k] = __expf(pre4);
}

__device__ __forceinline__ void hgrn_b_scan(int bx, int G, unsigned char* P, const float* DD) {
    int tid_ = threadIdx.x; asm volatile("" : "+v"(tid_));
    float* UT = (float*)(P + P_US);
    for (int gid = bx * 512 + tid_; gid < 32 * 4096; gid += G * 512) {
        const int bh = gid >> 12, e = gid & 4095; float* u = UT + (size_t)bh * 64 * 4096 + e; const float* dd = DD + (size_t)bh * 64 * 64 + (e & 63);
        float S = 0.f;
        for (int c0 = 0; c0 < 64; c0 += 8) { float tu[8], td[8];
#pragma unroll
            for (int i = 0; i < 8; ++i) { tu[i] = u[(size_t)(c0 + i) * 4096]; td[i] = dd[(c0 + i) * 64]; }
#pragma unroll
            for (int i = 0; i < 8; ++i) { u[(size_t)(c0 + i) * 4096] = S; S = td[i] * S + tu[i]; } }
    }
}

__device__ __forceinline__ void hgrn_c_item(int item, unsigned char* P, bf16_t* MIX, const float* hgn, LAS unsigned char* L) {
    int tid_ = threadIdx.x; asm volatile("" : "+v"(tid_)); const int tid = tid_, lane = tid & 63, I = (tid >> 6) & 3, cs = tid >> 8, r = lane & 15, g = lane >> 4;
    const int bh = item >> 5, chunk = (item & 31) * 2 + cs, b = bh >> 2, h = bh & 3;
    const size_t row0 = (size_t)b * SEQ + chunk * 64;
    const bf16_t* HQ = (const bf16_t*)(P + P_HQ); const bf16_t* HK = (const bf16_t*)(P + P_HK); const bf16_t* HG = (const bf16_t*)(P + P_HG); const float* ST = (const float*)(P + P_US);
    LAS unsigned char* sb = L + cs * HG_SLOT;
    hg_stage(tid, row0, h, (const float*)(P + P_HLF), (const bf16_t*)(P + P_HI), sb);
    const LAS float* bl = (const LAS float*)sb; const LAS float* pre = (const LAS float*)(sb + HG_PRE); const LAS unsigned char* vt = sb + HG_VT;
    const int t = 16 * I + r;
    hbf16x8 qtf[2], qhf[2];
#pragma unroll
    for (int ks = 0; ks < 2; ++ks) { const int kb = 32 * ks + 8 * g; float q[8], xt[8], xh[8];
        unpack8(*(const u32x4*)(HQ + (row0 + t) * 256 + h * 64 + kb), q);
#pragma unroll
        for (int j = 0; j < 8; ++j) { xt[j] = q[j] * __expf(bl[t * 64 + kb + j]); xh[j] = xt[j] * __expf(pre[I * 64 + kb + j]); }
        qtf[ks] = pack8(xt); qhf[ks] = pack8(xh); }
    f32x4 at[4];
#pragma unroll
    for (int J = 0; J < 4; ++J) { at[J] = (f32x4){0.f, 0.f, 0.f, 0.f};
        if (J <= I) { const int s = 16 * J + r;
#pragma unroll
            for (int ks = 0; ks < 2; ++ks) { const int kb = 32 * ks + 8 * g; float kk[8], x[8];
                unpack8(*(const u32x4*)(HK + (row0 + s) * 256 + h * 64 + kb), kk);
#pragma unroll
                for (int j = 0; j < 8; ++j) x[j] = kk[j] * __expf(fminf(pre[I * 64 + kb + j] - pre[J * 64 + kb + j] - bl[s * 64 + kb + j], 80.f));
                at[J] = __builtin_amdgcn_mfma_f32_16x16x32_bf16(pack8(x), qtf[ks], at[J], 0, 0, 0); }
            if (J == I) {
#pragma unroll
                for (int i = 0; i < 4; ++i) at[J][i] = (4 * g + i <= r) ? at[J][i] : 0.f; } } }
    hbf16x8 pf[2];
#pragma unroll
    for (int k2 = 0; k2 < 2; ++k2) { const float x[8] = {at[2 * k2][0], at[2 * k2][1], at[2 * k2][2], at[2 * k2][3], at[2 * k2 + 1][0], at[2 * k2 + 1][1], at[2 * k2 + 1][2], at[2 * k2 + 1][3]}; pf[k2] = pack8(x); }
    const float* st = ST + ((size_t)(bh * 64 + chunk) * 64) * 64;
    f32x4 o[4];
#pragma unroll
    for (int vtile = 0; vtile < 4; ++vtile) { f32x4 acc = {0.f, 0.f, 0.f, 0.f}; const int v = 16 * vtile + r;
#pragma unroll
        for (int ks = 0; ks < 2; ++ks) { const float* sp = st + (size_t)v * 64 + 32 * ks + 8 * g; const f32x4 s0 = *(const f32x4*)sp, s1 = *(const f32x4*)(sp + 4);
            const float x[8] = {s0[0], s0[1], s0[2], s0[3], s1[0], s1[1], s1[2], s1[3]};
            acc = __builtin_amdgcn_mfma_f32_16x16x32_bf16(qhf[ks], pack8(x), acc, 0, 0, 0); }
#pragma unroll
        for (int k2 = 0; k2 < 2; ++k2) { if (k2 == 0 || I >= 2) {
            const hbf16x4 v0 = *(const LAS hbf16x4*)(vt + v * (HG_VP * 2) + (32 * k2 + 4 * g) * 2), v1 = *(const LAS hbf16x4*)(vt + v * (HG_VP * 2) + (32 * k2 + 16 + 4 * g) * 2);
            const hbf16x8 vf = {v0[0], v0[1], v0[2], v0[3], v1[0], v1[1], v1[2], v1[3]};
            acc = __builtin_amdgcn_mfma_f32_16x16x32_bf16(pf[k2], vf, acc, 0, 0, 0); } }
        o[vtile] = acc; }
#pragma unroll
    for (int i = 0; i < 4; ++i) { float sq = 0.f;
#pragma unroll
        for (int vtile = 0; vtile < 4; ++vtile) sq += o[vtile][i] * o[vtile][i];
        sq += __shfl_xor(sq, 1); sq += __shfl_xor(sq, 2); sq += __shfl_xor(sq, 4); sq += __shfl_xor(sq, 8);
        const float rn = rsqrtf(sq * (1.0f / 64.0f) + EPS); const size_t row = row0 + 16 * I + 4 * g + i;
#pragma unroll
        for (int vtile = 0; vtile < 4; ++vtile) { const int v = 16 * vtile + r; const float gg = bf2f(HG[row * 256 + h * 64 + v]);
            MIX[row * DM + h * 64 + v] = (bf16_t)f2bf(o[vtile][i] * rn * hgn[v] * (gg / (1.0f + __expf(-gg)))); } }
}

struct Args { const float* in[14]; float* out; unsigned char* ws; int ph_lo, ph_hi; };
constexpr int NPHASE = 1 + 7 * DEPTH;

__global__ void __launch_bounds__(512, 2) fwd(Args a) {
    extern __shared__ __attribute__((aligned(16))) unsigned char lds[];
    cg::grid_group grid = cg::this_grid();
    LAS unsigned char* L = (LAS unsigned char*)lds;
    for (int ph = a.ph_lo; ph < a.ph_hi; ++ph) {
        int G = gridDim.x, bx = blockIdx.x; asm volatile("" : "+s"(G), "+s"(bx));
        typedef const __attribute__((address_space(4))) Args* KArgP;
        KArgP ap = (KArgP)__builtin_amdgcn_kernarg_segment_ptr(); asm volatile("" : "+s"(ap));
        unsigned char* ws = ap->ws;
        float* SS = (float*)(ws + WS_SS); float* LB = (float*)(ws + WS_LB);
        bf16_t* XB = (bf16_t*)(ws + WS_XB); bf16_t* MIX = (bf16_t*)(ws + WS_MIX); bf16_t* UB = (bf16_t*)(ws + WS_U);
        unsigned char* P = ws + WS_P;
        if (ph == 0) {
            int tid = threadIdx.x; asm volatile("" : "+v"(tid)); const int lane = tid & 63, wave = __builtin_amdgcn_readfirstlane(tid >> 6);
            LAS float* scr = (LAS float*)(L + wave * 16384);
            const int gw = bx * 8 + wave, NGW = G * 8;
            constexpr int I_IN = 16 * 112, I_OUT = 16 * 32, I_1 = 16 * 128, I_2 = 64 * 32, I_L = I_IN + I_OUT + I_1 + I_2;
            for (int it = gw; it < DEPTH * I_L; it += NGW) {
                const int l = it / I_L; int r = it % I_L;
                unsigned char* wl = ws + WS_W + (size_t)l * W_LAYER;
                if (r < I_IN) { const int kb = r / 112, nb = r % 112, n0 = nb * 32, pn = n0 >> 8, p = n0 & 255, slot = 4 * pn + ((p & 127) >> 5), sc0 = 64 * slot + 32 * (p >> 7);
                    tr_item(ap->in[3] + (size_t)l * DM * INC, INC, INC, sc0, kb * 64, ap->in[2] + l * DM, (bf16_t*)wl, DM, n0, scr, lane); continue; }
                r -= I_IN;
                if (r < I_OUT) { const int kb = r / 32, nb = r % 32; tr_item(ap->in[10] + (size_t)l * DM * DM, DM, DM, nb * 32, kb * 64, nullptr, (bf16_t*)(wl + W_OUT), DM, nb * 32, scr, lane); continue; }
                r -= I_OUT;
                if (r < I_1) { const int kb = r / 128, nb = r % 128; tr_item(ap->in[12] + (size_t)l * DM * DFF, DFF, DFF, nb * 32, kb * 64, ap->in[11] + l * DM, (bf16_t*)(wl + W_1), DM, nb * 32, scr, lane); continue; }
                r -= I_1;
                { const int kb = r / 32, nb = r % 32; tr_item(ap->in[13] + (size_t)l * DFF * DM, DM, DM, nb * 32, kb * 64, nullptr, (bf16_t*)(wl + W_2), DFF, nb * 32, scr, lane); }
            }
            const float* x = ap->in[0];
            for (int m = gw; m < M; m += NGW) {
                const f32x4* xr = (const f32x4*)(x + (size_t)m * DM) + lane; f32x4 v[4]; float s = 0.f;
#pragma unroll
                for (int j = 0; j < 4; ++j) { v[j] = xr[64 * j]; s += (v[j][0] * v[j][0] + v[j][1] * v[j][1]) + (v[j][2] * v[j][2] + v[j][3] * v[j][3]); }
                const float tot = wave_sum(s);
                u32x2* o8 = (u32x2*)(XB + (size_t)m * DM) + lane;
#pragma unroll
                for (int j = 0; j < 4; ++j) { u32x2 w; w.x = pk2(v[j][0], v[j][1]); w.y = pk2(v[j][2], v[j][3]); o8[64 * j] = w; }
                if (lane < 16) SS[(size_t)m * 16 + lane] = (lane == 0) ? tot : 0.f;
            }
            if (bx == 2 && tid < 64) ((unsigned*)ws)[tid] = 0u;
            if (bx == 1) {
                for (int i = tid; i < 1024; i += 512) { const int l = i >> 8, wh = (i >> 6) & 3, d = i & 63; LB[2048 + i] = ap->in[5 + wh][l * 64 + d]; }
                if (tid < 32) { const int l = tid >> 3, e = tid & 7; LB[3072 + tid] = (e < 6) ? ap->in[9][l * 6 + e] : 0.f; }
            }
            if (bx == 0 && tid < 256) {
                const float* lg = ap->in[1]; float e[DEPTH]; float mx = -1e30f, sum = 0.f;
#pragma unroll
                for (int l = 0; l < DEPTH; ++l) mx = fmaxf(mx, lg[l * 256 + tid]);
#pragma unroll
                for (int l = 0; l < DEPTH; ++l) { e[l] = expf(lg[l * 256 + tid] - mx); sum += e[l]; }
                float c = 0.f;
#pragma unroll
                for (int l = 0; l < DEPTH; ++l) { if (l > 0) c += e[l] / sum; LB[l * 512 + tid] = logf(fmaxf(c, 1e-30f)); LB[l * 512 + 256 + tid] = 1.0f - c; }
            }
        } else {
            const int l = (ph - 1) / 7, k = (ph - 1) % 7;
            unsigned char* wl = ws + WS_W + (size_t)l * W_LAYER;
            if (k == 0) {
                pg8::Gemm g{XB, (const bf16_t*)wl, M, NIN, DM}; pg8::StaticOrder S; S.init(M, NIN, G, bx);
                EpiInProj E{SS, P, LB + l * 512, LB + 2048 + l * 256, LB + 3072 + l * 8};
                pg8::gemm_phase<EpiInProj, pg8::StaticOrder, true, true>(L, g, S, E);
            } else if (k == 1) {
                int tid = threadIdx.x; asm volatile("" : "+v"(tid));
                unsigned* ctr = (unsigned*)ws + l * 16 + 1;
                volatile LAS int* sh = (volatile LAS int*)(L + LDS_BYTES - 64);
                for (;;) {
                    if (tid == 0) sh[0] = (int)atomicAdd(ctr, 1u);
                    __syncthreads();
                    const int idx = __builtin_amdgcn_readfirstlane(sh[0]);
                    __syncthreads();
                    if (idx >= 816 + 1024) break;
                    if (idx < 768) { const int qb = 15 - idx / 48, bh = idx % 48, b = bh / 6, h = bh % 6; typedef attn_body::bf16 abf;
                        attn_body::sb_unit(qb, (const abf*)(P + P_SQ) + (size_t)bh * SEQ * 64, (const abf*)(P + P_SQ + HEADBUF) + (size_t)bh * SEQ * 64, (const abf*)(P + P_SQ + 2 * HEADBUF) + (size_t)bh * SEQ * 64,
                                           (abf*)MIX + (size_t)b * SEQ * DM + 256 + h * 64, (char*)lds); }
                    else if (idx < 816) fox_cumsum_item(idx - 768, (const float*)(P + P_LF), (float*)(P + P_CC), (LAS float*)L);
                    else hgrn_a_item(idx - 816, P, (float*)(ws + WS_DD), L);
                    __syncthreads();
                }
            } else if (k == 2) {
                hgrn_b_scan(bx, G, P, (const float*)(ws + WS_DD));
            } else if (k == 3) {
                int tid = threadIdx.x; asm volatile("" : "+v"(tid));
                unsigned* ctr = (unsigned*)ws + l * 16;
                volatile LAS int* sh = (volatile LAS int*)(L + LDS_BYTES - 64);
                for (;;) {
                    if (tid == 0) sh[0] = (int)atomicAdd(ctr, 1u);
                    __syncthreads();
                    const int idx = __builtin_amdgcn_readfirstlane(sh[0]);
                    __syncthreads();
                    if (idx >= 768 + 1024) break;
                    if (idx >= 768) { hgrn_c_item(idx - 768, P, MIX, ap->in[4] + l * 64, L); __syncthreads(); continue; }
                    const int qb = 15 - idx / 48, bh = idx % 48, b = bh / 6, h = bh % 6;
                    typedef attn_body::bf16 abf;
                    attn_body::attn_unit<8>(qb, (const abf*)(P + P_FQ) + (size_t)bh * SEQ * 64, (const abf*)(P + P_FQ + HEADBUF) + (size_t)bh * SEQ * 64, (const abf*)(P + P_FQ + 2 * HEADBUF) + (size_t)bh * SEQ * 64,
                                            (abf*)MIX + (size_t)b * SEQ * DM + 640 + h * 64, (const float*)(P + P_CC) + (size_t)bh * SEQ, (char*)lds);
                }
            } else if (k == 5) {
                pg8::Gemm g{XB, (const bf16_t*)(wl + W_1), M, DFF, DM}; pg8::StaticOrder S; S.init(M, DFF, G, bx);
                EpiRelu2 E{UB, SS};
                pg8::gemm_phase<EpiRelu2, pg8::StaticOrder, true, true>(L, g, S, E);
            } else {
                const bool ff2 = (k == 6);
                pg8::Gemm g{ff2 ? UB : MIX, (const bf16_t*)(wl + (ff2 ? W_2 : W_OUT)), M, DM, ff2 ? DFF : DM}; pg8::StaticOrder S; S.init(M, DM, G, bx);
                EpiResid E{(!ff2 && l == 0) ? ap->in[0] : ap->out, ap->out, XB, SS};
                pg8::gemm_phase<EpiResid, pg8::StaticOrder, true, true>(L, g, S, E);
            }
        }
        if (ph + 1 < a.ph_hi) grid.sync();
    }
}

#ifndef MK_MULTI
#define MK_MULTI 0
#endif
extern "C" void kernel_launch(void* const* d_in, const int* in_sizes, int n_in, void* d_out, int out_size, void* d_ws, size_t ws_size, hipStream_t stream) {
    static int grid = 0;
    if (grid == 0) {
        int dev = 0, cus = 0, per = 0;
        if (n_in != 14 || out_size != M * DM || ws_size < WS_END) { fprintf(stderr, "kernel_launch: unexpected shapes (n_in %d out %d ws %zu)\n", n_in, out_size, ws_size); grid = -1; return; }
        (void)hipGetDevice(&dev); (void)hipDeviceGetAttribute(&cus, hipDeviceAttributeMultiprocessorCount, dev);
        (void)hipFuncSetAttribute((const void*)fwd, hipFuncAttributeMaxDynamicSharedMemorySize, LDS_BYTES);
        (void)hipOccupancyMaxActiveBlocksPerMultiprocessor(&per, (const void*)fwd, 512, LDS_BYTES);
        if (per < 1) per = 1;
        grid = cus * per;
        fprintf(stderr, "kernel_launch: grid %d (cus %d x %d)\n", grid, cus, per);
    }
    if (grid < 0) return;
    Args a{};
    for (int i = 0; i < 14; ++i) a.in[i] = (const float*)d_in[i];
    a.out = (float*)d_out; a.ws = (unsigned char*)d_ws;
#if MK_MULTI
    for (int ph = 0; ph < NPHASE; ++ph) { a.ph_lo = ph; a.ph_hi = ph + 1; hipLaunchKernelGGL(fwd, dim3(grid), dim3(512), LDS_BYTES, stream, a); }
#else
    a.ph_lo = 0; a.ph_hi = NPHASE;
    void* args[] = {&a};
    hipError_t e = hipLaunchCooperativeKernel((const void*)fwd, dim3(grid), dim3(512), args, LDS_BYTES, stream);
    if (e != hipSuccess) fprintf(stderr, "kernel_launch: cooperative launch failed: %s (grid %d)\n", hipGetErrorString(e), grid);
#endif
}
```

```cpp
#include <hip/hip_runtime.h>
#include <hip/hip_cooperative_groups.h>
#include <cstdio>
#include <cstdint>
namespace cg = cooperative_groups;
namespace pg8 {
#define PG8_LAS __attribute__((address_space(3)))
typedef unsigned short bf16_t;
typedef short bf16x8 __attribute__((ext_vector_type(8)));
typedef float f32x4 __attribute__((ext_vector_type(4)));
typedef unsigned u32x4 __attribute__((ext_vector_type(4)));
constexpr int BM = 256, BK = 64, HALF = 128, HTB = HALF * BK * 2  , STAGE_BYTES = 8 * HTB, NXCD = 8, WGM = 8;

__host__ __device__ __forceinline__ int lds_byte(int r, int c) { const int st = (r >> 4) * 2 + (c >> 5), rr = r & 15, cc = c & 31, ob = rr * 64 + cc * 2; return st * 1024 + (ob ^ (((ob >> 9) & 1) << 5)); }
__host__ __device__ __forceinline__ void stage_rc(int b, int& R, int& C) { const int st = b / 1024, sb = b % 1024, swz = sb ^ (((sb >> 9) & 1) << 5); R = (st >> 1) * 16 + swz / 64; C = (st & 1) * 32 + (swz % 64) / 2; }
__host__ __device__ __forceinline__ int perm32(int rho) { const int n = rho >> 4, i = rho & 15; return 8 * (i >> 2) + 4 * n + (i & 3); }

struct Unit { int pm, pn; };
struct Gemm { const bf16_t* A; const bf16_t* Bt; int M, N, K; };

struct StaticOrder {
    int nM, nN, nwg, G, c;
    __host__ __device__ void init(int M, int N, int G_, int c_) { nM = M / BM; nN = N / BM; nwg = nM * nN; G = G_; c = c_; }
    __host__ __device__ bool next(int i, Unit& u) const {
        const long L = (long)i * G + c; if (L >= nwg) return false;
        int wgid = (int)L; { const int q = nwg / NXCD, r = nwg % NXCD, xcd = wgid % NXCD, off = wgid / NXCD; wgid = (xcd < r ? xcd * (q + 1) : r * (q + 1) + (xcd - r) * q) + off; }
        const int nig = WGM * nN, gid = wgid / nig, fm = gid * WGM, gsz = (nM - fm) < WGM ? (nM - fm) : WGM;
        u.pm = fm + ((wgid % nig) % gsz); u.pn = (wgid % nig) / gsz; return true;
    }
    __device__ __forceinline__ void a_ready(const Unit&) const {}
    __device__ __forceinline__ void done(const Unit&) const {}
};

__device__ __forceinline__ unsigned cvt_pk_bf16(float lo, float hi) { unsigned r; asm volatile("v_cvt_pk_bf16_f32 %0, %1, %2" : "=v"(r) : "v"(lo), "v"(hi)); return r; }
typedef float f32x2 __attribute__((ext_vector_type(2)));
template <class Epi, class Sched, bool ALIGN_EPI = false, bool SP2 = false>
__device__ __forceinline__ void gemm_phase(PG8_LAS unsigned char* lds, const Gemm g, const Sched& S, const Epi& E) {
    int tid_ = threadIdx.x; asm volatile("" : "+v"(tid_));
    const int tid = tid_, wid = __builtin_amdgcn_readfirstlane(tid >> 6), lane = tid & 63, wr = wid >> 2, wc = wid & 3, fr = lane & 15, fq = lane >> 4;
    const int K = g.K, nt = K / BK;
    unsigned voffA[2], voffB[2];
#pragma unroll
    for (int i = 0; i < 2; ++i) { int R, C; stage_rc(tid * 16 + i * 8192, R, C); const int Rb = Epi::PERM ? ((R & ~31) + perm32(R & 31)) : R;
        voffA[i] = (unsigned)(R * K + C) * 2u; voffB[i] = (unsigned)(Rb * K + C) * 2u; }
    const size_t kstep = (size_t)(BK * 2);
    const size_t hstep = (size_t)HALF * K * 2;
    const size_t tstep = 2 * hstep;
    const unsigned ldsw = (unsigned)wid * 1024u;
    const int aoff = lds_byte(wr * 64 + fr, fq * 8), boff = lds_byte(wc * 32 + fr, fq * 8);
#define PG8_SA(b, h) (((b) * 2 + (h)) * HTB)
#define PG8_SB(b, h) ((4 + (b) * 2 + (h)) * HTB)
#define PG8_STAGE(bufoff, gbase, voff) do { _Pragma("unroll") for (int _i = 0; _i < 2; ++_i) \
        __builtin_amdgcn_global_load_lds((const unsigned*)((const char*)(gbase) + (voff)[_i]), (PG8_LAS unsigned*)(lds + (bufoff) + ldsw + _i * 8192), 16, 0, 0); } while (0)
#define PG8_LDA(dst, b, h) do { _Pragma("unroll") for (int m = 0; m < 4; ++m) _Pragma("unroll") for (int k = 0; k < 2; ++k) dst[m][k] = *(const PG8_LAS bf16x8*)(lds + PG8_SA(b, h) + aoff + m * 2048 + k * 1024); } while (0)
#define PG8_LDB(dst, b, h) do { _Pragma("unroll") for (int n = 0; n < 2; ++n) _Pragma("unroll") for (int k = 0; k < 2; ++k) dst[n][k] = *(const PG8_LAS bf16x8*)(lds + PG8_SB(b, h) + boff + n * 2048 + k * 1024); } while (0)
#define PG8_MMA(ai, bj, At, Bt) do { __builtin_amdgcn_s_setprio(1); _Pragma("unroll") for (int m = 0; m < 4; ++m) _Pragma("unroll") for (int n = 0; n < 2; ++n) _Pragma("unroll") for (int k = 0; k < 2; ++k) \
        acc[ai][bj][m][n] = __builtin_amdgcn_mfma_f32_16x16x32_bf16(Bt[n][k], At[m][k], acc[ai][bj][m][n], 0, 0, 0); __builtin_amdgcn_s_setprio(0); } while (0)
#define PG8_WAIT_V(n) asm volatile("s_waitcnt vmcnt(" #n ")" ::: "memory")
#define PG8_WAIT_L(n) asm volatile("s_waitcnt lgkmcnt(" #n ")" ::: "memory")
#define PG8_BAR __builtin_amdgcn_s_barrier()
#define PG8_SCHED __builtin_amdgcn_sched_barrier(0)
    Unit cur, nxt; int ui = 0;
    if (!S.next(0, cur)) return;
    f32x4 acc[2][2][4][2];
#pragma unroll
    for (int a = 0; a < 2; ++a)
#pragma unroll
        for (int b = 0; b < 2; ++b)
#pragma unroll
            for (int m = 0; m < 4; ++m)
#pragma unroll
                for (int n = 0; n < 2; ++n) acc[a][b][m][n] = (f32x4){0.f, 0.f, 0.f, 0.f};
    bf16x8 At[4][2], B0[2][2], B1[2][2];
    const char* cA = (const char*)g.A + (size_t)cur.pm * tstep; const char* cB = (const char*)g.Bt + (size_t)cur.pn * tstep;
    S.a_ready(cur);
    if constexpr (SP2) {
        PG8_STAGE(PG8_SB(0, 0), cB, voffB); PG8_STAGE(PG8_SB(0, 1), cB + hstep, voffB); PG8_STAGE(PG8_SA(0, 0), cA, voffA); PG8_STAGE(PG8_SA(0, 1), cA + hstep, voffA);
        if (wr == 1) PG8_BAR;
        PG8_WAIT_V(2); PG8_BAR;
        PG8_STAGE(PG8_SB(1, 0), cB + kstep, voffB); PG8_STAGE(PG8_SA(1, 0), cA + kstep, voffA); PG8_STAGE(PG8_SB(1, 1), cB + hstep + kstep, voffB);
        PG8_WAIT_V(6); PG8_BAR;
    } else {
        PG8_STAGE(PG8_SB(0, 0), cB, voffB); PG8_STAGE(PG8_SA(0, 0), cA, voffA); PG8_STAGE(PG8_SB(0, 1), cB + hstep, voffB); PG8_STAGE(PG8_SA(0, 1), cA + hstep, voffA);
        if (wr == 1) PG8_BAR;
        PG8_WAIT_V(4); PG8_BAR;
        PG8_STAGE(PG8_SB(1, 0), cB + kstep, voffB); PG8_STAGE(PG8_SA(1, 0), cA + kstep, voffA); PG8_STAGE(PG8_SB(1, 1), cB + hstep + kstep, voffB);
        PG8_WAIT_V(6); PG8_BAR;
    }
    for (;;) {
        const bool has_next = S.next(ui + 1, nxt);
        const char* nA = has_next ? (const char*)g.A + (size_t)nxt.pm * tstep : cA; const char* nB = has_next ? (const char*)g.Bt + (size_t)nxt.pn * tstep : cB;
        for (int t = 0; t < nt; t += 2) {
            const bool last = (t == nt - 2);
            const char* a1 = cA + (size_t)(t + 1) * kstep;
            const char* a2 = last ? nA : cA + (size_t)(t + 2) * kstep; const char* b2 = last ? nB : cB + (size_t)(t + 2) * kstep;
            const char* a3 = a2 + kstep; const char* b3 = b2 + kstep;
            if (last && has_next) S.a_ready(nxt);
            if constexpr (SP2) {
            PG8_LDB(B0, 0, 0); PG8_LDB(B1, 0, 1); PG8_SCHED; PG8_LDA(At, 0, 0); PG8_STAGE(PG8_SA(1, 1), a1 + hstep, voffA);
            PG8_WAIT_V(8); PG8_WAIT_L(0); PG8_BAR; PG8_MMA(0, 0, At, B0); PG8_MMA(0, 1, At, B1); PG8_BAR; PG8_SCHED;
            PG8_LDA(At, 0, 1); PG8_STAGE(PG8_SB(0, 0), b2, voffB); PG8_STAGE(PG8_SB(0, 1), b2 + hstep, voffB); PG8_STAGE(PG8_SA(0, 0), a2, voffA);
            PG8_WAIT_V(8); PG8_WAIT_L(0); PG8_BAR; PG8_MMA(1, 0, At, B0); PG8_MMA(1, 1, At, B1); PG8_BAR; PG8_SCHED;
            PG8_LDB(B0, 1, 0); PG8_LDB(B1, 1, 1); PG8_SCHED; PG8_LDA(At, 1, 0); PG8_STAGE(PG8_SA(0, 1), a2 + hstep, voffA);
            PG8_WAIT_V(8); PG8_WAIT_L(0); PG8_BAR; PG8_MMA(0, 0, At, B0); PG8_MMA(0, 1, At, B1); PG8_BAR; PG8_SCHED;
            PG8_LDA(At, 1, 1); PG8_STAGE(PG8_SB(1, 0), b3, voffB); PG8_STAGE(PG8_SB(1, 1), b3 + hstep, voffB); PG8_STAGE(PG8_SA(1, 0), a3, voffA);
            PG8_WAIT_V(8); PG8_WAIT_L(0); PG8_BAR; PG8_MMA(1, 0, At, B0); PG8_MMA(1, 1, At, B1); PG8_BAR; PG8_SCHED;
            } else {
            PG8_LDB(B0, 0, 0); PG8_SCHED; PG8_LDA(At, 0, 0); PG8_STAGE(PG8_SA(1, 1), a1 + hstep, voffA);
            PG8_WAIT_L(8); PG8_BAR; PG8_WAIT_L(0); PG8_MMA(0, 0, At, B0); PG8_BAR; PG8_SCHED;
            PG8_LDB(B1, 0, 1); PG8_STAGE(PG8_SB(0, 0), b2, voffB);
            PG8_BAR; PG8_WAIT_L(0); PG8_MMA(0, 1, At, B1); PG8_BAR;
            PG8_LDA(At, 0, 1); PG8_STAGE(PG8_SA(0, 0), a2, voffA);
            PG8_BAR; PG8_WAIT_L(0); PG8_MMA(1, 0, At, B0); PG8_BAR; PG8_SCHED;
            PG8_STAGE(PG8_SB(0, 1), b2 + hstep, voffB);
            PG8_WAIT_V(6); PG8_BAR; PG8_MMA(1, 1, At, B1); PG8_BAR;
            PG8_LDB(B0, 1, 0); PG8_SCHED; PG8_LDA(At, 1, 0); PG8_STAGE(PG8_SA(0, 1), a2 + hstep, voffA);
            PG8_WAIT_L(8); PG8_BAR; PG8_WAIT_L(0); PG8_MMA(0, 0, At, B0); PG8_BAR; PG8_SCHED;
            PG8_LDB(B1, 1, 1); PG8_STAGE(PG8_SB(1, 0), b3, voffB);
            PG8_BAR; PG8_WAIT_L(0); PG8_MMA(0, 1, At, B1); PG8_BAR;
            PG8_LDA(At, 1, 1); PG8_STAGE(PG8_SA(1, 0), a3, voffA);
            PG8_BAR; PG8_WAIT_L(0); PG8_MMA(1, 0, At, B0); PG8_BAR; PG8_SCHED;
            PG8_STAGE(PG8_SB(1, 1), b3 + hstep, voffB);
            PG8_WAIT_V(6); PG8_BAR; PG8_MMA(1, 1, At, B1); PG8_BAR;
            }
        }
        if constexpr (ALIGN_EPI) { if (wr == 0) PG8_BAR; }
        if constexpr (!Epi::AFTER_DRAIN) { E(acc, cur, wr, wc, fr, fq); S.done(cur); }
        if (!has_next) break;
#pragma unroll
        for (int a = 0; a < 2; ++a)
#pragma unroll
            for (int b = 0; b < 2; ++b)
#pragma unroll
                for (int m = 0; m < 4; ++m)
#pragma unroll
                    for (int n = 0; n < 2; ++n) acc[a][b][m][n] = (f32x4){0.f, 0.f, 0.f, 0.f};
        cur = nxt; cA = nA; cB = nB; ++ui;
        if constexpr (ALIGN_EPI) { if (wr == 1) PG8_BAR; }
    }
    PG8_WAIT_V(0);
    if constexpr (!ALIGN_EPI) { if (wr == 0) PG8_BAR; }
    PG8_BAR;
    if constexpr (Epi::AFTER_DRAIN) { E.fused(acc, cur, wr, wc, fr, fq, lds, wid, lane); S.done(cur); }
#undef PG8_SA
#undef PG8_SB
#undef PG8_STAGE
#undef PG8_LDA
#undef PG8_LDB
#undef PG8_MMA
#undef PG8_WAIT_V
#undef PG8_WAIT_L
#undef PG8_BAR
#undef PG8_SCHED
}
}
#include <hip/hip_bf16.h>
#include <cmath>
namespace attn_body {
using bf16=__hip_bfloat16;
using bf16x8=__attribute__((ext_vector_type(8)))short;
using s16x4=__attribute__((ext_vector_type(4)))short;
using f32x16=__attribute__((ext_vector_type(16)))float;
using u32x4=__attribute__((ext_vector_type(4)))unsigned;
using f32x4v=__attribute__((ext_vector_type(4)))float;
constexpr int SEQ=4096,D=64,DM=64,OPITCH=1024;
constexpr int LDS_C=98304;
constexpr int NW=8,QBLK=32,QB=QBLK*NW,KVBLK=64,NQB=SEQ/QB;
constexpr int ATTN_UNIT_ROWS=QB;
__device__ __forceinline__ int crow(int r,int hi){return (r&3)+8*(r>>2)+4*hi;}
#define SBAR() __builtin_amdgcn_sched_barrier(0)
__device__ __forceinline__ void cmask(f32x16&p0,f32x16&p1,int jb,int qrel,int hi){
  const float NEG=-INFINITY; int kb=64*jb+4*hi;
  #pragma unroll
  for(int r=0;r<16;++r){int kv=kb+(r&3)+8*(r>>2); if(kv>qrel)p0[r]=NEG; if(kv+32>qrel)p1[r]=NEG;}
}

constexpr int NSLOT=3, SLOTB=8192;
constexpr int LDS_K=0, LDS_V=NSLOT*SLOTB, LDS_WS=2*NSLOT*SLOTB, LDS_OST=LDS_WS+NW*64*4, LDS_BYTES=LDS_OST+NW*4096;
constexpr float C2=0.125f*1.4426950408889634f;
__device__ __forceinline__ void glds16(const void*gsrc,unsigned lds_dst){unsigned keep;
  asm volatile("s_mov_b32 %0, m0\n\ts_mov_b32 m0, %2\n\ts_nop 0\n\tglobal_load_lds_dwordx4 %1, off\n\ts_mov_b32 m0, %0":"=&s"(keep):"v"(gsrc),"s"(lds_dst):"memory");}
__device__ __forceinline__ float max3f(float a,float b,float c){float r;asm("v_max3_f32 %0, %1, %2, %3":"=v"(r):"v"(a),"v"(b),"v"(c));return r;}
__device__ __forceinline__ float max2f(float a,float b){float r;asm("v_max_f32_e32 %0, %1, %2":"=v"(r):"v"(a),"v"(b));return r;}
__device__ __forceinline__ float fadd_s(float a,float b){float r;asm("v_add_f32_e32 %0, %1, %2":"=v"(r):"v"(a),"v"(b));return r;}
__device__ __forceinline__ float fsub_s(float a,float b){float r;asm("v_sub_f32_e32 %0, %1, %2":"=v"(r):"v"(a),"v"(b));return r;}
typedef float f32x2_t __attribute__((ext_vector_type(2))); typedef __bf16 bf16x2_t __attribute__((ext_vector_type(2)));
__device__ __forceinline__ unsigned cvtpk_s(float lo,float hi){f32x2_t v={lo,hi};bf16x2_t b=__builtin_convertvector(v,bf16x2_t);return __builtin_bit_cast(unsigned,b);}
#define WAIT_BAR(N) asm volatile("s_waitcnt vmcnt(" #N ") lgkmcnt(0)\n\ts_barrier":::"memory")

__device__ __forceinline__ void qkt(f32x16&p0,f32x16&p1,const char*Kslot,const bf16x8*qr,const f32x16&negm,int r32,int hi){
  const char*kb=Kslot+hi*1024+r32*16;
  #pragma unroll
  for(int d0=0;d0<4;++d0){
    const bf16x8 b0=*reinterpret_cast<const bf16x8*>(kb+d0*2048);
    const bf16x8 b1=*reinterpret_cast<const bf16x8*>(kb+d0*2048+512);
    if(d0==0){p0=__builtin_amdgcn_mfma_f32_32x32x16_bf16(b0,qr[0],negm,0,0,0);p1=__builtin_amdgcn_mfma_f32_32x32x16_bf16(b1,qr[0],negm,0,0,0);}
    else{p0=__builtin_amdgcn_mfma_f32_32x32x16_bf16(b0,qr[d0],p0,0,0,0);p1=__builtin_amdgcn_mfma_f32_32x32x16_bf16(b1,qr[d0],p1,0,0,0);}}
}
typedef __attribute__((address_space(3))) const char* lds_cptr;
typedef short v4i16_t __attribute__((ext_vector_type(4)));
__device__ __forceinline__ void kload8(bf16x8*kf,lds_cptr kp){
  kf[0]=*(const __attribute__((address_space(3))) bf16x8*)(kp);      kf[1]=*(const __attribute__((address_space(3))) bf16x8*)(kp+512);
  kf[2]=*(const __attribute__((address_space(3))) bf16x8*)(kp+2048); kf[3]=*(const __attribute__((address_space(3))) bf16x8*)(kp+2560);
  kf[4]=*(const __attribute__((address_space(3))) bf16x8*)(kp+4096); kf[5]=*(const __attribute__((address_space(3))) bf16x8*)(kp+4608);
  kf[6]=*(const __attribute__((address_space(3))) bf16x8*)(kp+6144); kf[7]=*(const __attribute__((address_space(3))) bf16x8*)(kp+6656);
}
__device__ __forceinline__ void kload2(bf16x8*kf,lds_cptr kp,int j){ kf[2*j]=*(const __attribute__((address_space(3))) bf16x8*)(kp+j*2048); kf[2*j+1]=*(const __attribute__((address_space(3))) bf16x8*)(kp+j*2048+512); }
__device__ __forceinline__ s16x4 vtr(lds_cptr p){ return __builtin_bit_cast(s16x4,__builtin_amdgcn_ds_read_tr16_b64_v4i16((__attribute__((address_space(3))) v4i16_t*)p)); }
__device__ __forceinline__ float rowmax(const f32x16&p0,const f32x16&p1){
  float a=max3f(p0[0],p0[1],p1[0]),b=max3f(p0[2],p0[3],p1[1]);a=max3f(a,p1[2],p1[3]);
  #pragma unroll
  for(int r=4;r<16;r+=4){a=max3f(a,p0[r],p0[r+1]);b=max3f(b,p0[r+2],p0[r+3]);a=max3f(a,p1[r],p1[r+1]);b=max3f(b,p1[r+2],p1[r+3]);}
  const float m=max2f(a,b);
  auto rr=__builtin_amdgcn_permlane32_swap(__float_as_uint(m),__float_as_uint(m),false,false);
  return max2f(__uint_as_float(rr[0]),__uint_as_float(rr[1]));
}
__device__ __forceinline__ void pv(f32x16*o,int vb,bf16x8 pa0,bf16x8 pa1,bf16x8 pa2,bf16x8 pa3){
  #pragma unroll
  for(int d0=0;d0<2;++d0){s16x4 lo[4],hi[4];
    #pragma unroll
    for(int ks=0;ks<4;++ks){
      asm volatile("ds_read_b64_tr_b16 %0,%1 offset:%c2":"=&v"(lo[ks]):"v"(vb),"i"(d0*4096+ks*1024):"memory");
      asm volatile("ds_read_b64_tr_b16 %0,%1 offset:%c2":"=&v"(hi[ks]):"v"(vb),"i"(d0*4096+ks*1024+512):"memory");}
    asm volatile("s_waitcnt lgkmcnt(0)":::"memory");SBAR();
    #define PK(k) (bf16x8){lo[k][0],lo[k][1],lo[k][2],lo[k][3],hi[k][0],hi[k][1],hi[k][2],hi[k][3]}
    o[d0]=__builtin_amdgcn_mfma_f32_32x32x16_bf16(pa0,PK(0),o[d0],0,0,0);
    o[d0]=__builtin_amdgcn_mfma_f32_32x32x16_bf16(pa1,PK(1),o[d0],0,0,0);
    o[d0]=__builtin_amdgcn_mfma_f32_32x32x16_bf16(pa2,PK(2),o[d0],0,0,0);
    o[d0]=__builtin_amdgcn_mfma_f32_32x32x16_bf16(pa3,PK(3),o[d0],0,0,0);
    #undef PK
  }
}

#ifndef ATTN_STORE16
#define ATTN_STORE16(p,v) (*(u32x4*)(p)=(v))
#endif
template<int THRL> __device__ __forceinline__ void attn_unit(int qb,int jstart,const bf16*Q,const bf16*__restrict__ K,const bf16*__restrict__ V,bf16*O,const float*__restrict__ Cg,char*shm){
  int tid_=threadIdx.x; asm volatile("":"+v"(tid_)); const int tid=tid_,lane=tid&63,r32=lane&31,hi=lane>>5; const int wid=__builtin_amdgcn_readfirstlane(tid>>6);
  const int q0=qb*QB;
  const bf16*Qw=Q+(long)(q0+wid*QBLK)*DM;
  const bf16*Kh=K+(long)jstart*KVBLK*DM,*Vh=V+(long)jstart*KVBLK*DM;
  const lds_cptr shm3=(lds_cptr)shm;
  const unsigned lds0=(unsigned)(uintptr_t)shm;
  float*wsf=(float*)(shm+LDS_WS)+wid*64;
  const bf16*ksrc=Kh+(long)lane*DM+wid*8;
  const bf16*vsrc=Vh+(long)(16*(wid&3)+(lane>>2))*DM+(wid>>2)*32+(lane&3)*8;
  const unsigned kdst=lds0+LDS_K+wid*1024, vdst=lds0+LDS_V+wid*1024;
  #define DMA_K(t,slot) glds16(ksrc+(long)(t)*KVBLK*DM,(unsigned)__builtin_amdgcn_readfirstlane(kdst+(slot)))
  #define DMA_V(t,slot) glds16(vsrc+(long)(t)*KVBLK*DM,(unsigned)__builtin_amdgcn_readfirstlane(vdst+(slot)))
  const int vb0=(int)(lds0+LDS_V)+((lane>>4)&1)*32+(lane&3)*8+(4*hi+((lane&15)>>2))*64;
  const char*Kbase=shm+LDS_K; bf16x8 kf[8];
  const lds_cptr kp0=shm3+LDS_K+hi*1024+r32*16; const lds_cptr vp0=shm3+LDS_V+((lane>>4)&1)*32+(lane&3)*8+(4*hi+((lane&15)>>2))*64;
  const int NT=(q0+QB)/KVBLK-jstart;
  { typedef __attribute__((address_space(3))) f32x4v lf32x4; lf32x4*cl_=(lf32x4*)(shm3+LDS_C); const f32x4v*cg_=(const f32x4v*)(Cg+jstart*KVBLK); const int n4_=(q0+QB-jstart*KVBLK)>>2;
    f32x4v c0_=f32x4v{},c1_=f32x4v{}; if(tid<n4_)c0_=cg_[tid]; if(tid+NW*64<n4_)c1_=cg_[tid+NW*64]; if(tid<n4_)cl_[tid]=c0_; if(tid+NW*64<n4_)cl_[tid+NW*64]=c1_; }
  DMA_K(0,0);DMA_V(0,0);DMA_K(1,SLOTB);
  bf16x8 qr[4];
  #pragma unroll
  for(int d0=0;d0<4;++d0)qr[d0]=*reinterpret_cast<const bf16x8*>(&Qw[(long)r32*DM+d0*16+hi*8]);
  float mhat=0.f,l_reg=0.f;f32x16 o[2];o[0]=f32x16{};o[1]=f32x16{};
  const int qrel=wid*QBLK+r32;
  #define CMASK(P0,P1,t) do{int jb_=(t)-(NT-4); if(jb_>=0)cmask(P0,P1,jb_,qrel,hi);}while(0)
  typedef __attribute__((address_space(3))) const float* lds_fptr; typedef __attribute__((address_space(3))) const f32x4v* lds_f4ptr;
  const lds_fptr cl0=(lds_fptr)(shm3+LDS_C)+4*hi;
  #define BIAS(P0,P1,t) do{ const lds_fptr cb_=cl0+64*(t); _Pragma("unroll") for(int g_=0;g_<4;++g_){ const f32x4v a_=*(lds_f4ptr)(cb_+8*g_), b_=*(lds_f4ptr)(cb_+32+8*g_); \
      _Pragma("unroll") for(int i_=0;i_<4;++i_){P0[4*g_+i_]-=a_[i_];P1[4*g_+i_]-=b_[i_];} } }while(0)
  #define BIASINIT(C0_,C1_,t) do{ const lds_fptr cb_=cl0+64*(t); const float nm_=-mhat; _Pragma("unroll") for(int g_=0;g_<4;++g_){ const f32x4v a_=*(lds_f4ptr)(cb_+8*g_), b_=*(lds_f4ptr)(cb_+32+8*g_); \
      _Pragma("unroll") for(int i_=0;i_<4;++i_){C0_[4*g_+i_]=nm_-a_[i_];C1_[4*g_+i_]=nm_-b_[i_];} } }while(0)
  bool resc=false;
  #define START(P0,P1) do{ const float rm=rowmax(P0,P1); resc=false; \
    { const float dl=rm; mhat=fadd_s(mhat,dl); \
      _Pragma("unroll") for(int r=0;r<16;++r){P0[r]=fsub_s(P0[r],dl);P1[r]=fsub_s(P1[r],dl);} \
      } \
    _Pragma("unroll") for(int r=0;r<16;++r)P0[r]=__builtin_amdgcn_exp2f(P0[r]); }while(0)
  #define RESC() do{ if(resc){ asm volatile("s_waitcnt lgkmcnt(0)":::"memory"); \
      _Pragma("unroll") for(int d_=0;d_<2;++d_) _Pragma("unroll") for(int r=0;r<16;++r)o[d_][r]*=wsf[crow(r,hi)]; } }while(0)
  f32x16 pA0,pA1,pB0,pB1;
  int sl_prev=0,sl_cur=0,sl_next=SLOTB;
  #define ROT() do{sl_prev=sl_cur;sl_cur=sl_next;sl_next=(sl_next==(NSLOT-1)*SLOTB)?0:sl_next+SLOTB;}while(0)
  DMA_K(2,2*SLOTB);
  WAIT_BAR(3);
  { const f32x16 zero_=f32x16{}; qkt(pA0,pA1,Kbase,qr,zero_,r32,hi); }asm volatile("s_nop 15\n\ts_nop 7":"+v"(pA0),"+v"(pA1));BIAS(pA0,pA1,0);CMASK(pA0,pA1,0);
  START(pA0,pA1);
  _Pragma("unroll") for(int r=0;r<16;++r)pA1[r]=__builtin_amdgcn_exp2f(pA1[r]);
  WAIT_BAR(0);
  DMA_K(3,0);DMA_V(1,SLOTB);
  ROT();
  kload8(kf,kp0+sl_cur);
  WAIT_BAR(2);
  s16x4 vlo[8],vhi[8]; u32x4 pw0,pw1,pw2,pw3;
  #define PKW(P,B) cvtpk_s(P[B],P[B+1])
  #define PAF(k) __builtin_bit_cast(bf16x8,pw##k)
  #define VFR(i) (bf16x8){vlo[i][0],vlo[i][1],vlo[i][2],vlo[i][3],vhi[i][0],vhi[i][1],vhi[i][2],vhi[i][3]}
  #define PIN(x) asm volatile("":"+v"(x))
  #define MX3(a,b,c) __builtin_fmaxf(__builtin_fmaxf((a),(b)),(c))
  #define GAPA(MF,A0,A1,A2,A3,W0,W1,PW) do{ MF; sacc+=A0; sacc+=A1; sacc+=A2; sacc+=A3; PIN(sacc); W0; W1; PIN(PW); SBAR(); }while(0)
  #define EX(v) __builtin_amdgcn_exp2f(v)
  #define GAPB(MF,X,B) do{ MF; X[B]=EX(X[B]); X[B+1]=EX(X[B+1]); X[B+2]=EX(X[B+2]); X[B+3]=EX(X[B+3]); PIN(X); SBAR(); }while(0)
  #define VRD(i) do{ vlo[i]=vtr(vp_+(((i)>>2)*4096+((i)&3)*1024)); vhi[i]=vtr(vp_+(((i)>>2)*4096+((i)&3)*1024+512)); }while(0)
  #define KRD(G,j) do{ if(G){ kload2(kf,kp0+sl_next,j); SBAR(); } }while(0)
  #define STEP(C0,C1,P0,P1,t,GK,GV,GL) do{ SBAR(); BIASINIT(C0,C1,t); SBAR(); \
    const lds_cptr vp_=vp0+sl_prev; \
    VRD(0); SBAR(); float sacc=(P0[0]+P0[1]); \
    GAPA(C0=__builtin_amdgcn_mfma_f32_32x32x16_bf16(kf[0],qr[0],C0,0,0,0), P0[2],P0[3],P0[4],P0[5],     pw0[0]=PKW(P0,0), pw0[1]=PKW(P0,2), pw0); \
    VRD(4); SBAR(); GAPA(C1=__builtin_amdgcn_mfma_f32_32x32x16_bf16(kf[1],qr[0],C1,0,0,0), P0[6],P0[7],P0[8],P0[9],     pw0[2]=PKW(P0,4), pw0[3]=PKW(P0,6), pw0); \
    VRD(1); SBAR(); GAPA(C0=__builtin_amdgcn_mfma_f32_32x32x16_bf16(kf[2],qr[1],C0,0,0,0),   P0[10],P0[11],P0[12],P0[13], pw1[0]=PKW(P0,8), pw1[1]=PKW(P0,10), pw1); \
    VRD(5); SBAR(); GAPA(C1=__builtin_amdgcn_mfma_f32_32x32x16_bf16(kf[3],qr[1],C1,0,0,0),   P0[14],P0[15],P1[0],P1[1],   pw1[2]=PKW(P0,12),pw1[3]=PKW(P0,14), pw1); \
    VRD(2); SBAR(); GAPA(C0=__builtin_amdgcn_mfma_f32_32x32x16_bf16(kf[4],qr[2],C0,0,0,0),   P1[2],P1[3],P1[4],P1[5],     pw2[0]=PKW(P1,0), pw2[1]=PKW(P1,2), pw2); \
    VRD(6); SBAR(); GAPA(C1=__builtin_amdgcn_mfma_f32_32x32x16_bf16(kf[5],qr[2],C1,0,0,0),   P1[6],P1[7],P1[8],P1[9],     pw2[2]=PKW(P1,4), pw2[3]=PKW(P1,6), pw2); \
    VRD(3); SBAR(); GAPA(C0=__builtin_amdgcn_mfma_f32_32x32x16_bf16(kf[6],qr[3],C0,0,0,0),   P1[10],P1[11],P1[12],P1[13], pw3[0]=PKW(P1,8), pw3[1]=PKW(P1,10), pw3); \
    VRD(7); SBAR(); GAPA(C1=__builtin_amdgcn_mfma_f32_32x32x16_bf16(kf[7],qr[3],C1,0,0,0),   P1[14],P1[15],0.f,0.f,       pw3[2]=PKW(P1,12),pw3[3]=PKW(P1,14), pw3); \
    l_reg+=sacc; \
    if(GK){DMA_K((t)+3,sl_cur);} if(GV){DMA_V((t)+1,sl_next);} \
    CMASK(C0,C1,t); \
    { float a=MX3(C0[0],C0[1],C1[0]),b=MX3(C0[2],C0[3],C1[1]); a=MX3(a,C1[2],C1[3]); \
      _Pragma("unroll") for(int r=4;r<16;r+=4){a=MX3(a,C0[r],C0[r+1]);b=MX3(b,C0[r+2],C0[r+3]);a=MX3(a,C1[r],C1[r+1]);b=MX3(b,C1[r+2],C1[r+3]);} \
      float rm=__builtin_fmaxf(a,b); { auto rr=__builtin_amdgcn_permlane32_swap(__float_as_uint(rm),__float_as_uint(rm),false,false); rm=__builtin_fmaxf(__uint_as_float(rr[0]),__uint_as_float(rr[1])); } \
      resc=false; \
      if(__builtin_expect(__any(rm>(float)THRL),0)){ const float dl=__builtin_fmaxf(rm,0.f); mhat+=dl; \
        _Pragma("unroll") for(int r=0;r<16;++r){C0[r]-=dl;C1[r]-=dl;} \
        const float f=__builtin_amdgcn_exp2f(-dl); l_reg*=f; if(hi==0)wsf[r32]=f; resc=true; } } \
    SBAR(); \
    GAPB(o[0]=__builtin_amdgcn_mfma_f32_32x32x16_bf16(PAF(0),VFR(0),o[0],0,0,0), C0,0); \
    GAPB(o[1]=__builtin_amdgcn_mfma_f32_32x32x16_bf16(PAF(0),VFR(4),o[1],0,0,0), C0,4); \
    KRD(GL,0); GAPB(o[0]=__builtin_amdgcn_mfma_f32_32x32x16_bf16(PAF(1),VFR(1),o[0],0,0,0), C0,8); \
    KRD(GL,1); GAPB(o[1]=__builtin_amdgcn_mfma_f32_32x32x16_bf16(PAF(1),VFR(5),o[1],0,0,0), C0,12); \
    KRD(GL,2); GAPB(o[0]=__builtin_amdgcn_mfma_f32_32x32x16_bf16(PAF(2),VFR(2),o[0],0,0,0), C1,0); \
    KRD(GL,3); GAPB(o[1]=__builtin_amdgcn_mfma_f32_32x32x16_bf16(PAF(2),VFR(6),o[1],0,0,0), C1,4); \
    GAPB(o[0]=__builtin_amdgcn_mfma_f32_32x32x16_bf16(PAF(3),VFR(3),o[0],0,0,0), C1,8); \
    GAPB(o[1]=__builtin_amdgcn_mfma_f32_32x32x16_bf16(PAF(3),VFR(7),o[1],0,0,0), C1,12); \
    }while(0)
  int t=1;
  #undef CMASK
  #define CMASK(P0,P1,t) do{}while(0)
  for(;t+5<NT;t+=2){
    STEP(pB0,pB1,pA0,pA1,t,true,true,true);     WAIT_BAR(2); RESC(); ROT();
    STEP(pA0,pA1,pB0,pB1,t+1,true,true,true);   WAIT_BAR(2); RESC(); ROT();
  }
  #undef CMASK
  #define CMASK(P0,P1,t) do{int jb_=(t)-(NT-4); if(jb_>=0)cmask(P0,P1,jb_,qrel,hi);}while(0)
  #define ENDW(tt) do{ if((tt)+3<NT){WAIT_BAR(2);} else if((tt)+2<NT){WAIT_BAR(1);} else {WAIT_BAR(0);} }while(0)
  for(;t+1<NT;t+=2){
    STEP(pB0,pB1,pA0,pA1,t,(t+3<NT),(t+1<NT),(t+1<NT));       ENDW(t);   RESC(); ROT();
    STEP(pA0,pA1,pB0,pB1,t+1,(t+4<NT),(t+2<NT),(t+2<NT));     ENDW(t+1); RESC(); ROT();
  }
  STEP(pB0,pB1,pA0,pA1,NT-1,false,false,false); RESC();
  { float sacc=pB0[0]+pB0[1]; _Pragma("unroll") for(int r=2;r<16;++r)sacc+=pB0[r]; _Pragma("unroll") for(int r=0;r<16;++r)sacc+=pB1[r]; l_reg+=sacc;
    pw0=(u32x4){PKW(pB0,0),PKW(pB0,2),PKW(pB0,4),PKW(pB0,6)};pw1=(u32x4){PKW(pB0,8),PKW(pB0,10),PKW(pB0,12),PKW(pB0,14)};pw2=(u32x4){PKW(pB1,0),PKW(pB1,2),PKW(pB1,4),PKW(pB1,6)};pw3=(u32x4){PKW(pB1,8),PKW(pB1,10),PKW(pB1,12),PKW(pB1,14)};
    SBAR(); pv(o,vb0+sl_cur,PAF(0),PAF(1),PAF(2),PAF(3)); }
  #undef PKW
  #undef PAF
  #undef VFR
  #undef PIN
  #undef MX3
  #undef GAPA
  #undef GAPB
  #undef EX
  #undef VRD
  #undef KRD
  #undef STEP
  #undef ENDW
  {auto rr=__builtin_amdgcn_permlane32_swap(__float_as_uint(l_reg),__float_as_uint(l_reg),false,false);l_reg=__uint_as_float(rr[0])+__uint_as_float(rr[1]);}
  if(hi==0)wsf[32+r32]=l_reg;asm volatile("s_waitcnt lgkmcnt(0)":::"memory");
  float rli[16];
  #pragma unroll
  for(int r=0;r<16;++r)rli[r]=__builtin_amdgcn_rcpf(wsf[32+crow(r,hi)]);
  bf16*Ow=O+(long)(q0+wid*QBLK)*OPITCH;
  { bf16*stg=(bf16*)(shm+LDS_OST)+wid*2048;
    #pragma unroll
    for(int r=0;r<16;++r){const int orow=crow(r,hi);
      #pragma unroll
      for(int d0=0;d0<2;++d0)stg[orow*64+d0*32+r32]=__float2bfloat16(o[d0][r]*rli[r]);}
    asm volatile("s_waitcnt lgkmcnt(0)":::"memory");
    #pragma unroll
    for(int i=0;i<4;++i){const int row=i*8+(lane>>3),ch=lane&7; const u32x4 v=*(const u32x4*)(stg+row*64+ch*8); ATTN_STORE16(Ow+(long)row*OPITCH+ch*8,v);} }
  asm volatile("s_waitcnt lgkmcnt(0)\n\ts_barrier":::"memory");
  #undef DMA_K
  #undef DMA_V
  #undef CMASK
  #undef BIAS
  #undef BIASINIT
  #undef START
  #undef RESC
  #undef ROT
}
__device__ __forceinline__ void sb_unit(int qb,const bf16*Q,const bf16*__restrict__ K,const bf16*__restrict__ V,bf16*O,char*shm){
  int tid_=threadIdx.x; asm volatile("":"+v"(tid_)); const int tid=tid_,lane=tid&63,r32=lane&31,hi=lane>>5; const int wid=__builtin_amdgcn_readfirstlane(tid>>6);
  const int q0=qb*QB;
  const bf16*Qw=Q+(long)(q0+wid*QBLK)*DM;
  const unsigned lds0=(unsigned)(uintptr_t)shm;
  typedef __attribute__((address_space(3))) int lds_i32; typedef __attribute__((address_space(3))) const u32x4* lds_u4ptr;
  lds_i32*flags=(lds_i32*)((lds_cptr)shm+LDS_WS);
  const bf16*ksrc=K+(long)lane*DM+wid*8;
  const bf16*vsrc=V+(long)(16*(wid&3)+(lane>>2))*DM+(wid>>2)*32+(lane&3)*8;
  const unsigned kdst=lds0+LDS_K+wid*1024, vdst=lds0+LDS_V+wid*1024;
  #define DMA_K(t,slot) glds16(ksrc+(long)(t)*KVBLK*DM,(unsigned)__builtin_amdgcn_readfirstlane(kdst+(slot)))
  #define DMA_V(t,slot) glds16(vsrc+(long)(t)*KVBLK*DM,(unsigned)__builtin_amdgcn_readfirstlane(vdst+(slot)))
  const int vb0=(int)(lds0+LDS_V)+((lane>>4)&1)*32+(lane&3)*8+(4*hi+((lane&15)>>2))*64;
  const int NT=(q0+QB)/KVBLK;
  DMA_K(NT-1,0);DMA_V(NT-1,0);
  bf16x8 qr[4];
  #pragma unroll
  for(int d0=0;d0<4;++d0)qr[d0]=*reinterpret_cast<const bf16x8*>(&Qw[(long)r32*DM+d0*16+hi*8]);
  f32x16 o[2];o[0]=f32x16{};o[1]=f32x16{};
  float T=0.f; const int t_abs=q0+wid*QBLK+r32; bool wdone=false;
  for(int i=0;;++i){
    const int jt=NT-1-i; const int slot=(i&1)*SLOTB; const bool more=jt>0;
    if(more){DMA_K(jt-1,slot^SLOTB);DMA_V(jt-1,slot^SLOTB); WAIT_BAR(2);} else {WAIT_BAR(0);}
    const bool band=(jt>=NT-4);
    if(!(wdone||(band&&64*(jt-(NT-4))>=QBLK*wid+QBLK))){
    f32x16 x0,x1; { f32x16 zero=f32x16{}; qkt(x0,x1,shm+LDS_K+slot,qr,zero,r32,hi); }
    f32x16 n0,n1;
    const int kb=64*jt+4*hi;
    #pragma unroll
    for(int r=0;r<16;++r){
      const float z0=x0[r],z1=x1[r];
      const float l0=__builtin_amdgcn_logf(1.0f+__builtin_amdgcn_exp2f(-__builtin_fabsf(z0))), l1=__builtin_amdgcn_logf(1.0f+__builtin_amdgcn_exp2f(-__builtin_fabsf(z1)));
      float a0=__builtin_fminf(z0,0.f)-l0, a1=__builtin_fminf(z1,0.f)-l1, m0=__builtin_fminf(-z0,0.f)-l0, m1=__builtin_fminf(-z1,0.f)-l1;
      if(band){ const int kv=kb+(r&3)+8*(r>>2); if(!(kv<t_abs)){a0=-INFINITY;m0=0.f;} if(!(kv+32<t_abs)){a1=-INFINITY;m1=0.f;} }
      x0[r]=a0;x1[r]=a1;n0[r]=m0;n1[r]=m1;
    }
    float g0[4],g1[4],p0s[4],p1s[4];
    #pragma unroll
    for(int a=0;a<4;++a){ g0[a]=(n0[4*a]+n0[4*a+1])+(n0[4*a+2]+n0[4*a+3]); g1[a]=(n1[4*a]+n1[4*a+1])+(n1[4*a+2]+n1[4*a+3]);
      { auto rr=__builtin_amdgcn_permlane32_swap(__float_as_uint(g0[a]),__float_as_uint(g0[a]),false,false); p0s[a]=__uint_as_float(hi?rr[0]:rr[1]); }
      { auto rr=__builtin_amdgcn_permlane32_swap(__float_as_uint(g1[a]),__float_as_uint(g1[a]),false,false); p1s[a]=__uint_as_float(hi?rr[0]:rr[1]); } }
    float run=T;
    #pragma unroll
    for(int a=3;a>=0;--a){ float off=run+(hi?0.f:p1s[a]); run+=g1[a]+p1s[a];
      const float t3=off,t2=t3+n1[4*a+3],t1=t2+n1[4*a+2],t0=t1+n1[4*a+1];
      x1[4*a+3]=__builtin_amdgcn_exp2f(x1[4*a+3]+t3); x1[4*a+2]=__builtin_amdgcn_exp2f(x1[4*a+2]+t2); x1[4*a+1]=__builtin_amdgcn_exp2f(x1[4*a+1]+t1); x1[4*a]=__builtin_amdgcn_exp2f(x1[4*a]+t0); }
    #pragma unroll
    for(int a=3;a>=0;--a){ float off=run+(hi?0.f:p0s[a]); run+=g0[a]+p0s[a];
      const float t3=off,t2=t3+n0[4*a+3],t1=t2+n0[4*a+2],t0=t1+n0[4*a+1];
      x0[4*a+3]=__builtin_amdgcn_exp2f(x0[4*a+3]+t3); x0[4*a+2]=__builtin_amdgcn_exp2f(x0[4*a+2]+t2); x0[4*a+1]=__builtin_amdgcn_exp2f(x0[4*a+1]+t1); x0[4*a]=__builtin_amdgcn_exp2f(x0[4*a]+t0); }
    T=run;
    u32x4 pw0,pw1,pw2,pw3;
    pw0=(u32x4){cvtpk_s(x0[0],x0[1]),cvtpk_s(x0[2],x0[3]),cvtpk_s(x0[4],x0[5]),cvtpk_s(x0[6],x0[7])};
    pw1=(u32x4){cvtpk_s(x0[8],x0[9]),cvtpk_s(x0[10],x0[11]),cvtpk_s(x0[12],x0[13]),cvtpk_s(x0[14],x0[15])};
    pw2=(u32x4){cvtpk_s(x1[0],x1[1]),cvtpk_s(x1[2],x1[3]),cvtpk_s(x1[4],x1[5]),cvtpk_s(x1[6],x1[7])};
    pw3=(u32x4){cvtpk_s(x1[8],x1[9]),cvtpk_s(x1[10],x1[11]),cvtpk_s(x1[12],x1[13]),cvtpk_s(x1[14],x1[15])};
    SBAR(); pv(o,vb0+slot,__builtin_bit_cast(bf16x8,pw0),__builtin_bit_cast(bf16x8,pw1),__builtin_bit_cast(bf16x8,pw2),__builtin_bit_cast(bf16x8,pw3));
    wdone=__all(T<-150.f);
    }
    if(lane==0)flags[wid]=wdone?1:0;
    WAIT_BAR(2);
    const u32x4 f0=*(lds_u4ptr)(flags), f1=*(lds_u4ptr)(flags+4);
    const bool alld=((f0.x&f0.y&f0.z&f0.w)&(f1.x&f1.y&f1.z&f1.w))!=0;
    if(!more||alld)break;
  }
  WAIT_BAR(0);
  bf16*Ow=O+(long)(q0+wid*QBLK)*OPITCH;
  { bf16*stg=(bf16*)(shm+LDS_OST)+wid*2048;
    #pragma unroll
    for(int r=0;r<16;++r){const int orow=crow(r,hi);
      #pragma unroll
      for(int d0=0;d0<2;++d0)stg[orow*64+d0*32+r32]=__float2bfloat16(o[d0][r]);}
    asm volatile("s_waitcnt lgkmcnt(0)":::"memory");
    #pragma unroll
    for(int i=0;i<4;++i){const int row=i*8+(lane>>3),ch=lane&7; const u32x4 v=*(const u32x4*)(stg+row*64+ch*8); ATTN_STORE16(Ow+(long)row*OPITCH+ch*8,v);} }
  asm volatile("s_waitcnt lgkmcnt(0)\n\ts_barrier":::"memory");
  #undef DMA_K
  #undef DMA_V
}
#undef SBAR
#undef WAIT_BAR
}

constexpr int BATCH = 8, SEQ = 4096, DM = 1024, DEPTH = 4, M = BATCH * SEQ, INC = 3334, NIN = 3584, DFF = 4096;
constexpr float EPS = 1e-6f;
constexpr size_t MiB = 1u << 20;
constexpr size_t WS_SS = 1 * MiB;
constexpr size_t WS_LB = 3 * MiB;
constexpr size_t WS_JS = 3 * MiB + 256 * 1024;
constexpr size_t WS_DD = 3 * MiB + 512 * 1024;
constexpr size_t WS_W = 4 * MiB;
constexpr size_t W_LAYER = 25 * MiB, W_OUT = 7 * MiB, W_1 = 9 * MiB, W_2 = 17 * MiB;
constexpr size_t WS_XB = 104 * MiB;
constexpr size_t WS_P = 168 * MiB;
constexpr size_t P_HQ = 0, P_HK = 16 * MiB, P_HI = 32 * MiB, P_HG = 48 * MiB, P_HLF = 64 * MiB, P_SQ = 96 * MiB, P_FQ = 168 * MiB, P_LF = 240 * MiB, P_CC = 241 * MiB, P_US = 242 * MiB;
constexpr size_t HEADBUF = 24 * MiB;
constexpr size_t WS_MIX = 442 * MiB;
constexpr size_t WS_U = 168 * MiB;
constexpr size_t WS_END = 506 * MiB;
constexpr int LDS_BYTES = 147456;

typedef pg8::bf16_t bf16_t;
typedef pg8::f32x4 f32x4;
typedef unsigned u32x4 __attribute__((ext_vector_type(4)));
typedef unsigned u32x2 __attribute__((ext_vector_type(2)));
#define LAS __attribute__((address_space(3)))

__device__ __forceinline__ unsigned f2bf(float f) { unsigned u = __builtin_bit_cast(unsigned, f); return (u + 0x7fffu + ((u >> 16) & 1u)) >> 16; }
__device__ __forceinline__ unsigned pk2(float lo, float hi) { return pg8::cvt_pk_bf16(lo, hi); }
__device__ __forceinline__ float bf2f(unsigned short b) { return __builtin_bit_cast(float, (unsigned)b << 16); }
__device__ __forceinline__ float bflo(unsigned w) { return __builtin_bit_cast(float, w << 16); }
__device__ __forceinline__ float bfhi(unsigned w) { return __builtin_bit_cast(float, w & 0xffff0000u); }
__device__ __forceinline__ float logsig(float x) { return fminf(x, 0.f) - log1pf(expf(-fabsf(x))); }
__device__ __forceinline__ float wave_sum(float v) {
#pragma unroll
    for (int o = 1; o < 64; o <<= 1) v += __shfl_xor(v, o);
    return v;
}
#define ROWSCALES8(rs, ss, row0, fq) float rs[2][4]; _Pragma("unroll") for (int ai_ = 0; ai_ < 2; ++ai_) _Pragma("unroll") for (int m_ = 0; m_ < 4; ++m_) rs[ai_][m_] = rowscale(ss, (row0) + ai_ * 128 + m_ * 16, fq);
__device__ __forceinline__ float rowscale(const float* ss, int row, int fq) {
    const f32x4 p = *(const f32x4*)(ss + (size_t)row * 16 + 4 * fq);
    float s = (p[0] + p[1]) + (p[2] + p[3]);
    s += __shfl_xor(s, 16); s += __shfl_xor(s, 32);
    return rsqrtf(s * (1.0f / DM) + EPS);
}

#define ROWFENCE() asm volatile("" ::: "memory")
struct EpiResid {
    static constexpr bool PERM = true, AFTER_DRAIN = false;
    const float* xold; float* xnew; bf16_t* xb; float* ss;
    __device__ __forceinline__ void operator()(const f32x4 (&acc)[2][2][4][2], const pg8::Unit& u, int wr, int wc, int fr, int fq) const {
        const int row0 = u.pm * 256 + wr * 64 + fr, col0 = u.pn * 256 + wc * 32 + 8 * fq;
#pragma unroll
        for (int ai = 0; ai < 2; ++ai) {
            f32x4 pre[4][2][2];
#pragma unroll
            for (int m = 0; m < 4; ++m)
#pragma unroll
                for (int bj = 0; bj < 2; ++bj) { const size_t off = (size_t)(row0 + ai * 128 + m * 16) * DM + col0 + bj * 128; pre[m][bj][0] = *(const f32x4*)(xold + off); pre[m][bj][1] = *(const f32x4*)(xold + off + 4); }
#pragma unroll
            for (int m = 0; m < 4; ++m) {
                const int row = row0 + ai * 128 + m * 16; float sq = 0.f;
#pragma unroll
                for (int bj = 0; bj < 2; ++bj) {
                    const size_t off = (size_t)row * DM + col0 + bj * 128;
                    const f32x4 v0 = acc[ai][bj][m][0] + pre[m][bj][0], v1 = acc[ai][bj][m][1] + pre[m][bj][1];
                    *(f32x4*)(xnew + off) = v0; *(f32x4*)(xnew + off + 4) = v1;
                    u32x4 w; w.x = pk2(v0[0], v0[1]); w.y = pk2(v0[2], v0[3]); w.z = pk2(v1[0], v1[1]); w.w = pk2(v1[2], v1[3]);
                    *(u32x4*)(xb + off) = w;
                    sq += (v0[0] * v0[0] + v0[1] * v0[1]) + (v0[2] * v0[2] + v0[3] * v0[3]) + (v1[0] * v1[0] + v1[1] * v1[1]) + (v1[2] * v1[2] + v1[3] * v1[3]);
                }
                sq += __shfl_xor(sq, 16); sq += __shfl_xor(sq, 32);
                if (fq == 0) ss[(size_t)row * 16 + u.pn * 4 + wc] = sq;
            }
            ROWFENCE();
        }
    }
};
struct EpiRelu2 {
    static constexpr bool PERM = true, AFTER_DRAIN = false;
    bf16_t* U; const float* ss;
    __device__ __forceinline__ void operator()(const f32x4 (&acc)[2][2][4][2], const pg8::Unit& u, int wr, int wc, int fr, int fq) const {
        const int row0 = u.pm * 256 + wr * 64 + fr, col0 = u.pn * 256 + wc * 32 + 8 * fq;
        ROWSCALES8(rs8, ss, row0, fq)
#pragma unroll
        for (int ai = 0; ai < 2; ++ai)
#pragma unroll
            for (int m = 0; m < 4; ++m) {
                const int row = row0 + ai * 128 + m * 16; const float rs = rs8[ai][m];
#pragma unroll
                for (int bj = 0; bj < 2; ++bj) {
                    f32x4 v0 = acc[ai][bj][m][0] * rs, v1 = acc[ai][bj][m][1] * rs;
                    v0 = __builtin_elementwise_max(v0, (f32x4){0.f, 0.f, 0.f, 0.f}); v1 = __builtin_elementwise_max(v1, (f32x4){0.f, 0.f, 0.f, 0.f});
                    v0 = v0 * v0; v1 = v1 * v1;
                    u32x4 w; w.x = pk2(v0[0], v0[1]); w.y = pk2(v0[2], v0[3]); w.z = pk2(v1[0], v1[1]); w.w = pk2(v1[2], v1[3]);
                    *(u32x4*)(U + (size_t)row * DFF + col0 + bj * 128) = w;
                }
                ROWFENCE();
            }
    }
};
struct EpiInProj {
    static constexpr bool PERM = true, AFTER_DRAIN = false;
    const float* ss; unsigned char* P; const float* lbt;
    const float* gt; const float* fbias;
    __device__ __forceinline__ void operator()(const f32x4 (&acc)[2][2][4][2], const pg8::Unit& u, int wr, int wc, int fr, int fq) const {
        const int slot = u.pn * 4 + wc;
        if (slot > 52) return;
        const int row0 = u.pm * 256 + wr * 64 + fr;
        ROWSCALES8(rs8, ss, row0, fq)
        if (slot < 16) {
            const int kind = slot >> 2, cb = (slot & 3) * 64 + 8 * fq;
            if (kind == 1) {
                float* HLF = (float*)(P + P_HLF); bf16_t* HK = (bf16_t*)(P + P_HK);
#pragma unroll
                for (int ai = 0; ai < 2; ++ai)
#pragma unroll
                    for (int m = 0; m < 4; ++m) {
                        const int row = row0 + ai * 128 + m * 16; const float rs = rs8[ai][m];
#pragma unroll
                        for (int bj = 0; bj < 2; ++bj) {
                            float lf[8], kk[8];
#pragma unroll
                            for (int n = 0; n < 2; ++n) {
                                const f32x4 ll = *(const f32x4*)(lbt + cb + 32 * bj + 4 * n), om = *(const f32x4*)(lbt + 256 + cb + 32 * bj + 4 * n);
#pragma unroll
                                for (int i = 0; i < 4; ++i) {
                                    const float fl = acc[ai][bj][m][n][i] * rs;
                                    const float a = fminf(fl, 0.f) - __logf(1.0f + __expf(-fabsf(fl)));
                                    const float an = a - fl;
                                    const float b = ll[i] + an;
                                    lf[4 * n + i] = fmaxf(a, b) + __logf(1.0f + __expf(-fabsf(a - b)));
                                    kk[4 * n + i] = om[i] * __expf(an);
                                }
                            }
                            const size_t off = (size_t)row * 256 + cb + 32 * bj;
                            *(f32x4*)(HLF + off) = (f32x4){lf[0], lf[1], lf[2], lf[3]}; *(f32x4*)(HLF + off + 4) = (f32x4){lf[4], lf[5], lf[6], lf[7]};
                            u32x4 w; w.x = pk2(kk[0], kk[1]); w.y = pk2(kk[2], kk[3]); w.z = pk2(kk[4], kk[5]); w.w = pk2(kk[6], kk[7]);
                            *(u32x4*)(HK + off) = w;
                        }
                        ROWFENCE();
                    }
            } else {
                bf16_t* dst = (bf16_t*)(P + (kind == 0 ? P_HQ : (kind == 2 ? P_HI : P_HG)));
#pragma unroll
                for (int ai = 0; ai < 2; ++ai)
#pragma unroll
                    for (int m = 0; m < 4; ++m) {
                        const int row = row0 + ai * 128 + m * 16; const float rs = rs8[ai][m];
#pragma unroll
                        for (int bj = 0; bj < 2; ++bj) {
                            const f32x4 v0 = acc[ai][bj][m][0] * rs, v1 = acc[ai][bj][m][1] * rs;
                            u32x4 w; w.x = pk2(v0[0], v0[1]); w.y = pk2(v0[2], v0[3]); w.z = pk2(v1[0], v1[1]); w.w = pk2(v1[2], v1[3]);
                            *(u32x4*)(dst + (size_t)row * 256 + cb + 32 * bj) = w;
                        }
                        ROWFENCE();
                    }
            }
        } else if (slot < 52) {
            const int s2 = slot - 16, grp = s2 / 6, h = s2 % 6, role = grp % 3;
            bf16_t* dst = (bf16_t*)(P + P_SQ + (size_t)grp * HEADBUF) + (size_t)((u.pm >> 4) * 6 + h) * SEQ * 64 + 8 * fq;
            const float* gp = gt + (grp - (grp >= 3 ? 1 : 0)) * 64 + 8 * fq;
            const float qs = (role == 0) ? 0.125f * 1.4426950408889634f : 1.0f;
#pragma unroll
            for (int ai = 0; ai < 2; ++ai)
#pragma unroll
                for (int m = 0; m < 4; ++m) {
                    const int row = row0 + ai * 128 + m * 16; const float rs = rs8[ai][m];
                    float fac = rs;
                    if (role != 2) {
                        float sq = 0.f;
#pragma unroll
                        for (int bj = 0; bj < 2; ++bj)
#pragma unroll
                            for (int n = 0; n < 2; ++n) { const f32x4 x = acc[ai][bj][m][n]; sq += (x[0] * x[0] + x[1] * x[1]) + (x[2] * x[2] + x[3] * x[3]); }
                        sq += __shfl_xor(sq, 16); sq += __shfl_xor(sq, 32);
                        fac = rs * rsqrtf(rs * rs * sq * (1.0f / 64.0f) + EPS) * qs;
                    }
                    const int t = row & (SEQ - 1);
#pragma unroll
                    for (int bj = 0; bj < 2; ++bj) {
                        f32x4 v0 = acc[ai][bj][m][0] * fac, v1 = acc[ai][bj][m][1] * fac;
                        if (role != 2) { v0 = v0 * *(const f32x4*)(gp + 32 * bj); v1 = v1 * *(const f32x4*)(gp + 32 * bj + 4); }
                        u32x4 w; w.x = pk2(v0[0], v0[1]); w.y = pk2(v0[2], v0[3]); w.z = pk2(v1[0], v1[1]); w.w = pk2(v1[2], v1[3]);
                        *(u32x4*)(dst + (size_t)t * 64 + 32 * bj) = w;
                    }
                    ROWFENCE();
                }
        } else {
            float* LF = (float*)(P + P_LF);
#pragma unroll
            for (int ai = 0; ai < 2; ++ai)
#pragma unroll
                for (int m = 0; m < 4; ++m) {
                    const int row = row0 + ai * 128 + m * 16; const float rs = rs8[ai][m];
                    if (fq == 0) {
                        const f32x4 a0 = acc[ai][0][m][0], a1 = acc[ai][0][m][1];
                        *(f32x4*)(LF + (size_t)row * 8) = (f32x4){logsig(a0[0] * rs + fbias[0]), logsig(a0[1] * rs + fbias[1]), logsig(a0[2] * rs + fbias[2]), logsig(a0[3] * rs + fbias[3])};
                        *(f32x4*)(LF + (size_t)row * 8 + 4) = (f32x4){logsig(a1[0] * rs + fbias[4]), logsig(a1[1] * rs + fbias[5]), 0.f, 0.f};
                    }
                    ROWFENCE();
                }
        }
    }
};

__device__ __forceinline__ void tr_item(const float* W, int ldw, int ncols_valid, int src_col0, int k0, const float* gain, bf16_t* WT, int K, int n0, LAS float* scr, int lane) {
#pragma unroll 8
    for (int i = 0; i < 32; ++i) { const int kk = 2 * i + (lane >> 5), c = src_col0 + (lane & 31);
        float v = (c < ncols_valid) ? W[(size_t)(k0 + kk) * ldw + c] : 0.f; if (gain) v *= gain[k0 + kk]; scr[kk * 33 + (lane & 31)] = v; }
    asm volatile("s_waitcnt lgkmcnt(0)" ::: "memory");
    const int c = lane & 7;
#pragma unroll
    for (int j = 0; j < 4; ++j) { const int n = (lane >> 3) + 8 * j; const LAS float* s = scr + (8 * c) * 33 + n;
        u32x4 o; o.x = pk2(s[0 * 33], s[1 * 33]); o.y = pk2(s[2 * 33], s[3 * 33]); o.z = pk2(s[4 * 33], s[5 * 33]); o.w = pk2(s[6 * 33], s[7 * 33]);
        *(u32x4*)(WT + (size_t)(n0 + n) * K + k0 + 8 * c) = o; }
    asm volatile("s_waitcnt lgkmcnt(0)" ::: "memory");
}

__device__ __forceinline__ void unpack8(const u32x4 w, float* d) { d[0] = bflo(w.x); d[1] = bfhi(w.x); d[2] = bflo(w.y); d[3] = bfhi(w.y); d[4] = bflo(w.z); d[5] = bfhi(w.z); d[6] = bflo(w.w); d[7] = bfhi(w.w); }

__device__ __forceinline__ void fox_cumsum_item(int bh, const float* LF, float* CC, int* JS, const float* gq, const float* gk, LAS float* sc) {
    int tid_ = threadIdx.x; asm volatile("" : "+v"(tid_)); const int tid = tid_, lane = tid & 63, wave = tid >> 6, b = bh / 6, h = bh % 6;
    float v[8]; float run = 0.f;
#pragma unroll
    for (int i = 0; i < 8; ++i) { run += LF[((size_t)b * SEQ + tid * 8 + i) * 8 + h]; v[i] = run; }
    float s = run;
#pragma unroll
    for (int o = 1; o < 64; o <<= 1) { const float n = __shfl_up(s, o); if (lane >= o) s += n; }
    __syncthreads();
    if (lane == 63) sc[wave] = s;
    __syncthreads();
    float base = s - run;
    for (int w = 0; w < wave; ++w) base += sc[w];
    LAS float* cl = sc + 64;
#pragma unroll
    for (int i = 0; i < 8; ++i) { const float c2 = (v[i] + base) * 1.4426950408889634f; CC[(size_t)bh * SEQ + tid * 8 + i] = c2; cl[tid * 8 + i] = c2; }
    __syncthreads();
    if (tid < 16) {
        float mq = 0.f, mk = 0.f;
        for (int d = 0; d < 64; ++d) { mq = fmaxf(mq, fabsf(gq[d])); mk = fmaxf(mk, fabsf(gk[d])); }
        const float zb = 1.4426950408889634f * 8.0f * mq * mk * 1.03f + 1.0f;
        const float thr = -(150.0f + 2.0f * zb);
        const int q0 = tid * 256, nt = q0 / 64 + 4; const float cq = cl[q0];
        int j = 0; while (j < nt - 4 && cq - cl[64 * j + 63] < thr) ++j;
        JS[bh * 16 + tid] = j & ~1;
    }
    __syncthreads();
}

__device__ __forceinline__ void stage_kv(const bf16_t* Kb, const bf16_t* Vb, int kt, LAS float* Kf, LAS float* Vf) {
    int tid_ = threadIdx.x; asm volatile("" : "+v"(tid_)); const int tid = tid_, key = tid >> 3, c8 = tid & 7;
    const u32x4 kw = *(const u32x4*)(Kb + ((size_t)(kt * 64 + key)) * 64 + c8 * 8), vw = *(const u32x4*)(Vb + ((size_t)(kt * 64 + key)) * 64 + c8 * 8);
    float kf[8], vf[8]; unpack8(kw, kf); unpack8(vw, vf);
    *(LAS f32x4*)(Kf + key * 64 + c8 * 8) = (f32x4){kf[0], kf[1], kf[2], kf[3]}; *(LAS f32x4*)(Kf + key * 64 + c8 * 8 + 4) = (f32x4){kf[4], kf[5], kf[6], kf[7]};
    *(LAS f32x4*)(Vf + key * 64 + c8 * 8) = (f32x4){vf[0], vf[1], vf[2], vf[3]}; *(LAS f32x4*)(Vf + key * 64 + c8 * 8 + 4) = (f32x4){vf[4], vf[5], vf[6], vf[7]};
}

__device__ __forceinline__ void fox_naive_item(int item, unsigned char* P, bf16_t* MIX, LAS float* lds) {
    int tid_ = threadIdx.x; asm volatile("" : "+v"(tid_)); const int tid = tid_, bh = item >> 3, qblk = item & 7, b = bh / 6, h = bh % 6, t = qblk * 512 + tid;
    const bf16_t* Qp = (const bf16_t*)(P + P_FQ) + ((size_t)bh * SEQ + t) * 64;
    const bf16_t* Kb = (const bf16_t*)(P + P_FQ + HEADBUF) + (size_t)bh * SEQ * 64;
    const bf16_t* Vb = (const bf16_t*)(P + P_FQ + 2 * HEADBUF) + (size_t)bh * SEQ * 64;
    const float* CC = (const float*)(P + P_CC) + (size_t)bh * SEQ;
    float q[64], o[64];
#pragma unroll
    for (int c = 0; c < 8; ++c) unpack8(*(const u32x4*)(Qp + c * 8), q + c * 8);
#pragma unroll
    for (int d = 0; d < 64; ++d) o[d] = 0.f;
    float m = -1e30f, l = 0.f; const float ct = CC[t];
    LAS float* Kf = lds; LAS float* Vf = lds + 4096; LAS float* cs = lds + 8192;
    const int ntile = (qblk + 1) * 8;
    for (int kt = 0; kt < ntile; ++kt) {
        __syncthreads();
        stage_kv(Kb, Vb, kt, Kf, Vf); if (tid < 64) cs[tid] = CC[kt * 64 + tid];
        __syncthreads();
        for (int s = 0; s < 64; ++s) {
            float z = 0.f;
#pragma unroll
            for (int d = 0; d < 64; ++d) z += q[d] * Kf[s * 64 + d];
            const float x = (kt * 64 + s <= t) ? z + (ct - cs[s]) : -1e30f;
            const float mn = fmaxf(m, x), sc = __expf(m - mn), p = __expf(x - mn);
            l = l * sc + p;
#pragma unroll
            for (int d = 0; d < 64; ++d) o[d] = o[d] * sc + p * Vf[s * 64 + d];
            m = mn;
        }
    }
    const float inv = 1.0f / l;
    bf16_t* op = MIX + ((size_t)b * SEQ + t) * DM + 640 + h * 64;
#pragma unroll
    for (int c = 0; c < 8; ++c) { u32x4 w; w.x = pk2(o[c * 8] * inv, o[c * 8 + 1] * inv); w.y = pk2(o[c * 8 + 2] * inv, o[c * 8 + 3] * inv); w.z = pk2(o[c * 8 + 4] * inv, o[c * 8 + 5] * inv); w.w = pk2(o[c * 8 + 6] * inv, o[c * 8 + 7] * inv); *(u32x4*)(op + c * 8) = w; }
}

__device__ __forceinline__ void sb_naive_item(int item, unsigned char* P, bf16_t* MIX, LAS float* lds) {
    int tid_ = threadIdx.x; asm volatile("" : "+v"(tid_)); const int tid = tid_, bh = item >> 3, qblk = item & 7, b = bh / 6, h = bh % 6, t = qblk * 512 + tid;
    const bf16_t* Qp = (const bf16_t*)(P + P_SQ) + ((size_t)bh * SEQ + t) * 64;
    const bf16_t* Kb = (const bf16_t*)(P + P_SQ + HEADBUF) + (size_t)bh * SEQ * 64;
    const bf16_t* Vb = (const bf16_t*)(P + P_SQ + 2 * HEADBUF) + (size_t)bh * SEQ * 64;
    float q[64], o[64];
#pragma unroll
    for (int c = 0; c < 8; ++c) unpack8(*(const u32x4*)(Qp + c * 8), q + c * 8);
#pragma unroll
    for (int d = 0; d < 64; ++d) o[d] = 0.f;
    float tail = 0.f;
    LAS float* Kf = lds; LAS float* Vf = lds + 4096;
    for (int kt = qblk * 8 + 7; kt >= 0; --kt) {
        __syncthreads();
        stage_kv(Kb, Vb, kt, Kf, Vf);
        __syncthreads();
        for (int s = 63; s >= 0; --s) {
            float z = 0.f;
#pragma unroll
            for (int d = 0; d < 64; ++d) z += q[d] * Kf[s * 64 + d];
            const float ls = fminf(z, 0.f) - __logf(1.0f + __expf(-fabsf(z)));
            const bool act = (kt * 64 + s) < t;
            const float A = act ? __expf(ls + tail) : 0.f;
#pragma unroll
            for (int d = 0; d < 64; ++d) o[d] += A * Vf[s * 64 + d];
            tail += act ? (ls - z) : 0.f;
        }
        if (__syncthreads_and(tail < -100.f)) break;
    }
    bf16_t* op = MIX + ((size_t)b * SEQ + t) * DM + 256 + h * 64;
#pragma unroll
    for (int c = 0; c < 8; ++c) { u32x4 w; w.x = pk2(o[c * 8], o[c * 8 + 1]); w.y = pk2(o[c * 8 + 2], o[c * 8 + 3]); w.z = pk2(o[c * 8 + 4], o[c * 8 + 5]); w.w = pk2(o[c * 8 + 6], o[c * 8 + 7]); *(u32x4*)(op + c * 8) = w; }
}

__device__ __forceinline__ void hgrn_naive_item(int item, unsigned char* P, bf16_t* MIX, const float* hgn, LAS float* lds) {
    int tid_ = threadIdx.x; asm volatile("" : "+v"(tid_)); const int tid = tid_, lane = tid & 63, w = tid >> 6, kg = lane >> 3, vi = lane & 7, vcol = 8 * w + vi, b = item >> 2, h = item & 3;
    const bf16_t* HQ = (const bf16_t*)(P + P_HQ); const bf16_t* HK = (const bf16_t*)(P + P_HK); const bf16_t* HI = (const bf16_t*)(P + P_HI); const bf16_t* HG = (const bf16_t*)(P + P_HG);
    const float* HLF = (const float*)(P + P_HLF);
    LAS float* qf = lds; LAS float* kf = lds + 4096; LAS float* ff = lds + 8192; LAS float* vf = lds + 12288; LAS float* ob = lds + 16384;
    float S[8];
#pragma unroll
    for (int j = 0; j < 8; ++j) S[j] = 0.f;
    const int tok = tid >> 3, c8 = tid & 7;
    float gn[8];
#pragma unroll
    for (int e = 0; e < 8; ++e) gn[e] = hgn[c8 * 8 + e];
    for (int c = 0; c < 64; ++c) {
        const size_t off = ((size_t)b * SEQ + c * 64 + tok) * 256 + h * 64 + c8 * 8;
        __syncthreads();
        {
            float a[8];
            unpack8(*(const u32x4*)(HQ + off), a);
#pragma unroll
            for (int e = 0; e < 8; ++e) qf[tok * 64 + c8 * 8 + e] = a[e];
            unpack8(*(const u32x4*)(HK + off), a);
#pragma unroll
            for (int e = 0; e < 8; ++e) kf[tok * 64 + c8 * 8 + e] = a[e];
            unpack8(*(const u32x4*)(HI + off), a);
#pragma unroll
            for (int e = 0; e < 8; ++e) vf[tok * 64 + c8 * 8 + e] = a[e];
            const f32x4 l0 = *(const f32x4*)(HLF + off), l1 = *(const f32x4*)(HLF + off + 4);
#pragma unroll
            for (int e = 0; e < 4; ++e) { ff[tok * 64 + c8 * 8 + e] = expf(l0[e]); ff[tok * 64 + c8 * 8 + 4 + e] = expf(l1[e]); }
        }
        __syncthreads();
        for (int tk = 0; tk < 64; ++tk) {
            const float vv = vf[tk * 64 + vcol]; float op = 0.f;
#pragma unroll
            for (int j = 0; j < 8; ++j) { const int k = 8 * kg + j; S[j] = ff[tk * 64 + k] * S[j] + kf[tk * 64 + k] * vv; op += qf[tk * 64 + k] * S[j]; }
            op += __shfl_xor(op, 8); op += __shfl_xor(op, 16); op += __shfl_xor(op, 32);
            if (kg == 0) ob[tk * 64 + vcol] = op;
        }
        __syncthreads();
        {
            float ov[8], g[8]; float sq = 0.f;
#pragma unroll
            for (int e = 0; e < 8; ++e) { ov[e] = ob[tok * 64 + c8 * 8 + e]; sq += ov[e] * ov[e]; }
            sq += __shfl_xor(sq, 1); sq += __shfl_xor(sq, 2); sq += __shfl_xor(sq, 4);
            const float rn = rsqrtf(sq * (1.0f / 64.0f) + EPS);
            unpack8(*(const u32x4*)(HG + off), g);
            float r[8];
#pragma unroll
            for (int e = 0; e < 8; ++e) r[e] = ov[e] * rn * gn[e] * (g[e] / (1.0f + expf(-g[e])));
            u32x4 wv; wv.x = pk2(r[0], r[1]); wv.y = pk2(r[2], r[3]); wv.z = pk2(r[4], r[5]); wv.w = pk2(r[6], r[7]);
            *(u32x4*)(MIX + ((size_t)b * SEQ + c * 64 + tok) * DM + h * 64 + c8 * 8) = wv;
        }
    }
}

constexpr int HG_SLOT = 32768, HG_PRE = 16384, HG_TOT = 16384 + 1280, HG_VT = 20480, HG_VP = 72;
typedef short hbf16x8 __attribute__((ext_vector_type(8)));
typedef short hbf16x4 __attribute__((ext_vector_type(4)));
__device__ __forceinline__ hbf16x8 pack8(const float* x) { u32x4 w; w.x = pk2(x[0], x[1]); w.y = pk2(x[2], x[3]); w.z = pk2(x[4], x[5]); w.w = pk2(x[6], x[7]); return __builtin_bit_cast(hbf16x8, w); }

__device__ __forceinline__ void hg_stage(int tid, size_t row0, int h, const float* HLF, const bf16_t* HI, LAS unsigned char* sb) {
    const int lt = tid & 255, k = lt & 63, seg = lt >> 6;
    LAS float* bl = (LAS float*)sb; LAS float* pre = (LAS float*)(sb + HG_PRE); LAS float* tot = (LAS float*)(sb + HG_TOT); LAS bf16_t* vt = (LAS bf16_t*)(sb + HG_VT);
    float run = 0.f;
#pragma unroll
    for (int i = 0; i < 16; ++i) { const int t = 16 * seg + i; run += HLF[(row0 + t) * 256 + h * 64 + k]; bl[t * 64 + k] = run; }
    tot[seg * 64 + k] = run;
    {
        const int s = lt >> 2, c0 = (lt & 3) * 16;
        const u32x4 w0 = *(const u32x4*)(HI + (row0 + s) * 256 + h * 64 + c0), w1 = *(const u32x4*)(HI + (row0 + s) * 256 + h * 64 + c0 + 8);
        const unsigned ww[8] = {w0.x, w0.y, w0.z, w0.w, w1.x, w1.y, w1.z, w1.w};
#pragma unroll
        for (int e = 0; e < 8; ++e) { vt[(c0 + 2 * e) * HG_VP + s] = (bf16_t)(ww[e] & 0xffffu); vt[(c0 + 2 * e + 1) * HG_VP + s] = (bf16_t)(ww[e] >> 16); }
    }
    __syncthreads();
    if (lt < 64) { float p = 0.f;
#pragma unroll
        for (int sg = 0; sg < 4; ++sg) { pre[sg * 64 + lt] = p; p += tot[sg * 64 + lt]; }
        pre[4 * 64 + lt] = p; }
    __syncthreads();
}

__device__ __forceinline__ void hgrn_a_item(int item, unsigned char* P, float* DD, LAS unsigned char* L) {
    int tid_ = threadIdx.x; asm volatile("" : "+v"(tid_)); const int tid = tid_, lane = tid & 63, wq = (tid >> 6) & 3, cs = tid >> 8, r = lane & 15, g = lane >> 4;
    const int bh = item >> 5, chunk = (item & 31) * 2 + cs, b = bh >> 2, h = bh & 3;
    const size_t row0 = (size_t)b * SEQ + chunk * 64;
    const bf16_t* HK = (const bf16_t*)(P + P_HK); float* UT = (float*)(P + P_US);
    LAS unsigned char* sb = L + cs * HG_SLOT;
    hg_stage(tid, row0, h, (const float*)(P + P_HLF), (const bf16_t*)(P + P_HI), sb);
    const LAS float* bl = (const LAS float*)sb; const LAS float* pre = (const LAS float*)(sb + HG_PRE); const LAS unsigned char* vt = sb + HG_VT;
    const int k = 16 * wq + r; const float pre4 = pre[4 * 64 + k];
    hbf16x8 af[2];
#pragma unroll
    for (int ks = 0; ks < 2; ++ks) { const float pj = pre4 - pre[(2 * ks + (g >> 1)) * 64 + k]; float x[8];
#pragma unroll
        for (int j = 0; j < 8; ++j) { const int s = 32 * ks + 8 * g + j; x[j] = bf2f(HK[(row0 + s) * 256 + h * 64 + k]) * __expf(pj - bl[s * 64 + k]); }
        af[ks] = pack8(x); }
    float* ut = UT + ((size_t)(bh * 64 + chunk) * 64) * 64;
#pragma unroll
    for (int vtile = 0; vtile < 4; ++vtile) { f32x4 acc = {0.f, 0.f, 0.f, 0.f};
#pragma unroll
        for (int ks = 0; ks < 2; ++ks) { const hbf16x8 bf = *(const LAS hbf16x8*)(vt + (16 * vtile + r) * (HG_VP * 2) + (32 * ks + 8 * g) * 2); acc = __builtin_amdgcn_mfma_f32_16x16x32_bf16(af[ks], bf, acc, 0, 0, 0); }
        *(f32x4*)(ut + (size_t)(16 * vtile + r) * 64 + 16 * wq + 4 * g) = acc; }
    if (g == 0) DD[(size_t)(bh * 64 + chunk) * 64 + k] = __expf(pre4);
}

__device__ __forceinline__ void hgrn_b_scan(int bx, int G, unsigned char* P, const float* DD) {
    int tid_ = threadIdx.x; asm volatile("" : "+v"(tid_));
    float* UT = (float*)(P + P_US);
    for (int gid = bx * 512 + tid_; gid < 32 * 4096; gid += G * 512) {
        const int bh = gid >> 12, e = gid & 4095; float* u = UT + (size_t)bh * 64 * 4096 + e; const float* dd = DD + (size_t)bh * 64 * 64 + (e & 63);
        float S = 0.f;
        for (int c0 = 0; c0 < 64; c0 += 8) { float tu[8], td[8];
#pragma unroll
            for (int i = 0; i < 8; ++i) { tu[i] = u[(size_t)(c0 + i) * 4096]; td[i] = dd[(c0 + i) * 64]; }
#pragma unroll
            for (int i = 0; i < 8; ++i) { u[(size_t)(c0 + i) * 4096] = S; S = td[i] * S + tu[i]; } }
    }
}

__device__ __forceinline__ void hgrn_c_item(int item, unsigned char* P, bf16_t* MIX, const float* hgn, LAS unsigned char* L) {
    int tid_ = threadIdx.x; asm volatile("" : "+v"(tid_)); const int tid = tid_, lane = tid & 63, I = (tid >> 6) & 3, cs = tid >> 8, r = lane & 15, g = lane >> 4;
    const int bh = item >> 5, chunk = (item & 31) * 2 + cs, b = bh >> 2, h = bh & 3;
    const size_t row0 = (size_t)b * SEQ + chunk * 64;
    const bf16_t* HQ = (const bf16_t*)(P + P_HQ); const bf16_t* HK = (const bf16_t*)(P + P_HK); const bf16_t* HG = (const bf16_t*)(P + P_HG); const float* ST = (const float*)(P + P_US);
    LAS unsigned char* sb = L + cs * HG_SLOT;
    hg_stage(tid, row0, h, (const float*)(P + P_HLF), (const bf16_t*)(P + P_HI), sb);
    const LAS float* bl = (const LAS float*)sb; const LAS float* pre = (const LAS float*)(sb + HG_PRE); const LAS unsigned char* vt = sb + HG_VT;
    const int t = 16 * I + r;
    hbf16x8 qtf[2], qhf[2];
#pragma unroll
    for (int ks = 0; ks < 2; ++ks) { const int kb = 32 * ks + 8 * g; float q[8], xt[8], xh[8];
        unpack8(*(const u32x4*)(HQ + (row0 + t) * 256 + h * 64 + kb), q);
#pragma unroll
        for (int j = 0; j < 8; ++j) { xt[j] = q[j] * __expf(bl[t * 64 + kb + j]); xh[j] = xt[j] * __expf(pre[I * 64 + kb + j]); }
        qtf[ks] = pack8(xt); qhf[ks] = pack8(xh); }
    f32x4 at[4];
#pragma unroll
    for (int J = 0; J < 4; ++J) { at[J] = (f32x4){0.f, 0.f, 0.f, 0.f};
        if (J <= I) { const int s = 16 * J + r;
#pragma unroll
            for (int ks = 0; ks < 2; ++ks) { const int kb = 32 * ks + 8 * g; float kk[8], x[8];
                unpack8(*(const u32x4*)(HK + (row0 + s) * 256 + h * 64 + kb), kk);
#pragma unroll
                for (int j = 0; j < 8; ++j) x[j] = kk[j] * __expf(fminf(pre[I * 64 + kb + j] - pre[J * 64 + kb + j] - bl[s * 64 + kb + j], 80.f));
                at[J] = __builtin_amdgcn_mfma_f32_16x16x32_bf16(pack8(x), qtf[ks], at[J], 0, 0, 0); }
            if (J == I) {
#pragma unroll
                for (int i = 0; i < 4; ++i) at[J][i] = (4 * g + i <= r) ? at[J][i] : 0.f; } } }
    hbf16x8 pf[2];
#pragma unroll
    for (int k2 = 0; k2 < 2; ++k2) { const float x[8] = {at[2 * k2][0], at[2 * k2][1], at[2 * k2][2], at[2 * k2][3], at[2 * k2 + 1][0], at[2 * k2 + 1][1], at[2 * k2 + 1][2], at[2 * k2 + 1][3]}; pf[k2] = pack8(x); }
    const float* st = ST + ((size_t)(bh * 64 + chunk) * 64) * 64;
    f32x4 o[4];
#pragma unroll
    for (int vtile = 0; vtile < 4; ++vtile) { f32x4 acc = {0.f, 0.f, 0.f, 0.f}; const int v = 16 * vtile + r;
#pragma unroll
        for (int ks = 0; ks < 2; ++ks) { const float* sp = st + (size_t)v * 64 + 32 * ks + 8 * g; const f32x4 s0 = *(const f32x4*)sp, s1 = *(const f32x4*)(sp + 4);
            const float x[8] = {s0[0], s0[1], s0[2], s0[3], s1[0], s1[1], s1[2], s1[3]};
            acc = __builtin_amdgcn_mfma_f32_16x16x32_bf16(qhf[ks], pack8(x), acc, 0, 0, 0); }
#pragma unroll
        for (int k2 = 0; k2 < 2; ++k2) { if (k2 == 0 || I >= 2) {
            const hbf16x4 v0 = *(const LAS hbf16x4*)(vt + v * (HG_VP * 2) + (32 * k2 + 4 * g) * 2), v1 = *(const LAS hbf16x4*)(vt + v * (HG_VP * 2) + (32 * k2 + 16 + 4 * g) * 2);
            const hbf16x8 vf = {v0[0], v0[1], v0[2], v0[3], v1[0], v1[1], v1[2], v1[3]};
            acc = __builtin_amdgcn_mfma_f32_16x16x32_bf16(pf[k2], vf, acc, 0, 0, 0); } }
        o[vtile] = acc; }
#pragma unroll
    for (int i = 0; i < 4; ++i) { float sq = 0.f;
#pragma unroll
        for (int vtile = 0; vtile < 4; ++vtile) sq += o[vtile][i] * o[vtile][i];
        sq += __shfl_xor(sq, 1); sq += __shfl_xor(sq, 2); sq += __shfl_xor(sq, 4); sq += __shfl_xor(sq, 8);
        const float rn = rsqrtf(sq * (1.0f / 64.0f) + EPS); const size_t row = row0 + 16 * I + 4 * g + i;
#pragma unroll
        for (int vtile = 0; vtile < 4; ++vtile) { const int v = 16 * vtile + r; const float gg = bf2f(HG[row * 256 + h * 64 + v]);
            MIX[row * DM + h * 64 + v] = (bf16_t)f2bf(o[vtile][i] * rn * hgn[v] * (gg / (1.0f + __expf(-gg)))); } }
}

struct Args { const float* in[14]; float* out; unsigned char* ws; int ph_lo, ph_hi; };
constexpr int NPHASE = 1 + 7 * DEPTH;

__global__ void __launch_bounds__(512, 2) fwd(Args a) {
    extern __shared__ __attribute__((aligned(16))) unsigned char lds[];
    cg::grid_group grid = cg::this_grid();
    LAS unsigned char* L = (LAS unsigned char*)lds;
    for (int ph = a.ph_lo; ph < a.ph_hi; ++ph) {
        int G = gridDim.x, bx = blockIdx.x; asm volatile("" : "+s"(G), "+s"(bx));
        typedef const __attribute__((address_space(4))) Args* KArgP;
        KArgP ap = (KArgP)__builtin_amdgcn_kernarg_segment_ptr(); asm volatile("" : "+s"(ap));
        unsigned char* ws = ap->ws;
        float* SS = (float*)(ws + WS_SS); float* LB = (float*)(ws + WS_LB);
        bf16_t* XB = (bf16_t*)(ws + WS_XB); bf16_t* MIX = (bf16_t*)(ws + WS_MIX); bf16_t* UB = (bf16_t*)(ws + WS_U);
        unsigned char* P = ws + WS_P;
#ifdef PROBE_T
        if (ph == NPHASE) {
            if (bx == 0) { const unsigned long long* ts_ = (const unsigned long long*)(ws + 65536); unsigned long long sa = 0, sb = 0;
                for (int p = 1; p < NPHASE; ++p) { const int kk_ = (p - 1) % 7; const unsigned long long d = ts_[p] - ts_[p - 1]; if (PROBE_A(kk_)) sa += d; if (PROBE_B(kk_)) sb += d; }
                const float fa = (float)sa * 1e-3f, fb = (float)sb * 1e-3f; float* o_ = ap->out;
                for (int i = threadIdx.x; i < (1 << 20); i += 512) o_[(1 << 20) + i] += fb;
                if (threadIdx.x == 0) o_[0] = fa; }
        } else
#endif
        if (ph == 0) {
            int tid = threadIdx.x; asm volatile("" : "+v"(tid)); const int lane = tid & 63, wave = __builtin_amdgcn_readfirstlane(tid >> 6);
            LAS float* scr = (LAS float*)(L + wave * 16384);
            const int gw = bx * 8 + wave, NGW = G * 8;
            constexpr int I_IN = 16 * 112, I_OUT = 16 * 32, I_1 = 16 * 128, I_2 = 64 * 32, I_L = I_IN + I_OUT + I_1 + I_2;
            for (int it = gw; it < DEPTH * I_L; it += NGW) {
                const int l = it / I_L; int r = it % I_L;
                unsigned char* wl = ws + WS_W + (size_t)l * W_LAYER;
                if (r < I_IN) { const int kb = r / 112, nb = r % 112, n0 = nb * 32, pn = n0 >> 8, p = n0 & 255, slot = 4 * pn + ((p & 127) >> 5), sc0 = 64 * slot + 32 * (p >> 7);
                    tr_item(ap->in[3] + (size_t)l * DM * INC, INC, INC, sc0, kb * 64, ap->in[2] + l * DM, (bf16_t*)wl, DM, n0, scr, lane); continue; }
                r -= I_IN;
                if (r < I_OUT) { const int kb = r / 32, nb = r % 32; tr_item(ap->in[10] + (size_t)l * DM * DM, DM, DM, nb * 32, kb * 64, nullptr, (bf16_t*)(wl + W_OUT), DM, nb * 32, scr, lane); continue; }
                r -= I_OUT;
                if (r < I_1) { const int kb = r / 128, nb = r % 128; tr_item(ap->in[12] + (size_t)l * DM * DFF, DFF, DFF, nb * 32, kb * 64, ap->in[11] + l * DM, (bf16_t*)(wl + W_1), DM, nb * 32, scr, lane); continue; }
                r -= I_1;
                { const int kb = r / 32, nb = r % 32; tr_item(ap->in[13] + (size_t)l * DFF * DM, DM, DM, nb * 32, kb * 64, nullptr, (bf16_t*)(wl + W_2), DFF, nb * 32, scr, lane); }
            }
            const float* x = ap->in[0];
            for (int m = gw; m < M; m += NGW) {
                const f32x4* xr = (const f32x4*)(x + (size_t)m * DM) + lane; f32x4 v[4]; float s = 0.f;
#pragma unroll
                for (int j = 0; j < 4; ++j) { v[j] = xr[64 * j]; s += (v[j][0] * v[j][0] + v[j][1] * v[j][1]) + (v[j][2] * v[j][2] + v[j][3] * v[j][3]); }
                const float tot = wave_sum(s);
                u32x2* o8 = (u32x2*)(XB + (size_t)m * DM) + lane;
#pragma unroll
                for (int j = 0; j < 4; ++j) { u32x2 w; w.x = pk2(v[j][0], v[j][1]); w.y = pk2(v[j][2], v[j][3]); o8[64 * j] = w; }
                if (lane < 16) SS[(size_t)m * 16 + lane] = (lane == 0) ? tot : 0.f;
            }
            if (bx == 2 && tid < 64) ((unsigned*)ws)[tid] = 0u;
            if (bx == 1) {
                for (int i = tid; i < 1024; i += 512) { const int l = i >> 8, wh = (i >> 6) & 3, d = i & 63; LB[2048 + i] = ap->in[5 + wh][l * 64 + d]; }
                if (tid < 32) { const int l = tid >> 3, e = tid & 7; LB[3072 + tid] = (e < 6) ? ap->in[9][l * 6 + e] : 0.f; }
            }
            if (bx == 0 && tid < 256) {
                const float* lg = ap->in[1]; float e[DEPTH]; float mx = -1e30f, sum = 0.f;
#pragma unroll
                for (int l = 0; l < DEPTH; ++l) mx = fmaxf(mx, lg[l * 256 + tid]);
#pragma unroll
                for (int l = 0; l < DEPTH; ++l) { e[l] = expf(lg[l * 256 + tid] - mx); sum += e[l]; }
                float c = 0.f;
#pragma unroll
                for (int l = 0; l < DEPTH; ++l) { if (l > 0) c += e[l] / sum; LB[l * 512 + tid] = logf(fmaxf(c, 1e-30f)); LB[l * 512 + 256 + tid] = 1.0f - c; }
            }
        } else {
            const int l = (ph - 1) / 7, k = (ph - 1) % 7;
#ifdef REP_K
            const int nrep = (k == REP_K) ? 2 : 1;
#else
            const int nrep = 1;
#endif
            for (int rep = 0; rep < nrep; ++rep) {
            if (rep) grid.sync();
            unsigned char* wl = ws + WS_W + (size_t)l * W_LAYER;
            if (k == 0) {
                pg8::Gemm g{XB, (const bf16_t*)wl, M, NIN, DM}; pg8::StaticOrder S; S.init(M, NIN, G, bx);
                EpiInProj E{SS, P, LB + l * 512, LB + 2048 + l * 256, LB + 3072 + l * 8};
                pg8::gemm_phase<EpiInProj, pg8::StaticOrder, true, true>(L, g, S, E);
            } else if (k == 1) {
                int tid = threadIdx.x; asm volatile("" : "+v"(tid));
                unsigned* ctr = (unsigned*)ws + l * 16 + 1 + rep * 4;
                volatile LAS int* sh = (volatile LAS int*)(L + LDS_BYTES - 64);
                for (;;) {
                    if (tid == 0) sh[0] = (int)atomicAdd(ctr, 1u);
                    __syncthreads();
                    const int idx = __builtin_amdgcn_readfirstlane(sh[0]);
                    __syncthreads();
                    if (idx >= 816 + 1024) break;
                    if (idx < 768) { const int qb = 15 - idx / 48, bh = idx % 48, b = bh / 6, h = bh % 6; typedef attn_body::bf16 abf;
                        attn_body::sb_unit(qb, (const abf*)(P + P_SQ) + (size_t)bh * SEQ * 64, (const abf*)(P + P_SQ + HEADBUF) + (size_t)bh * SEQ * 64, (const abf*)(P + P_SQ + 2 * HEADBUF) + (size_t)bh * SEQ * 64,
                                           (abf*)MIX + (size_t)b * SEQ * DM + 256 + h * 64, (char*)lds); }
                    else if (idx < 816) fox_cumsum_item(idx - 768, (const float*)(P + P_LF), (float*)(P + P_CC), (int*)(ws + WS_JS), LB + 2048 + l * 256 + 128, LB + 2048 + l * 256 + 192, (LAS float*)L);
                    else hgrn_a_item(idx - 816, P, (float*)(ws + WS_DD), L);
                    __syncthreads();
                }
            } else if (k == 2) {
                hgrn_b_scan(bx, G, P, (const float*)(ws + WS_DD));
            } else if (k == 3) {
                int tid = threadIdx.x; asm volatile("" : "+v"(tid));
                unsigned* ctr = (unsigned*)ws + l * 16 + rep * 4;
                volatile LAS int* sh = (volatile LAS int*)(L + LDS_BYTES - 64);
                for (;;) {
                    if (tid == 0) sh[0] = (int)atomicAdd(ctr, 1u);
                    __syncthreads();
                    const int idx = __builtin_amdgcn_readfirstlane(sh[0]);
                    __syncthreads();
                    if (idx >= 768 + 1024) break;
                    if (idx >= 768) { hgrn_c_item(idx - 768, P, MIX, ap->in[4] + l * 64, L); __syncthreads(); continue; }
                    const int qb = 15 - idx / 48, bh = idx % 48, b = bh / 6, h = bh % 6;
                    typedef attn_body::bf16 abf;
                    const int jstart = ((const int*)(ws + WS_JS))[bh * 16 + qb];
                    attn_body::attn_unit<8>(qb, jstart, (const abf*)(P + P_FQ) + (size_t)bh * SEQ * 64, (const abf*)(P + P_FQ + HEADBUF) + (size_t)bh * SEQ * 64, (const abf*)(P + P_FQ + 2 * HEADBUF) + (size_t)bh * SEQ * 64,
                                            (abf*)MIX + (size_t)b * SEQ * DM + 640 + h * 64, (const float*)(P + P_CC) + (size_t)bh * SEQ, (char*)lds);
                }
            } else if (k == 5) {
                pg8::Gemm g{XB, (const bf16_t*)(wl + W_1), M, DFF, DM}; pg8::StaticOrder S; S.init(M, DFF, G, bx);
                EpiRelu2 E{UB, SS};
                pg8::gemm_phase<EpiRelu2, pg8::StaticOrder, true, true>(L, g, S, E);
            } else {
                const bool ff2 = (k == 6);
                pg8::Gemm g{ff2 ? UB : MIX, (const bf16_t*)(wl + (ff2 ? W_2 : W_OUT)), M, DM, ff2 ? DFF : DM}; pg8::StaticOrder S; S.init(M, DM, G, bx);
                EpiResid E{(!ff2 && l == 0) ? ap->in[0] : ap->out, ap->out, XB, SS};
                pg8::gemm_phase<EpiResid, pg8::StaticOrder, true, true>(L, g, S, E);
            }
            }
        }
#ifdef PROBE_T
        if (bx == 0 && threadIdx.x == 0) ((unsigned long long*)(ws + 65536))[ph] = __builtin_amdgcn_s_memrealtime();
#endif
        if (ph + 1 < a.ph_hi) grid.sync();
    }
}

#ifndef MK_MULTI
#define MK_MULTI 0
#endif
extern "C" void kernel_launch(void* const* d_in, const int* in_sizes, int n_in, void* d_out, int out_size, void* d_ws, size_t ws_size, hipStream_t stream) {
    static int grid = 0;
    if (grid == 0) {
        int dev = 0, cus = 0, per = 0;
        if (n_in != 14 || out_size != M * DM || ws_size < WS_END) { fprintf(stderr, "kernel_launch: unexpected shapes (n_in %d out %d ws %zu)\n", n_in, out_size, ws_size); grid = -1; return; }
        (void)hipGetDevice(&dev); (void)hipDeviceGetAttribute(&cus, hipDeviceAttributeMultiprocessorCount, dev);
        (void)hipFuncSetAttribute((const void*)fwd, hipFuncAttributeMaxDynamicSharedMemorySize, LDS_BYTES);
        (void)hipOccupancyMaxActiveBlocksPerMultiprocessor(&per, (const void*)fwd, 512, LDS_BYTES);
        if (per < 1) per = 1;
        grid = cus * per;
        fprintf(stderr, "kernel_launch: grid %d (cus %d x %d)\n", grid, cus, per);
    }
    if (grid < 0) return;
    Args a{};
    for (int i = 0; i < 14; ++i) a.in[i] = (const float*)d_in[i];
    a.out = (float*)d_out; a.ws = (unsigned char*)d_ws;
#if MK_MULTI
    for (int ph = 0; ph < NPHASE; ++ph) { a.ph_lo = ph; a.ph_hi = ph + 1; hipLaunchKernelGGL(fwd, dim3(grid), dim3(512), LDS_BYTES, stream, a); }
#else
#ifdef PROBE_T
    a.ph_lo = 0; a.ph_hi = NPHASE + 1;
#else
    a.ph_lo = 0; a.ph_hi = NPHASE;
#endif
    void* args[] = {&a};
    hipError_t e = hipLaunchCooperativeKernel((const void*)fwd, dim3(grid), dim3(512), args, LDS_BYTES, stream);
    if (e != hipSuccess) fprintf(stderr, "kernel_launch: cooperative launch failed: %s (grid %d)\n", hipGetErrorString(e), grid);
#endif
}
```

```cpp
#include <hip/hip_runtime.h>
#include <hip/hip_cooperative_groups.h>
#include <cstdio>
#include <cstdint>
namespace cg = cooperative_groups;
namespace pg8 {
#define PG8_LAS __attribute__((address_space(3)))
typedef unsigned short bf16_t;
typedef short bf16x8 __attribute__((ext_vector_type(8)));
typedef float f32x4 __attribute__((ext_vector_type(4)));
typedef unsigned u32x4 __attribute__((ext_vector_type(4)));
constexpr int BM = 256, BK = 64, HALF = 128, HTB = HALF * BK * 2  , STAGE_BYTES = 8 * HTB, NXCD = 8, WGM = 8;

__host__ __device__ __forceinline__ int lds_byte(int r, int c) { const int st = (r >> 4) * 2 + (c >> 5), rr = r & 15, cc = c & 31, ob = rr * 64 + cc * 2; return st * 1024 + (ob ^ (((ob >> 9) & 1) << 5)); }
__host__ __device__ __forceinline__ void stage_rc(int b, int& R, int& C) { const int st = b / 1024, sb = b % 1024, swz = sb ^ (((sb >> 9) & 1) << 5); R = (st >> 1) * 16 + swz / 64; C = (st & 1) * 32 + (swz % 64) / 2; }
__host__ __device__ __forceinline__ int perm32(int rho) { const int n = rho >> 4, i = rho & 15; return 8 * (i >> 2) + 4 * n + (i & 3); }

struct Unit { int pm, pn; };
struct Gemm { const bf16_t* A; const bf16_t* Bt; int M, N, K; };

struct StaticOrder {
    int nM, nN, nwg, G, c;
    __host__ __device__ void init(int M, int N, int G_, int c_) { nM = M / BM; nN = N / BM; nwg = nM * nN; G = G_; c = c_; }
    __host__ __device__ bool next(int i, Unit& u) const {
        const long L = (long)i * G + c; if (L >= nwg) return false;
        int wgid = (int)L; { const int q = nwg / NXCD, r = nwg % NXCD, xcd = wgid % NXCD, off = wgid / NXCD; wgid = (xcd < r ? xcd * (q + 1) : r * (q + 1) + (xcd - r) * q) + off; }
        const int nig = WGM * nN, gid = wgid / nig, fm = gid * WGM, gsz = (nM - fm) < WGM ? (nM - fm) : WGM;
        u.pm = fm + ((wgid % nig) % gsz); u.pn = (wgid % nig) / gsz; return true;
    }
    __device__ __forceinline__ void a_ready(const Unit&) const {}
    __device__ __forceinline__ void done(const Unit&) const {}
};

__device__ __forceinline__ unsigned cvt_pk_bf16(float lo, float hi) { unsigned r; asm volatile("v_cvt_pk_bf16_f32 %0, %1, %2" : "=v"(r) : "v"(lo), "v"(hi)); return r; }
typedef float f32x2 __attribute__((ext_vector_type(2)));
template <class Epi, class Sched, bool ALIGN_EPI = false, bool SP2 = false>
__device__ __forceinline__ void gemm_phase(PG8_LAS unsigned char* lds, const Gemm g, const Sched& S, const Epi& E) {
    int tid_ = threadIdx.x; asm volatile("" : "+v"(tid_));
    const int tid = tid_, wid = __builtin_amdgcn_readfirstlane(tid >> 6), lane = tid & 63, wr = wid >> 2, wc = wid & 3, fr = lane & 15, fq = lane >> 4;
    const int K = g.K, nt = K / BK;
    unsigned voffA[2], voffB[2];
#pragma unroll
    for (int i = 0; i < 2; ++i) { int R, C; stage_rc(tid * 16 + i * 8192, R, C); const int Rb = Epi::PERM ? ((R & ~31) + perm32(R & 31)) : R;
        voffA[i] = (unsigned)(R * K + C) * 2u; voffB[i] = (unsigned)(Rb * K + C) * 2u; }
    const size_t kstep = (size_t)(BK * 2);
    const size_t hstep = (size_t)HALF * K * 2;
    const size_t tstep = 2 * hstep;
    const unsigned ldsw = (unsigned)wid * 1024u;
    const int aoff = lds_byte(wr * 64 + fr, fq * 8), boff = lds_byte(wc * 32 + fr, fq * 8);
#define PG8_SA(b, h) (((b) * 2 + (h)) * HTB)
#define PG8_SB(b, h) ((4 + (b) * 2 + (h)) * HTB)
#define PG8_STAGE(bufoff, gbase, voff) do { _Pragma("unroll") for (int _i = 0; _i < 2; ++_i) \
        __builtin_amdgcn_global_load_lds((const unsigned*)((const char*)(gbase) + (voff)[_i]), (PG8_LAS unsigned*)(lds + (bufoff) + ldsw + _i * 8192), 16, 0, 0); } while (0)
#define PG8_LDA(dst, b, h) do { _Pragma("unroll") for (int m = 0; m < 4; ++m) _Pragma("unroll") for (int k = 0; k < 2; ++k) dst[m][k] = *(const PG8_LAS bf16x8*)(lds + PG8_SA(b, h) + aoff + m * 2048 + k * 1024); } while (0)
#define PG8_LDB(dst, b, h) do { _Pragma("unroll") for (int n = 0; n < 2; ++n) _Pragma("unroll") for (int k = 0; k < 2; ++k) dst[n][k] = *(const PG8_LAS bf16x8*)(lds + PG8_SB(b, h) + boff + n * 2048 + k * 1024); } while (0)
#define PG8_MMA(ai, bj, At, Bt) do { __builtin_amdgcn_s_setprio(1); _Pragma("unroll") for (int m = 0; m < 4; ++m) _Pragma("unroll") for (int n = 0; n < 2; ++n) _Pragma("unroll") for (int k = 0; k < 2; ++k) \
        acc[ai][bj][m][n] = __builtin_amdgcn_mfma_f32_16x16x32_bf16(Bt[n][k], At[m][k], acc[ai][bj][m][n], 0, 0, 0); __builtin_amdgcn_s_setprio(0); } while (0)
#define PG8_WAIT_V(n) asm volatile("s_waitcnt vmcnt(" #n ")" ::: "memory")
#define PG8_WAIT_L(n) asm volatile("s_waitcnt lgkmcnt(" #n ")" ::: "memory")
#define PG8_BAR __builtin_amdgcn_s_barrier()
#define PG8_SCHED __builtin_amdgcn_sched_barrier(0)
    Unit cur, nxt; int ui = 0;
    if (!S.next(0, cur)) return;
    f32x4 acc[2][2][4][2];
#pragma unroll
    for (int a = 0; a < 2; ++a)
#pragma unroll
        for (int b = 0; b < 2; ++b)
#pragma unroll
            for (int m = 0; m < 4; ++m)
#pragma unroll
                for (int n = 0; n < 2; ++n) acc[a][b][m][n] = (f32x4){0.f, 0.f, 0.f, 0.f};
    bf16x8 At[4][2], B0[2][2], B1[2][2];
    const char* cA = (const char*)g.A + (size_t)cur.pm * tstep; const char* cB = (const char*)g.Bt + (size_t)cur.pn * tstep;
    S.a_ready(cur);
    if constexpr (SP2) {
        PG8_STAGE(PG8_SB(0, 0), cB, voffB); PG8_STAGE(PG8_SB(0, 1), cB + hstep, voffB); PG8_STAGE(PG8_SA(0, 0), cA, voffA); PG8_STAGE(PG8_SA(0, 1), cA + hstep, voffA);
        if (wr == 1) PG8_BAR;
        PG8_WAIT_V(2); PG8_BAR;
        PG8_STAGE(PG8_SB(1, 0), cB + kstep, voffB); PG8_STAGE(PG8_SA(1, 0), cA + kstep, voffA); PG8_STAGE(PG8_SB(1, 1), cB + hstep + kstep, voffB);
        PG8_WAIT_V(6); PG8_BAR;
    } else {
        PG8_STAGE(PG8_SB(0, 0), cB, voffB); PG8_STAGE(PG8_SA(0, 0), cA, voffA); PG8_STAGE(PG8_SB(0, 1), cB + hstep, voffB); PG8_STAGE(PG8_SA(0, 1), cA + hstep, voffA);
        if (wr == 1) PG8_BAR;
        PG8_WAIT_V(4); PG8_BAR;
        PG8_STAGE(PG8_SB(1, 0), cB + kstep, voffB); PG8_STAGE(PG8_SA(1, 0), cA + kstep, voffA); PG8_STAGE(PG8_SB(1, 1), cB + hstep + kstep, voffB);
        PG8_WAIT_V(6); PG8_BAR;
    }
    for (;;) {
        const bool has_next = S.next(ui + 1, nxt);
        const char* nA = has_next ? (const char*)g.A + (size_t)nxt.pm * tstep : cA; const char* nB = has_next ? (const char*)g.Bt + (size_t)nxt.pn * tstep : cB;
        for (int t = 0; t < nt; t += 2) {
            const bool last = (t == nt - 2);
            const char* a1 = cA + (size_t)(t + 1) * kstep;
            const char* a2 = last ? nA : cA + (size_t)(t + 2) * kstep; const char* b2 = last ? nB : cB + (size_t)(t + 2) * kstep;
            const char* a3 = a2 + kstep; const char* b3 = b2 + kstep;
            if (last && has_next) S.a_ready(nxt);
            if constexpr (SP2) {
            PG8_LDB(B0, 0, 0); PG8_LDB(B1, 0, 1); PG8_SCHED; PG8_LDA(At, 0, 0); PG8_STAGE(PG8_SA(1, 1), a1 + hstep, voffA);
            PG8_WAIT_V(8); PG8_WAIT_L(0); PG8_BAR; PG8_MMA(0, 0, At, B0); PG8_MMA(0, 1, At, B1); PG8_BAR; PG8_SCHED;
            PG8_LDA(At, 0, 1); PG8_STAGE(PG8_SB(0, 0), b2, voffB); PG8_STAGE(PG8_SB(0, 1), b2 + hstep, voffB); PG8_STAGE(PG8_SA(0, 0), a2, voffA);
            PG8_WAIT_V(8); PG8_WAIT_L(0); PG8_BAR; PG8_MMA(1, 0, At, B0); PG8_MMA(1, 1, At, B1); PG8_BAR; PG8_SCHED;
            PG8_LDB(B0, 1, 0); PG8_LDB(B1, 1, 1); PG8_SCHED; PG8_LDA(At, 1, 0); PG8_STAGE(PG8_SA(0, 1), a2 + hstep, voffA);
            PG8_WAIT_V(8); PG8_WAIT_L(0); PG8_BAR; PG8_MMA(0, 0, At, B0); PG8_MMA(0, 1, At, B1); PG8_BAR; PG8_SCHED;
            PG8_LDA(At, 1, 1); PG8_STAGE(PG8_SB(1, 0), b3, voffB); PG8_STAGE(PG8_SB(1, 1), b3 + hstep, voffB); PG8_STAGE(PG8_SA(1, 0), a3, voffA);
            PG8_WAIT_V(8); PG8_WAIT_L(0); PG8_BAR; PG8_MMA(1, 0, At, B0); PG8_MMA(1, 1, At, B1); PG8_BAR; PG8_SCHED;
            } else {
            PG8_LDB(B0, 0, 0); PG8_SCHED; PG8_LDA(At, 0, 0); PG8_STAGE(PG8_SA(1, 1), a1 + hstep, voffA);
            PG8_WAIT_L(8); PG8_BAR; PG8_WAIT_L(0); PG8_MMA(0, 0, At, B0); PG8_BAR; PG8_SCHED;
            PG8_LDB(B1, 0, 1); PG8_STAGE(PG8_SB(0, 0), b2, voffB);
            PG8_BAR; PG8_WAIT_L(0); PG8_MMA(0, 1, At, B1); PG8_BAR;
            PG8_LDA(At, 0, 1); PG8_STAGE(PG8_SA(0, 0), a2, voffA);
            PG8_BAR; PG8_WAIT_L(0); PG8_MMA(1, 0, At, B0); PG8_BAR; PG8_SCHED;
            PG8_STAGE(PG8_SB(0, 1), b2 + hstep, voffB);
            PG8_WAIT_V(6); PG8_BAR; PG8_MMA(1, 1, At, B1); PG8_BAR;
            PG8_LDB(B0, 1, 0); PG8_SCHED; PG8_LDA(At, 1, 0); PG8_STAGE(PG8_SA(0, 1), a2 + hstep, voffA);
            PG8_WAIT_L(8); PG8_BAR; PG8_WAIT_L(0); PG8_MMA(0, 0, At, B0); PG8_BAR; PG8_SCHED;
            PG8_LDB(B1, 1, 1); PG8_STAGE(PG8_SB(1, 0), b3, voffB);
            PG8_BAR; PG8_WAIT_L(0); PG8_MMA(0, 1, At, B1); PG8_BAR;
            PG8_LDA(At, 1, 1); PG8_STAGE(PG8_SA(1, 0), a3, voffA);
            PG8_BAR; PG8_WAIT_L(0); PG8_MMA(1, 0, At, B0); PG8_BAR; PG8_SCHED;
            PG8_STAGE(PG8_SB(1, 1), b3 + hstep, voffB);
            PG8_WAIT_V(6); PG8_BAR; PG8_MMA(1, 1, At, B1); PG8_BAR;
            }
        }
        if constexpr (ALIGN_EPI) { if (wr == 0) PG8_BAR; }
        if constexpr (!Epi::AFTER_DRAIN) { E(acc, cur, wr, wc, fr, fq); S.done(cur); }
        if (!has_next) break;
#pragma unroll
        for (int a = 0; a < 2; ++a)
#pragma unroll
            for (int b = 0; b < 2; ++b)
#pragma unroll
                for (int m = 0; m < 4; ++m)
#pragma unroll
                    for (int n = 0; n < 2; ++n) acc[a][b][m][n] = (f32x4){0.f, 0.f, 0.f, 0.f};
        cur = nxt; cA = nA; cB = nB; ++ui;
        if constexpr (ALIGN_EPI) { if (wr == 1) PG8_BAR; }
    }
    PG8_WAIT_V(0);
    if constexpr (!ALIGN_EPI) { if (wr == 0) PG8_BAR; }
    PG8_BAR;
    if constexpr (Epi::AFTER_DRAIN) { E.fused(acc, cur, wr, wc, fr, fq, lds, wid, lane); S.done(cur); }
#undef PG8_SA
#undef PG8_SB
#undef PG8_STAGE
#undef PG8_LDA
#undef PG8_LDB
#undef PG8_MMA
#undef PG8_WAIT_V
#undef PG8_WAIT_L
#undef PG8_BAR
#undef PG8_SCHED
}
}
#include <hip/hip_bf16.h>
#include <cmath>
namespace attn_body {
using bf16=__hip_bfloat16;
using bf16x8=__attribute__((ext_vector_type(8)))short;
using s16x4=__attribute__((ext_vector_type(4)))short;
using f32x16=__attribute__((ext_vector_type(16)))float;
using u32x4=__attribute__((ext_vector_type(4)))unsigned;
using f32x4v=__attribute__((ext_vector_type(4)))float;
constexpr int SEQ=4096,D=64,DM=64,OPITCH=1024;
constexpr int LDS_C=98304;
constexpr int NW=8,QBLK=32,QB=QBLK*NW,KVBLK=64,NQB=SEQ/QB;
constexpr int ATTN_UNIT_ROWS=QB;
__device__ __forceinline__ int crow(int r,int hi){return (r&3)+8*(r>>2)+4*hi;}
#define SBAR() __builtin_amdgcn_sched_barrier(0)
__device__ __forceinline__ void cmask(f32x16&p0,f32x16&p1,int jb,int qrel,int hi){
  const float NEG=-INFINITY; int kb=64*jb+4*hi;
  #pragma unroll
  for(int r=0;r<16;++r){int kv=kb+(r&3)+8*(r>>2); if(kv>qrel)p0[r]=NEG; if(kv+32>qrel)p1[r]=NEG;}
}

constexpr int NSLOT=3, SLOTB=8192;
constexpr int LDS_K=0, LDS_V=NSLOT*SLOTB, LDS_WS=2*NSLOT*SLOTB, LDS_OST=LDS_WS+NW*64*4, LDS_BYTES=LDS_OST+NW*4096;
constexpr float C2=0.125f*1.4426950408889634f;
__device__ __forceinline__ void glds16(const void*gsrc,unsigned lds_dst){unsigned keep;
  asm volatile("s_mov_b32 %0, m0\n\ts_mov_b32 m0, %2\n\ts_nop 0\n\tglobal_load_lds_dwordx4 %1, off\n\ts_mov_b32 m0, %0":"=&s"(keep):"v"(gsrc),"s"(lds_dst):"memory");}
__device__ __forceinline__ float max3f(float a,float b,float c){float r;asm("v_max3_f32 %0, %1, %2, %3":"=v"(r):"v"(a),"v"(b),"v"(c));return r;}
__device__ __forceinline__ float max2f(float a,float b){float r;asm("v_max_f32_e32 %0, %1, %2":"=v"(r):"v"(a),"v"(b));return r;}
__device__ __forceinline__ float fadd_s(float a,float b){float r;asm("v_add_f32_e32 %0, %1, %2":"=v"(r):"v"(a),"v"(b));return r;}
__device__ __forceinline__ float fsub_s(float a,float b){float r;asm("v_sub_f32_e32 %0, %1, %2":"=v"(r):"v"(a),"v"(b));return r;}
typedef float f32x2_t __attribute__((ext_vector_type(2))); typedef __bf16 bf16x2_t __attribute__((ext_vector_type(2)));
__device__ __forceinline__ unsigned cvtpk_s(float lo,float hi){f32x2_t v={lo,hi};bf16x2_t b=__builtin_convertvector(v,bf16x2_t);return __builtin_bit_cast(unsigned,b);}
#define WAIT_BAR(N) asm volatile("s_waitcnt vmcnt(" #N ") lgkmcnt(0)\n\ts_barrier":::"memory")

__device__ __forceinline__ void qkt(f32x16&p0,f32x16&p1,const char*Kslot,const bf16x8*qr,const f32x16&negm,int r32,int hi){
  const char*kb=Kslot+hi*1024+r32*16;
  #pragma unroll
  for(int d0=0;d0<4;++d0){
    const bf16x8 b0=*reinterpret_cast<const bf16x8*>(kb+d0*2048);
    const bf16x8 b1=*reinterpret_cast<const bf16x8*>(kb+d0*2048+512);
    if(d0==0){p0=__builtin_amdgcn_mfma_f32_32x32x16_bf16(b0,qr[0],negm,0,0,0);p1=__builtin_amdgcn_mfma_f32_32x32x16_bf16(b1,qr[0],negm,0,0,0);}
    else{p0=__builtin_amdgcn_mfma_f32_32x32x16_bf16(b0,qr[d0],p0,0,0,0);p1=__builtin_amdgcn_mfma_f32_32x32x16_bf16(b1,qr[d0],p1,0,0,0);}}
}
typedef __attribute__((address_space(3))) const char* lds_cptr;
typedef short v4i16_t __attribute__((ext_vector_type(4)));
__device__ __forceinline__ void kload8(bf16x8*kf,lds_cptr kp){
  kf[0]=*(const __attribute__((address_space(3))) bf16x8*)(kp);      kf[1]=*(const __attribute__((address_space(3))) bf16x8*)(kp+512);
  kf[2]=*(const __attribute__((address_space(3))) bf16x8*)(kp+2048); kf[3]=*(const __attribute__((address_space(3))) bf16x8*)(kp+2560);
  kf[4]=*(const __attribute__((address_space(3))) bf16x8*)(kp+4096); kf[5]=*(const __attribute__((address_space(3))) bf16x8*)(kp+4608);
  kf[6]=*(const __attribute__((address_space(3))) bf16x8*)(kp+6144); kf[7]=*(const __attribute__((address_space(3))) bf16x8*)(kp+6656);
}
__device__ __forceinline__ void kload2(bf16x8*kf,lds_cptr kp,int j){ kf[2*j]=*(const __attribute__((address_space(3))) bf16x8*)(kp+j*2048); kf[2*j+1]=*(const __attribute__((address_space(3))) bf16x8*)(kp+j*2048+512); }
__device__ __forceinline__ s16x4 vtr(lds_cptr p){ return __builtin_bit_cast(s16x4,__builtin_amdgcn_ds_read_tr16_b64_v4i16((__attribute__((address_space(3))) v4i16_t*)p)); }
__device__ __forceinline__ float rowmax(const f32x16&p0,const f32x16&p1){
  float a=max3f(p0[0],p0[1],p1[0]),b=max3f(p0[2],p0[3],p1[1]);a=max3f(a,p1[2],p1[3]);
  #pragma unroll
  for(int r=4;r<16;r+=4){a=max3f(a,p0[r],p0[r+1]);b=max3f(b,p0[r+2],p0[r+3]);a=max3f(a,p1[r],p1[r+1]);b=max3f(b,p1[r+2],p1[r+3]);}
  const float m=max2f(a,b);
  auto rr=__builtin_amdgcn_permlane32_swap(__float_as_uint(m),__float_as_uint(m),false,false);
  return max2f(__uint_as_float(rr[0]),__uint_as_float(rr[1]));
}
__device__ __forceinline__ void pv(f32x16*o,int vb,bf16x8 pa0,bf16x8 pa1,bf16x8 pa2,bf16x8 pa3){
  #pragma unroll
  for(int d0=0;d0<2;++d0){s16x4 lo[4],hi[4];
    #pragma unroll
    for(int ks=0;ks<4;++ks){
      asm volatile("ds_read_b64_tr_b16 %0,%1 offset:%c2":"=&v"(lo[ks]):"v"(vb),"i"(d0*4096+ks*1024):"memory");
      asm volatile("ds_read_b64_tr_b16 %0,%1 offset:%c2":"=&v"(hi[ks]):"v"(vb),"i"(d0*4096+ks*1024+512):"memory");}
    asm volatile("s_waitcnt lgkmcnt(0)":::"memory");SBAR();
    #define PK(k) (bf16x8){lo[k][0],lo[k][1],lo[k][2],lo[k][3],hi[k][0],hi[k][1],hi[k][2],hi[k][3]}
    o[d0]=__builtin_amdgcn_mfma_f32_32x32x16_bf16(pa0,PK(0),o[d0],0,0,0);
    o[d0]=__builtin_amdgcn_mfma_f32_32x32x16_bf16(pa1,PK(1),o[d0],0,0,0);
    o[d0]=__builtin_amdgcn_mfma_f32_32x32x16_bf16(pa2,PK(2),o[d0],0,0,0);
    o[d0]=__builtin_amdgcn_mfma_f32_32x32x16_bf16(pa3,PK(3),o[d0],0,0,0);
    #undef PK
  }
}

#ifndef ATTN_STORE16
#define ATTN_STORE16(p,v) (*(u32x4*)(p)=(v))
#endif
template<int THRL> __device__ __forceinline__ void attn_unit(int qb,int jstart,const bf16*Q,const bf16*__restrict__ K,const bf16*__restrict__ V,bf16*O,const float*__restrict__ Cg,char*shm){
  int tid_=threadIdx.x; asm volatile("":"+v"(tid_)); const int tid=tid_,lane=tid&63,r32=lane&31,hi=lane>>5; const int wid=__builtin_amdgcn_readfirstlane(tid>>6);
  const int q0=qb*QB;
  const bf16*Qw=Q+(long)(q0+wid*QBLK)*DM;
  const bf16*Kh=K+(long)jstart*KVBLK*DM,*Vh=V+(long)jstart*KVBLK*DM;
  const lds_cptr shm3=(lds_cptr)shm;
  const unsigned lds0=(unsigned)(uintptr_t)shm;
  float*wsf=(float*)(shm+LDS_WS)+wid*64;
  const bf16*ksrc=Kh+(long)lane*DM+wid*8;
  const bf16*vsrc=Vh+(long)(16*(wid&3)+(lane>>2))*DM+(wid>>2)*32+(lane&3)*8;
  const unsigned kdst=lds0+LDS_K+wid*1024, vdst=lds0+LDS_V+wid*1024;
  #define DMA_K(t,slot) glds16(ksrc+(long)(t)*KVBLK*DM,(unsigned)__builtin_amdgcn_readfirstlane(kdst+(slot)))
  #define DMA_V(t,slot) glds16(vsrc+(long)(t)*KVBLK*DM,(unsigned)__builtin_amdgcn_readfirstlane(vdst+(slot)))
  const int vb0=(int)(lds0+LDS_V)+((lane>>4)&1)*32+(lane&3)*8+(4*hi+((lane&15)>>2))*64;
  const char*Kbase=shm+LDS_K; bf16x8 kf[8];
  const lds_cptr kp0=shm3+LDS_K+hi*1024+r32*16; const lds_cptr vp0=shm3+LDS_V+((lane>>4)&1)*32+(lane&3)*8+(4*hi+((lane&15)>>2))*64;
  const int NT=(q0+QB)/KVBLK-jstart;
  { typedef __attribute__((address_space(3))) f32x4v lf32x4; lf32x4*cl_=(lf32x4*)(shm3+LDS_C); const f32x4v*cg_=(const f32x4v*)(Cg+jstart*KVBLK); const int n4_=(q0+QB-jstart*KVBLK)>>2;
    f32x4v c0_=f32x4v{},c1_=f32x4v{}; if(tid<n4_)c0_=cg_[tid]; if(tid+NW*64<n4_)c1_=cg_[tid+NW*64]; if(tid<n4_)cl_[tid]=c0_; if(tid+NW*64<n4_)cl_[tid+NW*64]=c1_; }
  DMA_K(0,0);DMA_V(0,0);DMA_K(1,SLOTB);
  bf16x8 qr[4];
  #pragma unroll
  for(int d0=0;d0<4;++d0)qr[d0]=*reinterpret_cast<const bf16x8*>(&Qw[(long)r32*DM+d0*16+hi*8]);
  float mhat=0.f,l_reg=0.f;f32x16 o[2];o[0]=f32x16{};o[1]=f32x16{};
  const int qrel=wid*QBLK+r32;
  #define CMASK(P0,P1,t) do{int jb_=(t)-(NT-4); if(jb_>=0)cmask(P0,P1,jb_,qrel,hi);}while(0)
  typedef __attribute__((address_space(3))) const float* lds_fptr; typedef __attribute__((address_space(3))) const f32x4v* lds_f4ptr;
  const lds_fptr cl0=(lds_fptr)(shm3+LDS_C)+4*hi;
  #define BIAS(P0,P1,t) do{ const lds_fptr cb_=cl0+64*(t); _Pragma("unroll") for(int g_=0;g_<4;++g_){ const f32x4v a_=*(lds_f4ptr)(cb_+8*g_), b_=*(lds_f4ptr)(cb_+32+8*g_); \
      _Pragma("unroll") for(int i_=0;i_<4;++i_){P0[4*g_+i_]-=a_[i_];P1[4*g_+i_]-=b_[i_];} } }while(0)
  #define BIASINIT(C0_,C1_,t) do{ const lds_fptr cb_=cl0+64*(t); const float nm_=-mhat; _Pragma("unroll") for(int g_=0;g_<4;++g_){ const f32x4v a_=*(lds_f4ptr)(cb_+8*g_), b_=*(lds_f4ptr)(cb_+32+8*g_); \
      _Pragma("unroll") for(int i_=0;i_<4;++i_){C0_[4*g_+i_]=nm_-a_[i_];C1_[4*g_+i_]=nm_-b_[i_];} } }while(0)
  bool resc=false;
  #define START(P0,P1) do{ const float rm=rowmax(P0,P1); resc=false; \
    { const float dl=rm; mhat=fadd_s(mhat,dl); \
      _Pragma("unroll") for(int r=0;r<16;++r){P0[r]=fsub_s(P0[r],dl);P1[r]=fsub_s(P1[r],dl);} \
      } \
    _Pragma("unroll") for(int r=0;r<16;++r)P0[r]=__builtin_amdgcn_exp2f(P0[r]); }while(0)
  #define RESC() do{ if(resc){ asm volatile("s_waitcnt lgkmcnt(0)":::"memory"); \
      _Pragma("unroll") for(int d_=0;d_<2;++d_) _Pragma("unroll") for(int r=0;r<16;++r)o[d_][r]*=wsf[crow(r,hi)]; } }while(0)
  f32x16 pA0,pA1,pB0,pB1;
  int sl_prev=0,sl_cur=0,sl_next=SLOTB;
  #define ROT() do{sl_prev=sl_cur;sl_cur=sl_next;sl_next=(sl_next==(NSLOT-1)*SLOTB)?0:sl_next+SLOTB;}while(0)
  DMA_K(2,2*SLOTB);
  WAIT_BAR(3);
  { const f32x16 zero_=f32x16{}; qkt(pA0,pA1,Kbase,qr,zero_,r32,hi); }asm volatile("s_nop 15\n\ts_nop 7":"+v"(pA0),"+v"(pA1));BIAS(pA0,pA1,0);CMASK(pA0,pA1,0);
  START(pA0,pA1);
  _Pragma("unroll") for(int r=0;r<16;++r)pA1[r]=__builtin_amdgcn_exp2f(pA1[r]);
  WAIT_BAR(0);
  DMA_K(3,0);DMA_V(1,SLOTB);
  ROT();
  kload8(kf,kp0+sl_cur);
  WAIT_BAR(2);
  s16x4 vlo[8],vhi[8]; u32x4 pw0,pw1,pw2,pw3;
  #define PKW(P,B) cvtpk_s(P[B],P[B+1])
  #define PAF(k) __builtin_bit_cast(bf16x8,pw##k)
  #define VFR(i) (bf16x8){vlo[i][0],vlo[i][1],vlo[i][2],vlo[i][3],vhi[i][0],vhi[i][1],vhi[i][2],vhi[i][3]}
  #define PIN(x) asm volatile("":"+v"(x))
  #define MX3(a,b,c) __builtin_fmaxf(__builtin_fmaxf((a),(b)),(c))
  #define GAPA(MF,A0,A1,A2,A3,W0,W1,PW) do{ MF; sacc+=A0; sacc+=A1; sacc+=A2; sacc+=A3; PIN(sacc); W0; W1; PIN(PW); SBAR(); }while(0)
  #define EX(v) __builtin_amdgcn_exp2f(v)
  #define GAPB(MF,X,B) do{ MF; X[B]=EX(X[B]); X[B+1]=EX(X[B+1]); X[B+2]=EX(X[B+2]); X[B+3]=EX(X[B+3]); PIN(X); SBAR(); }while(0)
  #define VRD(i) do{ vlo[i]=vtr(vp_+(((i)>>2)*4096+((i)&3)*1024)); vhi[i]=vtr(vp_+(((i)>>2)*4096+((i)&3)*1024+512)); }while(0)
  #define KRD(G,j) do{ if(G){ kload2(kf,kp0+sl_next,j); SBAR(); } }while(0)
  #define STEP(C0,C1,P0,P1,t,GK,GV,GL) do{ SBAR(); BIASINIT(C0,C1,t); SBAR(); \
    const lds_cptr vp_=vp0+sl_prev; \
    VRD(0); SBAR(); float sacc=(P0[0]+P0[1]); \
    GAPA(C0=__builtin_amdgcn_mfma_f32_32x32x16_bf16(kf[0],qr[0],C0,0,0,0), P0[2],P0[3],P0[4],P0[5],     pw0[0]=PKW(P0,0), pw0[1]=PKW(P0,2), pw0); \
    VRD(4); SBAR(); GAPA(C1=__builtin_amdgcn_mfma_f32_32x32x16_bf16(kf[1],qr[0],C1,0,0,0), P0[6],P0[7],P0[8],P0[9],     pw0[2]=PKW(P0,4), pw0[3]=PKW(P0,6), pw0); \
    VRD(1); SBAR(); GAPA(C0=__builtin_amdgcn_mfma_f32_32x32x16_bf16(kf[2],qr[1],C0,0,0,0),   P0[10],P0[11],P0[12],P0[13], pw1[0]=PKW(P0,8), pw1[1]=PKW(P0,10), pw1); \
    VRD(5); SBAR(); GAPA(C1=__builtin_amdgcn_mfma_f32_32x32x16_bf16(kf[3],qr[1],C1,0,0,0),   P0[14],P0[15],P1[0],P1[1],   pw1[2]=PKW(P0,12),pw1[3]=PKW(P0,14), pw1); \
    VRD(2); SBAR(); GAPA(C0=__builtin_amdgcn_mfma_f32_32x32x16_bf16(kf[4],qr[2],C0,0,0,0),   P1[2],P1[3],P1[4],P1[5],     pw2[0]=PKW(P1,0), pw2[1]=PKW(P1,2), pw2); \
    VRD(6); SBAR(); GAPA(C1=__builtin_amdgcn_mfma_f32_32x32x16_bf16(kf[5],qr[2],C1,0,0,0),   P1[6],P1[7],P1[8],P1[9],     pw2[2]=PKW(P1,4), pw2[3]=PKW(P1,6), pw2); \
    VRD(3); SBAR(); GAPA(C0=__builtin_amdgcn_mfma_f32_32x32x16_bf16(kf[6],qr[3],C0,0,0,0),   P1[10],P1[11],P1[12],P1[13], pw3[0]=PKW(P1,8), pw3[1]=PKW(P1,10), pw3); \
    VRD(7); SBAR(); GAPA(C1=__builtin_amdgcn_mfma_f32_32x32x16_bf16(kf[7],qr[3],C1,0,0,0),   P1[14],P1[15],0.f,0.f,       pw3[2]=PKW(P1,12),pw3[3]=PKW(P1,14), pw3); \
    l_reg+=sacc; \
    if(GK){DMA_K((t)+3,sl_cur);} if(GV){DMA_V((t)+1,sl_next);} \
    CMASK(C0,C1,t); \
    { float a=MX3(C0[0],C0[1],C1[0]),b=MX3(C0[2],C0[3],C1[1]); a=MX3(a,C1[2],C1[3]); \
      _Pragma("unroll") for(int r=4;r<16;r+=4){a=MX3(a,C0[r],C0[r+1]);b=MX3(b,C0[r+2],C0[r+3]);a=MX3(a,C1[r],C1[r+1]);b=MX3(b,C1[r+2],C1[r+3]);} \
      float rm=__builtin_fmaxf(a,b); { auto rr=__builtin_amdgcn_permlane32_swap(__float_as_uint(rm),__float_as_uint(rm),false,false); rm=__builtin_fmaxf(__uint_as_float(rr[0]),__uint_as_float(rr[1])); } \
      resc=false; \
      if(__builtin_expect(__any(rm>(float)THRL),0)){ const float dl=__builtin_fmaxf(rm,0.f); mhat+=dl; \
        _Pragma("unroll") for(int r=0;r<16;++r){C0[r]-=dl;C1[r]-=dl;} \
        const float f=__builtin_amdgcn_exp2f(-dl); l_reg*=f; if(hi==0)wsf[r32]=f; resc=true; } } \
    SBAR(); \
    GAPB(o[0]=__builtin_amdgcn_mfma_f32_32x32x16_bf16(PAF(0),VFR(0),o[0],0,0,0), C0,0); \
    GAPB(o[1]=__builtin_amdgcn_mfma_f32_32x32x16_bf16(PAF(0),VFR(4),o[1],0,0,0), C0,4); \
    KRD(GL,0); GAPB(o[0]=__builtin_amdgcn_mfma_f32_32x32x16_bf16(PAF(1),VFR(1),o[0],0,0,0), C0,8); \
    KRD(GL,1); GAPB(o[1]=__builtin_amdgcn_mfma_f32_32x32x16_bf16(PAF(1),VFR(5),o[1],0,0,0), C0,12); \
    KRD(GL,2); GAPB(o[0]=__builtin_amdgcn_mfma_f32_32x32x16_bf16(PAF(2),VFR(2),o[0],0,0,0), C1,0); \
    KRD(GL,3); GAPB(o[1]=__builtin_amdgcn_mfma_f32_32x32x16_bf16(PAF(2),VFR(6),o[1],0,0,0), C1,4); \
    GAPB(o[0]=__builtin_amdgcn_mfma_f32_32x32x16_bf16(PAF(3),VFR(3),o[0],0,0,0), C1,8); \
    GAPB(o[1]=__builtin_amdgcn_mfma_f32_32x32x16_bf16(PAF(3),VFR(7),o[1],0,0,0), C1,12); \
    }while(0)
  int t=1;
  #undef CMASK
  #define CMASK(P0,P1,t) do{}while(0)
  for(;t+5<NT;t+=2){
    STEP(pB0,pB1,pA0,pA1,t,true,true,true);     WAIT_BAR(2); RESC(); ROT();
    STEP(pA0,pA1,pB0,pB1,t+1,true,true,true);   WAIT_BAR(2); RESC(); ROT();
  }
  #undef CMASK
  #define CMASK(P0,P1,t) do{int jb_=(t)-(NT-4); if(jb_>=0)cmask(P0,P1,jb_,qrel,hi);}while(0)
  #define ENDW(tt) do{ if((tt)+3<NT){WAIT_BAR(2);} else if((tt)+2<NT){WAIT_BAR(1);} else {WAIT_BAR(0);} }while(0)
  for(;t+1<NT;t+=2){
    STEP(pB0,pB1,pA0,pA1,t,(t+3<NT),(t+1<NT),(t+1<NT));       ENDW(t);   RESC(); ROT();
    STEP(pA0,pA1,pB0,pB1,t+1,(t+4<NT),(t+2<NT),(t+2<NT));     ENDW(t+1); RESC(); ROT();
  }
  STEP(pB0,pB1,pA0,pA1,NT-1,false,false,false); RESC();
  { float sacc=pB0[0]+pB0[1]; _Pragma("unroll") for(int r=2;r<16;++r)sacc+=pB0[r]; _Pragma("unroll") for(int r=0;r<16;++r)sacc+=pB1[r]; l_reg+=sacc;
    pw0=(u32x4){PKW(pB0,0),PKW(pB0,2),PKW(pB0,4),PKW(pB0,6)};pw1=(u32x4){PKW(pB0,8),PKW(pB0,10),PKW(pB0,12),PKW(pB0,14)};pw2=(u32x4){PKW(pB1,0),PKW(pB1,2),PKW(pB1,4),PKW(pB1,6)};pw3=(u32x4){PKW(pB1,8),PKW(pB1,10),PKW(pB1,12),PKW(pB1,14)};
    SBAR(); pv(o,vb0+sl_cur,PAF(0),PAF(1),PAF(2),PAF(3)); }
  #undef PKW
  #undef PAF
  #undef VFR
  #undef PIN
  #undef MX3
  #undef GAPA
  #undef GAPB
  #undef EX
  #undef VRD
  #undef KRD
  #undef STEP
  #undef ENDW
  {auto rr=__builtin_amdgcn_permlane32_swap(__float_as_uint(l_reg),__float_as_uint(l_reg),false,false);l_reg=__uint_as_float(rr[0])+__uint_as_float(rr[1]);}
  if(hi==0)wsf[32+r32]=l_reg;asm volatile("s_waitcnt lgkmcnt(0)":::"memory");
  float rli[16];
  #pragma unroll
  for(int r=0;r<16;++r)rli[r]=__builtin_amdgcn_rcpf(wsf[32+crow(r,hi)]);
  bf16*Ow=O+(long)(q0+wid*QBLK)*OPITCH;
  { bf16*stg=(bf16*)(shm+LDS_OST)+wid*2048;
    #pragma unroll
    for(int r=0;r<16;++r){const int orow=crow(r,hi);
      #pragma unroll
      for(int d0=0;d0<2;++d0)stg[orow*64+d0*32+r32]=__float2bfloat16(o[d0][r]*rli[r]);}
    asm volatile("s_waitcnt lgkmcnt(0)":::"memory");
    #pragma unroll
    for(int i=0;i<4;++i){const int row=i*8+(lane>>3),ch=lane&7; const u32x4 v=*(const u32x4*)(stg+row*64+ch*8); ATTN_STORE16(Ow+(long)row*OPITCH+ch*8,v);} }
  asm volatile("s_waitcnt lgkmcnt(0)\n\ts_barrier":::"memory");
  #undef DMA_K
  #undef DMA_V
  #undef CMASK
  #undef BIAS
  #undef BIASINIT
  #undef START
  #undef RESC
  #undef ROT
}
__device__ __forceinline__ void sb_unit(int qb,const bf16*Q,const bf16*__restrict__ K,const bf16*__restrict__ V,bf16*O,char*shm){
  int tid_=threadIdx.x; asm volatile("":"+v"(tid_)); const int tid=tid_,lane=tid&63,r32=lane&31,hi=lane>>5; const int wid=__builtin_amdgcn_readfirstlane(tid>>6);
  const int q0=qb*QB;
  const bf16*Qw=Q+(long)(q0+wid*QBLK)*DM;
  const unsigned lds0=(unsigned)(uintptr_t)shm;
  typedef __attribute__((address_space(3))) int lds_i32; typedef __attribute__((address_space(3))) const u32x4* lds_u4ptr;
  lds_i32*flags=(lds_i32*)((lds_cptr)shm+LDS_WS);
  const bf16*ksrc=K+(long)lane*DM+wid*8;
  const bf16*vsrc=V+(long)(16*(wid&3)+(lane>>2))*DM+(wid>>2)*32+(lane&3)*8;
  const unsigned kdst=lds0+LDS_K+wid*1024, vdst=lds0+LDS_V+wid*1024;
  #define DMA_K(t,slot) glds16(ksrc+(long)(t)*KVBLK*DM,(unsigned)__builtin_amdgcn_readfirstlane(kdst+(slot)))
  #define DMA_V(t,slot) glds16(vsrc+(long)(t)*KVBLK*DM,(unsigned)__builtin_amdgcn_readfirstlane(vdst+(slot)))
  const int vb0=(int)(lds0+LDS_V)+((lane>>4)&1)*32+(lane&3)*8+(4*hi+((lane&15)>>2))*64;
  const int NT=(q0+QB)/KVBLK;
  DMA_K(NT-1,0);DMA_V(NT-1,0);
  bf16x8 qr[4];
  #pragma unroll
  for(int d0=0;d0<4;++d0)qr[d0]=*reinterpret_cast<const bf16x8*>(&Qw[(long)r32*DM+d0*16+hi*8]);
  f32x16 o[2];o[0]=f32x16{};o[1]=f32x16{};
  float T=0.f; const int t_abs=q0+wid*QBLK+r32; bool wdone=false;
  for(int i=0;;++i){
    const int jt=NT-1-i; const int slot=(i&1)*SLOTB; const bool more=jt>0;
    if(more){DMA_K(jt-1,slot^SLOTB);DMA_V(jt-1,slot^SLOTB); WAIT_BAR(2);} else {WAIT_BAR(0);}
    const bool band=(jt>=NT-4);
    if(!(wdone||(band&&64*(jt-(NT-4))>=QBLK*wid+QBLK))){
    f32x16 x0,x1; { f32x16 zero=f32x16{}; qkt(x0,x1,shm+LDS_K+slot,qr,zero,r32,hi); }
    f32x16 n0,n1;
    const int kb=64*jt+4*hi;
    #pragma unroll
    for(int r=0;r<16;++r){
      const float z0=x0[r],z1=x1[r];
      const float l0=__builtin_amdgcn_logf(1.0f+__builtin_amdgcn_exp2f(-__builtin_fabsf(z0))), l1=__builtin_amdgcn_logf(1.0f+__builtin_amdgcn_exp2f(-__builtin_fabsf(z1)));
      float a0=__builtin_fminf(z0,0.f)-l0, a1=__builtin_fminf(z1,0.f)-l1, m0=__builtin_fminf(-z0,0.f)-l0, m1=__builtin_fminf(-z1,0.f)-l1;
      if(band){ const int kv=kb+(r&3)+8*(r>>2); if(!(kv<t_abs)){a0=-INFINITY;m0=0.f;} if(!(kv+32<t_abs)){a1=-INFINITY;m1=0.f;} }
      x0[r]=a0;x1[r]=a1;n0[r]=m0;n1[r]=m1;
    }
    float g0[4],g1[4],p0s[4],p1s[4];
    #pragma unroll
    for(int a=0;a<4;++a){ g0[a]=(n0[4*a]+n0[4*a+1])+(n0[4*a+2]+n0[4*a+3]); g1[a]=(n1[4*a]+n1[4*a+1])+(n1[4*a+2]+n1[4*a+3]);
      { auto rr=__builtin_amdgcn_permlane32_swap(__float_as_uint(g0[a]),__float_as_uint(g0[a]),false,false); p0s[a]=__uint_as_float(hi?rr[0]:rr[1]); }
      { auto rr=__builtin_amdgcn_permlane32_swap(__float_as_uint(g1[a]),__float_as_uint(g1[a]),false,false); p1s[a]=__uint_as_float(hi?rr[0]:rr[1]); } }
    float run=T;
    #pragma unroll
    for(int a=3;a>=0;--a){ float off=run+(hi?0.f:p1s[a]); run+=g1[a]+p1s[a];
      const float t3=off,t2=t3+n1[4*a+3],t1=t2+n1[4*a+2],t0=t1+n1[4*a+1];
      x1[4*a+3]=__builtin_amdgcn_exp2f(x1[4*a+3]+t3); x1[4*a+2]=__builtin_amdgcn_exp2f(x1[4*a+2]+t2); x1[4*a+1]=__builtin_amdgcn_exp2f(x1[4*a+1]+t1); x1[4*a]=__builtin_amdgcn_exp2f(x1[4*a]+t0); }
    #pragma unroll
    for(int a=3;a>=0;--a){ float off=run+(hi?0.f:p0s[a]); run+=g0[a]+p0s[a];
      const float t3=off,t2=t3+n0[4*a+3],t1=t2+n0[4*a+2],t0=t1+n0[4*a+1];
      x0[4*a+3]=__builtin_amdgcn_exp2f(x0[4*a+3]+t3); x0[4*a+2]=__builtin_amdgcn_exp2f(x0[4*a+2]+t2); x0[4*a+1]=__builtin_amdgcn_exp2f(x0[4*a+1]+t1); x0[4*a]=__builtin_amdgcn_exp2f(x0[4*a]+t0); }
    T=run;
    u32x4 pw0,pw1,pw2,pw3;
    pw0=(u32x4){cvtpk_s(x0[0],x0[1]),cvtpk_s(x0[2],x0[3]),cvtpk_s(x0[4],x0[5]),cvtpk_s(x0[6],x0[7])};
    pw1=(u32x4){cvtpk_s(x0[8],x0[9]),cvtpk_s(x0[10],x0[11]),cvtpk_s(x0[12],x0[13]),cvtpk_s(x0[14],x0[15])};
    pw2=(u32x4){cvtpk_s(x1[0],x1[1]),cvtpk_s(x1[2],x1[3]),cvtpk_s(x1[4],x1[5]),cvtpk_s(x1[6],x1[7])};
    pw3=(u32x4){cvtpk_s(x1[8],x1[9]),cvtpk_s(x1[10],x1[11]),cvtpk_s(x1[12],x1[13]),cvtpk_s(x1[14],x1[15])};
    SBAR(); pv(o,vb0+slot,__builtin_bit_cast(bf16x8,pw0),__builtin_bit_cast(bf16x8,pw1),__builtin_bit_cast(bf16x8,pw2),__builtin_bit_cast(bf16x8,pw3));
    wdone=__all(T<-150.f);
    }
    if(lane==0)flags[wid]=wdone?1:0;
    WAIT_BAR(2);
    const u32x4 f0=*(lds_u4ptr)(flags), f1=*(lds_u4ptr)(flags+4);
    const bool alld=((f0.x&f0.y&f0.z&f0.w)&(f1.x&f1.y&f1.z&f1.w))!=0;
    if(!more||alld)break;
  }
  WAIT_BAR(0);
  bf16*Ow=O+(long)(q0+wid*QBLK)*OPITCH;
  { bf16*stg=(bf16*)(shm+LDS_OST)+wid*2048;
    #pragma unroll
    for(int r=0;r<16;++r){const int orow=crow(r,hi);
      #pragma unroll
      for(int d0=0;d0<2;++d0)stg[orow*64+d0*32+r32]=__float2bfloat16(o[d0][r]);}
    asm volatile("s_waitcnt lgkmcnt(0)":::"memory");
    #pragma unroll
    for(int i=0;i<4;++i){const int row=i*8+(lane>>3),ch=lane&7; const u32x4 v=*(const u32x4*)(stg+row*64+ch*8); ATTN_STORE16(Ow+(long)row*OPITCH+ch*8,v);} }
  asm volatile("s_waitcnt lgkmcnt(0)\n\ts_barrier":::"memory");
  #undef DMA_K
  #undef DMA_V
}
#undef SBAR
#undef WAIT_BAR
}

constexpr int BATCH = 8, SEQ = 4096, DM = 1024, DEPTH = 4, M = BATCH * SEQ, INC = 3334, NIN = 3584, DFF = 4096;
constexpr float EPS = 1e-6f;
constexpr size_t MiB = 1u << 20;
constexpr size_t WS_BAR = 128 * 1024;
constexpr size_t WS_SS = 1 * MiB;
constexpr size_t WS_LB = 3 * MiB;
constexpr size_t WS_JS = 3 * MiB + 256 * 1024;
constexpr size_t WS_DD = 3 * MiB + 512 * 1024;
constexpr size_t WS_W = 4 * MiB;
constexpr size_t W_LAYER = 25 * MiB, W_OUT = 7 * MiB, W_1 = 9 * MiB, W_2 = 17 * MiB;
constexpr size_t WS_XB = 104 * MiB;
constexpr size_t WS_P = 168 * MiB;
constexpr size_t P_HQ = 0, P_HK = 16 * MiB, P_HI = 32 * MiB, P_HG = 48 * MiB, P_HLF = 64 * MiB, P_SQ = 96 * MiB, P_FQ = 168 * MiB, P_LF = 240 * MiB, P_CC = 241 * MiB, P_US = 242 * MiB;
constexpr size_t HEADBUF = 24 * MiB;
constexpr size_t WS_MIX = 442 * MiB;
constexpr size_t WS_U = 168 * MiB;
constexpr size_t WS_END = 506 * MiB;
constexpr int LDS_BYTES = 147456;

typedef pg8::bf16_t bf16_t;
typedef pg8::f32x4 f32x4;
typedef unsigned u32x4 __attribute__((ext_vector_type(4)));
typedef unsigned u32x2 __attribute__((ext_vector_type(2)));
#define LAS __attribute__((address_space(3)))

__device__ __forceinline__ unsigned f2bf(float f) { unsigned u = __builtin_bit_cast(unsigned, f); return (u + 0x7fffu + ((u >> 16) & 1u)) >> 16; }
__device__ __forceinline__ unsigned pk2(float lo, float hi) { return pg8::cvt_pk_bf16(lo, hi); }
__device__ __forceinline__ float bf2f(unsigned short b) { return __builtin_bit_cast(float, (unsigned)b << 16); }
__device__ __forceinline__ float bflo(unsigned w) { return __builtin_bit_cast(float, w << 16); }
__device__ __forceinline__ float bfhi(unsigned w) { return __builtin_bit_cast(float, w & 0xffff0000u); }
__device__ __forceinline__ float logsig(float x) { return fminf(x, 0.f) - log1pf(expf(-fabsf(x))); }
__device__ __forceinline__ float wave_sum(float v) {
#pragma unroll
    for (int o = 1; o < 64; o <<= 1) v += __shfl_xor(v, o);
    return v;
}
#define ROWSCALES8(rs, ss, row0, fq) float rs[2][4]; _Pragma("unroll") for (int ai_ = 0; ai_ < 2; ++ai_) _Pragma("unroll") for (int m_ = 0; m_ < 4; ++m_) rs[ai_][m_] = rowscale(ss, (row0) + ai_ * 128 + m_ * 16, fq);
__device__ __forceinline__ float rowscale(const float* ss, int row, int fq) {
    const f32x4 p = *(const f32x4*)(ss + (size_t)row * 16 + 4 * fq);
    float s = (p[0] + p[1]) + (p[2] + p[3]);
    s += __shfl_xor(s, 16); s += __shfl_xor(s, 32);
    return rsqrtf(s * (1.0f / DM) + EPS);
}

#define ROWFENCE() asm volatile("" ::: "memory")
struct EpiResid {
    static constexpr bool PERM = true, AFTER_DRAIN = false;
    const float* xold; float* xnew; bf16_t* xb; float* ss;
    __device__ __forceinline__ void operator()(const f32x4 (&acc)[2][2][4][2], const pg8::Unit& u, int wr, int wc, int fr, int fq) const {
        const int row0 = u.pm * 256 + wr * 64 + fr, col0 = u.pn * 256 + wc * 32 + 8 * fq;
#pragma unroll
        for (int ai = 0; ai < 2; ++ai) {
            f32x4 pre[4][2][2];
#pragma unroll
            for (int m = 0; m < 4; ++m)
#pragma unroll
                for (int bj = 0; bj < 2; ++bj) { const size_t off = (size_t)(row0 + ai * 128 + m * 16) * DM + col0 + bj * 128; pre[m][bj][0] = *(const f32x4*)(xold + off); pre[m][bj][1] = *(const f32x4*)(xold + off + 4); }
#pragma unroll
            for (int m = 0; m < 4; ++m) {
                const int row = row0 + ai * 128 + m * 16; float sq = 0.f;
#pragma unroll
                for (int bj = 0; bj < 2; ++bj) {
                    const size_t off = (size_t)row * DM + col0 + bj * 128;
                    const f32x4 v0 = acc[ai][bj][m][0] + pre[m][bj][0], v1 = acc[ai][bj][m][1] + pre[m][bj][1];
                    *(f32x4*)(xnew + off) = v0; *(f32x4*)(xnew + off + 4) = v1;
                    u32x4 w; w.x = pk2(v0[0], v0[1]); w.y = pk2(v0[2], v0[3]); w.z = pk2(v1[0], v1[1]); w.w = pk2(v1[2], v1[3]);
                    *(u32x4*)(xb + off) = w;
                    sq += (v0[0] * v0[0] + v0[1] * v0[1]) + (v0[2] * v0[2] + v0[3] * v0[3]) + (v1[0] * v1[0] + v1[1] * v1[1]) + (v1[2] * v1[2] + v1[3] * v1[3]);
                }
                sq += __shfl_xor(sq, 16); sq += __shfl_xor(sq, 32);
                if (fq == 0) ss[(size_t)row * 16 + u.pn * 4 + wc] = sq;
            }
            ROWFENCE();
        }
    }
};
struct EpiRelu2 {
    static constexpr bool PERM = true, AFTER_DRAIN = false;
    bf16_t* U; const float* ss;
    __device__ __forceinline__ void operator()(const f32x4 (&acc)[2][2][4][2], const pg8::Unit& u, int wr, int wc, int fr, int fq) const {
        const int row0 = u.pm * 256 + wr * 64 + fr, col0 = u.pn * 256 + wc * 32 + 8 * fq;
        ROWSCALES8(rs8, ss, row0, fq)
#pragma unroll
        for (int ai = 0; ai < 2; ++ai)
#pragma unroll
            for (int m = 0; m < 4; ++m) {
                const int row = row0 + ai * 128 + m * 16; const float rs = rs8[ai][m];
#pragma unroll
                for (int bj = 0; bj < 2; ++bj) {
                    f32x4 v0 = acc[ai][bj][m][0] * rs, v1 = acc[ai][bj][m][1] * rs;
                    v0 = __builtin_elementwise_max(v0, (f32x4){0.f, 0.f, 0.f, 0.f}); v1 = __builtin_elementwise_max(v1, (f32x4){0.f, 0.f, 0.f, 0.f});
                    v0 = v0 * v0; v1 = v1 * v1;
                    u32x4 w; w.x = pk2(v0[0], v0[1]); w.y = pk2(v0[2], v0[3]); w.z = pk2(v1[0], v1[1]); w.w = pk2(v1[2], v1[3]);
                    *(u32x4*)(U + (size_t)row * DFF + col0 + bj * 128) = w;
                }
                ROWFENCE();
            }
    }
};
struct EpiInProj {
    static constexpr bool PERM = true, AFTER_DRAIN = false;
    const float* ss; unsigned char* P; const float* lbt;
    const float* gt; const float* fbias;
    __device__ __forceinline__ void operator()(const f32x4 (&acc)[2][2][4][2], const pg8::Unit& u, int wr, int wc, int fr, int fq) const {
        const int slot = u.pn * 4 + wc;
        if (slot > 52) return;
        const int row0 = u.pm * 256 + wr * 64 + fr;
        ROWSCALES8(rs8, ss, row0, fq)
        if (slot < 16) {
            const int kind = slot >> 2, cb = (slot & 3) * 64 + 8 * fq;
            if (kind == 1) {
                float* HLF = (float*)(P + P_HLF); bf16_t* HK = (bf16_t*)(P + P_HK);
#pragma unroll
                for (int ai = 0; ai < 2; ++ai)
#pragma unroll
                    for (int m = 0; m < 4; ++m) {
                        const int row = row0 + ai * 128 + m * 16; const float rs = rs8[ai][m];
#pragma unroll
                        for (int bj = 0; bj < 2; ++bj) {
                            float lf[8], kk[8];
#pragma unroll
                            for (int n = 0; n < 2; ++n) {
                                const f32x4 ll = *(const f32x4*)(lbt + cb + 32 * bj + 4 * n), om = *(const f32x4*)(lbt + 256 + cb + 32 * bj + 4 * n);
#pragma unroll
                                for (int i = 0; i < 4; ++i) {
                                    const float fl = acc[ai][bj][m][n][i] * rs;
                                    const float a = fminf(fl, 0.f) - __logf(1.0f + __expf(-fabsf(fl)));
                                    const float an = a - fl;
                                    const float b = ll[i] + an;
                                    lf[4 * n + i] = fmaxf(a, b) + __logf(1.0f + __expf(-fabsf(a - b)));
                                    kk[4 * n + i] = om[i] * __expf(an);
                                }
                            }
                            const size_t off = (size_t)row * 256 + cb + 32 * bj;
                            *(f32x4*)(HLF + off) = (f32x4){lf[0], lf[1], lf[2], lf[3]}; *(f32x4*)(HLF + off + 4) = (f32x4){lf[4], lf[5], lf[6], lf[7]};
                            u32x4 w; w.x = pk2(kk[0], kk[1]); w.y = pk2(kk[2], kk[3]); w.z = pk2(kk[4], kk[5]); w.w = pk2(kk[6], kk[7]);
                            *(u32x4*)(HK + off) = w;
                        }
                        ROWFENCE();
                    }
            } else {
                bf16_t* dst = (bf16_t*)(P + (kind == 0 ? P_HQ : (kind == 2 ? P_HI : P_HG)));
#pragma unroll
                for (int ai = 0; ai < 2; ++ai)
#pragma unroll
                    for (int m = 0; m < 4; ++m) {
                        const int row = row0 + ai * 128 + m * 16; const float rs = rs8[ai][m];
#pragma unroll
                        for (int bj = 0; bj < 2; ++bj) {
                            const f32x4 v0 = acc[ai][bj][m][0] * rs, v1 = acc[ai][bj][m][1] * rs;
                            u32x4 w; w.x = pk2(v0[0], v0[1]); w.y = pk2(v0[2], v0[3]); w.z = pk2(v1[0], v1[1]); w.w = pk2(v1[2], v1[3]);
                            *(u32x4*)(dst + (size_t)row * 256 + cb + 32 * bj) = w;
                        }
                        ROWFENCE();
                    }
            }
        } else if (slot < 52) {
            const int s2 = slot - 16, grp = s2 / 6, h = s2 % 6, role = grp % 3;
            bf16_t* dst = (bf16_t*)(P + P_SQ + (size_t)grp * HEADBUF) + (size_t)((u.pm >> 4) * 6 + h) * SEQ * 64 + 8 * fq;
            const float* gp = gt + (grp - (grp >= 3 ? 1 : 0)) * 64 + 8 * fq;
            const float qs = (role == 0) ? 0.125f * 1.4426950408889634f : 1.0f;
#pragma unroll
            for (int ai = 0; ai < 2; ++ai)
#pragma unroll
                for (int m = 0; m < 4; ++m) {
                    const int row = row0 + ai * 128 + m * 16; const float rs = rs8[ai][m];
                    float fac = rs;
                    if (role != 2) {
                        float sq = 0.f;
#pragma unroll
                        for (int bj = 0; bj < 2; ++bj)
#pragma unroll
                            for (int n = 0; n < 2; ++n) { const f32x4 x = acc[ai][bj][m][n]; sq += (x[0] * x[0] + x[1] * x[1]) + (x[2] * x[2] + x[3] * x[3]); }
                        sq += __shfl_xor(sq, 16); sq += __shfl_xor(sq, 32);
                        fac = rs * rsqrtf(rs * rs * sq * (1.0f / 64.0f) + EPS) * qs;
                    }
                    const int t = row & (SEQ - 1);
#pragma unroll
                    for (int bj = 0; bj < 2; ++bj) {
                        f32x4 v0 = acc[ai][bj][m][0] * fac, v1 = acc[ai][bj][m][1] * fac;
                        if (role != 2) { v0 = v0 * *(const f32x4*)(gp + 32 * bj); v1 = v1 * *(const f32x4*)(gp + 32 * bj + 4); }
                        u32x4 w; w.x = pk2(v0[0], v0[1]); w.y = pk2(v0[2], v0[3]); w.z = pk2(v1[0], v1[1]); w.w = pk2(v1[2], v1[3]);
                        *(u32x4*)(dst + (size_t)t * 64 + 32 * bj) = w;
                    }
                    ROWFENCE();
                }
        } else {
            float* LF = (float*)(P + P_LF);
#pragma unroll
            for (int ai = 0; ai < 2; ++ai)
#pragma unroll
                for (int m = 0; m < 4; ++m) {
                    const int row = row0 + ai * 128 + m * 16; const float rs = rs8[ai][m];
                    if (fq == 0) {
                        const f32x4 a0 = acc[ai][0][m][0], a1 = acc[ai][0][m][1];
                        *(f32x4*)(LF + (size_t)row * 8) = (f32x4){logsig(a0[0] * rs + fbias[0]), logsig(a0[1] * rs + fbias[1]), logsig(a0[2] * rs + fbias[2]), logsig(a0[3] * rs + fbias[3])};
                        *(f32x4*)(LF + (size_t)row * 8 + 4) = (f32x4){logsig(a1[0] * rs + fbias[4]), logsig(a1[1] * rs + fbias[5]), 0.f, 0.f};
                    }
                    ROWFENCE();
                }
        }
    }
};
#define XB_TMO      128
#define XB_XCNT(j)  (256  + 64 * (j))
#define XB_XSUB(j)  (1280 + 64 * (j))
#define XB_XGEN(j)  (2304 + 64 * (j))
#define XB_TOP      3328
#define XB_TOPGEN   3392
#define XCD_BAR_WORDS 3456
#define XB_SPIN_CAP (1u << 18)

__device__ __forceinline__ unsigned xb_ld(unsigned* p)              { return __hip_atomic_load(p, __ATOMIC_RELAXED, __HIP_MEMORY_SCOPE_AGENT); }
__device__ __forceinline__ unsigned xb_add(unsigned* p, unsigned v) { return __hip_atomic_fetch_add(p, v, __ATOMIC_RELAXED, __HIP_MEMORY_SCOPE_AGENT); }
__device__ __forceinline__ unsigned xb_xcc_id() { return (unsigned)__builtin_amdgcn_s_getreg((3 << 11) | 20) & 0xFu; }
#define XB_SPIN(cond, bar) do { unsigned _sp = 0; while (cond) { __builtin_amdgcn_s_sleep(1); \
    if ((++_sp & 255u) == 0u) { if (xb_ld(&(bar)[XB_TMO])) break; if (_sp > XB_SPIN_CAP) { atomicAdd(&(bar)[XB_TMO], 1u); break; } } } } while (0)

struct XcdBarrier {
    unsigned* bar; unsigned x;
    volatile LAS unsigned* st;
};

__device__ __forceinline__ XcdBarrier xcd_barrier_post(unsigned* bar, volatile LAS unsigned* st) {
    XcdBarrier b; b.bar = bar; b.x = xb_xcc_id(); b.st = st;
    if (threadIdx.x == 0) (void)xb_add(&bar[XB_XCNT(b.x)], 1u);
    return b;
}
__device__ __forceinline__ void xcd_barrier_complete(unsigned* bar, unsigned x, unsigned& nloc, unsigned& nx) {
    const unsigned G = gridDim.x * gridDim.y * gridDim.z;
    unsigned sum, cnt, mine, sp = 0u;
    for (;;) {
        sum = 0u; cnt = 0u; mine = 0u;
#pragma unroll
        for (unsigned j = 0; j < 16; ++j) { const unsigned c = xb_ld(&bar[XB_XCNT(j)]); sum += c; cnt += (c > 0u) ? 1u : 0u; mine = (j == x) ? c : mine; }
        if (sum == G) break;
        __builtin_amdgcn_s_sleep(1);
        if ((++sp & 255u) == 0u) { if (xb_ld(&bar[XB_TMO])) break; if (sp > XB_SPIN_CAP) { atomicAdd(&bar[XB_TMO], 1u); break; } }
    }
    nloc = mine > 0u ? mine : 1u; nx = cnt > 0u ? cnt : 1u;
}

__device__ __forceinline__ void xcd_barrier(const XcdBarrier& b) {
    asm volatile("s_waitcnt vmcnt(0)" ::: "memory");
    __syncthreads();
    if (threadIdx.x == 0) {
        unsigned* bar = b.bar;
        __builtin_amdgcn_s_waitcnt(0);
        unsigned nloc = b.st[0], nx = b.st[1];
        if (nloc == 0u) { xcd_barrier_complete(bar, b.x, nloc, nx); b.st[0] = nloc; b.st[1] = nx; }
        const unsigned old = xb_add(&bar[XB_XSUB(b.x)], 1u);
        const unsigned gen = old / nloc;
        if (old + 1u == (gen + 1u) * nloc) {
            __builtin_amdgcn_fence(__ATOMIC_RELEASE, "agent");
            asm volatile("s_waitcnt vmcnt(0)" ::: "memory");
            const unsigned og = xb_add(&bar[XB_TOP], 1u);
            const unsigned tg = og / nx;
            if (og + 1u == (tg + 1u) * nx) xb_add(&bar[XB_TOPGEN], 1u);
            else XB_SPIN(xb_ld(&bar[XB_TOPGEN]) == tg, bar);
            __builtin_amdgcn_fence(__ATOMIC_ACQUIRE, "agent");
            xb_add(&bar[XB_XGEN(b.x)], 1u);
            asm volatile("s_waitcnt vmcnt(0)" ::: "memory");
        } else {
            XB_SPIN(xb_ld(&bar[XB_XGEN(b.x)]) == gen, bar);
            __builtin_amdgcn_fence(__ATOMIC_ACQUIRE, "agent");
            asm volatile("s_waitcnt vmcnt(0)" ::: "memory");
        }
    }
    __syncthreads();
}

__device__ __forceinline__ void tr_item(const float* W, int ldw, int ncols_valid, int src_col0, int k0, const float* gain, bf16_t* WT, int K, int n0, LAS float* scr, int lane) {
#pragma unroll 8
    for (int i = 0; i < 32; ++i) { const int kk = 2 * i + (lane >> 5), c = src_col0 + (lane & 31);
        float v = (c < ncols_valid) ? W[(size_t)(k0 + kk) * ldw + c] : 0.f; if (gain) v *= gain[k0 + kk]; scr[kk * 33 + (lane & 31)] = v; }
    asm volatile("s_waitcnt lgkmcnt(0)" ::: "memory");
    const int c = lane & 7;
#pragma unroll
    for (int j = 0; j < 4; ++j) { const int n = (lane >> 3) + 8 * j; const LAS float* s = scr + (8 * c) * 33 + n;
        u32x4 o; o.x = pk2(s[0 * 33], s[1 * 33]); o.y = pk2(s[2 * 33], s[3 * 33]); o.z = pk2(s[4 * 33], s[5 * 33]); o.w = pk2(s[6 * 33], s[7 * 33]);
        *(u32x4*)(WT + (size_t)(n0 + n) * K + k0 + 8 * c) = o; }
    asm volatile("s_waitcnt lgkmcnt(0)" ::: "memory");
}

__device__ __forceinline__ void unpack8(const u32x4 w, float* d) { d[0] = bflo(w.x); d[1] = bfhi(w.x); d[2] = bflo(w.y); d[3] = bfhi(w.y); d[4] = bflo(w.z); d[5] = bfhi(w.z); d[6] = bflo(w.w); d[7] = bfhi(w.w); }

__device__ __forceinline__ void fox_cumsum_item(int bh, const float* LF, float* CC, int* JS, const float* gq, const float* gk, LAS float* sc) {
    int tid_ = threadIdx.x; asm volatile("" : "+v"(tid_)); const int tid = tid_, lane = tid & 63, wave = tid >> 6, b = bh / 6, h = bh % 6;
    float v[8]; float run = 0.f;
#pragma unroll
    for (int i = 0; i < 8; ++i) { run += LF[((size_t)b * SEQ + tid * 8 + i) * 8 + h]; v[i] = run; }
    float s = run;
#pragma unroll
    for (int o = 1; o < 64; o <<= 1) { const float n = __shfl_up(s, o); if (lane >= o) s += n; }
    __syncthreads();
    if (lane == 63) sc[wave] = s;
    __syncthreads();
    float base = s - run;
    for (int w = 0; w < wave; ++w) base += sc[w];
    LAS float* cl = sc + 64;
#pragma unroll
    for (int i = 0; i < 8; ++i) { const float c2 = (v[i] + base) * 1.4426950408889634f; CC[(size_t)bh * SEQ + tid * 8 + i] = c2; cl[tid * 8 + i] = c2; }
    __syncthreads();
    if (tid < 16) {
        float mq = 0.f, mk = 0.f;
        for (int d = 0; d < 64; ++d) { mq = fmaxf(mq, fabsf(gq[d])); mk = fmaxf(mk, fabsf(gk[d])); }
        const float zb = 1.4426950408889634f * 8.0f * mq * mk * 1.03f + 1.0f;
        const float thr = -(150.0f + 2.0f * zb);
        const int q0 = tid * 256, nt = q0 / 64 + 4; const float cq = cl[q0];
        int j = 0; while (j < nt - 4 && cq - cl[64 * j + 63] < thr) ++j;
        JS[bh * 16 + tid] = j & ~1;
    }
    __syncthreads();
}

__device__ __forceinline__ void stage_kv(const bf16_t* Kb, const bf16_t* Vb, int kt, LAS float* Kf, LAS float* Vf) {
    int tid_ = threadIdx.x; asm volatile("" : "+v"(tid_)); const int tid = tid_, key = tid >> 3, c8 = tid & 7;
    const u32x4 kw = *(const u32x4*)(Kb + ((size_t)(kt * 64 + key)) * 64 + c8 * 8), vw = *(const u32x4*)(Vb + ((size_t)(kt * 64 + key)) * 64 + c8 * 8);
    float kf[8], vf[8]; unpack8(kw, kf); unpack8(vw, vf);
    *(LAS f32x4*)(Kf + key * 64 + c8 * 8) = (f32x4){kf[0], kf[1], kf[2], kf[3]}; *(LAS f32x4*)(Kf + key * 64 + c8 * 8 + 4) = (f32x4){kf[4], kf[5], kf[6], kf[7]};
    *(LAS f32x4*)(Vf + key * 64 + c8 * 8) = (f32x4){vf[0], vf[1], vf[2], vf[3]}; *(LAS f32x4*)(Vf + key * 64 + c8 * 8 + 4) = (f32x4){vf[4], vf[5], vf[6], vf[7]};
}

__device__ __forceinline__ void fox_naive_item(int item, unsigned char* P, bf16_t* MIX, LAS float* lds) {
    int tid_ = threadIdx.x; asm volatile("" : "+v"(tid_)); const int tid = tid_, bh = item >> 3, qblk = item & 7, b = bh / 6, h = bh % 6, t = qblk * 512 + tid;
    const bf16_t* Qp = (const bf16_t*)(P + P_FQ) + ((size_t)bh * SEQ + t) * 64;
    const bf16_t* Kb = (const bf16_t*)(P + P_FQ + HEADBUF) + (size_t)bh * SEQ * 64;
    const bf16_t* Vb = (const bf16_t*)(P + P_FQ + 2 * HEADBUF) + (size_t)bh * SEQ * 64;
    const float* CC = (const float*)(P + P_CC) + (size_t)bh * SEQ;
    float q[64], o[64];
#pragma unroll
    for (int c = 0; c < 8; ++c) unpack8(*(const u32x4*)(Qp + c * 8), q + c * 8);
#pragma unroll
    for (int d = 0; d < 64; ++d) o[d] = 0.f;
    float m = -1e30f, l = 0.f; const float ct = CC[t];
    LAS float* Kf = lds; LAS float* Vf = lds + 4096; LAS float* cs = lds + 8192;
    const int ntile = (qblk + 1) * 8;
    for (int kt = 0; kt < ntile; ++kt) {
        __syncthreads();
        stage_kv(Kb, Vb, kt, Kf, Vf); if (tid < 64) cs[tid] = CC[kt * 64 + tid];
        __syncthreads();
        for (int s = 0; s < 64; ++s) {
            float z = 0.f;
#pragma unroll
            for (int d = 0; d < 64; ++d) z += q[d] * Kf[s * 64 + d];
            const float x = (kt * 64 + s <= t) ? z + (ct - cs[s]) : -1e30f;
            const float mn = fmaxf(m, x), sc = __expf(m - mn), p = __expf(x - mn);
            l = l * sc + p;
#pragma unroll
            for (int d = 0; d < 64; ++d) o[d] = o[d] * sc + p * Vf[s * 64 + d];
            m = mn;
        }
    }
    const float inv = 1.0f / l;
    bf16_t* op = MIX + ((size_t)b * SEQ + t) * DM + 640 + h * 64;
#pragma unroll
    for (int c = 0; c < 8; ++c) { u32x4 w; w.x = pk2(o[c * 8] * inv, o[c * 8 + 1] * inv); w.y = pk2(o[c * 8 + 2] * inv, o[c * 8 + 3] * inv); w.z = pk2(o[c * 8 + 4] * inv, o[c * 8 + 5] * inv); w.w = pk2(o[c * 8 + 6] * inv, o[c * 8 + 7] * inv); *(u32x4*)(op + c * 8) = w; }
}

__device__ __forceinline__ void sb_naive_item(int item, unsigned char* P, bf16_t* MIX, LAS float* lds) {
    int tid_ = threadIdx.x; asm volatile("" : "+v"(tid_)); const int tid = tid_, bh = item >> 3, qblk = item & 7, b = bh / 6, h = bh % 6, t = qblk * 512 + tid;
    const bf16_t* Qp = (const bf16_t*)(P + P_SQ) + ((size_t)bh * SEQ + t) * 64;
    const bf16_t* Kb = (const bf16_t*)(P + P_SQ + HEADBUF) + (size_t)bh * SEQ * 64;
    const bf16_t* Vb = (const bf16_t*)(P + P_SQ + 2 * HEADBUF) + (size_t)bh * SEQ * 64;
    float q[64], o[64];
#pragma unroll
    for (int c = 0; c < 8; ++c) unpack8(*(const u32x4*)(Qp + c * 8), q + c * 8);
#pragma unroll
    for (int d = 0; d < 64; ++d) o[d] = 0.f;
    float tail = 0.f;
    LAS float* Kf = lds; LAS float* Vf = lds + 4096;
    for (int kt = qblk * 8 + 7; kt >= 0; --kt) {
        __syncthreads();
        stage_kv(Kb, Vb, kt, Kf, Vf);
        __syncthreads();
        for (int s = 63; s >= 0; --s) {
            float z = 0.f;
#pragma unroll
            for (int d = 0; d < 64; ++d) z += q[d] * Kf[s * 64 + d];
            const float ls = fminf(z, 0.f) - __logf(1.0f + __expf(-fabsf(z)));
            const bool act = (kt * 64 + s) < t;
            const float A = act ? __expf(ls + tail) : 0.f;
#pragma unroll
            for (int d = 0; d < 64; ++d) o[d] += A * Vf[s * 64 + d];
            tail += act ? (ls - z) : 0.f;
        }
        if (__syncthreads_and(tail < -100.f)) break;
    }
    bf16_t* op = MIX + ((size_t)b * SEQ + t) * DM + 256 + h * 64;
#pragma unroll
    for (int c = 0; c < 8; ++c) { u32x4 w; w.x = pk2(o[c * 8], o[c * 8 + 1]); w.y = pk2(o[c * 8 + 2], o[c * 8 + 3]); w.z = pk2(o[c * 8 + 4], o[c * 8 + 5]); w.w = pk2(o[c * 8 + 6], o[c * 8 + 7]); *(u32x4*)(op + c * 8) = w; }
}

__device__ __forceinline__ void hgrn_naive_item(int item, unsigned char* P, bf16_t* MIX, const float* hgn, LAS float* lds) {
    int tid_ = threadIdx.x; asm volatile("" : "+v"(tid_)); const int tid = tid_, lane = tid & 63, w = tid >> 6, kg = lane >> 3, vi = lane & 7, vcol = 8 * w + vi, b = item >> 2, h = item & 3;
    const bf16_t* HQ = (const bf16_t*)(P + P_HQ); const bf16_t* HK = (const bf16_t*)(P + P_HK); const bf16_t* HI = (const bf16_t*)(P + P_HI); const bf16_t* HG = (const bf16_t*)(P + P_HG);
    const float* HLF = (const float*)(P + P_HLF);
    LAS float* qf = lds; LAS float* kf = lds + 4096; LAS float* ff = lds + 8192; LAS float* vf = lds + 12288; LAS float* ob = lds + 16384;
    float S[8];
#pragma unroll
    for (int j = 0; j < 8; ++j) S[j] = 0.f;
    const int tok = tid >> 3, c8 = tid & 7;
    float gn[8];
#pragma unroll
    for (int e = 0; e < 8; ++e) gn[e] = hgn[c8 * 8 + e];
    for (int c = 0; c < 64; ++c) {
        const size_t off = ((size_t)b * SEQ + c * 64 + tok) * 256 + h * 64 + c8 * 8;
        __syncthreads();
        {
            float a[8];
            unpack8(*(const u32x4*)(HQ + off), a);
#pragma unroll
            for (int e = 0; e < 8; ++e) qf[tok * 64 + c8 * 8 + e] = a[e];
            unpack8(*(const u32x4*)(HK + off), a);
#pragma unroll
            for (int e = 0; e < 8; ++e) kf[tok * 64 + c8 * 8 + e] = a[e];
            unpack8(*(const u32x4*)(HI + off), a);
#pragma unroll
            for (int e = 0; e < 8; ++e) vf[tok * 64 + c8 * 8 + e] = a[e];
            const f32x4 l0 = *(const f32x4*)(HLF + off), l1 = *(const f32x4*)(HLF + off + 4);
#pragma unroll
            for (int e = 0; e < 4; ++e) { ff[tok * 64 + c8 * 8 + e] = expf(l0[e]); ff[tok * 64 + c8 * 8 + 4 + e] = expf(l1[e]); }
        }
        __syncthreads();
        for (int tk = 0; tk < 64; ++tk) {
            const float vv = vf[tk * 64 + vcol]; float op = 0.f;
#pragma unroll
            for (int j = 0; j < 8; ++j) { const int k = 8 * kg + j; S[j] = ff[tk * 64 + k] * S[j] + kf[tk * 64 + k] * vv; op += qf[tk * 64 + k] * S[j]; }
            op += __shfl_xor(op, 8); op += __shfl_xor(op, 16); op += __shfl_xor(op, 32);
            if (kg == 0) ob[tk * 64 + vcol] = op;
        }
        __syncthreads();
        {
            float ov[8], g[8]; float sq = 0.f;
#pragma unroll
            for (int e = 0; e < 8; ++e) { ov[e] = ob[tok * 64 + c8 * 8 + e]; sq += ov[e] * ov[e]; }
            sq += __shfl_xor(sq, 1); sq += __shfl_xor(sq, 2); sq += __shfl_xor(sq, 4);
            const float rn = rsqrtf(sq * (1.0f / 64.0f) + EPS);
            unpack8(*(const u32x4*)(HG + off), g);
            float r[8];
#pragma unroll
            for (int e = 0; e < 8; ++e) r[e] = ov[e] * rn * gn[e] * (g[e] / (1.0f + expf(-g[e])));
            u32x4 wv; wv.x = pk2(r[0], r[1]); wv.y = pk2(r[2], r[3]); wv.z = pk2(r[4], r[5]); wv.w = pk2(r[6], r[7]);
            *(u32x4*)(MIX + ((size_t)b * SEQ + c * 64 + tok) * DM + h * 64 + c8 * 8) = wv;
        }
    }
}

constexpr int HG_SLOT = 32768, HG_PRE = 16384, HG_TOT = 16384 + 1280, HG_VT = 20480, HG_VP = 72;
typedef short hbf16x8 __attribute__((ext_vector_type(8)));
typedef short hbf16x4 __attribute__((ext_vector_type(4)));
__device__ __forceinline__ hbf16x8 pack8(const float* x) { u32x4 w; w.x = pk2(x[0], x[1]); w.y = pk2(x[2], x[3]); w.z = pk2(x[4], x[5]); w.w = pk2(x[6], x[7]); return __builtin_bit_cast(hbf16x8, w); }

__device__ __forceinline__ void hg_stage(int tid, size_t row0, int h, const float* HLF, const bf16_t* HI, LAS unsigned char* sb) {
    const int lt = tid & 255, k = lt & 63, seg = lt >> 6;
    LAS float* bl = (LAS float*)sb; LAS float* pre = (LAS float*)(sb + HG_PRE); LAS float* tot = (LAS float*)(sb + HG_TOT); LAS bf16_t* vt = (LAS bf16_t*)(sb + HG_VT);
    float run = 0.f;
#pragma unroll
    for (int i = 0; i < 16; ++i) { const int t = 16 * seg + i; run += HLF[(row0 + t) * 256 + h * 64 + k]; bl[t * 64 + k] = run; }
    tot[seg * 64 + k] = run;
    {
        const int s = lt >> 2, c0 = (lt & 3) * 16;
        const u32x4 w0 = *(const u32x4*)(HI + (row0 + s) * 256 + h * 64 + c0), w1 = *(const u32x4*)(HI + (row0 + s) * 256 + h * 64 + c0 + 8);
        const unsigned ww[8] = {w0.x, w0.y, w0.z, w0.w, w1.x, w1.y, w1.z, w1.w};
#pragma unroll
        for (int e = 0; e < 8; ++e) { vt[(c0 + 2 * e) * HG_VP + s] = (bf16_t)(ww[e] & 0xffffu); vt[(c0 + 2 * e + 1) * HG_VP + s] = (bf16_t)(ww[e] >> 16); }
    }
    __syncthreads();
    if (lt < 64) { float p = 0.f;
#pragma unroll
        for (int sg = 0; sg < 4; ++sg) { pre[sg * 64 + lt] = p; p += tot[sg * 64 + lt]; }
        pre[4 * 64 + lt] = p; }
    __syncthreads();
}

__device__ __forceinline__ void hgrn_a_item(int item, unsigned char* P, float* DD, LAS unsigned char* L) {
    int tid_ = threadIdx.x; asm volatile("" : "+v"(tid_)); const int tid = tid_, lane = tid & 63, wq = (tid >> 6) & 3, cs = tid >> 8, r = lane & 15, g = lane >> 4;
    const int bh = item >> 5, chunk = (item & 31) * 2 + cs, b = bh >> 2, h = bh & 3;
    const size_t row0 = (size_t)b * SEQ + chunk * 64;
    const bf16_t* HK = (const bf16_t*)(P + P_HK); float* UT = (float*)(P + P_US);
    LAS unsigned char* sb = L + cs * HG_SLOT;
    hg_stage(tid, row0, h, (const float*)(P + P_HLF), (const bf16_t*)(P + P_HI), sb);
    const LAS float* bl = (const LAS float*)sb; const LAS float* pre = (const LAS float*)(sb + HG_PRE); const LAS unsigned char* vt = sb + HG_VT;
    const int k = 16 * wq + r; const float pre4 = pre[4 * 64 + k];
    hbf16x8 af[2];
#pragma unroll
    for (int ks = 0; ks < 2; ++ks) { const float pj = pre4 - pre[(2 * ks + (g >> 1)) * 64 + k]; float x[8];
#pragma unroll
        for (int j = 0; j < 8; ++j) { const int s = 32 * ks + 8 * g + j; x[j] = bf2f(HK[(row0 + s) * 256 + h * 64 + k]) * __expf(pj - bl[s * 64 + k]); }
        af[ks] = pack8(x); }
    float* ut = UT + ((size_t)(bh * 64 + chunk) * 64) * 64;
#pragma unroll
    for (int vtile = 0; vtile < 4; ++vtile) { f32x4 acc = {0.f, 0.f, 0.f, 0.f};
#pragma unroll
        for (int ks = 0; ks < 2; ++ks) { const hbf16x8 bf = *(const LAS hbf16x8*)(vt + (16 * vtile + r) * (HG_VP * 2) + (32 * ks + 8 * g) * 2); acc = __builtin_amdgcn_mfma_f32_16x16x32_bf16(af[ks], bf, acc, 0, 0, 0); }
        *(f32x4*)(ut + (size_t)(16 * vtile + r) * 64 + 16 * wq + 4 * g) = acc; }
    if (g == 0) DD[(size_t)(bh * 64 + chunk) * 64 + k] = __expf(pre4);
}

__device__ __forceinline__ void hgrn_b_scan(int bx, int G, unsigned char* P, const float* DD) {
    int tid_ = threadIdx.x; asm volatile("" : "+v"(tid_));
    float* UT = (float*)(P + P_US);
    for (int gid = bx * 512 + tid_; gid < 32 * 4096; gid += G * 512) {
        const int bh = gid >> 12, e = gid & 4095; float* u = UT + (size_t)bh * 64 * 4096 + e; const float* dd = DD + (size_t)bh * 64 * 64 + (e & 63);
        float S = 0.f;
        for (int c0 = 0; c0 < 64; c0 += 8) { float tu[8], td[8];
#pragma unroll
            for (int i = 0; i < 8; ++i) { tu[i] = u[(size_t)(c0 + i) * 4096]; td[i] = dd[(c0 + i) * 64]; }
#pragma unroll
            for (int i = 0; i < 8; ++i) { u[(size_t)(c0 + i) * 4096] = S; S = td[i] * S + tu[i]; } }
    }
}

__device__ __forceinline__ void hgrn_c_item(int item, unsigned char* P, bf16_t* MIX, const float* hgn, LAS unsigned char* L) {
    int tid_ = threadIdx.x; asm volatile("" : "+v"(tid_)); const int tid = tid_, lane = tid & 63, I = (tid >> 6) & 3, cs = tid >> 8, r = lane & 15, g = lane >> 4;
    const int bh = item >> 5, chunk = (item & 31) * 2 + cs, b = bh >> 2, h = bh & 3;
    const size_t row0 = (size_t)b * SEQ + chunk * 64;
    const bf16_t* HQ = (const bf16_t*)(P + P_HQ); const bf16_t* HK = (const bf16_t*)(P + P_HK); const bf16_t* HG = (const bf16_t*)(P + P_HG); const float* ST = (const float*)(P + P_US);
    LAS unsigned char* sb = L + cs * HG_SLOT;
    hg_stage(tid, row0, h, (const float*)(P + P_HLF), (const bf16_t*)(P + P_HI), sb);
    const LAS float* bl = (const LAS float*)sb; const LAS float* pre = (const LAS float*)(sb + HG_PRE); const LAS unsigned char* vt = sb + HG_VT;
    const int t = 16 * I + r;
    hbf16x8 qtf[2], qhf[2];
#pragma unroll
    for (int ks = 0; ks < 2; ++ks) { const int kb = 32 * ks + 8 * g; float q[8], xt[8], xh[8];
        unpack8(*(const u32x4*)(HQ + (row0 + t) * 256 + h * 64 + kb), q);
#pragma unroll
        for (int j = 0; j < 8; ++j) { xt[j] = q[j] * __expf(bl[t * 64 + kb + j]); xh[j] = xt[j] * __expf(pre[I * 64 + kb + j]); }
        qtf[ks] = pack8(xt); qhf[ks] = pack8(xh); }
    f32x4 at[4];
#pragma unroll
    for (int J = 0; J < 4; ++J) { at[J] = (f32x4){0.f, 0.f, 0.f, 0.f};
        if (J <= I) { const int s = 16 * J + r;
#pragma unroll
            for (int ks = 0; ks < 2; ++ks) { const int kb = 32 * ks + 8 * g; float kk[8], x[8];
                unpack8(*(const u32x4*)(HK + (row0 + s) * 256 + h * 64 + kb), kk);
#pragma unroll
                for (int j = 0; j < 8; ++j) x[j] = kk[j] * __expf(fminf(pre[I * 64 + kb + j] - pre[J * 64 + kb + j] - bl[s * 64 + kb + j], 80.f));
                at[J] = __builtin_amdgcn_mfma_f32_16x16x32_bf16(pack8(x), qtf[ks], at[J], 0, 0, 0); }
            if (J == I) {
#pragma unroll
                for (int i = 0; i < 4; ++i) at[J][i] = (4 * g + i <= r) ? at[J][i] : 0.f; } } }
    hbf16x8 pf[2];
#pragma unroll
    for (int k2 = 0; k2 < 2; ++k2) { const float x[8] = {at[2 * k2][0], at[2 * k2][1], at[2 * k2][2], at[2 * k2][3], at[2 * k2 + 1][0], at[2 * k2 + 1][1], at[2 * k2 + 1][2], at[2 * k2 + 1][3]}; pf[k2] = pack8(x); }
    const float* st = ST + ((size_t)(bh * 64 + chunk) * 64) * 64;
    f32x4 o[4];
#pragma unroll
    for (int vtile = 0; vtile < 4; ++vtile) { f32x4 acc = {0.f, 0.f, 0.f, 0.f}; const int v = 16 * vtile + r;
#pragma unroll
        for (int ks = 0; ks < 2; ++ks) { const float* sp = st + (size_t)v * 64 + 32 * ks + 8 * g; const f32x4 s0 = *(const f32x4*)sp, s1 = *(const f32x4*)(sp + 4);
            const float x[8] = {s0[0], s0[1], s0[2], s0[3], s1[0], s1[1], s1[2], s1[3]};
            acc = __builtin_amdgcn_mfma_f32_16x16x32_bf16(qhf[ks], pack8(x), acc, 0, 0, 0); }
#pragma unroll
        for (int k2 = 0; k2 < 2; ++k2) { if (k2 == 0 || I >= 2) {
            const hbf16x4 v0 = *(const LAS hbf16x4*)(vt + v * (HG_VP * 2) + (32 * k2 + 4 * g) * 2), v1 = *(const LAS hbf16x4*)(vt + v * (HG_VP * 2) + (32 * k2 + 16 + 4 * g) * 2);
            const hbf16x8 vf = {v0[0], v0[1], v0[2], v0[3], v1[0], v1[1], v1[2], v1[3]};
            acc = __builtin_amdgcn_mfma_f32_16x16x32_bf16(pf[k2], vf, acc, 0, 0, 0); } }
        o[vtile] = acc; }
#pragma unroll
    for (int i = 0; i < 4; ++i) { float sq = 0.f;
#pragma unroll
        for (int vtile = 0; vtile < 4; ++vtile) sq += o[vtile][i] * o[vtile][i];
        sq += __shfl_xor(sq, 1); sq += __shfl_xor(sq, 2); sq += __shfl_xor(sq, 4); sq += __shfl_xor(sq, 8);
        const float rn = rsqrtf(sq * (1.0f / 64.0f) + EPS); const size_t row = row0 + 16 * I + 4 * g + i;
#pragma unroll
        for (int vtile = 0; vtile < 4; ++vtile) { const int v = 16 * vtile + r; const float gg = bf2f(HG[row * 256 + h * 64 + v]);
            MIX[row * DM + h * 64 + v] = (bf16_t)f2bf(o[vtile][i] * rn * hgn[v] * (gg / (1.0f + __expf(-gg)))); } }
}

struct Args { const float* in[14]; float* out; unsigned char* ws; int ph_lo, ph_hi; };
constexpr int NPHASE = 1 + 7 * DEPTH;

__global__ void __launch_bounds__(512, 2) fwd(Args a) {
    extern __shared__ __attribute__((aligned(16))) unsigned char lds[];
    cg::grid_group grid = cg::this_grid();
    LAS unsigned char* L = (LAS unsigned char*)lds;
    if (threadIdx.x < 32) ((LAS unsigned*)(L + LDS_BYTES - 128))[threadIdx.x] = 0u;
    __syncthreads();
    for (int ph = a.ph_lo; ph < a.ph_hi; ++ph) {
        int G = gridDim.x, bx = blockIdx.x; asm volatile("" : "+s"(G), "+s"(bx));
        typedef const __attribute__((address_space(4))) Args* KArgP;
        KArgP ap = (KArgP)__builtin_amdgcn_kernarg_segment_ptr(); asm volatile("" : "+s"(ap));
        unsigned char* ws = ap->ws;
        float* SS = (float*)(ws + WS_SS); float* LB = (float*)(ws + WS_LB);
        bf16_t* XB = (bf16_t*)(ws + WS_XB); bf16_t* MIX = (bf16_t*)(ws + WS_MIX); bf16_t* UB = (bf16_t*)(ws + WS_U);
        unsigned char* P = ws + WS_P;
#ifdef PROBE_T
        if (ph == NPHASE) {
            if (bx == 0) { const unsigned long long* ts_ = (const unsigned long long*)(ws + 65536); unsigned long long sa = 0, sb = 0;
                for (int p = 1; p < NPHASE; ++p) { const int kk_ = (p - 1) % 7; const unsigned long long d = ts_[p] - ts_[p - 1]; if (PROBE_A(kk_)) sa += d; if (PROBE_B(kk_)) sb += d; }
                const float fa = (float)sa * 1e-3f, fb = (float)sb * 1e-3f; float* o_ = ap->out;
                for (int i = threadIdx.x; i < (1 << 20); i += 512) o_[(1 << 20) + i] += fb;
                if (threadIdx.x == 0) o_[0] = fa; }
        } else
#endif
        if (ph == 0) {
            int tid = threadIdx.x; asm volatile("" : "+v"(tid)); const int lane = tid & 63, wave = __builtin_amdgcn_readfirstlane(tid >> 6);
            LAS float* scr = (LAS float*)(L + wave * 16384);
            const int gw = bx * 8 + wave, NGW = G * 8;
            constexpr int I_IN = 16 * 112, I_OUT = 16 * 32, I_1 = 16 * 128, I_2 = 64 * 32, I_L = I_IN + I_OUT + I_1 + I_2;
            for (int it = gw; it < DEPTH * I_L; it += NGW) {
                const int l = it / I_L; int r = it % I_L;
                unsigned char* wl = ws + WS_W + (size_t)l * W_LAYER;
                if (r < I_IN) { const int kb = r / 112, nb = r % 112, n0 = nb * 32, pn = n0 >> 8, p = n0 & 255, slot = 4 * pn + ((p & 127) >> 5), sc0 = 64 * slot + 32 * (p >> 7);
                    tr_item(ap->in[3] + (size_t)l * DM * INC, INC, INC, sc0, kb * 64, ap->in[2] + l * DM, (bf16_t*)wl, DM, n0, scr, lane); continue; }
                r -= I_IN;
                if (r < I_OUT) { const int kb = r / 32, nb = r % 32; tr_item(ap->in[10] + (size_t)l * DM * DM, DM, DM, nb * 32, kb * 64, nullptr, (bf16_t*)(wl + W_OUT), DM, nb * 32, scr, lane); continue; }
                r -= I_OUT;
                if (r < I_1) { const int kb = r / 128, nb = r % 128; tr_item(ap->in[12] + (size_t)l * DM * DFF, DFF, DFF, nb * 32, kb * 64, ap->in[11] + l * DM, (bf16_t*)(wl + W_1), DM, nb * 32, scr, lane); continue; }
                r -= I_1;
                { const int kb = r / 32, nb = r % 32; tr_item(ap->in[13] + (size_t)l * DFF * DM, DM, DM, nb * 32, kb * 64, nullptr, (bf16_t*)(wl + W_2), DFF, nb * 32, scr, lane); }
            }
            const float* x = ap->in[0];
            for (int m = gw; m < M; m += NGW) {
                const f32x4* xr = (const f32x4*)(x + (size_t)m * DM) + lane; f32x4 v[4]; float s = 0.f;
#pragma unroll
                for (int j = 0; j < 4; ++j) { v[j] = xr[64 * j]; s += (v[j][0] * v[j][0] + v[j][1] * v[j][1]) + (v[j][2] * v[j][2] + v[j][3] * v[j][3]); }
                const float tot = wave_sum(s);
                u32x2* o8 = (u32x2*)(XB + (size_t)m * DM) + lane;
#pragma unroll
                for (int j = 0; j < 4; ++j) { u32x2 w; w.x = pk2(v[j][0], v[j][1]); w.y = pk2(v[j][2], v[j][3]); o8[64 * j] = w; }
                if (lane < 16) SS[(size_t)m * 16 + lane] = (lane == 0) ? tot : 0.f;
            }
            if (bx == 2 && tid < 64) ((unsigned*)ws)[tid] = 0u;
            if (bx == 3) for (int i = tid; i < XCD_BAR_WORDS; i += 512) ((unsigned*)(ws + WS_BAR))[i] = 0u;
            if (bx == 1) {
                for (int i = tid; i < 1024; i += 512) { const int l = i >> 8, wh = (i >> 6) & 3, d = i & 63; LB[2048 + i] = ap->in[5 + wh][l * 64 + d]; }
                if (tid < 32) { const int l = tid >> 3, e = tid & 7; LB[3072 + tid] = (e < 6) ? ap->in[9][l * 6 + e] : 0.f; }
            }
            if (bx == 0 && tid < 256) {
                const float* lg = ap->in[1]; float e[DEPTH]; float mx = -1e30f, sum = 0.f;
#pragma unroll
                for (int l = 0; l < DEPTH; ++l) mx = fmaxf(mx, lg[l * 256 + tid]);
#pragma unroll
                for (int l = 0; l < DEPTH; ++l) { e[l] = expf(lg[l * 256 + tid] - mx); sum += e[l]; }
                float c = 0.f;
#pragma unroll
                for (int l = 0; l < DEPTH; ++l) { if (l > 0) c += e[l] / sum; LB[l * 512 + tid] = logf(fmaxf(c, 1e-30f)); LB[l * 512 + 256 + tid] = 1.0f - c; }
            }
        } else {
            const int l = (ph - 1) / 7, k = (ph - 1) % 7;
#ifdef REP_K
            const int nrep = (k == REP_K) ? 2 : 1;
#else
            const int nrep = 1;
#endif
            for (int rep = 0; rep < nrep; ++rep) {
            if (rep) { XcdBarrier xb_; xb_.bar = (unsigned*)(ws + WS_BAR); xb_.x = xb_xcc_id(); xb_.st = (volatile LAS unsigned*)(L + LDS_BYTES - 128); xcd_barrier(xb_); }
            unsigned char* wl = ws + WS_W + (size_t)l * W_LAYER;
            if (k == 0) {
                pg8::Gemm g{XB, (const bf16_t*)wl, M, NIN, DM}; pg8::StaticOrder S; S.init(M, NIN, G, bx);
                EpiInProj E{SS, P, LB + l * 512, LB + 2048 + l * 256, LB + 3072 + l * 8};
                pg8::gemm_phase<EpiInProj, pg8::StaticOrder, true, true>(L, g, S, E);
            } else if (k == 1) {
                int tid = threadIdx.x; asm volatile("" : "+v"(tid));
                unsigned* ctr = (unsigned*)ws + l * 16 + 1 + rep * 4;
                volatile LAS int* sh = (volatile LAS int*)(L + LDS_BYTES - 64);
                for (;;) {
                    if (tid == 0) sh[0] = (int)atomicAdd(ctr, 1u);
                    __syncthreads();
                    const int idx = __builtin_amdgcn_readfirstlane(sh[0]);
                    __syncthreads();
                    if (idx >= 816 + 1024) break;
                    if (idx < 768) { const int qb = 15 - idx / 48, bh = idx % 48, b = bh / 6, h = bh % 6; typedef attn_body::bf16 abf;
                        attn_body::sb_unit(qb, (const abf*)(P + P_SQ) + (size_t)bh * SEQ * 64, (const abf*)(P + P_SQ + HEADBUF) + (size_t)bh * SEQ * 64, (const abf*)(P + P_SQ + 2 * HEADBUF) + (size_t)bh * SEQ * 64,
                                           (abf*)MIX + (size_t)b * SEQ * DM + 256 + h * 64, (char*)lds); }
                    else if (idx < 816) fox_cumsum_item(idx - 768, (const float*)(P + P_LF), (float*)(P + P_CC), (int*)(ws + WS_JS), LB + 2048 + l * 256 + 128, LB + 2048 + l * 256 + 192, (LAS float*)L);
                    else hgrn_a_item(idx - 816, P, (float*)(ws + WS_DD), L);
                    __syncthreads();
                }
            } else if (k == 2) {
                hgrn_b_scan(bx, G, P, (const float*)(ws + WS_DD));
            } else if (k == 3) {
                int tid = threadIdx.x; asm volatile("" : "+v"(tid));
                unsigned* ctr = (unsigned*)ws + l * 16 + rep * 4;
                volatile LAS int* sh = (volatile LAS int*)(L + LDS_BYTES - 64);
                for (;;) {
                    if (tid == 0) sh[0] = (int)atomicAdd(ctr, 1u);
                    __syncthreads();
                    const int idx = __builtin_amdgcn_readfirstlane(sh[0]);
                    __syncthreads();
                    if (idx >= 768 + 1024) break;
                    if (idx >= 768) { hgrn_c_item(idx - 768, P, MIX, ap->in[4] + l * 64, L); __syncthreads(); continue; }
                    const int qb = 15 - idx / 48, bh = idx % 48, b = bh / 6, h = bh % 6;
                    typedef attn_body::bf16 abf;
                    const int jstart = ((const int*)(ws + WS_JS))[bh * 16 + qb];
                    attn_body::attn_unit<8>(qb, jstart, (const abf*)(P + P_FQ) + (size_t)bh * SEQ * 64, (const abf*)(P + P_FQ + HEADBUF) + (size_t)bh * SEQ * 64, (const abf*)(P + P_FQ + 2 * HEADBUF) + (size_t)bh * SEQ * 64,
                                            (abf*)MIX + (size_t)b * SEQ * DM + 640 + h * 64, (const float*)(P + P_CC) + (size_t)bh * SEQ, (char*)lds);
                }
            } else if (k == 5) {
                pg8::Gemm g{XB, (const bf16_t*)(wl + W_1), M, DFF, DM}; pg8::StaticOrder S; S.init(M, DFF, G, bx);
                EpiRelu2 E{UB, SS};
                pg8::gemm_phase<EpiRelu2, pg8::StaticOrder, true, true>(L, g, S, E);
            } else {
                const bool ff2 = (k == 6);
                pg8::Gemm g{ff2 ? UB : MIX, (const bf16_t*)(wl + (ff2 ? W_2 : W_OUT)), M, DM, ff2 ? DFF : DM}; pg8::StaticOrder S; S.init(M, DM, G, bx);
                EpiResid E{(!ff2 && l == 0) ? ap->in[0] : ap->out, ap->out, XB, SS};
                pg8::gemm_phase<EpiResid, pg8::StaticOrder, true, true>(L, g, S, E);
            }
            }
        }
#ifdef PROBE_T
        if (bx == 0 && threadIdx.x == 0) ((unsigned long long*)(ws + 65536))[ph] = __builtin_amdgcn_s_memrealtime();
#endif
        if (ph + 1 < a.ph_hi) {
            if (ph == 0) {
                grid.sync();
                (void)xcd_barrier_post((unsigned*)(ws + WS_BAR), (volatile LAS unsigned*)(L + LDS_BYTES - 128));
            } else {
                XcdBarrier xb_; xb_.bar = (unsigned*)(ws + WS_BAR); xb_.x = xb_xcc_id(); xb_.st = (volatile LAS unsigned*)(L + LDS_BYTES - 128);
                xcd_barrier(xb_);
            }
        }
    }
}

#ifndef MK_MULTI
#define MK_MULTI 0
#endif
extern "C" void kernel_launch(void* const* d_in, const int* in_sizes, int n_in, void* d_out, int out_size, void* d_ws, size_t ws_size, hipStream_t stream) {
    static int grid = 0;
    if (grid == 0) {
        int dev = 0, cus = 0, per = 0;
        if (n_in != 14 || out_size != M * DM || ws_size < WS_END) { fprintf(stderr, "kernel_launch: unexpected shapes (n_in %d out %d ws %zu)\n", n_in, out_size, ws_size); grid = -1; return; }
        (void)hipGetDevice(&dev); (void)hipDeviceGetAttribute(&cus, hipDeviceAttributeMultiprocessorCount, dev);
        (void)hipFuncSetAttribute((const void*)fwd, hipFuncAttributeMaxDynamicSharedMemorySize, LDS_BYTES);
        (void)hipOccupancyMaxActiveBlocksPerMultiprocessor(&per, (const void*)fwd, 512, LDS_BYTES);
        if (per < 1) per = 1;
        grid = cus * per;
        fprintf(stderr, "kernel_launch: grid %d (cus %d x %d)\n", grid, cus, per);
    }
    if (grid < 0) return;
    Args a{};
    for (int i = 0; i < 14; ++i) a.in[i] = (const float*)d_in[i];
    a.out = (float*)d_out; a.ws = (unsigned char*)d_ws;
#if MK_MULTI
    for (int ph = 0; ph < NPHASE; ++ph) { a.ph_lo = ph; a.ph_hi = ph + 1; hipLaunchKernelGGL(fwd, dim3(grid), dim3(512), LDS_BYTES, stream, a); }
#else
#ifdef PROBE_T
    a.ph_lo = 0; a.ph_hi = NPHASE + 1;
#else
    a.ph_lo = 0; a.ph_hi = NPHASE;
#endif
    void* args[] = {&a};
    hipError_t e = hipLaunchCooperativeKernel((const void*)fwd, dim3(grid), dim3(512), args, LDS_BYTES, stream);
    if (e != hipSuccess) fprintf(stderr, "kernel_launch: cooperative launch failed: %s (grid %d)\n", hipGetErrorString(e), grid);
#endif
}
```

```cpp
#include <hip/hip_runtime.h>
#include <hip/hip_cooperative_groups.h>
#include <cstdio>
#include <cstdint>
namespace cg = cooperative_groups;
namespace pg8 {
#define PG8_LAS __attribute__((address_space(3)))
typedef unsigned short bf16_t;
typedef short bf16x8 __attribute__((ext_vector_type(8)));
typedef float f32x4 __attribute__((ext_vector_type(4)));
typedef unsigned u32x4 __attribute__((ext_vector_type(4)));
constexpr int BM = 256, BK = 64, HALF = 128, HTB = HALF * BK * 2  , STAGE_BYTES = 8 * HTB, NXCD = 8, WGM = 8;

__host__ __device__ __forceinline__ int lds_byte(int r, int c) { const int st = (r >> 4) * 2 + (c >> 5), rr = r & 15, cc = c & 31, ob = rr * 64 + cc * 2; return st * 1024 + (ob ^ (((ob >> 9) & 1) << 5)); }
__host__ __device__ __forceinline__ void stage_rc(int b, int& R, int& C) { const int st = b / 1024, sb = b % 1024, swz = sb ^ (((sb >> 9) & 1) << 5); R = (st >> 1) * 16 + swz / 64; C = (st & 1) * 32 + (swz % 64) / 2; }
__host__ __device__ __forceinline__ int perm32(int rho) { const int n = rho >> 4, i = rho & 15; return 8 * (i >> 2) + 4 * n + (i & 3); }

struct Unit { int pm, pn; };
struct Gemm { const bf16_t* A; const bf16_t* Bt; int M, N, K; };

struct StaticOrder {
    int nM, nN, nwg, G, c;
    __host__ __device__ void init(int M, int N, int G_, int c_) { nM = M / BM; nN = N / BM; nwg = nM * nN; G = G_; c = c_; }
    __host__ __device__ bool next(int i, Unit& u) const {
        const long L = (long)i * G + c; if (L >= nwg) return false;
        int wgid = (int)L; { const int q = nwg / NXCD, r = nwg % NXCD, xcd = wgid % NXCD, off = wgid / NXCD; wgid = (xcd < r ? xcd * (q + 1) : r * (q + 1) + (xcd - r) * q) + off; }
        const int nig = WGM * nN, gid = wgid / nig, fm = gid * WGM, gsz = (nM - fm) < WGM ? (nM - fm) : WGM;
        u.pm = fm + ((wgid % nig) % gsz); u.pn = (wgid % nig) / gsz; return true;
    }
    __device__ __forceinline__ void a_ready(const Unit&) const {}
    __device__ __forceinline__ void done(const Unit&) const {}
};

__device__ __forceinline__ unsigned cvt_pk_bf16(float lo, float hi) { unsigned r; asm volatile("v_cvt_pk_bf16_f32 %0, %1, %2" : "=v"(r) : "v"(lo), "v"(hi)); return r; }
typedef float f32x2 __attribute__((ext_vector_type(2)));
template <class Epi, class Sched, bool ALIGN_EPI = false, bool SP2 = false>
__device__ __forceinline__ void gemm_phase(PG8_LAS unsigned char* lds, const Gemm g, const Sched& S, const Epi& E) {
    int tid_ = threadIdx.x; asm volatile("" : "+v"(tid_));
    const int tid = tid_, wid = __builtin_amdgcn_readfirstlane(tid >> 6), lane = tid & 63, wr = wid >> 2, wc = wid & 3, fr = lane & 15, fq = lane >> 4;
    const int K = g.K, nt = K / BK;
    unsigned voffA[2], voffB[2];
#pragma unroll
    for (int i = 0; i < 2; ++i) { int R, C; stage_rc(tid * 16 + i * 8192, R, C); const int Rb = Epi::PERM ? ((R & ~31) + perm32(R & 31)) : R;
        voffA[i] = (unsigned)(R * K + C) * 2u; voffB[i] = (unsigned)(Rb * K + C) * 2u; }
    const size_t kstep = (size_t)(BK * 2);
    const size_t hstep = (size_t)HALF * K * 2;
    const size_t tstep = 2 * hstep;
    const unsigned ldsw = (unsigned)wid * 1024u;
    const int aoff = lds_byte(wr * 64 + fr, fq * 8), boff = lds_byte(wc * 32 + fr, fq * 8);
#define PG8_SA(b, h) (((b) * 2 + (h)) * HTB)
#define PG8_SB(b, h) ((4 + (b) * 2 + (h)) * HTB)
#define PG8_STAGE(bufoff, gbase, voff) do { _Pragma("unroll") for (int _i = 0; _i < 2; ++_i) \
        __builtin_amdgcn_global_load_lds((const unsigned*)((const char*)(gbase) + (voff)[_i]), (PG8_LAS unsigned*)(lds + (bufoff) + ldsw + _i * 8192), 16, 0, 0); } while (0)
#define PG8_LDA(dst, b, h) do { _Pragma("unroll") for (int m = 0; m < 4; ++m) _Pragma("unroll") for (int k = 0; k < 2; ++k) dst[m][k] = *(const PG8_LAS bf16x8*)(lds + PG8_SA(b, h) + aoff + m * 2048 + k * 1024); } while (0)
#define PG8_LDB(dst, b, h) do { _Pragma("unroll") for (int n = 0; n < 2; ++n) _Pragma("unroll") for (int k = 0; k < 2; ++k) dst[n][k] = *(const PG8_LAS bf16x8*)(lds + PG8_SB(b, h) + boff + n * 2048 + k * 1024); } while (0)
#define PG8_MMA(ai, bj, At, Bt) do { __builtin_amdgcn_s_setprio(1); _Pragma("unroll") for (int m = 0; m < 4; ++m) _Pragma("unroll") for (int n = 0; n < 2; ++n) _Pragma("unroll") for (int k = 0; k < 2; ++k) \
        acc[ai][bj][m][n] = __builtin_amdgcn_mfma_f32_16x16x32_bf16(Bt[n][k], At[m][k], acc[ai][bj][m][n], 0, 0, 0); __builtin_amdgcn_s_setprio(0); } while (0)
#define PG8_WAIT_V(n) asm volatile("s_waitcnt vmcnt(" #n ")" ::: "memory")
#define PG8_WAIT_L(n) asm volatile("s_waitcnt lgkmcnt(" #n ")" ::: "memory")
#define PG8_BAR __builtin_amdgcn_s_barrier()
#define PG8_SCHED __builtin_amdgcn_sched_barrier(0)
    Unit cur, nxt; int ui = 0;
    if (!S.next(0, cur)) return;
    f32x4 acc[2][2][4][2];
#pragma unroll
    for (int a = 0; a < 2; ++a)
#pragma unroll
        for (int b = 0; b < 2; ++b)
#pragma unroll
            for (int m = 0; m < 4; ++m)
#pragma unroll
                for (int n = 0; n < 2; ++n) acc[a][b][m][n] = (f32x4){0.f, 0.f, 0.f, 0.f};
    bf16x8 At[4][2], B0[2][2], B1[2][2];
    const char* cA = (const char*)g.A + (size_t)cur.pm * tstep; const char* cB = (const char*)g.Bt + (size_t)cur.pn * tstep;
    S.a_ready(cur);
    if constexpr (SP2) {
        PG8_STAGE(PG8_SB(0, 0), cB, voffB); PG8_STAGE(PG8_SB(0, 1), cB + hstep, voffB); PG8_STAGE(PG8_SA(0, 0), cA, voffA); PG8_STAGE(PG8_SA(0, 1), cA + hstep, voffA);
        if (wr == 1) PG8_BAR;
        PG8_WAIT_V(2); PG8_BAR;
        PG8_STAGE(PG8_SB(1, 0), cB + kstep, voffB); PG8_STAGE(PG8_SA(1, 0), cA + kstep, voffA); PG8_STAGE(PG8_SB(1, 1), cB + hstep + kstep, voffB);
        PG8_WAIT_V(6); PG8_BAR;
    } else {
        PG8_STAGE(PG8_SB(0, 0), cB, voffB); PG8_STAGE(PG8_SA(0, 0), cA, voffA); PG8_STAGE(PG8_SB(0, 1), cB + hstep, voffB); PG8_STAGE(PG8_SA(0, 1), cA + hstep, voffA);
        if (wr == 1) PG8_BAR;
        PG8_WAIT_V(4); PG8_BAR;
        PG8_STAGE(PG8_SB(1, 0), cB + kstep, voffB); PG8_STAGE(PG8_SA(1, 0), cA + kstep, voffA); PG8_STAGE(PG8_SB(1, 1), cB + hstep + kstep, voffB);
        PG8_WAIT_V(6); PG8_BAR;
    }
    for (;;) {
        const bool has_next = S.next(ui + 1, nxt);
        const char* nA = has_next ? (const char*)g.A + (size_t)nxt.pm * tstep : cA; const char* nB = has_next ? (const char*)g.Bt + (size_t)nxt.pn * tstep : cB;
        for (int t = 0; t < nt; t += 2) {
            const bool last = (t == nt - 2);
            const char* a1 = cA + (size_t)(t + 1) * kstep;
            const char* a2 = last ? nA : cA + (size_t)(t + 2) * kstep; const char* b2 = last ? nB : cB + (size_t)(t + 2) * kstep;
            const char* a3 = a2 + kstep; const char* b3 = b2 + kstep;
            if (last && has_next) S.a_ready(nxt);
            if constexpr (SP2) {
            PG8_LDB(B0, 0, 0); PG8_LDB(B1, 0, 1); PG8_SCHED; PG8_LDA(At, 0, 0); PG8_STAGE(PG8_SA(1, 1), a1 + hstep, voffA);
            PG8_WAIT_V(8); PG8_WAIT_L(0); PG8_BAR; PG8_MMA(0, 0, At, B0); PG8_MMA(0, 1, At, B1); PG8_BAR; PG8_SCHED;
            PG8_LDA(At, 0, 1); PG8_STAGE(PG8_SB(0, 0), b2, voffB); PG8_STAGE(PG8_SB(0, 1), b2 + hstep, voffB); PG8_STAGE(PG8_SA(0, 0), a2, voffA);
            PG8_WAIT_V(8); PG8_WAIT_L(0); PG8_BAR; PG8_MMA(1, 0, At, B0); PG8_MMA(1, 1, At, B1); PG8_BAR; PG8_SCHED;
            PG8_LDB(B0, 1, 0); PG8_LDB(B1, 1, 1); PG8_SCHED; PG8_LDA(At, 1, 0); PG8_STAGE(PG8_SA(0, 1), a2 + hstep, voffA);
            PG8_WAIT_V(8); PG8_WAIT_L(0); PG8_BAR; PG8_MMA(0, 0, At, B0); PG8_MMA(0, 1, At, B1); PG8_BAR; PG8_SCHED;
            PG8_LDA(At, 1, 1); PG8_STAGE(PG8_SB(1, 0), b3, voffB); PG8_STAGE(PG8_SB(1, 1), b3 + hstep, voffB); PG8_STAGE(PG8_SA(1, 0), a3, voffA);
            PG8_WAIT_V(8); PG8_WAIT_L(0); PG8_BAR; PG8_MMA(1, 0, At, B0); PG8_MMA(1, 1, At, B1); PG8_BAR; PG8_SCHED;
            } else {
            PG8_LDB(B0, 0, 0); PG8_SCHED; PG8_LDA(At, 0, 0); PG8_STAGE(PG8_SA(1, 1), a1 + hstep, voffA);
            PG8_WAIT_L(8); PG8_BAR; PG8_WAIT_L(0); PG8_MMA(0, 0, At, B0); PG8_BAR; PG8_SCHED;
            PG8_LDB(B1, 0, 1); PG8_STAGE(PG8_SB(0, 0), b2, voffB);
            PG8_BAR; PG8_WAIT_L(0); PG8_MMA(0, 1, At, B1); PG8_BAR;
            PG8_LDA(At, 0, 1); PG8_STAGE(PG8_SA(0, 0), a2, voffA);
            PG8_BAR; PG8_WAIT_L(0); PG8_MMA(1, 0, At, B0); PG8_BAR; PG8_SCHED;
            PG8_STAGE(PG8_SB(0, 1), b2 + hstep, voffB);
            PG8_WAIT_V(6); PG8_BAR; PG8_MMA(1, 1, At, B1); PG8_BAR;
            PG8_LDB(B0, 1, 0); PG8_SCHED; PG8_LDA(At, 1, 0); PG8_STAGE(PG8_SA(0, 1), a2 + hstep, voffA);
            PG8_WAIT_L(8); PG8_BAR; PG8_WAIT_L(0); PG8_MMA(0, 0, At, B0); PG8_BAR; PG8_SCHED;
            PG8_LDB(B1, 1, 1); PG8_STAGE(PG8_SB(1, 0), b3, voffB);
            PG8_BAR; PG8_WAIT_L(0); PG8_MMA(0, 1, At, B1); PG8_BAR;
            PG8_LDA(At, 1, 1); PG8_STAGE(PG8_SA(1, 0), a3, voffA);
            PG8_BAR; PG8_WAIT_L(0); PG8_MMA(1, 0, At, B0); PG8_BAR; PG8_SCHED;
            PG8_STAGE(PG8_SB(1, 1), b3 + hstep, voffB);
            PG8_WAIT_V(6); PG8_BAR; PG8_MMA(1, 1, At, B1); PG8_BAR;
            }
        }
        if constexpr (ALIGN_EPI) { if (wr == 0) PG8_BAR; }
        if constexpr (!Epi::AFTER_DRAIN) { E(acc, cur, wr, wc, fr, fq); S.done(cur); }
        if (!has_next) break;
#pragma unroll
        for (int a = 0; a < 2; ++a)
#pragma unroll
            for (int b = 0; b < 2; ++b)
#pragma unroll
                for (int m = 0; m < 4; ++m)
#pragma unroll
                    for (int n = 0; n < 2; ++n) acc[a][b][m][n] = (f32x4){0.f, 0.f, 0.f, 0.f};
        cur = nxt; cA = nA; cB = nB; ++ui;
        if constexpr (ALIGN_EPI) { if (wr == 1) PG8_BAR; }
    }
    PG8_WAIT_V(0);
    if constexpr (!ALIGN_EPI) { if (wr == 0) PG8_BAR; }
    PG8_BAR;
    if constexpr (Epi::AFTER_DRAIN) { E.fused(acc, cur, wr, wc, fr, fq, lds, wid, lane); S.done(cur); }
#undef PG8_SA
#undef PG8_SB
#undef PG8_STAGE
#undef PG8_LDA
#undef PG8_LDB
#undef PG8_MMA
#undef PG8_WAIT_V
#undef PG8_WAIT_L
#undef PG8_BAR
#undef PG8_SCHED
}
}
#include <hip/hip_bf16.h>
#include <cmath>
namespace attn_body {
using bf16=__hip_bfloat16;
using bf16x8=__attribute__((ext_vector_type(8)))short;
using s16x4=__attribute__((ext_vector_type(4)))short;
using f32x16=__attribute__((ext_vector_type(16)))float;
using u32x4=__attribute__((ext_vector_type(4)))unsigned;
using f32x4v=__attribute__((ext_vector_type(4)))float;
constexpr int SEQ=4096,D=64,DM=64,OPITCH=1024;
constexpr int LDS_C=98304;
constexpr int NW=8,QBLK=32,QB=QBLK*NW,KVBLK=64,NQB=SEQ/QB;
constexpr int ATTN_UNIT_ROWS=QB;
__device__ __forceinline__ int crow(int r,int hi){return (r&3)+8*(r>>2)+4*hi;}
#define SBAR() __builtin_amdgcn_sched_barrier(0)
__device__ __forceinline__ void cmask(f32x16&p0,f32x16&p1,int jb,int qrel,int hi){
  const float NEG=-INFINITY; int kb=64*jb+4*hi;
  #pragma unroll
  for(int r=0;r<16;++r){int kv=kb+(r&3)+8*(r>>2); if(kv>qrel)p0[r]=NEG; if(kv+32>qrel)p1[r]=NEG;}
}

constexpr int NSLOT=3, SLOTB=8192;
constexpr int LDS_K=0, LDS_V=NSLOT*SLOTB, LDS_WS=2*NSLOT*SLOTB, LDS_OST=LDS_WS+NW*64*4, LDS_BYTES=LDS_OST+NW*4096;
constexpr float C2=0.125f*1.4426950408889634f;
__device__ __forceinline__ void glds16(const void*gsrc,unsigned lds_dst){unsigned keep;
  asm volatile("s_mov_b32 %0, m0\n\ts_mov_b32 m0, %2\n\ts_nop 0\n\tglobal_load_lds_dwordx4 %1, off\n\ts_mov_b32 m0, %0":"=&s"(keep):"v"(gsrc),"s"(lds_dst):"memory");}
__device__ __forceinline__ float max3f(float a,float b,float c){float r;asm("v_max3_f32 %0, %1, %2, %3":"=v"(r):"v"(a),"v"(b),"v"(c));return r;}
__device__ __forceinline__ float max2f(float a,float b){float r;asm("v_max_f32_e32 %0, %1, %2":"=v"(r):"v"(a),"v"(b));return r;}
__device__ __forceinline__ float fadd_s(float a,float b){float r;asm("v_add_f32_e32 %0, %1, %2":"=v"(r):"v"(a),"v"(b));return r;}
__device__ __forceinline__ float fsub_s(float a,float b){float r;asm("v_sub_f32_e32 %0, %1, %2":"=v"(r):"v"(a),"v"(b));return r;}
typedef float f32x2_t __attribute__((ext_vector_type(2))); typedef __bf16 bf16x2_t __attribute__((ext_vector_type(2)));
__device__ __forceinline__ unsigned cvtpk_s(float lo,float hi){f32x2_t v={lo,hi};bf16x2_t b=__builtin_convertvector(v,bf16x2_t);return __builtin_bit_cast(unsigned,b);}
#define WAIT_BAR(N) asm volatile("s_waitcnt vmcnt(" #N ") lgkmcnt(0)\n\ts_barrier":::"memory")

__device__ __forceinline__ void qkt(f32x16&p0,f32x16&p1,const char*Kslot,const bf16x8*qr,const f32x16&negm,int r32,int hi){
  const char*kb=Kslot+hi*1024+r32*16;
  #pragma unroll
  for(int d0=0;d0<4;++d0){
    const bf16x8 b0=*reinterpret_cast<const bf16x8*>(kb+d0*2048);
    const bf16x8 b1=*reinterpret_cast<const bf16x8*>(kb+d0*2048+512);
    if(d0==0){p0=__builtin_amdgcn_mfma_f32_32x32x16_bf16(b0,qr[0],negm,0,0,0);p1=__builtin_amdgcn_mfma_f32_32x32x16_bf16(b1,qr[0],negm,0,0,0);}
    else{p0=__builtin_amdgcn_mfma_f32_32x32x16_bf16(b0,qr[d0],p0,0,0,0);p1=__builtin_amdgcn_mfma_f32_32x32x16_bf16(b1,qr[d0],p1,0,0,0);}}
}
typedef __attribute__((address_space(3))) const char* lds_cptr;
typedef short v4i16_t __attribute__((ext_vector_type(4)));
__device__ __forceinline__ void kload8(bf16x8*kf,lds_cptr kp){
  kf[0]=*(const __attribute__((address_space(3))) bf16x8*)(kp);      kf[1]=*(const __attribute__((address_space(3))) bf16x8*)(kp+512);
  kf[2]=*(const __attribute__((address_space(3))) bf16x8*)(kp+2048); kf[3]=*(const __attribute__((address_space(3))) bf16x8*)(kp+2560);
  kf[4]=*(const __attribute__((address_space(3))) bf16x8*)(kp+4096); kf[5]=*(const __attribute__((address_space(3))) bf16x8*)(kp+4608);
  kf[6]=*(const __attribute__((address_space(3))) bf16x8*)(kp+6144); kf[7]=*(const __attribute__((address_space(3))) bf16x8*)(kp+6656);
}
__device__ __forceinline__ void kload2(bf16x8*kf,lds_cptr kp,int j){ kf[2*j]=*(const __attribute__((address_space(3))) bf16x8*)(kp+j*2048); kf[2*j+1]=*(const __attribute__((address_space(3))) bf16x8*)(kp+j*2048+512); }
__device__ __forceinline__ s16x4 vtr(lds_cptr p){ return __builtin_bit_cast(s16x4,__builtin_amdgcn_ds_read_tr16_b64_v4i16((__attribute__((address_space(3))) v4i16_t*)p)); }
__device__ __forceinline__ float rowmax(const f32x16&p0,const f32x16&p1){
  float a=max3f(p0[0],p0[1],p1[0]),b=max3f(p0[2],p0[3],p1[1]);a=max3f(a,p1[2],p1[3]);
  #pragma unroll
  for(int r=4;r<16;r+=4){a=max3f(a,p0[r],p0[r+1]);b=max3f(b,p0[r+2],p0[r+3]);a=max3f(a,p1[r],p1[r+1]);b=max3f(b,p1[r+2],p1[r+3]);}
  const float m=max2f(a,b);
  auto rr=__builtin_amdgcn_permlane32_swap(__float_as_uint(m),__float_as_uint(m),false,false);
  return max2f(__uint_as_float(rr[0]),__uint_as_float(rr[1]));
}
__device__ __forceinline__ void pv(f32x16*o,int vb,bf16x8 pa0,bf16x8 pa1,bf16x8 pa2,bf16x8 pa3){
  #pragma unroll
  for(int d0=0;d0<2;++d0){s16x4 lo[4],hi[4];
    #pragma unroll
    for(int ks=0;ks<4;++ks){
      asm volatile("ds_read_b64_tr_b16 %0,%1 offset:%c2":"=&v"(lo[ks]):"v"(vb),"i"(d0*4096+ks*1024):"memory");
      asm volatile("ds_read_b64_tr_b16 %0,%1 offset:%c2":"=&v"(hi[ks]):"v"(vb),"i"(d0*4096+ks*1024+512):"memory");}
    asm volatile("s_waitcnt lgkmcnt(0)":::"memory");SBAR();
    #define PK(k) (bf16x8){lo[k][0],lo[k][1],lo[k][2],lo[k][3],hi[k][0],hi[k][1],hi[k][2],hi[k][3]}
    o[d0]=__builtin_amdgcn_mfma_f32_32x32x16_bf16(pa0,PK(0),o[d0],0,0,0);
    o[d0]=__builtin_amdgcn_mfma_f32_32x32x16_bf16(pa1,PK(1),o[d0],0,0,0);
    o[d0]=__builtin_amdgcn_mfma_f32_32x32x16_bf16(pa2,PK(2),o[d0],0,0,0);
    o[d0]=__builtin_amdgcn_mfma_f32_32x32x16_bf16(pa3,PK(3),o[d0],0,0,0);
    #undef PK
  }
}

#ifndef ATTN_STORE16
#define ATTN_STORE16(p,v) (*(u32x4*)(p)=(v))
#endif
template<int THRL> __device__ __forceinline__ void attn_unit(int qb,int jstart,const bf16*Q,const bf16*__restrict__ K,const bf16*__restrict__ V,bf16*O,const float*__restrict__ Cg,char*shm){
  int tid_=threadIdx.x; asm volatile("":"+v"(tid_)); const int tid=tid_,lane=tid&63,r32=lane&31,hi=lane>>5; const int wid=__builtin_amdgcn_readfirstlane(tid>>6);
  const int q0=qb*QB;
  const bf16*Qw=Q+(long)(q0+wid*QBLK)*DM;
  const bf16*Kh=K+(long)jstart*KVBLK*DM,*Vh=V+(long)jstart*KVBLK*DM;
  const lds_cptr shm3=(lds_cptr)shm;
  const unsigned lds0=(unsigned)(uintptr_t)shm;
  float*wsf=(float*)(shm+LDS_WS)+wid*64;
  const bf16*ksrc=Kh+(long)lane*DM+wid*8;
  const bf16*vsrc=Vh+(long)(16*(wid&3)+(lane>>2))*DM+(wid>>2)*32+(lane&3)*8;
  const unsigned kdst=lds0+LDS_K+wid*1024, vdst=lds0+LDS_V+wid*1024;
  #define DMA_K(t,slot) glds16(ksrc+(long)(t)*KVBLK*DM,(unsigned)__builtin_amdgcn_readfirstlane(kdst+(slot)))
  #define DMA_V(t,slot) glds16(vsrc+(long)(t)*KVBLK*DM,(unsigned)__builtin_amdgcn_readfirstlane(vdst+(slot)))
  const int vb0=(int)(lds0+LDS_V)+((lane>>4)&1)*32+(lane&3)*8+(4*hi+((lane&15)>>2))*64;
  const char*Kbase=shm+LDS_K; bf16x8 kf[8];
  const lds_cptr kp0=shm3+LDS_K+hi*1024+r32*16; const lds_cptr vp0=shm3+LDS_V+((lane>>4)&1)*32+(lane&3)*8+(4*hi+((lane&15)>>2))*64;
  const int NT=(q0+QB)/KVBLK-jstart;
  { typedef __attribute__((address_space(3))) f32x4v lf32x4; lf32x4*cl_=(lf32x4*)(shm3+LDS_C); const f32x4v*cg_=(const f32x4v*)(Cg+jstart*KVBLK); const int n4_=(q0+QB-jstart*KVBLK)>>2;
    f32x4v c0_=f32x4v{},c1_=f32x4v{}; if(tid<n4_)c0_=cg_[tid]; if(tid+NW*64<n4_)c1_=cg_[tid+NW*64]; if(tid<n4_)cl_[tid]=c0_; if(tid+NW*64<n4_)cl_[tid+NW*64]=c1_; }
  DMA_K(0,0);DMA_V(0,0);DMA_K(1,SLOTB);
  bf16x8 qr[4];
  #pragma unroll
  for(int d0=0;d0<4;++d0)qr[d0]=*reinterpret_cast<const bf16x8*>(&Qw[(long)r32*DM+d0*16+hi*8]);
  float mhat=0.f,l_reg=0.f;f32x16 o[2];o[0]=f32x16{};o[1]=f32x16{};
  const int qrel=wid*QBLK+r32;
  #define CMASK(P0,P1,t) do{int jb_=(t)-(NT-4); if(jb_>=0)cmask(P0,P1,jb_,qrel,hi);}while(0)
  typedef __attribute__((address_space(3))) const float* lds_fptr; typedef __attribute__((address_space(3))) const f32x4v* lds_f4ptr;
  const lds_fptr cl0=(lds_fptr)(shm3+LDS_C)+4*hi;
  #define BIAS(P0,P1,t) do{ const lds_fptr cb_=cl0+64*(t); _Pragma("unroll") for(int g_=0;g_<4;++g_){ const f32x4v a_=*(lds_f4ptr)(cb_+8*g_), b_=*(lds_f4ptr)(cb_+32+8*g_); \
      _Pragma("unroll") for(int i_=0;i_<4;++i_){P0[4*g_+i_]-=a_[i_];P1[4*g_+i_]-=b_[i_];} } }while(0)
  #define BIASINIT(C0_,C1_,t) do{ const lds_fptr cb_=cl0+64*(t); const float nm_=-mhat; _Pragma("unroll") for(int g_=0;g_<4;++g_){ const f32x4v a_=*(lds_f4ptr)(cb_+8*g_), b_=*(lds_f4ptr)(cb_+32+8*g_); \
      _Pragma("unroll") for(int i_=0;i_<4;++i_){C0_[4*g_+i_]=nm_-a_[i_];C1_[4*g_+i_]=nm_-b_[i_];} } }while(0)
  bool resc=false;
  #define START(P0,P1) do{ const float rm=rowmax(P0,P1); resc=false; \
    { const float dl=rm; mhat=fadd_s(mhat,dl); \
      _Pragma("unroll") for(int r=0;r<16;++r){P0[r]=fsub_s(P0[r],dl);P1[r]=fsub_s(P1[r],dl);} \
      } \
    _Pragma("unroll") for(int r=0;r<16;++r)P0[r]=__builtin_amdgcn_exp2f(P0[r]); }while(0)
  #define RESC() do{ if(resc){ asm volatile("s_waitcnt lgkmcnt(0)":::"memory"); \
      _Pragma("unroll") for(int d_=0;d_<2;++d_) _Pragma("unroll") for(int r=0;r<16;++r)o[d_][r]*=wsf[crow(r,hi)]; } }while(0)
  f32x16 pA0,pA1,pB0,pB1;
  int sl_prev=0,sl_cur=0,sl_next=SLOTB;
  #define ROT() do{sl_prev=sl_cur;sl_cur=sl_next;sl_next=(sl_next==(NSLOT-1)*SLOTB)?0:sl_next+SLOTB;}while(0)
  DMA_K(2,2*SLOTB);
  WAIT_BAR(3);
  { const f32x16 zero_=f32x16{}; qkt(pA0,pA1,Kbase,qr,zero_,r32,hi); }asm volatile("s_nop 15\n\ts_nop 7":"+v"(pA0),"+v"(pA1));BIAS(pA0,pA1,0);CMASK(pA0,pA1,0);
  START(pA0,pA1);
  _Pragma("unroll") for(int r=0;r<16;++r)pA1[r]=__builtin_amdgcn_exp2f(pA1[r]);
  WAIT_BAR(0);
  DMA_K(3,0);DMA_V(1,SLOTB);
  ROT();
  kload8(kf,kp0+sl_cur);
  WAIT_BAR(2);
  s16x4 vlo[8],vhi[8]; u32x4 pw0,pw1,pw2,pw3;
  #define PKW(P,B) cvtpk_s(P[B],P[B+1])
  #define PAF(k) __builtin_bit_cast(bf16x8,pw##k)
  #define VFR(i) (bf16x8){vlo[i][0],vlo[i][1],vlo[i][2],vlo[i][3],vhi[i][0],vhi[i][1],vhi[i][2],vhi[i][3]}
  #define PIN(x) asm volatile("":"+v"(x))
  #define MX3(a,b,c) __builtin_fmaxf(__builtin_fmaxf((a),(b)),(c))
  #define GAPA(MF,A0,A1,A2,A3,W0,W1,PW) do{ MF; sacc+=A0; sacc+=A1; sacc+=A2; sacc+=A3; PIN(sacc); W0; W1; PIN(PW); SBAR(); }while(0)
  #define EX(v) __builtin_amdgcn_exp2f(v)
  #define GAPB(MF,X,B) do{ MF; X[B]=EX(X[B]); X[B+1]=EX(X[B+1]); X[B+2]=EX(X[B+2]); X[B+3]=EX(X[B+3]); PIN(X); SBAR(); }while(0)
  #define VRD(i) do{ vlo[i]=vtr(vp_+(((i)>>2)*4096+((i)&3)*1024)); vhi[i]=vtr(vp_+(((i)>>2)*4096+((i)&3)*1024+512)); }while(0)
  #define KRD(G,j) do{ if(G){ kload2(kf,kp0+sl_next,j); SBAR(); } }while(0)
  #define STEP(C0,C1,P0,P1,t,GK,GV,GL) do{ SBAR(); BIASINIT(C0,C1,t); SBAR(); \
    const lds_cptr vp_=vp0+sl_prev; \
    VRD(0); SBAR(); float sacc=(P0[0]+P0[1]); \
    GAPA(C0=__builtin_amdgcn_mfma_f32_32x32x16_bf16(kf[0],qr[0],C0,0,0,0), P0[2],P0[3],P0[4],P0[5],     pw0[0]=PKW(P0,0), pw0[1]=PKW(P0,2), pw0); \
    VRD(4); SBAR(); GAPA(C1=__builtin_amdgcn_mfma_f32_32x32x16_bf16(kf[1],qr[0],C1,0,0,0), P0[6],P0[7],P0[8],P0[9],     pw0[2]=PKW(P0,4), pw0[3]=PKW(P0,6), pw0); \
    VRD(1); SBAR(); GAPA(C0=__builtin_amdgcn_mfma_f32_32x32x16_bf16(kf[2],qr[1],C0,0,0,0),   P0[10],P0[11],P0[12],P0[13], pw1[0]=PKW(P0,8), pw1[1]=PKW(P0,10), pw1); \
    VRD(5); SBAR(); GAPA(C1=__builtin_amdgcn_mfma_f32_32x32x16_bf16(kf[3],qr[1],C1,0,0,0),   P0[14],P0[15],P1[0],P1[1],   pw1[2]=PKW(P0,12),pw1[3]=PKW(P0,14), pw1); \
    VRD(2); SBAR(); GAPA(C0=__builtin_amdgcn_mfma_f32_32x32x16_bf16(kf[4],qr[2],C0,0,0,0),   P1[2],P1[3],P1[4],P1[5],     pw2[0]=PKW(P1,0), pw2[1]=PKW(P1,2), pw2); \
    VRD(6); SBAR(); GAPA(C1=__builtin_amdgcn_mfma_f32_32x32x16_bf16(kf[5],qr[2],C1,0,0,0),   P1[6],P1[7],P1[8],P1[9],     pw2[2]=PKW(P1,4), pw2[3]=PKW(P1,6), pw2); \
    VRD(3); SBAR(); GAPA(C0=__builtin_amdgcn_mfma_f32_32x32x16_bf16(kf[6],qr[3],C0,0,0,0),   P1[10],P1[11],P1[12],P1[13], pw3[0]=PKW(P1,8), pw3[1]=PKW(P1,10), pw3); \
    VRD(7); SBAR(); GAPA(C1=__builtin_amdgcn_mfma_f32_32x32x16_bf16(kf[7],qr[3],C1,0,0,0),   P1[14],P1[15],0.f,0.f,       pw3[2]=PKW(P1,12),pw3[3]=PKW(P1,14), pw3); \
    l_reg+=sacc; \
    if(GK){DMA_K((t)+3,sl_cur);} if(GV){DMA_V((t)+1,sl_next);} \
    CMASK(C0,C1,t); \
    { float a=MX3(C0[0],C0[1],C1[0]),b=MX3(C0[2],C0[3],C1[1]); a=MX3(a,C1[2],C1[3]); \
      _Pragma("unroll") for(int r=4;r<16;r+=4){a=MX3(a,C0[r],C0[r+1]);b=MX3(b,C0[r+2],C0[r+3]);a=MX3(a,C1[r],C1[r+1]);b=MX3(b,C1[r+2],C1[r+3]);} \
      float rm=__builtin_fmaxf(a,b); { auto rr=__builtin_amdgcn_permlane32_swap(__float_as_uint(rm),__float_as_uint(rm),false,false); rm=__builtin_fmaxf(__uint_as_float(rr[0]),__uint_as_float(rr[1])); } \
      resc=false; \
      if(__builtin_expect(__any(rm>(float)THRL),0)){ const float dl=__builtin_fmaxf(rm,0.f); mhat+=dl; \
        _Pragma("unroll") for(int r=0;r<16;++r){C0[r]-=dl;C1[r]-=dl;} \
        const float f=__builtin_amdgcn_exp2f(-dl); l_reg*=f; if(hi==0)wsf[r32]=f; resc=true; } } \
    SBAR(); \
    GAPB(o[0]=__builtin_amdgcn_mfma_f32_32x32x16_bf16(PAF(0),VFR(0),o[0],0,0,0), C0,0); \
    GAPB(o[1]=__builtin_amdgcn_mfma_f32_32x32x16_bf16(PAF(0),VFR(4),o[1],0,0,0), C0,4); \
    KRD(GL,0); GAPB(o[0]=__builtin_amdgcn_mfma_f32_32x32x16_bf16(PAF(1),VFR(1),o[0],0,0,0), C0,8); \
    KRD(GL,1); GAPB(o[1]=__builtin_amdgcn_mfma_f32_32x32x16_bf16(PAF(1),VFR(5),o[1],0,0,0), C0,12); \
    KRD(GL,2); GAPB(o[0]=__builtin_amdgcn_mfma_f32_32x32x16_bf16(PAF(2),VFR(2),o[0],0,0,0), C1,0); \
    KRD(GL,3); GAPB(o[1]=__builtin_amdgcn_mfma_f32_32x32x16_bf16(PAF(2),VFR(6),o[1],0,0,0), C1,4); \
    GAPB(o[0]=__builtin_amdgcn_mfma_f32_32x32x16_bf16(PAF(3),VFR(3),o[0],0,0,0), C1,8); \
    GAPB(o[1]=__builtin_amdgcn_mfma_f32_32x32x16_bf16(PAF(3),VFR(7),o[1],0,0,0), C1,12); \
    }while(0)
  int t=1;
  #undef CMASK
  #define CMASK(P0,P1,t) do{}while(0)
  for(;t+5<NT;t+=2){
    STEP(pB0,pB1,pA0,pA1,t,true,true,true);     WAIT_BAR(2); RESC(); ROT();
    STEP(pA0,pA1,pB0,pB1,t+1,true,true,true);   WAIT_BAR(2); RESC(); ROT();
  }
  #undef CMASK
  #define CMASK(P0,P1,t) do{int jb_=(t)-(NT-4); if(jb_>=0)cmask(P0,P1,jb_,qrel,hi);}while(0)
  #define ENDW(tt) do{ if((tt)+3<NT){WAIT_BAR(2);} else if((tt)+2<NT){WAIT_BAR(1);} else {WAIT_BAR(0);} }while(0)
  for(;t+1<NT;t+=2){
    STEP(pB0,pB1,pA0,pA1,t,(t+3<NT),(t+1<NT),(t+1<NT));       ENDW(t);   RESC(); ROT();
    STEP(pA0,pA1,pB0,pB1,t+1,(t+4<NT),(t+2<NT),(t+2<NT));     ENDW(t+1); RESC(); ROT();
  }
  STEP(pB0,pB1,pA0,pA1,NT-1,false,false,false); RESC();
  { float sacc=pB0[0]+pB0[1]; _Pragma("unroll") for(int r=2;r<16;++r)sacc+=pB0[r]; _Pragma("unroll") for(int r=0;r<16;++r)sacc+=pB1[r]; l_reg+=sacc;
    pw0=(u32x4){PKW(pB0,0),PKW(pB0,2),PKW(pB0,4),PKW(pB0,6)};pw1=(u32x4){PKW(pB0,8),PKW(pB0,10),PKW(pB0,12),PKW(pB0,14)};pw2=(u32x4){PKW(pB1,0),PKW(pB1,2),PKW(pB1,4),PKW(pB1,6)};pw3=(u32x4){PKW(pB1,8),PKW(pB1,10),PKW(pB1,12),PKW(pB1,14)};
    SBAR(); pv(o,vb0+sl_cur,PAF(0),PAF(1),PAF(2),PAF(3)); }
  #undef PKW
  #undef PAF
  #undef VFR
  #undef PIN
  #undef MX3
  #undef GAPA
  #undef GAPB
  #undef EX
  #undef VRD
  #undef KRD
  #undef STEP
  #undef ENDW
  {auto rr=__builtin_amdgcn_permlane32_swap(__float_as_uint(l_reg),__float_as_uint(l_reg),false,false);l_reg=__uint_as_float(rr[0])+__uint_as_float(rr[1]);}
  if(hi==0)wsf[32+r32]=l_reg;asm volatile("s_waitcnt lgkmcnt(0)":::"memory");
  float rli[16];
  #pragma unroll
  for(int r=0;r<16;++r)rli[r]=__builtin_amdgcn_rcpf(wsf[32+crow(r,hi)]);
  bf16*Ow=O+(long)(q0+wid*QBLK)*OPITCH;
  { bf16*stg=(bf16*)(shm+LDS_OST)+wid*2048;
    #pragma unroll
    for(int r=0;r<16;++r){const int orow=crow(r,hi);
      #pragma unroll
      for(int d0=0;d0<2;++d0)stg[orow*64+d0*32+r32]=__float2bfloat16(o[d0][r]*rli[r]);}
    asm volatile("s_waitcnt lgkmcnt(0)":::"memory");
    #pragma unroll
    for(int i=0;i<4;++i){const int row=i*8+(lane>>3),ch=lane&7; const u32x4 v=*(const u32x4*)(stg+row*64+ch*8); ATTN_STORE16(Ow+(long)row*OPITCH+ch*8,v);} }
  asm volatile("s_waitcnt lgkmcnt(0)\n\ts_barrier":::"memory");
  #undef DMA_K
  #undef DMA_V
  #undef CMASK
  #undef BIAS
  #undef BIASINIT
  #undef START
  #undef RESC
  #undef ROT
}
__device__ __forceinline__ void sb_unit(int qb,const bf16*Q,const bf16*__restrict__ K,const bf16*__restrict__ V,bf16*O,char*shm){
  int tid_=threadIdx.x; asm volatile("":"+v"(tid_)); const int tid=tid_,lane=tid&63,r32=lane&31,hi=lane>>5; const int wid=__builtin_amdgcn_readfirstlane(tid>>6);
  const int q0=qb*QB;
  const bf16*Qw=Q+(long)(q0+wid*QBLK)*DM;
  const unsigned lds0=(unsigned)(uintptr_t)shm;
  typedef __attribute__((address_space(3))) int lds_i32; typedef __attribute__((address_space(3))) const u32x4* lds_u4ptr;
  lds_i32*flags=(lds_i32*)((lds_cptr)shm+LDS_WS);
  const bf16*ksrc=K+(long)lane*DM+wid*8;
  const bf16*vsrc=V+(long)(16*(wid&3)+(lane>>2))*DM+(wid>>2)*32+(lane&3)*8;
  const unsigned kdst=lds0+LDS_K+wid*1024, vdst=lds0+LDS_V+wid*1024;
  #define DMA_K(t,slot) glds16(ksrc+(long)(t)*KVBLK*DM,(unsigned)__builtin_amdgcn_readfirstlane(kdst+(slot)))
  #define DMA_V(t,slot) glds16(vsrc+(long)(t)*KVBLK*DM,(unsigned)__builtin_amdgcn_readfirstlane(vdst+(slot)))
  const int vb0=(int)(lds0+LDS_V)+((lane>>4)&1)*32+(lane&3)*8+(4*hi+((lane&15)>>2))*64;
  const int NT=(q0+QB)/KVBLK;
  DMA_K(NT-1,0);DMA_V(NT-1,0);
  bf16x8 qr[4];
  #pragma unroll
  for(int d0=0;d0<4;++d0)qr[d0]=*reinterpret_cast<const bf16x8*>(&Qw[(long)r32*DM+d0*16+hi*8]);
  f32x16 o[2];o[0]=f32x16{};o[1]=f32x16{};
  float T=0.f; const int t_abs=q0+wid*QBLK+r32; bool wdone=false;
  for(int i=0;;++i){
    const int jt=NT-1-i; const int slot=(i&1)*SLOTB; const bool more=jt>0;
    if(more){DMA_K(jt-1,slot^SLOTB);DMA_V(jt-1,slot^SLOTB); WAIT_BAR(2);} else {WAIT_BAR(0);}
    const bool band=(jt>=NT-4);
    if(!(wdone||(band&&64*(jt-(NT-4))>=QBLK*wid+QBLK))){
    f32x16 x0,x1; { f32x16 zero=f32x16{}; qkt(x0,x1,shm+LDS_K+slot,qr,zero,r32,hi); }
    f32x16 n0,n1;
    const int kb=64*jt+4*hi;
    #pragma unroll
    for(int r=0;r<16;++r){
      const float z0=x0[r],z1=x1[r];
      const float l0=__builtin_amdgcn_logf(1.0f+__builtin_amdgcn_exp2f(-__builtin_fabsf(z0))), l1=__builtin_amdgcn_logf(1.0f+__builtin_amdgcn_exp2f(-__builtin_fabsf(z1)));
      float a0=__builtin_fminf(z0,0.f)-l0, a1=__builtin_fminf(z1,0.f)-l1, m0=__builtin_fminf(-z0,0.f)-l0, m1=__builtin_fminf(-z1,0.f)-l1;
      if(band){ const int kv=kb+(r&3)+8*(r>>2); if(!(kv<t_abs)){a0=-INFINITY;m0=0.f;} if(!(kv+32<t_abs)){a1=-INFINITY;m1=0.f;} }
      x0[r]=a0;x1[r]=a1;n0[r]=m0;n1[r]=m1;
    }
    float g0[4],g1[4],p0s[4],p1s[4];
    #pragma unroll
    for(int a=0;a<4;++a){ g0[a]=(n0[4*a]+n0[4*a+1])+(n0[4*a+2]+n0[4*a+3]); g1[a]=(n1[4*a]+n1[4*a+1])+(n1[4*a+2]+n1[4*a+3]);
      { auto rr=__builtin_amdgcn_permlane32_swap(__float_as_uint(g0[a]),__float_as_uint(g0[a]),false,false); p0s[a]=__uint_as_float(hi?rr[0]:rr[1]); }
      { auto rr=__builtin_amdgcn_permlane32_swap(__float_as_uint(g1[a]),__float_as_uint(g1[a]),false,false); p1s[a]=__uint_as_float(hi?rr[0]:rr[1]); } }
    float run=T;
    #pragma unroll
    for(int a=3;a>=0;--a){ float off=run+(hi?0.f:p1s[a]); run+=g1[a]+p1s[a];
      const float t3=off,t2=t3+n1[4*a+3],t1=t2+n1[4*a+2],t0=t1+n1[4*a+1];
      x1[4*a+3]=__builtin_amdgcn_exp2f(x1[4*a+3]+t3); x1[4*a+2]=__builtin_amdgcn_exp2f(x1[4*a+2]+t2); x1[4*a+1]=__builtin_amdgcn_exp2f(x1[4*a+1]+t1); x1[4*a]=__builtin_amdgcn_exp2f(x1[4*a]+t0); }
    #pragma unroll
    for(int a=3;a>=0;--a){ float off=run+(hi?0.f:p0s[a]); run+=g0[a]+p0s[a];
      const float t3=off,t2=t3+n0[4*a+3],t1=t2+n0[4*a+2],t0=t1+n0[4*a+1];
      x0[4*a+3]=__builtin_amdgcn_exp2f(x0[4*a+3]+t3); x0[4*a+2]=__builtin_amdgcn_exp2f(x0[4*a+2]+t2); x0[4*a+1]=__builtin_amdgcn_exp2f(x0[4*a+1]+t1); x0[4*a]=__builtin_amdgcn_exp2f(x0[4*a]+t0); }
    T=run;
    u32x4 pw0,pw1,pw2,pw3;
    pw0=(u32x4){cvtpk_s(x0[0],x0[1]),cvtpk_s(x0[2],x0[3]),cvtpk_s(x0[4],x0[5]),cvtpk_s(x0[6],x0[7])};
    pw1=(u32x4){cvtpk_s(x0[8],x0[9]),cvtpk_s(x0[10],x0[11]),cvtpk_s(x0[12],x0[13]),cvtpk_s(x0[14],x0[15])};
    pw2=(u32x4){cvtpk_s(x1[0],x1[1]),cvtpk_s(x1[2],x1[3]),cvtpk_s(x1[4],x1[5]),cvtpk_s(x1[6],x1[7])};
    pw3=(u32x4){cvtpk_s(x1[8],x1[9]),cvtpk_s(x1[10],x1[11]),cvtpk_s(x1[12],x1[13]),cvtpk_s(x1[14],x1[15])};
    SBAR(); pv(o,vb0+slot,__builtin_bit_cast(bf16x8,pw0),__builtin_bit_cast(bf16x8,pw1),__builtin_bit_cast(bf16x8,pw2),__builtin_bit_cast(bf16x8,pw3));
    wdone=__all(T<-150.f);
    }
    if(lane==0)flags[wid]=wdone?1:0;
    WAIT_BAR(2);
    const u32x4 f0=*(lds_u4ptr)(flags), f1=*(lds_u4ptr)(flags+4);
    const bool alld=((f0.x&f0.y&f0.z&f0.w)&(f1.x&f1.y&f1.z&f1.w))!=0;
    if(!more||alld)break;
  }
  WAIT_BAR(0);
  bf16*Ow=O+(long)(q0+wid*QBLK)*OPITCH;
  { bf16*stg=(bf16*)(shm+LDS_OST)+wid*2048;
    #pragma unroll
    for(int r=0;r<16;++r){const int orow=crow(r,hi);
      #pragma unroll
      for(int d0=0;d0<2;++d0)stg[orow*64+d0*32+r32]=__float2bfloat16(o[d0][r]);}
    asm volatile("s_waitcnt lgkmcnt(0)":::"memory");
    #pragma unroll
    for(int i=0;i<4;++i){const int row=i*8+(lane>>3),ch=lane&7; const u32x4 v=*(const u32x4*)(stg+row*64+ch*8); ATTN_STORE16(Ow+(long)row*OPITCH+ch*8,v);} }
  asm volatile("s_waitcnt lgkmcnt(0)\n\ts_barrier":::"memory");
  #undef DMA_K
  #undef DMA_V
}
#undef SBAR
#undef WAIT_BAR
}

constexpr int BATCH = 8, SEQ = 4096, DM = 1024, DEPTH = 4, M = BATCH * SEQ, INC = 3334, NIN = 3584, DFF = 4096;
constexpr float EPS = 1e-6f;
constexpr size_t MiB = 1u << 20;
constexpr size_t WS_BAR = 128 * 1024;
constexpr size_t WS_SS = 1 * MiB;
constexpr size_t WS_LB = 3 * MiB;
constexpr size_t WS_JS = 3 * MiB + 256 * 1024;
constexpr size_t WS_DD = 3 * MiB + 512 * 1024;
constexpr size_t WS_W = 4 * MiB;
constexpr size_t W_LAYER = 25 * MiB, W_OUT = 7 * MiB, W_1 = 9 * MiB, W_2 = 17 * MiB;
constexpr size_t WS_XB = 104 * MiB;
constexpr size_t WS_P = 168 * MiB;
constexpr size_t P_HQ = 0, P_HK = 16 * MiB, P_HI = 32 * MiB, P_HG = 48 * MiB, P_HLF = 64 * MiB, P_SQ = 96 * MiB, P_FQ = 168 * MiB, P_LF = 240 * MiB, P_CC = 241 * MiB, P_US = 242 * MiB;
constexpr size_t HEADBUF = 24 * MiB;
constexpr size_t WS_MIX = 442 * MiB;
constexpr size_t WS_U = 168 * MiB;
constexpr size_t WS_END = 506 * MiB;
constexpr int LDS_BYTES = 147456;

typedef pg8::bf16_t bf16_t;
typedef pg8::f32x4 f32x4;
typedef unsigned u32x4 __attribute__((ext_vector_type(4)));
typedef unsigned u32x2 __attribute__((ext_vector_type(2)));
#define LAS __attribute__((address_space(3)))

__device__ __forceinline__ unsigned f2bf(float f) { unsigned u = __builtin_bit_cast(unsigned, f); return (u + 0x7fffu + ((u >> 16) & 1u)) >> 16; }
__device__ __forceinline__ unsigned pk2(float lo, float hi) { return pg8::cvt_pk_bf16(lo, hi); }
__device__ __forceinline__ float bf2f(unsigned short b) { return __builtin_bit_cast(float, (unsigned)b << 16); }
__device__ __forceinline__ float bflo(unsigned w) { return __builtin_bit_cast(float, w << 16); }
__device__ __forceinline__ float bfhi(unsigned w) { return __builtin_bit_cast(float, w & 0xffff0000u); }
__device__ __forceinline__ float logsig(float x) { return fminf(x, 0.f) - log1pf(expf(-fabsf(x))); }
__device__ __forceinline__ float wave_sum(float v) {
#pragma unroll
    for (int o = 1; o < 64; o <<= 1) v += __shfl_xor(v, o);
    return v;
}
#define ROWSCALES8(rs, ss, row0, fq) float rs[2][4]; _Pragma("unroll") for (int ai_ = 0; ai_ < 2; ++ai_) _Pragma("unroll") for (int m_ = 0; m_ < 4; ++m_) rs[ai_][m_] = rowscale(ss, (row0) + ai_ * 128 + m_ * 16, fq);
__device__ __forceinline__ float rowscale(const float* ss, int row, int fq) {
    const f32x4 p = *(const f32x4*)(ss + (size_t)row * 16 + 4 * fq);
    float s = (p[0] + p[1]) + (p[2] + p[3]);
    s += __shfl_xor(s, 16); s += __shfl_xor(s, 32);
    return rsqrtf(s * (1.0f / DM) + EPS);
}

#define ROWFENCE() asm volatile("" ::: "memory")
struct EpiResid {
    static constexpr bool PERM = true, AFTER_DRAIN = false;
    bf16_t* xb; float* outf; float* ss;
    __device__ __forceinline__ void operator()(const f32x4 (&acc)[2][2][4][2], const pg8::Unit& u, int wr, int wc, int fr, int fq) const {
        const int row0 = u.pm * 256 + wr * 64 + fr, col0 = u.pn * 256 + wc * 32 + 8 * fq;
#pragma unroll
        for (int ai = 0; ai < 2; ++ai) {
            u32x4 pre[4][2];
#pragma unroll
            for (int m = 0; m < 4; ++m)
#pragma unroll
                for (int bj = 0; bj < 2; ++bj) pre[m][bj] = *(const u32x4*)(xb + (size_t)(row0 + ai * 128 + m * 16) * DM + col0 + bj * 128);
#pragma unroll
            for (int m = 0; m < 4; ++m) {
                const int row = row0 + ai * 128 + m * 16; float sq = 0.f;
#pragma unroll
                for (int bj = 0; bj < 2; ++bj) {
                    const size_t off = (size_t)row * DM + col0 + bj * 128; const u32x4 p = pre[m][bj];
                    const f32x4 v0 = acc[ai][bj][m][0] + (f32x4){bflo(p.x), bfhi(p.x), bflo(p.y), bfhi(p.y)}, v1 = acc[ai][bj][m][1] + (f32x4){bflo(p.z), bfhi(p.z), bflo(p.w), bfhi(p.w)};
                    if (outf) { *(f32x4*)(outf + off) = v0; *(f32x4*)(outf + off + 4) = v1; }
                    u32x4 w; w.x = pk2(v0[0], v0[1]); w.y = pk2(v0[2], v0[3]); w.z = pk2(v1[0], v1[1]); w.w = pk2(v1[2], v1[3]);
                    *(u32x4*)(xb + off) = w;
                    sq += (v0[0] * v0[0] + v0[1] * v0[1]) + (v0[2] * v0[2] + v0[3] * v0[3]) + (v1[0] * v1[0] + v1[1] * v1[1]) + (v1[2] * v1[2] + v1[3] * v1[3]);
                }
                sq += __shfl_xor(sq, 16); sq += __shfl_xor(sq, 32);
                if (fq == 0) ss[(size_t)row * 16 + u.pn * 4 + wc] = sq;
            }
            ROWFENCE();
        }
    }
};
struct EpiRelu2 {
    static constexpr bool PERM = true, AFTER_DRAIN = false;
    bf16_t* U; const float* ss;
    __device__ __forceinline__ void operator()(const f32x4 (&acc)[2][2][4][2], const pg8::Unit& u, int wr, int wc, int fr, int fq) const {
        const int row0 = u.pm * 256 + wr * 64 + fr, col0 = u.pn * 256 + wc * 32 + 8 * fq;
        ROWSCALES8(rs8, ss, row0, fq)
#pragma unroll
        for (int ai = 0; ai < 2; ++ai)
#pragma unroll
            for (int m = 0; m < 4; ++m) {
                const int row = row0 + ai * 128 + m * 16; const float rs = rs8[ai][m];
#pragma unroll
                for (int bj = 0; bj < 2; ++bj) {
                    f32x4 v0 = acc[ai][bj][m][0] * rs, v1 = acc[ai][bj][m][1] * rs;
                    v0 = __builtin_elementwise_max(v0, (f32x4){0.f, 0.f, 0.f, 0.f}); v1 = __builtin_elementwise_max(v1, (f32x4){0.f, 0.f, 0.f, 0.f});
                    v0 = v0 * v0; v1 = v1 * v1;
                    u32x4 w; w.x = pk2(v0[0], v0[1]); w.y = pk2(v0[2], v0[3]); w.z = pk2(v1[0], v1[1]); w.w = pk2(v1[2], v1[3]);
                    *(u32x4*)(U + (size_t)row * DFF + col0 + bj * 128) = w;
                }
                ROWFENCE();
            }
    }
};
struct EpiInProj {
    static constexpr bool PERM = true, AFTER_DRAIN = false;
    const float* ss; unsigned char* P; const float* lbt;
    const float* gt; const float* fbias;
    __device__ __forceinline__ void operator()(const f32x4 (&acc)[2][2][4][2], const pg8::Unit& u, int wr, int wc, int fr, int fq) const {
        const int slot = u.pn * 4 + wc;
        if (slot > 52) return;
        const int row0 = u.pm * 256 + wr * 64 + fr;
        ROWSCALES8(rs8, ss, row0, fq)
        if (slot < 16) {
            const int kind = slot >> 2, cb = (slot & 3) * 64 + 8 * fq;
            if (kind == 1) {
                float* HLF = (float*)(P + P_HLF); bf16_t* HK = (bf16_t*)(P + P_HK);
#pragma unroll
                for (int ai = 0; ai < 2; ++ai)
#pragma unroll
                    for (int m = 0; m < 4; ++m) {
                        const int row = row0 + ai * 128 + m * 16; const float rs = rs8[ai][m];
#pragma unroll
                        for (int bj = 0; bj < 2; ++bj) {
                            float lf[8], kk[8];
#pragma unroll
                            for (int n = 0; n < 2; ++n) {
                                const f32x4 ll = *(const f32x4*)(lbt + cb + 32 * bj + 4 * n), om = *(const f32x4*)(lbt + 256 + cb + 32 * bj + 4 * n);
#pragma unroll
                                for (int i = 0; i < 4; ++i) {
                                    const float fl = acc[ai][bj][m][n][i] * rs;
                                    const float a = fminf(fl, 0.f) - __logf(1.0f + __expf(-fabsf(fl)));
                                    const float an = a - fl;
                                    const float b = ll[i] + an;
                                    lf[4 * n + i] = fmaxf(a, b) + __logf(1.0f + __expf(-fabsf(a - b)));
                                    kk[4 * n + i] = om[i] * __expf(an);
                                }
                            }
                            const size_t off = (size_t)row * 256 + cb + 32 * bj;
                            *(f32x4*)(HLF + off) = (f32x4){lf[0], lf[1], lf[2], lf[3]}; *(f32x4*)(HLF + off + 4) = (f32x4){lf[4], lf[5], lf[6], lf[7]};
                            u32x4 w; w.x = pk2(kk[0], kk[1]); w.y = pk2(kk[2], kk[3]); w.z = pk2(kk[4], kk[5]); w.w = pk2(kk[6], kk[7]);
                            *(u32x4*)(HK + off) = w;
                        }
                        ROWFENCE();
                    }
            } else {
                bf16_t* dst = (bf16_t*)(P + (kind == 0 ? P_HQ : (kind == 2 ? P_HI : P_HG)));
#pragma unroll
                for (int ai = 0; ai < 2; ++ai)
#pragma unroll
                    for (int m = 0; m < 4; ++m) {
                        const int row = row0 + ai * 128 + m * 16; const float rs = rs8[ai][m];
#pragma unroll
                        for (int bj = 0; bj < 2; ++bj) {
                            const f32x4 v0 = acc[ai][bj][m][0] * rs, v1 = acc[ai][bj][m][1] * rs;
                            u32x4 w; w.x = pk2(v0[0], v0[1]); w.y = pk2(v0[2], v0[3]); w.z = pk2(v1[0], v1[1]); w.w = pk2(v1[2], v1[3]);
                            *(u32x4*)(dst + (size_t)row * 256 + cb + 32 * bj) = w;
                        }
                        ROWFENCE();
                    }
            }
        } else if (slot < 52) {
            const int s2 = slot - 16, grp = s2 / 6, h = s2 % 6, role = grp % 3;
            bf16_t* dst = (bf16_t*)(P + P_SQ + (size_t)grp * HEADBUF) + (size_t)((u.pm >> 4) * 6 + h) * SEQ * 64 + 8 * fq;
            const float* gp = gt + (grp - (grp >= 3 ? 1 : 0)) * 64 + 8 * fq;
            const float qs = (role == 0) ? 0.125f * 1.4426950408889634f : 1.0f;
#pragma unroll
            for (int ai = 0; ai < 2; ++ai)
#pragma unroll
                for (int m = 0; m < 4; ++m) {
                    const int row = row0 + ai * 128 + m * 16; const float rs = rs8[ai][m];
                    float fac = rs;
                    if (role != 2) {
                        float sq = 0.f;
#pragma unroll
                        for (int bj = 0; bj < 2; ++bj)
#pragma unroll
                            for (int n = 0; n < 2; ++n) { const f32x4 x = acc[ai][bj][m][n]; sq += (x[0] * x[0] + x[1] * x[1]) + (x[2] * x[2] + x[3] * x[3]); }
                        sq += __shfl_xor(sq, 16); sq += __shfl_xor(sq, 32);
                        fac = rs * rsqrtf(rs * rs * sq * (1.0f / 64.0f) + EPS) * qs;
                    }
                    const int t = row & (SEQ - 1);
#pragma unroll
                    for (int bj = 0; bj < 2; ++bj) {
                        f32x4 v0 = acc[ai][bj][m][0] * fac, v1 = acc[ai][bj][m][1] * fac;
                        if (role != 2) { v0 = v0 * *(const f32x4*)(gp + 32 * bj); v1 = v1 * *(const f32x4*)(gp + 32 * bj + 4); }
                        u32x4 w; w.x = pk2(v0[0], v0[1]); w.y = pk2(v0[2], v0[3]); w.z = pk2(v1[0], v1[1]); w.w = pk2(v1[2], v1[3]);
                        *(u32x4*)(dst + (size_t)t * 64 + 32 * bj) = w;
                    }
                    ROWFENCE();
                }
        } else {
            float* LF = (float*)(P + P_LF);
#pragma unroll
            for (int ai = 0; ai < 2; ++ai)
#pragma unroll
                for (int m = 0; m < 4; ++m) {
                    const int row = row0 + ai * 128 + m * 16; const float rs = rs8[ai][m];
                    if (fq == 0) {
                        const f32x4 a0 = acc[ai][0][m][0], a1 = acc[ai][0][m][1];
                        *(f32x4*)(LF + (size_t)row * 8) = (f32x4){logsig(a0[0] * rs + fbias[0]), logsig(a0[1] * rs + fbias[1]), logsig(a0[2] * rs + fbias[2]), logsig(a0[3] * rs + fbias[3])};
                        *(f32x4*)(LF + (size_t)row * 8 + 4) = (f32x4){logsig(a1[0] * rs + fbias[4]), logsig(a1[1] * rs + fbias[5]), 0.f, 0.f};
                    }
                    ROWFENCE();
                }
        }
    }
};
#define XB_TMO      128
#define XB_XCNT(j)  (256  + 64 * (j))
#define XB_XSUB(j)  (1280 + 64 * (j))
#define XB_XGEN(j)  (2304 + 64 * (j))
#define XB_TOP      3328
#define XB_TOPGEN   3392
#define XCD_BAR_WORDS 3456
#define XB_SPIN_CAP (1u << 18)

__device__ __forceinline__ unsigned xb_ld(unsigned* p)              { return __hip_atomic_load(p, __ATOMIC_RELAXED, __HIP_MEMORY_SCOPE_AGENT); }
__device__ __forceinline__ unsigned xb_add(unsigned* p, unsigned v) { return __hip_atomic_fetch_add(p, v, __ATOMIC_RELAXED, __HIP_MEMORY_SCOPE_AGENT); }
__device__ __forceinline__ unsigned xb_xcc_id() { return (unsigned)__builtin_amdgcn_s_getreg((3 << 11) | 20) & 0xFu; }
#define XB_SPIN(cond, bar) do { unsigned _sp = 0; while (cond) { __builtin_amdgcn_s_sleep(1); \
    if ((++_sp & 255u) == 0u) { if (xb_ld(&(bar)[XB_TMO])) break; if (_sp > XB_SPIN_CAP) { atomicAdd(&(bar)[XB_TMO], 1u); break; } } } } while (0)

struct XcdBarrier {
    unsigned* bar; unsigned x;
    volatile LAS unsigned* st;
};

__device__ __forceinline__ XcdBarrier xcd_barrier_post(unsigned* bar, volatile LAS unsigned* st) {
    XcdBarrier b; b.bar = bar; b.x = xb_xcc_id(); b.st = st;
    if (threadIdx.x == 0) (void)xb_add(&bar[XB_XCNT(b.x)], 1u);
    return b;
}
__device__ __forceinline__ void xcd_barrier_complete(unsigned* bar, unsigned x, unsigned& nloc, unsigned& nx) {
    const unsigned G = gridDim.x * gridDim.y * gridDim.z;
    unsigned sum, cnt, mine, sp = 0u;
    for (;;) {
        sum = 0u; cnt = 0u; mine = 0u;
#pragma unroll
        for (unsigned j = 0; j < 16; ++j) { const unsigned c = xb_ld(&bar[XB_XCNT(j)]); sum += c; cnt += (c > 0u) ? 1u : 0u; mine = (j == x) ? c : mine; }
        if (sum == G) break;
        __builtin_amdgcn_s_sleep(1);
        if ((++sp & 255u) == 0u) { if (xb_ld(&bar[XB_TMO])) break; if (sp > XB_SPIN_CAP) { atomicAdd(&bar[XB_TMO], 1u); break; } }
    }
    nloc = mine > 0u ? mine : 1u; nx = cnt > 0u ? cnt : 1u;
}

__device__ __forceinline__ void xcd_barrier(const XcdBarrier& b) {
    asm volatile("s_waitcnt vmcnt(0)" ::: "memory");
    __syncthreads();
    if (threadIdx.x == 0) {
        unsigned* bar = b.bar;
        __builtin_amdgcn_s_waitcnt(0);
        unsigned nloc = b.st[0], nx = b.st[1];
        if (nloc == 0u) { xcd_barrier_complete(bar, b.x, nloc, nx); b.st[0] = nloc; b.st[1] = nx; }
        const unsigned old = xb_add(&bar[XB_XSUB(b.x)], 1u);
        const unsigned gen = old / nloc;
        if (old + 1u == (gen + 1u) * nloc) {
            __builtin_amdgcn_fence(__ATOMIC_RELEASE, "agent");
            asm volatile("s_waitcnt vmcnt(0)" ::: "memory");
            const unsigned og = xb_add(&bar[XB_TOP], 1u);
            const unsigned tg = og / nx;
            if (og + 1u == (tg + 1u) * nx) xb_add(&bar[XB_TOPGEN], 1u);
            else XB_SPIN(xb_ld(&bar[XB_TOPGEN]) == tg, bar);
            __builtin_amdgcn_fence(__ATOMIC_ACQUIRE, "agent");
            xb_add(&bar[XB_XGEN(b.x)], 1u);
            asm volatile("s_waitcnt vmcnt(0)" ::: "memory");
        } else {
            XB_SPIN(xb_ld(&bar[XB_XGEN(b.x)]) == gen, bar);
            __builtin_amdgcn_fence(__ATOMIC_ACQUIRE, "agent");
            asm volatile("s_waitcnt vmcnt(0)" ::: "memory");
        }
    }
    __syncthreads();
}

__device__ __forceinline__ void tr_item(const float* W, int ldw, int ncols_valid, int src_col0, int k0, const float* gain, bf16_t* WT, int K, int n0, LAS float* scr, int lane) {
#pragma unroll 8
    for (int i = 0; i < 32; ++i) { const int kk = 2 * i + (lane >> 5), c = src_col0 + (lane & 31);
        float v = (c < ncols_valid) ? W[(size_t)(k0 + kk) * ldw + c] : 0.f; if (gain) v *= gain[k0 + kk]; scr[kk * 33 + (lane & 31)] = v; }
    asm volatile("s_waitcnt lgkmcnt(0)" ::: "memory");
    const int c = lane & 7;
#pragma unroll
    for (int j = 0; j < 4; ++j) { const int n = (lane >> 3) + 8 * j; const LAS float* s = scr + (8 * c) * 33 + n;
        u32x4 o; o.x = pk2(s[0 * 33], s[1 * 33]); o.y = pk2(s[2 * 33], s[3 * 33]); o.z = pk2(s[4 * 33], s[5 * 33]); o.w = pk2(s[6 * 33], s[7 * 33]);
        *(u32x4*)(WT + (size_t)(n0 + n) * K + k0 + 8 * c) = o; }
    asm volatile("s_waitcnt lgkmcnt(0)" ::: "memory");
}

__device__ __forceinline__ void unpack8(const u32x4 w, float* d) { d[0] = bflo(w.x); d[1] = bfhi(w.x); d[2] = bflo(w.y); d[3] = bfhi(w.y); d[4] = bflo(w.z); d[5] = bfhi(w.z); d[6] = bflo(w.w); d[7] = bfhi(w.w); }

__device__ __forceinline__ void fox_cumsum_item(int bh, const float* LF, float* CC, int* JS, const float* gq, const float* gk, LAS float* sc) {
    int tid_ = threadIdx.x; asm volatile("" : "+v"(tid_)); const int tid = tid_, lane = tid & 63, wave = tid >> 6, b = bh / 6, h = bh % 6;
    float v[8]; float run = 0.f;
#pragma unroll
    for (int i = 0; i < 8; ++i) { run += LF[((size_t)b * SEQ + tid * 8 + i) * 8 + h]; v[i] = run; }
    float s = run;
#pragma unroll
    for (int o = 1; o < 64; o <<= 1) { const float n = __shfl_up(s, o); if (lane >= o) s += n; }
    __syncthreads();
    if (lane == 63) sc[wave] = s;
    __syncthreads();
    float base = s - run;
    for (int w = 0; w < wave; ++w) base += sc[w];
    LAS float* cl = sc + 64;
#pragma unroll
    for (int i = 0; i < 8; ++i) { const float c2 = (v[i] + base) * 1.4426950408889634f; CC[(size_t)bh * SEQ + tid * 8 + i] = c2; cl[tid * 8 + i] = c2; }
    __syncthreads();
    if (tid < 16) {
        float mq = 0.f, mk = 0.f;
        for (int d = 0; d < 64; ++d) { mq = fmaxf(mq, fabsf(gq[d])); mk = fmaxf(mk, fabsf(gk[d])); }
        const float zb = 1.4426950408889634f * 8.0f * mq * mk * 1.03f + 1.0f;
        const float thr = -(150.0f + 2.0f * zb);
        const int q0 = tid * 256, nt = q0 / 64 + 4; const float cq = cl[q0];
        int j = 0; while (j < nt - 4 && cq - cl[64 * j + 63] < thr) ++j;
        JS[bh * 16 + tid] = j & ~1;
    }
    __syncthreads();
}

__device__ __forceinline__ void stage_kv(const bf16_t* Kb, const bf16_t* Vb, int kt, LAS float* Kf, LAS float* Vf) {
    int tid_ = threadIdx.x; asm volatile("" : "+v"(tid_)); const int tid = tid_, key = tid >> 3, c8 = tid & 7;
    const u32x4 kw = *(const u32x4*)(Kb + ((size_t)(kt * 64 + key)) * 64 + c8 * 8), vw = *(const u32x4*)(Vb + ((size_t)(kt * 64 + key)) * 64 + c8 * 8);
    float kf[8], vf[8]; unpack8(kw, kf); unpack8(vw, vf);
    *(LAS f32x4*)(Kf + key * 64 + c8 * 8) = (f32x4){kf[0], kf[1], kf[2], kf[3]}; *(LAS f32x4*)(Kf + key * 64 + c8 * 8 + 4) = (f32x4){kf[4], kf[5], kf[6], kf[7]};
    *(LAS f32x4*)(Vf + key * 64 + c8 * 8) = (f32x4){vf[0], vf[1], vf[2], vf[3]}; *(LAS f32x4*)(Vf + key * 64 + c8 * 8 + 4) = (f32x4){vf[4], vf[5], vf[6], vf[7]};
}

__device__ __forceinline__ void fox_naive_item(int item, unsigned char* P, bf16_t* MIX, LAS float* lds) {
    int tid_ = threadIdx.x; asm volatile("" : "+v"(tid_)); const int tid = tid_, bh = item >> 3, qblk = item & 7, b = bh / 6, h = bh % 6, t = qblk * 512 + tid;
    const bf16_t* Qp = (const bf16_t*)(P + P_FQ) + ((size_t)bh * SEQ + t) * 64;
    const bf16_t* Kb = (const bf16_t*)(P + P_FQ + HEADBUF) + (size_t)bh * SEQ * 64;
    const bf16_t* Vb = (const bf16_t*)(P + P_FQ + 2 * HEADBUF) + (size_t)bh * SEQ * 64;
    const float* CC = (const float*)(P + P_CC) + (size_t)bh * SEQ;
    float q[64], o[64];
#pragma unroll
    for (int c = 0; c < 8; ++c) unpack8(*(const u32x4*)(Qp + c * 8), q + c * 8);
#pragma unroll
    for (int d = 0; d < 64; ++d) o[d] = 0.f;
    float m = -1e30f, l = 0.f; const float ct = CC[t];
    LAS float* Kf = lds; LAS float* Vf = lds + 4096; LAS float* cs = lds + 8192;
    const int ntile = (qblk + 1) * 8;
    for (int kt = 0; kt < ntile; ++kt) {
        __syncthreads();
        stage_kv(Kb, Vb, kt, Kf, Vf); if (tid < 64) cs[tid] = CC[kt * 64 + tid];
        __syncthreads();
        for (int s = 0; s < 64; ++s) {
            float z = 0.f;
#pragma unroll
            for (int d = 0; d < 64; ++d) z += q[d] * Kf[s * 64 + d];
            const float x = (kt * 64 + s <= t) ? z + (ct - cs[s]) : -1e30f;
            const float mn = fmaxf(m, x), sc = __expf(m - mn), p = __expf(x - mn);
            l = l * sc + p;
#pragma unroll
            for (int d = 0; d < 64; ++d) o[d] = o[d] * sc + p * Vf[s * 64 + d];
            m = mn;
        }
    }
    const float inv = 1.0f / l;
    bf16_t* op = MIX + ((size_t)b * SEQ + t) * DM + 640 + h * 64;
#pragma unroll
    for (int c = 0; c < 8; ++c) { u32x4 w; w.x = pk2(o[c * 8] * inv, o[c * 8 + 1] * inv); w.y = pk2(o[c * 8 + 2] * inv, o[c * 8 + 3] * inv); w.z = pk2(o[c * 8 + 4] * inv, o[c * 8 + 5] * inv); w.w = pk2(o[c * 8 + 6] * inv, o[c * 8 + 7] * inv); *(u32x4*)(op + c * 8) = w; }
}

__device__ __forceinline__ void sb_naive_item(int item, unsigned char* P, bf16_t* MIX, LAS float* lds) {
    int tid_ = threadIdx.x; asm volatile("" : "+v"(tid_)); const int tid = tid_, bh = item >> 3, qblk = item & 7, b = bh / 6, h = bh % 6, t = qblk * 512 + tid;
    const bf16_t* Qp = (const bf16_t*)(P + P_SQ) + ((size_t)bh * SEQ + t) * 64;
    const bf16_t* Kb = (const bf16_t*)(P + P_SQ + HEADBUF) + (size_t)bh * SEQ * 64;
    const bf16_t* Vb = (const bf16_t*)(P + P_SQ + 2 * HEADBUF) + (size_t)bh * SEQ * 64;
    float q[64], o[64];
#pragma unroll
    for (int c = 0; c < 8; ++c) unpack8(*(const u32x4*)(Qp + c * 8), q + c * 8);
#pragma unroll
    for (int d = 0; d < 64; ++d) o[d] = 0.f;
    float tail = 0.f;
    LAS float* Kf = lds; LAS float* Vf = lds + 4096;
    for (int kt = qblk * 8 + 7; kt >= 0; --kt) {
        __syncthreads();
        stage_kv(Kb, Vb, kt, Kf, Vf);
        __syncthreads();
        for (int s = 63; s >= 0; --s) {
            float z = 0.f;
#pragma unroll
            for (int d = 0; d < 64; ++d) z += q[d] * Kf[s * 64 + d];
            const float ls = fminf(z, 0.f) - __logf(1.0f + __expf(-fabsf(z)));
            const bool act = (kt * 64 + s) < t;
            const float A = act ? __expf(ls + tail) : 0.f;
#pragma unroll
            for (int d = 0; d < 64; ++d) o[d] += A * Vf[s * 64 + d];
            tail += act ? (ls - z) : 0.f;
        }
        if (__syncthreads_and(tail < -100.f)) break;
    }
    bf16_t* op = MIX + ((size_t)b * SEQ + t) * DM + 256 + h * 64;
#pragma unroll
    for (int c = 0; c < 8; ++c) { u32x4 w; w.x = pk2(o[c * 8], o[c * 8 + 1]); w.y = pk2(o[c * 8 + 2], o[c * 8 + 3]); w.z = pk2(o[c * 8 + 4], o[c * 8 + 5]); w.w = pk2(o[c * 8 + 6], o[c * 8 + 7]); *(u32x4*)(op + c * 8) = w; }
}

__device__ __forceinline__ void hgrn_naive_item(int item, unsigned char* P, bf16_t* MIX, const float* hgn, LAS float* lds) {
    int tid_ = threadIdx.x; asm volatile("" : "+v"(tid_)); const int tid = tid_, lane = tid & 63, w = tid >> 6, kg = lane >> 3, vi = lane & 7, vcol = 8 * w + vi, b = item >> 2, h = item & 3;
    const bf16_t* HQ = (const bf16_t*)(P + P_HQ); const bf16_t* HK = (const bf16_t*)(P + P_HK); const bf16_t* HI = (const bf16_t*)(P + P_HI); const bf16_t* HG = (const bf16_t*)(P + P_HG);
    const float* HLF = (const float*)(P + P_HLF);
    LAS float* qf = lds; LAS float* kf = lds + 4096; LAS float* ff = lds + 8192; LAS float* vf = lds + 12288; LAS float* ob = lds + 16384;
    float S[8];
#pragma unroll
    for (int j = 0; j < 8; ++j) S[j] = 0.f;
    const int tok = tid >> 3, c8 = tid & 7;
    float gn[8];
#pragma unroll
    for (int e = 0; e < 8; ++e) gn[e] = hgn[c8 * 8 + e];
    for (int c = 0; c < 64; ++c) {
        const size_t off = ((size_t)b * SEQ + c * 64 + tok) * 256 + h * 64 + c8 * 8;
        __syncthreads();
        {
            float a[8];
            unpack8(*(const u32x4*)(HQ + off), a);
#pragma unroll
            for (int e = 0; e < 8; ++e) qf[tok * 64 + c8 * 8 + e] = a[e];
            unpack8(*(const u32x4*)(HK + off), a);
#pragma unroll
            for (int e = 0; e < 8; ++e) kf[tok * 64 + c8 * 8 + e] = a[e];
            unpack8(*(const u32x4*)(HI + off), a);
#pragma unroll
            for (int e = 0; e < 8; ++e) vf[tok * 64 + c8 * 8 + e] = a[e];
            const f32x4 l0 = *(const f32x4*)(HLF + off), l1 = *(const f32x4*)(HLF + off + 4);
#pragma unroll
            for (int e = 0; e < 4; ++e) { ff[tok * 64 + c8 * 8 + e] = expf(l0[e]); ff[tok * 64 + c8 * 8 + 4 + e] = expf(l1[e]); }
        }
        __syncthreads();
        for (int tk = 0; tk < 64; ++tk) {
            const float vv = vf[tk * 64 + vcol]; float op = 0.f;
#pragma unroll
            for (int j = 0; j < 8; ++j) { const int k = 8 * kg + j; S[j] = ff[tk * 64 + k] * S[j] + kf[tk * 64 + k] * vv; op += qf[tk * 64 + k] * S[j]; }
            op += __shfl_xor(op, 8); op += __shfl_xor(op, 16); op += __shfl_xor(op, 32);
            if (kg == 0) ob[tk * 64 + vcol] = op;
        }
        __syncthreads();
        {
            float ov[8], g[8]; float sq = 0.f;
#pragma unroll
            for (int e = 0; e < 8; ++e) { ov[e] = ob[tok * 64 + c8 * 8 + e]; sq += ov[e] * ov[e]; }
            sq += __shfl_xor(sq, 1); sq += __shfl_xor(sq, 2); sq += __shfl_xor(sq, 4);
            const float rn = rsqrtf(sq * (1.0f / 64.0f) + EPS);
            unpack8(*(const u32x4*)(HG + off), g);
            float r[8];
#pragma unroll
            for (int e = 0; e < 8; ++e) r[e] = ov[e] * rn * gn[e] * (g[e] / (1.0f + expf(-g[e])));
            u32x4 wv; wv.x = pk2(r[0], r[1]); wv.y = pk2(r[2], r[3]); wv.z = pk2(r[4], r[5]); wv.w = pk2(r[6], r[7]);
            *(u32x4*)(MIX + ((size_t)b * SEQ + c * 64 + tok) * DM + h * 64 + c8 * 8) = wv;
        }
    }
}

constexpr int HG_SLOT = 32768, HG_PRE = 16384, HG_TOT = 16384 + 1280, HG_VT = 20480, HG_VP = 72;
typedef short hbf16x8 __attribute__((ext_vector_type(8)));
typedef short hbf16x4 __attribute__((ext_vector_type(4)));
__device__ __forceinline__ hbf16x8 pack8(const float* x) { u32x4 w; w.x = pk2(x[0], x[1]); w.y = pk2(x[2], x[3]); w.z = pk2(x[4], x[5]); w.w = pk2(x[6], x[7]); return __builtin_bit_cast(hbf16x8, w); }

__device__ __forceinline__ void hg_stage(int tid, size_t row0, int h, const float* HLF, const bf16_t* HI, LAS unsigned char* sb) {
    const int lt = tid & 255, k = lt & 63, seg = lt >> 6;
    LAS float* bl = (LAS float*)sb; LAS float* pre = (LAS float*)(sb + HG_PRE); LAS float* tot = (LAS float*)(sb + HG_TOT); LAS bf16_t* vt = (LAS bf16_t*)(sb + HG_VT);
    float run = 0.f;
#pragma unroll
    for (int i = 0; i < 16; ++i) { const int t = 16 * seg + i; run += HLF[(row0 + t) * 256 + h * 64 + k]; bl[t * 64 + k] = run; }
    tot[seg * 64 + k] = run;
    {
        const int s = lt >> 2, c0 = (lt & 3) * 16;
        const u32x4 w0 = *(const u32x4*)(HI + (row0 + s) * 256 + h * 64 + c0), w1 = *(const u32x4*)(HI + (row0 + s) * 256 + h * 64 + c0 + 8);
        const unsigned ww[8] = {w0.x, w0.y, w0.z, w0.w, w1.x, w1.y, w1.z, w1.w};
#pragma unroll
        for (int e = 0; e < 8; ++e) { vt[(c0 + 2 * e) * HG_VP + s] = (bf16_t)(ww[e] & 0xffffu); vt[(c0 + 2 * e + 1) * HG_VP + s] = (bf16_t)(ww[e] >> 16); }
    }
    __syncthreads();
    if (lt < 64) { float p = 0.f;
#pragma unroll
        for (int sg = 0; sg < 4; ++sg) { pre[sg * 64 + lt] = p; p += tot[sg * 64 + lt]; }
        pre[4 * 64 + lt] = p; }
    __syncthreads();
}

__device__ __forceinline__ void hgrn_a_item(int item, unsigned char* P, float* DD, LAS unsigned char* L) {
    int tid_ = threadIdx.x; asm volatile("" : "+v"(tid_)); const int tid = tid_, lane = tid & 63, wq = (tid >> 6) & 3, cs = tid >> 8, r = lane & 15, g = lane >> 4;
    const int bh = item >> 5, chunk = (item & 31) * 2 + cs, b = bh >> 2, h = bh & 3;
    const size_t row0 = (size_t)b * SEQ + chunk * 64;
    const bf16_t* HK = (const bf16_t*)(P + P_HK); float* UT = (float*)(P + P_US);
    LAS unsigned char* sb = L + cs * HG_SLOT;
    hg_stage(tid, row0, h, (const float*)(P + P_HLF), (const bf16_t*)(P + P_HI), sb);
    const LAS float* bl = (const LAS float*)sb; const LAS float* pre = (const LAS float*)(sb + HG_PRE); const LAS unsigned char* vt = sb + HG_VT;
    const int k = 16 * wq + r; const float pre4 = pre[4 * 64 + k];
    hbf16x8 af[2];
#pragma unroll
    for (int ks = 0; ks < 2; ++ks) { const float pj = pre4 - pre[(2 * ks + (g >> 1)) * 64 + k]; float x[8];
#pragma unroll
        for (int j = 0; j < 8; ++j) { const int s = 32 * ks + 8 * g + j; x[j] = bf2f(HK[(row0 + s) * 256 + h * 64 + k]) * __expf(pj - bl[s * 64 + k]); }
        af[ks] = pack8(x); }
    float* ut = UT + ((size_t)(bh * 64 + chunk) * 64) * 64;
#pragma unroll
    for (int vtile = 0; vtile < 4; ++vtile) { f32x4 acc = {0.f, 0.f, 0.f, 0.f};
#pragma unroll
        for (int ks = 0; ks < 2; ++ks) { const hbf16x8 bf = *(const LAS hbf16x8*)(vt + (16 * vtile + r) * (HG_VP * 2) + (32 * ks + 8 * g) * 2); acc = __builtin_amdgcn_mfma_f32_16x16x32_bf16(af[ks], bf, acc, 0, 0, 0); }
        *(f32x4*)(ut + (size_t)(16 * vtile + r) * 64 + 16 * wq + 4 * g) = acc; }
    if (g == 0) DD[(size_t)(bh * 64 + chunk) * 64 + k] = __expf(pre4);
}

__device__ __forceinline__ void hgrn_b_scan(int bx, int G, unsigned char* P, const float* DD) {
    int tid_ = threadIdx.x; asm volatile("" : "+v"(tid_));
    float* UT = (float*)(P + P_US);
    for (int gid = bx * 512 + tid_; gid < 32 * 4096; gid += G * 512) {
        const int bh = gid >> 12, e = gid & 4095; float* u = UT + (size_t)bh * 64 * 4096 + e; const float* dd = DD + (size_t)bh * 64 * 64 + (e & 63);
        float S = 0.f;
        for (int c0 = 0; c0 < 64; c0 += 8) { float tu[8], td[8];
#pragma unroll
            for (int i = 0; i < 8; ++i) { tu[i] = u[(size_t)(c0 + i) * 4096]; td[i] = dd[(c0 + i) * 64]; }
#pragma unroll
            for (int i = 0; i < 8; ++i) { u[(size_t)(c0 + i) * 4096] = S; S = td[i] * S + tu[i]; } }
    }
}

__device__ __forceinline__ void hgrn_c_item(int item, unsigned char* P, bf16_t* MIX, const float* hgn, LAS unsigned char* L) {
    int tid_ = threadIdx.x; asm volatile("" : "+v"(tid_)); const int tid = tid_, lane = tid & 63, I = (tid >> 6) & 3, cs = tid >> 8, r = lane & 15, g = lane >> 4;
    const int bh = item >> 5, chunk = (item & 31) * 2 + cs, b = bh >> 2, h = bh & 3;
    const size_t row0 = (size_t)b * SEQ + chunk * 64;
    const bf16_t* HQ = (const bf16_t*)(P + P_HQ); const bf16_t* HK = (const bf16_t*)(P + P_HK); const bf16_t* HG = (const bf16_t*)(P + P_HG); const float* ST = (const float*)(P + P_US);
    LAS unsigned char* sb = L + cs * HG_SLOT;
    hg_stage(tid, row0, h, (const float*)(P + P_HLF), (const bf16_t*)(P + P_HI), sb);
    const LAS float* bl = (const LAS float*)sb; const LAS float* pre = (const LAS float*)(sb + HG_PRE); const LAS unsigned char* vt = sb + HG_VT;
    const int t = 16 * I + r;
    hbf16x8 qtf[2], qhf[2];
#pragma unroll
    for (int ks = 0; ks < 2; ++ks) { const int kb = 32 * ks + 8 * g; float q[8], xt[8], xh[8];
        unpack8(*(const u32x4*)(HQ + (row0 + t) * 256 + h * 64 + kb), q);
#pragma unroll
        for (int j = 0; j < 8; ++j) { xt[j] = q[j] * __expf(bl[t * 64 + kb + j]); xh[j] = xt[j] * __expf(pre[I * 64 + kb + j]); }
        qtf[ks] = pack8(xt); qhf[ks] = pack8(xh); }
    f32x4 at[4];
#pragma unroll
    for (int J = 0; J < 4; ++J) { at[J] = (f32x4){0.f, 0.f, 0.f, 0.f};
        if (J <= I) { const int s = 16 * J + r;
#pragma unroll
            for (int ks = 0; ks < 2; ++ks) { const int kb = 32 * ks + 8 * g; float kk[8], x[8];
                unpack8(*(const u32x4*)(HK + (row0 + s) * 256 + h * 64 + kb), kk);
#pragma unroll
                for (int j = 0; j < 8; ++j) x[j] = kk[j] * __expf(fminf(pre[I * 64 + kb + j] - pre[J * 64 + kb + j] - bl[s * 64 + kb + j], 80.f));
                at[J] = __builtin_amdgcn_mfma_f32_16x16x32_bf16(pack8(x), qtf[ks], at[J], 0, 0, 0); }
            if (J == I) {
#pragma unroll
                for (int i = 0; i < 4; ++i) at[J][i] = (4 * g + i <= r) ? at[J][i] : 0.f; } } }
    hbf16x8 pf[2];
#pragma unroll
    for (int k2 = 0; k2 < 2; ++k2) { const float x[8] = {at[2 * k2][0], at[2 * k2][1], at[2 * k2][2], at[2 * k2][3], at[2 * k2 + 1][0], at[2 * k2 + 1][1], at[2 * k2 + 1][2], at[2 * k2 + 1][3]}; pf[k2] = pack8(x); }
    const float* st = ST + ((size_t)(bh * 64 + chunk) * 64) * 64;
    f32x4 o[4];
#pragma unroll
    for (int vtile = 0; vtile < 4; ++vtile) { f32x4 acc = {0.f, 0.f, 0.f, 0.f}; const int v = 16 * vtile + r;
#pragma unroll
        for (int ks = 0; ks < 2; ++ks) { const float* sp = st + (size_t)v * 64 + 32 * ks + 8 * g; const f32x4 s0 = *(const f32x4*)sp, s1 = *(const f32x4*)(sp + 4);
            const float x[8] = {s0[0], s0[1], s0[2], s0[3], s1[0], s1[1], s1[2], s1[3]};
            acc = __builtin_amdgcn_mfma_f32_16x16x32_bf16(qhf[ks], pack8(x), acc, 0, 0, 0); }
#pragma unroll
        for (int k2 = 0; k2 < 2; ++k2) { if (k2 == 0 || I >= 2) {
            const hbf16x4 v0 = *(const LAS hbf16x4*)(vt + v * (HG_VP * 2) + (32 * k2 + 4 * g) * 2), v1 = *(const LAS hbf16x4*)(vt + v * (HG_VP * 2) + (32 * k2 + 16 + 4 * g) * 2);
            const hbf16x8 vf = {v0[0], v0[1], v0[2], v0[3], v1[0], v1[1], v1[2], v1[3]};
            acc = __builtin_amdgcn_mfma_f32_16x16x32_bf16(pf[k2], vf, acc, 0, 0, 0); } }
        o[vtile] = acc; }
#pragma unroll
    for (int i = 0; i < 4; ++i) { float sq = 0.f;
#pragma unroll
        for (int vtile = 0; vtile < 4; ++vtile) sq += o[vtile][i] * o[vtile][i];
        sq += __shfl_xor(sq, 1); sq += __shfl_xor(sq, 2); sq += __shfl_xor(sq, 4); sq += __shfl_xor(sq, 8);
        const float rn = rsqrtf(sq * (1.0f / 64.0f) + EPS); const size_t row = row0 + 16 * I + 4 * g + i;
#pragma unroll
        for (int vtile = 0; vtile < 4; ++vtile) { const int v = 16 * vtile + r; const float gg = bf2f(HG[row * 256 + h * 64 + v]);
            MIX[row * DM + h * 64 + v] = (bf16_t)f2bf(o[vtile][i] * rn * hgn[v] * (gg / (1.0f + __expf(-gg)))); } }
}

struct Args { const float* in[14]; float* out; unsigned char* ws; int ph_lo, ph_hi; };
constexpr int NPHASE = 1 + 7 * DEPTH;

__global__ void __launch_bounds__(512, 2) fwd(Args a) {
    extern __shared__ __attribute__((aligned(16))) unsigned char lds[];
    cg::grid_group grid = cg::this_grid();
    LAS unsigned char* L = (LAS unsigned char*)lds;
    if (threadIdx.x < 32) ((LAS unsigned*)(L + LDS_BYTES - 128))[threadIdx.x] = 0u;
    __syncthreads();
    for (int ph = a.ph_lo; ph < a.ph_hi; ++ph) {
        int G = gridDim.x, bx = blockIdx.x; asm volatile("" : "+s"(G), "+s"(bx));
        typedef const __attribute__((address_space(4))) Args* KArgP;
        KArgP ap = (KArgP)__builtin_amdgcn_kernarg_segment_ptr(); asm volatile("" : "+s"(ap));
        unsigned char* ws = ap->ws;
        float* SS = (float*)(ws + WS_SS); float* LB = (float*)(ws + WS_LB);
        bf16_t* XB = (bf16_t*)(ws + WS_XB); bf16_t* MIX = (bf16_t*)(ws + WS_MIX); bf16_t* UB = (bf16_t*)(ws + WS_U);
        unsigned char* P = ws + WS_P;
#ifdef PROBE_T
        if (ph == NPHASE) {
            if (bx == 0) { const unsigned long long* ts_ = (const unsigned long long*)(ws + 65536); unsigned long long sa = 0, sb = 0;
                for (int p = 1; p < NPHASE; ++p) { const int kk_ = (p - 1) % 7; const unsigned long long d = ts_[p] - ts_[p - 1]; if (PROBE_A(kk_)) sa += d; if (PROBE_B(kk_)) sb += d; }
                const float fa = (float)sa * 1e-3f, fb = (float)sb * 1e-3f; float* o_ = ap->out;
                for (int i = threadIdx.x; i < (1 << 20); i += 512) o_[(1 << 20) + i] += fb;
                if (threadIdx.x == 0) o_[0] = fa; }
        } else
#endif
        if (ph == 0) {
            int tid = threadIdx.x; asm volatile("" : "+v"(tid)); const int lane = tid & 63, wave = __builtin_amdgcn_readfirstlane(tid >> 6);
            LAS float* scr = (LAS float*)(L + wave * 16384);
            const int gw = bx * 8 + wave, NGW = G * 8;
            constexpr int I_IN = 16 * 112, I_OUT = 16 * 32, I_1 = 16 * 128, I_2 = 64 * 32, I_L = I_IN + I_OUT + I_1 + I_2;
            for (int it = gw; it < DEPTH * I_L; it += NGW) {
                const int l = it / I_L; int r = it % I_L;
                unsigned char* wl = ws + WS_W + (size_t)l * W_LAYER;
                if (r < I_IN) { const int kb = r / 112, nb = r % 112, n0 = nb * 32, pn = n0 >> 8, p = n0 & 255, slot = 4 * pn + ((p & 127) >> 5), sc0 = 64 * slot + 32 * (p >> 7);
                    tr_item(ap->in[3] + (size_t)l * DM * INC, INC, INC, sc0, kb * 64, ap->in[2] + l * DM, (bf16_t*)wl, DM, n0, scr, lane); continue; }
                r -= I_IN;
                if (r < I_OUT) { const int kb = r / 32, nb = r % 32; tr_item(ap->in[10] + (size_t)l * DM * DM, DM, DM, nb * 32, kb * 64, nullptr, (bf16_t*)(wl + W_OUT), DM, nb * 32, scr, lane); continue; }
                r -= I_OUT;
                if (r < I_1) { const int kb = r / 128, nb = r % 128; tr_item(ap->in[12] + (size_t)l * DM * DFF, DFF, DFF, nb * 32, kb * 64, ap->in[11] + l * DM, (bf16_t*)(wl + W_1), DM, nb * 32, scr, lane); continue; }
                r -= I_1;
                { const int kb = r / 32, nb = r % 32; tr_item(ap->in[13] + (size_t)l * DFF * DM, DM, DM, nb * 32, kb * 64, nullptr, (bf16_t*)(wl + W_2), DFF, nb * 32, scr, lane); }
            }
            const float* x = ap->in[0];
            for (int m = gw; m < M; m += NGW) {
                const f32x4* xr = (const f32x4*)(x + (size_t)m * DM) + lane; f32x4 v[4]; float s = 0.f;
#pragma unroll
                for (int j = 0; j < 4; ++j) { v[j] = xr[64 * j]; s += (v[j][0] * v[j][0] + v[j][1] * v[j][1]) + (v[j][2] * v[j][2] + v[j][3] * v[j][3]); }
                const float tot = wave_sum(s);
                u32x2* o8 = (u32x2*)(XB + (size_t)m * DM) + lane;
#pragma unroll
                for (int j = 0; j < 4; ++j) { u32x2 w; w.x = pk2(v[j][0], v[j][1]); w.y = pk2(v[j][2], v[j][3]); o8[64 * j] = w; }
                if (lane < 16) SS[(size_t)m * 16 + lane] = (lane == 0) ? tot : 0.f;
            }
            if (bx == 2 && tid < 64) ((unsigned*)ws)[tid] = 0u;
            if (bx == 3) for (int i = tid; i < XCD_BAR_WORDS; i += 512) ((unsigned*)(ws + WS_BAR))[i] = 0u;
            if (bx == 1) {
                for (int i = tid; i < 1024; i += 512) { const int l = i >> 8, wh = (i >> 6) & 3, d = i & 63; LB[2048 + i] = ap->in[5 + wh][l * 64 + d]; }
                if (tid < 32) { const int l = tid >> 3, e = tid & 7; LB[3072 + tid] = (e < 6) ? ap->in[9][l * 6 + e] : 0.f; }
            }
            if (bx == 0 && tid < 256) {
                const float* lg = ap->in[1]; float e[DEPTH]; float mx = -1e30f, sum = 0.f;
#pragma unroll
                for (int l = 0; l < DEPTH; ++l) mx = fmaxf(mx, lg[l * 256 + tid]);
#pragma unroll
                for (int l = 0; l < DEPTH; ++l) { e[l] = expf(lg[l * 256 + tid] - mx); sum += e[l]; }
                float c = 0.f;
#pragma unroll
                for (int l = 0; l < DEPTH; ++l) { if (l > 0) c += e[l] / sum; LB[l * 512 + tid] = logf(fmaxf(c, 1e-30f)); LB[l * 512 + 256 + tid] = 1.0f - c; }
            }
        } else {
            const int l = (ph - 1) / 7, k = (ph - 1) % 7;
#ifdef REP_K
            const int nrep = (k == REP_K) ? 2 : 1;
#else
            const int nrep = 1;
#endif
            for (int rep = 0; rep < nrep; ++rep) {
            if (rep) { XcdBarrier xb_; xb_.bar = (unsigned*)(ws + WS_BAR); xb_.x = xb_xcc_id(); xb_.st = (volatile LAS unsigned*)(L + LDS_BYTES - 128); xcd_barrier(xb_); }
            unsigned char* wl = ws + WS_W + (size_t)l * W_LAYER;
            if (k == 0) {
                pg8::Gemm g{XB, (const bf16_t*)wl, M, NIN, DM}; pg8::StaticOrder S; S.init(M, NIN, G, bx);
                EpiInProj E{SS, P, LB + l * 512, LB + 2048 + l * 256, LB + 3072 + l * 8};
                pg8::gemm_phase<EpiInProj, pg8::StaticOrder, true, true>(L, g, S, E);
            } else if (k == 1) {
                int tid = threadIdx.x; asm volatile("" : "+v"(tid));
                unsigned* ctr = (unsigned*)ws + l * 16 + 1 + rep * 4;
                volatile LAS int* sh = (volatile LAS int*)(L + LDS_BYTES - 64);
                for (;;) {
                    if (tid == 0) sh[0] = (int)atomicAdd(ctr, 1u);
                    __syncthreads();
                    const int idx = __builtin_amdgcn_readfirstlane(sh[0]);
                    __syncthreads();
                    if (idx >= 816 + 1024) break;
                    if (idx < 768) { const int qb = 15 - idx / 48, bh = idx % 48, b = bh / 6, h = bh % 6; typedef attn_body::bf16 abf;
                        attn_body::sb_unit(qb, (const abf*)(P + P_SQ) + (size_t)bh * SEQ * 64, (const abf*)(P + P_SQ + HEADBUF) + (size_t)bh * SEQ * 64, (const abf*)(P + P_SQ + 2 * HEADBUF) + (size_t)bh * SEQ * 64,
                                           (abf*)MIX + (size_t)b * SEQ * DM + 256 + h * 64, (char*)lds); }
                    else if (idx < 816) fox_cumsum_item(idx - 768, (const float*)(P + P_LF), (float*)(P + P_CC), (int*)(ws + WS_JS), LB + 2048 + l * 256 + 128, LB + 2048 + l * 256 + 192, (LAS float*)L);
                    else hgrn_a_item(idx - 816, P, (float*)(ws + WS_DD), L);
                    __syncthreads();
                }
            } else if (k == 2) {
                hgrn_b_scan(bx, G, P, (const float*)(ws + WS_DD));
            } else if (k == 3) {
                int tid = threadIdx.x; asm volatile("" : "+v"(tid));
                unsigned* ctr = (unsigned*)ws + l * 16 + rep * 4;
                volatile LAS int* sh = (volatile LAS int*)(L + LDS_BYTES - 64);
                for (;;) {
                    if (tid == 0) sh[0] = (int)atomicAdd(ctr, 1u);
                    __syncthreads();
                    const int idx = __builtin_amdgcn_readfirstlane(sh[0]);
                    __syncthreads();
                    if (idx >= 768 + 1024) break;
                    if (idx >= 768) { hgrn_c_item(idx - 768, P, MIX, ap->in[4] + l * 64, L); __syncthreads(); continue; }
                    const int qb = 15 - idx / 48, bh = idx % 48, b = bh / 6, h = bh % 6;
                    typedef attn_body::bf16 abf;
                    const int jstart = ((const int*)(ws + WS_JS))[bh * 16 + qb];
                    attn_body::attn_unit<8>(qb, jstart, (const abf*)(P + P_FQ) + (size_t)bh * SEQ * 64, (const abf*)(P + P_FQ + HEADBUF) + (size_t)bh * SEQ * 64, (const abf*)(P + P_FQ + 2 * HEADBUF) + (size_t)bh * SEQ * 64,
                                            (abf*)MIX + (size_t)b * SEQ * DM + 640 + h * 64, (const float*)(P + P_CC) + (size_t)bh * SEQ, (char*)lds);
                }
            } else if (k == 5) {
                pg8::Gemm g{XB, (const bf16_t*)(wl + W_1), M, DFF, DM}; pg8::StaticOrder S; S.init(M, DFF, G, bx);
                EpiRelu2 E{UB, SS};
                pg8::gemm_phase<EpiRelu2, pg8::StaticOrder, true, true>(L, g, S, E);
            } else {
                const bool ff2 = (k == 6);
                pg8::Gemm g{ff2 ? UB : MIX, (const bf16_t*)(wl + (ff2 ? W_2 : W_OUT)), M, DM, ff2 ? DFF : DM}; pg8::StaticOrder S; S.init(M, DM, G, bx);
                EpiResid E{XB, (ff2 && l == DEPTH - 1) ? ap->out : nullptr, SS};
                pg8::gemm_phase<EpiResid, pg8::StaticOrder, true, true>(L, g, S, E);
            }
            }
        }
#ifdef PROBE_T
        if (bx == 0 && threadIdx.x == 0) ((unsigned long long*)(ws + 65536))[ph] = __builtin_amdgcn_s_memrealtime();
#endif
        if (ph + 1 < a.ph_hi) {
            if (ph == 0) {
                grid.sync();
                (void)xcd_barrier_post((unsigned*)(ws + WS_BAR), (volatile LAS unsigned*)(L + LDS_BYTES - 128));
            } else {
                XcdBarrier xb_; xb_.bar = (unsigned*)(ws + WS_BAR); xb_.x = xb_xcc_id(); xb_.st = (volatile LAS unsigned*)(L + LDS_BYTES - 128);
                xcd_barrier(xb_);
            }
        }
    }
}

#ifndef MK_MULTI
#define MK_MULTI 0
#endif
extern "C" void kernel_launch(void* const* d_in, const int* in_sizes, int n_in, void* d_out, int out_size, void* d_ws, size_t ws_size, hipStream_t stream) {
    static int grid = 0;
    if (grid == 0) {
        int dev = 0, cus = 0, per = 0;
        if (n_in != 14 || out_size != M * DM || ws_size < WS_END) { fprintf(stderr, "kernel_launch: unexpected shapes (n_in %d out %d ws %zu)\n", n_in, out_size, ws_size); grid = -1; return; }
        (void)hipGetDevice(&dev); (void)hipDeviceGetAttribute(&cus, hipDeviceAttributeMultiprocessorCount, dev);
        (void)hipFuncSetAttribute((const void*)fwd, hipFuncAttributeMaxDynamicSharedMemorySize, LDS_BYTES);
        (void)hipOccupancyMaxActiveBlocksPerMultiprocessor(&per, (const void*)fwd, 512, LDS_BYTES);
        if (per < 1) per = 1;
        grid = cus * per;
        fprintf(stderr, "kernel_launch: grid %d (cus %d x %d)\n", grid, cus, per);
    }
    if (grid < 0) return;
    Args a{};
    for (int i = 0; i < 14; ++i) a.in[i] = (const float*)d_in[i];
    a.out = (float*)d_out; a.ws = (unsigned char*)d_ws;
#if MK_MULTI
    for (int ph = 0; ph < NPHASE; ++ph) { a.ph_lo = ph; a.ph_hi = ph + 1; hipLaunchKernelGGL(fwd, dim3(grid), dim3(512), LDS_BYTES, stream, a); }
#else
#ifdef PROBE_T
    a.ph_lo = 0; a.ph_hi = NPHASE + 1;
#else
    a.ph_lo = 0; a.ph_hi = NPHASE;
#endif
    void* args[] = {&a};
    hipError_t e = hipLaunchCooperativeKernel((const void*)fwd, dim3(grid), dim3(512), args, LDS_BYTES, stream);
    if (e != hipSuccess) fprintf(stderr, "kernel_launch: cooperative launch failed: %s (grid %d)\n", hipGetErrorString(e), grid);
#endif
}
```

```cpp
#include <hip/hip_runtime.h>
#include <hip/hip_cooperative_groups.h>
#include <cstdio>
#include <cstdint>
namespace cg = cooperative_groups;
namespace pg8 {
#define PG8_LAS __attribute__((address_space(3)))
typedef unsigned short bf16_t;
typedef short bf16x8 __attribute__((ext_vector_type(8)));
typedef float f32x4 __attribute__((ext_vector_type(4)));
typedef unsigned u32x4 __attribute__((ext_vector_type(4)));
constexpr int BM = 256, BK = 64, HALF = 128, HTB = HALF * BK * 2  , STAGE_BYTES = 8 * HTB, NXCD = 8, WGM = 8;

__host__ __device__ __forceinline__ int lds_byte(int r, int c) { const int st = (r >> 4) * 2 + (c >> 5), rr = r & 15, cc = c & 31, ob = rr * 64 + cc * 2; return st * 1024 + (ob ^ (((ob >> 9) & 1) << 5)); }
__host__ __device__ __forceinline__ void stage_rc(int b, int& R, int& C) { const int st = b / 1024, sb = b % 1024, swz = sb ^ (((sb >> 9) & 1) << 5); R = (st >> 1) * 16 + swz / 64; C = (st & 1) * 32 + (swz % 64) / 2; }
__host__ __device__ __forceinline__ int perm32(int rho) { const int n = rho >> 4, i = rho & 15; return 8 * (i >> 2) + 4 * n + (i & 3); }

struct Unit { int pm, pn; };
struct Gemm { const bf16_t* A; const bf16_t* Bt; int M, N, K; };

struct StaticOrder {
    int nM, nN, nwg, G, c;
    __host__ __device__ void init(int M, int N, int G_, int c_) { nM = M / BM; nN = N / BM; nwg = nM * nN; G = G_; c = c_; }
    __host__ __device__ bool next(int i, Unit& u) const {
        const long L = (long)i * G + c; if (L >= nwg) return false;
        int wgid = (int)L; { const int q = nwg / NXCD, r = nwg % NXCD, xcd = wgid % NXCD, off = wgid / NXCD; wgid = (xcd < r ? xcd * (q + 1) : r * (q + 1) + (xcd - r) * q) + off; }
        const int nig = WGM * nN, gid = wgid / nig, fm = gid * WGM, gsz = (nM - fm) < WGM ? (nM - fm) : WGM;
        u.pm = fm + ((wgid % nig) % gsz); u.pn = (wgid % nig) / gsz; return true;
    }
    __device__ __forceinline__ void a_ready(const Unit&) const {}
    __device__ __forceinline__ void done(const Unit&) const {}
};

__device__ __forceinline__ unsigned cvt_pk_bf16(float lo, float hi) { unsigned r; asm volatile("v_cvt_pk_bf16_f32 %0, %1, %2" : "=v"(r) : "v"(lo), "v"(hi)); return r; }
typedef float f32x2 __attribute__((ext_vector_type(2)));
template <class Epi, class Sched, bool ALIGN_EPI = false, bool SP2 = false>
__device__ __forceinline__ void gemm_phase(PG8_LAS unsigned char* lds, const Gemm g, const Sched& S, const Epi& E) {
    int tid_ = threadIdx.x; asm volatile("" : "+v"(tid_));
    const int tid = tid_, wid = __builtin_amdgcn_readfirstlane(tid >> 6), lane = tid & 63, wr = wid >> 2, wc = wid & 3, fr = lane & 15, fq = lane >> 4;
    const int K = g.K, nt = K / BK;
    unsigned voffA[2], voffB[2];
#pragma unroll
    for (int i = 0; i < 2; ++i) { int R, C; stage_rc(tid * 16 + i * 8192, R, C); const int Rb = Epi::PERM ? ((R & ~31) + perm32(R & 31)) : R;
        voffA[i] = (unsigned)(R * K + C) * 2u; voffB[i] = (unsigned)(Rb * K + C) * 2u; }
    const size_t kstep = (size_t)(BK * 2);
    const size_t hstep = (size_t)HALF * K * 2;
    const size_t tstep = 2 * hstep;
    const unsigned ldsw = (unsigned)wid * 1024u;
    const int aoff = lds_byte(wr * 64 + fr, fq * 8), boff = lds_byte(wc * 32 + fr, fq * 8);
#define PG8_SA(b, h) (((b) * 2 + (h)) * HTB)
#define PG8_SB(b, h) ((4 + (b) * 2 + (h)) * HTB)
#define PG8_STAGE(bufoff, gbase, voff) do { _Pragma("unroll") for (int _i = 0; _i < 2; ++_i) \
        __builtin_amdgcn_global_load_lds((const unsigned*)((const char*)(gbase) + (voff)[_i]), (PG8_LAS unsigned*)(lds + (bufoff) + ldsw + _i * 8192), 16, 0, 0); } while (0)
#define PG8_LDA(dst, b, h) do { _Pragma("unroll") for (int m = 0; m < 4; ++m) _Pragma("unroll") for (int k = 0; k < 2; ++k) dst[m][k] = *(const PG8_LAS bf16x8*)(lds + PG8_SA(b, h) + aoff + m * 2048 + k * 1024); } while (0)
#define PG8_LDB(dst, b, h) do { _Pragma("unroll") for (int n = 0; n < 2; ++n) _Pragma("unroll") for (int k = 0; k < 2; ++k) dst[n][k] = *(const PG8_LAS bf16x8*)(lds + PG8_SB(b, h) + boff + n * 2048 + k * 1024); } while (0)
#define PG8_MMA(ai, bj, At, Bt) do { __builtin_amdgcn_s_setprio(1); _Pragma("unroll") for (int m = 0; m < 4; ++m) _Pragma("unroll") for (int n = 0; n < 2; ++n) _Pragma("unroll") for (int k = 0; k < 2; ++k) \
        acc[ai][bj][m][n] = __builtin_amdgcn_mfma_f32_16x16x32_bf16(Bt[n][k], At[m][k], acc[ai][bj][m][n], 0, 0, 0); __builtin_amdgcn_s_setprio(0); } while (0)
#define PG8_WAIT_V(n) asm volatile("s_waitcnt vmcnt(" #n ")" ::: "memory")
#define PG8_WAIT_L(n) asm volatile("s_waitcnt lgkmcnt(" #n ")" ::: "memory")
#define PG8_BAR __builtin_amdgcn_s_barrier()
#define PG8_SCHED __builtin_amdgcn_sched_barrier(0)
    Unit cur, nxt; int ui = 0;
    if (!S.next(0, cur)) return;
    f32x4 acc[2][2][4][2];
#pragma unroll
    for (int a = 0; a < 2; ++a)
#pragma unroll
        for (int b = 0; b < 2; ++b)
#pragma unroll
            for (int m = 0; m < 4; ++m)
#pragma unroll
                for (int n = 0; n < 2; ++n) acc[a][b][m][n] = (f32x4){0.f, 0.f, 0.f, 0.f};
    bf16x8 At[4][2], B0[2][2], B1[2][2];
    const char* cA = (const char*)g.A + (size_t)cur.pm * tstep; const char* cB = (const char*)g.Bt + (size_t)cur.pn * tstep;
    S.a_ready(cur);
    if constexpr (SP2) {
        PG8_STAGE(PG8_SB(0, 0), cB, voffB); PG8_STAGE(PG8_SB(0, 1), cB + hstep, voffB); PG8_STAGE(PG8_SA(0, 0), cA, voffA); PG8_STAGE(PG8_SA(0, 1), cA + hstep, voffA);
        if (wr == 1) PG8_BAR;
        PG8_WAIT_V(2); PG8_BAR;
        PG8_STAGE(PG8_SB(1, 0), cB + kstep, voffB); PG8_STAGE(PG8_SA(1, 0), cA + kstep, voffA); PG8_STAGE(PG8_SB(1, 1), cB + hstep + kstep, voffB);
        PG8_WAIT_V(6); PG8_BAR;
    } else {
        PG8_STAGE(PG8_SB(0, 0), cB, voffB); PG8_STAGE(PG8_SA(0, 0), cA, voffA); PG8_STAGE(PG8_SB(0, 1), cB + hstep, voffB); PG8_STAGE(PG8_SA(0, 1), cA + hstep, voffA);
        if (wr == 1) PG8_BAR;
        PG8_WAIT_V(4); PG8_BAR;
        PG8_STAGE(PG8_SB(1, 0), cB + kstep, voffB); PG8_STAGE(PG8_SA(1, 0), cA + kstep, voffA); PG8_STAGE(PG8_SB(1, 1), cB + hstep + kstep, voffB);
        PG8_WAIT_V(6); PG8_BAR;
    }
    for (;;) {
        const bool has_next = S.next(ui + 1, nxt);
        const char* nA = has_next ? (const char*)g.A + (size_t)nxt.pm * tstep : cA; const char* nB = has_next ? (const char*)g.Bt + (size_t)nxt.pn * tstep : cB;
        for (int t = 0; t < nt; t += 2) {
            const bool last = (t == nt - 2);
            const char* a1 = cA + (size_t)(t + 1) * kstep;
            const char* a2 = last ? nA : cA + (size_t)(t + 2) * kstep; const char* b2 = last ? nB : cB + (size_t)(t + 2) * kstep;
            const char* a3 = a2 + kstep; const char* b3 = b2 + kstep;
            if (last && has_next) S.a_ready(nxt);
            if constexpr (SP2) {
            PG8_LDB(B0, 0, 0); PG8_LDB(B1, 0, 1); PG8_SCHED; PG8_LDA(At, 0, 0); PG8_STAGE(PG8_SA(1, 1), a1 + hstep, voffA);
            PG8_WAIT_V(8); PG8_WAIT_L(0); PG8_BAR; PG8_MMA(0, 0, At, B0); PG8_MMA(0, 1, At, B1); PG8_BAR; PG8_SCHED;
            PG8_LDA(At, 0, 1); PG8_STAGE(PG8_SB(0, 0), b2, voffB); PG8_STAGE(PG8_SB(0, 1), b2 + hstep, voffB); PG8_STAGE(PG8_SA(0, 0), a2, voffA);
            PG8_WAIT_V(8); PG8_WAIT_L(0); PG8_BAR; PG8_MMA(1, 0, At, B0); PG8_MMA(1, 1, At, B1); PG8_BAR; PG8_SCHED;
            PG8_LDB(B0, 1, 0); PG8_LDB(B1, 1, 1); PG8_SCHED; PG8_LDA(At, 1, 0); PG8_STAGE(PG8_SA(0, 1), a2 + hstep, voffA);
            PG8_WAIT_V(8); PG8_WAIT_L(0); PG8_BAR; PG8_MMA(0, 0, At, B0); PG8_MMA(0, 1, At, B1); PG8_BAR; PG8_SCHED;
            PG8_LDA(At, 1, 1); PG8_STAGE(PG8_SB(1, 0), b3, voffB); PG8_STAGE(PG8_SB(1, 1), b3 + hstep, voffB); PG8_STAGE(PG8_SA(1, 0), a3, voffA);
            PG8_WAIT_V(8); PG8_WAIT_L(0); PG8_BAR; PG8_MMA(1, 0, At, B0); PG8_MMA(1, 1, At, B1); PG8_BAR; PG8_SCHED;
            } else {
            PG8_LDB(B0, 0, 0); PG8_SCHED; PG8_LDA(At, 0, 0); PG8_STAGE(PG8_SA(1, 1), a1 + hstep, voffA);
            PG8_WAIT_L(8); PG8_BAR; PG8_WAIT_L(0); PG8_MMA(0, 0, At, B0); PG8_BAR; PG8_SCHED;
            PG8_LDB(B1, 0, 1); PG8_STAGE(PG8_SB(0, 0), b2, voffB);
            PG8_BAR; PG8_WAIT_L(0); PG8_MMA(0, 1, At, B1); PG8_BAR;
            PG8_LDA(At, 0, 1); PG8_STAGE(PG8_SA(0, 0), a2, voffA);
            PG8_BAR; PG8_WAIT_L(0); PG8_MMA(1, 0, At, B0); PG8_BAR; PG8_SCHED;
            PG8_STAGE(PG8_SB(0, 1), b2 + hstep, voffB);
            PG8_WAIT_V(6); PG8_BAR; PG8_MMA(1, 1, At, B1); PG8_BAR;
            PG8_LDB(B0, 1, 0); PG8_SCHED; PG8_LDA(At, 1, 0); PG8_STAGE(PG8_SA(0, 1), a2 + hstep, voffA);
            PG8_WAIT_L(8); PG8_BAR; PG8_WAIT_L(0); PG8_MMA(0, 0, At, B0); PG8_BAR; PG8_SCHED;
            PG8_LDB(B1, 1, 1); PG8_STAGE(PG8_SB(1, 0), b3, voffB);
            PG8_BAR; PG8_WAIT_L(0); PG8_MMA(0, 1, At, B1); PG8_BAR;
            PG8_LDA(At, 1, 1); PG8_STAGE(PG8_SA(1, 0), a3, voffA);
            PG8_BAR; PG8_WAIT_L(0); PG8_MMA(1, 0, At, B0); PG8_BAR; PG8_SCHED;
            PG8_STAGE(PG8_SB(1, 1), b3 + hstep, voffB);
            PG8_WAIT_V(6); PG8_BAR; PG8_MMA(1, 1, At, B1); PG8_BAR;
            }
        }
        if constexpr (ALIGN_EPI) { if (wr == 0) PG8_BAR; }
        if constexpr (!Epi::AFTER_DRAIN) { E(acc, cur, wr, wc, fr, fq); S.done(cur); }
        if (!has_next) break;
#pragma unroll
        for (int a = 0; a < 2; ++a)
#pragma unroll
            for (int b = 0; b < 2; ++b)
#pragma unroll
                for (int m = 0; m < 4; ++m)
#pragma unroll
                    for (int n = 0; n < 2; ++n) acc[a][b][m][n] = (f32x4){0.f, 0.f, 0.f, 0.f};
        cur = nxt; cA = nA; cB = nB; ++ui;
        if constexpr (ALIGN_EPI) { if (wr == 1) PG8_BAR; }
    }
    PG8_WAIT_V(0);
    if constexpr (!ALIGN_EPI) { if (wr == 0) PG8_BAR; }
    PG8_BAR;
    if constexpr (Epi::AFTER_DRAIN) { E.fused(acc, cur, wr, wc, fr, fq, lds, wid, lane); S.done(cur); }
#undef PG8_SA
#undef PG8_SB
#undef PG8_STAGE
#undef PG8_LDA
#undef PG8_LDB
#undef PG8_MMA
#undef PG8_WAIT_V
#undef PG8_WAIT_L
#undef PG8_BAR
#undef PG8_SCHED
}
}
#include <hip/hip_bf16.h>
#include <cmath>
namespace attn_body {
using bf16=__hip_bfloat16;
using bf16x8=__attribute__((ext_vector_type(8)))short;
using s16x4=__attribute__((ext_vector_type(4)))short;
using f32x16=__attribute__((ext_vector_type(16)))float;
using u32x4=__attribute__((ext_vector_type(4)))unsigned;
using f32x4v=__attribute__((ext_vector_type(4)))float;
constexpr int SEQ=4096,D=64,DM=64,OPITCH=1024;
constexpr int LDS_C=98304;
constexpr int NW=8,QBLK=32,QB=QBLK*NW,KVBLK=64,NQB=SEQ/QB;
constexpr int ATTN_UNIT_ROWS=QB;
__device__ __forceinline__ int crow(int r,int hi){return (r&3)+8*(r>>2)+4*hi;}
#define SBAR() __builtin_amdgcn_sched_barrier(0)
__device__ __forceinline__ void cmask(f32x16&p0,f32x16&p1,int jb,int qrel,int hi){
  const float NEG=-INFINITY; int kb=64*jb+4*hi;
  #pragma unroll
  for(int r=0;r<16;++r){int kv=kb+(r&3)+8*(r>>2); if(kv>qrel)p0[r]=NEG; if(kv+32>qrel)p1[r]=NEG;}
}

constexpr int NSLOT=3, SLOTB=8192;
constexpr int LDS_K=0, LDS_V=NSLOT*SLOTB, LDS_WS=2*NSLOT*SLOTB, LDS_OST=LDS_WS+NW*64*4, LDS_BYTES=LDS_OST+NW*4096;
constexpr float C2=0.125f*1.4426950408889634f;
__device__ __forceinline__ void glds16(const void*gsrc,unsigned lds_dst){unsigned keep;
  asm volatile("s_mov_b32 %0, m0\n\ts_mov_b32 m0, %2\n\ts_nop 0\n\tglobal_load_lds_dwordx4 %1, off\n\ts_mov_b32 m0, %0":"=&s"(keep):"v"(gsrc),"s"(lds_dst):"memory");}
__device__ __forceinline__ float max3f(float a,float b,float c){float r;asm("v_max3_f32 %0, %1, %2, %3":"=v"(r):"v"(a),"v"(b),"v"(c));return r;}
__device__ __forceinline__ float max2f(float a,float b){float r;asm("v_max_f32_e32 %0, %1, %2":"=v"(r):"v"(a),"v"(b));return r;}
__device__ __forceinline__ float fadd_s(float a,float b){float r;asm("v_add_f32_e32 %0, %1, %2":"=v"(r):"v"(a),"v"(b));return r;}
__device__ __forceinline__ float fsub_s(float a,float b){float r;asm("v_sub_f32_e32 %0, %1, %2":"=v"(r):"v"(a),"v"(b));return r;}
typedef float f32x2_t __attribute__((ext_vector_type(2))); typedef __bf16 bf16x2_t __attribute__((ext_vector_type(2)));
__device__ __forceinline__ unsigned cvtpk_s(float lo,float hi){f32x2_t v={lo,hi};bf16x2_t b=__builtin_convertvector(v,bf16x2_t);return __builtin_bit_cast(unsigned,b);}
#define WAIT_BAR(N) asm volatile("s_waitcnt vmcnt(" #N ") lgkmcnt(0)\n\ts_barrier":::"memory")

__device__ __forceinline__ void qkt(f32x16&p0,f32x16&p1,const char*Kslot,const bf16x8*qr,const f32x16&negm,int r32,int hi){
  const char*kb=Kslot+hi*1024+r32*16;
  #pragma unroll
  for(int d0=0;d0<4;++d0){
    const bf16x8 b0=*reinterpret_cast<const bf16x8*>(kb+d0*2048);
    const bf16x8 b1=*reinterpret_cast<const bf16x8*>(kb+d0*2048+512);
    if(d0==0){p0=__builtin_amdgcn_mfma_f32_32x32x16_bf16(b0,qr[0],negm,0,0,0);p1=__builtin_amdgcn_mfma_f32_32x32x16_bf16(b1,qr[0],negm,0,0,0);}
    else{p0=__builtin_amdgcn_mfma_f32_32x32x16_bf16(b0,qr[d0],p0,0,0,0);p1=__builtin_amdgcn_mfma_f32_32x32x16_bf16(b1,qr[d0],p1,0,0,0);}}
}
typedef __attribute__((address_space(3))) const char* lds_cptr;
typedef short v4i16_t __attribute__((ext_vector_type(4)));
__device__ __forceinline__ void kload8(bf16x8*kf,lds_cptr kp){
  kf[0]=*(const __attribute__((address_space(3))) bf16x8*)(kp);      kf[1]=*(const __attribute__((address_space(3))) bf16x8*)(kp+512);
  kf[2]=*(const __attribute__((address_space(3))) bf16x8*)(kp+2048); kf[3]=*(const __attribute__((address_space(3))) bf16x8*)(kp+2560);
  kf[4]=*(const __attribute__((address_space(3))) bf16x8*)(kp+4096); kf[5]=*(const __attribute__((address_space(3))) bf16x8*)(kp+4608);
  kf[6]=*(const __attribute__((address_space(3))) bf16x8*)(kp+6144); kf[7]=*(const __attribute__((address_space(3))) bf16x8*)(kp+6656);
}
__device__ __forceinline__ void kload2(bf16x8*kf,lds_cptr kp,int j){ kf[2*j]=*(const __attribute__((address_space(3))) bf16x8*)(kp+j*2048); kf[2*j+1]=*(const __attribute__((address_space(3))) bf16x8*)(kp+j*2048+512); }
__device__ __forceinline__ s16x4 vtr(lds_cptr p){ return __builtin_bit_cast(s16x4,__builtin_amdgcn_ds_read_tr16_b64_v4i16((__attribute__((address_space(3))) v4i16_t*)p)); }
__device__ __forceinline__ float rowmax(const f32x16&p0,const f32x16&p1){
  float a=max3f(p0[0],p0[1],p1[0]),b=max3f(p0[2],p0[3],p1[1]);a=max3f(a,p1[2],p1[3]);
  #pragma unroll
  for(int r=4;r<16;r+=4){a=max3f(a,p0[r],p0[r+1]);b=max3f(b,p0[r+2],p0[r+3]);a=max3f(a,p1[r],p1[r+1]);b=max3f(b,p1[r+2],p1[r+3]);}
  const float m=max2f(a,b);
  auto rr=__builtin_amdgcn_permlane32_swap(__float_as_uint(m),__float_as_uint(m),false,false);
  return max2f(__uint_as_float(rr[0]),__uint_as_float(rr[1]));
}
__device__ __forceinline__ void pv(f32x16*o,int vb,bf16x8 pa0,bf16x8 pa1,bf16x8 pa2,bf16x8 pa3){
  #pragma unroll
  for(int d0=0;d0<2;++d0){s16x4 lo[4],hi[4];
    #pragma unroll
    for(int ks=0;ks<4;++ks){
      asm volatile("ds_read_b64_tr_b16 %0,%1 offset:%c2":"=&v"(lo[ks]):"v"(vb),"i"(d0*4096+ks*1024):"memory");
      asm volatile("ds_read_b64_tr_b16 %0,%1 offset:%c2":"=&v"(hi[ks]):"v"(vb),"i"(d0*4096+ks*1024+512):"memory");}
    asm volatile("s_waitcnt lgkmcnt(0)":::"memory");SBAR();
    #define PK(k) (bf16x8){lo[k][0],lo[k][1],lo[k][2],lo[k][3],hi[k][0],hi[k][1],hi[k][2],hi[k][3]}
    o[d0]=__builtin_amdgcn_mfma_f32_32x32x16_bf16(pa0,PK(0),o[d0],0,0,0);
    o[d0]=__builtin_amdgcn_mfma_f32_32x32x16_bf16(pa1,PK(1),o[d0],0,0,0);
    o[d0]=__builtin_amdgcn_mfma_f32_32x32x16_bf16(pa2,PK(2),o[d0],0,0,0);
    o[d0]=__builtin_amdgcn_mfma_f32_32x32x16_bf16(pa3,PK(3),o[d0],0,0,0);
    #undef PK
  }
}

#ifndef ATTN_STORE16
#define ATTN_STORE16(p,v) (*(u32x4*)(p)=(v))
#endif
template<int THRL> __device__ __forceinline__ void attn_unit(int qb,int jstart,const bf16*Q,const bf16*__restrict__ K,const bf16*__restrict__ V,bf16*O,const float*__restrict__ Cg,char*shm){
  int tid_=threadIdx.x; asm volatile("":"+v"(tid_)); const int tid=tid_,lane=tid&63,r32=lane&31,hi=lane>>5; const int wid=__builtin_amdgcn_readfirstlane(tid>>6);
  const int q0=qb*QB;
  const bf16*Qw=Q+(long)(q0+wid*QBLK)*DM;
  const bf16*Kh=K+(long)jstart*KVBLK*DM,*Vh=V+(long)jstart*KVBLK*DM;
  const lds_cptr shm3=(lds_cptr)shm;
  const unsigned lds0=(unsigned)(uintptr_t)shm;
  float*wsf=(float*)(shm+LDS_WS)+wid*64;
  const bf16*ksrc=Kh+(long)lane*DM+wid*8;
  const bf16*vsrc=Vh+(long)(16*(wid&3)+(lane>>2))*DM+(wid>>2)*32+(lane&3)*8;
  const unsigned kdst=lds0+LDS_K+wid*1024, vdst=lds0+LDS_V+wid*1024;
  #define DMA_K(t,slot) glds16(ksrc+(long)(t)*KVBLK*DM,(unsigned)__builtin_amdgcn_readfirstlane(kdst+(slot)))
  #define DMA_V(t,slot) glds16(vsrc+(long)(t)*KVBLK*DM,(unsigned)__builtin_amdgcn_readfirstlane(vdst+(slot)))
  const int vb0=(int)(lds0+LDS_V)+((lane>>4)&1)*32+(lane&3)*8+(4*hi+((lane&15)>>2))*64;
  const char*Kbase=shm+LDS_K; bf16x8 kf[8];
  const lds_cptr kp0=shm3+LDS_K+hi*1024+r32*16; const lds_cptr vp0=shm3+LDS_V+((lane>>4)&1)*32+(lane&3)*8+(4*hi+((lane&15)>>2))*64;
  const int NT=(q0+QB)/KVBLK-jstart;
  { typedef __attribute__((address_space(3))) f32x4v lf32x4; lf32x4*cl_=(lf32x4*)(shm3+LDS_C); const f32x4v*cg_=(const f32x4v*)(Cg+jstart*KVBLK); const int n4_=(q0+QB-jstart*KVBLK)>>2;
    f32x4v c0_=f32x4v{},c1_=f32x4v{}; if(tid<n4_)c0_=cg_[tid]; if(tid+NW*64<n4_)c1_=cg_[tid+NW*64]; if(tid<n4_)cl_[tid]=c0_; if(tid+NW*64<n4_)cl_[tid+NW*64]=c1_; }
  DMA_K(0,0);DMA_V(0,0);DMA_K(1,SLOTB);
  bf16x8 qr[4];
  #pragma unroll
  for(int d0=0;d0<4;++d0)qr[d0]=*reinterpret_cast<const bf16x8*>(&Qw[(long)r32*DM+d0*16+hi*8]);
  float mhat=0.f,l_reg=0.f;f32x16 o[2];o[0]=f32x16{};o[1]=f32x16{};
  const int qrel=wid*QBLK+r32;
  #define CMASK(P0,P1,t) do{int jb_=(t)-(NT-4); if(jb_>=0)cmask(P0,P1,jb_,qrel,hi);}while(0)
  typedef __attribute__((address_space(3))) const float* lds_fptr; typedef __attribute__((address_space(3))) const f32x4v* lds_f4ptr;
  const lds_fptr cl0=(lds_fptr)(shm3+LDS_C)+4*hi;
  #define BIAS(P0,P1,t) do{ const lds_fptr cb_=cl0+64*(t); _Pragma("unroll") for(int g_=0;g_<4;++g_){ const f32x4v a_=*(lds_f4ptr)(cb_+8*g_), b_=*(lds_f4ptr)(cb_+32+8*g_); \
      _Pragma("unroll") for(int i_=0;i_<4;++i_){P0[4*g_+i_]-=a_[i_];P1[4*g_+i_]-=b_[i_];} } }while(0)
  #define BIASINIT(C0_,C1_,t) do{ const lds_fptr cb_=cl0+64*(t); const float nm_=-mhat; _Pragma("unroll") for(int g_=0;g_<4;++g_){ const f32x4v a_=*(lds_f4ptr)(cb_+8*g_), b_=*(lds_f4ptr)(cb_+32+8*g_); \
      _Pragma("unroll") for(int i_=0;i_<4;++i_){C0_[4*g_+i_]=nm_-a_[i_];C1_[4*g_+i_]=nm_-b_[i_];} } }while(0)
  bool resc=false;
  #define START(P0,P1) do{ const float rm=rowmax(P0,P1); resc=false; \
    { const float dl=rm; mhat=fadd_s(mhat,dl); \
      _Pragma("unroll") for(int r=0;r<16;++r){P0[r]=fsub_s(P0[r],dl);P1[r]=fsub_s(P1[r],dl);} \
      } \
    _Pragma("unroll") for(int r=0;r<16;++r)P0[r]=__builtin_amdgcn_exp2f(P0[r]); }while(0)
  #define RESC() do{ if(resc){ asm volatile("s_waitcnt lgkmcnt(0)":::"memory"); \
      _Pragma("unroll") for(int d_=0;d_<2;++d_) _Pragma("unroll") for(int r=0;r<16;++r)o[d_][r]*=wsf[crow(r,hi)]; } }while(0)
  f32x16 pA0,pA1,pB0,pB1;
  int sl_prev=0,sl_cur=0,sl_next=SLOTB;
  #define ROT() do{sl_prev=sl_cur;sl_cur=sl_next;sl_next=(sl_next==(NSLOT-1)*SLOTB)?0:sl_next+SLOTB;}while(0)
  DMA_K(2,2*SLOTB);
  WAIT_BAR(3);
  { const f32x16 zero_=f32x16{}; qkt(pA0,pA1,Kbase,qr,zero_,r32,hi); }asm volatile("s_nop 15\n\ts_nop 7":"+v"(pA0),"+v"(pA1));BIAS(pA0,pA1,0);CMASK(pA0,pA1,0);
  START(pA0,pA1);
  _Pragma("unroll") for(int r=0;r<16;++r)pA1[r]=__builtin_amdgcn_exp2f(pA1[r]);
  WAIT_BAR(0);
  DMA_K(3,0);DMA_V(1,SLOTB);
  ROT();
  kload8(kf,kp0+sl_cur);
  WAIT_BAR(2);
  s16x4 vlo[8],vhi[8]; u32x4 pw0,pw1,pw2,pw3;
  #define PKW(P,B) cvtpk_s(P[B],P[B+1])
  #define PAF(k) __builtin_bit_cast(bf16x8,pw##k)
  #define VFR(i) (bf16x8){vlo[i][0],vlo[i][1],vlo[i][2],vlo[i][3],vhi[i][0],vhi[i][1],vhi[i][2],vhi[i][3]}
  #define PIN(x) asm volatile("":"+v"(x))
  #define MX3(a,b,c) __builtin_fmaxf(__builtin_fmaxf((a),(b)),(c))
  #define GAPA(MF,A0,A1,A2,A3,W0,W1,PW) do{ MF; sacc+=A0; sacc+=A1; sacc+=A2; sacc+=A3; PIN(sacc); W0; W1; PIN(PW); SBAR(); }while(0)
  #define EX(v) __builtin_amdgcn_exp2f(v)
  #define GAPB(MF,X,B) do{ MF; X[B]=EX(X[B]); X[B+1]=EX(X[B+1]); X[B+2]=EX(X[B+2]); X[B+3]=EX(X[B+3]); PIN(X); SBAR(); }while(0)
  #define VRD(i) do{ vlo[i]=vtr(vp_+(((i)>>2)*4096+((i)&3)*1024)); vhi[i]=vtr(vp_+(((i)>>2)*4096+((i)&3)*1024+512)); }while(0)
  #define KRD(G,j) do{ if(G){ kload2(kf,kp0+sl_next,j); SBAR(); } }while(0)
  #define STEP(C0,C1,P0,P1,t,GK,GV,GL) do{ SBAR(); BIASINIT(C0,C1,t); SBAR(); \
    const lds_cptr vp_=vp0+sl_prev; \
    VRD(0); SBAR(); float sacc=(P0[0]+P0[1]); \
    GAPA(C0=__builtin_amdgcn_mfma_f32_32x32x16_bf16(kf[0],qr[0],C0,0,0,0), P0[2],P0[3],P0[4],P0[5],     pw0[0]=PKW(P0,0), pw0[1]=PKW(P0,2), pw0); \
    VRD(4); SBAR(); GAPA(C1=__builtin_amdgcn_mfma_f32_32x32x16_bf16(kf[1],qr[0],C1,0,0,0), P0[6],P0[7],P0[8],P0[9],     pw0[2]=PKW(P0,4), pw0[3]=PKW(P0,6), pw0); \
    VRD(1); SBAR(); GAPA(C0=__builtin_amdgcn_mfma_f32_32x32x16_bf16(kf[2],qr[1],C0,0,0,0),   P0[10],P0[11],P0[12],P0[13], pw1[0]=PKW(P0,8), pw1[1]=PKW(P0,10), pw1); \
    VRD(5); SBAR(); GAPA(C1=__builtin_amdgcn_mfma_f32_32x32x16_bf16(kf[3],qr[1],C1,0,0,0),   P0[14],P0[15],P1[0],P1[1],   pw1[2]=PKW(P0,12),pw1[3]=PKW(P0,14), pw1); \
    VRD(2); SBAR(); GAPA(C0=__builtin_amdgcn_mfma_f32_32x32x16_bf16(kf[4],qr[2],C0,0,0,0),   P1[2],P1[3],P1[4],P1[5],     pw2[0]=PKW(P1,0), pw2[1]=PKW(P1,2), pw2); \
    VRD(6); SBAR(); GAPA(C1=__builtin_amdgcn_mfma_f32_32x32x16_bf16(kf[5],qr[2],C1,0,0,0),   P1[6],P1[7],P1[8],P1[9],     pw2[2]=PKW(P1,4), pw2[3]=PKW(P1,6), pw2); \
    VRD(3); SBAR(); GAPA(C0=__builtin_amdgcn_mfma_f32_32x32x16_bf16(kf[6],qr[3],C0,0,0,0),   P1[10],P1[11],P1[12],P1[13], pw3[0]=PKW(P1,8), pw3[1]=PKW(P1,10), pw3); \
    VRD(7); SBAR(); GAPA(C1=__builtin_amdgcn_mfma_f32_32x32x16_bf16(kf[7],qr[3],C1,0,0,0),   P1[14],P1[15],0.f,0.f,       pw3[2]=PKW(P1,12),pw3[3]=PKW(P1,14), pw3); \
    l_reg+=sacc; \
    if(GK){DMA_K((t)+3,sl_cur);} if(GV){DMA_V((t)+1,sl_next);} \
    CMASK(C0,C1,t); \
    { float a=MX3(C0[0],C0[1],C1[0]),b=MX3(C0[2],C0[3],C1[1]); a=MX3(a,C1[2],C1[3]); \
      _Pragma("unroll") for(int r=4;r<16;r+=4){a=MX3(a,C0[r],C0[r+1]);b=MX3(b,C0[r+2],C0[r+3]);a=MX3(a,C1[r],C1[r+1]);b=MX3(b,C1[r+2],C1[r+3]);} \
      float rm=__builtin_fmaxf(a,b); { auto rr=__builtin_amdgcn_permlane32_swap(__float_as_uint(rm),__float_as_uint(rm),false,false); rm=__builtin_fmaxf(__uint_as_float(rr[0]),__uint_as_float(rr[1])); } \
      resc=false; \
      if(__builtin_expect(__any(rm>(float)THRL),0)){ const float dl=__builtin_fmaxf(rm,0.f); mhat+=dl; \
        _Pragma("unroll") for(int r=0;r<16;++r){C0[r]-=dl;C1[r]-=dl;} \
        const float f=__builtin_amdgcn_exp2f(-dl); l_reg*=f; if(hi==0)wsf[r32]=f; resc=true; } } \
    SBAR(); \
    GAPB(o[0]=__builtin_amdgcn_mfma_f32_32x32x16_bf16(PAF(0),VFR(0),o[0],0,0,0), C0,0); \
    GAPB(o[1]=__builtin_amdgcn_mfma_f32_32x32x16_bf16(PAF(0),VFR(4),o[1],0,0,0), C0,4); \
    KRD(GL,0); GAPB(o[0]=__builtin_amdgcn_mfma_f32_32x32x16_bf16(PAF(1),VFR(1),o[0],0,0,0), C0,8); \
    KRD(GL,1); GAPB(o[1]=__builtin_amdgcn_mfma_f32_32x32x16_bf16(PAF(1),VFR(5),o[1],0,0,0), C0,12); \
    KRD(GL,2); GAPB(o[0]=__builtin_amdgcn_mfma_f32_32x32x16_bf16(PAF(2),VFR(2),o[0],0,0,0), C1,0); \
    KRD(GL,3); GAPB(o[1]=__builtin_amdgcn_mfma_f32_32x32x16_bf16(PAF(2),VFR(6),o[1],0,0,0), C1,4); \
    GAPB(o[0]=__builtin_amdgcn_mfma_f32_32x32x16_bf16(PAF(3),VFR(3),o[0],0,0,0), C1,8); \
    GAPB(o[1]=__builtin_amdgcn_mfma_f32_32x32x16_bf16(PAF(3),VFR(7),o[1],0,0,0), C1,12); \
    }while(0)
  int t=1;
  #undef CMASK
  #define CMASK(P0,P1,t) do{}while(0)
  for(;t+5<NT;t+=2){
    STEP(pB0,pB1,pA0,pA1,t,true,true,true);     WAIT_BAR(2); RESC(); ROT();
    STEP(pA0,pA1,pB0,pB1,t+1,true,true,true);   WAIT_BAR(2); RESC(); ROT();
  }
  #undef CMASK
  #define CMASK(P0,P1,t) do{int jb_=(t)-(NT-4); if(jb_>=0)cmask(P0,P1,jb_,qrel,hi);}while(0)
  #define ENDW(tt) do{ if((tt)+3<NT){WAIT_BAR(2);} else if((tt)+2<NT){WAIT_BAR(1);} else {WAIT_BAR(0);} }while(0)
  for(;t+1<NT;t+=2){
    STEP(pB0,pB1,pA0,pA1,t,(t+3<NT),(t+1<NT),(t+1<NT));       ENDW(t);   RESC(); ROT();
    STEP(pA0,pA1,pB0,pB1,t+1,(t+4<NT),(t+2<NT),(t+2<NT));     ENDW(t+1); RESC(); ROT();
  }
  STEP(pB0,pB1,pA0,pA1,NT-1,false,false,false); RESC();
  { float sacc=pB0[0]+pB0[1]; _Pragma("unroll") for(int r=2;r<16;++r)sacc+=pB0[r]; _Pragma("unroll") for(int r=0;r<16;++r)sacc+=pB1[r]; l_reg+=sacc;
    pw0=(u32x4){PKW(pB0,0),PKW(pB0,2),PKW(pB0,4),PKW(pB0,6)};pw1=(u32x4){PKW(pB0,8),PKW(pB0,10),PKW(pB0,12),PKW(pB0,14)};pw2=(u32x4){PKW(pB1,0),PKW(pB1,2),PKW(pB1,4),PKW(pB1,6)};pw3=(u32x4){PKW(pB1,8),PKW(pB1,10),PKW(pB1,12),PKW(pB1,14)};
    SBAR(); pv(o,vb0+sl_cur,PAF(0),PAF(1),PAF(2),PAF(3)); }
  #undef PKW
  #undef PAF
  #undef VFR
  #undef PIN
  #undef MX3
  #undef GAPA
  #undef GAPB
  #undef EX
  #undef VRD
  #undef KRD
  #undef STEP
  #undef ENDW
  {auto rr=__builtin_amdgcn_permlane32_swap(__float_as_uint(l_reg),__float_as_uint(l_reg),false,false);l_reg=__uint_as_float(rr[0])+__uint_as_float(rr[1]);}
  if(hi==0)wsf[32+r32]=l_reg;asm volatile("s_waitcnt lgkmcnt(0)":::"memory");
  float rli[16];
  #pragma unroll
  for(int r=0;r<16;++r)rli[r]=__builtin_amdgcn_rcpf(wsf[32+crow(r,hi)]);
  bf16*Ow=O+(long)(q0+wid*QBLK)*OPITCH;
  { bf16*stg=(bf16*)(shm+LDS_OST)+wid*2048;
    #pragma unroll
    for(int r=0;r<16;++r){const int orow=crow(r,hi);
      #pragma unroll
      for(int d0=0;d0<2;++d0)stg[orow*64+d0*32+r32]=__float2bfloat16(o[d0][r]*rli[r]);}
    asm volatile("s_waitcnt lgkmcnt(0)":::"memory");
    #pragma unroll
    for(int i=0;i<4;++i){const int row=i*8+(lane>>3),ch=lane&7; const u32x4 v=*(const u32x4*)(stg+row*64+ch*8); ATTN_STORE16(Ow+(long)row*OPITCH+ch*8,v);} }
  asm volatile("s_waitcnt lgkmcnt(0)\n\ts_barrier":::"memory");
  #undef DMA_K
  #undef DMA_V
  #undef CMASK
  #undef BIAS
  #undef BIASINIT
  #undef START
  #undef RESC
  #undef ROT
}
__device__ __forceinline__ void sb_unit(int qb,const bf16*Q,const bf16*__restrict__ K,const bf16*__restrict__ V,bf16*O,char*shm){
  int tid_=threadIdx.x; asm volatile("":"+v"(tid_)); const int tid=tid_,lane=tid&63,r32=lane&31,hi=lane>>5; const int wid=__builtin_amdgcn_readfirstlane(tid>>6);
  const int q0=qb*QB;
  const bf16*Qw=Q+(long)(q0+wid*QBLK)*DM;
  const unsigned lds0=(unsigned)(uintptr_t)shm;
  typedef __attribute__((address_space(3))) int lds_i32; typedef __attribute__((address_space(3))) const u32x4* lds_u4ptr;
  lds_i32*flags=(lds_i32*)((lds_cptr)shm+LDS_WS);
  const bf16*ksrc=K+(long)lane*DM+wid*8;
  const bf16*vsrc=V+(long)(16*(wid&3)+(lane>>2))*DM+(wid>>2)*32+(lane&3)*8;
  const unsigned kdst=lds0+LDS_K+wid*1024, vdst=lds0+LDS_V+wid*1024;
  #define DMA_K(t,slot) glds16(ksrc+(long)(t)*KVBLK*DM,(unsigned)__builtin_amdgcn_readfirstlane(kdst+(slot)))
  #define DMA_V(t,slot) glds16(vsrc+(long)(t)*KVBLK*DM,(unsigned)__builtin_amdgcn_readfirstlane(vdst+(slot)))
  const int vb0=(int)(lds0+LDS_V)+((lane>>4)&1)*32+(lane&3)*8+(4*hi+((lane&15)>>2))*64;
  const int NT=(q0+QB)/KVBLK;
  DMA_K(NT-1,0);DMA_V(NT-1,0);
  bf16x8 qr[4];
  #pragma unroll
  for(int d0=0;d0<4;++d0)qr[d0]=*reinterpret_cast<const bf16x8*>(&Qw[(long)r32*DM+d0*16+hi*8]);
  f32x16 o[2];o[0]=f32x16{};o[1]=f32x16{};
  float T=0.f; const int t_abs=q0+wid*QBLK+r32; bool wdone=false;
  for(int i=0;;++i){
    const int jt=NT-1-i; const int slot=(i&1)*SLOTB; const bool more=jt>0;
    if(more){DMA_K(jt-1,slot^SLOTB);DMA_V(jt-1,slot^SLOTB); WAIT_BAR(2);} else {WAIT_BAR(0);}
    const bool band=(jt>=NT-4);
    if(!(wdone||(band&&64*(jt-(NT-4))>=QBLK*wid+QBLK))){
    f32x16 x0,x1; { f32x16 zero=f32x16{}; qkt(x0,x1,shm+LDS_K+slot,qr,zero,r32,hi); }
    f32x16 n0,n1;
    const int kb=64*jt+4*hi;
    #pragma unroll
    for(int r=0;r<16;++r){
      const float z0=x0[r],z1=x1[r];
      const float l0=__builtin_amdgcn_logf(1.0f+__builtin_amdgcn_exp2f(-__builtin_fabsf(z0))), l1=__builtin_amdgcn_logf(1.0f+__builtin_amdgcn_exp2f(-__builtin_fabsf(z1)));
      float a0=__builtin_fminf(z0,0.f)-l0, a1=__builtin_fminf(z1,0.f)-l1, m0=__builtin_fminf(-z0,0.f)-l0, m1=__builtin_fminf(-z1,0.f)-l1;
      if(band){ const int kv=kb+(r&3)+8*(r>>2); if(!(kv<t_abs)){a0=-INFINITY;m0=0.f;} if(!(kv+32<t_abs)){a1=-INFINITY;m1=0.f;} }
      x0[r]=a0;x1[r]=a1;n0[r]=m0;n1[r]=m1;
    }
    float g0[4],g1[4],p0s[4],p1s[4];
    #pragma unroll
    for(int a=0;a<4;++a){ g0[a]=(n0[4*a]+n0[4*a+1])+(n0[4*a+2]+n0[4*a+3]); g1[a]=(n1[4*a]+n1[4*a+1])+(n1[4*a+2]+n1[4*a+3]);
      { auto rr=__builtin_amdgcn_permlane32_swap(__float_as_uint(g0[a]),__float_as_uint(g0[a]),false,false); p0s[a]=__uint_as_float(hi?rr[0]:rr[1]); }
      { auto rr=__builtin_amdgcn_permlane32_swap(__float_as_uint(g1[a]),__float_as_uint(g1[a]),false,false); p1s[a]=__uint_as_float(hi?rr[0]:rr[1]); } }
    float run=T;
    #pragma unroll
    for(int a=3;a>=0;--a){ float off=run+(hi?0.f:p1s[a]); run+=g1[a]+p1s[a];
      const float t3=off,t2=t3+n1[4*a+3],t1=t2+n1[4*a+2],t0=t1+n1[4*a+1];
      x1[4*a+3]=__builtin_amdgcn_exp2f(x1[4*a+3]+t3); x1[4*a+2]=__builtin_amdgcn_exp2f(x1[4*a+2]+t2); x1[4*a+1]=__builtin_amdgcn_exp2f(x1[4*a+1]+t1); x1[4*a]=__builtin_amdgcn_exp2f(x1[4*a]+t0); }
    #pragma unroll
    for(int a=3;a>=0;--a){ float off=run+(hi?0.f:p0s[a]); run+=g0[a]+p0s[a];
      const float t3=off,t2=t3+n0[4*a+3],t1=t2+n0[4*a+2],t0=t1+n0[4*a+1];
      x0[4*a+3]=__builtin_amdgcn_exp2f(x0[4*a+3]+t3); x0[4*a+2]=__builtin_amdgcn_exp2f(x0[4*a+2]+t2); x0[4*a+1]=__builtin_amdgcn_exp2f(x0[4*a+1]+t1); x0[4*a]=__builtin_amdgcn_exp2f(x0[4*a]+t0); }
    T=run;
    u32x4 pw0,pw1,pw2,pw3;
    pw0=(u32x4){cvtpk_s(x0[0],x0[1]),cvtpk_s(x0[2],x0[3]),cvtpk_s(x0[4],x0[5]),cvtpk_s(x0[6],x0[7])};
    pw1=(u32x4){cvtpk_s(x0[8],x0[9]),cvtpk_s(x0[10],x0[11]),cvtpk_s(x0[12],x0[13]),cvtpk_s(x0[14],x0[15])};
    pw2=(u32x4){cvtpk_s(x1[0],x1[1]),cvtpk_s(x1[2],x1[3]),cvtpk_s(x1[4],x1[5]),cvtpk_s(x1[6],x1[7])};
    pw3=(u32x4){cvtpk_s(x1[8],x1[9]),cvtpk_s(x1[10],x1[11]),cvtpk_s(x1[12],x1[13]),cvtpk_s(x1[14],x1[15])};
    SBAR(); pv(o,vb0+slot,__builtin_bit_cast(bf16x8,pw0),__builtin_bit_cast(bf16x8,pw1),__builtin_bit_cast(bf16x8,pw2),__builtin_bit_cast(bf16x8,pw3));
    wdone=__all(T<-150.f);
    }
    if(lane==0)flags[wid]=wdone?1:0;
    WAIT_BAR(2);
    const u32x4 f0=*(lds_u4ptr)(flags), f1=*(lds_u4ptr)(flags+4);
    const bool alld=((f0.x&f0.y&f0.z&f0.w)&(f1.x&f1.y&f1.z&f1.w))!=0;
    if(!more||alld)break;
  }
  WAIT_BAR(0);
  bf16*Ow=O+(long)(q0+wid*QBLK)*OPITCH;
  { bf16*stg=(bf16*)(shm+LDS_OST)+wid*2048;
    #pragma unroll
    for(int r=0;r<16;++r){const int orow=crow(r,hi);
      #pragma unroll
      for(int d0=0;d0<2;++d0)stg[orow*64+d0*32+r32]=__float2bfloat16(o[d0][r]);}
    asm volatile("s_waitcnt lgkmcnt(0)":::"memory");
    #pragma unroll
    for(int i=0;i<4;++i){const int row=i*8+(lane>>3),ch=lane&7; const u32x4 v=*(const u32x4*)(stg+row*64+ch*8); ATTN_STORE16(Ow+(long)row*OPITCH+ch*8,v);} }
  asm volatile("s_waitcnt lgkmcnt(0)\n\ts_barrier":::"memory");
  #undef DMA_K
  #undef DMA_V
}
#undef SBAR
#undef WAIT_BAR
}

constexpr int BATCH = 8, SEQ = 4096, DM = 1024, DEPTH = 4, M = BATCH * SEQ, INC = 3334, NIN = 3584, DFF = 4096;
constexpr float EPS = 1e-6f;
constexpr size_t MiB = 1u << 20;
constexpr size_t WS_BAR = 128 * 1024;
constexpr size_t WS_SS = 1 * MiB;
constexpr size_t WS_LB = 3 * MiB;
constexpr size_t WS_JS = 3 * MiB + 256 * 1024;
constexpr size_t WS_DD = 3 * MiB + 512 * 1024;
constexpr size_t WS_W = 4 * MiB;
constexpr size_t W_LAYER = 25 * MiB, W_OUT = 7 * MiB, W_1 = 9 * MiB, W_2 = 17 * MiB;
constexpr size_t WS_XB = 104 * MiB;
constexpr size_t WS_P = 168 * MiB;
constexpr size_t P_HQ = 0, P_HK = 16 * MiB, P_HI = 32 * MiB, P_HG = 48 * MiB, P_HLF = 64 * MiB, P_SQ = 96 * MiB, P_FQ = 168 * MiB, P_LF = 240 * MiB, P_CC = 241 * MiB, P_US = 242 * MiB;
constexpr size_t HEADBUF = 24 * MiB;
constexpr size_t WS_MIX = 442 * MiB;
constexpr size_t WS_U = 168 * MiB;
constexpr size_t WS_END = 506 * MiB;
constexpr int LDS_BYTES = 147456;

typedef pg8::bf16_t bf16_t;
typedef pg8::f32x4 f32x4;
typedef unsigned u32x4 __attribute__((ext_vector_type(4)));
typedef unsigned u32x2 __attribute__((ext_vector_type(2)));
#define LAS __attribute__((address_space(3)))

__device__ __forceinline__ unsigned f2bf(float f) { unsigned u = __builtin_bit_cast(unsigned, f); return (u + 0x7fffu + ((u >> 16) & 1u)) >> 16; }
__device__ __forceinline__ unsigned pk2(float lo, float hi) { return pg8::cvt_pk_bf16(lo, hi); }
__device__ __forceinline__ float bf2f(unsigned short b) { return __builtin_bit_cast(float, (unsigned)b << 16); }
__device__ __forceinline__ float bflo(unsigned w) { return __builtin_bit_cast(float, w << 16); }
__device__ __forceinline__ float bfhi(unsigned w) { return __builtin_bit_cast(float, w & 0xffff0000u); }
__device__ __forceinline__ float logsig(float x) { return fminf(x, 0.f) - log1pf(expf(-fabsf(x))); }
__device__ __forceinline__ float wave_sum(float v) {
#pragma unroll
    for (int o = 1; o < 64; o <<= 1) v += __shfl_xor(v, o);
    return v;
}
#define ROWSCALES8(rs, ss, row0, fq) float rs[2][4]; _Pragma("unroll") for (int ai_ = 0; ai_ < 2; ++ai_) _Pragma("unroll") for (int m_ = 0; m_ < 4; ++m_) rs[ai_][m_] = rowscale(ss, (row0) + ai_ * 128 + m_ * 16, fq);
__device__ __forceinline__ float rowscale(const float* ss, int row, int fq) {
    const f32x4 p = *(const f32x4*)(ss + (size_t)row * 16 + 4 * fq);
    float s = (p[0] + p[1]) + (p[2] + p[3]);
    s += __shfl_xor(s, 16); s += __shfl_xor(s, 32);
    return rsqrtf(s * (1.0f / DM) + EPS);
}

#define ROWFENCE() asm volatile("" ::: "memory")
struct EpiResid {
    static constexpr bool PERM = true, AFTER_DRAIN = false;
    bf16_t* xb; float* outf; float* ss;
    __device__ __forceinline__ void operator()(const f32x4 (&acc)[2][2][4][2], const pg8::Unit& u, int wr, int wc, int fr, int fq) const {
        const int row0 = u.pm * 256 + wr * 64 + fr, col0 = u.pn * 256 + wc * 32 + 8 * fq;
#pragma unroll
        for (int ai = 0; ai < 2; ++ai) {
            u32x4 pre[4][2];
#pragma unroll
            for (int m = 0; m < 4; ++m)
#pragma unroll
                for (int bj = 0; bj < 2; ++bj) pre[m][bj] = *(const u32x4*)(xb + (size_t)(row0 + ai * 128 + m * 16) * DM + col0 + bj * 128);
#pragma unroll
            for (int m = 0; m < 4; ++m) {
                const int row = row0 + ai * 128 + m * 16; float sq = 0.f;
#pragma unroll
                for (int bj = 0; bj < 2; ++bj) {
                    const size_t off = (size_t)row * DM + col0 + bj * 128; const u32x4 p = pre[m][bj];
                    const f32x4 v0 = acc[ai][bj][m][0] + (f32x4){bflo(p.x), bfhi(p.x), bflo(p.y), bfhi(p.y)}, v1 = acc[ai][bj][m][1] + (f32x4){bflo(p.z), bfhi(p.z), bflo(p.w), bfhi(p.w)};
                    if (outf) { *(f32x4*)(outf + off) = v0; *(f32x4*)(outf + off + 4) = v1; }
                    u32x4 w; w.x = pk2(v0[0], v0[1]); w.y = pk2(v0[2], v0[3]); w.z = pk2(v1[0], v1[1]); w.w = pk2(v1[2], v1[3]);
                    *(u32x4*)(xb + off) = w;
                    sq += (v0[0] * v0[0] + v0[1] * v0[1]) + (v0[2] * v0[2] + v0[3] * v0[3]) + (v1[0] * v1[0] + v1[1] * v1[1]) + (v1[2] * v1[2] + v1[3] * v1[3]);
                }
                sq += __shfl_xor(sq, 16); sq += __shfl_xor(sq, 32);
                if (fq == 0) ss[(size_t)row * 16 + u.pn * 4 + wc] = sq;
            }
            ROWFENCE();
        }
    }
};
struct EpiRelu2 {
    static constexpr bool PERM = true, AFTER_DRAIN = false;
    bf16_t* U; const float* ss;
    __device__ __forceinline__ void operator()(const f32x4 (&acc)[2][2][4][2], const pg8::Unit& u, int wr, int wc, int fr, int fq) const {
        const int row0 = u.pm * 256 + wr * 64 + fr, col0 = u.pn * 256 + wc * 32 + 8 * fq;
        ROWSCALES8(rs8, ss, row0, fq)
#pragma unroll
        for (int ai = 0; ai < 2; ++ai)
#pragma unroll
            for (int m = 0; m < 4; ++m) {
                const int row = row0 + ai * 128 + m * 16; const float rs = rs8[ai][m];
#pragma unroll
                for (int bj = 0; bj < 2; ++bj) {
                    f32x4 v0 = acc[ai][bj][m][0] * rs, v1 = acc[ai][bj][m][1] * rs;
                    v0 = __builtin_elementwise_max(v0, (f32x4){0.f, 0.f, 0.f, 0.f}); v1 = __builtin_elementwise_max(v1, (f32x4){0.f, 0.f, 0.f, 0.f});
                    v0 = v0 * v0; v1 = v1 * v1;
                    u32x4 w; w.x = pk2(v0[0], v0[1]); w.y = pk2(v0[2], v0[3]); w.z = pk2(v1[0], v1[1]); w.w = pk2(v1[2], v1[3]);
                    *(u32x4*)(U + (size_t)row * DFF + col0 + bj * 128) = w;
                }
                ROWFENCE();
            }
    }
};
struct EpiInProj {
    static constexpr bool PERM = true, AFTER_DRAIN = false;
    const float* ss; unsigned char* P; const float* lbt;
    const float* gt; const float* fbias;
    __device__ __forceinline__ void operator()(const f32x4 (&acc)[2][2][4][2], const pg8::Unit& u, int wr, int wc, int fr, int fq) const {
        const int slot = u.pn * 4 + wc;
        if (slot > 52) return;
        const int row0 = u.pm * 256 + wr * 64 + fr;
        ROWSCALES8(rs8, ss, row0, fq)
        if (slot < 16) {
            const int kind = slot >> 2, cb = (slot & 3) * 64 + 8 * fq;
            if (kind == 1) {
                float* HLF = (float*)(P + P_HLF); bf16_t* HK = (bf16_t*)(P + P_HK);
#pragma unroll
                for (int ai = 0; ai < 2; ++ai)
#pragma unroll
                    for (int m = 0; m < 4; ++m) {
                        const int row = row0 + ai * 128 + m * 16; const float rs = rs8[ai][m];
#pragma unroll
                        for (int bj = 0; bj < 2; ++bj) {
                            float lf[8], kk[8];
#pragma unroll
                            for (int n = 0; n < 2; ++n) {
                                const f32x4 ll = *(const f32x4*)(lbt + cb + 32 * bj + 4 * n), om = *(const f32x4*)(lbt + 256 + cb + 32 * bj + 4 * n);
#pragma unroll
                                for (int i = 0; i < 4; ++i) {
                                    const float fl = acc[ai][bj][m][n][i] * rs;
                                    const float a = fminf(fl, 0.f) - __logf(1.0f + __expf(-fabsf(fl)));
                                    const float an = a - fl;
                                    const float b = ll[i] + an;
                                    lf[4 * n + i] = fmaxf(a, b) + __logf(1.0f + __expf(-fabsf(a - b)));
                                    kk[4 * n + i] = om[i] * __expf(an);
                                }
                            }
                            const size_t off = (size_t)row * 256 + cb + 32 * bj;
                            *(f32x4*)(HLF + off) = (f32x4){lf[0], lf[1], lf[2], lf[3]}; *(f32x4*)(HLF + off + 4) = (f32x4){lf[4], lf[5], lf[6], lf[7]};
                            u32x4 w; w.x = pk2(kk[0], kk[1]); w.y = pk2(kk[2], kk[3]); w.z = pk2(kk[4], kk[5]); w.w = pk2(kk[6], kk[7]);
                            *(u32x4*)(HK + off) = w;
                        }
                        ROWFENCE();
                    }
            } else {
                bf16_t* dst = (bf16_t*)(P + (kind == 0 ? P_HQ : (kind == 2 ? P_HI : P_HG)));
#pragma unroll
                for (int ai = 0; ai < 2; ++ai)
#pragma unroll
                    for (int m = 0; m < 4; ++m) {
                        const int row = row0 + ai * 128 + m * 16; const float rs = rs8[ai][m];
#pragma unroll
                        for (int bj = 0; bj < 2; ++bj) {
                            const f32x4 v0 = acc[ai][bj][m][0] * rs, v1 = acc[ai][bj][m][1] * rs;
                            u32x4 w; w.x = pk2(v0[0], v0[1]); w.y = pk2(v0[2], v0[3]); w.z = pk2(v1[0], v1[1]); w.w = pk2(v1[2], v1[3]);
                            *(u32x4*)(dst + (size_t)row * 256 + cb + 32 * bj) = w;
                        }
                        ROWFENCE();
                    }
            }
        } else if (slot < 52) {
            const int s2 = slot - 16, grp = s2 / 6, h = s2 % 6, role = grp % 3;
            bf16_t* dst = (bf16_t*)(P + P_SQ + (size_t)grp * HEADBUF) + (size_t)((u.pm >> 4) * 6 + h) * SEQ * 64 + 8 * fq;
            const float* gp = gt + (grp - (grp >= 3 ? 1 : 0)) * 64 + 8 * fq;
            const float qs = (role == 0) ? 0.125f * 1.4426950408889634f : 1.0f;
#pragma unroll
            for (int ai = 0; ai < 2; ++ai)
#pragma unroll
                for (int m = 0; m < 4; ++m) {
                    const int row = row0 + ai * 128 + m * 16; const float rs = rs8[ai][m];
                    float fac = rs;
                    if (role != 2) {
                        float sq = 0.f;
#pragma unroll
                        for (int bj = 0; bj < 2; ++bj)
#pragma unroll
                            for (int n = 0; n < 2; ++n) { const f32x4 x = acc[ai][bj][m][n]; sq += (x[0] * x[0] + x[1] * x[1]) + (x[2] * x[2] + x[3] * x[3]); }
                        sq += __shfl_xor(sq, 16); sq += __shfl_xor(sq, 32);
                        fac = rs * rsqrtf(rs * rs * sq * (1.0f / 64.0f) + EPS) * qs;
                    }
                    const int t = row & (SEQ - 1);
#pragma unroll
                    for (int bj = 0; bj < 2; ++bj) {
                        f32x4 v0 = acc[ai][bj][m][0] * fac, v1 = acc[ai][bj][m][1] * fac;
                        if (role != 2) { v0 = v0 * *(const f32x4*)(gp + 32 * bj); v1 = v1 * *(const f32x4*)(gp + 32 * bj + 4); }
                        u32x4 w; w.x = pk2(v0[0], v0[1]); w.y = pk2(v0[2], v0[3]); w.z = pk2(v1[0], v1[1]); w.w = pk2(v1[2], v1[3]);
                        *(u32x4*)(dst + (size_t)t * 64 + 32 * bj) = w;
                    }
                    ROWFENCE();
                }
        } else {
            float* LF = (float*)(P + P_LF);
#pragma unroll
            for (int ai = 0; ai < 2; ++ai)
#pragma unroll
                for (int m = 0; m < 4; ++m) {
                    const int row = row0 + ai * 128 + m * 16; const float rs = rs8[ai][m];
                    if (fq == 0) {
                        const f32x4 a0 = acc[ai][0][m][0], a1 = acc[ai][0][m][1];
                        *(f32x4*)(LF + (size_t)row * 8) = (f32x4){logsig(a0[0] * rs + fbias[0]), logsig(a0[1] * rs + fbias[1]), logsig(a0[2] * rs + fbias[2]), logsig(a0[3] * rs + fbias[3])};
                        *(f32x4*)(LF + (size_t)row * 8 + 4) = (f32x4){logsig(a1[0] * rs + fbias[4]), logsig(a1[1] * rs + fbias[5]), 0.f, 0.f};
                    }
                    ROWFENCE();
                }
        }
    }
};
#define XB_TMO      128
#define XB_XCNT(j)  (256  + 64 * (j))
#define XB_XSUB(j)  (1280 + 64 * (j))
#define XB_XGEN(j)  (2304 + 64 * (j))
#define XB_TOP      3328
#define XB_TOPGEN   3392
#define XCD_BAR_WORDS 3456
#define XB_SPIN_CAP (1u << 18)

__device__ __forceinline__ unsigned xb_ld(unsigned* p)              { return __hip_atomic_load(p, __ATOMIC_RELAXED, __HIP_MEMORY_SCOPE_AGENT); }
__device__ __forceinline__ unsigned xb_add(unsigned* p, unsigned v) { return __hip_atomic_fetch_add(p, v, __ATOMIC_RELAXED, __HIP_MEMORY_SCOPE_AGENT); }
__device__ __forceinline__ unsigned xb_xcc_id() { return (unsigned)__builtin_amdgcn_s_getreg((3 << 11) | 20) & 0xFu; }
#define XB_SPIN(cond, bar) do { unsigned _sp = 0; while (cond) { __builtin_amdgcn_s_sleep(1); \
    if ((++_sp & 255u) == 0u) { if (xb_ld(&(bar)[XB_TMO])) break; if (_sp > XB_SPIN_CAP) { atomicAdd(&(bar)[XB_TMO], 1u); break; } } } } while (0)

struct XcdBarrier {
    unsigned* bar; unsigned x;
    volatile LAS unsigned* st;
};

__device__ __forceinline__ XcdBarrier xcd_barrier_post(unsigned* bar, volatile LAS unsigned* st) {
    XcdBarrier b; b.bar = bar; b.x = xb_xcc_id(); b.st = st;
    if (threadIdx.x == 0) (void)xb_add(&bar[XB_XCNT(b.x)], 1u);
    return b;
}
__device__ __forceinline__ void xcd_barrier_complete(unsigned* bar, unsigned x, unsigned& nloc, unsigned& nx) {
    const unsigned G = gridDim.x * gridDim.y * gridDim.z;
    unsigned sum, cnt, mine, sp = 0u;
    for (;;) {
        sum = 0u; cnt = 0u; mine = 0u;
#pragma unroll
        for (unsigned j = 0; j < 16; ++j) { const unsigned c = xb_ld(&bar[XB_XCNT(j)]); sum += c; cnt += (c > 0u) ? 1u : 0u; mine = (j == x) ? c : mine; }
        if (sum == G) break;
        __builtin_amdgcn_s_sleep(1);
        if ((++sp & 255u) == 0u) { if (xb_ld(&bar[XB_TMO])) break; if (sp > XB_SPIN_CAP) { atomicAdd(&bar[XB_TMO], 1u); break; } }
    }
    nloc = mine > 0u ? mine : 1u; nx = cnt > 0u ? cnt : 1u;
}

__device__ __forceinline__ void xcd_barrier(const XcdBarrier& b) {
    asm volatile("s_waitcnt vmcnt(0)" ::: "memory");
    __syncthreads();
    if (threadIdx.x == 0) {
        unsigned* bar = b.bar;
        __builtin_amdgcn_s_waitcnt(0);
        unsigned nloc = b.st[0], nx = b.st[1];
        if (nloc == 0u) { xcd_barrier_complete(bar, b.x, nloc, nx); b.st[0] = nloc; b.st[1] = nx; }
        const unsigned old = xb_add(&bar[XB_XSUB(b.x)], 1u);
        const unsigned gen = old / nloc;
        if (old + 1u == (gen + 1u) * nloc) {
            __builtin_amdgcn_fence(__ATOMIC_RELEASE, "agent");
            asm volatile("s_waitcnt vmcnt(0)" ::: "memory");
            const unsigned og = xb_add(&bar[XB_TOP], 1u);
            const unsigned tg = og / nx;
            if (og + 1u == (tg + 1u) * nx) xb_add(&bar[XB_TOPGEN], 1u);
            else XB_SPIN(xb_ld(&bar[XB_TOPGEN]) == tg, bar);
            __builtin_amdgcn_fence(__ATOMIC_ACQUIRE, "agent");
            xb_add(&bar[XB_XGEN(b.x)], 1u);
            asm volatile("s_waitcnt vmcnt(0)" ::: "memory");
        } else {
            XB_SPIN(xb_ld(&bar[XB_XGEN(b.x)]) == gen, bar);
            __builtin_amdgcn_fence(__ATOMIC_ACQUIRE, "agent");
            asm volatile("s_waitcnt vmcnt(0)" ::: "memory");
        }
    }
    __syncthreads();
}

__device__ __forceinline__ void tr_item(const float* W, int ldw, int ncols_valid, int src_col0, int k0, const float* gain, bf16_t* WT, int K, int n0, LAS float* scr, int lane) {
#pragma unroll 8
    for (int i = 0; i < 32; ++i) { const int kk = 2 * i + (lane >> 5), c = src_col0 + (lane & 31);
        float v = (c < ncols_valid) ? W[(size_t)(k0 + kk) * ldw + c] : 0.f; if (gain) v *= gain[k0 + kk]; scr[kk * 33 + (lane & 31)] = v; }
    asm volatile("s_waitcnt lgkmcnt(0)" ::: "memory");
    const int c = lane & 7;
#pragma unroll
    for (int j = 0; j < 4; ++j) { const int n = (lane >> 3) + 8 * j; const LAS float* s = scr + (8 * c) * 33 + n;
        u32x4 o; o.x = pk2(s[0 * 33], s[1 * 33]); o.y = pk2(s[2 * 33], s[3 * 33]); o.z = pk2(s[4 * 33], s[5 * 33]); o.w = pk2(s[6 * 33], s[7 * 33]);
        *(u32x4*)(WT + (size_t)(n0 + n) * K + k0 + 8 * c) = o; }
    asm volatile("s_waitcnt lgkmcnt(0)" ::: "memory");
}

__device__ __forceinline__ void unpack8(const u32x4 w, float* d) { d[0] = bflo(w.x); d[1] = bfhi(w.x); d[2] = bflo(w.y); d[3] = bfhi(w.y); d[4] = bflo(w.z); d[5] = bfhi(w.z); d[6] = bflo(w.w); d[7] = bfhi(w.w); }

__device__ __forceinline__ void fox_cumsum_item(int bh, const float* LF, float* CC, int* JS, const float* gq, const float* gk, LAS float* sc) {
    int tid_ = threadIdx.x; asm volatile("" : "+v"(tid_)); const int tid = tid_, lane = tid & 63, wave = tid >> 6, b = bh / 6, h = bh % 6;
    float v[8]; float run = 0.f;
#pragma unroll
    for (int i = 0; i < 8; ++i) { run += LF[((size_t)b * SEQ + tid * 8 + i) * 8 + h]; v[i] = run; }
    float s = run;
#pragma unroll
    for (int o = 1; o < 64; o <<= 1) { const float n = __shfl_up(s, o); if (lane >= o) s += n; }
    __syncthreads();
    if (lane == 63) sc[wave] = s;
    __syncthreads();
    float base = s - run;
    for (int w = 0; w < wave; ++w) base += sc[w];
    LAS float* cl = sc + 64;
#pragma unroll
    for (int i = 0; i < 8; ++i) { const float c2 = (v[i] + base) * 1.4426950408889634f; CC[(size_t)bh * SEQ + tid * 8 + i] = c2; cl[tid * 8 + i] = c2; }
    __syncthreads();
    if (tid < 16) {
        float mq = 0.f, mk = 0.f;
        for (int d = 0; d < 64; ++d) { mq = fmaxf(mq, fabsf(gq[d])); mk = fmaxf(mk, fabsf(gk[d])); }
        const float zb = 1.4426950408889634f * 8.0f * mq * mk * 1.03f + 1.0f;
        const float thr = -(150.0f + 2.0f * zb);
        const int q0 = tid * 256, nt = q0 / 64 + 4; const float cq = cl[q0];
        int j = 0; while (j < nt - 4 && cq - cl[64 * j + 63] < thr) ++j;
        JS[bh * 16 + tid] = j & ~1;
    }
    __syncthreads();
}

__device__ __forceinline__ void stage_kv(const bf16_t* Kb, const bf16_t* Vb, int kt, LAS float* Kf, LAS float* Vf) {
    int tid_ = threadIdx.x; asm volatile("" : "+v"(tid_)); const int tid = tid_, key = tid >> 3, c8 = tid & 7;
    const u32x4 kw = *(const u32x4*)(Kb + ((size_t)(kt * 64 + key)) * 64 + c8 * 8), vw = *(const u32x4*)(Vb + ((size_t)(kt * 64 + key)) * 64 + c8 * 8);
    float kf[8], vf[8]; unpack8(kw, kf); unpack8(vw, vf);
    *(LAS f32x4*)(Kf + key * 64 + c8 * 8) = (f32x4){kf[0], kf[1], kf[2], kf[3]}; *(LAS f32x4*)(Kf + key * 64 + c8 * 8 + 4) = (f32x4){kf[4], kf[5], kf[6], kf[7]};
    *(LAS f32x4*)(Vf + key * 64 + c8 * 8) = (f32x4){vf[0], vf[1], vf[2], vf[3]}; *(LAS f32x4*)(Vf + key * 64 + c8 * 8 + 4) = (f32x4){vf[4], vf[5], vf[6], vf[7]};
}

__device__ __forceinline__ void fox_naive_item(int item, unsigned char* P, bf16_t* MIX, LAS float* lds) {
    int tid_ = threadIdx.x; asm volatile("" : "+v"(tid_)); const int tid = tid_, bh = item >> 3, qblk = item & 7, b = bh / 6, h = bh % 6, t = qblk * 512 + tid;
    const bf16_t* Qp = (const bf16_t*)(P + P_FQ) + ((size_t)bh * SEQ + t) * 64;
    const bf16_t* Kb = (const bf16_t*)(P + P_FQ + HEADBUF) + (size_t)bh * SEQ * 64;
    const bf16_t* Vb = (const bf16_t*)(P + P_FQ + 2 * HEADBUF) + (size_t)bh * SEQ * 64;
    const float* CC = (const float*)(P + P_CC) + (size_t)bh * SEQ;
    float q[64], o[64];
#pragma unroll
    for (int c = 0; c < 8; ++c) unpack8(*(const u32x4*)(Qp + c * 8), q + c * 8);
#pragma unroll
    for (int d = 0; d < 64; ++d) o[d] = 0.f;
    float m = -1e30f, l = 0.f; const float ct = CC[t];
    LAS float* Kf = lds; LAS float* Vf = lds + 4096; LAS float* cs = lds + 8192;
    const int ntile = (qblk + 1) * 8;
    for (int kt = 0; kt < ntile; ++kt) {
        __syncthreads();
        stage_kv(Kb, Vb, kt, Kf, Vf); if (tid < 64) cs[tid] = CC[kt * 64 + tid];
        __syncthreads();
        for (int s = 0; s < 64; ++s) {
            float z = 0.f;
#pragma unroll
            for (int d = 0; d < 64; ++d) z += q[d] * Kf[s * 64 + d];
            const float x = (kt * 64 + s <= t) ? z + (ct - cs[s]) : -1e30f;
            const float mn = fmaxf(m, x), sc = __expf(m - mn), p = __expf(x - mn);
            l = l * sc + p;
#pragma unroll
            for (int d = 0; d < 64; ++d) o[d] = o[d] * sc + p * Vf[s * 64 + d];
            m = mn;
        }
    }
    const float inv = 1.0f / l;
    bf16_t* op = MIX + ((size_t)b * SEQ + t) * DM + 640 + h * 64;
#pragma unroll
    for (int c = 0; c < 8; ++c) { u32x4 w; w.x = pk2(o[c * 8] * inv, o[c * 8 + 1] * inv); w.y = pk2(o[c * 8 + 2] * inv, o[c * 8 + 3] * inv); w.z = pk2(o[c * 8 + 4] * inv, o[c * 8 + 5] * inv); w.w = pk2(o[c * 8 + 6] * inv, o[c * 8 + 7] * inv); *(u32x4*)(op + c * 8) = w; }
}

__device__ __forceinline__ void sb_naive_item(int item, unsigned char* P, bf16_t* MIX, LAS float* lds) {
    int tid_ = threadIdx.x; asm volatile("" : "+v"(tid_)); const int tid = tid_, bh = item >> 3, qblk = item & 7, b = bh / 6, h = bh % 6, t = qblk * 512 + tid;
    const bf16_t* Qp = (const bf16_t*)(P + P_SQ) + ((size_t)bh * SEQ + t) * 64;
    const bf16_t* Kb = (const bf16_t*)(P + P_SQ + HEADBUF) + (size_t)bh * SEQ * 64;
    const bf16_t* Vb = (const bf16_t*)(P + P_SQ + 2 * HEADBUF) + (size_t)bh * SEQ * 64;
    float q[64], o[64];
#pragma unroll
    for (int c = 0; c < 8; ++c) unpack8(*(const u32x4*)(Qp + c * 8), q + c * 8);
#pragma unroll
    for (int d = 0; d < 64; ++d) o[d] = 0.f;
    float tail = 0.f;
    LAS float* Kf = lds; LAS float* Vf = lds + 4096;
    for (int kt = qblk * 8 + 7; kt >= 0; --kt) {
        __syncthreads();
        stage_kv(Kb, Vb, kt, Kf, Vf);
        __syncthreads();
        for (int s = 63; s >= 0; --s) {
            float z = 0.f;
#pragma unroll
            for (int d = 0; d < 64; ++d) z += q[d] * Kf[s * 64 + d];
            const float ls = fminf(z, 0.f) - __logf(1.0f + __expf(-fabsf(z)));
            const bool act = (kt * 64 + s) < t;
            const float A = act ? __expf(ls + tail) : 0.f;
#pragma unroll
            for (int d = 0; d < 64; ++d) o[d] += A * Vf[s * 64 + d];
            tail += act ? (ls - z) : 0.f;
        }
        if (__syncthreads_and(tail < -100.f)) break;
    }
    bf16_t* op = MIX + ((size_t)b * SEQ + t) * DM + 256 + h * 64;
#pragma unroll
    for (int c = 0; c < 8; ++c) { u32x4 w; w.x = pk2(o[c * 8], o[c * 8 + 1]); w.y = pk2(o[c * 8 + 2], o[c * 8 + 3]); w.z = pk2(o[c * 8 + 4], o[c * 8 + 5]); w.w = pk2(o[c * 8 + 6], o[c * 8 + 7]); *(u32x4*)(op + c * 8) = w; }
}

__device__ __forceinline__ void hgrn_naive_item(int item, unsigned char* P, bf16_t* MIX, const float* hgn, LAS float* lds) {
    int tid_ = threadIdx.x; asm volatile("" : "+v"(tid_)); const int tid = tid_, lane = tid & 63, w = tid >> 6, kg = lane >> 3, vi = lane & 7, vcol = 8 * w + vi, b = item >> 2, h = item & 3;
    const bf16_t* HQ = (const bf16_t*)(P + P_HQ); const bf16_t* HK = (const bf16_t*)(P + P_HK); const bf16_t* HI = (const bf16_t*)(P + P_HI); const bf16_t* HG = (const bf16_t*)(P + P_HG);
    const float* HLF = (const float*)(P + P_HLF);
    LAS float* qf = lds; LAS float* kf = lds + 4096; LAS float* ff = lds + 8192; LAS float* vf = lds + 12288; LAS float* ob = lds + 16384;
    float S[8];
#pragma unroll
    for (int j = 0; j < 8; ++j) S[j] = 0.f;
    const int tok = tid >> 3, c8 = tid & 7;
    float gn[8];
#pragma unroll
    for (int e = 0; e < 8; ++e) gn[e] = hgn[c8 * 8 + e];
    for (int c = 0; c < 64; ++c) {
        const size_t off = ((size_t)b * SEQ + c * 64 + tok) * 256 + h * 64 + c8 * 8;
        __syncthreads();
        {
            float a[8];
            unpack8(*(const u32x4*)(HQ + off), a);
#pragma unroll
            for (int e = 0; e < 8; ++e) qf[tok * 64 + c8 * 8 + e] = a[e];
            unpack8(*(const u32x4*)(HK + off), a);
#pragma unroll
            for (int e = 0; e < 8; ++e) kf[tok * 64 + c8 * 8 + e] = a[e];
            unpack8(*(const u32x4*)(HI + off), a);
#pragma unroll
            for (int e = 0; e < 8; ++e) vf[tok * 64 + c8 * 8 + e] = a[e];
            const f32x4 l0 = *(const f32x4*)(HLF + off), l1 = *(const f32x4*)(HLF + off + 4);
#pragma unroll
            for (int e = 0; e < 4; ++e) { ff[tok * 64 + c8 * 8 + e] = expf(l0[e]); ff[tok * 64 + c8 * 8 + 4 + e] = expf(l1[e]); }
        }
        __syncthreads();
        for (int tk = 0; tk < 64; ++tk) {
            const float vv = vf[tk * 64 + vcol]; float op = 0.f;
#pragma unroll
            for (int j = 0; j < 8; ++j) { const int k = 8 * kg + j; S[j] = ff[tk * 64 + k] * S[j] + kf[tk * 64 + k] * vv; op += qf[tk * 64 + k] * S[j]; }
            op += __shfl_xor(op, 8); op += __shfl_xor(op, 16); op += __shfl_xor(op, 32);
            if (kg == 0) ob[tk * 64 + vcol] = op;
        }
        __syncthreads();
        {
            float ov[8], g[8]; float sq = 0.f;
#pragma unroll
            for (int e = 0; e < 8; ++e) { ov[e] = ob[tok * 64 + c8 * 8 + e]; sq += ov[e] * ov[e]; }
            sq += __shfl_xor(sq, 1); sq += __shfl_xor(sq, 2); sq += __shfl_xor(sq, 4);
            const float rn = rsqrtf(sq * (1.0f / 64.0f) + EPS);
            unpack8(*(const u32x4*)(HG + off), g);
            float r[8];
#pragma unroll
            for (int e = 0; e < 8; ++e) r[e] = ov[e] * rn * gn[e] * (g[e] / (1.0f + expf(-g[e])));
            u32x4 wv; wv.x = pk2(r[0], r[1]); wv.y = pk2(r[2], r[3]); wv.z = pk2(r[4], r[5]); wv.w = pk2(r[6], r[7]);
            *(u32x4*)(MIX + ((size_t)b * SEQ + c * 64 + tok) * DM + h * 64 + c8 * 8) = wv;
        }
    }
}

constexpr int HG_SLOT = 32768, HG_PRE = 16384, HG_TOT = 16384 + 1280, HG_VT = 20480, HG_VP = 72;
typedef short hbf16x8 __attribute__((ext_vector_type(8)));
typedef short hbf16x4 __attribute__((ext_vector_type(4)));
__device__ __forceinline__ hbf16x8 pack8(const float* x) { u32x4 w; w.x = pk2(x[0], x[1]); w.y = pk2(x[2], x[3]); w.z = pk2(x[4], x[5]); w.w = pk2(x[6], x[7]); return __builtin_bit_cast(hbf16x8, w); }

__device__ __forceinline__ void hg_stage(int tid, size_t row0, int h, const float* HLF, const bf16_t* HI, LAS unsigned char* sb) {
    const int lt = tid & 255, k = lt & 63, seg = lt >> 6;
    LAS float* bl = (LAS float*)sb; LAS float* pre = (LAS float*)(sb + HG_PRE); LAS float* tot = (LAS float*)(sb + HG_TOT); LAS bf16_t* vt = (LAS bf16_t*)(sb + HG_VT);
    float run = 0.f;
#pragma unroll
    for (int i = 0; i < 16; ++i) { const int t = 16 * seg + i; run += HLF[(row0 + t) * 256 + h * 64 + k]; bl[t * 64 + k] = run; }
    tot[seg * 64 + k] = run;
    {
        const int s = lt >> 2, c0 = (lt & 3) * 16;
        const u32x4 w0 = *(const u32x4*)(HI + (row0 + s) * 256 + h * 64 + c0), w1 = *(const u32x4*)(HI + (row0 + s) * 256 + h * 64 + c0 + 8);
        const unsigned ww[8] = {w0.x, w0.y, w0.z, w0.w, w1.x, w1.y, w1.z, w1.w};
#pragma unroll
        for (int e = 0; e < 8; ++e) { vt[(c0 + 2 * e) * HG_VP + s] = (bf16_t)(ww[e] & 0xffffu); vt[(c0 + 2 * e + 1) * HG_VP + s] = (bf16_t)(ww[e] >> 16); }
    }
    __syncthreads();
    if (lt < 64) { float p = 0.f;
#pragma unroll
        for (int sg = 0; sg < 4; ++sg) { pre[sg * 64 + lt] = p; p += tot[sg * 64 + lt]; }
        pre[4 * 64 + lt] = p; }
    __syncthreads();
}

__device__ __forceinline__ void hgrn_a_item(int item, unsigned char* P, float* DD, LAS unsigned char* L) {
    int tid_ = threadIdx.x; asm volatile("" : "+v"(tid_)); const int tid = tid_, lane = tid & 63, wq = (tid >> 6) & 3, cs = tid >> 8, r = lane & 15, g = lane >> 4;
    const int bh = item >> 5, chunk = (item & 31) * 2 + cs, b = bh >> 2, h = bh & 3;
    const size_t row0 = (size_t)b * SEQ + chunk * 64;
    const bf16_t* HK = (const bf16_t*)(P + P_HK); float* UT = (float*)(P + P_US);
    LAS unsigned char* sb = L + cs * HG_SLOT;
    const int k = 16 * wq + r;
    unsigned short kraw[2][8];
#pragma unroll
    for (int ks = 0; ks < 2; ++ks)
#pragma unroll
        for (int j = 0; j < 8; ++j) kraw[ks][j] = HK[(row0 + 32 * ks + 8 * g + j) * 256 + h * 64 + k];
    hg_stage(tid, row0, h, (const float*)(P + P_HLF), (const bf16_t*)(P + P_HI), sb);
    const LAS float* bl = (const LAS float*)sb; const LAS float* pre = (const LAS float*)(sb + HG_PRE); const LAS unsigned char* vt = sb + HG_VT;
    const float pre4 = pre[4 * 64 + k];
    hbf16x8 af[2];
#pragma unroll
    for (int ks = 0; ks < 2; ++ks) { const float pj = pre4 - pre[(2 * ks + (g >> 1)) * 64 + k]; float x[8];
#pragma unroll
        for (int j = 0; j < 8; ++j) { const int s = 32 * ks + 8 * g + j; x[j] = bf2f(kraw[ks][j]) * __expf(pj - bl[s * 64 + k]); }
        af[ks] = pack8(x); }
    float* ut = UT + ((size_t)(bh * 64 + chunk) * 64) * 64;
#pragma unroll
    for (int vtile = 0; vtile < 4; ++vtile) { f32x4 acc = {0.f, 0.f, 0.f, 0.f};
#pragma unroll
        for (int ks = 0; ks < 2; ++ks) { const hbf16x8 bf = *(const LAS hbf16x8*)(vt + (16 * vtile + r) * (HG_VP * 2) + (32 * ks + 8 * g) * 2); acc = __builtin_amdgcn_mfma_f32_16x16x32_bf16(af[ks], bf, acc, 0, 0, 0); }
        *(f32x4*)(ut + (size_t)(16 * vtile + r) * 64 + 16 * wq + 4 * g) = acc; }
    if (g == 0) DD[(size_t)(bh * 64 + chunk) * 64 + k] = __expf(pre4);
}

__device__ __forceinline__ void hgrn_b_scan(int bx, int G, unsigned char* P, const float* DD) {
    int tid_ = threadIdx.x; asm volatile("" : "+v"(tid_));
    float* UT = (float*)(P + P_US);
    for (int gid = bx * 512 + tid_; gid < 32 * 4096; gid += G * 512) {
        const int bh = gid >> 12, e = gid & 4095; float* u = UT + (size_t)bh * 64 * 4096 + e; const float* dd = DD + (size_t)bh * 64 * 64 + (e & 63);
        float S = 0.f;
        for (int c0 = 0; c0 < 64; c0 += 8) { float tu[8], td[8];
#pragma unroll
            for (int i = 0; i < 8; ++i) { tu[i] = u[(size_t)(c0 + i) * 4096]; td[i] = dd[(c0 + i) * 64]; }
#pragma unroll
            for (int i = 0; i < 8; ++i) { u[(size_t)(c0 + i) * 4096] = S; S = td[i] * S + tu[i]; } }
    }
}

__device__ __forceinline__ void hgrn_c_item(int item, unsigned char* P, bf16_t* MIX, const float* hgn, LAS unsigned char* L) {
    int tid_ = threadIdx.x; asm volatile("" : "+v"(tid_)); const int tid = tid_, lane = tid & 63, I = (tid >> 6) & 3, cs = tid >> 8, r = lane & 15, g = lane >> 4;
    const int bh = item >> 5, chunk = (item & 31) * 2 + cs, b = bh >> 2, h = bh & 3;
    const size_t row0 = (size_t)b * SEQ + chunk * 64;
    const bf16_t* HQ = (const bf16_t*)(P + P_HQ); const bf16_t* HK = (const bf16_t*)(P + P_HK); const bf16_t* HG = (const bf16_t*)(P + P_HG); const float* ST = (const float*)(P + P_US);
    LAS unsigned char* sb = L + cs * HG_SLOT;
    const int t = 16 * I + r;
    u32x4 qraw[2], kraw[4][2]; f32x4 sraw[4][2][2]; unsigned short graw[4][4];
    const float* st = ST + ((size_t)(bh * 64 + chunk) * 64) * 64;
#pragma unroll
    for (int ks = 0; ks < 2; ++ks) { qraw[ks] = *(const u32x4*)(HQ + (row0 + t) * 256 + h * 64 + 32 * ks + 8 * g);
#pragma unroll
        for (int J = 0; J < 4; ++J) kraw[J][ks] = *(const u32x4*)(HK + (row0 + 16 * J + r) * 256 + h * 64 + 32 * ks + 8 * g);
#pragma unroll
        for (int vtile = 0; vtile < 4; ++vtile) { const float* sp = st + (size_t)(16 * vtile + r) * 64 + 32 * ks + 8 * g; sraw[vtile][ks][0] = *(const f32x4*)sp; sraw[vtile][ks][1] = *(const f32x4*)(sp + 4); } }
#pragma unroll
    for (int i = 0; i < 4; ++i)
#pragma unroll
        for (int vtile = 0; vtile < 4; ++vtile) graw[i][vtile] = HG[(row0 + 16 * I + 4 * g + i) * 256 + h * 64 + 16 * vtile + r];
    hg_stage(tid, row0, h, (const float*)(P + P_HLF), (const bf16_t*)(P + P_HI), sb);
    const LAS float* bl = (const LAS float*)sb; const LAS float* pre = (const LAS float*)(sb + HG_PRE); const LAS unsigned char* vt = sb + HG_VT;
    hbf16x8 qtf[2], qhf[2];
#pragma unroll
    for (int ks = 0; ks < 2; ++ks) { const int kb = 32 * ks + 8 * g; float q[8], xt[8], xh[8];
        unpack8(qraw[ks], q);
#pragma unroll
        for (int j = 0; j < 8; ++j) { xt[j] = q[j] * __expf(bl[t * 64 + kb + j]); xh[j] = xt[j] * __expf(pre[I * 64 + kb + j]); }
        qtf[ks] = pack8(xt); qhf[ks] = pack8(xh); }
    f32x4 at[4];
#pragma unroll
    for (int J = 0; J < 4; ++J) { at[J] = (f32x4){0.f, 0.f, 0.f, 0.f};
        if (J <= I) { const int s = 16 * J + r;
#pragma unroll
            for (int ks = 0; ks < 2; ++ks) { const int kb = 32 * ks + 8 * g; float kk[8], x[8];
                unpack8(kraw[J][ks], kk);
#pragma unroll
                for (int j = 0; j < 8; ++j) x[j] = kk[j] * __expf(fminf(pre[I * 64 + kb + j] - pre[J * 64 + kb + j] - bl[s * 64 + kb + j], 80.f));
                at[J] = __builtin_amdgcn_mfma_f32_16x16x32_bf16(pack8(x), qtf[ks], at[J], 0, 0, 0); }
            if (J == I) {
#pragma unroll
                for (int i = 0; i < 4; ++i) at[J][i] = (4 * g + i <= r) ? at[J][i] : 0.f; } } }
    hbf16x8 pf[2];
#pragma unroll
    for (int k2 = 0; k2 < 2; ++k2) { const float x[8] = {at[2 * k2][0], at[2 * k2][1], at[2 * k2][2], at[2 * k2][3], at[2 * k2 + 1][0], at[2 * k2 + 1][1], at[2 * k2 + 1][2], at[2 * k2 + 1][3]}; pf[k2] = pack8(x); }
    f32x4 o[4];
#pragma unroll
    for (int vtile = 0; vtile < 4; ++vtile) { f32x4 acc = {0.f, 0.f, 0.f, 0.f}; const int v = 16 * vtile + r;
#pragma unroll
        for (int ks = 0; ks < 2; ++ks) { const f32x4 s0 = sraw[vtile][ks][0], s1 = sraw[vtile][ks][1];
            const float x[8] = {s0[0], s0[1], s0[2], s0[3], s1[0], s1[1], s1[2], s1[3]};
            acc = __builtin_amdgcn_mfma_f32_16x16x32_bf16(qhf[ks], pack8(x), acc, 0, 0, 0); }
#pragma unroll
        for (int k2 = 0; k2 < 2; ++k2) { if (k2 == 0 || I >= 2) {
            const hbf16x4 v0 = *(const LAS hbf16x4*)(vt + v * (HG_VP * 2) + (32 * k2 + 4 * g) * 2), v1 = *(const LAS hbf16x4*)(vt + v * (HG_VP * 2) + (32 * k2 + 16 + 4 * g) * 2);
            const hbf16x8 vf = {v0[0], v0[1], v0[2], v0[3], v1[0], v1[1], v1[2], v1[3]};
            acc = __builtin_amdgcn_mfma_f32_16x16x32_bf16(pf[k2], vf, acc, 0, 0, 0); } }
        o[vtile] = acc; }
#pragma unroll
    for (int i = 0; i < 4; ++i) { float sq = 0.f;
#pragma unroll
        for (int vtile = 0; vtile < 4; ++vtile) sq += o[vtile][i] * o[vtile][i];
        sq += __shfl_xor(sq, 1); sq += __shfl_xor(sq, 2); sq += __shfl_xor(sq, 4); sq += __shfl_xor(sq, 8);
        const float rn = rsqrtf(sq * (1.0f / 64.0f) + EPS); const size_t row = row0 + 16 * I + 4 * g + i;
#pragma unroll
        for (int vtile = 0; vtile < 4; ++vtile) { const int v = 16 * vtile + r; const float gg = bf2f(graw[i][vtile]);
            MIX[row * DM + h * 64 + v] = (bf16_t)f2bf(o[vtile][i] * rn * hgn[v] * (gg / (1.0f + __expf(-gg)))); } }
}

struct Args { const float* in[14]; float* out; unsigned char* ws; int ph_lo, ph_hi; };
constexpr int NPHASE = 1 + 7 * DEPTH;

__global__ void __launch_bounds__(512, 2) fwd(Args a) {
    extern __shared__ __attribute__((aligned(16))) unsigned char lds[];
    cg::grid_group grid = cg::this_grid();
    LAS unsigned char* L = (LAS unsigned char*)lds;
    if (threadIdx.x < 32) ((LAS unsigned*)(L + LDS_BYTES - 128))[threadIdx.x] = 0u;
    __syncthreads();
    for (int ph = a.ph_lo; ph < a.ph_hi; ++ph) {
        int G = gridDim.x, bx = blockIdx.x; asm volatile("" : "+s"(G), "+s"(bx));
        typedef const __attribute__((address_space(4))) Args* KArgP;
        KArgP ap = (KArgP)__builtin_amdgcn_kernarg_segment_ptr(); asm volatile("" : "+s"(ap));
        unsigned char* ws = ap->ws;
        float* SS = (float*)(ws + WS_SS); float* LB = (float*)(ws + WS_LB);
        bf16_t* XB = (bf16_t*)(ws + WS_XB); bf16_t* MIX = (bf16_t*)(ws + WS_MIX); bf16_t* UB = (bf16_t*)(ws + WS_U);
        unsigned char* P = ws + WS_P;
#ifdef PROBE_T
        if (ph == NPHASE) {
            if (bx == 0) { const unsigned long long* ts_ = (const unsigned long long*)(ws + 65536); unsigned long long sa = 0, sb = 0;
                for (int p = 1; p < NPHASE; ++p) { const int kk_ = (p - 1) % 7; const unsigned long long d = ts_[p] - ts_[p - 1]; if (PROBE_A(kk_)) sa += d; if (PROBE_B(kk_)) sb += d; }
                const float fa = (float)sa * 1e-3f, fb = (float)sb * 1e-3f; float* o_ = ap->out;
                for (int i = threadIdx.x; i < (1 << 20); i += 512) o_[(1 << 20) + i] += fb;
                if (threadIdx.x == 0) o_[0] = fa; }
        } else
#endif
        if (ph == 0) {
            int tid = threadIdx.x; asm volatile("" : "+v"(tid)); const int lane = tid & 63, wave = __builtin_amdgcn_readfirstlane(tid >> 6);
            LAS float* scr = (LAS float*)(L + wave * 16384);
            const int gw = bx * 8 + wave, NGW = G * 8;
            constexpr int I_IN = 16 * 112, I_OUT = 16 * 32, I_1 = 16 * 128, I_2 = 64 * 32, I_L = I_IN + I_OUT + I_1 + I_2;
            for (int it = gw; it < DEPTH * I_L; it += NGW) {
                const int l = it / I_L; int r = it % I_L;
                unsigned char* wl = ws + WS_W + (size_t)l * W_LAYER;
                if (r < I_IN) { const int kb = r / 112, nb = r % 112, n0 = nb * 32, pn = n0 >> 8, p = n0 & 255, slot = 4 * pn + ((p & 127) >> 5), sc0 = 64 * slot + 32 * (p >> 7);
                    tr_item(ap->in[3] + (size_t)l * DM * INC, INC, INC, sc0, kb * 64, ap->in[2] + l * DM, (bf16_t*)wl, DM, n0, scr, lane); continue; }
                r -= I_IN;
                if (r < I_OUT) { const int kb = r / 32, nb = r % 32; tr_item(ap->in[10] + (size_t)l * DM * DM, DM, DM, nb * 32, kb * 64, nullptr, (bf16_t*)(wl + W_OUT), DM, nb * 32, scr, lane); continue; }
                r -= I_OUT;
                if (r < I_1) { const int kb = r / 128, nb = r % 128; tr_item(ap->in[12] + (size_t)l * DM * DFF, DFF, DFF, nb * 32, kb * 64, ap->in[11] + l * DM, (bf16_t*)(wl + W_1), DM, nb * 32, scr, lane); continue; }
                r -= I_1;
                { const int kb = r / 32, nb = r % 32; tr_item(ap->in[13] + (size_t)l * DFF * DM, DM, DM, nb * 32, kb * 64, nullptr, (bf16_t*)(wl + W_2), DFF, nb * 32, scr, lane); }
            }
            const float* x = ap->in[0];
            for (int m = gw; m < M; m += NGW) {
                const f32x4* xr = (const f32x4*)(x + (size_t)m * DM) + lane; f32x4 v[4]; float s = 0.f;
#pragma unroll
                for (int j = 0; j < 4; ++j) { v[j] = xr[64 * j]; s += (v[j][0] * v[j][0] + v[j][1] * v[j][1]) + (v[j][2] * v[j][2] + v[j][3] * v[j][3]); }
                const float tot = wave_sum(s);
                u32x2* o8 = (u32x2*)(XB + (size_t)m * DM) + lane;
#pragma unroll
                for (int j = 0; j < 4; ++j) { u32x2 w; w.x = pk2(v[j][0], v[j][1]); w.y = pk2(v[j][2], v[j][3]); o8[64 * j] = w; }
                if (lane < 16) SS[(size_t)m * 16 + lane] = (lane == 0) ? tot : 0.f;
            }
            if (bx == 2 && tid < 64) ((unsigned*)ws)[tid] = 0u;
            if (bx == 3) for (int i = tid; i < XCD_BAR_WORDS; i += 512) ((unsigned*)(ws + WS_BAR))[i] = 0u;
            if (bx == 1) {
                for (int i = tid; i < 1024; i += 512) { const int l = i >> 8, wh = (i >> 6) & 3, d = i & 63; LB[2048 + i] = ap->in[5 + wh][l * 64 + d]; }
                if (tid < 32) { const int l = tid >> 3, e = tid & 7; LB[3072 + tid] = (e < 6) ? ap->in[9][l * 6 + e] : 0.f; }
            }
            if (bx == 0 && tid < 256) {
                const float* lg = ap->in[1]; float e[DEPTH]; float mx = -1e30f, sum = 0.f;
#pragma unroll
                for (int l = 0; l < DEPTH; ++l) mx = fmaxf(mx, lg[l * 256 + tid]);
#pragma unroll
                for (int l = 0; l < DEPTH; ++l) { e[l] = expf(lg[l * 256 + tid] - mx); sum += e[l]; }
                float c = 0.f;
#pragma unroll
                for (int l = 0; l < DEPTH; ++l) { if (l > 0) c += e[l] / sum; LB[l * 512 + tid] = logf(fmaxf(c, 1e-30f)); LB[l * 512 + 256 + tid] = 1.0f - c; }
            }
        } else {
            const int l = (ph - 1) / 7, k = (ph - 1) % 7;
#ifdef REP_K
            const int nrep = (k == REP_K) ? 2 : 1;
#else
            const int nrep = 1;
#endif
            for (int rep = 0; rep < nrep; ++rep) {
            if (rep) { XcdBarrier xb_; xb_.bar = (unsigned*)(ws + WS_BAR); xb_.x = xb_xcc_id(); xb_.st = (volatile LAS unsigned*)(L + LDS_BYTES - 128); xcd_barrier(xb_); }
            unsigned char* wl = ws + WS_W + (size_t)l * W_LAYER;
            if (k == 0) {
                pg8::Gemm g{XB, (const bf16_t*)wl, M, NIN, DM}; pg8::StaticOrder S; S.init(M, NIN, G, bx);
                EpiInProj E{SS, P, LB + l * 512, LB + 2048 + l * 256, LB + 3072 + l * 8};
                pg8::gemm_phase<EpiInProj, pg8::StaticOrder, true, true>(L, g, S, E);
            } else if (k == 1) {
                int tid = threadIdx.x; asm volatile("" : "+v"(tid));
                unsigned* ctr = (unsigned*)ws + l * 16 + 1 + rep * 4;
                volatile LAS int* sh = (volatile LAS int*)(L + LDS_BYTES - 64);
                int nxt = 0; if (tid == 0) nxt = (int)atomicAdd(ctr, 1u);
                for (;;) {
                    if (tid == 0) sh[0] = nxt;
                    __syncthreads();
                    const int idx = __builtin_amdgcn_readfirstlane(sh[0]);
                    __syncthreads();
                    if (idx >= 816 + 1024) break;
                    if (tid == 0) nxt = (int)atomicAdd(ctr, 1u);
                    if (idx < 768) { const int qb = 15 - idx / 48, bh = idx % 48, b = bh / 6, h = bh % 6; typedef attn_body::bf16 abf;
                        attn_body::sb_unit(qb, (const abf*)(P + P_SQ) + (size_t)bh * SEQ * 64, (const abf*)(P + P_SQ + HEADBUF) + (size_t)bh * SEQ * 64, (const abf*)(P + P_SQ + 2 * HEADBUF) + (size_t)bh * SEQ * 64,
                                           (abf*)MIX + (size_t)b * SEQ * DM + 256 + h * 64, (char*)lds); }
                    else if (idx < 816) fox_cumsum_item(idx - 768, (const float*)(P + P_LF), (float*)(P + P_CC), (int*)(ws + WS_JS), LB + 2048 + l * 256 + 128, LB + 2048 + l * 256 + 192, (LAS float*)L);
                    else hgrn_a_item(idx - 816, P, (float*)(ws + WS_DD), L);
                    __syncthreads();
                }
            } else if (k == 2) {
                hgrn_b_scan(bx, G, P, (const float*)(ws + WS_DD));
            } else if (k == 3) {
                int tid = threadIdx.x; asm volatile("" : "+v"(tid));
                unsigned* ctr = (unsigned*)ws + l * 16 + rep * 4;
                volatile LAS int* sh = (volatile LAS int*)(L + LDS_BYTES - 64);
                int nxt = 0; if (tid == 0) nxt = (int)atomicAdd(ctr, 1u);
                for (;;) {
                    if (tid == 0) sh[0] = nxt;
                    __syncthreads();
                    const int idx = __builtin_amdgcn_readfirstlane(sh[0]);
                    __syncthreads();
                    if (idx >= 768 + 1024) break;
                    if (tid == 0) nxt = (int)atomicAdd(ctr, 1u);
                    if (idx >= 768) { hgrn_c_item(idx - 768, P, MIX, ap->in[4] + l * 64, L); __syncthreads(); continue; }
                    const int qb = 15 - idx / 48, bh = idx % 48, b = bh / 6, h = bh % 6;
                    typedef attn_body::bf16 abf;
                    const int jstart = ((const int*)(ws + WS_JS))[bh * 16 + qb];
                    attn_body::attn_unit<8>(qb, jstart, (const abf*)(P + P_FQ) + (size_t)bh * SEQ * 64, (const abf*)(P + P_FQ + HEADBUF) + (size_t)bh * SEQ * 64, (const abf*)(P + P_FQ + 2 * HEADBUF) + (size_t)bh * SEQ * 64,
                                            (abf*)MIX + (size_t)b * SEQ * DM + 640 + h * 64, (const float*)(P + P_CC) + (size_t)bh * SEQ, (char*)lds);
                }
            } else if (k == 5) {
                pg8::Gemm g{XB, (const bf16_t*)(wl + W_1), M, DFF, DM}; pg8::StaticOrder S; S.init(M, DFF, G, bx);
                EpiRelu2 E{UB, SS};
                pg8::gemm_phase<EpiRelu2, pg8::StaticOrder, true, true>(L, g, S, E);
            } else {
                const bool ff2 = (k == 6);
                pg8::Gemm g{ff2 ? UB : MIX, (const bf16_t*)(wl + (ff2 ? W_2 : W_OUT)), M, DM, ff2 ? DFF : DM}; pg8::StaticOrder S; S.init(M, DM, G, bx);
                EpiResid E{XB, (ff2 && l == DEPTH - 1) ? ap->out : nullptr, SS};
                pg8::gemm_phase<EpiResid, pg8::StaticOrder, true, true>(L, g, S, E);
            }
            }
        }
#ifdef PROBE_T
        if (bx == 0 && threadIdx.x == 0) ((unsigned long long*)(ws + 65536))[ph] = __builtin_amdgcn_s_memrealtime();
#endif
        if (ph + 1 < a.ph_hi) {
            if (ph == 0) {
                grid.sync();
                (void)xcd_barrier_post((unsigned*)(ws + WS_BAR), (volatile LAS unsigned*)(L + LDS_BYTES - 128));
            } else {
                XcdBarrier xb_; xb_.bar = (unsigned*)(ws + WS_BAR); xb_.x = xb_xcc_id(); xb_.st = (volatile LAS unsigned*)(L + LDS_BYTES - 128);
                xcd_barrier(xb_);
            }
        }
    }
}

#ifndef MK_MULTI
#define MK_MULTI 0
#endif
extern "C" void kernel_launch(void* const* d_in, const int* in_sizes, int n_in, void* d_out, int out_size, void* d_ws, size_t ws_size, hipStream_t stream) {
    static int grid = 0;
    if (grid == 0) {
        int dev = 0, cus = 0, per = 0;
        if (n_in != 14 || out_size != M * DM || ws_size < WS_END) { fprintf(stderr, "kernel_launch: unexpected shapes (n_in %d out %d ws %zu)\n", n_in, out_size, ws_size); grid = -1; return; }
        (void)hipGetDevice(&dev); (void)hipDeviceGetAttribute(&cus, hipDeviceAttributeMultiprocessorCount, dev);
        (void)hipFuncSetAttribute((const void*)fwd, hipFuncAttributeMaxDynamicSharedMemorySize, LDS_BYTES);
        (void)hipOccupancyMaxActiveBlocksPerMultiprocessor(&per, (const void*)fwd, 512, LDS_BYTES);
        if (per < 1) per = 1;
        grid = cus * per;
        fprintf(stderr, "kernel_launch: grid %d (cus %d x %d)\n", grid, cus, per);
    }
    if (grid < 0) return;
    Args a{};
    for (int i = 0; i < 14; ++i) a.in[i] = (const float*)d_in[i];
    a.out = (float*)d_out; a.ws = (unsigned char*)d_ws;
#if MK_MULTI
    for (int ph = 0; ph < NPHASE; ++ph) { a.ph_lo = ph; a.ph_hi = ph + 1; hipLaunchKernelGGL(fwd, dim3(grid), dim3(512), LDS_BYTES, stream, a); }
#else
#ifdef PROBE_T
    a.ph_lo = 0; a.ph_hi = NPHASE + 1;
#else
    a.ph_lo = 0; a.ph_hi = NPHASE;
#endif
    void* args[] = {&a};
    hipError_t e = hipLaunchCooperativeKernel((const void*)fwd, dim3(grid), dim3(512), args, LDS_BYTES, stream);
    if (e != hipSuccess) fprintf(stderr, "kernel_launch: cooperative launch failed: %s (grid %d)\n", hipGetErrorString(e), grid);
#endif
}
```

```cpp
#include <hip/hip_runtime.h>
#include <hip/hip_cooperative_groups.h>
#include <cstdio>
#include <cstdint>
namespace cg = cooperative_groups;
namespace pg8 {
#define PG8_LAS __attribute__((address_space(3)))
typedef unsigned short bf16_t;
typedef short bf16x8 __attribute__((ext_vector_type(8)));
typedef float f32x4 __attribute__((ext_vector_type(4)));
typedef unsigned u32x4 __attribute__((ext_vector_type(4)));
constexpr int BM = 256, BK = 64, HALF = 128, HTB = HALF * BK * 2  , STAGE_BYTES = 8 * HTB, NXCD = 8, WGM = 8;

__host__ __device__ __forceinline__ int lds_byte(int r, int c) { const int st = (r >> 4) * 2 + (c >> 5), rr = r & 15, cc = c & 31, ob = rr * 64 + cc * 2; return st * 1024 + (ob ^ (((ob >> 9) & 1) << 5)); }
__host__ __device__ __forceinline__ void stage_rc(int b, int& R, int& C) { const int st = b / 1024, sb = b % 1024, swz = sb ^ (((sb >> 9) & 1) << 5); R = (st >> 1) * 16 + swz / 64; C = (st & 1) * 32 + (swz % 64) / 2; }
__host__ __device__ __forceinline__ int perm32(int rho) { const int n = rho >> 4, i = rho & 15; return 8 * (i >> 2) + 4 * n + (i & 3); }

struct Unit { int pm, pn; };
struct Gemm { const bf16_t* A; const bf16_t* Bt; int M, N, K; };

struct StaticOrder {
    int nM, nN, nwg, G, c;
    __host__ __device__ void init(int M, int N, int G_, int c_) { nM = M / BM; nN = N / BM; nwg = nM * nN; G = G_; c = c_; }
    __host__ __device__ bool next(int i, Unit& u) const {
        const long L = (long)i * G + c; if (L >= nwg) return false;
        int wgid = (int)L; { const int q = nwg / NXCD, r = nwg % NXCD, xcd = wgid % NXCD, off = wgid / NXCD; wgid = (xcd < r ? xcd * (q + 1) : r * (q + 1) + (xcd - r) * q) + off; }
        const int nig = WGM * nN, gid = wgid / nig, fm = gid * WGM, gsz = (nM - fm) < WGM ? (nM - fm) : WGM;
        u.pm = fm + ((wgid % nig) % gsz); u.pn = (wgid % nig) / gsz; return true;
    }
    __device__ __forceinline__ void a_ready(const Unit&) const {}
    __device__ __forceinline__ void done(const Unit&) const {}
};

__device__ __forceinline__ unsigned cvt_pk_bf16(float lo, float hi) { unsigned r; asm volatile("v_cvt_pk_bf16_f32 %0, %1, %2" : "=v"(r) : "v"(lo), "v"(hi)); return r; }
typedef float f32x2 __attribute__((ext_vector_type(2)));
template <class Epi, class Sched, bool ALIGN_EPI = false, bool SP2 = false>
__device__ __forceinline__ void gemm_phase(PG8_LAS unsigned char* lds, const Gemm g, const Sched& S, const Epi& E) {
    int tid_ = threadIdx.x; asm volatile("" : "+v"(tid_));
    const int tid = tid_, wid = __builtin_amdgcn_readfirstlane(tid >> 6), lane = tid & 63, wr = wid >> 2, wc = wid & 3, fr = lane & 15, fq = lane >> 4;
    const int K = g.K, nt = K / BK;
    unsigned voffA[2], voffB[2];
#pragma unroll
    for (int i = 0; i < 2; ++i) { int R, C; stage_rc(tid * 16 + i * 8192, R, C); const int Rb = Epi::PERM ? ((R & ~31) + perm32(R & 31)) : R;
        voffA[i] = (unsigned)(R * K + C) * 2u; voffB[i] = (unsigned)(Rb * K + C) * 2u; }
    const size_t kstep = (size_t)(BK * 2);
    const size_t hstep = (size_t)HALF * K * 2;
    const size_t tstep = 2 * hstep;
    const unsigned ldsw = (unsigned)wid * 1024u;
    const int aoff = lds_byte(wr * 64 + fr, fq * 8), boff = lds_byte(wc * 32 + fr, fq * 8);
#define PG8_SA(b, h) (((b) * 2 + (h)) * HTB)
#define PG8_SB(b, h) ((4 + (b) * 2 + (h)) * HTB)
#define PG8_STAGE(bufoff, gbase, voff) do { _Pragma("unroll") for (int _i = 0; _i < 2; ++_i) \
        __builtin_amdgcn_global_load_lds((const unsigned*)((const char*)(gbase) + (voff)[_i]), (PG8_LAS unsigned*)(lds + (bufoff) + ldsw + _i * 8192), 16, 0, 0); } while (0)
#define PG8_LDA(dst, b, h) do { _Pragma("unroll") for (int m = 0; m < 4; ++m) _Pragma("unroll") for (int k = 0; k < 2; ++k) dst[m][k] = *(const PG8_LAS bf16x8*)(lds + PG8_SA(b, h) + aoff + m * 2048 + k * 1024); } while (0)
#define PG8_LDB(dst, b, h) do { _Pragma("unroll") for (int n = 0; n < 2; ++n) _Pragma("unroll") for (int k = 0; k < 2; ++k) dst[n][k] = *(const PG8_LAS bf16x8*)(lds + PG8_SB(b, h) + boff + n * 2048 + k * 1024); } while (0)
#define PG8_MMA(ai, bj, At, Bt) do { __builtin_amdgcn_s_setprio(1); _Pragma("unroll") for (int m = 0; m < 4; ++m) _Pragma("unroll") for (int n = 0; n < 2; ++n) _Pragma("unroll") for (int k = 0; k < 2; ++k) \
        acc[ai][bj][m][n] = __builtin_amdgcn_mfma_f32_16x16x32_bf16(Bt[n][k], At[m][k], acc[ai][bj][m][n], 0, 0, 0); __builtin_amdgcn_s_setprio(0); } while (0)
#define PG8_WAIT_V(n) asm volatile("s_waitcnt vmcnt(" #n ")" ::: "memory")
#define PG8_WAIT_L(n) asm volatile("s_waitcnt lgkmcnt(" #n ")" ::: "memory")
#define PG8_BAR __builtin_amdgcn_s_barrier()
#define PG8_SCHED __builtin_amdgcn_sched_barrier(0)
    Unit cur, nxt; int ui = 0;
    if (!S.next(0, cur)) return;
    f32x4 acc[2][2][4][2];
#pragma unroll
    for (int a = 0; a < 2; ++a)
#pragma unroll
        for (int b = 0; b < 2; ++b)
#pragma unroll
            for (int m = 0; m < 4; ++m)
#pragma unroll
                for (int n = 0; n < 2; ++n) acc[a][b][m][n] = (f32x4){0.f, 0.f, 0.f, 0.f};
    bf16x8 At[4][2], B0[2][2], B1[2][2];
    const char* cA = (const char*)g.A + (size_t)cur.pm * tstep; const char* cB = (const char*)g.Bt + (size_t)cur.pn * tstep;
    S.a_ready(cur);
    if constexpr (SP2) {
        PG8_STAGE(PG8_SB(0, 0), cB, voffB); PG8_STAGE(PG8_SB(0, 1), cB + hstep, voffB); PG8_STAGE(PG8_SA(0, 0), cA, voffA); PG8_STAGE(PG8_SA(0, 1), cA + hstep, voffA);
        if (wr == 1) PG8_BAR;
        PG8_WAIT_V(2); PG8_BAR;
        PG8_STAGE(PG8_SB(1, 0), cB + kstep, voffB); PG8_STAGE(PG8_SA(1, 0), cA + kstep, voffA); PG8_STAGE(PG8_SB(1, 1), cB + hstep + kstep, voffB);
        PG8_WAIT_V(6); PG8_BAR;
    } else {
        PG8_STAGE(PG8_SB(0, 0), cB, voffB); PG8_STAGE(PG8_SA(0, 0), cA, voffA); PG8_STAGE(PG8_SB(0, 1), cB + hstep, voffB); PG8_STAGE(PG8_SA(0, 1), cA + hstep, voffA);
        if (wr == 1) PG8_BAR;
        PG8_WAIT_V(4); PG8_BAR;
        PG8_STAGE(PG8_SB(1, 0), cB + kstep, voffB); PG8_STAGE(PG8_SA(1, 0), cA + kstep, voffA); PG8_STAGE(PG8_SB(1, 1), cB + hstep + kstep, voffB);
        PG8_WAIT_V(6); PG8_BAR;
    }
    for (;;) {
        const bool has_next = S.next(ui + 1, nxt);
        const char* nA = has_next ? (const char*)g.A + (size_t)nxt.pm * tstep : cA; const char* nB = has_next ? (const char*)g.Bt + (size_t)nxt.pn * tstep : cB;
        for (int t = 0; t < nt; t += 2) {
            const bool last = (t == nt - 2);
            const char* a1 = cA + (size_t)(t + 1) * kstep;
            const char* a2 = last ? nA : cA + (size_t)(t + 2) * kstep; const char* b2 = last ? nB : cB + (size_t)(t + 2) * kstep;
            const char* a3 = a2 + kstep; const char* b3 = b2 + kstep;
            if (last && has_next) S.a_ready(nxt);
            if constexpr (SP2) {
            PG8_LDB(B0, 0, 0); PG8_LDB(B1, 0, 1); PG8_SCHED; PG8_LDA(At, 0, 0); PG8_STAGE(PG8_SA(1, 1), a1 + hstep, voffA);
            PG8_WAIT_V(8); PG8_WAIT_L(0); PG8_BAR; PG8_MMA(0, 0, At, B0); PG8_MMA(0, 1, At, B1); PG8_BAR; PG8_SCHED;
            PG8_LDA(At, 0, 1); PG8_STAGE(PG8_SB(0, 0), b2, voffB); PG8_STAGE(PG8_SB(0, 1), b2 + hstep, voffB); PG8_STAGE(PG8_SA(0, 0), a2, voffA);
            PG8_WAIT_V(8); PG8_WAIT_L(0); PG8_BAR; PG8_MMA(1, 0, At, B0); PG8_MMA(1, 1, At, B1); PG8_BAR; PG8_SCHED;
            PG8_LDB(B0, 1, 0); PG8_LDB(B1, 1, 1); PG8_SCHED; PG8_LDA(At, 1, 0); PG8_STAGE(PG8_SA(0, 1), a2 + hstep, voffA);
            PG8_WAIT_V(8); PG8_WAIT_L(0); PG8_BAR; PG8_MMA(0, 0, At, B0); PG8_MMA(0, 1, At, B1); PG8_BAR; PG8_SCHED;
            PG8_LDA(At, 1, 1); PG8_STAGE(PG8_SB(1, 0), b3, voffB); PG8_STAGE(PG8_SB(1, 1), b3 + hstep, voffB); PG8_STAGE(PG8_SA(1, 0), a3, voffA);
            PG8_WAIT_V(8); PG8_WAIT_L(0); PG8_BAR; PG8_MMA(1, 0, At, B0); PG8_MMA(1, 1, At, B1); PG8_BAR; PG8_SCHED;
            } else {
            PG8_LDB(B0, 0, 0); PG8_SCHED; PG8_LDA(At, 0, 0); PG8_STAGE(PG8_SA(1, 1), a1 + hstep, voffA);
            PG8_WAIT_L(8); PG8_BAR; PG8_WAIT_L(0); PG8_MMA(0, 0, At, B0); PG8_BAR; PG8_SCHED;
            PG8_LDB(B1, 0, 1); PG8_STAGE(PG8_SB(0, 0), b2, voffB);
            PG8_BAR; PG8_WAIT_L(0); PG8_MMA(0, 1, At, B1); PG8_BAR;
            PG8_LDA(At, 0, 1); PG8_STAGE(PG8_SA(0, 0), a2, voffA);
            PG8_BAR; PG8_WAIT_L(0); PG8_MMA(1, 0, At, B0); PG8_BAR; PG8_SCHED;
            PG8_STAGE(PG8_SB(0, 1), b2 + hstep, voffB);
            PG8_WAIT_V(6); PG8_BAR; PG8_MMA(1, 1, At, B1); PG8_BAR;
            PG8_LDB(B0, 1, 0); PG8_SCHED; PG8_LDA(At, 1, 0); PG8_STAGE(PG8_SA(0, 1), a2 + hstep, voffA);
            PG8_WAIT_L(8); PG8_BAR; PG8_WAIT_L(0); PG8_MMA(0, 0, At, B0); PG8_BAR; PG8_SCHED;
            PG8_LDB(B1, 1, 1); PG8_STAGE(PG8_SB(1, 0), b3, voffB);
            PG8_BAR; PG8_WAIT_L(0); PG8_MMA(0, 1, At, B1); PG8_BAR;
            PG8_LDA(At, 1, 1); PG8_STAGE(PG8_SA(1, 0), a3, voffA);
            PG8_BAR; PG8_WAIT_L(0); PG8_MMA(1, 0, At, B0); PG8_BAR; PG8_SCHED;
            PG8_STAGE(PG8_SB(1, 1), b3 + hstep, voffB);
            PG8_WAIT_V(6); PG8_BAR; PG8_MMA(1, 1, At, B1); PG8_BAR;
            }
        }
        if constexpr (ALIGN_EPI) { if (wr == 0) PG8_BAR; }
        if constexpr (!Epi::AFTER_DRAIN) { E(acc, cur, wr, wc, fr, fq); S.done(cur); }
        if (!has_next) break;
#pragma unroll
        for (int a = 0; a < 2; ++a)
#pragma unroll
            for (int b = 0; b < 2; ++b)
#pragma unroll
                for (int m = 0; m < 4; ++m)
#pragma unroll
                    for (int n = 0; n < 2; ++n) acc[a][b][m][n] = (f32x4){0.f, 0.f, 0.f, 0.f};
        cur = nxt; cA = nA; cB = nB; ++ui;
        if constexpr (ALIGN_EPI) { if (wr == 1) PG8_BAR; }
    }
    PG8_WAIT_V(0);
    if constexpr (!ALIGN_EPI) { if (wr == 0) PG8_BAR; }
    PG8_BAR;
    if constexpr (Epi::AFTER_DRAIN) { E.fused(acc, cur, wr, wc, fr, fq, lds, wid, lane); S.done(cur); }
#undef PG8_SA
#undef PG8_SB
#undef PG8_STAGE
#undef PG8_LDA
#undef PG8_LDB
#undef PG8_MMA
#undef PG8_WAIT_V
#undef PG8_WAIT_L
#undef PG8_BAR
#undef PG8_SCHED
}
}
#include <hip/hip_bf16.h>
#include <cmath>
namespace attn_body {
using bf16=__hip_bfloat16;
using bf16x8=__attribute__((ext_vector_type(8)))short;
using s16x4=__attribute__((ext_vector_type(4)))short;
using f32x16=__attribute__((ext_vector_type(16)))float;
using u32x4=__attribute__((ext_vector_type(4)))unsigned;
using f32x4v=__attribute__((ext_vector_type(4)))float;
constexpr int SEQ=4096,D=64,DM=64,OPITCH=1024;
constexpr int LDS_C=98304;
constexpr int NW=8,QBLK=32,QB=QBLK*NW,KVBLK=64,NQB=SEQ/QB;
constexpr int ATTN_UNIT_ROWS=QB;
__device__ __forceinline__ int crow(int r,int hi){return (r&3)+8*(r>>2)+4*hi;}
#define SBAR() __builtin_amdgcn_sched_barrier(0)
__device__ __forceinline__ void cmask(f32x16&p0,f32x16&p1,int jb,int qrel,int hi){
  const float NEG=-INFINITY; int kb=64*jb+4*hi;
  #pragma unroll
  for(int r=0;r<16;++r){int kv=kb+(r&3)+8*(r>>2); if(kv>qrel)p0[r]=NEG; if(kv+32>qrel)p1[r]=NEG;}
}

constexpr int NSLOT=3, SLOTB=8192;
constexpr int LDS_K=0, LDS_V=NSLOT*SLOTB, LDS_WS=2*NSLOT*SLOTB, LDS_OST=LDS_WS+NW*64*4, LDS_BYTES=LDS_OST+NW*4096;
constexpr float C2=0.125f*1.4426950408889634f;
__device__ __forceinline__ void glds16(const void*gsrc,unsigned lds_dst){unsigned keep;
  asm volatile("s_mov_b32 %0, m0\n\ts_mov_b32 m0, %2\n\ts_nop 0\n\tglobal_load_lds_dwordx4 %1, off\n\ts_mov_b32 m0, %0":"=&s"(keep):"v"(gsrc),"s"(lds_dst):"memory");}
__device__ __forceinline__ float max3f(float a,float b,float c){float r;asm("v_max3_f32 %0, %1, %2, %3":"=v"(r):"v"(a),"v"(b),"v"(c));return r;}
__device__ __forceinline__ float max2f(float a,float b){float r;asm("v_max_f32_e32 %0, %1, %2":"=v"(r):"v"(a),"v"(b));return r;}
__device__ __forceinline__ float fadd_s(float a,float b){float r;asm("v_add_f32_e32 %0, %1, %2":"=v"(r):"v"(a),"v"(b));return r;}
__device__ __forceinline__ float fsub_s(float a,float b){float r;asm("v_sub_f32_e32 %0, %1, %2":"=v"(r):"v"(a),"v"(b));return r;}
typedef float f32x2_t __attribute__((ext_vector_type(2))); typedef __bf16 bf16x2_t __attribute__((ext_vector_type(2)));
__device__ __forceinline__ unsigned cvtpk_s(float lo,float hi){f32x2_t v={lo,hi};bf16x2_t b=__builtin_convertvector(v,bf16x2_t);return __builtin_bit_cast(unsigned,b);}
#define WAIT_BAR(N) asm volatile("s_waitcnt vmcnt(" #N ") lgkmcnt(0)\n\ts_barrier":::"memory")

__device__ __forceinline__ void qkt(f32x16&p0,f32x16&p1,const char*Kslot,const bf16x8*qr,const f32x16&negm,int r32,int hi){
  const char*kb=Kslot+hi*1024+r32*16;
  #pragma unroll
  for(int d0=0;d0<4;++d0){
    const bf16x8 b0=*reinterpret_cast<const bf16x8*>(kb+d0*2048);
    const bf16x8 b1=*reinterpret_cast<const bf16x8*>(kb+d0*2048+512);
    if(d0==0){p0=__builtin_amdgcn_mfma_f32_32x32x16_bf16(b0,qr[0],negm,0,0,0);p1=__builtin_amdgcn_mfma_f32_32x32x16_bf16(b1,qr[0],negm,0,0,0);}
    else{p0=__builtin_amdgcn_mfma_f32_32x32x16_bf16(b0,qr[d0],p0,0,0,0);p1=__builtin_amdgcn_mfma_f32_32x32x16_bf16(b1,qr[d0],p1,0,0,0);}}
}
typedef __attribute__((address_space(3))) const char* lds_cptr;
typedef short v4i16_t __attribute__((ext_vector_type(4)));
__device__ __forceinline__ void kload8(bf16x8*kf,lds_cptr kp){
  kf[0]=*(const __attribute__((address_space(3))) bf16x8*)(kp);      kf[1]=*(const __attribute__((address_space(3))) bf16x8*)(kp+512);
  kf[2]=*(const __attribute__((address_space(3))) bf16x8*)(kp+2048); kf[3]=*(const __attribute__((address_space(3))) bf16x8*)(kp+2560);
  kf[4]=*(const __attribute__((address_space(3))) bf16x8*)(kp+4096); kf[5]=*(const __attribute__((address_space(3))) bf16x8*)(kp+4608);
  kf[6]=*(const __attribute__((address_space(3))) bf16x8*)(kp+6144); kf[7]=*(const __attribute__((address_space(3))) bf16x8*)(kp+6656);
}
__device__ __forceinline__ void kload2(bf16x8*kf,lds_cptr kp,int j){ kf[2*j]=*(const __attribute__((address_space(3))) bf16x8*)(kp+j*2048); kf[2*j+1]=*(const __attribute__((address_space(3))) bf16x8*)(kp+j*2048+512); }
__device__ __forceinline__ s16x4 vtr(lds_cptr p){ return __builtin_bit_cast(s16x4,__builtin_amdgcn_ds_read_tr16_b64_v4i16((__attribute__((address_space(3))) v4i16_t*)p)); }
__device__ __forceinline__ float rowmax(const f32x16&p0,const f32x16&p1){
  float a=max3f(p0[0],p0[1],p1[0]),b=max3f(p0[2],p0[3],p1[1]);a=max3f(a,p1[2],p1[3]);
  #pragma unroll
  for(int r=4;r<16;r+=4){a=max3f(a,p0[r],p0[r+1]);b=max3f(b,p0[r+2],p0[r+3]);a=max3f(a,p1[r],p1[r+1]);b=max3f(b,p1[r+2],p1[r+3]);}
  const float m=max2f(a,b);
  auto rr=__builtin_amdgcn_permlane32_swap(__float_as_uint(m),__float_as_uint(m),false,false);
  return max2f(__uint_as_float(rr[0]),__uint_as_float(rr[1]));
}
__device__ __forceinline__ void pv(f32x16*o,int vb,bf16x8 pa0,bf16x8 pa1,bf16x8 pa2,bf16x8 pa3){
  #pragma unroll
  for(int d0=0;d0<2;++d0){s16x4 lo[4],hi[4];
    #pragma unroll
    for(int ks=0;ks<4;++ks){
      asm volatile("ds_read_b64_tr_b16 %0,%1 offset:%c2":"=&v"(lo[ks]):"v"(vb),"i"(d0*4096+ks*1024):"memory");
      asm volatile("ds_read_b64_tr_b16 %0,%1 offset:%c2":"=&v"(hi[ks]):"v"(vb),"i"(d0*4096+ks*1024+512):"memory");}
    asm volatile("s_waitcnt lgkmcnt(0)":::"memory");SBAR();
    #define PK(k) (bf16x8){lo[k][0],lo[k][1],lo[k][2],lo[k][3],hi[k][0],hi[k][1],hi[k][2],hi[k][3]}
    o[d0]=__builtin_amdgcn_mfma_f32_32x32x16_bf16(pa0,PK(0),o[d0],0,0,0);
    o[d0]=__builtin_amdgcn_mfma_f32_32x32x16_bf16(pa1,PK(1),o[d0],0,0,0);
    o[d0]=__builtin_amdgcn_mfma_f32_32x32x16_bf16(pa2,PK(2),o[d0],0,0,0);
    o[d0]=__builtin_amdgcn_mfma_f32_32x32x16_bf16(pa3,PK(3),o[d0],0,0,0);
    #undef PK
  }
}

#ifndef ATTN_STORE16
#define ATTN_STORE16(p,v) (*(u32x4*)(p)=(v))
#endif
template<int THRL> __device__ __forceinline__ void attn_unit(int qb,int jstart,const bf16*Q,const bf16*__restrict__ K,const bf16*__restrict__ V,bf16*O,const float*__restrict__ Cg,char*shm){
  int tid_=threadIdx.x; asm volatile("":"+v"(tid_)); const int tid=tid_,lane=tid&63,r32=lane&31,hi=lane>>5; const int wid=__builtin_amdgcn_readfirstlane(tid>>6);
  const int q0=qb*QB;
  const bf16*Qw=Q+(long)(q0+wid*QBLK)*DM;
  const bf16*Kh=K+(long)jstart*KVBLK*DM,*Vh=V+(long)jstart*KVBLK*DM;
  const lds_cptr shm3=(lds_cptr)shm;
  const unsigned lds0=(unsigned)(uintptr_t)shm;
  float*wsf=(float*)(shm+LDS_WS)+wid*64;
  const bf16*ksrc=Kh+(long)lane*DM+wid*8;
  const bf16*vsrc=Vh+(long)(16*(wid&3)+(lane>>2))*DM+(wid>>2)*32+(lane&3)*8;
  const unsigned kdst=lds0+LDS_K+wid*1024, vdst=lds0+LDS_V+wid*1024;
  #define DMA_K(t,slot) glds16(ksrc+(long)(t)*KVBLK*DM,(unsigned)__builtin_amdgcn_readfirstlane(kdst+(slot)))
  #define DMA_V(t,slot) glds16(vsrc+(long)(t)*KVBLK*DM,(unsigned)__builtin_amdgcn_readfirstlane(vdst+(slot)))
  const int vb0=(int)(lds0+LDS_V)+((lane>>4)&1)*32+(lane&3)*8+(4*hi+((lane&15)>>2))*64;
  const char*Kbase=shm+LDS_K; bf16x8 kf[8];
  const lds_cptr kp0=shm3+LDS_K+hi*1024+r32*16; const lds_cptr vp0=shm3+LDS_V+((lane>>4)&1)*32+(lane&3)*8+(4*hi+((lane&15)>>2))*64;
  const int NT=(q0+QB)/KVBLK-jstart;
  { typedef __attribute__((address_space(3))) f32x4v lf32x4; lf32x4*cl_=(lf32x4*)(shm3+LDS_C); const f32x4v*cg_=(const f32x4v*)(Cg+jstart*KVBLK); const int n4_=(q0+QB-jstart*KVBLK)>>2;
    f32x4v c0_=f32x4v{},c1_=f32x4v{}; if(tid<n4_)c0_=cg_[tid]; if(tid+NW*64<n4_)c1_=cg_[tid+NW*64]; if(tid<n4_)cl_[tid]=c0_; if(tid+NW*64<n4_)cl_[tid+NW*64]=c1_; }
  DMA_K(0,0);DMA_V(0,0);DMA_K(1,SLOTB);
  bf16x8 qr[4];
  #pragma unroll
  for(int d0=0;d0<4;++d0)qr[d0]=*reinterpret_cast<const bf16x8*>(&Qw[(long)r32*DM+d0*16+hi*8]);
  float mhat=0.f,l_reg=0.f;f32x16 o[2];o[0]=f32x16{};o[1]=f32x16{};
  const int qrel=wid*QBLK+r32;
  #define CMASK(P0,P1,t) do{int jb_=(t)-(NT-4); if(jb_>=0)cmask(P0,P1,jb_,qrel,hi);}while(0)
  typedef __attribute__((address_space(3))) const float* lds_fptr; typedef __attribute__((address_space(3))) const f32x4v* lds_f4ptr;
  const lds_fptr cl0=(lds_fptr)(shm3+LDS_C)+4*hi;
  #define BIAS(P0,P1,t) do{ const lds_fptr cb_=cl0+64*(t); _Pragma("unroll") for(int g_=0;g_<4;++g_){ const f32x4v a_=*(lds_f4ptr)(cb_+8*g_), b_=*(lds_f4ptr)(cb_+32+8*g_); \
      _Pragma("unroll") for(int i_=0;i_<4;++i_){P0[4*g_+i_]-=a_[i_];P1[4*g_+i_]-=b_[i_];} } }while(0)
  #define BIASINIT(C0_,C1_,t) do{ const lds_fptr cb_=cl0+64*(t); const float nm_=-mhat; _Pragma("unroll") for(int g_=0;g_<4;++g_){ const f32x4v a_=*(lds_f4ptr)(cb_+8*g_), b_=*(lds_f4ptr)(cb_+32+8*g_); \
      _Pragma("unroll") for(int i_=0;i_<4;++i_){C0_[4*g_+i_]=nm_-a_[i_];C1_[4*g_+i_]=nm_-b_[i_];} } }while(0)
  bool resc=false;
  #define START(P0,P1) do{ const float rm=rowmax(P0,P1); resc=false; \
    { const float dl=rm; mhat=fadd_s(mhat,dl); \
      _Pragma("unroll") for(int r=0;r<16;++r){P0[r]=fsub_s(P0[r],dl);P1[r]=fsub_s(P1[r],dl);} \
      } \
    _Pragma("unroll") for(int r=0;r<16;++r)P0[r]=__builtin_amdgcn_exp2f(P0[r]); }while(0)
  #define RESC() do{ if(resc){ asm volatile("s_waitcnt lgkmcnt(0)":::"memory"); \
      _Pragma("unroll") for(int d_=0;d_<2;++d_) _Pragma("unroll") for(int r=0;r<16;++r)o[d_][r]*=wsf[crow(r,hi)]; } }while(0)
  f32x16 pA0,pA1,pB0,pB1;
  int sl_prev=0,sl_cur=0,sl_next=SLOTB;
  #define ROT() do{sl_prev=sl_cur;sl_cur=sl_next;sl_next=(sl_next==(NSLOT-1)*SLOTB)?0:sl_next+SLOTB;}while(0)
  DMA_K(2,2*SLOTB);
  WAIT_BAR(3);
  { const f32x16 zero_=f32x16{}; qkt(pA0,pA1,Kbase,qr,zero_,r32,hi); }asm volatile("s_nop 15\n\ts_nop 7":"+v"(pA0),"+v"(pA1));BIAS(pA0,pA1,0);CMASK(pA0,pA1,0);
  START(pA0,pA1);
  _Pragma("unroll") for(int r=0;r<16;++r)pA1[r]=__builtin_amdgcn_exp2f(pA1[r]);
  WAIT_BAR(0);
  DMA_K(3,0);DMA_V(1,SLOTB);
  ROT();
  kload8(kf,kp0+sl_cur);
  WAIT_BAR(2);
  s16x4 vlo[8],vhi[8]; u32x4 pw0,pw1,pw2,pw3;
  #define PKW(P,B) cvtpk_s(P[B],P[B+1])
  #define PAF(k) __builtin_bit_cast(bf16x8,pw##k)
  #define VFR(i) (bf16x8){vlo[i][0],vlo[i][1],vlo[i][2],vlo[i][3],vhi[i][0],vhi[i][1],vhi[i][2],vhi[i][3]}
  #define PIN(x) asm volatile("":"+v"(x))
  #define MX3(a,b,c) __builtin_fmaxf(__builtin_fmaxf((a),(b)),(c))
  #define GAPA(MF,A0,A1,A2,A3,W0,W1,PW) do{ MF; sacc+=A0; sacc+=A1; sacc+=A2; sacc+=A3; PIN(sacc); W0; W1; PIN(PW); SBAR(); }while(0)
  #define EX(v) __builtin_amdgcn_exp2f(v)
  #define GAPB(MF,X,B) do{ MF; X[B]=EX(X[B]); X[B+1]=EX(X[B+1]); X[B+2]=EX(X[B+2]); X[B+3]=EX(X[B+3]); PIN(X); SBAR(); }while(0)
  #define VRD(i) do{ vlo[i]=vtr(vp_+(((i)>>2)*4096+((i)&3)*1024)); vhi[i]=vtr(vp_+(((i)>>2)*4096+((i)&3)*1024+512)); }while(0)
  #define KRD(G,j) do{ if(G){ kload2(kf,kp0+sl_next,j); SBAR(); } }while(0)
  #define STEP(C0,C1,P0,P1,t,GK,GV,GL) do{ SBAR(); BIASINIT(C0,C1,t); SBAR(); \
    const lds_cptr vp_=vp0+sl_prev; \
    VRD(0); SBAR(); float sacc=(P0[0]+P0[1]); \
    GAPA(C0=__builtin_amdgcn_mfma_f32_32x32x16_bf16(kf[0],qr[0],C0,0,0,0), P0[2],P0[3],P0[4],P0[5],     pw0[0]=PKW(P0,0), pw0[1]=PKW(P0,2), pw0); \
    VRD(4); SBAR(); GAPA(C1=__builtin_amdgcn_mfma_f32_32x32x16_bf16(kf[1],qr[0],C1,0,0,0), P0[6],P0[7],P0[8],P0[9],     pw0[2]=PKW(P0,4), pw0[3]=PKW(P0,6), pw0); \
    VRD(1); SBAR(); GAPA(C0=__builtin_amdgcn_mfma_f32_32x32x16_bf16(kf[2],qr[1],C0,0,0,0),   P0[10],P0[11],P0[12],P0[13], pw1[0]=PKW(P0,8), pw1[1]=PKW(P0,10), pw1); \
    VRD(5); SBAR(); GAPA(C1=__builtin_amdgcn_mfma_f32_32x32x16_bf16(kf[3],qr[1],C1,0,0,0),   P0[14],P0[15],P1[0],P1[1],   pw1[2]=PKW(P0,12),pw1[3]=PKW(P0,14), pw1); \
    VRD(2); SBAR(); GAPA(C0=__builtin_amdgcn_mfma_f32_32x32x16_bf16(kf[4],qr[2],C0,0,0,0),   P1[2],P1[3],P1[4],P1[5],     pw2[0]=PKW(P1,0), pw2[1]=PKW(P1,2), pw2); \
    VRD(6); SBAR(); GAPA(C1=__builtin_amdgcn_mfma_f32_32x32x16_bf16(kf[5],qr[2],C1,0,0,0),   P1[6],P1[7],P1[8],P1[9],     pw2[2]=PKW(P1,4), pw2[3]=PKW(P1,6), pw2); \
    VRD(3); SBAR(); GAPA(C0=__builtin_amdgcn_mfma_f32_32x32x16_bf16(kf[6],qr[3],C0,0,0,0),   P1[10],P1[11],P1[12],P1[13], pw3[0]=PKW(P1,8), pw3[1]=PKW(P1,10), pw3); \
    VRD(7); SBAR(); GAPA(C1=__builtin_amdgcn_mfma_f32_32x32x16_bf16(kf[7],qr[3],C1,0,0,0),   P1[14],P1[15],0.f,0.f,       pw3[2]=PKW(P1,12),pw3[3]=PKW(P1,14), pw3); \
    l_reg+=sacc; \
    if(GK){DMA_K((t)+3,sl_cur);} if(GV){DMA_V((t)+1,sl_next);} \
    CMASK(C0,C1,t); \
    { float a=MX3(C0[0],C0[1],C1[0]),b=MX3(C0[2],C0[3],C1[1]); a=MX3(a,C1[2],C1[3]); \
      _Pragma("unroll") for(int r=4;r<16;r+=4){a=MX3(a,C0[r],C0[r+1]);b=MX3(b,C0[r+2],C0[r+3]);a=MX3(a,C1[r],C1[r+1]);b=MX3(b,C1[r+2],C1[r+3]);} \
      float rm=__builtin_fmaxf(a,b); { auto rr=__builtin_amdgcn_permlane32_swap(__float_as_uint(rm),__float_as_uint(rm),false,false); rm=__builtin_fmaxf(__uint_as_float(rr[0]),__uint_as_float(rr[1])); } \
      resc=false; \
      if(__builtin_expect(__any(rm>(float)THRL),0)){ const float dl=__builtin_fmaxf(rm+30.f,0.f); mhat+=dl; \
        _Pragma("unroll") for(int r=0;r<16;++r){C0[r]-=dl;C1[r]-=dl;} \
        const float f=__builtin_amdgcn_exp2f(-dl); l_reg*=f; if(hi==0)wsf[r32]=f; resc=true; } } \
    SBAR(); \
    GAPB(o[0]=__builtin_amdgcn_mfma_f32_32x32x16_bf16(PAF(0),VFR(0),o[0],0,0,0), C0,0); \
    GAPB(o[1]=__builtin_amdgcn_mfma_f32_32x32x16_bf16(PAF(0),VFR(4),o[1],0,0,0), C0,4); \
    KRD(GL,0); GAPB(o[0]=__builtin_amdgcn_mfma_f32_32x32x16_bf16(PAF(1),VFR(1),o[0],0,0,0), C0,8); \
    KRD(GL,1); GAPB(o[1]=__builtin_amdgcn_mfma_f32_32x32x16_bf16(PAF(1),VFR(5),o[1],0,0,0), C0,12); \
    KRD(GL,2); GAPB(o[0]=__builtin_amdgcn_mfma_f32_32x32x16_bf16(PAF(2),VFR(2),o[0],0,0,0), C1,0); \
    KRD(GL,3); GAPB(o[1]=__builtin_amdgcn_mfma_f32_32x32x16_bf16(PAF(2),VFR(6),o[1],0,0,0), C1,4); \
    GAPB(o[0]=__builtin_amdgcn_mfma_f32_32x32x16_bf16(PAF(3),VFR(3),o[0],0,0,0), C1,8); \
    GAPB(o[1]=__builtin_amdgcn_mfma_f32_32x32x16_bf16(PAF(3),VFR(7),o[1],0,0,0), C1,12); \
    }while(0)
  int t=1;
  #undef CMASK
  #define CMASK(P0,P1,t) do{}while(0)
  for(;t+5<NT;t+=2){
    STEP(pB0,pB1,pA0,pA1,t,true,true,true);     WAIT_BAR(2); RESC(); ROT();
    STEP(pA0,pA1,pB0,pB1,t+1,true,true,true);   WAIT_BAR(2); RESC(); ROT();
  }
  #undef CMASK
  #define CMASK(P0,P1,t) do{int jb_=(t)-(NT-4); if(jb_>=0)cmask(P0,P1,jb_,qrel,hi);}while(0)
  #define ENDW(tt) do{ if((tt)+3<NT){WAIT_BAR(2);} else if((tt)+2<NT){WAIT_BAR(1);} else {WAIT_BAR(0);} }while(0)
  for(;t+1<NT;t+=2){
    STEP(pB0,pB1,pA0,pA1,t,(t+3<NT),(t+1<NT),(t+1<NT));       ENDW(t);   RESC(); ROT();
    STEP(pA0,pA1,pB0,pB1,t+1,(t+4<NT),(t+2<NT),(t+2<NT));     ENDW(t+1); RESC(); ROT();
  }
  STEP(pB0,pB1,pA0,pA1,NT-1,false,false,false); RESC();
  { float sacc=pB0[0]+pB0[1]; _Pragma("unroll") for(int r=2;r<16;++r)sacc+=pB0[r]; _Pragma("unroll") for(int r=0;r<16;++r)sacc+=pB1[r]; l_reg+=sacc;
    pw0=(u32x4){PKW(pB0,0),PKW(pB0,2),PKW(pB0,4),PKW(pB0,6)};pw1=(u32x4){PKW(pB0,8),PKW(pB0,10),PKW(pB0,12),PKW(pB0,14)};pw2=(u32x4){PKW(pB1,0),PKW(pB1,2),PKW(pB1,4),PKW(pB1,6)};pw3=(u32x4){PKW(pB1,8),PKW(pB1,10),PKW(pB1,12),PKW(pB1,14)};
    SBAR(); pv(o,vb0+sl_cur,PAF(0),PAF(1),PAF(2),PAF(3)); }
  #undef PKW
  #undef PAF
  #undef VFR
  #undef PIN
  #undef MX3
  #undef GAPA
  #undef GAPB
  #undef EX
  #undef VRD
  #undef KRD
  #undef STEP
  #undef ENDW
  {auto rr=__builtin_amdgcn_permlane32_swap(__float_as_uint(l_reg),__float_as_uint(l_reg),false,false);l_reg=__uint_as_float(rr[0])+__uint_as_float(rr[1]);}
  if(hi==0)wsf[32+r32]=l_reg;asm volatile("s_waitcnt lgkmcnt(0)":::"memory");
  float rli[16];
  #pragma unroll
  for(int r=0;r<16;++r)rli[r]=__builtin_amdgcn_rcpf(wsf[32+crow(r,hi)]);
  bf16*Ow=O+(long)(q0+wid*QBLK)*OPITCH;
  { bf16*stg=(bf16*)(shm+LDS_OST)+wid*2048;
    #pragma unroll
    for(int r=0;r<16;++r){const int orow=crow(r,hi);
      #pragma unroll
      for(int d0=0;d0<2;++d0)stg[orow*64+d0*32+r32]=__float2bfloat16(o[d0][r]*rli[r]);}
    asm volatile("s_waitcnt lgkmcnt(0)":::"memory");
    #pragma unroll
    for(int i=0;i<4;++i){const int row=i*8+(lane>>3),ch=lane&7; const u32x4 v=*(const u32x4*)(stg+row*64+ch*8); ATTN_STORE16(Ow+(long)row*OPITCH+ch*8,v);} }
  asm volatile("s_waitcnt lgkmcnt(0)\n\ts_barrier":::"memory");
  #undef DMA_K
  #undef DMA_V
  #undef CMASK
  #undef BIAS
  #undef BIASINIT
  #undef START
  #undef RESC
  #undef ROT
}
__device__ __forceinline__ void sb_unit(int qb,const bf16*Q,const bf16*__restrict__ K,const bf16*__restrict__ V,bf16*O,char*shm){
  int tid_=threadIdx.x; asm volatile("":"+v"(tid_)); const int tid=tid_,lane=tid&63,r32=lane&31,hi=lane>>5; const int wid=__builtin_amdgcn_readfirstlane(tid>>6);
  const int q0=qb*QB;
  const bf16*Qw=Q+(long)(q0+wid*QBLK)*DM;
  const unsigned lds0=(unsigned)(uintptr_t)shm;
  typedef __attribute__((address_space(3))) int lds_i32; typedef __attribute__((address_space(3))) const u32x4* lds_u4ptr;
  lds_i32*flags=(lds_i32*)((lds_cptr)shm+LDS_WS);
  const bf16*ksrc=K+(long)lane*DM+wid*8;
  const bf16*vsrc=V+(long)(16*(wid&3)+(lane>>2))*DM+(wid>>2)*32+(lane&3)*8;
  const unsigned kdst=lds0+LDS_K+wid*1024, vdst=lds0+LDS_V+wid*1024;
  #define DMA_K(t,slot) glds16(ksrc+(long)(t)*KVBLK*DM,(unsigned)__builtin_amdgcn_readfirstlane(kdst+(slot)))
  #define DMA_V(t,slot) glds16(vsrc+(long)(t)*KVBLK*DM,(unsigned)__builtin_amdgcn_readfirstlane(vdst+(slot)))
  const int vb0=(int)(lds0+LDS_V)+((lane>>4)&1)*32+(lane&3)*8+(4*hi+((lane&15)>>2))*64;
  const int NT=(q0+QB)/KVBLK;
  DMA_K(NT-1,0);DMA_V(NT-1,0);
  bf16x8 qr[4];
  #pragma unroll
  for(int d0=0;d0<4;++d0)qr[d0]=*reinterpret_cast<const bf16x8*>(&Qw[(long)r32*DM+d0*16+hi*8]);
  f32x16 o[2];o[0]=f32x16{};o[1]=f32x16{};
  float T=0.f; const int t_abs=q0+wid*QBLK+r32; bool wdone=false;
  for(int i=0;;++i){
    const int jt=NT-1-i; const int slot=(i&1)*SLOTB; const bool more=jt>0;
    if(more){DMA_K(jt-1,slot^SLOTB);DMA_V(jt-1,slot^SLOTB); WAIT_BAR(2);} else {WAIT_BAR(0);}
    const bool band=(jt>=NT-4);
    if(!(wdone||(band&&64*(jt-(NT-4))>=QBLK*wid+QBLK))){
    f32x16 x0,x1; { f32x16 zero=f32x16{}; qkt(x0,x1,shm+LDS_K+slot,qr,zero,r32,hi); }
    f32x16 n0,n1;
    const int kb=64*jt+4*hi;
    #pragma unroll
    for(int r=0;r<16;++r){
      const float z0=x0[r],z1=x1[r];
      const float l0=__builtin_amdgcn_logf(1.0f+__builtin_amdgcn_exp2f(-__builtin_fabsf(z0))), l1=__builtin_amdgcn_logf(1.0f+__builtin_amdgcn_exp2f(-__builtin_fabsf(z1)));
      float a0=__builtin_fminf(z0,0.f)-l0, a1=__builtin_fminf(z1,0.f)-l1, m0=__builtin_fminf(-z0,0.f)-l0, m1=__builtin_fminf(-z1,0.f)-l1;
      if(band){ const int kv=kb+(r&3)+8*(r>>2); if(!(kv<t_abs)){a0=-INFINITY;m0=0.f;} if(!(kv+32<t_abs)){a1=-INFINITY;m1=0.f;} }
      x0[r]=a0;x1[r]=a1;n0[r]=m0;n1[r]=m1;
    }
    float g0[4],g1[4],p0s[4],p1s[4];
    #pragma unroll
    for(int a=0;a<4;++a){ g0[a]=(n0[4*a]+n0[4*a+1])+(n0[4*a+2]+n0[4*a+3]); g1[a]=(n1[4*a]+n1[4*a+1])+(n1[4*a+2]+n1[4*a+3]);
      { auto rr=__builtin_amdgcn_permlane32_swap(__float_as_uint(g0[a]),__float_as_uint(g0[a]),false,false); p0s[a]=__uint_as_float(hi?rr[0]:rr[1]); }
      { auto rr=__builtin_amdgcn_permlane32_swap(__float_as_uint(g1[a]),__float_as_uint(g1[a]),false,false); p1s[a]=__uint_as_float(hi?rr[0]:rr[1]); } }
    float run=T;
    #pragma unroll
    for(int a=3;a>=0;--a){ float off=run+(hi?0.f:p1s[a]); run+=g1[a]+p1s[a];
      const float t3=off,t2=t3+n1[4*a+3],t1=t2+n1[4*a+2],t0=t1+n1[4*a+1];
      x1[4*a+3]=__builtin_amdgcn_exp2f(x1[4*a+3]+t3); x1[4*a+2]=__builtin_amdgcn_exp2f(x1[4*a+2]+t2); x1[4*a+1]=__builtin_amdgcn_exp2f(x1[4*a+1]+t1); x1[4*a]=__builtin_amdgcn_exp2f(x1[4*a]+t0); }
    #pragma unroll
    for(int a=3;a>=0;--a){ float off=run+(hi?0.f:p0s[a]); run+=g0[a]+p0s[a];
      const float t3=off,t2=t3+n0[4*a+3],t1=t2+n0[4*a+2],t0=t1+n0[4*a+1];
      x0[4*a+3]=__builtin_amdgcn_exp2f(x0[4*a+3]+t3); x0[4*a+2]=__builtin_amdgcn_exp2f(x0[4*a+2]+t2); x0[4*a+1]=__builtin_amdgcn_exp2f(x0[4*a+1]+t1); x0[4*a]=__builtin_amdgcn_exp2f(x0[4*a]+t0); }
    T=run;
    u32x4 pw0,pw1,pw2,pw3;
    pw0=(u32x4){cvtpk_s(x0[0],x0[1]),cvtpk_s(x0[2],x0[3]),cvtpk_s(x0[4],x0[5]),cvtpk_s(x0[6],x0[7])};
    pw1=(u32x4){cvtpk_s(x0[8],x0[9]),cvtpk_s(x0[10],x0[11]),cvtpk_s(x0[12],x0[13]),cvtpk_s(x0[14],x0[15])};
    pw2=(u32x4){cvtpk_s(x1[0],x1[1]),cvtpk_s(x1[2],x1[3]),cvtpk_s(x1[4],x1[5]),cvtpk_s(x1[6],x1[7])};
    pw3=(u32x4){cvtpk_s(x1[8],x1[9]),cvtpk_s(x1[10],x1[11]),cvtpk_s(x1[12],x1[13]),cvtpk_s(x1[14],x1[15])};
    SBAR(); pv(o,vb0+slot,__builtin_bit_cast(bf16x8,pw0),__builtin_bit_cast(bf16x8,pw1),__builtin_bit_cast(bf16x8,pw2),__builtin_bit_cast(bf16x8,pw3));
    wdone=__all(T<-150.f);
    }
    if(lane==0)flags[wid]=wdone?1:0;
    WAIT_BAR(2);
    const u32x4 f0=*(lds_u4ptr)(flags), f1=*(lds_u4ptr)(flags+4);
    const bool alld=((f0.x&f0.y&f0.z&f0.w)&(f1.x&f1.y&f1.z&f1.w))!=0;
    if(!more||alld)break;
  }
  WAIT_BAR(0);
  bf16*Ow=O+(long)(q0+wid*QBLK)*OPITCH;
  { bf16*stg=(bf16*)(shm+LDS_OST)+wid*2048;
    #pragma unroll
    for(int r=0;r<16;++r){const int orow=crow(r,hi);
      #pragma unroll
      for(int d0=0;d0<2;++d0)stg[orow*64+d0*32+r32]=__float2bfloat16(o[d0][r]);}
    asm volatile("s_waitcnt lgkmcnt(0)":::"memory");
    #pragma unroll
    for(int i=0;i<4;++i){const int row=i*8+(lane>>3),ch=lane&7; const u32x4 v=*(const u32x4*)(stg+row*64+ch*8); ATTN_STORE16(Ow+(long)row*OPITCH+ch*8,v);} }
  asm volatile("s_waitcnt lgkmcnt(0)\n\ts_barrier":::"memory");
  #undef DMA_K
  #undef DMA_V
}
#undef SBAR
#undef WAIT_BAR
}

constexpr int BATCH = 8, SEQ = 4096, DM = 1024, DEPTH = 4, M = BATCH * SEQ, INC = 3334, NIN = 3584, DFF = 4096;
constexpr float EPS = 1e-6f;
constexpr size_t MiB = 1u << 20;
constexpr size_t WS_BAR = 128 * 1024;
constexpr size_t WS_SS = 1 * MiB;
constexpr size_t WS_LB = 3 * MiB;
constexpr size_t WS_JS = 3 * MiB + 256 * 1024;
constexpr size_t WS_DD = 3 * MiB + 512 * 1024;
constexpr size_t WS_W = 4 * MiB;
constexpr size_t W_LAYER = 25 * MiB, W_OUT = 7 * MiB, W_1 = 9 * MiB, W_2 = 17 * MiB;
constexpr size_t WS_XB = 104 * MiB;
constexpr size_t WS_P = 168 * MiB;
constexpr size_t P_HQ = 0, P_HK = 16 * MiB, P_HI = 32 * MiB, P_HG = 48 * MiB, P_HLF = 64 * MiB, P_SQ = 96 * MiB, P_FQ = 168 * MiB, P_LF = 240 * MiB, P_CC = 241 * MiB, P_US = 242 * MiB;
constexpr size_t HEADBUF = 24 * MiB;
constexpr size_t WS_MIX = 442 * MiB;
constexpr size_t WS_U = 168 * MiB;
constexpr size_t WS_END = 506 * MiB;
constexpr int LDS_BYTES = 147456;

typedef pg8::bf16_t bf16_t;
typedef pg8::f32x4 f32x4;
typedef unsigned u32x4 __attribute__((ext_vector_type(4)));
typedef unsigned u32x2 __attribute__((ext_vector_type(2)));
#define LAS __attribute__((address_space(3)))

__device__ __forceinline__ unsigned f2bf(float f) { unsigned u = __builtin_bit_cast(unsigned, f); return (u + 0x7fffu + ((u >> 16) & 1u)) >> 16; }
__device__ __forceinline__ unsigned pk2(float lo, float hi) { return pg8::cvt_pk_bf16(lo, hi); }
__device__ __forceinline__ float bf2f(unsigned short b) { return __builtin_bit_cast(float, (unsigned)b << 16); }
__device__ __forceinline__ float bflo(unsigned w) { return __builtin_bit_cast(float, w << 16); }
__device__ __forceinline__ float bfhi(unsigned w) { return __builtin_bit_cast(float, w & 0xffff0000u); }
__device__ __forceinline__ float logsig(float x) { return fminf(x, 0.f) - log1pf(expf(-fabsf(x))); }
__device__ __forceinline__ float wave_sum(float v) {
#pragma unroll
    for (int o = 1; o < 64; o <<= 1) v += __shfl_xor(v, o);
    return v;
}
#define ROWSCALES8(rs, ss, row0, fq) float rs[2][4]; _Pragma("unroll") for (int ai_ = 0; ai_ < 2; ++ai_) _Pragma("unroll") for (int m_ = 0; m_ < 4; ++m_) rs[ai_][m_] = rowscale(ss, (row0) + ai_ * 128 + m_ * 16, fq);
__device__ __forceinline__ float rowscale(const float* ss, int row, int fq) {
    const f32x4 p = *(const f32x4*)(ss + (size_t)row * 16 + 4 * fq);
    float s = (p[0] + p[1]) + (p[2] + p[3]);
    s += __shfl_xor(s, 16); s += __shfl_xor(s, 32);
    return rsqrtf(s * (1.0f / DM) + EPS);
}

#define ROWFENCE() asm volatile("" ::: "memory")
struct EpiResid {
    static constexpr bool PERM = true, AFTER_DRAIN = false;
    bf16_t* xb; float* outf; float* ss;
    __device__ __forceinline__ void operator()(const f32x4 (&acc)[2][2][4][2], const pg8::Unit& u, int wr, int wc, int fr, int fq) const {
        const int row0 = u.pm * 256 + wr * 64 + fr, col0 = u.pn * 256 + wc * 32 + 8 * fq;
#pragma unroll
        for (int ai = 0; ai < 2; ++ai) {
            u32x4 pre[4][2];
#pragma unroll
            for (int m = 0; m < 4; ++m)
#pragma unroll
                for (int bj = 0; bj < 2; ++bj) pre[m][bj] = *(const u32x4*)(xb + (size_t)(row0 + ai * 128 + m * 16) * DM + col0 + bj * 128);
#pragma unroll
            for (int m = 0; m < 4; ++m) {
                const int row = row0 + ai * 128 + m * 16; float sq = 0.f;
#pragma unroll
                for (int bj = 0; bj < 2; ++bj) {
                    const size_t off = (size_t)row * DM + col0 + bj * 128; const u32x4 p = pre[m][bj];
                    const f32x4 v0 = acc[ai][bj][m][0] + (f32x4){bflo(p.x), bfhi(p.x), bflo(p.y), bfhi(p.y)}, v1 = acc[ai][bj][m][1] + (f32x4){bflo(p.z), bfhi(p.z), bflo(p.w), bfhi(p.w)};
                    if (outf) { *(f32x4*)(outf + off) = v0; *(f32x4*)(outf + off + 4) = v1; }
                    u32x4 w; w.x = pk2(v0[0], v0[1]); w.y = pk2(v0[2], v0[3]); w.z = pk2(v1[0], v1[1]); w.w = pk2(v1[2], v1[3]);
                    *(u32x4*)(xb + off) = w;
                    sq += (v0[0] * v0[0] + v0[1] * v0[1]) + (v0[2] * v0[2] + v0[3] * v0[3]) + (v1[0] * v1[0] + v1[1] * v1[1]) + (v1[2] * v1[2] + v1[3] * v1[3]);
                }
                sq += __shfl_xor(sq, 16); sq += __shfl_xor(sq, 32);
                if (fq == 0) ss[(size_t)row * 16 + u.pn * 4 + wc] = sq;
            }
            ROWFENCE();
        }
    }
};
struct EpiRelu2 {
    static constexpr bool PERM = true, AFTER_DRAIN = false;
    bf16_t* U; const float* ss;
    __device__ __forceinline__ void operator()(const f32x4 (&acc)[2][2][4][2], const pg8::Unit& u, int wr, int wc, int fr, int fq) const {
        const int row0 = u.pm * 256 + wr * 64 + fr, col0 = u.pn * 256 + wc * 32 + 8 * fq;
        ROWSCALES8(rs8, ss, row0, fq)
#pragma unroll
        for (int ai = 0; ai < 2; ++ai)
#pragma unroll
            for (int m = 0; m < 4; ++m) {
                const int row = row0 + ai * 128 + m * 16; const float rs = rs8[ai][m];
#pragma unroll
                for (int bj = 0; bj < 2; ++bj) {
                    f32x4 v0 = acc[ai][bj][m][0] * rs, v1 = acc[ai][bj][m][1] * rs;
                    v0 = __builtin_elementwise_max(v0, (f32x4){0.f, 0.f, 0.f, 0.f}); v1 = __builtin_elementwise_max(v1, (f32x4){0.f, 0.f, 0.f, 0.f});
                    v0 = v0 * v0; v1 = v1 * v1;
                    u32x4 w; w.x = pk2(v0[0], v0[1]); w.y = pk2(v0[2], v0[3]); w.z = pk2(v1[0], v1[1]); w.w = pk2(v1[2], v1[3]);
                    *(u32x4*)(U + (size_t)row * DFF + col0 + bj * 128) = w;
                }
                ROWFENCE();
            }
    }
};
struct EpiInProj {
    static constexpr bool PERM = true, AFTER_DRAIN = false;
    const float* ss; unsigned char* P; const float* lbt;
    const float* gt; const float* fbias;
    __device__ __forceinline__ void operator()(const f32x4 (&acc)[2][2][4][2], const pg8::Unit& u, int wr, int wc, int fr, int fq) const {
        const int slot = u.pn * 4 + wc;
        if (slot > 52) return;
        const int row0 = u.pm * 256 + wr * 64 + fr;
        ROWSCALES8(rs8, ss, row0, fq)
        if (slot < 16) {
            const int kind = slot >> 2, cb = (slot & 3) * 64 + 8 * fq;
            if (kind == 1) {
                float* HLF = (float*)(P + P_HLF); bf16_t* HK = (bf16_t*)(P + P_HK);
#pragma unroll
                for (int ai = 0; ai < 2; ++ai)
#pragma unroll
                    for (int m = 0; m < 4; ++m) {
                        const int row = row0 + ai * 128 + m * 16; const float rs = rs8[ai][m];
#pragma unroll
                        for (int bj = 0; bj < 2; ++bj) {
                            float lf[8], kk[8];
#pragma unroll
                            for (int n = 0; n < 2; ++n) {
                                const f32x4 ll = *(const f32x4*)(lbt + cb + 32 * bj + 4 * n), om = *(const f32x4*)(lbt + 256 + cb + 32 * bj + 4 * n);
#pragma unroll
                                for (int i = 0; i < 4; ++i) {
                                    const float fl = acc[ai][bj][m][n][i] * rs;
                                    const float a = fminf(fl, 0.f) - __logf(1.0f + __expf(-fabsf(fl)));
                                    const float an = a - fl;
                                    const float b = ll[i] + an;
                                    lf[4 * n + i] = fmaxf(a, b) + __logf(1.0f + __expf(-fabsf(a - b)));
                                    kk[4 * n + i] = om[i] * __expf(an);
                                }
                            }
                            const size_t off = (size_t)row * 256 + cb + 32 * bj;
                            *(f32x4*)(HLF + off) = (f32x4){lf[0], lf[1], lf[2], lf[3]}; *(f32x4*)(HLF + off + 4) = (f32x4){lf[4], lf[5], lf[6], lf[7]};
                            u32x4 w; w.x = pk2(kk[0], kk[1]); w.y = pk2(kk[2], kk[3]); w.z = pk2(kk[4], kk[5]); w.w = pk2(kk[6], kk[7]);
                            *(u32x4*)(HK + off) = w;
                        }
                        ROWFENCE();
                    }
            } else {
                bf16_t* dst = (bf16_t*)(P + (kind == 0 ? P_HQ : (kind == 2 ? P_HI : P_HG)));
#pragma unroll
                for (int ai = 0; ai < 2; ++ai)
#pragma unroll
                    for (int m = 0; m < 4; ++m) {
                        const int row = row0 + ai * 128 + m * 16; const float rs = rs8[ai][m];
#pragma unroll
                        for (int bj = 0; bj < 2; ++bj) {
                            const f32x4 v0 = acc[ai][bj][m][0] * rs, v1 = acc[ai][bj][m][1] * rs;
                            u32x4 w; w.x = pk2(v0[0], v0[1]); w.y = pk2(v0[2], v0[3]); w.z = pk2(v1[0], v1[1]); w.w = pk2(v1[2], v1[3]);
                            *(u32x4*)(dst + (size_t)row * 256 + cb + 32 * bj) = w;
                        }
                        ROWFENCE();
                    }
            }
        } else if (slot < 52) {
            const int s2 = slot - 16, grp = s2 / 6, h = s2 % 6, role = grp % 3;
            bf16_t* dst = (bf16_t*)(P + P_SQ + (size_t)grp * HEADBUF) + (size_t)((u.pm >> 4) * 6 + h) * SEQ * 64 + 8 * fq;
            const float* gp = gt + (grp - (grp >= 3 ? 1 : 0)) * 64 + 8 * fq;
            const float qs = (role == 0) ? 0.125f * 1.4426950408889634f : 1.0f;
#pragma unroll
            for (int ai = 0; ai < 2; ++ai)
#pragma unroll
                for (int m = 0; m < 4; ++m) {
                    const int row = row0 + ai * 128 + m * 16; const float rs = rs8[ai][m];
                    float fac = rs;
                    if (role != 2) {
                        float sq = 0.f;
#pragma unroll
                        for (int bj = 0; bj < 2; ++bj)
#pragma unroll
                            for (int n = 0; n < 2; ++n) { const f32x4 x = acc[ai][bj][m][n]; sq += (x[0] * x[0] + x[1] * x[1]) + (x[2] * x[2] + x[3] * x[3]); }
                        sq += __shfl_xor(sq, 16); sq += __shfl_xor(sq, 32);
                        fac = rs * rsqrtf(rs * rs * sq * (1.0f / 64.0f) + EPS) * qs;
                    }
                    const int t = row & (SEQ - 1);
#pragma unroll
                    for (int bj = 0; bj < 2; ++bj) {
                        f32x4 v0 = acc[ai][bj][m][0] * fac, v1 = acc[ai][bj][m][1] * fac;
                        if (role != 2) { v0 = v0 * *(const f32x4*)(gp + 32 * bj); v1 = v1 * *(const f32x4*)(gp + 32 * bj + 4); }
                        u32x4 w; w.x = pk2(v0[0], v0[1]); w.y = pk2(v0[2], v0[3]); w.z = pk2(v1[0], v1[1]); w.w = pk2(v1[2], v1[3]);
                        *(u32x4*)(dst + (size_t)t * 64 + 32 * bj) = w;
                    }
                    ROWFENCE();
                }
        } else {
            float* LF = (float*)(P + P_LF);
#pragma unroll
            for (int ai = 0; ai < 2; ++ai)
#pragma unroll
                for (int m = 0; m < 4; ++m) {
                    const int row = row0 + ai * 128 + m * 16; const float rs = rs8[ai][m];
                    if (fq == 0) {
                        const f32x4 a0 = acc[ai][0][m][0], a1 = acc[ai][0][m][1];
                        *(f32x4*)(LF + (size_t)row * 8) = (f32x4){logsig(a0[0] * rs + fbias[0]), logsig(a0[1] * rs + fbias[1]), logsig(a0[2] * rs + fbias[2]), logsig(a0[3] * rs + fbias[3])};
                        *(f32x4*)(LF + (size_t)row * 8 + 4) = (f32x4){logsig(a1[0] * rs + fbias[4]), logsig(a1[1] * rs + fbias[5]), 0.f, 0.f};
                    }
                    ROWFENCE();
                }
        }
    }
};
#define XB_TMO      128
#define XB_XCNT(j)  (256  + 64 * (j))
#define XB_XSUB(j)  (1280 + 64 * (j))
#define XB_XGEN(j)  (2304 + 64 * (j))
#define XB_TOP      3328
#define XB_TOPGEN   3392
#define XCD_BAR_WORDS 3456
#define XB_SPIN_CAP (1u << 18)

__device__ __forceinline__ unsigned xb_ld(unsigned* p)              { return __hip_atomic_load(p, __ATOMIC_RELAXED, __HIP_MEMORY_SCOPE_AGENT); }
__device__ __forceinline__ unsigned xb_add(unsigned* p, unsigned v) { return __hip_atomic_fetch_add(p, v, __ATOMIC_RELAXED, __HIP_MEMORY_SCOPE_AGENT); }
__device__ __forceinline__ unsigned xb_xcc_id() { return (unsigned)__builtin_amdgcn_s_getreg((3 << 11) | 20) & 0xFu; }
#define XB_SPIN(cond, bar) do { unsigned _sp = 0; while (cond) { __builtin_amdgcn_s_sleep(1); \
    if ((++_sp & 255u) == 0u) { if (xb_ld(&(bar)[XB_TMO])) break; if (_sp > XB_SPIN_CAP) { atomicAdd(&(bar)[XB_TMO], 1u); break; } } } } while (0)

struct XcdBarrier {
    unsigned* bar; unsigned x;
    volatile LAS unsigned* st;
};

__device__ __forceinline__ XcdBarrier xcd_barrier_post(unsigned* bar, volatile LAS unsigned* st) {
    XcdBarrier b; b.bar = bar; b.x = xb_xcc_id(); b.st = st;
    if (threadIdx.x == 0) (void)xb_add(&bar[XB_XCNT(b.x)], 1u);
    return b;
}
__device__ __forceinline__ void xcd_barrier_complete(unsigned* bar, unsigned x, unsigned& nloc, unsigned& nx) {
    const unsigned G = gridDim.x * gridDim.y * gridDim.z;
    unsigned sum, cnt, mine, sp = 0u;
    for (;;) {
        sum = 0u; cnt = 0u; mine = 0u;
#pragma unroll
        for (unsigned j = 0; j < 16; ++j) { const unsigned c = xb_ld(&bar[XB_XCNT(j)]); sum += c; cnt += (c > 0u) ? 1u : 0u; mine = (j == x) ? c : mine; }
        if (sum == G) break;
        __builtin_amdgcn_s_sleep(1);
        if ((++sp & 255u) == 0u) { if (xb_ld(&bar[XB_TMO])) break; if (sp > XB_SPIN_CAP) { atomicAdd(&bar[XB_TMO], 1u); break; } }
    }
    nloc = mine > 0u ? mine : 1u; nx = cnt > 0u ? cnt : 1u;
}

__device__ __forceinline__ void xcd_barrier(const XcdBarrier& b) {
    asm volatile("s_waitcnt vmcnt(0)" ::: "memory");
    __syncthreads();
    if (threadIdx.x == 0) {
        unsigned* bar = b.bar;
        __builtin_amdgcn_s_waitcnt(0);
        unsigned nloc = b.st[0], nx = b.st[1];
        if (nloc == 0u) { xcd_barrier_complete(bar, b.x, nloc, nx); b.st[0] = nloc; b.st[1] = nx; }
        const unsigned old = xb_add(&bar[XB_XSUB(b.x)], 1u);
        const unsigned gen = old / nloc;
        if (old + 1u == (gen + 1u) * nloc) {
            __builtin_amdgcn_fence(__ATOMIC_RELEASE, "agent");
            asm volatile("s_waitcnt vmcnt(0)" ::: "memory");
            const unsigned og = xb_add(&bar[XB_TOP], 1u);
            const unsigned tg = og / nx;
            if (og + 1u == (tg + 1u) * nx) xb_add(&bar[XB_TOPGEN], 1u);
            else XB_SPIN(xb_ld(&bar[XB_TOPGEN]) == tg, bar);
            __builtin_amdgcn_fence(__ATOMIC_ACQUIRE, "agent");
            xb_add(&bar[XB_XGEN(b.x)], 1u);
            asm volatile("s_waitcnt vmcnt(0)" ::: "memory");
        } else {
            XB_SPIN(xb_ld(&bar[XB_XGEN(b.x)]) == gen, bar);
            __builtin_amdgcn_fence(__ATOMIC_ACQUIRE, "agent");
            asm volatile("s_waitcnt vmcnt(0)" ::: "memory");
        }
    }
    __syncthreads();
}

__device__ __forceinline__ void tr_item(const float* W, int ldw, int ncols_valid, int src_col0, int k0, const float* gain, bf16_t* WT, int K, int n0, LAS float* scr, int lane) {
#pragma unroll 8
    for (int i = 0; i < 32; ++i) { const int kk = 2 * i + (lane >> 5), c = src_col0 + (lane & 31);
        float v = (c < ncols_valid) ? W[(size_t)(k0 + kk) * ldw + c] : 0.f; if (gain) v *= gain[k0 + kk]; scr[kk * 33 + (lane & 31)] = v; }
    asm volatile("s_waitcnt lgkmcnt(0)" ::: "memory");
    const int c = lane & 7;
#pragma unroll
    for (int j = 0; j < 4; ++j) { const int n = (lane >> 3) + 8 * j; const LAS float* s = scr + (8 * c) * 33 + n;
        u32x4 o; o.x = pk2(s[0 * 33], s[1 * 33]); o.y = pk2(s[2 * 33], s[3 * 33]); o.z = pk2(s[4 * 33], s[5 * 33]); o.w = pk2(s[6 * 33], s[7 * 33]);
        *(u32x4*)(WT + (size_t)(n0 + n) * K + k0 + 8 * c) = o; }
    asm volatile("s_waitcnt lgkmcnt(0)" ::: "memory");
}

__device__ __forceinline__ void unpack8(const u32x4 w, float* d) { d[0] = bflo(w.x); d[1] = bfhi(w.x); d[2] = bflo(w.y); d[3] = bfhi(w.y); d[4] = bflo(w.z); d[5] = bfhi(w.z); d[6] = bflo(w.w); d[7] = bfhi(w.w); }

__device__ __forceinline__ void fox_cumsum_item(int bh, const float* LF, float* CC, int* JS, const float* gq, const float* gk, LAS float* sc) {
    int tid_ = threadIdx.x; asm volatile("" : "+v"(tid_)); const int tid = tid_, lane = tid & 63, wave = tid >> 6, b = bh / 6, h = bh % 6;
    float v[8]; float run = 0.f;
#pragma unroll
    for (int i = 0; i < 8; ++i) { run += LF[((size_t)b * SEQ + tid * 8 + i) * 8 + h]; v[i] = run; }
    float s = run;
#pragma unroll
    for (int o = 1; o < 64; o <<= 1) { const float n = __shfl_up(s, o); if (lane >= o) s += n; }
    __syncthreads();
    if (lane == 63) sc[wave] = s;
    __syncthreads();
    float base = s - run;
    for (int w = 0; w < wave; ++w) base += sc[w];
    LAS float* cl = sc + 64;
#pragma unroll
    for (int i = 0; i < 8; ++i) { const float c2 = (v[i] + base) * 1.4426950408889634f; CC[(size_t)bh * SEQ + tid * 8 + i] = c2; cl[tid * 8 + i] = c2; }
    __syncthreads();
    if (tid < 16) {
        float mq = 0.f, mk = 0.f;
        for (int d = 0; d < 64; ++d) { mq = fmaxf(mq, fabsf(gq[d])); mk = fmaxf(mk, fabsf(gk[d])); }
        const float zb = 1.4426950408889634f * 8.0f * mq * mk * 1.03f + 1.0f;
        const float thr = -(150.0f + 2.0f * zb);
        const int q0 = tid * 256, nt = q0 / 64 + 4; const float cq = cl[q0];
        int j = 0; while (j < nt - 4 && cq - cl[64 * j + 63] < thr) ++j;
        JS[bh * 16 + tid] = j & ~1;
    }
    __syncthreads();
}

__device__ __forceinline__ void stage_kv(const bf16_t* Kb, const bf16_t* Vb, int kt, LAS float* Kf, LAS float* Vf) {
    int tid_ = threadIdx.x; asm volatile("" : "+v"(tid_)); const int tid = tid_, key = tid >> 3, c8 = tid & 7;
    const u32x4 kw = *(const u32x4*)(Kb + ((size_t)(kt * 64 + key)) * 64 + c8 * 8), vw = *(const u32x4*)(Vb + ((size_t)(kt * 64 + key)) * 64 + c8 * 8);
    float kf[8], vf[8]; unpack8(kw, kf); unpack8(vw, vf);
    *(LAS f32x4*)(Kf + key * 64 + c8 * 8) = (f32x4){kf[0], kf[1], kf[2], kf[3]}; *(LAS f32x4*)(Kf + key * 64 + c8 * 8 + 4) = (f32x4){kf[4], kf[5], kf[6], kf[7]};
    *(LAS f32x4*)(Vf + key * 64 + c8 * 8) = (f32x4){vf[0], vf[1], vf[2], vf[3]}; *(LAS f32x4*)(Vf + key * 64 + c8 * 8 + 4) = (f32x4){vf[4], vf[5], vf[6], vf[7]};
}

__device__ __forceinline__ void fox_naive_item(int item, unsigned char* P, bf16_t* MIX, LAS float* lds) {
    int tid_ = threadIdx.x; asm volatile("" : "+v"(tid_)); const int tid = tid_, bh = item >> 3, qblk = item & 7, b = bh / 6, h = bh % 6, t = qblk * 512 + tid;
    const bf16_t* Qp = (const bf16_t*)(P + P_FQ) + ((size_t)bh * SEQ + t) * 64;
    const bf16_t* Kb = (const bf16_t*)(P + P_FQ + HEADBUF) + (size_t)bh * SEQ * 64;
    const bf16_t* Vb = (const bf16_t*)(P + P_FQ + 2 * HEADBUF) + (size_t)bh * SEQ * 64;
    const float* CC = (const float*)(P + P_CC) + (size_t)bh * SEQ;
    float q[64], o[64];
#pragma unroll
    for (int c = 0; c < 8; ++c) unpack8(*(const u32x4*)(Qp + c * 8), q + c * 8);
#pragma unroll
    for (int d = 0; d < 64; ++d) o[d] = 0.f;
    float m = -1e30f, l = 0.f; const float ct = CC[t];
    LAS float* Kf = lds; LAS float* Vf = lds + 4096; LAS float* cs = lds + 8192;
    const int ntile = (qblk + 1) * 8;
    for (int kt = 0; kt < ntile; ++kt) {
        __syncthreads();
        stage_kv(Kb, Vb, kt, Kf, Vf); if (tid < 64) cs[tid] = CC[kt * 64 + tid];
        __syncthreads();
        for (int s = 0; s < 64; ++s) {
            float z = 0.f;
#pragma unroll
            for (int d = 0; d < 64; ++d) z += q[d] * Kf[s * 64 + d];
            const float x = (kt * 64 + s <= t) ? z + (ct - cs[s]) : -1e30f;
            const float mn = fmaxf(m, x), sc = __expf(m - mn), p = __expf(x - mn);
            l = l * sc + p;
#pragma unroll
            for (int d = 0; d < 64; ++d) o[d] = o[d] * sc + p * Vf[s * 64 + d];
            m = mn;
        }
    }
    const float inv = 1.0f / l;
    bf16_t* op = MIX + ((size_t)b * SEQ + t) * DM + 640 + h * 64;
#pragma unroll
    for (int c = 0; c < 8; ++c) { u32x4 w; w.x = pk2(o[c * 8] * inv, o[c * 8 + 1] * inv); w.y = pk2(o[c * 8 + 2] * inv, o[c * 8 + 3] * inv); w.z = pk2(o[c * 8 + 4] * inv, o[c * 8 + 5] * inv); w.w = pk2(o[c * 8 + 6] * inv, o[c * 8 + 7] * inv); *(u32x4*)(op + c * 8) = w; }
}

__device__ __forceinline__ void sb_naive_item(int item, unsigned char* P, bf16_t* MIX, LAS float* lds) {
    int tid_ = threadIdx.x; asm volatile("" : "+v"(tid_)); const int tid = tid_, bh = item >> 3, qblk = item & 7, b = bh / 6, h = bh % 6, t = qblk * 512 + tid;
    const bf16_t* Qp = (const bf16_t*)(P + P_SQ) + ((size_t)bh * SEQ + t) * 64;
    const bf16_t* Kb = (const bf16_t*)(P + P_SQ + HEADBUF) + (size_t)bh * SEQ * 64;
    const bf16_t* Vb = (const bf16_t*)(P + P_SQ + 2 * HEADBUF) + (size_t)bh * SEQ * 64;
    float q[64], o[64];
#pragma unroll
    for (int c = 0; c < 8; ++c) unpack8(*(const u32x4*)(Qp + c * 8), q + c * 8);
#pragma unroll
    for (int d = 0; d < 64; ++d) o[d] = 0.f;
    float tail = 0.f;
    LAS float* Kf = lds; LAS float* Vf = lds + 4096;
    for (int kt = qblk * 8 + 7; kt >= 0; --kt) {
        __syncthreads();
        stage_kv(Kb, Vb, kt, Kf, Vf);
        __syncthreads();
        for (int s = 63; s >= 0; --s) {
            float z = 0.f;
#pragma unroll
            for (int d = 0; d < 64; ++d) z += q[d] * Kf[s * 64 + d];
            const float ls = fminf(z, 0.f) - __logf(1.0f + __expf(-fabsf(z)));
            const bool act = (kt * 64 + s) < t;
            const float A = act ? __expf(ls + tail) : 0.f;
#pragma unroll
            for (int d = 0; d < 64; ++d) o[d] += A * Vf[s * 64 + d];
            tail += act ? (ls - z) : 0.f;
        }
        if (__syncthreads_and(tail < -100.f)) break;
    }
    bf16_t* op = MIX + ((size_t)b * SEQ + t) * DM + 256 + h * 64;
#pragma unroll
    for (int c = 0; c < 8; ++c) { u32x4 w; w.x = pk2(o[c * 8], o[c * 8 + 1]); w.y = pk2(o[c * 8 + 2], o[c * 8 + 3]); w.z = pk2(o[c * 8 + 4], o[c * 8 + 5]); w.w = pk2(o[c * 8 + 6], o[c * 8 + 7]); *(u32x4*)(op + c * 8) = w; }
}

__device__ __forceinline__ void hgrn_naive_item(int item, unsigned char* P, bf16_t* MIX, const float* hgn, LAS float* lds) {
    int tid_ = threadIdx.x; asm volatile("" : "+v"(tid_)); const int tid = tid_, lane = tid & 63, w = tid >> 6, kg = lane >> 3, vi = lane & 7, vcol = 8 * w + vi, b = item >> 2, h = item & 3;
    const bf16_t* HQ = (const bf16_t*)(P + P_HQ); const bf16_t* HK = (const bf16_t*)(P + P_HK); const bf16_t* HI = (const bf16_t*)(P + P_HI); const bf16_t* HG = (const bf16_t*)(P + P_HG);
    const float* HLF = (const float*)(P + P_HLF);
    LAS float* qf = lds; LAS float* kf = lds + 4096; LAS float* ff = lds + 8192; LAS float* vf = lds + 12288; LAS float* ob = lds + 16384;
    float S[8];
#pragma unroll
    for (int j = 0; j < 8; ++j) S[j] = 0.f;
    const int tok = tid >> 3, c8 = tid & 7;
    float gn[8];
#pragma unroll
    for (int e = 0; e < 8; ++e) gn[e] = hgn[c8 * 8 + e];
    for (int c = 0; c < 64; ++c) {
        const size_t off = ((size_t)b * SEQ + c * 64 + tok) * 256 + h * 64 + c8 * 8;
        __syncthreads();
        {
            float a[8];
            unpack8(*(const u32x4*)(HQ + off), a);
#pragma unroll
            for (int e = 0; e < 8; ++e) qf[tok * 64 + c8 * 8 + e] = a[e];
            unpack8(*(const u32x4*)(HK + off), a);
#pragma unroll
            for (int e = 0; e < 8; ++e) kf[tok * 64 + c8 * 8 + e] = a[e];
            unpack8(*(const u32x4*)(HI + off), a);
#pragma unroll
            for (int e = 0; e < 8; ++e) vf[tok * 64 + c8 * 8 + e] = a[e];
            const f32x4 l0 = *(const f32x4*)(HLF + off), l1 = *(const f32x4*)(HLF + off + 4);
#pragma unroll
            for (int e = 0; e < 4; ++e) { ff[tok * 64 + c8 * 8 + e] = expf(l0[e]); ff[tok * 64 + c8 * 8 + 4 + e] = expf(l1[e]); }
        }
        __syncthreads();
        for (int tk = 0; tk < 64; ++tk) {
            const float vv = vf[tk * 64 + vcol]; float op = 0.f;
#pragma unroll
            for (int j = 0; j < 8; ++j) { const int k = 8 * kg + j; S[j] = ff[tk * 64 + k] * S[j] + kf[tk * 64 + k] * vv; op += qf[tk * 64 + k] * S[j]; }
            op += __shfl_xor(op, 8); op += __shfl_xor(op, 16); op += __shfl_xor(op, 32);
            if (kg == 0) ob[tk * 64 + vcol] = op;
        }
        __syncthreads();
        {
            float ov[8], g[8]; float sq = 0.f;
#pragma unroll
            for (int e = 0; e < 8; ++e) { ov[e] = ob[tok * 64 + c8 * 8 + e]; sq += ov[e] * ov[e]; }
            sq += __shfl_xor(sq, 1); sq += __shfl_xor(sq, 2); sq += __shfl_xor(sq, 4);
            const float rn = rsqrtf(sq * (1.0f / 64.0f) + EPS);
            unpack8(*(const u32x4*)(HG + off), g);
            float r[8];
#pragma unroll
            for (int e = 0; e < 8; ++e) r[e] = ov[e] * rn * gn[e] * (g[e] / (1.0f + expf(-g[e])));
            u32x4 wv; wv.x = pk2(r[0], r[1]); wv.y = pk2(r[2], r[3]); wv.z = pk2(r[4], r[5]); wv.w = pk2(r[6], r[7]);
            *(u32x4*)(MIX + ((size_t)b * SEQ + c * 64 + tok) * DM + h * 64 + c8 * 8) = wv;
        }
    }
}

constexpr int HG_SLOT = 32768, HG_PRE = 16384, HG_TOT = 16384 + 1280, HG_VT = 20480, HG_VP = 72;
typedef short hbf16x8 __attribute__((ext_vector_type(8)));
typedef short hbf16x4 __attribute__((ext_vector_type(4)));
__device__ __forceinline__ hbf16x8 pack8(const float* x) { u32x4 w; w.x = pk2(x[0], x[1]); w.y = pk2(x[2], x[3]); w.z = pk2(x[4], x[5]); w.w = pk2(x[6], x[7]); return __builtin_bit_cast(hbf16x8, w); }

__device__ __forceinline__ void hg_stage(int tid, size_t row0, int h, const float* HLF, const bf16_t* HI, LAS unsigned char* sb) {
    const int lt = tid & 255, k = lt & 63, seg = lt >> 6;
    LAS float* bl = (LAS float*)sb; LAS float* pre = (LAS float*)(sb + HG_PRE); LAS float* tot = (LAS float*)(sb + HG_TOT); LAS bf16_t* vt = (LAS bf16_t*)(sb + HG_VT);
    float run = 0.f;
#pragma unroll
    for (int i = 0; i < 16; ++i) { const int t = 16 * seg + i; run += HLF[(row0 + t) * 256 + h * 64 + k]; bl[t * 64 + k] = run; }
    tot[seg * 64 + k] = run;
    {
        const int s = lt >> 2, c0 = (lt & 3) * 16;
        const u32x4 w0 = *(const u32x4*)(HI + (row0 + s) * 256 + h * 64 + c0), w1 = *(const u32x4*)(HI + (row0 + s) * 256 + h * 64 + c0 + 8);
        const unsigned ww[8] = {w0.x, w0.y, w0.z, w0.w, w1.x, w1.y, w1.z, w1.w};
#pragma unroll
        for (int e = 0; e < 8; ++e) { vt[(c0 + 2 * e) * HG_VP + s] = (bf16_t)(ww[e] & 0xffffu); vt[(c0 + 2 * e + 1) * HG_VP + s] = (bf16_t)(ww[e] >> 16); }
    }
    __syncthreads();
    if (lt < 64) { float p = 0.f;
#pragma unroll
        for (int sg = 0; sg < 4; ++sg) { pre[sg * 64 + lt] = p; p += tot[sg * 64 + lt]; }
        pre[4 * 64 + lt] = p; }
    __syncthreads();
}

__device__ __forceinline__ void hgrn_a_item(int item, unsigned char* P, float* DD, LAS unsigned char* L) {
    int tid_ = threadIdx.x; asm volatile("" : "+v"(tid_)); const int tid = tid_, lane = tid & 63, wq = (tid >> 6) & 3, cs = tid >> 8, r = lane & 15, g = lane >> 4;
    const int bh = item >> 5, chunk = (item & 31) * 2 + cs, b = bh >> 2, h = bh & 3;
    const size_t row0 = (size_t)b * SEQ + chunk * 64;
    const bf16_t* HK = (const bf16_t*)(P + P_HK); float* UT = (float*)(P + P_US);
    LAS unsigned char* sb = L + cs * HG_SLOT;
    const int k = 16 * wq + r;
    unsigned short kraw[2][8];
#pragma unroll
    for (int ks = 0; ks < 2; ++ks)
#pragma unroll
        for (int j = 0; j < 8; ++j) kraw[ks][j] = HK[(row0 + 32 * ks + 8 * g + j) * 256 + h * 64 + k];
    hg_stage(tid, row0, h, (const float*)(P + P_HLF), (const bf16_t*)(P + P_HI), sb);
    const LAS float* bl = (const LAS float*)sb; const LAS float* pre = (const LAS float*)(sb + HG_PRE); const LAS unsigned char* vt = sb + HG_VT;
    const float pre4 = pre[4 * 64 + k];
    hbf16x8 af[2];
#pragma unroll
    for (int ks = 0; ks < 2; ++ks) { const float pj = pre4 - pre[(2 * ks + (g >> 1)) * 64 + k]; float x[8];
#pragma unroll
        for (int j = 0; j < 8; ++j) { const int s = 32 * ks + 8 * g + j; x[j] = bf2f(kraw[ks][j]) * __expf(pj - bl[s * 64 + k]); }
        af[ks] = pack8(x); }
    float* ut = UT + ((size_t)(bh * 64 + chunk) * 64) * 64;
#pragma unroll
    for (int vtile = 0; vtile < 4; ++vtile) { f32x4 acc = {0.f, 0.f, 0.f, 0.f};
#pragma unroll
        for (int ks = 0; ks < 2; ++ks) { const hbf16x8 bf = *(const LAS hbf16x8*)(vt + (16 * vtile + r) * (HG_VP * 2) + (32 * ks + 8 * g) * 2); acc = __builtin_amdgcn_mfma_f32_16x16x32_bf16(af[ks], bf, acc, 0, 0, 0); }
        *(f32x4*)(ut + (size_t)(16 * vtile + r) * 64 + 16 * wq + 4 * g) = acc; }
    if (g == 0) DD[(size_t)(bh * 64 + chunk) * 64 + k] = __expf(pre4);
}

__device__ __forceinline__ void hgrn_b_scan(int bx, int G, unsigned char* P, const float* DD) {
    int tid_ = threadIdx.x; asm volatile("" : "+v"(tid_));
    float* UT = (float*)(P + P_US);
    for (int gid = bx * 512 + tid_; gid < 32 * 4096; gid += G * 512) {
        const int bh = gid >> 12, e = gid & 4095; float* u = UT + (size_t)bh * 64 * 4096 + e; const float* dd = DD + (size_t)bh * 64 * 64 + (e & 63);
        float S = 0.f;
        for (int c0 = 0; c0 < 64; c0 += 8) { float tu[8], td[8];
#pragma unroll
            for (int i = 0; i < 8; ++i) { tu[i] = u[(size_t)(c0 + i) * 4096]; td[i] = dd[(c0 + i) * 64]; }
#pragma unroll
            for (int i = 0; i < 8; ++i) { u[(size_t)(c0 + i) * 4096] = S; S = td[i] * S + tu[i]; } }
    }
}

__device__ __forceinline__ void hgrn_c_item(int item, unsigned char* P, bf16_t* MIX, const float* hgn, LAS unsigned char* L) {
    int tid_ = threadIdx.x; asm volatile("" : "+v"(tid_)); const int tid = tid_, lane = tid & 63, I = (tid >> 6) & 3, cs = tid >> 8, r = lane & 15, g = lane >> 4;
    const int bh = item >> 5, chunk = (item & 31) * 2 + cs, b = bh >> 2, h = bh & 3;
    const size_t row0 = (size_t)b * SEQ + chunk * 64;
    const bf16_t* HQ = (const bf16_t*)(P + P_HQ); const bf16_t* HK = (const bf16_t*)(P + P_HK); const bf16_t* HG = (const bf16_t*)(P + P_HG); const float* ST = (const float*)(P + P_US);
    LAS unsigned char* sb = L + cs * HG_SLOT;
    const int t = 16 * I + r;
    u32x4 qraw[2], kraw[4][2]; f32x4 sraw[4][2][2]; unsigned short graw[4][4];
    const float* st = ST + ((size_t)(bh * 64 + chunk) * 64) * 64;
#pragma unroll
    for (int ks = 0; ks < 2; ++ks) { qraw[ks] = *(const u32x4*)(HQ + (row0 + t) * 256 + h * 64 + 32 * ks + 8 * g);
#pragma unroll
        for (int J = 0; J < 4; ++J) kraw[J][ks] = *(const u32x4*)(HK + (row0 + 16 * J + r) * 256 + h * 64 + 32 * ks + 8 * g);
#pragma unroll
        for (int vtile = 0; vtile < 4; ++vtile) { const float* sp = st + (size_t)(16 * vtile + r) * 64 + 32 * ks + 8 * g; sraw[vtile][ks][0] = *(const f32x4*)sp; sraw[vtile][ks][1] = *(const f32x4*)(sp + 4); } }
#pragma unroll
    for (int i = 0; i < 4; ++i)
#pragma unroll
        for (int vtile = 0; vtile < 4; ++vtile) graw[i][vtile] = HG[(row0 + 16 * I + 4 * g + i) * 256 + h * 64 + 16 * vtile + r];
    hg_stage(tid, row0, h, (const float*)(P + P_HLF), (const bf16_t*)(P + P_HI), sb);
    const LAS float* bl = (const LAS float*)sb; const LAS float* pre = (const LAS float*)(sb + HG_PRE); const LAS unsigned char* vt = sb + HG_VT;
    hbf16x8 qtf[2], qhf[2];
#pragma unroll
    for (int ks = 0; ks < 2; ++ks) { const int kb = 32 * ks + 8 * g; float q[8], xt[8], xh[8];
        unpack8(qraw[ks], q);
#pragma unroll
        for (int j = 0; j < 8; ++j) { xt[j] = q[j] * __expf(bl[t * 64 + kb + j]); xh[j] = xt[j] * __expf(pre[I * 64 + kb + j]); }
        qtf[ks] = pack8(xt); qhf[ks] = pack8(xh); }
    f32x4 at[4];
#pragma unroll
    for (int J = 0; J < 4; ++J) { at[J] = (f32x4){0.f, 0.f, 0.f, 0.f};
        if (J <= I) { const int s = 16 * J + r;
#pragma unroll
            for (int ks = 0; ks < 2; ++ks) { const int kb = 32 * ks + 8 * g; float kk[8], x[8];
                unpack8(kraw[J][ks], kk);
#pragma unroll
                for (int j = 0; j < 8; ++j) x[j] = kk[j] * __expf(fminf(pre[I * 64 + kb + j] - pre[J * 64 + kb + j] - bl[s * 64 + kb + j], 80.f));
                at[J] = __builtin_amdgcn_mfma_f32_16x16x32_bf16(pack8(x), qtf[ks], at[J], 0, 0, 0); }
            if (J == I) {
#pragma unroll
                for (int i = 0; i < 4; ++i) at[J][i] = (4 * g + i <= r) ? at[J][i] : 0.f; } } }
    hbf16x8 pf[2];
#pragma unroll
    for (int k2 = 0; k2 < 2; ++k2) { const float x[8] = {at[2 * k2][0], at[2 * k2][1], at[2 * k2][2], at[2 * k2][3], at[2 * k2 + 1][0], at[2 * k2 + 1][1], at[2 * k2 + 1][2], at[2 * k2 + 1][3]}; pf[k2] = pack8(x); }
    f32x4 o[4];
#pragma unroll
    for (int vtile = 0; vtile < 4; ++vtile) { f32x4 acc = {0.f, 0.f, 0.f, 0.f}; const int v = 16 * vtile + r;
#pragma unroll
        for (int ks = 0; ks < 2; ++ks) { const f32x4 s0 = sraw[vtile][ks][0], s1 = sraw[vtile][ks][1];
            const float x[8] = {s0[0], s0[1], s0[2], s0[3], s1[0], s1[1], s1[2], s1[3]};
            acc = __builtin_amdgcn_mfma_f32_16x16x32_bf16(qhf[ks], pack8(x), acc, 0, 0, 0); }
#pragma unroll
        for (int k2 = 0; k2 < 2; ++k2) { if (k2 == 0 || I >= 2) {
            const hbf16x4 v0 = *(const LAS hbf16x4*)(vt + v * (HG_VP * 2) + (32 * k2 + 4 * g) * 2), v1 = *(const LAS hbf16x4*)(vt + v * (HG_VP * 2) + (32 * k2 + 16 + 4 * g) * 2);
            const hbf16x8 vf = {v0[0], v0[1], v0[2], v0[3], v1[0], v1[1], v1[2], v1[3]};
            acc = __builtin_amdgcn_mfma_f32_16x16x32_bf16(pf[k2], vf, acc, 0, 0, 0); } }
        o[vtile] = acc; }
#pragma unroll
    for (int i = 0; i < 4; ++i) { float sq = 0.f;
#pragma unroll
        for (int vtile = 0; vtile < 4; ++vtile) sq += o[vtile][i] * o[vtile][i];
        sq += __shfl_xor(sq, 1); sq += __shfl_xor(sq, 2); sq += __shfl_xor(sq, 4); sq += __shfl_xor(sq, 8);
        const float rn = rsqrtf(sq * (1.0f / 64.0f) + EPS); const size_t row = row0 + 16 * I + 4 * g + i;
#pragma unroll
        for (int vtile = 0; vtile < 4; ++vtile) { const int v = 16 * vtile + r; const float gg = bf2f(graw[i][vtile]);
            MIX[row * DM + h * 64 + v] = (bf16_t)f2bf(o[vtile][i] * rn * hgn[v] * (gg / (1.0f + __expf(-gg)))); } }
}

struct Args { const float* in[14]; float* out; unsigned char* ws; int ph_lo, ph_hi; };
constexpr int NPHASE = 1 + 7 * DEPTH;

__global__ void __launch_bounds__(512, 2) fwd(Args a) {
    extern __shared__ __attribute__((aligned(16))) unsigned char lds[];
    cg::grid_group grid = cg::this_grid();
    LAS unsigned char* L = (LAS unsigned char*)lds;
    if (threadIdx.x < 32) ((LAS unsigned*)(L + LDS_BYTES - 128))[threadIdx.x] = 0u;
    __syncthreads();
    for (int ph = a.ph_lo; ph < a.ph_hi; ++ph) {
        int G = gridDim.x, bx = blockIdx.x; asm volatile("" : "+s"(G), "+s"(bx));
        typedef const __attribute__((address_space(4))) Args* KArgP;
        KArgP ap = (KArgP)__builtin_amdgcn_kernarg_segment_ptr(); asm volatile("" : "+s"(ap));
        unsigned char* ws = ap->ws;
        float* SS = (float*)(ws + WS_SS); float* LB = (float*)(ws + WS_LB);
        bf16_t* XB = (bf16_t*)(ws + WS_XB); bf16_t* MIX = (bf16_t*)(ws + WS_MIX); bf16_t* UB = (bf16_t*)(ws + WS_U);
        unsigned char* P = ws + WS_P;
#ifdef PROBE_T
        if (ph == NPHASE) {
            if (bx == 0) { const unsigned long long* ts_ = (const unsigned long long*)(ws + 65536); unsigned long long sa = 0, sb = 0;
                for (int p = 1; p < NPHASE; ++p) { const int kk_ = (p - 1) % 7; const unsigned long long d = ts_[p] - ts_[p - 1]; if (PROBE_A(kk_)) sa += d; if (PROBE_B(kk_)) sb += d; }
                const float fa = (float)sa * 1e-3f, fb = (float)sb * 1e-3f; float* o_ = ap->out;
                for (int i = threadIdx.x; i < (1 << 20); i += 512) o_[(1 << 20) + i] += fb;
                if (threadIdx.x == 0) o_[0] = fa; }
        } else
#endif
        if (ph == 0) {
            int tid = threadIdx.x; asm volatile("" : "+v"(tid)); const int lane = tid & 63, wave = __builtin_amdgcn_readfirstlane(tid >> 6);
            LAS float* scr = (LAS float*)(L + wave * 16384);
            const int gw = bx * 8 + wave, NGW = G * 8;
            constexpr int I_IN = 16 * 112, I_OUT = 16 * 32, I_1 = 16 * 128, I_2 = 64 * 32, I_L = I_IN + I_OUT + I_1 + I_2;
            for (int it = gw; it < DEPTH * I_L; it += NGW) {
                const int l = it / I_L; int r = it % I_L;
                unsigned char* wl = ws + WS_W + (size_t)l * W_LAYER;
                if (r < I_IN) { const int kb = r / 112, nb = r % 112, n0 = nb * 32, pn = n0 >> 8, p = n0 & 255, slot = 4 * pn + ((p & 127) >> 5), sc0 = 64 * slot + 32 * (p >> 7);
                    tr_item(ap->in[3] + (size_t)l * DM * INC, INC, INC, sc0, kb * 64, ap->in[2] + l * DM, (bf16_t*)wl, DM, n0, scr, lane); continue; }
                r -= I_IN;
                if (r < I_OUT) { const int kb = r / 32, nb = r % 32; tr_item(ap->in[10] + (size_t)l * DM * DM, DM, DM, nb * 32, kb * 64, nullptr, (bf16_t*)(wl + W_OUT), DM, nb * 32, scr, lane); continue; }
                r -= I_OUT;
                if (r < I_1) { const int kb = r / 128, nb = r % 128; tr_item(ap->in[12] + (size_t)l * DM * DFF, DFF, DFF, nb * 32, kb * 64, ap->in[11] + l * DM, (bf16_t*)(wl + W_1), DM, nb * 32, scr, lane); continue; }
                r -= I_1;
                { const int kb = r / 32, nb = r % 32; tr_item(ap->in[13] + (size_t)l * DFF * DM, DM, DM, nb * 32, kb * 64, nullptr, (bf16_t*)(wl + W_2), DFF, nb * 32, scr, lane); }
            }
            const float* x = ap->in[0];
            for (int m = gw; m < M; m += NGW) {
                const f32x4* xr = (const f32x4*)(x + (size_t)m * DM) + lane; f32x4 v[4]; float s = 0.f;
#pragma unroll
                for (int j = 0; j < 4; ++j) { v[j] = xr[64 * j]; s += (v[j][0] * v[j][0] + v[j][1] * v[j][1]) + (v[j][2] * v[j][2] + v[j][3] * v[j][3]); }
                const float tot = wave_sum(s);
                u32x2* o8 = (u32x2*)(XB + (size_t)m * DM) + lane;
#pragma unroll
                for (int j = 0; j < 4; ++j) { u32x2 w; w.x = pk2(v[j][0], v[j][1]); w.y = pk2(v[j][2], v[j][3]); o8[64 * j] = w; }
                if (lane < 16) SS[(size_t)m * 16 + lane] = (lane == 0) ? tot : 0.f;
            }
            if (bx == 2 && tid < 64) ((unsigned*)ws)[tid] = 0u;
            if (bx == 3) for (int i = tid; i < XCD_BAR_WORDS; i += 512) ((unsigned*)(ws + WS_BAR))[i] = 0u;
            if (bx == 1) {
                for (int i = tid; i < 1024; i += 512) { const int l = i >> 8, wh = (i >> 6) & 3, d = i & 63; LB[2048 + i] = ap->in[5 + wh][l * 64 + d]; }
                if (tid < 32) { const int l = tid >> 3, e = tid & 7; LB[3072 + tid] = (e < 6) ? ap->in[9][l * 6 + e] : 0.f; }
            }
            if (bx == 0 && tid < 256) {
                const float* lg = ap->in[1]; float e[DEPTH]; float mx = -1e30f, sum = 0.f;
#pragma unroll
                for (int l = 0; l < DEPTH; ++l) mx = fmaxf(mx, lg[l * 256 + tid]);
#pragma unroll
                for (int l = 0; l < DEPTH; ++l) { e[l] = expf(lg[l * 256 + tid] - mx); sum += e[l]; }
                float c = 0.f;
#pragma unroll
                for (int l = 0; l < DEPTH; ++l) { if (l > 0) c += e[l] / sum; LB[l * 512 + tid] = logf(fmaxf(c, 1e-30f)); LB[l * 512 + 256 + tid] = 1.0f - c; }
            }
        } else {
            const int l = (ph - 1) / 7, k = (ph - 1) % 7;
#ifdef REP_K
            const int nrep = (k == REP_K) ? 2 : 1;
#else
            const int nrep = 1;
#endif
            for (int rep = 0; rep < nrep; ++rep) {
            if (rep) { XcdBarrier xb_; xb_.bar = (unsigned*)(ws + WS_BAR); xb_.x = xb_xcc_id(); xb_.st = (volatile LAS unsigned*)(L + LDS_BYTES - 128); xcd_barrier(xb_); }
            unsigned char* wl = ws + WS_W + (size_t)l * W_LAYER;
            if (k == 0) {
                pg8::Gemm g{XB, (const bf16_t*)wl, M, NIN, DM}; pg8::StaticOrder S; S.init(M, NIN, G, bx);
                EpiInProj E{SS, P, LB + l * 512, LB + 2048 + l * 256, LB + 3072 + l * 8};
                pg8::gemm_phase<EpiInProj, pg8::StaticOrder, true, true>(L, g, S, E);
            } else if (k == 1) {
                int tid = threadIdx.x; asm volatile("" : "+v"(tid));
                unsigned* ctr = (unsigned*)ws + l * 16 + 1 + rep * 4;
                volatile LAS int* sh = (volatile LAS int*)(L + LDS_BYTES - 64);
                int nxt = 0; if (tid == 0) nxt = (int)atomicAdd(ctr, 1u);
                for (;;) {
                    if (tid == 0) sh[0] = nxt;
                    __syncthreads();
                    const int idx = __builtin_amdgcn_readfirstlane(sh[0]);
                    __syncthreads();
                    if (idx >= 816 + 1024) break;
                    if (tid == 0) nxt = (int)atomicAdd(ctr, 1u);
                    if (idx < 768) { const int qb = 15 - idx / 48, bh = idx % 48, b = bh / 6, h = bh % 6; typedef attn_body::bf16 abf;
                        attn_body::sb_unit(qb, (const abf*)(P + P_SQ) + (size_t)bh * SEQ * 64, (const abf*)(P + P_SQ + HEADBUF) + (size_t)bh * SEQ * 64, (const abf*)(P + P_SQ + 2 * HEADBUF) + (size_t)bh * SEQ * 64,
                                           (abf*)MIX + (size_t)b * SEQ * DM + 256 + h * 64, (char*)lds); }
                    else if (idx < 816) fox_cumsum_item(idx - 768, (const float*)(P + P_LF), (float*)(P + P_CC), (int*)(ws + WS_JS), LB + 2048 + l * 256 + 128, LB + 2048 + l * 256 + 192, (LAS float*)L);
                    else hgrn_a_item(idx - 816, P, (float*)(ws + WS_DD), L);
                    __syncthreads();
                }
            } else if (k == 2) {
                hgrn_b_scan(bx, G, P, (const float*)(ws + WS_DD));
            } else if (k == 3) {
                int tid = threadIdx.x; asm volatile("" : "+v"(tid));
                unsigned* ctr = (unsigned*)ws + l * 16 + rep * 4;
                volatile LAS int* sh = (volatile LAS int*)(L + LDS_BYTES - 64);
                int nxt = 0; if (tid == 0) nxt = (int)atomicAdd(ctr, 1u);
                for (;;) {
                    if (tid == 0) sh[0] = nxt;
                    __syncthreads();
                    const int idx = __builtin_amdgcn_readfirstlane(sh[0]);
                    __syncthreads();
                    if (idx >= 768 + 1024) break;
                    if (tid == 0) nxt = (int)atomicAdd(ctr, 1u);
                    if (idx >= 768) { hgrn_c_item(idx - 768, P, MIX, ap->in[4] + l * 64, L); __syncthreads(); continue; }
                    const int qb = 15 - idx / 48, bh = idx % 48, b = bh / 6, h = bh % 6;
                    typedef attn_body::bf16 abf;
                    const int jstart = ((const int*)(ws + WS_JS))[bh * 16 + qb];
                    attn_body::attn_unit<30>(qb, jstart, (const abf*)(P + P_FQ) + (size_t)bh * SEQ * 64, (const abf*)(P + P_FQ + HEADBUF) + (size_t)bh * SEQ * 64, (const abf*)(P + P_FQ + 2 * HEADBUF) + (size_t)bh * SEQ * 64,
                                            (abf*)MIX + (size_t)b * SEQ * DM + 640 + h * 64, (const float*)(P + P_CC) + (size_t)bh * SEQ, (char*)lds);
                }
            } else if (k == 5) {
                pg8::Gemm g{XB, (const bf16_t*)(wl + W_1), M, DFF, DM}; pg8::StaticOrder S; S.init(M, DFF, G, bx);
                EpiRelu2 E{UB, SS};
                pg8::gemm_phase<EpiRelu2, pg8::StaticOrder, true, true>(L, g, S, E);
            } else {
                const bool ff2 = (k == 6);
                pg8::Gemm g{ff2 ? UB : MIX, (const bf16_t*)(wl + (ff2 ? W_2 : W_OUT)), M, DM, ff2 ? DFF : DM}; pg8::StaticOrder S; S.init(M, DM, G, bx);
                EpiResid E{XB, (ff2 && l == DEPTH - 1) ? ap->out : nullptr, SS};
                pg8::gemm_phase<EpiResid, pg8::StaticOrder, true, true>(L, g, S, E);
            }
            }
        }
#ifdef PROBE_T
        if (bx == 0 && threadIdx.x == 0) ((unsigned long long*)(ws + 65536))[ph] = __builtin_amdgcn_s_memrealtime();
#endif
        if (ph + 1 < a.ph_hi) {
            if (ph == 0) {
                grid.sync();
                (void)xcd_barrier_post((unsigned*)(ws + WS_BAR), (volatile LAS unsigned*)(L + LDS_BYTES - 128));
            } else {
                XcdBarrier xb_; xb_.bar = (unsigned*)(ws + WS_BAR); xb_.x = xb_xcc_id(); xb_.st = (volatile LAS unsigned*)(L + LDS_BYTES - 128);
                xcd_barrier(xb_);
            }
        }
    }
}

#ifndef MK_MULTI
#define MK_MULTI 0
#endif
extern "C" void kernel_launch(void* const* d_in, const int* in_sizes, int n_in, void* d_out, int out_size, void* d_ws, size_t ws_size, hipStream_t stream) {
    static int grid = 0;
    if (grid == 0) {
        int dev = 0, cus = 0, per = 0;
        if (n_in != 14 || out_size != M * DM || ws_size < WS_END) { fprintf(stderr, "kernel_launch: unexpected shapes (n_in %d out %d ws %zu)\n", n_in, out_size, ws_size); grid = -1; return; }
        (void)hipGetDevice(&dev); (void)hipDeviceGetAttribute(&cus, hipDeviceAttributeMultiprocessorCount, dev);
        (void)hipFuncSetAttribute((const void*)fwd, hipFuncAttributeMaxDynamicSharedMemorySize, LDS_BYTES);
        (void)hipOccupancyMaxActiveBlocksPerMultiprocessor(&per, (const void*)fwd, 512, LDS_BYTES);
        if (per < 1) per = 1;
        grid = cus * per;
        fprintf(stderr, "kernel_launch: grid %d (cus %d x %d)\n", grid, cus, per);
    }
    if (grid < 0) return;
    Args a{};
    for (int i = 0; i < 14; ++i) a.in[i] = (const float*)d_in[i];
    a.out = (float*)d_out; a.ws = (unsigned char*)d_ws;
#if MK_MULTI
    for (int ph = 0; ph < NPHASE; ++ph) { a.ph_lo = ph; a.ph_hi = ph + 1; hipLaunchKernelGGL(fwd, dim3(grid), dim3(512), LDS_BYTES, stream, a); }
#else
#ifdef PROBE_T
    a.ph_lo = 0; a.ph_hi = NPHASE + 1;
#else
    a.ph_lo = 0; a.ph_hi = NPHASE;
#endif
    void* args[] = {&a};
    hipError_t e = hipLaunchCooperativeKernel((const void*)fwd, dim3(grid), dim3(512), args, LDS_BYTES, stream);
    if (e != hipSuccess) fprintf(stderr, "kernel_launch: cooperative launch failed: %s (grid %d)\n", hipGetErrorString(e), grid);
#endif
}
```

```cpp
#include <hip/hip_runtime.h>
#include <hip/hip_cooperative_groups.h>
#include <cstdio>
#include <cstdint>
namespace cg = cooperative_groups;
namespace pg8 {
#define PG8_LAS __attribute__((address_space(3)))
typedef unsigned short bf16_t;
typedef short bf16x8 __attribute__((ext_vector_type(8)));
typedef float f32x4 __attribute__((ext_vector_type(4)));
typedef unsigned u32x4 __attribute__((ext_vector_type(4)));
constexpr int BM = 256, BK = 64, HALF = 128, HTB = HALF * BK * 2  , STAGE_BYTES = 8 * HTB, NXCD = 8, WGM = 8;

__host__ __device__ __forceinline__ int lds_byte(int r, int c) { const int st = (r >> 4) * 2 + (c >> 5), rr = r & 15, cc = c & 31, ob = rr * 64 + cc * 2; return st * 1024 + (ob ^ (((ob >> 9) & 1) << 5)); }
__host__ __device__ __forceinline__ void stage_rc(int b, int& R, int& C) { const int st = b / 1024, sb = b % 1024, swz = sb ^ (((sb >> 9) & 1) << 5); R = (st >> 1) * 16 + swz / 64; C = (st & 1) * 32 + (swz % 64) / 2; }
__host__ __device__ __forceinline__ int perm32(int rho) { const int n = rho >> 4, i = rho & 15; return 8 * (i >> 2) + 4 * n + (i & 3); }

struct Unit { int pm, pn; };
struct Gemm { const bf16_t* A; const bf16_t* Bt; int M, N, K; };

struct StaticOrder {
    int nM, nN, nwg, G, c;
    __host__ __device__ void init(int M, int N, int G_, int c_) { nM = M / BM; nN = N / BM; nwg = nM * nN; G = G_; c = c_; }
    __host__ __device__ bool next(int i, Unit& u) const {
        const long L = (long)i * G + c; if (L >= nwg) return false;
        int wgid = (int)L; { const int q = nwg / NXCD, r = nwg % NXCD, xcd = wgid % NXCD, off = wgid / NXCD; wgid = (xcd < r ? xcd * (q + 1) : r * (q + 1) + (xcd - r) * q) + off; }
        const int nig = WGM * nN, gid = wgid / nig, fm = gid * WGM, gsz = (nM - fm) < WGM ? (nM - fm) : WGM;
        u.pm = fm + ((wgid % nig) % gsz); u.pn = (wgid % nig) / gsz; return true;
    }
    __device__ __forceinline__ void a_ready(const Unit&) const {}
    __device__ __forceinline__ void done(const Unit&) const {}
};

__device__ __forceinline__ unsigned cvt_pk_bf16(float lo, float hi) { unsigned r; asm volatile("v_cvt_pk_bf16_f32 %0, %1, %2" : "=v"(r) : "v"(lo), "v"(hi)); return r; }
typedef float f32x2 __attribute__((ext_vector_type(2)));
template <class Epi, class Sched, bool ALIGN_EPI = false, bool SP2 = false>
__device__ __forceinline__ void gemm_phase(PG8_LAS unsigned char* lds, const Gemm g, const Sched& S, const Epi& E) {
    int tid_ = threadIdx.x; asm volatile("" : "+v"(tid_));
    const int tid = tid_, wid = __builtin_amdgcn_readfirstlane(tid >> 6), lane = tid & 63, wr = wid >> 2, wc = wid & 3, fr = lane & 15, fq = lane >> 4;
    const int K = g.K, nt = K / BK;
    unsigned voffA[2], voffB[2];
#pragma unroll
    for (int i = 0; i < 2; ++i) { int R, C; stage_rc(tid * 16 + i * 8192, R, C); const int Rb = Epi::PERM ? ((R & ~31) + perm32(R & 31)) : R;
        voffA[i] = (unsigned)(R * K + C) * 2u; voffB[i] = (unsigned)(Rb * K + C) * 2u; }
    const size_t kstep = (size_t)(BK * 2);
    const size_t hstep = (size_t)HALF * K * 2;
    const size_t tstep = 2 * hstep;
    const unsigned ldsw = (unsigned)wid * 1024u;
    const int aoff = lds_byte(wr * 64 + fr, fq * 8), boff = lds_byte(wc * 32 + fr, fq * 8);
#define PG8_SA(b, h) (((b) * 2 + (h)) * HTB)
#define PG8_SB(b, h) ((4 + (b) * 2 + (h)) * HTB)
#define PG8_STAGE(bufoff, gbase, voff) do { _Pragma("unroll") for (int _i = 0; _i < 2; ++_i) \
        __builtin_amdgcn_global_load_lds((const unsigned*)((const char*)(gbase) + (voff)[_i]), (PG8_LAS unsigned*)(lds + (bufoff) + ldsw + _i * 8192), 16, 0, 0); } while (0)
#define PG8_LDA(dst, b, h) do { _Pragma("unroll") for (int m = 0; m < 4; ++m) _Pragma("unroll") for (int k = 0; k < 2; ++k) dst[m][k] = *(const PG8_LAS bf16x8*)(lds + PG8_SA(b, h) + aoff + m * 2048 + k * 1024); } while (0)
#define PG8_LDB(dst, b, h) do { _Pragma("unroll") for (int n = 0; n < 2; ++n) _Pragma("unroll") for (int k = 0; k < 2; ++k) dst[n][k] = *(const PG8_LAS bf16x8*)(lds + PG8_SB(b, h) + boff + n * 2048 + k * 1024); } while (0)
#define PG8_MMA(ai, bj, At, Bt) do { __builtin_amdgcn_s_setprio(1); _Pragma("unroll") for (int m = 0; m < 4; ++m) _Pragma("unroll") for (int n = 0; n < 2; ++n) _Pragma("unroll") for (int k = 0; k < 2; ++k) \
        acc[ai][bj][m][n] = __builtin_amdgcn_mfma_f32_16x16x32_bf16(Bt[n][k], At[m][k], acc[ai][bj][m][n], 0, 0, 0); __builtin_amdgcn_s_setprio(0); } while (0)
#define PG8_WAIT_V(n) asm volatile("s_waitcnt vmcnt(" #n ")" ::: "memory")
#define PG8_WAIT_L(n) asm volatile("s_waitcnt lgkmcnt(" #n ")" ::: "memory")
#define PG8_BAR __builtin_amdgcn_s_barrier()
#define PG8_SCHED __builtin_amdgcn_sched_barrier(0)
    Unit cur, nxt; int ui = 0;
    if (!S.next(0, cur)) return;
    f32x4 acc[2][2][4][2];
#pragma unroll
    for (int a = 0; a < 2; ++a)
#pragma unroll
        for (int b = 0; b < 2; ++b)
#pragma unroll
            for (int m = 0; m < 4; ++m)
#pragma unroll
                for (int n = 0; n < 2; ++n) acc[a][b][m][n] = (f32x4){0.f, 0.f, 0.f, 0.f};
    bf16x8 At[4][2], B0[2][2], B1[2][2];
    const char* cA = (const char*)g.A + (size_t)cur.pm * tstep; const char* cB = (const char*)g.Bt + (size_t)cur.pn * tstep;
    S.a_ready(cur);
    if constexpr (SP2) {
        PG8_STAGE(PG8_SB(0, 0), cB, voffB); PG8_STAGE(PG8_SB(0, 1), cB + hstep, voffB); PG8_STAGE(PG8_SA(0, 0), cA, voffA); PG8_STAGE(PG8_SA(0, 1), cA + hstep, voffA);
        if (wr == 1) PG8_BAR;
        PG8_WAIT_V(2); PG8_BAR;
        PG8_STAGE(PG8_SB(1, 0), cB + kstep, voffB); PG8_STAGE(PG8_SA(1, 0), cA + kstep, voffA); PG8_STAGE(PG8_SB(1, 1), cB + hstep + kstep, voffB);
        PG8_WAIT_V(6); PG8_BAR;
    } else {
        PG8_STAGE(PG8_SB(0, 0), cB, voffB); PG8_STAGE(PG8_SA(0, 0), cA, voffA); PG8_STAGE(PG8_SB(0, 1), cB + hstep, voffB); PG8_STAGE(PG8_SA(0, 1), cA + hstep, voffA);
        if (wr == 1) PG8_BAR;
        PG8_WAIT_V(4); PG8_BAR;
        PG8_STAGE(PG8_SB(1, 0), cB + kstep, voffB); PG8_STAGE(PG8_SA(1, 0), cA + kstep, voffA); PG8_STAGE(PG8_SB(1, 1), cB + hstep + kstep, voffB);
        PG8_WAIT_V(6); PG8_BAR;
    }
    for (;;) {
        const bool has_next = S.next(ui + 1, nxt);
        const char* nA = has_next ? (const char*)g.A + (size_t)nxt.pm * tstep : cA; const char* nB = has_next ? (const char*)g.Bt + (size_t)nxt.pn * tstep : cB;
        for (int t = 0; t < nt; t += 2) {
            const bool last = (t == nt - 2);
            const char* a1 = cA + (size_t)(t + 1) * kstep;
            const char* a2 = last ? nA : cA + (size_t)(t + 2) * kstep; const char* b2 = last ? nB : cB + (size_t)(t + 2) * kstep;
            const char* a3 = a2 + kstep; const char* b3 = b2 + kstep;
            if (last && has_next) S.a_ready(nxt);
            if constexpr (SP2) {
            PG8_LDB(B0, 0, 0); PG8_LDB(B1, 0, 1); PG8_SCHED; PG8_LDA(At, 0, 0); PG8_STAGE(PG8_SA(1, 1), a1 + hstep, voffA);
            PG8_WAIT_V(8); PG8_WAIT_L(0); PG8_BAR; PG8_MMA(0, 0, At, B0); PG8_MMA(0, 1, At, B1); PG8_BAR; PG8_SCHED;
            PG8_LDA(At, 0, 1); PG8_STAGE(PG8_SB(0, 0), b2, voffB); PG8_STAGE(PG8_SB(0, 1), b2 + hstep, voffB); PG8_STAGE(PG8_SA(0, 0), a2, voffA);
            PG8_WAIT_V(8); PG8_WAIT_L(0); PG8_BAR; PG8_MMA(1, 0, At, B0); PG8_MMA(1, 1, At, B1); PG8_BAR; PG8_SCHED;
            PG8_LDB(B0, 1, 0); PG8_LDB(B1, 1, 1); PG8_SCHED; PG8_LDA(At, 1, 0); PG8_STAGE(PG8_SA(0, 1), a2 + hstep, voffA);
            PG8_WAIT_V(8); PG8_WAIT_L(0); PG8_BAR; PG8_MMA(0, 0, At, B0); PG8_MMA(0, 1, At, B1); PG8_BAR; PG8_SCHED;
            PG8_LDA(At, 1, 1); PG8_STAGE(PG8_SB(1, 0), b3, voffB); PG8_STAGE(PG8_SB(1, 1), b3 + hstep, voffB); PG8_STAGE(PG8_SA(1, 0), a3, voffA);
            PG8_WAIT_V(8); PG8_WAIT_L(0); PG8_BAR; PG8_MMA(1, 0, At, B0); PG8_MMA(1, 1, At, B1); PG8_BAR; PG8_SCHED;
            } else {
            PG8_LDB(B0, 0, 0); PG8_SCHED; PG8_LDA(At, 0, 0); PG8_STAGE(PG8_SA(1, 1), a1 + hstep, voffA);
            PG8_WAIT_L(8); PG8_BAR; PG8_WAIT_L(0); PG8_MMA(0, 0, At, B0); PG8_BAR; PG8_SCHED;
            PG8_LDB(B1, 0, 1); PG8_STAGE(PG8_SB(0, 0), b2, voffB);
            PG8_BAR; PG8_WAIT_L(0); PG8_MMA(0, 1, At, B1); PG8_BAR;
            PG8_LDA(At, 0, 1); PG8_STAGE(PG8_SA(0, 0), a2, voffA);
            PG8_BAR; PG8_WAIT_L(0); PG8_MMA(1, 0, At, B0); PG8_BAR; PG8_SCHED;
            PG8_STAGE(PG8_SB(0, 1), b2 + hstep, voffB);
            PG8_WAIT_V(6); PG8_BAR; PG8_MMA(1, 1, At, B1); PG8_BAR;
            PG8_LDB(B0, 1, 0); PG8_SCHED; PG8_LDA(At, 1, 0); PG8_STAGE(PG8_SA(0, 1), a2 + hstep, voffA);
            PG8_WAIT_L(8); PG8_BAR; PG8_WAIT_L(0); PG8_MMA(0, 0, At, B0); PG8_BAR; PG8_SCHED;
            PG8_LDB(B1, 1, 1); PG8_STAGE(PG8_SB(1, 0), b3, voffB);
            PG8_BAR; PG8_WAIT_L(0); PG8_MMA(0, 1, At, B1); PG8_BAR;
            PG8_LDA(At, 1, 1); PG8_STAGE(PG8_SA(1, 0), a3, voffA);
            PG8_BAR; PG8_WAIT_L(0); PG8_MMA(1, 0, At, B0); PG8_BAR; PG8_SCHED;
            PG8_STAGE(PG8_SB(1, 1), b3 + hstep, voffB);
            PG8_WAIT_V(6); PG8_BAR; PG8_MMA(1, 1, At, B1); PG8_BAR;
            }
        }
        if constexpr (ALIGN_EPI) { if (wr == 0) PG8_BAR; }
        if constexpr (!Epi::AFTER_DRAIN) { E(acc, cur, wr, wc, fr, fq); S.done(cur); }
        if (!has_next) break;
#pragma unroll
        for (int a = 0; a < 2; ++a)
#pragma unroll
            for (int b = 0; b < 2; ++b)
#pragma unroll
                for (int m = 0; m < 4; ++m)
#pragma unroll
                    for (int n = 0; n < 2; ++n) acc[a][b][m][n] = (f32x4){0.f, 0.f, 0.f, 0.f};
        cur = nxt; cA = nA; cB = nB; ++ui;
        if constexpr (ALIGN_EPI) { if (wr == 1) PG8_BAR; }
    }
    PG8_WAIT_V(0);
    if constexpr (!ALIGN_EPI) { if (wr == 0) PG8_BAR; }
    PG8_BAR;
    if constexpr (Epi::AFTER_DRAIN) { E.fused(acc, cur, wr, wc, fr, fq, lds, wid, lane); S.done(cur); }
#undef PG8_SA
#undef PG8_SB
#undef PG8_STAGE
#undef PG8_LDA
#undef PG8_LDB
#undef PG8_MMA
#undef PG8_WAIT_V
#undef PG8_WAIT_L
#undef PG8_BAR
#undef PG8_SCHED
}
}
#include <hip/hip_bf16.h>
#include <cmath>
namespace attn_body {
using bf16=__hip_bfloat16;
using bf16x8=__attribute__((ext_vector_type(8)))short;
using s16x4=__attribute__((ext_vector_type(4)))short;
using f32x16=__attribute__((ext_vector_type(16)))float;
using u32x4=__attribute__((ext_vector_type(4)))unsigned;
using f32x4v=__attribute__((ext_vector_type(4)))float;
constexpr int SEQ=4096,D=64,DM=64,OPITCH=1024;
constexpr int LDS_C=98304;
constexpr int NW=8,QBLK=32,QB=QBLK*NW,KVBLK=64,NQB=SEQ/QB;
constexpr int ATTN_UNIT_ROWS=QB;
__device__ __forceinline__ int crow(int r,int hi){return (r&3)+8*(r>>2)+4*hi;}
#define SBAR() __builtin_amdgcn_sched_barrier(0)
__device__ __forceinline__ void cmask(f32x16&p0,f32x16&p1,int jb,int qrel,int hi){
  const float NEG=-INFINITY; int kb=64*jb+4*hi;
  #pragma unroll
  for(int r=0;r<16;++r){int kv=kb+(r&3)+8*(r>>2); if(kv>qrel)p0[r]=NEG; if(kv+32>qrel)p1[r]=NEG;}
}

constexpr int NSLOT=3, SLOTB=8192;
constexpr int LDS_K=0, LDS_V=NSLOT*SLOTB, LDS_WS=2*NSLOT*SLOTB, LDS_OST=LDS_WS+NW*64*4, LDS_BYTES=LDS_OST+NW*4096;
constexpr float C2=0.125f*1.4426950408889634f;
__device__ __forceinline__ void glds16(const void*gsrc,unsigned lds_dst){unsigned keep;
  asm volatile("s_mov_b32 %0, m0\n\ts_mov_b32 m0, %2\n\ts_nop 0\n\tglobal_load_lds_dwordx4 %1, off\n\ts_mov_b32 m0, %0":"=&s"(keep):"v"(gsrc),"s"(lds_dst):"memory");}
__device__ __forceinline__ float max3f(float a,float b,float c){float r;asm("v_max3_f32 %0, %1, %2, %3":"=v"(r):"v"(a),"v"(b),"v"(c));return r;}
__device__ __forceinline__ float max2f(float a,float b){float r;asm("v_max_f32_e32 %0, %1, %2":"=v"(r):"v"(a),"v"(b));return r;}
__device__ __forceinline__ float fadd_s(float a,float b){float r;asm("v_add_f32_e32 %0, %1, %2":"=v"(r):"v"(a),"v"(b));return r;}
__device__ __forceinline__ float fsub_s(float a,float b){float r;asm("v_sub_f32_e32 %0, %1, %2":"=v"(r):"v"(a),"v"(b));return r;}
typedef float f32x2_t __attribute__((ext_vector_type(2))); typedef __bf16 bf16x2_t __attribute__((ext_vector_type(2)));
__device__ __forceinline__ unsigned cvtpk_s(float lo,float hi){f32x2_t v={lo,hi};bf16x2_t b=__builtin_convertvector(v,bf16x2_t);return __builtin_bit_cast(unsigned,b);}
#define WAIT_BAR(N) asm volatile("s_waitcnt vmcnt(" #N ") lgkmcnt(0)\n\ts_barrier":::"memory")

__device__ __forceinline__ void qkt(f32x16&p0,f32x16&p1,const char*Kslot,const bf16x8*qr,const f32x16&negm,int r32,int hi){
  const char*kb=Kslot+hi*1024+r32*16;
  #pragma unroll
  for(int d0=0;d0<4;++d0){
    const bf16x8 b0=*reinterpret_cast<const bf16x8*>(kb+d0*2048);
    const bf16x8 b1=*reinterpret_cast<const bf16x8*>(kb+d0*2048+512);
    if(d0==0){p0=__builtin_amdgcn_mfma_f32_32x32x16_bf16(b0,qr[0],negm,0,0,0);p1=__builtin_amdgcn_mfma_f32_32x32x16_bf16(b1,qr[0],negm,0,0,0);}
    else{p0=__builtin_amdgcn_mfma_f32_32x32x16_bf16(b0,qr[d0],p0,0,0,0);p1=__builtin_amdgcn_mfma_f32_32x32x16_bf16(b1,qr[d0],p1,0,0,0);}}
}
typedef __attribute__((address_space(3))) const char* lds_cptr;
typedef short v4i16_t __attribute__((ext_vector_type(4)));
__device__ __forceinline__ void kload8(bf16x8*kf,lds_cptr kp){
  kf[0]=*(const __attribute__((address_space(3))) bf16x8*)(kp);      kf[1]=*(const __attribute__((address_space(3))) bf16x8*)(kp+512);
  kf[2]=*(const __attribute__((address_space(3))) bf16x8*)(kp+2048); kf[3]=*(const __attribute__((address_space(3))) bf16x8*)(kp+2560);
  kf[4]=*(const __attribute__((address_space(3))) bf16x8*)(kp+4096); kf[5]=*(const __attribute__((address_space(3))) bf16x8*)(kp+4608);
  kf[6]=*(const __attribute__((address_space(3))) bf16x8*)(kp+6144); kf[7]=*(const __attribute__((address_space(3))) bf16x8*)(kp+6656);
}
__device__ __forceinline__ void kload2(bf16x8*kf,lds_cptr kp,int j){ kf[2*j]=*(const __attribute__((address_space(3))) bf16x8*)(kp+j*2048); kf[2*j+1]=*(const __attribute__((address_space(3))) bf16x8*)(kp+j*2048+512); }
__device__ __forceinline__ s16x4 vtr(lds_cptr p){ return __builtin_bit_cast(s16x4,__builtin_amdgcn_ds_read_tr16_b64_v4i16((__attribute__((address_space(3))) v4i16_t*)p)); }
__device__ __forceinline__ float rowmax(const f32x16&p0,const f32x16&p1){
  float a=max3f(p0[0],p0[1],p1[0]),b=max3f(p0[2],p0[3],p1[1]);a=max3f(a,p1[2],p1[3]);
  #pragma unroll
  for(int r=4;r<16;r+=4){a=max3f(a,p0[r],p0[r+1]);b=max3f(b,p0[r+2],p0[r+3]);a=max3f(a,p1[r],p1[r+1]);b=max3f(b,p1[r+2],p1[r+3]);}
  const float m=max2f(a,b);
  auto rr=__builtin_amdgcn_permlane32_swap(__float_as_uint(m),__float_as_uint(m),false,false);
  return max2f(__uint_as_float(rr[0]),__uint_as_float(rr[1]));
}
__device__ __forceinline__ void pv(f32x16*o,int vb,bf16x8 pa0,bf16x8 pa1,bf16x8 pa2,bf16x8 pa3){
  #pragma unroll
  for(int d0=0;d0<2;++d0){s16x4 lo[4],hi[4];
    #pragma unroll
    for(int ks=0;ks<4;++ks){
      asm volatile("ds_read_b64_tr_b16 %0,%1 offset:%c2":"=&v"(lo[ks]):"v"(vb),"i"(d0*4096+ks*1024):"memory");
      asm volatile("ds_read_b64_tr_b16 %0,%1 offset:%c2":"=&v"(hi[ks]):"v"(vb),"i"(d0*4096+ks*1024+512):"memory");}
    asm volatile("s_waitcnt lgkmcnt(0)":::"memory");SBAR();
    #define PK(k) (bf16x8){lo[k][0],lo[k][1],lo[k][2],lo[k][3],hi[k][0],hi[k][1],hi[k][2],hi[k][3]}
    o[d0]=__builtin_amdgcn_mfma_f32_32x32x16_bf16(pa0,PK(0),o[d0],0,0,0);
    o[d0]=__builtin_amdgcn_mfma_f32_32x32x16_bf16(pa1,PK(1),o[d0],0,0,0);
    o[d0]=__builtin_amdgcn_mfma_f32_32x32x16_bf16(pa2,PK(2),o[d0],0,0,0);
    o[d0]=__builtin_amdgcn_mfma_f32_32x32x16_bf16(pa3,PK(3),o[d0],0,0,0);
    #undef PK
  }
}

#ifndef ATTN_STORE16
#define ATTN_STORE16(p,v) (*(u32x4*)(p)=(v))
#endif
template<int THRL,bool BIASON=true> __device__ __forceinline__ void attn_unit(int qb,int jstart,const bf16*Q,const bf16*__restrict__ K,const bf16*__restrict__ V,bf16*O,const float*__restrict__ Cg,char*shm){
  int tid_=threadIdx.x; asm volatile("":"+v"(tid_)); const int tid=tid_,lane=tid&63,r32=lane&31,hi=lane>>5; const int wid=__builtin_amdgcn_readfirstlane(tid>>6);
  const int q0=qb*QB;
  const bf16*Qw=Q+(long)(q0+wid*QBLK)*DM;
  const bf16*Kh=K+(long)jstart*KVBLK*DM,*Vh=V+(long)jstart*KVBLK*DM;
  const lds_cptr shm3=(lds_cptr)shm;
  const unsigned lds0=(unsigned)(uintptr_t)shm;
  float*wsf=(float*)(shm+LDS_WS)+wid*64;
  const bf16*ksrc=Kh+(long)lane*DM+wid*8;
  const bf16*vsrc=Vh+(long)(16*(wid&3)+(lane>>2))*DM+(wid>>2)*32+(lane&3)*8;
  const unsigned kdst=lds0+LDS_K+wid*1024, vdst=lds0+LDS_V+wid*1024;
  #define DMA_K(t,slot) glds16(ksrc+(long)(t)*KVBLK*DM,(unsigned)__builtin_amdgcn_readfirstlane(kdst+(slot)))
  #define DMA_V(t,slot) glds16(vsrc+(long)(t)*KVBLK*DM,(unsigned)__builtin_amdgcn_readfirstlane(vdst+(slot)))
  const int vb0=(int)(lds0+LDS_V)+((lane>>4)&1)*32+(lane&3)*8+(4*hi+((lane&15)>>2))*64;
  const char*Kbase=shm+LDS_K; bf16x8 kf[8];
  const lds_cptr kp0=shm3+LDS_K+hi*1024+r32*16; const lds_cptr vp0=shm3+LDS_V+((lane>>4)&1)*32+(lane&3)*8+(4*hi+((lane&15)>>2))*64;
  const int NT=(q0+QB)/KVBLK-jstart;
  { typedef __attribute__((address_space(3))) f32x4v lf32x4; lf32x4*cl_=(lf32x4*)(shm3+LDS_C); const f32x4v*cg_=(const f32x4v*)(Cg+jstart*KVBLK); const int n4_=(q0+QB-jstart*KVBLK)>>2;
    f32x4v c0_=f32x4v{},c1_=f32x4v{}; if(tid<n4_)c0_=cg_[tid]; if(tid+NW*64<n4_)c1_=cg_[tid+NW*64]; if(tid<n4_)cl_[tid]=c0_; if(tid+NW*64<n4_)cl_[tid+NW*64]=c1_; }
  DMA_K(0,0);DMA_V(0,0);DMA_K(1,SLOTB);
  bf16x8 qr[4];
  #pragma unroll
  for(int d0=0;d0<4;++d0)qr[d0]=*reinterpret_cast<const bf16x8*>(&Qw[(long)r32*DM+d0*16+hi*8]);
  float mhat=0.f,l_reg=0.f;f32x16 o[2];o[0]=f32x16{};o[1]=f32x16{};
  const int qrel=wid*QBLK+r32;
  #define CMASK(P0,P1,t) do{int jb_=(t)-(NT-4); if(jb_>=0)cmask(P0,P1,jb_,qrel,hi);}while(0)
  typedef __attribute__((address_space(3))) const float* lds_fptr; typedef __attribute__((address_space(3))) const f32x4v* lds_f4ptr;
  const lds_fptr cl0=(lds_fptr)(shm3+LDS_C)+4*hi;
  #define BIAS(P0,P1,t) do{ const lds_fptr cb_=cl0+64*(t); _Pragma("unroll") for(int g_=0;g_<4;++g_){ const f32x4v a_=*(lds_f4ptr)(cb_+8*g_), b_=*(lds_f4ptr)(cb_+32+8*g_); \
      _Pragma("unroll") for(int i_=0;i_<4;++i_){P0[4*g_+i_]-=a_[i_];P1[4*g_+i_]-=b_[i_];} } }while(0)
  #define BIASINIT(C0_,C1_,t) do{ const lds_fptr cb_=cl0+64*(t); const float nm_=-mhat; _Pragma("unroll") for(int g_=0;g_<4;++g_){ f32x4v a_=f32x4v{},b_=f32x4v{}; if(BIASON){a_=*(lds_f4ptr)(cb_+8*g_); b_=*(lds_f4ptr)(cb_+32+8*g_);} \
      _Pragma("unroll") for(int i_=0;i_<4;++i_){C0_[4*g_+i_]=nm_-a_[i_];C1_[4*g_+i_]=nm_-b_[i_];} } }while(0)
  bool resc=false;
  #define START(P0,P1) do{ const float rm=rowmax(P0,P1); resc=false; \
    { const float dl=rm; mhat=fadd_s(mhat,dl); \
      _Pragma("unroll") for(int r=0;r<16;++r){P0[r]=fsub_s(P0[r],dl);P1[r]=fsub_s(P1[r],dl);} \
      } \
    _Pragma("unroll") for(int r=0;r<16;++r)P0[r]=__builtin_amdgcn_exp2f(P0[r]); }while(0)
  #define RESC() do{ if(resc){ asm volatile("s_waitcnt lgkmcnt(0)":::"memory"); \
      _Pragma("unroll") for(int d_=0;d_<2;++d_) _Pragma("unroll") for(int r=0;r<16;++r)o[d_][r]*=wsf[crow(r,hi)]; } }while(0)
  f32x16 pA0,pA1,pB0,pB1;
  int sl_prev=0,sl_cur=0,sl_next=SLOTB;
  #define ROT() do{sl_prev=sl_cur;sl_cur=sl_next;sl_next=(sl_next==(NSLOT-1)*SLOTB)?0:sl_next+SLOTB;}while(0)
  DMA_K(2,2*SLOTB);
  WAIT_BAR(3);
  { const f32x16 zero_=f32x16{}; qkt(pA0,pA1,Kbase,qr,zero_,r32,hi); }asm volatile("s_nop 15\n\ts_nop 7":"+v"(pA0),"+v"(pA1));BIAS(pA0,pA1,0);CMASK(pA0,pA1,0);
  START(pA0,pA1);
  BIASINIT(pB0,pB1,1);
  _Pragma("unroll") for(int r=0;r<16;++r)pA1[r]=__builtin_amdgcn_exp2f(pA1[r]);
  WAIT_BAR(0);
  DMA_K(3,0);DMA_V(1,SLOTB);
  ROT();
  kload8(kf,kp0+sl_cur);
  WAIT_BAR(2);
  s16x4 vlo[8],vhi[8]; u32x4 pw0,pw1,pw2,pw3;
  #define PKW(P,B) cvtpk_s(P[B],P[B+1])
  #define PAF(k) __builtin_bit_cast(bf16x8,pw##k)
  #define VFR(i) (bf16x8){vlo[i][0],vlo[i][1],vlo[i][2],vlo[i][3],vhi[i][0],vhi[i][1],vhi[i][2],vhi[i][3]}
  #define PIN(x) asm volatile("":"+v"(x))
  #define MX3(a,b,c) __builtin_fmaxf(__builtin_fmaxf((a),(b)),(c))
  #define GAPA(MF,A0,A1,A2,A3,W0,W1,PW) do{ MF; sacc+=A0; sacc+=A1; sacc+=A2; sacc+=A3; PIN(sacc); W0; W1; PIN(PW); SBAR(); }while(0)
  #define EX(v) __builtin_amdgcn_exp2f(v)
  #define GAPB(MF,X,B) do{ MF; X[B]=EX(X[B]); X[B+1]=EX(X[B+1]); X[B+2]=EX(X[B+2]); X[B+3]=EX(X[B+3]); PIN(X); SBAR(); }while(0)
  #define VRD(i) do{ vlo[i]=vtr(vp_+(((i)>>2)*4096+((i)&3)*1024)); vhi[i]=vtr(vp_+(((i)>>2)*4096+((i)&3)*1024+512)); }while(0)
  #define KRD(G,j) do{ if(G){ kload2(kf,kp0+sl_next,j); SBAR(); } }while(0)
  #define STEP(C0,C1,P0,P1,t,GK,GV,GL) do{ SBAR(); \
    const lds_cptr vp_=vp0+sl_prev; \
    VRD(0); SBAR(); float sacc=(P0[0]+P0[1]); \
    GAPA(C0=__builtin_amdgcn_mfma_f32_32x32x16_bf16(kf[0],qr[0],C0,0,0,0), P0[2],P0[3],P0[4],P0[5],     pw0[0]=PKW(P0,0), pw0[1]=PKW(P0,2), pw0); \
    VRD(4); SBAR(); GAPA(C1=__builtin_amdgcn_mfma_f32_32x32x16_bf16(kf[1],qr[0],C1,0,0,0), P0[6],P0[7],P0[8],P0[9],     pw0[2]=PKW(P0,4), pw0[3]=PKW(P0,6), pw0); \
    VRD(1); SBAR(); GAPA(C0=__builtin_amdgcn_mfma_f32_32x32x16_bf16(kf[2],qr[1],C0,0,0,0),   P0[10],P0[11],P0[12],P0[13], pw1[0]=PKW(P0,8), pw1[1]=PKW(P0,10), pw1); \
    VRD(5); SBAR(); GAPA(C1=__builtin_amdgcn_mfma_f32_32x32x16_bf16(kf[3],qr[1],C1,0,0,0),   P0[14],P0[15],P1[0],P1[1],   pw1[2]=PKW(P0,12),pw1[3]=PKW(P0,14), pw1); \
    VRD(2); SBAR(); GAPA(C0=__builtin_amdgcn_mfma_f32_32x32x16_bf16(kf[4],qr[2],C0,0,0,0),   P1[2],P1[3],P1[4],P1[5],     pw2[0]=PKW(P1,0), pw2[1]=PKW(P1,2), pw2); \
    VRD(6); SBAR(); GAPA(C1=__builtin_amdgcn_mfma_f32_32x32x16_bf16(kf[5],qr[2],C1,0,0,0),   P1[6],P1[7],P1[8],P1[9],     pw2[2]=PKW(P1,4), pw2[3]=PKW(P1,6), pw2); \
    VRD(3); SBAR(); GAPA(C0=__builtin_amdgcn_mfma_f32_32x32x16_bf16(kf[6],qr[3],C0,0,0,0),   P1[10],P1[11],P1[12],P1[13], pw3[0]=PKW(P1,8), pw3[1]=PKW(P1,10), pw3); \
    VRD(7); SBAR(); GAPA(C1=__builtin_amdgcn_mfma_f32_32x32x16_bf16(kf[7],qr[3],C1,0,0,0),   P1[14],P1[15],0.f,0.f,       pw3[2]=PKW(P1,12),pw3[3]=PKW(P1,14), pw3); \
    l_reg+=sacc; \
    if(GK){DMA_K((t)+3,sl_cur);} if(GV){DMA_V((t)+1,sl_next);} \
    CMASK(C0,C1,t); \
    { float a=MX3(C0[0],C0[1],C1[0]),b=MX3(C0[2],C0[3],C1[1]); a=MX3(a,C1[2],C1[3]); \
      _Pragma("unroll") for(int r=4;r<16;r+=4){a=MX3(a,C0[r],C0[r+1]);b=MX3(b,C0[r+2],C0[r+3]);a=MX3(a,C1[r],C1[r+1]);b=MX3(b,C1[r+2],C1[r+3]);} \
      float rm=__builtin_fmaxf(a,b); { auto rr=__builtin_amdgcn_permlane32_swap(__float_as_uint(rm),__float_as_uint(rm),false,false); rm=__builtin_fmaxf(__uint_as_float(rr[0]),__uint_as_float(rr[1])); } \
      resc=false; \
      if(__builtin_expect(__any(rm>(float)THRL),0)){ const float dl=__builtin_fmaxf(rm+30.f,0.f); mhat+=dl; \
        _Pragma("unroll") for(int r=0;r<16;++r){C0[r]-=dl;C1[r]-=dl;} \
        const float f=__builtin_amdgcn_exp2f(-dl); l_reg*=f; if(hi==0)wsf[r32]=f; resc=true; } } \
    SBAR(); \
    GAPB(o[0]=__builtin_amdgcn_mfma_f32_32x32x16_bf16(PAF(0),VFR(0),o[0],0,0,0), C0,0); \
    GAPB(o[1]=__builtin_amdgcn_mfma_f32_32x32x16_bf16(PAF(0),VFR(4),o[1],0,0,0), C0,4); \
    KRD(GL,0); GAPB(o[0]=__builtin_amdgcn_mfma_f32_32x32x16_bf16(PAF(1),VFR(1),o[0],0,0,0), C0,8); \
    KRD(GL,1); GAPB(o[1]=__builtin_amdgcn_mfma_f32_32x32x16_bf16(PAF(1),VFR(5),o[1],0,0,0), C0,12); \
    KRD(GL,2); GAPB(o[0]=__builtin_amdgcn_mfma_f32_32x32x16_bf16(PAF(2),VFR(2),o[0],0,0,0), C1,0); \
    KRD(GL,3); GAPB(o[1]=__builtin_amdgcn_mfma_f32_32x32x16_bf16(PAF(2),VFR(6),o[1],0,0,0), C1,4); \
    GAPB(o[0]=__builtin_amdgcn_mfma_f32_32x32x16_bf16(PAF(3),VFR(3),o[0],0,0,0), C1,8); \
    GAPB(o[1]=__builtin_amdgcn_mfma_f32_32x32x16_bf16(PAF(3),VFR(7),o[1],0,0,0), C1,12); \
    BIASINIT(P0,P1,(t)+1); SBAR(); \
    }while(0)
  int t=1;
  #undef CMASK
  #define CMASK(P0,P1,t) do{}while(0)
  for(;t+5<NT;t+=2){
    STEP(pB0,pB1,pA0,pA1,t,true,true,true);     WAIT_BAR(2); RESC(); ROT();
    STEP(pA0,pA1,pB0,pB1,t+1,true,true,true);   WAIT_BAR(2); RESC(); ROT();
  }
  #undef CMASK
  #define CMASK(P0,P1,t) do{int jb_=(t)-(NT-4); if(jb_>=0)cmask(P0,P1,jb_,qrel,hi);}while(0)
  #define ENDW(tt) do{ if((tt)+3<NT){WAIT_BAR(2);} else if((tt)+2<NT){WAIT_BAR(1);} else {WAIT_BAR(0);} }while(0)
  for(;t+1<NT;t+=2){
    STEP(pB0,pB1,pA0,pA1,t,(t+3<NT),(t+1<NT),(t+1<NT));       ENDW(t);   RESC(); ROT();
    STEP(pA0,pA1,pB0,pB1,t+1,(t+4<NT),(t+2<NT),(t+2<NT));     ENDW(t+1); RESC(); ROT();
  }
  STEP(pB0,pB1,pA0,pA1,NT-1,false,false,false); RESC();
  { float sacc=pB0[0]+pB0[1]; _Pragma("unroll") for(int r=2;r<16;++r)sacc+=pB0[r]; _Pragma("unroll") for(int r=0;r<16;++r)sacc+=pB1[r]; l_reg+=sacc;
    pw0=(u32x4){PKW(pB0,0),PKW(pB0,2),PKW(pB0,4),PKW(pB0,6)};pw1=(u32x4){PKW(pB0,8),PKW(pB0,10),PKW(pB0,12),PKW(pB0,14)};pw2=(u32x4){PKW(pB1,0),PKW(pB1,2),PKW(pB1,4),PKW(pB1,6)};pw3=(u32x4){PKW(pB1,8),PKW(pB1,10),PKW(pB1,12),PKW(pB1,14)};
    SBAR(); pv(o,vb0+sl_cur,PAF(0),PAF(1),PAF(2),PAF(3)); }
  #undef PKW
  #undef PAF
  #undef VFR
  #undef PIN
  #undef MX3
  #undef GAPA
  #undef GAPB
  #undef EX
  #undef VRD
  #undef KRD
  #undef STEP
  #undef ENDW
  {auto rr=__builtin_amdgcn_permlane32_swap(__float_as_uint(l_reg),__float_as_uint(l_reg),false,false);l_reg=__uint_as_float(rr[0])+__uint_as_float(rr[1]);}
  if(hi==0)wsf[32+r32]=l_reg;asm volatile("s_waitcnt lgkmcnt(0)":::"memory");
  float rli[16];
  #pragma unroll
  for(int r=0;r<16;++r)rli[r]=__builtin_amdgcn_rcpf(wsf[32+crow(r,hi)]);
  bf16*Ow=O+(long)(q0+wid*QBLK)*OPITCH;
  { bf16*stg=(bf16*)(shm+LDS_OST)+wid*2048;
    #pragma unroll
    for(int r=0;r<16;++r){const int orow=crow(r,hi);
      #pragma unroll
      for(int d0=0;d0<2;++d0)stg[orow*64+d0*32+r32]=__float2bfloat16(o[d0][r]*rli[r]);}
    asm volatile("s_waitcnt lgkmcnt(0)":::"memory");
    #pragma unroll
    for(int i=0;i<4;++i){const int row=i*8+(lane>>3),ch=lane&7; const u32x4 v=*(const u32x4*)(stg+row*64+ch*8); ATTN_STORE16(Ow+(long)row*OPITCH+ch*8,v);} }
  asm volatile("s_waitcnt lgkmcnt(0)\n\ts_barrier":::"memory");
  #undef DMA_K
  #undef DMA_V
  #undef CMASK
  #undef BIAS
  #undef BIASINIT
  #undef START
  #undef RESC
  #undef ROT
}
__device__ __forceinline__ void sb_unit(int qb,const bf16*Q,const bf16*__restrict__ K,const bf16*__restrict__ V,bf16*O,char*shm){
  int tid_=threadIdx.x; asm volatile("":"+v"(tid_)); const int tid=tid_,lane=tid&63,r32=lane&31,hi=lane>>5; const int wid=__builtin_amdgcn_readfirstlane(tid>>6);
  const int q0=qb*QB;
  const bf16*Qw=Q+(long)(q0+wid*QBLK)*DM;
  const unsigned lds0=(unsigned)(uintptr_t)shm;
  typedef __attribute__((address_space(3))) int lds_i32; typedef __attribute__((address_space(3))) const u32x4* lds_u4ptr;
  lds_i32*flags=(lds_i32*)((lds_cptr)shm+LDS_WS);
  const bf16*ksrc=K+(long)lane*DM+wid*8;
  const bf16*vsrc=V+(long)(16*(wid&3)+(lane>>2))*DM+(wid>>2)*32+(lane&3)*8;
  const unsigned kdst=lds0+LDS_K+wid*1024, vdst=lds0+LDS_V+wid*1024;
  #define DMA_K(t,slot) glds16(ksrc+(long)(t)*KVBLK*DM,(unsigned)__builtin_amdgcn_readfirstlane(kdst+(slot)))
  #define DMA_V(t,slot) glds16(vsrc+(long)(t)*KVBLK*DM,(unsigned)__builtin_amdgcn_readfirstlane(vdst+(slot)))
  const int vb0=(int)(lds0+LDS_V)+((lane>>4)&1)*32+(lane&3)*8+(4*hi+((lane&15)>>2))*64;
  const int NT=(q0+QB)/KVBLK;
  DMA_K(NT-1,0);DMA_V(NT-1,0);
  bf16x8 qr[4];
  #pragma unroll
  for(int d0=0;d0<4;++d0)qr[d0]=*reinterpret_cast<const bf16x8*>(&Qw[(long)r32*DM+d0*16+hi*8]);
  f32x16 o[2];o[0]=f32x16{};o[1]=f32x16{};
  float T=0.f; const int t_abs=q0+wid*QBLK+r32; bool wdone=false;
  for(int i=0;;++i){
    const int jt=NT-1-i; const int slot=(i&1)*SLOTB; const bool more=jt>0;
    if(more){DMA_K(jt-1,slot^SLOTB);DMA_V(jt-1,slot^SLOTB); WAIT_BAR(2);} else {WAIT_BAR(0);}
    const bool band=(jt>=NT-4);
    if(!(wdone||(band&&64*(jt-(NT-4))>=QBLK*wid+QBLK))){
    f32x16 x0,x1; { f32x16 zero=f32x16{}; qkt(x0,x1,shm+LDS_K+slot,qr,zero,r32,hi); }
    f32x16 n0,n1;
    const int kb=64*jt+4*hi;
    #pragma unroll
    for(int r=0;r<16;++r){
      const float z0=x0[r],z1=x1[r];
      const float l0=__builtin_amdgcn_logf(1.0f+__builtin_amdgcn_exp2f(-__builtin_fabsf(z0))), l1=__builtin_amdgcn_logf(1.0f+__builtin_amdgcn_exp2f(-__builtin_fabsf(z1)));
      float a0=__builtin_fminf(z0,0.f)-l0, a1=__builtin_fminf(z1,0.f)-l1, m0=__builtin_fminf(-z0,0.f)-l0, m1=__builtin_fminf(-z1,0.f)-l1;
      if(band){ const int kv=kb+(r&3)+8*(r>>2); if(!(kv<t_abs)){a0=-INFINITY;m0=0.f;} if(!(kv+32<t_abs)){a1=-INFINITY;m1=0.f;} }
      x0[r]=a0;x1[r]=a1;n0[r]=m0;n1[r]=m1;
    }
    float g0[4],g1[4],p0s[4],p1s[4];
    #pragma unroll
    for(int a=0;a<4;++a){ g0[a]=(n0[4*a]+n0[4*a+1])+(n0[4*a+2]+n0[4*a+3]); g1[a]=(n1[4*a]+n1[4*a+1])+(n1[4*a+2]+n1[4*a+3]);
      { auto rr=__builtin_amdgcn_permlane32_swap(__float_as_uint(g0[a]),__float_as_uint(g0[a]),false,false); p0s[a]=__uint_as_float(hi?rr[0]:rr[1]); }
      { auto rr=__builtin_amdgcn_permlane32_swap(__float_as_uint(g1[a]),__float_as_uint(g1[a]),false,false); p1s[a]=__uint_as_float(hi?rr[0]:rr[1]); } }
    float run=T;
    #pragma unroll
    for(int a=3;a>=0;--a){ float off=run+(hi?0.f:p1s[a]); run+=g1[a]+p1s[a];
      const float t3=off,t2=t3+n1[4*a+3],t1=t2+n1[4*a+2],t0=t1+n1[4*a+1];
      x1[4*a+3]=__builtin_amdgcn_exp2f(x1[4*a+3]+t3); x1[4*a+2]=__builtin_amdgcn_exp2f(x1[4*a+2]+t2); x1[4*a+1]=__builtin_amdgcn_exp2f(x1[4*a+1]+t1); x1[4*a]=__builtin_amdgcn_exp2f(x1[4*a]+t0); }
    #pragma unroll
    for(int a=3;a>=0;--a){ float off=run+(hi?0.f:p0s[a]); run+=g0[a]+p0s[a];
      const float t3=off,t2=t3+n0[4*a+3],t1=t2+n0[4*a+2],t0=t1+n0[4*a+1];
      x0[4*a+3]=__builtin_amdgcn_exp2f(x0[4*a+3]+t3); x0[4*a+2]=__builtin_amdgcn_exp2f(x0[4*a+2]+t2); x0[4*a+1]=__builtin_amdgcn_exp2f(x0[4*a+1]+t1); x0[4*a]=__builtin_amdgcn_exp2f(x0[4*a]+t0); }
    T=run;
    u32x4 pw0,pw1,pw2,pw3;
    pw0=(u32x4){cvtpk_s(x0[0],x0[1]),cvtpk_s(x0[2],x0[3]),cvtpk_s(x0[4],x0[5]),cvtpk_s(x0[6],x0[7])};
    pw1=(u32x4){cvtpk_s(x0[8],x0[9]),cvtpk_s(x0[10],x0[11]),cvtpk_s(x0[12],x0[13]),cvtpk_s(x0[14],x0[15])};
    pw2=(u32x4){cvtpk_s(x1[0],x1[1]),cvtpk_s(x1[2],x1[3]),cvtpk_s(x1[4],x1[5]),cvtpk_s(x1[6],x1[7])};
    pw3=(u32x4){cvtpk_s(x1[8],x1[9]),cvtpk_s(x1[10],x1[11]),cvtpk_s(x1[12],x1[13]),cvtpk_s(x1[14],x1[15])};
    SBAR(); pv(o,vb0+slot,__builtin_bit_cast(bf16x8,pw0),__builtin_bit_cast(bf16x8,pw1),__builtin_bit_cast(bf16x8,pw2),__builtin_bit_cast(bf16x8,pw3));
    wdone=__all(T<-150.f);
    }
    if(lane==0)flags[wid]=wdone?1:0;
    WAIT_BAR(2);
    const u32x4 f0=*(lds_u4ptr)(flags), f1=*(lds_u4ptr)(flags+4);
    const bool alld=((f0.x&f0.y&f0.z&f0.w)&(f1.x&f1.y&f1.z&f1.w))!=0;
    if(!more||alld)break;
  }
  WAIT_BAR(0);
  bf16*Ow=O+(long)(q0+wid*QBLK)*OPITCH;
  { bf16*stg=(bf16*)(shm+LDS_OST)+wid*2048;
    #pragma unroll
    for(int r=0;r<16;++r){const int orow=crow(r,hi);
      #pragma unroll
      for(int d0=0;d0<2;++d0)stg[orow*64+d0*32+r32]=__float2bfloat16(o[d0][r]);}
    asm volatile("s_waitcnt lgkmcnt(0)":::"memory");
    #pragma unroll
    for(int i=0;i<4;++i){const int row=i*8+(lane>>3),ch=lane&7; const u32x4 v=*(const u32x4*)(stg+row*64+ch*8); ATTN_STORE16(Ow+(long)row*OPITCH+ch*8,v);} }
  asm volatile("s_waitcnt lgkmcnt(0)\n\ts_barrier":::"memory");
  #undef DMA_K
  #undef DMA_V
}
#undef SBAR
#undef WAIT_BAR
}

constexpr int BATCH = 8, SEQ = 4096, DM = 1024, DEPTH = 4, M = BATCH * SEQ, INC = 3334, NIN = 3584, DFF = 4096;
constexpr float EPS = 1e-6f;
constexpr size_t MiB = 1u << 20;
constexpr size_t WS_BAR = 128 * 1024;
constexpr size_t WS_SS = 1 * MiB;
constexpr size_t WS_LB = 3 * MiB;
constexpr size_t WS_JS = 3 * MiB + 256 * 1024;
constexpr size_t WS_DD = 3 * MiB + 512 * 1024;
constexpr size_t WS_W = 4 * MiB;
constexpr size_t W_LAYER = 25 * MiB, W_OUT = 7 * MiB, W_1 = 9 * MiB, W_2 = 17 * MiB;
constexpr size_t WS_XB = 104 * MiB;
constexpr size_t WS_P = 168 * MiB;
constexpr size_t P_HQ = 0, P_HK = 16 * MiB, P_HI = 32 * MiB, P_HG = 48 * MiB, P_HLF = 64 * MiB, P_SQ = 96 * MiB, P_FQ = 168 * MiB, P_LF = 240 * MiB, P_CC = 241 * MiB, P_US = 242 * MiB;
constexpr size_t HEADBUF = 24 * MiB;
constexpr size_t WS_MIX = 442 * MiB;
constexpr size_t WS_U = 168 * MiB;
constexpr size_t WS_END = 506 * MiB;
constexpr int LDS_BYTES = 147456;

typedef pg8::bf16_t bf16_t;
typedef pg8::f32x4 f32x4;
typedef unsigned u32x4 __attribute__((ext_vector_type(4)));
typedef unsigned u32x2 __attribute__((ext_vector_type(2)));
#define LAS __attribute__((address_space(3)))

__device__ __forceinline__ unsigned f2bf(float f) { unsigned u = __builtin_bit_cast(unsigned, f); return (u + 0x7fffu + ((u >> 16) & 1u)) >> 16; }
__device__ __forceinline__ unsigned pk2(float lo, float hi) { return pg8::cvt_pk_bf16(lo, hi); }
__device__ __forceinline__ float bf2f(unsigned short b) { return __builtin_bit_cast(float, (unsigned)b << 16); }
__device__ __forceinline__ float bflo(unsigned w) { return __builtin_bit_cast(float, w << 16); }
__device__ __forceinline__ float bfhi(unsigned w) { return __builtin_bit_cast(float, w & 0xffff0000u); }
__device__ __forceinline__ float logsig(float x) { return fminf(x, 0.f) - log1pf(expf(-fabsf(x))); }
__device__ __forceinline__ float wave_sum(float v) {
#pragma unroll
    for (int o = 1; o < 64; o <<= 1) v += __shfl_xor(v, o);
    return v;
}
#define ROWSCALES8(rs, ss, row0, fq) float rs[2][4]; _Pragma("unroll") for (int ai_ = 0; ai_ < 2; ++ai_) _Pragma("unroll") for (int m_ = 0; m_ < 4; ++m_) rs[ai_][m_] = rowscale(ss, (row0) + ai_ * 128 + m_ * 16, fq);
__device__ __forceinline__ float rowscale(const float* ss, int row, int fq) {
    const f32x4 p = *(const f32x4*)(ss + (size_t)row * 16 + 4 * fq);
    float s = (p[0] + p[1]) + (p[2] + p[3]);
    s += __shfl_xor(s, 16); s += __shfl_xor(s, 32);
    return rsqrtf(s * (1.0f / DM) + EPS);
}

#define ROWFENCE() asm volatile("" ::: "memory")
struct EpiResid {
    static constexpr bool PERM = true, AFTER_DRAIN = false;
    bf16_t* xb; float* outf; float* ss;
    __device__ __forceinline__ void operator()(const f32x4 (&acc)[2][2][4][2], const pg8::Unit& u, int wr, int wc, int fr, int fq) const {
        const int row0 = u.pm * 256 + wr * 64 + fr, col0 = u.pn * 256 + wc * 32 + 8 * fq;
#pragma unroll
        for (int ai = 0; ai < 2; ++ai) {
            u32x4 pre[4][2];
#pragma unroll
            for (int m = 0; m < 4; ++m)
#pragma unroll
                for (int bj = 0; bj < 2; ++bj) pre[m][bj] = *(const u32x4*)(xb + (size_t)(row0 + ai * 128 + m * 16) * DM + col0 + bj * 128);
#pragma unroll
            for (int m = 0; m < 4; ++m) {
                const int row = row0 + ai * 128 + m * 16; float sq = 0.f;
#pragma unroll
                for (int bj = 0; bj < 2; ++bj) {
                    const size_t off = (size_t)row * DM + col0 + bj * 128; const u32x4 p = pre[m][bj];
                    const f32x4 v0 = acc[ai][bj][m][0] + (f32x4){bflo(p.x), bfhi(p.x), bflo(p.y), bfhi(p.y)}, v1 = acc[ai][bj][m][1] + (f32x4){bflo(p.z), bfhi(p.z), bflo(p.w), bfhi(p.w)};
                    if (outf) { *(f32x4*)(outf + off) = v0; *(f32x4*)(outf + off + 4) = v1; }
                    u32x4 w; w.x = pk2(v0[0], v0[1]); w.y = pk2(v0[2], v0[3]); w.z = pk2(v1[0], v1[1]); w.w = pk2(v1[2], v1[3]);
                    *(u32x4*)(xb + off) = w;
                    sq += (v0[0] * v0[0] + v0[1] * v0[1]) + (v0[2] * v0[2] + v0[3] * v0[3]) + (v1[0] * v1[0] + v1[1] * v1[1]) + (v1[2] * v1[2] + v1[3] * v1[3]);
                }
                sq += __shfl_xor(sq, 16); sq += __shfl_xor(sq, 32);
                if (fq == 0) ss[(size_t)row * 16 + u.pn * 4 + wc] = sq;
            }
            ROWFENCE();
        }
    }
};
struct EpiRelu2 {
    static constexpr bool PERM = true, AFTER_DRAIN = false;
    bf16_t* U; const float* ss;
    __device__ __forceinline__ void operator()(const f32x4 (&acc)[2][2][4][2], const pg8::Unit& u, int wr, int wc, int fr, int fq) const {
        const int row0 = u.pm * 256 + wr * 64 + fr, col0 = u.pn * 256 + wc * 32 + 8 * fq;
        ROWSCALES8(rs8, ss, row0, fq)
#pragma unroll
        for (int ai = 0; ai < 2; ++ai)
#pragma unroll
            for (int m = 0; m < 4; ++m) {
                const int row = row0 + ai * 128 + m * 16; const float rs = rs8[ai][m];
#pragma unroll
                for (int bj = 0; bj < 2; ++bj) {
                    f32x4 v0 = acc[ai][bj][m][0] * rs, v1 = acc[ai][bj][m][1] * rs;
                    v0 = __builtin_elementwise_max(v0, (f32x4){0.f, 0.f, 0.f, 0.f}); v1 = __builtin_elementwise_max(v1, (f32x4){0.f, 0.f, 0.f, 0.f});
                    v0 = v0 * v0; v1 = v1 * v1;
                    u32x4 w; w.x = pk2(v0[0], v0[1]); w.y = pk2(v0[2], v0[3]); w.z = pk2(v1[0], v1[1]); w.w = pk2(v1[2], v1[3]);
                    *(u32x4*)(U + (size_t)row * DFF + col0 + bj * 128) = w;
                }
                ROWFENCE();
            }
    }
};
struct EpiInProj {
    static constexpr bool PERM = true, AFTER_DRAIN = false;
    const float* ss; unsigned char* P; const float* lbt;
    const float* gt; const float* fbias;
    __device__ __forceinline__ void operator()(const f32x4 (&acc)[2][2][4][2], const pg8::Unit& u, int wr, int wc, int fr, int fq) const {
        const int slot = u.pn * 4 + wc;
        if (slot > 52) return;
        const int row0 = u.pm * 256 + wr * 64 + fr;
        ROWSCALES8(rs8, ss, row0, fq)
        if (slot < 16) {
            const int kind = slot >> 2, cb = (slot & 3) * 64 + 8 * fq;
            if (kind == 1) {
                float* HLF = (float*)(P + P_HLF); bf16_t* HK = (bf16_t*)(P + P_HK);
#pragma unroll
                for (int ai = 0; ai < 2; ++ai)
#pragma unroll
                    for (int m = 0; m < 4; ++m) {
                        const int row = row0 + ai * 128 + m * 16; const float rs = rs8[ai][m];
#pragma unroll
                        for (int bj = 0; bj < 2; ++bj) {
                            float lf[8], kk[8];
#pragma unroll
                            for (int n = 0; n < 2; ++n) {
                                const f32x4 ll = *(const f32x4*)(lbt + cb + 32 * bj + 4 * n), om = *(const f32x4*)(lbt + 256 + cb + 32 * bj + 4 * n);
#pragma unroll
                                for (int i = 0; i < 4; ++i) {
                                    const float fl = acc[ai][bj][m][n][i] * rs;
                                    const float a = fminf(fl, 0.f) - __logf(1.0f + __expf(-fabsf(fl)));
                                    const float an = a - fl;
                                    const float b = ll[i] + an;
                                    lf[4 * n + i] = fmaxf(a, b) + __logf(1.0f + __expf(-fabsf(a - b)));
                                    kk[4 * n + i] = om[i] * __expf(an);
                                }
                            }
                            const size_t off = (size_t)row * 256 + cb + 32 * bj;
                            *(f32x4*)(HLF + off) = (f32x4){lf[0], lf[1], lf[2], lf[3]}; *(f32x4*)(HLF + off + 4) = (f32x4){lf[4], lf[5], lf[6], lf[7]};
                            u32x4 w; w.x = pk2(kk[0], kk[1]); w.y = pk2(kk[2], kk[3]); w.z = pk2(kk[4], kk[5]); w.w = pk2(kk[6], kk[7]);
                            *(u32x4*)(HK + off) = w;
                        }
                        ROWFENCE();
                    }
            } else {
                bf16_t* dst = (bf16_t*)(P + (kind == 0 ? P_HQ : (kind == 2 ? P_HI : P_HG)));
#pragma unroll
                for (int ai = 0; ai < 2; ++ai)
#pragma unroll
                    for (int m = 0; m < 4; ++m) {
                        const int row = row0 + ai * 128 + m * 16; const float rs = rs8[ai][m];
#pragma unroll
                        for (int bj = 0; bj < 2; ++bj) {
                            const f32x4 v0 = acc[ai][bj][m][0] * rs, v1 = acc[ai][bj][m][1] * rs;
                            u32x4 w; w.x = pk2(v0[0], v0[1]); w.y = pk2(v0[2], v0[3]); w.z = pk2(v1[0], v1[1]); w.w = pk2(v1[2], v1[3]);
                            *(u32x4*)(dst + (size_t)row * 256 + cb + 32 * bj) = w;
                        }
                        ROWFENCE();
                    }
            }
        } else if (slot < 52) {
            const int s2 = slot - 16, grp = s2 / 6, h = s2 % 6, role = grp % 3;
            bf16_t* dst = (bf16_t*)(P + P_SQ + (size_t)grp * HEADBUF) + (size_t)((u.pm >> 4) * 6 + h) * SEQ * 64 + 8 * fq;
            const float* gp = gt + (grp - (grp >= 3 ? 1 : 0)) * 64 + 8 * fq;
            const float qs = (role == 0) ? 0.125f * 1.4426950408889634f : 1.0f;
#pragma unroll
            for (int ai = 0; ai < 2; ++ai)
#pragma unroll
                for (int m = 0; m < 4; ++m) {
                    const int row = row0 + ai * 128 + m * 16; const float rs = rs8[ai][m];
                    float fac = rs;
                    if (role != 2) {
                        float sq = 0.f;
#pragma unroll
                        for (int bj = 0; bj < 2; ++bj)
#pragma unroll
                            for (int n = 0; n < 2; ++n) { const f32x4 x = acc[ai][bj][m][n]; sq += (x[0] * x[0] + x[1] * x[1]) + (x[2] * x[2] + x[3] * x[3]); }
                        sq += __shfl_xor(sq, 16); sq += __shfl_xor(sq, 32);
                        fac = rs * rsqrtf(rs * rs * sq * (1.0f / 64.0f) + EPS) * qs;
                    }
                    const int t = row & (SEQ - 1);
#pragma unroll
                    for (int bj = 0; bj < 2; ++bj) {
                        f32x4 v0 = acc[ai][bj][m][0] * fac, v1 = acc[ai][bj][m][1] * fac;
                        if (role != 2) { v0 = v0 * *(const f32x4*)(gp + 32 * bj); v1 = v1 * *(const f32x4*)(gp + 32 * bj + 4); }
                        u32x4 w; w.x = pk2(v0[0], v0[1]); w.y = pk2(v0[2], v0[3]); w.z = pk2(v1[0], v1[1]); w.w = pk2(v1[2], v1[3]);
                        *(u32x4*)(dst + (size_t)t * 64 + 32 * bj) = w;
                    }
                    ROWFENCE();
                }
        } else {
            float* LF = (float*)(P + P_LF);
#pragma unroll
            for (int ai = 0; ai < 2; ++ai)
#pragma unroll
                for (int m = 0; m < 4; ++m) {
                    const int row = row0 + ai * 128 + m * 16; const float rs = rs8[ai][m];
                    if (fq == 0) {
                        const f32x4 a0 = acc[ai][0][m][0], a1 = acc[ai][0][m][1];
                        *(f32x4*)(LF + (size_t)row * 8) = (f32x4){logsig(a0[0] * rs + fbias[0]), logsig(a0[1] * rs + fbias[1]), logsig(a0[2] * rs + fbias[2]), logsig(a0[3] * rs + fbias[3])};
                        *(f32x4*)(LF + (size_t)row * 8 + 4) = (f32x4){logsig(a1[0] * rs + fbias[4]), logsig(a1[1] * rs + fbias[5]), 0.f, 0.f};
                    }
                    ROWFENCE();
                }
        }
    }
};
#define XB_TMO      128
#define XB_XCNT(j)  (256  + 64 * (j))
#define XB_XSUB(j)  (1280 + 64 * (j))
#define XB_XGEN(j)  (2304 + 64 * (j))
#define XB_TOP      3328
#define XB_TOPGEN   3392
#define XCD_BAR_WORDS 3456
#define XB_SPIN_CAP (1u << 18)

__device__ __forceinline__ unsigned xb_ld(unsigned* p)              { return __hip_atomic_load(p, __ATOMIC_RELAXED, __HIP_MEMORY_SCOPE_AGENT); }
__device__ __forceinline__ unsigned xb_add(unsigned* p, unsigned v) { return __hip_atomic_fetch_add(p, v, __ATOMIC_RELAXED, __HIP_MEMORY_SCOPE_AGENT); }
__device__ __forceinline__ unsigned xb_xcc_id() { return (unsigned)__builtin_amdgcn_s_getreg((3 << 11) | 20) & 0xFu; }
#define XB_SPIN(cond, bar) do { unsigned _sp = 0; while (cond) { __builtin_amdgcn_s_sleep(1); \
    if ((++_sp & 255u) == 0u) { if (xb_ld(&(bar)[XB_TMO])) break; if (_sp > XB_SPIN_CAP) { atomicAdd(&(bar)[XB_TMO], 1u); break; } } } } while (0)

struct XcdBarrier {
    unsigned* bar; unsigned x;
    volatile LAS unsigned* st;
};

__device__ __forceinline__ XcdBarrier xcd_barrier_post(unsigned* bar, volatile LAS unsigned* st) {
    XcdBarrier b; b.bar = bar; b.x = xb_xcc_id(); b.st = st;
    if (threadIdx.x == 0) (void)xb_add(&bar[XB_XCNT(b.x)], 1u);
    return b;
}
__device__ __forceinline__ void xcd_barrier_complete(unsigned* bar, unsigned x, unsigned& nloc, unsigned& nx) {
    const unsigned G = gridDim.x * gridDim.y * gridDim.z;
    unsigned sum, cnt, mine, sp = 0u;
    for (;;) {
        sum = 0u; cnt = 0u; mine = 0u;
#pragma unroll
        for (unsigned j = 0; j < 16; ++j) { const unsigned c = xb_ld(&bar[XB_XCNT(j)]); sum += c; cnt += (c > 0u) ? 1u : 0u; mine = (j == x) ? c : mine; }
        if (sum == G) break;
        __builtin_amdgcn_s_sleep(1);
        if ((++sp & 255u) == 0u) { if (xb_ld(&bar[XB_TMO])) break; if (sp > XB_SPIN_CAP) { atomicAdd(&bar[XB_TMO], 1u); break; } }
    }
    nloc = mine > 0u ? mine : 1u; nx = cnt > 0u ? cnt : 1u;
}

__device__ __forceinline__ void xcd_barrier(const XcdBarrier& b) {
    asm volatile("s_waitcnt vmcnt(0)" ::: "memory");
    __syncthreads();
    if (threadIdx.x == 0) {
        unsigned* bar = b.bar;
        __builtin_amdgcn_s_waitcnt(0);
        unsigned nloc = b.st[0], nx = b.st[1];
        if (nloc == 0u) { xcd_barrier_complete(bar, b.x, nloc, nx); b.st[0] = nloc; b.st[1] = nx; }
        const unsigned old = xb_add(&bar[XB_XSUB(b.x)], 1u);
        const unsigned gen = old / nloc;
        if (old + 1u == (gen + 1u) * nloc) {
            __builtin_amdgcn_fence(__ATOMIC_RELEASE, "agent");
            asm volatile("s_waitcnt vmcnt(0)" ::: "memory");
            const unsigned og = xb_add(&bar[XB_TOP], 1u);
            const unsigned tg = og / nx;
            if (og + 1u == (tg + 1u) * nx) xb_add(&bar[XB_TOPGEN], 1u);
            else XB_SPIN(xb_ld(&bar[XB_TOPGEN]) == tg, bar);
            __builtin_amdgcn_fence(__ATOMIC_ACQUIRE, "agent");
            xb_add(&bar[XB_XGEN(b.x)], 1u);
            asm volatile("s_waitcnt vmcnt(0)" ::: "memory");
        } else {
            XB_SPIN(xb_ld(&bar[XB_XGEN(b.x)]) == gen, bar);
            __builtin_amdgcn_fence(__ATOMIC_ACQUIRE, "agent");
            asm volatile("s_waitcnt vmcnt(0)" ::: "memory");
        }
    }
    __syncthreads();
}

__device__ __forceinline__ void tr_item(const float* W, int ldw, int ncols_valid, int src_col0, int k0, const float* gain, bf16_t* WT, int K, int n0, LAS float* scr, int lane) {
#pragma unroll 8
    for (int i = 0; i < 32; ++i) { const int kk = 2 * i + (lane >> 5), c = src_col0 + (lane & 31);
        float v = (c < ncols_valid) ? W[(size_t)(k0 + kk) * ldw + c] : 0.f; if (gain) v *= gain[k0 + kk]; scr[kk * 33 + (lane & 31)] = v; }
    asm volatile("s_waitcnt lgkmcnt(0)" ::: "memory");
    const int c = lane & 7;
#pragma unroll
    for (int j = 0; j < 4; ++j) { const int n = (lane >> 3) + 8 * j; const LAS float* s = scr + (8 * c) * 33 + n;
        u32x4 o; o.x = pk2(s[0 * 33], s[1 * 33]); o.y = pk2(s[2 * 33], s[3 * 33]); o.z = pk2(s[4 * 33], s[5 * 33]); o.w = pk2(s[6 * 33], s[7 * 33]);
        *(u32x4*)(WT + (size_t)(n0 + n) * K + k0 + 8 * c) = o; }
    asm volatile("s_waitcnt lgkmcnt(0)" ::: "memory");
}

__device__ __forceinline__ void unpack8(const u32x4 w, float* d) { d[0] = bflo(w.x); d[1] = bfhi(w.x); d[2] = bflo(w.y); d[3] = bfhi(w.y); d[4] = bflo(w.z); d[5] = bfhi(w.z); d[6] = bflo(w.w); d[7] = bfhi(w.w); }

__device__ __forceinline__ void fox_cumsum_item(int bh, const float* LF, float* CC, int* JS, const float* gq, const float* gk, LAS float* sc) {
    int tid_ = threadIdx.x; asm volatile("" : "+v"(tid_)); const int tid = tid_, lane = tid & 63, wave = tid >> 6, b = bh / 6, h = bh % 6;
    float v[8]; float run = 0.f;
#pragma unroll
    for (int i = 0; i < 8; ++i) { run += LF[((size_t)b * SEQ + tid * 8 + i) * 8 + h]; v[i] = run; }
    float s = run;
#pragma unroll
    for (int o = 1; o < 64; o <<= 1) { const float n = __shfl_up(s, o); if (lane >= o) s += n; }
    __syncthreads();
    if (lane == 63) sc[wave] = s;
    __syncthreads();
    float base = s - run;
    for (int w = 0; w < wave; ++w) base += sc[w];
    LAS float* cl = sc + 64;
#pragma unroll
    for (int i = 0; i < 8; ++i) { const float c2 = (v[i] + base) * 1.4426950408889634f; CC[(size_t)bh * SEQ + tid * 8 + i] = c2; cl[tid * 8 + i] = c2; }
    __syncthreads();
    if (tid < 16) {
        float mq = 0.f, mk = 0.f;
        for (int d = 0; d < 64; ++d) { mq = fmaxf(mq, fabsf(gq[d])); mk = fmaxf(mk, fabsf(gk[d])); }
        const float zb = 1.4426950408889634f * 8.0f * mq * mk * 1.03f + 1.0f;
        const float thr = -(150.0f + 2.0f * zb);
        const int q0 = tid * 256, nt = q0 / 64 + 4; const float cq = cl[q0];
        int j = 0; while (j < nt - 4 && cq - cl[64 * j + 63] < thr) ++j;
        JS[bh * 16 + tid] = j & ~1;
    }
    __syncthreads();
}

__device__ __forceinline__ void stage_kv(const bf16_t* Kb, const bf16_t* Vb, int kt, LAS float* Kf, LAS float* Vf) {
    int tid_ = threadIdx.x; asm volatile("" : "+v"(tid_)); const int tid = tid_, key = tid >> 3, c8 = tid & 7;
    const u32x4 kw = *(const u32x4*)(Kb + ((size_t)(kt * 64 + key)) * 64 + c8 * 8), vw = *(const u32x4*)(Vb + ((size_t)(kt * 64 + key)) * 64 + c8 * 8);
    float kf[8], vf[8]; unpack8(kw, kf); unpack8(vw, vf);
    *(LAS f32x4*)(Kf + key * 64 + c8 * 8) = (f32x4){kf[0], kf[1], kf[2], kf[3]}; *(LAS f32x4*)(Kf + key * 64 + c8 * 8 + 4) = (f32x4){kf[4], kf[5], kf[6], kf[7]};
    *(LAS f32x4*)(Vf + key * 64 + c8 * 8) = (f32x4){vf[0], vf[1], vf[2], vf[3]}; *(LAS f32x4*)(Vf + key * 64 + c8 * 8 + 4) = (f32x4){vf[4], vf[5], vf[6], vf[7]};
}

__device__ __forceinline__ void fox_naive_item(int item, unsigned char* P, bf16_t* MIX, LAS float* lds) {
    int tid_ = threadIdx.x; asm volatile("" : "+v"(tid_)); const int tid = tid_, bh = item >> 3, qblk = item & 7, b = bh / 6, h = bh % 6, t = qblk * 512 + tid;
    const bf16_t* Qp = (const bf16_t*)(P + P_FQ) + ((size_t)bh * SEQ + t) * 64;
    const bf16_t* Kb = (const bf16_t*)(P + P_FQ + HEADBUF) + (size_t)bh * SEQ * 64;
    const bf16_t* Vb = (const bf16_t*)(P + P_FQ + 2 * HEADBUF) + (size_t)bh * SEQ * 64;
    const float* CC = (const float*)(P + P_CC) + (size_t)bh * SEQ;
    float q[64], o[64];
#pragma unroll
    for (int c = 0; c < 8; ++c) unpack8(*(const u32x4*)(Qp + c * 8), q + c * 8);
#pragma unroll
    for (int d = 0; d < 64; ++d) o[d] = 0.f;
    float m = -1e30f, l = 0.f; const float ct = CC[t];
    LAS float* Kf = lds; LAS float* Vf = lds + 4096; LAS float* cs = lds + 8192;
    const int ntile = (qblk + 1) * 8;
    for (int kt = 0; kt < ntile; ++kt) {
        __syncthreads();
        stage_kv(Kb, Vb, kt, Kf, Vf); if (tid < 64) cs[tid] = CC[kt * 64 + tid];
        __syncthreads();
        for (int s = 0; s < 64; ++s) {
            float z = 0.f;
#pragma unroll
            for (int d = 0; d < 64; ++d) z += q[d] * Kf[s * 64 + d];
            const float x = (kt * 64 + s <= t) ? z + (ct - cs[s]) : -1e30f;
            const float mn = fmaxf(m, x), sc = __expf(m - mn), p = __expf(x - mn);
            l = l * sc + p;
#pragma unroll
            for (int d = 0; d < 64; ++d) o[d] = o[d] * sc + p * Vf[s * 64 + d];
            m = mn;
        }
    }
    const float inv = 1.0f / l;
    bf16_t* op = MIX + ((size_t)b * SEQ + t) * DM + 640 + h * 64;
#pragma unroll
    for (int c = 0; c < 8; ++c) { u32x4 w; w.x = pk2(o[c * 8] * inv, o[c * 8 + 1] * inv); w.y = pk2(o[c * 8 + 2] * inv, o[c * 8 + 3] * inv); w.z = pk2(o[c * 8 + 4] * inv, o[c * 8 + 5] * inv); w.w = pk2(o[c * 8 + 6] * inv, o[c * 8 + 7] * inv); *(u32x4*)(op + c * 8) = w; }
}

__device__ __forceinline__ void sb_naive_item(int item, unsigned char* P, bf16_t* MIX, LAS float* lds) {
    int tid_ = threadIdx.x; asm volatile("" : "+v"(tid_)); const int tid = tid_, bh = item >> 3, qblk = item & 7, b = bh / 6, h = bh % 6, t = qblk * 512 + tid;
    const bf16_t* Qp = (const bf16_t*)(P + P_SQ) + ((size_t)bh * SEQ + t) * 64;
    const bf16_t* Kb = (const bf16_t*)(P + P_SQ + HEADBUF) + (size_t)bh * SEQ * 64;
    const bf16_t* Vb = (const bf16_t*)(P + P_SQ + 2 * HEADBUF) + (size_t)bh * SEQ * 64;
    float q[64], o[64];
#pragma unroll
    for (int c = 0; c < 8; ++c) unpack8(*(const u32x4*)(Qp + c * 8), q + c * 8);
#pragma unroll
    for (int d = 0; d < 64; ++d) o[d] = 0.f;
    float tail = 0.f;
    LAS float* Kf = lds; LAS float* Vf = lds + 4096;
    for (int kt = qblk * 8 + 7; kt >= 0; --kt) {
        __syncthreads();
        stage_kv(Kb, Vb, kt, Kf, Vf);
        __syncthreads();
        for (int s = 63; s >= 0; --s) {
            float z = 0.f;
#pragma unroll
            for (int d = 0; d < 64; ++d) z += q[d] * Kf[s * 64 + d];
            const float ls = fminf(z, 0.f) - __logf(1.0f + __expf(-fabsf(z)));
            const bool act = (kt * 64 + s) < t;
            const float A = act ? __expf(ls + tail) : 0.f;
#pragma unroll
            for (int d = 0; d < 64; ++d) o[d] += A * Vf[s * 64 + d];
            tail += act ? (ls - z) : 0.f;
        }
        if (__syncthreads_and(tail < -100.f)) break;
    }
    bf16_t* op = MIX + ((size_t)b * SEQ + t) * DM + 256 + h * 64;
#pragma unroll
    for (int c = 0; c < 8; ++c) { u32x4 w; w.x = pk2(o[c * 8], o[c * 8 + 1]); w.y = pk2(o[c * 8 + 2], o[c * 8 + 3]); w.z = pk2(o[c * 8 + 4], o[c * 8 + 5]); w.w = pk2(o[c * 8 + 6], o[c * 8 + 7]); *(u32x4*)(op + c * 8) = w; }
}

__device__ __forceinline__ void hgrn_naive_item(int item, unsigned char* P, bf16_t* MIX, const float* hgn, LAS float* lds) {
    int tid_ = threadIdx.x; asm volatile("" : "+v"(tid_)); const int tid = tid_, lane = tid & 63, w = tid >> 6, kg = lane >> 3, vi = lane & 7, vcol = 8 * w + vi, b = item >> 2, h = item & 3;
    const bf16_t* HQ = (const bf16_t*)(P + P_HQ); const bf16_t* HK = (const bf16_t*)(P + P_HK); const bf16_t* HI = (const bf16_t*)(P + P_HI); const bf16_t* HG = (const bf16_t*)(P + P_HG);
    const float* HLF = (const float*)(P + P_HLF);
    LAS float* qf = lds; LAS float* kf = lds + 4096; LAS float* ff = lds + 8192; LAS float* vf = lds + 12288; LAS float* ob = lds + 16384;
    float S[8];
#pragma unroll
    for (int j = 0; j < 8; ++j) S[j] = 0.f;
    const int tok = tid >> 3, c8 = tid & 7;
    float gn[8];
#pragma unroll
    for (int e = 0; e < 8; ++e) gn[e] = hgn[c8 * 8 + e];
    for (int c = 0; c < 64; ++c) {
        const size_t off = ((size_t)b * SEQ + c * 64 + tok) * 256 + h * 64 + c8 * 8;
        __syncthreads();
        {
            float a[8];
            unpack8(*(const u32x4*)(HQ + off), a);
#pragma unroll
            for (int e = 0; e < 8; ++e) qf[tok * 64 + c8 * 8 + e] = a[e];
            unpack8(*(const u32x4*)(HK + off), a);
#pragma unroll
            for (int e = 0; e < 8; ++e) kf[tok * 64 + c8 * 8 + e] = a[e];
            unpack8(*(const u32x4*)(HI + off), a);
#pragma unroll
            for (int e = 0; e < 8; ++e) vf[tok * 64 + c8 * 8 + e] = a[e];
            const f32x4 l0 = *(const f32x4*)(HLF + off), l1 = *(const f32x4*)(HLF + off + 4);
#pragma unroll
            for (int e = 0; e < 4; ++e) { ff[tok * 64 + c8 * 8 + e] = expf(l0[e]); ff[tok * 64 + c8 * 8 + 4 + e] = expf(l1[e]); }
        }
        __syncthreads();
        for (int tk = 0; tk < 64; ++tk) {
            const float vv = vf[tk * 64 + vcol]; float op = 0.f;
#pragma unroll
            for (int j = 0; j < 8; ++j) { const int k = 8 * kg + j; S[j] = ff[tk * 64 + k] * S[j] + kf[tk * 64 + k] * vv; op += qf[tk * 64 + k] * S[j]; }
            op += __shfl_xor(op, 8); op += __shfl_xor(op, 16); op += __shfl_xor(op, 32);
            if (kg == 0) ob[tk * 64 + vcol] = op;
        }
        __syncthreads();
        {
            float ov[8], g[8]; float sq = 0.f;
#pragma unroll
            for (int e = 0; e < 8; ++e) { ov[e] = ob[tok * 64 + c8 * 8 + e]; sq += ov[e] * ov[e]; }
            sq += __shfl_xor(sq, 1); sq += __shfl_xor(sq, 2); sq += __shfl_xor(sq, 4);
            const float rn = rsqrtf(sq * (1.0f / 64.0f) + EPS);
            unpack8(*(const u32x4*)(HG + off), g);
            float r[8];
#pragma unroll
            for (int e = 0; e < 8; ++e) r[e] = ov[e] * rn * gn[e] * (g[e] / (1.0f + expf(-g[e])));
            u32x4 wv; wv.x = pk2(r[0], r[1]); wv.y = pk2(r[2], r[3]); wv.z = pk2(r[4], r[5]); wv.w = pk2(r[6], r[7]);
            *(u32x4*)(MIX + ((size_t)b * SEQ + c * 64 + tok) * DM + h * 64 + c8 * 8) = wv;
        }
    }
}

constexpr int HG_SLOT = 32768, HG_BP = 68  , HG_PRE = 64 * HG_BP * 4, HG_TOT = HG_PRE + 1280, HG_VT = 20480, HG_VP = 72;
static_assert(HG_TOT + 1024 <= HG_VT && HG_VT + 64 * HG_VP * 2 <= HG_SLOT, "HGRN LDS slot map");
typedef short hbf16x8 __attribute__((ext_vector_type(8)));
typedef short hbf16x4 __attribute__((ext_vector_type(4)));
__device__ __forceinline__ hbf16x8 pack8(const float* x) { u32x4 w; w.x = pk2(x[0], x[1]); w.y = pk2(x[2], x[3]); w.z = pk2(x[4], x[5]); w.w = pk2(x[6], x[7]); return __builtin_bit_cast(hbf16x8, w); }

__device__ __forceinline__ void hg_stage(int tid, size_t row0, int h, const float* HLF, const bf16_t* HI, LAS unsigned char* sb) {
    const int lt = tid & 255, k = lt & 63, seg = lt >> 6;
    LAS float* bl = (LAS float*)sb; LAS float* pre = (LAS float*)(sb + HG_PRE); LAS float* tot = (LAS float*)(sb + HG_TOT); LAS bf16_t* vt = (LAS bf16_t*)(sb + HG_VT);
    float run = 0.f;
#pragma unroll
    for (int i = 0; i < 16; ++i) { const int t = 16 * seg + i; run += HLF[(row0 + t) * 256 + h * 64 + k]; bl[t * HG_BP + k] = run; }
    tot[seg * 64 + k] = run;
    {
        const int s = lt & 63, c0 = (lt >> 6) * 16;
        const u32x4 w0 = *(const u32x4*)(HI + (row0 + s) * 256 + h * 64 + c0), w1 = *(const u32x4*)(HI + (row0 + s) * 256 + h * 64 + c0 + 8);
        const unsigned ww[8] = {w0.x, w0.y, w0.z, w0.w, w1.x, w1.y, w1.z, w1.w};
#pragma unroll
        for (int e = 0; e < 8; ++e) { vt[(c0 + 2 * e) * HG_VP + s] = (bf16_t)(ww[e] & 0xffffu); vt[(c0 + 2 * e + 1) * HG_VP + s] = (bf16_t)(ww[e] >> 16); }
    }
    __syncthreads();
    if (lt < 64) { float p = 0.f;
#pragma unroll
        for (int sg = 0; sg < 4; ++sg) { pre[sg * 64 + lt] = p; p += tot[sg * 64 + lt]; }
        pre[4 * 64 + lt] = p; }
    __syncthreads();
}

__device__ __forceinline__ void hgrn_a_item(int item, unsigned char* P, float* DD, LAS unsigned char* L) {
    int tid_ = threadIdx.x; asm volatile("" : "+v"(tid_)); const int tid = tid_, lane = tid & 63, wq = (tid >> 6) & 3, cs = tid >> 8, r = lane & 15, g = lane >> 4;
    const int bh = item >> 5, chunk = (item & 31) * 2 + cs, b = bh >> 2, h = bh & 3;
    const size_t row0 = (size_t)b * SEQ + chunk * 64;
    const bf16_t* HK = (const bf16_t*)(P + P_HK); float* UT = (float*)(P + P_US);
    LAS unsigned char* sb = L + cs * HG_SLOT;
    const int k = 16 * wq + r;
    unsigned short kraw[2][8];
#pragma unroll
    for (int ks = 0; ks < 2; ++ks)
#pragma unroll
        for (int j = 0; j < 8; ++j) kraw[ks][j] = HK[(row0 + 32 * ks + 8 * g + j) * 256 + h * 64 + k];
    hg_stage(tid, row0, h, (const float*)(P + P_HLF), (const bf16_t*)(P + P_HI), sb);
    const LAS float* bl = (const LAS float*)sb; const LAS float* pre = (const LAS float*)(sb + HG_PRE); const LAS unsigned char* vt = sb + HG_VT;
    const float pre4 = pre[4 * 64 + k];
    hbf16x8 af[2];
#pragma unroll
    for (int ks = 0; ks < 2; ++ks) { const float pj = pre4 - pre[(2 * ks + (g >> 1)) * 64 + k]; float x[8];
#pragma unroll
        for (int j = 0; j < 8; ++j) { const int s = 32 * ks + 8 * g + j; x[j] = bf2f(kraw[ks][j]) * __expf(pj - bl[s * HG_BP + k]); }
        af[ks] = pack8(x); }
    float* ut = UT + ((size_t)(bh * 64 + chunk) * 64) * 64;
#pragma unroll
    for (int vtile = 0; vtile < 4; ++vtile) { f32x4 acc = {0.f, 0.f, 0.f, 0.f};
#pragma unroll
        for (int ks = 0; ks < 2; ++ks) { const hbf16x8 bf = *(const LAS hbf16x8*)(vt + (16 * vtile + r) * (HG_VP * 2) + (32 * ks + 8 * g) * 2); acc = __builtin_amdgcn_mfma_f32_16x16x32_bf16(af[ks], bf, acc, 0, 0, 0); }
        *(f32x4*)(ut + (size_t)(16 * vtile + r) * 64 + 16 * wq + 4 * g) = acc; }
    if (g == 0) DD[(size_t)(bh * 64 + chunk) * 64 + k] = __expf(pre4);
}

__device__ __forceinline__ void hgrn_b_scan(int bx, int G, unsigned char* P, const float* DD) {
    int tid_ = threadIdx.x; asm volatile("" : "+v"(tid_));
    float* UT = (float*)(P + P_US);
    for (int gid = bx * 512 + tid_; gid < 32 * 4096; gid += G * 512) {
        const int bh = gid >> 12, e = gid & 4095; float* u = UT + (size_t)bh * 64 * 4096 + e; const float* dd = DD + (size_t)bh * 64 * 64 + (e & 63);
        float S = 0.f;
        for (int c0 = 0; c0 < 64; c0 += 32) { float tu[32], td[32];
#pragma unroll
            for (int i = 0; i < 32; ++i) { tu[i] = u[(size_t)(c0 + i) * 4096]; td[i] = dd[(c0 + i) * 64]; }
#pragma unroll
            for (int i = 0; i < 32; ++i) { u[(size_t)(c0 + i) * 4096] = S; S = td[i] * S + tu[i]; } }
    }
}

__device__ __forceinline__ void hgrn_c_item(int item, unsigned char* P, bf16_t* MIX, const float* hgn, LAS unsigned char* L) {
    int tid_ = threadIdx.x; asm volatile("" : "+v"(tid_)); const int tid = tid_, lane = tid & 63, I = (tid >> 6) & 3, cs = tid >> 8, r = lane & 15, g = lane >> 4;
    const int bh = item >> 5, chunk = (item & 31) * 2 + cs, b = bh >> 2, h = bh & 3;
    const size_t row0 = (size_t)b * SEQ + chunk * 64;
    const bf16_t* HQ = (const bf16_t*)(P + P_HQ); const bf16_t* HK = (const bf16_t*)(P + P_HK); const bf16_t* HG = (const bf16_t*)(P + P_HG); const float* ST = (const float*)(P + P_US);
    LAS unsigned char* sb = L + cs * HG_SLOT;
    const int t = 16 * I + r;
    u32x4 qraw[2], kraw[4][2]; f32x4 sraw[4][2][2]; unsigned short graw[4][4];
    const float* st = ST + ((size_t)(bh * 64 + chunk) * 64) * 64;
#pragma unroll
    for (int ks = 0; ks < 2; ++ks) { qraw[ks] = *(const u32x4*)(HQ + (row0 + t) * 256 + h * 64 + 32 * ks + 8 * g);
#pragma unroll
        for (int J = 0; J < 4; ++J) kraw[J][ks] = *(const u32x4*)(HK + (row0 + 16 * J + r) * 256 + h * 64 + 32 * ks + 8 * g);
#pragma unroll
        for (int vtile = 0; vtile < 4; ++vtile) { const float* sp = st + (size_t)(16 * vtile + r) * 64 + 32 * ks + 8 * g; sraw[vtile][ks][0] = *(const f32x4*)sp; sraw[vtile][ks][1] = *(const f32x4*)(sp + 4); } }
#pragma unroll
    for (int i = 0; i < 4; ++i)
#pragma unroll
        for (int vtile = 0; vtile < 4; ++vtile) graw[i][vtile] = HG[(row0 + 16 * I + 4 * g + i) * 256 + h * 64 + 16 * vtile + r];
    hg_stage(tid, row0, h, (const float*)(P + P_HLF), (const bf16_t*)(P + P_HI), sb);
    const LAS float* bl = (const LAS float*)sb; const LAS float* pre = (const LAS float*)(sb + HG_PRE); const LAS unsigned char* vt = sb + HG_VT;
    hbf16x8 qtf[2], qhf[2];
#pragma unroll
    for (int ks = 0; ks < 2; ++ks) { const int kb = 32 * ks + 8 * g; float q[8], xt[8], xh[8];
        unpack8(qraw[ks], q);
#pragma unroll
        for (int j = 0; j < 8; ++j) { xt[j] = q[j] * __expf(bl[t * HG_BP + kb + j]); xh[j] = xt[j] * __expf(pre[I * 64 + kb + j]); }
        qtf[ks] = pack8(xt); qhf[ks] = pack8(xh); }
    f32x4 at[4];
#pragma unroll
    for (int J = 0; J < 4; ++J) { at[J] = (f32x4){0.f, 0.f, 0.f, 0.f};
        if (J <= I) { const int s = 16 * J + r;
#pragma unroll
            for (int ks = 0; ks < 2; ++ks) { const int kb = 32 * ks + 8 * g; float kk[8], x[8];
                unpack8(kraw[J][ks], kk);
#pragma unroll
                for (int j = 0; j < 8; ++j) x[j] = kk[j] * __expf(fminf(pre[I * 64 + kb + j] - pre[J * 64 + kb + j] - bl[s * HG_BP + kb + j], 80.f));
                at[J] = __builtin_amdgcn_mfma_f32_16x16x32_bf16(pack8(x), qtf[ks], at[J], 0, 0, 0); }
            if (J == I) {
#pragma unroll
                for (int i = 0; i < 4; ++i) at[J][i] = (4 * g + i <= r) ? at[J][i] : 0.f; } } }
    hbf16x8 pf[2];
#pragma unroll
    for (int k2 = 0; k2 < 2; ++k2) { const float x[8] = {at[2 * k2][0], at[2 * k2][1], at[2 * k2][2], at[2 * k2][3], at[2 * k2 + 1][0], at[2 * k2 + 1][1], at[2 * k2 + 1][2], at[2 * k2 + 1][3]}; pf[k2] = pack8(x); }
    f32x4 o[4];
#pragma unroll
    for (int vtile = 0; vtile < 4; ++vtile) { f32x4 acc = {0.f, 0.f, 0.f, 0.f}; const int v = 16 * vtile + r;
#pragma unroll
        for (int ks = 0; ks < 2; ++ks) { const f32x4 s0 = sraw[vtile][ks][0], s1 = sraw[vtile][ks][1];
            const float x[8] = {s0[0], s0[1], s0[2], s0[3], s1[0], s1[1], s1[2], s1[3]};
            acc = __builtin_amdgcn_mfma_f32_16x16x32_bf16(qhf[ks], pack8(x), acc, 0, 0, 0); }
#pragma unroll
        for (int k2 = 0; k2 < 2; ++k2) { if (k2 == 0 || I >= 2) {
            const hbf16x4 v0 = *(const LAS hbf16x4*)(vt + v * (HG_VP * 2) + (32 * k2 + 4 * g) * 2), v1 = *(const LAS hbf16x4*)(vt + v * (HG_VP * 2) + (32 * k2 + 16 + 4 * g) * 2);
            const hbf16x8 vf = {v0[0], v0[1], v0[2], v0[3], v1[0], v1[1], v1[2], v1[3]};
            acc = __builtin_amdgcn_mfma_f32_16x16x32_bf16(pf[k2], vf, acc, 0, 0, 0); } }
        o[vtile] = acc; }
#pragma unroll
    for (int i = 0; i < 4; ++i) { float sq = 0.f;
#pragma unroll
        for (int vtile = 0; vtile < 4; ++vtile) sq += o[vtile][i] * o[vtile][i];
        sq += __shfl_xor(sq, 1); sq += __shfl_xor(sq, 2); sq += __shfl_xor(sq, 4); sq += __shfl_xor(sq, 8);
        const float rn = rsqrtf(sq * (1.0f / 64.0f) + EPS); const size_t row = row0 + 16 * I + 4 * g + i;
#pragma unroll
        for (int vtile = 0; vtile < 4; ++vtile) { const int v = 16 * vtile + r; const float gg = bf2f(graw[i][vtile]);
            MIX[row * DM + h * 64 + v] = (bf16_t)f2bf(o[vtile][i] * rn * hgn[v] * (gg / (1.0f + __expf(-gg)))); } }
}

struct Args { const float* in[14]; float* out; unsigned char* ws; int ph_lo, ph_hi; };
constexpr int NPHASE = 1 + 7 * DEPTH;

__global__ void __launch_bounds__(512, 2) fwd(Args a) {
    extern __shared__ __attribute__((aligned(16))) unsigned char lds[];
    cg::grid_group grid = cg::this_grid();
    LAS unsigned char* L = (LAS unsigned char*)lds;
    if (threadIdx.x < 32) ((LAS unsigned*)(L + LDS_BYTES - 128))[threadIdx.x] = 0u;
    __syncthreads();
    for (int ph = a.ph_lo; ph < a.ph_hi; ++ph) {
        int G = gridDim.x, bx = blockIdx.x; asm volatile("" : "+s"(G), "+s"(bx));
        typedef const __attribute__((address_space(4))) Args* KArgP;
        KArgP ap = (KArgP)__builtin_amdgcn_kernarg_segment_ptr(); asm volatile("" : "+s"(ap));
        unsigned char* ws = ap->ws;
        float* SS = (float*)(ws + WS_SS); float* LB = (float*)(ws + WS_LB);
        bf16_t* XB = (bf16_t*)(ws + WS_XB); bf16_t* MIX = (bf16_t*)(ws + WS_MIX); bf16_t* UB = (bf16_t*)(ws + WS_U);
        unsigned char* P = ws + WS_P;
#ifdef PROBE_T
        if (ph == NPHASE) {
            if (bx == 0) { const unsigned long long* ts_ = (const unsigned long long*)(ws + 65536); unsigned long long sa = 0, sb = 0;
                for (int p = 1; p < NPHASE; ++p) { const int kk_ = (p - 1) % 7; const unsigned long long d = ts_[p] - ts_[p - 1]; if (PROBE_A(kk_)) sa += d; if (PROBE_B(kk_)) sb += d; }
                const float fa = (float)sa * 1e-3f, fb = (float)sb * 1e-3f; float* o_ = ap->out;
                for (int i = threadIdx.x; i < (1 << 20); i += 512) o_[(1 << 20) + i] += fb;
                if (threadIdx.x == 0) o_[0] = fa; }
        } else
#endif
        if (ph == 0) {
            int tid = threadIdx.x; asm volatile("" : "+v"(tid)); const int lane = tid & 63, wave = __builtin_amdgcn_readfirstlane(tid >> 6);
            LAS float* scr = (LAS float*)(L + wave * 16384);
            const int gw = bx * 8 + wave, NGW = G * 8;
            constexpr int I_IN = 16 * 112, I_OUT = 16 * 32, I_1 = 16 * 128, I_2 = 64 * 32, I_L = I_IN + I_OUT + I_1 + I_2;
            for (int it = gw; it < DEPTH * I_L; it += NGW) {
                const int l = it / I_L; int r = it % I_L;
                unsigned char* wl = ws + WS_W + (size_t)l * W_LAYER;
                if (r < I_IN) { const int kb = r / 112, nb = r % 112, n0 = nb * 32, pn = n0 >> 8, p = n0 & 255, slot = 4 * pn + ((p & 127) >> 5), sc0 = 64 * slot + 32 * (p >> 7);
                    tr_item(ap->in[3] + (size_t)l * DM * INC, INC, INC, sc0, kb * 64, ap->in[2] + l * DM, (bf16_t*)wl, DM, n0, scr, lane); continue; }
                r -= I_IN;
                if (r < I_OUT) { const int kb = r / 32, nb = r % 32; tr_item(ap->in[10] + (size_t)l * DM * DM, DM, DM, nb * 32, kb * 64, nullptr, (bf16_t*)(wl + W_OUT), DM, nb * 32, scr, lane); continue; }
                r -= I_OUT;
                if (r < I_1) { const int kb = r / 128, nb = r % 128; tr_item(ap->in[12] + (size_t)l * DM * DFF, DFF, DFF, nb * 32, kb * 64, ap->in[11] + l * DM, (bf16_t*)(wl + W_1), DM, nb * 32, scr, lane); continue; }
                r -= I_1;
                { const int kb = r / 32, nb = r % 32; tr_item(ap->in[13] + (size_t)l * DFF * DM, DM, DM, nb * 32, kb * 64, nullptr, (bf16_t*)(wl + W_2), DFF, nb * 32, scr, lane); }
            }
            const float* x = ap->in[0];
            for (int m = gw; m < M; m += NGW) {
                const f32x4* xr = (const f32x4*)(x + (size_t)m * DM) + lane; f32x4 v[4]; float s = 0.f;
#pragma unroll
                for (int j = 0; j < 4; ++j) { v[j] = xr[64 * j]; s += (v[j][0] * v[j][0] + v[j][1] * v[j][1]) + (v[j][2] * v[j][2] + v[j][3] * v[j][3]); }
                const float tot = wave_sum(s);
                u32x2* o8 = (u32x2*)(XB + (size_t)m * DM) + lane;
#pragma unroll
                for (int j = 0; j < 4; ++j) { u32x2 w; w.x = pk2(v[j][0], v[j][1]); w.y = pk2(v[j][2], v[j][3]); o8[64 * j] = w; }
                if (lane < 16) SS[(size_t)m * 16 + lane] = (lane == 0) ? tot : 0.f;
            }
            if (bx == 2 && tid < 64) ((unsigned*)ws)[tid] = 0u;
            if (bx == 3) for (int i = tid; i < XCD_BAR_WORDS; i += 512) ((unsigned*)(ws + WS_BAR))[i] = 0u;
            if (bx == 1) {
                for (int i = tid; i < 1024; i += 512) { const int l = i >> 8, wh = (i >> 6) & 3, d = i & 63; LB[2048 + i] = ap->in[5 + wh][l * 64 + d]; }
                if (tid < 32) { const int l = tid >> 3, e = tid & 7; LB[3072 + tid] = (e < 6) ? ap->in[9][l * 6 + e] : 0.f; }
            }
            if (bx == 0 && tid < 256) {
                const float* lg = ap->in[1]; float e[DEPTH]; float mx = -1e30f, sum = 0.f;
#pragma unroll
                for (int l = 0; l < DEPTH; ++l) mx = fmaxf(mx, lg[l * 256 + tid]);
#pragma unroll
                for (int l = 0; l < DEPTH; ++l) { e[l] = expf(lg[l * 256 + tid] - mx); sum += e[l]; }
                float c = 0.f;
#pragma unroll
                for (int l = 0; l < DEPTH; ++l) { if (l > 0) c += e[l] / sum; LB[l * 512 + tid] = logf(fmaxf(c, 1e-30f)); LB[l * 512 + 256 + tid] = 1.0f - c; }
            }
        } else {
            const int l = (ph - 1) / 7, k = (ph - 1) % 7;
#ifdef REP_K
            const int nrep = (k == REP_K) ? 2 : 1;
#else
            const int nrep = 1;
#endif
            for (int rep = 0; rep < nrep; ++rep) {
            if (rep) { XcdBarrier xb_; xb_.bar = (unsigned*)(ws + WS_BAR); xb_.x = xb_xcc_id(); xb_.st = (volatile LAS unsigned*)(L + LDS_BYTES - 128); xcd_barrier(xb_); }
            unsigned char* wl = ws + WS_W + (size_t)l * W_LAYER;
            if (k == 0) {
                pg8::Gemm g{XB, (const bf16_t*)wl, M, NIN, DM}; pg8::StaticOrder S; S.init(M, NIN, G, bx);
                EpiInProj E{SS, P, LB + l * 512, LB + 2048 + l * 256, LB + 3072 + l * 8};
                pg8::gemm_phase<EpiInProj, pg8::StaticOrder, true, true>(L, g, S, E);
            } else if (k == 1) {
                int tid = threadIdx.x; asm volatile("" : "+v"(tid));
                unsigned* ctr = (unsigned*)ws + l * 16 + 1 + rep * 4;
                volatile LAS int* sh = (volatile LAS int*)(L + LDS_BYTES - 64);
                int nxt = 0; if (tid == 0) nxt = (int)atomicAdd(ctr, 1u);
                for (;;) {
                    if (tid == 0) sh[0] = nxt;
                    __syncthreads();
                    const int idx = __builtin_amdgcn_readfirstlane(sh[0]);
                    __syncthreads();
                    if (idx >= 816 + 1024) break;
                    if (tid == 0) nxt = (int)atomicAdd(ctr, 1u);
                    if (idx < 768) { const int qb = 15 - idx / 48, bh = idx % 48, b = bh / 6, h = bh % 6; typedef attn_body::bf16 abf;
                        attn_body::sb_unit(qb, (const abf*)(P + P_SQ) + (size_t)bh * SEQ * 64, (const abf*)(P + P_SQ + HEADBUF) + (size_t)bh * SEQ * 64, (const abf*)(P + P_SQ + 2 * HEADBUF) + (size_t)bh * SEQ * 64,
                                           (abf*)MIX + (size_t)b * SEQ * DM + 256 + h * 64, (char*)lds); }
                    else if (idx < 816) fox_cumsum_item(idx - 768, (const float*)(P + P_LF), (float*)(P + P_CC), (int*)(ws + WS_JS), LB + 2048 + l * 256 + 128, LB + 2048 + l * 256 + 192, (LAS float*)L);
                    else hgrn_a_item(idx - 816, P, (float*)(ws + WS_DD), L);
                    __syncthreads();
                }
            } else if (k == 2) {
                hgrn_b_scan(bx, G, P, (const float*)(ws + WS_DD));
            } else if (k == 3) {
                int tid = threadIdx.x; asm volatile("" : "+v"(tid));
                unsigned* ctr = (unsigned*)ws + l * 16 + rep * 4;
                volatile LAS int* sh = (volatile LAS int*)(L + LDS_BYTES - 64);
                int nxt = 0; if (tid == 0) nxt = (int)atomicAdd(ctr, 1u);
                for (;;) {
                    if (tid == 0) sh[0] = nxt;
                    __syncthreads();
                    const int idx = __builtin_amdgcn_readfirstlane(sh[0]);
                    __syncthreads();
#ifdef PROBE_FOX
                    if (idx >= 768 + 1024 || (rep && idx >= 768)) break;
#else
                    if (idx >= 768 + 1024) break;
#endif
                    if (tid == 0) nxt = (int)atomicAdd(ctr, 1u);
                    if (idx >= 768) { hgrn_c_item(idx - 768, P, MIX, ap->in[4] + l * 64, L); __syncthreads(); continue; }
                    const int qb = 15 - idx / 48, bh = idx % 48, b = bh / 6, h = bh % 6;
                    typedef attn_body::bf16 abf;
                    const int jstart = ((const int*)(ws + WS_JS))[bh * 16 + qb];
#ifdef PROBE_FOX
                    if (rep) attn_body::attn_unit<30, PROBE_FOX_BIAS>(qb, PROBE_FOX_JS(jstart), (const abf*)(P + P_FQ) + (size_t)bh * SEQ * 64, (const abf*)(P + P_FQ + HEADBUF) + (size_t)bh * SEQ * 64, (const abf*)(P + P_FQ + 2 * HEADBUF) + (size_t)bh * SEQ * 64,
                                            (abf*)ap->out + (size_t)b * SEQ * DM + 640 + h * 64, (const float*)(P + P_CC) + (size_t)bh * SEQ, (char*)lds);
                    else
#endif
                    attn_body::attn_unit<30>(qb, jstart, (const abf*)(P + P_FQ) + (size_t)bh * SEQ * 64, (const abf*)(P + P_FQ + HEADBUF) + (size_t)bh * SEQ * 64, (const abf*)(P + P_FQ + 2 * HEADBUF) + (size_t)bh * SEQ * 64,
                                            (abf*)MIX + (size_t)b * SEQ * DM + 640 + h * 64, (const float*)(P + P_CC) + (size_t)bh * SEQ, (char*)lds);
                }
            } else if (k == 5) {
                pg8::Gemm g{XB, (const bf16_t*)(wl + W_1), M, DFF, DM}; pg8::StaticOrder S; S.init(M, DFF, G, bx);
                EpiRelu2 E{UB, SS};
                pg8::gemm_phase<EpiRelu2, pg8::StaticOrder, true, true>(L, g, S, E);
            } else {
                const bool ff2 = (k == 6);
                pg8::Gemm g{ff2 ? UB : MIX, (const bf16_t*)(wl + (ff2 ? W_2 : W_OUT)), M, DM, ff2 ? DFF : DM}; pg8::StaticOrder S; S.init(M, DM, G, bx);
                EpiResid E{XB, (ff2 && l == DEPTH - 1) ? ap->out : nullptr, SS};
                pg8::gemm_phase<EpiResid, pg8::StaticOrder, true, true>(L, g, S, E);
            }
            }
        }
#ifdef PROBE_T
        if (bx == 0 && threadIdx.x == 0) ((unsigned long long*)(ws + 65536))[ph] = __builtin_amdgcn_s_memrealtime();
#endif
        if (ph + 1 < a.ph_hi) {
            if (ph == 0) {
                grid.sync();
                (void)xcd_barrier_post((unsigned*)(ws + WS_BAR), (volatile LAS unsigned*)(L + LDS_BYTES - 128));
            } else {
                XcdBarrier xb_; xb_.bar = (unsigned*)(ws + WS_BAR); xb_.x = xb_xcc_id(); xb_.st = (volatile LAS unsigned*)(L + LDS_BYTES - 128);
                xcd_barrier(xb_);
            }
        }
    }
}

#ifndef MK_MULTI
#define MK_MULTI 0
#endif
extern "C" void kernel_launch(void* const* d_in, const int* in_sizes, int n_in, void* d_out, int out_size, void* d_ws, size_t ws_size, hipStream_t stream) {
    static int grid = 0;
    if (grid == 0) {
        int dev = 0, cus = 0, per = 0;
        if (n_in != 14 || out_size != M * DM || ws_size < WS_END) { fprintf(stderr, "kernel_launch: unexpected shapes (n_in %d out %d ws %zu)\n", n_in, out_size, ws_size); grid = -1; return; }
        (void)hipGetDevice(&dev); (void)hipDeviceGetAttribute(&cus, hipDeviceAttributeMultiprocessorCount, dev);
        (void)hipFuncSetAttribute((const void*)fwd, hipFuncAttributeMaxDynamicSharedMemorySize, LDS_BYTES);
        (void)hipOccupancyMaxActiveBlocksPerMultiprocessor(&per, (const void*)fwd, 512, LDS_BYTES);
        if (per < 1) per = 1;
        grid = cus * per;
        fprintf(stderr, "kernel_launch: grid %d (cus %d x %d)\n", grid, cus, per);
    }
    if (grid < 0) return;
    Args a{};
    for (int i = 0; i < 14; ++i) a.in[i] = (const float*)d_in[i];
    a.out = (float*)d_out; a.ws = (unsigned char*)d_ws;
#if MK_MULTI
    for (int ph = 0; ph < NPHASE; ++ph) { a.ph_lo = ph; a.ph_hi = ph + 1; hipLaunchKernelGGL(fwd, dim3(grid), dim3(512), LDS_BYTES, stream, a); }
#else
#ifdef PROBE_T
    a.ph_lo = 0; a.ph_hi = NPHASE + 1;
#else
    a.ph_lo = 0; a.ph_hi = NPHASE;
#endif
    void* args[] = {&a};
    hipError_t e = hipLaunchCooperativeKernel((const void*)fwd, dim3(grid), dim3(512), args, LDS_BYTES, stream);
    if (e != hipSuccess) fprintf(stderr, "kernel_launch: cooperative launch failed: %s (grid %d)\n", hipGetErrorString(e), grid);
#endif
}
```

```cpp
#include <hip/hip_runtime.h>
#include <hip/hip_cooperative_groups.h>
#include <cstdio>
#include <cstdint>
namespace cg = cooperative_groups;
namespace pg8 {
#define PG8_LAS __attribute__((address_space(3)))
typedef unsigned short bf16_t;
typedef short bf16x8 __attribute__((ext_vector_type(8)));
typedef float f32x4 __attribute__((ext_vector_type(4)));
typedef unsigned u32x4 __attribute__((ext_vector_type(4)));
constexpr int BM = 256, BK = 64, HALF = 128, HTB = HALF * BK * 2  , STAGE_BYTES = 8 * HTB, NXCD = 8, WGM = 8;

__host__ __device__ __forceinline__ int lds_byte(int r, int c) { const int st = (r >> 4) * 2 + (c >> 5), rr = r & 15, cc = c & 31, ob = rr * 64 + cc * 2; return st * 1024 + (ob ^ (((ob >> 9) & 1) << 5)); }
__host__ __device__ __forceinline__ void stage_rc(int b, int& R, int& C) { const int st = b / 1024, sb = b % 1024, swz = sb ^ (((sb >> 9) & 1) << 5); R = (st >> 1) * 16 + swz / 64; C = (st & 1) * 32 + (swz % 64) / 2; }
__host__ __device__ __forceinline__ int perm32(int rho) { const int n = rho >> 4, i = rho & 15; return 8 * (i >> 2) + 4 * n + (i & 3); }

struct Unit { int pm, pn; };
struct Gemm { const bf16_t* A; const bf16_t* Bt; int M, N, K; };

struct StaticOrder {
    int nM, nN, nwg, G, c;
    __host__ __device__ void init(int M, int N, int G_, int c_) { nM = M / BM; nN = N / BM; nwg = nM * nN; G = G_; c = c_; }
    __host__ __device__ bool next(int i, Unit& u) const {
        const long L = (long)i * G + c; if (L >= nwg) return false;
        int wgid = (int)L; { const int q = nwg / NXCD, r = nwg % NXCD, xcd = wgid % NXCD, off = wgid / NXCD; wgid = (xcd < r ? xcd * (q + 1) : r * (q + 1) + (xcd - r) * q) + off; }
        const int nig = WGM * nN, gid = wgid / nig, fm = gid * WGM, gsz = (nM - fm) < WGM ? (nM - fm) : WGM;
        u.pm = fm + ((wgid % nig) % gsz); u.pn = (wgid % nig) / gsz; return true;
    }
    __device__ __forceinline__ void a_ready(const Unit&) const {}
    __device__ __forceinline__ void done(const Unit&) const {}
};

__device__ __forceinline__ unsigned cvt_pk_bf16(float lo, float hi) { unsigned r; asm volatile("v_cvt_pk_bf16_f32 %0, %1, %2" : "=v"(r) : "v"(lo), "v"(hi)); return r; }
typedef float f32x2 __attribute__((ext_vector_type(2)));
template <class Epi, class Sched, bool ALIGN_EPI = false, bool SP2 = false>
__device__ __forceinline__ void gemm_phase(PG8_LAS unsigned char* lds, const Gemm g, const Sched& S, const Epi& E) {
    int tid_ = threadIdx.x; asm volatile("" : "+v"(tid_));
    const int tid = tid_, wid = __builtin_amdgcn_readfirstlane(tid >> 6), lane = tid & 63, wr = wid >> 2, wc = wid & 3, fr = lane & 15, fq = lane >> 4;
    const int K = g.K, nt = K / BK;
    unsigned voffA[2], voffB[2];
#pragma unroll
    for (int i = 0; i < 2; ++i) { int R, C; stage_rc(tid * 16 + i * 8192, R, C); const int Rb = Epi::PERM ? ((R & ~31) + perm32(R & 31)) : R;
        voffA[i] = (unsigned)(R * K + C) * 2u; voffB[i] = (unsigned)(Rb * K + C) * 2u; }
    const size_t kstep = (size_t)(BK * 2);
    const size_t hstep = (size_t)HALF * K * 2;
    const size_t tstep = 2 * hstep;
    const unsigned ldsw = (unsigned)wid * 1024u;
    const int aoff = lds_byte(wr * 64 + fr, fq * 8), boff = lds_byte(wc * 32 + fr, fq * 8);
#define PG8_SA(b, h) (((b) * 2 + (h)) * HTB)
#define PG8_SB(b, h) ((4 + (b) * 2 + (h)) * HTB)
#define PG8_STAGE(bufoff, gbase, voff) do { _Pragma("unroll") for (int _i = 0; _i < 2; ++_i) \
        __builtin_amdgcn_global_load_lds((const unsigned*)((const char*)(gbase) + (voff)[_i]), (PG8_LAS unsigned*)(lds + (bufoff) + ldsw + _i * 8192), 16, 0, 0); } while (0)
#define PG8_LDA(dst, b, h) do { _Pragma("unroll") for (int m = 0; m < 4; ++m) _Pragma("unroll") for (int k = 0; k < 2; ++k) dst[m][k] = *(const PG8_LAS bf16x8*)(lds + PG8_SA(b, h) + aoff + m * 2048 + k * 1024); } while (0)
#define PG8_LDB(dst, b, h) do { _Pragma("unroll") for (int n = 0; n < 2; ++n) _Pragma("unroll") for (int k = 0; k < 2; ++k) dst[n][k] = *(const PG8_LAS bf16x8*)(lds + PG8_SB(b, h) + boff + n * 2048 + k * 1024); } while (0)
#define PG8_MMA(ai, bj, At, Bt) do { __builtin_amdgcn_s_setprio(1); _Pragma("unroll") for (int m = 0; m < 4; ++m) _Pragma("unroll") for (int n = 0; n < 2; ++n) _Pragma("unroll") for (int k = 0; k < 2; ++k) \
        acc[ai][bj][m][n] = __builtin_amdgcn_mfma_f32_16x16x32_bf16(Bt[n][k], At[m][k], acc[ai][bj][m][n], 0, 0, 0); __builtin_amdgcn_s_setprio(0); } while (0)
#define PG8_WAIT_V(n) asm volatile("s_waitcnt vmcnt(" #n ")" ::: "memory")
#define PG8_WAIT_L(n) asm volatile("s_waitcnt lgkmcnt(" #n ")" ::: "memory")
#define PG8_BAR __builtin_amdgcn_s_barrier()
#define PG8_SCHED __builtin_amdgcn_sched_barrier(0)
    Unit cur, nxt; int ui = 0;
    if (!S.next(0, cur)) return;
    f32x4 acc[2][2][4][2];
#pragma unroll
    for (int a = 0; a < 2; ++a)
#pragma unroll
        for (int b = 0; b < 2; ++b)
#pragma unroll
            for (int m = 0; m < 4; ++m)
#pragma unroll
                for (int n = 0; n < 2; ++n) acc[a][b][m][n] = (f32x4){0.f, 0.f, 0.f, 0.f};
    bf16x8 At[4][2], B0[2][2], B1[2][2];
    const char* cA = (const char*)g.A + (size_t)cur.pm * tstep; const char* cB = (const char*)g.Bt + (size_t)cur.pn * tstep;
    S.a_ready(cur);
    if constexpr (SP2) {
        PG8_STAGE(PG8_SB(0, 0), cB, voffB); PG8_STAGE(PG8_SB(0, 1), cB + hstep, voffB); PG8_STAGE(PG8_SA(0, 0), cA, voffA); PG8_STAGE(PG8_SA(0, 1), cA + hstep, voffA);
        if (wr == 1) PG8_BAR;
        PG8_WAIT_V(2); PG8_BAR;
        PG8_STAGE(PG8_SB(1, 0), cB + kstep, voffB); PG8_STAGE(PG8_SA(1, 0), cA + kstep, voffA); PG8_STAGE(PG8_SB(1, 1), cB + hstep + kstep, voffB);
        PG8_WAIT_V(6); PG8_BAR;
    } else {
        PG8_STAGE(PG8_SB(0, 0), cB, voffB); PG8_STAGE(PG8_SA(0, 0), cA, voffA); PG8_STAGE(PG8_SB(0, 1), cB + hstep, voffB); PG8_STAGE(PG8_SA(0, 1), cA + hstep, voffA);
        if (wr == 1) PG8_BAR;
        PG8_WAIT_V(4); PG8_BAR;
        PG8_STAGE(PG8_SB(1, 0), cB + kstep, voffB); PG8_STAGE(PG8_SA(1, 0), cA + kstep, voffA); PG8_STAGE(PG8_SB(1, 1), cB + hstep + kstep, voffB);
        PG8_WAIT_V(6); PG8_BAR;
    }
    for (;;) {
        const bool has_next = S.next(ui + 1, nxt);
        const char* nA = has_next ? (const char*)g.A + (size_t)nxt.pm * tstep : cA; const char* nB = has_next ? (const char*)g.Bt + (size_t)nxt.pn * tstep : cB;
        for (int t = 0; t < nt; t += 2) {
            const bool last = (t == nt - 2);
            const char* a1 = cA + (size_t)(t + 1) * kstep;
            const char* a2 = last ? nA : cA + (size_t)(t + 2) * kstep; const char* b2 = last ? nB : cB + (size_t)(t + 2) * kstep;
            const char* a3 = a2 + kstep; const char* b3 = b2 + kstep;
            if (last && has_next) S.a_ready(nxt);
            if constexpr (SP2) {
            PG8_LDB(B0, 0, 0); PG8_LDB(B1, 0, 1); PG8_SCHED; PG8_LDA(At, 0, 0); PG8_STAGE(PG8_SA(1, 1), a1 + hstep, voffA);
            PG8_WAIT_V(8); PG8_WAIT_L(0); PG8_BAR; PG8_MMA(0, 0, At, B0); PG8_MMA(0, 1, At, B1); PG8_BAR; PG8_SCHED;
            PG8_LDA(At, 0, 1); PG8_STAGE(PG8_SB(0, 0), b2, voffB); PG8_STAGE(PG8_SB(0, 1), b2 + hstep, voffB); PG8_STAGE(PG8_SA(0, 0), a2, voffA);
            PG8_WAIT_V(8); PG8_WAIT_L(0); PG8_BAR; PG8_MMA(1, 0, At, B0); PG8_MMA(1, 1, At, B1); PG8_BAR; PG8_SCHED;
            PG8_LDB(B0, 1, 0); PG8_LDB(B1, 1, 1); PG8_SCHED; PG8_LDA(At, 1, 0); PG8_STAGE(PG8_SA(0, 1), a2 + hstep, voffA);
            PG8_WAIT_V(8); PG8_WAIT_L(0); PG8_BAR; PG8_MMA(0, 0, At, B0); PG8_MMA(0, 1, At, B1); PG8_BAR; PG8_SCHED;
            PG8_LDA(At, 1, 1); PG8_STAGE(PG8_SB(1, 0), b3, voffB); PG8_STAGE(PG8_SB(1, 1), b3 + hstep, voffB); PG8_STAGE(PG8_SA(1, 0), a3, voffA);
            PG8_WAIT_V(8); PG8_WAIT_L(0); PG8_BAR; PG8_MMA(1, 0, At, B0); PG8_MMA(1, 1, At, B1); PG8_BAR; PG8_SCHED;
            } else {
            PG8_LDB(B0, 0, 0); PG8_SCHED; PG8_LDA(At, 0, 0); PG8_STAGE(PG8_SA(1, 1), a1 + hstep, voffA);
            PG8_WAIT_L(8); PG8_BAR; PG8_WAIT_L(0); PG8_MMA(0, 0, At, B0); PG8_BAR; PG8_SCHED;
            PG8_LDB(B1, 0, 1); PG8_STAGE(PG8_SB(0, 0), b2, voffB);
            PG8_BAR; PG8_WAIT_L(0); PG8_MMA(0, 1, At, B1); PG8_BAR;
            PG8_LDA(At, 0, 1); PG8_STAGE(PG8_SA(0, 0), a2, voffA);
            PG8_BAR; PG8_WAIT_L(0); PG8_MMA(1, 0, At, B0); PG8_BAR; PG8_SCHED;
            PG8_STAGE(PG8_SB(0, 1), b2 + hstep, voffB);
            PG8_WAIT_V(6); PG8_BAR; PG8_MMA(1, 1, At, B1); PG8_BAR;
            PG8_LDB(B0, 1, 0); PG8_SCHED; PG8_LDA(At, 1, 0); PG8_STAGE(PG8_SA(0, 1), a2 + hstep, voffA);
            PG8_WAIT_L(8); PG8_BAR; PG8_WAIT_L(0); PG8_MMA(0, 0, At, B0); PG8_BAR; PG8_SCHED;
            PG8_LDB(B1, 1, 1); PG8_STAGE(PG8_SB(1, 0), b3, voffB);
            PG8_BAR; PG8_WAIT_L(0); PG8_MMA(0, 1, At, B1); PG8_BAR;
            PG8_LDA(At, 1, 1); PG8_STAGE(PG8_SA(1, 0), a3, voffA);
            PG8_BAR; PG8_WAIT_L(0); PG8_MMA(1, 0, At, B0); PG8_BAR; PG8_SCHED;
            PG8_STAGE(PG8_SB(1, 1), b3 + hstep, voffB);
            PG8_WAIT_V(6); PG8_BAR; PG8_MMA(1, 1, At, B1); PG8_BAR;
            }
        }
        if constexpr (ALIGN_EPI) { if (wr == 0) PG8_BAR; }
        if constexpr (!Epi::AFTER_DRAIN) { E(acc, cur, wr, wc, fr, fq); S.done(cur); }
        if (!has_next) break;
#pragma unroll
        for (int a = 0; a < 2; ++a)
#pragma unroll
            for (int b = 0; b < 2; ++b)
#pragma unroll
                for (int m = 0; m < 4; ++m)
#pragma unroll
                    for (int n = 0; n < 2; ++n) acc[a][b][m][n] = (f32x4){0.f, 0.f, 0.f, 0.f};
        cur = nxt; cA = nA; cB = nB; ++ui;
        if constexpr (ALIGN_EPI) { if (wr == 1) PG8_BAR; }
    }
    PG8_WAIT_V(0);
    if constexpr (!ALIGN_EPI) { if (wr == 0) PG8_BAR; }
    PG8_BAR;
    if constexpr (Epi::AFTER_DRAIN) { E.fused(acc, cur, wr, wc, fr, fq, lds, wid, lane); S.done(cur); }
#undef PG8_SA
#undef PG8_SB
#undef PG8_STAGE
#undef PG8_LDA
#undef PG8_LDB
#undef PG8_MMA
#undef PG8_WAIT_V
#undef PG8_WAIT_L
#undef PG8_BAR
#undef PG8_SCHED
}
}
#include <hip/hip_bf16.h>
#include <cmath>
namespace attn_body {
using bf16=__hip_bfloat16;
using bf16x8=__attribute__((ext_vector_type(8)))short;
using s16x4=__attribute__((ext_vector_type(4)))short;
using f32x16=__attribute__((ext_vector_type(16)))float;
using u32x4=__attribute__((ext_vector_type(4)))unsigned;
using f32x4v=__attribute__((ext_vector_type(4)))float;
constexpr int SEQ=4096,D=64,DM=64,OPITCH=1024;
constexpr int LDS_C=98304;
constexpr int NW=8,QBLK=32,QB=QBLK*NW,KVBLK=64,NQB=SEQ/QB;
constexpr int ATTN_UNIT_ROWS=QB;
__device__ __forceinline__ int crow(int r,int hi){return (r&3)+8*(r>>2)+4*hi;}
#define SBAR() __builtin_amdgcn_sched_barrier(0)
__device__ __forceinline__ void cmask(f32x16&p0,f32x16&p1,int jb,int qrel,int hi){
  const float NEG=-INFINITY; int kb=64*jb+4*hi;
  #pragma unroll
  for(int r=0;r<16;++r){int kv=kb+(r&3)+8*(r>>2); if(kv>qrel)p0[r]=NEG; if(kv+32>qrel)p1[r]=NEG;}
}

constexpr int NSLOT=3, SLOTB=8192;
constexpr int LDS_K=0, LDS_V=NSLOT*SLOTB, LDS_WS=2*NSLOT*SLOTB, LDS_OST=LDS_WS+NW*64*4, LDS_BYTES=LDS_OST+NW*4096;
constexpr float C2=0.125f*1.4426950408889634f;
__device__ __forceinline__ void glds16(const void*gsrc,unsigned lds_dst){unsigned keep;
  asm volatile("s_mov_b32 %0, m0\n\ts_mov_b32 m0, %2\n\ts_nop 0\n\tglobal_load_lds_dwordx4 %1, off\n\ts_mov_b32 m0, %0":"=&s"(keep):"v"(gsrc),"s"(lds_dst):"memory");}
__device__ __forceinline__ float max3f(float a,float b,float c){float r;asm("v_max3_f32 %0, %1, %2, %3":"=v"(r):"v"(a),"v"(b),"v"(c));return r;}
__device__ __forceinline__ float max2f(float a,float b){float r;asm("v_max_f32_e32 %0, %1, %2":"=v"(r):"v"(a),"v"(b));return r;}
__device__ __forceinline__ float fadd_s(float a,float b){float r;asm("v_add_f32_e32 %0, %1, %2":"=v"(r):"v"(a),"v"(b));return r;}
__device__ __forceinline__ float fsub_s(float a,float b){float r;asm("v_sub_f32_e32 %0, %1, %2":"=v"(r):"v"(a),"v"(b));return r;}
typedef float f32x2_t __attribute__((ext_vector_type(2))); typedef __bf16 bf16x2_t __attribute__((ext_vector_type(2)));
__device__ __forceinline__ unsigned cvtpk_s(float lo,float hi){f32x2_t v={lo,hi};bf16x2_t b=__builtin_convertvector(v,bf16x2_t);return __builtin_bit_cast(unsigned,b);}
#define WAIT_BAR(N) asm volatile("s_waitcnt vmcnt(" #N ") lgkmcnt(0)\n\ts_barrier":::"memory")

__device__ __forceinline__ void qkt(f32x16&p0,f32x16&p1,const char*Kslot,const bf16x8*qr,const f32x16&negm,int r32,int hi){
  const char*kb=Kslot+hi*1024+r32*16;
  #pragma unroll
  for(int d0=0;d0<4;++d0){
    const bf16x8 b0=*reinterpret_cast<const bf16x8*>(kb+d0*2048);
    const bf16x8 b1=*reinterpret_cast<const bf16x8*>(kb+d0*2048+512);
    if(d0==0){p0=__builtin_amdgcn_mfma_f32_32x32x16_bf16(b0,qr[0],negm,0,0,0);p1=__builtin_amdgcn_mfma_f32_32x32x16_bf16(b1,qr[0],negm,0,0,0);}
    else{p0=__builtin_amdgcn_mfma_f32_32x32x16_bf16(b0,qr[d0],p0,0,0,0);p1=__builtin_amdgcn_mfma_f32_32x32x16_bf16(b1,qr[d0],p1,0,0,0);}}
}
typedef __attribute__((address_space(3))) const char* lds_cptr;
typedef short v4i16_t __attribute__((ext_vector_type(4)));
__device__ __forceinline__ void kload8(bf16x8*kf,lds_cptr kp){
  kf[0]=*(const __attribute__((address_space(3))) bf16x8*)(kp);      kf[1]=*(const __attribute__((address_space(3))) bf16x8*)(kp+512);
  kf[2]=*(const __attribute__((address_space(3))) bf16x8*)(kp+2048); kf[3]=*(const __attribute__((address_space(3))) bf16x8*)(kp+2560);
  kf[4]=*(const __attribute__((address_space(3))) bf16x8*)(kp+4096); kf[5]=*(const __attribute__((address_space(3))) bf16x8*)(kp+4608);
  kf[6]=*(const __attribute__((address_space(3))) bf16x8*)(kp+6144); kf[7]=*(const __attribute__((address_space(3))) bf16x8*)(kp+6656);
}
__device__ __forceinline__ void kload2(bf16x8*kf,lds_cptr kp,int j){ kf[2*j]=*(const __attribute__((address_space(3))) bf16x8*)(kp+j*2048); kf[2*j+1]=*(const __attribute__((address_space(3))) bf16x8*)(kp+j*2048+512); }
__device__ __forceinline__ s16x4 vtr(lds_cptr p){ return __builtin_bit_cast(s16x4,__builtin_amdgcn_ds_read_tr16_b64_v4i16((__attribute__((address_space(3))) v4i16_t*)p)); }
__device__ __forceinline__ float rowmax(const f32x16&p0,const f32x16&p1){
  float a=max3f(p0[0],p0[1],p1[0]),b=max3f(p0[2],p0[3],p1[1]);a=max3f(a,p1[2],p1[3]);
  #pragma unroll
  for(int r=4;r<16;r+=4){a=max3f(a,p0[r],p0[r+1]);b=max3f(b,p0[r+2],p0[r+3]);a=max3f(a,p1[r],p1[r+1]);b=max3f(b,p1[r+2],p1[r+3]);}
  const float m=max2f(a,b);
  auto rr=__builtin_amdgcn_permlane32_swap(__float_as_uint(m),__float_as_uint(m),false,false);
  return max2f(__uint_as_float(rr[0]),__uint_as_float(rr[1]));
}
__device__ __forceinline__ void pv(f32x16*o,int vb,bf16x8 pa0,bf16x8 pa1,bf16x8 pa2,bf16x8 pa3){
  #pragma unroll
  for(int d0=0;d0<2;++d0){s16x4 lo[4],hi[4];
    #pragma unroll
    for(int ks=0;ks<4;++ks){
      asm volatile("ds_read_b64_tr_b16 %0,%1 offset:%c2":"=&v"(lo[ks]):"v"(vb),"i"(d0*4096+ks*1024):"memory");
      asm volatile("ds_read_b64_tr_b16 %0,%1 offset:%c2":"=&v"(hi[ks]):"v"(vb),"i"(d0*4096+ks*1024+512):"memory");}
    asm volatile("s_waitcnt lgkmcnt(0)":::"memory");SBAR();
    #define PK(k) (bf16x8){lo[k][0],lo[k][1],lo[k][2],lo[k][3],hi[k][0],hi[k][1],hi[k][2],hi[k][3]}
    o[d0]=__builtin_amdgcn_mfma_f32_32x32x16_bf16(pa0,PK(0),o[d0],0,0,0);
    o[d0]=__builtin_amdgcn_mfma_f32_32x32x16_bf16(pa1,PK(1),o[d0],0,0,0);
    o[d0]=__builtin_amdgcn_mfma_f32_32x32x16_bf16(pa2,PK(2),o[d0],0,0,0);
    o[d0]=__builtin_amdgcn_mfma_f32_32x32x16_bf16(pa3,PK(3),o[d0],0,0,0);
    #undef PK
  }
}

#ifndef ATTN_STORE16
#define ATTN_STORE16(p,v) (*(u32x4*)(p)=(v))
#endif
template<int THRL,bool BIASON=true> __device__ __forceinline__ void attn_unit(int qb,int jstart,const bf16*Q,const bf16*__restrict__ K,const bf16*__restrict__ V,bf16*O,const float*__restrict__ Cg,char*shm){
  int tid_=threadIdx.x; asm volatile("":"+v"(tid_)); const int tid=tid_,lane=tid&63,r32=lane&31,hi=lane>>5; const int wid=__builtin_amdgcn_readfirstlane(tid>>6);
  const int q0=qb*QB;
  const bf16*Qw=Q+(long)(q0+wid*QBLK)*DM;
  const bf16*Kh=K+(long)jstart*KVBLK*DM,*Vh=V+(long)jstart*KVBLK*DM;
  const lds_cptr shm3=(lds_cptr)shm;
  const unsigned lds0=(unsigned)(uintptr_t)shm;
  float*wsf=(float*)(shm+LDS_WS)+wid*64;
  const bf16*ksrc=Kh+(long)lane*DM+wid*8;
  const bf16*vsrc=Vh+(long)(16*(wid&3)+(lane>>2))*DM+(wid>>2)*32+(lane&3)*8;
  const unsigned kdst=lds0+LDS_K+wid*1024, vdst=lds0+LDS_V+wid*1024;
  #define DMA_K(t,slot) glds16(ksrc+(long)(t)*KVBLK*DM,(unsigned)__builtin_amdgcn_readfirstlane(kdst+(slot)))
  #define DMA_V(t,slot) glds16(vsrc+(long)(t)*KVBLK*DM,(unsigned)__builtin_amdgcn_readfirstlane(vdst+(slot)))
  const int vb0=(int)(lds0+LDS_V)+((lane>>4)&1)*32+(lane&3)*8+(4*hi+((lane&15)>>2))*64;
  const char*Kbase=shm+LDS_K; bf16x8 kf[8];
  const lds_cptr kp0=shm3+LDS_K+hi*1024+r32*16; const lds_cptr vp0=shm3+LDS_V+((lane>>4)&1)*32+(lane&3)*8+(4*hi+((lane&15)>>2))*64;
  const int NT=(q0+QB)/KVBLK-jstart;
  { typedef __attribute__((address_space(3))) f32x4v lf32x4; lf32x4*cl_=(lf32x4*)(shm3+LDS_C); const f32x4v*cg_=(const f32x4v*)(Cg+jstart*KVBLK); const int n4_=(q0+QB-jstart*KVBLK)>>2;
    f32x4v c0_=f32x4v{},c1_=f32x4v{}; if(tid<n4_)c0_=cg_[tid]; if(tid+NW*64<n4_)c1_=cg_[tid+NW*64]; if(tid<n4_)cl_[tid]=c0_; if(tid+NW*64<n4_)cl_[tid+NW*64]=c1_; }
  DMA_K(0,0);DMA_V(0,0);DMA_K(1,SLOTB);
  bf16x8 qr[4];
  #pragma unroll
  for(int d0=0;d0<4;++d0)qr[d0]=*reinterpret_cast<const bf16x8*>(&Qw[(long)r32*DM+d0*16+hi*8]);
  float mhat=0.f,l_reg=0.f;f32x16 o[2];o[0]=f32x16{};o[1]=f32x16{};
  const int qrel=wid*QBLK+r32;
  #define CMASK(P0,P1,t) do{int jb_=(t)-(NT-4); if(jb_>=0)cmask(P0,P1,jb_,qrel,hi);}while(0)
  typedef __attribute__((address_space(3))) const float* lds_fptr; typedef __attribute__((address_space(3))) const f32x4v* lds_f4ptr;
  const lds_fptr cl0=(lds_fptr)(shm3+LDS_C)+4*hi;
  #define BIAS(P0,P1,t) do{ const lds_fptr cb_=cl0+64*(t); _Pragma("unroll") for(int g_=0;g_<4;++g_){ const f32x4v a_=*(lds_f4ptr)(cb_+8*g_), b_=*(lds_f4ptr)(cb_+32+8*g_); \
      _Pragma("unroll") for(int i_=0;i_<4;++i_){P0[4*g_+i_]-=a_[i_];P1[4*g_+i_]-=b_[i_];} } }while(0)
  #define BIASINIT(C0_,C1_,t) do{ const lds_fptr cb_=cl0+64*(t); const float nm_=-mhat; _Pragma("unroll") for(int g_=0;g_<4;++g_){ f32x4v a_=f32x4v{},b_=f32x4v{}; if(BIASON){a_=*(lds_f4ptr)(cb_+8*g_); b_=*(lds_f4ptr)(cb_+32+8*g_);} \
      _Pragma("unroll") for(int i_=0;i_<4;++i_){C0_[4*g_+i_]=nm_-a_[i_];C1_[4*g_+i_]=nm_-b_[i_];} } }while(0)
  bool resc=false;
  #define START(P0,P1) do{ const float rm=rowmax(P0,P1); resc=false; \
    { const float dl=rm; mhat=fadd_s(mhat,dl); \
      _Pragma("unroll") for(int r=0;r<16;++r){P0[r]=fsub_s(P0[r],dl);P1[r]=fsub_s(P1[r],dl);} \
      } \
    _Pragma("unroll") for(int r=0;r<16;++r)P0[r]=__builtin_amdgcn_exp2f(P0[r]); }while(0)
  #define RESC() do{ if(resc){ asm volatile("s_waitcnt lgkmcnt(0)":::"memory"); \
      _Pragma("unroll") for(int d_=0;d_<2;++d_) _Pragma("unroll") for(int r=0;r<16;++r)o[d_][r]*=wsf[crow(r,hi)]; } }while(0)
  f32x16 pA0,pA1,pB0,pB1;
  int sl_prev=0,sl_cur=0,sl_next=SLOTB;
  #define ROT() do{sl_prev=sl_cur;sl_cur=sl_next;sl_next=(sl_next==(NSLOT-1)*SLOTB)?0:sl_next+SLOTB;}while(0)
  DMA_K(2,2*SLOTB);
  WAIT_BAR(3);
  { const f32x16 zero_=f32x16{}; qkt(pA0,pA1,Kbase,qr,zero_,r32,hi); }asm volatile("s_nop 15\n\ts_nop 7":"+v"(pA0),"+v"(pA1));BIAS(pA0,pA1,0);CMASK(pA0,pA1,0);
  START(pA0,pA1);
  BIASINIT(pB0,pB1,1);
  _Pragma("unroll") for(int r=0;r<16;++r)pA1[r]=__builtin_amdgcn_exp2f(pA1[r]);
  WAIT_BAR(0);
  DMA_K(3,0);DMA_V(1,SLOTB);
  ROT();
  kload8(kf,kp0+sl_cur);
  WAIT_BAR(2);
  s16x4 vlo[8],vhi[8]; u32x4 pw0,pw1,pw2,pw3;
  #define PKW(P,B) cvtpk_s(P[B],P[B+1])
  #define PAF(k) __builtin_bit_cast(bf16x8,pw##k)
  #define VFR(i) (bf16x8){vlo[i][0],vlo[i][1],vlo[i][2],vlo[i][3],vhi[i][0],vhi[i][1],vhi[i][2],vhi[i][3]}
  #define PIN(x) asm volatile("":"+v"(x))
  #define MX3(a,b,c) __builtin_fmaxf(__builtin_fmaxf((a),(b)),(c))
  #define GAPA(MF,A0,A1,A2,A3,W0,W1,PW) do{ MF; sacc+=A0; sacc+=A1; sacc+=A2; sacc+=A3; PIN(sacc); W0; W1; PIN(PW); SBAR(); }while(0)
  #define EX(v) __builtin_amdgcn_exp2f(v)
  #define GAPB(MF,X,B) do{ MF; X[B]=EX(X[B]); X[B+1]=EX(X[B+1]); X[B+2]=EX(X[B+2]); X[B+3]=EX(X[B+3]); PIN(X); SBAR(); }while(0)
  #define VRD(i) do{ vlo[i]=vtr(vp_+(((i)>>2)*4096+((i)&3)*1024)); vhi[i]=vtr(vp_+(((i)>>2)*4096+((i)&3)*1024+512)); }while(0)
  #define KRD(G,j) do{ if(G){ kload2(kf,kp0+sl_next,j); SBAR(); } }while(0)
  #define STEP(C0,C1,P0,P1,t,GK,GV,GL) do{ SBAR(); \
    const lds_cptr vp_=vp0+sl_prev; \
    VRD(0); SBAR(); float sacc=(P0[0]+P0[1]); \
    GAPA(C0=__builtin_amdgcn_mfma_f32_32x32x16_bf16(kf[0],qr[0],C0,0,0,0), P0[2],P0[3],P0[4],P0[5],     pw0[0]=PKW(P0,0), pw0[1]=PKW(P0,2), pw0); \
    VRD(4); SBAR(); GAPA(C1=__builtin_amdgcn_mfma_f32_32x32x16_bf16(kf[1],qr[0],C1,0,0,0), P0[6],P0[7],P0[8],P0[9],     pw0[2]=PKW(P0,4), pw0[3]=PKW(P0,6), pw0); \
    VRD(1); SBAR(); GAPA(C0=__builtin_amdgcn_mfma_f32_32x32x16_bf16(kf[2],qr[1],C0,0,0,0),   P0[10],P0[11],P0[12],P0[13], pw1[0]=PKW(P0,8), pw1[1]=PKW(P0,10), pw1); \
    VRD(5); SBAR(); GAPA(C1=__builtin_amdgcn_mfma_f32_32x32x16_bf16(kf[3],qr[1],C1,0,0,0),   P0[14],P0[15],P1[0],P1[1],   pw1[2]=PKW(P0,12),pw1[3]=PKW(P0,14), pw1); \
    VRD(2); SBAR(); GAPA(C0=__builtin_amdgcn_mfma_f32_32x32x16_bf16(kf[4],qr[2],C0,0,0,0),   P1[2],P1[3],P1[4],P1[5],     pw2[0]=PKW(P1,0), pw2[1]=PKW(P1,2), pw2); \
    VRD(6); SBAR(); GAPA(C1=__builtin_amdgcn_mfma_f32_32x32x16_bf16(kf[5],qr[2],C1,0,0,0),   P1[6],P1[7],P1[8],P1[9],     pw2[2]=PKW(P1,4), pw2[3]=PKW(P1,6), pw2); \
    VRD(3); SBAR(); GAPA(C0=__builtin_amdgcn_mfma_f32_32x32x16_bf16(kf[6],qr[3],C0,0,0,0),   P1[10],P1[11],P1[12],P1[13], pw3[0]=PKW(P1,8), pw3[1]=PKW(P1,10), pw3); \
    VRD(7); SBAR(); GAPA(C1=__builtin_amdgcn_mfma_f32_32x32x16_bf16(kf[7],qr[3],C1,0,0,0),   P1[14],P1[15],0.f,0.f,       pw3[2]=PKW(P1,12),pw3[3]=PKW(P1,14), pw3); \
    l_reg+=sacc; \
    if(GK){DMA_K((t)+3,sl_cur);} if(GV){DMA_V((t)+1,sl_next);} \
    CMASK(C0,C1,t); \
    { float a=MX3(C0[0],C0[1],C1[0]),b=MX3(C0[2],C0[3],C1[1]); a=MX3(a,C1[2],C1[3]); \
      _Pragma("unroll") for(int r=4;r<16;r+=4){a=MX3(a,C0[r],C0[r+1]);b=MX3(b,C0[r+2],C0[r+3]);a=MX3(a,C1[r],C1[r+1]);b=MX3(b,C1[r+2],C1[r+3]);} \
      float rm=__builtin_fmaxf(a,b); { auto rr=__builtin_amdgcn_permlane32_swap(__float_as_uint(rm),__float_as_uint(rm),false,false); rm=__builtin_fmaxf(__uint_as_float(rr[0]),__uint_as_float(rr[1])); } \
      resc=false; \
      if(__builtin_expect(__any(rm>(float)THRL),0)){ const float dl=__builtin_fmaxf(rm+30.f,0.f); mhat+=dl; \
        _Pragma("unroll") for(int r=0;r<16;++r){C0[r]-=dl;C1[r]-=dl;} \
        const float f=__builtin_amdgcn_exp2f(-dl); l_reg*=f; if(hi==0)wsf[r32]=f; resc=true; } } \
    SBAR(); \
    GAPB(o[0]=__builtin_amdgcn_mfma_f32_32x32x16_bf16(PAF(0),VFR(0),o[0],0,0,0), C0,0); \
    GAPB(o[1]=__builtin_amdgcn_mfma_f32_32x32x16_bf16(PAF(0),VFR(4),o[1],0,0,0), C0,4); \
    KRD(GL,0); GAPB(o[0]=__builtin_amdgcn_mfma_f32_32x32x16_bf16(PAF(1),VFR(1),o[0],0,0,0), C0,8); \
    KRD(GL,1); GAPB(o[1]=__builtin_amdgcn_mfma_f32_32x32x16_bf16(PAF(1),VFR(5),o[1],0,0,0), C0,12); \
    KRD(GL,2); GAPB(o[0]=__builtin_amdgcn_mfma_f32_32x32x16_bf16(PAF(2),VFR(2),o[0],0,0,0), C1,0); \
    KRD(GL,3); GAPB(o[1]=__builtin_amdgcn_mfma_f32_32x32x16_bf16(PAF(2),VFR(6),o[1],0,0,0), C1,4); \
    GAPB(o[0]=__builtin_amdgcn_mfma_f32_32x32x16_bf16(PAF(3),VFR(3),o[0],0,0,0), C1,8); \
    GAPB(o[1]=__builtin_amdgcn_mfma_f32_32x32x16_bf16(PAF(3),VFR(7),o[1],0,0,0), C1,12); \
    BIASINIT(P0,P1,(t)+1); SBAR(); \
    }while(0)
  int t=1;
  #undef CMASK
  #define CMASK(P0,P1,t) do{}while(0)
  for(;t+5<NT;t+=2){
    STEP(pB0,pB1,pA0,pA1,t,true,true,true);     WAIT_BAR(2); RESC(); ROT();
    STEP(pA0,pA1,pB0,pB1,t+1,true,true,true);   WAIT_BAR(2); RESC(); ROT();
  }
  #undef CMASK
  #define CMASK(P0,P1,t) do{int jb_=(t)-(NT-4); if(jb_>=0)cmask(P0,P1,jb_,qrel,hi);}while(0)
  #define ENDW(tt) do{ if((tt)+3<NT){WAIT_BAR(2);} else if((tt)+2<NT){WAIT_BAR(1);} else {WAIT_BAR(0);} }while(0)
  for(;t+1<NT;t+=2){
    STEP(pB0,pB1,pA0,pA1,t,(t+3<NT),(t+1<NT),(t+1<NT));       ENDW(t);   RESC(); ROT();
    STEP(pA0,pA1,pB0,pB1,t+1,(t+4<NT),(t+2<NT),(t+2<NT));     ENDW(t+1); RESC(); ROT();
  }
  STEP(pB0,pB1,pA0,pA1,NT-1,false,false,false); RESC();
  { float sacc=pB0[0]+pB0[1]; _Pragma("unroll") for(int r=2;r<16;++r)sacc+=pB0[r]; _Pragma("unroll") for(int r=0;r<16;++r)sacc+=pB1[r]; l_reg+=sacc;
    pw0=(u32x4){PKW(pB0,0),PKW(pB0,2),PKW(pB0,4),PKW(pB0,6)};pw1=(u32x4){PKW(pB0,8),PKW(pB0,10),PKW(pB0,12),PKW(pB0,14)};pw2=(u32x4){PKW(pB1,0),PKW(pB1,2),PKW(pB1,4),PKW(pB1,6)};pw3=(u32x4){PKW(pB1,8),PKW(pB1,10),PKW(pB1,12),PKW(pB1,14)};
    SBAR(); pv(o,vb0+sl_cur,PAF(0),PAF(1),PAF(2),PAF(3)); }
  #undef PKW
  #undef PAF
  #undef VFR
  #undef PIN
  #undef MX3
  #undef GAPA
  #undef GAPB
  #undef EX
  #undef VRD
  #undef KRD
  #undef STEP
  #undef ENDW
  {auto rr=__builtin_amdgcn_permlane32_swap(__float_as_uint(l_reg),__float_as_uint(l_reg),false,false);l_reg=__uint_as_float(rr[0])+__uint_as_float(rr[1]);}
  if(hi==0)wsf[32+r32]=l_reg;asm volatile("s_waitcnt lgkmcnt(0)":::"memory");
  float rli[16];
  #pragma unroll
  for(int r=0;r<16;++r)rli[r]=__builtin_amdgcn_rcpf(wsf[32+crow(r,hi)]);
  bf16*Ow=O+(long)(q0+wid*QBLK)*OPITCH;
  { bf16*stg=(bf16*)(shm+LDS_OST)+wid*2048;
    #pragma unroll
    for(int r=0;r<16;++r){const int orow=crow(r,hi);
      #pragma unroll
      for(int d0=0;d0<2;++d0)stg[orow*64+d0*32+r32]=__float2bfloat16(o[d0][r]*rli[r]);}
    asm volatile("s_waitcnt lgkmcnt(0)":::"memory");
    #pragma unroll
    for(int i=0;i<4;++i){const int row=i*8+(lane>>3),ch=lane&7; const u32x4 v=*(const u32x4*)(stg+row*64+ch*8); ATTN_STORE16(Ow+(long)row*OPITCH+ch*8,v);} }
  asm volatile("s_waitcnt lgkmcnt(0)\n\ts_barrier":::"memory");
  #undef DMA_K
  #undef DMA_V
  #undef CMASK
  #undef BIAS
  #undef BIASINIT
  #undef START
  #undef RESC
  #undef ROT
}
__device__ __forceinline__ void sb_unit(int qb,const bf16*Q,const bf16*__restrict__ K,const bf16*__restrict__ V,bf16*O,char*shm){
  int tid_=threadIdx.x; asm volatile("":"+v"(tid_)); const int tid=tid_,lane=tid&63,r32=lane&31,hi=lane>>5; const int wid=__builtin_amdgcn_readfirstlane(tid>>6);
  const int q0=qb*QB;
  const bf16*Qw=Q+(long)(q0+wid*QBLK)*DM;
  const unsigned lds0=(unsigned)(uintptr_t)shm;
  typedef __attribute__((address_space(3))) int lds_i32; typedef __attribute__((address_space(3))) const u32x4* lds_u4ptr;
  lds_i32*flags=(lds_i32*)((lds_cptr)shm+LDS_WS);
  const bf16*ksrc=K+(long)lane*DM+wid*8;
  const bf16*vsrc=V+(long)(16*(wid&3)+(lane>>2))*DM+(wid>>2)*32+(lane&3)*8;
  const unsigned kdst=lds0+LDS_K+wid*1024, vdst=lds0+LDS_V+wid*1024;
  #define DMA_K(t,slot) glds16(ksrc+(long)(t)*KVBLK*DM,(unsigned)__builtin_amdgcn_readfirstlane(kdst+(slot)))
  #define DMA_V(t,slot) glds16(vsrc+(long)(t)*KVBLK*DM,(unsigned)__builtin_amdgcn_readfirstlane(vdst+(slot)))
  const int vb0=(int)(lds0+LDS_V)+((lane>>4)&1)*32+(lane&3)*8+(4*hi+((lane&15)>>2))*64;
  const int NT=(q0+QB)/KVBLK;
  DMA_K(NT-1,0);DMA_V(NT-1,0);
  bf16x8 qr[4];
  #pragma unroll
  for(int d0=0;d0<4;++d0)qr[d0]=*reinterpret_cast<const bf16x8*>(&Qw[(long)r32*DM+d0*16+hi*8]);
  f32x16 o[2];o[0]=f32x16{};o[1]=f32x16{};
  float T=1.0f; const int t_abs=q0+wid*QBLK+r32; bool wdone=false;
  for(int i=0;;++i){
    const int jt=NT-1-i; const int slot=(i&1)*SLOTB; const bool more=jt>0;
    if(more){DMA_K(jt-1,slot^SLOTB);DMA_V(jt-1,slot^SLOTB); WAIT_BAR(2);} else {WAIT_BAR(0);}
    const bool band=(jt>=NT-4);
    if(!(wdone||(band&&64*(jt-(NT-4))>=QBLK*wid+QBLK))){
    f32x16 x0,x1; { f32x16 zero=f32x16{}; qkt(x0,x1,shm+LDS_K+slot,qr,zero,r32,hi); }
    f32x16 n0,n1;
    const int kb=64*jt+4*hi;
    #pragma unroll
    for(int r=0;r<16;++r){
      const float z0=x0[r],z1=x1[r];
      const float e0=__builtin_amdgcn_exp2f(-__builtin_fabsf(z0)), e1=__builtin_amdgcn_exp2f(-__builtin_fabsf(z1));
      const float r0=__builtin_amdgcn_rcpf(1.0f+e0), r1=__builtin_amdgcn_rcpf(1.0f+e1), er0=e0*r0, er1=e1*r1;
      float b0=z0>0.f?r0:er0, m0=z0>0.f?er0:r0, b1=z1>0.f?r1:er1, m1=z1>0.f?er1:r1;
      if(band){ const int kv=kb+(r&3)+8*(r>>2); if(!(kv<t_abs)){b0=0.f;m0=1.f;} if(!(kv+32<t_abs)){b1=0.f;m1=1.f;} }
      x0[r]=b0;x1[r]=b1;n0[r]=m0;n1[r]=m1;
    }
    float g0[4],g1[4],p0s[4],p1s[4];
    #pragma unroll
    for(int a=0;a<4;++a){ g0[a]=(n0[4*a]*n0[4*a+1])*(n0[4*a+2]*n0[4*a+3]); g1[a]=(n1[4*a]*n1[4*a+1])*(n1[4*a+2]*n1[4*a+3]);
      { auto rr=__builtin_amdgcn_permlane32_swap(__float_as_uint(g0[a]),__float_as_uint(g0[a]),false,false); p0s[a]=__uint_as_float(hi?rr[0]:rr[1]); }
      { auto rr=__builtin_amdgcn_permlane32_swap(__float_as_uint(g1[a]),__float_as_uint(g1[a]),false,false); p1s[a]=__uint_as_float(hi?rr[0]:rr[1]); } }
    float run=T;
    #pragma unroll
    for(int a=3;a>=0;--a){ const float off=hi?run:run*p1s[a]; run*=g1[a]*p1s[a];
      const float t3=off,t2=t3*n1[4*a+3],t1=t2*n1[4*a+2],t0=t1*n1[4*a+1];
      x1[4*a+3]*=t3; x1[4*a+2]*=t2; x1[4*a+1]*=t1; x1[4*a]*=t0; }
    #pragma unroll
    for(int a=3;a>=0;--a){ const float off=hi?run:run*p0s[a]; run*=g0[a]*p0s[a];
      const float t3=off,t2=t3*n0[4*a+3],t1=t2*n0[4*a+2],t0=t1*n0[4*a+1];
      x0[4*a+3]*=t3; x0[4*a+2]*=t2; x0[4*a+1]*=t1; x0[4*a]*=t0; }
    T=run;
    u32x4 pw0,pw1,pw2,pw3;
    pw0=(u32x4){cvtpk_s(x0[0],x0[1]),cvtpk_s(x0[2],x0[3]),cvtpk_s(x0[4],x0[5]),cvtpk_s(x0[6],x0[7])};
    pw1=(u32x4){cvtpk_s(x0[8],x0[9]),cvtpk_s(x0[10],x0[11]),cvtpk_s(x0[12],x0[13]),cvtpk_s(x0[14],x0[15])};
    pw2=(u32x4){cvtpk_s(x1[0],x1[1]),cvtpk_s(x1[2],x1[3]),cvtpk_s(x1[4],x1[5]),cvtpk_s(x1[6],x1[7])};
    pw3=(u32x4){cvtpk_s(x1[8],x1[9]),cvtpk_s(x1[10],x1[11]),cvtpk_s(x1[12],x1[13]),cvtpk_s(x1[14],x1[15])};
    SBAR(); pv(o,vb0+slot,__builtin_bit_cast(bf16x8,pw0),__builtin_bit_cast(bf16x8,pw1),__builtin_bit_cast(bf16x8,pw2),__builtin_bit_cast(bf16x8,pw3));
    wdone=__all(T<1.2e-38f);
    }
    if(lane==0)flags[wid]=wdone?1:0;
    WAIT_BAR(2);
    const u32x4 f0=*(lds_u4ptr)(flags), f1=*(lds_u4ptr)(flags+4);
    const bool alld=((f0.x&f0.y&f0.z&f0.w)&(f1.x&f1.y&f1.z&f1.w))!=0;
    if(!more||alld)break;
  }
  WAIT_BAR(0);
  bf16*Ow=O+(long)(q0+wid*QBLK)*OPITCH;
  { bf16*stg=(bf16*)(shm+LDS_OST)+wid*2048;
    #pragma unroll
    for(int r=0;r<16;++r){const int orow=crow(r,hi);
      #pragma unroll
      for(int d0=0;d0<2;++d0)stg[orow*64+d0*32+r32]=__float2bfloat16(o[d0][r]);}
    asm volatile("s_waitcnt lgkmcnt(0)":::"memory");
    #pragma unroll
    for(int i=0;i<4;++i){const int row=i*8+(lane>>3),ch=lane&7; const u32x4 v=*(const u32x4*)(stg+row*64+ch*8); ATTN_STORE16(Ow+(long)row*OPITCH+ch*8,v);} }
  asm volatile("s_waitcnt lgkmcnt(0)\n\ts_barrier":::"memory");
  #undef DMA_K
  #undef DMA_V
}
#undef SBAR
#undef WAIT_BAR
}

constexpr int BATCH = 8, SEQ = 4096, DM = 1024, DEPTH = 4, M = BATCH * SEQ, INC = 3334, NIN = 3584, DFF = 4096;
constexpr float EPS = 1e-6f;
constexpr size_t MiB = 1u << 20;
constexpr size_t WS_BAR = 128 * 1024;
constexpr size_t WS_SS = 1 * MiB;
constexpr size_t WS_LB = 3 * MiB;
constexpr size_t WS_JS = 3 * MiB + 256 * 1024;
constexpr size_t WS_DD = 3 * MiB + 512 * 1024;
constexpr size_t WS_W = 4 * MiB;
constexpr size_t W_LAYER = 25 * MiB, W_OUT = 7 * MiB, W_1 = 9 * MiB, W_2 = 17 * MiB;
constexpr size_t WS_XB = 104 * MiB;
constexpr size_t WS_P = 168 * MiB;
constexpr size_t P_HQ = 0, P_HK = 16 * MiB, P_HI = 32 * MiB, P_HG = 48 * MiB, P_HLF = 64 * MiB, P_SQ = 96 * MiB, P_FQ = 168 * MiB, P_LF = 240 * MiB, P_CC = 241 * MiB, P_US = 242 * MiB;
constexpr size_t HEADBUF = 24 * MiB;
constexpr size_t WS_MIX = 442 * MiB;
constexpr size_t WS_U = 168 * MiB;
constexpr size_t WS_END = 506 * MiB;
constexpr int LDS_BYTES = 147456;

typedef pg8::bf16_t bf16_t;
typedef pg8::f32x4 f32x4;
typedef unsigned u32x4 __attribute__((ext_vector_type(4)));
typedef unsigned u32x2 __attribute__((ext_vector_type(2)));
#define LAS __attribute__((address_space(3)))

__device__ __forceinline__ unsigned f2bf(float f) { unsigned u = __builtin_bit_cast(unsigned, f); return (u + 0x7fffu + ((u >> 16) & 1u)) >> 16; }
__device__ __forceinline__ unsigned pk2(float lo, float hi) { return pg8::cvt_pk_bf16(lo, hi); }
__device__ __forceinline__ float bf2f(unsigned short b) { return __builtin_bit_cast(float, (unsigned)b << 16); }
__device__ __forceinline__ float bflo(unsigned w) { return __builtin_bit_cast(float, w << 16); }
__device__ __forceinline__ float bfhi(unsigned w) { return __builtin_bit_cast(float, w & 0xffff0000u); }
__device__ __forceinline__ float logsig(float x) { return fminf(x, 0.f) - log1pf(expf(-fabsf(x))); }
__device__ __forceinline__ float wave_sum(float v) {
#pragma unroll
    for (int o = 1; o < 64; o <<= 1) v += __shfl_xor(v, o);
    return v;
}
#define ROWSCALES8(rs, ss, row0, fq) float rs[2][4]; _Pragma("unroll") for (int ai_ = 0; ai_ < 2; ++ai_) _Pragma("unroll") for (int m_ = 0; m_ < 4; ++m_) rs[ai_][m_] = rowscale(ss, (row0) + ai_ * 128 + m_ * 16, fq);
__device__ __forceinline__ float rowscale(const float* ss, int row, int fq) {
    const f32x4 p = *(const f32x4*)(ss + (size_t)row * 16 + 4 * fq);
    float s = (p[0] + p[1]) + (p[2] + p[3]);
    s += __shfl_xor(s, 16); s += __shfl_xor(s, 32);
    return rsqrtf(s * (1.0f / DM) + EPS);
}

#define ROWFENCE() asm volatile("" ::: "memory")
struct EpiResid {
    static constexpr bool PERM = true, AFTER_DRAIN = false;
    bf16_t* xb; float* outf; float* ss;
    __device__ __forceinline__ void operator()(const f32x4 (&acc)[2][2][4][2], const pg8::Unit& u, int wr, int wc, int fr, int fq) const {
        const int row0 = u.pm * 256 + wr * 64 + fr, col0 = u.pn * 256 + wc * 32 + 8 * fq;
#pragma unroll
        for (int ai = 0; ai < 2; ++ai) {
            u32x4 pre[4][2];
#pragma unroll
            for (int m = 0; m < 4; ++m)
#pragma unroll
                for (int bj = 0; bj < 2; ++bj) pre[m][bj] = *(const u32x4*)(xb + (size_t)(row0 + ai * 128 + m * 16) * DM + col0 + bj * 128);
#pragma unroll
            for (int m = 0; m < 4; ++m) {
                const int row = row0 + ai * 128 + m * 16; float sq = 0.f;
#pragma unroll
                for (int bj = 0; bj < 2; ++bj) {
                    const size_t off = (size_t)row * DM + col0 + bj * 128; const u32x4 p = pre[m][bj];
                    const f32x4 v0 = acc[ai][bj][m][0] + (f32x4){bflo(p.x), bfhi(p.x), bflo(p.y), bfhi(p.y)}, v1 = acc[ai][bj][m][1] + (f32x4){bflo(p.z), bfhi(p.z), bflo(p.w), bfhi(p.w)};
                    if (outf) { *(f32x4*)(outf + off) = v0; *(f32x4*)(outf + off + 4) = v1; }
                    u32x4 w; w.x = pk2(v0[0], v0[1]); w.y = pk2(v0[2], v0[3]); w.z = pk2(v1[0], v1[1]); w.w = pk2(v1[2], v1[3]);
                    *(u32x4*)(xb + off) = w;
                    sq += (v0[0] * v0[0] + v0[1] * v0[1]) + (v0[2] * v0[2] + v0[3] * v0[3]) + (v1[0] * v1[0] + v1[1] * v1[1]) + (v1[2] * v1[2] + v1[3] * v1[3]);
                }
                sq += __shfl_xor(sq, 16); sq += __shfl_xor(sq, 32);
                if (fq == 0) ss[(size_t)row * 16 + u.pn * 4 + wc] = sq;
            }
            ROWFENCE();
        }
    }
};
struct EpiRelu2 {
    static constexpr bool PERM = true, AFTER_DRAIN = false;
    bf16_t* U; const float* ss;
    __device__ __forceinline__ void operator()(const f32x4 (&acc)[2][2][4][2], const pg8::Unit& u, int wr, int wc, int fr, int fq) const {
        const int row0 = u.pm * 256 + wr * 64 + fr, col0 = u.pn * 256 + wc * 32 + 8 * fq;
        ROWSCALES8(rs8, ss, row0, fq)
#pragma unroll
        for (int ai = 0; ai < 2; ++ai)
#pragma unroll
            for (int m = 0; m < 4; ++m) {
                const int row = row0 + ai * 128 + m * 16; const float rs = rs8[ai][m];
#pragma unroll
                for (int bj = 0; bj < 2; ++bj) {
                    f32x4 v0 = acc[ai][bj][m][0] * rs, v1 = acc[ai][bj][m][1] * rs;
                    v0 = __builtin_elementwise_max(v0, (f32x4){0.f, 0.f, 0.f, 0.f}); v1 = __builtin_elementwise_max(v1, (f32x4){0.f, 0.f, 0.f, 0.f});
                    v0 = v0 * v0; v1 = v1 * v1;
                    u32x4 w; w.x = pk2(v0[0], v0[1]); w.y = pk2(v0[2], v0[3]); w.z = pk2(v1[0], v1[1]); w.w = pk2(v1[2], v1[3]);
                    *(u32x4*)(U + (size_t)row * DFF + col0 + bj * 128) = w;
                }
                ROWFENCE();
            }
    }
};
struct EpiInProj {
    static constexpr bool PERM = true, AFTER_DRAIN = false;
    const float* ss; unsigned char* P; const float* lbt;
    const float* gt; const float* fbias;
    __device__ __forceinline__ void operator()(const f32x4 (&acc)[2][2][4][2], const pg8::Unit& u, int wr, int wc, int fr, int fq) const {
        const int slot = u.pn * 4 + wc;
        if (slot > 52) return;
        const int row0 = u.pm * 256 + wr * 64 + fr;
        ROWSCALES8(rs8, ss, row0, fq)
        if (slot < 16) {
            const int kind = slot >> 2, cb = (slot & 3) * 64 + 8 * fq;
            if (kind == 1) {
                float* HLF = (float*)(P + P_HLF); bf16_t* HK = (bf16_t*)(P + P_HK);
#pragma unroll
                for (int ai = 0; ai < 2; ++ai)
#pragma unroll
                    for (int m = 0; m < 4; ++m) {
                        const int row = row0 + ai * 128 + m * 16; const float rs = rs8[ai][m];
#pragma unroll
                        for (int bj = 0; bj < 2; ++bj) {
                            float lf[8], kk[8];
#pragma unroll
                            for (int n = 0; n < 2; ++n) {
                                const f32x4 ll = *(const f32x4*)(lbt + cb + 32 * bj + 4 * n), om = *(const f32x4*)(lbt + 256 + cb + 32 * bj + 4 * n);
#pragma unroll
                                for (int i = 0; i < 4; ++i) {
                                    const float fl = acc[ai][bj][m][n][i] * rs;
                                    const float a = fminf(fl, 0.f) - __logf(1.0f + __expf(-fabsf(fl)));
                                    const float an = a - fl;
                                    const float b = ll[i] + an;
                                    lf[4 * n + i] = fmaxf(a, b) + __logf(1.0f + __expf(-fabsf(a - b)));
                                    kk[4 * n + i] = om[i] * __expf(an);
                                }
                            }
                            const size_t off = (size_t)row * 256 + cb + 32 * bj;
                            *(f32x4*)(HLF + off) = (f32x4){lf[0], lf[1], lf[2], lf[3]}; *(f32x4*)(HLF + off + 4) = (f32x4){lf[4], lf[5], lf[6], lf[7]};
                            u32x4 w; w.x = pk2(kk[0], kk[1]); w.y = pk2(kk[2], kk[3]); w.z = pk2(kk[4], kk[5]); w.w = pk2(kk[6], kk[7]);
                            *(u32x4*)(HK + off) = w;
                        }
                        ROWFENCE();
                    }
            } else {
                bf16_t* dst = (bf16_t*)(P + (kind == 0 ? P_HQ : (kind == 2 ? P_HI : P_HG)));
#pragma unroll
                for (int ai = 0; ai < 2; ++ai)
#pragma unroll
                    for (int m = 0; m < 4; ++m) {
                        const int row = row0 + ai * 128 + m * 16; const float rs = rs8[ai][m];
#pragma unroll
                        for (int bj = 0; bj < 2; ++bj) {
                            const f32x4 v0 = acc[ai][bj][m][0] * rs, v1 = acc[ai][bj][m][1] * rs;
                            u32x4 w; w.x = pk2(v0[0], v0[1]); w.y = pk2(v0[2], v0[3]); w.z = pk2(v1[0], v1[1]); w.w = pk2(v1[2], v1[3]);
                            *(u32x4*)(dst + (size_t)row * 256 + cb + 32 * bj) = w;
                        }
                        ROWFENCE();
                    }
            }
        } else if (slot < 52) {
            const int s2 = slot - 16, grp = s2 / 6, h = s2 % 6, role = grp % 3;
            bf16_t* dst = (bf16_t*)(P + P_SQ + (size_t)grp * HEADBUF) + (size_t)((u.pm >> 4) * 6 + h) * SEQ * 64 + 8 * fq;
            const float* gp = gt + (grp - (grp >= 3 ? 1 : 0)) * 64 + 8 * fq;
            const float qs = (role == 0) ? 0.125f * 1.4426950408889634f : 1.0f;
#pragma unroll
            for (int ai = 0; ai < 2; ++ai)
#pragma unroll
                for (int m = 0; m < 4; ++m) {
                    const int row = row0 + ai * 128 + m * 16; const float rs = rs8[ai][m];
                    float fac = rs;
                    if (role != 2) {
                        float sq = 0.f;
#pragma unroll
                        for (int bj = 0; bj < 2; ++bj)
#pragma unroll
                            for (int n = 0; n < 2; ++n) { const f32x4 x = acc[ai][bj][m][n]; sq += (x[0] * x[0] + x[1] * x[1]) + (x[2] * x[2] + x[3] * x[3]); }
                        sq += __shfl_xor(sq, 16); sq += __shfl_xor(sq, 32);
                        fac = rs * rsqrtf(rs * rs * sq * (1.0f / 64.0f) + EPS) * qs;
                    }
                    const int t = row & (SEQ - 1);
#pragma unroll
                    for (int bj = 0; bj < 2; ++bj) {
                        f32x4 v0 = acc[ai][bj][m][0] * fac, v1 = acc[ai][bj][m][1] * fac;
                        if (role != 2) { v0 = v0 * *(const f32x4*)(gp + 32 * bj); v1 = v1 * *(const f32x4*)(gp + 32 * bj + 4); }
                        u32x4 w; w.x = pk2(v0[0], v0[1]); w.y = pk2(v0[2], v0[3]); w.z = pk2(v1[0], v1[1]); w.w = pk2(v1[2], v1[3]);
                        *(u32x4*)(dst + (size_t)t * 64 + 32 * bj) = w;
                    }
                    ROWFENCE();
                }
        } else {
            float* LF = (float*)(P + P_LF);
#pragma unroll
            for (int ai = 0; ai < 2; ++ai)
#pragma unroll
                for (int m = 0; m < 4; ++m) {
                    const int row = row0 + ai * 128 + m * 16; const float rs = rs8[ai][m];
                    if (fq == 0) {
                        const f32x4 a0 = acc[ai][0][m][0], a1 = acc[ai][0][m][1];
                        *(f32x4*)(LF + (size_t)row * 8) = (f32x4){logsig(a0[0] * rs + fbias[0]), logsig(a0[1] * rs + fbias[1]), logsig(a0[2] * rs + fbias[2]), logsig(a0[3] * rs + fbias[3])};
                        *(f32x4*)(LF + (size_t)row * 8 + 4) = (f32x4){logsig(a1[0] * rs + fbias[4]), logsig(a1[1] * rs + fbias[5]), 0.f, 0.f};
                    }
                    ROWFENCE();
                }
        }
    }
};
#define XB_TMO      128
#define XB_XCNT(j)  (256  + 64 * (j))
#define XB_XSUB(j)  (1280 + 64 * (j))
#define XB_XGEN(j)  (2304 + 64 * (j))
#define XB_TOP      3328
#define XB_TOPGEN   3392
#define XCD_BAR_WORDS 3456
#define XB_SPIN_CAP (1u << 18)

__device__ __forceinline__ unsigned xb_ld(unsigned* p)              { return __hip_atomic_load(p, __ATOMIC_RELAXED, __HIP_MEMORY_SCOPE_AGENT); }
__device__ __forceinline__ unsigned xb_add(unsigned* p, unsigned v) { return __hip_atomic_fetch_add(p, v, __ATOMIC_RELAXED, __HIP_MEMORY_SCOPE_AGENT); }
__device__ __forceinline__ unsigned xb_xcc_id() { return (unsigned)__builtin_amdgcn_s_getreg((3 << 11) | 20) & 0xFu; }
#define XB_SPIN(cond, bar) do { unsigned _sp = 0; while (cond) { __builtin_amdgcn_s_sleep(1); \
    if ((++_sp & 255u) == 0u) { if (xb_ld(&(bar)[XB_TMO])) break; if (_sp > XB_SPIN_CAP) { atomicAdd(&(bar)[XB_TMO], 1u); break; } } } } while (0)

struct XcdBarrier {
    unsigned* bar; unsigned x;
    volatile LAS unsigned* st;
};

__device__ __forceinline__ XcdBarrier xcd_barrier_post(unsigned* bar, volatile LAS unsigned* st) {
    XcdBarrier b; b.bar = bar; b.x = xb_xcc_id(); b.st = st;
    if (threadIdx.x == 0) (void)xb_add(&bar[XB_XCNT(b.x)], 1u);
    return b;
}
__device__ __forceinline__ void xcd_barrier_complete(unsigned* bar, unsigned x, unsigned& nloc, unsigned& nx) {
    const unsigned G = gridDim.x * gridDim.y * gridDim.z;
    unsigned sum, cnt, mine, sp = 0u;
    for (;;) {
        sum = 0u; cnt = 0u; mine = 0u;
#pragma unroll
        for (unsigned j = 0; j < 16; ++j) { const unsigned c = xb_ld(&bar[XB_XCNT(j)]); sum += c; cnt += (c > 0u) ? 1u : 0u; mine = (j == x) ? c : mine; }
        if (sum == G) break;
        __builtin_amdgcn_s_sleep(1);
        if ((++sp & 255u) == 0u) { if (xb_ld(&bar[XB_TMO])) break; if (sp > XB_SPIN_CAP) { atomicAdd(&bar[XB_TMO], 1u); break; } }
    }
    nloc = mine > 0u ? mine : 1u; nx = cnt > 0u ? cnt : 1u;
}

__device__ __forceinline__ void xcd_barrier(const XcdBarrier& b) {
    asm volatile("s_waitcnt vmcnt(0)" ::: "memory");
    __syncthreads();
    if (threadIdx.x == 0) {
        unsigned* bar = b.bar;
        __builtin_amdgcn_s_waitcnt(0);
        unsigned nloc = b.st[0], nx = b.st[1];
        if (nloc == 0u) { xcd_barrier_complete(bar, b.x, nloc, nx); b.st[0] = nloc; b.st[1] = nx; }
        const unsigned old = xb_add(&bar[XB_XSUB(b.x)], 1u);
        const unsigned gen = old / nloc;
        if (old + 1u == (gen + 1u) * nloc) {
            __builtin_amdgcn_fence(__ATOMIC_RELEASE, "agent");
            asm volatile("s_waitcnt vmcnt(0)" ::: "memory");
            const unsigned og = xb_add(&bar[XB_TOP], 1u);
            const unsigned tg = og / nx;
            if (og + 1u == (tg + 1u) * nx) xb_add(&bar[XB_TOPGEN], 1u);
            else XB_SPIN(xb_ld(&bar[XB_TOPGEN]) == tg, bar);
            __builtin_amdgcn_fence(__ATOMIC_ACQUIRE, "agent");
            xb_add(&bar[XB_XGEN(b.x)], 1u);
            asm volatile("s_waitcnt vmcnt(0)" ::: "memory");
        } else {
            XB_SPIN(xb_ld(&bar[XB_XGEN(b.x)]) == gen, bar);
            __builtin_amdgcn_fence(__ATOMIC_ACQUIRE, "agent");
            asm volatile("s_waitcnt vmcnt(0)" ::: "memory");
        }
    }
    __syncthreads();
}

__device__ __forceinline__ void tr_item(const float* W, int ldw, int ncols_valid, int src_col0, int k0, const float* gain, bf16_t* WT, int K, int n0, LAS float* scr, int lane) {
#pragma unroll 8
    for (int i = 0; i < 32; ++i) { const int kk = 2 * i + (lane >> 5), c = src_col0 + (lane & 31);
        float v = (c < ncols_valid) ? W[(size_t)(k0 + kk) * ldw + c] : 0.f; if (gain) v *= gain[k0 + kk]; scr[kk * 33 + (lane & 31)] = v; }
    asm volatile("s_waitcnt lgkmcnt(0)" ::: "memory");
    const int c = lane & 7;
#pragma unroll
    for (int j = 0; j < 4; ++j) { const int n = (lane >> 3) + 8 * j; const LAS float* s = scr + (8 * c) * 33 + n;
        u32x4 o; o.x = pk2(s[0 * 33], s[1 * 33]); o.y = pk2(s[2 * 33], s[3 * 33]); o.z = pk2(s[4 * 33], s[5 * 33]); o.w = pk2(s[6 * 33], s[7 * 33]);
        *(u32x4*)(WT + (size_t)(n0 + n) * K + k0 + 8 * c) = o; }
    asm volatile("s_waitcnt lgkmcnt(0)" ::: "memory");
}

__device__ __forceinline__ void unpack8(const u32x4 w, float* d) { d[0] = bflo(w.x); d[1] = bfhi(w.x); d[2] = bflo(w.y); d[3] = bfhi(w.y); d[4] = bflo(w.z); d[5] = bfhi(w.z); d[6] = bflo(w.w); d[7] = bfhi(w.w); }

__device__ __forceinline__ void fox_cumsum_item(int bh, const float* LF, float* CC, int* JS, const float* gq, const float* gk, LAS float* sc) {
    int tid_ = threadIdx.x; asm volatile("" : "+v"(tid_)); const int tid = tid_, lane = tid & 63, wave = tid >> 6, b = bh / 6, h = bh % 6;
    float v[8]; float run = 0.f;
#pragma unroll
    for (int i = 0; i < 8; ++i) { run += LF[((size_t)b * SEQ + tid * 8 + i) * 8 + h]; v[i] = run; }
    float s = run;
#pragma unroll
    for (int o = 1; o < 64; o <<= 1) { const float n = __shfl_up(s, o); if (lane >= o) s += n; }
    __syncthreads();
    if (lane == 63) sc[wave] = s;
    __syncthreads();
    float base = s - run;
    for (int w = 0; w < wave; ++w) base += sc[w];
    LAS float* cl = sc + 64;
#pragma unroll
    for (int i = 0; i < 8; ++i) { const float c2 = (v[i] + base) * 1.4426950408889634f; CC[(size_t)bh * SEQ + tid * 8 + i] = c2; cl[tid * 8 + i] = c2; }
    __syncthreads();
    if (tid < 16) {
        float mq = 0.f, mk = 0.f;
        for (int d = 0; d < 64; ++d) { mq = fmaxf(mq, fabsf(gq[d])); mk = fmaxf(mk, fabsf(gk[d])); }
        const float zb = 1.4426950408889634f * 8.0f * mq * mk * 1.03f + 1.0f;
        const float thr = -(150.0f + 2.0f * zb);
        const int q0 = tid * 256, nt = q0 / 64 + 4; const float cq = cl[q0];
        int j = 0; while (j < nt - 4 && cq - cl[64 * j + 63] < thr) ++j;
        JS[bh * 16 + tid] = j & ~1;
    }
    __syncthreads();
}

__device__ __forceinline__ void stage_kv(const bf16_t* Kb, const bf16_t* Vb, int kt, LAS float* Kf, LAS float* Vf) {
    int tid_ = threadIdx.x; asm volatile("" : "+v"(tid_)); const int tid = tid_, key = tid >> 3, c8 = tid & 7;
    const u32x4 kw = *(const u32x4*)(Kb + ((size_t)(kt * 64 + key)) * 64 + c8 * 8), vw = *(const u32x4*)(Vb + ((size_t)(kt * 64 + key)) * 64 + c8 * 8);
    float kf[8], vf[8]; unpack8(kw, kf); unpack8(vw, vf);
    *(LAS f32x4*)(Kf + key * 64 + c8 * 8) = (f32x4){kf[0], kf[1], kf[2], kf[3]}; *(LAS f32x4*)(Kf + key * 64 + c8 * 8 + 4) = (f32x4){kf[4], kf[5], kf[6], kf[7]};
    *(LAS f32x4*)(Vf + key * 64 + c8 * 8) = (f32x4){vf[0], vf[1], vf[2], vf[3]}; *(LAS f32x4*)(Vf + key * 64 + c8 * 8 + 4) = (f32x4){vf[4], vf[5], vf[6], vf[7]};
}

__device__ __forceinline__ void fox_naive_item(int item, unsigned char* P, bf16_t* MIX, LAS float* lds) {
    int tid_ = threadIdx.x; asm volatile("" : "+v"(tid_)); const int tid = tid_, bh = item >> 3, qblk = item & 7, b = bh / 6, h = bh % 6, t = qblk * 512 + tid;
    const bf16_t* Qp = (const bf16_t*)(P + P_FQ) + ((size_t)bh * SEQ + t) * 64;
    const bf16_t* Kb = (const bf16_t*)(P + P_FQ + HEADBUF) + (size_t)bh * SEQ * 64;
    const bf16_t* Vb = (const bf16_t*)(P + P_FQ + 2 * HEADBUF) + (size_t)bh * SEQ * 64;
    const float* CC = (const float*)(P + P_CC) + (size_t)bh * SEQ;
    float q[64], o[64];
#pragma unroll
    for (int c = 0; c < 8; ++c) unpack8(*(const u32x4*)(Qp + c * 8), q + c * 8);
#pragma unroll
    for (int d = 0; d < 64; ++d) o[d] = 0.f;
    float m = -1e30f, l = 0.f; const float ct = CC[t];
    LAS float* Kf = lds; LAS float* Vf = lds + 4096; LAS float* cs = lds + 8192;
    const int ntile = (qblk + 1) * 8;
    for (int kt = 0; kt < ntile; ++kt) {
        __syncthreads();
        stage_kv(Kb, Vb, kt, Kf, Vf); if (tid < 64) cs[tid] = CC[kt * 64 + tid];
        __syncthreads();
        for (int s = 0; s < 64; ++s) {
            float z = 0.f;
#pragma unroll
            for (int d = 0; d < 64; ++d) z += q[d] * Kf[s * 64 + d];
            const float x = (kt * 64 + s <= t) ? z + (ct - cs[s]) : -1e30f;
            const float mn = fmaxf(m, x), sc = __expf(m - mn), p = __expf(x - mn);
            l = l * sc + p;
#pragma unroll
            for (int d = 0; d < 64; ++d) o[d] = o[d] * sc + p * Vf[s * 64 + d];
            m = mn;
        }
    }
    const float inv = 1.0f / l;
    bf16_t* op = MIX + ((size_t)b * SEQ + t) * DM + 640 + h * 64;
#pragma unroll
    for (int c = 0; c < 8; ++c) { u32x4 w; w.x = pk2(o[c * 8] * inv, o[c * 8 + 1] * inv); w.y = pk2(o[c * 8 + 2] * inv, o[c * 8 + 3] * inv); w.z = pk2(o[c * 8 + 4] * inv, o[c * 8 + 5] * inv); w.w = pk2(o[c * 8 + 6] * inv, o[c * 8 + 7] * inv); *(u32x4*)(op + c * 8) = w; }
}

__device__ __forceinline__ void sb_naive_item(int item, unsigned char* P, bf16_t* MIX, LAS float* lds) {
    int tid_ = threadIdx.x; asm volatile("" : "+v"(tid_)); const int tid = tid_, bh = item >> 3, qblk = item & 7, b = bh / 6, h = bh % 6, t = qblk * 512 + tid;
    const bf16_t* Qp = (const bf16_t*)(P + P_SQ) + ((size_t)bh * SEQ + t) * 64;
    const bf16_t* Kb = (const bf16_t*)(P + P_SQ + HEADBUF) + (size_t)bh * SEQ * 64;
    const bf16_t* Vb = (const bf16_t*)(P + P_SQ + 2 * HEADBUF) + (size_t)bh * SEQ * 64;
    float q[64], o[64];
#pragma unroll
    for (int c = 0; c < 8; ++c) unpack8(*(const u32x4*)(Qp + c * 8), q + c * 8);
#pragma unroll
    for (int d = 0; d < 64; ++d) o[d] = 0.f;
    float tail = 0.f;
    LAS float* Kf = lds; LAS float* Vf = lds + 4096;
    for (int kt = qblk * 8 + 7; kt >= 0; --kt) {
        __syncthreads();
        stage_kv(Kb, Vb, kt, Kf, Vf);
        __syncthreads();
        for (int s = 63; s >= 0; --s) {
            float z = 0.f;
#pragma unroll
            for (int d = 0; d < 64; ++d) z += q[d] * Kf[s * 64 + d];
            const float ls = fminf(z, 0.f) - __logf(1.0f + __expf(-fabsf(z)));
            const bool act = (kt * 64 + s) < t;
            const float A = act ? __expf(ls + tail) : 0.f;
#pragma unroll
            for (int d = 0; d < 64; ++d) o[d] += A * Vf[s * 64 + d];
            tail += act ? (ls - z) : 0.f;
        }
        if (__syncthreads_and(tail < -100.f)) break;
    }
    bf16_t* op = MIX + ((size_t)b * SEQ + t) * DM + 256 + h * 64;
#pragma unroll
    for (int c = 0; c < 8; ++c) { u32x4 w; w.x = pk2(o[c * 8], o[c * 8 + 1]); w.y = pk2(o[c * 8 + 2], o[c * 8 + 3]); w.z = pk2(o[c * 8 + 4], o[c * 8 + 5]); w.w = pk2(o[c * 8 + 6], o[c * 8 + 7]); *(u32x4*)(op + c * 8) = w; }
}

__device__ __forceinline__ void hgrn_naive_item(int item, unsigned char* P, bf16_t* MIX, const float* hgn, LAS float* lds) {
    int tid_ = threadIdx.x; asm volatile("" : "+v"(tid_)); const int tid = tid_, lane = tid & 63, w = tid >> 6, kg = lane >> 3, vi = lane & 7, vcol = 8 * w + vi, b = item >> 2, h = item & 3;
    const bf16_t* HQ = (const bf16_t*)(P + P_HQ); const bf16_t* HK = (const bf16_t*)(P + P_HK); const bf16_t* HI = (const bf16_t*)(P + P_HI); const bf16_t* HG = (const bf16_t*)(P + P_HG);
    const float* HLF = (const float*)(P + P_HLF);
    LAS float* qf = lds; LAS float* kf = lds + 4096; LAS float* ff = lds + 8192; LAS float* vf = lds + 12288; LAS float* ob = lds + 16384;
    float S[8];
#pragma unroll
    for (int j = 0; j < 8; ++j) S[j] = 0.f;
    const int tok = tid >> 3, c8 = tid & 7;
    float gn[8];
#pragma unroll
    for (int e = 0; e < 8; ++e) gn[e] = hgn[c8 * 8 + e];
    for (int c = 0; c < 64; ++c) {
        const size_t off = ((size_t)b * SEQ + c * 64 + tok) * 256 + h * 64 + c8 * 8;
        __syncthreads();
        {
            float a[8];
            unpack8(*(const u32x4*)(HQ + off), a);
#pragma unroll
            for (int e = 0; e < 8; ++e) qf[tok * 64 + c8 * 8 + e] = a[e];
            unpack8(*(const u32x4*)(HK + off), a);
#pragma unroll
            for (int e = 0; e < 8; ++e) kf[tok * 64 + c8 * 8 + e] = a[e];
            unpack8(*(const u32x4*)(HI + off), a);
#pragma unroll
            for (int e = 0; e < 8; ++e) vf[tok * 64 + c8 * 8 + e] = a[e];
            const f32x4 l0 = *(const f32x4*)(HLF + off), l1 = *(const f32x4*)(HLF + off + 4);
#pragma unroll
            for (int e = 0; e < 4; ++e) { ff[tok * 64 + c8 * 8 + e] = expf(l0[e]); ff[tok * 64 + c8 * 8 + 4 + e] = expf(l1[e]); }
        }
        __syncthreads();
        for (int tk = 0; tk < 64; ++tk) {
            const float vv = vf[tk * 64 + vcol]; float op = 0.f;
#pragma unroll
            for (int j = 0; j < 8; ++j) { const int k = 8 * kg + j; S[j] = ff[tk * 64 + k] * S[j] + kf[tk * 64 + k] * vv; op += qf[tk * 64 + k] * S[j]; }
            op += __shfl_xor(op, 8); op += __shfl_xor(op, 16); op += __shfl_xor(op, 32);
            if (kg == 0) ob[tk * 64 + vcol] = op;
        }
        __syncthreads();
        {
            float ov[8], g[8]; float sq = 0.f;
#pragma unroll
            for (int e = 0; e < 8; ++e) { ov[e] = ob[tok * 64 + c8 * 8 + e]; sq += ov[e] * ov[e]; }
            sq += __shfl_xor(sq, 1); sq += __shfl_xor(sq, 2); sq += __shfl_xor(sq, 4);
            const float rn = rsqrtf(sq * (1.0f / 64.0f) + EPS);
            unpack8(*(const u32x4*)(HG + off), g);
            float r[8];
#pragma unroll
            for (int e = 0; e < 8; ++e) r[e] = ov[e] * rn * gn[e] * (g[e] / (1.0f + expf(-g[e])));
            u32x4 wv; wv.x = pk2(r[0], r[1]); wv.y = pk2(r[2], r[3]); wv.z = pk2(r[4], r[5]); wv.w = pk2(r[6], r[7]);
            *(u32x4*)(MIX + ((size_t)b * SEQ + c * 64 + tok) * DM + h * 64 + c8 * 8) = wv;
        }
    }
}

constexpr int HG_SLOT = 32768, HG_BP = 68  , HG_PRE = 64 * HG_BP * 4, HG_TOT = HG_PRE + 1280, HG_VT = 20480, HG_VP = 72;
static_assert(HG_TOT + 1024 <= HG_VT && HG_VT + 64 * HG_VP * 2 <= HG_SLOT, "HGRN LDS slot map");
typedef short hbf16x8 __attribute__((ext_vector_type(8)));
typedef short hbf16x4 __attribute__((ext_vector_type(4)));
__device__ __forceinline__ hbf16x8 pack8(const float* x) { u32x4 w; w.x = pk2(x[0], x[1]); w.y = pk2(x[2], x[3]); w.z = pk2(x[4], x[5]); w.w = pk2(x[6], x[7]); return __builtin_bit_cast(hbf16x8, w); }

__device__ __forceinline__ void hg_stage(int tid, size_t row0, int h, const float* HLF, const bf16_t* HI, LAS unsigned char* sb) {
    const int lt = tid & 255, k = lt & 63, seg = lt >> 6;
    LAS float* bl = (LAS float*)sb; LAS float* pre = (LAS float*)(sb + HG_PRE); LAS float* tot = (LAS float*)(sb + HG_TOT); LAS bf16_t* vt = (LAS bf16_t*)(sb + HG_VT);
    float run = 0.f;
#pragma unroll
    for (int i = 0; i < 16; ++i) { const int t = 16 * seg + i; run += HLF[(row0 + t) * 256 + h * 64 + k]; bl[t * HG_BP + k] = run; }
    tot[seg * 64 + k] = run;
    {
        const int s = lt & 63, c0 = (lt >> 6) * 16;
        const u32x4 w0 = *(const u32x4*)(HI + (row0 + s) * 256 + h * 64 + c0), w1 = *(const u32x4*)(HI + (row0 + s) * 256 + h * 64 + c0 + 8);
        const unsigned ww[8] = {w0.x, w0.y, w0.z, w0.w, w1.x, w1.y, w1.z, w1.w};
#pragma unroll
        for (int e = 0; e < 8; ++e) { vt[(c0 + 2 * e) * HG_VP + s] = (bf16_t)(ww[e] & 0xffffu); vt[(c0 + 2 * e + 1) * HG_VP + s] = (bf16_t)(ww[e] >> 16); }
    }
    __syncthreads();
    if (lt < 64) { float p = 0.f;
#pragma unroll
        for (int sg = 0; sg < 4; ++sg) { pre[sg * 64 + lt] = p; p += tot[sg * 64 + lt]; }
        pre[4 * 64 + lt] = p; }
    __syncthreads();
}

__device__ __forceinline__ void hgrn_a_item(int item, unsigned char* P, float* DD, LAS unsigned char* L) {
    int tid_ = threadIdx.x; asm volatile("" : "+v"(tid_)); const int tid = tid_, lane = tid & 63, wq = (tid >> 6) & 3, cs = tid >> 8, r = lane & 15, g = lane >> 4;
    const int bh = item >> 5, chunk = (item & 31) * 2 + cs, b = bh >> 2, h = bh & 3;
    const size_t row0 = (size_t)b * SEQ + chunk * 64;
    const bf16_t* HK = (const bf16_t*)(P + P_HK); float* UT = (float*)(P + P_US);
    LAS unsigned char* sb = L + cs * HG_SLOT;
    const int k = 16 * wq + r;
    unsigned short kraw[2][8];
#pragma unroll
    for (int ks = 0; ks < 2; ++ks)
#pragma unroll
        for (int j = 0; j < 8; ++j) kraw[ks][j] = HK[(row0 + 32 * ks + 8 * g + j) * 256 + h * 64 + k];
    hg_stage(tid, row0, h, (const float*)(P + P_HLF), (const bf16_t*)(P + P_HI), sb);
    const LAS float* bl = (const LAS float*)sb; const LAS float* pre = (const LAS float*)(sb + HG_PRE); const LAS unsigned char* vt = sb + HG_VT;
    const float pre4 = pre[4 * 64 + k];
    hbf16x8 af[2];
#pragma unroll
    for (int ks = 0; ks < 2; ++ks) { const float pj = pre4 - pre[(2 * ks + (g >> 1)) * 64 + k]; float x[8];
#pragma unroll
        for (int j = 0; j < 8; ++j) { const int s = 32 * ks + 8 * g + j; x[j] = bf2f(kraw[ks][j]) * __expf(pj - bl[s * HG_BP + k]); }
        af[ks] = pack8(x); }
    float* ut = UT + ((size_t)(bh * 64 + chunk) * 64) * 64;
#pragma unroll
    for (int vtile = 0; vtile < 4; ++vtile) { f32x4 acc = {0.f, 0.f, 0.f, 0.f};
#pragma unroll
        for (int ks = 0; ks < 2; ++ks) { const hbf16x8 bf = *(const LAS hbf16x8*)(vt + (16 * vtile + r) * (HG_VP * 2) + (32 * ks + 8 * g) * 2); acc = __builtin_amdgcn_mfma_f32_16x16x32_bf16(af[ks], bf, acc, 0, 0, 0); }
        *(f32x4*)(ut + (size_t)(16 * vtile + r) * 64 + 16 * wq + 4 * g) = acc; }
    if (g == 0) DD[(size_t)(bh * 64 + chunk) * 64 + k] = __expf(pre4);
}

__device__ __forceinline__ void hgrn_b_scan(int bx, int G, unsigned char* P, const float* DD) {
    int tid_ = threadIdx.x; asm volatile("" : "+v"(tid_));
    float* UT = (float*)(P + P_US);
    for (int gid = bx * 512 + tid_; gid < 32 * 4096; gid += G * 512) {
        const int bh = gid >> 12, e = gid & 4095; float* u = UT + (size_t)bh * 64 * 4096 + e; const float* dd = DD + (size_t)bh * 64 * 64 + (e & 63);
        float S = 0.f;
        for (int c0 = 0; c0 < 64; c0 += 32) { float tu[32], td[32];
#pragma unroll
            for (int i = 0; i < 32; ++i) { tu[i] = u[(size_t)(c0 + i) * 4096]; td[i] = dd[(c0 + i) * 64]; }
#pragma unroll
            for (int i = 0; i < 32; ++i) { u[(size_t)(c0 + i) * 4096] = S; S = td[i] * S + tu[i]; } }
    }
}

__device__ __forceinline__ void hgrn_c_item(int item, unsigned char* P, bf16_t* MIX, const float* hgn, LAS unsigned char* L) {
    int tid_ = threadIdx.x; asm volatile("" : "+v"(tid_)); const int tid = tid_, lane = tid & 63, I = (tid >> 6) & 3, cs = tid >> 8, r = lane & 15, g = lane >> 4;
    const int bh = item >> 5, chunk = (item & 31) * 2 + cs, b = bh >> 2, h = bh & 3;
    const size_t row0 = (size_t)b * SEQ + chunk * 64;
    const bf16_t* HQ = (const bf16_t*)(P + P_HQ); const bf16_t* HK = (const bf16_t*)(P + P_HK); const bf16_t* HG = (const bf16_t*)(P + P_HG); const float* ST = (const float*)(P + P_US);
    LAS unsigned char* sb = L + cs * HG_SLOT;
    const int t = 16 * I + r;
    u32x4 qraw[2], kraw[4][2]; f32x4 sraw[4][2][2]; unsigned short graw[4][4];
    const float* st = ST + ((size_t)(bh * 64 + chunk) * 64) * 64;
#pragma unroll
    for (int ks = 0; ks < 2; ++ks) { qraw[ks] = *(const u32x4*)(HQ + (row0 + t) * 256 + h * 64 + 32 * ks + 8 * g);
#pragma unroll
        for (int J = 0; J < 4; ++J) kraw[J][ks] = *(const u32x4*)(HK + (row0 + 16 * J + r) * 256 + h * 64 + 32 * ks + 8 * g);
#pragma unroll
        for (int vtile = 0; vtile < 4; ++vtile) { const float* sp = st + (size_t)(16 * vtile + r) * 64 + 32 * ks + 8 * g; sraw[vtile][ks][0] = *(const f32x4*)sp; sraw[vtile][ks][1] = *(const f32x4*)(sp + 4); } }
#pragma unroll
    for (int i = 0; i < 4; ++i)
#pragma unroll
        for (int vtile = 0; vtile < 4; ++vtile) graw[i][vtile] = HG[(row0 + 16 * I + 4 * g + i) * 256 + h * 64 + 16 * vtile + r];
    hg_stage(tid, row0, h, (const float*)(P + P_HLF), (const bf16_t*)(P + P_HI), sb);
    const LAS float* bl = (const LAS float*)sb; const LAS float* pre = (const LAS float*)(sb + HG_PRE); const LAS unsigned char* vt = sb + HG_VT;
    hbf16x8 qtf[2], qhf[2];
#pragma unroll
    for (int ks = 0; ks < 2; ++ks) { const int kb = 32 * ks + 8 * g; float q[8], xt[8], xh[8];
        unpack8(qraw[ks], q);
#pragma unroll
        for (int j = 0; j < 8; ++j) { xt[j] = q[j] * __expf(bl[t * HG_BP + kb + j]); xh[j] = xt[j] * __expf(pre[I * 64 + kb + j]); }
        qtf[ks] = pack8(xt); qhf[ks] = pack8(xh); }
    f32x4 at[4];
#pragma unroll
    for (int J = 0; J < 4; ++J) { at[J] = (f32x4){0.f, 0.f, 0.f, 0.f};
        if (J <= I) { const int s = 16 * J + r;
#pragma unroll
            for (int ks = 0; ks < 2; ++ks) { const int kb = 32 * ks + 8 * g; float kk[8], x[8];
                unpack8(kraw[J][ks], kk);
#pragma unroll
                for (int j = 0; j < 8; ++j) x[j] = kk[j] * __expf(fminf(pre[I * 64 + kb + j] - pre[J * 64 + kb + j] - bl[s * HG_BP + kb + j], 80.f));
                at[J] = __builtin_amdgcn_mfma_f32_16x16x32_bf16(pack8(x), qtf[ks], at[J], 0, 0, 0); }
            if (J == I) {
#pragma unroll
                for (int i = 0; i < 4; ++i) at[J][i] = (4 * g + i <= r) ? at[J][i] : 0.f; } } }
    hbf16x8 pf[2];
#pragma unroll
    for (int k2 = 0; k2 < 2; ++k2) { const float x[8] = {at[2 * k2][0], at[2 * k2][1], at[2 * k2][2], at[2 * k2][3], at[2 * k2 + 1][0], at[2 * k2 + 1][1], at[2 * k2 + 1][2], at[2 * k2 + 1][3]}; pf[k2] = pack8(x); }
    f32x4 o[4];
#pragma unroll
    for (int vtile = 0; vtile < 4; ++vtile) { f32x4 acc = {0.f, 0.f, 0.f, 0.f}; const int v = 16 * vtile + r;
#pragma unroll
        for (int ks = 0; ks < 2; ++ks) { const f32x4 s0 = sraw[vtile][ks][0], s1 = sraw[vtile][ks][1];
            const float x[8] = {s0[0], s0[1], s0[2], s0[3], s1[0], s1[1], s1[2], s1[3]};
            acc = __builtin_amdgcn_mfma_f32_16x16x32_bf16(qhf[ks], pack8(x), acc, 0, 0, 0); }
#pragma unroll
        for (int k2 = 0; k2 < 2; ++k2) { if (k2 == 0 || I >= 2) {
            const hbf16x4 v0 = *(const LAS hbf16x4*)(vt + v * (HG_VP * 2) + (32 * k2 + 4 * g) * 2), v1 = *(const LAS hbf16x4*)(vt + v * (HG_VP * 2) + (32 * k2 + 16 + 4 * g) * 2);
            const hbf16x8 vf = {v0[0], v0[1], v0[2], v0[3], v1[0], v1[1], v1[2], v1[3]};
            acc = __builtin_amdgcn_mfma_f32_16x16x32_bf16(pf[k2], vf, acc, 0, 0, 0); } }
        o[vtile] = acc; }
#pragma unroll
    for (int i = 0; i < 4; ++i) { float sq = 0.f;
#pragma unroll
        for (int vtile = 0; vtile < 4; ++vtile) sq += o[vtile][i] * o[vtile][i];
        sq += __shfl_xor(sq, 1); sq += __shfl_xor(sq, 2); sq += __shfl_xor(sq, 4); sq += __shfl_xor(sq, 8);
        const float rn = rsqrtf(sq * (1.0f / 64.0f) + EPS); const size_t row = row0 + 16 * I + 4 * g + i;
#pragma unroll
        for (int vtile = 0; vtile < 4; ++vtile) { const int v = 16 * vtile + r; const float gg = bf2f(graw[i][vtile]);
            MIX[row * DM + h * 64 + v] = (bf16_t)f2bf(o[vtile][i] * rn * hgn[v] * (gg / (1.0f + __expf(-gg)))); } }
}

struct Args { const float* in[14]; float* out; unsigned char* ws; int ph_lo, ph_hi; };
constexpr int NPHASE = 1 + 7 * DEPTH;

__global__ void __launch_bounds__(512, 2) fwd(Args a) {
    extern __shared__ __attribute__((aligned(16))) unsigned char lds[];
    cg::grid_group grid = cg::this_grid();
    LAS unsigned char* L = (LAS unsigned char*)lds;
    if (threadIdx.x < 32) ((LAS unsigned*)(L + LDS_BYTES - 128))[threadIdx.x] = 0u;
    __syncthreads();
    for (int ph = a.ph_lo; ph < a.ph_hi; ++ph) {
        int G = gridDim.x, bx = blockIdx.x; asm volatile("" : "+s"(G), "+s"(bx));
        typedef const __attribute__((address_space(4))) Args* KArgP;
        KArgP ap = (KArgP)__builtin_amdgcn_kernarg_segment_ptr(); asm volatile("" : "+s"(ap));
        unsigned char* ws = ap->ws;
        float* SS = (float*)(ws + WS_SS); float* LB = (float*)(ws + WS_LB);
        bf16_t* XB = (bf16_t*)(ws + WS_XB); bf16_t* MIX = (bf16_t*)(ws + WS_MIX); bf16_t* UB = (bf16_t*)(ws + WS_U);
        unsigned char* P = ws + WS_P;
#ifdef PROBE_T
        if (ph == NPHASE) {
            if (bx == 0) { const unsigned long long* ts_ = (const unsigned long long*)(ws + 65536); unsigned long long sa = 0, sb = 0;
                for (int p = 1; p < NPHASE; ++p) { const int kk_ = (p - 1) % 7; const unsigned long long d = ts_[p] - ts_[p - 1]; if (PROBE_A(kk_)) sa += d; if (PROBE_B(kk_)) sb += d; }
                const float fa = (float)sa * 1e-3f, fb = (float)sb * 1e-3f; float* o_ = ap->out;
                for (int i = threadIdx.x; i < (1 << 20); i += 512) o_[(1 << 20) + i] += fb;
                if (threadIdx.x == 0) o_[0] = fa; }
        } else
#endif
        if (ph == 0) {
            int tid = threadIdx.x; asm volatile("" : "+v"(tid)); const int lane = tid & 63, wave = __builtin_amdgcn_readfirstlane(tid >> 6);
            LAS float* scr = (LAS float*)(L + wave * 16384);
            const int gw = bx * 8 + wave, NGW = G * 8;
            constexpr int I_IN = 16 * 112, I_OUT = 16 * 32, I_1 = 16 * 128, I_2 = 64 * 32, I_L = I_IN + I_OUT + I_1 + I_2;
            for (int it = gw; it < DEPTH * I_L; it += NGW) {
                const int l = it / I_L; int r = it % I_L;
                unsigned char* wl = ws + WS_W + (size_t)l * W_LAYER;
                if (r < I_IN) { const int kb = r / 112, nb = r % 112, n0 = nb * 32, pn = n0 >> 8, p = n0 & 255, slot = 4 * pn + ((p & 127) >> 5), sc0 = 64 * slot + 32 * (p >> 7);
                    tr_item(ap->in[3] + (size_t)l * DM * INC, INC, INC, sc0, kb * 64, ap->in[2] + l * DM, (bf16_t*)wl, DM, n0, scr, lane); continue; }
                r -= I_IN;
                if (r < I_OUT) { const int kb = r / 32, nb = r % 32; tr_item(ap->in[10] + (size_t)l * DM * DM, DM, DM, nb * 32, kb * 64, nullptr, (bf16_t*)(wl + W_OUT), DM, nb * 32, scr, lane); continue; }
                r -= I_OUT;
                if (r < I_1) { const int kb = r / 128, nb = r % 128; tr_item(ap->in[12] + (size_t)l * DM * DFF, DFF, DFF, nb * 32, kb * 64, ap->in[11] + l * DM, (bf16_t*)(wl + W_1), DM, nb * 32, scr, lane); continue; }
                r -= I_1;
                { const int kb = r / 32, nb = r % 32; tr_item(ap->in[13] + (size_t)l * DFF * DM, DM, DM, nb * 32, kb * 64, nullptr, (bf16_t*)(wl + W_2), DFF, nb * 32, scr, lane); }
            }
            const float* x = ap->in[0];
            for (int m = gw; m < M; m += NGW) {
                const f32x4* xr = (const f32x4*)(x + (size_t)m * DM) + lane; f32x4 v[4]; float s = 0.f;
#pragma unroll
                for (int j = 0; j < 4; ++j) { v[j] = xr[64 * j]; s += (v[j][0] * v[j][0] + v[j][1] * v[j][1]) + (v[j][2] * v[j][2] + v[j][3] * v[j][3]); }
                const float tot = wave_sum(s);
                u32x2* o8 = (u32x2*)(XB + (size_t)m * DM) + lane;
#pragma unroll
                for (int j = 0; j < 4; ++j) { u32x2 w; w.x = pk2(v[j][0], v[j][1]); w.y = pk2(v[j][2], v[j][3]); o8[64 * j] = w; }
                if (lane < 16) SS[(size_t)m * 16 + lane] = (lane == 0) ? tot : 0.f;
            }
            if (bx == 2 && tid < 64) ((unsigned*)ws)[tid] = 0u;
            if (bx == 3) for (int i = tid; i < XCD_BAR_WORDS; i += 512) ((unsigned*)(ws + WS_BAR))[i] = 0u;
            if (bx == 1) {
                for (int i = tid; i < 1024; i += 512) { const int l = i >> 8, wh = (i >> 6) & 3, d = i & 63; LB[2048 + i] = ap->in[5 + wh][l * 64 + d]; }
                if (tid < 32) { const int l = tid >> 3, e = tid & 7; LB[3072 + tid] = (e < 6) ? ap->in[9][l * 6 + e] : 0.f; }
            }
            if (bx == 0 && tid < 256) {
                const float* lg = ap->in[1]; float e[DEPTH]; float mx = -1e30f, sum = 0.f;
#pragma unroll
                for (int l = 0; l < DEPTH; ++l) mx = fmaxf(mx, lg[l * 256 + tid]);
#pragma unroll
                for (int l = 0; l < DEPTH; ++l) { e[l] = expf(lg[l * 256 + tid] - mx); sum += e[l]; }
                float c = 0.f;
#pragma unroll
                for (int l = 0; l < DEPTH; ++l) { if (l > 0) c += e[l] / sum; LB[l * 512 + tid] = logf(fmaxf(c, 1e-30f)); LB[l * 512 + 256 + tid] = 1.0f - c; }
            }
        } else {
            const int l = (ph - 1) / 7, k = (ph - 1) % 7;
#ifdef REP_K
            const int nrep = (k == REP_K) ? 2 : 1;
#else
            const int nrep = 1;
#endif
            for (int rep = 0; rep < nrep; ++rep) {
            if (rep) { XcdBarrier xb_; xb_.bar = (unsigned*)(ws + WS_BAR); xb_.x = xb_xcc_id(); xb_.st = (volatile LAS unsigned*)(L + LDS_BYTES - 128); xcd_barrier(xb_); }
            unsigned char* wl = ws + WS_W + (size_t)l * W_LAYER;
            if (k == 0) {
                pg8::Gemm g{XB, (const bf16_t*)wl, M, NIN, DM}; pg8::StaticOrder S; S.init(M, NIN, G, bx);
                EpiInProj E{SS, P, LB + l * 512, LB + 2048 + l * 256, LB + 3072 + l * 8};
                pg8::gemm_phase<EpiInProj, pg8::StaticOrder, true, true>(L, g, S, E);
            } else if (k == 1) {
                int tid = threadIdx.x; asm volatile("" : "+v"(tid));
                unsigned* ctr = (unsigned*)ws + l * 16 + 1 + rep * 4;
                volatile LAS int* sh = (volatile LAS int*)(L + LDS_BYTES - 64);
                int nxt = 0; if (tid == 0) nxt = (int)atomicAdd(ctr, 1u);
                for (;;) {
                    if (tid == 0) sh[0] = nxt;
                    __syncthreads();
                    const int idx = __builtin_amdgcn_readfirstlane(sh[0]);
                    __syncthreads();
                    if (idx >= 816 + 1024) break;
                    if (tid == 0) nxt = (int)atomicAdd(ctr, 1u);
                    if (idx < 768) { const int qb = 15 - idx / 48, bh = idx % 48, b = bh / 6, h = bh % 6; typedef attn_body::bf16 abf;
                        attn_body::sb_unit(qb, (const abf*)(P + P_SQ) + (size_t)bh * SEQ * 64, (const abf*)(P + P_SQ + HEADBUF) + (size_t)bh * SEQ * 64, (const abf*)(P + P_SQ + 2 * HEADBUF) + (size_t)bh * SEQ * 64,
                                           (abf*)MIX + (size_t)b * SEQ * DM + 256 + h * 64, (char*)lds); }
                    else if (idx < 816) fox_cumsum_item(idx - 768, (const float*)(P + P_LF), (float*)(P + P_CC), (int*)(ws + WS_JS), LB + 2048 + l * 256 + 128, LB + 2048 + l * 256 + 192, (LAS float*)L);
                    else hgrn_a_item(idx - 816, P, (float*)(ws + WS_DD), L);
                    __syncthreads();
                }
            } else if (k == 2) {
                hgrn_b_scan(bx, G, P, (const float*)(ws + WS_DD));
            } else if (k == 3) {
                int tid = threadIdx.x; asm volatile("" : "+v"(tid));
                unsigned* ctr = (unsigned*)ws + l * 16 + rep * 4;
                volatile LAS int* sh = (volatile LAS int*)(L + LDS_BYTES - 64);
                int nxt = 0; if (tid == 0) nxt = (int)atomicAdd(ctr, 1u);
                for (;;) {
                    if (tid == 0) sh[0] = nxt;
                    __syncthreads();
                    const int idx = __builtin_amdgcn_readfirstlane(sh[0]);
                    __syncthreads();
#ifdef PROBE_FOX
                    if (idx >= 768 + 1024 || (rep && idx >= 768)) break;
#else
                    if (idx >= 768 + 1024) break;
#endif
                    if (tid == 0) nxt = (int)atomicAdd(ctr, 1u);
                    if (idx >= 768) { hgrn_c_item(idx - 768, P, MIX, ap->in[4] + l * 64, L); __syncthreads(); continue; }
                    const int qb = 15 - idx / 48, bh = idx % 48, b = bh / 6, h = bh % 6;
                    typedef attn_body::bf16 abf;
                    const int jstart = ((const int*)(ws + WS_JS))[bh * 16 + qb];
#ifdef PROBE_FOX
                    if (rep) attn_body::attn_unit<30, PROBE_FOX_BIAS>(qb, PROBE_FOX_JS(jstart), (const abf*)(P + P_FQ) + (size_t)bh * SEQ * 64, (const abf*)(P + P_FQ + HEADBUF) + (size_t)bh * SEQ * 64, (const abf*)(P + P_FQ + 2 * HEADBUF) + (size_t)bh * SEQ * 64,
                                            (abf*)ap->out + (size_t)b * SEQ * DM + 640 + h * 64, (const float*)(P + P_CC) + (size_t)bh * SEQ, (char*)lds);
                    else
#endif
                    attn_body::attn_unit<30>(qb, jstart, (const abf*)(P + P_FQ) + (size_t)bh * SEQ * 64, (const abf*)(P + P_FQ + HEADBUF) + (size_t)bh * SEQ * 64, (const abf*)(P + P_FQ + 2 * HEADBUF) + (size_t)bh * SEQ * 64,
                                            (abf*)MIX + (size_t)b * SEQ * DM + 640 + h * 64, (const float*)(P + P_CC) + (size_t)bh * SEQ, (char*)lds);
                }
            } else if (k == 5) {
                pg8::Gemm g{XB, (const bf16_t*)(wl + W_1), M, DFF, DM}; pg8::StaticOrder S; S.init(M, DFF, G, bx);
                EpiRelu2 E{UB, SS};
                pg8::gemm_phase<EpiRelu2, pg8::StaticOrder, true, true>(L, g, S, E);
            } else {
                const bool ff2 = (k == 6);
                pg8::Gemm g{ff2 ? UB : MIX, (const bf16_t*)(wl + (ff2 ? W_2 : W_OUT)), M, DM, ff2 ? DFF : DM}; pg8::StaticOrder S; S.init(M, DM, G, bx);
                EpiResid E{XB, (ff2 && l == DEPTH - 1) ? ap->out : nullptr, SS};
                pg8::gemm_phase<EpiResid, pg8::StaticOrder, true, true>(L, g, S, E);
            }
            }
        }
#ifdef PROBE_T
        if (bx == 0 && threadIdx.x == 0) ((unsigned long long*)(ws + 65536))[ph] = __builtin_amdgcn_s_memrealtime();
#endif
        if (ph + 1 < a.ph_hi) {
            if (ph == 0) {
                grid.sync();
                (void)xcd_barrier_post((unsigned*)(ws + WS_BAR), (volatile LAS unsigned*)(L + LDS_BYTES - 128));
            } else {
                XcdBarrier xb_; xb_.bar = (unsigned*)(ws + WS_BAR); xb_.x = xb_xcc_id(); xb_.st = (volatile LAS unsigned*)(L + LDS_BYTES - 128);
                xcd_barrier(xb_);
            }
        }
    }
}

#ifndef MK_MULTI
#define MK_MULTI 0
#endif
extern "C" void kernel_launch(void* const* d_in, const int* in_sizes, int n_in, void* d_out, int out_size, void* d_ws, size_t ws_size, hipStream_t stream) {
    static int grid = 0;
    if (grid == 0) {
        int dev = 0, cus = 0, per = 0;
        if (n_in != 14 || out_size != M * DM || ws_size < WS_END) { fprintf(stderr, "kernel_launch: unexpected shapes (n_in %d out %d ws %zu)\n", n_in, out_size, ws_size); grid = -1; return; }
        (void)hipGetDevice(&dev); (void)hipDeviceGetAttribute(&cus, hipDeviceAttributeMultiprocessorCount, dev);
        (void)hipFuncSetAttribute((const void*)fwd, hipFuncAttributeMaxDynamicSharedMemorySize, LDS_BYTES);
        (void)hipOccupancyMaxActiveBlocksPerMultiprocessor(&per, (const void*)fwd, 512, LDS_BYTES);
        if (per < 1) per = 1;
        grid = cus * per;
        fprintf(stderr, "kernel_launch: grid %d (cus %d x %d)\n", grid, cus, per);
    }
    if (grid < 0) return;
    Args a{};
    for (int i = 0; i < 14; ++i) a.in[i] = (const float*)d_in[i];
    a.out = (float*)d_out; a.ws = (unsigned char*)d_ws;
#if MK_MULTI
    for (int ph = 0; ph < NPHASE; ++ph) { a.ph_lo = ph; a.ph_hi = ph + 1; hipLaunchKernelGGL(fwd, dim3(grid), dim3(512), LDS_BYTES, stream, a); }
#else
#ifdef PROBE_T
    a.ph_lo = 0; a.ph_hi = NPHASE + 1;
#else
    a.ph_lo = 0; a.ph_hi = NPHASE;
#endif
    void* args[] = {&a};
    hipError_t e = hipLaunchCooperativeKernel((const void*)fwd, dim3(grid), dim3(512), args, LDS_BYTES, stream);
    if (e != hipSuccess) fprintf(stderr, "kernel_launch: cooperative launch failed: %s (grid %d)\n", hipGetErrorString(e), grid);
#endif
}
```

```cpp
#include <hip/hip_runtime.h>
#include <hip/hip_cooperative_groups.h>
#include <cstdio>
#include <cstdint>
namespace cg = cooperative_groups;
namespace pg8 {
#define PG8_LAS __attribute__((address_space(3)))
typedef unsigned short bf16_t;
typedef short bf16x8 __attribute__((ext_vector_type(8)));
typedef float f32x4 __attribute__((ext_vector_type(4)));
typedef unsigned u32x4 __attribute__((ext_vector_type(4)));
constexpr int BM = 256, BK = 64, HALF = 128, HTB = HALF * BK * 2  , STAGE_BYTES = 8 * HTB, NXCD = 8, WGM = 8;

__host__ __device__ __forceinline__ int lds_byte(int r, int c) { const int st = (r >> 4) * 2 + (c >> 5), rr = r & 15, cc = c & 31, ob = rr * 64 + cc * 2; return st * 1024 + (ob ^ (((ob >> 9) & 1) << 5)); }
__host__ __device__ __forceinline__ void stage_rc(int b, int& R, int& C) { const int st = b / 1024, sb = b % 1024, swz = sb ^ (((sb >> 9) & 1) << 5); R = (st >> 1) * 16 + swz / 64; C = (st & 1) * 32 + (swz % 64) / 2; }
__host__ __device__ __forceinline__ int perm32(int rho) { const int n = rho >> 4, i = rho & 15; return 8 * (i >> 2) + 4 * n + (i & 3); }

struct Unit { int pm, pn; };
struct Gemm { const bf16_t* A; const bf16_t* Bt; int M, N, K; };

struct StaticOrder {
    int nM, nN, nwg, G, c;
    __host__ __device__ void init(int M, int N, int G_, int c_) { nM = M / BM; nN = N / BM; nwg = nM * nN; G = G_; c = c_; }
    __host__ __device__ bool next(int i, Unit& u) const {
        const long L = (long)i * G + c; if (L >= nwg) return false;
        int wgid = (int)L; { const int q = nwg / NXCD, r = nwg % NXCD, xcd = wgid % NXCD, off = wgid / NXCD; wgid = (xcd < r ? xcd * (q + 1) : r * (q + 1) + (xcd - r) * q) + off; }
        const int nig = WGM * nN, gid = wgid / nig, fm = gid * WGM, gsz = (nM - fm) < WGM ? (nM - fm) : WGM;
        u.pm = fm + ((wgid % nig) % gsz); u.pn = (wgid % nig) / gsz; return true;
    }
    __device__ __forceinline__ void a_ready(const Unit&) const {}
    __device__ __forceinline__ void done(const Unit&) const {}
};

__device__ __forceinline__ unsigned cvt_pk_bf16(float lo, float hi) { unsigned r; asm volatile("v_cvt_pk_bf16_f32 %0, %1, %2" : "=v"(r) : "v"(lo), "v"(hi)); return r; }
typedef float f32x2 __attribute__((ext_vector_type(2)));
template <class Epi, class Sched, bool ALIGN_EPI = false, bool SP2 = false>
__device__ __forceinline__ void gemm_phase(PG8_LAS unsigned char* lds, const Gemm g, const Sched& S, const Epi& E) {
    int tid_ = threadIdx.x; asm volatile("" : "+v"(tid_));
    const int tid = tid_, wid = __builtin_amdgcn_readfirstlane(tid >> 6), lane = tid & 63, wr = wid >> 2, wc = wid & 3, fr = lane & 15, fq = lane >> 4;
    const int K = g.K, nt = K / BK;
    unsigned voffA[2], voffB[2];
#pragma unroll
    for (int i = 0; i < 2; ++i) { int R, C; stage_rc(tid * 16 + i * 8192, R, C); const int Rb = Epi::PERM ? ((R & ~31) + perm32(R & 31)) : R;
        voffA[i] = (unsigned)(R * K + C) * 2u; voffB[i] = (unsigned)(Rb * K + C) * 2u; }
    const size_t kstep = (size_t)(BK * 2);
    const size_t hstep = (size_t)HALF * K * 2;
    const size_t tstep = 2 * hstep;
    const unsigned ldsw = (unsigned)wid * 1024u;
    const int aoff = lds_byte(wr * 64 + fr, fq * 8), boff = lds_byte(wc * 32 + fr, fq * 8);
#define PG8_SA(b, h) (((b) * 2 + (h)) * HTB)
#define PG8_SB(b, h) ((4 + (b) * 2 + (h)) * HTB)
#define PG8_STAGE(bufoff, gbase, voff) do { _Pragma("unroll") for (int _i = 0; _i < 2; ++_i) \
        __builtin_amdgcn_global_load_lds((const unsigned*)((const char*)(gbase) + (voff)[_i]), (PG8_LAS unsigned*)(lds + (bufoff) + ldsw + _i * 8192), 16, 0, 0); } while (0)
#define PG8_LDA(dst, b, h) do { _Pragma("unroll") for (int m = 0; m < 4; ++m) _Pragma("unroll") for (int k = 0; k < 2; ++k) dst[m][k] = *(const PG8_LAS bf16x8*)(lds + PG8_SA(b, h) + aoff + m * 2048 + k * 1024); } while (0)
#define PG8_LDB(dst, b, h) do { _Pragma("unroll") for (int n = 0; n < 2; ++n) _Pragma("unroll") for (int k = 0; k < 2; ++k) dst[n][k] = *(const PG8_LAS bf16x8*)(lds + PG8_SB(b, h) + boff + n * 2048 + k * 1024); } while (0)
#define PG8_MMA(ai, bj, At, Bt) do { __builtin_amdgcn_s_setprio(1); _Pragma("unroll") for (int m = 0; m < 4; ++m) _Pragma("unroll") for (int n = 0; n < 2; ++n) _Pragma("unroll") for (int k = 0; k < 2; ++k) \
        acc[ai][bj][m][n] = __builtin_amdgcn_mfma_f32_16x16x32_bf16(Bt[n][k], At[m][k], acc[ai][bj][m][n], 0, 0, 0); __builtin_amdgcn_s_setprio(0); } while (0)
#define PG8_WAIT_V(n) asm volatile("s_waitcnt vmcnt(" #n ")" ::: "memory")
#define PG8_WAIT_L(n) asm volatile("s_waitcnt lgkmcnt(" #n ")" ::: "memory")
#define PG8_BAR __builtin_amdgcn_s_barrier()
#define PG8_SCHED __builtin_amdgcn_sched_barrier(0)
    Unit cur, nxt; int ui = 0;
    if (!S.next(0, cur)) return;
    f32x4 acc[2][2][4][2];
#pragma unroll
    for (int a = 0; a < 2; ++a)
#pragma unroll
        for (int b = 0; b < 2; ++b)
#pragma unroll
            for (int m = 0; m < 4; ++m)
#pragma unroll
                for (int n = 0; n < 2; ++n) acc[a][b][m][n] = (f32x4){0.f, 0.f, 0.f, 0.f};
    bf16x8 At[4][2], B0[2][2], B1[2][2];
    const char* cA = (const char*)g.A + (size_t)cur.pm * tstep; const char* cB = (const char*)g.Bt + (size_t)cur.pn * tstep;
    S.a_ready(cur);
    if constexpr (SP2) {
        PG8_STAGE(PG8_SB(0, 0), cB, voffB); PG8_STAGE(PG8_SB(0, 1), cB + hstep, voffB); PG8_STAGE(PG8_SA(0, 0), cA, voffA); PG8_STAGE(PG8_SA(0, 1), cA + hstep, voffA);
        if (wr == 1) PG8_BAR;
        PG8_WAIT_V(2); PG8_BAR;
        PG8_STAGE(PG8_SB(1, 0), cB + kstep, voffB); PG8_STAGE(PG8_SA(1, 0), cA + kstep, voffA); PG8_STAGE(PG8_SB(1, 1), cB + hstep + kstep, voffB);
        PG8_WAIT_V(6); PG8_BAR;
    } else {
        PG8_STAGE(PG8_SB(0, 0), cB, voffB); PG8_STAGE(PG8_SA(0, 0), cA, voffA); PG8_STAGE(PG8_SB(0, 1), cB + hstep, voffB); PG8_STAGE(PG8_SA(0, 1), cA + hstep, voffA);
        if (wr == 1) PG8_BAR;
        PG8_WAIT_V(4); PG8_BAR;
        PG8_STAGE(PG8_SB(1, 0), cB + kstep, voffB); PG8_STAGE(PG8_SA(1, 0), cA + kstep, voffA); PG8_STAGE(PG8_SB(1, 1), cB + hstep + kstep, voffB);
        PG8_WAIT_V(6); PG8_BAR;
    }
    for (;;) {
        const bool has_next = S.next(ui + 1, nxt);
        const char* nA = has_next ? (const char*)g.A + (size_t)nxt.pm * tstep : cA; const char* nB = has_next ? (const char*)g.Bt + (size_t)nxt.pn * tstep : cB;
        for (int t = 0; t < nt; t += 2) {
            const bool last = (t == nt - 2);
            const char* a1 = cA + (size_t)(t + 1) * kstep;
            const char* a2 = last ? nA : cA + (size_t)(t + 2) * kstep; const char* b2 = last ? nB : cB + (size_t)(t + 2) * kstep;
            const char* a3 = a2 + kstep; const char* b3 = b2 + kstep;
            if (last && has_next) S.a_ready(nxt);
            if constexpr (SP2) {
            PG8_LDB(B0, 0, 0); PG8_LDB(B1, 0, 1); PG8_SCHED; PG8_LDA(At, 0, 0); PG8_STAGE(PG8_SA(1, 1), a1 + hstep, voffA);
            PG8_WAIT_V(8); PG8_WAIT_L(0); PG8_BAR; PG8_MMA(0, 0, At, B0); PG8_MMA(0, 1, At, B1); PG8_BAR; PG8_SCHED;
            PG8_LDA(At, 0, 1); PG8_STAGE(PG8_SB(0, 0), b2, voffB); PG8_STAGE(PG8_SB(0, 1), b2 + hstep, voffB); PG8_STAGE(PG8_SA(0, 0), a2, voffA);
            PG8_WAIT_V(8); PG8_WAIT_L(0); PG8_BAR; PG8_MMA(1, 0, At, B0); PG8_MMA(1, 1, At, B1); PG8_BAR; PG8_SCHED;
            PG8_LDB(B0, 1, 0); PG8_LDB(B1, 1, 1); PG8_SCHED; PG8_LDA(At, 1, 0); PG8_STAGE(PG8_SA(0, 1), a2 + hstep, voffA);
            PG8_WAIT_V(8); PG8_WAIT_L(0); PG8_BAR; PG8_MMA(0, 0, At, B0); PG8_MMA(0, 1, At, B1); PG8_BAR; PG8_SCHED;
            PG8_LDA(At, 1, 1); PG8_STAGE(PG8_SB(1, 0), b3, voffB); PG8_STAGE(PG8_SB(1, 1), b3 + hstep, voffB); PG8_STAGE(PG8_SA(1, 0), a3, voffA);
            PG8_WAIT_V(8); PG8_WAIT_L(0); PG8_BAR; PG8_MMA(1, 0, At, B0); PG8_MMA(1, 1, At, B1); PG8_BAR; PG8_SCHED;
            } else {
            PG8_LDB(B0, 0, 0); PG8_SCHED; PG8_LDA(At, 0, 0); PG8_STAGE(PG8_SA(1, 1), a1 + hstep, voffA);
            PG8_WAIT_L(8); PG8_BAR; PG8_WAIT_L(0); PG8_MMA(0, 0, At, B0); PG8_BAR; PG8_SCHED;
            PG8_LDB(B1, 0, 1); PG8_STAGE(PG8_SB(0, 0), b2, voffB);
            PG8_BAR; PG8_WAIT_L(0); PG8_MMA(0, 1, At, B1); PG8_BAR;
            PG8_LDA(At, 0, 1); PG8_STAGE(PG8_SA(0, 0), a2, voffA);
            PG8_BAR; PG8_WAIT_L(0); PG8_MMA(1, 0, At, B0); PG8_BAR; PG8_SCHED;
            PG8_STAGE(PG8_SB(0, 1), b2 + hstep, voffB);
            PG8_WAIT_V(6); PG8_BAR; PG8_MMA(1, 1, At, B1); PG8_BAR;
            PG8_LDB(B0, 1, 0); PG8_SCHED; PG8_LDA(At, 1, 0); PG8_STAGE(PG8_SA(0, 1), a2 + hstep, voffA);
            PG8_WAIT_L(8); PG8_BAR; PG8_WAIT_L(0); PG8_MMA(0, 0, At, B0); PG8_BAR; PG8_SCHED;
            PG8_LDB(B1, 1, 1); PG8_STAGE(PG8_SB(1, 0), b3, voffB);
            PG8_BAR; PG8_WAIT_L(0); PG8_MMA(0, 1, At, B1); PG8_BAR;
            PG8_LDA(At, 1, 1); PG8_STAGE(PG8_SA(1, 0), a3, voffA);
            PG8_BAR; PG8_WAIT_L(0); PG8_MMA(1, 0, At, B0); PG8_BAR; PG8_SCHED;
            PG8_STAGE(PG8_SB(1, 1), b3 + hstep, voffB);
            PG8_WAIT_V(6); PG8_BAR; PG8_MMA(1, 1, At, B1); PG8_BAR;
            }
        }
        if constexpr (ALIGN_EPI) { if (wr == 0) PG8_BAR; }
        if constexpr (!Epi::AFTER_DRAIN) { E(acc, cur, wr, wc, fr, fq); S.done(cur); }
        if (!has_next) break;
#pragma unroll
        for (int a = 0; a < 2; ++a)
#pragma unroll
            for (int b = 0; b < 2; ++b)
#pragma unroll
                for (int m = 0; m < 4; ++m)
#pragma unroll
                    for (int n = 0; n < 2; ++n) acc[a][b][m][n] = (f32x4){0.f, 0.f, 0.f, 0.f};
        cur = nxt; cA = nA; cB = nB; ++ui;
        if constexpr (ALIGN_EPI) { if (wr == 1) PG8_BAR; }
    }
    PG8_WAIT_V(0);
    if constexpr (!ALIGN_EPI) { if (wr == 0) PG8_BAR; }
    PG8_BAR;
    if constexpr (Epi::AFTER_DRAIN) { E.fused(acc, cur, wr, wc, fr, fq, lds, wid, lane); S.done(cur); }
#undef PG8_SA
#undef PG8_SB
#undef PG8_STAGE
#undef PG8_LDA
#undef PG8_LDB
#undef PG8_MMA
#undef PG8_WAIT_V
#undef PG8_WAIT_L
#undef PG8_BAR
#undef PG8_SCHED
}
}
#include <hip/hip_bf16.h>
#include <cmath>
namespace attn_body {
using bf16=__hip_bfloat16;
using bf16x8=__attribute__((ext_vector_type(8)))short;
using s16x4=__attribute__((ext_vector_type(4)))short;
using f32x16=__attribute__((ext_vector_type(16)))float;
using u32x4=__attribute__((ext_vector_type(4)))unsigned;
using f32x4v=__attribute__((ext_vector_type(4)))float;
constexpr int SEQ=4096,D=64,DM=64,OPITCH=1024;
constexpr int LDS_C=98304;
constexpr int NW=8,QBLK=32,QB=QBLK*NW,KVBLK=64,NQB=SEQ/QB;
constexpr int ATTN_UNIT_ROWS=QB;
__device__ __forceinline__ int crow(int r,int hi){return (r&3)+8*(r>>2)+4*hi;}
#define SBAR() __builtin_amdgcn_sched_barrier(0)
__device__ __forceinline__ void cmask(f32x16&p0,f32x16&p1,int jb,int qrel,int hi){
  const float NEG=-INFINITY; int kb=64*jb+4*hi;
  #pragma unroll
  for(int r=0;r<16;++r){int kv=kb+(r&3)+8*(r>>2); if(kv>qrel)p0[r]=NEG; if(kv+32>qrel)p1[r]=NEG;}
}

constexpr int NSLOT=3, SLOTB=8192;
constexpr int LDS_K=0, LDS_V=NSLOT*SLOTB, LDS_WS=2*NSLOT*SLOTB, LDS_OST=LDS_WS+NW*64*4, LDS_BYTES=LDS_OST+NW*4096;
constexpr float C2=0.125f*1.4426950408889634f;
__device__ __forceinline__ void glds16(const void*gsrc,unsigned lds_dst){unsigned keep;
  asm volatile("s_mov_b32 %0, m0\n\ts_mov_b32 m0, %2\n\ts_nop 0\n\tglobal_load_lds_dwordx4 %1, off\n\ts_mov_b32 m0, %0":"=&s"(keep):"v"(gsrc),"s"(lds_dst):"memory");}
__device__ __forceinline__ float max3f(float a,float b,float c){float r;asm("v_max3_f32 %0, %1, %2, %3":"=v"(r):"v"(a),"v"(b),"v"(c));return r;}
__device__ __forceinline__ float max2f(float a,float b){float r;asm("v_max_f32_e32 %0, %1, %2":"=v"(r):"v"(a),"v"(b));return r;}
__device__ __forceinline__ float fadd_s(float a,float b){float r;asm("v_add_f32_e32 %0, %1, %2":"=v"(r):"v"(a),"v"(b));return r;}
__device__ __forceinline__ float fsub_s(float a,float b){float r;asm("v_sub_f32_e32 %0, %1, %2":"=v"(r):"v"(a),"v"(b));return r;}
typedef float f32x2_t __attribute__((ext_vector_type(2))); typedef __bf16 bf16x2_t __attribute__((ext_vector_type(2)));
__device__ __forceinline__ unsigned cvtpk_s(float lo,float hi){f32x2_t v={lo,hi};bf16x2_t b=__builtin_convertvector(v,bf16x2_t);return __builtin_bit_cast(unsigned,b);}
#define WAIT_BAR(N) asm volatile("s_waitcnt vmcnt(" #N ") lgkmcnt(0)\n\ts_barrier":::"memory")

__device__ __forceinline__ void qkt(f32x16&p0,f32x16&p1,const char*Kslot,const bf16x8*qr,const f32x16&negm,int r32,int hi){
  const char*kb=Kslot+hi*1024+r32*16;
  #pragma unroll
  for(int d0=0;d0<4;++d0){
    const bf16x8 b0=*reinterpret_cast<const bf16x8*>(kb+d0*2048);
    const bf16x8 b1=*reinterpret_cast<const bf16x8*>(kb+d0*2048+512);
    if(d0==0){p0=__builtin_amdgcn_mfma_f32_32x32x16_bf16(b0,qr[0],negm,0,0,0);p1=__builtin_amdgcn_mfma_f32_32x32x16_bf16(b1,qr[0],negm,0,0,0);}
    else{p0=__builtin_amdgcn_mfma_f32_32x32x16_bf16(b0,qr[d0],p0,0,0,0);p1=__builtin_amdgcn_mfma_f32_32x32x16_bf16(b1,qr[d0],p1,0,0,0);}}
}
typedef __attribute__((address_space(3))) const char* lds_cptr;
typedef short v4i16_t __attribute__((ext_vector_type(4)));
__device__ __forceinline__ void kload8(bf16x8*kf,lds_cptr kp){
  kf[0]=*(const __attribute__((address_space(3))) bf16x8*)(kp);      kf[1]=*(const __attribute__((address_space(3))) bf16x8*)(kp+512);
  kf[2]=*(const __attribute__((address_space(3))) bf16x8*)(kp+2048); kf[3]=*(const __attribute__((address_space(3))) bf16x8*)(kp+2560);
  kf[4]=*(const __attribute__((address_space(3))) bf16x8*)(kp+4096); kf[5]=*(const __attribute__((address_space(3))) bf16x8*)(kp+4608);
  kf[6]=*(const __attribute__((address_space(3))) bf16x8*)(kp+6144); kf[7]=*(const __attribute__((address_space(3))) bf16x8*)(kp+6656);
}
__device__ __forceinline__ void kload2(bf16x8*kf,lds_cptr kp,int j){ kf[2*j]=*(const __attribute__((address_space(3))) bf16x8*)(kp+j*2048); kf[2*j+1]=*(const __attribute__((address_space(3))) bf16x8*)(kp+j*2048+512); }
__device__ __forceinline__ s16x4 vtr(lds_cptr p){ return __builtin_bit_cast(s16x4,__builtin_amdgcn_ds_read_tr16_b64_v4i16((__attribute__((address_space(3))) v4i16_t*)p)); }
__device__ __forceinline__ float rowmax(const f32x16&p0,const f32x16&p1){
  float a=max3f(p0[0],p0[1],p1[0]),b=max3f(p0[2],p0[3],p1[1]);a=max3f(a,p1[2],p1[3]);
  #pragma unroll
  for(int r=4;r<16;r+=4){a=max3f(a,p0[r],p0[r+1]);b=max3f(b,p0[r+2],p0[r+3]);a=max3f(a,p1[r],p1[r+1]);b=max3f(b,p1[r+2],p1[r+3]);}
  const float m=max2f(a,b);
  auto rr=__builtin_amdgcn_permlane32_swap(__float_as_uint(m),__float_as_uint(m),false,false);
  return max2f(__uint_as_float(rr[0]),__uint_as_float(rr[1]));
}
__device__ __forceinline__ void pv(f32x16*o,int vb,bf16x8 pa0,bf16x8 pa1,bf16x8 pa2,bf16x8 pa3){
  #pragma unroll
  for(int d0=0;d0<2;++d0){s16x4 lo[4],hi[4];
    #pragma unroll
    for(int ks=0;ks<4;++ks){
      asm volatile("ds_read_b64_tr_b16 %0,%1 offset:%c2":"=&v"(lo[ks]):"v"(vb),"i"(d0*4096+ks*1024):"memory");
      asm volatile("ds_read_b64_tr_b16 %0,%1 offset:%c2":"=&v"(hi[ks]):"v"(vb),"i"(d0*4096+ks*1024+512):"memory");}
    asm volatile("s_waitcnt lgkmcnt(0)":::"memory");SBAR();
    #define PK(k) (bf16x8){lo[k][0],lo[k][1],lo[k][2],lo[k][3],hi[k][0],hi[k][1],hi[k][2],hi[k][3]}
    o[d0]=__builtin_amdgcn_mfma_f32_32x32x16_bf16(pa0,PK(0),o[d0],0,0,0);
    o[d0]=__builtin_amdgcn_mfma_f32_32x32x16_bf16(pa1,PK(1),o[d0],0,0,0);
    o[d0]=__builtin_amdgcn_mfma_f32_32x32x16_bf16(pa2,PK(2),o[d0],0,0,0);
    o[d0]=__builtin_amdgcn_mfma_f32_32x32x16_bf16(pa3,PK(3),o[d0],0,0,0);
    #undef PK
  }
}

#ifndef ATTN_STORE16
#define ATTN_STORE16(p,v) (*(u32x4*)(p)=(v))
#endif
template<int THRL,bool BIASON=true> __device__ __forceinline__ void attn_unit(int qb,int jstart,const bf16*Q,const bf16*__restrict__ K,const bf16*__restrict__ V,bf16*O,const float*__restrict__ Cg,char*shm){
  int tid_=threadIdx.x; asm volatile("":"+v"(tid_)); const int tid=tid_,lane=tid&63,r32=lane&31,hi=lane>>5; const int wid=__builtin_amdgcn_readfirstlane(tid>>6);
  const int q0=qb*QB;
  const bf16*Qw=Q+(long)(q0+wid*QBLK)*DM;
  const bf16*Kh=K+(long)jstart*KVBLK*DM,*Vh=V+(long)jstart*KVBLK*DM;
  const lds_cptr shm3=(lds_cptr)shm;
  const unsigned lds0=(unsigned)(uintptr_t)shm;
  float*wsf=(float*)(shm+LDS_WS)+wid*64;
  const bf16*ksrc=Kh+(long)lane*DM+wid*8;
  const bf16*vsrc=Vh+(long)(16*(wid&3)+(lane>>2))*DM+(wid>>2)*32+(lane&3)*8;
  const unsigned kdst=lds0+LDS_K+wid*1024, vdst=lds0+LDS_V+wid*1024;
  #define DMA_K(t,slot) glds16(ksrc+(long)(t)*KVBLK*DM,(unsigned)__builtin_amdgcn_readfirstlane(kdst+(slot)))
  #define DMA_V(t,slot) glds16(vsrc+(long)(t)*KVBLK*DM,(unsigned)__builtin_amdgcn_readfirstlane(vdst+(slot)))
  const int vb0=(int)(lds0+LDS_V)+((lane>>4)&1)*32+(lane&3)*8+(4*hi+((lane&15)>>2))*64;
  const char*Kbase=shm+LDS_K; bf16x8 kf[8];
  const lds_cptr kp0=shm3+LDS_K+hi*1024+r32*16; const lds_cptr vp0=shm3+LDS_V+((lane>>4)&1)*32+(lane&3)*8+(4*hi+((lane&15)>>2))*64;
  const int NT=(q0+QB)/KVBLK-jstart;
  { typedef __attribute__((address_space(3))) f32x4v lf32x4; lf32x4*cl_=(lf32x4*)(shm3+LDS_C); const f32x4v*cg_=(const f32x4v*)(Cg+jstart*KVBLK); const int n4_=(q0+QB-jstart*KVBLK)>>2;
    f32x4v c0_=f32x4v{},c1_=f32x4v{}; if(tid<n4_)c0_=cg_[tid]; if(tid+NW*64<n4_)c1_=cg_[tid+NW*64]; if(tid<n4_)cl_[tid]=c0_; if(tid+NW*64<n4_)cl_[tid+NW*64]=c1_; }
  DMA_K(0,0);DMA_V(0,0);DMA_K(1,SLOTB);
  bf16x8 qr[4];
  #pragma unroll
  for(int d0=0;d0<4;++d0)qr[d0]=*reinterpret_cast<const bf16x8*>(&Qw[(long)r32*DM+d0*16+hi*8]);
  float mhat=0.f,l_reg=0.f;f32x16 o[2];o[0]=f32x16{};o[1]=f32x16{};
  const int qrel=wid*QBLK+r32;
  #define CMASK(P0,P1,t) do{int jb_=(t)-(NT-4); if(jb_>=0)cmask(P0,P1,jb_,qrel,hi);}while(0)
  typedef __attribute__((address_space(3))) const float* lds_fptr; typedef __attribute__((address_space(3))) const f32x4v* lds_f4ptr;
  const lds_fptr cl0=(lds_fptr)(shm3+LDS_C)+4*hi;
  #define BIAS(P0,P1,t) do{ const lds_fptr cb_=cl0+64*(t); _Pragma("unroll") for(int g_=0;g_<4;++g_){ const f32x4v a_=*(lds_f4ptr)(cb_+8*g_), b_=*(lds_f4ptr)(cb_+32+8*g_); \
      _Pragma("unroll") for(int i_=0;i_<4;++i_){P0[4*g_+i_]-=a_[i_];P1[4*g_+i_]-=b_[i_];} } }while(0)
  #define BIASINIT(C0_,C1_,t) do{ const lds_fptr cb_=cl0+64*(t); const float nm_=-mhat; _Pragma("unroll") for(int g_=0;g_<4;++g_){ f32x4v a_=f32x4v{},b_=f32x4v{}; if(BIASON){a_=*(lds_f4ptr)(cb_+8*g_); b_=*(lds_f4ptr)(cb_+32+8*g_);} \
      _Pragma("unroll") for(int i_=0;i_<4;++i_){C0_[4*g_+i_]=nm_-a_[i_];C1_[4*g_+i_]=nm_-b_[i_];} } }while(0)
  bool resc=false;
  #define START(P0,P1) do{ const float rm=rowmax(P0,P1); resc=false; \
    { const float dl=rm; mhat=fadd_s(mhat,dl); \
      _Pragma("unroll") for(int r=0;r<16;++r){P0[r]=fsub_s(P0[r],dl);P1[r]=fsub_s(P1[r],dl);} \
      } \
    _Pragma("unroll") for(int r=0;r<16;++r)P0[r]=__builtin_amdgcn_exp2f(P0[r]); }while(0)
  #define RESC() do{ if(resc){ asm volatile("s_waitcnt lgkmcnt(0)":::"memory"); \
      _Pragma("unroll") for(int d_=0;d_<2;++d_) _Pragma("unroll") for(int r=0;r<16;++r)o[d_][r]*=wsf[crow(r,hi)]; } }while(0)
  f32x16 pA0,pA1,pB0,pB1;
  int sl_prev=0,sl_cur=0,sl_next=SLOTB;
  #define ROT() do{sl_prev=sl_cur;sl_cur=sl_next;sl_next=(sl_next==(NSLOT-1)*SLOTB)?0:sl_next+SLOTB;}while(0)
  DMA_K(2,2*SLOTB);
  WAIT_BAR(3);
  { const f32x16 zero_=f32x16{}; qkt(pA0,pA1,Kbase,qr,zero_,r32,hi); }asm volatile("s_nop 15\n\ts_nop 7":"+v"(pA0),"+v"(pA1));BIAS(pA0,pA1,0);CMASK(pA0,pA1,0);
  START(pA0,pA1);
  BIASINIT(pB0,pB1,1);
  _Pragma("unroll") for(int r=0;r<16;++r)pA1[r]=__builtin_amdgcn_exp2f(pA1[r]);
  WAIT_BAR(0);
  DMA_K(3,0);DMA_V(1,SLOTB);
  ROT();
  kload8(kf,kp0+sl_cur);
  WAIT_BAR(2);
  s16x4 vlo[8],vhi[8]; u32x4 pw0,pw1,pw2,pw3;
  #define PKW(P,B) cvtpk_s(P[B],P[B+1])
  #define PAF(k) __builtin_bit_cast(bf16x8,pw##k)
  #define VFR(i) (bf16x8){vlo[i][0],vlo[i][1],vlo[i][2],vlo[i][3],vhi[i][0],vhi[i][1],vhi[i][2],vhi[i][3]}
  #define PIN(x) asm volatile("":"+v"(x))
  #define MX3(a,b,c) __builtin_fmaxf(__builtin_fmaxf((a),(b)),(c))
  #define GAPA(MF,A0,A1,A2,A3,W0,W1,PW) do{ MF; sacc+=A0; sacc+=A1; sacc+=A2; sacc+=A3; PIN(sacc); W0; W1; PIN(PW); SBAR(); }while(0)
  #define EX(v) __builtin_amdgcn_exp2f(v)
  #define GAPB(MF,X,B) do{ MF; X[B]=EX(X[B]); X[B+1]=EX(X[B+1]); X[B+2]=EX(X[B+2]); X[B+3]=EX(X[B+3]); PIN(X); SBAR(); }while(0)
  #define VRD(i) do{ vlo[i]=vtr(vp_+(((i)>>2)*4096+((i)&3)*1024)); vhi[i]=vtr(vp_+(((i)>>2)*4096+((i)&3)*1024+512)); }while(0)
  #define KRD(G,j) do{ if(G){ kload2(kf,kp0+sl_next,j); SBAR(); } }while(0)
  #define STEP(C0,C1,P0,P1,t,GK,GV,GL) do{ SBAR(); \
    const lds_cptr vp_=vp0+sl_prev; \
    VRD(0); SBAR(); float sacc=(P0[0]+P0[1]); \
    GAPA(C0=__builtin_amdgcn_mfma_f32_32x32x16_bf16(kf[0],qr[0],C0,0,0,0), P0[2],P0[3],P0[4],P0[5],     pw0[0]=PKW(P0,0), pw0[1]=PKW(P0,2), pw0); \
    VRD(4); SBAR(); GAPA(C1=__builtin_amdgcn_mfma_f32_32x32x16_bf16(kf[1],qr[0],C1,0,0,0), P0[6],P0[7],P0[8],P0[9],     pw0[2]=PKW(P0,4), pw0[3]=PKW(P0,6), pw0); \
    VRD(1); SBAR(); GAPA(C0=__builtin_amdgcn_mfma_f32_32x32x16_bf16(kf[2],qr[1],C0,0,0,0),   P0[10],P0[11],P0[12],P0[13], pw1[0]=PKW(P0,8), pw1[1]=PKW(P0,10), pw1); \
    VRD(5); SBAR(); GAPA(C1=__builtin_amdgcn_mfma_f32_32x32x16_bf16(kf[3],qr[1],C1,0,0,0),   P0[14],P0[15],P1[0],P1[1],   pw1[2]=PKW(P0,12),pw1[3]=PKW(P0,14), pw1); \
    VRD(2); SBAR(); GAPA(C0=__builtin_amdgcn_mfma_f32_32x32x16_bf16(kf[4],qr[2],C0,0,0,0),   P1[2],P1[3],P1[4],P1[5],     pw2[0]=PKW(P1,0), pw2[1]=PKW(P1,2), pw2); \
    VRD(6); SBAR(); GAPA(C1=__builtin_amdgcn_mfma_f32_32x32x16_bf16(kf[5],qr[2],C1,0,0,0),   P1[6],P1[7],P1[8],P1[9],     pw2[2]=PKW(P1,4), pw2[3]=PKW(P1,6), pw2); \
    VRD(3); SBAR(); GAPA(C0=__builtin_amdgcn_mfma_f32_32x32x16_bf16(kf[6],qr[3],C0,0,0,0),   P1[10],P1[11],P1[12],P1[13], pw3[0]=PKW(P1,8), pw3[1]=PKW(P1,10), pw3); \
    VRD(7); SBAR(); GAPA(C1=__builtin_amdgcn_mfma_f32_32x32x16_bf16(kf[7],qr[3],C1,0,0,0),   P1[14],P1[15],0.f,0.f,       pw3[2]=PKW(P1,12),pw3[3]=PKW(P1,14), pw3); \
    l_reg+=sacc; \
    if(GK){DMA_K((t)+3,sl_cur);} if(GV){DMA_V((t)+1,sl_next);} \
    CMASK(C0,C1,t); \
    { float a=MX3(C0[0],C0[1],C1[0]),b=MX3(C0[2],C0[3],C1[1]); a=MX3(a,C1[2],C1[3]); \
      _Pragma("unroll") for(int r=4;r<16;r+=4){a=MX3(a,C0[r],C0[r+1]);b=MX3(b,C0[r+2],C0[r+3]);a=MX3(a,C1[r],C1[r+1]);b=MX3(b,C1[r+2],C1[r+3]);} \
      float rm=__builtin_fmaxf(a,b); { auto rr=__builtin_amdgcn_permlane32_swap(__float_as_uint(rm),__float_as_uint(rm),false,false); rm=__builtin_fmaxf(__uint_as_float(rr[0]),__uint_as_float(rr[1])); } \
      resc=false; \
      if(__builtin_expect(__any(rm>(float)THRL),0)){ const float dl=__builtin_fmaxf(rm+30.f,0.f); mhat+=dl; \
        _Pragma("unroll") for(int r=0;r<16;++r){C0[r]-=dl;C1[r]-=dl;} \
        const float f=__builtin_amdgcn_exp2f(-dl); l_reg*=f; if(hi==0)wsf[r32]=f; resc=true; } } \
    SBAR(); \
    GAPB(o[0]=__builtin_amdgcn_mfma_f32_32x32x16_bf16(PAF(0),VFR(0),o[0],0,0,0), C0,0); \
    GAPB(o[1]=__builtin_amdgcn_mfma_f32_32x32x16_bf16(PAF(0),VFR(4),o[1],0,0,0), C0,4); \
    KRD(GL,0); GAPB(o[0]=__builtin_amdgcn_mfma_f32_32x32x16_bf16(PAF(1),VFR(1),o[0],0,0,0), C0,8); \
    KRD(GL,1); GAPB(o[1]=__builtin_amdgcn_mfma_f32_32x32x16_bf16(PAF(1),VFR(5),o[1],0,0,0), C0,12); \
    KRD(GL,2); GAPB(o[0]=__builtin_amdgcn_mfma_f32_32x32x16_bf16(PAF(2),VFR(2),o[0],0,0,0), C1,0); \
    KRD(GL,3); GAPB(o[1]=__builtin_amdgcn_mfma_f32_32x32x16_bf16(PAF(2),VFR(6),o[1],0,0,0), C1,4); \
    GAPB(o[0]=__builtin_amdgcn_mfma_f32_32x32x16_bf16(PAF(3),VFR(3),o[0],0,0,0), C1,8); \
    GAPB(o[1]=__builtin_amdgcn_mfma_f32_32x32x16_bf16(PAF(3),VFR(7),o[1],0,0,0), C1,12); \
    BIASINIT(P0,P1,(t)+1); SBAR(); \
    }while(0)
  int t=1;
  #undef CMASK
  #define CMASK(P0,P1,t) do{}while(0)
  for(;t+5<NT;t+=2){
    STEP(pB0,pB1,pA0,pA1,t,true,true,true);     WAIT_BAR(2); RESC(); ROT();
    STEP(pA0,pA1,pB0,pB1,t+1,true,true,true);   WAIT_BAR(2); RESC(); ROT();
  }
  #undef CMASK
  #define CMASK(P0,P1,t) do{int jb_=(t)-(NT-4); if(jb_>=0)cmask(P0,P1,jb_,qrel,hi);}while(0)
  #define ENDW(tt) do{ if((tt)+3<NT){WAIT_BAR(2);} else if((tt)+2<NT){WAIT_BAR(1);} else {WAIT_BAR(0);} }while(0)
  for(;t+1<NT;t+=2){
    STEP(pB0,pB1,pA0,pA1,t,(t+3<NT),(t+1<NT),(t+1<NT));       ENDW(t);   RESC(); ROT();
    STEP(pA0,pA1,pB0,pB1,t+1,(t+4<NT),(t+2<NT),(t+2<NT));     ENDW(t+1); RESC(); ROT();
  }
  STEP(pB0,pB1,pA0,pA1,NT-1,false,false,false); RESC();
  { float sacc=pB0[0]+pB0[1]; _Pragma("unroll") for(int r=2;r<16;++r)sacc+=pB0[r]; _Pragma("unroll") for(int r=0;r<16;++r)sacc+=pB1[r]; l_reg+=sacc;
    pw0=(u32x4){PKW(pB0,0),PKW(pB0,2),PKW(pB0,4),PKW(pB0,6)};pw1=(u32x4){PKW(pB0,8),PKW(pB0,10),PKW(pB0,12),PKW(pB0,14)};pw2=(u32x4){PKW(pB1,0),PKW(pB1,2),PKW(pB1,4),PKW(pB1,6)};pw3=(u32x4){PKW(pB1,8),PKW(pB1,10),PKW(pB1,12),PKW(pB1,14)};
    SBAR(); pv(o,vb0+sl_cur,PAF(0),PAF(1),PAF(2),PAF(3)); }
  #undef PKW
  #undef PAF
  #undef VFR
  #undef PIN
  #undef MX3
  #undef GAPA
  #undef GAPB
  #undef EX
  #undef VRD
  #undef KRD
  #undef STEP
  #undef ENDW
  {auto rr=__builtin_amdgcn_permlane32_swap(__float_as_uint(l_reg),__float_as_uint(l_reg),false,false);l_reg=__uint_as_float(rr[0])+__uint_as_float(rr[1]);}
  if(hi==0)wsf[32+r32]=l_reg;asm volatile("s_waitcnt lgkmcnt(0)":::"memory");
  float rli[16];
  #pragma unroll
  for(int r=0;r<16;++r)rli[r]=__builtin_amdgcn_rcpf(wsf[32+crow(r,hi)]);
  bf16*Ow=O+(long)(q0+wid*QBLK)*OPITCH;
  { bf16*stg=(bf16*)(shm+LDS_OST)+wid*2048;
    #pragma unroll
    for(int r=0;r<16;++r){const int orow=crow(r,hi);
      #pragma unroll
      for(int d0=0;d0<2;++d0)stg[orow*64+d0*32+r32]=__float2bfloat16(o[d0][r]*rli[r]);}
    asm volatile("s_waitcnt lgkmcnt(0)":::"memory");
    #pragma unroll
    for(int i=0;i<4;++i){const int row=i*8+(lane>>3),ch=lane&7; const u32x4 v=*(const u32x4*)(stg+row*64+ch*8); ATTN_STORE16(Ow+(long)row*OPITCH+ch*8,v);} }
  asm volatile("s_waitcnt lgkmcnt(0)\n\ts_barrier":::"memory");
  #undef DMA_K
  #undef DMA_V
  #undef CMASK
  #undef BIAS
  #undef BIASINIT
  #undef START
  #undef RESC
  #undef ROT
}
constexpr int SB_NS=8, SB_V=65536, SB_FLAGS=131072;
__device__ __forceinline__ void sb_unit(int qb,const bf16*Q,const bf16*__restrict__ K,const bf16*__restrict__ V,bf16*O,char*shm){
  int tid_=threadIdx.x; asm volatile("":"+v"(tid_)); const int tid=tid_,lane=tid&63,r32=lane&31,hi=lane>>5; const int wid=__builtin_amdgcn_readfirstlane(tid>>6);
  const int q0=qb*QB;
  const bf16*Qw=Q+(long)(q0+wid*QBLK)*DM;
  const unsigned lds0=(unsigned)(uintptr_t)shm;
  typedef __attribute__((address_space(3))) int lds_i32; typedef __attribute__((address_space(3))) const u32x4* lds_u4ptr;
  lds_i32*flags=(lds_i32*)((lds_cptr)shm+SB_FLAGS);
  const bf16*ksrc=K+(long)lane*DM+wid*8;
  const bf16*vsrc=V+(long)(16*(wid&3)+(lane>>2))*DM+(wid>>2)*32+(lane&3)*8;
  const unsigned kdst=lds0+wid*1024, vdst=lds0+SB_V+wid*1024;
  #define DMA_K(t,slot) glds16(ksrc+(long)(t)*KVBLK*DM,(unsigned)__builtin_amdgcn_readfirstlane(kdst+(slot)))
  #define DMA_V(t,slot) glds16(vsrc+(long)(t)*KVBLK*DM,(unsigned)__builtin_amdgcn_readfirstlane(vdst+(slot)))
  const int vb0=(int)(lds0+SB_V)+((lane>>4)&1)*32+(lane&3)*8+(4*hi+((lane&15)>>2))*64;
  const int NT=(q0+QB)/KVBLK;
  bf16x8 qr[4];
  #pragma unroll
  for(int d0=0;d0<4;++d0)qr[d0]=*reinterpret_cast<const bf16x8*>(&Qw[(long)r32*DM+d0*16+hi*8]);
  f32x16 o[2];o[0]=f32x16{};o[1]=f32x16{};
  float T=1.0f; const int t_abs=q0+wid*QBLK+r32; bool wdone=false;
  for(int jtop=NT-1;;jtop-=SB_NS){
    const int nb=(jtop+1<SB_NS)?jtop+1:SB_NS;
    for(int s=0;s<nb;++s){DMA_K(jtop-s,s*SLOTB);DMA_V(jtop-s,s*SLOTB);}
    WAIT_BAR(0);
    int s=(jtop==NT-1)?3-(wid>>1):0;
    for(;s<nb&&!wdone;++s){
      const int jt=jtop-s; const int slot=s*SLOTB; const bool band=(jt>=NT-4);
      f32x16 x0,x1; { f32x16 zero=f32x16{}; qkt(x0,x1,shm+slot,qr,zero,r32,hi); }
      f32x16 n0,n1;
      const int kb=64*jt+4*hi;
      #pragma unroll
      for(int r=0;r<16;++r){
        const float z0=x0[r],z1=x1[r];
        const float e0=__builtin_amdgcn_exp2f(-__builtin_fabsf(z0)), e1=__builtin_amdgcn_exp2f(-__builtin_fabsf(z1));
        const float r0=__builtin_amdgcn_rcpf(1.0f+e0), r1=__builtin_amdgcn_rcpf(1.0f+e1), er0=e0*r0, er1=e1*r1;
        float b0=z0>0.f?r0:er0, m0=z0>0.f?er0:r0, b1=z1>0.f?r1:er1, m1=z1>0.f?er1:r1;
        if(band){ const int kv=kb+(r&3)+8*(r>>2); if(!(kv<t_abs)){b0=0.f;m0=1.f;} if(!(kv+32<t_abs)){b1=0.f;m1=1.f;} }
        x0[r]=b0;x1[r]=b1;n0[r]=m0;n1[r]=m1;
      }
      float g0[4],g1[4],p0s[4],p1s[4];
      #pragma unroll
      for(int a=0;a<4;++a){ g0[a]=(n0[4*a]*n0[4*a+1])*(n0[4*a+2]*n0[4*a+3]); g1[a]=(n1[4*a]*n1[4*a+1])*(n1[4*a+2]*n1[4*a+3]);
        { auto rr=__builtin_amdgcn_permlane32_swap(__float_as_uint(g0[a]),__float_as_uint(g0[a]),false,false); p0s[a]=__uint_as_float(hi?rr[0]:rr[1]); }
        { auto rr=__builtin_amdgcn_permlane32_swap(__float_as_uint(g1[a]),__float_as_uint(g1[a]),false,false); p1s[a]=__uint_as_float(hi?rr[0]:rr[1]); } }
      float run=T;
      #pragma unroll
      for(int a=3;a>=0;--a){ const float off=hi?run:run*p1s[a]; run*=g1[a]*p1s[a];
        const float t3=off,t2=t3*n1[4*a+3],t1=t2*n1[4*a+2],t0=t1*n1[4*a+1];
        x1[4*a+3]*=t3; x1[4*a+2]*=t2; x1[4*a+1]*=t1; x1[4*a]*=t0; }
      #pragma unroll
      for(int a=3;a>=0;--a){ const float off=hi?run:run*p0s[a]; run*=g0[a]*p0s[a];
        const float t3=off,t2=t3*n0[4*a+3],t1=t2*n0[4*a+2],t0=t1*n0[4*a+1];
        x0[4*a+3]*=t3; x0[4*a+2]*=t2; x0[4*a+1]*=t1; x0[4*a]*=t0; }
      T=run;
      u32x4 pw0,pw1,pw2,pw3;
      pw0=(u32x4){cvtpk_s(x0[0],x0[1]),cvtpk_s(x0[2],x0[3]),cvtpk_s(x0[4],x0[5]),cvtpk_s(x0[6],x0[7])};
      pw1=(u32x4){cvtpk_s(x0[8],x0[9]),cvtpk_s(x0[10],x0[11]),cvtpk_s(x0[12],x0[13]),cvtpk_s(x0[14],x0[15])};
      pw2=(u32x4){cvtpk_s(x1[0],x1[1]),cvtpk_s(x1[2],x1[3]),cvtpk_s(x1[4],x1[5]),cvtpk_s(x1[6],x1[7])};
      pw3=(u32x4){cvtpk_s(x1[8],x1[9]),cvtpk_s(x1[10],x1[11]),cvtpk_s(x1[12],x1[13]),cvtpk_s(x1[14],x1[15])};
      SBAR(); pv(o,vb0+slot,__builtin_bit_cast(bf16x8,pw0),__builtin_bit_cast(bf16x8,pw1),__builtin_bit_cast(bf16x8,pw2),__builtin_bit_cast(bf16x8,pw3));
      wdone=__all(T<1.2e-38f);
    }
    if(lane==0)flags[wid]=wdone?1:0;
    WAIT_BAR(0);
    const u32x4 f0=*(lds_u4ptr)(flags), f1=*(lds_u4ptr)(flags+4);
    const bool alld=((f0.x&f0.y&f0.z&f0.w)&(f1.x&f1.y&f1.z&f1.w))!=0;
    if(alld||jtop<SB_NS)break;
    WAIT_BAR(0);
  }
  bf16*Ow=O+(long)(q0+wid*QBLK)*OPITCH;
  { bf16*stg=(bf16*)(shm)+wid*2048;
    #pragma unroll
    for(int r=0;r<16;++r){const int orow=crow(r,hi);
      #pragma unroll
      for(int d0=0;d0<2;++d0)stg[orow*64+d0*32+r32]=__float2bfloat16(o[d0][r]);}
    asm volatile("s_waitcnt lgkmcnt(0)":::"memory");
    #pragma unroll
    for(int i=0;i<4;++i){const int row=i*8+(lane>>3),ch=lane&7; const u32x4 v=*(const u32x4*)(stg+row*64+ch*8); ATTN_STORE16(Ow+(long)row*OPITCH+ch*8,v);} }
  asm volatile("s_waitcnt lgkmcnt(0)\n\ts_barrier":::"memory");
  #undef DMA_K
  #undef DMA_V
}
#undef SBAR
#undef WAIT_BAR
}

constexpr int BATCH = 8, SEQ = 4096, DM = 1024, DEPTH = 4, M = BATCH * SEQ, INC = 3334, NIN = 3584, DFF = 4096;
constexpr float EPS = 1e-6f;
constexpr size_t MiB = 1u << 20;
constexpr size_t WS_BAR = 128 * 1024;
constexpr size_t WS_SS = 1 * MiB;
constexpr size_t WS_LB = 3 * MiB;
constexpr size_t WS_JS = 3 * MiB + 256 * 1024;
constexpr size_t WS_DD = 3 * MiB + 512 * 1024;
constexpr size_t WS_W = 4 * MiB;
constexpr size_t W_LAYER = 25 * MiB, W_OUT = 7 * MiB, W_1 = 9 * MiB, W_2 = 17 * MiB;
constexpr size_t WS_XB = 104 * MiB;
constexpr size_t WS_P = 168 * MiB;
constexpr size_t P_HQ = 0, P_HK = 16 * MiB, P_HI = 32 * MiB, P_HG = 48 * MiB, P_HLF = 64 * MiB, P_SQ = 96 * MiB, P_FQ = 168 * MiB, P_LF = 240 * MiB, P_CC = 241 * MiB, P_US = 242 * MiB;
constexpr size_t HEADBUF = 24 * MiB;
constexpr size_t WS_MIX = 442 * MiB;
constexpr size_t WS_U = 168 * MiB;
constexpr size_t WS_END = 506 * MiB;
constexpr int LDS_BYTES = 147456;

typedef pg8::bf16_t bf16_t;
typedef pg8::f32x4 f32x4;
typedef unsigned u32x4 __attribute__((ext_vector_type(4)));
typedef unsigned u32x2 __attribute__((ext_vector_type(2)));
#define LAS __attribute__((address_space(3)))

__device__ __forceinline__ unsigned f2bf(float f) { unsigned u = __builtin_bit_cast(unsigned, f); return (u + 0x7fffu + ((u >> 16) & 1u)) >> 16; }
__device__ __forceinline__ unsigned pk2(float lo, float hi) { return pg8::cvt_pk_bf16(lo, hi); }
__device__ __forceinline__ float bf2f(unsigned short b) { return __builtin_bit_cast(float, (unsigned)b << 16); }
__device__ __forceinline__ float bflo(unsigned w) { return __builtin_bit_cast(float, w << 16); }
__device__ __forceinline__ float bfhi(unsigned w) { return __builtin_bit_cast(float, w & 0xffff0000u); }
__device__ __forceinline__ float logsig(float x) { return fminf(x, 0.f) - log1pf(expf(-fabsf(x))); }
__device__ __forceinline__ float wave_sum(float v) {
#pragma unroll
    for (int o = 1; o < 64; o <<= 1) v += __shfl_xor(v, o);
    return v;
}
#define ROWSCALES8(rs, ss, row0, fq) float rs[2][4]; _Pragma("unroll") for (int ai_ = 0; ai_ < 2; ++ai_) _Pragma("unroll") for (int m_ = 0; m_ < 4; ++m_) rs[ai_][m_] = rowscale(ss, (row0) + ai_ * 128 + m_ * 16, fq);
__device__ __forceinline__ float rowscale(const float* ss, int row, int fq) {
    const f32x4 p = *(const f32x4*)(ss + (size_t)row * 16 + 4 * fq);
    float s = (p[0] + p[1]) + (p[2] + p[3]);
    s += __shfl_xor(s, 16); s += __shfl_xor(s, 32);
    return rsqrtf(s * (1.0f / DM) + EPS);
}

#define ROWFENCE() asm volatile("" ::: "memory")
struct EpiResid {
    static constexpr bool PERM = true, AFTER_DRAIN = false;
    bf16_t* xb; float* outf; float* ss;
    __device__ __forceinline__ void operator()(const f32x4 (&acc)[2][2][4][2], const pg8::Unit& u, int wr, int wc, int fr, int fq) const {
        const int row0 = u.pm * 256 + wr * 64 + fr, col0 = u.pn * 256 + wc * 32 + 8 * fq;
#pragma unroll
        for (int ai = 0; ai < 2; ++ai) {
            u32x4 pre[4][2];
#pragma unroll
            for (int m = 0; m < 4; ++m)
#pragma unroll
                for (int bj = 0; bj < 2; ++bj) pre[m][bj] = *(const u32x4*)(xb + (size_t)(row0 + ai * 128 + m * 16) * DM + col0 + bj * 128);
#pragma unroll
            for (int m = 0; m < 4; ++m) {
                const int row = row0 + ai * 128 + m * 16; float sq = 0.f;
#pragma unroll
                for (int bj = 0; bj < 2; ++bj) {
                    const size_t off = (size_t)row * DM + col0 + bj * 128; const u32x4 p = pre[m][bj];
                    const f32x4 v0 = acc[ai][bj][m][0] + (f32x4){bflo(p.x), bfhi(p.x), bflo(p.y), bfhi(p.y)}, v1 = acc[ai][bj][m][1] + (f32x4){bflo(p.z), bfhi(p.z), bflo(p.w), bfhi(p.w)};
                    if (outf) { *(f32x4*)(outf + off) = v0; *(f32x4*)(outf + off + 4) = v1; }
                    u32x4 w; w.x = pk2(v0[0], v0[1]); w.y = pk2(v0[2], v0[3]); w.z = pk2(v1[0], v1[1]); w.w = pk2(v1[2], v1[3]);
                    *(u32x4*)(xb + off) = w;
                    sq += (v0[0] * v0[0] + v0[1] * v0[1]) + (v0[2] * v0[2] + v0[3] * v0[3]) + (v1[0] * v1[0] + v1[1] * v1[1]) + (v1[2] * v1[2] + v1[3] * v1[3]);
                }
                sq += __shfl_xor(sq, 16); sq += __shfl_xor(sq, 32);
                if (fq == 0) ss[(size_t)row * 16 + u.pn * 4 + wc] = sq;
            }
            ROWFENCE();
        }
    }
};
struct EpiRelu2 {
    static constexpr bool PERM = true, AFTER_DRAIN = false;
    bf16_t* U; const float* ss;
    __device__ __forceinline__ void operator()(const f32x4 (&acc)[2][2][4][2], const pg8::Unit& u, int wr, int wc, int fr, int fq) const {
        const int row0 = u.pm * 256 + wr * 64 + fr, col0 = u.pn * 256 + wc * 32 + 8 * fq;
        ROWSCALES8(rs8, ss, row0, fq)
#pragma unroll
        for (int ai = 0; ai < 2; ++ai)
#pragma unroll
            for (int m = 0; m < 4; ++m) {
                const int row = row0 + ai * 128 + m * 16; const float rs = rs8[ai][m];
#pragma unroll
                for (int bj = 0; bj < 2; ++bj) {
                    f32x4 v0 = acc[ai][bj][m][0] * rs, v1 = acc[ai][bj][m][1] * rs;
                    v0 = __builtin_elementwise_max(v0, (f32x4){0.f, 0.f, 0.f, 0.f}); v1 = __builtin_elementwise_max(v1, (f32x4){0.f, 0.f, 0.f, 0.f});
                    v0 = v0 * v0; v1 = v1 * v1;
                    u32x4 w; w.x = pk2(v0[0], v0[1]); w.y = pk2(v0[2], v0[3]); w.z = pk2(v1[0], v1[1]); w.w = pk2(v1[2], v1[3]);
                    *(u32x4*)(U + (size_t)row * DFF + col0 + bj * 128) = w;
                }
                ROWFENCE();
            }
    }
};
struct EpiInProj {
    static constexpr bool PERM = true, AFTER_DRAIN = false;
    const float* ss; unsigned char* P; const float* lbt;
    const float* gt; const float* fbias;
    __device__ __forceinline__ void operator()(const f32x4 (&acc)[2][2][4][2], const pg8::Unit& u, int wr, int wc, int fr, int fq) const {
        const int slot = u.pn * 4 + wc;
        if (slot > 52) return;
        const int row0 = u.pm * 256 + wr * 64 + fr;
        ROWSCALES8(rs8, ss, row0, fq)
        if (slot < 16) {
            const int kind = slot >> 2, cb = (slot & 3) * 64 + 8 * fq;
            if (kind == 1) {
                float* HLF = (float*)(P + P_HLF); bf16_t* HK = (bf16_t*)(P + P_HK);
#pragma unroll
                for (int ai = 0; ai < 2; ++ai)
#pragma unroll
                    for (int m = 0; m < 4; ++m) {
                        const int row = row0 + ai * 128 + m * 16; const float rs = rs8[ai][m];
#pragma unroll
                        for (int bj = 0; bj < 2; ++bj) {
                            float lf[8], kk[8];
#pragma unroll
                            for (int n = 0; n < 2; ++n) {
                                const f32x4 ll = *(const f32x4*)(lbt + cb + 32 * bj + 4 * n), om = *(const f32x4*)(lbt + 256 + cb + 32 * bj + 4 * n);
#pragma unroll
                                for (int i = 0; i < 4; ++i) {
                                    const float fl = acc[ai][bj][m][n][i] * rs;
                                    const float a = fminf(fl, 0.f) - __logf(1.0f + __expf(-fabsf(fl)));
                                    const float an = a - fl;
                                    const float b = ll[i] + an;
                                    lf[4 * n + i] = fmaxf(a, b) + __logf(1.0f + __expf(-fabsf(a - b)));
                                    kk[4 * n + i] = om[i] * __expf(an);
                                }
                            }
                            const size_t off = (size_t)row * 256 + cb + 32 * bj;
                            *(f32x4*)(HLF + off) = (f32x4){lf[0], lf[1], lf[2], lf[3]}; *(f32x4*)(HLF + off + 4) = (f32x4){lf[4], lf[5], lf[6], lf[7]};
                            u32x4 w; w.x = pk2(kk[0], kk[1]); w.y = pk2(kk[2], kk[3]); w.z = pk2(kk[4], kk[5]); w.w = pk2(kk[6], kk[7]);
                            *(u32x4*)(HK + off) = w;
                        }
                        ROWFENCE();
                    }
            } else {
                bf16_t* dst = (bf16_t*)(P + (kind == 0 ? P_HQ : (kind == 2 ? P_HI : P_HG)));
#pragma unroll
                for (int ai = 0; ai < 2; ++ai)
#pragma unroll
                    for (int m = 0; m < 4; ++m) {
                        const int row = row0 + ai * 128 + m * 16; const float rs = rs8[ai][m];
#pragma unroll
                        for (int bj = 0; bj < 2; ++bj) {
                            const f32x4 v0 = acc[ai][bj][m][0] * rs, v1 = acc[ai][bj][m][1] * rs;
                            u32x4 w; w.x = pk2(v0[0], v0[1]); w.y = pk2(v0[2], v0[3]); w.z = pk2(v1[0], v1[1]); w.w = pk2(v1[2], v1[3]);
                            *(u32x4*)(dst + (size_t)row * 256 + cb + 32 * bj) = w;
                        }
                        ROWFENCE();
                    }
            }
        } else if (slot < 52) {
            const int s2 = slot - 16, grp = s2 / 6, h = s2 % 6, role = grp % 3;
            bf16_t* dst = (bf16_t*)(P + P_SQ + (size_t)grp * HEADBUF) + (size_t)((u.pm >> 4) * 6 + h) * SEQ * 64 + 8 * fq;
            const float* gp = gt + (grp - (grp >= 3 ? 1 : 0)) * 64 + 8 * fq;
            const float qs = (role == 0) ? 0.125f * 1.4426950408889634f : 1.0f;
            f32x4 gv[2][2];
#pragma unroll
            for (int bj = 0; bj < 2; ++bj)
#pragma unroll
                for (int n = 0; n < 2; ++n) gv[bj][n] = (role != 2) ? *(const f32x4*)(gp + 32 * bj + 4 * n) * qs : (f32x4){1.f, 1.f, 1.f, 1.f};
#pragma unroll
            for (int ai = 0; ai < 2; ++ai)
#pragma unroll
                for (int m = 0; m < 4; ++m) {
                    const int row = row0 + ai * 128 + m * 16; const float rs = rs8[ai][m];
                    float fac = rs;
                    if (role != 2) {
                        float sq = 0.f;
#pragma unroll
                        for (int bj = 0; bj < 2; ++bj)
#pragma unroll
                            for (int n = 0; n < 2; ++n) { const f32x4 x = acc[ai][bj][m][n]; sq += (x[0] * x[0] + x[1] * x[1]) + (x[2] * x[2] + x[3] * x[3]); }
                        sq += __shfl_xor(sq, 16); sq += __shfl_xor(sq, 32);
                        fac = rs * rsqrtf(rs * rs * sq * (1.0f / 64.0f) + EPS);
                    }
                    const int t = row & (SEQ - 1);
#pragma unroll
                    for (int bj = 0; bj < 2; ++bj) {
                        const f32x4 v0 = acc[ai][bj][m][0] * fac * gv[bj][0], v1 = acc[ai][bj][m][1] * fac * gv[bj][1];
                        u32x4 w; w.x = pk2(v0[0], v0[1]); w.y = pk2(v0[2], v0[3]); w.z = pk2(v1[0], v1[1]); w.w = pk2(v1[2], v1[3]);
                        *(u32x4*)(dst + (size_t)t * 64 + 32 * bj) = w;
                    }
                    ROWFENCE();
                }
        } else {
            float* LF = (float*)(P + P_LF);
#pragma unroll
            for (int ai = 0; ai < 2; ++ai)
#pragma unroll
                for (int m = 0; m < 4; ++m) {
                    const int row = row0 + ai * 128 + m * 16; const float rs = rs8[ai][m];
                    if (fq == 0) {
                        const f32x4 a0 = acc[ai][0][m][0], a1 = acc[ai][0][m][1];
                        *(f32x4*)(LF + (size_t)row * 8) = (f32x4){logsig(a0[0] * rs + fbias[0]), logsig(a0[1] * rs + fbias[1]), logsig(a0[2] * rs + fbias[2]), logsig(a0[3] * rs + fbias[3])};
                        *(f32x4*)(LF + (size_t)row * 8 + 4) = (f32x4){logsig(a1[0] * rs + fbias[4]), logsig(a1[1] * rs + fbias[5]), 0.f, 0.f};
                    }
                    ROWFENCE();
                }
        }
    }
};
#define XB_TMO      128
#define XB_XCNT(j)  (256  + 64 * (j))
#define XB_XSUB(j)  (1280 + 64 * (j))
#define XB_XGEN(j)  (2304 + 64 * (j))
#define XB_TOP      3328
#define XB_TOPGEN   3392
#define XCD_BAR_WORDS 3456
#define XB_SPIN_CAP (1u << 18)

__device__ __forceinline__ unsigned xb_ld(unsigned* p)              { return __hip_atomic_load(p, __ATOMIC_RELAXED, __HIP_MEMORY_SCOPE_AGENT); }
__device__ __forceinline__ unsigned xb_add(unsigned* p, unsigned v) { return __hip_atomic_fetch_add(p, v, __ATOMIC_RELAXED, __HIP_MEMORY_SCOPE_AGENT); }
__device__ __forceinline__ unsigned xb_xcc_id() { return (unsigned)__builtin_amdgcn_s_getreg((3 << 11) | 20) & 0xFu; }
#define XB_SPIN(cond, bar) do { unsigned _sp = 0; while (cond) { __builtin_amdgcn_s_sleep(1); \
    if ((++_sp & 255u) == 0u) { if (xb_ld(&(bar)[XB_TMO])) break; if (_sp > XB_SPIN_CAP) { atomicAdd(&(bar)[XB_TMO], 1u); break; } } } } while (0)

struct XcdBarrier {
    unsigned* bar; unsigned x;
    volatile LAS unsigned* st;
};

__device__ __forceinline__ XcdBarrier xcd_barrier_post(unsigned* bar, volatile LAS unsigned* st) {
    XcdBarrier b; b.bar = bar; b.x = xb_xcc_id(); b.st = st;
    if (threadIdx.x == 0) (void)xb_add(&bar[XB_XCNT(b.x)], 1u);
    return b;
}
__device__ __forceinline__ void xcd_barrier_complete(unsigned* bar, unsigned x, unsigned& nloc, unsigned& nx) {
    const unsigned G = gridDim.x * gridDim.y * gridDim.z;
    unsigned sum, cnt, mine, sp = 0u;
    for (;;) {
        sum = 0u; cnt = 0u; mine = 0u;
#pragma unroll
        for (unsigned j = 0; j < 16; ++j) { const unsigned c = xb_ld(&bar[XB_XCNT(j)]); sum += c; cnt += (c > 0u) ? 1u : 0u; mine = (j == x) ? c : mine; }
        if (sum == G) break;
        __builtin_amdgcn_s_sleep(1);
        if ((++sp & 255u) == 0u) { if (xb_ld(&bar[XB_TMO])) break; if (sp > XB_SPIN_CAP) { atomicAdd(&bar[XB_TMO], 1u); break; } }
    }
    nloc = mine > 0u ? mine : 1u; nx = cnt > 0u ? cnt : 1u;
}

__device__ __forceinline__ void xcd_barrier(const XcdBarrier& b) {
    asm volatile("s_waitcnt vmcnt(0)" ::: "memory");
    __syncthreads();
    if (threadIdx.x == 0) {
        unsigned* bar = b.bar;
        __builtin_amdgcn_s_waitcnt(0);
        unsigned nloc = b.st[0], nx = b.st[1];
        if (nloc == 0u) { xcd_barrier_complete(bar, b.x, nloc, nx); b.st[0] = nloc; b.st[1] = nx; }
        const unsigned old = xb_add(&bar[XB_XSUB(b.x)], 1u);
        const unsigned gen = old / nloc;
        if (old + 1u == (gen + 1u) * nloc) {
            __builtin_amdgcn_fence(__ATOMIC_RELEASE, "agent");
            asm volatile("s_waitcnt vmcnt(0)" ::: "memory");
            const unsigned og = xb_add(&bar[XB_TOP], 1u);
            const unsigned tg = og / nx;
            if (og + 1u == (tg + 1u) * nx) xb_add(&bar[XB_TOPGEN], 1u);
            else XB_SPIN(xb_ld(&bar[XB_TOPGEN]) == tg, bar);
            __builtin_amdgcn_fence(__ATOMIC_ACQUIRE, "agent");
            xb_add(&bar[XB_XGEN(b.x)], 1u);
            asm volatile("s_waitcnt vmcnt(0)" ::: "memory");
        } else {
            XB_SPIN(xb_ld(&bar[XB_XGEN(b.x)]) == gen, bar);
            __builtin_amdgcn_fence(__ATOMIC_ACQUIRE, "agent");
            asm volatile("s_waitcnt vmcnt(0)" ::: "memory");
        }
    }
    __syncthreads();
}

__device__ __forceinline__ void tr_item(const float* W, int ldw, int ncols_valid, int src_col0, int k0, const float* gain, bf16_t* WT, int K, int n0, LAS float* scr, int lane) {
#pragma unroll 8
    for (int i = 0; i < 32; ++i) { const int kk = 2 * i + (lane >> 5), c = src_col0 + (lane & 31);
        float v = (c < ncols_valid) ? W[(size_t)(k0 + kk) * ldw + c] : 0.f; if (gain) v *= gain[k0 + kk]; scr[kk * 33 + (lane & 31)] = v; }
    asm volatile("s_waitcnt lgkmcnt(0)" ::: "memory");
    const int c = lane & 7;
#pragma unroll
    for (int j = 0; j < 4; ++j) { const int n = (lane >> 3) + 8 * j; const LAS float* s = scr + (8 * c) * 33 + n;
        u32x4 o; o.x = pk2(s[0 * 33], s[1 * 33]); o.y = pk2(s[2 * 33], s[3 * 33]); o.z = pk2(s[4 * 33], s[5 * 33]); o.w = pk2(s[6 * 33], s[7 * 33]);
        *(u32x4*)(WT + (size_t)(n0 + n) * K + k0 + 8 * c) = o; }
    asm volatile("s_waitcnt lgkmcnt(0)" ::: "memory");
}

__device__ __forceinline__ void unpack8(const u32x4 w, float* d) { d[0] = bflo(w.x); d[1] = bfhi(w.x); d[2] = bflo(w.y); d[3] = bfhi(w.y); d[4] = bflo(w.z); d[5] = bfhi(w.z); d[6] = bflo(w.w); d[7] = bfhi(w.w); }

__device__ __forceinline__ void fox_cumsum_item(int bh, const float* LF, float* CC, int* JS, const float* gq, const float* gk, LAS float* sc) {
    int tid_ = threadIdx.x; asm volatile("" : "+v"(tid_)); const int tid = tid_, lane = tid & 63, wave = tid >> 6, b = bh / 6, h = bh % 6;
    float v[8]; float run = 0.f;
#pragma unroll
    for (int i = 0; i < 8; ++i) { run += LF[((size_t)b * SEQ + tid * 8 + i) * 8 + h]; v[i] = run; }
    float s = run;
#pragma unroll
    for (int o = 1; o < 64; o <<= 1) { const float n = __shfl_up(s, o); if (lane >= o) s += n; }
    __syncthreads();
    if (lane == 63) sc[wave] = s;
    __syncthreads();
    float base = s - run;
    for (int w = 0; w < wave; ++w) base += sc[w];
    LAS float* cl = sc + 64;
#pragma unroll
    for (int i = 0; i < 8; ++i) { const float c2 = (v[i] + base) * 1.4426950408889634f; CC[(size_t)bh * SEQ + tid * 8 + i] = c2; cl[tid * 8 + i] = c2; }
    __syncthreads();
    if (tid < 16) {
        float mq = 0.f, mk = 0.f;
        for (int d = 0; d < 64; ++d) { mq = fmaxf(mq, fabsf(gq[d])); mk = fmaxf(mk, fabsf(gk[d])); }
        const float zb = 1.4426950408889634f * 8.0f * mq * mk * 1.03f + 1.0f;
        const float thr = -(150.0f + 2.0f * zb);
        const int q0 = tid * 256, nt = q0 / 64 + 4; const float cq = cl[q0];
        int j = 0; while (j < nt - 4 && cq - cl[64 * j + 63] < thr) ++j;
        JS[bh * 16 + tid] = j & ~1;
    }
    __syncthreads();
}

__device__ __forceinline__ void stage_kv(const bf16_t* Kb, const bf16_t* Vb, int kt, LAS float* Kf, LAS float* Vf) {
    int tid_ = threadIdx.x; asm volatile("" : "+v"(tid_)); const int tid = tid_, key = tid >> 3, c8 = tid & 7;
    const u32x4 kw = *(const u32x4*)(Kb + ((size_t)(kt * 64 + key)) * 64 + c8 * 8), vw = *(const u32x4*)(Vb + ((size_t)(kt * 64 + key)) * 64 + c8 * 8);
    float kf[8], vf[8]; unpack8(kw, kf); unpack8(vw, vf);
    *(LAS f32x4*)(Kf + key * 64 + c8 * 8) = (f32x4){kf[0], kf[1], kf[2], kf[3]}; *(LAS f32x4*)(Kf + key * 64 + c8 * 8 + 4) = (f32x4){kf[4], kf[5], kf[6], kf[7]};
    *(LAS f32x4*)(Vf + key * 64 + c8 * 8) = (f32x4){vf[0], vf[1], vf[2], vf[3]}; *(LAS f32x4*)(Vf + key * 64 + c8 * 8 + 4) = (f32x4){vf[4], vf[5], vf[6], vf[7]};
}

__device__ __forceinline__ void fox_naive_item(int item, unsigned char* P, bf16_t* MIX, LAS float* lds) {
    int tid_ = threadIdx.x; asm volatile("" : "+v"(tid_)); const int tid = tid_, bh = item >> 3, qblk = item & 7, b = bh / 6, h = bh % 6, t = qblk * 512 + tid;
    const bf16_t* Qp = (const bf16_t*)(P + P_FQ) + ((size_t)bh * SEQ + t) * 64;
    const bf16_t* Kb = (const bf16_t*)(P + P_FQ + HEADBUF) + (size_t)bh * SEQ * 64;
    const bf16_t* Vb = (const bf16_t*)(P + P_FQ + 2 * HEADBUF) + (size_t)bh * SEQ * 64;
    const float* CC = (const float*)(P + P_CC) + (size_t)bh * SEQ;
    float q[64], o[64];
#pragma unroll
    for (int c = 0; c < 8; ++c) unpack8(*(const u32x4*)(Qp + c * 8), q + c * 8);
#pragma unroll
    for (int d = 0; d < 64; ++d) o[d] = 0.f;
    float m = -1e30f, l = 0.f; const float ct = CC[t];
    LAS float* Kf = lds; LAS float* Vf = lds + 4096; LAS float* cs = lds + 8192;
    const int ntile = (qblk + 1) * 8;
    for (int kt = 0; kt < ntile; ++kt) {
        __syncthreads();
        stage_kv(Kb, Vb, kt, Kf, Vf); if (tid < 64) cs[tid] = CC[kt * 64 + tid];
        __syncthreads();
        for (int s = 0; s < 64; ++s) {
            float z = 0.f;
#pragma unroll
            for (int d = 0; d < 64; ++d) z += q[d] * Kf[s * 64 + d];
            const float x = (kt * 64 + s <= t) ? z + (ct - cs[s]) : -1e30f;
            const float mn = fmaxf(m, x), sc = __expf(m - mn), p = __expf(x - mn);
            l = l * sc + p;
#pragma unroll
            for (int d = 0; d < 64; ++d) o[d] = o[d] * sc + p * Vf[s * 64 + d];
            m = mn;
        }
    }
    const float inv = 1.0f / l;
    bf16_t* op = MIX + ((size_t)b * SEQ + t) * DM + 640 + h * 64;
#pragma unroll
    for (int c = 0; c < 8; ++c) { u32x4 w; w.x = pk2(o[c * 8] * inv, o[c * 8 + 1] * inv); w.y = pk2(o[c * 8 + 2] * inv, o[c * 8 + 3] * inv); w.z = pk2(o[c * 8 + 4] * inv, o[c * 8 + 5] * inv); w.w = pk2(o[c * 8 + 6] * inv, o[c * 8 + 7] * inv); *(u32x4*)(op + c * 8) = w; }
}

__device__ __forceinline__ void sb_naive_item(int item, unsigned char* P, bf16_t* MIX, LAS float* lds) {
    int tid_ = threadIdx.x; asm volatile("" : "+v"(tid_)); const int tid = tid_, bh = item >> 3, qblk = item & 7, b = bh / 6, h = bh % 6, t = qblk * 512 + tid;
    const bf16_t* Qp = (const bf16_t*)(P + P_SQ) + ((size_t)bh * SEQ + t) * 64;
    const bf16_t* Kb = (const bf16_t*)(P + P_SQ + HEADBUF) + (size_t)bh * SEQ * 64;
    const bf16_t* Vb = (const bf16_t*)(P + P_SQ + 2 * HEADBUF) + (size_t)bh * SEQ * 64;
    float q[64], o[64];
#pragma unroll
    for (int c = 0; c < 8; ++c) unpack8(*(const u32x4*)(Qp + c * 8), q + c * 8);
#pragma unroll
    for (int d = 0; d < 64; ++d) o[d] = 0.f;
    float tail = 0.f;
    LAS float* Kf = lds; LAS float* Vf = lds + 4096;
    for (int kt = qblk * 8 + 7; kt >= 0; --kt) {
        __syncthreads();
        stage_kv(Kb, Vb, kt, Kf, Vf);
        __syncthreads();
        for (int s = 63; s >= 0; --s) {
            float z = 0.f;
#pragma unroll
            for (int d = 0; d < 64; ++d) z += q[d] * Kf[s * 64 + d];
            const float ls = fminf(z, 0.f) - __logf(1.0f + __expf(-fabsf(z)));
            const bool act = (kt * 64 + s) < t;
            const float A = act ? __expf(ls + tail) : 0.f;
#pragma unroll
            for (int d = 0; d < 64; ++d) o[d] += A * Vf[s * 64 + d];
            tail += act ? (ls - z) : 0.f;
        }
        if (__syncthreads_and(tail < -100.f)) break;
    }
    bf16_t* op = MIX + ((size_t)b * SEQ + t) * DM + 256 + h * 64;
#pragma unroll
    for (int c = 0; c < 8; ++c) { u32x4 w; w.x = pk2(o[c * 8], o[c * 8 + 1]); w.y = pk2(o[c * 8 + 2], o[c * 8 + 3]); w.z = pk2(o[c * 8 + 4], o[c * 8 + 5]); w.w = pk2(o[c * 8 + 6], o[c * 8 + 7]); *(u32x4*)(op + c * 8) = w; }
}

__device__ __forceinline__ void hgrn_naive_item(int item, unsigned char* P, bf16_t* MIX, const float* hgn, LAS float* lds) {
    int tid_ = threadIdx.x; asm volatile("" : "+v"(tid_)); const int tid = tid_, lane = tid & 63, w = tid >> 6, kg = lane >> 3, vi = lane & 7, vcol = 8 * w + vi, b = item >> 2, h = item & 3;
    const bf16_t* HQ = (const bf16_t*)(P + P_HQ); const bf16_t* HK = (const bf16_t*)(P + P_HK); const bf16_t* HI = (const bf16_t*)(P + P_HI); const bf16_t* HG = (const bf16_t*)(P + P_HG);
    const float* HLF = (const float*)(P + P_HLF);
    LAS float* qf = lds; LAS float* kf = lds + 4096; LAS float* ff = lds + 8192; LAS float* vf = lds + 12288; LAS float* ob = lds + 16384;
    float S[8];
#pragma unroll
    for (int j = 0; j < 8; ++j) S[j] = 0.f;
    const int tok = tid >> 3, c8 = tid & 7;
    float gn[8];
#pragma unroll
    for (int e = 0; e < 8; ++e) gn[e] = hgn[c8 * 8 + e];
    for (int c = 0; c < 64; ++c) {
        const size_t off = ((size_t)b * SEQ + c * 64 + tok) * 256 + h * 64 + c8 * 8;
        __syncthreads();
        {
            float a[8];
            unpack8(*(const u32x4*)(HQ + off), a);
#pragma unroll
            for (int e = 0; e < 8; ++e) qf[tok * 64 + c8 * 8 + e] = a[e];
            unpack8(*(const u32x4*)(HK + off), a);
#pragma unroll
            for (int e = 0; e < 8; ++e) kf[tok * 64 + c8 * 8 + e] = a[e];
            unpack8(*(const u32x4*)(HI + off), a);
#pragma unroll
            for (int e = 0; e < 8; ++e) vf[tok * 64 + c8 * 8 + e] = a[e];
            const f32x4 l0 = *(const f32x4*)(HLF + off), l1 = *(const f32x4*)(HLF + off + 4);
#pragma unroll
            for (int e = 0; e < 4; ++e) { ff[tok * 64 + c8 * 8 + e] = expf(l0[e]); ff[tok * 64 + c8 * 8 + 4 + e] = expf(l1[e]); }
        }
        __syncthreads();
        for (int tk = 0; tk < 64; ++tk) {
            const float vv = vf[tk * 64 + vcol]; float op = 0.f;
#pragma unroll
            for (int j = 0; j < 8; ++j) { const int k = 8 * kg + j; S[j] = ff[tk * 64 + k] * S[j] + kf[tk * 64 + k] * vv; op += qf[tk * 64 + k] * S[j]; }
            op += __shfl_xor(op, 8); op += __shfl_xor(op, 16); op += __shfl_xor(op, 32);
            if (kg == 0) ob[tk * 64 + vcol] = op;
        }
        __syncthreads();
        {
            float ov[8], g[8]; float sq = 0.f;
#pragma unroll
            for (int e = 0; e < 8; ++e) { ov[e] = ob[tok * 64 + c8 * 8 + e]; sq += ov[e] * ov[e]; }
            sq += __shfl_xor(sq, 1); sq += __shfl_xor(sq, 2); sq += __shfl_xor(sq, 4);
            const float rn = rsqrtf(sq * (1.0f / 64.0f) + EPS);
            unpack8(*(const u32x4*)(HG + off), g);
            float r[8];
#pragma unroll
            for (int e = 0; e < 8; ++e) r[e] = ov[e] * rn * gn[e] * (g[e] / (1.0f + expf(-g[e])));
            u32x4 wv; wv.x = pk2(r[0], r[1]); wv.y = pk2(r[2], r[3]); wv.z = pk2(r[4], r[5]); wv.w = pk2(r[6], r[7]);
            *(u32x4*)(MIX + ((size_t)b * SEQ + c * 64 + tok) * DM + h * 64 + c8 * 8) = wv;
        }
    }
}

constexpr int HG_SLOT = 32768, HG_BP = 68  , HG_PRE = 64 * HG_BP * 4, HG_TOT = HG_PRE + 1280, HG_VT = 20480, HG_VP = 72;
static_assert(HG_TOT + 1024 <= HG_VT && HG_VT + 64 * HG_VP * 2 <= HG_SLOT, "HGRN LDS slot map");
typedef short hbf16x8 __attribute__((ext_vector_type(8)));
typedef short hbf16x4 __attribute__((ext_vector_type(4)));
__device__ __forceinline__ hbf16x8 pack8(const float* x) { u32x4 w; w.x = pk2(x[0], x[1]); w.y = pk2(x[2], x[3]); w.z = pk2(x[4], x[5]); w.w = pk2(x[6], x[7]); return __builtin_bit_cast(hbf16x8, w); }

__device__ __forceinline__ void hg_stage(int tid, size_t row0, int h, const float* HLF, const bf16_t* HI, LAS unsigned char* sb) {
    const int lt = tid & 255, k = lt & 63, seg = lt >> 6;
    LAS float* bl = (LAS float*)sb; LAS float* pre = (LAS float*)(sb + HG_PRE); LAS float* tot = (LAS float*)(sb + HG_TOT); LAS bf16_t* vt = (LAS bf16_t*)(sb + HG_VT);
    float run = 0.f;
#pragma unroll
    for (int i = 0; i < 16; ++i) { const int t = 16 * seg + i; run += HLF[(row0 + t) * 256 + h * 64 + k]; bl[t * HG_BP + k] = run; }
    tot[seg * 64 + k] = run;
    {
        const int s = lt & 63, c0 = (lt >> 6) * 16;
        const u32x4 w0 = *(const u32x4*)(HI + (row0 + s) * 256 + h * 64 + c0), w1 = *(const u32x4*)(HI + (row0 + s) * 256 + h * 64 + c0 + 8);
        const unsigned ww[8] = {w0.x, w0.y, w0.z, w0.w, w1.x, w1.y, w1.z, w1.w};
#pragma unroll
        for (int e = 0; e < 8; ++e) { vt[(c0 + 2 * e) * HG_VP + s] = (bf16_t)(ww[e] & 0xffffu); vt[(c0 + 2 * e + 1) * HG_VP + s] = (bf16_t)(ww[e] >> 16); }
    }
    __syncthreads();
    if (lt < 64) { float p = 0.f;
#pragma unroll
        for (int sg = 0; sg < 4; ++sg) { pre[sg * 64 + lt] = p; p += tot[sg * 64 + lt]; }
        pre[4 * 64 + lt] = p; }
    __syncthreads();
}

__device__ __forceinline__ void hgrn_a_item(int item, unsigned char* P, float* DD, LAS unsigned char* L) {
    int tid_ = threadIdx.x; asm volatile("" : "+v"(tid_)); const int tid = tid_, lane = tid & 63, wq = (tid >> 6) & 3, cs = tid >> 8, r = lane & 15, g = lane >> 4;
    const int bh = item >> 5, chunk = (item & 31) * 2 + cs, b = bh >> 2, h = bh & 3;
    const size_t row0 = (size_t)b * SEQ + chunk * 64;
    const bf16_t* HK = (const bf16_t*)(P + P_HK); float* UT = (float*)(P + P_US);
    LAS unsigned char* sb = L + cs * HG_SLOT;
    const int k = 16 * wq + r;
    unsigned short kraw[2][8];
#pragma unroll
    for (int ks = 0; ks < 2; ++ks)
#pragma unroll
        for (int j = 0; j < 8; ++j) kraw[ks][j] = HK[(row0 + 32 * ks + 8 * g + j) * 256 + h * 64 + k];
    hg_stage(tid, row0, h, (const float*)(P + P_HLF), (const bf16_t*)(P + P_HI), sb);
    const LAS float* bl = (const LAS float*)sb; const LAS float* pre = (const LAS float*)(sb + HG_PRE); const LAS unsigned char* vt = sb + HG_VT;
    const float pre4 = pre[4 * 64 + k];
    hbf16x8 af[2];
#pragma unroll
    for (int ks = 0; ks < 2; ++ks) { const float pj = pre4 - pre[(2 * ks + (g >> 1)) * 64 + k]; float x[8];
#pragma unroll
        for (int j = 0; j < 8; ++j) { const int s = 32 * ks + 8 * g + j; x[j] = bf2f(kraw[ks][j]) * __expf(pj - bl[s * HG_BP + k]); }
        af[ks] = pack8(x); }
    float* ut = UT + ((size_t)(bh * 64 + chunk) * 64) * 64;
#pragma unroll
    for (int vtile = 0; vtile < 4; ++vtile) { f32x4 acc = {0.f, 0.f, 0.f, 0.f};
#pragma unroll
        for (int ks = 0; ks < 2; ++ks) { const hbf16x8 bf = *(const LAS hbf16x8*)(vt + (16 * vtile + r) * (HG_VP * 2) + (32 * ks + 8 * g) * 2); acc = __builtin_amdgcn_mfma_f32_16x16x32_bf16(af[ks], bf, acc, 0, 0, 0); }
        *(f32x4*)(ut + (size_t)(16 * vtile + r) * 64 + 16 * wq + 4 * g) = acc; }
    if (g == 0) DD[(size_t)(bh * 64 + chunk) * 64 + k] = __expf(pre4);
}

__device__ __forceinline__ void hgrn_b_scan(int bx, int G, unsigned char* P, const float* DD) {
    int tid_ = threadIdx.x; asm volatile("" : "+v"(tid_));
    float* UT = (float*)(P + P_US);
    for (int gid = bx * 512 + tid_; gid < 32 * 4096; gid += G * 512) {
        const int bh = gid >> 12, e = gid & 4095; float* u = UT + (size_t)bh * 64 * 4096 + e; const float* dd = DD + (size_t)bh * 64 * 64 + (e & 63);
        float S = 0.f;
        for (int c0 = 0; c0 < 64; c0 += 32) { float tu[32], td[32];
#pragma unroll
            for (int i = 0; i < 32; ++i) { tu[i] = u[(size_t)(c0 + i) * 4096]; td[i] = dd[(c0 + i) * 64]; }
#pragma unroll
            for (int i = 0; i < 32; ++i) { u[(size_t)(c0 + i) * 4096] = S; S = td[i] * S + tu[i]; } }
    }
}

template <int MODE = 0>
__device__ __forceinline__ void hgrn_c_item(int item, unsigned char* P, bf16_t* MIX, const float* hgn, LAS unsigned char* L) {
    int tid_ = threadIdx.x; asm volatile("" : "+v"(tid_)); const int tid = tid_, lane = tid & 63, cs = tid >> 8, I = cs ? 3 - ((tid >> 6) & 3) : ((tid >> 6) & 3), r = lane & 15, g = lane >> 4;
    const int bh = item >> 5, chunk = (item & 31) * 2 + cs, b = bh >> 2, h = bh & 3;
    const size_t row0 = (size_t)b * SEQ + chunk * 64;
    const bf16_t* HQ = (const bf16_t*)(P + P_HQ); const bf16_t* HK = (const bf16_t*)(P + P_HK); const bf16_t* HG = (const bf16_t*)(P + P_HG); const float* ST = (const float*)(P + P_US);
    LAS unsigned char* sb = L + cs * HG_SLOT;
    const int t = 16 * I + r;
    u32x4 qraw[2], kraw[4][2]; f32x4 sraw[4][2][2]; unsigned short graw[4][4];
    const float* st = ST + ((size_t)(bh * 64 + chunk) * 64) * 64;
#pragma unroll
    for (int ks = 0; ks < 2; ++ks) { qraw[ks] = *(const u32x4*)(HQ + (row0 + t) * 256 + h * 64 + 32 * ks + 8 * g);
#pragma unroll
        for (int J = 0; J < 4; ++J) kraw[J][ks] = *(const u32x4*)(HK + (row0 + 16 * J + r) * 256 + h * 64 + 32 * ks + 8 * g);
#pragma unroll
        for (int vtile = 0; vtile < 4; ++vtile) { const float* sp = st + (size_t)(16 * vtile + r) * 64 + 32 * ks + 8 * g; sraw[vtile][ks][0] = *(const f32x4*)sp; sraw[vtile][ks][1] = *(const f32x4*)(sp + 4); } }
#pragma unroll
    for (int i = 0; i < 4; ++i)
#pragma unroll
        for (int vtile = 0; vtile < 4; ++vtile) graw[i][vtile] = HG[(row0 + 16 * I + 4 * g + i) * 256 + h * 64 + 16 * vtile + r];
    hg_stage(tid, row0, h, (const float*)(P + P_HLF), (const bf16_t*)(P + P_HI), sb);
    const LAS float* bl = (const LAS float*)sb; const LAS float* pre = (const LAS float*)(sb + HG_PRE); const LAS unsigned char* vt = sb + HG_VT;
    if (MODE == 1) { if (qraw[0].x == 0x12345678u && kraw[3][1].y == 0x9abcdef0u && sraw[3][1][1][3] == 1.2345f && graw[3][3] == 0x1234) MIX[0] = 0; return; }
    hbf16x8 qtf[2], qhf[2];
#pragma unroll
    for (int ks = 0; ks < 2; ++ks) { const int kb = 32 * ks + 8 * g; float q[8], xt[8], xh[8];
        unpack8(qraw[ks], q);
#pragma unroll
        for (int j = 0; j < 8; ++j) { xt[j] = q[j] * __expf(bl[t * HG_BP + kb + j]); xh[j] = xt[j] * __expf(pre[I * 64 + kb + j]); }
        qtf[ks] = pack8(xt); qhf[ks] = pack8(xh); }
    f32x4 at[4];
#pragma unroll
    for (int J = 0; J < 4; ++J) { at[J] = (f32x4){0.f, 0.f, 0.f, 0.f};
        if (J <= I) { const int s = 16 * J + r;
#pragma unroll
            for (int ks = 0; ks < 2; ++ks) { const int kb = 32 * ks + 8 * g; float kk[8], x[8];
                unpack8(kraw[J][ks], kk);
#pragma unroll
                for (int j = 0; j < 8; ++j) x[j] = kk[j] * __expf(fminf(pre[I * 64 + kb + j] - pre[J * 64 + kb + j] - bl[s * HG_BP + kb + j], 80.f));
                at[J] = __builtin_amdgcn_mfma_f32_16x16x32_bf16(pack8(x), qtf[ks], at[J], 0, 0, 0); }
            if (J == I) {
#pragma unroll
                for (int i = 0; i < 4; ++i) at[J][i] = (4 * g + i <= r) ? at[J][i] : 0.f; } } }
    hbf16x8 pf[2];
#pragma unroll
    for (int k2 = 0; k2 < 2; ++k2) { const float x[8] = {at[2 * k2][0], at[2 * k2][1], at[2 * k2][2], at[2 * k2][3], at[2 * k2 + 1][0], at[2 * k2 + 1][1], at[2 * k2 + 1][2], at[2 * k2 + 1][3]}; pf[k2] = pack8(x); }
    f32x4 o[4];
#pragma unroll
    for (int vtile = 0; vtile < 4; ++vtile) { f32x4 acc = {0.f, 0.f, 0.f, 0.f}; const int v = 16 * vtile + r;
#pragma unroll
        for (int ks = 0; ks < 2; ++ks) { const f32x4 s0 = sraw[vtile][ks][0], s1 = sraw[vtile][ks][1];
            const float x[8] = {s0[0], s0[1], s0[2], s0[3], s1[0], s1[1], s1[2], s1[3]};
            acc = __builtin_amdgcn_mfma_f32_16x16x32_bf16(qhf[ks], pack8(x), acc, 0, 0, 0); }
#pragma unroll
        for (int k2 = 0; k2 < 2; ++k2) { if (k2 == 0 || I >= 2) {
            const hbf16x4 v0 = *(const LAS hbf16x4*)(vt + v * (HG_VP * 2) + (32 * k2 + 4 * g) * 2), v1 = *(const LAS hbf16x4*)(vt + v * (HG_VP * 2) + (32 * k2 + 16 + 4 * g) * 2);
            const hbf16x8 vf = {v0[0], v0[1], v0[2], v0[3], v1[0], v1[1], v1[2], v1[3]};
            acc = __builtin_amdgcn_mfma_f32_16x16x32_bf16(pf[k2], vf, acc, 0, 0, 0); } }
        o[vtile] = acc; }
    if (MODE == 2) { if (o[0][0] == 1.2345f && o[1][1] == 2.5f && o[2][2] == 3.5f && o[3][3] == 4.5f && graw[3][3] == 0x1234) MIX[0] = 0; return; }
#pragma unroll
    for (int i = 0; i < 4; ++i) { float sq = 0.f;
#pragma unroll
        for (int vtile = 0; vtile < 4; ++vtile) sq += o[vtile][i] * o[vtile][i];
        sq += __shfl_xor(sq, 1); sq += __shfl_xor(sq, 2); sq += __shfl_xor(sq, 4); sq += __shfl_xor(sq, 8);
        const float rn = rsqrtf(sq * (1.0f / 64.0f) + EPS); const size_t row = row0 + 16 * I + 4 * g + i;
#pragma unroll
        for (int vtile = 0; vtile < 4; ++vtile) { const int v = 16 * vtile + r; const float gg = bf2f(graw[i][vtile]);
            MIX[row * DM + h * 64 + v] = (bf16_t)f2bf(o[vtile][i] * rn * hgn[v] * (gg / (1.0f + __expf(-gg)))); } }
}

struct Args { const float* in[14]; float* out; unsigned char* ws; int ph_lo, ph_hi; };
constexpr int NPHASE = 1 + 7 * DEPTH;

__global__ void __launch_bounds__(512, 2) fwd(Args a) {
    extern __shared__ __attribute__((aligned(16))) unsigned char lds[];
    cg::grid_group grid = cg::this_grid();
    LAS unsigned char* L = (LAS unsigned char*)lds;
    if (threadIdx.x < 32) ((LAS unsigned*)(L + LDS_BYTES - 128))[threadIdx.x] = 0u;
    __syncthreads();
    for (int ph = a.ph_lo; ph < a.ph_hi; ++ph) {
        int G = gridDim.x, bx = blockIdx.x; asm volatile("" : "+s"(G), "+s"(bx));
        typedef const __attribute__((address_space(4))) Args* KArgP;
        KArgP ap = (KArgP)__builtin_amdgcn_kernarg_segment_ptr(); asm volatile("" : "+s"(ap));
        unsigned char* ws = ap->ws;
        float* SS = (float*)(ws + WS_SS); float* LB = (float*)(ws + WS_LB);
        bf16_t* XB = (bf16_t*)(ws + WS_XB); bf16_t* MIX = (bf16_t*)(ws + WS_MIX); bf16_t* UB = (bf16_t*)(ws + WS_U);
        unsigned char* P = ws + WS_P;
#ifdef PROBE_T
        if (ph == NPHASE) {
            if (bx == 0) { const unsigned long long* ts_ = (const unsigned long long*)(ws + 65536); unsigned long long sa = 0, sb = 0;
                for (int p = 1; p < NPHASE; ++p) { const int kk_ = (p - 1) % 7; const unsigned long long d = ts_[p] - ts_[p - 1]; if (PROBE_A(kk_)) sa += d; if (PROBE_B(kk_)) sb += d; }
                const float fa = (float)sa * 1e-3f, fb = (float)sb * 1e-3f; float* o_ = ap->out;
                for (int i = threadIdx.x; i < (1 << 20); i += 512) o_[(1 << 20) + i] += fb;
                if (threadIdx.x == 0) o_[0] = fa; }
        } else
#endif
        if (ph == 0) {
            int tid = threadIdx.x; asm volatile("" : "+v"(tid)); const int lane = tid & 63, wave = __builtin_amdgcn_readfirstlane(tid >> 6);
            LAS float* scr = (LAS float*)(L + wave * 16384);
            const int gw = bx * 8 + wave, NGW = G * 8;
            constexpr int I_IN = 16 * 112, I_OUT = 16 * 32, I_1 = 16 * 128, I_2 = 64 * 32, I_L = I_IN + I_OUT + I_1 + I_2;
            for (int it = gw; it < DEPTH * I_L; it += NGW) {
                const int l = it / I_L; int r = it % I_L;
                unsigned char* wl = ws + WS_W + (size_t)l * W_LAYER;
                if (r < I_IN) { const int kb = r / 112, nb = r % 112, n0 = nb * 32, pn = n0 >> 8, p = n0 & 255, slot = 4 * pn + ((p & 127) >> 5), sc0 = 64 * slot + 32 * (p >> 7);
                    tr_item(ap->in[3] + (size_t)l * DM * INC, INC, INC, sc0, kb * 64, ap->in[2] + l * DM, (bf16_t*)wl, DM, n0, scr, lane); continue; }
                r -= I_IN;
                if (r < I_OUT) { const int kb = r / 32, nb = r % 32; tr_item(ap->in[10] + (size_t)l * DM * DM, DM, DM, nb * 32, kb * 64, nullptr, (bf16_t*)(wl + W_OUT), DM, nb * 32, scr, lane); continue; }
                r -= I_OUT;
                if (r < I_1) { const int kb = r / 128, nb = r % 128; tr_item(ap->in[12] + (size_t)l * DM * DFF, DFF, DFF, nb * 32, kb * 64, ap->in[11] + l * DM, (bf16_t*)(wl + W_1), DM, nb * 32, scr, lane); continue; }
                r -= I_1;
                { const int kb = r / 32, nb = r % 32; tr_item(ap->in[13] + (size_t)l * DFF * DM, DM, DM, nb * 32, kb * 64, nullptr, (bf16_t*)(wl + W_2), DFF, nb * 32, scr, lane); }
            }
            const float* x = ap->in[0];
            for (int m = gw; m < M; m += NGW) {
                const f32x4* xr = (const f32x4*)(x + (size_t)m * DM) + lane; f32x4 v[4]; float s = 0.f;
#pragma unroll
                for (int j = 0; j < 4; ++j) { v[j] = xr[64 * j]; s += (v[j][0] * v[j][0] + v[j][1] * v[j][1]) + (v[j][2] * v[j][2] + v[j][3] * v[j][3]); }
                const float tot = wave_sum(s);
                u32x2* o8 = (u32x2*)(XB + (size_t)m * DM) + lane;
#pragma unroll
                for (int j = 0; j < 4; ++j) { u32x2 w; w.x = pk2(v[j][0], v[j][1]); w.y = pk2(v[j][2], v[j][3]); o8[64 * j] = w; }
                if (lane < 16) SS[(size_t)m * 16 + lane] = (lane == 0) ? tot : 0.f;
            }
            if (bx == 2 && tid < 64) ((unsigned*)ws)[tid] = 0u;
            if (bx == 3) for (int i = tid; i < XCD_BAR_WORDS; i += 512) ((unsigned*)(ws + WS_BAR))[i] = 0u;
            if (bx == 1) {
                for (int i = tid; i < 1024; i += 512) { const int l = i >> 8, wh = (i >> 6) & 3, d = i & 63; LB[2048 + i] = ap->in[5 + wh][l * 64 + d]; }
                if (tid < 32) { const int l = tid >> 3, e = tid & 7; LB[3072 + tid] = (e < 6) ? ap->in[9][l * 6 + e] : 0.f; }
            }
            if (bx == 0 && tid < 256) {
                const float* lg = ap->in[1]; float e[DEPTH]; float mx = -1e30f, sum = 0.f;
#pragma unroll
                for (int l = 0; l < DEPTH; ++l) mx = fmaxf(mx, lg[l * 256 + tid]);
#pragma unroll
                for (int l = 0; l < DEPTH; ++l) { e[l] = expf(lg[l * 256 + tid] - mx); sum += e[l]; }
                float c = 0.f;
#pragma unroll
                for (int l = 0; l < DEPTH; ++l) { if (l > 0) c += e[l] / sum; LB[l * 512 + tid] = logf(fmaxf(c, 1e-30f)); LB[l * 512 + 256 + tid] = 1.0f - c; }
            }
        } else {
            const int l = (ph - 1) / 7, k = (ph - 1) % 7;
#ifdef REP_K
            const int nrep = (k == REP_K) ? 2 : 1;
#else
            const int nrep = 1;
#endif
            for (int rep = 0; rep < nrep; ++rep) {
            if (rep) { XcdBarrier xb_; xb_.bar = (unsigned*)(ws + WS_BAR); xb_.x = xb_xcc_id(); xb_.st = (volatile LAS unsigned*)(L + LDS_BYTES - 128); xcd_barrier(xb_); }
            unsigned char* wl = ws + WS_W + (size_t)l * W_LAYER;
            if (k == 0) {
                pg8::Gemm g{XB, (const bf16_t*)wl, M, NIN, DM}; pg8::StaticOrder S; S.init(M, NIN, G, bx);
                EpiInProj E{SS, P, LB + l * 512, LB + 2048 + l * 256, LB + 3072 + l * 8};
                pg8::gemm_phase<EpiInProj, pg8::StaticOrder, true, true>(L, g, S, E);
            } else if (k == 1) {
                int tid = threadIdx.x; asm volatile("" : "+v"(tid));
                unsigned* ctr = (unsigned*)ws + l * 16 + 1 + rep * 4;
                volatile LAS int* sh = (volatile LAS int*)(L + LDS_BYTES - 64);
                int nxt = 0; if (tid == 0) nxt = (int)atomicAdd(ctr, 1u);
                for (;;) {
                    if (tid == 0) sh[0] = nxt;
                    __syncthreads();
                    const int idx = __builtin_amdgcn_readfirstlane(sh[0]);
                    __syncthreads();
                    if (idx >= 816 + 1024) break;
                    if (tid == 0) nxt = (int)atomicAdd(ctr, 1u);
                    if (idx < 768) { const int qb = 15 - idx / 48, bh = idx % 48, b = bh / 6, h = bh % 6; typedef attn_body::bf16 abf;
                        attn_body::sb_unit(qb, (const abf*)(P + P_SQ) + (size_t)bh * SEQ * 64, (const abf*)(P + P_SQ + HEADBUF) + (size_t)bh * SEQ * 64, (const abf*)(P + P_SQ + 2 * HEADBUF) + (size_t)bh * SEQ * 64,
                                           (abf*)MIX + (size_t)b * SEQ * DM + 256 + h * 64, (char*)lds); }
                    else if (idx < 816) fox_cumsum_item(idx - 768, (const float*)(P + P_LF), (float*)(P + P_CC), (int*)(ws + WS_JS), LB + 2048 + l * 256 + 128, LB + 2048 + l * 256 + 192, (LAS float*)L);
                    else hgrn_a_item(idx - 816, P, (float*)(ws + WS_DD), L);
                    __syncthreads();
                }
            } else if (k == 2) {
                hgrn_b_scan(bx, G, P, (const float*)(ws + WS_DD));
            } else if (k == 3) {
                int tid = threadIdx.x; asm volatile("" : "+v"(tid));
                unsigned* ctr = (unsigned*)ws + l * 16 + rep * 4;
                volatile LAS int* sh = (volatile LAS int*)(L + LDS_BYTES - 64);
                int nxt = 0; if (tid == 0) nxt = (int)atomicAdd(ctr, 1u);
                for (;;) {
                    if (tid == 0) sh[0] = nxt;
                    __syncthreads();
                    const int idx = __builtin_amdgcn_readfirstlane(sh[0]);
                    __syncthreads();
#ifdef PROBE_FOX
                    if (idx >= 768 + 1024 || (rep && idx >= 768)) break;
#else
                    if (idx >= 768 + 1024) break;
#endif
                    if (tid == 0) nxt = (int)atomicAdd(ctr, 1u);
#ifdef PROBE_HGC
                    if (rep) { if (idx >= 768) {
#pragma unroll 1
                        for (int rr = 0; rr < PROBE_HGC_N; ++rr) { hgrn_c_item<PROBE_HGC>(idx - 768, P, (bf16_t*)ap->out, ap->in[4] + l * 64, L); __syncthreads(); } } continue; }
#endif
                    if (idx >= 768) { hgrn_c_item(idx - 768, P, MIX, ap->in[4] + l * 64, L); __syncthreads(); continue; }
                    const int qb = 15 - idx / 48, bh = idx % 48, b = bh / 6, h = bh % 6;
                    typedef attn_body::bf16 abf;
                    const int jstart = ((const int*)(ws + WS_JS))[bh * 16 + qb];
#ifdef PROBE_FOX
                    if (rep) attn_body::attn_unit<30, PROBE_FOX_BIAS>(qb, PROBE_FOX_JS(jstart), (const abf*)(P + P_FQ) + (size_t)bh * SEQ * 64, (const abf*)(P + P_FQ + HEADBUF) + (size_t)bh * SEQ * 64, (const abf*)(P + P_FQ + 2 * HEADBUF) + (size_t)bh * SEQ * 64,
                                            (abf*)ap->out + (size_t)b * SEQ * DM + 640 + h * 64, (const float*)(P + P_CC) + (size_t)bh * SEQ, (char*)lds);
                    else
#endif
                    attn_body::attn_unit<30>(qb, jstart, (const abf*)(P + P_FQ) + (size_t)bh * SEQ * 64, (const abf*)(P + P_FQ + HEADBUF) + (size_t)bh * SEQ * 64, (const abf*)(P + P_FQ + 2 * HEADBUF) + (size_t)bh * SEQ * 64,
                                            (abf*)MIX + (size_t)b * SEQ * DM + 640 + h * 64, (const float*)(P + P_CC) + (size_t)bh * SEQ, (char*)lds);
                }
            } else if (k == 5) {
                pg8::Gemm g{XB, (const bf16_t*)(wl + W_1), M, DFF, DM}; pg8::StaticOrder S; S.init(M, DFF, G, bx);
                EpiRelu2 E{UB, SS};
                pg8::gemm_phase<EpiRelu2, pg8::StaticOrder, true, true>(L, g, S, E);
            } else {
                const bool ff2 = (k == 6);
                pg8::Gemm g{ff2 ? UB : MIX, (const bf16_t*)(wl + (ff2 ? W_2 : W_OUT)), M, DM, ff2 ? DFF : DM}; pg8::StaticOrder S; S.init(M, DM, G, bx);
                EpiResid E{XB, (ff2 && l == DEPTH - 1) ? ap->out : nullptr, SS};
                pg8::gemm_phase<EpiResid, pg8::StaticOrder, true, true>(L, g, S, E);
            }
            }
        }
#ifdef PROBE_T
        if (bx == 0 && threadIdx.x == 0) ((unsigned long long*)(ws + 65536))[ph] = __builtin_amdgcn_s_memrealtime();
#endif
        if (ph + 1 < a.ph_hi) {
            if (ph == 0) {
                grid.sync();
                (void)xcd_barrier_post((unsigned*)(ws + WS_BAR), (volatile LAS unsigned*)(L + LDS_BYTES - 128));
            } else {
                XcdBarrier xb_; xb_.bar = (unsigned*)(ws + WS_BAR); xb_.x = xb_xcc_id(); xb_.st = (volatile LAS unsigned*)(L + LDS_BYTES - 128);
                xcd_barrier(xb_);
            }
        }
    }
}

#ifndef MK_MULTI
#define MK_MULTI 0
#endif
extern "C" void kernel_launch(void* const* d_in, const int* in_sizes, int n_in, void* d_out, int out_size, void* d_ws, size_t ws_size, hipStream_t stream) {
    static int grid = 0;
    if (grid == 0) {
        int dev = 0, cus = 0, per = 0;
        if (n_in != 14 || out_size != M * DM || ws_size < WS_END) { fprintf(stderr, "kernel_launch: unexpected shapes (n_in %d out %d ws %zu)\n", n_in, out_size, ws_size); grid = -1; return; }
        (void)hipGetDevice(&dev); (void)hipDeviceGetAttribute(&cus, hipDeviceAttributeMultiprocessorCount, dev);
        (void)hipFuncSetAttribute((const void*)fwd, hipFuncAttributeMaxDynamicSharedMemorySize, LDS_BYTES);
        (void)hipOccupancyMaxActiveBlocksPerMultiprocessor(&per, (const void*)fwd, 512, LDS_BYTES);
        if (per < 1) per = 1;
        grid = cus * per;
        fprintf(stderr, "kernel_launch: grid %d (cus %d x %d)\n", grid, cus, per);
    }
    if (grid < 0) return;
    Args a{};
    for (int i = 0; i < 14; ++i) a.in[i] = (const float*)d_in[i];
    a.out = (float*)d_out; a.ws = (unsigned char*)d_ws;
#if MK_MULTI
    for (int ph = 0; ph < NPHASE; ++ph) { a.ph_lo = ph; a.ph_hi = ph + 1; hipLaunchKernelGGL(fwd, dim3(grid), dim3(512), LDS_BYTES, stream, a); }
#else
#ifdef PROBE_T
    a.ph_lo = 0; a.ph_hi = NPHASE + 1;
#else
    a.ph_lo = 0; a.ph_hi = NPHASE;
#endif
    void* args[] = {&a};
    hipError_t e = hipLaunchCooperativeKernel((const void*)fwd, dim3(grid), dim3(512), args, LDS_BYTES, stream);
    if (e != hipSuccess) fprintf(stderr, "kernel_launch: cooperative launch failed: %s (grid %d)\n", hipGetErrorString(e), grid);
#endif
}
```

```cpp
#include <hip/hip_runtime.h>
#include <hip/hip_cooperative_groups.h>
#include <cstdio>
#include <cstdint>
namespace cg = cooperative_groups;
namespace pg8 {
#define PG8_LAS __attribute__((address_space(3)))
typedef unsigned short bf16_t;
typedef short bf16x8 __attribute__((ext_vector_type(8)));
typedef float f32x4 __attribute__((ext_vector_type(4)));
typedef unsigned u32x4 __attribute__((ext_vector_type(4)));
constexpr int BM = 256, BK = 64, HALF = 128, HTB = HALF * BK * 2  , STAGE_BYTES = 8 * HTB, NXCD = 8, WGM = 8;

__host__ __device__ __forceinline__ int lds_byte(int r, int c) { const int st = (r >> 4) * 2 + (c >> 5), rr = r & 15, cc = c & 31, ob = rr * 64 + cc * 2; return st * 1024 + (ob ^ (((ob >> 9) & 1) << 5)); }
__host__ __device__ __forceinline__ void stage_rc(int b, int& R, int& C) { const int st = b / 1024, sb = b % 1024, swz = sb ^ (((sb >> 9) & 1) << 5); R = (st >> 1) * 16 + swz / 64; C = (st & 1) * 32 + (swz % 64) / 2; }
__host__ __device__ __forceinline__ int perm32(int rho) { const int n = rho >> 4, i = rho & 15; return 8 * (i >> 2) + 4 * n + (i & 3); }

struct Unit { int pm, pn; };
struct Gemm { const bf16_t* A; const bf16_t* Bt; int M, N, K; };

struct StaticOrder {
    int nM, nN, nwg, G, c;
    __host__ __device__ void init(int M, int N, int G_, int c_) { nM = M / BM; nN = N / BM; nwg = nM * nN; G = G_; c = c_; }
    __host__ __device__ bool next(int i, Unit& u) const {
        const long L = (long)i * G + c; if (L >= nwg) return false;
        int wgid = (int)L; { const int q = nwg / NXCD, r = nwg % NXCD, xcd = wgid % NXCD, off = wgid / NXCD; wgid = (xcd < r ? xcd * (q + 1) : r * (q + 1) + (xcd - r) * q) + off; }
        const int nig = WGM * nN, gid = wgid / nig, fm = gid * WGM, gsz = (nM - fm) < WGM ? (nM - fm) : WGM;
        u.pm = fm + ((wgid % nig) % gsz); u.pn = (wgid % nig) / gsz; return true;
    }
    __device__ __forceinline__ void a_ready(const Unit&) const {}
    __device__ __forceinline__ void done(const Unit&) const {}
};

__device__ __forceinline__ unsigned cvt_pk_bf16(float lo, float hi) { unsigned r; asm volatile("v_cvt_pk_bf16_f32 %0, %1, %2" : "=v"(r) : "v"(lo), "v"(hi)); return r; }
typedef float f32x2 __attribute__((ext_vector_type(2)));
template <class Epi, class Sched, bool ALIGN_EPI = false, bool SP2 = false>
__device__ __forceinline__ void gemm_phase(PG8_LAS unsigned char* lds, const Gemm g, const Sched& S, const Epi& E) {
    int tid_ = threadIdx.x; asm volatile("" : "+v"(tid_));
    const int tid = tid_, wid = __builtin_amdgcn_readfirstlane(tid >> 6), lane = tid & 63, wr = wid >> 2, wc = wid & 3, fr = lane & 15, fq = lane >> 4;
    const int K = g.K, nt = K / BK;
    unsigned voffA[2], voffB[2];
#pragma unroll
    for (int i = 0; i < 2; ++i) { int R, C; stage_rc(tid * 16 + i * 8192, R, C); const int Rb = Epi::PERM ? ((R & ~31) + perm32(R & 31)) : R;
        voffA[i] = (unsigned)(R * K + C) * 2u; voffB[i] = (unsigned)(Rb * K + C) * 2u; }
    const size_t kstep = (size_t)(BK * 2);
    const size_t hstep = (size_t)HALF * K * 2;
    const size_t tstep = 2 * hstep;
    const unsigned ldsw = (unsigned)wid * 1024u;
    const int aoff = lds_byte(wr * 64 + fr, fq * 8), boff = lds_byte(wc * 32 + fr, fq * 8);
#define PG8_SA(b, h) (((b) * 2 + (h)) * HTB)
#define PG8_SB(b, h) ((4 + (b) * 2 + (h)) * HTB)
#define PG8_STAGE(bufoff, gbase, voff) do { _Pragma("unroll") for (int _i = 0; _i < 2; ++_i) \
        __builtin_amdgcn_global_load_lds((const unsigned*)((const char*)(gbase) + (voff)[_i]), (PG8_LAS unsigned*)(lds + (bufoff) + ldsw + _i * 8192), 16, 0, 0); } while (0)
#define PG8_LDA(dst, b, h) do { _Pragma("unroll") for (int m = 0; m < 4; ++m) _Pragma("unroll") for (int k = 0; k < 2; ++k) dst[m][k] = *(const PG8_LAS bf16x8*)(lds + PG8_SA(b, h) + aoff + m * 2048 + k * 1024); } while (0)
#define PG8_LDB(dst, b, h) do { _Pragma("unroll") for (int n = 0; n < 2; ++n) _Pragma("unroll") for (int k = 0; k < 2; ++k) dst[n][k] = *(const PG8_LAS bf16x8*)(lds + PG8_SB(b, h) + boff + n * 2048 + k * 1024); } while (0)
#define PG8_MMA(ai, bj, At, Bt) do { __builtin_amdgcn_s_setprio(1); _Pragma("unroll") for (int m = 0; m < 4; ++m) _Pragma("unroll") for (int n = 0; n < 2; ++n) _Pragma("unroll") for (int k = 0; k < 2; ++k) \
        acc[ai][bj][m][n] = __builtin_amdgcn_mfma_f32_16x16x32_bf16(Bt[n][k], At[m][k], acc[ai][bj][m][n], 0, 0, 0); __builtin_amdgcn_s_setprio(0); } while (0)
#define PG8_WAIT_V(n) asm volatile("s_waitcnt vmcnt(" #n ")" ::: "memory")
#define PG8_WAIT_L(n) asm volatile("s_waitcnt lgkmcnt(" #n ")" ::: "memory")
#define PG8_BAR __builtin_amdgcn_s_barrier()
#define PG8_SCHED __builtin_amdgcn_sched_barrier(0)
    Unit cur, nxt; int ui = 0;
    if (!S.next(0, cur)) return;
    f32x4 acc[2][2][4][2];
#pragma unroll
    for (int a = 0; a < 2; ++a)
#pragma unroll
        for (int b = 0; b < 2; ++b)
#pragma unroll
            for (int m = 0; m < 4; ++m)
#pragma unroll
                for (int n = 0; n < 2; ++n) acc[a][b][m][n] = (f32x4){0.f, 0.f, 0.f, 0.f};
    bf16x8 At[4][2], B0[2][2], B1[2][2];
    const char* cA = (const char*)g.A + (size_t)cur.pm * tstep; const char* cB = (const char*)g.Bt + (size_t)cur.pn * tstep;
    S.a_ready(cur);
    if constexpr (SP2) {
        PG8_STAGE(PG8_SB(0, 0), cB, voffB); PG8_STAGE(PG8_SB(0, 1), cB + hstep, voffB); PG8_STAGE(PG8_SA(0, 0), cA, voffA); PG8_STAGE(PG8_SA(0, 1), cA + hstep, voffA);
        if (wr == 1) PG8_BAR;
        PG8_WAIT_V(2); PG8_BAR;
        PG8_STAGE(PG8_SB(1, 0), cB + kstep, voffB); PG8_STAGE(PG8_SA(1, 0), cA + kstep, voffA); PG8_STAGE(PG8_SB(1, 1), cB + hstep + kstep, voffB);
        PG8_WAIT_V(6); PG8_BAR;
    } else {
        PG8_STAGE(PG8_SB(0, 0), cB, voffB); PG8_STAGE(PG8_SA(0, 0), cA, voffA); PG8_STAGE(PG8_SB(0, 1), cB + hstep, voffB); PG8_STAGE(PG8_SA(0, 1), cA + hstep, voffA);
        if (wr == 1) PG8_BAR;
        PG8_WAIT_V(4); PG8_BAR;
        PG8_STAGE(PG8_SB(1, 0), cB + kstep, voffB); PG8_STAGE(PG8_SA(1, 0), cA + kstep, voffA); PG8_STAGE(PG8_SB(1, 1), cB + hstep + kstep, voffB);
        PG8_WAIT_V(6); PG8_BAR;
    }
    for (;;) {
        const bool has_next = S.next(ui + 1, nxt);
        const char* nA = has_next ? (const char*)g.A + (size_t)nxt.pm * tstep : cA; const char* nB = has_next ? (const char*)g.Bt + (size_t)nxt.pn * tstep : cB;
        for (int t = 0; t < nt; t += 2) {
            const bool last = (t == nt - 2);
            const char* a1 = cA + (size_t)(t + 1) * kstep;
            const char* a2 = last ? nA : cA + (size_t)(t + 2) * kstep; const char* b2 = last ? nB : cB + (size_t)(t + 2) * kstep;
            const char* a3 = a2 + kstep; const char* b3 = b2 + kstep;
            if (last && has_next) S.a_ready(nxt);
            if constexpr (SP2) {
            PG8_LDB(B0, 0, 0); PG8_LDB(B1, 0, 1); PG8_SCHED; PG8_LDA(At, 0, 0); PG8_STAGE(PG8_SA(1, 1), a1 + hstep, voffA);
            PG8_WAIT_V(8); PG8_WAIT_L(0); PG8_BAR; PG8_MMA(0, 0, At, B0); PG8_MMA(0, 1, At, B1); PG8_BAR; PG8_SCHED;
            PG8_LDA(At, 0, 1); PG8_STAGE(PG8_SB(0, 0), b2, voffB); PG8_STAGE(PG8_SB(0, 1), b2 + hstep, voffB); PG8_STAGE(PG8_SA(0, 0), a2, voffA);
            PG8_WAIT_V(8); PG8_WAIT_L(0); PG8_BAR; PG8_MMA(1, 0, At, B0); PG8_MMA(1, 1, At, B1); PG8_BAR; PG8_SCHED;
            PG8_LDB(B0, 1, 0); PG8_LDB(B1, 1, 1); PG8_SCHED; PG8_LDA(At, 1, 0); PG8_STAGE(PG8_SA(0, 1), a2 + hstep, voffA);
            PG8_WAIT_V(8); PG8_WAIT_L(0); PG8_BAR; PG8_MMA(0, 0, At, B0); PG8_MMA(0, 1, At, B1); PG8_BAR; PG8_SCHED;
            PG8_LDA(At, 1, 1); PG8_STAGE(PG8_SB(1, 0), b3, voffB); PG8_STAGE(PG8_SB(1, 1), b3 + hstep, voffB); PG8_STAGE(PG8_SA(1, 0), a3, voffA);
            PG8_WAIT_V(8); PG8_WAIT_L(0); PG8_BAR; PG8_MMA(1, 0, At, B0); PG8_MMA(1, 1, At, B1); PG8_BAR; PG8_SCHED;
            } else {
            PG8_LDB(B0, 0, 0); PG8_SCHED; PG8_LDA(At, 0, 0); PG8_STAGE(PG8_SA(1, 1), a1 + hstep, voffA);
            PG8_WAIT_L(8); PG8_BAR; PG8_WAIT_L(0); PG8_MMA(0, 0, At, B0); PG8_BAR; PG8_SCHED;
            PG8_LDB(B1, 0, 1); PG8_STAGE(PG8_SB(0, 0), b2, voffB);
            PG8_BAR; PG8_WAIT_L(0); PG8_MMA(0, 1, At, B1); PG8_BAR;
            PG8_LDA(At, 0, 1); PG8_STAGE(PG8_SA(0, 0), a2, voffA);
            PG8_BAR; PG8_WAIT_L(0); PG8_MMA(1, 0, At, B0); PG8_BAR; PG8_SCHED;
            PG8_STAGE(PG8_SB(0, 1), b2 + hstep, voffB);
            PG8_WAIT_V(6); PG8_BAR; PG8_MMA(1, 1, At, B1); PG8_BAR;
            PG8_LDB(B0, 1, 0); PG8_SCHED; PG8_LDA(At, 1, 0); PG8_STAGE(PG8_SA(0, 1), a2 + hstep, voffA);
            PG8_WAIT_L(8); PG8_BAR; PG8_WAIT_L(0); PG8_MMA(0, 0, At, B0); PG8_BAR; PG8_SCHED;
            PG8_LDB(B1, 1, 1); PG8_STAGE(PG8_SB(1, 0), b3, voffB);
            PG8_BAR; PG8_WAIT_L(0); PG8_MMA(0, 1, At, B1); PG8_BAR;
            PG8_LDA(At, 1, 1); PG8_STAGE(PG8_SA(1, 0), a3, voffA);
            PG8_BAR; PG8_WAIT_L(0); PG8_MMA(1, 0, At, B0); PG8_BAR; PG8_SCHED;
            PG8_STAGE(PG8_SB(1, 1), b3 + hstep, voffB);
            PG8_WAIT_V(6); PG8_BAR; PG8_MMA(1, 1, At, B1); PG8_BAR;
            }
        }
        if constexpr (ALIGN_EPI) { if (wr == 0) PG8_BAR; }
        if constexpr (!Epi::AFTER_DRAIN) { E(acc, cur, wr, wc, fr, fq); S.done(cur); }
        if (!has_next) break;
#pragma unroll
        for (int a = 0; a < 2; ++a)
#pragma unroll
            for (int b = 0; b < 2; ++b)
#pragma unroll
                for (int m = 0; m < 4; ++m)
#pragma unroll
                    for (int n = 0; n < 2; ++n) acc[a][b][m][n] = (f32x4){0.f, 0.f, 0.f, 0.f};
        cur = nxt; cA = nA; cB = nB; ++ui;
        if constexpr (ALIGN_EPI) { if (wr == 1) PG8_BAR; }
    }
    PG8_WAIT_V(0);
    if constexpr (!ALIGN_EPI) { if (wr == 0) PG8_BAR; }
    PG8_BAR;
    if constexpr (Epi::AFTER_DRAIN) { E.fused(acc, cur, wr, wc, fr, fq, lds, wid, lane); S.done(cur); }
#undef PG8_SA
#undef PG8_SB
#undef PG8_STAGE
#undef PG8_LDA
#undef PG8_LDB
#undef PG8_MMA
#undef PG8_WAIT_V
#undef PG8_WAIT_L
#undef PG8_BAR
#undef PG8_SCHED
}
}
#include <hip/hip_bf16.h>
#include <cmath>
namespace attn_body {
using bf16=__hip_bfloat16;
using bf16x8=__attribute__((ext_vector_type(8)))short;
using s16x4=__attribute__((ext_vector_type(4)))short;
using f32x16=__attribute__((ext_vector_type(16)))float;
using u32x4=__attribute__((ext_vector_type(4)))unsigned;
using f32x4v=__attribute__((ext_vector_type(4)))float;
constexpr int SEQ=4096,D=64,DM=64,OPITCH=1024;
constexpr int LDS_C=98304;
constexpr int NW=8,QBLK=32,QB=QBLK*NW,KVBLK=64,NQB=SEQ/QB;
constexpr int ATTN_UNIT_ROWS=QB;
__device__ __forceinline__ int crow(int r,int hi){return (r&3)+8*(r>>2)+4*hi;}
#define SBAR() __builtin_amdgcn_sched_barrier(0)
__device__ __forceinline__ void cmask(f32x16&p0,f32x16&p1,int jb,int qrel,int hi){
  const float NEG=-INFINITY; int kb=64*jb+4*hi;
  #pragma unroll
  for(int r=0;r<16;++r){int kv=kb+(r&3)+8*(r>>2); if(kv>qrel)p0[r]=NEG; if(kv+32>qrel)p1[r]=NEG;}
}

constexpr int NSLOT=3, SLOTB=8192;
constexpr int LDS_K=0, LDS_V=NSLOT*SLOTB, LDS_WS=2*NSLOT*SLOTB, LDS_OST=LDS_WS+NW*64*4, LDS_BYTES=LDS_OST+NW*4096;
constexpr float C2=0.125f*1.4426950408889634f;
__device__ __forceinline__ void glds16(const void*gsrc,unsigned lds_dst){unsigned keep;
  asm volatile("s_mov_b32 %0, m0\n\ts_mov_b32 m0, %2\n\ts_nop 0\n\tglobal_load_lds_dwordx4 %1, off\n\ts_mov_b32 m0, %0":"=&s"(keep):"v"(gsrc),"s"(lds_dst):"memory");}
__device__ __forceinline__ float max3f(float a,float b,float c){float r;asm("v_max3_f32 %0, %1, %2, %3":"=v"(r):"v"(a),"v"(b),"v"(c));return r;}
__device__ __forceinline__ float max2f(float a,float b){float r;asm("v_max_f32_e32 %0, %1, %2":"=v"(r):"v"(a),"v"(b));return r;}
__device__ __forceinline__ float fadd_s(float a,float b){float r;asm("v_add_f32_e32 %0, %1, %2":"=v"(r):"v"(a),"v"(b));return r;}
__device__ __forceinline__ float fsub_s(float a,float b){float r;asm("v_sub_f32_e32 %0, %1, %2":"=v"(r):"v"(a),"v"(b));return r;}
typedef float f32x2_t __attribute__((ext_vector_type(2))); typedef __bf16 bf16x2_t __attribute__((ext_vector_type(2)));
__device__ __forceinline__ unsigned cvtpk_s(float lo,float hi){f32x2_t v={lo,hi};bf16x2_t b=__builtin_convertvector(v,bf16x2_t);return __builtin_bit_cast(unsigned,b);}
#define WAIT_BAR(N) asm volatile("s_waitcnt vmcnt(" #N ") lgkmcnt(0)\n\ts_barrier":::"memory")

__device__ __forceinline__ void qkt(f32x16&p0,f32x16&p1,const char*Kslot,const bf16x8*qr,const f32x16&negm,int r32,int hi){
  const char*kb=Kslot+hi*1024+r32*16;
  #pragma unroll
  for(int d0=0;d0<4;++d0){
    const bf16x8 b0=*reinterpret_cast<const bf16x8*>(kb+d0*2048);
    const bf16x8 b1=*reinterpret_cast<const bf16x8*>(kb+d0*2048+512);
    if(d0==0){p0=__builtin_amdgcn_mfma_f32_32x32x16_bf16(b0,qr[0],negm,0,0,0);p1=__builtin_amdgcn_mfma_f32_32x32x16_bf16(b1,qr[0],negm,0,0,0);}
    else{p0=__builtin_amdgcn_mfma_f32_32x32x16_bf16(b0,qr[d0],p0,0,0,0);p1=__builtin_amdgcn_mfma_f32_32x32x16_bf16(b1,qr[d0],p1,0,0,0);}}
}
typedef __attribute__((address_space(3))) const char* lds_cptr;
typedef short v4i16_t __attribute__((ext_vector_type(4)));
__device__ __forceinline__ void kload8(bf16x8*kf,lds_cptr kp){
  kf[0]=*(const __attribute__((address_space(3))) bf16x8*)(kp);      kf[1]=*(const __attribute__((address_space(3))) bf16x8*)(kp+512);
  kf[2]=*(const __attribute__((address_space(3))) bf16x8*)(kp+2048); kf[3]=*(const __attribute__((address_space(3))) bf16x8*)(kp+2560);
  kf[4]=*(const __attribute__((address_space(3))) bf16x8*)(kp+4096); kf[5]=*(const __attribute__((address_space(3))) bf16x8*)(kp+4608);
  kf[6]=*(const __attribute__((address_space(3))) bf16x8*)(kp+6144); kf[7]=*(const __attribute__((address_space(3))) bf16x8*)(kp+6656);
}
__device__ __forceinline__ void kload2(bf16x8*kf,lds_cptr kp,int j){ kf[2*j]=*(const __attribute__((address_space(3))) bf16x8*)(kp+j*2048); kf[2*j+1]=*(const __attribute__((address_space(3))) bf16x8*)(kp+j*2048+512); }
__device__ __forceinline__ s16x4 vtr(lds_cptr p){ return __builtin_bit_cast(s16x4,__builtin_amdgcn_ds_read_tr16_b64_v4i16((__attribute__((address_space(3))) v4i16_t*)p)); }
__device__ __forceinline__ float rowmax(const f32x16&p0,const f32x16&p1){
  float a=max3f(p0[0],p0[1],p1[0]),b=max3f(p0[2],p0[3],p1[1]);a=max3f(a,p1[2],p1[3]);
  #pragma unroll
  for(int r=4;r<16;r+=4){a=max3f(a,p0[r],p0[r+1]);b=max3f(b,p0[r+2],p0[r+3]);a=max3f(a,p1[r],p1[r+1]);b=max3f(b,p1[r+2],p1[r+3]);}
  const float m=max2f(a,b);
  auto rr=__builtin_amdgcn_permlane32_swap(__float_as_uint(m),__float_as_uint(m),false,false);
  return max2f(__uint_as_float(rr[0]),__uint_as_float(rr[1]));
}
__device__ __forceinline__ void pv(f32x16*o,int vb,bf16x8 pa0,bf16x8 pa1,bf16x8 pa2,bf16x8 pa3){
  #pragma unroll
  for(int d0=0;d0<2;++d0){s16x4 lo[4],hi[4];
    #pragma unroll
    for(int ks=0;ks<4;++ks){
      asm volatile("ds_read_b64_tr_b16 %0,%1 offset:%c2":"=&v"(lo[ks]):"v"(vb),"i"(d0*4096+ks*1024):"memory");
      asm volatile("ds_read_b64_tr_b16 %0,%1 offset:%c2":"=&v"(hi[ks]):"v"(vb),"i"(d0*4096+ks*1024+512):"memory");}
    asm volatile("s_waitcnt lgkmcnt(0)":::"memory");SBAR();
    #define PK(k) (bf16x8){lo[k][0],lo[k][1],lo[k][2],lo[k][3],hi[k][0],hi[k][1],hi[k][2],hi[k][3]}
    o[d0]=__builtin_amdgcn_mfma_f32_32x32x16_bf16(pa0,PK(0),o[d0],0,0,0);
    o[d0]=__builtin_amdgcn_mfma_f32_32x32x16_bf16(pa1,PK(1),o[d0],0,0,0);
    o[d0]=__builtin_amdgcn_mfma_f32_32x32x16_bf16(pa2,PK(2),o[d0],0,0,0);
    o[d0]=__builtin_amdgcn_mfma_f32_32x32x16_bf16(pa3,PK(3),o[d0],0,0,0);
    #undef PK
  }
}

#ifndef ATTN_STORE16
#define ATTN_STORE16(p,v) (*(u32x4*)(p)=(v))
#endif
template<int THRL,bool BIASON=true> __device__ __forceinline__ void attn_unit(int qb,int jstart,const bf16*Q,const bf16*__restrict__ K,const bf16*__restrict__ V,bf16*O,const float*__restrict__ Cg,char*shm){
  int tid_=threadIdx.x; asm volatile("":"+v"(tid_)); const int tid=tid_,lane=tid&63,r32=lane&31,hi=lane>>5; const int wid=__builtin_amdgcn_readfirstlane(tid>>6);
  const int q0=qb*QB;
  const bf16*Qw=Q+(long)(q0+wid*QBLK)*DM;
  const bf16*Kh=K+(long)jstart*KVBLK*DM,*Vh=V+(long)jstart*KVBLK*DM;
  const lds_cptr shm3=(lds_cptr)shm;
  const unsigned lds0=(unsigned)(uintptr_t)shm;
  float*wsf=(float*)(shm+LDS_WS)+wid*64;
  const bf16*ksrc=Kh+(long)lane*DM+wid*8;
  const bf16*vsrc=Vh+(long)(16*(wid&3)+(lane>>2))*DM+(wid>>2)*32+(lane&3)*8;
  const unsigned kdst=lds0+LDS_K+wid*1024, vdst=lds0+LDS_V+wid*1024;
  #define DMA_K(t,slot) glds16(ksrc+(long)(t)*KVBLK*DM,(unsigned)__builtin_amdgcn_readfirstlane(kdst+(slot)))
  #define DMA_V(t,slot) glds16(vsrc+(long)(t)*KVBLK*DM,(unsigned)__builtin_amdgcn_readfirstlane(vdst+(slot)))
  const int vb0=(int)(lds0+LDS_V)+((lane>>4)&1)*32+(lane&3)*8+(4*hi+((lane&15)>>2))*64;
  const char*Kbase=shm+LDS_K; bf16x8 kf[8];
  const lds_cptr kp0=shm3+LDS_K+hi*1024+r32*16; const lds_cptr vp0=shm3+LDS_V+((lane>>4)&1)*32+(lane&3)*8+(4*hi+((lane&15)>>2))*64;
  const int NT=(q0+QB)/KVBLK-jstart;
  { typedef __attribute__((address_space(3))) f32x4v lf32x4; lf32x4*cl_=(lf32x4*)(shm3+LDS_C); const f32x4v*cg_=(const f32x4v*)(Cg+jstart*KVBLK); const int n4_=(q0+QB-jstart*KVBLK)>>2;
    f32x4v c0_=f32x4v{},c1_=f32x4v{}; if(tid<n4_)c0_=cg_[tid]; if(tid+NW*64<n4_)c1_=cg_[tid+NW*64]; if(tid<n4_)cl_[tid]=c0_; if(tid+NW*64<n4_)cl_[tid+NW*64]=c1_; }
  DMA_K(0,0);DMA_V(0,0);DMA_K(1,SLOTB);
  bf16x8 qr[4];
  #pragma unroll
  for(int d0=0;d0<4;++d0)qr[d0]=*reinterpret_cast<const bf16x8*>(&Qw[(long)r32*DM+d0*16+hi*8]);
  float mhat=0.f,l_reg=0.f;f32x16 o[2];o[0]=f32x16{};o[1]=f32x16{};
  const int qrel=wid*QBLK+r32;
  #define CMASK(P0,P1,t) do{int jb_=(t)-(NT-4); if(jb_>=0)cmask(P0,P1,jb_,qrel,hi);}while(0)
  typedef __attribute__((address_space(3))) const float* lds_fptr; typedef __attribute__((address_space(3))) const f32x4v* lds_f4ptr;
  const lds_fptr cl0=(lds_fptr)(shm3+LDS_C)+4*hi;
  #define BIAS(P0,P1,t) do{ const lds_fptr cb_=cl0+64*(t); _Pragma("unroll") for(int g_=0;g_<4;++g_){ const f32x4v a_=*(lds_f4ptr)(cb_+8*g_), b_=*(lds_f4ptr)(cb_+32+8*g_); \
      _Pragma("unroll") for(int i_=0;i_<4;++i_){P0[4*g_+i_]-=a_[i_];P1[4*g_+i_]-=b_[i_];} } }while(0)
  #define BIASINIT(C0_,C1_,t) do{ const lds_fptr cb_=cl0+64*(t); const float nm_=-mhat; _Pragma("unroll") for(int g_=0;g_<4;++g_){ f32x4v a_=f32x4v{},b_=f32x4v{}; if(BIASON){a_=*(lds_f4ptr)(cb_+8*g_); b_=*(lds_f4ptr)(cb_+32+8*g_);} \
      _Pragma("unroll") for(int i_=0;i_<4;++i_){C0_[4*g_+i_]=nm_-a_[i_];C1_[4*g_+i_]=nm_-b_[i_];} } }while(0)
  bool resc=false;
  #define START(P0,P1) do{ const float rm=rowmax(P0,P1); resc=false; \
    { const float dl=rm; mhat=fadd_s(mhat,dl); \
      _Pragma("unroll") for(int r=0;r<16;++r){P0[r]=fsub_s(P0[r],dl);P1[r]=fsub_s(P1[r],dl);} \
      } \
    _Pragma("unroll") for(int r=0;r<16;++r)P0[r]=__builtin_amdgcn_exp2f(P0[r]); }while(0)
  #define RESC() do{ if(resc){ asm volatile("s_waitcnt lgkmcnt(0)":::"memory"); \
      _Pragma("unroll") for(int d_=0;d_<2;++d_) _Pragma("unroll") for(int r=0;r<16;++r)o[d_][r]*=wsf[crow(r,hi)]; } }while(0)
  f32x16 pA0,pA1,pB0,pB1;
  int sl_prev=0,sl_cur=0,sl_next=SLOTB;
  #define ROT() do{sl_prev=sl_cur;sl_cur=sl_next;sl_next=(sl_next==(NSLOT-1)*SLOTB)?0:sl_next+SLOTB;}while(0)
  DMA_K(2,2*SLOTB);
  WAIT_BAR(3);
  { const f32x16 zero_=f32x16{}; qkt(pA0,pA1,Kbase,qr,zero_,r32,hi); }asm volatile("s_nop 15\n\ts_nop 7":"+v"(pA0),"+v"(pA1));BIAS(pA0,pA1,0);CMASK(pA0,pA1,0);
  START(pA0,pA1);
  BIASINIT(pB0,pB1,1);
  _Pragma("unroll") for(int r=0;r<16;++r)pA1[r]=__builtin_amdgcn_exp2f(pA1[r]);
  WAIT_BAR(0);
  DMA_K(3,0);DMA_V(1,SLOTB);
  ROT();
  kload8(kf,kp0+sl_cur);
  WAIT_BAR(2);
  s16x4 vlo[8],vhi[8]; u32x4 pw0,pw1,pw2,pw3;
  #define PKW(P,B) cvtpk_s(P[B],P[B+1])
  #define PAF(k) __builtin_bit_cast(bf16x8,pw##k)
  #define VFR(i) (bf16x8){vlo[i][0],vlo[i][1],vlo[i][2],vlo[i][3],vhi[i][0],vhi[i][1],vhi[i][2],vhi[i][3]}
  #define PIN(x) asm volatile("":"+v"(x))
  #define MX3(a,b,c) __builtin_fmaxf(__builtin_fmaxf((a),(b)),(c))
  #define GAPA(MF,A0,A1,A2,A3,W0,W1,PW) do{ MF; sacc+=A0; sacc+=A1; sacc+=A2; sacc+=A3; PIN(sacc); W0; W1; PIN(PW); SBAR(); }while(0)
  #define EX(v) __builtin_amdgcn_exp2f(v)
  #define GAPB(MF,X,B) do{ MF; X[B]=EX(X[B]); X[B+1]=EX(X[B+1]); X[B+2]=EX(X[B+2]); X[B+3]=EX(X[B+3]); PIN(X); SBAR(); }while(0)
  #define VRD(i) do{ vlo[i]=vtr(vp_+(((i)>>2)*4096+((i)&3)*1024)); vhi[i]=vtr(vp_+(((i)>>2)*4096+((i)&3)*1024+512)); }while(0)
  #define KRD(G,j) do{ if(G){ kload2(kf,kp0+sl_next,j); SBAR(); } }while(0)
  #define STEP(C0,C1,P0,P1,t,GK,GV,GL) do{ SBAR(); \
    const lds_cptr vp_=vp0+sl_prev; \
    VRD(0); SBAR(); float sacc=(P0[0]+P0[1]); \
    GAPA(C0=__builtin_amdgcn_mfma_f32_32x32x16_bf16(kf[0],qr[0],C0,0,0,0), P0[2],P0[3],P0[4],P0[5],     pw0[0]=PKW(P0,0), pw0[1]=PKW(P0,2), pw0); \
    VRD(4); SBAR(); GAPA(C1=__builtin_amdgcn_mfma_f32_32x32x16_bf16(kf[1],qr[0],C1,0,0,0), P0[6],P0[7],P0[8],P0[9],     pw0[2]=PKW(P0,4), pw0[3]=PKW(P0,6), pw0); \
    VRD(1); SBAR(); GAPA(C0=__builtin_amdgcn_mfma_f32_32x32x16_bf16(kf[2],qr[1],C0,0,0,0),   P0[10],P0[11],P0[12],P0[13], pw1[0]=PKW(P0,8), pw1[1]=PKW(P0,10), pw1); \
    VRD(5); SBAR(); GAPA(C1=__builtin_amdgcn_mfma_f32_32x32x16_bf16(kf[3],qr[1],C1,0,0,0),   P0[14],P0[15],P1[0],P1[1],   pw1[2]=PKW(P0,12),pw1[3]=PKW(P0,14), pw1); \
    VRD(2); SBAR(); GAPA(C0=__builtin_amdgcn_mfma_f32_32x32x16_bf16(kf[4],qr[2],C0,0,0,0),   P1[2],P1[3],P1[4],P1[5],     pw2[0]=PKW(P1,0), pw2[1]=PKW(P1,2), pw2); \
    VRD(6); SBAR(); GAPA(C1=__builtin_amdgcn_mfma_f32_32x32x16_bf16(kf[5],qr[2],C1,0,0,0),   P1[6],P1[7],P1[8],P1[9],     pw2[2]=PKW(P1,4), pw2[3]=PKW(P1,6), pw2); \
    VRD(3); SBAR(); GAPA(C0=__builtin_amdgcn_mfma_f32_32x32x16_bf16(kf[6],qr[3],C0,0,0,0),   P1[10],P1[11],P1[12],P1[13], pw3[0]=PKW(P1,8), pw3[1]=PKW(P1,10), pw3); \
    VRD(7); SBAR(); GAPA(C1=__builtin_amdgcn_mfma_f32_32x32x16_bf16(kf[7],qr[3],C1,0,0,0),   P1[14],P1[15],0.f,0.f,       pw3[2]=PKW(P1,12),pw3[3]=PKW(P1,14), pw3); \
    l_reg+=sacc; \
    if(GK){DMA_K((t)+3,sl_cur);} if(GV){DMA_V((t)+1,sl_next);} \
    CMASK(C0,C1,t); \
    { float a=MX3(C0[0],C0[1],C1[0]),b=MX3(C0[2],C0[3],C1[1]); a=MX3(a,C1[2],C1[3]); \
      _Pragma("unroll") for(int r=4;r<16;r+=4){a=MX3(a,C0[r],C0[r+1]);b=MX3(b,C0[r+2],C0[r+3]);a=MX3(a,C1[r],C1[r+1]);b=MX3(b,C1[r+2],C1[r+3]);} \
      float rm=__builtin_fmaxf(a,b); { auto rr=__builtin_amdgcn_permlane32_swap(__float_as_uint(rm),__float_as_uint(rm),false,false); rm=__builtin_fmaxf(__uint_as_float(rr[0]),__uint_as_float(rr[1])); } \
      resc=false; \
      if(__builtin_expect(__any(rm>(float)THRL),0)){ const float dl=__builtin_fmaxf(rm+30.f,0.f); mhat+=dl; \
        _Pragma("unroll") for(int r=0;r<16;++r){C0[r]-=dl;C1[r]-=dl;} \
        const float f=__builtin_amdgcn_exp2f(-dl); l_reg*=f; if(hi==0)wsf[r32]=f; resc=true; } } \
    SBAR(); \
    GAPB(o[0]=__builtin_amdgcn_mfma_f32_32x32x16_bf16(PAF(0),VFR(0),o[0],0,0,0), C0,0); \
    GAPB(o[1]=__builtin_amdgcn_mfma_f32_32x32x16_bf16(PAF(0),VFR(4),o[1],0,0,0), C0,4); \
    KRD(GL,0); GAPB(o[0]=__builtin_amdgcn_mfma_f32_32x32x16_bf16(PAF(1),VFR(1),o[0],0,0,0), C0,8); \
    KRD(GL,1); GAPB(o[1]=__builtin_amdgcn_mfma_f32_32x32x16_bf16(PAF(1),VFR(5),o[1],0,0,0), C0,12); \
    KRD(GL,2); GAPB(o[0]=__builtin_amdgcn_mfma_f32_32x32x16_bf16(PAF(2),VFR(2),o[0],0,0,0), C1,0); \
    KRD(GL,3); GAPB(o[1]=__builtin_amdgcn_mfma_f32_32x32x16_bf16(PAF(2),VFR(6),o[1],0,0,0), C1,4); \
    GAPB(o[0]=__builtin_amdgcn_mfma_f32_32x32x16_bf16(PAF(3),VFR(3),o[0],0,0,0), C1,8); \
    GAPB(o[1]=__builtin_amdgcn_mfma_f32_32x32x16_bf16(PAF(3),VFR(7),o[1],0,0,0), C1,12); \
    BIASINIT(P0,P1,(t)+1); SBAR(); \
    }while(0)
  int t=1;
  #undef CMASK
  #define CMASK(P0,P1,t) do{}while(0)
  for(;t+5<NT;t+=2){
    STEP(pB0,pB1,pA0,pA1,t,true,true,true);     WAIT_BAR(2); RESC(); ROT();
    STEP(pA0,pA1,pB0,pB1,t+1,true,true,true);   WAIT_BAR(2); RESC(); ROT();
  }
  #undef CMASK
  #define CMASK(P0,P1,t) do{int jb_=(t)-(NT-4); if(jb_>=0)cmask(P0,P1,jb_,qrel,hi);}while(0)
  #define ENDW(tt) do{ if((tt)+3<NT){WAIT_BAR(2);} else if((tt)+2<NT){WAIT_BAR(1);} else {WAIT_BAR(0);} }while(0)
  for(;t+1<NT;t+=2){
    STEP(pB0,pB1,pA0,pA1,t,(t+3<NT),(t+1<NT),(t+1<NT));       ENDW(t);   RESC(); ROT();
    STEP(pA0,pA1,pB0,pB1,t+1,(t+4<NT),(t+2<NT),(t+2<NT));     ENDW(t+1); RESC(); ROT();
  }
  STEP(pB0,pB1,pA0,pA1,NT-1,false,false,false); RESC();
  { float sacc=pB0[0]+pB0[1]; _Pragma("unroll") for(int r=2;r<16;++r)sacc+=pB0[r]; _Pragma("unroll") for(int r=0;r<16;++r)sacc+=pB1[r]; l_reg+=sacc;
    pw0=(u32x4){PKW(pB0,0),PKW(pB0,2),PKW(pB0,4),PKW(pB0,6)};pw1=(u32x4){PKW(pB0,8),PKW(pB0,10),PKW(pB0,12),PKW(pB0,14)};pw2=(u32x4){PKW(pB1,0),PKW(pB1,2),PKW(pB1,4),PKW(pB1,6)};pw3=(u32x4){PKW(pB1,8),PKW(pB1,10),PKW(pB1,12),PKW(pB1,14)};
    SBAR(); pv(o,vb0+sl_cur,PAF(0),PAF(1),PAF(2),PAF(3)); }
  #undef PKW
  #undef PAF
  #undef VFR
  #undef PIN
  #undef MX3
  #undef GAPA
  #undef GAPB
  #undef EX
  #undef VRD
  #undef KRD
  #undef STEP
  #undef ENDW
  {auto rr=__builtin_amdgcn_permlane32_swap(__float_as_uint(l_reg),__float_as_uint(l_reg),false,false);l_reg=__uint_as_float(rr[0])+__uint_as_float(rr[1]);}
  if(hi==0)wsf[32+r32]=l_reg;asm volatile("s_waitcnt lgkmcnt(0)":::"memory");
  float rli[16];
  #pragma unroll
  for(int r=0;r<16;++r)rli[r]=__builtin_amdgcn_rcpf(wsf[32+crow(r,hi)]);
  bf16*Ow=O+(long)(q0+wid*QBLK)*OPITCH;
  { bf16*stg=(bf16*)(shm+LDS_OST)+wid*2048;
    #pragma unroll
    for(int r=0;r<16;++r){const int orow=crow(r,hi);
      #pragma unroll
      for(int d0=0;d0<2;++d0)stg[orow*64+d0*32+r32]=__float2bfloat16(o[d0][r]*rli[r]);}
    asm volatile("s_waitcnt lgkmcnt(0)":::"memory");
    #pragma unroll
    for(int i=0;i<4;++i){const int row=i*8+(lane>>3),ch=lane&7; const u32x4 v=*(const u32x4*)(stg+row*64+ch*8); ATTN_STORE16(Ow+(long)row*OPITCH+ch*8,v);} }
  asm volatile("s_waitcnt lgkmcnt(0)\n\ts_barrier":::"memory");
  #undef DMA_K
  #undef DMA_V
  #undef CMASK
  #undef BIAS
  #undef BIASINIT
  #undef START
  #undef RESC
  #undef ROT
}
constexpr int SB_NS=8, SB_V=65536, SB_FLAGS=131072;
__device__ __forceinline__ void sb_unit(int qb,const bf16*Q,const bf16*__restrict__ K,const bf16*__restrict__ V,bf16*O,char*shm){
  int tid_=threadIdx.x; asm volatile("":"+v"(tid_)); const int tid=tid_,lane=tid&63,r32=lane&31,hi=lane>>5; const int wid=__builtin_amdgcn_readfirstlane(tid>>6);
  const int q0=qb*QB;
  const bf16*Qw=Q+(long)(q0+wid*QBLK)*DM;
  const unsigned lds0=(unsigned)(uintptr_t)shm;
  typedef __attribute__((address_space(3))) int lds_i32; typedef __attribute__((address_space(3))) const u32x4* lds_u4ptr;
  lds_i32*flags=(lds_i32*)((lds_cptr)shm+SB_FLAGS);
  const bf16*ksrc=K+(long)lane*DM+wid*8;
  const bf16*vsrc=V+(long)(16*(wid&3)+(lane>>2))*DM+(wid>>2)*32+(lane&3)*8;
  const unsigned kdst=lds0+wid*1024, vdst=lds0+SB_V+wid*1024;
  #define DMA_K(t,slot) glds16(ksrc+(long)(t)*KVBLK*DM,(unsigned)__builtin_amdgcn_readfirstlane(kdst+(slot)))
  #define DMA_V(t,slot) glds16(vsrc+(long)(t)*KVBLK*DM,(unsigned)__builtin_amdgcn_readfirstlane(vdst+(slot)))
  const int vb0=(int)(lds0+SB_V)+((lane>>4)&1)*32+(lane&3)*8+(4*hi+((lane&15)>>2))*64;
  const int NT=(q0+QB)/KVBLK;
  bf16x8 qr[4];
  #pragma unroll
  for(int d0=0;d0<4;++d0)qr[d0]=*reinterpret_cast<const bf16x8*>(&Qw[(long)r32*DM+d0*16+hi*8]);
  f32x16 o[2];o[0]=f32x16{};o[1]=f32x16{};
  float T=1.0f; const int t_abs=q0+wid*QBLK+r32; bool wdone=false;
  for(int jtop=NT-1;;jtop-=SB_NS){
    const int nb=(jtop+1<SB_NS)?jtop+1:SB_NS;
    for(int s=0;s<nb;++s){DMA_K(jtop-s,s*SLOTB);DMA_V(jtop-s,s*SLOTB);}
    WAIT_BAR(0);
    int s=(jtop==NT-1)?3-(wid>>1):0;
    for(;s<nb&&!wdone;++s){
      const int jt=jtop-s; const int slot=s*SLOTB; const bool band=(jt>=NT-4);
      f32x16 x0,x1; { f32x16 zero=f32x16{}; qkt(x0,x1,shm+slot,qr,zero,r32,hi); }
      f32x16 n0,n1;
      const int kb=64*jt+4*hi;
      #pragma unroll
      for(int r=0;r<16;++r){
        const float z0=x0[r],z1=x1[r];
        const float e0=__builtin_amdgcn_exp2f(-__builtin_fabsf(z0)), e1=__builtin_amdgcn_exp2f(-__builtin_fabsf(z1));
        const float r0=__builtin_amdgcn_rcpf(1.0f+e0), r1=__builtin_amdgcn_rcpf(1.0f+e1), er0=e0*r0, er1=e1*r1;
        float b0=z0>0.f?r0:er0, m0=z0>0.f?er0:r0, b1=z1>0.f?r1:er1, m1=z1>0.f?er1:r1;
        if(band){ const int kv=kb+(r&3)+8*(r>>2); if(!(kv<t_abs)){b0=0.f;m0=1.f;} if(!(kv+32<t_abs)){b1=0.f;m1=1.f;} }
        x0[r]=b0;x1[r]=b1;n0[r]=m0;n1[r]=m1;
      }
      float g0[4],g1[4],p0s[4],p1s[4];
      #pragma unroll
      for(int a=0;a<4;++a){ g0[a]=(n0[4*a]*n0[4*a+1])*(n0[4*a+2]*n0[4*a+3]); g1[a]=(n1[4*a]*n1[4*a+1])*(n1[4*a+2]*n1[4*a+3]);
        { auto rr=__builtin_amdgcn_permlane32_swap(__float_as_uint(g0[a]),__float_as_uint(g0[a]),false,false); p0s[a]=__uint_as_float(hi?rr[0]:rr[1]); }
        { auto rr=__builtin_amdgcn_permlane32_swap(__float_as_uint(g1[a]),__float_as_uint(g1[a]),false,false); p1s[a]=__uint_as_float(hi?rr[0]:rr[1]); } }
      float run=T;
      #pragma unroll
      for(int a=3;a>=0;--a){ const float off=hi?run:run*p1s[a]; run*=g1[a]*p1s[a];
        const float t3=off,t2=t3*n1[4*a+3],t1=t2*n1[4*a+2],t0=t1*n1[4*a+1];
        x1[4*a+3]*=t3; x1[4*a+2]*=t2; x1[4*a+1]*=t1; x1[4*a]*=t0; }
      #pragma unroll
      for(int a=3;a>=0;--a){ const float off=hi?run:run*p0s[a]; run*=g0[a]*p0s[a];
        const float t3=off,t2=t3*n0[4*a+3],t1=t2*n0[4*a+2],t0=t1*n0[4*a+1];
        x0[4*a+3]*=t3; x0[4*a+2]*=t2; x0[4*a+1]*=t1; x0[4*a]*=t0; }
      T=run;
      u32x4 pw0,pw1,pw2,pw3;
      pw0=(u32x4){cvtpk_s(x0[0],x0[1]),cvtpk_s(x0[2],x0[3]),cvtpk_s(x0[4],x0[5]),cvtpk_s(x0[6],x0[7])};
      pw1=(u32x4){cvtpk_s(x0[8],x0[9]),cvtpk_s(x0[10],x0[11]),cvtpk_s(x0[12],x0[13]),cvtpk_s(x0[14],x0[15])};
      pw2=(u32x4){cvtpk_s(x1[0],x1[1]),cvtpk_s(x1[2],x1[3]),cvtpk_s(x1[4],x1[5]),cvtpk_s(x1[6],x1[7])};
      pw3=(u32x4){cvtpk_s(x1[8],x1[9]),cvtpk_s(x1[10],x1[11]),cvtpk_s(x1[12],x1[13]),cvtpk_s(x1[14],x1[15])};
      SBAR(); pv(o,vb0+slot,__builtin_bit_cast(bf16x8,pw0),__builtin_bit_cast(bf16x8,pw1),__builtin_bit_cast(bf16x8,pw2),__builtin_bit_cast(bf16x8,pw3));
      wdone=__all(T<1.2e-38f);
    }
    if(lane==0)flags[wid]=wdone?1:0;
    WAIT_BAR(0);
    const u32x4 f0=*(lds_u4ptr)(flags), f1=*(lds_u4ptr)(flags+4);
    const bool alld=((f0.x&f0.y&f0.z&f0.w)&(f1.x&f1.y&f1.z&f1.w))!=0;
    if(alld||jtop<SB_NS)break;
    WAIT_BAR(0);
  }
  bf16*Ow=O+(long)(q0+wid*QBLK)*OPITCH;
  { bf16*stg=(bf16*)(shm)+wid*2048;
    #pragma unroll
    for(int r=0;r<16;++r){const int orow=crow(r,hi);
      #pragma unroll
      for(int d0=0;d0<2;++d0)stg[orow*64+d0*32+r32]=__float2bfloat16(o[d0][r]);}
    asm volatile("s_waitcnt lgkmcnt(0)":::"memory");
    #pragma unroll
    for(int i=0;i<4;++i){const int row=i*8+(lane>>3),ch=lane&7; const u32x4 v=*(const u32x4*)(stg+row*64+ch*8); ATTN_STORE16(Ow+(long)row*OPITCH+ch*8,v);} }
  asm volatile("s_waitcnt lgkmcnt(0)\n\ts_barrier":::"memory");
  #undef DMA_K
  #undef DMA_V
}
#undef SBAR
#undef WAIT_BAR
}

constexpr int BATCH = 8, SEQ = 4096, DM = 1024, DEPTH = 4, M = BATCH * SEQ, INC = 3334, NIN = 3584, DFF = 4096;
constexpr float EPS = 1e-6f;
constexpr size_t MiB = 1u << 20;
constexpr size_t WS_BAR = 128 * 1024;
constexpr size_t WS_SS = 1 * MiB;
constexpr size_t WS_LB = 3 * MiB;
constexpr size_t WS_JS = 3 * MiB + 256 * 1024;
constexpr size_t WS_DD = 3 * MiB + 512 * 1024;
constexpr size_t WS_W = 4 * MiB;
constexpr size_t W_LAYER = 25 * MiB, W_OUT = 7 * MiB, W_1 = 9 * MiB, W_2 = 17 * MiB;
constexpr size_t WS_XB = 104 * MiB;
constexpr size_t WS_P = 168 * MiB;
constexpr size_t P_HQ = 0, P_HK = 16 * MiB, P_HI = 32 * MiB, P_HG = 48 * MiB, P_HLF = 64 * MiB, P_SQ = 96 * MiB, P_FQ = 168 * MiB, P_LF = 240 * MiB, P_CC = 241 * MiB, P_US = 242 * MiB;
constexpr size_t HEADBUF = 24 * MiB;
constexpr size_t WS_MIX = 442 * MiB;
constexpr size_t WS_U = 168 * MiB;
constexpr size_t WS_END = 506 * MiB;
constexpr int LDS_BYTES = 147456;

typedef pg8::bf16_t bf16_t;
typedef pg8::f32x4 f32x4;
typedef unsigned u32x4 __attribute__((ext_vector_type(4)));
typedef unsigned u32x2 __attribute__((ext_vector_type(2)));
#define LAS __attribute__((address_space(3)))

__device__ __forceinline__ unsigned f2bf(float f) { unsigned u = __builtin_bit_cast(unsigned, f); return (u + 0x7fffu + ((u >> 16) & 1u)) >> 16; }
__device__ __forceinline__ unsigned pk2(float lo, float hi) { return pg8::cvt_pk_bf16(lo, hi); }
__device__ __forceinline__ float bf2f(unsigned short b) { return __builtin_bit_cast(float, (unsigned)b << 16); }
__device__ __forceinline__ float bflo(unsigned w) { return __builtin_bit_cast(float, w << 16); }
__device__ __forceinline__ float bfhi(unsigned w) { return __builtin_bit_cast(float, w & 0xffff0000u); }
__device__ __forceinline__ float logsig(float x) { return fminf(x, 0.f) - log1pf(expf(-fabsf(x))); }
__device__ __forceinline__ float wave_sum(float v) {
#pragma unroll
    for (int o = 1; o < 64; o <<= 1) v += __shfl_xor(v, o);
    return v;
}
#define ROWSCALES8(rs, ss, row0, fq) float rs[2][4]; _Pragma("unroll") for (int ai_ = 0; ai_ < 2; ++ai_) _Pragma("unroll") for (int m_ = 0; m_ < 4; ++m_) rs[ai_][m_] = rowscale(ss, (row0) + ai_ * 128 + m_ * 16, fq);
__device__ __forceinline__ float rowscale(const float* ss, int row, int fq) {
    const f32x4 p = *(const f32x4*)(ss + (size_t)row * 16 + 4 * fq);
    float s = (p[0] + p[1]) + (p[2] + p[3]);
    s += __shfl_xor(s, 16); s += __shfl_xor(s, 32);
    return rsqrtf(s * (1.0f / DM) + EPS);
}

#define ROWFENCE() asm volatile("" ::: "memory")
struct EpiResid {
    static constexpr bool PERM = true, AFTER_DRAIN = false;
    bf16_t* xb; float* outf; float* ss;
    __device__ __forceinline__ void operator()(const f32x4 (&acc)[2][2][4][2], const pg8::Unit& u, int wr, int wc, int fr, int fq) const {
        const int row0 = u.pm * 256 + wr * 64 + fr, col0 = u.pn * 256 + wc * 32 + 8 * fq;
#pragma unroll
        for (int ai = 0; ai < 2; ++ai) {
            u32x4 pre[4][2];
#pragma unroll
            for (int m = 0; m < 4; ++m)
#pragma unroll
                for (int bj = 0; bj < 2; ++bj) pre[m][bj] = *(const u32x4*)(xb + (size_t)(row0 + ai * 128 + m * 16) * DM + col0 + bj * 128);
#pragma unroll
            for (int m = 0; m < 4; ++m) {
                const int row = row0 + ai * 128 + m * 16; float sq = 0.f;
#pragma unroll
                for (int bj = 0; bj < 2; ++bj) {
                    const size_t off = (size_t)row * DM + col0 + bj * 128; const u32x4 p = pre[m][bj];
                    const f32x4 v0 = acc[ai][bj][m][0] + (f32x4){bflo(p.x), bfhi(p.x), bflo(p.y), bfhi(p.y)}, v1 = acc[ai][bj][m][1] + (f32x4){bflo(p.z), bfhi(p.z), bflo(p.w), bfhi(p.w)};
                    if (outf) { *(f32x4*)(outf + off) = v0; *(f32x4*)(outf + off + 4) = v1; }
                    else {
                        u32x4 w; w.x = pk2(v0[0], v0[1]); w.y = pk2(v0[2], v0[3]); w.z = pk2(v1[0], v1[1]); w.w = pk2(v1[2], v1[3]);
                        *(u32x4*)(xb + off) = w;
                        sq += (v0[0] * v0[0] + v0[1] * v0[1]) + (v0[2] * v0[2] + v0[3] * v0[3]) + (v1[0] * v1[0] + v1[1] * v1[1]) + (v1[2] * v1[2] + v1[3] * v1[3]);
                    }
                }
                if (!outf) {
                    sq += __shfl_xor(sq, 16); sq += __shfl_xor(sq, 32);
                    if (fq == 0) ss[(size_t)row * 16 + u.pn * 4 + wc] = sq;
                }
            }
            ROWFENCE();
        }
    }
};
struct EpiRelu2 {
    static constexpr bool PERM = true, AFTER_DRAIN = false;
    bf16_t* U; const float* ss;
    __device__ __forceinline__ void operator()(const f32x4 (&acc)[2][2][4][2], const pg8::Unit& u, int wr, int wc, int fr, int fq) const {
        const int row0 = u.pm * 256 + wr * 64 + fr, col0 = u.pn * 256 + wc * 32 + 8 * fq;
        ROWSCALES8(rs8, ss, row0, fq)
#pragma unroll
        for (int ai = 0; ai < 2; ++ai)
#pragma unroll
            for (int m = 0; m < 4; ++m) {
                const int row = row0 + ai * 128 + m * 16; const float rs = rs8[ai][m];
#pragma unroll
                for (int bj = 0; bj < 2; ++bj) {
                    f32x4 v0 = acc[ai][bj][m][0] * rs, v1 = acc[ai][bj][m][1] * rs;
                    v0 = __builtin_elementwise_max(v0, (f32x4){0.f, 0.f, 0.f, 0.f}); v1 = __builtin_elementwise_max(v1, (f32x4){0.f, 0.f, 0.f, 0.f});
                    v0 = v0 * v0; v1 = v1 * v1;
                    u32x4 w; w.x = pk2(v0[0], v0[1]); w.y = pk2(v0[2], v0[3]); w.z = pk2(v1[0], v1[1]); w.w = pk2(v1[2], v1[3]);
                    *(u32x4*)(U + (size_t)row * DFF + col0 + bj * 128) = w;
                }
                ROWFENCE();
            }
    }
};
struct EpiInProj {
    static constexpr bool PERM = true, AFTER_DRAIN = false;
    const float* ss; unsigned char* P; const float* lbt;
    const float* gt; const float* fbias;
    __device__ __forceinline__ void operator()(const f32x4 (&acc)[2][2][4][2], const pg8::Unit& u, int wr, int wc, int fr, int fq) const {
        const int slot = u.pn * 4 + wc;
        if (slot > 52) return;
        const int row0 = u.pm * 256 + wr * 64 + fr;
        ROWSCALES8(rs8, ss, row0, fq)
        if (slot < 16) {
            const int kind = slot >> 2, cb = (slot & 3) * 64 + 8 * fq;
            if (kind == 1) {
                float* HLF = (float*)(P + P_HLF); bf16_t* HK = (bf16_t*)(P + P_HK);
#pragma unroll
                for (int ai = 0; ai < 2; ++ai)
#pragma unroll
                    for (int m = 0; m < 4; ++m) {
                        const int row = row0 + ai * 128 + m * 16; const float rs = rs8[ai][m];
#pragma unroll
                        for (int bj = 0; bj < 2; ++bj) {
                            float lf[8], kk[8];
#pragma unroll
                            for (int n = 0; n < 2; ++n) {
                                const f32x4 ll = *(const f32x4*)(lbt + cb + 32 * bj + 4 * n), om = *(const f32x4*)(lbt + 256 + cb + 32 * bj + 4 * n);
#pragma unroll
                                for (int i = 0; i < 4; ++i) {
                                    const float fl = acc[ai][bj][m][n][i] * rs;
                                    const float a = fminf(fl, 0.f) - __logf(1.0f + __expf(-fabsf(fl)));
                                    const float an = a - fl;
                                    const float b = ll[i] + an;
                                    lf[4 * n + i] = fmaxf(a, b) + __logf(1.0f + __expf(-fabsf(a - b)));
                                    kk[4 * n + i] = om[i] * __expf(an);
                                }
                            }
                            const size_t off = (size_t)row * 256 + cb + 32 * bj;
                            *(f32x4*)(HLF + off) = (f32x4){lf[0], lf[1], lf[2], lf[3]}; *(f32x4*)(HLF + off + 4) = (f32x4){lf[4], lf[5], lf[6], lf[7]};
                            u32x4 w; w.x = pk2(kk[0], kk[1]); w.y = pk2(kk[2], kk[3]); w.z = pk2(kk[4], kk[5]); w.w = pk2(kk[6], kk[7]);
                            *(u32x4*)(HK + off) = w;
                        }
                        ROWFENCE();
                    }
            } else {
                bf16_t* dst = (bf16_t*)(P + (kind == 0 ? P_HQ : (kind == 2 ? P_HI : P_HG)));
#pragma unroll
                for (int ai = 0; ai < 2; ++ai)
#pragma unroll
                    for (int m = 0; m < 4; ++m) {
                        const int row = row0 + ai * 128 + m * 16; const float rs = rs8[ai][m];
#pragma unroll
                        for (int bj = 0; bj < 2; ++bj) {
                            const f32x4 v0 = acc[ai][bj][m][0] * rs, v1 = acc[ai][bj][m][1] * rs;
                            u32x4 w; w.x = pk2(v0[0], v0[1]); w.y = pk2(v0[2], v0[3]); w.z = pk2(v1[0], v1[1]); w.w = pk2(v1[2], v1[3]);
                            *(u32x4*)(dst + (size_t)row * 256 + cb + 32 * bj) = w;
                        }
                        ROWFENCE();
                    }
            }
        } else if (slot < 52) {
            const int s2 = slot - 16, grp = s2 / 6, h = s2 % 6, role = grp % 3;
            bf16_t* dst = (bf16_t*)(P + P_SQ + (size_t)grp * HEADBUF) + (size_t)((u.pm >> 4) * 6 + h) * SEQ * 64 + 8 * fq;
            const float* gp = gt + (grp - (grp >= 3 ? 1 : 0)) * 64 + 8 * fq;
            const float qs = (role == 0) ? 0.125f * 1.4426950408889634f : 1.0f;
            f32x4 gv[2][2];
#pragma unroll
            for (int bj = 0; bj < 2; ++bj)
#pragma unroll
                for (int n = 0; n < 2; ++n) gv[bj][n] = (role != 2) ? *(const f32x4*)(gp + 32 * bj + 4 * n) * qs : (f32x4){1.f, 1.f, 1.f, 1.f};
#pragma unroll
            for (int ai = 0; ai < 2; ++ai)
#pragma unroll
                for (int m = 0; m < 4; ++m) {
                    const int row = row0 + ai * 128 + m * 16; const float rs = rs8[ai][m];
                    float fac = rs;
                    if (role != 2) {
                        float sq = 0.f;
#pragma unroll
                        for (int bj = 0; bj < 2; ++bj)
#pragma unroll
                            for (int n = 0; n < 2; ++n) { const f32x4 x = acc[ai][bj][m][n]; sq += (x[0] * x[0] + x[1] * x[1]) + (x[2] * x[2] + x[3] * x[3]); }
                        sq += __shfl_xor(sq, 16); sq += __shfl_xor(sq, 32);
                        fac = rs * rsqrtf(rs * rs * sq * (1.0f / 64.0f) + EPS);
                    }
                    const int t = row & (SEQ - 1);
#pragma unroll
                    for (int bj = 0; bj < 2; ++bj) {
                        const f32x4 v0 = acc[ai][bj][m][0] * fac * gv[bj][0], v1 = acc[ai][bj][m][1] * fac * gv[bj][1];
                        u32x4 w; w.x = pk2(v0[0], v0[1]); w.y = pk2(v0[2], v0[3]); w.z = pk2(v1[0], v1[1]); w.w = pk2(v1[2], v1[3]);
                        *(u32x4*)(dst + (size_t)t * 64 + 32 * bj) = w;
                    }
                    ROWFENCE();
                }
        } else {
            float* LF = (float*)(P + P_LF);
#pragma unroll
            for (int ai = 0; ai < 2; ++ai)
#pragma unroll
                for (int m = 0; m < 4; ++m) {
                    const int row = row0 + ai * 128 + m * 16; const float rs = rs8[ai][m];
                    if (fq == 0) {
                        const f32x4 a0 = acc[ai][0][m][0], a1 = acc[ai][0][m][1];
                        *(f32x4*)(LF + (size_t)row * 8) = (f32x4){logsig(a0[0] * rs + fbias[0]), logsig(a0[1] * rs + fbias[1]), logsig(a0[2] * rs + fbias[2]), logsig(a0[3] * rs + fbias[3])};
                        *(f32x4*)(LF + (size_t)row * 8 + 4) = (f32x4){logsig(a1[0] * rs + fbias[4]), logsig(a1[1] * rs + fbias[5]), 0.f, 0.f};
                    }
                    ROWFENCE();
                }
        }
    }
};
#define XB_TMO      128
#define XB_XCNT(j)  (256  + 64 * (j))
#define XB_XSUB(j)  (1280 + 64 * (j))
#define XB_XGEN(j)  (2304 + 64 * (j))
#define XB_TOP      3328
#define XB_TOPGEN   3392
#define XCD_BAR_WORDS 3456
#define XB_SPIN_CAP (1u << 18)

__device__ __forceinline__ unsigned xb_ld(unsigned* p)              { return __hip_atomic_load(p, __ATOMIC_RELAXED, __HIP_MEMORY_SCOPE_AGENT); }
__device__ __forceinline__ unsigned xb_add(unsigned* p, unsigned v) { return __hip_atomic_fetch_add(p, v, __ATOMIC_RELAXED, __HIP_MEMORY_SCOPE_AGENT); }
__device__ __forceinline__ unsigned xb_xcc_id() { return (unsigned)__builtin_amdgcn_s_getreg((3 << 11) | 20) & 0xFu; }
#define XB_SPIN(cond, bar) do { unsigned _sp = 0; while (cond) { __builtin_amdgcn_s_sleep(1); \
    if ((++_sp & 255u) == 0u) { if (xb_ld(&(bar)[XB_TMO])) break; if (_sp > XB_SPIN_CAP) { atomicAdd(&(bar)[XB_TMO], 1u); break; } } } } while (0)

struct XcdBarrier {
    unsigned* bar; unsigned x;
    volatile LAS unsigned* st;
};

__device__ __forceinline__ XcdBarrier xcd_barrier_post(unsigned* bar, volatile LAS unsigned* st) {
    XcdBarrier b; b.bar = bar; b.x = xb_xcc_id(); b.st = st;
    if (threadIdx.x == 0) (void)xb_add(&bar[XB_XCNT(b.x)], 1u);
    return b;
}
__device__ __forceinline__ void xcd_barrier_complete(unsigned* bar, unsigned x, unsigned& nloc, unsigned& nx) {
    const unsigned G = gridDim.x * gridDim.y * gridDim.z;
    unsigned sum, cnt, mine, sp = 0u;
    for (;;) {
        sum = 0u; cnt = 0u; mine = 0u;
#pragma unroll
        for (unsigned j = 0; j < 16; ++j) { const unsigned c = xb_ld(&bar[XB_XCNT(j)]); sum += c; cnt += (c > 0u) ? 1u : 0u; mine = (j == x) ? c : mine; }
        if (sum == G) break;
        __builtin_amdgcn_s_sleep(1);
        if ((++sp & 255u) == 0u) { if (xb_ld(&bar[XB_TMO])) break; if (sp > XB_SPIN_CAP) { atomicAdd(&bar[XB_TMO], 1u); break; } }
    }
    nloc = mine > 0u ? mine : 1u; nx = cnt > 0u ? cnt : 1u;
}

__device__ __forceinline__ void xcd_barrier(const XcdBarrier& b) {
    asm volatile("s_waitcnt vmcnt(0)" ::: "memory");
    __syncthreads();
    if (threadIdx.x == 0) {
        unsigned* bar = b.bar;
        __builtin_amdgcn_s_waitcnt(0);
        unsigned nloc = b.st[0], nx = b.st[1];
        if (nloc == 0u) { xcd_barrier_complete(bar, b.x, nloc, nx); b.st[0] = nloc; b.st[1] = nx; }
        const unsigned old = xb_add(&bar[XB_XSUB(b.x)], 1u);
        const unsigned gen = old / nloc;
        if (old + 1u == (gen + 1u) * nloc) {
            __builtin_amdgcn_fence(__ATOMIC_RELEASE, "agent");
            asm volatile("s_waitcnt vmcnt(0)" ::: "memory");
            const unsigned og = xb_add(&bar[XB_TOP], 1u);
            const unsigned tg = og / nx;
            if (og + 1u == (tg + 1u) * nx) xb_add(&bar[XB_TOPGEN], 1u);
            else XB_SPIN(xb_ld(&bar[XB_TOPGEN]) == tg, bar);
            __builtin_amdgcn_fence(__ATOMIC_ACQUIRE, "agent");
            xb_add(&bar[XB_XGEN(b.x)], 1u);
            asm volatile("s_waitcnt vmcnt(0)" ::: "memory");
        } else {
            XB_SPIN(xb_ld(&bar[XB_XGEN(b.x)]) == gen, bar);
            __builtin_amdgcn_fence(__ATOMIC_ACQUIRE, "agent");
            asm volatile("s_waitcnt vmcnt(0)" ::: "memory");
        }
    }
    __syncthreads();
}

__device__ __forceinline__ void tr_item(const float* W, int ldw, int ncols_valid, int src_col0, int k0, const float* gain, bf16_t* WT, int K, int n0, LAS float* scr, int lane) {
#pragma unroll 8
    for (int i = 0; i < 32; ++i) { const int kk = 2 * i + (lane >> 5), c = src_col0 + (lane & 31);
        float v = (c < ncols_valid) ? W[(size_t)(k0 + kk) * ldw + c] : 0.f; if (gain) v *= gain[k0 + kk]; scr[kk * 33 + (lane & 31)] = v; }
    asm volatile("s_waitcnt lgkmcnt(0)" ::: "memory");
    const int c = lane & 7;
#pragma unroll
    for (int j = 0; j < 4; ++j) { const int n = (lane >> 3) + 8 * j; const LAS float* s = scr + (8 * c) * 33 + n;
        u32x4 o; o.x = pk2(s[0 * 33], s[1 * 33]); o.y = pk2(s[2 * 33], s[3 * 33]); o.z = pk2(s[4 * 33], s[5 * 33]); o.w = pk2(s[6 * 33], s[7 * 33]);
        *(u32x4*)(WT + (size_t)(n0 + n) * K + k0 + 8 * c) = o; }
    asm volatile("s_waitcnt lgkmcnt(0)" ::: "memory");
}

__device__ __forceinline__ void unpack8(const u32x4 w, float* d) { d[0] = bflo(w.x); d[1] = bfhi(w.x); d[2] = bflo(w.y); d[3] = bfhi(w.y); d[4] = bflo(w.z); d[5] = bfhi(w.z); d[6] = bflo(w.w); d[7] = bfhi(w.w); }

__device__ __forceinline__ void fox_cumsum_item(int bh, const float* LF, float* CC, int* JS, const float* gq, const float* gk, LAS float* sc) {
    int tid_ = threadIdx.x; asm volatile("" : "+v"(tid_)); const int tid = tid_, lane = tid & 63, wave = tid >> 6, b = bh / 6, h = bh % 6;
    float v[8]; float run = 0.f;
#pragma unroll
    for (int i = 0; i < 8; ++i) { run += LF[((size_t)b * SEQ + tid * 8 + i) * 8 + h]; v[i] = run; }
    float s = run;
#pragma unroll
    for (int o = 1; o < 64; o <<= 1) { const float n = __shfl_up(s, o); if (lane >= o) s += n; }
    __syncthreads();
    if (lane == 63) sc[wave] = s;
    __syncthreads();
    float base = s - run;
    for (int w = 0; w < wave; ++w) base += sc[w];
    LAS float* cl = sc + 64;
#pragma unroll
    for (int i = 0; i < 8; ++i) { const float c2 = (v[i] + base) * 1.4426950408889634f; CC[(size_t)bh * SEQ + tid * 8 + i] = c2; cl[tid * 8 + i] = c2; }
    __syncthreads();
    if (tid < 16) {
        float mq = 0.f, mk = 0.f;
        for (int d = 0; d < 64; ++d) { mq = fmaxf(mq, fabsf(gq[d])); mk = fmaxf(mk, fabsf(gk[d])); }
        const float zb = 1.4426950408889634f * 8.0f * mq * mk * 1.03f + 1.0f;
        const float thr = -(150.0f + 2.0f * zb);
        const int q0 = tid * 256, nt = q0 / 64 + 4; const float cq = cl[q0];
        int j = 0; while (j < nt - 4 && cq - cl[64 * j + 63] < thr) ++j;
        JS[bh * 16 + tid] = j & ~1;
    }
    __syncthreads();
}

__device__ __forceinline__ void stage_kv(const bf16_t* Kb, const bf16_t* Vb, int kt, LAS float* Kf, LAS float* Vf) {
    int tid_ = threadIdx.x; asm volatile("" : "+v"(tid_)); const int tid = tid_, key = tid >> 3, c8 = tid & 7;
    const u32x4 kw = *(const u32x4*)(Kb + ((size_t)(kt * 64 + key)) * 64 + c8 * 8), vw = *(const u32x4*)(Vb + ((size_t)(kt * 64 + key)) * 64 + c8 * 8);
    float kf[8], vf[8]; unpack8(kw, kf); unpack8(vw, vf);
    *(LAS f32x4*)(Kf + key * 64 + c8 * 8) = (f32x4){kf[0], kf[1], kf[2], kf[3]}; *(LAS f32x4*)(Kf + key * 64 + c8 * 8 + 4) = (f32x4){kf[4], kf[5], kf[6], kf[7]};
    *(LAS f32x4*)(Vf + key * 64 + c8 * 8) = (f32x4){vf[0], vf[1], vf[2], vf[3]}; *(LAS f32x4*)(Vf + key * 64 + c8 * 8 + 4) = (f32x4){vf[4], vf[5], vf[6], vf[7]};
}

__device__ __forceinline__ void fox_naive_item(int item, unsigned char* P, bf16_t* MIX, LAS float* lds) {
    int tid_ = threadIdx.x; asm volatile("" : "+v"(tid_)); const int tid = tid_, bh = item >> 3, qblk = item & 7, b = bh / 6, h = bh % 6, t = qblk * 512 + tid;
    const bf16_t* Qp = (const bf16_t*)(P + P_FQ) + ((size_t)bh * SEQ + t) * 64;
    const bf16_t* Kb = (const bf16_t*)(P + P_FQ + HEADBUF) + (size_t)bh * SEQ * 64;
    const bf16_t* Vb = (const bf16_t*)(P + P_FQ + 2 * HEADBUF) + (size_t)bh * SEQ * 64;
    const float* CC = (const float*)(P + P_CC) + (size_t)bh * SEQ;
    float q[64], o[64];
#pragma unroll
    for (int c = 0; c < 8; ++c) unpack8(*(const u32x4*)(Qp + c * 8), q + c * 8);
#pragma unroll
    for (int d = 0; d < 64; ++d) o[d] = 0.f;
    float m = -1e30f, l = 0.f; const float ct = CC[t];
    LAS float* Kf = lds; LAS float* Vf = lds + 4096; LAS float* cs = lds + 8192;
    const int ntile = (qblk + 1) * 8;
    for (int kt = 0; kt < ntile; ++kt) {
        __syncthreads();
        stage_kv(Kb, Vb, kt, Kf, Vf); if (tid < 64) cs[tid] = CC[kt * 64 + tid];
        __syncthreads();
        for (int s = 0; s < 64; ++s) {
            float z = 0.f;
#pragma unroll
            for (int d = 0; d < 64; ++d) z += q[d] * Kf[s * 64 + d];
            const float x = (kt * 64 + s <= t) ? z + (ct - cs[s]) : -1e30f;
            const float mn = fmaxf(m, x), sc = __expf(m - mn), p = __expf(x - mn);
            l = l * sc + p;
#pragma unroll
            for (int d = 0; d < 64; ++d) o[d] = o[d] * sc + p * Vf[s * 64 + d];
            m = mn;
        }
    }
    const float inv = 1.0f / l;
    bf16_t* op = MIX + ((size_t)b * SEQ + t) * DM + 640 + h * 64;
#pragma unroll
    for (int c = 0; c < 8; ++c) { u32x4 w; w.x = pk2(o[c * 8] * inv, o[c * 8 + 1] * inv); w.y = pk2(o[c * 8 + 2] * inv, o[c * 8 + 3] * inv); w.z = pk2(o[c * 8 + 4] * inv, o[c * 8 + 5] * inv); w.w = pk2(o[c * 8 + 6] * inv, o[c * 8 + 7] * inv); *(u32x4*)(op + c * 8) = w; }
}

__device__ __forceinline__ void sb_naive_item(int item, unsigned char* P, bf16_t* MIX, LAS float* lds) {
    int tid_ = threadIdx.x; asm volatile("" : "+v"(tid_)); const int tid = tid_, bh = item >> 3, qblk = item & 7, b = bh / 6, h = bh % 6, t = qblk * 512 + tid;
    const bf16_t* Qp = (const bf16_t*)(P + P_SQ) + ((size_t)bh * SEQ + t) * 64;
    const bf16_t* Kb = (const bf16_t*)(P + P_SQ + HEADBUF) + (size_t)bh * SEQ * 64;
    const bf16_t* Vb = (const bf16_t*)(P + P_SQ + 2 * HEADBUF) + (size_t)bh * SEQ * 64;
    float q[64], o[64];
#pragma unroll
    for (int c = 0; c < 8; ++c) unpack8(*(const u32x4*)(Qp + c * 8), q + c * 8);
#pragma unroll
    for (int d = 0; d < 64; ++d) o[d] = 0.f;
    float tail = 0.f;
    LAS float* Kf = lds; LAS float* Vf = lds + 4096;
    for (int kt = qblk * 8 + 7; kt >= 0; --kt) {
        __syncthreads();
        stage_kv(Kb, Vb, kt, Kf, Vf);
        __syncthreads();
        for (int s = 63; s >= 0; --s) {
            float z = 0.f;
#pragma unroll
            for (int d = 0; d < 64; ++d) z += q[d] * Kf[s * 64 + d];
            const float ls = fminf(z, 0.f) - __logf(1.0f + __expf(-fabsf(z)));
            const bool act = (kt * 64 + s) < t;
            const float A = act ? __expf(ls + tail) : 0.f;
#pragma unroll
            for (int d = 0; d < 64; ++d) o[d] += A * Vf[s * 64 + d];
            tail += act ? (ls - z) : 0.f;
        }
        if (__syncthreads_and(tail < -100.f)) break;
    }
    bf16_t* op = MIX + ((size_t)b * SEQ + t) * DM + 256 + h * 64;
#pragma unroll
    for (int c = 0; c < 8; ++c) { u32x4 w; w.x = pk2(o[c * 8], o[c * 8 + 1]); w.y = pk2(o[c * 8 + 2], o[c * 8 + 3]); w.z = pk2(o[c * 8 + 4], o[c * 8 + 5]); w.w = pk2(o[c * 8 + 6], o[c * 8 + 7]); *(u32x4*)(op + c * 8) = w; }
}

__device__ __forceinline__ void hgrn_naive_item(int item, unsigned char* P, bf16_t* MIX, const float* hgn, LAS float* lds) {
    int tid_ = threadIdx.x; asm volatile("" : "+v"(tid_)); const int tid = tid_, lane = tid & 63, w = tid >> 6, kg = lane >> 3, vi = lane & 7, vcol = 8 * w + vi, b = item >> 2, h = item & 3;
    const bf16_t* HQ = (const bf16_t*)(P + P_HQ); const bf16_t* HK = (const bf16_t*)(P + P_HK); const bf16_t* HI = (const bf16_t*)(P + P_HI); const bf16_t* HG = (const bf16_t*)(P + P_HG);
    const float* HLF = (const float*)(P + P_HLF);
    LAS float* qf = lds; LAS float* kf = lds + 4096; LAS float* ff = lds + 8192; LAS float* vf = lds + 12288; LAS float* ob = lds + 16384;
    float S[8];
#pragma unroll
    for (int j = 0; j < 8; ++j) S[j] = 0.f;
    const int tok = tid >> 3, c8 = tid & 7;
    float gn[8];
#pragma unroll
    for (int e = 0; e < 8; ++e) gn[e] = hgn[c8 * 8 + e];
    for (int c = 0; c < 64; ++c) {
        const size_t off = ((size_t)b * SEQ + c * 64 + tok) * 256 + h * 64 + c8 * 8;
        __syncthreads();
        {
            float a[8];
            unpack8(*(const u32x4*)(HQ + off), a);
#pragma unroll
            for (int e = 0; e < 8; ++e) qf[tok * 64 + c8 * 8 + e] = a[e];
            unpack8(*(const u32x4*)(HK + off), a);
#pragma unroll
            for (int e = 0; e < 8; ++e) kf[tok * 64 + c8 * 8 + e] = a[e];
            unpack8(*(const u32x4*)(HI + off), a);
#pragma unroll
            for (int e = 0; e < 8; ++e) vf[tok * 64 + c8 * 8 + e] = a[e];
            const f32x4 l0 = *(const f32x4*)(HLF + off), l1 = *(const f32x4*)(HLF + off + 4);
#pragma unroll
            for (int e = 0; e < 4; ++e) { ff[tok * 64 + c8 * 8 + e] = expf(l0[e]); ff[tok * 64 + c8 * 8 + 4 + e] = expf(l1[e]); }
        }
        __syncthreads();
        for (int tk = 0; tk < 64; ++tk) {
            const float vv = vf[tk * 64 + vcol]; float op = 0.f;
#pragma unroll
            for (int j = 0; j < 8; ++j) { const int k = 8 * kg + j; S[j] = ff[tk * 64 + k] * S[j] + kf[tk * 64 + k] * vv; op += qf[tk * 64 + k] * S[j]; }
            op += __shfl_xor(op, 8); op += __shfl_xor(op, 16); op += __shfl_xor(op, 32);
            if (kg == 0) ob[tk * 64 + vcol] = op;
        }
        __syncthreads();
        {
            float ov[8], g[8]; float sq = 0.f;
#pragma unroll
            for (int e = 0; e < 8; ++e) { ov[e] = ob[tok * 64 + c8 * 8 + e]; sq += ov[e] * ov[e]; }
            sq += __shfl_xor(sq, 1); sq += __shfl_xor(sq, 2); sq += __shfl_xor(sq, 4);
            const float rn = rsqrtf(sq * (1.0f / 64.0f) + EPS);
            unpack8(*(const u32x4*)(HG + off), g);
            float r[8];
#pragma unroll
            for (int e = 0; e < 8; ++e) r[e] = ov[e] * rn * gn[e] * (g[e] / (1.0f + expf(-g[e])));
            u32x4 wv; wv.x = pk2(r[0], r[1]); wv.y = pk2(r[2], r[3]); wv.z = pk2(r[4], r[5]); wv.w = pk2(r[6], r[7]);
            *(u32x4*)(MIX + ((size_t)b * SEQ + c * 64 + tok) * DM + h * 64 + c8 * 8) = wv;
        }
    }
}

constexpr int HG_SLOT = 30720, HG_BP = 68  , HG_PRE = 64 * HG_BP * 4, HG_TOT = HG_PRE + 1280, HG_VT = 20480, HG_VP = 72;
static_assert(HG_TOT + 1024 <= HG_VT && HG_VT + 64 * HG_VP * 2 <= HG_SLOT, "HGRN LDS slot map");
typedef short hbf16x8 __attribute__((ext_vector_type(8)));
typedef short hbf16x4 __attribute__((ext_vector_type(4)));
__device__ __forceinline__ hbf16x8 pack8(const float* x) { u32x4 w; w.x = pk2(x[0], x[1]); w.y = pk2(x[2], x[3]); w.z = pk2(x[4], x[5]); w.w = pk2(x[6], x[7]); return __builtin_bit_cast(hbf16x8, w); }

__device__ __forceinline__ void hg_stage(int tid, size_t row0, int h, const float* HLF, const bf16_t* HI, LAS unsigned char* sb) {
    const int lt = tid & 127, k = lt & 63, half = lt >> 6;
    LAS float* bl = (LAS float*)sb; LAS float* pre = (LAS float*)(sb + HG_PRE); LAS float* tot = (LAS float*)(sb + HG_TOT); LAS bf16_t* vt = (LAS bf16_t*)(sb + HG_VT);
    float lfv[32];
#pragma unroll
    for (int i = 0; i < 32; ++i) lfv[i] = HLF[(row0 + 32 * half + i) * 256 + h * 64 + k];
    u32x4 vw[4];
    {
        const int s = lt & 63, c0 = half * 32;
#pragma unroll
        for (int q = 0; q < 4; ++q) vw[q] = *(const u32x4*)(HI + (row0 + s) * 256 + h * 64 + c0 + 8 * q);
    }
#pragma unroll
    for (int sg = 0; sg < 2; ++sg) { float run = 0.f;
#pragma unroll
        for (int i = 0; i < 16; ++i) { run += lfv[16 * sg + i]; bl[(32 * half + 16 * sg + i) * HG_BP + k] = run; }
        tot[(2 * half + sg) * 64 + k] = run; }
    {   const int s = lt & 63, c0 = half * 32;
#pragma unroll
        for (int q = 0; q < 4; ++q) { const unsigned ww[4] = {vw[q].x, vw[q].y, vw[q].z, vw[q].w};
#pragma unroll
            for (int e = 0; e < 4; ++e) { vt[(c0 + 8 * q + 2 * e) * HG_VP + s] = (bf16_t)(ww[e] & 0xffffu); vt[(c0 + 8 * q + 2 * e + 1) * HG_VP + s] = (bf16_t)(ww[e] >> 16); } } }
    __syncthreads();
    if (lt < 64) { float p = 0.f;
#pragma unroll
        for (int sg = 0; sg < 4; ++sg) { pre[sg * 64 + lt] = p; p += tot[sg * 64 + lt]; }
        pre[4 * 64 + lt] = p; }
    __syncthreads();
}

__device__ __forceinline__ void hgrn_a_item(int item, unsigned char* P, float* DD, LAS unsigned char* L) {
    int tid_ = threadIdx.x; asm volatile("" : "+v"(tid_)); const int tid = tid_, lane = tid & 63, wq = (tid >> 6) & 1, cs = tid >> 7, r = lane & 15, g = lane >> 4;
    const int bh = item >> 4, chunk = (item & 15) * 4 + cs, b = bh >> 2, h = bh & 3;
    const size_t row0 = (size_t)b * SEQ + chunk * 64;
    const bf16_t* HK = (const bf16_t*)(P + P_HK); float* UT = (float*)(P + P_US);
    LAS unsigned char* sb = L + cs * HG_SLOT;
    unsigned short kraw[2][2][8];
#pragma unroll
    for (int kt2 = 0; kt2 < 2; ++kt2)
#pragma unroll
        for (int ks = 0; ks < 2; ++ks)
#pragma unroll
            for (int j = 0; j < 8; ++j) kraw[kt2][ks][j] = HK[(row0 + 32 * ks + 8 * g + j) * 256 + h * 64 + 16 * (2 * wq + kt2) + r];
    hg_stage(tid, row0, h, (const float*)(P + P_HLF), (const bf16_t*)(P + P_HI), sb);
    const LAS float* bl = (const LAS float*)sb; const LAS float* pre = (const LAS float*)(sb + HG_PRE); const LAS unsigned char* vt = sb + HG_VT;
    float* ut = UT + ((size_t)(bh * 64 + chunk) * 64) * 64;
#pragma unroll
    for (int kt2 = 0; kt2 < 2; ++kt2) {
        const int kt = 2 * wq + kt2, k = 16 * kt + r; const float pre4 = pre[4 * 64 + k];
        hbf16x8 af[2];
#pragma unroll
        for (int ks = 0; ks < 2; ++ks) { const float pj = pre4 - pre[(2 * ks + (g >> 1)) * 64 + k]; float x[8];
#pragma unroll
            for (int j = 0; j < 8; ++j) { const int s = 32 * ks + 8 * g + j; x[j] = bf2f(kraw[kt2][ks][j]) * __expf(pj - bl[s * HG_BP + k]); }
            af[ks] = pack8(x); }
#pragma unroll
        for (int vtile = 0; vtile < 4; ++vtile) { f32x4 acc = {0.f, 0.f, 0.f, 0.f};
#pragma unroll
            for (int ks = 0; ks < 2; ++ks) { const hbf16x8 bf = *(const LAS hbf16x8*)(vt + (16 * vtile + r) * (HG_VP * 2) + (32 * ks + 8 * g) * 2); acc = __builtin_amdgcn_mfma_f32_16x16x32_bf16(af[ks], bf, acc, 0, 0, 0); }
            *(f32x4*)(ut + (size_t)(16 * vtile + r) * 64 + 16 * kt + 4 * g) = acc; }
        if (g == 0) DD[(size_t)(bh * 64 + chunk) * 64 + k] = __expf(pre4);
    }
}

__device__ __forceinline__ void hgrn_b_scan(int bx, int G, unsigned char* P, const float* DD) {
    int tid_ = threadIdx.x; asm volatile("" : "+v"(tid_));
    float* UT = (float*)(P + P_US);
    for (int gid = bx * 512 + tid_; gid < 32 * 4096; gid += G * 512) {
        const int bh = gid >> 12, e = gid & 4095; float* u = UT + (size_t)bh * 64 * 4096 + e; const float* dd = DD + (size_t)bh * 64 * 64 + (e & 63);
        float S = 0.f;
        for (int c0 = 0; c0 < 64; c0 += 32) { float tu[32], td[32];
#pragma unroll
            for (int i = 0; i < 32; ++i) { tu[i] = u[(size_t)(c0 + i) * 4096]; td[i] = dd[(c0 + i) * 64]; }
#pragma unroll
            for (int i = 0; i < 32; ++i) { u[(size_t)(c0 + i) * 4096] = S; S = td[i] * S + tu[i]; } }
    }
}

__device__ __forceinline__ void hgrn_c_item(int item, unsigned char* P, bf16_t* MIX, const float* hgn, LAS unsigned char* L) {
    int tid_ = threadIdx.x; asm volatile("" : "+v"(tid_)); const int tid = tid_, lane = tid & 63, wq = (tid >> 6) & 1, cs = tid >> 7, r = lane & 15, g = lane >> 4;
    const int bh = item >> 4, chunk = (item & 15) * 4 + cs, b = bh >> 2, h = bh & 3;
    const size_t row0 = (size_t)b * SEQ + chunk * 64;
    const bf16_t* HQ = (const bf16_t*)(P + P_HQ); const bf16_t* HK = (const bf16_t*)(P + P_HK); const bf16_t* HG = (const bf16_t*)(P + P_HG); const float* ST = (const float*)(P + P_US);
    LAS unsigned char* sb = L + cs * HG_SLOT;
    u32x4 qraw[2][2], kraw[4][2]; f32x4 sraw[4][2][2];
    const float* st = ST + ((size_t)(bh * 64 + chunk) * 64) * 64;
#pragma unroll
    for (int ks = 0; ks < 2; ++ks) {
#pragma unroll
        for (int ii = 0; ii < 2; ++ii) { const int I = ii ? (wq ? 2 : 3) : (wq ? 1 : 0); qraw[ii][ks] = *(const u32x4*)(HQ + (row0 + 16 * I + r) * 256 + h * 64 + 32 * ks + 8 * g); }
#pragma unroll
        for (int J = 0; J < 4; ++J) kraw[J][ks] = *(const u32x4*)(HK + (row0 + 16 * J + r) * 256 + h * 64 + 32 * ks + 8 * g);
#pragma unroll
        for (int vtile = 0; vtile < 4; ++vtile) { const float* sp = st + (size_t)(16 * vtile + r) * 64 + 32 * ks + 8 * g; sraw[vtile][ks][0] = *(const f32x4*)sp; sraw[vtile][ks][1] = *(const f32x4*)(sp + 4); } }
    hg_stage(tid, row0, h, (const float*)(P + P_HLF), (const bf16_t*)(P + P_HI), sb);
    const LAS float* bl = (const LAS float*)sb; const LAS float* pre = (const LAS float*)(sb + HG_PRE); const LAS unsigned char* vt = sb + HG_VT;
    hbf16x8 sfr[4][2];
#pragma unroll
    for (int vtile = 0; vtile < 4; ++vtile)
#pragma unroll
        for (int ks = 0; ks < 2; ++ks) { const f32x4 s0 = sraw[vtile][ks][0], s1 = sraw[vtile][ks][1]; const float x[8] = {s0[0], s0[1], s0[2], s0[3], s1[0], s1[1], s1[2], s1[3]}; sfr[vtile][ks] = pack8(x); }
#pragma unroll
    for (int ii = 0; ii < 2; ++ii) {
        const int I = ii ? (wq ? 2 : 3) : (wq ? 1 : 0), t = 16 * I + r;
        unsigned short graw[4][4];
#pragma unroll
        for (int i = 0; i < 4; ++i)
#pragma unroll
            for (int vtile = 0; vtile < 4; ++vtile) graw[i][vtile] = HG[(row0 + 16 * I + 4 * g + i) * 256 + h * 64 + 16 * vtile + r];
        hbf16x8 qtf[2], qhf[2];
#pragma unroll
        for (int ks = 0; ks < 2; ++ks) { const int kb = 32 * ks + 8 * g; float q[8], xt[8], xh[8];
            unpack8(qraw[ii][ks], q);
#pragma unroll
            for (int j = 0; j < 8; ++j) { xt[j] = q[j] * __expf(bl[t * HG_BP + kb + j]); xh[j] = xt[j] * __expf(pre[I * 64 + kb + j]); }
            qtf[ks] = pack8(xt); qhf[ks] = pack8(xh); }
        f32x4 at[4];
#pragma unroll
        for (int J = 0; J < 4; ++J) { at[J] = (f32x4){0.f, 0.f, 0.f, 0.f};
            if (J <= I) { const int s = 16 * J + r;
#pragma unroll
                for (int ks = 0; ks < 2; ++ks) { const int kb = 32 * ks + 8 * g; float kk[8], x[8];
                    unpack8(kraw[J][ks], kk);
#pragma unroll
                    for (int j = 0; j < 8; ++j) x[j] = kk[j] * __expf(fminf(pre[I * 64 + kb + j] - pre[J * 64 + kb + j] - bl[s * HG_BP + kb + j], 80.f));
                    at[J] = __builtin_amdgcn_mfma_f32_16x16x32_bf16(pack8(x), qtf[ks], at[J], 0, 0, 0); }
                if (J == I) {
#pragma unroll
                    for (int i = 0; i < 4; ++i) at[J][i] = (4 * g + i <= r) ? at[J][i] : 0.f; } } }
        hbf16x8 pf[2];
#pragma unroll
        for (int k2 = 0; k2 < 2; ++k2) { const float x[8] = {at[2 * k2][0], at[2 * k2][1], at[2 * k2][2], at[2 * k2][3], at[2 * k2 + 1][0], at[2 * k2 + 1][1], at[2 * k2 + 1][2], at[2 * k2 + 1][3]}; pf[k2] = pack8(x); }
        f32x4 o[4];
#pragma unroll
        for (int vtile = 0; vtile < 4; ++vtile) { f32x4 acc = {0.f, 0.f, 0.f, 0.f}; const int v = 16 * vtile + r;
#pragma unroll
            for (int ks = 0; ks < 2; ++ks) acc = __builtin_amdgcn_mfma_f32_16x16x32_bf16(qhf[ks], sfr[vtile][ks], acc, 0, 0, 0);
#pragma unroll
            for (int k2 = 0; k2 < 2; ++k2) { if (k2 == 0 || I >= 2) {
                const hbf16x4 v0 = *(const LAS hbf16x4*)(vt + v * (HG_VP * 2) + (32 * k2 + 4 * g) * 2), v1 = *(const LAS hbf16x4*)(vt + v * (HG_VP * 2) + (32 * k2 + 16 + 4 * g) * 2);
                const hbf16x8 vf = {v0[0], v0[1], v0[2], v0[3], v1[0], v1[1], v1[2], v1[3]};
                acc = __builtin_amdgcn_mfma_f32_16x16x32_bf16(pf[k2], vf, acc, 0, 0, 0); } }
            o[vtile] = acc; }
#pragma unroll
        for (int i = 0; i < 4; ++i) { float sq = 0.f;
#pragma unroll
            for (int vtile = 0; vtile < 4; ++vtile) sq += o[vtile][i] * o[vtile][i];
            sq += __shfl_xor(sq, 1); sq += __shfl_xor(sq, 2); sq += __shfl_xor(sq, 4); sq += __shfl_xor(sq, 8);
            const float rn = rsqrtf(sq * (1.0f / 64.0f) + EPS); const size_t row = row0 + 16 * I + 4 * g + i;
#pragma unroll
            for (int vtile = 0; vtile < 4; ++vtile) { const int v = 16 * vtile + r; const float gg = bf2f(graw[i][vtile]);
                MIX[row * DM + h * 64 + v] = (bf16_t)f2bf(o[vtile][i] * rn * hgn[v] * (gg / (1.0f + __expf(-gg)))); } }
    }
}

struct Args { const float* in[14]; float* out; unsigned char* ws; int ph_lo, ph_hi; };
constexpr int NPHASE = 1 + 7 * DEPTH;

__global__ void __launch_bounds__(512, 2) fwd(Args a) {
    extern __shared__ __attribute__((aligned(16))) unsigned char lds[];
    cg::grid_group grid = cg::this_grid();
    LAS unsigned char* L = (LAS unsigned char*)lds;
    if (threadIdx.x < 32) ((LAS unsigned*)(L + LDS_BYTES - 128))[threadIdx.x] = 0u;
    __syncthreads();
    for (int ph = a.ph_lo; ph < a.ph_hi; ++ph) {
        int G = gridDim.x, bx = blockIdx.x; asm volatile("" : "+s"(G), "+s"(bx));
        typedef const __attribute__((address_space(4))) Args* KArgP;
        KArgP ap = (KArgP)__builtin_amdgcn_kernarg_segment_ptr(); asm volatile("" : "+s"(ap));
        unsigned char* ws = ap->ws;
        float* SS = (float*)(ws + WS_SS); float* LB = (float*)(ws + WS_LB);
        bf16_t* XB = (bf16_t*)(ws + WS_XB); bf16_t* MIX = (bf16_t*)(ws + WS_MIX); bf16_t* UB = (bf16_t*)(ws + WS_U);
        unsigned char* P = ws + WS_P;
#ifdef PROBE_T
        if (ph == NPHASE) {
            if (bx == 0) { const unsigned long long* ts_ = (const unsigned long long*)(ws + 65536); unsigned long long sa = 0, sb = 0;
                for (int p = 1; p < NPHASE; ++p) { const int kk_ = (p - 1) % 7; const unsigned long long d = ts_[p] - ts_[p - 1]; if (PROBE_A(kk_)) sa += d; if (PROBE_B(kk_)) sb += d; }
                const float fa = (float)sa * 1e-3f, fb = (float)sb * 1e-3f; float* o_ = ap->out;
                for (int i = threadIdx.x; i < (1 << 20); i += 512) o_[(1 << 20) + i] += fb;
                if (threadIdx.x == 0) o_[0] = fa; }
        } else
#endif
        if (ph == 0) {
            int tid = threadIdx.x; asm volatile("" : "+v"(tid)); const int lane = tid & 63, wave = __builtin_amdgcn_readfirstlane(tid >> 6);
            LAS float* scr = (LAS float*)(L + wave * 16384);
            const int gw = bx * 8 + wave, NGW = G * 8;
            constexpr int I_IN = 16 * 112, I_OUT = 16 * 32, I_1 = 16 * 128, I_2 = 64 * 32, I_L = I_IN + I_OUT + I_1 + I_2;
            for (int it = gw; it < DEPTH * I_L; it += NGW) {
                const int l = it / I_L; int r = it % I_L;
                unsigned char* wl = ws + WS_W + (size_t)l * W_LAYER;
                if (r < I_IN) { const int kb = r / 112, nb = r % 112, n0 = nb * 32, pn = n0 >> 8, p = n0 & 255, slot = 4 * pn + ((p & 127) >> 5), sc0 = 64 * slot + 32 * (p >> 7);
                    tr_item(ap->in[3] + (size_t)l * DM * INC, INC, INC, sc0, kb * 64, ap->in[2] + l * DM, (bf16_t*)wl, DM, n0, scr, lane); continue; }
                r -= I_IN;
                if (r < I_OUT) { const int kb = r / 32, nb = r % 32; tr_item(ap->in[10] + (size_t)l * DM * DM, DM, DM, nb * 32, kb * 64, nullptr, (bf16_t*)(wl + W_OUT), DM, nb * 32, scr, lane); continue; }
                r -= I_OUT;
                if (r < I_1) { const int kb = r / 128, nb = r % 128; tr_item(ap->in[12] + (size_t)l * DM * DFF, DFF, DFF, nb * 32, kb * 64, ap->in[11] + l * DM, (bf16_t*)(wl + W_1), DM, nb * 32, scr, lane); continue; }
                r -= I_1;
                { const int kb = r / 32, nb = r % 32; tr_item(ap->in[13] + (size_t)l * DFF * DM, DM, DM, nb * 32, kb * 64, nullptr, (bf16_t*)(wl + W_2), DFF, nb * 32, scr, lane); }
            }
            const float* x = ap->in[0];
            for (int m = gw; m < M; m += NGW) {
                const f32x4* xr = (const f32x4*)(x + (size_t)m * DM) + lane; f32x4 v[4]; float s = 0.f;
#pragma unroll
                for (int j = 0; j < 4; ++j) { v[j] = xr[64 * j]; s += (v[j][0] * v[j][0] + v[j][1] * v[j][1]) + (v[j][2] * v[j][2] + v[j][3] * v[j][3]); }
                const float tot = wave_sum(s);
                u32x2* o8 = (u32x2*)(XB + (size_t)m * DM) + lane;
#pragma unroll
                for (int j = 0; j < 4; ++j) { u32x2 w; w.x = pk2(v[j][0], v[j][1]); w.y = pk2(v[j][2], v[j][3]); o8[64 * j] = w; }
                if (lane < 16) SS[(size_t)m * 16 + lane] = (lane == 0) ? tot : 0.f;
            }
            if (bx == 2 && tid < 64) ((unsigned*)ws)[tid] = 0u;
            if (bx == 3) for (int i = tid; i < XCD_BAR_WORDS; i += 512) ((unsigned*)(ws + WS_BAR))[i] = 0u;
            if (bx == 1) {
                for (int i = tid; i < 1024; i += 512) { const int l = i >> 8, wh = (i >> 6) & 3, d = i & 63; LB[2048 + i] = ap->in[5 + wh][l * 64 + d]; }
                if (tid < 32) { const int l = tid >> 3, e = tid & 7; LB[3072 + tid] = (e < 6) ? ap->in[9][l * 6 + e] : 0.f; }
            }
            if (bx == 0 && tid < 256) {
                const float* lg = ap->in[1]; float e[DEPTH]; float mx = -1e30f, sum = 0.f;
#pragma unroll
                for (int l = 0; l < DEPTH; ++l) mx = fmaxf(mx, lg[l * 256 + tid]);
#pragma unroll
                for (int l = 0; l < DEPTH; ++l) { e[l] = expf(lg[l * 256 + tid] - mx); sum += e[l]; }
                float c = 0.f;
#pragma unroll
                for (int l = 0; l < DEPTH; ++l) { if (l > 0) c += e[l] / sum; LB[l * 512 + tid] = logf(fmaxf(c, 1e-30f)); LB[l * 512 + 256 + tid] = 1.0f - c; }
            }
        } else {
            const int l = (ph - 1) / 7, k = (ph - 1) % 7;
#ifdef REP_K
            const int nrep = (k == REP_K) ? 2 : 1;
#else
            const int nrep = 1;
#endif
            for (int rep = 0; rep < nrep; ++rep) {
            if (rep) { XcdBarrier xb_; xb_.bar = (unsigned*)(ws + WS_BAR); xb_.x = xb_xcc_id(); xb_.st = (volatile LAS unsigned*)(L + LDS_BYTES - 128); xcd_barrier(xb_); }
            unsigned char* wl = ws + WS_W + (size_t)l * W_LAYER;
            if (k == 0) {
                pg8::Gemm g{XB, (const bf16_t*)wl, M, NIN, DM}; pg8::StaticOrder S; S.init(M, NIN, G, bx);
                EpiInProj E{SS, P, LB + l * 512, LB + 2048 + l * 256, LB + 3072 + l * 8};
                pg8::gemm_phase<EpiInProj, pg8::StaticOrder, true, true>(L, g, S, E);
            } else if (k == 1) {
                int tid = threadIdx.x; asm volatile("" : "+v"(tid));
                unsigned* ctr = (unsigned*)ws + l * 16 + 1 + rep * 4;
                volatile LAS int* sh = (volatile LAS int*)(L + LDS_BYTES - 64);
                int nxt = 0; if (tid == 0) nxt = (int)atomicAdd(ctr, 1u);
                for (;;) {
                    if (tid == 0) sh[0] = nxt;
                    __syncthreads();
                    const int idx = __builtin_amdgcn_readfirstlane(sh[0]);
                    __syncthreads();
                    if (idx >= 816 + 512) break;
                    if (tid == 0) nxt = (int)atomicAdd(ctr, 1u);
                    if (idx < 768) { const int qb = 15 - idx / 48, bh = idx % 48, b = bh / 6, h = bh % 6; typedef attn_body::bf16 abf;
                        attn_body::sb_unit(qb, (const abf*)(P + P_SQ) + (size_t)bh * SEQ * 64, (const abf*)(P + P_SQ + HEADBUF) + (size_t)bh * SEQ * 64, (const abf*)(P + P_SQ + 2 * HEADBUF) + (size_t)bh * SEQ * 64,
                                           (abf*)MIX + (size_t)b * SEQ * DM + 256 + h * 64, (char*)lds); }
                    else if (idx < 816) fox_cumsum_item(idx - 768, (const float*)(P + P_LF), (float*)(P + P_CC), (int*)(ws + WS_JS), LB + 2048 + l * 256 + 128, LB + 2048 + l * 256 + 192, (LAS float*)L);
                    else hgrn_a_item(idx - 816, P, (float*)(ws + WS_DD), L);
                    __syncthreads();
                }
            } else if (k == 2) {
                hgrn_b_scan(bx, G, P, (const float*)(ws + WS_DD));
            } else if (k == 3) {
                int tid = threadIdx.x; asm volatile("" : "+v"(tid));
                unsigned* ctr = (unsigned*)ws + l * 16 + rep * 4;
                volatile LAS int* sh = (volatile LAS int*)(L + LDS_BYTES - 64);
                int nxt = 0; if (tid == 0) nxt = (int)atomicAdd(ctr, 1u);
                for (;;) {
                    if (tid == 0) sh[0] = nxt;
                    __syncthreads();
                    const int idx = __builtin_amdgcn_readfirstlane(sh[0]);
                    __syncthreads();
#ifdef PROBE_FOX
                    if (idx >= 768 + 512 || (rep && idx >= 768)) break;
#else
                    if (idx >= 768 + 512) break;
#endif
                    if (tid == 0) nxt = (int)atomicAdd(ctr, 1u);
                    if (idx >= 768) { hgrn_c_item(idx - 768, P, MIX, ap->in[4] + l * 64, L); __syncthreads(); continue; }
                    const int qb = 15 - idx / 48, bh = idx % 48, b = bh / 6, h = bh % 6;
                    typedef attn_body::bf16 abf;
                    const int jstart = ((const int*)(ws + WS_JS))[bh * 16 + qb];
#ifdef PROBE_FOX
                    if (rep) attn_body::attn_unit<30, PROBE_FOX_BIAS>(qb, PROBE_FOX_JS(jstart), (const abf*)(P + P_FQ) + (size_t)bh * SEQ * 64, (const abf*)(P + P_FQ + HEADBUF) + (size_t)bh * SEQ * 64, (const abf*)(P + P_FQ + 2 * HEADBUF) + (size_t)bh * SEQ * 64,
                                            (abf*)ap->out + (size_t)b * SEQ * DM + 640 + h * 64, (const float*)(P + P_CC) + (size_t)bh * SEQ, (char*)lds);
                    else
#endif
                    attn_body::attn_unit<30>(qb, jstart, (const abf*)(P + P_FQ) + (size_t)bh * SEQ * 64, (const abf*)(P + P_FQ + HEADBUF) + (size_t)bh * SEQ * 64, (const abf*)(P + P_FQ + 2 * HEADBUF) + (size_t)bh * SEQ * 64,
                                            (abf*)MIX + (size_t)b * SEQ * DM + 640 + h * 64, (const float*)(P + P_CC) + (size_t)bh * SEQ, (char*)lds);
                }
            } else if (k == 5) {
                pg8::Gemm g{XB, (const bf16_t*)(wl + W_1), M, DFF, DM}; pg8::StaticOrder S; S.init(M, DFF, G, bx);
                EpiRelu2 E{UB, SS};
                pg8::gemm_phase<EpiRelu2, pg8::StaticOrder, true, true>(L, g, S, E);
            } else {
                const bool ff2 = (k == 6);
                pg8::Gemm g{ff2 ? UB : MIX, (const bf16_t*)(wl + (ff2 ? W_2 : W_OUT)), M, DM, ff2 ? DFF : DM}; pg8::StaticOrder S; S.init(M, DM, G, bx);
                EpiResid E{XB, (ff2 && l == DEPTH - 1) ? ap->out : nullptr, SS};
                pg8::gemm_phase<EpiResid, pg8::StaticOrder, true, true>(L, g, S, E);
            }
            }
        }
#ifdef PROBE_T
        if (bx == 0 && threadIdx.x == 0) ((unsigned long long*)(ws + 65536))[ph] = __builtin_amdgcn_s_memrealtime();
#endif
        if (ph + 1 < a.ph_hi) {
            if (ph == 0) {
                grid.sync();
                (void)xcd_barrier_post((unsigned*)(ws + WS_BAR), (volatile LAS unsigned*)(L + LDS_BYTES - 128));
            } else {
                XcdBarrier xb_; xb_.bar = (unsigned*)(ws + WS_BAR); xb_.x = xb_xcc_id(); xb_.st = (volatile LAS unsigned*)(L + LDS_BYTES - 128);
                xcd_barrier(xb_);
            }
        }
    }
}

#ifndef MK_MULTI
#define MK_MULTI 0
#endif
extern "C" void kernel_launch(void* const* d_in, const int* in_sizes, int n_in, void* d_out, int out_size, void* d_ws, size_t ws_size, hipStream_t stream) {
    static int grid = 0;
    if (grid == 0) {
        int dev = 0, cus = 0, per = 0;
        if (n_in != 14 || out_size != M * DM || ws_size < WS_END) { fprintf(stderr, "kernel_launch: unexpected shapes (n_in %d out %d ws %zu)\n", n_in, out_size, ws_size); grid = -1; return; }
        (void)hipGetDevice(&dev); (void)hipDeviceGetAttribute(&cus, hipDeviceAttributeMultiprocessorCount, dev);
        (void)hipFuncSetAttribute((const void*)fwd, hipFuncAttributeMaxDynamicSharedMemorySize, LDS_BYTES);
        (void)hipOccupancyMaxActiveBlocksPerMultiprocessor(&per, (const void*)fwd, 512, LDS_BYTES);
        if (per < 1) per = 1;
        grid = cus * per;
        fprintf(stderr, "kernel_launch: grid %d (cus %d x %d)\n", grid, cus, per);
    }
    if (grid < 0) return;
    Args a{};
    for (int i = 0; i < 14; ++i) a.in[i] = (const float*)d_in[i];
    a.out = (float*)d_out; a.ws = (unsigned char*)d_ws;
#if MK_MULTI
    for (int ph = 0; ph < NPHASE; ++ph) { a.ph_lo = ph; a.ph_hi = ph + 1; hipLaunchKernelGGL(fwd, dim3(grid), dim3(512), LDS_BYTES, stream, a); }
#else
#ifdef PROBE_T
    a.ph_lo = 0; a.ph_hi = NPHASE + 1;
#else
    a.ph_lo = 0; a.ph_hi = NPHASE;
#endif
    void* args[] = {&a};
    hipError_t e = hipLaunchCooperativeKernel((const void*)fwd, dim3(grid), dim3(512), args, LDS_BYTES, stream);
    if (e != hipSuccess) fprintf(stderr, "kernel_launch: cooperative launch failed: %s (grid %d)\n", hipGetErrorString(e), grid);
#endif
}
```

```cpp
#include <hip/hip_runtime.h>
#include <hip/hip_cooperative_groups.h>
#include <cstdio>
#include <cstdint>
namespace cg = cooperative_groups;
namespace pg8 {
#define PG8_LAS __attribute__((address_space(3)))
typedef unsigned short bf16_t;
typedef short bf16x8 __attribute__((ext_vector_type(8)));
typedef float f32x4 __attribute__((ext_vector_type(4)));
typedef unsigned u32x4 __attribute__((ext_vector_type(4)));
constexpr int BM = 256, BK = 64, HALF = 128, HTB = HALF * BK * 2  , STAGE_BYTES = 8 * HTB, NXCD = 8, WGM = 8;

__host__ __device__ __forceinline__ int lds_byte(int r, int c) { const int st = (r >> 4) * 2 + (c >> 5), rr = r & 15, cc = c & 31, ob = rr * 64 + cc * 2; return st * 1024 + (ob ^ (((ob >> 9) & 1) << 5)); }
__host__ __device__ __forceinline__ void stage_rc(int b, int& R, int& C) { const int st = b / 1024, sb = b % 1024, swz = sb ^ (((sb >> 9) & 1) << 5); R = (st >> 1) * 16 + swz / 64; C = (st & 1) * 32 + (swz % 64) / 2; }
__host__ __device__ __forceinline__ int perm32(int rho) { const int n = rho >> 4, i = rho & 15; return 8 * (i >> 2) + 4 * n + (i & 3); }

struct Unit { int pm, pn; };
struct Gemm { const bf16_t* A; const bf16_t* Bt; int M, N, K; };

struct StaticOrder {
    int nM, nN, nwg, G, c;
    __host__ __device__ void init(int M, int N, int G_, int c_) { nM = M / BM; nN = N / BM; nwg = nM * nN; G = G_; c = c_; }
    __host__ __device__ bool next(int i, Unit& u) const {
        const long L = (long)i * G + c; if (L >= nwg) return false;
        int wgid = (int)L; { const int q = nwg / NXCD, r = nwg % NXCD, xcd = wgid % NXCD, off = wgid / NXCD; wgid = (xcd < r ? xcd * (q + 1) : r * (q + 1) + (xcd - r) * q) + off; }
        const int nig = WGM * nN, gid = wgid / nig, fm = gid * WGM, gsz = (nM - fm) < WGM ? (nM - fm) : WGM;
        u.pm = fm + ((wgid % nig) % gsz); u.pn = (wgid % nig) / gsz; return true;
    }
    __device__ __forceinline__ void a_ready(const Unit&) const {}
    __device__ __forceinline__ void done(const Unit&) const {}
};

__device__ __forceinline__ unsigned cvt_pk_bf16(float lo, float hi) { unsigned r; asm volatile("v_cvt_pk_bf16_f32 %0, %1, %2" : "=v"(r) : "v"(lo), "v"(hi)); return r; }
typedef float f32x2 __attribute__((ext_vector_type(2)));
template <class Epi, class Sched, bool ALIGN_EPI = false, bool SP2 = false>
__device__ __forceinline__ void gemm_phase(PG8_LAS unsigned char* lds, const Gemm g, const Sched& S, const Epi& E) {
    int tid_ = threadIdx.x; asm volatile("" : "+v"(tid_));
    const int tid = tid_, wid = __builtin_amdgcn_readfirstlane(tid >> 6), lane = tid & 63, wr = wid >> 2, wc = wid & 3, fr = lane & 15, fq = lane >> 4;
    const int K = g.K, nt = K / BK;
    unsigned voffA[2], voffB[2];
#pragma unroll
    for (int i = 0; i < 2; ++i) { int R, C; stage_rc(tid * 16 + i * 8192, R, C); const int Rb = Epi::PERM ? ((R & ~31) + perm32(R & 31)) : R;
        voffA[i] = (unsigned)(R * K + C) * 2u; voffB[i] = (unsigned)(Rb * K + C) * 2u; }
    const size_t kstep = (size_t)(BK * 2);
    const size_t hstep = (size_t)HALF * K * 2;
    const size_t tstep = 2 * hstep;
    const unsigned ldsw = (unsigned)wid * 1024u;
    const int aoff = lds_byte(wr * 64 + fr, fq * 8), boff = lds_byte(wc * 32 + fr, fq * 8);
#define PG8_SA(b, h) (((b) * 2 + (h)) * HTB)
#define PG8_SB(b, h) ((4 + (b) * 2 + (h)) * HTB)
#define PG8_STAGE(bufoff, gbase, voff) do { _Pragma("unroll") for (int _i = 0; _i < 2; ++_i) \
        __builtin_amdgcn_global_load_lds((const unsigned*)((const char*)(gbase) + (voff)[_i]), (PG8_LAS unsigned*)(lds + (bufoff) + ldsw + _i * 8192), 16, 0, 0); } while (0)
#define PG8_LDA(dst, b, h) do { _Pragma("unroll") for (int m = 0; m < 4; ++m) _Pragma("unroll") for (int k = 0; k < 2; ++k) dst[m][k] = *(const PG8_LAS bf16x8*)(lds + PG8_SA(b, h) + aoff + m * 2048 + k * 1024); } while (0)
#define PG8_LDB(dst, b, h) do { _Pragma("unroll") for (int n = 0; n < 2; ++n) _Pragma("unroll") for (int k = 0; k < 2; ++k) dst[n][k] = *(const PG8_LAS bf16x8*)(lds + PG8_SB(b, h) + boff + n * 2048 + k * 1024); } while (0)
#define PG8_MMA(ai, bj, At, Bt) do { __builtin_amdgcn_s_setprio(1); _Pragma("unroll") for (int m = 0; m < 4; ++m) _Pragma("unroll") for (int n = 0; n < 2; ++n) _Pragma("unroll") for (int k = 0; k < 2; ++k) \
        acc[ai][bj][m][n] = __builtin_amdgcn_mfma_f32_16x16x32_bf16(Bt[n][k], At[m][k], acc[ai][bj][m][n], 0, 0, 0); __builtin_amdgcn_s_setprio(0); } while (0)
#define PG8_WAIT_V(n) asm volatile("s_waitcnt vmcnt(" #n ")" ::: "memory")
#define PG8_WAIT_L(n) asm volatile("s_waitcnt lgkmcnt(" #n ")" ::: "memory")
#define PG8_BAR __builtin_amdgcn_s_barrier()
#define PG8_SCHED __builtin_amdgcn_sched_barrier(0)
    Unit cur, nxt; int ui = 0;
    if (!S.next(0, cur)) return;
    f32x4 acc[2][2][4][2];
#pragma unroll
    for (int a = 0; a < 2; ++a)
#pragma unroll
        for (int b = 0; b < 2; ++b)
#pragma unroll
            for (int m = 0; m < 4; ++m)
#pragma unroll
                for (int n = 0; n < 2; ++n) acc[a][b][m][n] = (f32x4){0.f, 0.f, 0.f, 0.f};
    bf16x8 At[4][2], B0[2][2], B1[2][2];
    const char* cA = (const char*)g.A + (size_t)cur.pm * tstep; const char* cB = (const char*)g.Bt + (size_t)cur.pn * tstep;
    S.a_ready(cur);
    if constexpr (SP2) {
        PG8_STAGE(PG8_SB(0, 0), cB, voffB); PG8_STAGE(PG8_SB(0, 1), cB + hstep, voffB); PG8_STAGE(PG8_SA(0, 0), cA, voffA); PG8_STAGE(PG8_SA(0, 1), cA + hstep, voffA);
        if (wr == 1) PG8_BAR;
        PG8_WAIT_V(2); PG8_BAR;
        PG8_STAGE(PG8_SB(1, 0), cB + kstep, voffB); PG8_STAGE(PG8_SA(1, 0), cA + kstep, voffA); PG8_STAGE(PG8_SB(1, 1), cB + hstep + kstep, voffB);
        PG8_WAIT_V(6); PG8_BAR;
    } else {
        PG8_STAGE(PG8_SB(0, 0), cB, voffB); PG8_STAGE(PG8_SA(0, 0), cA, voffA); PG8_STAGE(PG8_SB(0, 1), cB + hstep, voffB); PG8_STAGE(PG8_SA(0, 1), cA + hstep, voffA);
        if (wr == 1) PG8_BAR;
        PG8_WAIT_V(4); PG8_BAR;
        PG8_STAGE(PG8_SB(1, 0), cB + kstep, voffB); PG8_STAGE(PG8_SA(1, 0), cA + kstep, voffA); PG8_STAGE(PG8_SB(1, 1), cB + hstep + kstep, voffB);
        PG8_WAIT_V(6); PG8_BAR;
    }
    for (;;) {
        const bool has_next = S.next(ui + 1, nxt);
        const char* nA = has_next ? (const char*)g.A + (size_t)nxt.pm * tstep : cA; const char* nB = has_next ? (const char*)g.Bt + (size_t)nxt.pn * tstep : cB;
        for (int t = 0; t < nt; t += 2) {
            const bool last = (t == nt - 2);
            const char* a1 = cA + (size_t)(t + 1) * kstep;
            const char* a2 = last ? nA : cA + (size_t)(t + 2) * kstep; const char* b2 = last ? nB : cB + (size_t)(t + 2) * kstep;
            const char* a3 = a2 + kstep; const char* b3 = b2 + kstep;
            if (last && has_next) S.a_ready(nxt);
            if constexpr (SP2) {
            PG8_LDB(B0, 0, 0); PG8_LDB(B1, 0, 1); PG8_SCHED; PG8_LDA(At, 0, 0); PG8_STAGE(PG8_SA(1, 1), a1 + hstep, voffA);
            PG8_WAIT_V(8); PG8_WAIT_L(0); PG8_BAR; PG8_MMA(0, 0, At, B0); PG8_MMA(0, 1, At, B1); PG8_BAR; PG8_SCHED;
            PG8_LDA(At, 0, 1); PG8_STAGE(PG8_SB(0, 0), b2, voffB); PG8_STAGE(PG8_SB(0, 1), b2 + hstep, voffB); PG8_STAGE(PG8_SA(0, 0), a2, voffA);
            PG8_WAIT_V(8); PG8_WAIT_L(0); PG8_BAR; PG8_MMA(1, 0, At, B0); PG8_MMA(1, 1, At, B1); PG8_BAR; PG8_SCHED;
            PG8_LDB(B0, 1, 0); PG8_LDB(B1, 1, 1); PG8_SCHED; PG8_LDA(At, 1, 0); PG8_STAGE(PG8_SA(0, 1), a2 + hstep, voffA);
            PG8_WAIT_V(8); PG8_WAIT_L(0); PG8_BAR; PG8_MMA(0, 0, At, B0); PG8_MMA(0, 1, At, B1); PG8_BAR; PG8_SCHED;
            PG8_LDA(At, 1, 1); PG8_STAGE(PG8_SB(1, 0), b3, voffB); PG8_STAGE(PG8_SB(1, 1), b3 + hstep, voffB); PG8_STAGE(PG8_SA(1, 0), a3, voffA);
            PG8_WAIT_V(8); PG8_WAIT_L(0); PG8_BAR; PG8_MMA(1, 0, At, B0); PG8_MMA(1, 1, At, B1); PG8_BAR; PG8_SCHED;
            } else {
            PG8_LDB(B0, 0, 0); PG8_SCHED; PG8_LDA(At, 0, 0); PG8_STAGE(PG8_SA(1, 1), a1 + hstep, voffA);
            PG8_WAIT_L(8); PG8_BAR; PG8_WAIT_L(0); PG8_MMA(0, 0, At, B0); PG8_BAR; PG8_SCHED;
            PG8_LDB(B1, 0, 1); PG8_STAGE(PG8_SB(0, 0), b2, voffB);
            PG8_BAR; PG8_WAIT_L(0); PG8_MMA(0, 1, At, B1); PG8_BAR;
            PG8_LDA(At, 0, 1); PG8_STAGE(PG8_SA(0, 0), a2, voffA);
            PG8_BAR; PG8_WAIT_L(0); PG8_MMA(1, 0, At, B0); PG8_BAR; PG8_SCHED;
            PG8_STAGE(PG8_SB(0, 1), b2 + hstep, voffB);
            PG8_WAIT_V(6); PG8_BAR; PG8_MMA(1, 1, At, B1); PG8_BAR;
            PG8_LDB(B0, 1, 0); PG8_SCHED; PG8_LDA(At, 1, 0); PG8_STAGE(PG8_SA(0, 1), a2 + hstep, voffA);
            PG8_WAIT_L(8); PG8_BAR; PG8_WAIT_L(0); PG8_MMA(0, 0, At, B0); PG8_BAR; PG8_SCHED;
            PG8_LDB(B1, 1, 1); PG8_STAGE(PG8_SB(1, 0), b3, voffB);
            PG8_BAR; PG8_WAIT_L(0); PG8_MMA(0, 1, At, B1); PG8_BAR;
            PG8_LDA(At, 1, 1); PG8_STAGE(PG8_SA(1, 0), a3, voffA);
            PG8_BAR; PG8_WAIT_L(0); PG8_MMA(1, 0, At, B0); PG8_BAR; PG8_SCHED;
            PG8_STAGE(PG8_SB(1, 1), b3 + hstep, voffB);
            PG8_WAIT_V(6); PG8_BAR; PG8_MMA(1, 1, At, B1); PG8_BAR;
            }
        }
        if constexpr (ALIGN_EPI) { if (wr == 0) PG8_BAR; }
        if constexpr (!Epi::AFTER_DRAIN) { E(acc, cur, wr, wc, fr, fq); S.done(cur); }
        if (!has_next) break;
#pragma unroll
        for (int a = 0; a < 2; ++a)
#pragma unroll
            for (int b = 0; b < 2; ++b)
#pragma unroll
                for (int m = 0; m < 4; ++m)
#pragma unroll
                    for (int n = 0; n < 2; ++n) acc[a][b][m][n] = (f32x4){0.f, 0.f, 0.f, 0.f};
        cur = nxt; cA = nA; cB = nB; ++ui;
        if constexpr (ALIGN_EPI) { if (wr == 1) PG8_BAR; }
    }
    PG8_WAIT_V(0);
    if constexpr (!ALIGN_EPI) { if (wr == 0) PG8_BAR; }
    PG8_BAR;
    if constexpr (Epi::AFTER_DRAIN) { E.fused(acc, cur, wr, wc, fr, fq, lds, wid, lane); S.done(cur); }
#undef PG8_SA
#undef PG8_SB
#undef PG8_STAGE
#undef PG8_LDA
#undef PG8_LDB
#undef PG8_MMA
#undef PG8_WAIT_V
#undef PG8_WAIT_L
#undef PG8_BAR
#undef PG8_SCHED
}
}
#include <hip/hip_bf16.h>
#include <cmath>
namespace attn_body {
using bf16=__hip_bfloat16;
using bf16x8=__attribute__((ext_vector_type(8)))short;
using s16x4=__attribute__((ext_vector_type(4)))short;
using f32x16=__attribute__((ext_vector_type(16)))float;
using u32x4=__attribute__((ext_vector_type(4)))unsigned;
using f32x4v=__attribute__((ext_vector_type(4)))float;
constexpr int SEQ=4096,D=64,DM=64,OPITCH=1024;
constexpr int LDS_C=98304;
constexpr int NW=8,QBLK=32,QB=QBLK*NW,KVBLK=64,NQB=SEQ/QB;
constexpr int ATTN_UNIT_ROWS=QB;
__device__ __forceinline__ int crow(int r,int hi){return (r&3)+8*(r>>2)+4*hi;}
#define SBAR() __builtin_amdgcn_sched_barrier(0)
__device__ __forceinline__ void cmask(f32x16&p0,f32x16&p1,int jb,int qrel,int hi){
  const float NEG=-INFINITY; int kb=64*jb+4*hi;
  #pragma unroll
  for(int r=0;r<16;++r){int kv=kb+(r&3)+8*(r>>2); if(kv>qrel)p0[r]=NEG; if(kv+32>qrel)p1[r]=NEG;}
}

constexpr int NSLOT=3, SLOTB=8192;
constexpr int LDS_K=0, LDS_V=NSLOT*SLOTB, LDS_WS=2*NSLOT*SLOTB, LDS_OST=LDS_WS+NW*64*4, LDS_BYTES=LDS_OST+NW*4096;
constexpr float C2=0.125f*1.4426950408889634f;
__device__ __forceinline__ void glds16(const void*gsrc,unsigned lds_dst){unsigned keep;
  asm volatile("s_mov_b32 %0, m0\n\ts_mov_b32 m0, %2\n\ts_nop 0\n\tglobal_load_lds_dwordx4 %1, off\n\ts_mov_b32 m0, %0":"=&s"(keep):"v"(gsrc),"s"(lds_dst):"memory");}
__device__ __forceinline__ float max3f(float a,float b,float c){float r;asm("v_max3_f32 %0, %1, %2, %3":"=v"(r):"v"(a),"v"(b),"v"(c));return r;}
__device__ __forceinline__ float max2f(float a,float b){float r;asm("v_max_f32_e32 %0, %1, %2":"=v"(r):"v"(a),"v"(b));return r;}
__device__ __forceinline__ float fadd_s(float a,float b){float r;asm("v_add_f32_e32 %0, %1, %2":"=v"(r):"v"(a),"v"(b));return r;}
__device__ __forceinline__ float fsub_s(float a,float b){float r;asm("v_sub_f32_e32 %0, %1, %2":"=v"(r):"v"(a),"v"(b));return r;}
typedef float f32x2_t __attribute__((ext_vector_type(2))); typedef __bf16 bf16x2_t __attribute__((ext_vector_type(2)));
__device__ __forceinline__ unsigned cvtpk_s(float lo,float hi){f32x2_t v={lo,hi};bf16x2_t b=__builtin_convertvector(v,bf16x2_t);return __builtin_bit_cast(unsigned,b);}
#define WAIT_BAR(N) asm volatile("s_waitcnt vmcnt(" #N ") lgkmcnt(0)\n\ts_barrier":::"memory")

__device__ __forceinline__ void qkt(f32x16&p0,f32x16&p1,const char*Kslot,const bf16x8*qr,const f32x16&negm,int r32,int hi){
  const char*kb=Kslot+hi*1024+r32*16;
  #pragma unroll
  for(int d0=0;d0<4;++d0){
    const bf16x8 b0=*reinterpret_cast<const bf16x8*>(kb+d0*2048);
    const bf16x8 b1=*reinterpret_cast<const bf16x8*>(kb+d0*2048+512);
    if(d0==0){p0=__builtin_amdgcn_mfma_f32_32x32x16_bf16(b0,qr[0],negm,0,0,0);p1=__builtin_amdgcn_mfma_f32_32x32x16_bf16(b1,qr[0],negm,0,0,0);}
    else{p0=__builtin_amdgcn_mfma_f32_32x32x16_bf16(b0,qr[d0],p0,0,0,0);p1=__builtin_amdgcn_mfma_f32_32x32x16_bf16(b1,qr[d0],p1,0,0,0);}}
}
typedef __attribute__((address_space(3))) const char* lds_cptr;
typedef short v4i16_t __attribute__((ext_vector_type(4)));
__device__ __forceinline__ void kload8(bf16x8*kf,lds_cptr kp){
  kf[0]=*(const __attribute__((address_space(3))) bf16x8*)(kp);      kf[1]=*(const __attribute__((address_space(3))) bf16x8*)(kp+512);
  kf[2]=*(const __attribute__((address_space(3))) bf16x8*)(kp+2048); kf[3]=*(const __attribute__((address_space(3))) bf16x8*)(kp+2560);
  kf[4]=*(const __attribute__((address_space(3))) bf16x8*)(kp+4096); kf[5]=*(const __attribute__((address_space(3))) bf16x8*)(kp+4608);
  kf[6]=*(const __attribute__((address_space(3))) bf16x8*)(kp+6144); kf[7]=*(const __attribute__((address_space(3))) bf16x8*)(kp+6656);
}
__device__ __forceinline__ void kload2(bf16x8*kf,lds_cptr kp,int j){ kf[2*j]=*(const __attribute__((address_space(3))) bf16x8*)(kp+j*2048); kf[2*j+1]=*(const __attribute__((address_space(3))) bf16x8*)(kp+j*2048+512); }
__device__ __forceinline__ s16x4 vtr(lds_cptr p){ return __builtin_bit_cast(s16x4,__builtin_amdgcn_ds_read_tr16_b64_v4i16((__attribute__((address_space(3))) v4i16_t*)p)); }
__device__ __forceinline__ float rowmax(const f32x16&p0,const f32x16&p1){
  float a=max3f(p0[0],p0[1],p1[0]),b=max3f(p0[2],p0[3],p1[1]);a=max3f(a,p1[2],p1[3]);
  #pragma unroll
  for(int r=4;r<16;r+=4){a=max3f(a,p0[r],p0[r+1]);b=max3f(b,p0[r+2],p0[r+3]);a=max3f(a,p1[r],p1[r+1]);b=max3f(b,p1[r+2],p1[r+3]);}
  const float m=max2f(a,b);
  auto rr=__builtin_amdgcn_permlane32_swap(__float_as_uint(m),__float_as_uint(m),false,false);
  return max2f(__uint_as_float(rr[0]),__uint_as_float(rr[1]));
}
__device__ __forceinline__ void pv(f32x16*o,int vb,bf16x8 pa0,bf16x8 pa1,bf16x8 pa2,bf16x8 pa3){
  #pragma unroll
  for(int d0=0;d0<2;++d0){s16x4 lo[4],hi[4];
    #pragma unroll
    for(int ks=0;ks<4;++ks){
      asm volatile("ds_read_b64_tr_b16 %0,%1 offset:%c2":"=&v"(lo[ks]):"v"(vb),"i"(d0*4096+ks*1024):"memory");
      asm volatile("ds_read_b64_tr_b16 %0,%1 offset:%c2":"=&v"(hi[ks]):"v"(vb),"i"(d0*4096+ks*1024+512):"memory");}
    asm volatile("s_waitcnt lgkmcnt(0)":::"memory");SBAR();
    #define PK(k) (bf16x8){lo[k][0],lo[k][1],lo[k][2],lo[k][3],hi[k][0],hi[k][1],hi[k][2],hi[k][3]}
    o[d0]=__builtin_amdgcn_mfma_f32_32x32x16_bf16(pa0,PK(0),o[d0],0,0,0);
    o[d0]=__builtin_amdgcn_mfma_f32_32x32x16_bf16(pa1,PK(1),o[d0],0,0,0);
    o[d0]=__builtin_amdgcn_mfma_f32_32x32x16_bf16(pa2,PK(2),o[d0],0,0,0);
    o[d0]=__builtin_amdgcn_mfma_f32_32x32x16_bf16(pa3,PK(3),o[d0],0,0,0);
    #undef PK
  }
}

#ifndef ATTN_STORE16
#define ATTN_STORE16(p,v) (*(u32x4*)(p)=(v))
#endif
template<int THRL,bool BIASON=true> __device__ __forceinline__ void attn_unit(int qb,int jstart,const bf16*Q,const bf16*__restrict__ K,const bf16*__restrict__ V,bf16*O,const float*__restrict__ Cg,char*shm){
  int tid_=threadIdx.x; asm volatile("":"+v"(tid_)); const int tid=tid_,lane=tid&63,r32=lane&31,hi=lane>>5; const int wid=__builtin_amdgcn_readfirstlane(tid>>6);
  const int q0=qb*QB;
  const bf16*Qw=Q+(long)(q0+wid*QBLK)*DM;
  const bf16*Kh=K+(long)jstart*KVBLK*DM,*Vh=V+(long)jstart*KVBLK*DM;
  const lds_cptr shm3=(lds_cptr)shm;
  const unsigned lds0=(unsigned)(uintptr_t)shm;
  float*wsf=(float*)(shm+LDS_WS)+wid*64;
  const bf16*ksrc=Kh+(long)lane*DM+wid*8;
  const bf16*vsrc=Vh+(long)(16*(wid&3)+(lane>>2))*DM+(wid>>2)*32+(lane&3)*8;
  const unsigned kdst=lds0+LDS_K+wid*1024, vdst=lds0+LDS_V+wid*1024;
  #define DMA_K(t,slot) glds16(ksrc+(long)(t)*KVBLK*DM,(unsigned)__builtin_amdgcn_readfirstlane(kdst+(slot)))
  #define DMA_V(t,slot) glds16(vsrc+(long)(t)*KVBLK*DM,(unsigned)__builtin_amdgcn_readfirstlane(vdst+(slot)))
  const int vb0=(int)(lds0+LDS_V)+((lane>>4)&1)*32+(lane&3)*8+(4*hi+((lane&15)>>2))*64;
  const char*Kbase=shm+LDS_K; bf16x8 kf[8];
  const lds_cptr kp0=shm3+LDS_K+hi*1024+r32*16; const lds_cptr vp0=shm3+LDS_V+((lane>>4)&1)*32+(lane&3)*8+(4*hi+((lane&15)>>2))*64;
  const int NT=(q0+QB)/KVBLK-jstart;
  { typedef __attribute__((address_space(3))) f32x4v lf32x4; lf32x4*cl_=(lf32x4*)(shm3+LDS_C); const f32x4v*cg_=(const f32x4v*)(Cg+jstart*KVBLK); const int n4_=(q0+QB-jstart*KVBLK)>>2;
    f32x4v c0_=f32x4v{},c1_=f32x4v{}; if(tid<n4_)c0_=cg_[tid]; if(tid+NW*64<n4_)c1_=cg_[tid+NW*64]; if(tid<n4_)cl_[tid]=c0_; if(tid+NW*64<n4_)cl_[tid+NW*64]=c1_; }
  DMA_K(0,0);DMA_V(0,0);DMA_K(1,SLOTB);
  bf16x8 qr[4];
  #pragma unroll
  for(int d0=0;d0<4;++d0)qr[d0]=*reinterpret_cast<const bf16x8*>(&Qw[(long)r32*DM+d0*16+hi*8]);
  float mhat=0.f,l_reg=0.f;f32x16 o[2];o[0]=f32x16{};o[1]=f32x16{};
  const int qrel=wid*QBLK+r32;
  #define CMASK(P0,P1,t) do{int jb_=(t)-(NT-4); if(jb_>=0)cmask(P0,P1,jb_,qrel,hi);}while(0)
  typedef __attribute__((address_space(3))) const float* lds_fptr; typedef __attribute__((address_space(3))) const f32x4v* lds_f4ptr;
  const lds_fptr cl0=(lds_fptr)(shm3+LDS_C)+4*hi;
  #define BIAS(P0,P1,t) do{ const lds_fptr cb_=cl0+64*(t); _Pragma("unroll") for(int g_=0;g_<4;++g_){ const f32x4v a_=*(lds_f4ptr)(cb_+8*g_), b_=*(lds_f4ptr)(cb_+32+8*g_); \
      _Pragma("unroll") for(int i_=0;i_<4;++i_){P0[4*g_+i_]-=a_[i_];P1[4*g_+i_]-=b_[i_];} } }while(0)
  #define BIASINIT(C0_,C1_,t) do{ const lds_fptr cb_=cl0+64*(t); const float nm_=-mhat; _Pragma("unroll") for(int g_=0;g_<4;++g_){ f32x4v a_=f32x4v{},b_=f32x4v{}; if(BIASON){a_=*(lds_f4ptr)(cb_+8*g_); b_=*(lds_f4ptr)(cb_+32+8*g_);} \
      _Pragma("unroll") for(int i_=0;i_<4;++i_){C0_[4*g_+i_]=nm_-a_[i_];C1_[4*g_+i_]=nm_-b_[i_];} } }while(0)
  bool resc=false;
  #define START(P0,P1) do{ const float rm=rowmax(P0,P1); resc=false; \
    { const float dl=rm; mhat=fadd_s(mhat,dl); \
      _Pragma("unroll") for(int r=0;r<16;++r){P0[r]=fsub_s(P0[r],dl);P1[r]=fsub_s(P1[r],dl);} \
      } \
    _Pragma("unroll") for(int r=0;r<16;++r)P0[r]=__builtin_amdgcn_exp2f(P0[r]); }while(0)
  #define RESC() do{ if(resc){ asm volatile("s_waitcnt lgkmcnt(0)":::"memory"); \
      _Pragma("unroll") for(int d_=0;d_<2;++d_) _Pragma("unroll") for(int r=0;r<16;++r)o[d_][r]*=wsf[crow(r,hi)]; } }while(0)
  f32x16 pA0,pA1,pB0,pB1;
  int sl_prev=0,sl_cur=0,sl_next=SLOTB;
  #define ROT() do{sl_prev=sl_cur;sl_cur=sl_next;sl_next=(sl_next==(NSLOT-1)*SLOTB)?0:sl_next+SLOTB;}while(0)
  DMA_K(2,2*SLOTB);
  WAIT_BAR(3);
  { const f32x16 zero_=f32x16{}; qkt(pA0,pA1,Kbase,qr,zero_,r32,hi); }asm volatile("s_nop 15\n\ts_nop 7":"+v"(pA0),"+v"(pA1));BIAS(pA0,pA1,0);CMASK(pA0,pA1,0);
  START(pA0,pA1);
  BIASINIT(pB0,pB1,1);
  _Pragma("unroll") for(int r=0;r<16;++r)pA1[r]=__builtin_amdgcn_exp2f(pA1[r]);
  WAIT_BAR(0);
  DMA_K(3,0);DMA_V(1,SLOTB);
  ROT();
  kload8(kf,kp0+sl_cur);
  WAIT_BAR(2);
  s16x4 vlo[8],vhi[8]; u32x4 pw0,pw1,pw2,pw3;
  #define PKW(P,B) cvtpk_s(P[B],P[B+1])
  #define PAF(k) __builtin_bit_cast(bf16x8,pw##k)
  #define VFR(i) (bf16x8){vlo[i][0],vlo[i][1],vlo[i][2],vlo[i][3],vhi[i][0],vhi[i][1],vhi[i][2],vhi[i][3]}
  #define PIN(x) asm volatile("":"+v"(x))
  #define MX3(a,b,c) __builtin_fmaxf(__builtin_fmaxf((a),(b)),(c))
  #define GAPA(MF,A0,A1,A2,A3,W0,W1,PW) do{ MF; sacc+=A0; sacc+=A1; sacc+=A2; sacc+=A3; PIN(sacc); W0; W1; PIN(PW); SBAR(); }while(0)
  #define EX(v) __builtin_amdgcn_exp2f(v)
  #define GAPB(MF,X,B) do{ MF; X[B]=EX(X[B]); X[B+1]=EX(X[B+1]); X[B+2]=EX(X[B+2]); X[B+3]=EX(X[B+3]); PIN(X); SBAR(); }while(0)
  #define VRD(i) do{ vlo[i]=vtr(vp_+(((i)>>2)*4096+((i)&3)*1024)); vhi[i]=vtr(vp_+(((i)>>2)*4096+((i)&3)*1024+512)); }while(0)
  #define KRD(G,j) do{ if(G){ kload2(kf,kp0+sl_next,j); SBAR(); } }while(0)
  #define STEP(C0,C1,P0,P1,t,GK,GV,GL) do{ SBAR(); \
    const lds_cptr vp_=vp0+sl_prev; \
    VRD(0); SBAR(); float sacc=(P0[0]+P0[1]); \
    GAPA(C0=__builtin_amdgcn_mfma_f32_32x32x16_bf16(kf[0],qr[0],C0,0,0,0), P0[2],P0[3],P0[4],P0[5],     pw0[0]=PKW(P0,0), pw0[1]=PKW(P0,2), pw0); \
    VRD(4); SBAR(); GAPA(C1=__builtin_amdgcn_mfma_f32_32x32x16_bf16(kf[1],qr[0],C1,0,0,0), P0[6],P0[7],P0[8],P0[9],     pw0[2]=PKW(P0,4), pw0[3]=PKW(P0,6), pw0); \
    VRD(1); SBAR(); GAPA(C0=__builtin_amdgcn_mfma_f32_32x32x16_bf16(kf[2],qr[1],C0,0,0,0),   P0[10],P0[11],P0[12],P0[13], pw1[0]=PKW(P0,8), pw1[1]=PKW(P0,10), pw1); \
    VRD(5); SBAR(); GAPA(C1=__builtin_amdgcn_mfma_f32_32x32x16_bf16(kf[3],qr[1],C1,0,0,0),   P0[14],P0[15],P1[0],P1[1],   pw1[2]=PKW(P0,12),pw1[3]=PKW(P0,14), pw1); \
    VRD(2); SBAR(); GAPA(C0=__builtin_amdgcn_mfma_f32_32x32x16_bf16(kf[4],qr[2],C0,0,0,0),   P1[2],P1[3],P1[4],P1[5],     pw2[0]=PKW(P1,0), pw2[1]=PKW(P1,2), pw2); \
    VRD(6); SBAR(); GAPA(C1=__builtin_amdgcn_mfma_f32_32x32x16_bf16(kf[5],qr[2],C1,0,0,0),   P1[6],P1[7],P1[8],P1[9],     pw2[2]=PKW(P1,4), pw2[3]=PKW(P1,6), pw2); \
    VRD(3); SBAR(); GAPA(C0=__builtin_amdgcn_mfma_f32_32x32x16_bf16(kf[6],qr[3],C0,0,0,0),   P1[10],P1[11],P1[12],P1[13], pw3[0]=PKW(P1,8), pw3[1]=PKW(P1,10), pw3); \
    VRD(7); SBAR(); GAPA(C1=__builtin_amdgcn_mfma_f32_32x32x16_bf16(kf[7],qr[3],C1,0,0,0),   P1[14],P1[15],0.f,0.f,       pw3[2]=PKW(P1,12),pw3[3]=PKW(P1,14), pw3); \
    l_reg+=sacc; \
    if(GK){DMA_K((t)+3,sl_cur);} if(GV){DMA_V((t)+1,sl_next);} \
    CMASK(C0,C1,t); \
    { float a=MX3(C0[0],C0[1],C1[0]),b=MX3(C0[2],C0[3],C1[1]); a=MX3(a,C1[2],C1[3]); \
      _Pragma("unroll") for(int r=4;r<16;r+=4){a=MX3(a,C0[r],C0[r+1]);b=MX3(b,C0[r+2],C0[r+3]);a=MX3(a,C1[r],C1[r+1]);b=MX3(b,C1[r+2],C1[r+3]);} \
      float rm=__builtin_fmaxf(a,b); { auto rr=__builtin_amdgcn_permlane32_swap(__float_as_uint(rm),__float_as_uint(rm),false,false); rm=__builtin_fmaxf(__uint_as_float(rr[0]),__uint_as_float(rr[1])); } \
      resc=false; \
      if(__builtin_expect(__any(rm>(float)THRL),0)){ const float dl=__builtin_fmaxf(rm+30.f,0.f); mhat+=dl; \
        _Pragma("unroll") for(int r=0;r<16;++r){C0[r]-=dl;C1[r]-=dl;} \
        const float f=__builtin_amdgcn_exp2f(-dl); l_reg*=f; if(hi==0)wsf[r32]=f; resc=true; } } \
    SBAR(); \
    GAPB(o[0]=__builtin_amdgcn_mfma_f32_32x32x16_bf16(PAF(0),VFR(0),o[0],0,0,0), C0,0); \
    GAPB(o[1]=__builtin_amdgcn_mfma_f32_32x32x16_bf16(PAF(0),VFR(4),o[1],0,0,0), C0,4); \
    KRD(GL,0); GAPB(o[0]=__builtin_amdgcn_mfma_f32_32x32x16_bf16(PAF(1),VFR(1),o[0],0,0,0), C0,8); \
    KRD(GL,1); GAPB(o[1]=__builtin_amdgcn_mfma_f32_32x32x16_bf16(PAF(1),VFR(5),o[1],0,0,0), C0,12); \
    KRD(GL,2); GAPB(o[0]=__builtin_amdgcn_mfma_f32_32x32x16_bf16(PAF(2),VFR(2),o[0],0,0,0), C1,0); \
    KRD(GL,3); GAPB(o[1]=__builtin_amdgcn_mfma_f32_32x32x16_bf16(PAF(2),VFR(6),o[1],0,0,0), C1,4); \
    GAPB(o[0]=__builtin_amdgcn_mfma_f32_32x32x16_bf16(PAF(3),VFR(3),o[0],0,0,0), C1,8); \
    GAPB(o[1]=__builtin_amdgcn_mfma_f32_32x32x16_bf16(PAF(3),VFR(7),o[1],0,0,0), C1,12); \
    BIASINIT(P0,P1,(t)+1); SBAR(); \
    }while(0)
  int t=1;
  #undef CMASK
  #define CMASK(P0,P1,t) do{}while(0)
  for(;t+5<NT;t+=2){
    STEP(pB0,pB1,pA0,pA1,t,true,true,true);     WAIT_BAR(2); RESC(); ROT();
    STEP(pA0,pA1,pB0,pB1,t+1,true,true,true);   WAIT_BAR(2); RESC(); ROT();
  }
  #undef CMASK
  #define CMASK(P0,P1,t) do{int jb_=(t)-(NT-4); if(jb_>=0)cmask(P0,P1,jb_,qrel,hi);}while(0)
  #define ENDW(tt) do{ if((tt)+3<NT){WAIT_BAR(2);} else if((tt)+2<NT){WAIT_BAR(1);} else {WAIT_BAR(0);} }while(0)
  for(;t+1<NT;t+=2){
    STEP(pB0,pB1,pA0,pA1,t,(t+3<NT),(t+1<NT),(t+1<NT));       ENDW(t);   RESC(); ROT();
    STEP(pA0,pA1,pB0,pB1,t+1,(t+4<NT),(t+2<NT),(t+2<NT));     ENDW(t+1); RESC(); ROT();
  }
  STEP(pB0,pB1,pA0,pA1,NT-1,false,false,false); RESC();
  { float sacc=pB0[0]+pB0[1]; _Pragma("unroll") for(int r=2;r<16;++r)sacc+=pB0[r]; _Pragma("unroll") for(int r=0;r<16;++r)sacc+=pB1[r]; l_reg+=sacc;
    pw0=(u32x4){PKW(pB0,0),PKW(pB0,2),PKW(pB0,4),PKW(pB0,6)};pw1=(u32x4){PKW(pB0,8),PKW(pB0,10),PKW(pB0,12),PKW(pB0,14)};pw2=(u32x4){PKW(pB1,0),PKW(pB1,2),PKW(pB1,4),PKW(pB1,6)};pw3=(u32x4){PKW(pB1,8),PKW(pB1,10),PKW(pB1,12),PKW(pB1,14)};
    SBAR(); pv(o,vb0+sl_cur,PAF(0),PAF(1),PAF(2),PAF(3)); }
  #undef PKW
  #undef PAF
  #undef VFR
  #undef PIN
  #undef MX3
  #undef GAPA
  #undef GAPB
  #undef EX
  #undef VRD
  #undef KRD
  #undef STEP
  #undef ENDW
  {auto rr=__builtin_amdgcn_permlane32_swap(__float_as_uint(l_reg),__float_as_uint(l_reg),false,false);l_reg=__uint_as_float(rr[0])+__uint_as_float(rr[1]);}
  if(hi==0)wsf[32+r32]=l_reg;asm volatile("s_waitcnt lgkmcnt(0)":::"memory");
  float rli[16];
  #pragma unroll
  for(int r=0;r<16;++r)rli[r]=__builtin_amdgcn_rcpf(wsf[32+crow(r,hi)]);
  bf16*Ow=O+(long)(q0+wid*QBLK)*OPITCH;
  { bf16*stg=(bf16*)(shm+LDS_OST)+wid*2048;
    #pragma unroll
    for(int r=0;r<16;++r){const int orow=crow(r,hi);
      #pragma unroll
      for(int d0=0;d0<2;++d0)stg[orow*64+d0*32+r32]=__float2bfloat16(o[d0][r]*rli[r]);}
    asm volatile("s_waitcnt lgkmcnt(0)":::"memory");
    #pragma unroll
    for(int i=0;i<4;++i){const int row=i*8+(lane>>3),ch=lane&7; const u32x4 v=*(const u32x4*)(stg+row*64+ch*8); ATTN_STORE16(Ow+(long)row*OPITCH+ch*8,v);} }
  asm volatile("s_waitcnt lgkmcnt(0)\n\ts_barrier":::"memory");
  #undef DMA_K
  #undef DMA_V
  #undef CMASK
  #undef BIAS
  #undef BIASINIT
  #undef START
  #undef RESC
  #undef ROT
}
constexpr int SB_NS=8, SB_V=65536, SB_FLAGS=131072;
__device__ __forceinline__ void sb_unit(int qb,const bf16*Q,const bf16*__restrict__ K,const bf16*__restrict__ V,bf16*O,char*shm){
  int tid_=threadIdx.x; asm volatile("":"+v"(tid_)); const int tid=tid_,lane=tid&63,r32=lane&31,hi=lane>>5; const int wid=__builtin_amdgcn_readfirstlane(tid>>6);
  const int q0=qb*QB;
  const bf16*Qw=Q+(long)(q0+wid*QBLK)*DM;
  const unsigned lds0=(unsigned)(uintptr_t)shm;
  typedef __attribute__((address_space(3))) int lds_i32; typedef __attribute__((address_space(3))) const u32x4* lds_u4ptr;
  lds_i32*flags=(lds_i32*)((lds_cptr)shm+SB_FLAGS);
  const bf16*ksrc=K+(long)lane*DM+wid*8;
  const bf16*vsrc=V+(long)(16*(wid&3)+(lane>>2))*DM+(wid>>2)*32+(lane&3)*8;
  const unsigned kdst=lds0+wid*1024, vdst=lds0+SB_V+wid*1024;
  #define DMA_K(t,slot) glds16(ksrc+(long)(t)*KVBLK*DM,(unsigned)__builtin_amdgcn_readfirstlane(kdst+(slot)))
  #define DMA_V(t,slot) glds16(vsrc+(long)(t)*KVBLK*DM,(unsigned)__builtin_amdgcn_readfirstlane(vdst+(slot)))
  const int vb0=(int)(lds0+SB_V)+((lane>>4)&1)*32+(lane&3)*8+(4*hi+((lane&15)>>2))*64;
  const int NT=(q0+QB)/KVBLK;
  bf16x8 qr[4];
  #pragma unroll
  for(int d0=0;d0<4;++d0)qr[d0]=*reinterpret_cast<const bf16x8*>(&Qw[(long)r32*DM+d0*16+hi*8]);
  f32x16 o[2];o[0]=f32x16{};o[1]=f32x16{};
  float T=1.0f; const int t_abs=q0+wid*QBLK+r32; bool wdone=false;
  for(int jtop=NT-1;;jtop-=SB_NS){
    const int nb=(jtop+1<SB_NS)?jtop+1:SB_NS;
    for(int s=0;s<nb;++s){DMA_K(jtop-s,s*SLOTB);DMA_V(jtop-s,s*SLOTB);}
    WAIT_BAR(0);
    int s=(jtop==NT-1)?3-(wid>>1):0;
    for(;s<nb&&!wdone;++s){
      const int jt=jtop-s; const int slot=s*SLOTB; const bool band=(jt>=NT-4);
      f32x16 x0,x1; { f32x16 zero=f32x16{}; qkt(x0,x1,shm+slot,qr,zero,r32,hi); }
      f32x16 n0,n1;
      const int kb=64*jt+4*hi;
      #pragma unroll
      for(int r=0;r<16;++r){
        const float z0=x0[r],z1=x1[r];
        const float e0=__builtin_amdgcn_exp2f(-__builtin_fabsf(z0)), e1=__builtin_amdgcn_exp2f(-__builtin_fabsf(z1));
        const float r0=__builtin_amdgcn_rcpf(1.0f+e0), r1=__builtin_amdgcn_rcpf(1.0f+e1), er0=e0*r0, er1=e1*r1;
        float b0=z0>0.f?r0:er0, m0=z0>0.f?er0:r0, b1=z1>0.f?r1:er1, m1=z1>0.f?er1:r1;
        if(band){ const int kv=kb+(r&3)+8*(r>>2); if(!(kv<t_abs)){b0=0.f;m0=1.f;} if(!(kv+32<t_abs)){b1=0.f;m1=1.f;} }
        x0[r]=b0;x1[r]=b1;n0[r]=m0;n1[r]=m1;
      }
      float g0[4],g1[4],p0s[4],p1s[4];
      #pragma unroll
      for(int a=0;a<4;++a){ g0[a]=(n0[4*a]*n0[4*a+1])*(n0[4*a+2]*n0[4*a+3]); g1[a]=(n1[4*a]*n1[4*a+1])*(n1[4*a+2]*n1[4*a+3]);
        { auto rr=__builtin_amdgcn_permlane32_swap(__float_as_uint(g0[a]),__float_as_uint(g0[a]),false,false); p0s[a]=__uint_as_float(hi?rr[0]:rr[1]); }
        { auto rr=__builtin_amdgcn_permlane32_swap(__float_as_uint(g1[a]),__float_as_uint(g1[a]),false,false); p1s[a]=__uint_as_float(hi?rr[0]:rr[1]); } }
      float run=T;
      #pragma unroll
      for(int a=3;a>=0;--a){ const float off=hi?run:run*p1s[a]; run*=g1[a]*p1s[a];
        const float t3=off,t2=t3*n1[4*a+3],t1=t2*n1[4*a+2],t0=t1*n1[4*a+1];
        x1[4*a+3]*=t3; x1[4*a+2]*=t2; x1[4*a+1]*=t1; x1[4*a]*=t0; }
      #pragma unroll
      for(int a=3;a>=0;--a){ const float off=hi?run:run*p0s[a]; run*=g0[a]*p0s[a];
        const float t3=off,t2=t3*n0[4*a+3],t1=t2*n0[4*a+2],t0=t1*n0[4*a+1];
        x0[4*a+3]*=t3; x0[4*a+2]*=t2; x0[4*a+1]*=t1; x0[4*a]*=t0; }
      T=run;
      u32x4 pw0,pw1,pw2,pw3;
      pw0=(u32x4){cvtpk_s(x0[0],x0[1]),cvtpk_s(x0[2],x0[3]),cvtpk_s(x0[4],x0[5]),cvtpk_s(x0[6],x0[7])};
      pw1=(u32x4){cvtpk_s(x0[8],x0[9]),cvtpk_s(x0[10],x0[11]),cvtpk_s(x0[12],x0[13]),cvtpk_s(x0[14],x0[15])};
      pw2=(u32x4){cvtpk_s(x1[0],x1[1]),cvtpk_s(x1[2],x1[3]),cvtpk_s(x1[4],x1[5]),cvtpk_s(x1[6],x1[7])};
      pw3=(u32x4){cvtpk_s(x1[8],x1[9]),cvtpk_s(x1[10],x1[11]),cvtpk_s(x1[12],x1[13]),cvtpk_s(x1[14],x1[15])};
      SBAR(); pv(o,vb0+slot,__builtin_bit_cast(bf16x8,pw0),__builtin_bit_cast(bf16x8,pw1),__builtin_bit_cast(bf16x8,pw2),__builtin_bit_cast(bf16x8,pw3));
      wdone=__all(T<1.2e-38f);
    }
    if(lane==0)flags[wid]=wdone?1:0;
    WAIT_BAR(0);
    const u32x4 f0=*(lds_u4ptr)(flags), f1=*(lds_u4ptr)(flags+4);
    const bool alld=((f0.x&f0.y&f0.z&f0.w)&(f1.x&f1.y&f1.z&f1.w))!=0;
    if(alld||jtop<SB_NS)break;
    WAIT_BAR(0);
  }
  bf16*Ow=O+(long)(q0+wid*QBLK)*OPITCH;
  { bf16*stg=(bf16*)(shm)+wid*2048;
    #pragma unroll
    for(int r=0;r<16;++r){const int orow=crow(r,hi);
      #pragma unroll
      for(int d0=0;d0<2;++d0)stg[orow*64+d0*32+r32]=__float2bfloat16(o[d0][r]);}
    asm volatile("s_waitcnt lgkmcnt(0)":::"memory");
    #pragma unroll
    for(int i=0;i<4;++i){const int row=i*8+(lane>>3),ch=lane&7; const u32x4 v=*(const u32x4*)(stg+row*64+ch*8); ATTN_STORE16(Ow+(long)row*OPITCH+ch*8,v);} }
  asm volatile("s_waitcnt lgkmcnt(0)\n\ts_barrier":::"memory");
  #undef DMA_K
  #undef DMA_V
}
#undef SBAR
#undef WAIT_BAR
}

constexpr int BATCH = 8, SEQ = 4096, DM = 1024, DEPTH = 4, M = BATCH * SEQ, INC = 3334, NIN = 3584, DFF = 4096;
constexpr float EPS = 1e-6f;
constexpr size_t MiB = 1u << 20;
constexpr size_t WS_BAR = 128 * 1024;
constexpr size_t WS_SS = 1 * MiB;
constexpr size_t WS_LB = 3 * MiB;
constexpr size_t WS_JS = 3 * MiB + 256 * 1024;
constexpr size_t WS_DD = 3 * MiB + 512 * 1024;
constexpr size_t WS_W = 4 * MiB;
constexpr size_t W_LAYER = 25 * MiB, W_OUT = 7 * MiB, W_1 = 9 * MiB, W_2 = 17 * MiB;
constexpr size_t WS_XB = 104 * MiB;
constexpr size_t WS_P = 168 * MiB;
constexpr size_t P_HQ = 0, P_HK = 16 * MiB, P_HI = 32 * MiB, P_HG = 48 * MiB, P_HLF = 64 * MiB, P_SQ = 96 * MiB, P_FQ = 168 * MiB, P_LF = 240 * MiB, P_CC = 241 * MiB, P_US = 242 * MiB;
constexpr size_t HEADBUF = 24 * MiB;
constexpr size_t WS_MIX = 442 * MiB;
constexpr size_t WS_U = 168 * MiB;
constexpr size_t WS_END = 506 * MiB;
constexpr int LDS_BYTES = 147456;

typedef pg8::bf16_t bf16_t;
typedef pg8::f32x4 f32x4;
typedef unsigned u32x4 __attribute__((ext_vector_type(4)));
typedef unsigned u32x2 __attribute__((ext_vector_type(2)));
#define LAS __attribute__((address_space(3)))

__device__ __forceinline__ unsigned f2bf(float f) { unsigned u = __builtin_bit_cast(unsigned, f); return (u + 0x7fffu + ((u >> 16) & 1u)) >> 16; }
__device__ __forceinline__ unsigned pk2(float lo, float hi) { return pg8::cvt_pk_bf16(lo, hi); }
__device__ __forceinline__ float bf2f(unsigned short b) { return __builtin_bit_cast(float, (unsigned)b << 16); }
__device__ __forceinline__ float bflo(unsigned w) { return __builtin_bit_cast(float, w << 16); }
__device__ __forceinline__ float bfhi(unsigned w) { return __builtin_bit_cast(float, w & 0xffff0000u); }
__device__ __forceinline__ float logsig(float x) { return fminf(x, 0.f) - log1pf(expf(-fabsf(x))); }
__device__ __forceinline__ float wave_sum(float v) {
#pragma unroll
    for (int o = 1; o < 64; o <<= 1) v += __shfl_xor(v, o);
    return v;
}
#define ROWSCALES8(rs, ss, row0, fq) float rs[2][4]; _Pragma("unroll") for (int ai_ = 0; ai_ < 2; ++ai_) _Pragma("unroll") for (int m_ = 0; m_ < 4; ++m_) rs[ai_][m_] = rowscale(ss, (row0) + ai_ * 128 + m_ * 16, fq);
__device__ __forceinline__ float rowscale(const float* ss, int row, int fq) {
    const f32x4 p = *(const f32x4*)(ss + (size_t)row * 16 + 4 * fq);
    float s = (p[0] + p[1]) + (p[2] + p[3]);
    s += __shfl_xor(s, 16); s += __shfl_xor(s, 32);
    return rsqrtf(s * (1.0f / DM) + EPS);
}

#define ROWFENCE() asm volatile("" ::: "memory")
struct EpiResid {
    static constexpr bool PERM = true, AFTER_DRAIN = false;
    bf16_t* xb; float* outf; float* ss;
    __device__ __forceinline__ void operator()(const f32x4 (&acc)[2][2][4][2], const pg8::Unit& u, int wr, int wc, int fr, int fq) const {
        const int row0 = u.pm * 256 + wr * 64 + fr, col0 = u.pn * 256 + wc * 32 + 8 * fq;
#pragma unroll
        for (int ai = 0; ai < 2; ++ai) {
            u32x4 pre[4][2];
#pragma unroll
            for (int m = 0; m < 4; ++m)
#pragma unroll
                for (int bj = 0; bj < 2; ++bj) pre[m][bj] = *(const u32x4*)(xb + (size_t)(row0 + ai * 128 + m * 16) * DM + col0 + bj * 128);
#pragma unroll
            for (int m = 0; m < 4; ++m) {
                const int row = row0 + ai * 128 + m * 16; float sq = 0.f;
#pragma unroll
                for (int bj = 0; bj < 2; ++bj) {
                    const size_t off = (size_t)row * DM + col0 + bj * 128; const u32x4 p = pre[m][bj];
                    const f32x4 v0 = acc[ai][bj][m][0] + (f32x4){bflo(p.x), bfhi(p.x), bflo(p.y), bfhi(p.y)}, v1 = acc[ai][bj][m][1] + (f32x4){bflo(p.z), bfhi(p.z), bflo(p.w), bfhi(p.w)};
                    if (outf) { *(f32x4*)(outf + off) = v0; *(f32x4*)(outf + off + 4) = v1; }
                    else {
                        u32x4 w; w.x = pk2(v0[0], v0[1]); w.y = pk2(v0[2], v0[3]); w.z = pk2(v1[0], v1[1]); w.w = pk2(v1[2], v1[3]);
                        *(u32x4*)(xb + off) = w;
                        sq += (v0[0] * v0[0] + v0[1] * v0[1]) + (v0[2] * v0[2] + v0[3] * v0[3]) + (v1[0] * v1[0] + v1[1] * v1[1]) + (v1[2] * v1[2] + v1[3] * v1[3]);
                    }
                }
                if (!outf) {
                    sq += __shfl_xor(sq, 16); sq += __shfl_xor(sq, 32);
                    if (fq == 0) ss[(size_t)row * 16 + u.pn * 4 + wc] = sq;
                }
            }
            ROWFENCE();
        }
    }
};
struct EpiRelu2 {
    static constexpr bool PERM = true, AFTER_DRAIN = false;
    bf16_t* U; const float* ss;
    __device__ __forceinline__ void operator()(const f32x4 (&acc)[2][2][4][2], const pg8::Unit& u, int wr, int wc, int fr, int fq) const {
        const int row0 = u.pm * 256 + wr * 64 + fr, col0 = u.pn * 256 + wc * 32 + 8 * fq;
        ROWSCALES8(rs8, ss, row0, fq)
#pragma unroll
        for (int ai = 0; ai < 2; ++ai)
#pragma unroll
            for (int m = 0; m < 4; ++m) {
                const int row = row0 + ai * 128 + m * 16; const float rs = rs8[ai][m];
#pragma unroll
                for (int bj = 0; bj < 2; ++bj) {
                    f32x4 v0 = acc[ai][bj][m][0] * rs, v1 = acc[ai][bj][m][1] * rs;
                    v0 = __builtin_elementwise_max(v0, (f32x4){0.f, 0.f, 0.f, 0.f}); v1 = __builtin_elementwise_max(v1, (f32x4){0.f, 0.f, 0.f, 0.f});
                    v0 = v0 * v0; v1 = v1 * v1;
                    u32x4 w; w.x = pk2(v0[0], v0[1]); w.y = pk2(v0[2], v0[3]); w.z = pk2(v1[0], v1[1]); w.w = pk2(v1[2], v1[3]);
                    *(u32x4*)(U + (size_t)row * DFF + col0 + bj * 128) = w;
                }
                ROWFENCE();
            }
    }
};
struct EpiInProj {
    static constexpr bool PERM = true, AFTER_DRAIN = false;
    const float* ss; unsigned char* P; const float* lbt;
    const float* gt; const float* fbias;
    __device__ __forceinline__ void operator()(const f32x4 (&acc)[2][2][4][2], const pg8::Unit& u, int wr, int wc, int fr, int fq) const {
        const int slot = u.pn * 4 + wc;
        if (slot > 52) return;
        const int row0 = u.pm * 256 + wr * 64 + fr;
        ROWSCALES8(rs8, ss, row0, fq)
        if (slot < 16) {
            const int kind = slot >> 2, cb = (slot & 3) * 64 + 8 * fq;
            if (kind == 1) {
                float* HLF = (float*)(P + P_HLF); bf16_t* HK = (bf16_t*)(P + P_HK);
#pragma unroll
                for (int ai = 0; ai < 2; ++ai)
#pragma unroll
                    for (int m = 0; m < 4; ++m) {
                        const int row = row0 + ai * 128 + m * 16; const float rs = rs8[ai][m];
#pragma unroll
                        for (int bj = 0; bj < 2; ++bj) {
                            float lf[8], kk[8];
#pragma unroll
                            for (int n = 0; n < 2; ++n) {
                                const f32x4 ll = *(const f32x4*)(lbt + cb + 32 * bj + 4 * n), om = *(const f32x4*)(lbt + 256 + cb + 32 * bj + 4 * n);
#pragma unroll
                                for (int i = 0; i < 4; ++i) {
                                    const float fl = acc[ai][bj][m][n][i] * rs;
                                    const float a = fminf(fl, 0.f) - __logf(1.0f + __expf(-fabsf(fl)));
                                    const float an = a - fl;
                                    const float b = ll[i] + an;
                                    lf[4 * n + i] = fmaxf(a, b) + __logf(1.0f + __expf(-fabsf(a - b)));
                                    kk[4 * n + i] = om[i] * __expf(an);
                                }
                            }
                            const size_t off = (size_t)row * 256 + cb + 32 * bj;
                            *(f32x4*)(HLF + off) = (f32x4){lf[0], lf[1], lf[2], lf[3]}; *(f32x4*)(HLF + off + 4) = (f32x4){lf[4], lf[5], lf[6], lf[7]};
                            u32x4 w; w.x = pk2(kk[0], kk[1]); w.y = pk2(kk[2], kk[3]); w.z = pk2(kk[4], kk[5]); w.w = pk2(kk[6], kk[7]);
                            *(u32x4*)(HK + off) = w;
                        }
                        ROWFENCE();
                    }
            } else {
                bf16_t* dst = (bf16_t*)(P + (kind == 0 ? P_HQ : (kind == 2 ? P_HI : P_HG)));
#pragma unroll
                for (int ai = 0; ai < 2; ++ai)
#pragma unroll
                    for (int m = 0; m < 4; ++m) {
                        const int row = row0 + ai * 128 + m * 16; const float rs = rs8[ai][m];
#pragma unroll
                        for (int bj = 0; bj < 2; ++bj) {
                            const f32x4 v0 = acc[ai][bj][m][0] * rs, v1 = acc[ai][bj][m][1] * rs;
                            u32x4 w; w.x = pk2(v0[0], v0[1]); w.y = pk2(v0[2], v0[3]); w.z = pk2(v1[0], v1[1]); w.w = pk2(v1[2], v1[3]);
                            *(u32x4*)(dst + (size_t)row * 256 + cb + 32 * bj) = w;
                        }
                        ROWFENCE();
                    }
            }
        } else if (slot < 52) {
            const int s2 = slot - 16, grp = s2 / 6, h = s2 % 6, role = grp % 3;
            bf16_t* dst = (bf16_t*)(P + P_SQ + (size_t)grp * HEADBUF) + (size_t)((u.pm >> 4) * 6 + h) * SEQ * 64 + 8 * fq;
            const float* gp = gt + (grp - (grp >= 3 ? 1 : 0)) * 64 + 8 * fq;
            const float qs = (role == 0) ? 0.125f * 1.4426950408889634f : 1.0f;
            f32x4 gv[2][2];
#pragma unroll
            for (int bj = 0; bj < 2; ++bj)
#pragma unroll
                for (int n = 0; n < 2; ++n) gv[bj][n] = (role != 2) ? *(const f32x4*)(gp + 32 * bj + 4 * n) * qs : (f32x4){1.f, 1.f, 1.f, 1.f};
#pragma unroll
            for (int ai = 0; ai < 2; ++ai)
#pragma unroll
                for (int m = 0; m < 4; ++m) {
                    const int row = row0 + ai * 128 + m * 16; const float rs = rs8[ai][m];
                    float fac = rs;
                    if (role != 2) {
                        float sq = 0.f;
#pragma unroll
                        for (int bj = 0; bj < 2; ++bj)
#pragma unroll
                            for (int n = 0; n < 2; ++n) { const f32x4 x = acc[ai][bj][m][n]; sq += (x[0] * x[0] + x[1] * x[1]) + (x[2] * x[2] + x[3] * x[3]); }
                        sq += __shfl_xor(sq, 16); sq += __shfl_xor(sq, 32);
                        fac = rs * rsqrtf(rs * rs * sq * (1.0f / 64.0f) + EPS);
                    }
                    const int t = row & (SEQ - 1);
#pragma unroll
                    for (int bj = 0; bj < 2; ++bj) {
                        const f32x4 v0 = acc[ai][bj][m][0] * fac * gv[bj][0], v1 = acc[ai][bj][m][1] * fac * gv[bj][1];
                        u32x4 w; w.x = pk2(v0[0], v0[1]); w.y = pk2(v0[2], v0[3]); w.z = pk2(v1[0], v1[1]); w.w = pk2(v1[2], v1[3]);
                        *(u32x4*)(dst + (size_t)t * 64 + 32 * bj) = w;
                    }
                    ROWFENCE();
                }
        } else {
            float* LF = (float*)(P + P_LF);
#pragma unroll
            for (int ai = 0; ai < 2; ++ai)
#pragma unroll
                for (int m = 0; m < 4; ++m) {
                    const int row = row0 + ai * 128 + m * 16; const float rs = rs8[ai][m];
                    if (fq == 0) {
                        const f32x4 a0 = acc[ai][0][m][0], a1 = acc[ai][0][m][1];
                        *(f32x4*)(LF + (size_t)row * 8) = (f32x4){logsig(a0[0] * rs + fbias[0]), logsig(a0[1] * rs + fbias[1]), logsig(a0[2] * rs + fbias[2]), logsig(a0[3] * rs + fbias[3])};
                        *(f32x4*)(LF + (size_t)row * 8 + 4) = (f32x4){logsig(a1[0] * rs + fbias[4]), logsig(a1[1] * rs + fbias[5]), 0.f, 0.f};
                    }
                    ROWFENCE();
                }
        }
    }
};
#define XB_TMO      128
#define XB_XCNT(j)  (256  + 64 * (j))
#define XB_XSUB(j)  (1280 + 64 * (j))
#define XB_XGEN(j)  (2304 + 64 * (j))
#define XB_TOP      3328
#define XB_TOPGEN   3392
#define XCD_BAR_WORDS 3456
#define XB_SPIN_CAP (1u << 18)

__device__ __forceinline__ unsigned xb_ld(unsigned* p)              { return __hip_atomic_load(p, __ATOMIC_RELAXED, __HIP_MEMORY_SCOPE_AGENT); }
__device__ __forceinline__ unsigned xb_add(unsigned* p, unsigned v) { return __hip_atomic_fetch_add(p, v, __ATOMIC_RELAXED, __HIP_MEMORY_SCOPE_AGENT); }
__device__ __forceinline__ unsigned xb_xcc_id() { return (unsigned)__builtin_amdgcn_s_getreg((3 << 11) | 20) & 0xFu; }
#define XB_SPIN(cond, bar) do { unsigned _sp = 0; while (cond) { __builtin_amdgcn_s_sleep(1); \
    if ((++_sp & 255u) == 0u) { if (xb_ld(&(bar)[XB_TMO])) break; if (_sp > XB_SPIN_CAP) { atomicAdd(&(bar)[XB_TMO], 1u); break; } } } } while (0)

struct XcdBarrier {
    unsigned* bar; unsigned x;
    volatile LAS unsigned* st;
};

__device__ __forceinline__ XcdBarrier xcd_barrier_post(unsigned* bar, volatile LAS unsigned* st) {
    XcdBarrier b; b.bar = bar; b.x = xb_xcc_id(); b.st = st;
    if (threadIdx.x == 0) (void)xb_add(&bar[XB_XCNT(b.x)], 1u);
    return b;
}
__device__ __forceinline__ void xcd_barrier_complete(unsigned* bar, unsigned x, unsigned& nloc, unsigned& nx) {
    const unsigned G = gridDim.x * gridDim.y * gridDim.z;
    unsigned sum, cnt, mine, sp = 0u;
    for (;;) {
        sum = 0u; cnt = 0u; mine = 0u;
#pragma unroll
        for (unsigned j = 0; j < 16; ++j) { const unsigned c = xb_ld(&bar[XB_XCNT(j)]); sum += c; cnt += (c > 0u) ? 1u : 0u; mine = (j == x) ? c : mine; }
        if (sum == G) break;
        __builtin_amdgcn_s_sleep(1);
        if ((++sp & 255u) == 0u) { if (xb_ld(&bar[XB_TMO])) break; if (sp > XB_SPIN_CAP) { atomicAdd(&bar[XB_TMO], 1u); break; } }
    }
    nloc = mine > 0u ? mine : 1u; nx = cnt > 0u ? cnt : 1u;
}

__device__ __forceinline__ void xcd_barrier(const XcdBarrier& b) {
    asm volatile("s_waitcnt vmcnt(0)" ::: "memory");
    __syncthreads();
    if (threadIdx.x == 0) {
        unsigned* bar = b.bar;
        __builtin_amdgcn_s_waitcnt(0);
        unsigned nloc = b.st[0], nx = b.st[1];
        if (nloc == 0u) { xcd_barrier_complete(bar, b.x, nloc, nx); b.st[0] = nloc; b.st[1] = nx; }
        const unsigned old = xb_add(&bar[XB_XSUB(b.x)], 1u);
        const unsigned gen = old / nloc;
        if (old + 1u == (gen + 1u) * nloc) {
            __builtin_amdgcn_fence(__ATOMIC_RELEASE, "agent");
            asm volatile("s_waitcnt vmcnt(0)" ::: "memory");
            const unsigned og = xb_add(&bar[XB_TOP], 1u);
            const unsigned tg = og / nx;
            if (og + 1u == (tg + 1u) * nx) xb_add(&bar[XB_TOPGEN], 1u);
            else XB_SPIN(xb_ld(&bar[XB_TOPGEN]) == tg, bar);
            __builtin_amdgcn_fence(__ATOMIC_ACQUIRE, "agent");
            xb_add(&bar[XB_XGEN(b.x)], 1u);
            asm volatile("s_waitcnt vmcnt(0)" ::: "memory");
        } else {
            XB_SPIN(xb_ld(&bar[XB_XGEN(b.x)]) == gen, bar);
            __builtin_amdgcn_fence(__ATOMIC_ACQUIRE, "agent");
            asm volatile("s_waitcnt vmcnt(0)" ::: "memory");
        }
    }
    __syncthreads();
}

__device__ __forceinline__ void tr_item(const float* W, int ldw, int ncols_valid, int src_col0, int k0, const float* gain, bf16_t* WT, int K, int n0, LAS float* scr, int lane) {
#pragma unroll 8
    for (int i = 0; i < 32; ++i) { const int kk = 2 * i + (lane >> 5), c = src_col0 + (lane & 31);
        float v = (c < ncols_valid) ? W[(size_t)(k0 + kk) * ldw + c] : 0.f; if (gain) v *= gain[k0 + kk]; scr[kk * 33 + (lane & 31)] = v; }
    asm volatile("s_waitcnt lgkmcnt(0)" ::: "memory");
    const int c = lane & 7;
#pragma unroll
    for (int j = 0; j < 4; ++j) { const int n = (lane >> 3) + 8 * j; const LAS float* s = scr + (8 * c) * 33 + n;
        u32x4 o; o.x = pk2(s[0 * 33], s[1 * 33]); o.y = pk2(s[2 * 33], s[3 * 33]); o.z = pk2(s[4 * 33], s[5 * 33]); o.w = pk2(s[6 * 33], s[7 * 33]);
        *(u32x4*)(WT + (size_t)(n0 + n) * K + k0 + 8 * c) = o; }
    asm volatile("s_waitcnt lgkmcnt(0)" ::: "memory");
}

__device__ __forceinline__ void unpack8(const u32x4 w, float* d) { d[0] = bflo(w.x); d[1] = bfhi(w.x); d[2] = bflo(w.y); d[3] = bfhi(w.y); d[4] = bflo(w.z); d[5] = bfhi(w.z); d[6] = bflo(w.w); d[7] = bfhi(w.w); }

__device__ __forceinline__ void fox_cumsum_item(int bh, const float* LF, float* CC, int* JS, const float* gq, const float* gk, LAS float* sc) {
    int tid_ = threadIdx.x; asm volatile("" : "+v"(tid_)); const int tid = tid_, lane = tid & 63, wave = tid >> 6, b = bh / 6, h = bh % 6;
    float v[8]; float run = 0.f;
#pragma unroll
    for (int i = 0; i < 8; ++i) { run += LF[((size_t)b * SEQ + tid * 8 + i) * 8 + h]; v[i] = run; }
    float s = run;
#pragma unroll
    for (int o = 1; o < 64; o <<= 1) { const float n = __shfl_up(s, o); if (lane >= o) s += n; }
    __syncthreads();
    if (lane == 63) sc[wave] = s;
    __syncthreads();
    float base = s - run;
    for (int w = 0; w < wave; ++w) base += sc[w];
    LAS float* cl = sc + 64;
#pragma unroll
    for (int i = 0; i < 8; ++i) { const float c2 = (v[i] + base) * 1.4426950408889634f; CC[(size_t)bh * SEQ + tid * 8 + i] = c2; cl[tid * 8 + i] = c2; }
    __syncthreads();
    if (tid < 16) {
        float mq = 0.f, mk = 0.f;
        for (int d = 0; d < 64; ++d) { mq = fmaxf(mq, fabsf(gq[d])); mk = fmaxf(mk, fabsf(gk[d])); }
        const float zb = 1.4426950408889634f * 8.0f * mq * mk * 1.03f + 1.0f;
        const float thr = -(126.0f + 2.0f * zb);
        const int q0 = tid * 256, nt = q0 / 64 + 4; const float cq = cl[q0];
        int j = 0; while (j < nt - 4 && cq - cl[64 * j + 63] < thr) ++j;
        JS[bh * 16 + tid] = j & ~1;
    }
    __syncthreads();
}

__device__ __forceinline__ void stage_kv(const bf16_t* Kb, const bf16_t* Vb, int kt, LAS float* Kf, LAS float* Vf) {
    int tid_ = threadIdx.x; asm volatile("" : "+v"(tid_)); const int tid = tid_, key = tid >> 3, c8 = tid & 7;
    const u32x4 kw = *(const u32x4*)(Kb + ((size_t)(kt * 64 + key)) * 64 + c8 * 8), vw = *(const u32x4*)(Vb + ((size_t)(kt * 64 + key)) * 64 + c8 * 8);
    float kf[8], vf[8]; unpack8(kw, kf); unpack8(vw, vf);
    *(LAS f32x4*)(Kf + key * 64 + c8 * 8) = (f32x4){kf[0], kf[1], kf[2], kf[3]}; *(LAS f32x4*)(Kf + key * 64 + c8 * 8 + 4) = (f32x4){kf[4], kf[5], kf[6], kf[7]};
    *(LAS f32x4*)(Vf + key * 64 + c8 * 8) = (f32x4){vf[0], vf[1], vf[2], vf[3]}; *(LAS f32x4*)(Vf + key * 64 + c8 * 8 + 4) = (f32x4){vf[4], vf[5], vf[6], vf[7]};
}

__device__ __forceinline__ void fox_naive_item(int item, unsigned char* P, bf16_t* MIX, LAS float* lds) {
    int tid_ = threadIdx.x; asm volatile("" : "+v"(tid_)); const int tid = tid_, bh = item >> 3, qblk = item & 7, b = bh / 6, h = bh % 6, t = qblk * 512 + tid;
    const bf16_t* Qp = (const bf16_t*)(P + P_FQ) + ((size_t)bh * SEQ + t) * 64;
    const bf16_t* Kb = (const bf16_t*)(P + P_FQ + HEADBUF) + (size_t)bh * SEQ * 64;
    const bf16_t* Vb = (const bf16_t*)(P + P_FQ + 2 * HEADBUF) + (size_t)bh * SEQ * 64;
    const float* CC = (const float*)(P + P_CC) + (size_t)bh * SEQ;
    float q[64], o[64];
#pragma unroll
    for (int c = 0; c < 8; ++c) unpack8(*(const u32x4*)(Qp + c * 8), q + c * 8);
#pragma unroll
    for (int d = 0; d < 64; ++d) o[d] = 0.f;
    float m = -1e30f, l = 0.f; const float ct = CC[t];
    LAS float* Kf = lds; LAS float* Vf = lds + 4096; LAS float* cs = lds + 8192;
    const int ntile = (qblk + 1) * 8;
    for (int kt = 0; kt < ntile; ++kt) {
        __syncthreads();
        stage_kv(Kb, Vb, kt, Kf, Vf); if (tid < 64) cs[tid] = CC[kt * 64 + tid];
        __syncthreads();
        for (int s = 0; s < 64; ++s) {
            float z = 0.f;
#pragma unroll
            for (int d = 0; d < 64; ++d) z += q[d] * Kf[s * 64 + d];
            const float x = (kt * 64 + s <= t) ? z + (ct - cs[s]) : -1e30f;
            const float mn = fmaxf(m, x), sc = __expf(m - mn), p = __expf(x - mn);
            l = l * sc + p;
#pragma unroll
            for (int d = 0; d < 64; ++d) o[d] = o[d] * sc + p * Vf[s * 64 + d];
            m = mn;
        }
    }
    const float inv = 1.0f / l;
    bf16_t* op = MIX + ((size_t)b * SEQ + t) * DM + 640 + h * 64;
#pragma unroll
    for (int c = 0; c < 8; ++c) { u32x4 w; w.x = pk2(o[c * 8] * inv, o[c * 8 + 1] * inv); w.y = pk2(o[c * 8 + 2] * inv, o[c * 8 + 3] * inv); w.z = pk2(o[c * 8 + 4] * inv, o[c * 8 + 5] * inv); w.w = pk2(o[c * 8 + 6] * inv, o[c * 8 + 7] * inv); *(u32x4*)(op + c * 8) = w; }
}

__device__ __forceinline__ void sb_naive_item(int item, unsigned char* P, bf16_t* MIX, LAS float* lds) {
    int tid_ = threadIdx.x; asm volatile("" : "+v"(tid_)); const int tid = tid_, bh = item >> 3, qblk = item & 7, b = bh / 6, h = bh % 6, t = qblk * 512 + tid;
    const bf16_t* Qp = (const bf16_t*)(P + P_SQ) + ((size_t)bh * SEQ + t) * 64;
    const bf16_t* Kb = (const bf16_t*)(P + P_SQ + HEADBUF) + (size_t)bh * SEQ * 64;
    const bf16_t* Vb = (const bf16_t*)(P + P_SQ + 2 * HEADBUF) + (size_t)bh * SEQ * 64;
    float q[64], o[64];
#pragma unroll
    for (int c = 0; c < 8; ++c) unpack8(*(const u32x4*)(Qp + c * 8), q + c * 8);
#pragma unroll
    for (int d = 0; d < 64; ++d) o[d] = 0.f;
    float tail = 0.f;
    LAS float* Kf = lds; LAS float* Vf = lds + 4096;
    for (int kt = qblk * 8 + 7; kt >= 0; --kt) {
        __syncthreads();
        stage_kv(Kb, Vb, kt, Kf, Vf);
        __syncthreads();
        for (int s = 63; s >= 0; --s) {
            float z = 0.f;
#pragma unroll
            for (int d = 0; d < 64; ++d) z += q[d] * Kf[s * 64 + d];
            const float ls = fminf(z, 0.f) - __logf(1.0f + __expf(-fabsf(z)));
            const bool act = (kt * 64 + s) < t;
            const float A = act ? __expf(ls + tail) : 0.f;
#pragma unroll
            for (int d = 0; d < 64; ++d) o[d] += A * Vf[s * 64 + d];
            tail += act ? (ls - z) : 0.f;
        }
        if (__syncthreads_and(tail < -100.f)) break;
    }
    bf16_t* op = MIX + ((size_t)b * SEQ + t) * DM + 256 + h * 64;
#pragma unroll
    for (int c = 0; c < 8; ++c) { u32x4 w; w.x = pk2(o[c * 8], o[c * 8 + 1]); w.y = pk2(o[c * 8 + 2], o[c * 8 + 3]); w.z = pk2(o[c * 8 + 4], o[c * 8 + 5]); w.w = pk2(o[c * 8 + 6], o[c * 8 + 7]); *(u32x4*)(op + c * 8) = w; }
}

__device__ __forceinline__ void hgrn_naive_item(int item, unsigned char* P, bf16_t* MIX, const float* hgn, LAS float* lds) {
    int tid_ = threadIdx.x; asm volatile("" : "+v"(tid_)); const int tid = tid_, lane = tid & 63, w = tid >> 6, kg = lane >> 3, vi = lane & 7, vcol = 8 * w + vi, b = item >> 2, h = item & 3;
    const bf16_t* HQ = (const bf16_t*)(P + P_HQ); const bf16_t* HK = (const bf16_t*)(P + P_HK); const bf16_t* HI = (const bf16_t*)(P + P_HI); const bf16_t* HG = (const bf16_t*)(P + P_HG);
    const float* HLF = (const float*)(P + P_HLF);
    LAS float* qf = lds; LAS float* kf = lds + 4096; LAS float* ff = lds + 8192; LAS float* vf = lds + 12288; LAS float* ob = lds + 16384;
    float S[8];
#pragma unroll
    for (int j = 0; j < 8; ++j) S[j] = 0.f;
    const int tok = tid >> 3, c8 = tid & 7;
    float gn[8];
#pragma unroll
    for (int e = 0; e < 8; ++e) gn[e] = hgn[c8 * 8 + e];
    for (int c = 0; c < 64; ++c) {
        const size_t off = ((size_t)b * SEQ + c * 64 + tok) * 256 + h * 64 + c8 * 8;
        __syncthreads();
        {
            float a[8];
            unpack8(*(const u32x4*)(HQ + off), a);
#pragma unroll
            for (int e = 0; e < 8; ++e) qf[tok * 64 + c8 * 8 + e] = a[e];
            unpack8(*(const u32x4*)(HK + off), a);
#pragma unroll
            for (int e = 0; e < 8; ++e) kf[tok * 64 + c8 * 8 + e] = a[e];
            unpack8(*(const u32x4*)(HI + off), a);
#pragma unroll
            for (int e = 0; e < 8; ++e) vf[tok * 64 + c8 * 8 + e] = a[e];
            const f32x4 l0 = *(const f32x4*)(HLF + off), l1 = *(const f32x4*)(HLF + off + 4);
#pragma unroll
            for (int e = 0; e < 4; ++e) { ff[tok * 64 + c8 * 8 + e] = expf(l0[e]); ff[tok * 64 + c8 * 8 + 4 + e] = expf(l1[e]); }
        }
        __syncthreads();
        for (int tk = 0; tk < 64; ++tk) {
            const float vv = vf[tk * 64 + vcol]; float op = 0.f;
#pragma unroll
            for (int j = 0; j < 8; ++j) { const int k = 8 * kg + j; S[j] = ff[tk * 64 + k] * S[j] + kf[tk * 64 + k] * vv; op += qf[tk * 64 + k] * S[j]; }
            op += __shfl_xor(op, 8); op += __shfl_xor(op, 16); op += __shfl_xor(op, 32);
            if (kg == 0) ob[tk * 64 + vcol] = op;
        }
        __syncthreads();
        {
            float ov[8], g[8]; float sq = 0.f;
#pragma unroll
            for (int e = 0; e < 8; ++e) { ov[e] = ob[tok * 64 + c8 * 8 + e]; sq += ov[e] * ov[e]; }
            sq += __shfl_xor(sq, 1); sq += __shfl_xor(sq, 2); sq += __shfl_xor(sq, 4);
            const float rn = rsqrtf(sq * (1.0f / 64.0f) + EPS);
            unpack8(*(const u32x4*)(HG + off), g);
            float r[8];
#pragma unroll
            for (int e = 0; e < 8; ++e) r[e] = ov[e] * rn * gn[e] * (g[e] / (1.0f + expf(-g[e])));
            u32x4 wv; wv.x = pk2(r[0], r[1]); wv.y = pk2(r[2], r[3]); wv.z = pk2(r[4], r[5]); wv.w = pk2(r[6], r[7]);
            *(u32x4*)(MIX + ((size_t)b * SEQ + c * 64 + tok) * DM + h * 64 + c8 * 8) = wv;
        }
    }
}

constexpr int HG_SLOT = 30720, HG_BP = 68  , HG_PRE = 64 * HG_BP * 4, HG_TOT = HG_PRE + 1280, HG_VT = 20480, HG_VP = 72;
static_assert(HG_TOT + 1024 <= HG_VT && HG_VT + 64 * HG_VP * 2 <= HG_SLOT, "HGRN LDS slot map");
typedef short hbf16x8 __attribute__((ext_vector_type(8)));
typedef short hbf16x4 __attribute__((ext_vector_type(4)));
__device__ __forceinline__ hbf16x8 pack8(const float* x) { u32x4 w; w.x = pk2(x[0], x[1]); w.y = pk2(x[2], x[3]); w.z = pk2(x[4], x[5]); w.w = pk2(x[6], x[7]); return __builtin_bit_cast(hbf16x8, w); }

__device__ __forceinline__ void hg_stage(int tid, size_t row0, int h, const float* HLF, const bf16_t* HI, LAS unsigned char* sb) {
    const int lt = tid & 127, k = lt & 63, half = lt >> 6;
    LAS float* bl = (LAS float*)sb; LAS float* pre = (LAS float*)(sb + HG_PRE); LAS float* tot = (LAS float*)(sb + HG_TOT); LAS bf16_t* vt = (LAS bf16_t*)(sb + HG_VT);
    float lfv[32];
#pragma unroll
    for (int i = 0; i < 32; ++i) lfv[i] = HLF[(row0 + 32 * half + i) * 256 + h * 64 + k];
    u32x4 vw[4];
    {
        const int s = lt & 63, c0 = half * 32;
#pragma unroll
        for (int q = 0; q < 4; ++q) vw[q] = *(const u32x4*)(HI + (row0 + s) * 256 + h * 64 + c0 + 8 * q);
    }
#pragma unroll
    for (int sg = 0; sg < 2; ++sg) { float run = 0.f;
#pragma unroll
        for (int i = 0; i < 16; ++i) { run += lfv[16 * sg + i]; bl[(32 * half + 16 * sg + i) * HG_BP + k] = run; }
        tot[(2 * half + sg) * 64 + k] = run; }
    {   const int s = lt & 63, c0 = half * 32;
#pragma unroll
        for (int q = 0; q < 4; ++q) { const unsigned ww[4] = {vw[q].x, vw[q].y, vw[q].z, vw[q].w};
#pragma unroll
            for (int e = 0; e < 4; ++e) { vt[(c0 + 8 * q + 2 * e) * HG_VP + s] = (bf16_t)(ww[e] & 0xffffu); vt[(c0 + 8 * q + 2 * e + 1) * HG_VP + s] = (bf16_t)(ww[e] >> 16); } } }
    __syncthreads();
    if (lt < 64) { float p = 0.f;
#pragma unroll
        for (int sg = 0; sg < 4; ++sg) { pre[sg * 64 + lt] = p; p += tot[sg * 64 + lt]; }
        pre[4 * 64 + lt] = p; }
    __syncthreads();
}

__device__ __forceinline__ void hgrn_a_item(int item, unsigned char* P, float* DD, LAS unsigned char* L) {
    int tid_ = threadIdx.x; asm volatile("" : "+v"(tid_)); const int tid = tid_, lane = tid & 63, wq = (tid >> 6) & 1, cs = tid >> 7, r = lane & 15, g = lane >> 4;
    const int bh = item >> 4, chunk = (item & 15) * 4 + cs, b = bh >> 2, h = bh & 3;
    const size_t row0 = (size_t)b * SEQ + chunk * 64;
    const bf16_t* HK = (const bf16_t*)(P + P_HK); float* UT = (float*)(P + P_US);
    LAS unsigned char* sb = L + cs * HG_SLOT;
    unsigned short kraw[2][2][8];
#pragma unroll
    for (int kt2 = 0; kt2 < 2; ++kt2)
#pragma unroll
        for (int ks = 0; ks < 2; ++ks)
#pragma unroll
            for (int j = 0; j < 8; ++j) kraw[kt2][ks][j] = HK[(row0 + 32 * ks + 8 * g + j) * 256 + h * 64 + 16 * (2 * wq + kt2) + r];
    hg_stage(tid, row0, h, (const float*)(P + P_HLF), (const bf16_t*)(P + P_HI), sb);
    const LAS float* bl = (const LAS float*)sb; const LAS float* pre = (const LAS float*)(sb + HG_PRE); const LAS unsigned char* vt = sb + HG_VT;
    float* ut = UT + ((size_t)(bh * 64 + chunk) * 64) * 64;
#pragma unroll
    for (int kt2 = 0; kt2 < 2; ++kt2) {
        const int kt = 2 * wq + kt2, k = 16 * kt + r; const float pre4 = pre[4 * 64 + k];
        hbf16x8 af[2];
#pragma unroll
        for (int ks = 0; ks < 2; ++ks) { const float pj = pre4 - pre[(2 * ks + (g >> 1)) * 64 + k]; float x[8];
#pragma unroll
            for (int j = 0; j < 8; ++j) { const int s = 32 * ks + 8 * g + j; x[j] = bf2f(kraw[kt2][ks][j]) * __expf(pj - bl[s * HG_BP + k]); }
            af[ks] = pack8(x); }
#pragma unroll
        for (int vtile = 0; vtile < 4; ++vtile) { f32x4 acc = {0.f, 0.f, 0.f, 0.f};
#pragma unroll
            for (int ks = 0; ks < 2; ++ks) { const hbf16x8 bf = *(const LAS hbf16x8*)(vt + (16 * vtile + r) * (HG_VP * 2) + (32 * ks + 8 * g) * 2); acc = __builtin_amdgcn_mfma_f32_16x16x32_bf16(af[ks], bf, acc, 0, 0, 0); }
            *(f32x4*)(ut + (size_t)(16 * vtile + r) * 64 + 16 * kt + 4 * g) = acc; }
        if (g == 0) DD[(size_t)(bh * 64 + chunk) * 64 + k] = __expf(pre4);
    }
}

__device__ __forceinline__ void hgrn_b_scan(int bx, int G, unsigned char* P, const float* DD) {
    int tid_ = threadIdx.x; asm volatile("" : "+v"(tid_));
    float* UT = (float*)(P + P_US);
    for (int gid = bx * 512 + tid_; gid < 32 * 4096; gid += G * 512) {
        const int bh = gid >> 12, e = gid & 4095; float* u = UT + (size_t)bh * 64 * 4096 + e; const float* dd = DD + (size_t)bh * 64 * 64 + (e & 63);
        float S = 0.f;
        for (int c0 = 0; c0 < 64; c0 += 32) { float tu[32], td[32];
#pragma unroll
            for (int i = 0; i < 32; ++i) { tu[i] = u[(size_t)(c0 + i) * 4096]; td[i] = dd[(c0 + i) * 64]; }
#pragma unroll
            for (int i = 0; i < 32; ++i) { u[(size_t)(c0 + i) * 4096] = S; S = td[i] * S + tu[i]; } }
    }
}

__device__ __forceinline__ void hgrn_c_item(int item, unsigned char* P, bf16_t* MIX, const float* hgn, LAS unsigned char* L) {
    int tid_ = threadIdx.x; asm volatile("" : "+v"(tid_)); const int tid = tid_, lane = tid & 63, wq = (tid >> 6) & 1, cs = tid >> 7, r = lane & 15, g = lane >> 4;
    const int bh = item >> 4, chunk = (item & 15) * 4 + cs, b = bh >> 2, h = bh & 3;
    const size_t row0 = (size_t)b * SEQ + chunk * 64;
    const bf16_t* HQ = (const bf16_t*)(P + P_HQ); const bf16_t* HK = (const bf16_t*)(P + P_HK); const bf16_t* HG = (const bf16_t*)(P + P_HG); const float* ST = (const float*)(P + P_US);
    LAS unsigned char* sb = L + cs * HG_SLOT;
    u32x4 qraw[2][2], kraw[4][2]; f32x4 sraw[4][2][2];
    const float* st = ST + ((size_t)(bh * 64 + chunk) * 64) * 64;
#pragma unroll
    for (int ks = 0; ks < 2; ++ks) {
#pragma unroll
        for (int ii = 0; ii < 2; ++ii) { const int I = ii ? (wq ? 2 : 3) : (wq ? 1 : 0); qraw[ii][ks] = *(const u32x4*)(HQ + (row0 + 16 * I + r) * 256 + h * 64 + 32 * ks + 8 * g); }
#pragma unroll
        for (int J = 0; J < 4; ++J) kraw[J][ks] = *(const u32x4*)(HK + (row0 + 16 * J + r) * 256 + h * 64 + 32 * ks + 8 * g);
#pragma unroll
        for (int vtile = 0; vtile < 4; ++vtile) { const float* sp = st + (size_t)(16 * vtile + r) * 64 + 32 * ks + 8 * g; sraw[vtile][ks][0] = *(const f32x4*)sp; sraw[vtile][ks][1] = *(const f32x4*)(sp + 4); } }
    hg_stage(tid, row0, h, (const float*)(P + P_HLF), (const bf16_t*)(P + P_HI), sb);
    const LAS float* bl = (const LAS float*)sb; const LAS float* pre = (const LAS float*)(sb + HG_PRE); const LAS unsigned char* vt = sb + HG_VT;
    hbf16x8 sfr[4][2];
#pragma unroll
    for (int vtile = 0; vtile < 4; ++vtile)
#pragma unroll
        for (int ks = 0; ks < 2; ++ks) { const f32x4 s0 = sraw[vtile][ks][0], s1 = sraw[vtile][ks][1]; const float x[8] = {s0[0], s0[1], s0[2], s0[3], s1[0], s1[1], s1[2], s1[3]}; sfr[vtile][ks] = pack8(x); }
#pragma unroll
    for (int ii = 0; ii < 2; ++ii) {
        const int I = ii ? (wq ? 2 : 3) : (wq ? 1 : 0), t = 16 * I + r;
        unsigned short graw[4][4];
#pragma unroll
        for (int i = 0; i < 4; ++i)
#pragma unroll
            for (int vtile = 0; vtile < 4; ++vtile) graw[i][vtile] = HG[(row0 + 16 * I + 4 * g + i) * 256 + h * 64 + 16 * vtile + r];
        hbf16x8 qtf[2], qhf[2];
#pragma unroll
        for (int ks = 0; ks < 2; ++ks) { const int kb = 32 * ks + 8 * g; float q[8], xt[8], xh[8];
            unpack8(qraw[ii][ks], q);
#pragma unroll
            for (int j = 0; j < 8; ++j) { xt[j] = q[j] * __expf(bl[t * HG_BP + kb + j]); xh[j] = xt[j] * __expf(pre[I * 64 + kb + j]); }
            qtf[ks] = pack8(xt); qhf[ks] = pack8(xh); }
        f32x4 at[4];
#pragma unroll
        for (int J = 0; J < 4; ++J) { at[J] = (f32x4){0.f, 0.f, 0.f, 0.f};
            if (J <= I) { const int s = 16 * J + r;
#pragma unroll
                for (int ks = 0; ks < 2; ++ks) { const int kb = 32 * ks + 8 * g; float kk[8], x[8];
                    unpack8(kraw[J][ks], kk);
#pragma unroll
                    for (int j = 0; j < 8; ++j) x[j] = kk[j] * __expf(fminf(pre[I * 64 + kb + j] - pre[J * 64 + kb + j] - bl[s * HG_BP + kb + j], 80.f));
                    at[J] = __builtin_amdgcn_mfma_f32_16x16x32_bf16(pack8(x), qtf[ks], at[J], 0, 0, 0); }
                if (J == I) {
#pragma unroll
                    for (int i = 0; i < 4; ++i) at[J][i] = (4 * g + i <= r) ? at[J][i] : 0.f; } } }
        hbf16x8 pf[2];
#pragma unroll
        for (int k2 = 0; k2 < 2; ++k2) { const float x[8] = {at[2 * k2][0], at[2 * k2][1], at[2 * k2][2], at[2 * k2][3], at[2 * k2 + 1][0], at[2 * k2 + 1][1], at[2 * k2 + 1][2], at[2 * k2 + 1][3]}; pf[k2] = pack8(x); }
        f32x4 o[4];
#pragma unroll
        for (int vtile = 0; vtile < 4; ++vtile) { f32x4 acc = {0.f, 0.f, 0.f, 0.f}; const int v = 16 * vtile + r;
#pragma unroll
            for (int ks = 0; ks < 2; ++ks) acc = __builtin_amdgcn_mfma_f32_16x16x32_bf16(qhf[ks], sfr[vtile][ks], acc, 0, 0, 0);
#pragma unroll
            for (int k2 = 0; k2 < 2; ++k2) { if (k2 == 0 || I >= 2) {
                const hbf16x4 v0 = *(const LAS hbf16x4*)(vt + v * (HG_VP * 2) + (32 * k2 + 4 * g) * 2), v1 = *(const LAS hbf16x4*)(vt + v * (HG_VP * 2) + (32 * k2 + 16 + 4 * g) * 2);
                const hbf16x8 vf = {v0[0], v0[1], v0[2], v0[3], v1[0], v1[1], v1[2], v1[3]};
                acc = __builtin_amdgcn_mfma_f32_16x16x32_bf16(pf[k2], vf, acc, 0, 0, 0); } }
            o[vtile] = acc; }
#pragma unroll
        for (int i = 0; i < 4; ++i) { float sq = 0.f;
#pragma unroll
            for (int vtile = 0; vtile < 4; ++vtile) sq += o[vtile][i] * o[vtile][i];
            sq += __shfl_xor(sq, 1); sq += __shfl_xor(sq, 2); sq += __shfl_xor(sq, 4); sq += __shfl_xor(sq, 8);
            const float rn = rsqrtf(sq * (1.0f / 64.0f) + EPS); const size_t row = row0 + 16 * I + 4 * g + i;
#pragma unroll
            for (int vtile = 0; vtile < 4; ++vtile) { const int v = 16 * vtile + r; const float gg = bf2f(graw[i][vtile]);
                MIX[row * DM + h * 64 + v] = (bf16_t)f2bf(o[vtile][i] * rn * hgn[v] * (gg / (1.0f + __expf(-gg)))); } }
    }
}

struct Args { const float* in[14]; float* out; unsigned char* ws; int ph_lo, ph_hi; };
constexpr int NPHASE = 1 + 7 * DEPTH;

__global__ void __launch_bounds__(512, 2) fwd(Args a) {
    extern __shared__ __attribute__((aligned(16))) unsigned char lds[];
    cg::grid_group grid = cg::this_grid();
    LAS unsigned char* L = (LAS unsigned char*)lds;
    if (threadIdx.x < 32) ((LAS unsigned*)(L + LDS_BYTES - 128))[threadIdx.x] = 0u;
    __syncthreads();
    for (int ph = a.ph_lo; ph < a.ph_hi; ++ph) {
        int G = gridDim.x, bx = blockIdx.x; asm volatile("" : "+s"(G), "+s"(bx));
        typedef const __attribute__((address_space(4))) Args* KArgP;
        KArgP ap = (KArgP)__builtin_amdgcn_kernarg_segment_ptr(); asm volatile("" : "+s"(ap));
        unsigned char* ws = ap->ws;
        float* SS = (float*)(ws + WS_SS); float* LB = (float*)(ws + WS_LB);
        bf16_t* XB = (bf16_t*)(ws + WS_XB); bf16_t* MIX = (bf16_t*)(ws + WS_MIX); bf16_t* UB = (bf16_t*)(ws + WS_U);
        unsigned char* P = ws + WS_P;
#ifdef PROBE_T
        if (ph == NPHASE) {
            if (bx == 0) { const unsigned long long* ts_ = (const unsigned long long*)(ws + 65536); unsigned long long sa = 0, sb = 0;
                for (int p = 1; p < NPHASE; ++p) { const int kk_ = (p - 1) % 7; const unsigned long long d = ts_[p] - ts_[p - 1]; if (PROBE_A(kk_)) sa += d; if (PROBE_B(kk_)) sb += d; }
                const float fa = (float)sa * 1e-3f, fb = (float)sb * 1e-3f; float* o_ = ap->out;
                for (int i = threadIdx.x; i < (1 << 20); i += 512) o_[(1 << 20) + i] += fb;
                if (threadIdx.x == 0) o_[0] = fa; }
        } else
#endif
        if (ph == 0) {
            int tid = threadIdx.x; asm volatile("" : "+v"(tid)); const int lane = tid & 63, wave = __builtin_amdgcn_readfirstlane(tid >> 6);
            LAS float* scr = (LAS float*)(L + wave * 16384);
            const int gw = bx * 8 + wave, NGW = G * 8;
            constexpr int I_IN = 16 * 112, I_OUT = 16 * 32, I_1 = 16 * 128, I_2 = 64 * 32, I_L = I_IN + I_OUT + I_1 + I_2;
            for (int it = gw; it < DEPTH * I_L; it += NGW) {
                const int l = it / I_L; int r = it % I_L;
                unsigned char* wl = ws + WS_W + (size_t)l * W_LAYER;
                if (r < I_IN) { const int kb = r / 112, nb = r % 112, n0 = nb * 32, pn = n0 >> 8, p = n0 & 255, slot = 4 * pn + ((p & 127) >> 5), sc0 = 64 * slot + 32 * (p >> 7);
                    tr_item(ap->in[3] + (size_t)l * DM * INC, INC, INC, sc0, kb * 64, ap->in[2] + l * DM, (bf16_t*)wl, DM, n0, scr, lane); continue; }
                r -= I_IN;
                if (r < I_OUT) { const int kb = r / 32, nb = r % 32; tr_item(ap->in[10] + (size_t)l * DM * DM, DM, DM, nb * 32, kb * 64, nullptr, (bf16_t*)(wl + W_OUT), DM, nb * 32, scr, lane); continue; }
                r -= I_OUT;
                if (r < I_1) { const int kb = r / 128, nb = r % 128; tr_item(ap->in[12] + (size_t)l * DM * DFF, DFF, DFF, nb * 32, kb * 64, ap->in[11] + l * DM, (bf16_t*)(wl + W_1), DM, nb * 32, scr, lane); continue; }
                r -= I_1;
                { const int kb = r / 32, nb = r % 32; tr_item(ap->in[13] + (size_t)l * DFF * DM, DM, DM, nb * 32, kb * 64, nullptr, (bf16_t*)(wl + W_2), DFF, nb * 32, scr, lane); }
            }
            const float* x = ap->in[0];
            for (int m0 = gw; m0 < M; m0 += 4 * NGW) {
                f32x4 v[4][4]; float s[4];
#pragma unroll
                for (int q = 0; q < 4; ++q) { const int m = m0 + q * NGW; const f32x4* xr = (const f32x4*)(x + (size_t)(m < M ? m : gw) * DM) + lane;
#pragma unroll
                    for (int j = 0; j < 4; ++j) v[q][j] = xr[64 * j]; }
#pragma unroll
                for (int q = 0; q < 4; ++q) { s[q] = 0.f;
#pragma unroll
                    for (int j = 0; j < 4; ++j) s[q] += (v[q][j][0] * v[q][j][0] + v[q][j][1] * v[q][j][1]) + (v[q][j][2] * v[q][j][2] + v[q][j][3] * v[q][j][3]); }
#pragma unroll
                for (int q = 0; q < 4; ++q) { const int m = m0 + q * NGW; const float tot = wave_sum(s[q]);
                    if (m < M) { u32x2* o8 = (u32x2*)(XB + (size_t)m * DM) + lane;
#pragma unroll
                        for (int j = 0; j < 4; ++j) { u32x2 w; w.x = pk2(v[q][j][0], v[q][j][1]); w.y = pk2(v[q][j][2], v[q][j][3]); o8[64 * j] = w; }
                        if (lane < 16) SS[(size_t)m * 16 + lane] = (lane == 0) ? tot : 0.f; } }
            }
            if (bx == 2 && tid < 64) ((unsigned*)ws)[tid] = 0u;
            if (bx == 3) for (int i = tid; i < XCD_BAR_WORDS; i += 512) ((unsigned*)(ws + WS_BAR))[i] = 0u;
            if (bx == 1) {
                for (int i = tid; i < 1024; i += 512) { const int l = i >> 8, wh = (i >> 6) & 3, d = i & 63; LB[2048 + i] = ap->in[5 + wh][l * 64 + d]; }
                if (tid < 32) { const int l = tid >> 3, e = tid & 7; LB[3072 + tid] = (e < 6) ? ap->in[9][l * 6 + e] : 0.f; }
            }
            if (bx == 0 && tid < 256) {
                const float* lg = ap->in[1]; float e[DEPTH]; float mx = -1e30f, sum = 0.f;
#pragma unroll
                for (int l = 0; l < DEPTH; ++l) mx = fmaxf(mx, lg[l * 256 + tid]);
#pragma unroll
                for (int l = 0; l < DEPTH; ++l) { e[l] = expf(lg[l * 256 + tid] - mx); sum += e[l]; }
                float c = 0.f;
#pragma unroll
                for (int l = 0; l < DEPTH; ++l) { if (l > 0) c += e[l] / sum; LB[l * 512 + tid] = logf(fmaxf(c, 1e-30f)); LB[l * 512 + 256 + tid] = 1.0f - c; }
            }
        } else {
            const int l = (ph - 1) / 7, k = (ph - 1) % 7;
#ifdef REP_K
            const int nrep = (k == REP_K) ? 2 : 1;
#else
            const int nrep = 1;
#endif
            for (int rep = 0; rep < nrep; ++rep) {
            if (rep) { XcdBarrier xb_; xb_.bar = (unsigned*)(ws + WS_BAR); xb_.x = xb_xcc_id(); xb_.st = (volatile LAS unsigned*)(L + LDS_BYTES - 128); xcd_barrier(xb_); }
            unsigned char* wl = ws + WS_W + (size_t)l * W_LAYER;
            if (k == 0) {
                pg8::Gemm g{XB, (const bf16_t*)wl, M, NIN, DM}; pg8::StaticOrder S; S.init(M, NIN, G, bx);
                EpiInProj E{SS, P, LB + l * 512, LB + 2048 + l * 256, LB + 3072 + l * 8};
                pg8::gemm_phase<EpiInProj, pg8::StaticOrder, true, true>(L, g, S, E);
            } else if (k == 1) {
                int tid = threadIdx.x; asm volatile("" : "+v"(tid));
                unsigned* ctr = (unsigned*)ws + l * 16 + 1 + rep * 4;
                volatile LAS int* sh = (volatile LAS int*)(L + LDS_BYTES - 64);
                int nxt = 0; if (tid == 0) nxt = (int)atomicAdd(ctr, 1u);
                for (;;) {
                    if (tid == 0) sh[0] = nxt;
                    __syncthreads();
                    const int idx = __builtin_amdgcn_readfirstlane(sh[0]);
                    __syncthreads();
                    if (idx >= 816 + 512) break;
                    if (tid == 0) nxt = (int)atomicAdd(ctr, 1u);
                    if (idx < 768) { const int qb = 15 - idx / 48, bh = idx % 48, b = bh / 6, h = bh % 6; typedef attn_body::bf16 abf;
                        attn_body::sb_unit(qb, (const abf*)(P + P_SQ) + (size_t)bh * SEQ * 64, (const abf*)(P + P_SQ + HEADBUF) + (size_t)bh * SEQ * 64, (const abf*)(P + P_SQ + 2 * HEADBUF) + (size_t)bh * SEQ * 64,
                                           (abf*)MIX + (size_t)b * SEQ * DM + 256 + h * 64, (char*)lds); }
                    else if (idx < 816) fox_cumsum_item(idx - 768, (const float*)(P + P_LF), (float*)(P + P_CC), (int*)(ws + WS_JS), LB + 2048 + l * 256 + 128, LB + 2048 + l * 256 + 192, (LAS float*)L);
                    else hgrn_a_item(idx - 816, P, (float*)(ws + WS_DD), L);
                    __syncthreads();
                }
            } else if (k == 2) {
                hgrn_b_scan(bx, G, P, (const float*)(ws + WS_DD));
            } else if (k == 3) {
                int tid = threadIdx.x; asm volatile("" : "+v"(tid));
                unsigned* ctr = (unsigned*)ws + l * 16 + rep * 4;
                volatile LAS int* sh = (volatile LAS int*)(L + LDS_BYTES - 64);
                int nxt = 0; if (tid == 0) nxt = (int)atomicAdd(ctr, 1u);
                for (;;) {
                    if (tid == 0) sh[0] = nxt;
                    __syncthreads();
                    const int idx = __builtin_amdgcn_readfirstlane(sh[0]);
                    __syncthreads();
#ifdef PROBE_FOX
                    if (idx >= 768 + 512 || (rep && idx >= 768)) break;
#else
                    if (idx >= 768 + 512) break;
#endif
                    if (tid == 0) nxt = (int)atomicAdd(ctr, 1u);
                    if (idx >= 768) { hgrn_c_item(idx - 768, P, MIX, ap->in[4] + l * 64, L); __syncthreads(); continue; }
                    const int qb = 15 - idx / 48, bh = idx % 48, b = bh / 6, h = bh % 6;
                    typedef attn_body::bf16 abf;
                    const int jstart = ((const int*)(ws + WS_JS))[bh * 16 + qb];
#ifdef PROBE_FOX
                    if (rep) attn_body::attn_unit<30, PROBE_FOX_BIAS>(qb, PROBE_FOX_JS(jstart), (const abf*)(P + P_FQ) + (size_t)bh * SEQ * 64, (const abf*)(P + P_FQ + HEADBUF) + (size_t)bh * SEQ * 64, (const abf*)(P + P_FQ + 2 * HEADBUF) + (size_t)bh * SEQ * 64,
                                            (abf*)ap->out + (size_t)b * SEQ * DM + 640 + h * 64, (const float*)(P + P_CC) + (size_t)bh * SEQ, (char*)lds);
                    else
#endif
                    attn_body::attn_unit<30>(qb, jstart, (const abf*)(P + P_FQ) + (size_t)bh * SEQ * 64, (const abf*)(P + P_FQ + HEADBUF) + (size_t)bh * SEQ * 64, (const abf*)(P + P_FQ + 2 * HEADBUF) + (size_t)bh * SEQ * 64,
                                            (abf*)MIX + (size_t)b * SEQ * DM + 640 + h * 64, (const float*)(P + P_CC) + (size_t)bh * SEQ, (char*)lds);
                }
            } else if (k == 5) {
                pg8::Gemm g{XB, (const bf16_t*)(wl + W_1), M, DFF, DM}; pg8::StaticOrder S; S.init(M, DFF, G, bx);
                EpiRelu2 E{UB, SS};
                pg8::gemm_phase<EpiRelu2, pg8::StaticOrder, true, true>(L, g, S, E);
            } else {
                const bool ff2 = (k == 6);
                pg8::Gemm g{ff2 ? UB : MIX, (const bf16_t*)(wl + (ff2 ? W_2 : W_OUT)), M, DM, ff2 ? DFF : DM}; pg8::StaticOrder S; S.init(M, DM, G, bx);
                EpiResid E{XB, (ff2 && l == DEPTH - 1) ? ap->out : nullptr, SS};
                pg8::gemm_phase<EpiResid, pg8::StaticOrder, true, true>(L, g, S, E);
            }
            }
        }
#ifdef PROBE_T
        if (bx == 0 && threadIdx.x == 0) ((unsigned long long*)(ws + 65536))[ph] = __builtin_amdgcn_s_memrealtime();
#endif
        if (ph + 1 < a.ph_hi) {
            if (ph == 0) {
                grid.sync();
                (void)xcd_barrier_post((unsigned*)(ws + WS_BAR), (volatile LAS unsigned*)(L + LDS_BYTES - 128));
            } else {
                XcdBarrier xb_; xb_.bar = (unsigned*)(ws + WS_BAR); xb_.x = xb_xcc_id(); xb_.st = (volatile LAS unsigned*)(L + LDS_BYTES - 128);
                xcd_barrier(xb_);
            }
        }
    }
}

#ifndef MK_MULTI
#define MK_MULTI 0
#endif
extern "C" void kernel_launch(void* const* d_in, const int* in_sizes, int n_in, void* d_out, int out_size, void* d_ws, size_t ws_size, hipStream_t stream) {
    static int grid = 0;
    if (grid == 0) {
        int dev = 0, cus = 0, per = 0;
        if (n_in != 14 || out_size != M * DM || ws_size < WS_END) { fprintf(stderr, "kernel_launch: unexpected shapes (n_in %d out %d ws %zu)\n", n_in, out_size, ws_size); grid = -1; return; }
        (void)hipGetDevice(&dev); (void)hipDeviceGetAttribute(&cus, hipDeviceAttributeMultiprocessorCount, dev);
        (void)hipFuncSetAttribute((const void*)fwd, hipFuncAttributeMaxDynamicSharedMemorySize, LDS_BYTES);
        (void)hipOccupancyMaxActiveBlocksPerMultiprocessor(&per, (const void*)fwd, 512, LDS_BYTES);
        if (per < 1) per = 1;
        grid = cus * per;
        fprintf(stderr, "kernel_launch: grid %d (cus %d x %d)\n", grid, cus, per);
    }
    if (grid < 0) return;
    Args a{};
    for (int i = 0; i < 14; ++i) a.in[i] = (const float*)d_in[i];
    a.out = (float*)d_out; a.ws = (unsigned char*)d_ws;
#if MK_MULTI
    for (int ph = 0; ph < NPHASE; ++ph) { a.ph_lo = ph; a.ph_hi = ph + 1; hipLaunchKernelGGL(fwd, dim3(grid), dim3(512), LDS_BYTES, stream, a); }
#else
#ifdef PROBE_T
    a.ph_lo = 0; a.ph_hi = NPHASE + 1;
#else
    a.ph_lo = 0; a.ph_hi = NPHASE;
#endif
    void* args[] = {&a};
    hipError_t e = hipLaunchCooperativeKernel((const void*)fwd, dim3(grid), dim3(512), args, LDS_BYTES, stream);
    if (e != hipSuccess) fprintf(stderr, "kernel_launch: cooperative launch failed: %s (grid %d)\n", hipGetErrorString(e), grid);
#endif
}
```

```cpp
#include <hip/hip_runtime.h>
#include <hip/hip_cooperative_groups.h>
#include <cstdio>
#include <cstdint>
namespace cg = cooperative_groups;
namespace pg8 {
#define PG8_LAS __attribute__((address_space(3)))
typedef unsigned short bf16_t;
typedef short bf16x8 __attribute__((ext_vector_type(8)));
typedef float f32x4 __attribute__((ext_vector_type(4)));
typedef unsigned u32x4 __attribute__((ext_vector_type(4)));
constexpr int BM = 256, BK = 64, HALF = 128, HTB = HALF * BK * 2  , STAGE_BYTES = 8 * HTB, NXCD = 8, WGM = 8;

__host__ __device__ __forceinline__ int lds_byte(int r, int c) { const int st = (r >> 4) * 2 + (c >> 5), rr = r & 15, cc = c & 31, ob = rr * 64 + cc * 2; return st * 1024 + (ob ^ (((ob >> 9) & 1) << 5)); }
__host__ __device__ __forceinline__ void stage_rc(int b, int& R, int& C) { const int st = b / 1024, sb = b % 1024, swz = sb ^ (((sb >> 9) & 1) << 5); R = (st >> 1) * 16 + swz / 64; C = (st & 1) * 32 + (swz % 64) / 2; }
__host__ __device__ __forceinline__ int perm32(int rho) { const int n = rho >> 4, i = rho & 15; return 8 * (i >> 2) + 4 * n + (i & 3); }

struct Unit { int pm, pn; };
struct Gemm { const bf16_t* A; const bf16_t* Bt; int M, N, K; };

struct StaticOrder {
    int nM, nN, nwg, G, c;
    __host__ __device__ void init(int M, int N, int G_, int c_) { nM = M / BM; nN = N / BM; nwg = nM * nN; G = G_; c = c_; }
    __host__ __device__ bool next(int i, Unit& u) const {
        const long L = (long)i * G + c; if (L >= nwg) return false;
        int wgid = (int)L; { const int q = nwg / NXCD, r = nwg % NXCD, xcd = wgid % NXCD, off = wgid / NXCD; wgid = (xcd < r ? xcd * (q + 1) : r * (q + 1) + (xcd - r) * q) + off; }
        const int nig = WGM * nN, gid = wgid / nig, fm = gid * WGM, gsz = (nM - fm) < WGM ? (nM - fm) : WGM;
        u.pm = fm + ((wgid % nig) % gsz); u.pn = (wgid % nig) / gsz; return true;
    }
    __device__ __forceinline__ void a_ready(const Unit&) const {}
    __device__ __forceinline__ void done(const Unit&) const {}
};

__device__ __forceinline__ unsigned cvt_pk_bf16(float lo, float hi) { unsigned r; asm volatile("v_cvt_pk_bf16_f32 %0, %1, %2" : "=v"(r) : "v"(lo), "v"(hi)); return r; }
typedef float f32x2 __attribute__((ext_vector_type(2)));
template <class Epi, class Sched, bool ALIGN_EPI = false, bool SP2 = false>
__device__ __forceinline__ void gemm_phase(PG8_LAS unsigned char* lds, const Gemm g, const Sched& S, const Epi& E) {
    int tid_ = threadIdx.x; asm volatile("" : "+v"(tid_));
    const int tid = tid_, wid = __builtin_amdgcn_readfirstlane(tid >> 6), lane = tid & 63, wr = wid >> 2, wc = wid & 3, fr = lane & 15, fq = lane >> 4;
    const int K = g.K, nt = K / BK;
    unsigned voffA[2], voffB[2];
#pragma unroll
    for (int i = 0; i < 2; ++i) { int R, C; stage_rc(tid * 16 + i * 8192, R, C); const int Rb = Epi::PERM ? ((R & ~31) + perm32(R & 31)) : R;
        voffA[i] = (unsigned)(R * K + C) * 2u; voffB[i] = (unsigned)(Rb * K + C) * 2u; }
    const size_t kstep = (size_t)(BK * 2);
    const size_t hstep = (size_t)HALF * K * 2;
    const size_t tstep = 2 * hstep;
    const unsigned ldsw = (unsigned)wid * 1024u;
    const int aoff = lds_byte(wr * 64 + fr, fq * 8), boff = lds_byte(wc * 32 + fr, fq * 8);
#define PG8_SA(b, h) (((b) * 2 + (h)) * HTB)
#define PG8_SB(b, h) ((4 + (b) * 2 + (h)) * HTB)
#define PG8_STAGE(bufoff, gbase, voff) do { _Pragma("unroll") for (int _i = 0; _i < 2; ++_i) \
        __builtin_amdgcn_global_load_lds((const unsigned*)((const char*)(gbase) + (voff)[_i]), (PG8_LAS unsigned*)(lds + (bufoff) + ldsw + _i * 8192), 16, 0, 0); } while (0)
#define PG8_LDA(dst, b, h) do { _Pragma("unroll") for (int m = 0; m < 4; ++m) _Pragma("unroll") for (int k = 0; k < 2; ++k) dst[m][k] = *(const PG8_LAS bf16x8*)(lds + PG8_SA(b, h) + aoff + m * 2048 + k * 1024); } while (0)
#define PG8_LDB(dst, b, h) do { _Pragma("unroll") for (int n = 0; n < 2; ++n) _Pragma("unroll") for (int k = 0; k < 2; ++k) dst[n][k] = *(const PG8_LAS bf16x8*)(lds + PG8_SB(b, h) + boff + n * 2048 + k * 1024); } while (0)
#define PG8_MMA(ai, bj, At, Bt) do { __builtin_amdgcn_s_setprio(1); _Pragma("unroll") for (int m = 0; m < 4; ++m) _Pragma("unroll") for (int n = 0; n < 2; ++n) _Pragma("unroll") for (int k = 0; k < 2; ++k) \
        acc[ai][bj][m][n] = __builtin_amdgcn_mfma_f32_16x16x32_bf16(Bt[n][k], At[m][k], acc[ai][bj][m][n], 0, 0, 0); __builtin_amdgcn_s_setprio(0); } while (0)
#define PG8_WAIT_V(n) asm volatile("s_waitcnt vmcnt(" #n ")" ::: "memory")
#define PG8_WAIT_L(n) asm volatile("s_waitcnt lgkmcnt(" #n ")" ::: "memory")
#define PG8_BAR __builtin_amdgcn_s_barrier()
#define PG8_SCHED __builtin_amdgcn_sched_barrier(0)
    Unit cur, nxt; int ui = 0;
    if (!S.next(0, cur)) return;
    f32x4 acc[2][2][4][2];
#pragma unroll
    for (int a = 0; a < 2; ++a)
#pragma unroll
        for (int b = 0; b < 2; ++b)
#pragma unroll
            for (int m = 0; m < 4; ++m)
#pragma unroll
                for (int n = 0; n < 2; ++n) acc[a][b][m][n] = (f32x4){0.f, 0.f, 0.f, 0.f};
    bf16x8 At[4][2], B0[2][2], B1[2][2];
    const char* cA = (const char*)g.A + (size_t)cur.pm * tstep; const char* cB = (const char*)g.Bt + (size_t)cur.pn * tstep;
    S.a_ready(cur);
    if constexpr (SP2) {
        PG8_STAGE(PG8_SB(0, 0), cB, voffB); PG8_STAGE(PG8_SB(0, 1), cB + hstep, voffB); PG8_STAGE(PG8_SA(0, 0), cA, voffA); PG8_STAGE(PG8_SA(0, 1), cA + hstep, voffA);
        if (wr == 1) PG8_BAR;
        PG8_WAIT_V(2); PG8_BAR;
        PG8_STAGE(PG8_SB(1, 0), cB + kstep, voffB); PG8_STAGE(PG8_SA(1, 0), cA + kstep, voffA); PG8_STAGE(PG8_SB(1, 1), cB + hstep + kstep, voffB);
        PG8_WAIT_V(6); PG8_BAR;
    } else {
        PG8_STAGE(PG8_SB(0, 0), cB, voffB); PG8_STAGE(PG8_SA(0, 0), cA, voffA); PG8_STAGE(PG8_SB(0, 1), cB + hstep, voffB); PG8_STAGE(PG8_SA(0, 1), cA + hstep, voffA);
        if (wr == 1) PG8_BAR;
        PG8_WAIT_V(4); PG8_BAR;
        PG8_STAGE(PG8_SB(1, 0), cB + kstep, voffB); PG8_STAGE(PG8_SA(1, 0), cA + kstep, voffA); PG8_STAGE(PG8_SB(1, 1), cB + hstep + kstep, voffB);
        PG8_WAIT_V(6); PG8_BAR;
    }
    for (;;) {
        const bool has_next = S.next(ui + 1, nxt);
        const char* nA = has_next ? (const char*)g.A + (size_t)nxt.pm * tstep : cA; const char* nB = has_next ? (const char*)g.Bt + (size_t)nxt.pn * tstep : cB;
        for (int t = 0; t < nt; t += 2) {
            const bool last = (t == nt - 2);
            const char* a1 = cA + (size_t)(t + 1) * kstep;
            const char* a2 = last ? nA : cA + (size_t)(t + 2) * kstep; const char* b2 = last ? nB : cB + (size_t)(t + 2) * kstep;
            const char* a3 = a2 + kstep; const char* b3 = b2 + kstep;
            if (last && has_next) S.a_ready(nxt);
            if constexpr (SP2) {
            PG8_LDB(B0, 0, 0); PG8_LDB(B1, 0, 1); PG8_SCHED; PG8_LDA(At, 0, 0); PG8_STAGE(PG8_SA(1, 1), a1 + hstep, voffA);
            PG8_WAIT_V(8); PG8_WAIT_L(0); PG8_BAR; PG8_MMA(0, 0, At, B0); PG8_MMA(0, 1, At, B1); PG8_BAR; PG8_SCHED;
            PG8_LDA(At, 0, 1); PG8_STAGE(PG8_SB(0, 0), b2, voffB); PG8_STAGE(PG8_SB(0, 1), b2 + hstep, voffB); PG8_STAGE(PG8_SA(0, 0), a2, voffA);
            PG8_WAIT_V(8); PG8_WAIT_L(0); PG8_BAR; PG8_MMA(1, 0, At, B0); PG8_MMA(1, 1, At, B1); PG8_BAR; PG8_SCHED;
            PG8_LDB(B0, 1, 0); PG8_LDB(B1, 1, 1); PG8_SCHED; PG8_LDA(At, 1, 0); PG8_STAGE(PG8_SA(0, 1), a2 + hstep, voffA);
            PG8_WAIT_V(8); PG8_WAIT_L(0); PG8_BAR; PG8_MMA(0, 0, At, B0); PG8_MMA(0, 1, At, B1); PG8_BAR; PG8_SCHED;
            PG8_LDA(At, 1, 1); PG8_STAGE(PG8_SB(1, 0), b3, voffB); PG8_STAGE(PG8_SB(1, 1), b3 + hstep, voffB); PG8_STAGE(PG8_SA(1, 0), a3, voffA);
            PG8_WAIT_V(8); PG8_WAIT_L(0); PG8_BAR; PG8_MMA(1, 0, At, B0); PG8_MMA(1, 1, At, B1); PG8_BAR; PG8_SCHED;
            } else {
            PG8_LDB(B0, 0, 0); PG8_SCHED; PG8_LDA(At, 0, 0); PG8_STAGE(PG8_SA(1, 1), a1 + hstep, voffA);
            PG8_WAIT_L(8); PG8_BAR; PG8_WAIT_L(0); PG8_MMA(0, 0, At, B0); PG8_BAR; PG8_SCHED;
            PG8_LDB(B1, 0, 1); PG8_STAGE(PG8_SB(0, 0), b2, voffB);
            PG8_BAR; PG8_WAIT_L(0); PG8_MMA(0, 1, At, B1); PG8_BAR;
            PG8_LDA(At, 0, 1); PG8_STAGE(PG8_SA(0, 0), a2, voffA);
            PG8_BAR; PG8_WAIT_L(0); PG8_MMA(1, 0, At, B0); PG8_BAR; PG8_SCHED;
            PG8_STAGE(PG8_SB(0, 1), b2 + hstep, voffB);
            PG8_WAIT_V(6); PG8_BAR; PG8_MMA(1, 1, At, B1); PG8_BAR;
            PG8_LDB(B0, 1, 0); PG8_SCHED; PG8_LDA(At, 1, 0); PG8_STAGE(PG8_SA(0, 1), a2 + hstep, voffA);
            PG8_WAIT_L(8); PG8_BAR; PG8_WAIT_L(0); PG8_MMA(0, 0, At, B0); PG8_BAR; PG8_SCHED;
            PG8_LDB(B1, 1, 1); PG8_STAGE(PG8_SB(1, 0), b3, voffB);
            PG8_BAR; PG8_WAIT_L(0); PG8_MMA(0, 1, At, B1); PG8_BAR;
            PG8_LDA(At, 1, 1); PG8_STAGE(PG8_SA(1, 0), a3, voffA);
            PG8_BAR; PG8_WAIT_L(0); PG8_MMA(1, 0, At, B0); PG8_BAR; PG8_SCHED;
            PG8_STAGE(PG8_SB(1, 1), b3 + hstep, voffB);
            PG8_WAIT_V(6); PG8_BAR; PG8_MMA(1, 1, At, B1); PG8_BAR;
            }
        }
        if constexpr (ALIGN_EPI) { if (wr == 0) PG8_BAR; }
        if constexpr (!Epi::AFTER_DRAIN) { E(acc, cur, wr, wc, fr, fq); S.done(cur); }
        if (!has_next) break;
#pragma unroll
        for (int a = 0; a < 2; ++a)
#pragma unroll
            for (int b = 0; b < 2; ++b)
#pragma unroll
                for (int m = 0; m < 4; ++m)
#pragma unroll
                    for (int n = 0; n < 2; ++n) acc[a][b][m][n] = (f32x4){0.f, 0.f, 0.f, 0.f};
        cur = nxt; cA = nA; cB = nB; ++ui;
        if constexpr (ALIGN_EPI) { if (wr == 1) PG8_BAR; }
    }
    PG8_WAIT_V(0);
    if constexpr (!ALIGN_EPI) { if (wr == 0) PG8_BAR; }
    PG8_BAR;
    if constexpr (Epi::AFTER_DRAIN) { E.fused(acc, cur, wr, wc, fr, fq, lds, wid, lane); S.done(cur); }
#undef PG8_SA
#undef PG8_SB
#undef PG8_STAGE
#undef PG8_LDA
#undef PG8_LDB
#undef PG8_MMA
#undef PG8_WAIT_V
#undef PG8_WAIT_L
#undef PG8_BAR
#undef PG8_SCHED
}
}
#include <hip/hip_bf16.h>
#include <cmath>
namespace attn_body {
using bf16=__hip_bfloat16;
using bf16x8=__attribute__((ext_vector_type(8)))short;
using s16x4=__attribute__((ext_vector_type(4)))short;
using f32x16=__attribute__((ext_vector_type(16)))float;
using u32x4=__attribute__((ext_vector_type(4)))unsigned;
using f32x4v=__attribute__((ext_vector_type(4)))float;
constexpr int SEQ=4096,D=64,DM=64,OPITCH=1024;
constexpr int LDS_C=98304;
constexpr int NW=8,QBLK=32,QB=QBLK*NW,KVBLK=64,NQB=SEQ/QB;
constexpr int ATTN_UNIT_ROWS=QB;
__device__ __forceinline__ int crow(int r,int hi){return (r&3)+8*(r>>2)+4*hi;}
#define SBAR() __builtin_amdgcn_sched_barrier(0)
__device__ __forceinline__ void cmask(f32x16&p0,f32x16&p1,int jb,int qrel,int hi){
  const float NEG=-INFINITY; int kb=64*jb+4*hi;
  #pragma unroll
  for(int r=0;r<16;++r){int kv=kb+(r&3)+8*(r>>2); if(kv>qrel)p0[r]=NEG; if(kv+32>qrel)p1[r]=NEG;}
}

constexpr int NSLOT=3, SLOTB=8192;
constexpr int LDS_K=0, LDS_V=NSLOT*SLOTB, LDS_WS=2*NSLOT*SLOTB, LDS_OST=LDS_WS+NW*64*4, LDS_BYTES=LDS_OST+NW*4096;
constexpr float C2=0.125f*1.4426950408889634f;
__device__ __forceinline__ void glds16(const void*gsrc,unsigned lds_dst){unsigned keep;
  asm volatile("s_mov_b32 %0, m0\n\ts_mov_b32 m0, %2\n\ts_nop 0\n\tglobal_load_lds_dwordx4 %1, off\n\ts_mov_b32 m0, %0":"=&s"(keep):"v"(gsrc),"s"(lds_dst):"memory");}
__device__ __forceinline__ float max3f(float a,float b,float c){float r;asm("v_max3_f32 %0, %1, %2, %3":"=v"(r):"v"(a),"v"(b),"v"(c));return r;}
__device__ __forceinline__ float max2f(float a,float b){float r;asm("v_max_f32_e32 %0, %1, %2":"=v"(r):"v"(a),"v"(b));return r;}
__device__ __forceinline__ float fadd_s(float a,float b){float r;asm("v_add_f32_e32 %0, %1, %2":"=v"(r):"v"(a),"v"(b));return r;}
__device__ __forceinline__ float fsub_s(float a,float b){float r;asm("v_sub_f32_e32 %0, %1, %2":"=v"(r):"v"(a),"v"(b));return r;}
typedef float f32x2_t __attribute__((ext_vector_type(2))); typedef __bf16 bf16x2_t __attribute__((ext_vector_type(2)));
__device__ __forceinline__ unsigned cvtpk_s(float lo,float hi){f32x2_t v={lo,hi};bf16x2_t b=__builtin_convertvector(v,bf16x2_t);return __builtin_bit_cast(unsigned,b);}
#define WAIT_BAR(N) asm volatile("s_waitcnt vmcnt(" #N ") lgkmcnt(0)\n\ts_barrier":::"memory")

__device__ __forceinline__ void qkt(f32x16&p0,f32x16&p1,const char*Kslot,const bf16x8*qr,const f32x16&negm,int r32,int hi){
  const char*kb=Kslot+hi*1024+r32*16;
  #pragma unroll
  for(int d0=0;d0<4;++d0){
    const bf16x8 b0=*reinterpret_cast<const bf16x8*>(kb+d0*2048);
    const bf16x8 b1=*reinterpret_cast<const bf16x8*>(kb+d0*2048+512);
    if(d0==0){p0=__builtin_amdgcn_mfma_f32_32x32x16_bf16(b0,qr[0],negm,0,0,0);p1=__builtin_amdgcn_mfma_f32_32x32x16_bf16(b1,qr[0],negm,0,0,0);}
    else{p0=__builtin_amdgcn_mfma_f32_32x32x16_bf16(b0,qr[d0],p0,0,0,0);p1=__builtin_amdgcn_mfma_f32_32x32x16_bf16(b1,qr[d0],p1,0,0,0);}}
}
typedef __attribute__((address_space(3))) const char* lds_cptr;
typedef short v4i16_t __attribute__((ext_vector_type(4)));
__device__ __forceinline__ void kload8(bf16x8*kf,lds_cptr kp){
  kf[0]=*(const __attribute__((address_space(3))) bf16x8*)(kp);      kf[1]=*(const __attribute__((address_space(3))) bf16x8*)(kp+512);
  kf[2]=*(const __attribute__((address_space(3))) bf16x8*)(kp+2048); kf[3]=*(const __attribute__((address_space(3))) bf16x8*)(kp+2560);
  kf[4]=*(const __attribute__((address_space(3))) bf16x8*)(kp+4096); kf[5]=*(const __attribute__((address_space(3))) bf16x8*)(kp+4608);
  kf[6]=*(const __attribute__((address_space(3))) bf16x8*)(kp+6144); kf[7]=*(const __attribute__((address_space(3))) bf16x8*)(kp+6656);
}
__device__ __forceinline__ void kload2(bf16x8*kf,lds_cptr kp,int j){ kf[2*j]=*(const __attribute__((address_space(3))) bf16x8*)(kp+j*2048); kf[2*j+1]=*(const __attribute__((address_space(3))) bf16x8*)(kp+j*2048+512); }
__device__ __forceinline__ s16x4 vtr(lds_cptr p){ return __builtin_bit_cast(s16x4,__builtin_amdgcn_ds_read_tr16_b64_v4i16((__attribute__((address_space(3))) v4i16_t*)p)); }
__device__ __forceinline__ float rowmax(const f32x16&p0,const f32x16&p1){
  float a=max3f(p0[0],p0[1],p1[0]),b=max3f(p0[2],p0[3],p1[1]);a=max3f(a,p1[2],p1[3]);
  #pragma unroll
  for(int r=4;r<16;r+=4){a=max3f(a,p0[r],p0[r+1]);b=max3f(b,p0[r+2],p0[r+3]);a=max3f(a,p1[r],p1[r+1]);b=max3f(b,p1[r+2],p1[r+3]);}
  const float m=max2f(a,b);
  auto rr=__builtin_amdgcn_permlane32_swap(__float_as_uint(m),__float_as_uint(m),false,false);
  return max2f(__uint_as_float(rr[0]),__uint_as_float(rr[1]));
}
__device__ __forceinline__ void pv(f32x16*o,int vb,bf16x8 pa0,bf16x8 pa1,bf16x8 pa2,bf16x8 pa3){
  #pragma unroll
  for(int d0=0;d0<2;++d0){s16x4 lo[4],hi[4];
    #pragma unroll
    for(int ks=0;ks<4;++ks){
      asm volatile("ds_read_b64_tr_b16 %0,%1 offset:%c2":"=&v"(lo[ks]):"v"(vb),"i"(d0*4096+ks*1024):"memory");
      asm volatile("ds_read_b64_tr_b16 %0,%1 offset:%c2":"=&v"(hi[ks]):"v"(vb),"i"(d0*4096+ks*1024+512):"memory");}
    asm volatile("s_waitcnt lgkmcnt(0)":::"memory");SBAR();
    #define PK(k) (bf16x8){lo[k][0],lo[k][1],lo[k][2],lo[k][3],hi[k][0],hi[k][1],hi[k][2],hi[k][3]}
    o[d0]=__builtin_amdgcn_mfma_f32_32x32x16_bf16(pa0,PK(0),o[d0],0,0,0);
    o[d0]=__builtin_amdgcn_mfma_f32_32x32x16_bf16(pa1,PK(1),o[d0],0,0,0);
    o[d0]=__builtin_amdgcn_mfma_f32_32x32x16_bf16(pa2,PK(2),o[d0],0,0,0);
    o[d0]=__builtin_amdgcn_mfma_f32_32x32x16_bf16(pa3,PK(3),o[d0],0,0,0);
    #undef PK
  }
}

#ifndef ATTN_STORE16
#define ATTN_STORE16(p,v) (*(u32x4*)(p)=(v))
#endif
template<int THRL,bool BIASON=true> __device__ __forceinline__ void attn_unit(int qb,int jstart,const bf16*Q,const bf16*__restrict__ K,const bf16*__restrict__ V,bf16*O,const float*__restrict__ Cg,char*shm){
  int tid_=threadIdx.x; asm volatile("":"+v"(tid_)); const int tid=tid_,lane=tid&63,r32=lane&31,hi=lane>>5; const int wid=__builtin_amdgcn_readfirstlane(tid>>6);
  const int q0=qb*QB;
  const bf16*Qw=Q+(long)(q0+wid*QBLK)*DM;
  const bf16*Kh=K+(long)jstart*KVBLK*DM,*Vh=V+(long)jstart*KVBLK*DM;
  const lds_cptr shm3=(lds_cptr)shm;
  const unsigned lds0=(unsigned)(uintptr_t)shm;
  float*wsf=(float*)(shm+LDS_WS)+wid*64;
  const bf16*ksrc=Kh+(long)lane*DM+wid*8;
  const bf16*vsrc=Vh+(long)(16*(wid&3)+(lane>>2))*DM+(wid>>2)*32+(lane&3)*8;
  const unsigned kdst=lds0+LDS_K+wid*1024, vdst=lds0+LDS_V+wid*1024;
  #define DMA_K(t,slot) glds16(ksrc+(long)(t)*KVBLK*DM,(unsigned)__builtin_amdgcn_readfirstlane(kdst+(slot)))
  #define DMA_V(t,slot) glds16(vsrc+(long)(t)*KVBLK*DM,(unsigned)__builtin_amdgcn_readfirstlane(vdst+(slot)))
  const int vb0=(int)(lds0+LDS_V)+((lane>>4)&1)*32+(lane&3)*8+(4*hi+((lane&15)>>2))*64;
  const char*Kbase=shm+LDS_K; bf16x8 kf[8];
  const lds_cptr kp0=shm3+LDS_K+hi*1024+r32*16; const lds_cptr vp0=shm3+LDS_V+((lane>>4)&1)*32+(lane&3)*8+(4*hi+((lane&15)>>2))*64;
  const int NT=(q0+QB)/KVBLK-jstart;
  { typedef __attribute__((address_space(3))) f32x4v lf32x4; lf32x4*cl_=(lf32x4*)(shm3+LDS_C); const f32x4v*cg_=(const f32x4v*)(Cg+jstart*KVBLK); const int n4_=(q0+QB-jstart*KVBLK)>>2;
    f32x4v c0_=f32x4v{},c1_=f32x4v{}; if(tid<n4_)c0_=cg_[tid]; if(tid+NW*64<n4_)c1_=cg_[tid+NW*64]; if(tid<n4_)cl_[tid]=c0_; if(tid+NW*64<n4_)cl_[tid+NW*64]=c1_; }
  DMA_K(0,0);DMA_V(0,0);DMA_K(1,SLOTB);
  bf16x8 qr[4];
  #pragma unroll
  for(int d0=0;d0<4;++d0)qr[d0]=*reinterpret_cast<const bf16x8*>(&Qw[(long)r32*DM+d0*16+hi*8]);
  float mhat=0.f,l_reg=0.f;f32x16 o[2];o[0]=f32x16{};o[1]=f32x16{};
  const int qrel=wid*QBLK+r32;
  #define CMASK(P0,P1,t) do{int jb_=(t)-(NT-4); if(jb_>=0)cmask(P0,P1,jb_,qrel,hi);}while(0)
  typedef __attribute__((address_space(3))) const float* lds_fptr; typedef __attribute__((address_space(3))) const f32x4v* lds_f4ptr;
  const lds_fptr cl0=(lds_fptr)(shm3+LDS_C)+4*hi;
  #define BIAS(P0,P1,t) do{ const lds_fptr cb_=cl0+64*(t); _Pragma("unroll") for(int g_=0;g_<4;++g_){ const f32x4v a_=*(lds_f4ptr)(cb_+8*g_), b_=*(lds_f4ptr)(cb_+32+8*g_); \
      _Pragma("unroll") for(int i_=0;i_<4;++i_){P0[4*g_+i_]-=a_[i_];P1[4*g_+i_]-=b_[i_];} } }while(0)
  #define BIASINIT(C0_,C1_,t) do{ const lds_fptr cb_=cl0+64*(t); const float nm_=-mhat; _Pragma("unroll") for(int g_=0;g_<4;++g_){ f32x4v a_=f32x4v{},b_=f32x4v{}; if(BIASON){a_=*(lds_f4ptr)(cb_+8*g_); b_=*(lds_f4ptr)(cb_+32+8*g_);} \
      _Pragma("unroll") for(int i_=0;i_<4;++i_){C0_[4*g_+i_]=nm_-a_[i_];C1_[4*g_+i_]=nm_-b_[i_];} } }while(0)
  bool resc=false;
  #define START(P0,P1) do{ const float rm=rowmax(P0,P1); resc=false; \
    { const float dl=rm; mhat=fadd_s(mhat,dl); \
      _Pragma("unroll") for(int r=0;r<16;++r){P0[r]=fsub_s(P0[r],dl);P1[r]=fsub_s(P1[r],dl);} \
      } \
    _Pragma("unroll") for(int r=0;r<16;++r)P0[r]=__builtin_amdgcn_exp2f(P0[r]); }while(0)
  #define RESC() do{ if(resc){ asm volatile("s_waitcnt lgkmcnt(0)":::"memory"); \
      _Pragma("unroll") for(int d_=0;d_<2;++d_) _Pragma("unroll") for(int r=0;r<16;++r)o[d_][r]*=wsf[crow(r,hi)]; } }while(0)
  f32x16 pA0,pA1,pB0,pB1;
  int sl_prev=0,sl_cur=0,sl_next=SLOTB;
  #define ROT() do{sl_prev=sl_cur;sl_cur=sl_next;sl_next=(sl_next==(NSLOT-1)*SLOTB)?0:sl_next+SLOTB;}while(0)
  DMA_K(2,2*SLOTB);
  WAIT_BAR(3);
  { const f32x16 zero_=f32x16{}; qkt(pA0,pA1,Kbase,qr,zero_,r32,hi); }asm volatile("s_nop 15\n\ts_nop 7":"+v"(pA0),"+v"(pA1));BIAS(pA0,pA1,0);CMASK(pA0,pA1,0);
  START(pA0,pA1);
  BIASINIT(pB0,pB1,1);
  _Pragma("unroll") for(int r=0;r<16;++r)pA1[r]=__builtin_amdgcn_exp2f(pA1[r]);
  WAIT_BAR(0);
  DMA_K(3,0);DMA_V(1,SLOTB);
  ROT();
  kload8(kf,kp0+sl_cur);
  WAIT_BAR(2);
  s16x4 vlo[8],vhi[8]; u32x4 pw0,pw1,pw2,pw3;
  #define PKW(P,B) cvtpk_s(P[B],P[B+1])
  #define PAF(k) __builtin_bit_cast(bf16x8,pw##k)
  #define VFR(i) (bf16x8){vlo[i][0],vlo[i][1],vlo[i][2],vlo[i][3],vhi[i][0],vhi[i][1],vhi[i][2],vhi[i][3]}
  #define PIN(x) asm volatile("":"+v"(x))
  #define MX3(a,b,c) __builtin_fmaxf(__builtin_fmaxf((a),(b)),(c))
  #define GAPA(MF,A0,A1,A2,A3,W0,W1,PW) do{ MF; sacc+=A0; sacc+=A1; sacc+=A2; sacc+=A3; PIN(sacc); W0; W1; PIN(PW); SBAR(); }while(0)
  #define EX(v) __builtin_amdgcn_exp2f(v)
  #define GAPB(MF,X,B) do{ MF; X[B]=EX(X[B]); X[B+1]=EX(X[B+1]); X[B+2]=EX(X[B+2]); X[B+3]=EX(X[B+3]); PIN(X); SBAR(); }while(0)
  #define VRD(i) do{ vlo[i]=vtr(vp_+(((i)>>2)*4096+((i)&3)*1024)); vhi[i]=vtr(vp_+(((i)>>2)*4096+((i)&3)*1024+512)); }while(0)
  #define KRD(G,j) do{ if(G){ kload2(kf,kp0+sl_next,j); SBAR(); } }while(0)
  #define STEP(C0,C1,P0,P1,t,GK,GV,GL) do{ SBAR(); \
    const lds_cptr vp_=vp0+sl_prev; \
    VRD(0); SBAR(); float sacc=(P0[0]+P0[1]); \
    GAPA(C0=__builtin_amdgcn_mfma_f32_32x32x16_bf16(kf[0],qr[0],C0,0,0,0), P0[2],P0[3],P0[4],P0[5],     pw0[0]=PKW(P0,0), pw0[1]=PKW(P0,2), pw0); \
    VRD(4); SBAR(); GAPA(C1=__builtin_amdgcn_mfma_f32_32x32x16_bf16(kf[1],qr[0],C1,0,0,0), P0[6],P0[7],P0[8],P0[9],     pw0[2]=PKW(P0,4), pw0[3]=PKW(P0,6), pw0); \
    VRD(1); SBAR(); GAPA(C0=__builtin_amdgcn_mfma_f32_32x32x16_bf16(kf[2],qr[1],C0,0,0,0),   P0[10],P0[11],P0[12],P0[13], pw1[0]=PKW(P0,8), pw1[1]=PKW(P0,10), pw1); \
    VRD(5); SBAR(); GAPA(C1=__builtin_amdgcn_mfma_f32_32x32x16_bf16(kf[3],qr[1],C1,0,0,0),   P0[14],P0[15],P1[0],P1[1],   pw1[2]=PKW(P0,12),pw1[3]=PKW(P0,14), pw1); \
    VRD(2); SBAR(); GAPA(C0=__builtin_amdgcn_mfma_f32_32x32x16_bf16(kf[4],qr[2],C0,0,0,0),   P1[2],P1[3],P1[4],P1[5],     pw2[0]=PKW(P1,0), pw2[1]=PKW(P1,2), pw2); \
    VRD(6); SBAR(); GAPA(C1=__builtin_amdgcn_mfma_f32_32x32x16_bf16(kf[5],qr[2],C1,0,0,0),   P1[6],P1[7],P1[8],P1[9],     pw2[2]=PKW(P1,4), pw2[3]=PKW(P1,6), pw2); \
    VRD(3); SBAR(); GAPA(C0=__builtin_amdgcn_mfma_f32_32x32x16_bf16(kf[6],qr[3],C0,0,0,0),   P1[10],P1[11],P1[12],P1[13], pw3[0]=PKW(P1,8), pw3[1]=PKW(P1,10), pw3); \
    VRD(7); SBAR(); GAPA(C1=__builtin_amdgcn_mfma_f32_32x32x16_bf16(kf[7],qr[3],C1,0,0,0),   P1[14],P1[15],0.f,0.f,       pw3[2]=PKW(P1,12),pw3[3]=PKW(P1,14), pw3); \
    l_reg+=sacc; \
    if(GK){DMA_K((t)+3,sl_cur);} if(GV){DMA_V((t)+1,sl_next);} \
    CMASK(C0,C1,t); \
    { float a=MX3(C0[0],C0[1],C1[0]),b=MX3(C0[2],C0[3],C1[1]); a=MX3(a,C1[2],C1[3]); \
      _Pragma("unroll") for(int r=4;r<16;r+=4){a=MX3(a,C0[r],C0[r+1]);b=MX3(b,C0[r+2],C0[r+3]);a=MX3(a,C1[r],C1[r+1]);b=MX3(b,C1[r+2],C1[r+3]);} \
      float rm=__builtin_fmaxf(a,b); { auto rr=__builtin_amdgcn_permlane32_swap(__float_as_uint(rm),__float_as_uint(rm),false,false); rm=__builtin_fmaxf(__uint_as_float(rr[0]),__uint_as_float(rr[1])); } \
      resc=false; \
      if(__builtin_expect(__any(rm>(float)THRL),0)){ const float dl=__builtin_fmaxf(rm+30.f,0.f); mhat+=dl; \
        _Pragma("unroll") for(int r=0;r<16;++r){C0[r]-=dl;C1[r]-=dl;} \
        const float f=__builtin_amdgcn_exp2f(-dl); l_reg*=f; if(hi==0)wsf[r32]=f; resc=true; } } \
    SBAR(); \
    GAPB(o[0]=__builtin_amdgcn_mfma_f32_32x32x16_bf16(PAF(0),VFR(0),o[0],0,0,0), C0,0); \
    GAPB(o[1]=__builtin_amdgcn_mfma_f32_32x32x16_bf16(PAF(0),VFR(4),o[1],0,0,0), C0,4); \
    KRD(GL,0); GAPB(o[0]=__builtin_amdgcn_mfma_f32_32x32x16_bf16(PAF(1),VFR(1),o[0],0,0,0), C0,8); \
    KRD(GL,1); GAPB(o[1]=__builtin_amdgcn_mfma_f32_32x32x16_bf16(PAF(1),VFR(5),o[1],0,0,0), C0,12); \
    KRD(GL,2); GAPB(o[0]=__builtin_amdgcn_mfma_f32_32x32x16_bf16(PAF(2),VFR(2),o[0],0,0,0), C1,0); \
    KRD(GL,3); GAPB(o[1]=__builtin_amdgcn_mfma_f32_32x32x16_bf16(PAF(2),VFR(6),o[1],0,0,0), C1,4); \
    GAPB(o[0]=__builtin_amdgcn_mfma_f32_32x32x16_bf16(PAF(3),VFR(3),o[0],0,0,0), C1,8); \
    GAPB(o[1]=__builtin_amdgcn_mfma_f32_32x32x16_bf16(PAF(3),VFR(7),o[1],0,0,0), C1,12); \
    BIASINIT(P0,P1,(t)+1); SBAR(); \
    }while(0)
  int t=1;
  #undef CMASK
  #define CMASK(P0,P1,t) do{}while(0)
  for(;t+5<NT;t+=2){
    STEP(pB0,pB1,pA0,pA1,t,true,true,true);     WAIT_BAR(2); RESC(); ROT();
    STEP(pA0,pA1,pB0,pB1,t+1,true,true,true);   WAIT_BAR(2); RESC(); ROT();
  }
  #undef CMASK
  #define CMASK(P0,P1,t) do{int jb_=(t)-(NT-4); if(jb_>=0)cmask(P0,P1,jb_,qrel,hi);}while(0)
  #define ENDW(tt) do{ if((tt)+3<NT){WAIT_BAR(2);} else if((tt)+2<NT){WAIT_BAR(1);} else {WAIT_BAR(0);} }while(0)
  for(;t+1<NT;t+=2){
    STEP(pB0,pB1,pA0,pA1,t,(t+3<NT),(t+1<NT),(t+1<NT));       ENDW(t);   RESC(); ROT();
    STEP(pA0,pA1,pB0,pB1,t+1,(t+4<NT),(t+2<NT),(t+2<NT));     ENDW(t+1); RESC(); ROT();
  }
  STEP(pB0,pB1,pA0,pA1,NT-1,false,false,false); RESC();
  { float sacc=pB0[0]+pB0[1]; _Pragma("unroll") for(int r=2;r<16;++r)sacc+=pB0[r]; _Pragma("unroll") for(int r=0;r<16;++r)sacc+=pB1[r]; l_reg+=sacc;
    pw0=(u32x4){PKW(pB0,0),PKW(pB0,2),PKW(pB0,4),PKW(pB0,6)};pw1=(u32x4){PKW(pB0,8),PKW(pB0,10),PKW(pB0,12),PKW(pB0,14)};pw2=(u32x4){PKW(pB1,0),PKW(pB1,2),PKW(pB1,4),PKW(pB1,6)};pw3=(u32x4){PKW(pB1,8),PKW(pB1,10),PKW(pB1,12),PKW(pB1,14)};
    SBAR(); pv(o,vb0+sl_cur,PAF(0),PAF(1),PAF(2),PAF(3)); }
  #undef PKW
  #undef PAF
  #undef VFR
  #undef PIN
  #undef MX3
  #undef GAPA
  #undef GAPB
  #undef EX
  #undef VRD
  #undef KRD
  #undef STEP
  #undef ENDW
  {auto rr=__builtin_amdgcn_permlane32_swap(__float_as_uint(l_reg),__float_as_uint(l_reg),false,false);l_reg=__uint_as_float(rr[0])+__uint_as_float(rr[1]);}
  if(hi==0)wsf[32+r32]=l_reg;asm volatile("s_waitcnt lgkmcnt(0)":::"memory");
  float rli[16];
  #pragma unroll
  for(int r=0;r<16;++r)rli[r]=__builtin_amdgcn_rcpf(wsf[32+crow(r,hi)]);
  bf16*Ow=O+(long)(q0+wid*QBLK)*OPITCH;
  { bf16*stg=(bf16*)(shm+LDS_OST)+wid*2048;
    #pragma unroll
    for(int r=0;r<16;++r){const int orow=crow(r,hi);
      #pragma unroll
      for(int d0=0;d0<2;++d0)stg[orow*64+d0*32+r32]=__float2bfloat16(o[d0][r]*rli[r]);}
    asm volatile("s_waitcnt lgkmcnt(0)":::"memory");
    #pragma unroll
    for(int i=0;i<4;++i){const int row=i*8+(lane>>3),ch=lane&7; const u32x4 v=*(const u32x4*)(stg+row*64+ch*8); ATTN_STORE16(Ow+(long)row*OPITCH+ch*8,v);} }
  asm volatile("s_waitcnt lgkmcnt(0)\n\ts_barrier":::"memory");
  #undef DMA_K
  #undef DMA_V
  #undef CMASK
  #undef BIAS
  #undef BIASINIT
  #undef START
  #undef RESC
  #undef ROT
}
constexpr int SB_NS=8, SB_V=65536, SB_FLAGS=131072;
__device__ __forceinline__ void sb_unit(int qb,const bf16*Q,const bf16*__restrict__ K,const bf16*__restrict__ V,bf16*O,char*shm){
  int tid_=threadIdx.x; asm volatile("":"+v"(tid_)); const int tid=tid_,lane=tid&63,r32=lane&31,hi=lane>>5; const int wid=__builtin_amdgcn_readfirstlane(tid>>6);
  const int q0=qb*QB;
  const bf16*Qw=Q+(long)(q0+wid*QBLK)*DM;
  const unsigned lds0=(unsigned)(uintptr_t)shm;
  typedef __attribute__((address_space(3))) int lds_i32; typedef __attribute__((address_space(3))) const u32x4* lds_u4ptr;
  lds_i32*flags=(lds_i32*)((lds_cptr)shm+SB_FLAGS);
  const bf16*ksrc=K+(long)lane*DM+wid*8;
  const bf16*vsrc=V+(long)(16*(wid&3)+(lane>>2))*DM+(wid>>2)*32+(lane&3)*8;
  const unsigned kdst=lds0+wid*1024, vdst=lds0+SB_V+wid*1024;
  #define DMA_K(t,slot) glds16(ksrc+(long)(t)*KVBLK*DM,(unsigned)__builtin_amdgcn_readfirstlane(kdst+(slot)))
  #define DMA_V(t,slot) glds16(vsrc+(long)(t)*KVBLK*DM,(unsigned)__builtin_amdgcn_readfirstlane(vdst+(slot)))
  const int vb0=(int)(lds0+SB_V)+((lane>>4)&1)*32+(lane&3)*8+(4*hi+((lane&15)>>2))*64;
  const int NT=(q0+QB)/KVBLK;
  bf16x8 qr[4];
  #pragma unroll
  for(int d0=0;d0<4;++d0)qr[d0]=*reinterpret_cast<const bf16x8*>(&Qw[(long)r32*DM+d0*16+hi*8]);
  f32x16 o[2];o[0]=f32x16{};o[1]=f32x16{};
  float T=1.0f; const int t_abs=q0+wid*QBLK+r32; bool wdone=false;
  for(int jtop=NT-1;;jtop-=SB_NS){
    const int nb=(jtop+1<SB_NS)?jtop+1:SB_NS;
    for(int s=0;s<nb;++s){DMA_K(jtop-s,s*SLOTB);DMA_V(jtop-s,s*SLOTB);}
    WAIT_BAR(0);
    int s=(jtop==NT-1)?3-(wid>>1):0;
    for(;s<nb&&!wdone;++s){
      const int jt=jtop-s; const int slot=s*SLOTB; const bool band=(jt>=NT-4);
      f32x16 x0,x1; { f32x16 zero=f32x16{}; qkt(x0,x1,shm+slot,qr,zero,r32,hi); }
      f32x16 n0,n1;
      const int kb=64*jt+4*hi;
      #pragma unroll
      for(int r=0;r<16;++r){
        const float z0=x0[r],z1=x1[r];
        const float e0=__builtin_amdgcn_exp2f(-__builtin_fabsf(z0)), e1=__builtin_amdgcn_exp2f(-__builtin_fabsf(z1));
        const float r0=__builtin_amdgcn_rcpf(1.0f+e0), r1=__builtin_amdgcn_rcpf(1.0f+e1), er0=e0*r0, er1=e1*r1;
        float b0=z0>0.f?r0:er0, m0=z0>0.f?er0:r0, b1=z1>0.f?r1:er1, m1=z1>0.f?er1:r1;
        if(band){ const int kv=kb+(r&3)+8*(r>>2); if(!(kv<t_abs)){b0=0.f;m0=1.f;} if(!(kv+32<t_abs)){b1=0.f;m1=1.f;} }
        x0[r]=b0;x1[r]=b1;n0[r]=m0;n1[r]=m1;
      }
      float g0[4],g1[4],p0s[4],p1s[4];
      #pragma unroll
      for(int a=0;a<4;++a){ g0[a]=(n0[4*a]*n0[4*a+1])*(n0[4*a+2]*n0[4*a+3]); g1[a]=(n1[4*a]*n1[4*a+1])*(n1[4*a+2]*n1[4*a+3]);
        { auto rr=__builtin_amdgcn_permlane32_swap(__float_as_uint(g0[a]),__float_as_uint(g0[a]),false,false); p0s[a]=__uint_as_float(hi?rr[0]:rr[1]); }
        { auto rr=__builtin_amdgcn_permlane32_swap(__float_as_uint(g1[a]),__float_as_uint(g1[a]),false,false); p1s[a]=__uint_as_float(hi?rr[0]:rr[1]); } }
      float run=T;
      #pragma unroll
      for(int a=3;a>=0;--a){ const float off=hi?run:run*p1s[a]; run*=g1[a]*p1s[a];
        const float t3=off,t2=t3*n1[4*a+3],t1=t2*n1[4*a+2],t0=t1*n1[4*a+1];
        x1[4*a+3]*=t3; x1[4*a+2]*=t2; x1[4*a+1]*=t1; x1[4*a]*=t0; }
      #pragma unroll
      for(int a=3;a>=0;--a){ const float off=hi?run:run*p0s[a]; run*=g0[a]*p0s[a];
        const float t3=off,t2=t3*n0[4*a+3],t1=t2*n0[4*a+2],t0=t1*n0[4*a+1];
        x0[4*a+3]*=t3; x0[4*a+2]*=t2; x0[4*a+1]*=t1; x0[4*a]*=t0; }
      T=run;
      u32x4 pw0,pw1,pw2,pw3;
      pw0=(u32x4){cvtpk_s(x0[0],x0[1]),cvtpk_s(x0[2],x0[3]),cvtpk_s(x0[4],x0[5]),cvtpk_s(x0[6],x0[7])};
      pw1=(u32x4){cvtpk_s(x0[8],x0[9]),cvtpk_s(x0[10],x0[11]),cvtpk_s(x0[12],x0[13]),cvtpk_s(x0[14],x0[15])};
      pw2=(u32x4){cvtpk_s(x1[0],x1[1]),cvtpk_s(x1[2],x1[3]),cvtpk_s(x1[4],x1[5]),cvtpk_s(x1[6],x1[7])};
      pw3=(u32x4){cvtpk_s(x1[8],x1[9]),cvtpk_s(x1[10],x1[11]),cvtpk_s(x1[12],x1[13]),cvtpk_s(x1[14],x1[15])};
      SBAR(); pv(o,vb0+slot,__builtin_bit_cast(bf16x8,pw0),__builtin_bit_cast(bf16x8,pw1),__builtin_bit_cast(bf16x8,pw2),__builtin_bit_cast(bf16x8,pw3));
      wdone=__all(T<1.2e-38f);
    }
    if(lane==0)flags[wid]=wdone?1:0;
    WAIT_BAR(0);
    const u32x4 f0=*(lds_u4ptr)(flags), f1=*(lds_u4ptr)(flags+4);
    const bool alld=((f0.x&f0.y&f0.z&f0.w)&(f1.x&f1.y&f1.z&f1.w))!=0;
    if(alld||jtop<SB_NS)break;
    WAIT_BAR(0);
  }
  bf16*Ow=O+(long)(q0+wid*QBLK)*OPITCH;
  { bf16*stg=(bf16*)(shm)+wid*2048;
    #pragma unroll
    for(int r=0;r<16;++r){const int orow=crow(r,hi);
      #pragma unroll
      for(int d0=0;d0<2;++d0)stg[orow*64+d0*32+r32]=__float2bfloat16(o[d0][r]);}
    asm volatile("s_waitcnt lgkmcnt(0)":::"memory");
    #pragma unroll
    for(int i=0;i<4;++i){const int row=i*8+(lane>>3),ch=lane&7; const u32x4 v=*(const u32x4*)(stg+row*64+ch*8); ATTN_STORE16(Ow+(long)row*OPITCH+ch*8,v);} }
  asm volatile("s_waitcnt lgkmcnt(0)\n\ts_barrier":::"memory");
  #undef DMA_K
  #undef DMA_V
}
#undef SBAR
#undef WAIT_BAR
}

constexpr int BATCH = 8, SEQ = 4096, DM = 1024, DEPTH = 4, M = BATCH * SEQ, INC = 3334, NIN = 3584, DFF = 4096;
constexpr float EPS = 1e-6f;
constexpr size_t MiB = 1u << 20;
constexpr size_t WS_BAR = 128 * 1024;
constexpr size_t WS_SS = 1 * MiB;
constexpr size_t WS_LB = 3 * MiB;
constexpr size_t WS_JS = 3 * MiB + 256 * 1024;
constexpr size_t WS_DD = 3 * MiB + 512 * 1024;
constexpr size_t WS_W = 4 * MiB;
constexpr size_t W_LAYER = 25 * MiB, W_OUT = 7 * MiB, W_1 = 9 * MiB, W_2 = 17 * MiB;
constexpr size_t WS_XB = 104 * MiB;
constexpr size_t WS_P = 168 * MiB;
constexpr size_t P_HQ = 0, P_HK = 16 * MiB, P_HI = 32 * MiB, P_HG = 48 * MiB, P_HLF = 64 * MiB, P_SQ = 96 * MiB, P_FQ = 168 * MiB, P_LF = 240 * MiB, P_CC = 241 * MiB, P_US = 242 * MiB;
constexpr size_t HEADBUF = 24 * MiB;
constexpr size_t WS_MIX = 442 * MiB;
constexpr size_t WS_U = 168 * MiB;
constexpr size_t WS_END = 506 * MiB;
constexpr int LDS_BYTES = 147456;

typedef pg8::bf16_t bf16_t;
typedef pg8::f32x4 f32x4;
typedef unsigned u32x4 __attribute__((ext_vector_type(4)));
typedef unsigned u32x2 __attribute__((ext_vector_type(2)));
#define LAS __attribute__((address_space(3)))

__device__ __forceinline__ unsigned f2bf(float f) { unsigned u = __builtin_bit_cast(unsigned, f); return (u + 0x7fffu + ((u >> 16) & 1u)) >> 16; }
__device__ __forceinline__ unsigned pk2(float lo, float hi) { return pg8::cvt_pk_bf16(lo, hi); }
typedef float pk_f32x2 __attribute__((ext_vector_type(2))); typedef __bf16 pk_bf16x2 __attribute__((ext_vector_type(2)));
__device__ __forceinline__ unsigned pk2v(float lo, float hi) { const pk_f32x2 v = {lo, hi}; return __builtin_bit_cast(unsigned, __builtin_convertvector(v, pk_bf16x2)); }
__device__ __forceinline__ float bf2f(unsigned short b) { return __builtin_bit_cast(float, (unsigned)b << 16); }
__device__ __forceinline__ float bflo(unsigned w) { return __builtin_bit_cast(float, w << 16); }
__device__ __forceinline__ float bfhi(unsigned w) { return __builtin_bit_cast(float, w & 0xffff0000u); }
__device__ __forceinline__ float logsig(float x) { return fminf(x, 0.f) - log1pf(expf(-fabsf(x))); }
__device__ __forceinline__ float wave_sum(float v) {
#pragma unroll
    for (int o = 1; o < 64; o <<= 1) v += __shfl_xor(v, o);
    return v;
}
#define ROWSCALES8(rs, ss, row0, fq) float rs[2][4]; _Pragma("unroll") for (int ai_ = 0; ai_ < 2; ++ai_) _Pragma("unroll") for (int m_ = 0; m_ < 4; ++m_) rs[ai_][m_] = rowscale(ss, (row0) + ai_ * 128 + m_ * 16, fq);
__device__ __forceinline__ float rowscale(const float* ss, int row, int fq) {
    const f32x4 p = *(const f32x4*)(ss + (size_t)row * 16 + 4 * fq);
    float s = (p[0] + p[1]) + (p[2] + p[3]);
    s += __shfl_xor(s, 16); s += __shfl_xor(s, 32);
    return rsqrtf(s * (1.0f / DM) + EPS);
}

#define ROWFENCE() asm volatile("" ::: "memory")
struct EpiResid {
    static constexpr bool PERM = true, AFTER_DRAIN = false;
    bf16_t* xb; float* outf; float* ss;
    __device__ __forceinline__ void operator()(const f32x4 (&acc)[2][2][4][2], const pg8::Unit& u, int wr, int wc, int fr, int fq) const {
        const int row0 = u.pm * 256 + wr * 64 + fr, col0 = u.pn * 256 + wc * 32 + 8 * fq;
#pragma unroll
        for (int ai = 0; ai < 2; ++ai) {
            u32x4 pre[4][2];
#pragma unroll
            for (int m = 0; m < 4; ++m)
#pragma unroll
                for (int bj = 0; bj < 2; ++bj) pre[m][bj] = *(const u32x4*)(xb + (size_t)(row0 + ai * 128 + m * 16) * DM + col0 + bj * 128);
#pragma unroll
            for (int m = 0; m < 4; ++m) {
                const int row = row0 + ai * 128 + m * 16; float sq = 0.f;
#pragma unroll
                for (int bj = 0; bj < 2; ++bj) {
                    const size_t off = (size_t)row * DM + col0 + bj * 128; const u32x4 p = pre[m][bj];
                    const f32x4 v0 = acc[ai][bj][m][0] + (f32x4){bflo(p.x), bfhi(p.x), bflo(p.y), bfhi(p.y)}, v1 = acc[ai][bj][m][1] + (f32x4){bflo(p.z), bfhi(p.z), bflo(p.w), bfhi(p.w)};
                    if (outf) { *(f32x4*)(outf + off) = v0; *(f32x4*)(outf + off + 4) = v1; }
                    else {
                        u32x4 w; w.x = pk2(v0[0], v0[1]); w.y = pk2(v0[2], v0[3]); w.z = pk2(v1[0], v1[1]); w.w = pk2(v1[2], v1[3]);
                        *(u32x4*)(xb + off) = w;
                        sq += (v0[0] * v0[0] + v0[1] * v0[1]) + (v0[2] * v0[2] + v0[3] * v0[3]) + (v1[0] * v1[0] + v1[1] * v1[1]) + (v1[2] * v1[2] + v1[3] * v1[3]);
                    }
                }
                if (!outf) {
                    sq += __shfl_xor(sq, 16); sq += __shfl_xor(sq, 32);
                    if (fq == 0) ss[(size_t)row * 16 + u.pn * 4 + wc] = sq;
                }
            }
            ROWFENCE();
        }
    }
};
struct EpiRelu2 {
    static constexpr bool PERM = true, AFTER_DRAIN = false;
    bf16_t* U; const float* ss;
    __device__ __forceinline__ void operator()(const f32x4 (&acc)[2][2][4][2], const pg8::Unit& u, int wr, int wc, int fr, int fq) const {
        const int row0 = u.pm * 256 + wr * 64 + fr, col0 = u.pn * 256 + wc * 32 + 8 * fq;
        ROWSCALES8(rs8, ss, row0, fq)
#pragma unroll
        for (int ai = 0; ai < 2; ++ai)
#pragma unroll
            for (int m = 0; m < 4; ++m) {
                const int row = row0 + ai * 128 + m * 16; const float rs = rs8[ai][m];
#pragma unroll
                for (int bj = 0; bj < 2; ++bj) {
                    f32x4 v0 = acc[ai][bj][m][0] * rs, v1 = acc[ai][bj][m][1] * rs;
                    v0 = __builtin_elementwise_max(v0, (f32x4){0.f, 0.f, 0.f, 0.f}); v1 = __builtin_elementwise_max(v1, (f32x4){0.f, 0.f, 0.f, 0.f});
                    v0 = v0 * v0; v1 = v1 * v1;
                    u32x4 w; w.x = pk2(v0[0], v0[1]); w.y = pk2(v0[2], v0[3]); w.z = pk2(v1[0], v1[1]); w.w = pk2(v1[2], v1[3]);
                    *(u32x4*)(U + (size_t)row * DFF + col0 + bj * 128) = w;
                }
                ROWFENCE();
            }
    }
};
struct EpiInProj {
    static constexpr bool PERM = true, AFTER_DRAIN = false;
    const float* ss; unsigned char* P; const float* lbt;
    const float* gt; const float* fbias;
    __device__ __forceinline__ void operator()(const f32x4 (&acc)[2][2][4][2], const pg8::Unit& u, int wr, int wc, int fr, int fq) const {
        const int slot = u.pn * 4 + wc;
        if (slot > 52) return;
        const int row0 = u.pm * 256 + wr * 64 + fr;
        ROWSCALES8(rs8, ss, row0, fq)
        if (slot < 16) {
            const int kind = slot >> 2, cb = (slot & 3) * 64 + 8 * fq;
            if (kind == 1) {
                float* HLF = (float*)(P + P_HLF); bf16_t* HK = (bf16_t*)(P + P_HK);
#pragma unroll
                for (int ai = 0; ai < 2; ++ai)
#pragma unroll
                    for (int m = 0; m < 4; ++m) {
                        const int row = row0 + ai * 128 + m * 16; const float rs = rs8[ai][m];
#pragma unroll
                        for (int bj = 0; bj < 2; ++bj) {
                            float lf[8], kk[8];
#pragma unroll
                            for (int n = 0; n < 2; ++n) {
                                const f32x4 ll = *(const f32x4*)(lbt + cb + 32 * bj + 4 * n), om = *(const f32x4*)(lbt + 256 + cb + 32 * bj + 4 * n);
#pragma unroll
                                for (int i = 0; i < 4; ++i) {
                                    const float fl = acc[ai][bj][m][n][i] * rs;
                                    const float a = fminf(fl, 0.f) - __logf(1.0f + __expf(-fabsf(fl)));
                                    const float an = a - fl;
                                    const float b = ll[i] + an;
                                    lf[4 * n + i] = fmaxf(a, b) + __logf(1.0f + __expf(-fabsf(a - b)));
                                    kk[4 * n + i] = om[i] * __expf(an);
                                }
                            }
                            const size_t off = (size_t)row * 256 + cb + 32 * bj;
                            *(f32x4*)(HLF + off) = (f32x4){lf[0], lf[1], lf[2], lf[3]}; *(f32x4*)(HLF + off + 4) = (f32x4){lf[4], lf[5], lf[6], lf[7]};
                            u32x4 w; w.x = pk2(kk[0], kk[1]); w.y = pk2(kk[2], kk[3]); w.z = pk2(kk[4], kk[5]); w.w = pk2(kk[6], kk[7]);
                            *(u32x4*)(HK + off) = w;
                        }
                        ROWFENCE();
                    }
            } else {
                bf16_t* dst = (bf16_t*)(P + (kind == 0 ? P_HQ : (kind == 2 ? P_HI : P_HG)));
#pragma unroll
                for (int ai = 0; ai < 2; ++ai)
#pragma unroll
                    for (int m = 0; m < 4; ++m) {
                        const int row = row0 + ai * 128 + m * 16; const float rs = rs8[ai][m];
#pragma unroll
                        for (int bj = 0; bj < 2; ++bj) {
                            const f32x4 v0 = acc[ai][bj][m][0] * rs, v1 = acc[ai][bj][m][1] * rs;
                            u32x4 w; w.x = pk2(v0[0], v0[1]); w.y = pk2(v0[2], v0[3]); w.z = pk2(v1[0], v1[1]); w.w = pk2(v1[2], v1[3]);
                            *(u32x4*)(dst + (size_t)row * 256 + cb + 32 * bj) = w;
                        }
                        ROWFENCE();
                    }
            }
        } else if (slot < 52) {
            const int s2 = slot - 16, grp = s2 / 6, h = s2 % 6, role = grp % 3;
            bf16_t* dst = (bf16_t*)(P + P_SQ + (size_t)grp * HEADBUF) + (size_t)((u.pm >> 4) * 6 + h) * SEQ * 64 + 8 * fq;
            const float* gp = gt + (grp - (grp >= 3 ? 1 : 0)) * 64 + 8 * fq;
            const float qs = (role == 0) ? 0.125f * 1.4426950408889634f : 1.0f;
            f32x4 gv[2][2];
#pragma unroll
            for (int bj = 0; bj < 2; ++bj)
#pragma unroll
                for (int n = 0; n < 2; ++n) gv[bj][n] = (role != 2) ? *(const f32x4*)(gp + 32 * bj + 4 * n) * qs : (f32x4){1.f, 1.f, 1.f, 1.f};
#pragma unroll
            for (int ai = 0; ai < 2; ++ai)
#pragma unroll
                for (int m = 0; m < 4; ++m) {
                    const int row = row0 + ai * 128 + m * 16; const float rs = rs8[ai][m];
                    float fac = rs;
                    if (role != 2) {
                        float sq = 0.f;
#pragma unroll
                        for (int bj = 0; bj < 2; ++bj)
#pragma unroll
                            for (int n = 0; n < 2; ++n) { const f32x4 x = acc[ai][bj][m][n]; sq += (x[0] * x[0] + x[1] * x[1]) + (x[2] * x[2] + x[3] * x[3]); }
                        sq += __shfl_xor(sq, 16); sq += __shfl_xor(sq, 32);
                        fac = rs * rsqrtf(rs * rs * sq * (1.0f / 64.0f) + EPS);
                    }
                    const int t = row & (SEQ - 1);
#pragma unroll
                    for (int bj = 0; bj < 2; ++bj) {
                        const f32x4 v0 = acc[ai][bj][m][0] * fac * gv[bj][0], v1 = acc[ai][bj][m][1] * fac * gv[bj][1];
                        u32x4 w; w.x = pk2(v0[0], v0[1]); w.y = pk2(v0[2], v0[3]); w.z = pk2(v1[0], v1[1]); w.w = pk2(v1[2], v1[3]);
                        *(u32x4*)(dst + (size_t)t * 64 + 32 * bj) = w;
                    }
                    ROWFENCE();
                }
        } else {
            float* LF = (float*)(P + P_LF);
#pragma unroll
            for (int ai = 0; ai < 2; ++ai)
#pragma unroll
                for (int m = 0; m < 4; ++m) {
                    const int row = row0 + ai * 128 + m * 16; const float rs = rs8[ai][m];
                    if (fq == 0) {
                        const f32x4 a0 = acc[ai][0][m][0], a1 = acc[ai][0][m][1];
                        *(f32x4*)(LF + (size_t)row * 8) = (f32x4){logsig(a0[0] * rs + fbias[0]), logsig(a0[1] * rs + fbias[1]), logsig(a0[2] * rs + fbias[2]), logsig(a0[3] * rs + fbias[3])};
                        *(f32x4*)(LF + (size_t)row * 8 + 4) = (f32x4){logsig(a1[0] * rs + fbias[4]), logsig(a1[1] * rs + fbias[5]), 0.f, 0.f};
                    }
                    ROWFENCE();
                }
        }
    }
};
#define XB_TMO      128
#define XB_XCNT(j)  (256  + 64 * (j))
#define XB_XSUB(j)  (1280 + 64 * (j))
#define XB_XGEN(j)  (2304 + 64 * (j))
#define XB_TOP      3328
#define XB_TOPGEN   3392
#define XCD_BAR_WORDS 3456
#define XB_SPIN_CAP (1u << 18)

__device__ __forceinline__ unsigned xb_ld(unsigned* p)              { return __hip_atomic_load(p, __ATOMIC_RELAXED, __HIP_MEMORY_SCOPE_AGENT); }
__device__ __forceinline__ unsigned xb_add(unsigned* p, unsigned v) { return __hip_atomic_fetch_add(p, v, __ATOMIC_RELAXED, __HIP_MEMORY_SCOPE_AGENT); }
__device__ __forceinline__ unsigned xb_xcc_id() { return (unsigned)__builtin_amdgcn_s_getreg((3 << 11) | 20) & 0xFu; }
#define XB_SPIN(cond, bar) do { unsigned _sp = 0; while (cond) { __builtin_amdgcn_s_sleep(1); \
    if ((++_sp & 255u) == 0u) { if (xb_ld(&(bar)[XB_TMO])) break; if (_sp > XB_SPIN_CAP) { atomicAdd(&(bar)[XB_TMO], 1u); break; } } } } while (0)

struct XcdBarrier {
    unsigned* bar; unsigned x;
    volatile LAS unsigned* st;
};

__device__ __forceinline__ XcdBarrier xcd_barrier_post(unsigned* bar, volatile LAS unsigned* st) {
    XcdBarrier b; b.bar = bar; b.x = xb_xcc_id(); b.st = st;
    if (threadIdx.x == 0) (void)xb_add(&bar[XB_XCNT(b.x)], 1u);
    return b;
}
__device__ __forceinline__ void xcd_barrier_complete(unsigned* bar, unsigned x, unsigned& nloc, unsigned& nx) {
    const unsigned G = gridDim.x * gridDim.y * gridDim.z;
    unsigned sum, cnt, mine, sp = 0u;
    for (;;) {
        sum = 0u; cnt = 0u; mine = 0u;
#pragma unroll
        for (unsigned j = 0; j < 16; ++j) { const unsigned c = xb_ld(&bar[XB_XCNT(j)]); sum += c; cnt += (c > 0u) ? 1u : 0u; mine = (j == x) ? c : mine; }
        if (sum == G) break;
        __builtin_amdgcn_s_sleep(1);
        if ((++sp & 255u) == 0u) { if (xb_ld(&bar[XB_TMO])) break; if (sp > XB_SPIN_CAP) { atomicAdd(&bar[XB_TMO], 1u); break; } }
    }
    nloc = mine > 0u ? mine : 1u; nx = cnt > 0u ? cnt : 1u;
}

__device__ __forceinline__ void xcd_barrier(const XcdBarrier& b) {
    asm volatile("s_waitcnt vmcnt(0)" ::: "memory");
    __syncthreads();
    if (threadIdx.x == 0) {
        unsigned* bar = b.bar;
        __builtin_amdgcn_s_waitcnt(0);
        unsigned nloc = b.st[0], nx = b.st[1];
        if (nloc == 0u) { xcd_barrier_complete(bar, b.x, nloc, nx); b.st[0] = nloc; b.st[1] = nx; }
        const unsigned old = xb_add(&bar[XB_XSUB(b.x)], 1u);
        const unsigned gen = old / nloc;
        if (old + 1u == (gen + 1u) * nloc) {
            __builtin_amdgcn_fence(__ATOMIC_RELEASE, "agent");
            asm volatile("s_waitcnt vmcnt(0)" ::: "memory");
            const unsigned og = xb_add(&bar[XB_TOP], 1u);
            const unsigned tg = og / nx;
            if (og + 1u == (tg + 1u) * nx) xb_add(&bar[XB_TOPGEN], 1u);
            else XB_SPIN(xb_ld(&bar[XB_TOPGEN]) == tg, bar);
            __builtin_amdgcn_fence(__ATOMIC_ACQUIRE, "agent");
            xb_add(&bar[XB_XGEN(b.x)], 1u);
            asm volatile("s_waitcnt vmcnt(0)" ::: "memory");
        } else {
            XB_SPIN(xb_ld(&bar[XB_XGEN(b.x)]) == gen, bar);
            __builtin_amdgcn_fence(__ATOMIC_ACQUIRE, "agent");
            asm volatile("s_waitcnt vmcnt(0)" ::: "memory");
        }
    }
    __syncthreads();
}

__device__ __forceinline__ void tr_item(const float* W, int ldw, int ncols_valid, int src_col0, int k0, const float* gain, bf16_t* WT, int K, int n0, LAS float* scr, int lane) {
#pragma unroll 8
    for (int i = 0; i < 32; ++i) { const int kk = 2 * i + (lane >> 5), c = src_col0 + (lane & 31);
        float v = (c < ncols_valid) ? W[(size_t)(k0 + kk) * ldw + c] : 0.f; if (gain) v *= gain[k0 + kk]; scr[kk * 33 + (lane & 31)] = v; }
    asm volatile("s_waitcnt lgkmcnt(0)" ::: "memory");
    const int c = lane & 7;
#pragma unroll
    for (int j = 0; j < 4; ++j) { const int n = (lane >> 3) + 8 * j; const LAS float* s = scr + (8 * c) * 33 + n;
        u32x4 o; o.x = pk2(s[0 * 33], s[1 * 33]); o.y = pk2(s[2 * 33], s[3 * 33]); o.z = pk2(s[4 * 33], s[5 * 33]); o.w = pk2(s[6 * 33], s[7 * 33]);
        *(u32x4*)(WT + (size_t)(n0 + n) * K + k0 + 8 * c) = o; }
    asm volatile("s_waitcnt lgkmcnt(0)" ::: "memory");
}

__device__ __forceinline__ void unpack8(const u32x4 w, float* d) { d[0] = bflo(w.x); d[1] = bfhi(w.x); d[2] = bflo(w.y); d[3] = bfhi(w.y); d[4] = bflo(w.z); d[5] = bfhi(w.z); d[6] = bflo(w.w); d[7] = bfhi(w.w); }

__device__ __forceinline__ void fox_cumsum_item(int bh, const float* LF, float* CC, int* JS, const float* gq, const float* gk, LAS float* sc) {
    int tid_ = threadIdx.x; asm volatile("" : "+v"(tid_)); const int tid = tid_, lane = tid & 63, wave = tid >> 6, b = bh / 6, h = bh % 6;
    float v[8]; float run = 0.f;
#pragma unroll
    for (int i = 0; i < 8; ++i) { run += LF[((size_t)b * SEQ + tid * 8 + i) * 8 + h]; v[i] = run; }
    float s = run;
#pragma unroll
    for (int o = 1; o < 64; o <<= 1) { const float n = __shfl_up(s, o); if (lane >= o) s += n; }
    __syncthreads();
    if (lane == 63) sc[wave] = s;
    __syncthreads();
    float base = s - run;
    for (int w = 0; w < wave; ++w) base += sc[w];
    LAS float* cl = sc + 64;
#pragma unroll
    for (int i = 0; i < 8; ++i) { const float c2 = (v[i] + base) * 1.4426950408889634f; CC[(size_t)bh * SEQ + tid * 8 + i] = c2; cl[tid * 8 + i] = c2; }
    __syncthreads();
    if (tid < 16) {
        float mq = 0.f, mk = 0.f;
        for (int d = 0; d < 64; ++d) { mq = fmaxf(mq, fabsf(gq[d])); mk = fmaxf(mk, fabsf(gk[d])); }
        const float zb = 1.4426950408889634f * 8.0f * mq * mk * 1.03f + 1.0f;
        const float thr = -(126.0f + 2.0f * zb);
        const int q0 = tid * 256, nt = q0 / 64 + 4; const float cq = cl[q0];
        int j = 0; while (j < nt - 4 && cq - cl[64 * j + 63] < thr) ++j;
        JS[bh * 16 + tid] = j & ~1;
    }
    __syncthreads();
}

__device__ __forceinline__ void stage_kv(const bf16_t* Kb, const bf16_t* Vb, int kt, LAS float* Kf, LAS float* Vf) {
    int tid_ = threadIdx.x; asm volatile("" : "+v"(tid_)); const int tid = tid_, key = tid >> 3, c8 = tid & 7;
    const u32x4 kw = *(const u32x4*)(Kb + ((size_t)(kt * 64 + key)) * 64 + c8 * 8), vw = *(const u32x4*)(Vb + ((size_t)(kt * 64 + key)) * 64 + c8 * 8);
    float kf[8], vf[8]; unpack8(kw, kf); unpack8(vw, vf);
    *(LAS f32x4*)(Kf + key * 64 + c8 * 8) = (f32x4){kf[0], kf[1], kf[2], kf[3]}; *(LAS f32x4*)(Kf + key * 64 + c8 * 8 + 4) = (f32x4){kf[4], kf[5], kf[6], kf[7]};
    *(LAS f32x4*)(Vf + key * 64 + c8 * 8) = (f32x4){vf[0], vf[1], vf[2], vf[3]}; *(LAS f32x4*)(Vf + key * 64 + c8 * 8 + 4) = (f32x4){vf[4], vf[5], vf[6], vf[7]};
}

__device__ __forceinline__ void fox_naive_item(int item, unsigned char* P, bf16_t* MIX, LAS float* lds) {
    int tid_ = threadIdx.x; asm volatile("" : "+v"(tid_)); const int tid = tid_, bh = item >> 3, qblk = item & 7, b = bh / 6, h = bh % 6, t = qblk * 512 + tid;
    const bf16_t* Qp = (const bf16_t*)(P + P_FQ) + ((size_t)bh * SEQ + t) * 64;
    const bf16_t* Kb = (const bf16_t*)(P + P_FQ + HEADBUF) + (size_t)bh * SEQ * 64;
    const bf16_t* Vb = (const bf16_t*)(P + P_FQ + 2 * HEADBUF) + (size_t)bh * SEQ * 64;
    const float* CC = (const float*)(P + P_CC) + (size_t)bh * SEQ;
    float q[64], o[64];
#pragma unroll
    for (int c = 0; c < 8; ++c) unpack8(*(const u32x4*)(Qp + c * 8), q + c * 8);
#pragma unroll
    for (int d = 0; d < 64; ++d) o[d] = 0.f;
    float m = -1e30f, l = 0.f; const float ct = CC[t];
    LAS float* Kf = lds; LAS float* Vf = lds + 4096; LAS float* cs = lds + 8192;
    const int ntile = (qblk + 1) * 8;
    for (int kt = 0; kt < ntile; ++kt) {
        __syncthreads();
        stage_kv(Kb, Vb, kt, Kf, Vf); if (tid < 64) cs[tid] = CC[kt * 64 + tid];
        __syncthreads();
        for (int s = 0; s < 64; ++s) {
            float z = 0.f;
#pragma unroll
            for (int d = 0; d < 64; ++d) z += q[d] * Kf[s * 64 + d];
            const float x = (kt * 64 + s <= t) ? z + (ct - cs[s]) : -1e30f;
            const float mn = fmaxf(m, x), sc = __expf(m - mn), p = __expf(x - mn);
            l = l * sc + p;
#pragma unroll
            for (int d = 0; d < 64; ++d) o[d] = o[d] * sc + p * Vf[s * 64 + d];
            m = mn;
        }
    }
    const float inv = 1.0f / l;
    bf16_t* op = MIX + ((size_t)b * SEQ + t) * DM + 640 + h * 64;
#pragma unroll
    for (int c = 0; c < 8; ++c) { u32x4 w; w.x = pk2(o[c * 8] * inv, o[c * 8 + 1] * inv); w.y = pk2(o[c * 8 + 2] * inv, o[c * 8 + 3] * inv); w.z = pk2(o[c * 8 + 4] * inv, o[c * 8 + 5] * inv); w.w = pk2(o[c * 8 + 6] * inv, o[c * 8 + 7] * inv); *(u32x4*)(op + c * 8) = w; }
}

__device__ __forceinline__ void sb_naive_item(int item, unsigned char* P, bf16_t* MIX, LAS float* lds) {
    int tid_ = threadIdx.x; asm volatile("" : "+v"(tid_)); const int tid = tid_, bh = item >> 3, qblk = item & 7, b = bh / 6, h = bh % 6, t = qblk * 512 + tid;
    const bf16_t* Qp = (const bf16_t*)(P + P_SQ) + ((size_t)bh * SEQ + t) * 64;
    const bf16_t* Kb = (const bf16_t*)(P + P_SQ + HEADBUF) + (size_t)bh * SEQ * 64;
    const bf16_t* Vb = (const bf16_t*)(P + P_SQ + 2 * HEADBUF) + (size_t)bh * SEQ * 64;
    float q[64], o[64];
#pragma unroll
    for (int c = 0; c < 8; ++c) unpack8(*(const u32x4*)(Qp + c * 8), q + c * 8);
#pragma unroll
    for (int d = 0; d < 64; ++d) o[d] = 0.f;
    float tail = 0.f;
    LAS float* Kf = lds; LAS float* Vf = lds + 4096;
    for (int kt = qblk * 8 + 7; kt >= 0; --kt) {
        __syncthreads();
        stage_kv(Kb, Vb, kt, Kf, Vf);
        __syncthreads();
        for (int s = 63; s >= 0; --s) {
            float z = 0.f;
#pragma unroll
            for (int d = 0; d < 64; ++d) z += q[d] * Kf[s * 64 + d];
            const float ls = fminf(z, 0.f) - __logf(1.0f + __expf(-fabsf(z)));
            const bool act = (kt * 64 + s) < t;
            const float A = act ? __expf(ls + tail) : 0.f;
#pragma unroll
            for (int d = 0; d < 64; ++d) o[d] += A * Vf[s * 64 + d];
            tail += act ? (ls - z) : 0.f;
        }
        if (__syncthreads_and(tail < -100.f)) break;
    }
    bf16_t* op = MIX + ((size_t)b * SEQ + t) * DM + 256 + h * 64;
#pragma unroll
    for (int c = 0; c < 8; ++c) { u32x4 w; w.x = pk2(o[c * 8], o[c * 8 + 1]); w.y = pk2(o[c * 8 + 2], o[c * 8 + 3]); w.z = pk2(o[c * 8 + 4], o[c * 8 + 5]); w.w = pk2(o[c * 8 + 6], o[c * 8 + 7]); *(u32x4*)(op + c * 8) = w; }
}

__device__ __forceinline__ void hgrn_naive_item(int item, unsigned char* P, bf16_t* MIX, const float* hgn, LAS float* lds) {
    int tid_ = threadIdx.x; asm volatile("" : "+v"(tid_)); const int tid = tid_, lane = tid & 63, w = tid >> 6, kg = lane >> 3, vi = lane & 7, vcol = 8 * w + vi, b = item >> 2, h = item & 3;
    const bf16_t* HQ = (const bf16_t*)(P + P_HQ); const bf16_t* HK = (const bf16_t*)(P + P_HK); const bf16_t* HI = (const bf16_t*)(P + P_HI); const bf16_t* HG = (const bf16_t*)(P + P_HG);
    const float* HLF = (const float*)(P + P_HLF);
    LAS float* qf = lds; LAS float* kf = lds + 4096; LAS float* ff = lds + 8192; LAS float* vf = lds + 12288; LAS float* ob = lds + 16384;
    float S[8];
#pragma unroll
    for (int j = 0; j < 8; ++j) S[j] = 0.f;
    const int tok = tid >> 3, c8 = tid & 7;
    float gn[8];
#pragma unroll
    for (int e = 0; e < 8; ++e) gn[e] = hgn[c8 * 8 + e];
    for (int c = 0; c < 64; ++c) {
        const size_t off = ((size_t)b * SEQ + c * 64 + tok) * 256 + h * 64 + c8 * 8;
        __syncthreads();
        {
            float a[8];
            unpack8(*(const u32x4*)(HQ + off), a);
#pragma unroll
            for (int e = 0; e < 8; ++e) qf[tok * 64 + c8 * 8 + e] = a[e];
            unpack8(*(const u32x4*)(HK + off), a);
#pragma unroll
            for (int e = 0; e < 8; ++e) kf[tok * 64 + c8 * 8 + e] = a[e];
            unpack8(*(const u32x4*)(HI + off), a);
#pragma unroll
            for (int e = 0; e < 8; ++e) vf[tok * 64 + c8 * 8 + e] = a[e];
            const f32x4 l0 = *(const f32x4*)(HLF + off), l1 = *(const f32x4*)(HLF + off + 4);
#pragma unroll
            for (int e = 0; e < 4; ++e) { ff[tok * 64 + c8 * 8 + e] = expf(l0[e]); ff[tok * 64 + c8 * 8 + 4 + e] = expf(l1[e]); }
        }
        __syncthreads();
        for (int tk = 0; tk < 64; ++tk) {
            const float vv = vf[tk * 64 + vcol]; float op = 0.f;
#pragma unroll
            for (int j = 0; j < 8; ++j) { const int k = 8 * kg + j; S[j] = ff[tk * 64 + k] * S[j] + kf[tk * 64 + k] * vv; op += qf[tk * 64 + k] * S[j]; }
            op += __shfl_xor(op, 8); op += __shfl_xor(op, 16); op += __shfl_xor(op, 32);
            if (kg == 0) ob[tk * 64 + vcol] = op;
        }
        __syncthreads();
        {
            float ov[8], g[8]; float sq = 0.f;
#pragma unroll
            for (int e = 0; e < 8; ++e) { ov[e] = ob[tok * 64 + c8 * 8 + e]; sq += ov[e] * ov[e]; }
            sq += __shfl_xor(sq, 1); sq += __shfl_xor(sq, 2); sq += __shfl_xor(sq, 4);
            const float rn = rsqrtf(sq * (1.0f / 64.0f) + EPS);
            unpack8(*(const u32x4*)(HG + off), g);
            float r[8];
#pragma unroll
            for (int e = 0; e < 8; ++e) r[e] = ov[e] * rn * gn[e] * (g[e] / (1.0f + expf(-g[e])));
            u32x4 wv; wv.x = pk2(r[0], r[1]); wv.y = pk2(r[2], r[3]); wv.z = pk2(r[4], r[5]); wv.w = pk2(r[6], r[7]);
            *(u32x4*)(MIX + ((size_t)b * SEQ + c * 64 + tok) * DM + h * 64 + c8 * 8) = wv;
        }
    }
}

constexpr int HG_SLOT = 30720, HG_BP = 68  , HG_PRE = 64 * HG_BP * 4, HG_TOT = HG_PRE + 1280, HG_VT = 20480, HG_VP = 72;
static_assert(HG_TOT + 1024 <= HG_VT && HG_VT + 64 * HG_VP * 2 <= HG_SLOT, "HGRN LDS slot map");
typedef short hbf16x8 __attribute__((ext_vector_type(8)));
typedef short hbf16x4 __attribute__((ext_vector_type(4)));
__device__ __forceinline__ hbf16x8 pack8(const float* x) { u32x4 w; w.x = pk2(x[0], x[1]); w.y = pk2(x[2], x[3]); w.z = pk2(x[4], x[5]); w.w = pk2(x[6], x[7]); return __builtin_bit_cast(hbf16x8, w); }

__device__ __forceinline__ void hg_stage(int tid, size_t row0, int h, const float* HLF, const bf16_t* HI, LAS unsigned char* sb) {
    const int lt = tid & 127, k = lt & 63, half = lt >> 6;
    LAS float* bl = (LAS float*)sb; LAS float* pre = (LAS float*)(sb + HG_PRE); LAS float* tot = (LAS float*)(sb + HG_TOT); LAS bf16_t* vt = (LAS bf16_t*)(sb + HG_VT);
    float lfv[32];
#pragma unroll
    for (int i = 0; i < 32; ++i) lfv[i] = HLF[(row0 + 32 * half + i) * 256 + h * 64 + k];
    u32x4 vw[4];
    {
        const int s = lt & 63, c0 = half * 32;
#pragma unroll
        for (int q = 0; q < 4; ++q) vw[q] = *(const u32x4*)(HI + (row0 + s) * 256 + h * 64 + c0 + 8 * q);
    }
#pragma unroll
    for (int sg = 0; sg < 2; ++sg) { float run = 0.f;
#pragma unroll
        for (int i = 0; i < 16; ++i) { run += lfv[16 * sg + i]; bl[(32 * half + 16 * sg + i) * HG_BP + k] = run; }
        tot[(2 * half + sg) * 64 + k] = run; }
    {   const int s = lt & 63, c0 = half * 32;
#pragma unroll
        for (int q = 0; q < 4; ++q) { const unsigned ww[4] = {vw[q].x, vw[q].y, vw[q].z, vw[q].w};
#pragma unroll
            for (int e = 0; e < 4; ++e) { vt[(c0 + 8 * q + 2 * e) * HG_VP + s] = (bf16_t)(ww[e] & 0xffffu); vt[(c0 + 8 * q + 2 * e + 1) * HG_VP + s] = (bf16_t)(ww[e] >> 16); } } }
    __syncthreads();
    if (lt < 64) { float p = 0.f;
#pragma unroll
        for (int sg = 0; sg < 4; ++sg) { pre[sg * 64 + lt] = p; p += tot[sg * 64 + lt]; }
        pre[4 * 64 + lt] = p; }
    __syncthreads();
}

__device__ __forceinline__ void hgrn_a_item(int item, unsigned char* P, float* DD, LAS unsigned char* L) {
    int tid_ = threadIdx.x; asm volatile("" : "+v"(tid_)); const int tid = tid_, lane = tid & 63, wq = (tid >> 6) & 1, cs = tid >> 7, r = lane & 15, g = lane >> 4;
    const int bh = item >> 4, chunk = (item & 15) * 4 + cs, b = bh >> 2, h = bh & 3;
    const size_t row0 = (size_t)b * SEQ + chunk * 64;
    const bf16_t* HK = (const bf16_t*)(P + P_HK); bf16_t* UT = (bf16_t*)(P + P_US);
    LAS unsigned char* sb = L + cs * HG_SLOT;
    unsigned short kraw[2][2][8];
#pragma unroll
    for (int kt2 = 0; kt2 < 2; ++kt2)
#pragma unroll
        for (int ks = 0; ks < 2; ++ks)
#pragma unroll
            for (int j = 0; j < 8; ++j) kraw[kt2][ks][j] = HK[(row0 + 32 * ks + 8 * g + j) * 256 + h * 64 + 16 * (2 * wq + kt2) + r];
    hg_stage(tid, row0, h, (const float*)(P + P_HLF), (const bf16_t*)(P + P_HI), sb);
    const LAS float* bl = (const LAS float*)sb; const LAS float* pre = (const LAS float*)(sb + HG_PRE); const LAS unsigned char* vt = sb + HG_VT;
    bf16_t* ut = UT + ((size_t)(bh * 64 + chunk) * 64) * 64;
#pragma unroll
    for (int kt2 = 0; kt2 < 2; ++kt2) {
        const int kt = 2 * wq + kt2, k = 16 * kt + r; const float pre4 = pre[4 * 64 + k];
        hbf16x8 af[2];
#pragma unroll
        for (int ks = 0; ks < 2; ++ks) { const float pj = pre4 - pre[(2 * ks + (g >> 1)) * 64 + k]; float x[8];
#pragma unroll
            for (int j = 0; j < 8; ++j) { const int s = 32 * ks + 8 * g + j; x[j] = bf2f(kraw[kt2][ks][j]) * __expf(pj - bl[s * HG_BP + k]); }
            af[ks] = pack8(x); }
#pragma unroll
        for (int vtile = 0; vtile < 4; ++vtile) { f32x4 acc = {0.f, 0.f, 0.f, 0.f};
#pragma unroll
            for (int ks = 0; ks < 2; ++ks) { const hbf16x8 bf = *(const LAS hbf16x8*)(vt + (16 * vtile + r) * (HG_VP * 2) + (32 * ks + 8 * g) * 2); acc = __builtin_amdgcn_mfma_f32_16x16x32_bf16(af[ks], bf, acc, 0, 0, 0); }
            u32x2 w; w.x = pk2v(acc[0], acc[1]); w.y = pk2v(acc[2], acc[3]); *(u32x2*)(ut + (size_t)(16 * vtile + r) * 64 + 16 * kt + 4 * g) = w; }
        if (g == 0) DD[(size_t)(bh * 64 + chunk) * 64 + k] = __expf(pre4);
    }
}

__device__ __forceinline__ void hgrn_b_scan(int bx, int G, unsigned char* P, const float* DD) {
    int tid_ = threadIdx.x; asm volatile("" : "+v"(tid_));
    typedef float f32x2s __attribute__((ext_vector_type(2)));
    unsigned* UT = (unsigned*)(P + P_US);
    for (int gid = bx * 512 + tid_; gid < 32 * 2048; gid += G * 512) {
        const int bh = gid >> 11, e2 = gid & 2047; unsigned* u = UT + (size_t)bh * 64 * 2048 + e2; const f32x2s* dd = (const f32x2s*)(DD + (size_t)bh * 64 * 64) + (e2 & 31);
        float S0 = 0.f, S1 = 0.f;
        for (int c0 = 0; c0 < 64; c0 += 32) { unsigned tu[32]; f32x2s td[32];
#pragma unroll
            for (int i = 0; i < 32; ++i) { tu[i] = u[(size_t)(c0 + i) * 2048]; td[i] = dd[(c0 + i) * 32]; }
#pragma unroll
            for (int i = 0; i < 32; ++i) { u[(size_t)(c0 + i) * 2048] = pk2(S0, S1); S0 = td[i][0] * S0 + bflo(tu[i]); S1 = td[i][1] * S1 + bfhi(tu[i]); } }
    }
}

__device__ __forceinline__ void hgrn_c_item(int item, unsigned char* P, bf16_t* MIX, const float* hgn, LAS unsigned char* L) {
    int tid_ = threadIdx.x; asm volatile("" : "+v"(tid_)); const int tid = tid_, lane = tid & 63, wq = (tid >> 6) & 1, cs = tid >> 7, r = lane & 15, g = lane >> 4;
    const int bh = item >> 4, chunk = (item & 15) * 4 + cs, b = bh >> 2, h = bh & 3;
    const size_t row0 = (size_t)b * SEQ + chunk * 64;
    const bf16_t* HQ = (const bf16_t*)(P + P_HQ); const bf16_t* HK = (const bf16_t*)(P + P_HK); const bf16_t* HG = (const bf16_t*)(P + P_HG); const bf16_t* ST = (const bf16_t*)(P + P_US);
    LAS unsigned char* sb = L + cs * HG_SLOT;
    u32x4 qraw[2][2], kraw[4][2], sraw[4][2];
    const bf16_t* st = ST + ((size_t)(bh * 64 + chunk) * 64) * 64;
#pragma unroll
    for (int ks = 0; ks < 2; ++ks) {
#pragma unroll
        for (int ii = 0; ii < 2; ++ii) { const int I = ii ? (wq ? 2 : 3) : (wq ? 1 : 0); qraw[ii][ks] = *(const u32x4*)(HQ + (row0 + 16 * I + r) * 256 + h * 64 + 32 * ks + 8 * g); }
#pragma unroll
        for (int J = 0; J < 4; ++J) kraw[J][ks] = *(const u32x4*)(HK + (row0 + 16 * J + r) * 256 + h * 64 + 32 * ks + 8 * g);
#pragma unroll
        for (int vtile = 0; vtile < 4; ++vtile) sraw[vtile][ks] = *(const u32x4*)(st + (size_t)(16 * vtile + r) * 64 + 32 * ks + 8 * g); }
    hg_stage(tid, row0, h, (const float*)(P + P_HLF), (const bf16_t*)(P + P_HI), sb);
    const LAS float* bl = (const LAS float*)sb; const LAS float* pre = (const LAS float*)(sb + HG_PRE); const LAS unsigned char* vt = sb + HG_VT;
    hbf16x8 sfr[4][2];
#pragma unroll
    for (int vtile = 0; vtile < 4; ++vtile)
#pragma unroll
        for (int ks = 0; ks < 2; ++ks) sfr[vtile][ks] = __builtin_bit_cast(hbf16x8, sraw[vtile][ks]);
#pragma unroll
    for (int ii = 0; ii < 2; ++ii) {
        const int I = ii ? (wq ? 2 : 3) : (wq ? 1 : 0), t = 16 * I + r;
        unsigned short graw[4][4];
#pragma unroll
        for (int i = 0; i < 4; ++i)
#pragma unroll
            for (int vtile = 0; vtile < 4; ++vtile) graw[i][vtile] = HG[(row0 + 16 * I + 4 * g + i) * 256 + h * 64 + 16 * vtile + r];
        hbf16x8 qtf[2], qhf[2];
#pragma unroll
        for (int ks = 0; ks < 2; ++ks) { const int kb = 32 * ks + 8 * g; float q[8], xt[8], xh[8];
            unpack8(qraw[ii][ks], q);
#pragma unroll
            for (int j = 0; j < 8; ++j) { xt[j] = q[j] * __expf(bl[t * HG_BP + kb + j]); xh[j] = xt[j] * __expf(pre[I * 64 + kb + j]); }
            qtf[ks] = pack8(xt); qhf[ks] = pack8(xh); }
        f32x4 at[4];
#pragma unroll
        for (int J = 0; J < 4; ++J) { at[J] = (f32x4){0.f, 0.f, 0.f, 0.f};
            if (J <= I) { const int s = 16 * J + r;
#pragma unroll
                for (int ks = 0; ks < 2; ++ks) { const int kb = 32 * ks + 8 * g; float kk[8], x[8];
                    unpack8(kraw[J][ks], kk);
#pragma unroll
                    for (int j = 0; j < 8; ++j) x[j] = kk[j] * __expf(fminf(pre[I * 64 + kb + j] - pre[J * 64 + kb + j] - bl[s * HG_BP + kb + j], 80.f));
                    at[J] = __builtin_amdgcn_mfma_f32_16x16x32_bf16(pack8(x), qtf[ks], at[J], 0, 0, 0); }
                if (J == I) {
#pragma unroll
                    for (int i = 0; i < 4; ++i) at[J][i] = (4 * g + i <= r) ? at[J][i] : 0.f; } } }
        hbf16x8 pf[2];
#pragma unroll
        for (int k2 = 0; k2 < 2; ++k2) { const float x[8] = {at[2 * k2][0], at[2 * k2][1], at[2 * k2][2], at[2 * k2][3], at[2 * k2 + 1][0], at[2 * k2 + 1][1], at[2 * k2 + 1][2], at[2 * k2 + 1][3]}; { u32x4 w_; w_.x = pk2v(x[0], x[1]); w_.y = pk2v(x[2], x[3]); w_.z = pk2v(x[4], x[5]); w_.w = pk2v(x[6], x[7]); pf[k2] = __builtin_bit_cast(hbf16x8, w_); } }
        f32x4 o[4];
#pragma unroll
        for (int vtile = 0; vtile < 4; ++vtile) { f32x4 acc = {0.f, 0.f, 0.f, 0.f}; const int v = 16 * vtile + r;
#pragma unroll
            for (int ks = 0; ks < 2; ++ks) acc = __builtin_amdgcn_mfma_f32_16x16x32_bf16(qhf[ks], sfr[vtile][ks], acc, 0, 0, 0);
#pragma unroll
            for (int k2 = 0; k2 < 2; ++k2) { if (k2 == 0 || I >= 2) {
                const hbf16x4 v0 = *(const LAS hbf16x4*)(vt + v * (HG_VP * 2) + (32 * k2 + 4 * g) * 2), v1 = *(const LAS hbf16x4*)(vt + v * (HG_VP * 2) + (32 * k2 + 16 + 4 * g) * 2);
                const hbf16x8 vf = {v0[0], v0[1], v0[2], v0[3], v1[0], v1[1], v1[2], v1[3]};
                acc = __builtin_amdgcn_mfma_f32_16x16x32_bf16(pf[k2], vf, acc, 0, 0, 0); } }
            o[vtile] = acc; }
#pragma unroll
        for (int i = 0; i < 4; ++i) { float sq = 0.f;
#pragma unroll
            for (int vtile = 0; vtile < 4; ++vtile) sq += o[vtile][i] * o[vtile][i];
            sq += __shfl_xor(sq, 1); sq += __shfl_xor(sq, 2); sq += __shfl_xor(sq, 4); sq += __shfl_xor(sq, 8);
            const float rn = rsqrtf(sq * (1.0f / 64.0f) + EPS); const size_t row = row0 + 16 * I + 4 * g + i;
#pragma unroll
            for (int vtile = 0; vtile < 4; ++vtile) { const int v = 16 * vtile + r; const float gg = bf2f(graw[i][vtile]);
                MIX[row * DM + h * 64 + v] = (bf16_t)f2bf(o[vtile][i] * rn * hgn[v] * (gg / (1.0f + __expf(-gg)))); } }
    }
}

struct Args { const float* in[14]; float* out; unsigned char* ws; int ph_lo, ph_hi; };
constexpr int NPHASE = 1 + 7 * DEPTH;

__global__ void __launch_bounds__(512, 2) fwd(Args a) {
    extern __shared__ __attribute__((aligned(16))) unsigned char lds[];
    cg::grid_group grid = cg::this_grid();
    LAS unsigned char* L = (LAS unsigned char*)lds;
    if (threadIdx.x < 32) ((LAS unsigned*)(L + LDS_BYTES - 128))[threadIdx.x] = 0u;
    __syncthreads();
    for (int ph = a.ph_lo; ph < a.ph_hi; ++ph) {
        int G = gridDim.x, bx = blockIdx.x; asm volatile("" : "+s"(G), "+s"(bx));
        typedef const __attribute__((address_space(4))) Args* KArgP;
        KArgP ap = (KArgP)__builtin_amdgcn_kernarg_segment_ptr(); asm volatile("" : "+s"(ap));
        unsigned char* ws = ap->ws;
        float* SS = (float*)(ws + WS_SS); float* LB = (float*)(ws + WS_LB);
        bf16_t* XB = (bf16_t*)(ws + WS_XB); bf16_t* MIX = (bf16_t*)(ws + WS_MIX); bf16_t* UB = (bf16_t*)(ws + WS_U);
        unsigned char* P = ws + WS_P;
#ifdef PROBE_T
        if (ph == NPHASE) {
            if (bx == 0) { const unsigned long long* ts_ = (const unsigned long long*)(ws + 65536); unsigned long long sa = 0, sb = 0;
                for (int p = 1; p < NPHASE; ++p) { const int kk_ = (p - 1) % 7; const unsigned long long d = ts_[p] - ts_[p - 1]; if (PROBE_A(kk_)) sa += d; if (PROBE_B(kk_)) sb += d; }
                const float fa = (float)sa * 1e-3f, fb = (float)sb * 1e-3f; float* o_ = ap->out;
                for (int i = threadIdx.x; i < (1 << 20); i += 512) o_[(1 << 20) + i] += fb;
                if (threadIdx.x == 0) o_[0] = fa; }
        } else
#endif
        if (ph == 0) {
            int tid = threadIdx.x; asm volatile("" : "+v"(tid)); const int lane = tid & 63, wave = __builtin_amdgcn_readfirstlane(tid >> 6);
            LAS float* scr = (LAS float*)(L + wave * 16384);
            const int gw = bx * 8 + wave, NGW = G * 8;
            constexpr int I_IN = 16 * 112, I_OUT = 16 * 32, I_1 = 16 * 128, I_2 = 64 * 32, I_L = I_IN + I_OUT + I_1 + I_2;
            for (int it = gw; it < DEPTH * I_L; it += NGW) {
                const int l = it / I_L; int r = it % I_L;
                unsigned char* wl = ws + WS_W + (size_t)l * W_LAYER;
                if (r < I_IN) { const int kb = r / 112, nb = r % 112, n0 = nb * 32, pn = n0 >> 8, p = n0 & 255, slot = 4 * pn + ((p & 127) >> 5), sc0 = 64 * slot + 32 * (p >> 7);
                    tr_item(ap->in[3] + (size_t)l * DM * INC, INC, INC, sc0, kb * 64, ap->in[2] + l * DM, (bf16_t*)wl, DM, n0, scr, lane); continue; }
                r -= I_IN;
                if (r < I_OUT) { const int kb = r / 32, nb = r % 32; tr_item(ap->in[10] + (size_t)l * DM * DM, DM, DM, nb * 32, kb * 64, nullptr, (bf16_t*)(wl + W_OUT), DM, nb * 32, scr, lane); continue; }
                r -= I_OUT;
                if (r < I_1) { const int kb = r / 128, nb = r % 128; tr_item(ap->in[12] + (size_t)l * DM * DFF, DFF, DFF, nb * 32, kb * 64, ap->in[11] + l * DM, (bf16_t*)(wl + W_1), DM, nb * 32, scr, lane); continue; }
                r -= I_1;
                { const int kb = r / 32, nb = r % 32; tr_item(ap->in[13] + (size_t)l * DFF * DM, DM, DM, nb * 32, kb * 64, nullptr, (bf16_t*)(wl + W_2), DFF, nb * 32, scr, lane); }
            }
            const float* x = ap->in[0];
            for (int m0 = gw; m0 < M; m0 += 4 * NGW) {
                f32x4 v[4][4]; float s[4];
#pragma unroll
                for (int q = 0; q < 4; ++q) { const int m = m0 + q * NGW; const f32x4* xr = (const f32x4*)(x + (size_t)(m < M ? m : gw) * DM) + lane;
#pragma unroll
                    for (int j = 0; j < 4; ++j) v[q][j] = xr[64 * j]; }
#pragma unroll
                for (int q = 0; q < 4; ++q) { s[q] = 0.f;
#pragma unroll
                    for (int j = 0; j < 4; ++j) s[q] += (v[q][j][0] * v[q][j][0] + v[q][j][1] * v[q][j][1]) + (v[q][j][2] * v[q][j][2] + v[q][j][3] * v[q][j][3]); }
#pragma unroll
                for (int q = 0; q < 4; ++q) { const int m = m0 + q * NGW; const float tot = wave_sum(s[q]);
                    if (m < M) { u32x2* o8 = (u32x2*)(XB + (size_t)m * DM) + lane;
#pragma unroll
                        for (int j = 0; j < 4; ++j) { u32x2 w; w.x = pk2(v[q][j][0], v[q][j][1]); w.y = pk2(v[q][j][2], v[q][j][3]); o8[64 * j] = w; }
                        if (lane < 16) SS[(size_t)m * 16 + lane] = (lane == 0) ? tot : 0.f; } }
            }
            if (bx == 2 && tid < 64) ((unsigned*)ws)[tid] = 0u;
            if (bx == 3) for (int i = tid; i < XCD_BAR_WORDS; i += 512) ((unsigned*)(ws + WS_BAR))[i] = 0u;
            if (bx == 1) {
                for (int i = tid; i < 1024; i += 512) { const int l = i >> 8, wh = (i >> 6) & 3, d = i & 63; LB[2048 + i] = ap->in[5 + wh][l * 64 + d]; }
                if (tid < 32) { const int l = tid >> 3, e = tid & 7; LB[3072 + tid] = (e < 6) ? ap->in[9][l * 6 + e] : 0.f; }
            }
            if (bx == 0 && tid < 256) {
                const float* lg = ap->in[1]; float e[DEPTH]; float mx = -1e30f, sum = 0.f;
#pragma unroll
                for (int l = 0; l < DEPTH; ++l) mx = fmaxf(mx, lg[l * 256 + tid]);
#pragma unroll
                for (int l = 0; l < DEPTH; ++l) { e[l] = expf(lg[l * 256 + tid] - mx); sum += e[l]; }
                float c = 0.f;
#pragma unroll
                for (int l = 0; l < DEPTH; ++l) { if (l > 0) c += e[l] / sum; LB[l * 512 + tid] = logf(fmaxf(c, 1e-30f)); LB[l * 512 + 256 + tid] = 1.0f - c; }
            }
        } else {
            const int l = (ph - 1) / 7, k = (ph - 1) % 7;
#ifdef REP_K
            const int nrep = (k == REP_K) ? 2 : 1;
#else
            const int nrep = 1;
#endif
            for (int rep = 0; rep < nrep; ++rep) {
            if (rep) { XcdBarrier xb_; xb_.bar = (unsigned*)(ws + WS_BAR); xb_.x = xb_xcc_id(); xb_.st = (volatile LAS unsigned*)(L + LDS_BYTES - 128); xcd_barrier(xb_); }
            unsigned char* wl = ws + WS_W + (size_t)l * W_LAYER;
            if (k == 0) {
                pg8::Gemm g{XB, (const bf16_t*)wl, M, NIN, DM}; pg8::StaticOrder S; S.init(M, NIN, G, bx);
                EpiInProj E{SS, P, LB + l * 512, LB + 2048 + l * 256, LB + 3072 + l * 8};
                pg8::gemm_phase<EpiInProj, pg8::StaticOrder, true, true>(L, g, S, E);
            } else if (k == 1) {
                int tid = threadIdx.x; asm volatile("" : "+v"(tid));
                unsigned* ctr = (unsigned*)ws + l * 16 + 1 + rep * 4;
                volatile LAS int* sh = (volatile LAS int*)(L + LDS_BYTES - 64);
                int nxt = 0; if (tid == 0) nxt = (int)atomicAdd(ctr, 1u);
                for (;;) {
                    if (tid == 0) sh[0] = nxt;
                    __syncthreads();
                    const int idx = __builtin_amdgcn_readfirstlane(sh[0]);
                    __syncthreads();
                    if (idx >= 816 + 512) break;
                    if (tid == 0) nxt = (int)atomicAdd(ctr, 1u);
                    if (idx < 768) { const int qb = 15 - idx / 48, bh = idx % 48, b = bh / 6, h = bh % 6; typedef attn_body::bf16 abf;
                        attn_body::sb_unit(qb, (const abf*)(P + P_SQ) + (size_t)bh * SEQ * 64, (const abf*)(P + P_SQ + HEADBUF) + (size_t)bh * SEQ * 64, (const abf*)(P + P_SQ + 2 * HEADBUF) + (size_t)bh * SEQ * 64,
                                           (abf*)MIX + (size_t)b * SEQ * DM + 256 + h * 64, (char*)lds); }
                    else if (idx < 816) fox_cumsum_item(idx - 768, (const float*)(P + P_LF), (float*)(P + P_CC), (int*)(ws + WS_JS), LB + 2048 + l * 256 + 128, LB + 2048 + l * 256 + 192, (LAS float*)L);
                    else hgrn_a_item(idx - 816, P, (float*)(ws + WS_DD), L);
                    __syncthreads();
                }
            } else if (k == 2) {
                hgrn_b_scan(bx, G, P, (const float*)(ws + WS_DD));
            } else if (k == 3) {
                int tid = threadIdx.x; asm volatile("" : "+v"(tid));
                unsigned* ctr = (unsigned*)ws + l * 16 + rep * 4;
                volatile LAS int* sh = (volatile LAS int*)(L + LDS_BYTES - 64);
                int nxt = 0; if (tid == 0) nxt = (int)atomicAdd(ctr, 1u);
                for (;;) {
                    if (tid == 0) sh[0] = nxt;
                    __syncthreads();
                    const int idx = __builtin_amdgcn_readfirstlane(sh[0]);
                    __syncthreads();
#ifdef PROBE_FOX
                    if (idx >= 768 + 512 || (rep && idx >= 768)) break;
#else
                    if (idx >= 768 + 512) break;
#endif
                    if (tid == 0) nxt = (int)atomicAdd(ctr, 1u);
                    if (idx >= 768) { hgrn_c_item(idx - 768, P, MIX, ap->in[4] + l * 64, L); __syncthreads(); continue; }
                    const int qb = 15 - idx / 48, bh = idx % 48, b = bh / 6, h = bh % 6;
                    typedef attn_body::bf16 abf;
                    const int jstart = ((const int*)(ws + WS_JS))[bh * 16 + qb];
#ifdef PROBE_FOX
                    if (rep) attn_body::attn_unit<30, PROBE_FOX_BIAS>(qb, PROBE_FOX_JS(jstart), (const abf*)(P + P_FQ) + (size_t)bh * SEQ * 64, (const abf*)(P + P_FQ + HEADBUF) + (size_t)bh * SEQ * 64, (const abf*)(P + P_FQ + 2 * HEADBUF) + (size_t)bh * SEQ * 64,
                                            (abf*)ap->out + (size_t)b * SEQ * DM + 640 + h * 64, (const float*)(P + P_CC) + (size_t)bh * SEQ, (char*)lds);
                    else
#endif
                    attn_body::attn_unit<30>(qb, jstart, (const abf*)(P + P_FQ) + (size_t)bh * SEQ * 64, (const abf*)(P + P_FQ + HEADBUF) + (size_t)bh * SEQ * 64, (const abf*)(P + P_FQ + 2 * HEADBUF) + (size_t)bh * SEQ * 64,
                                            (abf*)MIX + (size_t)b * SEQ * DM + 640 + h * 64, (const float*)(P + P_CC) + (size_t)bh * SEQ, (char*)lds);
                }
            } else if (k == 5) {
                pg8::Gemm g{XB, (const bf16_t*)(wl + W_1), M, DFF, DM}; pg8::StaticOrder S; S.init(M, DFF, G, bx);
                EpiRelu2 E{UB, SS};
                pg8::gemm_phase<EpiRelu2, pg8::StaticOrder, true, true>(L, g, S, E);
            } else {
                const bool ff2 = (k == 6);
                pg8::Gemm g{ff2 ? UB : MIX, (const bf16_t*)(wl + (ff2 ? W_2 : W_OUT)), M, DM, ff2 ? DFF : DM}; pg8::StaticOrder S; S.init(M, DM, G, bx);
                EpiResid E{XB, (ff2 && l == DEPTH - 1) ? ap->out : nullptr, SS};
                pg8::gemm_phase<EpiResid, pg8::StaticOrder, true, true>(L, g, S, E);
            }
            }
        }
#ifdef PROBE_T
        if (bx == 0 && threadIdx.x == 0) ((unsigned long long*)(ws + 65536))[ph] = __builtin_amdgcn_s_memrealtime();
#endif
        if (ph + 1 < a.ph_hi) {
            if (ph == 0) {
                grid.sync();
                (void)xcd_barrier_post((unsigned*)(ws + WS_BAR), (volatile LAS unsigned*)(L + LDS_BYTES - 128));
            } else {
                XcdBarrier xb_; xb_.bar = (unsigned*)(ws + WS_BAR); xb_.x = xb_xcc_id(); xb_.st = (volatile LAS unsigned*)(L + LDS_BYTES - 128);
                xcd_barrier(xb_);
            }
        }
    }
}

#ifndef MK_MULTI
#define MK_MULTI 0
#endif
extern "C" void kernel_launch(void* const* d_in, const int* in_sizes, int n_in, void* d_out, int out_size, void* d_ws, size_t ws_size, hipStream_t stream) {
    static int grid = 0;
    if (grid == 0) {
        int dev = 0, cus = 0, per = 0;
        if (n_in != 14 || out_size != M * DM || ws_size < WS_END) { fprintf(stderr, "kernel_launch: unexpected shapes (n_in %d out %d ws %zu)\n", n_in, out_size, ws_size); grid = -1; return; }
        (void)hipGetDevice(&dev); (void)hipDeviceGetAttribute(&cus, hipDeviceAttributeMultiprocessorCount, dev);
        (void)hipFuncSetAttribute((const void*)fwd, hipFuncAttributeMaxDynamicSharedMemorySize, LDS_BYTES);
        (void)hipOccupancyMaxActiveBlocksPerMultiprocessor(&per, (const void*)fwd, 512, LDS_BYTES);
        if (per < 1) per = 1;
        grid = cus * per;
        fprintf(stderr, "kernel_launch: grid %d (cus %d x %d)\n", grid, cus, per);
    }
    if (grid < 0) return;
    Args a{};
    for (int i = 0; i < 14; ++i) a.in[i] = (const float*)d_in[i];
    a.out = (float*)d_out; a.ws = (unsigned char*)d_ws;
#if MK_MULTI
    for (int ph = 0; ph < NPHASE; ++ph) { a.ph_lo = ph; a.ph_hi = ph + 1; hipLaunchKernelGGL(fwd, dim3(grid), dim3(512), LDS_BYTES, stream, a); }
#else
#ifdef PROBE_T
    a.ph_lo = 0; a.ph_hi = NPHASE + 1;
#else
    a.ph_lo = 0; a.ph_hi = NPHASE;
#endif
    void* args[] = {&a};
    hipError_t e = hipLaunchCooperativeKernel((const void*)fwd, dim3(grid), dim3(512), args, LDS_BYTES, stream);
    if (e != hipSuccess) fprintf(stderr, "kernel_launch: cooperative launch failed: %s (grid %d)\n", hipGetErrorString(e), grid);
#endif
}
```

```cpp
#include <hip/hip_runtime.h>
#include <hip/hip_cooperative_groups.h>
#include <cstdio>
#include <cstdint>
namespace cg = cooperative_groups;
namespace pg8 {
#define PG8_LAS __attribute__((address_space(3)))
typedef unsigned short bf16_t;
typedef short bf16x8 __attribute__((ext_vector_type(8)));
typedef float f32x4 __attribute__((ext_vector_type(4)));
typedef unsigned u32x4 __attribute__((ext_vector_type(4)));
constexpr int BM = 256, BK = 64, HALF = 128, HTB = HALF * BK * 2  , STAGE_BYTES = 8 * HTB, NXCD = 8, WGM = 8;

__host__ __device__ __forceinline__ int lds_byte(int r, int c) { const int st = (r >> 4) * 2 + (c >> 5), rr = r & 15, cc = c & 31, ob = rr * 64 + cc * 2; return st * 1024 + (ob ^ (((ob >> 9) & 1) << 5)); }
__host__ __device__ __forceinline__ void stage_rc(int b, int& R, int& C) { const int st = b / 1024, sb = b % 1024, swz = sb ^ (((sb >> 9) & 1) << 5); R = (st >> 1) * 16 + swz / 64; C = (st & 1) * 32 + (swz % 64) / 2; }
__host__ __device__ __forceinline__ int perm32(int rho) { const int n = rho >> 4, i = rho & 15; return 8 * (i >> 2) + 4 * n + (i & 3); }

struct Unit { int pm, pn; };
struct Gemm { const bf16_t* A; const bf16_t* Bt; int M, N, K; };

struct StaticOrder {
    int nM, nN, nwg, G, c;
    __host__ __device__ void init(int M, int N, int G_, int c_) { nM = M / BM; nN = N / BM; nwg = nM * nN; G = G_; c = c_; }
    __host__ __device__ bool next(int i, Unit& u) const {
        const long L = (long)i * G + c; if (L >= nwg) return false;
        int wgid = (int)L; { const int q = nwg / NXCD, r = nwg % NXCD, xcd = wgid % NXCD, off = wgid / NXCD; wgid = (xcd < r ? xcd * (q + 1) : r * (q + 1) + (xcd - r) * q) + off; }
        const int nig = WGM * nN, gid = wgid / nig, fm = gid * WGM, gsz = (nM - fm) < WGM ? (nM - fm) : WGM;
        u.pm = fm + ((wgid % nig) % gsz); u.pn = (wgid % nig) / gsz; return true;
    }
    __device__ __forceinline__ void a_ready(const Unit&) const {}
    __device__ __forceinline__ void done(const Unit&) const {}
};

__device__ __forceinline__ unsigned cvt_pk_bf16(float lo, float hi) { unsigned r; asm volatile("v_cvt_pk_bf16_f32 %0, %1, %2" : "=v"(r) : "v"(lo), "v"(hi)); return r; }
typedef float f32x2 __attribute__((ext_vector_type(2)));
template <class Epi, class Sched, bool ALIGN_EPI = false, bool SP2 = false>
__device__ __forceinline__ void gemm_phase(PG8_LAS unsigned char* lds, const Gemm g, const Sched& S, const Epi& E) {
    int tid_ = threadIdx.x; asm volatile("" : "+v"(tid_));
    const int tid = tid_, wid = __builtin_amdgcn_readfirstlane(tid >> 6), lane = tid & 63, wr = wid >> 2, wc = wid & 3, fr = lane & 15, fq = lane >> 4;
    const int K = g.K, nt = K / BK;
    unsigned voffA[2], voffB[2];
#pragma unroll
    for (int i = 0; i < 2; ++i) { int R, C; stage_rc(tid * 16 + i * 8192, R, C); const int Rb = Epi::PERM ? ((R & ~31) + perm32(R & 31)) : R;
        voffA[i] = (unsigned)(R * K + C) * 2u; voffB[i] = (unsigned)(Rb * K + C) * 2u; }
    const size_t kstep = (size_t)(BK * 2);
    const size_t hstep = (size_t)HALF * K * 2;
    const size_t tstep = 2 * hstep;
    const unsigned ldsw = (unsigned)wid * 1024u;
    const int aoff = lds_byte(wr * 64 + fr, fq * 8), boff = lds_byte(wc * 32 + fr, fq * 8);
#define PG8_SA(b, h) (((b) * 2 + (h)) * HTB)
#define PG8_SB(b, h) ((4 + (b) * 2 + (h)) * HTB)
#define PG8_STAGE(bufoff, gbase, voff) do { _Pragma("unroll") for (int _i = 0; _i < 2; ++_i) \
        __builtin_amdgcn_global_load_lds((const unsigned*)((const char*)(gbase) + (voff)[_i]), (PG8_LAS unsigned*)(lds + (bufoff) + ldsw + _i * 8192), 16, 0, 0); } while (0)
#define PG8_LDA(dst, b, h) do { _Pragma("unroll") for (int m = 0; m < 4; ++m) _Pragma("unroll") for (int k = 0; k < 2; ++k) dst[m][k] = *(const PG8_LAS bf16x8*)(lds + PG8_SA(b, h) + aoff + m * 2048 + k * 1024); } while (0)
#define PG8_LDB(dst, b, h) do { _Pragma("unroll") for (int n = 0; n < 2; ++n) _Pragma("unroll") for (int k = 0; k < 2; ++k) dst[n][k] = *(const PG8_LAS bf16x8*)(lds + PG8_SB(b, h) + boff + n * 2048 + k * 1024); } while (0)
#define PG8_MMA(ai, bj, At, Bt) do { __builtin_amdgcn_s_setprio(1); _Pragma("unroll") for (int m = 0; m < 4; ++m) _Pragma("unroll") for (int n = 0; n < 2; ++n) _Pragma("unroll") for (int k = 0; k < 2; ++k) \
        acc[ai][bj][m][n] = __builtin_amdgcn_mfma_f32_16x16x32_bf16(Bt[n][k], At[m][k], acc[ai][bj][m][n], 0, 0, 0); __builtin_amdgcn_s_setprio(0); } while (0)
#define PG8_WAIT_V(n) asm volatile("s_waitcnt vmcnt(" #n ")" ::: "memory")
#define PG8_WAIT_L(n) asm volatile("s_waitcnt lgkmcnt(" #n ")" ::: "memory")
#define PG8_BAR __builtin_amdgcn_s_barrier()
#define PG8_SCHED __builtin_amdgcn_sched_barrier(0)
    Unit cur, nxt; int ui = 0;
    if (!S.next(0, cur)) return;
    f32x4 acc[2][2][4][2];
#pragma unroll
    for (int a = 0; a < 2; ++a)
#pragma unroll
        for (int b = 0; b < 2; ++b)
#pragma unroll
            for (int m = 0; m < 4; ++m)
#pragma unroll
                for (int n = 0; n < 2; ++n) acc[a][b][m][n] = (f32x4){0.f, 0.f, 0.f, 0.f};
    bf16x8 At[4][2], B0[2][2], B1[2][2];
    const char* cA = (const char*)g.A + (size_t)cur.pm * tstep; const char* cB = (const char*)g.Bt + (size_t)cur.pn * tstep;
    S.a_ready(cur);
    if constexpr (SP2) {
        PG8_STAGE(PG8_SB(0, 0), cB, voffB); PG8_STAGE(PG8_SB(0, 1), cB + hstep, voffB); PG8_STAGE(PG8_SA(0, 0), cA, voffA); PG8_STAGE(PG8_SA(0, 1), cA + hstep, voffA);
        if (wr == 1) PG8_BAR;
        PG8_WAIT_V(2); PG8_BAR;
        PG8_STAGE(PG8_SB(1, 0), cB + kstep, voffB); PG8_STAGE(PG8_SA(1, 0), cA + kstep, voffA); PG8_STAGE(PG8_SB(1, 1), cB + hstep + kstep, voffB);
        PG8_WAIT_V(6); PG8_BAR;
    } else {
        PG8_STAGE(PG8_SB(0, 0), cB, voffB); PG8_STAGE(PG8_SA(0, 0), cA, voffA); PG8_STAGE(PG8_SB(0, 1), cB + hstep, voffB); PG8_STAGE(PG8_SA(0, 1), cA + hstep, voffA);
        if (wr == 1) PG8_BAR;
        PG8_WAIT_V(4); PG8_BAR;
        PG8_STAGE(PG8_SB(1, 0), cB + kstep, voffB); PG8_STAGE(PG8_SA(1, 0), cA + kstep, voffA); PG8_STAGE(PG8_SB(1, 1), cB + hstep + kstep, voffB);
        PG8_WAIT_V(6); PG8_BAR;
    }
    for (;;) {
        const bool has_next = S.next(ui + 1, nxt);
        const char* nA = has_next ? (const char*)g.A + (size_t)nxt.pm * tstep : cA; const char* nB = has_next ? (const char*)g.Bt + (size_t)nxt.pn * tstep : cB;
        for (int t = 0; t < nt; t += 2) {
            const bool last = (t == nt - 2);
            const char* a1 = cA + (size_t)(t + 1) * kstep;
            const char* a2 = last ? nA : cA + (size_t)(t + 2) * kstep; const char* b2 = last ? nB : cB + (size_t)(t + 2) * kstep;
            const char* a3 = a2 + kstep; const char* b3 = b2 + kstep;
            if (last && has_next) S.a_ready(nxt);
            if constexpr (SP2) {
            PG8_LDB(B0, 0, 0); PG8_LDB(B1, 0, 1); PG8_SCHED; PG8_LDA(At, 0, 0); PG8_STAGE(PG8_SA(1, 1), a1 + hstep, voffA);
            PG8_WAIT_V(8); PG8_WAIT_L(0); PG8_BAR; PG8_MMA(0, 0, At, B0); PG8_MMA(0, 1, At, B1); PG8_BAR; PG8_SCHED;
            PG8_LDA(At, 0, 1); PG8_STAGE(PG8_SB(0, 0), b2, voffB); PG8_STAGE(PG8_SB(0, 1), b2 + hstep, voffB); PG8_STAGE(PG8_SA(0, 0), a2, voffA);
            PG8_WAIT_V(8); PG8_WAIT_L(0); PG8_BAR; PG8_MMA(1, 0, At, B0); PG8_MMA(1, 1, At, B1); PG8_BAR; PG8_SCHED;
            PG8_LDB(B0, 1, 0); PG8_LDB(B1, 1, 1); PG8_SCHED; PG8_LDA(At, 1, 0); PG8_STAGE(PG8_SA(0, 1), a2 + hstep, voffA);
            PG8_WAIT_V(8); PG8_WAIT_L(0); PG8_BAR; PG8_MMA(0, 0, At, B0); PG8_MMA(0, 1, At, B1); PG8_BAR; PG8_SCHED;
            PG8_LDA(At, 1, 1); PG8_STAGE(PG8_SB(1, 0), b3, voffB); PG8_STAGE(PG8_SB(1, 1), b3 + hstep, voffB); PG8_STAGE(PG8_SA(1, 0), a3, voffA);
            PG8_WAIT_V(8); PG8_WAIT_L(0); PG8_BAR; PG8_MMA(1, 0, At, B0); PG8_MMA(1, 1, At, B1); PG8_BAR; PG8_SCHED;
            } else {
            PG8_LDB(B0, 0, 0); PG8_SCHED; PG8_LDA(At, 0, 0); PG8_STAGE(PG8_SA(1, 1), a1 + hstep, voffA);
            PG8_WAIT_L(8); PG8_BAR; PG8_WAIT_L(0); PG8_MMA(0, 0, At, B0); PG8_BAR; PG8_SCHED;
            PG8_LDB(B1, 0, 1); PG8_STAGE(PG8_SB(0, 0), b2, voffB);
            PG8_BAR; PG8_WAIT_L(0); PG8_MMA(0, 1, At, B1); PG8_BAR;
            PG8_LDA(At, 0, 1); PG8_STAGE(PG8_SA(0, 0), a2, voffA);
            PG8_BAR; PG8_WAIT_L(0); PG8_MMA(1, 0, At, B0); PG8_BAR; PG8_SCHED;
            PG8_STAGE(PG8_SB(0, 1), b2 + hstep, voffB);
            PG8_WAIT_V(6); PG8_BAR; PG8_MMA(1, 1, At, B1); PG8_BAR;
            PG8_LDB(B0, 1, 0); PG8_SCHED; PG8_LDA(At, 1, 0); PG8_STAGE(PG8_SA(0, 1), a2 + hstep, voffA);
            PG8_WAIT_L(8); PG8_BAR; PG8_WAIT_L(0); PG8_MMA(0, 0, At, B0); PG8_BAR; PG8_SCHED;
            PG8_LDB(B1, 1, 1); PG8_STAGE(PG8_SB(1, 0), b3, voffB);
            PG8_BAR; PG8_WAIT_L(0); PG8_MMA(0, 1, At, B1); PG8_BAR;
            PG8_LDA(At, 1, 1); PG8_STAGE(PG8_SA(1, 0), a3, voffA);
            PG8_BAR; PG8_WAIT_L(0); PG8_MMA(1, 0, At, B0); PG8_BAR; PG8_SCHED;
            PG8_STAGE(PG8_SB(1, 1), b3 + hstep, voffB);
            PG8_WAIT_V(6); PG8_BAR; PG8_MMA(1, 1, At, B1); PG8_BAR;
            }
        }
        if constexpr (ALIGN_EPI) { if (wr == 0) PG8_BAR; }
        if constexpr (!Epi::AFTER_DRAIN) { E(acc, cur, wr, wc, fr, fq); S.done(cur); }
        if (!has_next) break;
#pragma unroll
        for (int a = 0; a < 2; ++a)
#pragma unroll
            for (int b = 0; b < 2; ++b)
#pragma unroll
                for (int m = 0; m < 4; ++m)
#pragma unroll
                    for (int n = 0; n < 2; ++n) acc[a][b][m][n] = (f32x4){0.f, 0.f, 0.f, 0.f};
        cur = nxt; cA = nA; cB = nB; ++ui;
        if constexpr (ALIGN_EPI) { if (wr == 1) PG8_BAR; }
    }
    PG8_WAIT_V(0);
    if constexpr (!ALIGN_EPI) { if (wr == 0) PG8_BAR; }
    PG8_BAR;
    if constexpr (Epi::AFTER_DRAIN) { E.fused(acc, cur, wr, wc, fr, fq, lds, wid, lane); S.done(cur); }
#undef PG8_SA
#undef PG8_SB
#undef PG8_STAGE
#undef PG8_LDA
#undef PG8_LDB
#undef PG8_MMA
#undef PG8_WAIT_V
#undef PG8_WAIT_L
#undef PG8_BAR
#undef PG8_SCHED
}
}
#include <hip/hip_bf16.h>
#include <cmath>
namespace attn_body {
using bf16=__hip_bfloat16;
using bf16x8=__attribute__((ext_vector_type(8)))short;
using s16x4=__attribute__((ext_vector_type(4)))short;
using f32x16=__attribute__((ext_vector_type(16)))float;
using u32x4=__attribute__((ext_vector_type(4)))unsigned;
using f32x4v=__attribute__((ext_vector_type(4)))float;
constexpr int SEQ=4096,D=64,DM=64,OPITCH=1024;
constexpr int LDS_C=98304;
constexpr int NW=8,QBLK=32,QB=QBLK*NW,KVBLK=64,NQB=SEQ/QB;
constexpr int ATTN_UNIT_ROWS=QB;
__device__ __forceinline__ int crow(int r,int hi){return (r&3)+8*(r>>2)+4*hi;}
#define SBAR() __builtin_amdgcn_sched_barrier(0)
__device__ __forceinline__ void cmask(f32x16&p0,f32x16&p1,int jb,int qrel,int hi){
  const float NEG=-INFINITY; int kb=64*jb+4*hi;
  #pragma unroll
  for(int r=0;r<16;++r){int kv=kb+(r&3)+8*(r>>2); if(kv>qrel)p0[r]=NEG; if(kv+32>qrel)p1[r]=NEG;}
}

constexpr int NSLOT=3, SLOTB=8192;
constexpr int LDS_K=0, LDS_V=NSLOT*SLOTB, LDS_WS=2*NSLOT*SLOTB, LDS_OST=LDS_WS+NW*64*4, LDS_BYTES=LDS_OST+NW*4096;
constexpr float C2=0.125f*1.4426950408889634f;
__device__ __forceinline__ void glds16(const void*gsrc,unsigned lds_dst){unsigned keep;
  asm volatile("s_mov_b32 %0, m0\n\ts_mov_b32 m0, %2\n\ts_nop 0\n\tglobal_load_lds_dwordx4 %1, off\n\ts_mov_b32 m0, %0":"=&s"(keep):"v"(gsrc),"s"(lds_dst):"memory");}
__device__ __forceinline__ float max3f(float a,float b,float c){float r;asm("v_max3_f32 %0, %1, %2, %3":"=v"(r):"v"(a),"v"(b),"v"(c));return r;}
__device__ __forceinline__ float max2f(float a,float b){float r;asm("v_max_f32_e32 %0, %1, %2":"=v"(r):"v"(a),"v"(b));return r;}
__device__ __forceinline__ float fadd_s(float a,float b){float r;asm("v_add_f32_e32 %0, %1, %2":"=v"(r):"v"(a),"v"(b));return r;}
__device__ __forceinline__ float fsub_s(float a,float b){float r;asm("v_sub_f32_e32 %0, %1, %2":"=v"(r):"v"(a),"v"(b));return r;}
typedef float f32x2_t __attribute__((ext_vector_type(2))); typedef __bf16 bf16x2_t __attribute__((ext_vector_type(2)));
__device__ __forceinline__ unsigned cvtpk_s(float lo,float hi){f32x2_t v={lo,hi};bf16x2_t b=__builtin_convertvector(v,bf16x2_t);return __builtin_bit_cast(unsigned,b);}
#define WAIT_BAR(N) asm volatile("s_waitcnt vmcnt(" #N ") lgkmcnt(0)\n\ts_barrier":::"memory")

__device__ __forceinline__ void qkt(f32x16&p0,f32x16&p1,const char*Kslot,const bf16x8*qr,const f32x16&negm,int r32,int hi){
  const char*kb=Kslot+hi*1024+r32*16;
  #pragma unroll
  for(int d0=0;d0<4;++d0){
    const bf16x8 b0=*reinterpret_cast<const bf16x8*>(kb+d0*2048);
    const bf16x8 b1=*reinterpret_cast<const bf16x8*>(kb+d0*2048+512);
    if(d0==0){p0=__builtin_amdgcn_mfma_f32_32x32x16_bf16(b0,qr[0],negm,0,0,0);p1=__builtin_amdgcn_mfma_f32_32x32x16_bf16(b1,qr[0],negm,0,0,0);}
    else{p0=__builtin_amdgcn_mfma_f32_32x32x16_bf16(b0,qr[d0],p0,0,0,0);p1=__builtin_amdgcn_mfma_f32_32x32x16_bf16(b1,qr[d0],p1,0,0,0);}}
}
typedef __attribute__((address_space(3))) const char* lds_cptr;
typedef short v4i16_t __attribute__((ext_vector_type(4)));
__device__ __forceinline__ void kload8(bf16x8*kf,lds_cptr kp){
  kf[0]=*(const __attribute__((address_space(3))) bf16x8*)(kp);      kf[1]=*(const __attribute__((address_space(3))) bf16x8*)(kp+512);
  kf[2]=*(const __attribute__((address_space(3))) bf16x8*)(kp+2048); kf[3]=*(const __attribute__((address_space(3))) bf16x8*)(kp+2560);
  kf[4]=*(const __attribute__((address_space(3))) bf16x8*)(kp+4096); kf[5]=*(const __attribute__((address_space(3))) bf16x8*)(kp+4608);
  kf[6]=*(const __attribute__((address_space(3))) bf16x8*)(kp+6144); kf[7]=*(const __attribute__((address_space(3))) bf16x8*)(kp+6656);
}
__device__ __forceinline__ void kload2(bf16x8*kf,lds_cptr kp,int j){ kf[2*j]=*(const __attribute__((address_space(3))) bf16x8*)(kp+j*2048); kf[2*j+1]=*(const __attribute__((address_space(3))) bf16x8*)(kp+j*2048+512); }
__device__ __forceinline__ s16x4 vtr(lds_cptr p){ return __builtin_bit_cast(s16x4,__builtin_amdgcn_ds_read_tr16_b64_v4i16((__attribute__((address_space(3))) v4i16_t*)p)); }
__device__ __forceinline__ float rowmax(const f32x16&p0,const f32x16&p1){
  float a=max3f(p0[0],p0[1],p1[0]),b=max3f(p0[2],p0[3],p1[1]);a=max3f(a,p1[2],p1[3]);
  #pragma unroll
  for(int r=4;r<16;r+=4){a=max3f(a,p0[r],p0[r+1]);b=max3f(b,p0[r+2],p0[r+3]);a=max3f(a,p1[r],p1[r+1]);b=max3f(b,p1[r+2],p1[r+3]);}
  const float m=max2f(a,b);
  auto rr=__builtin_amdgcn_permlane32_swap(__float_as_uint(m),__float_as_uint(m),false,false);
  return max2f(__uint_as_float(rr[0]),__uint_as_float(rr[1]));
}
__device__ __forceinline__ void pv(f32x16*o,int vb,bf16x8 pa0,bf16x8 pa1,bf16x8 pa2,bf16x8 pa3){
  #pragma unroll
  for(int d0=0;d0<2;++d0){s16x4 lo[4],hi[4];
    #pragma unroll
    for(int ks=0;ks<4;++ks){
      asm volatile("ds_read_b64_tr_b16 %0,%1 offset:%c2":"=&v"(lo[ks]):"v"(vb),"i"(d0*4096+ks*1024):"memory");
      asm volatile("ds_read_b64_tr_b16 %0,%1 offset:%c2":"=&v"(hi[ks]):"v"(vb),"i"(d0*4096+ks*1024+512):"memory");}
    asm volatile("s_waitcnt lgkmcnt(0)":::"memory");SBAR();
    #define PK(k) (bf16x8){lo[k][0],lo[k][1],lo[k][2],lo[k][3],hi[k][0],hi[k][1],hi[k][2],hi[k][3]}
    o[d0]=__builtin_amdgcn_mfma_f32_32x32x16_bf16(pa0,PK(0),o[d0],0,0,0);
    o[d0]=__builtin_amdgcn_mfma_f32_32x32x16_bf16(pa1,PK(1),o[d0],0,0,0);
    o[d0]=__builtin_amdgcn_mfma_f32_32x32x16_bf16(pa2,PK(2),o[d0],0,0,0);
    o[d0]=__builtin_amdgcn_mfma_f32_32x32x16_bf16(pa3,PK(3),o[d0],0,0,0);
    #undef PK
  }
}

#ifndef ATTN_STORE16
#define ATTN_STORE16(p,v) (*(u32x4*)(p)=(v))
#endif
template<int THRL,bool BIASON=true> __device__ __forceinline__ void attn_unit(int qb,int jstart,const bf16*Q,const bf16*__restrict__ K,const bf16*__restrict__ V,bf16*O,const float*__restrict__ Cg,char*shm){
  int tid_=threadIdx.x; asm volatile("":"+v"(tid_)); const int tid=tid_,lane=tid&63,r32=lane&31,hi=lane>>5; const int wid=__builtin_amdgcn_readfirstlane(tid>>6);
  const int q0=qb*QB;
  const bf16*Qw=Q+(long)(q0+wid*QBLK)*DM;
  const bf16*Kh=K+(long)jstart*KVBLK*DM,*Vh=V+(long)jstart*KVBLK*DM;
  const lds_cptr shm3=(lds_cptr)shm;
  const unsigned lds0=(unsigned)(uintptr_t)shm;
  float*wsf=(float*)(shm+LDS_WS)+wid*64;
  const bf16*ksrc=Kh+(long)lane*DM+wid*8;
  const bf16*vsrc=Vh+(long)(16*(wid&3)+(lane>>2))*DM+(wid>>2)*32+(lane&3)*8;
  const unsigned kdst=lds0+LDS_K+wid*1024, vdst=lds0+LDS_V+wid*1024;
  #define DMA_K(t,slot) glds16(ksrc+(long)(t)*KVBLK*DM,(unsigned)__builtin_amdgcn_readfirstlane(kdst+(slot)))
  #define DMA_V(t,slot) glds16(vsrc+(long)(t)*KVBLK*DM,(unsigned)__builtin_amdgcn_readfirstlane(vdst+(slot)))
  const int vb0=(int)(lds0+LDS_V)+((lane>>4)&1)*32+(lane&3)*8+(4*hi+((lane&15)>>2))*64;
  const char*Kbase=shm+LDS_K; bf16x8 kf[8];
  const lds_cptr kp0=shm3+LDS_K+hi*1024+r32*16; const lds_cptr vp0=shm3+LDS_V+((lane>>4)&1)*32+(lane&3)*8+(4*hi+((lane&15)>>2))*64;
  const int NT=(q0+QB)/KVBLK-jstart;
  { typedef __attribute__((address_space(3))) f32x4v lf32x4; lf32x4*cl_=(lf32x4*)(shm3+LDS_C); const f32x4v*cg_=(const f32x4v*)(Cg+jstart*KVBLK); const int n4_=(q0+QB-jstart*KVBLK)>>2;
    f32x4v c0_=f32x4v{},c1_=f32x4v{}; if(tid<n4_)c0_=cg_[tid]; if(tid+NW*64<n4_)c1_=cg_[tid+NW*64]; if(tid<n4_)cl_[tid]=c0_; if(tid+NW*64<n4_)cl_[tid+NW*64]=c1_; }
  DMA_K(0,0);DMA_V(0,0);DMA_K(1,SLOTB);
  bf16x8 qr[4];
  #pragma unroll
  for(int d0=0;d0<4;++d0)qr[d0]=*reinterpret_cast<const bf16x8*>(&Qw[(long)r32*DM+d0*16+hi*8]);
  float mhat=0.f,l_reg=0.f;f32x16 o[2];o[0]=f32x16{};o[1]=f32x16{};
  const int qrel=wid*QBLK+r32;
  #define CMASK(P0,P1,t) do{int jb_=(t)-(NT-4); if(jb_>=0)cmask(P0,P1,jb_,qrel,hi);}while(0)
  typedef __attribute__((address_space(3))) const float* lds_fptr; typedef __attribute__((address_space(3))) const f32x4v* lds_f4ptr;
  const lds_fptr cl0=(lds_fptr)(shm3+LDS_C)+4*hi;
  #define BIAS(P0,P1,t) do{ const lds_fptr cb_=cl0+64*(t); _Pragma("unroll") for(int g_=0;g_<4;++g_){ const f32x4v a_=*(lds_f4ptr)(cb_+8*g_), b_=*(lds_f4ptr)(cb_+32+8*g_); \
      _Pragma("unroll") for(int i_=0;i_<4;++i_){P0[4*g_+i_]-=a_[i_];P1[4*g_+i_]-=b_[i_];} } }while(0)
  #define BIASINIT(C0_,C1_,t) do{ const lds_fptr cb_=cl0+64*(t); const float nm_=-mhat; _Pragma("unroll") for(int g_=0;g_<4;++g_){ f32x4v a_=f32x4v{},b_=f32x4v{}; if(BIASON){a_=*(lds_f4ptr)(cb_+8*g_); b_=*(lds_f4ptr)(cb_+32+8*g_);} \
      _Pragma("unroll") for(int i_=0;i_<4;++i_){C0_[4*g_+i_]=nm_-a_[i_];C1_[4*g_+i_]=nm_-b_[i_];} } }while(0)
  bool resc=false;
  #define START(P0,P1) do{ const float rm=rowmax(P0,P1); resc=false; \
    { const float dl=rm; mhat=fadd_s(mhat,dl); \
      _Pragma("unroll") for(int r=0;r<16;++r){P0[r]=fsub_s(P0[r],dl);P1[r]=fsub_s(P1[r],dl);} \
      } \
    _Pragma("unroll") for(int r=0;r<16;++r)P0[r]=__builtin_amdgcn_exp2f(P0[r]); }while(0)
  #define RESC() do{ if(resc){ asm volatile("s_waitcnt lgkmcnt(0)":::"memory"); \
      _Pragma("unroll") for(int d_=0;d_<2;++d_) _Pragma("unroll") for(int r=0;r<16;++r)o[d_][r]*=wsf[crow(r,hi)]; } }while(0)
  f32x16 pA0,pA1,pB0,pB1;
  int sl_prev=0,sl_cur=0,sl_next=SLOTB;
  #define ROT() do{sl_prev=sl_cur;sl_cur=sl_next;sl_next=(sl_next==(NSLOT-1)*SLOTB)?0:sl_next+SLOTB;}while(0)
  DMA_K(2,2*SLOTB);
  WAIT_BAR(3);
  { const f32x16 zero_=f32x16{}; qkt(pA0,pA1,Kbase,qr,zero_,r32,hi); }asm volatile("s_nop 15\n\ts_nop 7":"+v"(pA0),"+v"(pA1));BIAS(pA0,pA1,0);CMASK(pA0,pA1,0);
  START(pA0,pA1);
  BIASINIT(pB0,pB1,1);
  _Pragma("unroll") for(int r=0;r<16;++r)pA1[r]=__builtin_amdgcn_exp2f(pA1[r]);
  WAIT_BAR(0);
  DMA_K(3,0);DMA_V(1,SLOTB);
  ROT();
  kload8(kf,kp0+sl_cur);
  WAIT_BAR(2);
  s16x4 vlo[8],vhi[8]; u32x4 pw0,pw1,pw2,pw3;
  #define PKW(P,B) cvtpk_s(P[B],P[B+1])
  #define PAF(k) __builtin_bit_cast(bf16x8,pw##k)
  #define VFR(i) (bf16x8){vlo[i][0],vlo[i][1],vlo[i][2],vlo[i][3],vhi[i][0],vhi[i][1],vhi[i][2],vhi[i][3]}
  #define PIN(x) asm volatile("":"+v"(x))
  #define MX3(a,b,c) __builtin_fmaxf(__builtin_fmaxf((a),(b)),(c))
  #define GAPA(MF,A0,A1,A2,A3,W0,W1,PW) do{ MF; sacc+=A0; sacc+=A1; sacc+=A2; sacc+=A3; PIN(sacc); W0; W1; PIN(PW); SBAR(); }while(0)
  #define EX(v) __builtin_amdgcn_exp2f(v)
  #define GAPB(MF,X,B) do{ MF; X[B]=EX(X[B]); X[B+1]=EX(X[B+1]); X[B+2]=EX(X[B+2]); X[B+3]=EX(X[B+3]); PIN(X); SBAR(); }while(0)
  #define VRD(i) do{ vlo[i]=vtr(vp_+(((i)>>2)*4096+((i)&3)*1024)); vhi[i]=vtr(vp_+(((i)>>2)*4096+((i)&3)*1024+512)); }while(0)
  #define KRD(G,j) do{ if(G){ kload2(kf,kp0+sl_next,j); SBAR(); } }while(0)
  #define STEP(C0,C1,P0,P1,t,GK,GV,GL) do{ SBAR(); \
    const lds_cptr vp_=vp0+sl_prev; \
    VRD(0); SBAR(); float sacc=(P0[0]+P0[1]); \
    GAPA(C0=__builtin_amdgcn_mfma_f32_32x32x16_bf16(kf[0],qr[0],C0,0,0,0), P0[2],P0[3],P0[4],P0[5],     pw0[0]=PKW(P0,0), pw0[1]=PKW(P0,2), pw0); \
    VRD(4); SBAR(); GAPA(C1=__builtin_amdgcn_mfma_f32_32x32x16_bf16(kf[1],qr[0],C1,0,0,0), P0[6],P0[7],P0[8],P0[9],     pw0[2]=PKW(P0,4), pw0[3]=PKW(P0,6), pw0); \
    VRD(1); SBAR(); GAPA(C0=__builtin_amdgcn_mfma_f32_32x32x16_bf16(kf[2],qr[1],C0,0,0,0),   P0[10],P0[11],P0[12],P0[13], pw1[0]=PKW(P0,8), pw1[1]=PKW(P0,10), pw1); \
    VRD(5); SBAR(); GAPA(C1=__builtin_amdgcn_mfma_f32_32x32x16_bf16(kf[3],qr[1],C1,0,0,0),   P0[14],P0[15],P1[0],P1[1],   pw1[2]=PKW(P0,12),pw1[3]=PKW(P0,14), pw1); \
    VRD(2); SBAR(); GAPA(C0=__builtin_amdgcn_mfma_f32_32x32x16_bf16(kf[4],qr[2],C0,0,0,0),   P1[2],P1[3],P1[4],P1[5],     pw2[0]=PKW(P1,0), pw2[1]=PKW(P1,2), pw2); \
    VRD(6); SBAR(); GAPA(C1=__builtin_amdgcn_mfma_f32_32x32x16_bf16(kf[5],qr[2],C1,0,0,0),   P1[6],P1[7],P1[8],P1[9],     pw2[2]=PKW(P1,4), pw2[3]=PKW(P1,6), pw2); \
    VRD(3); SBAR(); GAPA(C0=__builtin_amdgcn_mfma_f32_32x32x16_bf16(kf[6],qr[3],C0,0,0,0),   P1[10],P1[11],P1[12],P1[13], pw3[0]=PKW(P1,8), pw3[1]=PKW(P1,10), pw3); \
    VRD(7); SBAR(); GAPA(C1=__builtin_amdgcn_mfma_f32_32x32x16_bf16(kf[7],qr[3],C1,0,0,0),   P1[14],P1[15],0.f,0.f,       pw3[2]=PKW(P1,12),pw3[3]=PKW(P1,14), pw3); \
    l_reg+=sacc; \
    if(GK){DMA_K((t)+3,sl_cur);} if(GV){DMA_V((t)+1,sl_next);} \
    CMASK(C0,C1,t); \
    { float a=MX3(C0[0],C0[1],C1[0]),b=MX3(C0[2],C0[3],C1[1]); a=MX3(a,C1[2],C1[3]); \
      _Pragma("unroll") for(int r=4;r<16;r+=4){a=MX3(a,C0[r],C0[r+1]);b=MX3(b,C0[r+2],C0[r+3]);a=MX3(a,C1[r],C1[r+1]);b=MX3(b,C1[r+2],C1[r+3]);} \
      float rm=__builtin_fmaxf(a,b); { auto rr=__builtin_amdgcn_permlane32_swap(__float_as_uint(rm),__float_as_uint(rm),false,false); rm=__builtin_fmaxf(__uint_as_float(rr[0]),__uint_as_float(rr[1])); } \
      resc=false; \
      if(__builtin_expect(__any(rm>(float)THRL),0)){ const float dl=__builtin_fmaxf(rm+30.f,0.f); mhat+=dl; \
        _Pragma("unroll") for(int r=0;r<16;++r){C0[r]-=dl;C1[r]-=dl;} \
        const float f=__builtin_amdgcn_exp2f(-dl); l_reg*=f; if(hi==0)wsf[r32]=f; resc=true; } } \
    SBAR(); \
    GAPB(o[0]=__builtin_amdgcn_mfma_f32_32x32x16_bf16(PAF(0),VFR(0),o[0],0,0,0), C0,0); \
    GAPB(o[1]=__builtin_amdgcn_mfma_f32_32x32x16_bf16(PAF(0),VFR(4),o[1],0,0,0), C0,4); \
    KRD(GL,0); GAPB(o[0]=__builtin_amdgcn_mfma_f32_32x32x16_bf16(PAF(1),VFR(1),o[0],0,0,0), C0,8); \
    KRD(GL,1); GAPB(o[1]=__builtin_amdgcn_mfma_f32_32x32x16_bf16(PAF(1),VFR(5),o[1],0,0,0), C0,12); \
    KRD(GL,2); GAPB(o[0]=__builtin_amdgcn_mfma_f32_32x32x16_bf16(PAF(2),VFR(2),o[0],0,0,0), C1,0); \
    KRD(GL,3); GAPB(o[1]=__builtin_amdgcn_mfma_f32_32x32x16_bf16(PAF(2),VFR(6),o[1],0,0,0), C1,4); \
    GAPB(o[0]=__builtin_amdgcn_mfma_f32_32x32x16_bf16(PAF(3),VFR(3),o[0],0,0,0), C1,8); \
    GAPB(o[1]=__builtin_amdgcn_mfma_f32_32x32x16_bf16(PAF(3),VFR(7),o[1],0,0,0), C1,12); \
    BIASINIT(P0,P1,(t)+1); SBAR(); \
    }while(0)
  int t=1;
  #undef CMASK
  #define CMASK(P0,P1,t) do{}while(0)
  for(;t+5<NT;t+=2){
    STEP(pB0,pB1,pA0,pA1,t,true,true,true);     WAIT_BAR(2); RESC(); ROT();
    STEP(pA0,pA1,pB0,pB1,t+1,true,true,true);   WAIT_BAR(2); RESC(); ROT();
  }
  #undef CMASK
  #define CMASK(P0,P1,t) do{int jb_=(t)-(NT-4); if(jb_>=0)cmask(P0,P1,jb_,qrel,hi);}while(0)
  #define ENDW(tt) do{ if((tt)+3<NT){WAIT_BAR(2);} else if((tt)+2<NT){WAIT_BAR(1);} else {WAIT_BAR(0);} }while(0)
  for(;t+1<NT;t+=2){
    STEP(pB0,pB1,pA0,pA1,t,(t+3<NT),(t+1<NT),(t+1<NT));       ENDW(t);   RESC(); ROT();
    STEP(pA0,pA1,pB0,pB1,t+1,(t+4<NT),(t+2<NT),(t+2<NT));     ENDW(t+1); RESC(); ROT();
  }
  STEP(pB0,pB1,pA0,pA1,NT-1,false,false,false); RESC();
  { float sacc=pB0[0]+pB0[1]; _Pragma("unroll") for(int r=2;r<16;++r)sacc+=pB0[r]; _Pragma("unroll") for(int r=0;r<16;++r)sacc+=pB1[r]; l_reg+=sacc;
    pw0=(u32x4){PKW(pB0,0),PKW(pB0,2),PKW(pB0,4),PKW(pB0,6)};pw1=(u32x4){PKW(pB0,8),PKW(pB0,10),PKW(pB0,12),PKW(pB0,14)};pw2=(u32x4){PKW(pB1,0),PKW(pB1,2),PKW(pB1,4),PKW(pB1,6)};pw3=(u32x4){PKW(pB1,8),PKW(pB1,10),PKW(pB1,12),PKW(pB1,14)};
    SBAR(); pv(o,vb0+sl_cur,PAF(0),PAF(1),PAF(2),PAF(3)); }
  #undef PKW
  #undef PAF
  #undef VFR
  #undef PIN
  #undef MX3
  #undef GAPA
  #undef GAPB
  #undef EX
  #undef VRD
  #undef KRD
  #undef STEP
  #undef ENDW
  {auto rr=__builtin_amdgcn_permlane32_swap(__float_as_uint(l_reg),__float_as_uint(l_reg),false,false);l_reg=__uint_as_float(rr[0])+__uint_as_float(rr[1]);}
  if(hi==0)wsf[32+r32]=l_reg;asm volatile("s_waitcnt lgkmcnt(0)":::"memory");
  float rli[16];
  #pragma unroll
  for(int r=0;r<16;++r)rli[r]=__builtin_amdgcn_rcpf(wsf[32+crow(r,hi)]);
  bf16*Ow=O+(long)(q0+wid*QBLK)*OPITCH;
  { bf16*stg=(bf16*)(shm+LDS_OST)+wid*2048;
    #pragma unroll
    for(int r=0;r<16;++r){const int orow=crow(r,hi);
      #pragma unroll
      for(int d0=0;d0<2;++d0)stg[orow*64+d0*32+r32]=__float2bfloat16(o[d0][r]*rli[r]);}
    asm volatile("s_waitcnt lgkmcnt(0)":::"memory");
    #pragma unroll
    for(int i=0;i<4;++i){const int row=i*8+(lane>>3),ch=lane&7; const u32x4 v=*(const u32x4*)(stg+row*64+ch*8); ATTN_STORE16(Ow+(long)row*OPITCH+ch*8,v);} }
  asm volatile("s_waitcnt lgkmcnt(0)\n\ts_barrier":::"memory");
  #undef DMA_K
  #undef DMA_V
  #undef CMASK
  #undef BIAS
  #undef BIASINIT
  #undef START
  #undef RESC
  #undef ROT
}
constexpr int SB_NS=8, SB_V=65536, SB_FLAGS=131072;
__device__ __forceinline__ void sb_unit(int qb,const bf16*Q,const bf16*__restrict__ K,const bf16*__restrict__ V,bf16*O,char*shm){
  int tid_=threadIdx.x; asm volatile("":"+v"(tid_)); const int tid=tid_,lane=tid&63,r32=lane&31,hi=lane>>5; const int wid=__builtin_amdgcn_readfirstlane(tid>>6);
  const int q0=qb*QB;
  const bf16*Qw=Q+(long)(q0+wid*QBLK)*DM;
  const unsigned lds0=(unsigned)(uintptr_t)shm;
  typedef __attribute__((address_space(3))) int lds_i32; typedef __attribute__((address_space(3))) const u32x4* lds_u4ptr;
  lds_i32*flags=(lds_i32*)((lds_cptr)shm+SB_FLAGS);
  const bf16*ksrc=K+(long)lane*DM+wid*8;
  const bf16*vsrc=V+(long)(16*(wid&3)+(lane>>2))*DM+(wid>>2)*32+(lane&3)*8;
  const unsigned kdst=lds0+wid*1024, vdst=lds0+SB_V+wid*1024;
  #define DMA_K(t,slot) glds16(ksrc+(long)(t)*KVBLK*DM,(unsigned)__builtin_amdgcn_readfirstlane(kdst+(slot)))
  #define DMA_V(t,slot) glds16(vsrc+(long)(t)*KVBLK*DM,(unsigned)__builtin_amdgcn_readfirstlane(vdst+(slot)))
  const int vb0=(int)(lds0+SB_V)+((lane>>4)&1)*32+(lane&3)*8+(4*hi+((lane&15)>>2))*64;
  const int NT=(q0+QB)/KVBLK;
  bf16x8 qr[4];
  #pragma unroll
  for(int d0=0;d0<4;++d0)qr[d0]=*reinterpret_cast<const bf16x8*>(&Qw[(long)r32*DM+d0*16+hi*8]);
  f32x16 o[2];o[0]=f32x16{};o[1]=f32x16{};
  float T=1.0f; const int t_abs=q0+wid*QBLK+r32; bool wdone=false;
  for(int jtop=NT-1;;jtop-=SB_NS){
    const int nb=(jtop+1<SB_NS)?jtop+1:SB_NS;
    for(int s=0;s<nb;++s){DMA_K(jtop-s,s*SLOTB);DMA_V(jtop-s,s*SLOTB);}
    WAIT_BAR(0);
    int s=(jtop==NT-1)?3-(wid>>1):0;
    for(;s<nb&&!wdone;++s){
      const int jt=jtop-s; const int slot=s*SLOTB; const bool band=(jt>=NT-4);
      f32x16 x0,x1; { f32x16 zero=f32x16{}; qkt(x0,x1,shm+slot,qr,zero,r32,hi); }
      f32x16 n0,n1;
      const int kb=64*jt+4*hi;
      #pragma unroll
      for(int r=0;r<16;++r){
        const float z0=x0[r],z1=x1[r];
        const float e0=__builtin_amdgcn_exp2f(-__builtin_fabsf(z0)), e1=__builtin_amdgcn_exp2f(-__builtin_fabsf(z1));
        const float r0=__builtin_amdgcn_rcpf(1.0f+e0), r1=__builtin_amdgcn_rcpf(1.0f+e1), er0=e0*r0, er1=e1*r1;
        float b0=z0>0.f?r0:er0, m0=z0>0.f?er0:r0, b1=z1>0.f?r1:er1, m1=z1>0.f?er1:r1;
        if(band){ const int kv=kb+(r&3)+8*(r>>2); if(!(kv<t_abs)){b0=0.f;m0=1.f;} if(!(kv+32<t_abs)){b1=0.f;m1=1.f;} }
        x0[r]=b0;x1[r]=b1;n0[r]=m0;n1[r]=m1;
      }
      float g0[4],g1[4],p0s[4],p1s[4];
      #pragma unroll
      for(int a=0;a<4;++a){ g0[a]=(n0[4*a]*n0[4*a+1])*(n0[4*a+2]*n0[4*a+3]); g1[a]=(n1[4*a]*n1[4*a+1])*(n1[4*a+2]*n1[4*a+3]);
        { auto rr=__builtin_amdgcn_permlane32_swap(__float_as_uint(g0[a]),__float_as_uint(g0[a]),false,false); p0s[a]=__uint_as_float(hi?rr[0]:rr[1]); }
        { auto rr=__builtin_amdgcn_permlane32_swap(__float_as_uint(g1[a]),__float_as_uint(g1[a]),false,false); p1s[a]=__uint_as_float(hi?rr[0]:rr[1]); } }
      float run=T;
      #pragma unroll
      for(int a=3;a>=0;--a){ const float off=hi?run:run*p1s[a]; run*=g1[a]*p1s[a];
        const float t3=off,t2=t3*n1[4*a+3],t1=t2*n1[4*a+2],t0=t1*n1[4*a+1];
        x1[4*a+3]*=t3; x1[4*a+2]*=t2; x1[4*a+1]*=t1; x1[4*a]*=t0; }
      #pragma unroll
      for(int a=3;a>=0;--a){ const float off=hi?run:run*p0s[a]; run*=g0[a]*p0s[a];
        const float t3=off,t2=t3*n0[4*a+3],t1=t2*n0[4*a+2],t0=t1*n0[4*a+1];
        x0[4*a+3]*=t3; x0[4*a+2]*=t2; x0[4*a+1]*=t1; x0[4*a]*=t0; }
      T=run;
      u32x4 pw0,pw1,pw2,pw3;
      pw0=(u32x4){cvtpk_s(x0[0],x0[1]),cvtpk_s(x0[2],x0[3]),cvtpk_s(x0[4],x0[5]),cvtpk_s(x0[6],x0[7])};
      pw1=(u32x4){cvtpk_s(x0[8],x0[9]),cvtpk_s(x0[10],x0[11]),cvtpk_s(x0[12],x0[13]),cvtpk_s(x0[14],x0[15])};
      pw2=(u32x4){cvtpk_s(x1[0],x1[1]),cvtpk_s(x1[2],x1[3]),cvtpk_s(x1[4],x1[5]),cvtpk_s(x1[6],x1[7])};
      pw3=(u32x4){cvtpk_s(x1[8],x1[9]),cvtpk_s(x1[10],x1[11]),cvtpk_s(x1[12],x1[13]),cvtpk_s(x1[14],x1[15])};
      SBAR(); pv(o,vb0+slot,__builtin_bit_cast(bf16x8,pw0),__builtin_bit_cast(bf16x8,pw1),__builtin_bit_cast(bf16x8,pw2),__builtin_bit_cast(bf16x8,pw3));
      wdone=__all(T<1.2e-38f);
    }
    if(lane==0)flags[wid]=wdone?1:0;
    WAIT_BAR(0);
    const u32x4 f0=*(lds_u4ptr)(flags), f1=*(lds_u4ptr)(flags+4);
    const bool alld=((f0.x&f0.y&f0.z&f0.w)&(f1.x&f1.y&f1.z&f1.w))!=0;
    if(alld||jtop<SB_NS)break;
    WAIT_BAR(0);
  }
  bf16*Ow=O+(long)(q0+wid*QBLK)*OPITCH;
  { bf16*stg=(bf16*)(shm)+wid*2048;
    #pragma unroll
    for(int r=0;r<16;++r){const int orow=crow(r,hi);
      #pragma unroll
      for(int d0=0;d0<2;++d0)stg[orow*64+d0*32+r32]=__float2bfloat16(o[d0][r]);}
    asm volatile("s_waitcnt lgkmcnt(0)":::"memory");
    #pragma unroll
    for(int i=0;i<4;++i){const int row=i*8+(lane>>3),ch=lane&7; const u32x4 v=*(const u32x4*)(stg+row*64+ch*8); ATTN_STORE16(Ow+(long)row*OPITCH+ch*8,v);} }
  asm volatile("s_waitcnt lgkmcnt(0)\n\ts_barrier":::"memory");
  #undef DMA_K
  #undef DMA_V
}
#undef SBAR
#undef WAIT_BAR
}

constexpr int BATCH = 8, SEQ = 4096, DM = 1024, DEPTH = 4, M = BATCH * SEQ, INC = 3334, NIN = 3584, DFF = 4096;
constexpr float EPS = 1e-6f;
constexpr size_t MiB = 1u << 20;
constexpr size_t WS_BAR = 128 * 1024;
constexpr size_t WS_SS = 1 * MiB;
constexpr size_t WS_LB = 3 * MiB;
constexpr size_t WS_JS = 3 * MiB + 256 * 1024;
constexpr size_t WS_DD = 3 * MiB + 512 * 1024;
constexpr size_t WS_W = 4 * MiB;
constexpr size_t W_LAYER = 25 * MiB, W_OUT = 7 * MiB, W_1 = 9 * MiB, W_2 = 17 * MiB;
constexpr size_t WS_XB = 104 * MiB;
constexpr size_t WS_P = 168 * MiB;
constexpr size_t P_HQ = 0, P_HK = 16 * MiB, P_HI = 32 * MiB, P_HG = 48 * MiB, P_HLF = 64 * MiB, P_SQ = 96 * MiB, P_FQ = 168 * MiB, P_LF = 240 * MiB, P_CC = 241 * MiB, P_US = 242 * MiB;
constexpr size_t HEADBUF = 24 * MiB;
constexpr size_t WS_MIX = 442 * MiB;
constexpr size_t WS_U = 168 * MiB;
constexpr size_t WS_END = 506 * MiB;
constexpr int LDS_BYTES = 147456;

typedef pg8::bf16_t bf16_t;
typedef pg8::f32x4 f32x4;
typedef unsigned u32x4 __attribute__((ext_vector_type(4)));
typedef unsigned u32x2 __attribute__((ext_vector_type(2)));
#define LAS __attribute__((address_space(3)))

__device__ __forceinline__ unsigned f2bf(float f) { unsigned u = __builtin_bit_cast(unsigned, f); return (u + 0x7fffu + ((u >> 16) & 1u)) >> 16; }
__device__ __forceinline__ unsigned pk2(float lo, float hi) { return pg8::cvt_pk_bf16(lo, hi); }
typedef float pk_f32x2 __attribute__((ext_vector_type(2))); typedef __bf16 pk_bf16x2 __attribute__((ext_vector_type(2)));
__device__ __forceinline__ unsigned pk2v(float lo, float hi) { const pk_f32x2 v = {lo, hi}; return __builtin_bit_cast(unsigned, __builtin_convertvector(v, pk_bf16x2)); }
__device__ __forceinline__ float bf2f(unsigned short b) { return __builtin_bit_cast(float, (unsigned)b << 16); }
__device__ __forceinline__ float bflo(unsigned w) { return __builtin_bit_cast(float, w << 16); }
__device__ __forceinline__ float bfhi(unsigned w) { return __builtin_bit_cast(float, w & 0xffff0000u); }
__device__ __forceinline__ float logsig(float x) { return fminf(x, 0.f) - log1pf(expf(-fabsf(x))); }
__device__ __forceinline__ float wave_sum(float v) {
#pragma unroll
    for (int o = 1; o < 64; o <<= 1) v += __shfl_xor(v, o);
    return v;
}
#define ROWSCALES8(rs, ss, row0, fq) float rs[2][4]; _Pragma("unroll") for (int ai_ = 0; ai_ < 2; ++ai_) _Pragma("unroll") for (int m_ = 0; m_ < 4; ++m_) rs[ai_][m_] = rowscale(ss, (row0) + ai_ * 128 + m_ * 16, fq);
__device__ __forceinline__ float rowscale(const float* ss, int row, int fq) {
    const f32x4 p = *(const f32x4*)(ss + (size_t)row * 16 + 4 * fq);
    float s = (p[0] + p[1]) + (p[2] + p[3]);
    s += __shfl_xor(s, 16); s += __shfl_xor(s, 32);
    return rsqrtf(s * (1.0f / DM) + EPS);
}

#define ROWFENCE() asm volatile("" ::: "memory")
struct EpiResid {
    static constexpr bool PERM = true, AFTER_DRAIN = false;
    bf16_t* xb; float* outf; float* ss;
    __device__ __forceinline__ void operator()(const f32x4 (&acc)[2][2][4][2], const pg8::Unit& u, int wr, int wc, int fr, int fq) const {
        const int row0 = u.pm * 256 + wr * 64 + fr, col0 = u.pn * 256 + wc * 32 + 8 * fq;
#pragma unroll
        for (int ai = 0; ai < 2; ++ai) {
            u32x4 pre[4][2];
#pragma unroll
            for (int m = 0; m < 4; ++m)
#pragma unroll
                for (int bj = 0; bj < 2; ++bj) pre[m][bj] = *(const u32x4*)(xb + (size_t)(row0 + ai * 128 + m * 16) * DM + col0 + bj * 128);
#pragma unroll
            for (int m = 0; m < 4; ++m) {
                const int row = row0 + ai * 128 + m * 16; float sq = 0.f;
#pragma unroll
                for (int bj = 0; bj < 2; ++bj) {
                    const size_t off = (size_t)row * DM + col0 + bj * 128; const u32x4 p = pre[m][bj];
                    const f32x4 v0 = acc[ai][bj][m][0] + (f32x4){bflo(p.x), bfhi(p.x), bflo(p.y), bfhi(p.y)}, v1 = acc[ai][bj][m][1] + (f32x4){bflo(p.z), bfhi(p.z), bflo(p.w), bfhi(p.w)};
                    if (outf) { *(f32x4*)(outf + off) = v0; *(f32x4*)(outf + off + 4) = v1; }
                    else {
                        u32x4 w; w.x = pk2(v0[0], v0[1]); w.y = pk2(v0[2], v0[3]); w.z = pk2(v1[0], v1[1]); w.w = pk2(v1[2], v1[3]);
                        *(u32x4*)(xb + off) = w;
                        sq += (v0[0] * v0[0] + v0[1] * v0[1]) + (v0[2] * v0[2] + v0[3] * v0[3]) + (v1[0] * v1[0] + v1[1] * v1[1]) + (v1[2] * v1[2] + v1[3] * v1[3]);
                    }
                }
                if (!outf) {
                    sq += __shfl_xor(sq, 16); sq += __shfl_xor(sq, 32);
                    if (fq == 0) ss[(size_t)row * 16 + u.pn * 4 + wc] = sq;
                }
            }
            ROWFENCE();
        }
    }
};
struct EpiRelu2 {
    static constexpr bool PERM = true, AFTER_DRAIN = false;
    bf16_t* U; const float* ss;
    __device__ __forceinline__ void operator()(const f32x4 (&acc)[2][2][4][2], const pg8::Unit& u, int wr, int wc, int fr, int fq) const {
        const int row0 = u.pm * 256 + wr * 64 + fr, col0 = u.pn * 256 + wc * 32 + 8 * fq;
        ROWSCALES8(rs8, ss, row0, fq)
#pragma unroll
        for (int ai = 0; ai < 2; ++ai)
#pragma unroll
            for (int m = 0; m < 4; ++m) {
                const int row = row0 + ai * 128 + m * 16; const float rs = rs8[ai][m];
#pragma unroll
                for (int bj = 0; bj < 2; ++bj) {
                    f32x4 v0 = acc[ai][bj][m][0] * rs, v1 = acc[ai][bj][m][1] * rs;
                    v0 = __builtin_elementwise_max(v0, (f32x4){0.f, 0.f, 0.f, 0.f}); v1 = __builtin_elementwise_max(v1, (f32x4){0.f, 0.f, 0.f, 0.f});
                    v0 = v0 * v0; v1 = v1 * v1;
                    u32x4 w; w.x = pk2(v0[0], v0[1]); w.y = pk2(v0[2], v0[3]); w.z = pk2(v1[0], v1[1]); w.w = pk2(v1[2], v1[3]);
                    *(u32x4*)(U + (size_t)row * DFF + col0 + bj * 128) = w;
                }
                ROWFENCE();
            }
    }
};
struct EpiInProj {
    static constexpr bool PERM = true, AFTER_DRAIN = false;
    const float* ss; unsigned char* P; const float* lbt;
    const float* gt; const float* fbias;
    __device__ __forceinline__ void operator()(const f32x4 (&acc)[2][2][4][2], const pg8::Unit& u, int wr, int wc, int fr, int fq) const {
        const int slot = u.pn * 4 + wc;
        if (slot > 52) return;
        const int row0 = u.pm * 256 + wr * 64 + fr;
        ROWSCALES8(rs8, ss, row0, fq)
        if (slot < 16) {
            const int kind = slot >> 2, cb = (slot & 3) * 64 + 8 * fq;
            if (kind == 1) {
                float* HLF = (float*)(P + P_HLF); bf16_t* HK = (bf16_t*)(P + P_HK);
#pragma unroll
                for (int ai = 0; ai < 2; ++ai)
#pragma unroll
                    for (int m = 0; m < 4; ++m) {
                        const int row = row0 + ai * 128 + m * 16; const float rs = rs8[ai][m];
#pragma unroll
                        for (int bj = 0; bj < 2; ++bj) {
                            float lf[8], kk[8];
#pragma unroll
                            for (int n = 0; n < 2; ++n) {
                                const f32x4 ll = *(const f32x4*)(lbt + cb + 32 * bj + 4 * n), om = *(const f32x4*)(lbt + 256 + cb + 32 * bj + 4 * n);
#pragma unroll
                                for (int i = 0; i < 4; ++i) {
                                    const float fl = acc[ai][bj][m][n][i] * rs;
                                    const float a = fminf(fl, 0.f) - __logf(1.0f + __expf(-fabsf(fl)));
                                    const float an = a - fl;
                                    const float b = ll[i] + an;
                                    lf[4 * n + i] = fmaxf(a, b) + __logf(1.0f + __expf(-fabsf(a - b)));
                                    kk[4 * n + i] = om[i] * __expf(an);
                                }
                            }
                            const size_t off = (size_t)row * 256 + cb + 32 * bj;
                            *(f32x4*)(HLF + off) = (f32x4){lf[0], lf[1], lf[2], lf[3]}; *(f32x4*)(HLF + off + 4) = (f32x4){lf[4], lf[5], lf[6], lf[7]};
                            u32x4 w; w.x = pk2(kk[0], kk[1]); w.y = pk2(kk[2], kk[3]); w.z = pk2(kk[4], kk[5]); w.w = pk2(kk[6], kk[7]);
                            *(u32x4*)(HK + off) = w;
                        }
                        ROWFENCE();
                    }
            } else {
                bf16_t* dst = (bf16_t*)(P + (kind == 0 ? P_HQ : (kind == 2 ? P_HI : P_HG)));
#pragma unroll
                for (int ai = 0; ai < 2; ++ai)
#pragma unroll
                    for (int m = 0; m < 4; ++m) {
                        const int row = row0 + ai * 128 + m * 16; const float rs = rs8[ai][m];
#pragma unroll
                        for (int bj = 0; bj < 2; ++bj) {
                            const f32x4 v0 = acc[ai][bj][m][0] * rs, v1 = acc[ai][bj][m][1] * rs;
                            u32x4 w; w.x = pk2(v0[0], v0[1]); w.y = pk2(v0[2], v0[3]); w.z = pk2(v1[0], v1[1]); w.w = pk2(v1[2], v1[3]);
                            *(u32x4*)(dst + (size_t)row * 256 + cb + 32 * bj) = w;
                        }
                        ROWFENCE();
                    }
            }
        } else if (slot < 52) {
            const int s2 = slot - 16, grp = s2 / 6, h = s2 % 6, role = grp % 3;
            bf16_t* dst = (bf16_t*)(P + P_SQ + (size_t)grp * HEADBUF) + (size_t)((u.pm >> 4) * 6 + h) * SEQ * 64 + 8 * fq;
            const float* gp = gt + (grp - (grp >= 3 ? 1 : 0)) * 64 + 8 * fq;
            const float qs = (role == 0) ? 0.125f * 1.4426950408889634f : 1.0f;
            f32x4 gv[2][2];
#pragma unroll
            for (int bj = 0; bj < 2; ++bj)
#pragma unroll
                for (int n = 0; n < 2; ++n) gv[bj][n] = (role != 2) ? *(const f32x4*)(gp + 32 * bj + 4 * n) * qs : (f32x4){1.f, 1.f, 1.f, 1.f};
#pragma unroll
            for (int ai = 0; ai < 2; ++ai)
#pragma unroll
                for (int m = 0; m < 4; ++m) {
                    const int row = row0 + ai * 128 + m * 16; const float rs = rs8[ai][m];
                    float fac = rs;
                    if (role != 2) {
                        float sq = 0.f;
#pragma unroll
                        for (int bj = 0; bj < 2; ++bj)
#pragma unroll
                            for (int n = 0; n < 2; ++n) { const f32x4 x = acc[ai][bj][m][n]; sq += (x[0] * x[0] + x[1] * x[1]) + (x[2] * x[2] + x[3] * x[3]); }
                        sq += __shfl_xor(sq, 16); sq += __shfl_xor(sq, 32);
                        fac = rs * rsqrtf(rs * rs * sq * (1.0f / 64.0f) + EPS);
                    }
                    const int t = row & (SEQ - 1);
#pragma unroll
                    for (int bj = 0; bj < 2; ++bj) {
                        const f32x4 v0 = acc[ai][bj][m][0] * fac * gv[bj][0], v1 = acc[ai][bj][m][1] * fac * gv[bj][1];
                        u32x4 w; w.x = pk2(v0[0], v0[1]); w.y = pk2(v0[2], v0[3]); w.z = pk2(v1[0], v1[1]); w.w = pk2(v1[2], v1[3]);
                        *(u32x4*)(dst + (size_t)t * 64 + 32 * bj) = w;
                    }
                    ROWFENCE();
                }
        } else {
            float* LF = (float*)(P + P_LF);
#pragma unroll
            for (int ai = 0; ai < 2; ++ai)
#pragma unroll
                for (int m = 0; m < 4; ++m) {
                    const int row = row0 + ai * 128 + m * 16; const float rs = rs8[ai][m];
                    if (fq == 0) {
                        const f32x4 a0 = acc[ai][0][m][0], a1 = acc[ai][0][m][1];
                        *(f32x4*)(LF + (size_t)row * 8) = (f32x4){logsig(a0[0] * rs + fbias[0]), logsig(a0[1] * rs + fbias[1]), logsig(a0[2] * rs + fbias[2]), logsig(a0[3] * rs + fbias[3])};
                        *(f32x4*)(LF + (size_t)row * 8 + 4) = (f32x4){logsig(a1[0] * rs + fbias[4]), logsig(a1[1] * rs + fbias[5]), 0.f, 0.f};
                    }
                    ROWFENCE();
                }
        }
    }
};
#define XB_TMO      128
#define XB_XCNT(j)  (256  + 64 * (j))
#define XB_XSUB(j)  (1280 + 64 * (j))
#define XB_XGEN(j)  (2304 + 64 * (j))
#define XB_TOP      3328
#define XB_TOPGEN   3392
#define XCD_BAR_WORDS 3456
#define XB_SPIN_CAP (1u << 18)

__device__ __forceinline__ unsigned xb_ld(unsigned* p)              { return __hip_atomic_load(p, __ATOMIC_RELAXED, __HIP_MEMORY_SCOPE_AGENT); }
__device__ __forceinline__ unsigned xb_add(unsigned* p, unsigned v) { return __hip_atomic_fetch_add(p, v, __ATOMIC_RELAXED, __HIP_MEMORY_SCOPE_AGENT); }
__device__ __forceinline__ unsigned xb_xcc_id() { return (unsigned)__builtin_amdgcn_s_getreg((3 << 11) | 20) & 0xFu; }
#define XB_SPIN(cond, bar) do { unsigned _sp = 0; while (cond) { __builtin_amdgcn_s_sleep(1); \
    if ((++_sp & 255u) == 0u) { if (xb_ld(&(bar)[XB_TMO])) break; if (_sp > XB_SPIN_CAP) { atomicAdd(&(bar)[XB_TMO], 1u); break; } } } } while (0)

struct XcdBarrier {
    unsigned* bar; unsigned x;
    volatile LAS unsigned* st;
};

__device__ __forceinline__ XcdBarrier xcd_barrier_post(unsigned* bar, volatile LAS unsigned* st) {
    XcdBarrier b; b.bar = bar; b.x = xb_xcc_id(); b.st = st;
    if (threadIdx.x == 0) (void)xb_add(&bar[XB_XCNT(b.x)], 1u);
    return b;
}
__device__ __forceinline__ void xcd_barrier_complete(unsigned* bar, unsigned x, unsigned& nloc, unsigned& nx) {
    const unsigned G = gridDim.x * gridDim.y * gridDim.z;
    unsigned sum, cnt, mine, sp = 0u;
    for (;;) {
        sum = 0u; cnt = 0u; mine = 0u;
#pragma unroll
        for (unsigned j = 0; j < 16; ++j) { const unsigned c = xb_ld(&bar[XB_XCNT(j)]); sum += c; cnt += (c > 0u) ? 1u : 0u; mine = (j == x) ? c : mine; }
        if (sum == G) break;
        __builtin_amdgcn_s_sleep(1);
        if ((++sp & 255u) == 0u) { if (xb_ld(&bar[XB_TMO])) break; if (sp > XB_SPIN_CAP) { atomicAdd(&bar[XB_TMO], 1u); break; } }
    }
    nloc = mine > 0u ? mine : 1u; nx = cnt > 0u ? cnt : 1u;
}

__device__ __forceinline__ void xcd_barrier(const XcdBarrier& b) {
    asm volatile("s_waitcnt vmcnt(0)" ::: "memory");
    __syncthreads();
    if (threadIdx.x == 0) {
        unsigned* bar = b.bar;
        __builtin_amdgcn_s_waitcnt(0);
        unsigned nloc = b.st[0], nx = b.st[1];
        if (nloc == 0u) { xcd_barrier_complete(bar, b.x, nloc, nx); b.st[0] = nloc; b.st[1] = nx; }
        const unsigned old = xb_add(&bar[XB_XSUB(b.x)], 1u);
        const unsigned gen = old / nloc;
        if (old + 1u == (gen + 1u) * nloc) {
            __builtin_amdgcn_fence(__ATOMIC_RELEASE, "agent");
            asm volatile("s_waitcnt vmcnt(0)" ::: "memory");
            const unsigned og = xb_add(&bar[XB_TOP], 1u);
            const unsigned tg = og / nx;
            if (og + 1u == (tg + 1u) * nx) xb_add(&bar[XB_TOPGEN], 1u);
            else XB_SPIN(xb_ld(&bar[XB_TOPGEN]) == tg, bar);
            __builtin_amdgcn_fence(__ATOMIC_ACQUIRE, "agent");
            xb_add(&bar[XB_XGEN(b.x)], 1u);
            asm volatile("s_waitcnt vmcnt(0)" ::: "memory");
        } else {
            XB_SPIN(xb_ld(&bar[XB_XGEN(b.x)]) == gen, bar);
            __builtin_amdgcn_fence(__ATOMIC_ACQUIRE, "agent");
            asm volatile("s_waitcnt vmcnt(0)" ::: "memory");
        }
    }
    __syncthreads();
}

__device__ __forceinline__ void tr_item(const float* W, int ldw, int ncols_valid, int src_col0, int k0, const float* gain, bf16_t* WT, int K, int n0, LAS float* scr, int lane) {
#pragma unroll 8
    for (int i = 0; i < 32; ++i) { const int kk = 2 * i + (lane >> 5), c = src_col0 + (lane & 31);
        float v = (c < ncols_valid) ? W[(size_t)(k0 + kk) * ldw + c] : 0.f; if (gain) v *= gain[k0 + kk]; scr[kk * 33 + (lane & 31)] = v; }
    asm volatile("s_waitcnt lgkmcnt(0)" ::: "memory");
    const int c = lane & 7;
#pragma unroll
    for (int j = 0; j < 4; ++j) { const int n = (lane >> 3) + 8 * j; const LAS float* s = scr + (8 * c) * 33 + n;
        u32x4 o; o.x = pk2(s[0 * 33], s[1 * 33]); o.y = pk2(s[2 * 33], s[3 * 33]); o.z = pk2(s[4 * 33], s[5 * 33]); o.w = pk2(s[6 * 33], s[7 * 33]);
        *(u32x4*)(WT + (size_t)(n0 + n) * K + k0 + 8 * c) = o; }
    asm volatile("s_waitcnt lgkmcnt(0)" ::: "memory");
}

__device__ __forceinline__ void unpack8(const u32x4 w, float* d) { d[0] = bflo(w.x); d[1] = bfhi(w.x); d[2] = bflo(w.y); d[3] = bfhi(w.y); d[4] = bflo(w.z); d[5] = bfhi(w.z); d[6] = bflo(w.w); d[7] = bfhi(w.w); }

__device__ __forceinline__ void fox_cumsum_item(int bh, const float* LF, float* CC, int* JS, const float* gq, const float* gk, LAS float* sc) {
    int tid_ = threadIdx.x; asm volatile("" : "+v"(tid_)); const int tid = tid_, lane = tid & 63, wave = tid >> 6, b = bh / 6, h = bh % 6;
    float v[8]; float run = 0.f;
#pragma unroll
    for (int i = 0; i < 8; ++i) { run += LF[((size_t)b * SEQ + tid * 8 + i) * 8 + h]; v[i] = run; }
    float s = run;
#pragma unroll
    for (int o = 1; o < 64; o <<= 1) { const float n = __shfl_up(s, o); if (lane >= o) s += n; }
    __syncthreads();
    if (lane == 63) sc[wave] = s;
    __syncthreads();
    float base = s - run;
    for (int w = 0; w < wave; ++w) base += sc[w];
    LAS float* cl = sc + 64;
#pragma unroll
    for (int i = 0; i < 8; ++i) { const float c2 = (v[i] + base) * 1.4426950408889634f; CC[(size_t)bh * SEQ + tid * 8 + i] = c2; cl[tid * 8 + i] = c2; }
    __syncthreads();
    if (tid < 16) {
        float mq = 0.f, mk = 0.f;
        for (int d = 0; d < 64; ++d) { mq = fmaxf(mq, fabsf(gq[d])); mk = fmaxf(mk, fabsf(gk[d])); }
        const float zb = 1.4426950408889634f * 8.0f * mq * mk * 1.03f + 1.0f;
        const float thr = -(126.0f + 2.0f * zb);
        const int q0 = tid * 256, nt = q0 / 64 + 4; const float cq = cl[q0];
        int j = 0; while (j < nt - 4 && cq - cl[64 * j + 63] < thr) ++j;
        JS[bh * 16 + tid] = j & ~1;
    }
    __syncthreads();
}

__device__ __forceinline__ void stage_kv(const bf16_t* Kb, const bf16_t* Vb, int kt, LAS float* Kf, LAS float* Vf) {
    int tid_ = threadIdx.x; asm volatile("" : "+v"(tid_)); const int tid = tid_, key = tid >> 3, c8 = tid & 7;
    const u32x4 kw = *(const u32x4*)(Kb + ((size_t)(kt * 64 + key)) * 64 + c8 * 8), vw = *(const u32x4*)(Vb + ((size_t)(kt * 64 + key)) * 64 + c8 * 8);
    float kf[8], vf[8]; unpack8(kw, kf); unpack8(vw, vf);
    *(LAS f32x4*)(Kf + key * 64 + c8 * 8) = (f32x4){kf[0], kf[1], kf[2], kf[3]}; *(LAS f32x4*)(Kf + key * 64 + c8 * 8 + 4) = (f32x4){kf[4], kf[5], kf[6], kf[7]};
    *(LAS f32x4*)(Vf + key * 64 + c8 * 8) = (f32x4){vf[0], vf[1], vf[2], vf[3]}; *(LAS f32x4*)(Vf + key * 64 + c8 * 8 + 4) = (f32x4){vf[4], vf[5], vf[6], vf[7]};
}

__device__ __forceinline__ void fox_naive_item(int item, unsigned char* P, bf16_t* MIX, LAS float* lds) {
    int tid_ = threadIdx.x; asm volatile("" : "+v"(tid_)); const int tid = tid_, bh = item >> 3, qblk = item & 7, b = bh / 6, h = bh % 6, t = qblk * 512 + tid;
    const bf16_t* Qp = (const bf16_t*)(P + P_FQ) + ((size_t)bh * SEQ + t) * 64;
    const bf16_t* Kb = (const bf16_t*)(P + P_FQ + HEADBUF) + (size_t)bh * SEQ * 64;
    const bf16_t* Vb = (const bf16_t*)(P + P_FQ + 2 * HEADBUF) + (size_t)bh * SEQ * 64;
    const float* CC = (const float*)(P + P_CC) + (size_t)bh * SEQ;
    float q[64], o[64];
#pragma unroll
    for (int c = 0; c < 8; ++c) unpack8(*(const u32x4*)(Qp + c * 8), q + c * 8);
#pragma unroll
    for (int d = 0; d < 64; ++d) o[d] = 0.f;
    float m = -1e30f, l = 0.f; const float ct = CC[t];
    LAS float* Kf = lds; LAS float* Vf = lds + 4096; LAS float* cs = lds + 8192;
    const int ntile = (qblk + 1) * 8;
    for (int kt = 0; kt < ntile; ++kt) {
        __syncthreads();
        stage_kv(Kb, Vb, kt, Kf, Vf); if (tid < 64) cs[tid] = CC[kt * 64 + tid];
        __syncthreads();
        for (int s = 0; s < 64; ++s) {
            float z = 0.f;
#pragma unroll
            for (int d = 0; d < 64; ++d) z += q[d] * Kf[s * 64 + d];
            const float x = (kt * 64 + s <= t) ? z + (ct - cs[s]) : -1e30f;
            const float mn = fmaxf(m, x), sc = __expf(m - mn), p = __expf(x - mn);
            l = l * sc + p;
#pragma unroll
            for (int d = 0; d < 64; ++d) o[d] = o[d] * sc + p * Vf[s * 64 + d];
            m = mn;
        }
    }
    const float inv = 1.0f / l;
    bf16_t* op = MIX + ((size_t)b * SEQ + t) * DM + 640 + h * 64;
#pragma unroll
    for (int c = 0; c < 8; ++c) { u32x4 w; w.x = pk2(o[c * 8] * inv, o[c * 8 + 1] * inv); w.y = pk2(o[c * 8 + 2] * inv, o[c * 8 + 3] * inv); w.z = pk2(o[c * 8 + 4] * inv, o[c * 8 + 5] * inv); w.w = pk2(o[c * 8 + 6] * inv, o[c * 8 + 7] * inv); *(u32x4*)(op + c * 8) = w; }
}

__device__ __forceinline__ void sb_naive_item(int item, unsigned char* P, bf16_t* MIX, LAS float* lds) {
    int tid_ = threadIdx.x; asm volatile("" : "+v"(tid_)); const int tid = tid_, bh = item >> 3, qblk = item & 7, b = bh / 6, h = bh % 6, t = qblk * 512 + tid;
    const bf16_t* Qp = (const bf16_t*)(P + P_SQ) + ((size_t)bh * SEQ + t) * 64;
    const bf16_t* Kb = (const bf16_t*)(P + P_SQ + HEADBUF) + (size_t)bh * SEQ * 64;
    const bf16_t* Vb = (const bf16_t*)(P + P_SQ + 2 * HEADBUF) + (size_t)bh * SEQ * 64;
    float q[64], o[64];
#pragma unroll
    for (int c = 0; c < 8; ++c) unpack8(*(const u32x4*)(Qp + c * 8), q + c * 8);
#pragma unroll
    for (int d = 0; d < 64; ++d) o[d] = 0.f;
    float tail = 0.f;
    LAS float* Kf = lds; LAS float* Vf = lds + 4096;
    for (int kt = qblk * 8 + 7; kt >= 0; --kt) {
        __syncthreads();
        stage_kv(Kb, Vb, kt, Kf, Vf);
        __syncthreads();
        for (int s = 63; s >= 0; --s) {
            float z = 0.f;
#pragma unroll
            for (int d = 0; d < 64; ++d) z += q[d] * Kf[s * 64 + d];
            const float ls = fminf(z, 0.f) - __logf(1.0f + __expf(-fabsf(z)));
            const bool act = (kt * 64 + s) < t;
            const float A = act ? __expf(ls + tail) : 0.f;
#pragma unroll
            for (int d = 0; d < 64; ++d) o[d] += A * Vf[s * 64 + d];
            tail += act ? (ls - z) : 0.f;
        }
        if (__syncthreads_and(tail < -100.f)) break;
    }
    bf16_t* op = MIX + ((size_t)b * SEQ + t) * DM + 256 + h * 64;
#pragma unroll
    for (int c = 0; c < 8; ++c) { u32x4 w; w.x = pk2(o[c * 8], o[c * 8 + 1]); w.y = pk2(o[c * 8 + 2], o[c * 8 + 3]); w.z = pk2(o[c * 8 + 4], o[c * 8 + 5]); w.w = pk2(o[c * 8 + 6], o[c * 8 + 7]); *(u32x4*)(op + c * 8) = w; }
}

__device__ __forceinline__ void hgrn_naive_item(int item, unsigned char* P, bf16_t* MIX, const float* hgn, LAS float* lds) {
    int tid_ = threadIdx.x; asm volatile("" : "+v"(tid_)); const int tid = tid_, lane = tid & 63, w = tid >> 6, kg = lane >> 3, vi = lane & 7, vcol = 8 * w + vi, b = item >> 2, h = item & 3;
    const bf16_t* HQ = (const bf16_t*)(P + P_HQ); const bf16_t* HK = (const bf16_t*)(P + P_HK); const bf16_t* HI = (const bf16_t*)(P + P_HI); const bf16_t* HG = (const bf16_t*)(P + P_HG);
    const float* HLF = (const float*)(P + P_HLF);
    LAS float* qf = lds; LAS float* kf = lds + 4096; LAS float* ff = lds + 8192; LAS float* vf = lds + 12288; LAS float* ob = lds + 16384;
    float S[8];
#pragma unroll
    for (int j = 0; j < 8; ++j) S[j] = 0.f;
    const int tok = tid >> 3, c8 = tid & 7;
    float gn[8];
#pragma unroll
    for (int e = 0; e < 8; ++e) gn[e] = hgn[c8 * 8 + e];
    for (int c = 0; c < 64; ++c) {
        const size_t off = ((size_t)b * SEQ + c * 64 + tok) * 256 + h * 64 + c8 * 8;
        __syncthreads();
        {
            float a[8];
            unpack8(*(const u32x4*)(HQ + off), a);
#pragma unroll
            for (int e = 0; e < 8; ++e) qf[tok * 64 + c8 * 8 + e] = a[e];
            unpack8(*(const u32x4*)(HK + off), a);
#pragma unroll
            for (int e = 0; e < 8; ++e) kf[tok * 64 + c8 * 8 + e] = a[e];
            unpack8(*(const u32x4*)(HI + off), a);
#pragma unroll
            for (int e = 0; e < 8; ++e) vf[tok * 64 + c8 * 8 + e] = a[e];
            const f32x4 l0 = *(const f32x4*)(HLF + off), l1 = *(const f32x4*)(HLF + off + 4);
#pragma unroll
            for (int e = 0; e < 4; ++e) { ff[tok * 64 + c8 * 8 + e] = expf(l0[e]); ff[tok * 64 + c8 * 8 + 4 + e] = expf(l1[e]); }
        }
        __syncthreads();
        for (int tk = 0; tk < 64; ++tk) {
            const float vv = vf[tk * 64 + vcol]; float op = 0.f;
#pragma unroll
            for (int j = 0; j < 8; ++j) { const int k = 8 * kg + j; S[j] = ff[tk * 64 + k] * S[j] + kf[tk * 64 + k] * vv; op += qf[tk * 64 + k] * S[j]; }
            op += __shfl_xor(op, 8); op += __shfl_xor(op, 16); op += __shfl_xor(op, 32);
            if (kg == 0) ob[tk * 64 + vcol] = op;
        }
        __syncthreads();
        {
            float ov[8], g[8]; float sq = 0.f;
#pragma unroll
            for (int e = 0; e < 8; ++e) { ov[e] = ob[tok * 64 + c8 * 8 + e]; sq += ov[e] * ov[e]; }
            sq += __shfl_xor(sq, 1); sq += __shfl_xor(sq, 2); sq += __shfl_xor(sq, 4);
            const float rn = rsqrtf(sq * (1.0f / 64.0f) + EPS);
            unpack8(*(const u32x4*)(HG + off), g);
            float r[8];
#pragma unroll
            for (int e = 0; e < 8; ++e) r[e] = ov[e] * rn * gn[e] * (g[e] / (1.0f + expf(-g[e])));
            u32x4 wv; wv.x = pk2(r[0], r[1]); wv.y = pk2(r[2], r[3]); wv.z = pk2(r[4], r[5]); wv.w = pk2(r[6], r[7]);
            *(u32x4*)(MIX + ((size_t)b * SEQ + c * 64 + tok) * DM + h * 64 + c8 * 8) = wv;
        }
    }
}

constexpr int HG_SLOT = 30720, HG_BP = 68  , HG_PRE = 64 * HG_BP * 4, HG_TOT = HG_PRE + 1280, HG_VT = 20480, HG_VP = 72;
static_assert(HG_TOT + 1024 <= HG_VT && HG_VT + 64 * HG_VP * 2 <= HG_SLOT, "HGRN LDS slot map");
typedef short hbf16x8 __attribute__((ext_vector_type(8)));
typedef short hbf16x4 __attribute__((ext_vector_type(4)));
__device__ __forceinline__ hbf16x8 pack8(const float* x) { u32x4 w; w.x = pk2(x[0], x[1]); w.y = pk2(x[2], x[3]); w.z = pk2(x[4], x[5]); w.w = pk2(x[6], x[7]); return __builtin_bit_cast(hbf16x8, w); }

__device__ __forceinline__ void hg_stage(int tid, size_t row0, int h, const float* HLF, const bf16_t* HI, LAS unsigned char* sb) {
    const int lt = tid & 127, k = lt & 63, half = lt >> 6;
    LAS float* bl = (LAS float*)sb; LAS float* pre = (LAS float*)(sb + HG_PRE); LAS float* tot = (LAS float*)(sb + HG_TOT); LAS bf16_t* vt = (LAS bf16_t*)(sb + HG_VT);
    float lfv[32];
#pragma unroll
    for (int i = 0; i < 32; ++i) lfv[i] = HLF[(row0 + 32 * half + i) * 256 + h * 64 + k];
    u32x4 vw[4];
    {
        const int s = lt & 63, c0 = half * 32;
#pragma unroll
        for (int q = 0; q < 4; ++q) vw[q] = *(const u32x4*)(HI + (row0 + s) * 256 + h * 64 + c0 + 8 * q);
    }
#pragma unroll
    for (int sg = 0; sg < 2; ++sg) { float run = 0.f;
#pragma unroll
        for (int i = 0; i < 16; ++i) { run += lfv[16 * sg + i]; bl[(32 * half + 16 * sg + i) * HG_BP + k] = run; }
        tot[(2 * half + sg) * 64 + k] = run; }
    {   const int s = lt & 63, c0 = half * 32;
#pragma unroll
        for (int q = 0; q < 4; ++q) { const unsigned ww[4] = {vw[q].x, vw[q].y, vw[q].z, vw[q].w};
#pragma unroll
            for (int e = 0; e < 4; ++e) { vt[(c0 + 8 * q + 2 * e) * HG_VP + s] = (bf16_t)(ww[e] & 0xffffu); vt[(c0 + 8 * q + 2 * e + 1) * HG_VP + s] = (bf16_t)(ww[e] >> 16); } } }
    __syncthreads();
    if (lt < 64) { float p = 0.f;
#pragma unroll
        for (int sg = 0; sg < 4; ++sg) { pre[sg * 64 + lt] = p; p += tot[sg * 64 + lt]; }
        pre[4 * 64 + lt] = p; }
    __syncthreads();
}

__device__ __forceinline__ void hgrn_a_item(int item, unsigned char* P, float* DD, LAS unsigned char* L) {
    int tid_ = threadIdx.x; asm volatile("" : "+v"(tid_)); const int tid = tid_, lane = tid & 63, wq = (tid >> 6) & 1, cs = tid >> 7, r = lane & 15, g = lane >> 4;
    const int bh = item >> 4, chunk = (item & 15) * 4 + cs, b = bh >> 2, h = bh & 3;
    const size_t row0 = (size_t)b * SEQ + chunk * 64;
    const bf16_t* HK = (const bf16_t*)(P + P_HK); bf16_t* UT = (bf16_t*)(P + P_US);
    LAS unsigned char* sb = L + cs * HG_SLOT;
    unsigned short kraw[2][2][8];
#pragma unroll
    for (int kt2 = 0; kt2 < 2; ++kt2)
#pragma unroll
        for (int ks = 0; ks < 2; ++ks)
#pragma unroll
            for (int j = 0; j < 8; ++j) kraw[kt2][ks][j] = HK[(row0 + 32 * ks + 8 * g + j) * 256 + h * 64 + 16 * (2 * wq + kt2) + r];
    hg_stage(tid, row0, h, (const float*)(P + P_HLF), (const bf16_t*)(P + P_HI), sb);
    const LAS float* bl = (const LAS float*)sb; const LAS float* pre = (const LAS float*)(sb + HG_PRE); const LAS unsigned char* vt = sb + HG_VT;
    bf16_t* ut = UT + ((size_t)(bh * 64 + chunk) * 64) * 64;
#pragma unroll
    for (int kt2 = 0; kt2 < 2; ++kt2) {
        const int kt = 2 * wq + kt2, k = 16 * kt + r; const float pre4 = pre[4 * 64 + k];
        hbf16x8 af[2];
#pragma unroll
        for (int ks = 0; ks < 2; ++ks) { const float pj = pre4 - pre[(2 * ks + (g >> 1)) * 64 + k]; float x[8];
#pragma unroll
            for (int j = 0; j < 8; ++j) { const int s = 32 * ks + 8 * g + j; x[j] = bf2f(kraw[kt2][ks][j]) * __expf(pj - bl[s * HG_BP + k]); }
            af[ks] = pack8(x); }
#pragma unroll
        for (int vtile = 0; vtile < 4; ++vtile) { f32x4 acc = {0.f, 0.f, 0.f, 0.f};
#pragma unroll
            for (int ks = 0; ks < 2; ++ks) { const hbf16x8 bf = *(const LAS hbf16x8*)(vt + (16 * vtile + r) * (HG_VP * 2) + (32 * ks + 8 * g) * 2); acc = __builtin_amdgcn_mfma_f32_16x16x32_bf16(af[ks], bf, acc, 0, 0, 0); }
            u32x2 w; w.x = pk2v(acc[0], acc[1]); w.y = pk2v(acc[2], acc[3]); *(u32x2*)(ut + (size_t)(16 * vtile + r) * 64 + 16 * kt + 4 * g) = w; }
        if (g == 0) DD[(size_t)(bh * 64 + chunk) * 64 + k] = __expf(pre4);
    }
}

__device__ __forceinline__ void hgrn_b_scan(int bx, int G, unsigned char* P, const float* DD) {
    int tid_ = threadIdx.x; asm volatile("" : "+v"(tid_));
    typedef float f32x2s __attribute__((ext_vector_type(2)));
    unsigned* UT = (unsigned*)(P + P_US);
    for (int gid = bx * 512 + tid_; gid < 32 * 2048; gid += G * 512) {
        const int bh = gid >> 11, e2 = gid & 2047; unsigned* u = UT + (size_t)bh * 64 * 2048 + e2; const f32x2s* dd = (const f32x2s*)(DD + (size_t)bh * 64 * 64) + (e2 & 31);
        float S0 = 0.f, S1 = 0.f;
        for (int c0 = 0; c0 < 64; c0 += 32) { unsigned tu[32]; f32x2s td[32];
#pragma unroll
            for (int i = 0; i < 32; ++i) { tu[i] = u[(size_t)(c0 + i) * 2048]; td[i] = dd[(c0 + i) * 32]; }
#pragma unroll
            for (int i = 0; i < 32; ++i) { u[(size_t)(c0 + i) * 2048] = pk2(S0, S1); S0 = td[i][0] * S0 + bflo(tu[i]); S1 = td[i][1] * S1 + bfhi(tu[i]); } }
    }
}

__device__ __forceinline__ void hgrn_c_item(int item, unsigned char* P, bf16_t* MIX, const float* hgn, LAS unsigned char* L) {
    int tid_ = threadIdx.x; asm volatile("" : "+v"(tid_)); const int tid = tid_, lane = tid & 63, wq = (tid >> 6) & 1, cs = tid >> 7, r = lane & 15, g = lane >> 4;
    const int bh = item >> 4, chunk = (item & 15) * 4 + cs, b = bh >> 2, h = bh & 3;
    const size_t row0 = (size_t)b * SEQ + chunk * 64;
    const bf16_t* HQ = (const bf16_t*)(P + P_HQ); const bf16_t* HK = (const bf16_t*)(P + P_HK); const bf16_t* HG = (const bf16_t*)(P + P_HG); const bf16_t* ST = (const bf16_t*)(P + P_US);
    LAS unsigned char* sb = L + cs * HG_SLOT;
    u32x4 qraw[2][2], kraw[4][2], sraw[4][2];
    const bf16_t* st = ST + ((size_t)(bh * 64 + chunk) * 64) * 64;
#pragma unroll
    for (int ks = 0; ks < 2; ++ks) {
#pragma unroll
        for (int ii = 0; ii < 2; ++ii) { const int I = ii ? (wq ? 2 : 3) : (wq ? 1 : 0); qraw[ii][ks] = *(const u32x4*)(HQ + (row0 + 16 * I + r) * 256 + h * 64 + 32 * ks + 8 * g); }
#pragma unroll
        for (int J = 0; J < 4; ++J) kraw[J][ks] = *(const u32x4*)(HK + (row0 + 16 * J + r) * 256 + h * 64 + 32 * ks + 8 * g);
#pragma unroll
        for (int vtile = 0; vtile < 4; ++vtile) sraw[vtile][ks] = *(const u32x4*)(st + (size_t)(16 * vtile + r) * 64 + 32 * ks + 8 * g); }
    hg_stage(tid, row0, h, (const float*)(P + P_HLF), (const bf16_t*)(P + P_HI), sb);
    const LAS float* bl = (const LAS float*)sb; const LAS float* pre = (const LAS float*)(sb + HG_PRE); const LAS unsigned char* vt = sb + HG_VT;
    hbf16x8 sfr[4][2];
#pragma unroll
    for (int vtile = 0; vtile < 4; ++vtile)
#pragma unroll
        for (int ks = 0; ks < 2; ++ks) sfr[vtile][ks] = __builtin_bit_cast(hbf16x8, sraw[vtile][ks]);
#pragma unroll
    for (int ii = 0; ii < 2; ++ii) {
        const int I = ii ? (wq ? 2 : 3) : (wq ? 1 : 0), t = 16 * I + r;
        unsigned short graw[4][4];
#pragma unroll
        for (int i = 0; i < 4; ++i)
#pragma unroll
            for (int vtile = 0; vtile < 4; ++vtile) graw[i][vtile] = HG[(row0 + 16 * I + 4 * g + i) * 256 + h * 64 + 16 * vtile + r];
        hbf16x8 qtf[2], qhf[2];
#pragma unroll
        for (int ks = 0; ks < 2; ++ks) { const int kb = 32 * ks + 8 * g; float q[8], xt[8], xh[8];
            unpack8(qraw[ii][ks], q);
#pragma unroll
            for (int j = 0; j < 8; ++j) { xt[j] = q[j] * __expf(bl[t * HG_BP + kb + j]); xh[j] = xt[j] * __expf(pre[I * 64 + kb + j]); }
            qtf[ks] = pack8(xt); qhf[ks] = pack8(xh); }
        f32x4 at[4];
#pragma unroll
        for (int J = 0; J < 4; ++J) { at[J] = (f32x4){0.f, 0.f, 0.f, 0.f};
            if (J <= I) { const int s = 16 * J + r;
#pragma unroll
                for (int ks = 0; ks < 2; ++ks) { const int kb = 32 * ks + 8 * g; float kk[8], x[8];
                    unpack8(kraw[J][ks], kk);
#pragma unroll
                    for (int j = 0; j < 8; ++j) x[j] = kk[j] * __expf(fminf(pre[I * 64 + kb + j] - pre[J * 64 + kb + j] - bl[s * HG_BP + kb + j], 80.f));
                    at[J] = __builtin_amdgcn_mfma_f32_16x16x32_bf16(pack8(x), qtf[ks], at[J], 0, 0, 0); }
                if (J == I) {
#pragma unroll
                    for (int i = 0; i < 4; ++i) at[J][i] = (4 * g + i <= r) ? at[J][i] : 0.f; } } }
        hbf16x8 pf[2];
#pragma unroll
        for (int k2 = 0; k2 < 2; ++k2) { const float x[8] = {at[2 * k2][0], at[2 * k2][1], at[2 * k2][2], at[2 * k2][3], at[2 * k2 + 1][0], at[2 * k2 + 1][1], at[2 * k2 + 1][2], at[2 * k2 + 1][3]}; { u32x4 w_; w_.x = pk2v(x[0], x[1]); w_.y = pk2v(x[2], x[3]); w_.z = pk2v(x[4], x[5]); w_.w = pk2v(x[6], x[7]); pf[k2] = __builtin_bit_cast(hbf16x8, w_); } }
        f32x4 o[4];
#pragma unroll
        for (int vtile = 0; vtile < 4; ++vtile) { f32x4 acc = {0.f, 0.f, 0.f, 0.f}; const int v = 16 * vtile + r;
#pragma unroll
            for (int ks = 0; ks < 2; ++ks) acc = __builtin_amdgcn_mfma_f32_16x16x32_bf16(qhf[ks], sfr[vtile][ks], acc, 0, 0, 0);
#pragma unroll
            for (int k2 = 0; k2 < 2; ++k2) { if (k2 == 0 || I >= 2) {
                const hbf16x4 v0 = *(const LAS hbf16x4*)(vt + v * (HG_VP * 2) + (32 * k2 + 4 * g) * 2), v1 = *(const LAS hbf16x4*)(vt + v * (HG_VP * 2) + (32 * k2 + 16 + 4 * g) * 2);
                const hbf16x8 vf = {v0[0], v0[1], v0[2], v0[3], v1[0], v1[1], v1[2], v1[3]};
                acc = __builtin_amdgcn_mfma_f32_16x16x32_bf16(pf[k2], vf, acc, 0, 0, 0); } }
            o[vtile] = acc; }
#pragma unroll
        for (int i = 0; i < 4; ++i) { float sq = 0.f;
#pragma unroll
            for (int vtile = 0; vtile < 4; ++vtile) sq += o[vtile][i] * o[vtile][i];
            sq += __shfl_xor(sq, 1); sq += __shfl_xor(sq, 2); sq += __shfl_xor(sq, 4); sq += __shfl_xor(sq, 8);
            const float rn = rsqrtf(sq * (1.0f / 64.0f) + EPS); const size_t row = row0 + 16 * I + 4 * g + i;
#pragma unroll
            for (int vtile = 0; vtile < 4; ++vtile) { const int v = 16 * vtile + r; const float gg = bf2f(graw[i][vtile]);
                MIX[row * DM + h * 64 + v] = (bf16_t)f2bf(o[vtile][i] * rn * hgn[v] * (gg / (1.0f + __expf(-gg)))); } }
    }
}

struct Args { const float* in[14]; float* out; unsigned char* ws; int ph_lo, ph_hi; };
constexpr int NPHASE = 1 + 9 * DEPTH;

__global__ void __launch_bounds__(512, 2) fwd(Args a) {
    extern __shared__ __attribute__((aligned(16))) unsigned char lds[];
    cg::grid_group grid = cg::this_grid();
    LAS unsigned char* L = (LAS unsigned char*)lds;
    if (threadIdx.x < 32) ((LAS unsigned*)(L + LDS_BYTES - 128))[threadIdx.x] = 0u;
    __syncthreads();
    for (int ph = a.ph_lo; ph < a.ph_hi; ++ph) {
        int G = gridDim.x, bx = blockIdx.x; asm volatile("" : "+s"(G), "+s"(bx));
        typedef const __attribute__((address_space(4))) Args* KArgP;
        KArgP ap = (KArgP)__builtin_amdgcn_kernarg_segment_ptr(); asm volatile("" : "+s"(ap));
        unsigned char* ws = ap->ws;
        float* SS = (float*)(ws + WS_SS); float* LB = (float*)(ws + WS_LB);
        bf16_t* XB = (bf16_t*)(ws + WS_XB); bf16_t* MIX = (bf16_t*)(ws + WS_MIX); bf16_t* UB = (bf16_t*)(ws + WS_U);
        unsigned char* P = ws + WS_P;
#ifdef PROBE_T
        if (ph == NPHASE) {
            if (bx == 0) { const unsigned long long* ts_ = (const unsigned long long*)(ws + 65536); unsigned long long sa = 0, sb = 0;
                for (int p = 1; p < NPHASE; ++p) { const int kk_ = (p - 1) % 7; const unsigned long long d = ts_[p] - ts_[p - 1]; if (PROBE_A(kk_)) sa += d; if (PROBE_B(kk_)) sb += d; }
                const float fa = (float)sa * 1e-3f, fb = (float)sb * 1e-3f; float* o_ = ap->out;
                for (int i = threadIdx.x; i < (1 << 20); i += 512) o_[(1 << 20) + i] += fb;
                if (threadIdx.x == 0) o_[0] = fa; }
        } else
#endif
        if (ph == 0) {
            int tid = threadIdx.x; asm volatile("" : "+v"(tid)); const int lane = tid & 63, wave = __builtin_amdgcn_readfirstlane(tid >> 6);
            LAS float* scr = (LAS float*)(L + wave * 16384);
            const int gw = bx * 8 + wave, NGW = G * 8;
            constexpr int I_IN = 16 * 112, I_OUT = 16 * 32, I_1 = 16 * 128, I_2 = 64 * 32, I_L = I_IN + I_OUT + I_1 + I_2;
            for (int it = gw; it < DEPTH * I_L; it += NGW) {
                const int l = it / I_L; int r = it % I_L;
                unsigned char* wl = ws + WS_W + (size_t)l * W_LAYER;
                if (r < I_IN) { const int kb = r / 112, nb = r % 112, n0 = nb * 32, pn = n0 >> 8, p = n0 & 255, slot = 4 * pn + ((p & 127) >> 5), sc0 = 64 * slot + 32 * (p >> 7);
                    tr_item(ap->in[3] + (size_t)l * DM * INC, INC, INC, sc0, kb * 64, ap->in[2] + l * DM, (bf16_t*)wl, DM, n0, scr, lane); continue; }
                r -= I_IN;
                if (r < I_OUT) { const int kb = r / 32, nb = r % 32; tr_item(ap->in[10] + (size_t)l * DM * DM, DM, DM, nb * 32, kb * 64, nullptr, (bf16_t*)(wl + W_OUT), DM, nb * 32, scr, lane); continue; }
                r -= I_OUT;
                if (r < I_1) { const int kb = r / 128, nb = r % 128; tr_item(ap->in[12] + (size_t)l * DM * DFF, DFF, DFF, nb * 32, kb * 64, ap->in[11] + l * DM, (bf16_t*)(wl + W_1), DM, nb * 32, scr, lane); continue; }
                r -= I_1;
                { const int kb = r / 32, nb = r % 32; tr_item(ap->in[13] + (size_t)l * DFF * DM, DM, DM, nb * 32, kb * 64, nullptr, (bf16_t*)(wl + W_2), DFF, nb * 32, scr, lane); }
            }
            const float* x = ap->in[0];
            for (int m0 = gw; m0 < M; m0 += 4 * NGW) {
                f32x4 v[4][4]; float s[4];
#pragma unroll
                for (int q = 0; q < 4; ++q) { const int m = m0 + q * NGW; const f32x4* xr = (const f32x4*)(x + (size_t)(m < M ? m : gw) * DM) + lane;
#pragma unroll
                    for (int j = 0; j < 4; ++j) v[q][j] = xr[64 * j]; }
#pragma unroll
                for (int q = 0; q < 4; ++q) { s[q] = 0.f;
#pragma unroll
                    for (int j = 0; j < 4; ++j) s[q] += (v[q][j][0] * v[q][j][0] + v[q][j][1] * v[q][j][1]) + (v[q][j][2] * v[q][j][2] + v[q][j][3] * v[q][j][3]); }
#pragma unroll
                for (int q = 0; q < 4; ++q) { const int m = m0 + q * NGW; const float tot = wave_sum(s[q]);
                    if (m < M) { u32x2* o8 = (u32x2*)(XB + (size_t)m * DM) + lane;
#pragma unroll
                        for (int j = 0; j < 4; ++j) { u32x2 w; w.x = pk2(v[q][j][0], v[q][j][1]); w.y = pk2(v[q][j][2], v[q][j][3]); o8[64 * j] = w; }
                        if (lane < 16) SS[(size_t)m * 16 + lane] = (lane == 0) ? tot : 0.f; } }
            }
            if (bx == 2 && tid < 64) ((unsigned*)ws)[tid] = 0u;
            if (bx == 3) for (int i = tid; i < XCD_BAR_WORDS; i += 512) ((unsigned*)(ws + WS_BAR))[i] = 0u;
            if (bx == 1) {
                for (int i = tid; i < 1024; i += 512) { const int l = i >> 8, wh = (i >> 6) & 3, d = i & 63; LB[2048 + i] = ap->in[5 + wh][l * 64 + d]; }
                if (tid < 32) { const int l = tid >> 3, e = tid & 7; LB[3072 + tid] = (e < 6) ? ap->in[9][l * 6 + e] : 0.f; }
            }
            if (bx == 0 && tid < 256) {
                const float* lg = ap->in[1]; float e[DEPTH]; float mx = -1e30f, sum = 0.f;
#pragma unroll
                for (int l = 0; l < DEPTH; ++l) mx = fmaxf(mx, lg[l * 256 + tid]);
#pragma unroll
                for (int l = 0; l < DEPTH; ++l) { e[l] = expf(lg[l * 256 + tid] - mx); sum += e[l]; }
                float c = 0.f;
#pragma unroll
                for (int l = 0; l < DEPTH; ++l) { if (l > 0) c += e[l] / sum; LB[l * 512 + tid] = logf(fmaxf(c, 1e-30f)); LB[l * 512 + 256 + tid] = 1.0f - c; }
            }
        } else {
            const int l = (ph - 1) / 9, k = (ph - 1) % 9;
#ifdef REP_K
            const int nrep = (k == REP_K) ? 2 : 1;
#else
            const int nrep = 1;
#endif
            for (int rep = 0; rep < nrep; ++rep) {
            if (rep) { XcdBarrier xb_; xb_.bar = (unsigned*)(ws + WS_BAR); xb_.x = xb_xcc_id(); xb_.st = (volatile LAS unsigned*)(L + LDS_BYTES - 128); xcd_barrier(xb_); }
            unsigned char* wl = ws + WS_W + (size_t)l * W_LAYER;
            if (k == 0) {
                pg8::Gemm g{XB, (const bf16_t*)wl, M, NIN, DM}; pg8::StaticOrder S; S.init(M, NIN, G, bx);
                EpiInProj E{SS, P, LB + l * 512, LB + 2048 + l * 256, LB + 3072 + l * 8};
                pg8::gemm_phase<EpiInProj, pg8::StaticOrder, true, true>(L, g, S, E);
            } else if (k == 1) {
                int tid = threadIdx.x; asm volatile("" : "+v"(tid));
                unsigned* ctr = (unsigned*)ws + l * 16 + 1 + rep * 4;
                volatile LAS int* sh = (volatile LAS int*)(L + LDS_BYTES - 64);
                int nxt = 0; if (tid == 0) nxt = (int)atomicAdd(ctr, 1u);
                for (;;) {
                    if (tid == 0) sh[0] = nxt;
                    __syncthreads();
                    const int idx = __builtin_amdgcn_readfirstlane(sh[0]);
                    __syncthreads();
                    if (idx >= 816 + 512) break;
                    if (tid == 0) nxt = (int)atomicAdd(ctr, 1u);
                    if (idx < 768) { const int qb = 15 - idx / 48, bh = idx % 48, b = bh / 6, h = bh % 6; typedef attn_body::bf16 abf;
                        attn_body::sb_unit(qb, (const abf*)(P + P_SQ) + (size_t)bh * SEQ * 64, (const abf*)(P + P_SQ + HEADBUF) + (size_t)bh * SEQ * 64, (const abf*)(P + P_SQ + 2 * HEADBUF) + (size_t)bh * SEQ * 64,
                                           (abf*)MIX + (size_t)b * SEQ * DM + 256 + h * 64, (char*)lds); }
                    else if (idx < 816) fox_cumsum_item(idx - 768, (const float*)(P + P_LF), (float*)(P + P_CC), (int*)(ws + WS_JS), LB + 2048 + l * 256 + 128, LB + 2048 + l * 256 + 192, (LAS float*)L);
                    else hgrn_a_item(idx - 816, P, (float*)(ws + WS_DD), L);
                    __syncthreads();
                }
            } else if (k == 2) {
                hgrn_b_scan(bx, G, P, (const float*)(ws + WS_DD));
            } else if (k == 3) {
                int tid = threadIdx.x; asm volatile("" : "+v"(tid));
                unsigned* ctr = (unsigned*)ws + l * 16 + rep * 4;
                volatile LAS int* sh = (volatile LAS int*)(L + LDS_BYTES - 64);
                int nxt = 0; if (tid == 0) nxt = (int)atomicAdd(ctr, 1u);
                for (;;) {
                    if (tid == 0) sh[0] = nxt;
                    __syncthreads();
                    const int idx = __builtin_amdgcn_readfirstlane(sh[0]);
                    __syncthreads();
#ifdef PROBE_FOX
                    if (idx >= 768 + 512 || (rep && idx >= 768)) break;
#else
                    if (idx >= 768 + 512) break;
#endif
                    if (tid == 0) nxt = (int)atomicAdd(ctr, 1u);
                    if (idx >= 768) { hgrn_c_item(idx - 768, P, MIX, ap->in[4] + l * 64, L); __syncthreads(); continue; }
                    const int qb = 15 - idx / 48, bh = idx % 48, b = bh / 6, h = bh % 6;
                    typedef attn_body::bf16 abf;
                    const int jstart = ((const int*)(ws + WS_JS))[bh * 16 + qb];
#ifdef PROBE_FOX
                    if (rep) attn_body::attn_unit<30, PROBE_FOX_BIAS>(qb, PROBE_FOX_JS(jstart), (const abf*)(P + P_FQ) + (size_t)bh * SEQ * 64, (const abf*)(P + P_FQ + HEADBUF) + (size_t)bh * SEQ * 64, (const abf*)(P + P_FQ + 2 * HEADBUF) + (size_t)bh * SEQ * 64,
                                            (abf*)ap->out + (size_t)b * SEQ * DM + 640 + h * 64, (const float*)(P + P_CC) + (size_t)bh * SEQ, (char*)lds);
                    else
#endif
                    attn_body::attn_unit<30>(qb, jstart, (const abf*)(P + P_FQ) + (size_t)bh * SEQ * 64, (const abf*)(P + P_FQ + HEADBUF) + (size_t)bh * SEQ * 64, (const abf*)(P + P_FQ + 2 * HEADBUF) + (size_t)bh * SEQ * 64,
                                            (abf*)MIX + (size_t)b * SEQ * DM + 640 + h * 64, (const float*)(P + P_CC) + (size_t)bh * SEQ, (char*)lds);
                }
            } else if (k == 5 || k == 7) {
                const size_t r0 = (k == 7) ? (size_t)(M / 2) : 0;
                pg8::Gemm g{XB + r0 * DM, (const bf16_t*)(wl + W_1), M / 2, DFF, DM}; pg8::StaticOrder S; S.init(M / 2, DFF, G, bx);
                EpiRelu2 E{UB, SS + r0 * 16};
                pg8::gemm_phase<EpiRelu2, pg8::StaticOrder, true, true>(L, g, S, E);
            } else {
                const bool ff2 = (k != 4); const size_t r0 = (k == 8) ? (size_t)(M / 2) : 0;
                pg8::Gemm g{ff2 ? UB : MIX, (const bf16_t*)(wl + (ff2 ? W_2 : W_OUT)), ff2 ? M / 2 : M, DM, ff2 ? DFF : DM}; pg8::StaticOrder S; S.init(ff2 ? M / 2 : M, DM, G, bx);
                EpiResid E{XB + r0 * DM, (ff2 && l == DEPTH - 1) ? ap->out + r0 * DM : nullptr, SS + r0 * 16};
                pg8::gemm_phase<EpiResid, pg8::StaticOrder, true, true>(L, g, S, E);
            }
            }
        }
#ifdef PROBE_T
        if (bx == 0 && threadIdx.x == 0) ((unsigned long long*)(ws + 65536))[ph] = __builtin_amdgcn_s_memrealtime();
#endif
        if (ph + 1 < a.ph_hi) {
            if (ph == 0) {
                grid.sync();
                (void)xcd_barrier_post((unsigned*)(ws + WS_BAR), (volatile LAS unsigned*)(L + LDS_BYTES - 128));
            } else {
                XcdBarrier xb_; xb_.bar = (unsigned*)(ws + WS_BAR); xb_.x = xb_xcc_id(); xb_.st = (volatile LAS unsigned*)(L + LDS_BYTES - 128);
                xcd_barrier(xb_);
            }
        }
    }
}

#ifndef MK_MULTI
#define MK_MULTI 0
#endif
extern "C" void kernel_launch(void* const* d_in, const int* in_sizes, int n_in, void* d_out, int out_size, void* d_ws, size_t ws_size, hipStream_t stream) {
    static int grid = 0;
    if (grid == 0) {
        int dev = 0, cus = 0, per = 0;
        if (n_in != 14 || out_size != M * DM || ws_size < WS_END) { fprintf(stderr, "kernel_launch: unexpected shapes (n_in %d out %d ws %zu)\n", n_in, out_size, ws_size); grid = -1; return; }
        (void)hipGetDevice(&dev); (void)hipDeviceGetAttribute(&cus, hipDeviceAttributeMultiprocessorCount, dev);
        (void)hipFuncSetAttribute((const void*)fwd, hipFuncAttributeMaxDynamicSharedMemorySize, LDS_BYTES);
        (void)hipOccupancyMaxActiveBlocksPerMultiprocessor(&per, (const void*)fwd, 512, LDS_BYTES);
        if (per < 1) per = 1;
        grid = cus * per;
        fprintf(stderr, "kernel_launch: grid %d (cus %d x %d)\n", grid, cus, per);
    }
    if (grid < 0) return;
    Args a{};
    for (int i = 0; i < 14; ++i) a.in[i] = (const float*)d_in[i];
    a.out = (float*)d_out; a.ws = (unsigned char*)d_ws;
#if MK_MULTI
    for (int ph = 0; ph < NPHASE; ++ph) { a.ph_lo = ph; a.ph_hi = ph + 1; hipLaunchKernelGGL(fwd, dim3(grid), dim3(512), LDS_BYTES, stream, a); }
#else
#ifdef PROBE_T
    a.ph_lo = 0; a.ph_hi = NPHASE + 1;
#else
    a.ph_lo = 0; a.ph_hi = NPHASE;
#endif
    void* args[] = {&a};
    hipError_t e = hipLaunchCooperativeKernel((const void*)fwd, dim3(grid), dim3(512), args, LDS_BYTES, stream);
    if (e != hipSuccess) fprintf(stderr, "kernel_launch: cooperative launch failed: %s (grid %d)\n", hipGetErrorString(e), grid);
#endif
}
```

```cpp
#include <hip/hip_runtime.h>
#include <hip/hip_cooperative_groups.h>
#include <cstdio>
#include <cstdint>
namespace cg = cooperative_groups;
namespace pg8 {
#define PG8_LAS __attribute__((address_space(3)))
typedef unsigned short bf16_t;
typedef short bf16x8 __attribute__((ext_vector_type(8)));
typedef float f32x4 __attribute__((ext_vector_type(4)));
typedef unsigned u32x4 __attribute__((ext_vector_type(4)));
constexpr int BM = 256, BK = 64, HALF = 128, HTB = HALF * BK * 2  , STAGE_BYTES = 8 * HTB, NXCD = 8, WGM = 8;

__host__ __device__ __forceinline__ int lds_byte(int r, int c) { const int st = (r >> 4) * 2 + (c >> 5), rr = r & 15, cc = c & 31, ob = rr * 64 + cc * 2; return st * 1024 + (ob ^ (((ob >> 9) & 1) << 5)); }
__host__ __device__ __forceinline__ void stage_rc(int b, int& R, int& C) { const int st = b / 1024, sb = b % 1024, swz = sb ^ (((sb >> 9) & 1) << 5); R = (st >> 1) * 16 + swz / 64; C = (st & 1) * 32 + (swz % 64) / 2; }
__host__ __device__ __forceinline__ int perm32(int rho) { const int n = rho >> 4, i = rho & 15; return 8 * (i >> 2) + 4 * n + (i & 3); }

struct Unit { int pm, pn; };
struct Gemm { const bf16_t* A; const bf16_t* Bt; int M, N, K; };

struct StaticOrder {
    int nM, nN, nwg, G, c;
    __host__ __device__ void init(int M, int N, int G_, int c_) { nM = M / BM; nN = N / BM; nwg = nM * nN; G = G_; c = c_; }
    __host__ __device__ bool next(int i, Unit& u) const {
        const long L = (long)i * G + c; if (L >= nwg) return false;
        int wgid = (int)L; { const int q = nwg / NXCD, r = nwg % NXCD, xcd = wgid % NXCD, off = wgid / NXCD; wgid = (xcd < r ? xcd * (q + 1) : r * (q + 1) + (xcd - r) * q) + off; }
        const int nig = WGM * nN, gid = wgid / nig, fm = gid * WGM, gsz = (nM - fm) < WGM ? (nM - fm) : WGM;
        u.pm = fm + ((wgid % nig) % gsz); u.pn = (wgid % nig) / gsz; return true;
    }
    __device__ __forceinline__ void a_ready(const Unit&) const {}
    __device__ __forceinline__ void done(const Unit&) const {}
};

__device__ __forceinline__ unsigned cvt_pk_bf16(float lo, float hi) { unsigned r; asm volatile("v_cvt_pk_bf16_f32 %0, %1, %2" : "=v"(r) : "v"(lo), "v"(hi)); return r; }
typedef float f32x2 __attribute__((ext_vector_type(2)));
template <class Epi, class Sched, bool ALIGN_EPI = false, bool SP2 = false>
__device__ __forceinline__ void gemm_phase(PG8_LAS unsigned char* lds, const Gemm g, const Sched& S, const Epi& E) {
    int tid_ = threadIdx.x; asm volatile("" : "+v"(tid_));
    const int tid = tid_, wid = __builtin_amdgcn_readfirstlane(tid >> 6), lane = tid & 63, wr = wid >> 2, wc = wid & 3, fr = lane & 15, fq = lane >> 4;
    const int K = g.K, nt = K / BK;
    unsigned voffA[2], voffB[2];
#pragma unroll
    for (int i = 0; i < 2; ++i) { int R, C; stage_rc(tid * 16 + i * 8192, R, C); const int Rb = Epi::PERM ? ((R & ~31) + perm32(R & 31)) : R;
        voffA[i] = (unsigned)(R * K + C) * 2u; voffB[i] = (unsigned)(Rb * K + C) * 2u; }
    const size_t kstep = (size_t)(BK * 2);
    const size_t hstep = (size_t)HALF * K * 2;
    const size_t tstep = 2 * hstep;
    const unsigned ldsw = (unsigned)wid * 1024u;
    const int aoff = lds_byte(wr * 64 + fr, fq * 8), boff = lds_byte(wc * 32 + fr, fq * 8);
#define PG8_SA(b, h) (((b) * 2 + (h)) * HTB)
#define PG8_SB(b, h) ((4 + (b) * 2 + (h)) * HTB)
#define PG8_STAGE(bufoff, gbase, voff) do { _Pragma("unroll") for (int _i = 0; _i < 2; ++_i) \
        __builtin_amdgcn_global_load_lds((const unsigned*)((const char*)(gbase) + (voff)[_i]), (PG8_LAS unsigned*)(lds + (bufoff) + ldsw + _i * 8192), 16, 0, 0); } while (0)
#define PG8_LDA(dst, b, h) do { _Pragma("unroll") for (int m = 0; m < 4; ++m) _Pragma("unroll") for (int k = 0; k < 2; ++k) dst[m][k] = *(const PG8_LAS bf16x8*)(lds + PG8_SA(b, h) + aoff + m * 2048 + k * 1024); } while (0)
#define PG8_LDB(dst, b, h) do { _Pragma("unroll") for (int n = 0; n < 2; ++n) _Pragma("unroll") for (int k = 0; k < 2; ++k) dst[n][k] = *(const PG8_LAS bf16x8*)(lds + PG8_SB(b, h) + boff + n * 2048 + k * 1024); } while (0)
#define PG8_MMA(ai, bj, At, Bt) do { __builtin_amdgcn_s_setprio(1); _Pragma("unroll") for (int m = 0; m < 4; ++m) _Pragma("unroll") for (int n = 0; n < 2; ++n) _Pragma("unroll") for (int k = 0; k < 2; ++k) \
        acc[ai][bj][m][n] = __builtin_amdgcn_mfma_f32_16x16x32_bf16(Bt[n][k], At[m][k], acc[ai][bj][m][n], 0, 0, 0); __builtin_amdgcn_s_setprio(0); } while (0)
#define PG8_WAIT_V(n) asm volatile("s_waitcnt vmcnt(" #n ")" ::: "memory")
#define PG8_WAIT_L(n) asm volatile("s_waitcnt lgkmcnt(" #n ")" ::: "memory")
#define PG8_BAR __builtin_amdgcn_s_barrier()
#define PG8_SCHED __builtin_amdgcn_sched_barrier(0)
    Unit cur, nxt; int ui = 0;
    if (!S.next(0, cur)) return;
    f32x4 acc[2][2][4][2];
#pragma unroll
    for (int a = 0; a < 2; ++a)
#pragma unroll
        for (int b = 0; b < 2; ++b)
#pragma unroll
            for (int m = 0; m < 4; ++m)
#pragma unroll
                for (int n = 0; n < 2; ++n) acc[a][b][m][n] = (f32x4){0.f, 0.f, 0.f, 0.f};
    bf16x8 At[4][2], B0[2][2], B1[2][2];
    const char* cA = (const char*)g.A + (size_t)cur.pm * tstep; const char* cB = (const char*)g.Bt + (size_t)cur.pn * tstep;
    S.a_ready(cur);
    if constexpr (SP2) {
        PG8_STAGE(PG8_SB(0, 0), cB, voffB); PG8_STAGE(PG8_SB(0, 1), cB + hstep, voffB); PG8_STAGE(PG8_SA(0, 0), cA, voffA); PG8_STAGE(PG8_SA(0, 1), cA + hstep, voffA);
        if (wr == 1) PG8_BAR;
        PG8_WAIT_V(2); PG8_BAR;
        PG8_STAGE(PG8_SB(1, 0), cB + kstep, voffB); PG8_STAGE(PG8_SA(1, 0), cA + kstep, voffA); PG8_STAGE(PG8_SB(1, 1), cB + hstep + kstep, voffB);
        PG8_WAIT_V(6); PG8_BAR;
    } else {
        PG8_STAGE(PG8_SB(0, 0), cB, voffB); PG8_STAGE(PG8_SA(0, 0), cA, voffA); PG8_STAGE(PG8_SB(0, 1), cB + hstep, voffB); PG8_STAGE(PG8_SA(0, 1), cA + hstep, voffA);
        if (wr == 1) PG8_BAR;
        PG8_WAIT_V(4); PG8_BAR;
        PG8_STAGE(PG8_SB(1, 0), cB + kstep, voffB); PG8_STAGE(PG8_SA(1, 0), cA + kstep, voffA); PG8_STAGE(PG8_SB(1, 1), cB + hstep + kstep, voffB);
        PG8_WAIT_V(6); PG8_BAR;
    }
    for (;;) {
        const bool has_next = S.next(ui + 1, nxt);
        const char* nA = has_next ? (const char*)g.A + (size_t)nxt.pm * tstep : cA; const char* nB = has_next ? (const char*)g.Bt + (size_t)nxt.pn * tstep : cB;
        for (int t = 0; t < nt; t += 2) {
            const bool last = (t == nt - 2);
            const char* a1 = cA + (size_t)(t + 1) * kstep;
            const char* a2 = last ? nA : cA + (size_t)(t + 2) * kstep; const char* b2 = last ? nB : cB + (size_t)(t + 2) * kstep;
            const char* a3 = a2 + kstep; const char* b3 = b2 + kstep;
            if (last && has_next) S.a_ready(nxt);
            if constexpr (SP2) {
            PG8_LDB(B0, 0, 0); PG8_LDB(B1, 0, 1); PG8_SCHED; PG8_LDA(At, 0, 0); PG8_STAGE(PG8_SA(1, 1), a1 + hstep, voffA);
            PG8_WAIT_V(8); PG8_WAIT_L(0); PG8_BAR; PG8_MMA(0, 0, At, B0); PG8_MMA(0, 1, At, B1); PG8_BAR; PG8_SCHED;
            PG8_LDA(At, 0, 1); PG8_STAGE(PG8_SB(0, 0), b2, voffB); PG8_STAGE(PG8_SB(0, 1), b2 + hstep, voffB); PG8_STAGE(PG8_SA(0, 0), a2, voffA);
            PG8_WAIT_V(8); PG8_WAIT_L(0); PG8_BAR; PG8_MMA(1, 0, At, B0); PG8_MMA(1, 1, At, B1); PG8_BAR; PG8_SCHED;
            PG8_LDB(B0, 1, 0); PG8_LDB(B1, 1, 1); PG8_SCHED; PG8_LDA(At, 1, 0); PG8_STAGE(PG8_SA(0, 1), a2 + hstep, voffA);
            PG8_WAIT_V(8); PG8_WAIT_L(0); PG8_BAR; PG8_MMA(0, 0, At, B0); PG8_MMA(0, 1, At, B1); PG8_BAR; PG8_SCHED;
            PG8_LDA(At, 1, 1); PG8_STAGE(PG8_SB(1, 0), b3, voffB); PG8_STAGE(PG8_SB(1, 1), b3 + hstep, voffB); PG8_STAGE(PG8_SA(1, 0), a3, voffA);
            PG8_WAIT_V(8); PG8_WAIT_L(0); PG8_BAR; PG8_MMA(1, 0, At, B0); PG8_MMA(1, 1, At, B1); PG8_BAR; PG8_SCHED;
            } else {
            PG8_LDB(B0, 0, 0); PG8_SCHED; PG8_LDA(At, 0, 0); PG8_STAGE(PG8_SA(1, 1), a1 + hstep, voffA);
            PG8_WAIT_L(8); PG8_BAR; PG8_WAIT_L(0); PG8_MMA(0, 0, At, B0); PG8_BAR; PG8_SCHED;
            PG8_LDB(B1, 0, 1); PG8_STAGE(PG8_SB(0, 0), b2, voffB);
            PG8_BAR; PG8_WAIT_L(0); PG8_MMA(0, 1, At, B1); PG8_BAR;
            PG8_LDA(At, 0, 1); PG8_STAGE(PG8_SA(0, 0), a2, voffA);
            PG8_BAR; PG8_WAIT_L(0); PG8_MMA(1, 0, At, B0); PG8_BAR; PG8_SCHED;
            PG8_STAGE(PG8_SB(0, 1), b2 + hstep, voffB);
            PG8_WAIT_V(6); PG8_BAR; PG8_MMA(1, 1, At, B1); PG8_BAR;
            PG8_LDB(B0, 1, 0); PG8_SCHED; PG8_LDA(At, 1, 0); PG8_STAGE(PG8_SA(0, 1), a2 + hstep, voffA);
            PG8_WAIT_L(8); PG8_BAR; PG8_WAIT_L(0); PG8_MMA(0, 0, At, B0); PG8_BAR; PG8_SCHED;
            PG8_LDB(B1, 1, 1); PG8_STAGE(PG8_SB(1, 0), b3, voffB);
            PG8_BAR; PG8_WAIT_L(0); PG8_MMA(0, 1, At, B1); PG8_BAR;
            PG8_LDA(At, 1, 1); PG8_STAGE(PG8_SA(1, 0), a3, voffA);
            PG8_BAR; PG8_WAIT_L(0); PG8_MMA(1, 0, At, B0); PG8_BAR; PG8_SCHED;
            PG8_STAGE(PG8_SB(1, 1), b3 + hstep, voffB);
            PG8_WAIT_V(6); PG8_BAR; PG8_MMA(1, 1, At, B1); PG8_BAR;
            }
        }
        if constexpr (ALIGN_EPI) { if (wr == 0) PG8_BAR; }
        if constexpr (!Epi::AFTER_DRAIN) { E(acc, cur, wr, wc, fr, fq); S.done(cur); }
        if (!has_next) break;
#pragma unroll
        for (int a = 0; a < 2; ++a)
#pragma unroll
            for (int b = 0; b < 2; ++b)
#pragma unroll
                for (int m = 0; m < 4; ++m)
#pragma unroll
                    for (int n = 0; n < 2; ++n) acc[a][b][m][n] = (f32x4){0.f, 0.f, 0.f, 0.f};
        cur = nxt; cA = nA; cB = nB; ++ui;
        if constexpr (ALIGN_EPI) { if (wr == 1) PG8_BAR; }
    }
    PG8_WAIT_V(0);
    if constexpr (!ALIGN_EPI) { if (wr == 0) PG8_BAR; }
    PG8_BAR;
    if constexpr (Epi::AFTER_DRAIN) { E.fused(acc, cur, wr, wc, fr, fq, lds, wid, lane); S.done(cur); }
#undef PG8_SA
#undef PG8_SB
#undef PG8_STAGE
#undef PG8_LDA
#undef PG8_LDB
#undef PG8_MMA
#undef PG8_WAIT_V
#undef PG8_WAIT_L
#undef PG8_BAR
#undef PG8_SCHED
}
}
#include <hip/hip_bf16.h>
#include <cmath>
namespace attn_body {
using bf16=__hip_bfloat16;
using bf16x8=__attribute__((ext_vector_type(8)))short;
using s16x4=__attribute__((ext_vector_type(4)))short;
using f32x16=__attribute__((ext_vector_type(16)))float;
using u32x4=__attribute__((ext_vector_type(4)))unsigned;
using f32x4v=__attribute__((ext_vector_type(4)))float;
constexpr int SEQ=4096,D=64,DM=64,OPITCH=1024;
constexpr int LDS_C=98304;
constexpr int NW=8,QBLK=32,QB=QBLK*NW,KVBLK=64,NQB=SEQ/QB;
constexpr int ATTN_UNIT_ROWS=QB;
__device__ __forceinline__ int crow(int r,int hi){return (r&3)+8*(r>>2)+4*hi;}
#define SBAR() __builtin_amdgcn_sched_barrier(0)
__device__ __forceinline__ void cmask(f32x16&p0,f32x16&p1,int jb,int qrel,int hi){
  const float NEG=-INFINITY; int kb=64*jb+4*hi;
  #pragma unroll
  for(int r=0;r<16;++r){int kv=kb+(r&3)+8*(r>>2); if(kv>qrel)p0[r]=NEG; if(kv+32>qrel)p1[r]=NEG;}
}

constexpr int NSLOT=3, SLOTB=8192;
constexpr int LDS_K=0, LDS_V=NSLOT*SLOTB, LDS_WS=2*NSLOT*SLOTB, LDS_OST=LDS_WS+NW*64*4, LDS_BYTES=LDS_OST+NW*4096;
constexpr float C2=0.125f*1.4426950408889634f;
__device__ __forceinline__ void glds16(const void*gsrc,unsigned lds_dst){unsigned keep;
  asm volatile("s_mov_b32 %0, m0\n\ts_mov_b32 m0, %2\n\ts_nop 0\n\tglobal_load_lds_dwordx4 %1, off\n\ts_mov_b32 m0, %0":"=&s"(keep):"v"(gsrc),"s"(lds_dst):"memory");}
__device__ __forceinline__ float max3f(float a,float b,float c){float r;asm("v_max3_f32 %0, %1, %2, %3":"=v"(r):"v"(a),"v"(b),"v"(c));return r;}
__device__ __forceinline__ float max2f(float a,float b){float r;asm("v_max_f32_e32 %0, %1, %2":"=v"(r):"v"(a),"v"(b));return r;}
__device__ __forceinline__ float fadd_s(float a,float b){float r;asm("v_add_f32_e32 %0, %1, %2":"=v"(r):"v"(a),"v"(b));return r;}
__device__ __forceinline__ float fsub_s(float a,float b){float r;asm("v_sub_f32_e32 %0, %1, %2":"=v"(r):"v"(a),"v"(b));return r;}
typedef float f32x2_t __attribute__((ext_vector_type(2))); typedef __bf16 bf16x2_t __attribute__((ext_vector_type(2)));
__device__ __forceinline__ unsigned cvtpk_s(float lo,float hi){f32x2_t v={lo,hi};bf16x2_t b=__builtin_convertvector(v,bf16x2_t);return __builtin_bit_cast(unsigned,b);}
#define WAIT_BAR(N) asm volatile("s_waitcnt vmcnt(" #N ") lgkmcnt(0)\n\ts_barrier":::"memory")

__device__ __forceinline__ void qkt(f32x16&p0,f32x16&p1,const char*Kslot,const bf16x8*qr,const f32x16&negm,int r32,int hi){
  const char*kb=Kslot+hi*1024+r32*16;
  #pragma unroll
  for(int d0=0;d0<4;++d0){
    const bf16x8 b0=*reinterpret_cast<const bf16x8*>(kb+d0*2048);
    const bf16x8 b1=*reinterpret_cast<const bf16x8*>(kb+d0*2048+512);
    if(d0==0){p0=__builtin_amdgcn_mfma_f32_32x32x16_bf16(b0,qr[0],negm,0,0,0);p1=__builtin_amdgcn_mfma_f32_32x32x16_bf16(b1,qr[0],negm,0,0,0);}
    else{p0=__builtin_amdgcn_mfma_f32_32x32x16_bf16(b0,qr[d0],p0,0,0,0);p1=__builtin_amdgcn_mfma_f32_32x32x16_bf16(b1,qr[d0],p1,0,0,0);}}
}
typedef __attribute__((address_space(3))) const char* lds_cptr;
typedef short v4i16_t __attribute__((ext_vector_type(4)));
__device__ __forceinline__ void kload8(bf16x8*kf,lds_cptr kp){
  kf[0]=*(const __attribute__((address_space(3))) bf16x8*)(kp);      kf[1]=*(const __attribute__((address_space(3))) bf16x8*)(kp+512);
  kf[2]=*(const __attribute__((address_space(3))) bf16x8*)(kp+2048); kf[3]=*(const __attribute__((address_space(3))) bf16x8*)(kp+2560);
  kf[4]=*(const __attribute__((address_space(3))) bf16x8*)(kp+4096); kf[5]=*(const __attribute__((address_space(3))) bf16x8*)(kp+4608);
  kf[6]=*(const __attribute__((address_space(3))) bf16x8*)(kp+6144); kf[7]=*(const __attribute__((address_space(3))) bf16x8*)(kp+6656);
}
__device__ __forceinline__ void kload2(bf16x8*kf,lds_cptr kp,int j){ kf[2*j]=*(const __attribute__((address_space(3))) bf16x8*)(kp+j*2048); kf[2*j+1]=*(const __attribute__((address_space(3))) bf16x8*)(kp+j*2048+512); }
__device__ __forceinline__ s16x4 vtr(lds_cptr p){ return __builtin_bit_cast(s16x4,__builtin_amdgcn_ds_read_tr16_b64_v4i16((__attribute__((address_space(3))) v4i16_t*)p)); }
__device__ __forceinline__ float rowmax(const f32x16&p0,const f32x16&p1){
  float a=max3f(p0[0],p0[1],p1[0]),b=max3f(p0[2],p0[3],p1[1]);a=max3f(a,p1[2],p1[3]);
  #pragma unroll
  for(int r=4;r<16;r+=4){a=max3f(a,p0[r],p0[r+1]);b=max3f(b,p0[r+2],p0[r+3]);a=max3f(a,p1[r],p1[r+1]);b=max3f(b,p1[r+2],p1[r+3]);}
  const float m=max2f(a,b);
  auto rr=__builtin_amdgcn_permlane32_swap(__float_as_uint(m),__float_as_uint(m),false,false);
  return max2f(__uint_as_float(rr[0]),__uint_as_float(rr[1]));
}
__device__ __forceinline__ void pv(f32x16*o,int vb,bf16x8 pa0,bf16x8 pa1,bf16x8 pa2,bf16x8 pa3){
  #pragma unroll
  for(int d0=0;d0<2;++d0){s16x4 lo[4],hi[4];
    #pragma unroll
    for(int ks=0;ks<4;++ks){
      asm volatile("ds_read_b64_tr_b16 %0,%1 offset:%c2":"=&v"(lo[ks]):"v"(vb),"i"(d0*4096+ks*1024):"memory");
      asm volatile("ds_read_b64_tr_b16 %0,%1 offset:%c2":"=&v"(hi[ks]):"v"(vb),"i"(d0*4096+ks*1024+512):"memory");}
    asm volatile("s_waitcnt lgkmcnt(0)":::"memory");SBAR();
    #define PK(k) (bf16x8){lo[k][0],lo[k][1],lo[k][2],lo[k][3],hi[k][0],hi[k][1],hi[k][2],hi[k][3]}
    o[d0]=__builtin_amdgcn_mfma_f32_32x32x16_bf16(pa0,PK(0),o[d0],0,0,0);
    o[d0]=__builtin_amdgcn_mfma_f32_32x32x16_bf16(pa1,PK(1),o[d0],0,0,0);
    o[d0]=__builtin_amdgcn_mfma_f32_32x32x16_bf16(pa2,PK(2),o[d0],0,0,0);
    o[d0]=__builtin_amdgcn_mfma_f32_32x32x16_bf16(pa3,PK(3),o[d0],0,0,0);
    #undef PK
  }
}

#ifndef ATTN_STORE16
#define ATTN_STORE16(p,v) (*(u32x4*)(p)=(v))
#endif
template<int THRL,bool BIASON=true> __device__ __forceinline__ void attn_unit(int qb,int jstart,const bf16*Q,const bf16*__restrict__ K,const bf16*__restrict__ V,bf16*O,const float*__restrict__ Cg,char*shm){
  int tid_=threadIdx.x; asm volatile("":"+v"(tid_)); const int tid=tid_,lane=tid&63,r32=lane&31,hi=lane>>5; const int wid=__builtin_amdgcn_readfirstlane(tid>>6);
  const int q0=qb*QB;
  const bf16*Qw=Q+(long)(q0+wid*QBLK)*DM;
  const bf16*Kh=K+(long)jstart*KVBLK*DM,*Vh=V+(long)jstart*KVBLK*DM;
  const lds_cptr shm3=(lds_cptr)shm;
  const unsigned lds0=(unsigned)(uintptr_t)shm;
  float*wsf=(float*)(shm+LDS_WS)+wid*64;
  const bf16*ksrc=Kh+(long)lane*DM+wid*8;
  const bf16*vsrc=Vh+(long)(16*(wid&3)+(lane>>2))*DM+(wid>>2)*32+(lane&3)*8;
  const unsigned kdst=lds0+LDS_K+wid*1024, vdst=lds0+LDS_V+wid*1024;
  #define DMA_K(t,slot) glds16(ksrc+(long)(t)*KVBLK*DM,(unsigned)__builtin_amdgcn_readfirstlane(kdst+(slot)))
  #define DMA_V(t,slot) glds16(vsrc+(long)(t)*KVBLK*DM,(unsigned)__builtin_amdgcn_readfirstlane(vdst+(slot)))
  const int vb0=(int)(lds0+LDS_V)+((lane>>4)&1)*32+(lane&3)*8+(4*hi+((lane&15)>>2))*64;
  const char*Kbase=shm+LDS_K; bf16x8 kf[8];
  const lds_cptr kp0=shm3+LDS_K+hi*1024+r32*16; const lds_cptr vp0=shm3+LDS_V+((lane>>4)&1)*32+(lane&3)*8+(4*hi+((lane&15)>>2))*64;
  const int NT=(q0+QB)/KVBLK-jstart;
  { typedef __attribute__((address_space(3))) f32x4v lf32x4; lf32x4*cl_=(lf32x4*)(shm3+LDS_C); const f32x4v*cg_=(const f32x4v*)(Cg+jstart*KVBLK); const int n4_=(q0+QB-jstart*KVBLK)>>2;
    f32x4v c0_=f32x4v{},c1_=f32x4v{}; if(tid<n4_)c0_=cg_[tid]; if(tid+NW*64<n4_)c1_=cg_[tid+NW*64]; if(tid<n4_)cl_[tid]=c0_; if(tid+NW*64<n4_)cl_[tid+NW*64]=c1_; }
  DMA_K(0,0);DMA_V(0,0);DMA_K(1,SLOTB);
  bf16x8 qr[4];
  #pragma unroll
  for(int d0=0;d0<4;++d0)qr[d0]=*reinterpret_cast<const bf16x8*>(&Qw[(long)r32*DM+d0*16+hi*8]);
  float mhat=0.f,l_reg=0.f;f32x16 o[2];o[0]=f32x16{};o[1]=f32x16{};
  const int qrel=wid*QBLK+r32;
  #define CMASK(P0,P1,t) do{int jb_=(t)-(NT-4); if(jb_>=0)cmask(P0,P1,jb_,qrel,hi);}while(0)
  typedef __attribute__((address_space(3))) const float* lds_fptr; typedef __attribute__((address_space(3))) const f32x4v* lds_f4ptr;
  const lds_fptr cl0=(lds_fptr)(shm3+LDS_C)+4*hi;
  #define BIAS(P0,P1,t) do{ const lds_fptr cb_=cl0+64*(t); _Pragma("unroll") for(int g_=0;g_<4;++g_){ const f32x4v a_=*(lds_f4ptr)(cb_+8*g_), b_=*(lds_f4ptr)(cb_+32+8*g_); \
      _Pragma("unroll") for(int i_=0;i_<4;++i_){P0[4*g_+i_]-=a_[i_];P1[4*g_+i_]-=b_[i_];} } }while(0)
  #define BIASINIT(C0_,C1_,t) do{ const lds_fptr cb_=cl0+64*(t); const float nm_=-mhat; _Pragma("unroll") for(int g_=0;g_<4;++g_){ f32x4v a_=f32x4v{},b_=f32x4v{}; if(BIASON){a_=*(lds_f4ptr)(cb_+8*g_); b_=*(lds_f4ptr)(cb_+32+8*g_);} \
      _Pragma("unroll") for(int i_=0;i_<4;++i_){C0_[4*g_+i_]=nm_-a_[i_];C1_[4*g_+i_]=nm_-b_[i_];} } }while(0)
  bool resc=false;
  #define START(P0,P1) do{ const float rm=rowmax(P0,P1); resc=false; \
    { const float dl=rm; mhat=fadd_s(mhat,dl); \
      _Pragma("unroll") for(int r=0;r<16;++r){P0[r]=fsub_s(P0[r],dl);P1[r]=fsub_s(P1[r],dl);} \
      } \
    _Pragma("unroll") for(int r=0;r<16;++r)P0[r]=__builtin_amdgcn_exp2f(P0[r]); }while(0)
  #define RESC() do{ if(resc){ asm volatile("s_waitcnt lgkmcnt(0)":::"memory"); \
      _Pragma("unroll") for(int d_=0;d_<2;++d_) _Pragma("unroll") for(int r=0;r<16;++r)o[d_][r]*=wsf[crow(r,hi)]; } }while(0)
  f32x16 pA0,pA1,pB0,pB1;
  int sl_prev=0,sl_cur=0,sl_next=SLOTB;
  #define ROT() do{sl_prev=sl_cur;sl_cur=sl_next;sl_next=(sl_next==(NSLOT-1)*SLOTB)?0:sl_next+SLOTB;}while(0)
  DMA_K(2,2*SLOTB);
  WAIT_BAR(3);
  { const f32x16 zero_=f32x16{}; qkt(pA0,pA1,Kbase,qr,zero_,r32,hi); }asm volatile("s_nop 15\n\ts_nop 7":"+v"(pA0),"+v"(pA1));BIAS(pA0,pA1,0);CMASK(pA0,pA1,0);
  START(pA0,pA1);
  BIASINIT(pB0,pB1,1);
  _Pragma("unroll") for(int r=0;r<16;++r)pA1[r]=__builtin_amdgcn_exp2f(pA1[r]);
  WAIT_BAR(0);
  DMA_K(3,0);DMA_V(1,SLOTB);
  ROT();
  kload8(kf,kp0+sl_cur);
  WAIT_BAR(2);
  s16x4 vlo[8],vhi[8]; u32x4 pw0,pw1,pw2,pw3;
  #define PKW(P,B) cvtpk_s(P[B],P[B+1])
  #define PAF(k) __builtin_bit_cast(bf16x8,pw##k)
  #define VFR(i) (bf16x8){vlo[i][0],vlo[i][1],vlo[i][2],vlo[i][3],vhi[i][0],vhi[i][1],vhi[i][2],vhi[i][3]}
  #define PIN(x) asm volatile("":"+v"(x))
  #define MX3(a,b,c) __builtin_fmaxf(__builtin_fmaxf((a),(b)),(c))
  #define GAPA(MF,A0,A1,A2,A3,W0,W1,PW) do{ MF; sacc+=A0; sacc+=A1; sacc+=A2; sacc+=A3; PIN(sacc); W0; W1; PIN(PW); SBAR(); }while(0)
  #define EX(v) __builtin_amdgcn_exp2f(v)
  #define GAPB(MF,X,B) do{ MF; X[B]=EX(X[B]); X[B+1]=EX(X[B+1]); X[B+2]=EX(X[B+2]); X[B+3]=EX(X[B+3]); PIN(X); SBAR(); }while(0)
  #define VRD(i) do{ vlo[i]=vtr(vp_+(((i)>>2)*4096+((i)&3)*1024)); vhi[i]=vtr(vp_+(((i)>>2)*4096+((i)&3)*1024+512)); }while(0)
  #define KRD(G,j) do{ if(G){ kload2(kf,kp0+sl_next,j); SBAR(); } }while(0)
  #define STEP(C0,C1,P0,P1,t,GK,GV,GL) do{ SBAR(); \
    const lds_cptr vp_=vp0+sl_prev; \
    VRD(0); SBAR(); float sacc=(P0[0]+P0[1]); \
    GAPA(C0=__builtin_amdgcn_mfma_f32_32x32x16_bf16(kf[0],qr[0],C0,0,0,0), P0[2],P0[3],P0[4],P0[5],     pw0[0]=PKW(P0,0), pw0[1]=PKW(P0,2), pw0); \
    VRD(4); SBAR(); GAPA(C1=__builtin_amdgcn_mfma_f32_32x32x16_bf16(kf[1],qr[0],C1,0,0,0), P0[6],P0[7],P0[8],P0[9],     pw0[2]=PKW(P0,4), pw0[3]=PKW(P0,6), pw0); \
    VRD(1); SBAR(); GAPA(C0=__builtin_amdgcn_mfma_f32_32x32x16_bf16(kf[2],qr[1],C0,0,0,0),   P0[10],P0[11],P0[12],P0[13], pw1[0]=PKW(P0,8), pw1[1]=PKW(P0,10), pw1); \
    VRD(5); SBAR(); GAPA(C1=__builtin_amdgcn_mfma_f32_32x32x16_bf16(kf[3],qr[1],C1,0,0,0),   P0[14],P0[15],P1[0],P1[1],   pw1[2]=PKW(P0,12),pw1[3]=PKW(P0,14), pw1); \
    VRD(2); SBAR(); GAPA(C0=__builtin_amdgcn_mfma_f32_32x32x16_bf16(kf[4],qr[2],C0,0,0,0),   P1[2],P1[3],P1[4],P1[5],     pw2[0]=PKW(P1,0), pw2[1]=PKW(P1,2), pw2); \
    VRD(6); SBAR(); GAPA(C1=__builtin_amdgcn_mfma_f32_32x32x16_bf16(kf[5],qr[2],C1,0,0,0),   P1[6],P1[7],P1[8],P1[9],     pw2[2]=PKW(P1,4), pw2[3]=PKW(P1,6), pw2); \
    VRD(3); SBAR(); GAPA(C0=__builtin_amdgcn_mfma_f32_32x32x16_bf16(kf[6],qr[3],C0,0,0,0),   P1[10],P1[11],P1[12],P1[13], pw3[0]=PKW(P1,8), pw3[1]=PKW(P1,10), pw3); \
    VRD(7); SBAR(); GAPA(C1=__builtin_amdgcn_mfma_f32_32x32x16_bf16(kf[7],qr[3],C1,0,0,0),   P1[14],P1[15],0.f,0.f,       pw3[2]=PKW(P1,12),pw3[3]=PKW(P1,14), pw3); \
    l_reg+=sacc; \
    if(GK){DMA_K((t)+3,sl_cur);} if(GV){DMA_V((t)+1,sl_next);} \
    CMASK(C0,C1,t); \
    { float a=MX3(C0[0],C0[1],C1[0]),b=MX3(C0[2],C0[3],C1[1]); a=MX3(a,C1[2],C1[3]); \
      _Pragma("unroll") for(int r=4;r<16;r+=4){a=MX3(a,C0[r],C0[r+1]);b=MX3(b,C0[r+2],C0[r+3]);a=MX3(a,C1[r],C1[r+1]);b=MX3(b,C1[r+2],C1[r+3]);} \
      float rm=__builtin_fmaxf(a,b); { auto rr=__builtin_amdgcn_permlane32_swap(__float_as_uint(rm),__float_as_uint(rm),false,false); rm=__builtin_fmaxf(__uint_as_float(rr[0]),__uint_as_float(rr[1])); } \
      resc=false; \
      if(__builtin_expect(__any(rm>(float)THRL),0)){ const float dl=__builtin_fmaxf(rm+30.f,0.f); mhat+=dl; \
        _Pragma("unroll") for(int r=0;r<16;++r){C0[r]-=dl;C1[r]-=dl;} \
        const float f=__builtin_amdgcn_exp2f(-dl); l_reg*=f; if(hi==0)wsf[r32]=f; resc=true; } } \
    SBAR(); \
    GAPB(o[0]=__builtin_amdgcn_mfma_f32_32x32x16_bf16(PAF(0),VFR(0),o[0],0,0,0), C0,0); \
    GAPB(o[1]=__builtin_amdgcn_mfma_f32_32x32x16_bf16(PAF(0),VFR(4),o[1],0,0,0), C0,4); \
    KRD(GL,0); GAPB(o[0]=__builtin_amdgcn_mfma_f32_32x32x16_bf16(PAF(1),VFR(1),o[0],0,0,0), C0,8); \
    KRD(GL,1); GAPB(o[1]=__builtin_amdgcn_mfma_f32_32x32x16_bf16(PAF(1),VFR(5),o[1],0,0,0), C0,12); \
    KRD(GL,2); GAPB(o[0]=__builtin_amdgcn_mfma_f32_32x32x16_bf16(PAF(2),VFR(2),o[0],0,0,0), C1,0); \
    KRD(GL,3); GAPB(o[1]=__builtin_amdgcn_mfma_f32_32x32x16_bf16(PAF(2),VFR(6),o[1],0,0,0), C1,4); \
    GAPB(o[0]=__builtin_amdgcn_mfma_f32_32x32x16_bf16(PAF(3),VFR(3),o[0],0,0,0), C1,8); \
    GAPB(o[1]=__builtin_amdgcn_mfma_f32_32x32x16_bf16(PAF(3),VFR(7),o[1],0,0,0), C1,12); \
    BIASINIT(P0,P1,(t)+1); SBAR(); \
    }while(0)
  int t=1;
  #undef CMASK
  #define CMASK(P0,P1,t) do{}while(0)
  for(;t+5<NT;t+=2){
    STEP(pB0,pB1,pA0,pA1,t,true,true,true);     WAIT_BAR(2); RESC(); ROT();
    STEP(pA0,pA1,pB0,pB1,t+1,true,true,true);   WAIT_BAR(2); RESC(); ROT();
  }
  #undef CMASK
  #define CMASK(P0,P1,t) do{int jb_=(t)-(NT-4); if(jb_>=0)cmask(P0,P1,jb_,qrel,hi);}while(0)
  #define ENDW(tt) do{ if((tt)+3<NT){WAIT_BAR(2);} else if((tt)+2<NT){WAIT_BAR(1);} else {WAIT_BAR(0);} }while(0)
  for(;t+1<NT;t+=2){
    STEP(pB0,pB1,pA0,pA1,t,(t+3<NT),(t+1<NT),(t+1<NT));       ENDW(t);   RESC(); ROT();
    STEP(pA0,pA1,pB0,pB1,t+1,(t+4<NT),(t+2<NT),(t+2<NT));     ENDW(t+1); RESC(); ROT();
  }
  STEP(pB0,pB1,pA0,pA1,NT-1,false,false,false); RESC();
  { float sacc=pB0[0]+pB0[1]; _Pragma("unroll") for(int r=2;r<16;++r)sacc+=pB0[r]; _Pragma("unroll") for(int r=0;r<16;++r)sacc+=pB1[r]; l_reg+=sacc;
    pw0=(u32x4){PKW(pB0,0),PKW(pB0,2),PKW(pB0,4),PKW(pB0,6)};pw1=(u32x4){PKW(pB0,8),PKW(pB0,10),PKW(pB0,12),PKW(pB0,14)};pw2=(u32x4){PKW(pB1,0),PKW(pB1,2),PKW(pB1,4),PKW(pB1,6)};pw3=(u32x4){PKW(pB1,8),PKW(pB1,10),PKW(pB1,12),PKW(pB1,14)};
    SBAR(); pv(o,vb0+sl_cur,PAF(0),PAF(1),PAF(2),PAF(3)); }
  #undef PKW
  #undef PAF
  #undef VFR
  #undef PIN
  #undef MX3
  #undef GAPA
  #undef GAPB
  #undef EX
  #undef VRD
  #undef KRD
  #undef STEP
  #undef ENDW
  {auto rr=__builtin_amdgcn_permlane32_swap(__float_as_uint(l_reg),__float_as_uint(l_reg),false,false);l_reg=__uint_as_float(rr[0])+__uint_as_float(rr[1]);}
  if(hi==0)wsf[32+r32]=l_reg;asm volatile("s_waitcnt lgkmcnt(0)":::"memory");
  float rli[16];
  #pragma unroll
  for(int r=0;r<16;++r)rli[r]=__builtin_amdgcn_rcpf(wsf[32+crow(r,hi)]);
  bf16*Ow=O+(long)(q0+wid*QBLK)*OPITCH;
  { bf16*stg=(bf16*)(shm+LDS_OST)+wid*2048;
    #pragma unroll
    for(int r=0;r<16;++r){const int orow=crow(r,hi);
      #pragma unroll
      for(int d0=0;d0<2;++d0)stg[orow*64+d0*32+r32]=__float2bfloat16(o[d0][r]*rli[r]);}
    asm volatile("s_waitcnt lgkmcnt(0)":::"memory");
    #pragma unroll
    for(int i=0;i<4;++i){const int row=i*8+(lane>>3),ch=lane&7; const u32x4 v=*(const u32x4*)(stg+row*64+ch*8); ATTN_STORE16(Ow+(long)row*OPITCH+ch*8,v);} }
  asm volatile("s_waitcnt lgkmcnt(0)\n\ts_barrier":::"memory");
  #undef DMA_K
  #undef DMA_V
  #undef CMASK
  #undef BIAS
  #undef BIASINIT
  #undef START
  #undef RESC
  #undef ROT
}
constexpr int SB_NS=8, SB_V=65536, SB_FLAGS=131072;
__device__ __forceinline__ void sb_unit(int qb,const bf16*Q,const bf16*__restrict__ K,const bf16*__restrict__ V,bf16*O,char*shm){
  int tid_=threadIdx.x; asm volatile("":"+v"(tid_)); const int tid=tid_,lane=tid&63,r32=lane&31,hi=lane>>5; const int wid=__builtin_amdgcn_readfirstlane(tid>>6);
  const int q0=qb*QB;
  const bf16*Qw=Q+(long)(q0+wid*QBLK)*DM;
  const unsigned lds0=(unsigned)(uintptr_t)shm;
  typedef __attribute__((address_space(3))) int lds_i32; typedef __attribute__((address_space(3))) const u32x4* lds_u4ptr;
  lds_i32*flags=(lds_i32*)((lds_cptr)shm+SB_FLAGS);
  const bf16*ksrc=K+(long)lane*DM+wid*8;
  const bf16*vsrc=V+(long)(16*(wid&3)+(lane>>2))*DM+(wid>>2)*32+(lane&3)*8;
  const unsigned kdst=lds0+wid*1024, vdst=lds0+SB_V+wid*1024;
  #define DMA_K(t,slot) glds16(ksrc+(long)(t)*KVBLK*DM,(unsigned)__builtin_amdgcn_readfirstlane(kdst+(slot)))
  #define DMA_V(t,slot) glds16(vsrc+(long)(t)*KVBLK*DM,(unsigned)__builtin_amdgcn_readfirstlane(vdst+(slot)))
  const int vb0=(int)(lds0+SB_V)+((lane>>4)&1)*32+(lane&3)*8+(4*hi+((lane&15)>>2))*64;
  const int NT=(q0+QB)/KVBLK;
  bf16x8 qr[4];
  #pragma unroll
  for(int d0=0;d0<4;++d0)qr[d0]=*reinterpret_cast<const bf16x8*>(&Qw[(long)r32*DM+d0*16+hi*8]);
  f32x16 o[2];o[0]=f32x16{};o[1]=f32x16{};
  float T=1.0f; const int t_abs=q0+wid*QBLK+r32; bool wdone=false;
  for(int jtop=NT-1;;jtop-=SB_NS){
    const int nb=(jtop+1<SB_NS)?jtop+1:SB_NS;
    for(int s=0;s<nb;++s){DMA_K(jtop-s,s*SLOTB);DMA_V(jtop-s,s*SLOTB);}
    WAIT_BAR(0);
    int s=(jtop==NT-1)?3-(wid>>1):0;
    for(;s<nb&&!wdone;++s){
      const int jt=jtop-s; const int slot=s*SLOTB; const bool band=(jt>=NT-4);
      f32x16 x0,x1; { f32x16 zero=f32x16{}; qkt(x0,x1,shm+slot,qr,zero,r32,hi); }
      f32x16 n0,n1;
      const int kb=64*jt+4*hi;
      #pragma unroll
      for(int r=0;r<16;++r){
        const float z0=x0[r],z1=x1[r];
        const float e0=__builtin_amdgcn_exp2f(-__builtin_fabsf(z0)), e1=__builtin_amdgcn_exp2f(-__builtin_fabsf(z1));
        const float r0=__builtin_amdgcn_rcpf(1.0f+e0), r1=__builtin_amdgcn_rcpf(1.0f+e1), er0=e0*r0, er1=e1*r1;
        float b0=z0>0.f?r0:er0, m0=z0>0.f?er0:r0, b1=z1>0.f?r1:er1, m1=z1>0.f?er1:r1;
        if(band){ const int kv=kb+(r&3)+8*(r>>2); if(!(kv<t_abs)){b0=0.f;m0=1.f;} if(!(kv+32<t_abs)){b1=0.f;m1=1.f;} }
        x0[r]=b0;x1[r]=b1;n0[r]=m0;n1[r]=m1;
      }
      float g0[4],g1[4],p0s[4],p1s[4];
      #pragma unroll
      for(int a=0;a<4;++a){ g0[a]=(n0[4*a]*n0[4*a+1])*(n0[4*a+2]*n0[4*a+3]); g1[a]=(n1[4*a]*n1[4*a+1])*(n1[4*a+2]*n1[4*a+3]);
        { auto rr=__builtin_amdgcn_permlane32_swap(__float_as_uint(g0[a]),__float_as_uint(g0[a]),false,false); p0s[a]=__uint_as_float(hi?rr[0]:rr[1]); }
        { auto rr=__builtin_amdgcn_permlane32_swap(__float_as_uint(g1[a]),__float_as_uint(g1[a]),false,false); p1s[a]=__uint_as_float(hi?rr[0]:rr[1]); } }
      float run=T;
      #pragma unroll
      for(int a=3;a>=0;--a){ const float off=hi?run:run*p1s[a]; run*=g1[a]*p1s[a];
        const float t3=off,t2=t3*n1[4*a+3],t1=t2*n1[4*a+2],t0=t1*n1[4*a+1];
        x1[4*a+3]*=t3; x1[4*a+2]*=t2; x1[4*a+1]*=t1; x1[4*a]*=t0; }
      #pragma unroll
      for(int a=3;a>=0;--a){ const float off=hi?run:run*p0s[a]; run*=g0[a]*p0s[a];
        const float t3=off,t2=t3*n0[4*a+3],t1=t2*n0[4*a+2],t0=t1*n0[4*a+1];
        x0[4*a+3]*=t3; x0[4*a+2]*=t2; x0[4*a+1]*=t1; x0[4*a]*=t0; }
      T=run;
      u32x4 pw0,pw1,pw2,pw3;
      pw0=(u32x4){cvtpk_s(x0[0],x0[1]),cvtpk_s(x0[2],x0[3]),cvtpk_s(x0[4],x0[5]),cvtpk_s(x0[6],x0[7])};
      pw1=(u32x4){cvtpk_s(x0[8],x0[9]),cvtpk_s(x0[10],x0[11]),cvtpk_s(x0[12],x0[13]),cvtpk_s(x0[14],x0[15])};
      pw2=(u32x4){cvtpk_s(x1[0],x1[1]),cvtpk_s(x1[2],x1[3]),cvtpk_s(x1[4],x1[5]),cvtpk_s(x1[6],x1[7])};
      pw3=(u32x4){cvtpk_s(x1[8],x1[9]),cvtpk_s(x1[10],x1[11]),cvtpk_s(x1[12],x1[13]),cvtpk_s(x1[14],x1[15])};
      SBAR(); pv(o,vb0+slot,__builtin_bit_cast(bf16x8,pw0),__builtin_bit_cast(bf16x8,pw1),__builtin_bit_cast(bf16x8,pw2),__builtin_bit_cast(bf16x8,pw3));
      wdone=__all(T<1.2e-38f);
    }
    if(lane==0)flags[wid]=wdone?1:0;
    WAIT_BAR(0);
    const u32x4 f0=*(lds_u4ptr)(flags), f1=*(lds_u4ptr)(flags+4);
    const bool alld=((f0.x&f0.y&f0.z&f0.w)&(f1.x&f1.y&f1.z&f1.w))!=0;
    if(alld||jtop<SB_NS)break;
    WAIT_BAR(0);
  }
  bf16*Ow=O+(long)(q0+wid*QBLK)*OPITCH;
  { bf16*stg=(bf16*)(shm)+wid*2048;
    #pragma unroll
    for(int r=0;r<16;++r){const int orow=crow(r,hi);
      #pragma unroll
      for(int d0=0;d0<2;++d0)stg[orow*64+d0*32+r32]=__float2bfloat16(o[d0][r]);}
    asm volatile("s_waitcnt lgkmcnt(0)":::"memory");
    #pragma unroll
    for(int i=0;i<4;++i){const int row=i*8+(lane>>3),ch=lane&7; const u32x4 v=*(const u32x4*)(stg+row*64+ch*8); ATTN_STORE16(Ow+(long)row*OPITCH+ch*8,v);} }
  asm volatile("s_waitcnt lgkmcnt(0)\n\ts_barrier":::"memory");
  #undef DMA_K
  #undef DMA_V
}
#undef SBAR
#undef WAIT_BAR
}

constexpr int BATCH = 8, SEQ = 4096, DM = 1024, DEPTH = 4, M = BATCH * SEQ, INC = 3334, NIN = 3584, DFF = 4096;
constexpr float EPS = 1e-6f;
constexpr size_t MiB = 1u << 20;
constexpr size_t WS_BAR = 128 * 1024;
constexpr size_t WS_SS = 1 * MiB;
constexpr size_t WS_LB = 3 * MiB;
constexpr size_t WS_JS = 3 * MiB + 256 * 1024;
constexpr size_t WS_DD = 3 * MiB + 512 * 1024;
constexpr size_t WS_W = 4 * MiB;
constexpr size_t W_LAYER = 25 * MiB, W_OUT = 7 * MiB, W_1 = 9 * MiB, W_2 = 17 * MiB;
constexpr size_t WS_XB = 104 * MiB;
constexpr size_t WS_P = 168 * MiB;
constexpr size_t P_HQ = 0, P_HK = 16 * MiB, P_HI = 32 * MiB, P_HG = 48 * MiB, P_HLF = 64 * MiB, P_SQ = 96 * MiB, P_FQ = 168 * MiB, P_LF = 240 * MiB, P_CC = 241 * MiB, P_US = 242 * MiB;
constexpr size_t HEADBUF = 24 * MiB;
constexpr size_t WS_MIX = 442 * MiB;
constexpr size_t WS_U = 168 * MiB;
constexpr size_t WS_END = 506 * MiB;
constexpr int LDS_BYTES = 147456;

typedef pg8::bf16_t bf16_t;
typedef pg8::f32x4 f32x4;
typedef unsigned u32x4 __attribute__((ext_vector_type(4)));
typedef unsigned u32x2 __attribute__((ext_vector_type(2)));
#define LAS __attribute__((address_space(3)))

__device__ __forceinline__ unsigned f2bf(float f) { unsigned u = __builtin_bit_cast(unsigned, f); return (u + 0x7fffu + ((u >> 16) & 1u)) >> 16; }
__device__ __forceinline__ unsigned pk2(float lo, float hi) { return pg8::cvt_pk_bf16(lo, hi); }
typedef float pk_f32x2 __attribute__((ext_vector_type(2))); typedef __bf16 pk_bf16x2 __attribute__((ext_vector_type(2)));
__device__ __forceinline__ unsigned pk2v(float lo, float hi) { const pk_f32x2 v = {lo, hi}; return __builtin_bit_cast(unsigned, __builtin_convertvector(v, pk_bf16x2)); }
__device__ __forceinline__ float bf2f(unsigned short b) { return __builtin_bit_cast(float, (unsigned)b << 16); }
__device__ __forceinline__ float bflo(unsigned w) { return __builtin_bit_cast(float, w << 16); }
__device__ __forceinline__ float bfhi(unsigned w) { return __builtin_bit_cast(float, w & 0xffff0000u); }
__device__ __forceinline__ float logsig(float x) { return fminf(x, 0.f) - log1pf(expf(-fabsf(x))); }
__device__ __forceinline__ float wave_sum(float v) {
#pragma unroll
    for (int o = 1; o < 64; o <<= 1) v += __shfl_xor(v, o);
    return v;
}
#define ROWSCALES8(rs, ss, row0, fq) float rs[2][4]; _Pragma("unroll") for (int ai_ = 0; ai_ < 2; ++ai_) _Pragma("unroll") for (int m_ = 0; m_ < 4; ++m_) rs[ai_][m_] = rowscale(ss, (row0) + ai_ * 128 + m_ * 16, fq);
__device__ __forceinline__ float rowscale(const float* ss, int row, int fq) {
    const f32x4 p = *(const f32x4*)(ss + (size_t)row * 16 + 4 * fq);
    float s = (p[0] + p[1]) + (p[2] + p[3]);
    s += __shfl_xor(s, 16); s += __shfl_xor(s, 32);
    return rsqrtf(s * (1.0f / DM) + EPS);
}

#define ROWFENCE() asm volatile("" ::: "memory")
struct EpiResid {
    static constexpr bool PERM = true, AFTER_DRAIN = false;
    bf16_t* xb; float* outf; float* ss;
    __device__ __forceinline__ void operator()(const f32x4 (&acc)[2][2][4][2], const pg8::Unit& u, int wr, int wc, int fr, int fq) const {
        const int row0 = u.pm * 256 + wr * 64 + fr, col0 = u.pn * 256 + wc * 32 + 8 * fq;
#pragma unroll
        for (int ai = 0; ai < 2; ++ai) {
            u32x4 pre[4][2];
#pragma unroll
            for (int m = 0; m < 4; ++m)
#pragma unroll
                for (int bj = 0; bj < 2; ++bj) pre[m][bj] = *(const u32x4*)(xb + (size_t)(row0 + ai * 128 + m * 16) * DM + col0 + bj * 128);
#pragma unroll
            for (int m = 0; m < 4; ++m) {
                const int row = row0 + ai * 128 + m * 16; float sq = 0.f;
#pragma unroll
                for (int bj = 0; bj < 2; ++bj) {
                    const size_t off = (size_t)row * DM + col0 + bj * 128; const u32x4 p = pre[m][bj];
                    const f32x4 v0 = acc[ai][bj][m][0] + (f32x4){bflo(p.x), bfhi(p.x), bflo(p.y), bfhi(p.y)}, v1 = acc[ai][bj][m][1] + (f32x4){bflo(p.z), bfhi(p.z), bflo(p.w), bfhi(p.w)};
                    if (outf) { *(f32x4*)(outf + off) = v0; *(f32x4*)(outf + off + 4) = v1; }
                    else {
                        u32x4 w; w.x = pk2(v0[0], v0[1]); w.y = pk2(v0[2], v0[3]); w.z = pk2(v1[0], v1[1]); w.w = pk2(v1[2], v1[3]);
                        *(u32x4*)(xb + off) = w;
                        sq += (v0[0] * v0[0] + v0[1] * v0[1]) + (v0[2] * v0[2] + v0[3] * v0[3]) + (v1[0] * v1[0] + v1[1] * v1[1]) + (v1[2] * v1[2] + v1[3] * v1[3]);
                    }
                }
                if (!outf) {
                    sq += __shfl_xor(sq, 16); sq += __shfl_xor(sq, 32);
                    if (fq == 0) ss[(size_t)row * 16 + u.pn * 4 + wc] = sq;
                }
            }
            ROWFENCE();
        }
    }
};
struct EpiRelu2 {
    static constexpr bool PERM = true, AFTER_DRAIN = false;
    bf16_t* U; const float* ss;
    __device__ __forceinline__ void operator()(const f32x4 (&acc)[2][2][4][2], const pg8::Unit& u, int wr, int wc, int fr, int fq) const {
        const int row0 = u.pm * 256 + wr * 64 + fr, col0 = u.pn * 256 + wc * 32 + 8 * fq;
        ROWSCALES8(rs8, ss, row0, fq)
#pragma unroll
        for (int ai = 0; ai < 2; ++ai)
#pragma unroll
            for (int m = 0; m < 4; ++m) {
                const int row = row0 + ai * 128 + m * 16; const float rs = rs8[ai][m];
#pragma unroll
                for (int bj = 0; bj < 2; ++bj) {
                    f32x4 v0 = acc[ai][bj][m][0] * rs, v1 = acc[ai][bj][m][1] * rs;
                    v0 = __builtin_elementwise_max(v0, (f32x4){0.f, 0.f, 0.f, 0.f}); v1 = __builtin_elementwise_max(v1, (f32x4){0.f, 0.f, 0.f, 0.f});
                    v0 = v0 * v0; v1 = v1 * v1;
                    u32x4 w; w.x = pk2(v0[0], v0[1]); w.y = pk2(v0[2], v0[3]); w.z = pk2(v1[0], v1[1]); w.w = pk2(v1[2], v1[3]);
                    *(u32x4*)(U + (size_t)row * DFF + col0 + bj * 128) = w;
                }
                ROWFENCE();
            }
    }
};
struct EpiInProj {
    static constexpr bool PERM = true, AFTER_DRAIN = false;
    const float* ss; unsigned char* P; const float* lbt;
    const float* gt; const float* fbias;
    __device__ __forceinline__ void operator()(const f32x4 (&acc)[2][2][4][2], const pg8::Unit& u, int wr, int wc, int fr, int fq) const {
        const int slot = u.pn * 4 + wc;
        if (slot > 52) return;
        const int row0 = u.pm * 256 + wr * 64 + fr;
        ROWSCALES8(rs8, ss, row0, fq)
        if (slot < 16) {
            const int kind = slot >> 2, cb = (slot & 3) * 64 + 8 * fq;
            if (kind == 1) {
                float* HLF = (float*)(P + P_HLF); bf16_t* HK = (bf16_t*)(P + P_HK);
#pragma unroll
                for (int ai = 0; ai < 2; ++ai)
#pragma unroll
                    for (int m = 0; m < 4; ++m) {
                        const int row = row0 + ai * 128 + m * 16; const float rs = rs8[ai][m];
#pragma unroll
                        for (int bj = 0; bj < 2; ++bj) {
                            float lf[8], kk[8];
#pragma unroll
                            for (int n = 0; n < 2; ++n) {
                                const f32x4 ll = *(const f32x4*)(lbt + cb + 32 * bj + 4 * n), om = *(const f32x4*)(lbt + 256 + cb + 32 * bj + 4 * n);
#pragma unroll
                                for (int i = 0; i < 4; ++i) {
                                    const float fl = acc[ai][bj][m][n][i] * rs;
                                    const float a = fminf(fl, 0.f) - __logf(1.0f + __expf(-fabsf(fl)));
                                    const float an = a - fl;
                                    const float b = ll[i] + an;
                                    lf[4 * n + i] = fmaxf(a, b) + __logf(1.0f + __expf(-fabsf(a - b)));
                                    kk[4 * n + i] = om[i] * __expf(an);
                                }
                            }
                            const size_t off = (size_t)row * 256 + cb + 32 * bj;
                            *(f32x4*)(HLF + off) = (f32x4){lf[0], lf[1], lf[2], lf[3]}; *(f32x4*)(HLF + off + 4) = (f32x4){lf[4], lf[5], lf[6], lf[7]};
                            u32x4 w; w.x = pk2(kk[0], kk[1]); w.y = pk2(kk[2], kk[3]); w.z = pk2(kk[4], kk[5]); w.w = pk2(kk[6], kk[7]);
                            *(u32x4*)(HK + off) = w;
                        }
                        ROWFENCE();
                    }
            } else {
                bf16_t* dst = (bf16_t*)(P + (kind == 0 ? P_HQ : (kind == 2 ? P_HI : P_HG)));
#pragma unroll
                for (int ai = 0; ai < 2; ++ai)
#pragma unroll
                    for (int m = 0; m < 4; ++m) {
                        const int row = row0 + ai * 128 + m * 16; const float rs = rs8[ai][m];
#pragma unroll
                        for (int bj = 0; bj < 2; ++bj) {
                            const f32x4 v0 = acc[ai][bj][m][0] * rs, v1 = acc[ai][bj][m][1] * rs;
                            u32x4 w; w.x = pk2(v0[0], v0[1]); w.y = pk2(v0[2], v0[3]); w.z = pk2(v1[0], v1[1]); w.w = pk2(v1[2], v1[3]);
                            *(u32x4*)(dst + (size_t)row * 256 + cb + 32 * bj) = w;
                        }
                        ROWFENCE();
                    }
            }
        } else if (slot < 52) {
            const int s2 = slot - 16, grp = s2 / 6, h = s2 % 6, role = grp % 3;
            bf16_t* dst = (bf16_t*)(P + P_SQ + (size_t)grp * HEADBUF) + (size_t)((u.pm >> 4) * 6 + h) * SEQ * 64 + 8 * fq;
            const float* gp = gt + (grp - (grp >= 3 ? 1 : 0)) * 64 + 8 * fq;
            const float qs = (role == 0) ? 0.125f * 1.4426950408889634f : 1.0f;
            f32x4 gv[2][2];
#pragma unroll
            for (int bj = 0; bj < 2; ++bj)
#pragma unroll
                for (int n = 0; n < 2; ++n) gv[bj][n] = (role != 2) ? *(const f32x4*)(gp + 32 * bj + 4 * n) * qs : (f32x4){1.f, 1.f, 1.f, 1.f};
#pragma unroll
            for (int ai = 0; ai < 2; ++ai)
#pragma unroll
                for (int m = 0; m < 4; ++m) {
                    const int row = row0 + ai * 128 + m * 16; const float rs = rs8[ai][m];
                    float fac = rs;
                    if (role != 2) {
                        float sq = 0.f;
#pragma unroll
                        for (int bj = 0; bj < 2; ++bj)
#pragma unroll
                            for (int n = 0; n < 2; ++n) { const f32x4 x = acc[ai][bj][m][n]; sq += (x[0] * x[0] + x[1] * x[1]) + (x[2] * x[2] + x[3] * x[3]); }
                        sq += __shfl_xor(sq, 16); sq += __shfl_xor(sq, 32);
                        fac = rs * rsqrtf(rs * rs * sq * (1.0f / 64.0f) + EPS);
                    }
                    const int t = row & (SEQ - 1);
#pragma unroll
                    for (int bj = 0; bj < 2; ++bj) {
                        const f32x4 v0 = acc[ai][bj][m][0] * fac * gv[bj][0], v1 = acc[ai][bj][m][1] * fac * gv[bj][1];
                        u32x4 w; w.x = pk2(v0[0], v0[1]); w.y = pk2(v0[2], v0[3]); w.z = pk2(v1[0], v1[1]); w.w = pk2(v1[2], v1[3]);
                        *(u32x4*)(dst + (size_t)t * 64 + 32 * bj) = w;
                    }
                    ROWFENCE();
                }
        } else {
            float* LF = (float*)(P + P_LF);
#pragma unroll
            for (int ai = 0; ai < 2; ++ai)
#pragma unroll
                for (int m = 0; m < 4; ++m) {
                    const int row = row0 + ai * 128 + m * 16; const float rs = rs8[ai][m];
                    if (fq == 0) {
                        const f32x4 a0 = acc[ai][0][m][0], a1 = acc[ai][0][m][1];
                        *(f32x4*)(LF + (size_t)row * 8) = (f32x4){logsig(a0[0] * rs + fbias[0]), logsig(a0[1] * rs + fbias[1]), logsig(a0[2] * rs + fbias[2]), logsig(a0[3] * rs + fbias[3])};
                        *(f32x4*)(LF + (size_t)row * 8 + 4) = (f32x4){logsig(a1[0] * rs + fbias[4]), logsig(a1[1] * rs + fbias[5]), 0.f, 0.f};
                    }
                    ROWFENCE();
                }
        }
    }
};
#define XB_TMO      128
#define XB_XCNT(j)  (256  + 64 * (j))
#define XB_XSUB(j)  (1280 + 64 * (j))
#define XB_XGEN(j)  (2304 + 64 * (j))
#define XB_TOP      3328
#define XB_TOPGEN   3392
#define XCD_BAR_WORDS 3456
#define XB_SPIN_CAP (1u << 18)

__device__ __forceinline__ unsigned xb_ld(unsigned* p)              { return __hip_atomic_load(p, __ATOMIC_RELAXED, __HIP_MEMORY_SCOPE_AGENT); }
__device__ __forceinline__ unsigned xb_add(unsigned* p, unsigned v) { return __hip_atomic_fetch_add(p, v, __ATOMIC_RELAXED, __HIP_MEMORY_SCOPE_AGENT); }
__device__ __forceinline__ unsigned xb_xcc_id() { return (unsigned)__builtin_amdgcn_s_getreg((3 << 11) | 20) & 0xFu; }
#define XB_SPIN(cond, bar) do { unsigned _sp = 0; while (cond) { __builtin_amdgcn_s_sleep(1); \
    if ((++_sp & 255u) == 0u) { if (xb_ld(&(bar)[XB_TMO])) break; if (_sp > XB_SPIN_CAP) { atomicAdd(&(bar)[XB_TMO], 1u); break; } } } } while (0)

struct XcdBarrier {
    unsigned* bar; unsigned x;
    volatile LAS unsigned* st;
};

__device__ __forceinline__ XcdBarrier xcd_barrier_post(unsigned* bar, volatile LAS unsigned* st) {
    XcdBarrier b; b.bar = bar; b.x = xb_xcc_id(); b.st = st;
    if (threadIdx.x == 0) (void)xb_add(&bar[XB_XCNT(b.x)], 1u);
    return b;
}
__device__ __forceinline__ void xcd_barrier_complete(unsigned* bar, unsigned x, unsigned& nloc, unsigned& nx) {
    const unsigned G = gridDim.x * gridDim.y * gridDim.z;
    unsigned sum, cnt, mine, sp = 0u;
    for (;;) {
        sum = 0u; cnt = 0u; mine = 0u;
#pragma unroll
        for (unsigned j = 0; j < 16; ++j) { const unsigned c = xb_ld(&bar[XB_XCNT(j)]); sum += c; cnt += (c > 0u) ? 1u : 0u; mine = (j == x) ? c : mine; }
        if (sum == G) break;
        __builtin_amdgcn_s_sleep(1);
        if ((++sp & 255u) == 0u) { if (xb_ld(&bar[XB_TMO])) break; if (sp > XB_SPIN_CAP) { atomicAdd(&bar[XB_TMO], 1u); break; } }
    }
    nloc = mine > 0u ? mine : 1u; nx = cnt > 0u ? cnt : 1u;
}

__device__ __forceinline__ void xcd_barrier(const XcdBarrier& b) {
    asm volatile("s_waitcnt vmcnt(0)" ::: "memory");
    __syncthreads();
    if (threadIdx.x == 0) {
        unsigned* bar = b.bar;
        __builtin_amdgcn_s_waitcnt(0);
        unsigned nloc = b.st[0], nx = b.st[1];
        if (nloc == 0u) { xcd_barrier_complete(bar, b.x, nloc, nx); b.st[0] = nloc; b.st[1] = nx; }
        const unsigned old = xb_add(&bar[XB_XSUB(b.x)], 1u);
        const unsigned gen = old / nloc;
        if (old + 1u == (gen + 1u) * nloc) {
            __builtin_amdgcn_fence(__ATOMIC_RELEASE, "agent");
            asm volatile("s_waitcnt vmcnt(0)" ::: "memory");
            const unsigned og = xb_add(&bar[XB_TOP], 1u);
            const unsigned tg = og / nx;
            if (og + 1u == (tg + 1u) * nx) xb_add(&bar[XB_TOPGEN], 1u);
            else XB_SPIN(xb_ld(&bar[XB_TOPGEN]) == tg, bar);
            __builtin_amdgcn_fence(__ATOMIC_ACQUIRE, "agent");
            xb_add(&bar[XB_XGEN(b.x)], 1u);
            asm volatile("s_waitcnt vmcnt(0)" ::: "memory");
        } else {
            XB_SPIN(xb_ld(&bar[XB_XGEN(b.x)]) == gen, bar);
            __builtin_amdgcn_fence(__ATOMIC_ACQUIRE, "agent");
            asm volatile("s_waitcnt vmcnt(0)" ::: "memory");
        }
    }
    __syncthreads();
}

typedef float f32x4u __attribute__((ext_vector_type(4), aligned(4)));
__device__ __forceinline__ void tr_item(const float* W, int ldw, int ncols_valid, int src_col0, int k0, const float* gain, bf16_t* WT, int K, int n0, LAS float* scr, int lane) {
    if (src_col0 + 32 <= ncols_valid) {
        const int rr = lane >> 3, c4 = (lane & 7) * 4;
        f32x4u v[8];
#pragma unroll
        for (int i = 0; i < 8; ++i) v[i] = *(const f32x4u*)(W + (size_t)(k0 + 8 * i + rr) * ldw + src_col0 + c4);
#pragma unroll
        for (int i = 0; i < 8; ++i) { LAS float* d = scr + (8 * i + rr) * 33 + c4; d[0] = v[i][0]; d[1] = v[i][1]; d[2] = v[i][2]; d[3] = v[i][3]; }
    } else {
#pragma unroll 8
        for (int i = 0; i < 32; ++i) { const int kk = 2 * i + (lane >> 5), c = src_col0 + (lane & 31);
            scr[kk * 33 + (lane & 31)] = (c < ncols_valid) ? W[(size_t)(k0 + kk) * ldw + c] : 0.f; }
    }
    asm volatile("s_waitcnt lgkmcnt(0)" ::: "memory");
    const int c = lane & 7;
    float gv[8];
#pragma unroll
    for (int j = 0; j < 8; ++j) gv[j] = gain ? gain[k0 + 8 * c + j] : 1.0f;
#pragma unroll
    for (int j = 0; j < 4; ++j) { const int n = (lane >> 3) + 8 * j; const LAS float* sp = scr + (8 * c) * 33 + n;
        u32x4 o; o.x = pk2(sp[0 * 33] * gv[0], sp[1 * 33] * gv[1]); o.y = pk2(sp[2 * 33] * gv[2], sp[3 * 33] * gv[3]); o.z = pk2(sp[4 * 33] * gv[4], sp[5 * 33] * gv[5]); o.w = pk2(sp[6 * 33] * gv[6], sp[7 * 33] * gv[7]);
        *(u32x4*)(WT + (size_t)(n0 + n) * K + k0 + 8 * c) = o; }
    asm volatile("s_waitcnt lgkmcnt(0)" ::: "memory");
}

__device__ __forceinline__ void unpack8(const u32x4 w, float* d) { d[0] = bflo(w.x); d[1] = bfhi(w.x); d[2] = bflo(w.y); d[3] = bfhi(w.y); d[4] = bflo(w.z); d[5] = bfhi(w.z); d[6] = bflo(w.w); d[7] = bfhi(w.w); }

__device__ __forceinline__ void fox_cumsum_item(int bh, const float* LF, float* CC, int* JS, const float* gq, const float* gk, LAS float* sc) {
    int tid_ = threadIdx.x; asm volatile("" : "+v"(tid_)); const int tid = tid_, lane = tid & 63, wave = tid >> 6, b = bh / 6, h = bh % 6;
    float v[8]; float run = 0.f;
#pragma unroll
    for (int i = 0; i < 8; ++i) { run += LF[((size_t)b * SEQ + tid * 8 + i) * 8 + h]; v[i] = run; }
    float s = run;
#pragma unroll
    for (int o = 1; o < 64; o <<= 1) { const float n = __shfl_up(s, o); if (lane >= o) s += n; }
    __syncthreads();
    if (lane == 63) sc[wave] = s;
    __syncthreads();
    float base = s - run;
    for (int w = 0; w < wave; ++w) base += sc[w];
    LAS float* cl = sc + 64;
#pragma unroll
    for (int i = 0; i < 8; ++i) { const float c2 = (v[i] + base) * 1.4426950408889634f; CC[(size_t)bh * SEQ + tid * 8 + i] = c2; cl[tid * 8 + i] = c2; }
    __syncthreads();
    if (tid < 16) {
        float mq = 0.f, mk = 0.f;
        for (int d = 0; d < 64; ++d) { mq = fmaxf(mq, fabsf(gq[d])); mk = fmaxf(mk, fabsf(gk[d])); }
        const float zb = 1.4426950408889634f * 8.0f * mq * mk * 1.03f + 1.0f;
        const float thr = -(126.0f + 2.0f * zb);
        const int q0 = tid * 256, nt = q0 / 64 + 4; const float cq = cl[q0];
        int j = 0; while (j < nt - 4 && cq - cl[64 * j + 63] < thr) ++j;
        JS[bh * 16 + tid] = j & ~1;
    }
    __syncthreads();
}

__device__ __forceinline__ void stage_kv(const bf16_t* Kb, const bf16_t* Vb, int kt, LAS float* Kf, LAS float* Vf) {
    int tid_ = threadIdx.x; asm volatile("" : "+v"(tid_)); const int tid = tid_, key = tid >> 3, c8 = tid & 7;
    const u32x4 kw = *(const u32x4*)(Kb + ((size_t)(kt * 64 + key)) * 64 + c8 * 8), vw = *(const u32x4*)(Vb + ((size_t)(kt * 64 + key)) * 64 + c8 * 8);
    float kf[8], vf[8]; unpack8(kw, kf); unpack8(vw, vf);
    *(LAS f32x4*)(Kf + key * 64 + c8 * 8) = (f32x4){kf[0], kf[1], kf[2], kf[3]}; *(LAS f32x4*)(Kf + key * 64 + c8 * 8 + 4) = (f32x4){kf[4], kf[5], kf[6], kf[7]};
    *(LAS f32x4*)(Vf + key * 64 + c8 * 8) = (f32x4){vf[0], vf[1], vf[2], vf[3]}; *(LAS f32x4*)(Vf + key * 64 + c8 * 8 + 4) = (f32x4){vf[4], vf[5], vf[6], vf[7]};
}

__device__ __forceinline__ void fox_naive_item(int item, unsigned char* P, bf16_t* MIX, LAS float* lds) {
    int tid_ = threadIdx.x; asm volatile("" : "+v"(tid_)); const int tid = tid_, bh = item >> 3, qblk = item & 7, b = bh / 6, h = bh % 6, t = qblk * 512 + tid;
    const bf16_t* Qp = (const bf16_t*)(P + P_FQ) + ((size_t)bh * SEQ + t) * 64;
    const bf16_t* Kb = (const bf16_t*)(P + P_FQ + HEADBUF) + (size_t)bh * SEQ * 64;
    const bf16_t* Vb = (const bf16_t*)(P + P_FQ + 2 * HEADBUF) + (size_t)bh * SEQ * 64;
    const float* CC = (const float*)(P + P_CC) + (size_t)bh * SEQ;
    float q[64], o[64];
#pragma unroll
    for (int c = 0; c < 8; ++c) unpack8(*(const u32x4*)(Qp + c * 8), q + c * 8);
#pragma unroll
    for (int d = 0; d < 64; ++d) o[d] = 0.f;
    float m = -1e30f, l = 0.f; const float ct = CC[t];
    LAS float* Kf = lds; LAS float* Vf = lds + 4096; LAS float* cs = lds + 8192;
    const int ntile = (qblk + 1) * 8;
    for (int kt = 0; kt < ntile; ++kt) {
        __syncthreads();
        stage_kv(Kb, Vb, kt, Kf, Vf); if (tid < 64) cs[tid] = CC[kt * 64 + tid];
        __syncthreads();
        for (int s = 0; s < 64; ++s) {
            float z = 0.f;
#pragma unroll
            for (int d = 0; d < 64; ++d) z += q[d] * Kf[s * 64 + d];
            const float x = (kt * 64 + s <= t) ? z + (ct - cs[s]) : -1e30f;
            const float mn = fmaxf(m, x), sc = __expf(m - mn), p = __expf(x - mn);
            l = l * sc + p;
#pragma unroll
            for (int d = 0; d < 64; ++d) o[d] = o[d] * sc + p * Vf[s * 64 + d];
            m = mn;
        }
    }
    const float inv = 1.0f / l;
    bf16_t* op = MIX + ((size_t)b * SEQ + t) * DM + 640 + h * 64;
#pragma unroll
    for (int c = 0; c < 8; ++c) { u32x4 w; w.x = pk2(o[c * 8] * inv, o[c * 8 + 1] * inv); w.y = pk2(o[c * 8 + 2] * inv, o[c * 8 + 3] * inv); w.z = pk2(o[c * 8 + 4] * inv, o[c * 8 + 5] * inv); w.w = pk2(o[c * 8 + 6] * inv, o[c * 8 + 7] * inv); *(u32x4*)(op + c * 8) = w; }
}

__device__ __forceinline__ void sb_naive_item(int item, unsigned char* P, bf16_t* MIX, LAS float* lds) {
    int tid_ = threadIdx.x; asm volatile("" : "+v"(tid_)); const int tid = tid_, bh = item >> 3, qblk = item & 7, b = bh / 6, h = bh % 6, t = qblk * 512 + tid;
    const bf16_t* Qp = (const bf16_t*)(P + P_SQ) + ((size_t)bh * SEQ + t) * 64;
    const bf16_t* Kb = (const bf16_t*)(P + P_SQ + HEADBUF) + (size_t)bh * SEQ * 64;
    const bf16_t* Vb = (const bf16_t*)(P + P_SQ + 2 * HEADBUF) + (size_t)bh * SEQ * 64;
    float q[64], o[64];
#pragma unroll
    for (int c = 0; c < 8; ++c) unpack8(*(const u32x4*)(Qp + c * 8), q + c * 8);
#pragma unroll
    for (int d = 0; d < 64; ++d) o[d] = 0.f;
    float tail = 0.f;
    LAS float* Kf = lds; LAS float* Vf = lds + 4096;
    for (int kt = qblk * 8 + 7; kt >= 0; --kt) {
        __syncthreads();
        stage_kv(Kb, Vb, kt, Kf, Vf);
        __syncthreads();
        for (int s = 63; s >= 0; --s) {
            float z = 0.f;
#pragma unroll
            for (int d = 0; d < 64; ++d) z += q[d] * Kf[s * 64 + d];
            const float ls = fminf(z, 0.f) - __logf(1.0f + __expf(-fabsf(z)));
            const bool act = (kt * 64 + s) < t;
            const float A = act ? __expf(ls + tail) : 0.f;
#pragma unroll
            for (int d = 0; d < 64; ++d) o[d] += A * Vf[s * 64 + d];
            tail += act ? (ls - z) : 0.f;
        }
        if (__syncthreads_and(tail < -100.f)) break;
    }
    bf16_t* op = MIX + ((size_t)b * SEQ + t) * DM + 256 + h * 64;
#pragma unroll
    for (int c = 0; c < 8; ++c) { u32x4 w; w.x = pk2(o[c * 8], o[c * 8 + 1]); w.y = pk2(o[c * 8 + 2], o[c * 8 + 3]); w.z = pk2(o[c * 8 + 4], o[c * 8 + 5]); w.w = pk2(o[c * 8 + 6], o[c * 8 + 7]); *(u32x4*)(op + c * 8) = w; }
}

__device__ __forceinline__ void hgrn_naive_item(int item, unsigned char* P, bf16_t* MIX, const float* hgn, LAS float* lds) {
    int tid_ = threadIdx.x; asm volatile("" : "+v"(tid_)); const int tid = tid_, lane = tid & 63, w = tid >> 6, kg = lane >> 3, vi = lane & 7, vcol = 8 * w + vi, b = item >> 2, h = item & 3;
    const bf16_t* HQ = (const bf16_t*)(P + P_HQ); const bf16_t* HK = (const bf16_t*)(P + P_HK); const bf16_t* HI = (const bf16_t*)(P + P_HI); const bf16_t* HG = (const bf16_t*)(P + P_HG);
    const float* HLF = (const float*)(P + P_HLF);
    LAS float* qf = lds; LAS float* kf = lds + 4096; LAS float* ff = lds + 8192; LAS float* vf = lds + 12288; LAS float* ob = lds + 16384;
    float S[8];
#pragma unroll
    for (int j = 0; j < 8; ++j) S[j] = 0.f;
    const int tok = tid >> 3, c8 = tid & 7;
    float gn[8];
#pragma unroll
    for (int e = 0; e < 8; ++e) gn[e] = hgn[c8 * 8 + e];
    for (int c = 0; c < 64; ++c) {
        const size_t off = ((size_t)b * SEQ + c * 64 + tok) * 256 + h * 64 + c8 * 8;
        __syncthreads();
        {
            float a[8];
            unpack8(*(const u32x4*)(HQ + off), a);
#pragma unroll
            for (int e = 0; e < 8; ++e) qf[tok * 64 + c8 * 8 + e] = a[e];
            unpack8(*(const u32x4*)(HK + off), a);
#pragma unroll
            for (int e = 0; e < 8; ++e) kf[tok * 64 + c8 * 8 + e] = a[e];
            unpack8(*(const u32x4*)(HI + off), a);
#pragma unroll
            for (int e = 0; e < 8; ++e) vf[tok * 64 + c8 * 8 + e] = a[e];
            const f32x4 l0 = *(const f32x4*)(HLF + off), l1 = *(const f32x4*)(HLF + off + 4);
#pragma unroll
            for (int e = 0; e < 4; ++e) { ff[tok * 64 + c8 * 8 + e] = expf(l0[e]); ff[tok * 64 + c8 * 8 + 4 + e] = expf(l1[e]); }
        }
        __syncthreads();
        for (int tk = 0; tk < 64; ++tk) {
            const float vv = vf[tk * 64 + vcol]; float op = 0.f;
#pragma unroll
            for (int j = 0; j < 8; ++j) { const int k = 8 * kg + j; S[j] = ff[tk * 64 + k] * S[j] + kf[tk * 64 + k] * vv; op += qf[tk * 64 + k] * S[j]; }
            op += __shfl_xor(op, 8); op += __shfl_xor(op, 16); op += __shfl_xor(op, 32);
            if (kg == 0) ob[tk * 64 + vcol] = op;
        }
        __syncthreads();
        {
            float ov[8], g[8]; float sq = 0.f;
#pragma unroll
            for (int e = 0; e < 8; ++e) { ov[e] = ob[tok * 64 + c8 * 8 + e]; sq += ov[e] * ov[e]; }
            sq += __shfl_xor(sq, 1); sq += __shfl_xor(sq, 2); sq += __shfl_xor(sq, 4);
            const float rn = rsqrtf(sq * (1.0f / 64.0f) + EPS);
            unpack8(*(const u32x4*)(HG + off), g);
            float r[8];
#pragma unroll
            for (int e = 0; e < 8; ++e) r[e] = ov[e] * rn * gn[e] * (g[e] / (1.0f + expf(-g[e])));
            u32x4 wv; wv.x = pk2(r[0], r[1]); wv.y = pk2(r[2], r[3]); wv.z = pk2(r[4], r[5]); wv.w = pk2(r[6], r[7]);
            *(u32x4*)(MIX + ((size_t)b * SEQ + c * 64 + tok) * DM + h * 64 + c8 * 8) = wv;
        }
    }
}

constexpr int HG_SLOT = 30720, HG_BP = 68  , HG_PRE = 64 * HG_BP * 4, HG_TOT = HG_PRE + 1280, HG_VT = 20480, HG_VP = 72;
static_assert(HG_TOT + 1024 <= HG_VT && HG_VT + 64 * HG_VP * 2 <= HG_SLOT, "HGRN LDS slot map");
typedef short hbf16x8 __attribute__((ext_vector_type(8)));
typedef short hbf16x4 __attribute__((ext_vector_type(4)));
__device__ __forceinline__ hbf16x8 pack8(const float* x) { u32x4 w; w.x = pk2(x[0], x[1]); w.y = pk2(x[2], x[3]); w.z = pk2(x[4], x[5]); w.w = pk2(x[6], x[7]); return __builtin_bit_cast(hbf16x8, w); }

__device__ __forceinline__ void hg_stage(int tid, size_t row0, int h, const float* HLF, const bf16_t* HI, LAS unsigned char* sb) {
    const int lt = tid & 127, k = lt & 63, half = lt >> 6;
    LAS float* bl = (LAS float*)sb; LAS float* pre = (LAS float*)(sb + HG_PRE); LAS float* tot = (LAS float*)(sb + HG_TOT); LAS bf16_t* vt = (LAS bf16_t*)(sb + HG_VT);
    float lfv[32];
#pragma unroll
    for (int i = 0; i < 32; ++i) lfv[i] = HLF[(row0 + 32 * half + i) * 256 + h * 64 + k];
    u32x4 vw[4];
    {
        const int s = lt & 63, c0 = half * 32;
#pragma unroll
        for (int q = 0; q < 4; ++q) vw[q] = *(const u32x4*)(HI + (row0 + s) * 256 + h * 64 + c0 + 8 * q);
    }
#pragma unroll
    for (int sg = 0; sg < 2; ++sg) { float run = 0.f;
#pragma unroll
        for (int i = 0; i < 16; ++i) { run += lfv[16 * sg + i]; bl[(32 * half + 16 * sg + i) * HG_BP + k] = run; }
        tot[(2 * half + sg) * 64 + k] = run; }
    {   const int s = lt & 63, c0 = half * 32;
#pragma unroll
        for (int q = 0; q < 4; ++q) { const unsigned ww[4] = {vw[q].x, vw[q].y, vw[q].z, vw[q].w};
#pragma unroll
            for (int e = 0; e < 4; ++e) { vt[(c0 + 8 * q + 2 * e) * HG_VP + s] = (bf16_t)(ww[e] & 0xffffu); vt[(c0 + 8 * q + 2 * e + 1) * HG_VP + s] = (bf16_t)(ww[e] >> 16); } } }
    __syncthreads();
    if (lt < 64) { float p = 0.f;
#pragma unroll
        for (int sg = 0; sg < 4; ++sg) { pre[sg * 64 + lt] = p; p += tot[sg * 64 + lt]; }
        pre[4 * 64 + lt] = p; }
    __syncthreads();
}

__device__ __forceinline__ void hgrn_a_item(int item, unsigned char* P, float* DD, LAS unsigned char* L) {
    int tid_ = threadIdx.x; asm volatile("" : "+v"(tid_)); const int tid = tid_, lane = tid & 63, wq = (tid >> 6) & 1, cs = tid >> 7, r = lane & 15, g = lane >> 4;
    const int bh = item >> 4, chunk = (item & 15) * 4 + cs, b = bh >> 2, h = bh & 3;
    const size_t row0 = (size_t)b * SEQ + chunk * 64;
    const bf16_t* HK = (const bf16_t*)(P + P_HK); bf16_t* UT = (bf16_t*)(P + P_US);
    LAS unsigned char* sb = L + cs * HG_SLOT;
    unsigned short kraw[2][2][8];
#pragma unroll
    for (int kt2 = 0; kt2 < 2; ++kt2)
#pragma unroll
        for (int ks = 0; ks < 2; ++ks)
#pragma unroll
            for (int j = 0; j < 8; ++j) kraw[kt2][ks][j] = HK[(row0 + 32 * ks + 8 * g + j) * 256 + h * 64 + 16 * (2 * wq + kt2) + r];
    hg_stage(tid, row0, h, (const float*)(P + P_HLF), (const bf16_t*)(P + P_HI), sb);
    const LAS float* bl = (const LAS float*)sb; const LAS float* pre = (const LAS float*)(sb + HG_PRE); const LAS unsigned char* vt = sb + HG_VT;
    bf16_t* ut = UT + ((size_t)(bh * 64 + chunk) * 64) * 64;
#pragma unroll
    for (int kt2 = 0; kt2 < 2; ++kt2) {
        const int kt = 2 * wq + kt2, k = 16 * kt + r; const float pre4 = pre[4 * 64 + k];
        hbf16x8 af[2];
#pragma unroll
        for (int ks = 0; ks < 2; ++ks) { const float pj = pre4 - pre[(2 * ks + (g >> 1)) * 64 + k]; float x[8];
#pragma unroll
            for (int j = 0; j < 8; ++j) { const int s = 32 * ks + 8 * g + j; x[j] = bf2f(kraw[kt2][ks][j]) * __expf(pj - bl[s * HG_BP + k]); }
            af[ks] = pack8(x); }
#pragma unroll
        for (int vtile = 0; vtile < 4; ++vtile) { f32x4 acc = {0.f, 0.f, 0.f, 0.f};
#pragma unroll
            for (int ks = 0; ks < 2; ++ks) { const hbf16x8 bf = *(const LAS hbf16x8*)(vt + (16 * vtile + r) * (HG_VP * 2) + (32 * ks + 8 * g) * 2); acc = __builtin_amdgcn_mfma_f32_16x16x32_bf16(af[ks], bf, acc, 0, 0, 0); }
            u32x2 w; w.x = pk2v(acc[0], acc[1]); w.y = pk2v(acc[2], acc[3]); *(u32x2*)(ut + (size_t)(16 * vtile + r) * 64 + 16 * kt + 4 * g) = w; }
        if (g == 0) DD[(size_t)(bh * 64 + chunk) * 64 + k] = __expf(pre4);
    }
}

__device__ __forceinline__ void hgrn_b_scan(int bx, int G, unsigned char* P, const float* DD) {
    int tid_ = threadIdx.x; asm volatile("" : "+v"(tid_));
    typedef float f32x2s __attribute__((ext_vector_type(2)));
    unsigned* UT = (unsigned*)(P + P_US);
    for (int gid = bx * 512 + tid_; gid < 32 * 2048; gid += G * 512) {
        const int bh = gid >> 11, e2 = gid & 2047; unsigned* u = UT + (size_t)bh * 64 * 2048 + e2; const f32x2s* dd = (const f32x2s*)(DD + (size_t)bh * 64 * 64) + (e2 & 31);
        float S0 = 0.f, S1 = 0.f;
        for (int c0 = 0; c0 < 64; c0 += 32) { unsigned tu[32]; f32x2s td[32];
#pragma unroll
            for (int i = 0; i < 32; ++i) { tu[i] = u[(size_t)(c0 + i) * 2048]; td[i] = dd[(c0 + i) * 32]; }
#pragma unroll
            for (int i = 0; i < 32; ++i) { u[(size_t)(c0 + i) * 2048] = pk2(S0, S1); S0 = td[i][0] * S0 + bflo(tu[i]); S1 = td[i][1] * S1 + bfhi(tu[i]); } }
    }
}

__device__ __forceinline__ void hgrn_c_item(int item, unsigned char* P, bf16_t* MIX, const float* hgn, LAS unsigned char* L) {
    int tid_ = threadIdx.x; asm volatile("" : "+v"(tid_)); const int tid = tid_, lane = tid & 63, wq = (tid >> 6) & 1, cs = tid >> 7, r = lane & 15, g = lane >> 4;
    const int bh = item >> 4, chunk = (item & 15) * 4 + cs, b = bh >> 2, h = bh & 3;
    const size_t row0 = (size_t)b * SEQ + chunk * 64;
    const bf16_t* HQ = (const bf16_t*)(P + P_HQ); const bf16_t* HK = (const bf16_t*)(P + P_HK); const bf16_t* HG = (const bf16_t*)(P + P_HG); const bf16_t* ST = (const bf16_t*)(P + P_US);
    LAS unsigned char* sb = L + cs * HG_SLOT;
    u32x4 qraw[2][2], kraw[4][2], sraw[4][2];
    const bf16_t* st = ST + ((size_t)(bh * 64 + chunk) * 64) * 64;
#pragma unroll
    for (int ks = 0; ks < 2; ++ks) {
#pragma unroll
        for (int ii = 0; ii < 2; ++ii) { const int I = ii ? (wq ? 2 : 3) : (wq ? 1 : 0); qraw[ii][ks] = *(const u32x4*)(HQ + (row0 + 16 * I + r) * 256 + h * 64 + 32 * ks + 8 * g); }
#pragma unroll
        for (int J = 0; J < 4; ++J) kraw[J][ks] = *(const u32x4*)(HK + (row0 + 16 * J + r) * 256 + h * 64 + 32 * ks + 8 * g);
#pragma unroll
        for (int vtile = 0; vtile < 4; ++vtile) sraw[vtile][ks] = *(const u32x4*)(st + (size_t)(16 * vtile + r) * 64 + 32 * ks + 8 * g); }
    hg_stage(tid, row0, h, (const float*)(P + P_HLF), (const bf16_t*)(P + P_HI), sb);
    const LAS float* bl = (const LAS float*)sb; const LAS float* pre = (const LAS float*)(sb + HG_PRE); const LAS unsigned char* vt = sb + HG_VT;
    hbf16x8 sfr[4][2];
#pragma unroll
    for (int vtile = 0; vtile < 4; ++vtile)
#pragma unroll
        for (int ks = 0; ks < 2; ++ks) sfr[vtile][ks] = __builtin_bit_cast(hbf16x8, sraw[vtile][ks]);
#pragma unroll
    for (int ii = 0; ii < 2; ++ii) {
        const int I = ii ? (wq ? 2 : 3) : (wq ? 1 : 0), t = 16 * I + r;
        unsigned short graw[4][4];
#pragma unroll
        for (int i = 0; i < 4; ++i)
#pragma unroll
            for (int vtile = 0; vtile < 4; ++vtile) graw[i][vtile] = HG[(row0 + 16 * I + 4 * g + i) * 256 + h * 64 + 16 * vtile + r];
        hbf16x8 qtf[2], qhf[2];
#pragma unroll
        for (int ks = 0; ks < 2; ++ks) { const int kb = 32 * ks + 8 * g; float q[8], xt[8], xh[8];
            unpack8(qraw[ii][ks], q);
#pragma unroll
            for (int j = 0; j < 8; ++j) { xt[j] = q[j] * __expf(bl[t * HG_BP + kb + j]); xh[j] = xt[j] * __expf(pre[I * 64 + kb + j]); }
            qtf[ks] = pack8(xt); qhf[ks] = pack8(xh); }
        f32x4 at[4];
#pragma unroll
        for (int J = 0; J < 4; ++J) { at[J] = (f32x4){0.f, 0.f, 0.f, 0.f};
            if (J <= I) { const int s = 16 * J + r;
#pragma unroll
                for (int ks = 0; ks < 2; ++ks) { const int kb = 32 * ks + 8 * g; float kk[8], x[8];
                    unpack8(kraw[J][ks], kk);
#pragma unroll
                    for (int j = 0; j < 8; ++j) x[j] = kk[j] * __expf(fminf(pre[I * 64 + kb + j] - pre[J * 64 + kb + j] - bl[s * HG_BP + kb + j], 80.f));
                    at[J] = __builtin_amdgcn_mfma_f32_16x16x32_bf16(pack8(x), qtf[ks], at[J], 0, 0, 0); }
                if (J == I) {
#pragma unroll
                    for (int i = 0; i < 4; ++i) at[J][i] = (4 * g + i <= r) ? at[J][i] : 0.f; } } }
        hbf16x8 pf[2];
#pragma unroll
        for (int k2 = 0; k2 < 2; ++k2) { const float x[8] = {at[2 * k2][0], at[2 * k2][1], at[2 * k2][2], at[2 * k2][3], at[2 * k2 + 1][0], at[2 * k2 + 1][1], at[2 * k2 + 1][2], at[2 * k2 + 1][3]}; { u32x4 w_; w_.x = pk2v(x[0], x[1]); w_.y = pk2v(x[2], x[3]); w_.z = pk2v(x[4], x[5]); w_.w = pk2v(x[6], x[7]); pf[k2] = __builtin_bit_cast(hbf16x8, w_); } }
        f32x4 o[4];
#pragma unroll
        for (int vtile = 0; vtile < 4; ++vtile) { f32x4 acc = {0.f, 0.f, 0.f, 0.f}; const int v = 16 * vtile + r;
#pragma unroll
            for (int ks = 0; ks < 2; ++ks) acc = __builtin_amdgcn_mfma_f32_16x16x32_bf16(qhf[ks], sfr[vtile][ks], acc, 0, 0, 0);
#pragma unroll
            for (int k2 = 0; k2 < 2; ++k2) { if (k2 == 0 || I >= 2) {
                const hbf16x4 v0 = *(const LAS hbf16x4*)(vt + v * (HG_VP * 2) + (32 * k2 + 4 * g) * 2), v1 = *(const LAS hbf16x4*)(vt + v * (HG_VP * 2) + (32 * k2 + 16 + 4 * g) * 2);
                const hbf16x8 vf = {v0[0], v0[1], v0[2], v0[3], v1[0], v1[1], v1[2], v1[3]};
                acc = __builtin_amdgcn_mfma_f32_16x16x32_bf16(pf[k2], vf, acc, 0, 0, 0); } }
            o[vtile] = acc; }
#pragma unroll
        for (int i = 0; i < 4; ++i) { float sq = 0.f;
#pragma unroll
            for (int vtile = 0; vtile < 4; ++vtile) sq += o[vtile][i] * o[vtile][i];
            sq += __shfl_xor(sq, 1); sq += __shfl_xor(sq, 2); sq += __shfl_xor(sq, 4); sq += __shfl_xor(sq, 8);
            const float rn = rsqrtf(sq * (1.0f / 64.0f) + EPS); const size_t row = row0 + 16 * I + 4 * g + i;
#pragma unroll
            for (int vtile = 0; vtile < 4; ++vtile) { const int v = 16 * vtile + r; const float gg = bf2f(graw[i][vtile]);
                MIX[row * DM + h * 64 + v] = (bf16_t)f2bf(o[vtile][i] * rn * hgn[v] * (gg / (1.0f + __expf(-gg)))); } }
    }
}

struct Args { const float* in[14]; float* out; unsigned char* ws; int ph_lo, ph_hi; };
constexpr int NPHASE = 1 + 9 * DEPTH;

__global__ void __launch_bounds__(512, 2) fwd(Args a) {
    extern __shared__ __attribute__((aligned(16))) unsigned char lds[];
    cg::grid_group grid = cg::this_grid();
    LAS unsigned char* L = (LAS unsigned char*)lds;
    if (threadIdx.x < 32) ((LAS unsigned*)(L + LDS_BYTES - 128))[threadIdx.x] = 0u;
    __syncthreads();
    for (int ph = a.ph_lo; ph < a.ph_hi; ++ph) {
        int G = gridDim.x, bx = blockIdx.x; asm volatile("" : "+s"(G), "+s"(bx));
        typedef const __attribute__((address_space(4))) Args* KArgP;
        KArgP ap = (KArgP)__builtin_amdgcn_kernarg_segment_ptr(); asm volatile("" : "+s"(ap));
        unsigned char* ws = ap->ws;
        float* SS = (float*)(ws + WS_SS); float* LB = (float*)(ws + WS_LB);
        bf16_t* XB = (bf16_t*)(ws + WS_XB); bf16_t* MIX = (bf16_t*)(ws + WS_MIX); bf16_t* UB = (bf16_t*)(ws + WS_U);
        unsigned char* P = ws + WS_P;
#ifdef PROBE_T
        if (ph == NPHASE) {
            if (bx == 0) { const unsigned long long* ts_ = (const unsigned long long*)(ws + 65536); unsigned long long sa = 0, sb = 0;
                for (int p = 1; p < NPHASE; ++p) { const int kk_ = (p - 1) % 7; const unsigned long long d = ts_[p] - ts_[p - 1]; if (PROBE_A(kk_)) sa += d; if (PROBE_B(kk_)) sb += d; }
                const float fa = (float)sa * 1e-3f, fb = (float)sb * 1e-3f; float* o_ = ap->out;
                for (int i = threadIdx.x; i < (1 << 20); i += 512) o_[(1 << 20) + i] += fb;
                if (threadIdx.x == 0) o_[0] = fa; }
        } else
#endif
        if (ph == 0) {
            int tid = threadIdx.x; asm volatile("" : "+v"(tid)); const int lane = tid & 63, wave = __builtin_amdgcn_readfirstlane(tid >> 6);
            LAS float* scr = (LAS float*)(L + wave * 16384);
            const int gw = bx * 8 + wave, NGW = G * 8;
            constexpr int I_IN = 16 * 112, I_OUT = 16 * 32, I_1 = 16 * 128, I_2 = 64 * 32, I_L = I_IN + I_OUT + I_1 + I_2;
            for (int it = gw; it < DEPTH * I_L; it += NGW) {
                const int l = it / I_L; int r = it % I_L;
                unsigned char* wl = ws + WS_W + (size_t)l * W_LAYER;
                if (r < I_IN) { const int kb = r / 112, nb = r % 112, n0 = nb * 32, pn = n0 >> 8, p = n0 & 255, slot = 4 * pn + ((p & 127) >> 5), sc0 = 64 * slot + 32 * (p >> 7);
                    tr_item(ap->in[3] + (size_t)l * DM * INC, INC, INC, sc0, kb * 64, ap->in[2] + l * DM, (bf16_t*)wl, DM, n0, scr, lane); continue; }
                r -= I_IN;
                if (r < I_OUT) { const int kb = r / 32, nb = r % 32; tr_item(ap->in[10] + (size_t)l * DM * DM, DM, DM, nb * 32, kb * 64, nullptr, (bf16_t*)(wl + W_OUT), DM, nb * 32, scr, lane); continue; }
                r -= I_OUT;
                if (r < I_1) { const int kb = r / 128, nb = r % 128; tr_item(ap->in[12] + (size_t)l * DM * DFF, DFF, DFF, nb * 32, kb * 64, ap->in[11] + l * DM, (bf16_t*)(wl + W_1), DM, nb * 32, scr, lane); continue; }
                r -= I_1;
                { const int kb = r / 32, nb = r % 32; tr_item(ap->in[13] + (size_t)l * DFF * DM, DM, DM, nb * 32, kb * 64, nullptr, (bf16_t*)(wl + W_2), DFF, nb * 32, scr, lane); }
            }
            const float* x = ap->in[0];
            for (int m0 = gw; m0 < M; m0 += 4 * NGW) {
                f32x4 v[4][4]; float s[4];
#pragma unroll
                for (int q = 0; q < 4; ++q) { const int m = m0 + q * NGW; const f32x4* xr = (const f32x4*)(x + (size_t)(m < M ? m : gw) * DM) + lane;
#pragma unroll
                    for (int j = 0; j < 4; ++j) v[q][j] = xr[64 * j]; }
#pragma unroll
                for (int q = 0; q < 4; ++q) { s[q] = 0.f;
#pragma unroll
                    for (int j = 0; j < 4; ++j) s[q] += (v[q][j][0] * v[q][j][0] + v[q][j][1] * v[q][j][1]) + (v[q][j][2] * v[q][j][2] + v[q][j][3] * v[q][j][3]); }
#pragma unroll
                for (int q = 0; q < 4; ++q) { const int m = m0 + q * NGW; const float tot = wave_sum(s[q]);
                    if (m < M) { u32x2* o8 = (u32x2*)(XB + (size_t)m * DM) + lane;
#pragma unroll
                        for (int j = 0; j < 4; ++j) { u32x2 w; w.x = pk2(v[q][j][0], v[q][j][1]); w.y = pk2(v[q][j][2], v[q][j][3]); o8[64 * j] = w; }
                        if (lane < 16) SS[(size_t)m * 16 + lane] = (lane == 0) ? tot : 0.f; } }
            }
            if (bx == 2 && tid < 64) ((unsigned*)ws)[tid] = 0u;
            if (bx == 3) for (int i = tid; i < XCD_BAR_WORDS; i += 512) ((unsigned*)(ws + WS_BAR))[i] = 0u;
            if (bx == 1) {
                for (int i = tid; i < 1024; i += 512) { const int l = i >> 8, wh = (i >> 6) & 3, d = i & 63; LB[2048 + i] = ap->in[5 + wh][l * 64 + d]; }
                if (tid < 32) { const int l = tid >> 3, e = tid & 7; LB[3072 + tid] = (e < 6) ? ap->in[9][l * 6 + e] : 0.f; }
            }
            if (bx == 0 && tid < 256) {
                const float* lg = ap->in[1]; float e[DEPTH]; float mx = -1e30f, sum = 0.f;
#pragma unroll
                for (int l = 0; l < DEPTH; ++l) mx = fmaxf(mx, lg[l * 256 + tid]);
#pragma unroll
                for (int l = 0; l < DEPTH; ++l) { e[l] = expf(lg[l * 256 + tid] - mx); sum += e[l]; }
                float c = 0.f;
#pragma unroll
                for (int l = 0; l < DEPTH; ++l) { if (l > 0) c += e[l] / sum; LB[l * 512 + tid] = logf(fmaxf(c, 1e-30f)); LB[l * 512 + 256 + tid] = 1.0f - c; }
            }
        } else {
            const int l = (ph - 1) / 9, k = (ph - 1) % 9;
#ifdef REP_K
            const int nrep = (k == REP_K) ? 2 : 1;
#else
            const int nrep = 1;
#endif
            for (int rep = 0; rep < nrep; ++rep) {
            if (rep) { XcdBarrier xb_; xb_.bar = (unsigned*)(ws + WS_BAR); xb_.x = xb_xcc_id(); xb_.st = (volatile LAS unsigned*)(L + LDS_BYTES - 128); xcd_barrier(xb_); }
            unsigned char* wl = ws + WS_W + (size_t)l * W_LAYER;
            if (k == 0) {
                pg8::Gemm g{XB, (const bf16_t*)wl, M, NIN, DM}; pg8::StaticOrder S; S.init(M, NIN, G, bx);
                EpiInProj E{SS, P, LB + l * 512, LB + 2048 + l * 256, LB + 3072 + l * 8};
                pg8::gemm_phase<EpiInProj, pg8::StaticOrder, true, true>(L, g, S, E);
            } else if (k == 1) {
                int tid = threadIdx.x; asm volatile("" : "+v"(tid));
                unsigned* ctr = (unsigned*)ws + l * 16 + 1 + rep * 4;
                volatile LAS int* sh = (volatile LAS int*)(L + LDS_BYTES - 64);
                int nxt = 0; if (tid == 0) nxt = (int)atomicAdd(ctr, 1u);
                for (;;) {
                    if (tid == 0) sh[0] = nxt;
                    __syncthreads();
                    const int idx = __builtin_amdgcn_readfirstlane(sh[0]);
                    __syncthreads();
                    if (idx >= 816 + 512) break;
                    if (tid == 0) nxt = (int)atomicAdd(ctr, 1u);
                    if (idx < 768) { const int qb = 15 - idx / 48, bh = idx % 48, b = bh / 6, h = bh % 6; typedef attn_body::bf16 abf;
                        attn_body::sb_unit(qb, (const abf*)(P + P_SQ) + (size_t)bh * SEQ * 64, (const abf*)(P + P_SQ + HEADBUF) + (size_t)bh * SEQ * 64, (const abf*)(P + P_SQ + 2 * HEADBUF) + (size_t)bh * SEQ * 64,
                                           (abf*)MIX + (size_t)b * SEQ * DM + 256 + h * 64, (char*)lds); }
                    else if (idx < 816) fox_cumsum_item(idx - 768, (const float*)(P + P_LF), (float*)(P + P_CC), (int*)(ws + WS_JS), LB + 2048 + l * 256 + 128, LB + 2048 + l * 256 + 192, (LAS float*)L);
                    else hgrn_a_item(idx - 816, P, (float*)(ws + WS_DD), L);
                    __syncthreads();
                }
            } else if (k == 2) {
                hgrn_b_scan(bx, G, P, (const float*)(ws + WS_DD));
            } else if (k == 3) {
                int tid = threadIdx.x; asm volatile("" : "+v"(tid));
                unsigned* ctr = (unsigned*)ws + l * 16 + rep * 4;
                volatile LAS int* sh = (volatile LAS int*)(L + LDS_BYTES - 64);
                int nxt = 0; if (tid == 0) nxt = (int)atomicAdd(ctr, 1u);
                for (;;) {
                    if (tid == 0) sh[0] = nxt;
                    __syncthreads();
                    const int idx = __builtin_amdgcn_readfirstlane(sh[0]);
                    __syncthreads();
#ifdef PROBE_FOX
                    if (idx >= 768 + 512 || (rep && idx >= 768)) break;
#else
                    if (idx >= 768 + 512) break;
#endif
                    if (tid == 0) nxt = (int)atomicAdd(ctr, 1u);
                    if (idx >= 768) { hgrn_c_item(idx - 768, P, MIX, ap->in[4] + l * 64, L); __syncthreads(); continue; }
                    const int qb = 15 - idx / 48, bh = idx % 48, b = bh / 6, h = bh % 6;
                    typedef attn_body::bf16 abf;
                    const int jstart = ((const int*)(ws + WS_JS))[bh * 16 + qb];
#ifdef PROBE_FOX
                    if (rep) attn_body::attn_unit<30, PROBE_FOX_BIAS>(qb, PROBE_FOX_JS(jstart), (const abf*)(P + P_FQ) + (size_t)bh * SEQ * 64, (const abf*)(P + P_FQ + HEADBUF) + (size_t)bh * SEQ * 64, (const abf*)(P + P_FQ + 2 * HEADBUF) + (size_t)bh * SEQ * 64,
                                            (abf*)ap->out + (size_t)b * SEQ * DM + 640 + h * 64, (const float*)(P + P_CC) + (size_t)bh * SEQ, (char*)lds);
                    else
#endif
                    attn_body::attn_unit<30>(qb, jstart, (const abf*)(P + P_FQ) + (size_t)bh * SEQ * 64, (const abf*)(P + P_FQ + HEADBUF) + (size_t)bh * SEQ * 64, (const abf*)(P + P_FQ + 2 * HEADBUF) + (size_t)bh * SEQ * 64,
                                            (abf*)MIX + (size_t)b * SEQ * DM + 640 + h * 64, (const float*)(P + P_CC) + (size_t)bh * SEQ, (char*)lds);
                }
            } else if (k == 5 || k == 7) {
                const size_t r0 = (k == 7) ? (size_t)(M / 2) : 0;
                pg8::Gemm g{XB + r0 * DM, (const bf16_t*)(wl + W_1), M / 2, DFF, DM}; pg8::StaticOrder S; S.init(M / 2, DFF, G, bx);
                EpiRelu2 E{UB, SS + r0 * 16};
                pg8::gemm_phase<EpiRelu2, pg8::StaticOrder, true, true>(L, g, S, E);
            } else {
                const bool ff2 = (k != 4); const size_t r0 = (k == 8) ? (size_t)(M / 2) : 0;
                pg8::Gemm g{ff2 ? UB : MIX, (const bf16_t*)(wl + (ff2 ? W_2 : W_OUT)), ff2 ? M / 2 : M, DM, ff2 ? DFF : DM}; pg8::StaticOrder S; S.init(ff2 ? M / 2 : M, DM, G, bx);
                EpiResid E{XB + r0 * DM, (ff2 && l == DEPTH - 1) ? ap->out + r0 * DM : nullptr, SS + r0 * 16};
                pg8::gemm_phase<EpiResid, pg8::StaticOrder, true, true>(L, g, S, E);
            }
            }
        }
#ifdef PROBE_T
        if (bx == 0 && threadIdx.x == 0) ((unsigned long long*)(ws + 65536))[ph] = __builtin_amdgcn_s_memrealtime();
#endif
        if (ph + 1 < a.ph_hi) {
            if (ph == 0) {
                grid.sync();
                (void)xcd_barrier_post((unsigned*)(ws + WS_BAR), (volatile LAS unsigned*)(L + LDS_BYTES - 128));
            } else {
                XcdBarrier xb_; xb_.bar = (unsigned*)(ws + WS_BAR); xb_.x = xb_xcc_id(); xb_.st = (volatile LAS unsigned*)(L + LDS_BYTES - 128);
                xcd_barrier(xb_);
            }
        }
    }
}

#ifndef MK_MULTI
#define MK_MULTI 0
#endif
extern "C" void kernel_launch(void* const* d_in, const int* in_sizes, int n_in, void* d_out, int out_size, void* d_ws, size_t ws_size, hipStream_t stream) {
    static int grid = 0;
    if (grid == 0) {
        int dev = 0, cus = 0, per = 0;
        if (n_in != 14 || out_size != M * DM || ws_size < WS_END) { fprintf(stderr, "kernel_launch: unexpected shapes (n_in %d out %d ws %zu)\n", n_in, out_size, ws_size); grid = -1; return; }
        (void)hipGetDevice(&dev); (void)hipDeviceGetAttribute(&cus, hipDeviceAttributeMultiprocessorCount, dev);
        (void)hipFuncSetAttribute((const void*)fwd, hipFuncAttributeMaxDynamicSharedMemorySize, LDS_BYTES);
        (void)hipOccupancyMaxActiveBlocksPerMultiprocessor(&per, (const void*)fwd, 512, LDS_BYTES);
        if (per < 1) per = 1;
        grid = cus * per;
        fprintf(stderr, "kernel_launch: grid %d (cus %d x %d)\n", grid, cus, per);
    }
    if (grid < 0) return;
    Args a{};
    for (int i = 0; i < 14; ++i) a.in[i] = (const float*)d_in[i];
    a.out = (float*)d_out; a.ws = (unsigned char*)d_ws;
#if MK_MULTI
    for (int ph = 0; ph < NPHASE; ++ph) { a.ph_lo = ph; a.ph_hi = ph + 1; hipLaunchKernelGGL(fwd, dim3(grid), dim3(512), LDS_BYTES, stream, a); }
#else
#ifdef PROBE_T
    a.ph_lo = 0; a.ph_hi = NPHASE + 1;
#else
    a.ph_lo = 0; a.ph_hi = NPHASE;
#endif
    void* args[] = {&a};
    hipError_t e = hipLaunchCooperativeKernel((const void*)fwd, dim3(grid), dim3(512), args, LDS_BYTES, stream);
    if (e != hipSuccess) fprintf(stderr, "kernel_launch: cooperative launch failed: %s (grid %d)\n", hipGetErrorString(e), grid);
#endif
}
```
